# Optimizing an MI355X kernel written in HIP

```python
import math
import jax, jax.numpy as jnp
from jax import lax
import numpy as np

D_MODEL = 1024
BATCH = 8
SEQ = 2048
DEPTH = 1

NSA_HEADS = 8
NSA_KV_GROUPS = 2
NSA_REP = NSA_HEADS // NSA_KV_GROUPS
NSA_DH = 64
CMP_LEN = 32
CMP_STRIDE = 16
CMP_HIDDEN = 256
SLC_BLOCK = 64
SLC_TOP_N = 16
WINDOW = 512
NSA_Q_CHUNK = 64

MLA_HEADS = 8
MLA_Q_RANK = 256
MLA_KV_RANK = 128
MLA_NOPE = 64
MLA_ROPE = 32
MLA_V = 64
MLA_Q_BLOCK = 128
ROPE_THETA = 10000.0

T5_BUCKETS = 32
T5_MAX_DIST = 128

PEER_HEADS = 8
PEER_N_KEYS = 128
PEER_N_EXPERTS = PEER_N_KEYS * PEER_N_KEYS
PEER_KEY_DIM = 128
PEER_TOPK = 16
PEER_TOKEN_CHUNK = 128

NORM_EPS = 1e-6
MASK_VALUE = -1e30
FORCE_BONUS = 1e4

NSA_Q_COLS = NSA_HEADS * NSA_DH
NSA_KV_COLS = 6 * NSA_KV_GROUPS * NSA_DH
NSA_GATE_COLS = 3 * NSA_HEADS
MERGE_GATE_COLS = 2 * D_MODEL
IN_SPLITS = (NSA_Q_COLS, NSA_KV_COLS, NSA_GATE_COLS, MLA_Q_RANK, MLA_KV_RANK, MLA_ROPE, MERGE_GATE_COLS)
IN_COLS = sum(IN_SPLITS)

kernel_name = "hybrid_nsa_mla_peer_layer"


def rmsnorm(x, g):
    xf = x.astype(jnp.float32)
    y = xf * lax.rsqrt(jnp.mean(xf * xf, axis=-1, keepdims=True) + NORM_EPS)
    return y.astype(x.dtype) * g


def masked_softmax(logits, mask, axis):
    logits = jnp.where(mask, logits.astype(jnp.float32), MASK_VALUE)
    m = jnp.max(logits, axis=axis, keepdims=True)
    e = jnp.exp(logits - m) * mask
    return e / jnp.maximum(jnp.sum(e, axis=axis, keepdims=True), 1e-30)


def t5_bucket(n):
    n = jnp.maximum(n, 0)
    max_exact = T5_BUCKETS // 2
    ratio = jnp.maximum(n, max_exact).astype(jnp.float32) / max_exact
    large = max_exact + (jnp.log(ratio) / math.log(T5_MAX_DIST / max_exact)
                         * (T5_BUCKETS - max_exact)).astype(jnp.int32)
    large = jnp.minimum(large, T5_BUCKETS - 1)
    return jnp.where(n < max_exact, n, large)


def split_cols(a, sizes):
    offsets = np.cumsum(np.array(sizes))[:-1].tolist()
    return jnp.split(a, offsets, axis=-1)


def apply_rope(x, cos, sin):
    half = x.shape[-1] // 2
    x1, x2 = x[..., :half], x[..., half:]
    return jnp.concatenate([x1 * cos - x2 * sin, x2 * cos + x1 * sin], axis=-1)


def nsa_mixer(q, kv, gate_logits, t5_bias, cmp_pos_k, cmp_pos_v,
              cmp_k_w1, cmp_k_w2, cmp_v_w1, cmp_v_w2):
    B, S, _ = q.shape
    G, R, Dh = NSA_KV_GROUPS, NSA_REP, NSA_DH
    scale = Dh ** -0.5
    q = q.reshape(B, S, G, R, Dh)
    kv = kv.reshape(B, S, 6, G, Dh)
    k_cr, v_cr, k_slc, v_slc, k_win, v_win = [kv[:, :, i] for i in range(6)]
    t5_gr = t5_bias.reshape(T5_BUCKETS, G, R)
    pos = jnp.arange(S, dtype=jnp.int32)

    NC = (S - CMP_LEN) // CMP_STRIDE + 1
    cmp_start = jnp.arange(NC, dtype=jnp.int32) * CMP_STRIDE
    cmp_tok = cmp_start[:, None] + jnp.arange(CMP_LEN, dtype=jnp.int32)[None, :]

    def compress(src, pos_emb, w1, w2):
        blk = src[:, cmp_tok] + pos_emb[None, None, :, None, :]
        blk = blk.transpose(0, 1, 3, 2, 4).reshape(B, NC, G, CMP_LEN * Dh)
        return jax.nn.gelu(blk @ w1, approximate=False) @ w2

    k_c = compress(k_cr, cmp_pos_k, cmp_k_w1, cmp_k_w2)
    v_c = compress(v_cr, cmp_pos_v, cmp_v_w1, cmp_v_w2)
    cmp_end = cmp_start + CMP_LEN - 1
    dist_c = pos[:, None] - cmp_end[None, :]
    mask_c = dist_c >= 0
    bias_c = t5_gr[t5_bucket(dist_c)].transpose(2, 3, 0, 1)
    logit_c = jnp.einsum('bsgrd,bcgd->bgrsc', q, k_c).astype(jnp.float32) * scale + bias_c
    p_c = masked_softmax(logit_c, mask_c, -1)
    o_cmp = jnp.einsum('bgrsc,bcgd->bsgrd', p_c.astype(v_c.dtype), v_c)

    NB = S // SLC_BLOCK
    blk_start = jnp.arange(NB, dtype=jnp.int32) * SLC_BLOCK
    overlap = ((cmp_start[:, None] < blk_start[None, :] + SLC_BLOCK)
               & (cmp_start[:, None] + CMP_LEN > blk_start[None, :])).astype(jnp.float32)
    imp = jnp.einsum('bgrsc,cn->bgsn', p_c, overlap)
    cur = pos // SLC_BLOCK
    j = jnp.arange(NB, dtype=jnp.int32)
    forced = (j[None, :] == 0) | (j[None, :] == cur[:, None]) | (j[None, :] == cur[:, None] - 1)
    future = blk_start[None, :] > pos[:, None]
    score = jnp.where(future, -1.0, jnp.where(forced, FORCE_BONUS, imp))
    top_n = min(SLC_TOP_N, NB)
    _, sel_idx = lax.top_k(score, top_n)

    k_sb = k_slc.reshape(B, NB, SLC_BLOCK, G, Dh).transpose(0, 3, 1, 2, 4)
    v_sb = v_slc.reshape(B, NB, SLC_BLOCK, G, Dh).transpose(0, 3, 1, 2, 4)
    k_wp = jnp.pad(k_win, ((0, 0), (WINDOW, 0), (0, 0), (0, 0)))
    v_wp = jnp.pad(v_win, ((0, 0), (WINDOW, 0), (0, 0), (0, 0)))

    C = NSA_Q_CHUNK
    NQ = S // C
    q_ch = q.reshape(B, NQ, C, G, R, Dh).transpose(1, 0, 2, 3, 4, 5)
    idx_ch = sel_idx.reshape(B, G, NQ, C, top_n).transpose(2, 0, 1, 3, 4)
    b_ix = jnp.arange(B)[:, None, None, None]
    g_ix = jnp.arange(G)[None, :, None, None]
    g_ix5 = jnp.arange(G)[None, :, None, None, None]

    def chunk_fn(args):
        c, qc, idx = args
        t = c * C + jnp.arange(C, dtype=jnp.int32)
        ks = k_sb[b_ix, g_ix, idx]
        vs = v_sb[b_ix, g_ix, idx]
        kpos = idx[..., None] * SLC_BLOCK + jnp.arange(SLC_BLOCK, dtype=jnp.int32)
        d_s = t[None, None, :, None, None] - kpos
        bias_s = jnp.moveaxis(t5_gr[t5_bucket(d_s), g_ix5], -1, 2)
        logit_s = jnp.einsum('bcgrd,bgcnkd->bgrcnk', qc, ks).astype(jnp.float32) * scale + bias_s
        p_s = masked_softmax(logit_s, (d_s >= 0)[:, :, None], (-2, -1))
        o_s = jnp.einsum('bgrcnk,bgcnkd->bcgrd', p_s.astype(vs.dtype), vs)
        kw = lax.dynamic_slice_in_dim(k_wp, c * C, WINDOW + C, axis=1)
        vw = lax.dynamic_slice_in_dim(v_wp, c * C, WINDOW + C, axis=1)
        wpos = c * C - WINDOW + jnp.arange(WINDOW + C, dtype=jnp.int32)
        d_w = t[:, None] - wpos[None, :]
        mask_w = (d_w >= 0) & (d_w < WINDOW) & (wpos[None, :] >= 0)
        bias_w = t5_gr[t5_bucket(d_w)].transpose(2, 3, 0, 1)
        logit_w = jnp.einsum('bcgrd,bkgd->bgrck', qc, kw).astype(jnp.float32) * scale + bias_w
        p_w = masked_softmax(logit_w, mask_w, -1)
        o_w = jnp.einsum('bgrck,bkgd->bcgrd', p_w.astype(vw.dtype), vw)
        return o_s, o_w

    o_slc, o_win = lax.map(chunk_fn, (jnp.arange(NQ, dtype=jnp.int32), q_ch, idx_ch))
    o_slc = o_slc.transpose(1, 0, 2, 3, 4, 5).reshape(B, S, G, R, Dh)
    o_win = o_win.transpose(1, 0, 2, 3, 4, 5).reshape(B, S, G, R, Dh)

    gate = jax.nn.sigmoid(gate_logits.astype(jnp.float32)).astype(q.dtype).reshape(B, S, G, R, 3)
    o = gate[..., 0:1] * o_cmp + gate[..., 1:2] * o_slc + gate[..., 2:3] * o_win
    return o.reshape(B, S, NSA_HEADS * Dh)


def mla_mixer(c_q_raw, c_kv_raw, k_rope_raw, q_norm_g, kv_norm_g, w_uq, w_ukv):
    B, S, _ = c_q_raw.shape
    H = MLA_HEADS
    q = (rmsnorm(c_q_raw, q_norm_g) @ w_uq).reshape(B, S, H, MLA_NOPE + MLA_ROPE)
    q_nope, q_rope = q[..., :MLA_NOPE], q[..., MLA_NOPE:]
    kv = (rmsnorm(c_kv_raw, kv_norm_g) @ w_ukv).reshape(B, S, H, MLA_NOPE + MLA_V)
    k_nope, v = kv[..., :MLA_NOPE], kv[..., MLA_NOPE:]

    inv_freq = ROPE_THETA ** (-jnp.arange(0, MLA_ROPE, 2, dtype=jnp.float32) / MLA_ROPE)
    ang = jnp.arange(S, dtype=jnp.float32)[:, None] * inv_freq[None, :]
    cos, sin = jnp.cos(ang).astype(q.dtype), jnp.sin(ang).astype(q.dtype)
    q_rope = apply_rope(q_rope, cos[None, :, None, :], sin[None, :, None, :])
    k_rope = apply_rope(k_rope_raw, cos[None], sin[None])

    scale = (MLA_NOPE + MLA_ROPE) ** -0.5
    QB = MLA_Q_BLOCK
    NQ = S // QB
    qn_b = q_nope.reshape(B, NQ, QB, H, MLA_NOPE).transpose(1, 0, 2, 3, 4)
    qr_b = q_rope.reshape(B, NQ, QB, H, MLA_ROPE).transpose(1, 0, 2, 3, 4)
    kpos = jnp.arange(S, dtype=jnp.int32)

    def block_fn(args):
        c, qn, qr = args
        t = c * QB + jnp.arange(QB, dtype=jnp.int32)
        logits = (jnp.einsum('bqhd,bkhd->bhqk', qn, k_nope)
                  + jnp.einsum('bqhd,bkd->bhqk', qr, k_rope)).astype(jnp.float32) * scale
        p = masked_softmax(logits, kpos[None, :] <= t[:, None], -1)
        return jnp.einsum('bhqk,bkhd->bqhd', p.astype(v.dtype), v)

    o = lax.map(block_fn, (jnp.arange(NQ, dtype=jnp.int32), qn_b, qr_b))
    return o.transpose(1, 0, 2, 3, 4).reshape(B, S, H * MLA_V)


def peer_ffn(xn, w_query, sub_keys, u, v):
    B, S, D = xn.shape
    T = B * S
    H, K = PEER_HEADS, PEER_TOPK
    xt = xn.reshape(T, D)
    q = (xt @ w_query).reshape(T, H, 2, PEER_KEY_DIM // 2)
    s = jnp.einsum('thpd,hpkd->thpk', q, sub_keys).astype(jnp.float32)
    s_top, i_top = lax.top_k(s, K)
    cand = s_top[:, :, 0, :, None] + s_top[:, :, 1, None, :]
    cand_idx = i_top[:, :, 0, :, None] * PEER_N_KEYS + i_top[:, :, 1, None, :]
    best, pick = lax.top_k(cand.reshape(T, H, K * K), K)
    expert = jnp.take_along_axis(cand_idx.reshape(T, H, K * K), pick, axis=-1)
    g = jax.nn.softmax(best, axis=-1)

    C = PEER_TOKEN_CHUNK
    NT = T // C

    def chunk_fn(args):
        xc, ec, gc = args
        ue = u[ec]
        ve = v[ec]
        a = jax.nn.gelu(jnp.einsum('chkd,cd->chk', ue, xc).astype(jnp.float32), approximate=False)
        return jnp.einsum('chk,chkd->cd', (gc * a).astype(ve.dtype), ve)

    y = lax.map(chunk_fn, (xt.reshape(NT, C, D), expert.reshape(NT, C, H, K), g.reshape(NT, C, H, K)))
    return y.reshape(B, S, D)


def setup_inputs(seed: int = 0) -> dict:
    key = jax.random.key(seed)
    ks = jax.random.split(key, 23)
    L = DEPTH

    def nrm(k, shape, scale):
        return jax.random.normal(k, shape, jnp.float32) * scale

    def gain(k, shape):
        return 1.0 + 0.01 * jax.random.normal(k, shape, jnp.float32)

    return {
        "x": nrm(ks[0], (BATCH, SEQ, D_MODEL), 1.0),
        "ln_mix_g": gain(ks[1], (L, D_MODEL)),
        "w_in": nrm(ks[2], (L, D_MODEL, IN_COLS), D_MODEL ** -0.5),
        "nsa_cmp_pos_k": nrm(ks[3], (L, CMP_LEN, NSA_DH), 0.1),
        "nsa_cmp_pos_v": nrm(ks[4], (L, CMP_LEN, NSA_DH), 0.1),
        "nsa_cmp_k_w1": nrm(ks[5], (L, CMP_LEN * NSA_DH, CMP_HIDDEN), (CMP_LEN * NSA_DH) ** -0.5),
        "nsa_cmp_k_w2": nrm(ks[6], (L, CMP_HIDDEN, NSA_DH), CMP_HIDDEN ** -0.5),
        "nsa_cmp_v_w1": nrm(ks[7], (L, CMP_LEN * NSA_DH, CMP_HIDDEN), (CMP_LEN * NSA_DH) ** -0.5),
        "nsa_cmp_v_w2": nrm(ks[8], (L, CMP_HIDDEN, NSA_DH), CMP_HIDDEN ** -0.5),
        "mla_q_norm_g": gain(ks[9], (L, MLA_Q_RANK)),
        "mla_kv_norm_g": gain(ks[10], (L, MLA_KV_RANK)),
        "mla_w_uq": nrm(ks[11], (L, MLA_Q_RANK, MLA_HEADS * (MLA_NOPE + MLA_ROPE)), MLA_Q_RANK ** -0.5),
        "mla_w_ukv": nrm(ks[12], (L, MLA_KV_RANK, MLA_HEADS * (MLA_NOPE + MLA_V)), MLA_KV_RANK ** -0.5),
        "w_branch_nsa": nrm(ks[13], (L, NSA_HEADS * NSA_DH, D_MODEL), (NSA_HEADS * NSA_DH) ** -0.5),
        "w_branch_mla": nrm(ks[14], (L, MLA_HEADS * MLA_V, D_MODEL), (MLA_HEADS * MLA_V) ** -0.5),
        "w_out": nrm(ks[15], (L, D_MODEL, D_MODEL), D_MODEL ** -0.5),
        "ln_ffn_g": gain(ks[16], (L, D_MODEL)),
        "peer_w_query": nrm(ks[17], (L, D_MODEL, PEER_HEADS * PEER_KEY_DIM), D_MODEL ** -0.5),
        "peer_sub_keys": nrm(ks[18], (L, PEER_HEADS, 2, PEER_N_KEYS, PEER_KEY_DIM // 2), (PEER_KEY_DIM // 2) ** -0.5),
        "peer_u": nrm(ks[19], (L, PEER_N_EXPERTS, D_MODEL), D_MODEL ** -0.5),
        "peer_v": nrm(ks[20], (L, PEER_N_EXPERTS, D_MODEL), 0.5),
        "t5_bias": nrm(ks[21], (T5_BUCKETS, NSA_HEADS), 0.2),
        "ln_final_g": gain(ks[22], (D_MODEL,)),
    }


def reference(x, ln_mix_g, w_in, nsa_cmp_pos_k, nsa_cmp_pos_v, nsa_cmp_k_w1, nsa_cmp_k_w2,
              nsa_cmp_v_w1, nsa_cmp_v_w2, mla_q_norm_g, mla_kv_norm_g, mla_w_uq, mla_w_ukv,
              w_branch_nsa, w_branch_mla, w_out, ln_ffn_g, peer_w_query, peer_sub_keys,
              peer_u, peer_v, t5_bias, ln_final_g):
    B, S, D = x.shape
    h = x
    for l in range(DEPTH):
        xn = rmsnorm(h, ln_mix_g[l])
        proj = xn @ w_in[l]
        nsa_q, nsa_kv, nsa_gate, c_q, c_kv, k_rope, merge_gate = split_cols(proj, IN_SPLITS)
        o_nsa = nsa_mixer(nsa_q, nsa_kv, nsa_gate, t5_bias, nsa_cmp_pos_k[l], nsa_cmp_pos_v[l],
                          nsa_cmp_k_w1[l], nsa_cmp_k_w2[l], nsa_cmp_v_w1[l], nsa_cmp_v_w2[l])
        o_mla = mla_mixer(c_q, c_kv, k_rope, mla_q_norm_g[l], mla_kv_norm_g[l],
                          mla_w_uq[l], mla_w_ukv[l])
        gates = jax.nn.sigmoid(merge_gate.astype(jnp.float32)).astype(x.dtype).reshape(B, S, 2, D)
        merged = gates[:, :, 0] * (o_nsa @ w_branch_nsa[l]) + gates[:, :, 1] * (o_mla @ w_branch_mla[l])
        h = h + merged @ w_out[l]
        hn = rmsnorm(h, ln_ffn_g[l])
        h = h + peer_ffn(hn, peer_w_query[l], peer_sub_keys[l], peer_u[l], peer_v[l])
    return rmsnorm(h, ln_final_g)
```

```cpp
#include <hip/hip_runtime.h>
#include <stdint.h>
#include <cstdio>

typedef unsigned short bf16_t;
#define DEV __device__ __forceinline__

constexpr int BATCH = 8, SEQ = 2048, DM = 1024, T = BATCH * SEQ;
constexpr int IN_COLS = 3768;
constexpr int PROJ_LD = 1792;
constexpr int PC_Q = 0, PC_KV = 512, PC_CQ = 1280, PC_CKV = 1536, PC_KR = 1664, PC_GATE = 1696;
constexpr int NC = 127;
constexpr size_t MiB = 1u << 20;

constexpr size_t WS_WIN = 1 * MiB;
constexpr size_t WS_WBN = 9 * MiB;
constexpr size_t WS_WBM = 10 * MiB;
constexpr size_t WS_WOUT = 11 * MiB;
constexpr size_t WS_WQ = 13 * MiB;
constexpr size_t WS_CKW1 = 15 * MiB;
constexpr size_t WS_CVW1 = 16 * MiB;
constexpr size_t WS_CKW2 = 17 * MiB;
constexpr size_t WS_CVW2 = 17 * MiB + 64 * 1024;
constexpr size_t WS_UQ = 17 * MiB + 256 * 1024;
constexpr size_t WS_UKV = 17 * MiB + 768 * 1024;
constexpr size_t WS_SUBK = 18 * MiB;
constexpr size_t WS_GATES = 20 * MiB;
constexpr size_t WS_PQ = 20 * MiB;
constexpr size_t WS_PROJ = 84 * MiB;
constexpr size_t WS_MERGED = 84 * MiB;
constexpr size_t WS_PIDX = 84 * MiB;
constexpr size_t WS_PW = 92 * MiB;
constexpr size_t WS_XN = 140 * MiB;
constexpr size_t WS_MLAKV = 140 * MiB;
constexpr size_t WS_HN = 140 * MiB;
constexpr size_t WS_MLAQ = 172 * MiB;
constexpr size_t WS_KROPE = 196 * MiB;
constexpr size_t WS_KC = 197 * MiB;
constexpr size_t WS_VC = 197 * MiB + 512 * 1024;
constexpr size_t WS_ONSA = 198 * MiB;
constexpr size_t WS_OMLA = 214 * MiB;
constexpr size_t WS_CA = 198 * MiB;
constexpr size_t WS_HID = 206 * MiB;
constexpr size_t WS_CQN = 230 * MiB;
constexpr size_t WS_CKVN = 238 * MiB;
constexpr size_t WS_OCMP = 230 * MiB;
constexpr size_t WS_SEL = 246 * MiB;

__device__ const unsigned char T5B[128] = {
  0, 1, 2, 3, 4, 5, 6, 7, 8, 9, 10, 11, 12, 13, 14, 15, 16, 16, 16, 17, 17, 18, 18, 18, 19, 19, 19, 20, 20, 20, 20, 21,
  21, 21, 21, 22, 22, 22, 22, 22, 23, 23, 23, 23, 23, 23, 24, 24, 24, 24, 24, 24, 25, 25, 25, 25, 25, 25, 25, 26, 26, 26, 26, 26,
  26, 26, 26, 27, 27, 27, 27, 27, 27, 27, 27, 27, 27, 28, 28, 28, 28, 28, 28, 28, 28, 28, 28, 29, 29, 29, 29, 29, 29, 29, 29, 29,
  29, 29, 29, 30, 30, 30, 30, 30, 30, 30, 30, 30, 30, 30, 30, 30, 30, 31, 31, 31, 31, 31, 31, 31, 31, 31, 31, 31, 31, 31, 31, 31};

DEV float bf2f(bf16_t v) { return __uint_as_float(((unsigned)v) << 16); }
DEV bf16_t f2bf(float f) { unsigned u = __float_as_uint(f); u += 0x7fffu + ((u >> 16) & 1u); return (bf16_t)(u >> 16); }
DEV float wsum(float v) {
#pragma unroll
  for (int o = 32; o > 0; o >>= 1) v += __shfl_xor(v, o);
  return v;
}
DEV float wmaxf(float v) {
#pragma unroll
  for (int o = 32; o > 0; o >>= 1) v = fmaxf(v, __shfl_xor(v, o));
  return v;
}
DEV float sigmoidf_(float x) { return 1.0f / (1.0f + expf(-x)); }
DEV float gelu_exact(float x) { return 0.5f * x * (1.0f + erff(x * 0.70710678118654752f)); }
DEV void wave_lds_sync() { asm volatile("s_waitcnt lgkmcnt(0)" ::: "memory"); __builtin_amdgcn_wave_barrier(); asm volatile("" ::: "memory"); }
DEV float t5bias(const float* t5, int head, int dist) { int d = dist < 127 ? dist : 127; d = d < 0 ? 0 : d; return t5[(int)T5B[d] * 8 + head]; }

__global__ __launch_bounds__(256) void k_rms1024(const float* __restrict__ src, const float* __restrict__ g, bf16_t* __restrict__ dst, int rows) {
  const int lane = threadIdx.x & 63;
  const int gw = (blockIdx.x * blockDim.x + threadIdx.x) >> 6, nw = (gridDim.x * blockDim.x) >> 6;
  for (int r = gw; r < rows; r += nw) {
    const float4* s4 = (const float4*)(src + (size_t)r * 1024);
    float4 v[4]; float ss = 0.f;
#pragma unroll
    for (int j = 0; j < 4; ++j) { v[j] = s4[j * 64 + lane]; ss += v[j].x * v[j].x + v[j].y * v[j].y + v[j].z * v[j].z + v[j].w * v[j].w; }
    ss = wsum(ss);
    const float inv = rsqrtf(ss * (1.0f / 1024.0f) + 1e-6f);
#pragma unroll
    for (int j = 0; j < 4; ++j) {
      const float4 gg = ((const float4*)g)[j * 64 + lane];
      uint2 o;
      o.x = (unsigned)f2bf(v[j].x * inv * gg.x) | ((unsigned)f2bf(v[j].y * inv * gg.y) << 16);
      o.y = (unsigned)f2bf(v[j].z * inv * gg.z) | ((unsigned)f2bf(v[j].w * inv * gg.w) << 16);
      ((uint2*)(dst + (size_t)r * 1024))[j * 64 + lane] = o;
    }
  }
}

template <int PER> __global__ __launch_bounds__(256) void k_rms_cols(const bf16_t* __restrict__ proj, int col0, const float* __restrict__ g, bf16_t* __restrict__ dst) {
  const int lane = threadIdx.x & 63;
  const int gw = (blockIdx.x * blockDim.x + threadIdx.x) >> 6, nw = (gridDim.x * blockDim.x) >> 6;
  constexpr int W = 64 * PER;
  for (int r = gw; r < T; r += nw) {
    float v[PER]; float ss = 0.f;
#pragma unroll
    for (int j = 0; j < PER; ++j) { v[j] = bf2f(proj[(size_t)r * PROJ_LD + col0 + j * 64 + lane]); ss += v[j] * v[j]; }
    ss = wsum(ss);
    const float inv = rsqrtf(ss * (1.0f / W) + 1e-6f);
#pragma unroll
    for (int j = 0; j < PER; ++j) dst[(size_t)r * W + j * 64 + lane] = f2bf(v[j] * inv * g[j * 64 + lane]);
  }
}

DEV int win_src_col(int n) {
  if (n < 1280) return n;
  if (n < 1536) return 1304 + (n - 1280);
  if (n < 1664) return 1560 + (n - 1536);
  if (n < 1696) return 1688 + (n - 1664);
  if (n < 1720) return 1280 + (n - 1696);
  if (n < 1792) return -1;
  return 1720 + (n - 1792);
}
template <int MODE> __global__ __launch_bounds__(256) void k_convT(const float* __restrict__ W, int K, int Nsrc, bf16_t* __restrict__ WT, int Nout) {
  __shared__ float t[32][33];
  const int tx = threadIdx.x & 31, ty = threadIdx.x >> 5;
  const int n0 = blockIdx.x * 32, k0 = blockIdx.y * 32;
#pragma unroll
  for (int i = 0; i < 4; ++i) {
    const int k = k0 + ty + 8 * i, n = n0 + tx;
    const int sc = (MODE == 1) ? win_src_col(n) : n;
    t[ty + 8 * i][tx] = (n < Nout && sc >= 0) ? W[(size_t)k * Nsrc + sc] : 0.f;
  }
  __syncthreads();
#pragma unroll
  for (int i = 0; i < 4; ++i) {
    const int n = n0 + ty + 8 * i, k = k0 + tx;
    if (n < Nout) WT[(size_t)n * K + k] = f2bf(t[tx][ty + 8 * i]);
  }
}
__global__ void k_conv_plain(const float* __restrict__ src, bf16_t* __restrict__ dst, int n) {
  for (int i = blockIdx.x * blockDim.x + threadIdx.x; i < n; i += gridDim.x * blockDim.x) dst[i] = f2bf(src[i]);
}

struct EpiInProj { bf16_t* proj; bf16_t* gates;
  DEV void operator()(int m, int n, float v) const { if (n < PROJ_LD) proj[(size_t)m * PROJ_LD + n] = f2bf(v); else gates[(size_t)m * 2048 + (n - PROJ_LD)] = f2bf(sigmoidf_(v)); } };
struct EpiStore { bf16_t* dst; int ld;
  DEV void operator()(int m, int n, float v) const { dst[(size_t)m * ld + n] = f2bf(v); } };
struct EpiGelu { bf16_t* dst; int ld;
  DEV void operator()(int m, int n, float v) const { dst[(size_t)m * ld + n] = f2bf(gelu_exact(v)); } };
struct EpiCmpOut { bf16_t* dst;
  DEV void operator()(int m, int n, float v) const { if (m >= BATCH * NC * 2) return; const int g = m & 1, bc = m >> 1, b = bc / NC, c = bc % NC; dst[((size_t)(b * 2 + g) * 128 + c) * 64 + n] = f2bf(v); } };
struct EpiMerge1 { const bf16_t* gates; bf16_t* merged;
  DEV void operator()(int m, int n, float v) const { merged[(size_t)m * 1024 + n] = f2bf(bf2f(gates[(size_t)m * 2048 + n]) * v); } };
struct EpiMerge2 { const bf16_t* gates; bf16_t* merged;
  DEV void operator()(int m, int n, float v) const { const size_t i = (size_t)m * 1024 + n; merged[i] = f2bf(bf2f(merged[i]) + bf2f(gates[(size_t)m * 2048 + 1024 + n]) * v); } };
struct EpiResid { const float* x; float* h;
  DEV void operator()(int m, int n, float v) const { const size_t i = (size_t)m * 1024 + n; h[i] = x[i] + v; } };

template <class Epi> __global__ __launch_bounds__(256) void k_gemm(const bf16_t* __restrict__ A, int lda, const bf16_t* __restrict__ Bt, int ldb, int K, Epi epi) {
  __shared__ float sA[32][68];
  __shared__ float sB[32][68];
  const int tid = threadIdx.x, ty = tid >> 4, tx = tid & 15;
  const int m0 = blockIdx.y * 64, n0 = blockIdx.x * 64;
  const int lr = tid >> 2, lk = (tid & 3) * 8;
  float acc[4][4];
#pragma unroll
  for (int i = 0; i < 4; ++i)
#pragma unroll
    for (int j = 0; j < 4; ++j) acc[i][j] = 0.f;
  for (int k0 = 0; k0 < K; k0 += 32) {
    const uint4 va = *(const uint4*)(A + (size_t)(m0 + lr) * lda + k0 + lk);
    const uint4 vb = *(const uint4*)(Bt + (size_t)(n0 + lr) * ldb + k0 + lk);
    const unsigned ua[4] = {va.x, va.y, va.z, va.w}, ub[4] = {vb.x, vb.y, vb.z, vb.w};
#pragma unroll
    for (int j = 0; j < 4; ++j) {
      sA[lk + 2 * j][lr] = __uint_as_float(ua[j] << 16); sA[lk + 2 * j + 1][lr] = __uint_as_float(ua[j] & 0xffff0000u);
      sB[lk + 2 * j][lr] = __uint_as_float(ub[j] << 16); sB[lk + 2 * j + 1][lr] = __uint_as_float(ub[j] & 0xffff0000u);
    }
    __syncthreads();
#pragma unroll 8
    for (int k = 0; k < 32; ++k) {
      const float4 a = *(const float4*)&sA[k][ty * 4];
      const float4 b = *(const float4*)&sB[k][tx * 4];
      const float av[4] = {a.x, a.y, a.z, a.w}, bv[4] = {b.x, b.y, b.z, b.w};
#pragma unroll
      for (int i = 0; i < 4; ++i)
#pragma unroll
        for (int j = 0; j < 4; ++j) acc[i][j] += av[i] * bv[j];
    }
    __syncthreads();
  }
#pragma unroll
  for (int i = 0; i < 4; ++i)
#pragma unroll
    for (int j = 0; j < 4; ++j) epi(m0 + ty * 4 + i, n0 + tx * 4 + j, acc[i][j]);
}

__global__ void k_rope_q(bf16_t* __restrict__ q) {
  const int n = T * 8 * 16;
  for (int i = blockIdx.x * blockDim.x + threadIdx.x; i < n; i += gridDim.x * blockDim.x) {
    const int j = i & 15, h = (i >> 4) & 7, t = i >> 7;
    const float pos = (float)(t & (SEQ - 1));
    const float inv_freq = powf(10000.0f, -(float)(2 * j) / 32.0f);
    const float ang = pos * inv_freq, c = cosf(ang), s = sinf(ang);
    bf16_t* p = q + (size_t)t * 768 + h * 96 + 64 + j;
    const float x1 = bf2f(p[0]), x2 = bf2f(p[16]);
    p[0] = f2bf(x1 * c - x2 * s); p[16] = f2bf(x2 * c + x1 * s);
  }
}
__global__ void k_rope_k(const bf16_t* __restrict__ proj, bf16_t* __restrict__ kr) {
  const int n = T * 16;
  for (int i = blockIdx.x * blockDim.x + threadIdx.x; i < n; i += gridDim.x * blockDim.x) {
    const int j = i & 15, t = i >> 4;
    const float pos = (float)(t & (SEQ - 1));
    const float inv_freq = powf(10000.0f, -(float)(2 * j) / 32.0f);
    const float ang = pos * inv_freq, c = cosf(ang), s = sinf(ang);
    const float x1 = bf2f(proj[(size_t)t * PROJ_LD + PC_KR + j]), x2 = bf2f(proj[(size_t)t * PROJ_LD + PC_KR + 16 + j]);
    kr[(size_t)t * 32 + j] = f2bf(x1 * c - x2 * s); kr[(size_t)t * 32 + 16 + j] = f2bf(x2 * c + x1 * s);
  }
}

__global__ void k_cmp_gather(const bf16_t* __restrict__ proj, const float* __restrict__ pos, int which, bf16_t* __restrict__ ca) {
  const int n = 2048 * 2048;
  for (int i = blockIdx.x * blockDim.x + threadIdx.x; i < n; i += gridDim.x * blockDim.x) {
    const int e = i & 2047, row = i >> 11;
    float v = 0.f;
    if (row < BATCH * NC * 2) {
      const int g = row & 1, bc = row >> 1, b = bc / NC, c = bc % NC, l = e >> 6, d = e & 63;
      v = bf2f(proj[(size_t)(b * SEQ + 16 * c + l) * PROJ_LD + PC_KV + which * 128 + g * 64 + d]) + pos[e];
    }
    ca[i] = f2bf(v);
  }
}

__global__ __launch_bounds__(256) void k_cmp_attn(const bf16_t* __restrict__ proj, const bf16_t* __restrict__ kc, const bf16_t* __restrict__ vc,
                                                   const float* __restrict__ t5, bf16_t* __restrict__ ocmp, unsigned* __restrict__ sel) {
  __shared__ float s_p[4][128];
  __shared__ float s_q[4][64];
  const int lane = threadIdx.x & 63, wv = threadIdx.x >> 6;
  const int gw = (blockIdx.x * blockDim.x + threadIdx.x) >> 6, nw = (gridDim.x * blockDim.x) >> 6;
  float* P = s_p[wv]; float* Q = s_q[wv];
  for (int item = gw; item < BATCH * 2 * SEQ; item += nw) {
    const int t = item & (SEQ - 1), bg = item >> 11, g = bg & 1, b = bg >> 1;
    const size_t tok = (size_t)b * SEQ + t;
    const int nvalid = (t >= 31) ? min(NC, (t - 31) / 16 + 1) : 0;
    const bf16_t* kcb = kc + (size_t)bg * 128 * 64;
    const bf16_t* vcb = vc + (size_t)bg * 128 * 64;
    float impacc = 0.f;
    for (int r = 0; r < 4; ++r) {
      const int head = g * 4 + r;
      Q[lane] = bf2f(proj[tok * PROJ_LD + PC_Q + head * 64 + lane]);
      wave_lds_sync();
      float lg[2];
#pragma unroll
      for (int u = 0; u < 2; ++u) {
        const int c = lane + 64 * u;
        float d = 0.f;
        if (c < nvalid) { const bf16_t* kr = kcb + c * 64; for (int e = 0; e < 64; ++e) d += Q[e] * bf2f(kr[e]); }
        lg[u] = (c < nvalid) ? d * 0.125f + t5bias(t5, head, t - (16 * c + 31)) : -1e30f;
      }
      const float m = wmaxf(fmaxf(lg[0], lg[1]));
      const float e0 = (lane < nvalid) ? expf(lg[0] - m) : 0.f, e1 = (lane + 64 < nvalid) ? expf(lg[1] - m) : 0.f;
      const float s = wsum(e0 + e1);
      const float inv = (nvalid > 0) ? 1.0f / fmaxf(s, 1e-30f) : 0.f;
      P[lane] = e0 * inv; P[lane + 64] = e1 * inv;
      wave_lds_sync();
      float o = 0.f;
      for (int c = 0; c < nvalid; ++c) o += P[c] * bf2f(vcb[c * 64 + lane]);
      ocmp[tok * 512 + head * 64 + lane] = f2bf(o);
      if (lane < 32) { for (int c = 4 * lane - 1; c <= 4 * lane + 3; ++c) if (c >= 0 && c < NC) impacc += P[c]; }
      wave_lds_sync();
    }
    const int cur = t >> 6, n = lane;
    float score = (n > cur) ? -1.0f : ((n == 0 || n == cur || n == cur - 1) ? 1e4f : impacc);
    if (n >= 32) score = -2.0f;
    int rank = 0;
    for (int mth = 0; mth < 32; ++mth) { const float sm = __shfl(score, mth); rank += (sm > score || (sm == score && mth < n)) ? 1 : 0; }
    const unsigned long long bal = __ballot(n < 32 && rank < 16);
    if (lane == 0) sel[item] = (unsigned)bal;
  }
}

__global__ __launch_bounds__(256) void k_nsa_attn(const bf16_t* __restrict__ proj, const float* __restrict__ t5, const bf16_t* __restrict__ ocmp,
                                                   const unsigned* __restrict__ sel, bf16_t* __restrict__ onsa) {
  __shared__ float s_p[4][64];
  __shared__ float s_q[4][64];
  const int lane = threadIdx.x & 63, wv = threadIdx.x >> 6;
  const int gw = (blockIdx.x * blockDim.x + threadIdx.x) >> 6, nw = (gridDim.x * blockDim.x) >> 6;
  float* P = s_p[wv]; float* Q = s_q[wv];
  for (int item = gw; item < BATCH * 2 * SEQ * 4; item += nw) {
    const int r = item & 3, t = (item >> 2) & (SEQ - 1), bg = item >> 13, g = bg & 1, b = bg >> 1;
    const int head = g * 4 + r, cur = t >> 6;
    const size_t tok = (size_t)b * SEQ + t;
    Q[lane] = bf2f(proj[tok * PROJ_LD + PC_Q + head * 64 + lane]) * 0.125f;
    wave_lds_sync();
    const unsigned smask = sel[bg * SEQ + t];
    float res0 = 0.f, res1 = 0.f;
    for (int br = 0; br < 2; ++br) {
      float m = -1e30f, l = 0.f, o = 0.f;
      const int nb0 = (br == 0) ? 0 : max(0, cur - 8);
      for (int nb = nb0; nb <= cur; ++nb) {
        if (br == 0 && !((smask >> nb) & 1u)) continue;
        const int s = nb * 64 + lane, dist = t - s;
        const bool valid = (dist >= 0) && (br == 0 || dist < 512);
        const bf16_t* kp = proj + ((size_t)b * SEQ + s) * PROJ_LD + PC_KV + (2 + 2 * br) * 128 + g * 64;
        float d = 0.f;
        for (int e = 0; e < 64; e += 8) {
          const uint4 kv = *(const uint4*)(kp + e);
          d += Q[e + 0] * __uint_as_float(kv.x << 16) + Q[e + 1] * __uint_as_float(kv.x & 0xffff0000u);
          d += Q[e + 2] * __uint_as_float(kv.y << 16) + Q[e + 3] * __uint_as_float(kv.y & 0xffff0000u);
          d += Q[e + 4] * __uint_as_float(kv.z << 16) + Q[e + 5] * __uint_as_float(kv.z & 0xffff0000u);
          d += Q[e + 6] * __uint_as_float(kv.w << 16) + Q[e + 7] * __uint_as_float(kv.w & 0xffff0000u);
        }
        const float lg = valid ? d + t5bias(t5, head, dist) : -1e30f;
        const float mn = fmaxf(m, wmaxf(lg));
        const float sc = expf(m - mn);
        const float pe = valid ? expf(lg - mn) : 0.f;
        l = l * sc + wsum(pe); m = mn;
        P[lane] = pe;
        wave_lds_sync();
        const bf16_t* vp = proj + ((size_t)b * SEQ + nb * 64) * PROJ_LD + PC_KV + (3 + 2 * br) * 128 + g * 64 + lane;
        float acc = 0.f;
        for (int k = 0; k < 64; ++k) acc += P[k] * bf2f(vp[(size_t)k * PROJ_LD]);
        o = o * sc + acc;
        wave_lds_sync();
      }
      if (br == 0) res0 = o / fmaxf(l, 1e-30f); else res1 = o / fmaxf(l, 1e-30f);
    }
    const bf16_t* gp = proj + tok * PROJ_LD + PC_GATE + head * 3;
    const float g0 = sigmoidf_(bf2f(gp[0])), g1 = sigmoidf_(bf2f(gp[1])), g2 = sigmoidf_(bf2f(gp[2]));
    const float oc = bf2f(ocmp[tok * 512 + head * 64 + lane]);
    onsa[tok * 512 + head * 64 + lane] = f2bf(g0 * oc + g1 * res0 + g2 * res1);
    wave_lds_sync();
  }
}

__global__ __launch_bounds__(256) void k_mla_attn(const bf16_t* __restrict__ mq, const bf16_t* __restrict__ mkv, const bf16_t* __restrict__ kr, bf16_t* __restrict__ omla) {
  __shared__ float s_p[4][64];
  __shared__ float s_q[4][96];
  const int lane = threadIdx.x & 63, wv = threadIdx.x >> 6;
  const int gw = (blockIdx.x * blockDim.x + threadIdx.x) >> 6, nw = (gridDim.x * blockDim.x) >> 6;
  float* P = s_p[wv]; float* Q = s_q[wv];
  const float scale = 0.10206207261596575f;
  for (int item = gw; item < BATCH * 8 * SEQ; item += nw) {
    const int h = item & 7, t = (item >> 3) & (SEQ - 1), b = item >> 14;
    const size_t tok = (size_t)b * SEQ + t;
    Q[lane] = bf2f(mq[tok * 768 + h * 96 + lane]) * scale;
    if (lane < 32) Q[64 + lane] = bf2f(mq[tok * 768 + h * 96 + 64 + lane]) * scale;
    wave_lds_sync();
    float m = -1e30f, l = 0.f, o = 0.f;
    for (int nb = 0; nb <= (t >> 6); ++nb) {
      const int s = nb * 64 + lane;
      const bool valid = s <= t;
      const bf16_t* kp = mkv + ((size_t)b * SEQ + s) * 1024 + h * 128;
      const bf16_t* rp = kr + ((size_t)b * SEQ + s) * 32;
      float d = 0.f;
      for (int e = 0; e < 64; e += 8) {
        const uint4 kv = *(const uint4*)(kp + e);
        d += Q[e + 0] * __uint_as_float(kv.x << 16) + Q[e + 1] * __uint_as_float(kv.x & 0xffff0000u);
        d += Q[e + 2] * __uint_as_float(kv.y << 16) + Q[e + 3] * __uint_as_float(kv.y & 0xffff0000u);
        d += Q[e + 4] * __uint_as_float(kv.z << 16) + Q[e + 5] * __uint_as_float(kv.z & 0xffff0000u);
        d += Q[e + 6] * __uint_as_float(kv.w << 16) + Q[e + 7] * __uint_as_float(kv.w & 0xffff0000u);
      }
      for (int e = 0; e < 32; e += 8) {
        const uint4 kv = *(const uint4*)(rp + e);
        d += Q[64 + e + 0] * __uint_as_float(kv.x << 16) + Q[64 + e + 1] * __uint_as_float(kv.x & 0xffff0000u);
        d += Q[64 + e + 2] * __uint_as_float(kv.y << 16) + Q[64 + e + 3] * __uint_as_float(kv.y & 0xffff0000u);
        d += Q[64 + e + 4] * __uint_as_float(kv.z << 16) + Q[64 + e + 5] * __uint_as_float(kv.z & 0xffff0000u);
        d += Q[64 + e + 6] * __uint_as_float(kv.w << 16) + Q[64 + e + 7] * __uint_as_float(kv.w & 0xffff0000u);
      }
      const float lg = valid ? d : -1e30f;
      const float mn = fmaxf(m, wmaxf(lg));
      const float sc = expf(m - mn);
      const float pe = valid ? expf(lg - mn) : 0.f;
      l = l * sc + wsum(pe); m = mn;
      P[lane] = pe;
      wave_lds_sync();
      const bf16_t* vp = mkv + ((size_t)b * SEQ + nb * 64) * 1024 + h * 128 + 64 + lane;
      float acc = 0.f;
      for (int k = 0; k < 64; ++k) acc += P[k] * bf2f(vp[(size_t)k * 1024]);
      o = o * sc + acc;
      wave_lds_sync();
    }
    omla[tok * 512 + h * 64 + lane] = f2bf(o / fmaxf(l, 1e-30f));
    wave_lds_sync();
  }
}

DEV void wave_argmax(float& v, int& idx) {
#pragma unroll
  for (int o = 32; o > 0; o >>= 1) {
    const float ov = __shfl_xor(v, o); const int oi = __shfl_xor(idx, o);
    if (ov > v || (ov == v && oi < idx)) { v = ov; idx = oi; }
  }
}
__global__ __launch_bounds__(256) void k_route(const bf16_t* __restrict__ pq, const bf16_t* __restrict__ subk, int* __restrict__ pidx, float* __restrict__ pw) {
  __shared__ float s_q[4][128];
  __shared__ float s_ts[4][2][16];
  __shared__ int s_ti[4][2][16];
  const int lane = threadIdx.x & 63, wv = threadIdx.x >> 6;
  const int gw = (blockIdx.x * blockDim.x + threadIdx.x) >> 6, nw = (gridDim.x * blockDim.x) >> 6;
  float* Q = s_q[wv];
  for (int item = gw; item < T * 8; item += nw) {
    const int h = item & 7, t = item >> 3;
    Q[lane] = bf2f(pq[(size_t)t * 1024 + h * 128 + lane]);
    Q[lane + 64] = bf2f(pq[(size_t)t * 1024 + h * 128 + 64 + lane]);
    wave_lds_sync();
    for (int p = 0; p < 2; ++p) {
      const bf16_t* kb = subk + (size_t)((h * 2 + p) * 128) * 64;
      float s0 = 0.f, s1 = 0.f;
      for (int e = 0; e < 64; ++e) { const float qv = Q[p * 64 + e]; s0 += qv * bf2f(kb[lane * 64 + e]); s1 += qv * bf2f(kb[(lane + 64) * 64 + e]); }
      for (int k = 0; k < 16; ++k) {
        float v = (s0 >= s1) ? s0 : s1; int idx = (s0 >= s1) ? lane : lane + 64;
        wave_argmax(v, idx);
        if (lane == 0) { s_ts[wv][p][k] = v; s_ti[wv][p][k] = idx; }
        if (idx == lane) s0 = -3e38f;
        if (idx == lane + 64) s1 = -3e38f;
      }
    }
    wave_lds_sync();
    float cv[4];
#pragma unroll
    for (int u = 0; u < 4; ++u) { const int f = lane + 64 * u; cv[u] = s_ts[wv][0][f >> 4] + s_ts[wv][1][f & 15]; }
    int myexp = 0; float mybest = 0.f, best0 = 0.f, den = 0.f;
#pragma unroll
    for (int k = 0; k < 16; ++k) {
      float v = cv[0]; int idx = lane;
#pragma unroll
      for (int u = 1; u < 4; ++u) if (cv[u] > v) { v = cv[u]; idx = lane + 64 * u; }
      wave_argmax(v, idx);
#pragma unroll
      for (int u = 0; u < 4; ++u) if (idx == lane + 64 * u) cv[u] = -3e38f;
      if (k == 0) best0 = v;
      den += expf(v - best0);
      if (lane == k) { myexp = s_ti[wv][0][idx >> 4] * 128 + s_ti[wv][1][idx & 15]; mybest = v; }
    }
    if (lane < 16) { pidx[(size_t)t * 128 + h * 16 + lane] = myexp; pw[(size_t)t * 128 + h * 16 + lane] = expf(mybest - best0) / den; }
    wave_lds_sync();
  }
}

__global__ __launch_bounds__(256) void k_experts(const bf16_t* __restrict__ hn, const int* __restrict__ pidx, const float* __restrict__ pw,
                                                  const float* __restrict__ pu, const float* __restrict__ pv, const float* __restrict__ gfin, float* __restrict__ out) {
  const int lane = threadIdx.x & 63;
  const int gw = (blockIdx.x * blockDim.x + threadIdx.x) >> 6, nw = (gridDim.x * blockDim.x) >> 6;
  for (int t = gw; t < T; t += nw) {
    float4 x[4], y[4];
#pragma unroll
    for (int j = 0; j < 4; ++j) {
      const uint2 r = ((const uint2*)(hn + (size_t)t * 1024))[j * 64 + lane];
      x[j] = make_float4(__uint_as_float(r.x << 16), __uint_as_float(r.x & 0xffff0000u), __uint_as_float(r.y << 16), __uint_as_float(r.y & 0xffff0000u));
      y[j] = make_float4(0.f, 0.f, 0.f, 0.f);
    }
    const int e0 = pidx[(size_t)t * 128 + lane], e1 = pidx[(size_t)t * 128 + 64 + lane];
    const float w0 = pw[(size_t)t * 128 + lane], w1 = pw[(size_t)t * 128 + 64 + lane];
    for (int s = 0; s < 128; ++s) {
      const int e = __shfl((s < 64) ? e0 : e1, s & 63);
      const float w = __shfl((s < 64) ? w0 : w1, s & 63);
      const float4* ur = (const float4*)(pu + (size_t)e * 1024);
      float d = 0.f;
#pragma unroll
      for (int j = 0; j < 4; ++j) { const float4 u = ur[j * 64 + lane]; d += u.x * x[j].x + u.y * x[j].y + u.z * x[j].z + u.w * x[j].w; }
      d = wsum(d);
      const float c = w * gelu_exact(d);
      const float4* vr = (const float4*)(pv + (size_t)e * 1024);
#pragma unroll
      for (int j = 0; j < 4; ++j) { const float4 v = vr[j * 64 + lane]; y[j].x += c * v.x; y[j].y += c * v.y; y[j].z += c * v.z; y[j].w += c * v.w; }
    }
    float4* o4 = (float4*)(out + (size_t)t * 1024);
    float ss = 0.f;
#pragma unroll
    for (int j = 0; j < 4; ++j) {
      const float4 hv = o4[j * 64 + lane];
      y[j].x += hv.x; y[j].y += hv.y; y[j].z += hv.z; y[j].w += hv.w;
      ss += y[j].x * y[j].x + y[j].y * y[j].y + y[j].z * y[j].z + y[j].w * y[j].w;
    }
    ss = wsum(ss);
    const float inv = rsqrtf(ss * (1.0f / 1024.0f) + 1e-6f);
#pragma unroll
    for (int j = 0; j < 4; ++j) {
      const float4 gg = ((const float4*)gfin)[j * 64 + lane];
      o4[j * 64 + lane] = make_float4(y[j].x * inv * gg.x, y[j].y * inv * gg.y, y[j].z * inv * gg.z, y[j].w * inv * gg.w);
    }
  }
}

template <class Epi> static void gemm(hipStream_t st, const bf16_t* A, int lda, const bf16_t* Bt, int ldb, int M, int N, int K, Epi e) {
  hipLaunchKernelGGL((k_gemm<Epi>), dim3(N / 64, M / 64), dim3(256), 0, st, A, lda, Bt, ldb, K, e);
}
template <int MODE> static void convT(hipStream_t st, const float* W, int K, int Nsrc, bf16_t* WT, int Nout) {
  hipLaunchKernelGGL((k_convT<MODE>), dim3((Nout + 31) / 32, K / 32), dim3(256), 0, st, W, K, Nsrc, WT, Nout);
}

extern "C" void kernel_launch(void* const* d_in, const int* in_sizes, int n_in, void* d_out, int out_size, void* d_ws, size_t ws_size, hipStream_t stream) {
  if (n_in != 23 || ws_size < 256 * MiB) { fprintf(stderr, "kernel_launch: unexpected n_in %d / ws_size %zu\n", n_in, ws_size); return; }
  const float* x = (const float*)d_in[0]; const float* ln_mix_g = (const float*)d_in[1]; const float* w_in = (const float*)d_in[2];
  const float* cmp_pos_k = (const float*)d_in[3]; const float* cmp_pos_v = (const float*)d_in[4];
  const float* cmp_k_w1 = (const float*)d_in[5]; const float* cmp_k_w2 = (const float*)d_in[6];
  const float* cmp_v_w1 = (const float*)d_in[7]; const float* cmp_v_w2 = (const float*)d_in[8];
  const float* q_norm_g = (const float*)d_in[9]; const float* kv_norm_g = (const float*)d_in[10];
  const float* w_uq = (const float*)d_in[11]; const float* w_ukv = (const float*)d_in[12];
  const float* w_bn = (const float*)d_in[13]; const float* w_bm = (const float*)d_in[14]; const float* w_out = (const float*)d_in[15];
  const float* ln_ffn_g = (const float*)d_in[16]; const float* w_query = (const float*)d_in[17]; const float* sub_keys = (const float*)d_in[18];
  const float* peer_u = (const float*)d_in[19]; const float* peer_v = (const float*)d_in[20]; const float* t5 = (const float*)d_in[21];
  const float* ln_final_g = (const float*)d_in[22];
  float* out = (float*)d_out;
  char* ws = (char*)d_ws;
  bf16_t* WinT = (bf16_t*)(ws + WS_WIN); bf16_t* WbnT = (bf16_t*)(ws + WS_WBN); bf16_t* WbmT = (bf16_t*)(ws + WS_WBM);
  bf16_t* WoutT = (bf16_t*)(ws + WS_WOUT); bf16_t* WqT = (bf16_t*)(ws + WS_WQ);
  bf16_t* CkW1T = (bf16_t*)(ws + WS_CKW1); bf16_t* CvW1T = (bf16_t*)(ws + WS_CVW1); bf16_t* CkW2T = (bf16_t*)(ws + WS_CKW2); bf16_t* CvW2T = (bf16_t*)(ws + WS_CVW2);
  bf16_t* UqT = (bf16_t*)(ws + WS_UQ); bf16_t* UkvT = (bf16_t*)(ws + WS_UKV); bf16_t* SUBK = (bf16_t*)(ws + WS_SUBK);
  bf16_t* GATES = (bf16_t*)(ws + WS_GATES); bf16_t* PQ = (bf16_t*)(ws + WS_PQ);
  bf16_t* PROJ = (bf16_t*)(ws + WS_PROJ); bf16_t* MERGED = (bf16_t*)(ws + WS_MERGED);
  int* PIDX = (int*)(ws + WS_PIDX); float* PW = (float*)(ws + WS_PW);
  bf16_t* XN = (bf16_t*)(ws + WS_XN); bf16_t* MLAKV = (bf16_t*)(ws + WS_MLAKV); bf16_t* HN = (bf16_t*)(ws + WS_HN);
  bf16_t* MLAQ = (bf16_t*)(ws + WS_MLAQ); bf16_t* KROPE = (bf16_t*)(ws + WS_KROPE);
  bf16_t* KC = (bf16_t*)(ws + WS_KC); bf16_t* VC = (bf16_t*)(ws + WS_VC);
  bf16_t* ONSA = (bf16_t*)(ws + WS_ONSA); bf16_t* OMLA = (bf16_t*)(ws + WS_OMLA);
  bf16_t* CA = (bf16_t*)(ws + WS_CA); bf16_t* HID = (bf16_t*)(ws + WS_HID);
  bf16_t* CQN = (bf16_t*)(ws + WS_CQN); bf16_t* CKVN = (bf16_t*)(ws + WS_CKVN); bf16_t* OCMP = (bf16_t*)(ws + WS_OCMP);
  unsigned* SEL = (unsigned*)(ws + WS_SEL);
  const int G = 2048;

  convT<1>(stream, w_in, 1024, IN_COLS, WinT, 3840);
  convT<0>(stream, w_bn, 512, 1024, WbnT, 1024);
  convT<0>(stream, w_bm, 512, 1024, WbmT, 1024);
  convT<0>(stream, w_out, 1024, 1024, WoutT, 1024);
  convT<0>(stream, w_query, 1024, 1024, WqT, 1024);
  convT<0>(stream, cmp_k_w1, 2048, 256, CkW1T, 256);
  convT<0>(stream, cmp_v_w1, 2048, 256, CvW1T, 256);
  convT<0>(stream, cmp_k_w2, 256, 64, CkW2T, 64);
  convT<0>(stream, cmp_v_w2, 256, 64, CvW2T, 64);
  convT<0>(stream, w_uq, 256, 768, UqT, 768);
  convT<0>(stream, w_ukv, 128, 1024, UkvT, 1024);
  hipLaunchKernelGGL(k_conv_plain, dim3(256), dim3(256), 0, stream, sub_keys, SUBK, 16 * 128 * 64);
  hipLaunchKernelGGL(k_rms1024, dim3(G), dim3(256), 0, stream, x, ln_mix_g, XN, T);
  gemm(stream, XN, 1024, WinT, 1024, T, 3840, 1024, EpiInProj{PROJ, GATES});
  hipLaunchKernelGGL((k_rms_cols<4>), dim3(G), dim3(256), 0, stream, PROJ, PC_CQ, q_norm_g, CQN);
  hipLaunchKernelGGL((k_rms_cols<2>), dim3(G), dim3(256), 0, stream, PROJ, PC_CKV, kv_norm_g, CKVN);
  gemm(stream, CQN, 256, UqT, 256, T, 768, 256, EpiStore{MLAQ, 768});
  gemm(stream, CKVN, 128, UkvT, 128, T, 1024, 128, EpiStore{MLAKV, 1024});
  hipLaunchKernelGGL(k_rope_q, dim3(G), dim3(256), 0, stream, MLAQ);
  hipLaunchKernelGGL(k_rope_k, dim3(G), dim3(256), 0, stream, PROJ, KROPE);
  hipLaunchKernelGGL(k_cmp_gather, dim3(G), dim3(256), 0, stream, PROJ, cmp_pos_k, 0, CA);
  gemm(stream, CA, 2048, CkW1T, 2048, 2048, 256, 2048, EpiGelu{HID, 256});
  gemm(stream, HID, 256, CkW2T, 256, 2048, 64, 256, EpiCmpOut{KC});
  hipLaunchKernelGGL(k_cmp_gather, dim3(G), dim3(256), 0, stream, PROJ, cmp_pos_v, 1, CA);
  gemm(stream, CA, 2048, CvW1T, 2048, 2048, 256, 2048, EpiGelu{HID, 256});
  gemm(stream, HID, 256, CvW2T, 256, 2048, 64, 256, EpiCmpOut{VC});
  hipLaunchKernelGGL(k_cmp_attn, dim3(G), dim3(256), 0, stream, PROJ, KC, VC, t5, OCMP, SEL);
  hipLaunchKernelGGL(k_nsa_attn, dim3(2 * G), dim3(256), 0, stream, PROJ, t5, OCMP, SEL, ONSA);
  hipLaunchKernelGGL(k_mla_attn, dim3(2 * G), dim3(256), 0, stream, MLAQ, MLAKV, KROPE, OMLA);
  gemm(stream, ONSA, 512, WbnT, 512, T, 1024, 512, EpiMerge1{GATES, MERGED});
  gemm(stream, OMLA, 512, WbmT, 512, T, 1024, 512, EpiMerge2{GATES, MERGED});
  gemm(stream, MERGED, 1024, WoutT, 1024, T, 1024, 1024, EpiResid{x, out});
  hipLaunchKernelGGL(k_rms1024, dim3(G), dim3(256), 0, stream, out, ln_ffn_g, HN, T);
  gemm(stream, HN, 1024, WqT, 1024, T, 1024, 1024, EpiStore{PQ, 1024});
  hipLaunchKernelGGL(k_route, dim3(G), dim3(256), 0, stream, PQ, SUBK, PIDX, PW);
  hipLaunchKernelGGL(k_experts, dim3(G), dim3(256), 0, stream, HN, PIDX, PW, peer_u, peer_v, ln_final_g, out);
}
```

```cpp
#include <hip/hip_runtime.h>
#include <stdint.h>
#include <cstdio>
#include <hip/hip_cooperative_groups.h>
namespace cg = cooperative_groups;

typedef unsigned short bf16_t;
#define DEV __device__ __forceinline__

constexpr int BATCH = 8, SEQ = 2048, DM = 1024, T = BATCH * SEQ;
constexpr int IN_COLS = 3768;
constexpr int PROJ_LD = 1792;
constexpr int PC_Q = 0, PC_KV = 512, PC_CQ = 1280, PC_CKV = 1536, PC_KR = 1664, PC_GATE = 1696;
constexpr int NC = 127;
constexpr size_t MiB = 1u << 20;

constexpr size_t WS_WIN = 1 * MiB;
constexpr size_t WS_WBN = 9 * MiB;
constexpr size_t WS_WBM = 10 * MiB;
constexpr size_t WS_WOUT = 11 * MiB;
constexpr size_t WS_WQ = 13 * MiB;
constexpr size_t WS_CKW1 = 15 * MiB;
constexpr size_t WS_CVW1 = 16 * MiB;
constexpr size_t WS_CKW2 = 17 * MiB;
constexpr size_t WS_CVW2 = 17 * MiB + 64 * 1024;
constexpr size_t WS_UQ = 17 * MiB + 256 * 1024;
constexpr size_t WS_UKV = 17 * MiB + 768 * 1024;
constexpr size_t WS_SUBK = 18 * MiB;
constexpr size_t WS_GATES = 20 * MiB;
constexpr size_t WS_PQ = 20 * MiB;
constexpr size_t WS_PROJ = 84 * MiB;
constexpr size_t WS_MERGED = 84 * MiB;
constexpr size_t WS_PIDX = 84 * MiB;
constexpr size_t WS_PW = 92 * MiB;
constexpr size_t WS_XN = 140 * MiB;
constexpr size_t WS_MLAKV = 140 * MiB;
constexpr size_t WS_HN = 140 * MiB;
constexpr size_t WS_MLAQ = 172 * MiB;
constexpr size_t WS_KROPE = 196 * MiB;
constexpr size_t WS_KC = 197 * MiB;
constexpr size_t WS_VC = 197 * MiB + 512 * 1024;
constexpr size_t WS_ONSA = 198 * MiB;
constexpr size_t WS_OMLA = 214 * MiB;
constexpr size_t WS_CA = 198 * MiB;
constexpr size_t WS_HID = 206 * MiB;
constexpr size_t WS_HID2 = 207 * MiB;
constexpr size_t WS_CA2 = 214 * MiB;
constexpr size_t WS_CQN = 230 * MiB;
constexpr size_t WS_CKVN = 238 * MiB;
constexpr size_t WS_OCMP = 230 * MiB;
constexpr size_t WS_SEL = 246 * MiB;

__device__ const unsigned char T5B[128] = {
  0, 1, 2, 3, 4, 5, 6, 7, 8, 9, 10, 11, 12, 13, 14, 15, 16, 16, 16, 17, 17, 18, 18, 18, 19, 19, 19, 20, 20, 20, 20, 21,
  21, 21, 21, 22, 22, 22, 22, 22, 23, 23, 23, 23, 23, 23, 24, 24, 24, 24, 24, 24, 25, 25, 25, 25, 25, 25, 25, 26, 26, 26, 26, 26,
  26, 26, 26, 27, 27, 27, 27, 27, 27, 27, 27, 27, 27, 28, 28, 28, 28, 28, 28, 28, 28, 28, 28, 29, 29, 29, 29, 29, 29, 29, 29, 29,
  29, 29, 29, 30, 30, 30, 30, 30, 30, 30, 30, 30, 30, 30, 30, 30, 30, 31, 31, 31, 31, 31, 31, 31, 31, 31, 31, 31, 31, 31, 31, 31};

DEV float bf2f(bf16_t v) { return __uint_as_float(((unsigned)v) << 16); }
DEV bf16_t f2bf(float f) { unsigned u = __float_as_uint(f); u += 0x7fffu + ((u >> 16) & 1u); return (bf16_t)(u >> 16); }
DEV float wsum(float v) {
#pragma unroll
  for (int o = 32; o > 0; o >>= 1) v += __shfl_xor(v, o);
  return v;
}
DEV float wmaxf(float v) {
#pragma unroll
  for (int o = 32; o > 0; o >>= 1) v = fmaxf(v, __shfl_xor(v, o));
  return v;
}
DEV float sigmoidf_(float x) { return 1.0f / (1.0f + expf(-x)); }
DEV float gelu_exact(float x) { return 0.5f * x * (1.0f + erff(x * 0.70710678118654752f)); }
DEV void wave_lds_sync() { asm volatile("s_waitcnt lgkmcnt(0)" ::: "memory"); __builtin_amdgcn_wave_barrier(); asm volatile("" ::: "memory"); }
DEV float t5bias(const float* t5, int head, int dist) { int d = dist < 127 ? dist : 127; d = d < 0 ? 0 : d; return t5[(int)T5B[d] * 8 + head]; }


constexpr int NTHR = 512, NWV = NTHR / 64;
#define WAVE_IDS const int lane = threadIdx.x & 63, wv = threadIdx.x >> 6; const int gw = blockIdx.x * NWV + wv, nw = gridDim.x * NWV; (void)lane; (void)gw; (void)nw;

DEV void ph_rms1024(const float* __restrict__ src, const float* __restrict__ g, bf16_t* __restrict__ dst, int rows) {
  WAVE_IDS
  for (int r = gw; r < rows; r += nw) {
    const float4* s4 = (const float4*)(src + (size_t)r * 1024);
    float4 v[4]; float ss = 0.f;
#pragma unroll
    for (int j = 0; j < 4; ++j) { v[j] = s4[j * 64 + lane]; ss += v[j].x * v[j].x + v[j].y * v[j].y + v[j].z * v[j].z + v[j].w * v[j].w; }
    ss = wsum(ss);
    const float inv = rsqrtf(ss * (1.0f / 1024.0f) + 1e-6f);
#pragma unroll
    for (int j = 0; j < 4; ++j) {
      const float4 gg = ((const float4*)g)[j * 64 + lane];
      uint2 o;
      o.x = (unsigned)f2bf(v[j].x * inv * gg.x) | ((unsigned)f2bf(v[j].y * inv * gg.y) << 16);
      o.y = (unsigned)f2bf(v[j].z * inv * gg.z) | ((unsigned)f2bf(v[j].w * inv * gg.w) << 16);
      ((uint2*)(dst + (size_t)r * 1024))[j * 64 + lane] = o;
    }
  }
}
template <int PER> DEV void ph_rms_cols(const bf16_t* __restrict__ proj, int col0, const float* __restrict__ g, bf16_t* __restrict__ dst) {
  WAVE_IDS
  constexpr int W = 64 * PER;
  for (int r = gw; r < T; r += nw) {
    float v[PER]; float ss = 0.f;
#pragma unroll
    for (int j = 0; j < PER; ++j) { v[j] = bf2f(proj[(size_t)r * PROJ_LD + col0 + j * 64 + lane]); ss += v[j] * v[j]; }
    ss = wsum(ss);
    const float inv = rsqrtf(ss * (1.0f / W) + 1e-6f);
#pragma unroll
    for (int j = 0; j < PER; ++j) dst[(size_t)r * W + j * 64 + lane] = f2bf(v[j] * inv * g[j * 64 + lane]);
  }
}

DEV int win_src_col(int n) {
  if (n < 1280) return n;
  if (n < 1536) return 1304 + (n - 1280);
  if (n < 1664) return 1560 + (n - 1536);
  if (n < 1696) return 1688 + (n - 1664);
  if (n < 1720) return 1280 + (n - 1696);
  if (n < 1792) return -1;
  return 1720 + (n - 1792);
}
template <int MODE> DEV void ph_convT(const float* __restrict__ W, int K, int Nsrc, bf16_t* __restrict__ WT, int Nout, char* lds) {
  float (*t)[33] = (float (*)[33])lds;
  const int tx = threadIdx.x & 31, ty = threadIdx.x >> 5;
  const int ntn = (Nout + 31) / 32, ntk = K / 32;
  for (int tile = blockIdx.x; tile < ntn * ntk; tile += gridDim.x) {
    const int n0 = (tile % ntn) * 32, k0 = (tile / ntn) * 32;
#pragma unroll
    for (int i = 0; i < 2; ++i) {
      const int k = k0 + ty + 16 * i, n = n0 + tx;
      const int sc = (MODE == 1) ? win_src_col(n) : n;
      t[ty + 16 * i][tx] = (n < Nout && sc >= 0) ? W[(size_t)k * Nsrc + sc] : 0.f;
    }
    __syncthreads();
#pragma unroll
    for (int i = 0; i < 2; ++i) {
      const int n = n0 + ty + 16 * i, k = k0 + tx;
      if (n < Nout) WT[(size_t)n * K + k] = f2bf(t[tx][ty + 16 * i]);
    }
    __syncthreads();
  }
}
DEV void ph_conv_plain(const float* __restrict__ src, bf16_t* __restrict__ dst, int n) {
  for (int i = blockIdx.x * NTHR + threadIdx.x; i < n; i += gridDim.x * NTHR) dst[i] = f2bf(src[i]);
}

DEV void gemm_tile(const bf16_t* __restrict__ A, int lda, const bf16_t* __restrict__ Bt, int ldb, int m0, int n0, int K, float (&acc)[4][4], char* lds) {
  float (*sA)[132] = (float (*)[132])lds;
  float (*sB)[68] = (float (*)[68])(lds + 32 * 132 * 4);
  const int tid = threadIdx.x, ty = tid >> 4, tx = tid & 15;
  const int lr = tid >> 2, lk = (tid & 3) * 8;
  for (int k0 = 0; k0 < K; k0 += 32) {
    {
      const uint4 va = *(const uint4*)(A + (size_t)(m0 + lr) * lda + k0 + lk);
      const unsigned ua[4] = {va.x, va.y, va.z, va.w};
#pragma unroll
      for (int j = 0; j < 4; ++j) { sA[lk + 2 * j][lr] = __uint_as_float(ua[j] << 16); sA[lk + 2 * j + 1][lr] = __uint_as_float(ua[j] & 0xffff0000u); }
    }
    if (tid < 256) {
      const uint4 vb = *(const uint4*)(Bt + (size_t)(n0 + lr) * ldb + k0 + lk);
      const unsigned ub[4] = {vb.x, vb.y, vb.z, vb.w};
#pragma unroll
      for (int j = 0; j < 4; ++j) { sB[lk + 2 * j][lr] = __uint_as_float(ub[j] << 16); sB[lk + 2 * j + 1][lr] = __uint_as_float(ub[j] & 0xffff0000u); }
    }
    __syncthreads();
#pragma unroll 8
    for (int k = 0; k < 32; ++k) {
      const float4 a = *(const float4*)&sA[k][ty * 4];
      const float4 b = *(const float4*)&sB[k][tx * 4];
      const float av[4] = {a.x, a.y, a.z, a.w}, bv[4] = {b.x, b.y, b.z, b.w};
#pragma unroll
      for (int i = 0; i < 4; ++i)
#pragma unroll
        for (int j = 0; j < 4; ++j) acc[i][j] += av[i] * bv[j];
    }
    __syncthreads();
  }
}
struct EpiInProj { bf16_t* proj; bf16_t* gates;
  DEV void operator()(int m, int n, float v) const { if (n < PROJ_LD) proj[(size_t)m * PROJ_LD + n] = f2bf(v); else gates[(size_t)m * 2048 + (n - PROJ_LD)] = f2bf(sigmoidf_(v)); } };
struct EpiStore { bf16_t* dst; int ld;
  DEV void operator()(int m, int n, float v) const { dst[(size_t)m * ld + n] = f2bf(v); } };
struct EpiGelu { bf16_t* dst; int ld;
  DEV void operator()(int m, int n, float v) const { dst[(size_t)m * ld + n] = f2bf(gelu_exact(v)); } };
struct EpiCmpOut { bf16_t* dst;
  DEV void operator()(int m, int n, float v) const { if (m >= BATCH * NC * 2) return; const int g = m & 1, bc = m >> 1, b = bc / NC, c = bc % NC; dst[((size_t)(b * 2 + g) * 128 + c) * 64 + n] = f2bf(v); } };
struct EpiResid { const float* x; float* h;
  DEV void operator()(int m, int n, float v) const { const size_t i = (size_t)m * 1024 + n; h[i] = x[i] + v; } };

template <class Epi> DEV void ph_gemm(const bf16_t* A, int lda, const bf16_t* Bt, int ldb, int M, int N, int K, const Epi& epi, char* lds) {
  const int ntn = N / 64, ntm = M / 128;
  const int ty = threadIdx.x >> 4, tx = threadIdx.x & 15;
  for (int tile = blockIdx.x; tile < ntn * ntm; tile += gridDim.x) {
    const int m0 = (tile / ntn) * 128, n0 = (tile % ntn) * 64;
    float acc[4][4];
#pragma unroll
    for (int i = 0; i < 4; ++i)
#pragma unroll
      for (int j = 0; j < 4; ++j) acc[i][j] = 0.f;
    gemm_tile(A, lda, Bt, ldb, m0, n0, K, acc, lds);
#pragma unroll
    for (int i = 0; i < 4; ++i)
#pragma unroll
      for (int j = 0; j < 4; ++j) epi(m0 + ty * 4 + i, n0 + tx * 4 + j, acc[i][j]);
  }
}
DEV void ph_merge(const bf16_t* onsa, const bf16_t* omla, const bf16_t* wbn, const bf16_t* wbm, const bf16_t* gates, bf16_t* merged, char* lds) {
  const int ntn = 1024 / 64, ntm = T / 128;
  const int ty = threadIdx.x >> 4, tx = threadIdx.x & 15;
  for (int tile = blockIdx.x; tile < ntn * ntm; tile += gridDim.x) {
    const int m0 = (tile / ntn) * 128, n0 = (tile % ntn) * 64;
    float a1[4][4], a2[4][4];
#pragma unroll
    for (int i = 0; i < 4; ++i)
#pragma unroll
      for (int j = 0; j < 4; ++j) { a1[i][j] = 0.f; a2[i][j] = 0.f; }
    gemm_tile(onsa, 512, wbn, 512, m0, n0, 512, a1, lds);
    gemm_tile(omla, 512, wbm, 512, m0, n0, 512, a2, lds);
#pragma unroll
    for (int i = 0; i < 4; ++i)
#pragma unroll
      for (int j = 0; j < 4; ++j) {
        const int m = m0 + ty * 4 + i, n = n0 + tx * 4 + j;
        merged[(size_t)m * 1024 + n] = f2bf(bf2f(gates[(size_t)m * 2048 + n]) * a1[i][j] + bf2f(gates[(size_t)m * 2048 + 1024 + n]) * a2[i][j]);
      }
  }
}

DEV void ph_rope_q(bf16_t* __restrict__ q) {
  const int n = T * 8 * 16;
  for (int i = blockIdx.x * NTHR + threadIdx.x; i < n; i += gridDim.x * NTHR) {
    const int j = i & 15, h = (i >> 4) & 7, t = i >> 7;
    const float pos = (float)(t & (SEQ - 1));
    const float inv_freq = powf(10000.0f, -(float)(2 * j) / 32.0f);
    const float ang = pos * inv_freq, c = cosf(ang), s = sinf(ang);
    bf16_t* p = q + (size_t)t * 768 + h * 96 + 64 + j;
    const float x1 = bf2f(p[0]), x2 = bf2f(p[16]);
    p[0] = f2bf(x1 * c - x2 * s); p[16] = f2bf(x2 * c + x1 * s);
  }
}
DEV void ph_rope_k(const bf16_t* __restrict__ proj, bf16_t* __restrict__ kr) {
  const int n = T * 16;
  for (int i = blockIdx.x * NTHR + threadIdx.x; i < n; i += gridDim.x * NTHR) {
    const int j = i & 15, t = i >> 4;
    const float pos = (float)(t & (SEQ - 1));
    const float inv_freq = powf(10000.0f, -(float)(2 * j) / 32.0f);
    const float ang = pos * inv_freq, c = cosf(ang), s = sinf(ang);
    const float x1 = bf2f(proj[(size_t)t * PROJ_LD + PC_KR + j]), x2 = bf2f(proj[(size_t)t * PROJ_LD + PC_KR + 16 + j]);
    kr[(size_t)t * 32 + j] = f2bf(x1 * c - x2 * s); kr[(size_t)t * 32 + 16 + j] = f2bf(x2 * c + x1 * s);
  }
}
DEV void ph_cmp_gather(const bf16_t* __restrict__ proj, const float* __restrict__ pos, int which, bf16_t* __restrict__ ca) {
  const int n = 2048 * 2048;
  for (int i = blockIdx.x * NTHR + threadIdx.x; i < n; i += gridDim.x * NTHR) {
    const int e = i & 2047, row = i >> 11;
    float v = 0.f;
    if (row < BATCH * NC * 2) {
      const int g = row & 1, bc = row >> 1, b = bc / NC, c = bc % NC, l = e >> 6, d = e & 63;
      v = bf2f(proj[(size_t)(b * SEQ + 16 * c + l) * PROJ_LD + PC_KV + which * 128 + g * 64 + d]) + pos[e];
    }
    ca[i] = f2bf(v);
  }
}

DEV void ph_cmp_attn(const bf16_t* __restrict__ proj, const bf16_t* __restrict__ kc, const bf16_t* __restrict__ vc,
                     const float* __restrict__ t5, bf16_t* __restrict__ ocmp, unsigned* __restrict__ sel, char* lds) {
  WAVE_IDS
  float* P = (float*)(lds + wv * 1024); float* Q = P + 128;
  for (int item = gw; item < BATCH * 2 * SEQ; item += nw) {
    const int t = item & (SEQ - 1), bg = item >> 11, g = bg & 1, b = bg >> 1;
    const size_t tok = (size_t)b * SEQ + t;
    const int nvalid = (t >= 31) ? min(NC, (t - 31) / 16 + 1) : 0;
    const bf16_t* kcb = kc + (size_t)bg * 128 * 64;
    const bf16_t* vcb = vc + (size_t)bg * 128 * 64;
    float impacc = 0.f;
    for (int r = 0; r < 4; ++r) {
      const int head = g * 4 + r;
      Q[lane] = bf2f(proj[tok * PROJ_LD + PC_Q + head * 64 + lane]);
      wave_lds_sync();
      float lg[2];
#pragma unroll
      for (int u = 0; u < 2; ++u) {
        const int c = lane + 64 * u;
        float d = 0.f;
        if (c < nvalid) { const bf16_t* kr = kcb + c * 64; for (int e = 0; e < 64; ++e) d += Q[e] * bf2f(kr[e]); }
        lg[u] = (c < nvalid) ? d * 0.125f + t5bias(t5, head, t - (16 * c + 31)) : -1e30f;
      }
      const float m = wmaxf(fmaxf(lg[0], lg[1]));
      const float e0 = (lane < nvalid) ? expf(lg[0] - m) : 0.f, e1 = (lane + 64 < nvalid) ? expf(lg[1] - m) : 0.f;
      const float s = wsum(e0 + e1);
      const float inv = (nvalid > 0) ? 1.0f / fmaxf(s, 1e-30f) : 0.f;
      P[lane] = e0 * inv; P[lane + 64] = e1 * inv;
      wave_lds_sync();
      float o = 0.f;
      for (int c = 0; c < nvalid; ++c) o += P[c] * bf2f(vcb[c * 64 + lane]);
      ocmp[tok * 512 + head * 64 + lane] = f2bf(o);
      if (lane < 32) { for (int c = 4 * lane - 1; c <= 4 * lane + 3; ++c) if (c >= 0 && c < NC) impacc += P[c]; }
      wave_lds_sync();
    }
    const int cur = t >> 6, n = lane;
    float score = (n > cur) ? -1.0f : ((n == 0 || n == cur || n == cur - 1) ? 1e4f : impacc);
    if (n >= 32) score = -2.0f;
    int rank = 0;
    for (int mth = 0; mth < 32; ++mth) { const float sm = __shfl(score, mth); rank += (sm > score || (sm == score && mth < n)) ? 1 : 0; }
    const unsigned long long bal = __ballot(n < 32 && rank < 16);
    if (lane == 0) sel[item] = (unsigned)bal;
  }
}

DEV void ph_nsa_attn(const bf16_t* __restrict__ proj, const float* __restrict__ t5, const bf16_t* __restrict__ ocmp,
                     const unsigned* __restrict__ sel, bf16_t* __restrict__ onsa, char* lds) {
  WAVE_IDS
  float* P = (float*)(lds + wv * 1024); float* Q = P + 128;
  for (int item = gw; item < BATCH * 2 * SEQ * 4; item += nw) {
    const int r = item & 3, t = (item >> 2) & (SEQ - 1), bg = item >> 13, g = bg & 1, b = bg >> 1;
    const int head = g * 4 + r, cur = t >> 6;
    const size_t tok = (size_t)b * SEQ + t;
    Q[lane] = bf2f(proj[tok * PROJ_LD + PC_Q + head * 64 + lane]) * 0.125f;
    wave_lds_sync();
    const unsigned smask = sel[bg * SEQ + t];
    float res0 = 0.f, res1 = 0.f;
    for (int br = 0; br < 2; ++br) {
      float m = -1e30f, l = 0.f, o = 0.f;
      const int nb0 = (br == 0) ? 0 : max(0, cur - 8);
      for (int nb = nb0; nb <= cur; ++nb) {
        if (br == 0 && !((smask >> nb) & 1u)) continue;
        const int s = nb * 64 + lane, dist = t - s;
        const bool valid = (dist >= 0) && (br == 0 || dist < 512);
        const bf16_t* kp = proj + ((size_t)b * SEQ + s) * PROJ_LD + PC_KV + (2 + 2 * br) * 128 + g * 64;
        float d = 0.f;
        for (int e = 0; e < 64; e += 8) {
          const uint4 kv = *(const uint4*)(kp + e);
          d += Q[e + 0] * __uint_as_float(kv.x << 16) + Q[e + 1] * __uint_as_float(kv.x & 0xffff0000u);
          d += Q[e + 2] * __uint_as_float(kv.y << 16) + Q[e + 3] * __uint_as_float(kv.y & 0xffff0000u);
          d += Q[e + 4] * __uint_as_float(kv.z << 16) + Q[e + 5] * __uint_as_float(kv.z & 0xffff0000u);
          d += Q[e + 6] * __uint_as_float(kv.w << 16) + Q[e + 7] * __uint_as_float(kv.w & 0xffff0000u);
        }
        const float lg = valid ? d + t5bias(t5, head, dist) : -1e30f;
        const float mn = fmaxf(m, wmaxf(lg));
        const float sc = expf(m - mn);
        const float pe = valid ? expf(lg - mn) : 0.f;
        l = l * sc + wsum(pe); m = mn;
        P[lane] = pe;
        wave_lds_sync();
        const bf16_t* vp = proj + ((size_t)b * SEQ + nb * 64) * PROJ_LD + PC_KV + (3 + 2 * br) * 128 + g * 64 + lane;
        float acc = 0.f;
        for (int k = 0; k < 64; ++k) acc += P[k] * bf2f(vp[(size_t)k * PROJ_LD]);
        o = o * sc + acc;
        wave_lds_sync();
      }
      if (br == 0) res0 = o / fmaxf(l, 1e-30f); else res1 = o / fmaxf(l, 1e-30f);
    }
    const bf16_t* gp = proj + tok * PROJ_LD + PC_GATE + head * 3;
    const float g0 = sigmoidf_(bf2f(gp[0])), g1 = sigmoidf_(bf2f(gp[1])), g2 = sigmoidf_(bf2f(gp[2]));
    const float oc = bf2f(ocmp[tok * 512 + head * 64 + lane]);
    onsa[tok * 512 + head * 64 + lane] = f2bf(g0 * oc + g1 * res0 + g2 * res1);
    wave_lds_sync();
  }
}

DEV void ph_mla_attn(const bf16_t* __restrict__ mq, const bf16_t* __restrict__ mkv, const bf16_t* __restrict__ kr, bf16_t* __restrict__ omla, char* lds) {
  WAVE_IDS
  float* P = (float*)(lds + wv * 1024); float* Q = P + 128;
  const float scale = 0.10206207261596575f;
  for (int item = gw; item < BATCH * 8 * SEQ; item += nw) {
    const int h = item & 7, t = (item >> 3) & (SEQ - 1), b = item >> 14;
    const size_t tok = (size_t)b * SEQ + t;
    Q[lane] = bf2f(mq[tok * 768 + h * 96 + lane]) * scale;
    if (lane < 32) Q[64 + lane] = bf2f(mq[tok * 768 + h * 96 + 64 + lane]) * scale;
    wave_lds_sync();
    float m = -1e30f, l = 0.f, o = 0.f;
    for (int nb = 0; nb <= (t >> 6); ++nb) {
      const int s = nb * 64 + lane;
      const bool valid = s <= t;
      const bf16_t* kp = mkv + ((size_t)b * SEQ + s) * 1024 + h * 128;
      const bf16_t* rp = kr + ((size_t)b * SEQ + s) * 32;
      float d = 0.f;
      for (int e = 0; e < 64; e += 8) {
        const uint4 kv = *(const uint4*)(kp + e);
        d += Q[e + 0] * __uint_as_float(kv.x << 16) + Q[e + 1] * __uint_as_float(kv.x & 0xffff0000u);
        d += Q[e + 2] * __uint_as_float(kv.y << 16) + Q[e + 3] * __uint_as_float(kv.y & 0xffff0000u);
        d += Q[e + 4] * __uint_as_float(kv.z << 16) + Q[e + 5] * __uint_as_float(kv.z & 0xffff0000u);
        d += Q[e + 6] * __uint_as_float(kv.w << 16) + Q[e + 7] * __uint_as_float(kv.w & 0xffff0000u);
      }
      for (int e = 0; e < 32; e += 8) {
        const uint4 kv = *(const uint4*)(rp + e);
        d += Q[64 + e + 0] * __uint_as_float(kv.x << 16) + Q[64 + e + 1] * __uint_as_float(kv.x & 0xffff0000u);
        d += Q[64 + e + 2] * __uint_as_float(kv.y << 16) + Q[64 + e + 3] * __uint_as_float(kv.y & 0xffff0000u);
        d += Q[64 + e + 4] * __uint_as_float(kv.z << 16) + Q[64 + e + 5] * __uint_as_float(kv.z & 0xffff0000u);
        d += Q[64 + e + 6] * __uint_as_float(kv.w << 16) + Q[64 + e + 7] * __uint_as_float(kv.w & 0xffff0000u);
      }
      const float lg = valid ? d : -1e30f;
      const float mn = fmaxf(m, wmaxf(lg));
      const float sc = expf(m - mn);
      const float pe = valid ? expf(lg - mn) : 0.f;
      l = l * sc + wsum(pe); m = mn;
      P[lane] = pe;
      wave_lds_sync();
      const bf16_t* vp = mkv + ((size_t)b * SEQ + nb * 64) * 1024 + h * 128 + 64 + lane;
      float acc = 0.f;
      for (int k = 0; k < 64; ++k) acc += P[k] * bf2f(vp[(size_t)k * 1024]);
      o = o * sc + acc;
      wave_lds_sync();
    }
    omla[tok * 512 + h * 64 + lane] = f2bf(o / fmaxf(l, 1e-30f));
    wave_lds_sync();
  }
}

DEV void wave_argmax(float& v, int& idx) {
#pragma unroll
  for (int o = 32; o > 0; o >>= 1) {
    const float ov = __shfl_xor(v, o); const int oi = __shfl_xor(idx, o);
    if (ov > v || (ov == v && oi < idx)) { v = ov; idx = oi; }
  }
}
DEV void ph_route(const bf16_t* __restrict__ pq, const bf16_t* __restrict__ subk, int* __restrict__ pidx, float* __restrict__ pw, char* lds) {
  WAVE_IDS
  float* Q = (float*)(lds + wv * 1024);
  float* TS = Q + 128;
  int* TI = (int*)(TS + 32);
  for (int item = gw; item < T * 8; item += nw) {
    const int h = item & 7, t = item >> 3;
    Q[lane] = bf2f(pq[(size_t)t * 1024 + h * 128 + lane]);
    Q[lane + 64] = bf2f(pq[(size_t)t * 1024 + h * 128 + 64 + lane]);
    wave_lds_sync();
    for (int p = 0; p < 2; ++p) {
      const bf16_t* kb = subk + (size_t)((h * 2 + p) * 128) * 64;
      float s0 = 0.f, s1 = 0.f;
      for (int e = 0; e < 64; ++e) { const float qv = Q[p * 64 + e]; s0 += qv * bf2f(kb[lane * 64 + e]); s1 += qv * bf2f(kb[(lane + 64) * 64 + e]); }
      for (int k = 0; k < 16; ++k) {
        float v = (s0 >= s1) ? s0 : s1; int idx = (s0 >= s1) ? lane : lane + 64;
        wave_argmax(v, idx);
        if (lane == 0) { TS[p * 16 + k] = v; TI[p * 16 + k] = idx; }
        if (idx == lane) s0 = -3e38f;
        if (idx == lane + 64) s1 = -3e38f;
      }
    }
    wave_lds_sync();
    float cv[4];
#pragma unroll
    for (int u = 0; u < 4; ++u) { const int f = lane + 64 * u; cv[u] = TS[f >> 4] + TS[16 + (f & 15)]; }
    int myexp = 0; float mybest = 0.f, best0 = 0.f, den = 0.f;
#pragma unroll
    for (int k = 0; k < 16; ++k) {
      float v = cv[0]; int idx = lane;
#pragma unroll
      for (int u = 1; u < 4; ++u) if (cv[u] > v) { v = cv[u]; idx = lane + 64 * u; }
      wave_argmax(v, idx);
#pragma unroll
      for (int u = 0; u < 4; ++u) if (idx == lane + 64 * u) cv[u] = -3e38f;
      if (k == 0) best0 = v;
      den += expf(v - best0);
      if (lane == k) { myexp = TI[idx >> 4] * 128 + TI[16 + (idx & 15)]; mybest = v; }
    }
    if (lane < 16) { pidx[(size_t)t * 128 + h * 16 + lane] = myexp; pw[(size_t)t * 128 + h * 16 + lane] = expf(mybest - best0) / den; }
    wave_lds_sync();
  }
}

DEV void ph_experts(const bf16_t* __restrict__ hn, const int* __restrict__ pidx, const float* __restrict__ pw,
                    const float* __restrict__ pu, const float* __restrict__ pv, const float* __restrict__ gfin, float* __restrict__ out) {
  WAVE_IDS
  for (int t = gw; t < T; t += nw) {
    float4 x[4], y[4];
#pragma unroll
    for (int j = 0; j < 4; ++j) {
      const uint2 r = ((const uint2*)(hn + (size_t)t * 1024))[j * 64 + lane];
      x[j] = make_float4(__uint_as_float(r.x << 16), __uint_as_float(r.x & 0xffff0000u), __uint_as_float(r.y << 16), __uint_as_float(r.y & 0xffff0000u));
      y[j] = make_float4(0.f, 0.f, 0.f, 0.f);
    }
    const int e0 = pidx[(size_t)t * 128 + lane], e1 = pidx[(size_t)t * 128 + 64 + lane];
    const float w0 = pw[(size_t)t * 128 + lane], w1 = pw[(size_t)t * 128 + 64 + lane];
    for (int s = 0; s < 128; ++s) {
      const int e = __shfl((s < 64) ? e0 : e1, s & 63);
      const float w = __shfl((s < 64) ? w0 : w1, s & 63);
      const float4* ur = (const float4*)(pu + (size_t)e * 1024);
      float d = 0.f;
#pragma unroll
      for (int j = 0; j < 4; ++j) { const float4 u = ur[j * 64 + lane]; d += u.x * x[j].x + u.y * x[j].y + u.z * x[j].z + u.w * x[j].w; }
      d = wsum(d);
      const float c = w * gelu_exact(d);
      const float4* vr = (const float4*)(pv + (size_t)e * 1024);
#pragma unroll
      for (int j = 0; j < 4; ++j) { const float4 v = vr[j * 64 + lane]; y[j].x += c * v.x; y[j].y += c * v.y; y[j].z += c * v.z; y[j].w += c * v.w; }
    }
    float4* o4 = (float4*)(out + (size_t)t * 1024);
    float ss = 0.f;
#pragma unroll
    for (int j = 0; j < 4; ++j) {
      const float4 hv = o4[j * 64 + lane];
      y[j].x += hv.x; y[j].y += hv.y; y[j].z += hv.z; y[j].w += hv.w;
      ss += y[j].x * y[j].x + y[j].y * y[j].y + y[j].z * y[j].z + y[j].w * y[j].w;
    }
    ss = wsum(ss);
    const float inv = rsqrtf(ss * (1.0f / 1024.0f) + 1e-6f);
#pragma unroll
    for (int j = 0; j < 4; ++j) {
      const float4 gg = ((const float4*)gfin)[j * 64 + lane];
      o4[j * 64 + lane] = make_float4(y[j].x * inv * gg.x, y[j].y * inv * gg.y, y[j].z * inv * gg.z, y[j].w * inv * gg.w);
    }
  }
}

struct Args { const float* in[23]; float* out; char* ws; };
constexpr int LDS_BYTES = 32 * 1024;

__global__ __launch_bounds__(NTHR) void mega(Args a) {
  extern __shared__ __attribute__((aligned(16))) char lds[];
  cg::grid_group grid = cg::this_grid();
  const float* x = a.in[0]; const float* ln_mix_g = a.in[1]; const float* w_in = a.in[2];
  const float* cmp_pos_k = a.in[3]; const float* cmp_pos_v = a.in[4];
  const float* cmp_k_w1 = a.in[5]; const float* cmp_k_w2 = a.in[6]; const float* cmp_v_w1 = a.in[7]; const float* cmp_v_w2 = a.in[8];
  const float* q_norm_g = a.in[9]; const float* kv_norm_g = a.in[10]; const float* w_uq = a.in[11]; const float* w_ukv = a.in[12];
  const float* w_bn = a.in[13]; const float* w_bm = a.in[14]; const float* w_out = a.in[15];
  const float* ln_ffn_g = a.in[16]; const float* w_query = a.in[17]; const float* sub_keys = a.in[18];
  const float* peer_u = a.in[19]; const float* peer_v = a.in[20]; const float* t5 = a.in[21]; const float* ln_final_g = a.in[22];
  float* out = a.out; char* ws = a.ws;
  bf16_t* WinT = (bf16_t*)(ws + WS_WIN); bf16_t* WbnT = (bf16_t*)(ws + WS_WBN); bf16_t* WbmT = (bf16_t*)(ws + WS_WBM);
  bf16_t* WoutT = (bf16_t*)(ws + WS_WOUT); bf16_t* WqT = (bf16_t*)(ws + WS_WQ);
  bf16_t* CkW1T = (bf16_t*)(ws + WS_CKW1); bf16_t* CvW1T = (bf16_t*)(ws + WS_CVW1); bf16_t* CkW2T = (bf16_t*)(ws + WS_CKW2); bf16_t* CvW2T = (bf16_t*)(ws + WS_CVW2);
  bf16_t* UqT = (bf16_t*)(ws + WS_UQ); bf16_t* UkvT = (bf16_t*)(ws + WS_UKV); bf16_t* SUBK = (bf16_t*)(ws + WS_SUBK);
  bf16_t* GATES = (bf16_t*)(ws + WS_GATES); bf16_t* PQ = (bf16_t*)(ws + WS_PQ);
  bf16_t* PROJ = (bf16_t*)(ws + WS_PROJ); bf16_t* MERGED = (bf16_t*)(ws + WS_MERGED);
  int* PIDX = (int*)(ws + WS_PIDX); float* PW = (float*)(ws + WS_PW);
  bf16_t* XN = (bf16_t*)(ws + WS_XN); bf16_t* MLAKV = (bf16_t*)(ws + WS_MLAKV); bf16_t* HN = (bf16_t*)(ws + WS_HN);
  bf16_t* MLAQ = (bf16_t*)(ws + WS_MLAQ); bf16_t* KROPE = (bf16_t*)(ws + WS_KROPE);
  bf16_t* KC = (bf16_t*)(ws + WS_KC); bf16_t* VC = (bf16_t*)(ws + WS_VC);
  bf16_t* ONSA = (bf16_t*)(ws + WS_ONSA); bf16_t* OMLA = (bf16_t*)(ws + WS_OMLA);
  bf16_t* CA = (bf16_t*)(ws + WS_CA); bf16_t* CA2 = (bf16_t*)(ws + WS_CA2); bf16_t* HID = (bf16_t*)(ws + WS_HID); bf16_t* HID2 = (bf16_t*)(ws + WS_HID2);
  bf16_t* CQN = (bf16_t*)(ws + WS_CQN); bf16_t* CKVN = (bf16_t*)(ws + WS_CKVN); bf16_t* OCMP = (bf16_t*)(ws + WS_OCMP);
  unsigned* SEL = (unsigned*)(ws + WS_SEL);

  ph_convT<1>(w_in, 1024, IN_COLS, WinT, 3840, lds);
  ph_convT<0>(w_bn, 512, 1024, WbnT, 1024, lds);
  ph_convT<0>(w_bm, 512, 1024, WbmT, 1024, lds);
  ph_convT<0>(w_out, 1024, 1024, WoutT, 1024, lds);
  ph_convT<0>(w_query, 1024, 1024, WqT, 1024, lds);
  ph_convT<0>(cmp_k_w1, 2048, 256, CkW1T, 256, lds);
  ph_convT<0>(cmp_v_w1, 2048, 256, CvW1T, 256, lds);
  ph_convT<0>(cmp_k_w2, 256, 64, CkW2T, 64, lds);
  ph_convT<0>(cmp_v_w2, 256, 64, CvW2T, 64, lds);
  ph_convT<0>(w_uq, 256, 768, UqT, 768, lds);
  ph_convT<0>(w_ukv, 128, 1024, UkvT, 1024, lds);
  ph_conv_plain(sub_keys, SUBK, 16 * 128 * 64);
  ph_rms1024(x, ln_mix_g, XN, T);
  grid.sync();
  ph_gemm(XN, 1024, WinT, 1024, T, 3840, 1024, EpiInProj{PROJ, GATES}, lds);
  grid.sync();
  ph_rms_cols<4>(PROJ, PC_CQ, q_norm_g, CQN);
  ph_rms_cols<2>(PROJ, PC_CKV, kv_norm_g, CKVN);
  ph_rope_k(PROJ, KROPE);
  ph_cmp_gather(PROJ, cmp_pos_k, 0, CA);
  ph_cmp_gather(PROJ, cmp_pos_v, 1, CA2);
  grid.sync();
  ph_gemm(CQN, 256, UqT, 256, T, 768, 256, EpiStore{MLAQ, 768}, lds);
  ph_gemm(CKVN, 128, UkvT, 128, T, 1024, 128, EpiStore{MLAKV, 1024}, lds);
  ph_gemm(CA, 2048, CkW1T, 2048, 2048, 256, 2048, EpiGelu{HID, 256}, lds);
  ph_gemm(CA2, 2048, CvW1T, 2048, 2048, 256, 2048, EpiGelu{HID2, 256}, lds);
  grid.sync();
  ph_rope_q(MLAQ);
  ph_gemm(HID, 256, CkW2T, 256, 2048, 64, 256, EpiCmpOut{KC}, lds);
  ph_gemm(HID2, 256, CvW2T, 256, 2048, 64, 256, EpiCmpOut{VC}, lds);
  grid.sync();
  ph_cmp_attn(PROJ, KC, VC, t5, OCMP, SEL, lds);
  ph_mla_attn(MLAQ, MLAKV, KROPE, OMLA, lds);
  grid.sync();
  ph_nsa_attn(PROJ, t5, OCMP, SEL, ONSA, lds);
  grid.sync();
  ph_merge(ONSA, OMLA, WbnT, WbmT, GATES, MERGED, lds);
  grid.sync();
  ph_gemm(MERGED, 1024, WoutT, 1024, T, 1024, 1024, EpiResid{x, out}, lds);
  grid.sync();
  ph_rms1024(out, ln_ffn_g, HN, T);
  grid.sync();
  ph_gemm(HN, 1024, WqT, 1024, T, 1024, 1024, EpiStore{PQ, 1024}, lds);
  grid.sync();
  ph_route(PQ, SUBK, PIDX, PW, lds);
  grid.sync();
  ph_experts(HN, PIDX, PW, peer_u, peer_v, ln_final_g, out);
}

extern "C" void kernel_launch(void* const* d_in, const int* in_sizes, int n_in, void* d_out, int out_size, void* d_ws, size_t ws_size, hipStream_t stream) {
  if (n_in != 23 || ws_size < 256 * MiB) { fprintf(stderr, "kernel_launch: unexpected n_in %d / ws_size %zu\n", n_in, ws_size); return; }
  static int grid_blocks = 0;
  if (!grid_blocks) {
    int dev = 0, cus = 0, per_cu = 0;
    (void)hipGetDevice(&dev);
    (void)hipDeviceGetAttribute(&cus, hipDeviceAttributeMultiprocessorCount, dev);
    (void)hipOccupancyMaxActiveBlocksPerMultiprocessor(&per_cu, (const void*)mega, NTHR, LDS_BYTES);
    if (per_cu < 1) { fprintf(stderr, "kernel_launch: occupancy query returned %d\n", per_cu); per_cu = 1; }
    if (per_cu > 2) per_cu = 2;
    grid_blocks = cus * per_cu;
    fprintf(stderr, "kernel_launch: cus %d per_cu %d grid %d ws %zu\n", cus, per_cu, grid_blocks, ws_size);
  }
  Args a{};
  for (int i = 0; i < 23; ++i) a.in[i] = (const float*)d_in[i];
  a.out = (float*)d_out; a.ws = (char*)d_ws;
  void* args[] = {&a};
  hipError_t e = hipLaunchCooperativeKernel((const void*)mega, dim3(grid_blocks), dim3(NTHR), args, LDS_BYTES, stream);
  if (e != hipSuccess) fprintf(stderr, "cooperative launch failed: %s (grid %d)\n", hipGetErrorString(e), grid_blocks);
}
```

```cpp
#include <hip/hip_runtime.h>
#include <stdint.h>
#include <cstdio>
#include <hip/hip_cooperative_groups.h>
namespace cg = cooperative_groups;

typedef unsigned short bf16_t;
#define DEV __device__ __forceinline__

constexpr int BATCH = 8, SEQ = 2048, DM = 1024, T = BATCH * SEQ;
constexpr int IN_COLS = 3768;
constexpr int PROJ_LD = 1792;
constexpr int PC_Q = 0, PC_KV = 512, PC_CQ = 1280, PC_CKV = 1536, PC_KR = 1664, PC_GATE = 1696;
constexpr int NC = 127;
constexpr size_t MiB = 1u << 20;

constexpr size_t WS_WIN = 1 * MiB;
constexpr size_t WS_WBN = 9 * MiB;
constexpr size_t WS_WBM = 10 * MiB;
constexpr size_t WS_WOUT = 11 * MiB;
constexpr size_t WS_WQ = 13 * MiB;
constexpr size_t WS_CKW1 = 15 * MiB;
constexpr size_t WS_CVW1 = 16 * MiB;
constexpr size_t WS_CKW2 = 17 * MiB;
constexpr size_t WS_CVW2 = 17 * MiB + 64 * 1024;
constexpr size_t WS_UQ = 17 * MiB + 256 * 1024;
constexpr size_t WS_UKV = 17 * MiB + 768 * 1024;
constexpr size_t WS_SUBK = 18 * MiB;
constexpr size_t WS_ROPE = 18 * MiB + 512 * 1024;
constexpr size_t WS_GATES = 20 * MiB;
constexpr size_t WS_PQ = 20 * MiB;
constexpr size_t WS_PROJ = 84 * MiB;
constexpr size_t WS_MERGED = 84 * MiB;
constexpr size_t WS_PIDX = 84 * MiB;
constexpr size_t WS_PW = 92 * MiB;
constexpr size_t WS_XN = 140 * MiB;
constexpr size_t WS_MLAKV = 140 * MiB;
constexpr size_t WS_HN = 140 * MiB;
constexpr size_t WS_MLAQ = 172 * MiB;
constexpr size_t WS_KROPE = 196 * MiB;
constexpr size_t WS_KC = 197 * MiB;
constexpr size_t WS_VC = 197 * MiB + 512 * 1024;
constexpr size_t WS_ONSA = 198 * MiB;
constexpr size_t WS_OMLA = 214 * MiB;
constexpr size_t WS_CA = 198 * MiB;
constexpr size_t WS_HID = 206 * MiB;
constexpr size_t WS_HID2 = 207 * MiB;
constexpr size_t WS_CA2 = 214 * MiB;
constexpr size_t WS_CQN = 230 * MiB;
constexpr size_t WS_CKVN = 238 * MiB;
constexpr size_t WS_OCMP = 230 * MiB;
constexpr size_t WS_SEL = 246 * MiB;

__device__ const unsigned char T5B[128] = {
  0, 1, 2, 3, 4, 5, 6, 7, 8, 9, 10, 11, 12, 13, 14, 15, 16, 16, 16, 17, 17, 18, 18, 18, 19, 19, 19, 20, 20, 20, 20, 21,
  21, 21, 21, 22, 22, 22, 22, 22, 23, 23, 23, 23, 23, 23, 24, 24, 24, 24, 24, 24, 25, 25, 25, 25, 25, 25, 25, 26, 26, 26, 26, 26,
  26, 26, 26, 27, 27, 27, 27, 27, 27, 27, 27, 27, 27, 28, 28, 28, 28, 28, 28, 28, 28, 28, 28, 29, 29, 29, 29, 29, 29, 29, 29, 29,
  29, 29, 29, 30, 30, 30, 30, 30, 30, 30, 30, 30, 30, 30, 30, 30, 30, 31, 31, 31, 31, 31, 31, 31, 31, 31, 31, 31, 31, 31, 31, 31};

DEV float bf2f(bf16_t v) { return __uint_as_float(((unsigned)v) << 16); }
DEV bf16_t f2bf(float f) { unsigned u = __float_as_uint(f); u += 0x7fffu + ((u >> 16) & 1u); return (bf16_t)(u >> 16); }
DEV float wsum(float v) {
#pragma unroll
  for (int o = 32; o > 0; o >>= 1) v += __shfl_xor(v, o);
  return v;
}
DEV float wmaxf(float v) {
#pragma unroll
  for (int o = 32; o > 0; o >>= 1) v = fmaxf(v, __shfl_xor(v, o));
  return v;
}
DEV float sigmoidf_(float x) { return 1.0f / (1.0f + expf(-x)); }
DEV float gelu_exact(float x) { return 0.5f * x * (1.0f + erff(x * 0.70710678118654752f)); }
DEV void wave_lds_sync() { asm volatile("s_waitcnt lgkmcnt(0)" ::: "memory"); __builtin_amdgcn_wave_barrier(); asm volatile("" ::: "memory"); }
DEV float t5bias(const float* t5, int head, int dist) { int d = dist < 127 ? dist : 127; d = d < 0 ? 0 : d; return t5[(int)T5B[d] * 8 + head]; }


namespace pg8 {
#define PG8_LAS __attribute__((address_space(3)))
typedef unsigned short bf16_t;
typedef short bf16x8 __attribute__((ext_vector_type(8)));
typedef float f32x4 __attribute__((ext_vector_type(4)));
typedef unsigned u32x4 __attribute__((ext_vector_type(4)));
constexpr int BM = 256, BK = 64, HALF = 128, HTB = HALF * BK * 2  , STAGE_BYTES = 8 * HTB, NXCD = 8, WGM = 8;

__host__ __device__ __forceinline__ int lds_byte(int r, int c) { const int st = (r >> 4) * 2 + (c >> 5), rr = r & 15, cc = c & 31, ob = rr * 64 + cc * 2; return st * 1024 + (ob ^ (((ob >> 9) & 1) << 5)); }
__host__ __device__ __forceinline__ void stage_rc(int b, int& R, int& C) { const int st = b / 1024, sb = b % 1024, swz = sb ^ (((sb >> 9) & 1) << 5); R = (st >> 1) * 16 + swz / 64; C = (st & 1) * 32 + (swz % 64) / 2; }
__host__ __device__ __forceinline__ int perm32(int rho) { const int n = rho >> 4, i = rho & 15; return 8 * (i >> 2) + 4 * n + (i & 3); }

struct Unit { int pm, pn; };
struct Gemm { const bf16_t* A; const bf16_t* Bt; int M, N, K; };

struct StaticOrder {
    int nM, nN, nwg, G, c;
    __host__ __device__ void init(int M, int N, int G_, int c_) { nM = M / BM; nN = N / BM; nwg = nM * nN; G = G_; c = c_; }
    __host__ __device__ bool next(int i, Unit& u) const {
        const long L = (long)i * G + c; if (L >= nwg) return false;
        int wgid = (int)L; { const int q = nwg / NXCD, r = nwg % NXCD, xcd = wgid % NXCD, off = wgid / NXCD; wgid = (xcd < r ? xcd * (q + 1) : r * (q + 1) + (xcd - r) * q) + off; }
        const int nig = WGM * nN, gid = wgid / nig, fm = gid * WGM, gsz = (nM - fm) < WGM ? (nM - fm) : WGM;
        u.pm = fm + ((wgid % nig) % gsz); u.pn = (wgid % nig) / gsz; return true;
    }
    __device__ __forceinline__ void a_ready(const Unit&) const {}
    __device__ __forceinline__ void done(const Unit&) const {}
};

__device__ __forceinline__ unsigned cvt_pk_bf16(float lo, float hi) { unsigned r; asm volatile("v_cvt_pk_bf16_f32 %0, %1, %2" : "=v"(r) : "v"(lo), "v"(hi)); return r; }
typedef float f32x2 __attribute__((ext_vector_type(2)));
__device__ __forceinline__ f32x2 gelu_pk(f32x2 v) {
    const f32x2 av = __builtin_elementwise_abs(v), d = av * 0.2316418882f + 1.0f;
    f32x2 t; t.x = __builtin_amdgcn_rcpf(d.x); t.y = __builtin_amdgcn_rcpf(d.y);
    f32x2 q = t * 0.5307027145f + (-0.7265760135f); q = q * t + 0.7107068705f; q = q * t + (-0.142248368f); q = q * t + 0.127414796f; q = q * t;
    const f32x2 s = (v * v) * (-0.72134752044f);
    f32x2 e; e.x = __builtin_amdgcn_exp2f(s.x); e.y = __builtin_amdgcn_exp2f(s.y);
    const f32x2 m = v * (q * e), r = v - m;
    f32x2 o; o.x = v.x < 0.f ? m.x : r.x; o.y = v.y < 0.f ? m.y : r.y; return o;
}

template <int ACT  > struct EpiBf16 {
    static constexpr bool PERM = true, AFTER_DRAIN = false; static_assert(ACT == 0 || ACT == 1, "EpiBf16: ACT is 0 (none) or 1 (gelu_pk)");
    bf16_t* O; int ldc; const float* bias; int split_cols; size_t split_stride; float scale0;
    __device__ __forceinline__ void operator()(const f32x4 (&acc)[2][2][4][2], const Unit& u, int wr, int wc, int fr, int fq) const {
        const int row0 = u.pm * BM + wr * 64 + fr; int colt = u.pn * BM; bf16_t* base = O;
        float sc = 1.f; if (split_cols) { const int t = colt / split_cols; base += (size_t)t * split_stride; colt -= t * split_cols; if (t == 0) sc = scale0; }
        const int col0 = colt + wc * 32 + 8 * fq, bcol0 = u.pn * BM + wc * 32 + 8 * fq;
        f32x4 bv[2][2];
#pragma unroll
        for (int bj = 0; bj < 2; ++bj)
#pragma unroll
            for (int n = 0; n < 2; ++n) bv[bj][n] = bias ? *(const f32x4*)(bias + bcol0 + bj * HALF + 4 * n) : (f32x4){0.f, 0.f, 0.f, 0.f};
#pragma unroll
        for (int ai = 0; ai < 2; ++ai)
#pragma unroll
            for (int m = 0; m < 4; ++m) { bf16_t* rowp = base + (size_t)(row0 + ai * HALF + m * 16) * ldc + col0;
#pragma unroll
                for (int bj = 0; bj < 2; ++bj) { f32x4 v0 = acc[ai][bj][m][0] + bv[bj][0], v1 = acc[ai][bj][m][1] + bv[bj][1];
                    if (ACT == 1) { f32x2 a = gelu_pk((f32x2){v0[0], v0[1]}), b = gelu_pk((f32x2){v0[2], v0[3]}), c = gelu_pk((f32x2){v1[0], v1[1]}), d = gelu_pk((f32x2){v1[2], v1[3]});
                        v0 = (f32x4){a.x, a.y, b.x, b.y}; v1 = (f32x4){c.x, c.y, d.x, d.y}; }
                    v0 = v0 * sc; v1 = v1 * sc; u32x4 w; w.x = cvt_pk_bf16(v0[0], v0[1]); w.y = cvt_pk_bf16(v0[2], v0[3]); w.z = cvt_pk_bf16(v1[0], v1[1]); w.w = cvt_pk_bf16(v1[2], v1[3]);
                    *(u32x4*)(rowp + bj * HALF) = w; } }
    }
};

struct PanelStats {
    unsigned* xbuf;
    unsigned* cnt;
    unsigned* tmo;
    int ntn; float eps;
    unsigned code;
    __device__ __forceinline__ bool run(const f32x4 (&v)[2][2][4][2], const Unit& u, int wr, int wc, int fr, int fq, PG8_LAS unsigned char* lds, int wid, int lane) const {
        typedef float f32x2v __attribute__((ext_vector_type(2)));
        PG8_LAS f32x2v* P = (PG8_LAS f32x2v*)lds;
        PG8_LAS f32x2v* S = (PG8_LAS f32x2v*)(lds + 8192);
        PG8_LAS unsigned* flag = (PG8_LAS unsigned*)(lds + 8192 + 2048);
#pragma unroll
        for (int ai = 0; ai < 2; ++ai)
#pragma unroll
            for (int m = 0; m < 4; ++m) {
                float s = 0.f;
#pragma unroll
                for (int bj = 0; bj < 2; ++bj)
#pragma unroll
                    for (int n = 0; n < 2; ++n) { const f32x4 x = v[ai][bj][m][n]; s += (x[0] + x[1]) + (x[2] + x[3]); }
                s += __shfl_xor(s, 16); s += __shfl_xor(s, 32);
                const float mw = s * (1.0f / 64.0f); float q = 0.f;
#pragma unroll
                for (int bj = 0; bj < 2; ++bj)
#pragma unroll
                    for (int n = 0; n < 2; ++n) { const f32x4 d = v[ai][bj][m][n] - mw; q += (d[0] * d[0] + d[1] * d[1]) + (d[2] * d[2] + d[3] * d[3]); }
                q += __shfl_xor(q, 16); q += __shfl_xor(q, 32);
                if (fq == 0) P[(ai * HALF + wr * 64 + m * 16 + fr) * 4 + wc] = (f32x2v){mw, q};
            }
        asm volatile("s_waitcnt lgkmcnt(0)" ::: "memory"); __builtin_amdgcn_s_barrier(); asm volatile("" ::: "memory");
#if defined(BROKEN_EXCHANGE_NO_WAIT)
#warning BROKEN CONTROL BUILD: the row-statistics exchange does not wait; results are wrong by design
        if (blockIdx.x >= 64) { const long long t0_ = clock64(); while (clock64() - t0_ < 60000) __builtin_amdgcn_s_sleep(8); }
#endif
        const int row = wid * 32 + (lane & 31);
        if (lane < 32) {
            const f32x2v a = P[row * 4 + 0], b = P[row * 4 + 1], c = P[row * 4 + 2], d = P[row * 4 + 3];
            const float mt = (a.x + b.x + c.x + d.x) * 0.25f;
            const float da = a.x - mt, db = b.x - mt, dc = c.x - mt, dd = d.x - mt;
            const float m2 = (a.y + b.y) + (c.y + d.y) + 64.0f * ((da * da + db * db) + (dc * dc + dd * dd));
            unsigned long long* slot = (unsigned long long*)xbuf + ((size_t)(u.pm * BM + row) * 4 + u.pn);
            __hip_atomic_store(slot, ((unsigned long long)__float_as_uint(m2) << 32) | __float_as_uint(mt), __ATOMIC_RELAXED, __HIP_MEMORY_SCOPE_AGENT);
        }
        asm volatile("s_waitcnt vmcnt(0)" ::: "memory");
        if (lane == 0) __hip_atomic_fetch_add(cnt + 64 * u.pm, 1u, __ATOMIC_RELAXED, __HIP_MEMORY_SCOPE_AGENT);
        if (wid == 0) {
            bool dead = false; const unsigned long long t0 = __builtin_amdgcn_s_memrealtime(); const unsigned want = 8u * (unsigned)ntn;
            for (;;) {
#if defined(BROKEN_EXCHANGE_NO_WAIT)
                break;
#endif
                if ((unsigned)__builtin_amdgcn_readfirstlane(__hip_atomic_load(cnt + 64 * u.pm, __ATOMIC_RELAXED, __HIP_MEMORY_SCOPE_AGENT)) >= want) break;
                if (__builtin_amdgcn_s_memrealtime() - t0 > 2000000ull) {
                    if (lane == 0) { unsigned expect = 0u; __hip_atomic_compare_exchange_strong(tmo + 1, &expect, code | (unsigned)(u.pm & 0xff), __ATOMIC_RELAXED, __ATOMIC_RELAXED, __HIP_MEMORY_SCOPE_AGENT);
                                     __hip_atomic_store(tmo, 1u, __ATOMIC_RELAXED, __HIP_MEMORY_SCOPE_AGENT); }
                    dead = true; break; }
                __builtin_amdgcn_s_sleep(2);
            }
            __builtin_amdgcn_fence(__ATOMIC_ACQUIRE, "agent");
            if (lane == 0) flag[0] = dead ? 1u : 0u;
        }
        asm volatile("s_waitcnt vmcnt(0) lgkmcnt(0)" ::: "memory"); __builtin_amdgcn_s_barrier(); asm volatile("" ::: "memory");
        const bool bad = flag[0] != 0u;
        if (lane < 32) {
            const unsigned long long* slot = (const unsigned long long*)xbuf + (size_t)(u.pm * BM + row) * 4; float mt[4], m2[4]; float ms = 0.f;
#pragma unroll
            for (int t = 0; t < 4; ++t) { if (t < ntn) { const unsigned long long w = __hip_atomic_load(slot + t, __ATOMIC_RELAXED, __HIP_MEMORY_SCOPE_AGENT); mt[t] = __uint_as_float((unsigned)w); m2[t] = __uint_as_float((unsigned)(w >> 32)); } else { mt[t] = 0.f; m2[t] = 0.f; } ms += mt[t]; }
            const float mean = ms / (float)ntn; float q = 0.f;
#pragma unroll
            for (int t = 0; t < 4; ++t) if (t < ntn) { const float dm = mt[t] - mean; q += m2[t] + 256.0f * dm * dm; }
            S[row] = (f32x2v){mean, 1.0f / sqrtf(q / (256.0f * (float)ntn) + eps)};
        }
        asm volatile("s_waitcnt lgkmcnt(0)" ::: "memory"); __builtin_amdgcn_s_barrier(); asm volatile("" ::: "memory");
        return bad;
    }
};
struct EpiLnRes {
    static constexpr bool PERM = false, AFTER_DRAIN = true;
    const float* base; float* out; int ldc; const float* bias; PanelStats st; unsigned poison;
    __device__ __forceinline__ void fused(f32x4 (&acc)[2][2][4][2], const Unit& u, int wr, int wc, int fr, int fq, PG8_LAS unsigned char* lds, int wid, int lane) const {
        typedef float f32x2v __attribute__((ext_vector_type(2)));
        const PG8_LAS f32x2v* S = (const PG8_LAS f32x2v*)(lds + 8192);
        const int col0 = u.pn * BM + wc * 32 + 4 * fq;
#pragma unroll
        for (int bj = 0; bj < 2; ++bj)
#pragma unroll
            for (int n = 0; n < 2; ++n) { const f32x4 bv = bias ? *(const f32x4*)(bias + col0 + bj * HALF + n * 16) : (f32x4){0.f, 0.f, 0.f, 0.f};
#pragma unroll
                for (int ai = 0; ai < 2; ++ai)
#pragma unroll
                    for (int m = 0; m < 4; ++m) acc[ai][bj][m][n] += bv; }
        f32x4 pre[4][2][2];
#pragma unroll
        for (int m = 0; m < 4; ++m) { const size_t off = (size_t)(u.pm * BM + wr * 64 + m * 16 + fr) * ldc + col0;
#pragma unroll
            for (int bj = 0; bj < 2; ++bj)
#pragma unroll
                for (int n = 0; n < 2; ++n) pre[m][bj][n] = *(const f32x4*)(base + off + bj * HALF + n * 16); }
        const bool bad = st.run(acc, u, wr, wc, fr, fq, lds, wid, lane) || poison != 0u;
        const float qnan = __builtin_nanf("");
#pragma unroll
        for (int ai = 0; ai < 2; ++ai)
#pragma unroll
            for (int m = 0; m < 4; ++m) { const int r = ai * HALF + wr * 64 + m * 16 + fr; const f32x2v sr = S[r]; const size_t off = (size_t)(u.pm * BM + r) * ldc + col0;
#pragma unroll
                for (int bj = 0; bj < 2; ++bj)
#pragma unroll
                    for (int n = 0; n < 2; ++n) { const f32x4 bs = ai == 0 ? pre[m][bj][n] : *(const f32x4*)(base + off + bj * HALF + n * 16); f32x4 o = bs + (acc[ai][bj][m][n] - sr.x) * sr.y;
                        if (bad) o = (f32x4){qnan, qnan, qnan, qnan}; *(f32x4*)(out + off + bj * HALF + n * 16) = o; }
                if (m & 1) asm volatile("" ::: "memory"); }
    }
};
struct EpiLnResLn {
    static constexpr bool PERM = false, AFTER_DRAIN = true;
    const float* base; float* out; bf16_t* xn; int ldc; const float* bias; PanelStats st1, st2; unsigned poison;
    __device__ __forceinline__ void fused(f32x4 (&acc)[2][2][4][2], const Unit& u, int wr, int wc, int fr, int fq, PG8_LAS unsigned char* lds, int wid, int lane) const {
        typedef float f32x2v __attribute__((ext_vector_type(2))); typedef unsigned u32x2v __attribute__((ext_vector_type(2)));
        const PG8_LAS f32x2v* S = (const PG8_LAS f32x2v*)(lds + 8192);
        const int col0 = u.pn * BM + wc * 32 + 4 * fq;
#pragma unroll
        for (int bj = 0; bj < 2; ++bj)
#pragma unroll
            for (int n = 0; n < 2; ++n) { const f32x4 bv = bias ? *(const f32x4*)(bias + col0 + bj * HALF + n * 16) : (f32x4){0.f, 0.f, 0.f, 0.f};
#pragma unroll
                for (int ai = 0; ai < 2; ++ai)
#pragma unroll
                    for (int m = 0; m < 4; ++m) acc[ai][bj][m][n] += bv; }
        bool bad = st1.run(acc, u, wr, wc, fr, fq, lds, wid, lane) || poison != 0u;
        const float qnan = __builtin_nanf("");
#pragma unroll
        for (int ai = 0; ai < 2; ++ai)
#pragma unroll
            for (int m = 0; m < 4; ++m) { const int r = ai * HALF + wr * 64 + m * 16 + fr; const f32x2v sr = S[r]; const size_t off = (size_t)(u.pm * BM + r) * ldc + col0;
#pragma unroll
                for (int bj = 0; bj < 2; ++bj)
#pragma unroll
                    for (int n = 0; n < 2; ++n) { const f32x4 bs = *(const f32x4*)(base + off + bj * HALF + n * 16); acc[ai][bj][m][n] = bs + (acc[ai][bj][m][n] - sr.x) * sr.y; }
                asm volatile("" : "+v"(acc[ai][0][m][0]), "+v"(acc[ai][0][m][1]), "+v"(acc[ai][1][m][0]), "+v"(acc[ai][1][m][1]));
                if (m & 1) asm volatile("" ::: "memory"); }
        const bool bad1 = bad;
        bad = st2.run(acc, u, wr, wc, fr, fq, lds, wid, lane) || bad;
#pragma unroll
        for (int ai = 0; ai < 2; ++ai)
#pragma unroll
            for (int m = 0; m < 4; ++m) { const int r = ai * HALF + wr * 64 + m * 16 + fr; const f32x2v sr = S[r]; const size_t off = (size_t)(u.pm * BM + r) * ldc + col0;
#pragma unroll
                for (int bj = 0; bj < 2; ++bj)
#pragma unroll
                    for (int n = 0; n < 2; ++n) { const f32x4 x1 = acc[ai][bj][m][n]; *(f32x4*)(out + off + bj * HALF + n * 16) = bad1 ? (f32x4){qnan, qnan, qnan, qnan} : x1;
                        const f32x4 o = (x1 - sr.x) * sr.y; u32x2v w; w.x = cvt_pk_bf16(o[0], o[1]); w.y = cvt_pk_bf16(o[2], o[3]);
                        if (bad) { w.x = 0x7fc07fc0u; w.y = 0x7fc07fc0u; } *(u32x2v*)(xn + off + bj * HALF + n * 16) = w; }
                asm volatile("" ::: "memory"); }
    }
};

template <class Epi, class Sched, bool ALIGN_EPI = false, bool SP2 = false>
__device__ __forceinline__ void gemm_phase(PG8_LAS unsigned char* lds, const Gemm g, const Sched& S, const Epi& E) {
    const int tid = threadIdx.x, wid = __builtin_amdgcn_readfirstlane(tid >> 6), lane = tid & 63, wr = wid >> 2, wc = wid & 3, fr = lane & 15, fq = lane >> 4;
    int K = g.K; asm volatile("" : "+s"(K)); const int nt = K / BK;
    unsigned voffA[2], voffB[2];
#pragma unroll
    for (int i = 0; i < 2; ++i) { int R, C; stage_rc(tid * 16 + i * 8192, R, C); const int Rb = Epi::PERM ? ((R & ~31) + perm32(R & 31)) : R;
        voffA[i] = (unsigned)(R * K + C) * 2u; voffB[i] = (unsigned)(Rb * K + C) * 2u; }
    const size_t kstep = (size_t)(BK * 2);
    const size_t hstep = (size_t)HALF * K * 2;
    const size_t tstep = 2 * hstep;
    const unsigned ldsw = (unsigned)wid * 1024u;
    const int aoff = lds_byte(wr * 64 + fr, fq * 8), boff = lds_byte(wc * 32 + fr, fq * 8);
#define PG8_SA(b, h) (((b) * 2 + (h)) * HTB)
#define PG8_SB(b, h) ((4 + (b) * 2 + (h)) * HTB)
#define PG8_STAGE(bufoff, gbase, voff) do { _Pragma("unroll") for (int _i = 0; _i < 2; ++_i) \
        __builtin_amdgcn_global_load_lds((const unsigned*)((const char*)(gbase) + (voff)[_i]), (PG8_LAS unsigned*)(lds + (bufoff) + ldsw + _i * 8192), 16, 0, 0); } while (0)
#define PG8_LDA(dst, b, h) do { _Pragma("unroll") for (int m = 0; m < 4; ++m) _Pragma("unroll") for (int k = 0; k < 2; ++k) dst[m][k] = *(const PG8_LAS bf16x8*)(lds + PG8_SA(b, h) + aoff + m * 2048 + k * 1024); } while (0)
#define PG8_LDB(dst, b, h) do { _Pragma("unroll") for (int n = 0; n < 2; ++n) _Pragma("unroll") for (int k = 0; k < 2; ++k) dst[n][k] = *(const PG8_LAS bf16x8*)(lds + PG8_SB(b, h) + boff + n * 2048 + k * 1024); } while (0)
#define PG8_MMA(ai, bj, At, Bt) do { __builtin_amdgcn_s_setprio(1); _Pragma("unroll") for (int m = 0; m < 4; ++m) _Pragma("unroll") for (int n = 0; n < 2; ++n) _Pragma("unroll") for (int k = 0; k < 2; ++k) \
        acc[ai][bj][m][n] = __builtin_amdgcn_mfma_f32_16x16x32_bf16(Bt[n][k], At[m][k], acc[ai][bj][m][n], 0, 0, 0); __builtin_amdgcn_s_setprio(0); } while (0)
#define PG8_WAIT_V(n) asm volatile("s_waitcnt vmcnt(" #n ")" ::: "memory")
#define PG8_WAIT_L(n) asm volatile("s_waitcnt lgkmcnt(" #n ")" ::: "memory")
#define PG8_BAR __builtin_amdgcn_s_barrier()
#define PG8_SCHED __builtin_amdgcn_sched_barrier(0)
    Unit cur, nxt; int ui = 0;
    if (!S.next(0, cur)) return;
    f32x4 acc[2][2][4][2];
#pragma unroll
    for (int a = 0; a < 2; ++a)
#pragma unroll
        for (int b = 0; b < 2; ++b)
#pragma unroll
            for (int m = 0; m < 4; ++m)
#pragma unroll
                for (int n = 0; n < 2; ++n) acc[a][b][m][n] = (f32x4){0.f, 0.f, 0.f, 0.f};
    bf16x8 At[4][2], B0[2][2], B1[2][2];
    const char* cA = (const char*)g.A + (size_t)cur.pm * tstep; const char* cB = (const char*)g.Bt + (size_t)cur.pn * tstep;
    S.a_ready(cur);
    if constexpr (SP2) {
        PG8_STAGE(PG8_SB(0, 0), cB, voffB); PG8_STAGE(PG8_SB(0, 1), cB + hstep, voffB); PG8_STAGE(PG8_SA(0, 0), cA, voffA); PG8_STAGE(PG8_SA(0, 1), cA + hstep, voffA);
        if (wr == 1) PG8_BAR;
        PG8_WAIT_V(2); PG8_BAR;
        PG8_STAGE(PG8_SB(1, 0), cB + kstep, voffB); PG8_STAGE(PG8_SA(1, 0), cA + kstep, voffA); PG8_STAGE(PG8_SB(1, 1), cB + hstep + kstep, voffB);
        PG8_WAIT_V(6); PG8_BAR;
    } else {
        PG8_STAGE(PG8_SB(0, 0), cB, voffB); PG8_STAGE(PG8_SA(0, 0), cA, voffA); PG8_STAGE(PG8_SB(0, 1), cB + hstep, voffB); PG8_STAGE(PG8_SA(0, 1), cA + hstep, voffA);
        if (wr == 1) PG8_BAR;
        PG8_WAIT_V(4); PG8_BAR;
        PG8_STAGE(PG8_SB(1, 0), cB + kstep, voffB); PG8_STAGE(PG8_SA(1, 0), cA + kstep, voffA); PG8_STAGE(PG8_SB(1, 1), cB + hstep + kstep, voffB);
        PG8_WAIT_V(6); PG8_BAR;
    }
    for (;;) {
        const bool has_next = S.next(ui + 1, nxt);
        const char* nA = has_next ? (const char*)g.A + (size_t)nxt.pm * tstep : cA; const char* nB = has_next ? (const char*)g.Bt + (size_t)nxt.pn * tstep : cB;
        for (int t = 0; t < nt; t += 2) {
            const bool last = (t == nt - 2);
            const char* a1 = cA + (size_t)(t + 1) * kstep;
            const char* a2 = last ? nA : cA + (size_t)(t + 2) * kstep; const char* b2 = last ? nB : cB + (size_t)(t + 2) * kstep;
            const char* a3 = a2 + kstep; const char* b3 = b2 + kstep;
            if (last && has_next) S.a_ready(nxt);
            if constexpr (SP2) {
            PG8_LDB(B0, 0, 0); PG8_LDB(B1, 0, 1); PG8_SCHED; PG8_LDA(At, 0, 0); PG8_STAGE(PG8_SA(1, 1), a1 + hstep, voffA);
            PG8_WAIT_V(8); PG8_WAIT_L(0); PG8_BAR; PG8_MMA(0, 0, At, B0); PG8_MMA(0, 1, At, B1); PG8_BAR; PG8_SCHED;
            PG8_LDA(At, 0, 1); PG8_STAGE(PG8_SB(0, 0), b2, voffB); PG8_STAGE(PG8_SB(0, 1), b2 + hstep, voffB); PG8_STAGE(PG8_SA(0, 0), a2, voffA);
            PG8_WAIT_V(8); PG8_WAIT_L(0); PG8_BAR; PG8_MMA(1, 0, At, B0); PG8_MMA(1, 1, At, B1); PG8_BAR; PG8_SCHED;
            PG8_LDB(B0, 1, 0); PG8_LDB(B1, 1, 1); PG8_SCHED; PG8_LDA(At, 1, 0); PG8_STAGE(PG8_SA(0, 1), a2 + hstep, voffA);
            PG8_WAIT_V(8); PG8_WAIT_L(0); PG8_BAR; PG8_MMA(0, 0, At, B0); PG8_MMA(0, 1, At, B1); PG8_BAR; PG8_SCHED;
            PG8_LDA(At, 1, 1); PG8_STAGE(PG8_SB(1, 0), b3, voffB); PG8_STAGE(PG8_SB(1, 1), b3 + hstep, voffB); PG8_STAGE(PG8_SA(1, 0), a3, voffA);
            PG8_WAIT_V(8); PG8_WAIT_L(0); PG8_BAR; PG8_MMA(1, 0, At, B0); PG8_MMA(1, 1, At, B1); PG8_BAR; PG8_SCHED;
            } else {
            PG8_LDB(B0, 0, 0); PG8_SCHED; PG8_LDA(At, 0, 0); PG8_STAGE(PG8_SA(1, 1), a1 + hstep, voffA);
            PG8_WAIT_L(8); PG8_BAR; PG8_WAIT_L(0); PG8_MMA(0, 0, At, B0); PG8_BAR; PG8_SCHED;
            PG8_LDB(B1, 0, 1); PG8_STAGE(PG8_SB(0, 0), b2, voffB);
            PG8_BAR; PG8_WAIT_L(0); PG8_MMA(0, 1, At, B1); PG8_BAR;
            PG8_LDA(At, 0, 1); PG8_STAGE(PG8_SA(0, 0), a2, voffA);
            PG8_BAR; PG8_WAIT_L(0); PG8_MMA(1, 0, At, B0); PG8_BAR; PG8_SCHED;
            PG8_STAGE(PG8_SB(0, 1), b2 + hstep, voffB);
            PG8_WAIT_V(6); PG8_BAR; PG8_MMA(1, 1, At, B1); PG8_BAR;
            PG8_LDB(B0, 1, 0); PG8_SCHED; PG8_LDA(At, 1, 0); PG8_STAGE(PG8_SA(0, 1), a2 + hstep, voffA);
            PG8_WAIT_L(8); PG8_BAR; PG8_WAIT_L(0); PG8_MMA(0, 0, At, B0); PG8_BAR; PG8_SCHED;
            PG8_LDB(B1, 1, 1); PG8_STAGE(PG8_SB(1, 0), b3, voffB);
            PG8_BAR; PG8_WAIT_L(0); PG8_MMA(0, 1, At, B1); PG8_BAR;
            PG8_LDA(At, 1, 1); PG8_STAGE(PG8_SA(1, 0), a3, voffA);
            PG8_BAR; PG8_WAIT_L(0); PG8_MMA(1, 0, At, B0); PG8_BAR; PG8_SCHED;
            PG8_STAGE(PG8_SB(1, 1), b3 + hstep, voffB);
            PG8_WAIT_V(6); PG8_BAR; PG8_MMA(1, 1, At, B1); PG8_BAR;
            }
        }
        if constexpr (ALIGN_EPI) { if (wr == 0) PG8_BAR; }
        if constexpr (!Epi::AFTER_DRAIN) { E(acc, cur, wr, wc, fr, fq); S.done(cur); }
        if (!has_next) break;
#pragma unroll
        for (int a = 0; a < 2; ++a)
#pragma unroll
            for (int b = 0; b < 2; ++b)
#pragma unroll
                for (int m = 0; m < 4; ++m)
#pragma unroll
                    for (int n = 0; n < 2; ++n) acc[a][b][m][n] = (f32x4){0.f, 0.f, 0.f, 0.f};
        cur = nxt; cA = nA; cB = nB; ++ui;
        if constexpr (ALIGN_EPI) { if (wr == 1) PG8_BAR; }
    }
    PG8_WAIT_V(0);
    if constexpr (!ALIGN_EPI) { if (wr == 0) PG8_BAR; }
    PG8_BAR;
    if constexpr (Epi::AFTER_DRAIN) { E.fused(acc, cur, wr, wc, fr, fq, lds, wid, lane); S.done(cur); }
#undef PG8_SA
#undef PG8_SB
#undef PG8_STAGE
#undef PG8_LDA
#undef PG8_LDB
#undef PG8_MMA
#undef PG8_WAIT_V
#undef PG8_WAIT_L
#undef PG8_BAR
#undef PG8_SCHED
}
}

namespace pg8 {
constexpr float LOG2E = 1.4426950408889634f;
constexpr float QS_NSA = 0.125f * LOG2E;
constexpr float QS_MLA = 0.10206207261596575f * LOG2E;
__device__ __forceinline__ float fast_sigmoid(float x) { return __builtin_amdgcn_rcpf(1.0f + __builtin_amdgcn_exp2f(-LOG2E * x)); }
__device__ __forceinline__ float lo_bf(unsigned u) { return __uint_as_float(u << 16); }
__device__ __forceinline__ float hi_bf(unsigned u) { return __uint_as_float(u & 0xffff0000u); }
struct EpiInProjF {
    static constexpr bool PERM = true, AFTER_DRAIN = false;
    bf16_t* proj; bf16_t* gates;
    __device__ __forceinline__ void operator()(const f32x4 (&acc)[2][2][4][2], const Unit& u, int wr, int wc, int fr, int fq) const {
        const bool isg = u.pn >= 7;
        bf16_t* base = isg ? gates : proj; const int ld = isg ? 2048 : 1792; const int colt = isg ? (u.pn - 7) * BM : u.pn * BM;
        const float sc = (u.pn < 2) ? QS_NSA : 1.0f;
        const int row0 = u.pm * BM + wr * 64 + fr, col0 = colt + wc * 32 + 8 * fq;
#pragma unroll
        for (int ai = 0; ai < 2; ++ai)
#pragma unroll
            for (int m = 0; m < 4; ++m) { bf16_t* rowp = base + (size_t)(row0 + ai * HALF + m * 16) * ld + col0;
#pragma unroll
                for (int bj = 0; bj < 2; ++bj) { f32x4 v0 = acc[ai][bj][m][0], v1 = acc[ai][bj][m][1];
                    if (isg) {
#pragma unroll
                        for (int e = 0; e < 4; ++e) { v0[e] = fast_sigmoid(v0[e]); v1[e] = fast_sigmoid(v1[e]); } }
                    else { v0 = v0 * sc; v1 = v1 * sc; }
                    u32x4 w; w.x = cvt_pk_bf16(v0[0], v0[1]); w.y = cvt_pk_bf16(v0[2], v0[3]); w.z = cvt_pk_bf16(v1[0], v1[1]); w.w = cvt_pk_bf16(v1[2], v1[3]);
                    *(u32x4*)(rowp + bj * HALF) = w; } }
    }
};
template <int PASS> struct EpiMergeF {
    static constexpr bool PERM = true, AFTER_DRAIN = false;
    const bf16_t* gates; bf16_t* merged;
    __device__ __forceinline__ void operator()(const f32x4 (&acc)[2][2][4][2], const Unit& u, int wr, int wc, int fr, int fq) const {
        const int row0 = u.pm * BM + wr * 64 + fr, col0 = u.pn * BM + wc * 32 + 8 * fq;
#pragma unroll
        for (int ai = 0; ai < 2; ++ai)
#pragma unroll
            for (int m = 0; m < 4; ++m) { const size_t r = (size_t)(row0 + ai * HALF + m * 16);
#pragma unroll
                for (int bj = 0; bj < 2; ++bj) { const int c = col0 + bj * HALF;
                    const u32x4 g = *(const u32x4*)(gates + r * 2048 + PASS * 1024 + c);
                    f32x4 v0 = acc[ai][bj][m][0], v1 = acc[ai][bj][m][1];
                    v0[0] *= lo_bf(g.x); v0[1] *= hi_bf(g.x); v0[2] *= lo_bf(g.y); v0[3] *= hi_bf(g.y);
                    v1[0] *= lo_bf(g.z); v1[1] *= hi_bf(g.z); v1[2] *= lo_bf(g.w); v1[3] *= hi_bf(g.w);
                    if (PASS == 1) { const u32x4 o = *(const u32x4*)(merged + r * 1024 + c);
                        v0[0] += lo_bf(o.x); v0[1] += hi_bf(o.x); v0[2] += lo_bf(o.y); v0[3] += hi_bf(o.y);
                        v1[0] += lo_bf(o.z); v1[1] += hi_bf(o.z); v1[2] += lo_bf(o.w); v1[3] += hi_bf(o.w); }
                    u32x4 w; w.x = cvt_pk_bf16(v0[0], v0[1]); w.y = cvt_pk_bf16(v0[2], v0[3]); w.z = cvt_pk_bf16(v1[0], v1[1]); w.w = cvt_pk_bf16(v1[2], v1[3]);
                    *(u32x4*)(merged + r * 1024 + c) = w; } }
    }
};
struct EpiResidF {
    static constexpr bool PERM = false, AFTER_DRAIN = false;
    const float* x; float* h;
    __device__ __forceinline__ void operator()(const f32x4 (&acc)[2][2][4][2], const Unit& u, int wr, int wc, int fr, int fq) const {
        const int row0 = u.pm * BM + wr * 64 + fr, col0 = u.pn * BM + wc * 32 + 4 * fq;
#pragma unroll
        for (int ai = 0; ai < 2; ++ai)
#pragma unroll
            for (int m = 0; m < 4; ++m) { const size_t off = (size_t)(row0 + ai * HALF + m * 16) * 1024 + col0;
#pragma unroll
                for (int bj = 0; bj < 2; ++bj)
#pragma unroll
                    for (int n = 0; n < 2; ++n) { const f32x4 xv = *(const f32x4*)(x + off + bj * HALF + n * 16); *(f32x4*)(h + off + bj * HALF + n * 16) = xv + acc[ai][bj][m][n]; } }
    }
};
struct EpiMlaQF {
    static constexpr bool PERM = false, AFTER_DRAIN = false;
    bf16_t* q; const float2* cs;
    __device__ __forceinline__ void operator()(const f32x4 (&acc)[2][2][4][2], const Unit& u, int wr, int wc, int fr, int fq) const {
        const int row0 = u.pm * BM + wr * 64 + fr;
#pragma unroll
        for (int bj = 0; bj < 2; ++bj) {
            const int X = u.pn * BM + bj * HALF + wc * 32;
            const bool rope = (X % 96) == 64;
#pragma unroll
            for (int ai = 0; ai < 2; ++ai)
#pragma unroll
                for (int m = 0; m < 4; ++m) { const int r = row0 + ai * HALF + m * 16; const int pos = r & (SEQ - 1);
                    f32x4 v0 = acc[ai][bj][m][0], v1 = acc[ai][bj][m][1];
                    if (rope) {
#pragma unroll
                        for (int j = 0; j < 4; ++j) { const float2 c = cs[pos * 16 + 4 * fq + j]; const float x1 = v0[j], x2 = v1[j]; v0[j] = x1 * c.x - x2 * c.y; v1[j] = x2 * c.x + x1 * c.y; } }
                    v0 = v0 * QS_MLA; v1 = v1 * QS_MLA;
                    bf16_t* p = q + (size_t)r * 768 + X + 4 * fq;
                    uint2 w0, w1; w0.x = cvt_pk_bf16(v0[0], v0[1]); w0.y = cvt_pk_bf16(v0[2], v0[3]); w1.x = cvt_pk_bf16(v1[0], v1[1]); w1.y = cvt_pk_bf16(v1[2], v1[3]);
                    *(uint2*)p = w0; *(uint2*)(p + 16) = w1; }
        }
    }
};
}

#define PG8_SP2 true
#define PG8_ALIGN true
constexpr int NTHR = 512, NWV = NTHR / 64;
#define WAVE_IDS const int lane = threadIdx.x & 63, wv = threadIdx.x >> 6; const int gw = blockIdx.x * NWV + wv, nw = gridDim.x * NWV; (void)lane; (void)gw; (void)nw;

DEV void ph_rms1024(const float* __restrict__ src, const float* __restrict__ g, bf16_t* __restrict__ dst, int rows) {
  WAVE_IDS
  for (int r = gw; r < rows; r += nw) {
    const float4* s4 = (const float4*)(src + (size_t)r * 1024);
    float4 v[4]; float ss = 0.f;
#pragma unroll
    for (int j = 0; j < 4; ++j) { v[j] = s4[j * 64 + lane]; ss += v[j].x * v[j].x + v[j].y * v[j].y + v[j].z * v[j].z + v[j].w * v[j].w; }
    ss = wsum(ss);
    const float inv = rsqrtf(ss * (1.0f / 1024.0f) + 1e-6f);
#pragma unroll
    for (int j = 0; j < 4; ++j) {
      const float4 gg = ((const float4*)g)[j * 64 + lane];
      uint2 o;
      o.x = (unsigned)f2bf(v[j].x * inv * gg.x) | ((unsigned)f2bf(v[j].y * inv * gg.y) << 16);
      o.y = (unsigned)f2bf(v[j].z * inv * gg.z) | ((unsigned)f2bf(v[j].w * inv * gg.w) << 16);
      ((uint2*)(dst + (size_t)r * 1024))[j * 64 + lane] = o;
    }
  }
}
template <int PER> DEV void ph_rms_cols(const bf16_t* __restrict__ proj, int col0, const float* __restrict__ g, bf16_t* __restrict__ dst) {
  WAVE_IDS
  constexpr int W = 64 * PER;
  for (int r = gw; r < T; r += nw) {
    float v[PER]; float ss = 0.f;
#pragma unroll
    for (int j = 0; j < PER; ++j) { v[j] = bf2f(proj[(size_t)r * PROJ_LD + col0 + j * 64 + lane]); ss += v[j] * v[j]; }
    ss = wsum(ss);
    const float inv = rsqrtf(ss * (1.0f / W) + 1e-6f);
#pragma unroll
    for (int j = 0; j < PER; ++j) dst[(size_t)r * W + j * 64 + lane] = f2bf(v[j] * inv * g[j * 64 + lane]);
  }
}

DEV int win_src_col(int n) {
  if (n < 1280) return n;
  if (n < 1536) return 1304 + (n - 1280);
  if (n < 1664) return 1560 + (n - 1536);
  if (n < 1696) return 1688 + (n - 1664);
  if (n < 1720) return 1280 + (n - 1696);
  if (n < 1792) return -1;
  return 1720 + (n - 1792);
}
template <int MODE> DEV void ph_convT(const float* __restrict__ W, int K, int Nsrc, bf16_t* __restrict__ WT, int Nout, char* lds) {
  float (*t)[33] = (float (*)[33])lds;
  const int tx = threadIdx.x & 31, ty = threadIdx.x >> 5;
  const int ntn = (Nout + 31) / 32, ntk = K / 32;
  for (int tile = blockIdx.x; tile < ntn * ntk; tile += gridDim.x) {
    const int n0 = (tile % ntn) * 32, k0 = (tile / ntn) * 32;
#pragma unroll
    for (int i = 0; i < 2; ++i) {
      const int k = k0 + ty + 16 * i, n = n0 + tx;
      const int sc = (MODE == 1) ? win_src_col(n) : n;
      t[ty + 16 * i][tx] = (n < Nout && sc >= 0) ? W[(size_t)k * Nsrc + sc] : 0.f;
    }
    __syncthreads();
#pragma unroll
    for (int i = 0; i < 2; ++i) {
      const int n = n0 + ty + 16 * i, k = k0 + tx;
      if (n < Nout) WT[(size_t)n * K + k] = f2bf(t[tx][ty + 16 * i]);
    }
    __syncthreads();
  }
}
DEV void ph_conv_plain(const float* __restrict__ src, bf16_t* __restrict__ dst, int n) {
  for (int i = blockIdx.x * NTHR + threadIdx.x; i < n; i += gridDim.x * NTHR) dst[i] = f2bf(src[i]);
}

DEV void gemm_tile(const bf16_t* __restrict__ A, int lda, const bf16_t* __restrict__ Bt, int ldb, int m0, int n0, int K, float (&acc)[4][4], char* lds) {
  float (*sA)[132] = (float (*)[132])lds;
  float (*sB)[68] = (float (*)[68])(lds + 32 * 132 * 4);
  const int tid = threadIdx.x, ty = tid >> 4, tx = tid & 15;
  const int lr = tid >> 2, lk = (tid & 3) * 8;
  for (int k0 = 0; k0 < K; k0 += 32) {
    {
      const uint4 va = *(const uint4*)(A + (size_t)(m0 + lr) * lda + k0 + lk);
      const unsigned ua[4] = {va.x, va.y, va.z, va.w};
#pragma unroll
      for (int j = 0; j < 4; ++j) { sA[lk + 2 * j][lr] = __uint_as_float(ua[j] << 16); sA[lk + 2 * j + 1][lr] = __uint_as_float(ua[j] & 0xffff0000u); }
    }
    if (tid < 256) {
      const uint4 vb = *(const uint4*)(Bt + (size_t)(n0 + lr) * ldb + k0 + lk);
      const unsigned ub[4] = {vb.x, vb.y, vb.z, vb.w};
#pragma unroll
      for (int j = 0; j < 4; ++j) { sB[lk + 2 * j][lr] = __uint_as_float(ub[j] << 16); sB[lk + 2 * j + 1][lr] = __uint_as_float(ub[j] & 0xffff0000u); }
    }
    __syncthreads();
#pragma unroll 8
    for (int k = 0; k < 32; ++k) {
      const float4 a = *(const float4*)&sA[k][ty * 4];
      const float4 b = *(const float4*)&sB[k][tx * 4];
      const float av[4] = {a.x, a.y, a.z, a.w}, bv[4] = {b.x, b.y, b.z, b.w};
#pragma unroll
      for (int i = 0; i < 4; ++i)
#pragma unroll
        for (int j = 0; j < 4; ++j) acc[i][j] += av[i] * bv[j];
    }
    __syncthreads();
  }
}
struct EpiInProj { bf16_t* proj; bf16_t* gates;
  DEV void operator()(int m, int n, float v) const { if (n < PROJ_LD) proj[(size_t)m * PROJ_LD + n] = f2bf(v); else gates[(size_t)m * 2048 + (n - PROJ_LD)] = f2bf(sigmoidf_(v)); } };
struct EpiStore { bf16_t* dst; int ld;
  DEV void operator()(int m, int n, float v) const { dst[(size_t)m * ld + n] = f2bf(v); } };
struct EpiGelu { bf16_t* dst; int ld;
  DEV void operator()(int m, int n, float v) const { dst[(size_t)m * ld + n] = f2bf(gelu_exact(v)); } };
struct EpiCmpOut { bf16_t* dst;
  DEV void operator()(int m, int n, float v) const { if (m >= BATCH * NC * 2) return; const int g = m & 1, bc = m >> 1, b = bc / NC, c = bc % NC; dst[((size_t)(b * 2 + g) * 128 + c) * 64 + n] = f2bf(v); } };
struct EpiResid { const float* x; float* h;
  DEV void operator()(int m, int n, float v) const { const size_t i = (size_t)m * 1024 + n; h[i] = x[i] + v; } };

template <class Epi> DEV void ph_gemm(const bf16_t* A, int lda, const bf16_t* Bt, int ldb, int M, int N, int K, const Epi& epi, char* lds) {
  const int ntn = N / 64, ntm = M / 128;
  const int ty = threadIdx.x >> 4, tx = threadIdx.x & 15;
  for (int tile = blockIdx.x; tile < ntn * ntm; tile += gridDim.x) {
    const int m0 = (tile / ntn) * 128, n0 = (tile % ntn) * 64;
    float acc[4][4];
#pragma unroll
    for (int i = 0; i < 4; ++i)
#pragma unroll
      for (int j = 0; j < 4; ++j) acc[i][j] = 0.f;
    gemm_tile(A, lda, Bt, ldb, m0, n0, K, acc, lds);
#pragma unroll
    for (int i = 0; i < 4; ++i)
#pragma unroll
      for (int j = 0; j < 4; ++j) epi(m0 + ty * 4 + i, n0 + tx * 4 + j, acc[i][j]);
  }
}
DEV void ph_merge(const bf16_t* onsa, const bf16_t* omla, const bf16_t* wbn, const bf16_t* wbm, const bf16_t* gates, bf16_t* merged, char* lds) {
  const int ntn = 1024 / 64, ntm = T / 128;
  const int ty = threadIdx.x >> 4, tx = threadIdx.x & 15;
  for (int tile = blockIdx.x; tile < ntn * ntm; tile += gridDim.x) {
    const int m0 = (tile / ntn) * 128, n0 = (tile % ntn) * 64;
    float a1[4][4], a2[4][4];
#pragma unroll
    for (int i = 0; i < 4; ++i)
#pragma unroll
      for (int j = 0; j < 4; ++j) { a1[i][j] = 0.f; a2[i][j] = 0.f; }
    gemm_tile(onsa, 512, wbn, 512, m0, n0, 512, a1, lds);
    gemm_tile(omla, 512, wbm, 512, m0, n0, 512, a2, lds);
#pragma unroll
    for (int i = 0; i < 4; ++i)
#pragma unroll
      for (int j = 0; j < 4; ++j) {
        const int m = m0 + ty * 4 + i, n = n0 + tx * 4 + j;
        merged[(size_t)m * 1024 + n] = f2bf(bf2f(gates[(size_t)m * 2048 + n]) * a1[i][j] + bf2f(gates[(size_t)m * 2048 + 1024 + n]) * a2[i][j]);
      }
  }
}

DEV void ph_rope_table(float2* __restrict__ cs) {
  const int n = SEQ * 16;
  for (int i = blockIdx.x * NTHR + threadIdx.x; i < n; i += gridDim.x * NTHR) {
    const int j = i & 15, pos = i >> 4;
    const float inv_freq = powf(10000.0f, -(float)(2 * j) / 32.0f);
    const float ang = (float)pos * inv_freq;
    cs[i] = make_float2(cosf(ang), sinf(ang));
  }
}
DEV void ph_rope_k(const bf16_t* __restrict__ proj, bf16_t* __restrict__ kr) {
  const int n = T * 16;
  for (int i = blockIdx.x * NTHR + threadIdx.x; i < n; i += gridDim.x * NTHR) {
    const int j = i & 15, t = i >> 4;
    const float pos = (float)(t & (SEQ - 1));
    const float inv_freq = powf(10000.0f, -(float)(2 * j) / 32.0f);
    const float ang = pos * inv_freq, c = cosf(ang), s = sinf(ang);
    const float x1 = bf2f(proj[(size_t)t * PROJ_LD + PC_KR + j]), x2 = bf2f(proj[(size_t)t * PROJ_LD + PC_KR + 16 + j]);
    kr[(size_t)t * 32 + j] = f2bf(x1 * c - x2 * s); kr[(size_t)t * 32 + 16 + j] = f2bf(x2 * c + x1 * s);
  }
}
DEV void ph_cmp_gather(const bf16_t* __restrict__ proj, const float* __restrict__ pos, int which, bf16_t* __restrict__ ca) {
  const int n = 2048 * 2048;
  for (int i = blockIdx.x * NTHR + threadIdx.x; i < n; i += gridDim.x * NTHR) {
    const int e = i & 2047, row = i >> 11;
    float v = 0.f;
    if (row < BATCH * NC * 2) {
      const int g = row & 1, bc = row >> 1, b = bc / NC, c = bc % NC, l = e >> 6, d = e & 63;
      v = bf2f(proj[(size_t)(b * SEQ + 16 * c + l) * PROJ_LD + PC_KV + which * 128 + g * 64 + d]) + pos[e];
    }
    ca[i] = f2bf(v);
  }
}

DEV void ph_cmp_attn(const bf16_t* __restrict__ proj, const bf16_t* __restrict__ kc, const bf16_t* __restrict__ vc,
                     const float* __restrict__ t5, bf16_t* __restrict__ ocmp, unsigned* __restrict__ sel, char* lds) {
  WAVE_IDS
  float* P = (float*)(lds + wv * 1024); float* Q = P + 128;
  for (int item = gw; item < BATCH * 2 * SEQ; item += nw) {
    const int t = item & (SEQ - 1), bg = item >> 11, g = bg & 1, b = bg >> 1;
    const size_t tok = (size_t)b * SEQ + t;
    const int nvalid = (t >= 31) ? min(NC, (t - 31) / 16 + 1) : 0;
    const bf16_t* kcb = kc + (size_t)bg * 128 * 64;
    const bf16_t* vcb = vc + (size_t)bg * 128 * 64;
    float impacc = 0.f;
    for (int r = 0; r < 4; ++r) {
      const int head = g * 4 + r;
      Q[lane] = bf2f(proj[tok * PROJ_LD + PC_Q + head * 64 + lane]);
      wave_lds_sync();
      float lg[2];
#pragma unroll
      for (int u = 0; u < 2; ++u) {
        const int c = lane + 64 * u;
        float d = 0.f;
        if (c < nvalid) { const bf16_t* kr = kcb + c * 64; for (int e = 0; e < 64; ++e) d += Q[e] * bf2f(kr[e]); }
        lg[u] = (c < nvalid) ? d + 1.4426950408889634f * t5bias(t5, head, t - (16 * c + 31)) : -1e30f;
      }
      const float m = wmaxf(fmaxf(lg[0], lg[1]));
      const float e0 = (lane < nvalid) ? exp2f(lg[0] - m) : 0.f, e1 = (lane + 64 < nvalid) ? exp2f(lg[1] - m) : 0.f;
      const float s = wsum(e0 + e1);
      const float inv = (nvalid > 0) ? 1.0f / fmaxf(s, 1e-30f) : 0.f;
      P[lane] = e0 * inv; P[lane + 64] = e1 * inv;
      wave_lds_sync();
      float o = 0.f;
      for (int c = 0; c < nvalid; ++c) o += P[c] * bf2f(vcb[c * 64 + lane]);
      ocmp[tok * 512 + head * 64 + lane] = f2bf(o);
      if (lane < 32) { for (int c = 4 * lane - 1; c <= 4 * lane + 3; ++c) if (c >= 0 && c < NC) impacc += P[c]; }
      wave_lds_sync();
    }
    const int cur = t >> 6, n = lane;
    float score = (n > cur) ? -1.0f : ((n == 0 || n == cur || n == cur - 1) ? 1e4f : impacc);
    if (n >= 32) score = -2.0f;
    int rank = 0;
    for (int mth = 0; mth < 32; ++mth) { const float sm = __shfl(score, mth); rank += (sm > score || (sm == score && mth < n)) ? 1 : 0; }
    const unsigned long long bal = __ballot(n < 32 && rank < 16);
    if (lane == 0) sel[item] = (unsigned)bal;
  }
}

DEV void ph_nsa_attn(const bf16_t* __restrict__ proj, const float* __restrict__ t5, const bf16_t* __restrict__ ocmp,
                     const unsigned* __restrict__ sel, bf16_t* __restrict__ onsa, char* lds) {
  WAVE_IDS
  float* P = (float*)(lds + wv * 1024); float* Q = P + 128;
  for (int item = gw; item < BATCH * 2 * SEQ * 4; item += nw) {
    const int r = item & 3, t = (item >> 2) & (SEQ - 1), bg = item >> 13, g = bg & 1, b = bg >> 1;
    const int head = g * 4 + r, cur = t >> 6;
    const size_t tok = (size_t)b * SEQ + t;
    Q[lane] = bf2f(proj[tok * PROJ_LD + PC_Q + head * 64 + lane]);
    wave_lds_sync();
    const unsigned smask = sel[bg * SEQ + t];
    float res0 = 0.f, res1 = 0.f;
    for (int br = 0; br < 2; ++br) {
      float m = -1e30f, l = 0.f, o = 0.f;
      const int nb0 = (br == 0) ? 0 : max(0, cur - 8);
      for (int nb = nb0; nb <= cur; ++nb) {
        if (br == 0 && !((smask >> nb) & 1u)) continue;
        const int s = nb * 64 + lane, dist = t - s;
        const bool valid = (dist >= 0) && (br == 0 || dist < 512);
        const bf16_t* kp = proj + ((size_t)b * SEQ + s) * PROJ_LD + PC_KV + (2 + 2 * br) * 128 + g * 64;
        float d = 0.f;
        for (int e = 0; e < 64; e += 8) {
          const uint4 kv = *(const uint4*)(kp + e);
          d += Q[e + 0] * __uint_as_float(kv.x << 16) + Q[e + 1] * __uint_as_float(kv.x & 0xffff0000u);
          d += Q[e + 2] * __uint_as_float(kv.y << 16) + Q[e + 3] * __uint_as_float(kv.y & 0xffff0000u);
          d += Q[e + 4] * __uint_as_float(kv.z << 16) + Q[e + 5] * __uint_as_float(kv.z & 0xffff0000u);
          d += Q[e + 6] * __uint_as_float(kv.w << 16) + Q[e + 7] * __uint_as_float(kv.w & 0xffff0000u);
        }
        const float lg = valid ? d + 1.4426950408889634f * t5bias(t5, head, dist) : -1e30f;
        const float mn = fmaxf(m, wmaxf(lg));
        const float sc = exp2f(m - mn);
        const float pe = valid ? exp2f(lg - mn) : 0.f;
        l = l * sc + wsum(pe); m = mn;
        P[lane] = pe;
        wave_lds_sync();
        const bf16_t* vp = proj + ((size_t)b * SEQ + nb * 64) * PROJ_LD + PC_KV + (3 + 2 * br) * 128 + g * 64 + lane;
        float acc = 0.f;
        for (int k = 0; k < 64; ++k) acc += P[k] * bf2f(vp[(size_t)k * PROJ_LD]);
        o = o * sc + acc;
        wave_lds_sync();
      }
      if (br == 0) res0 = o / fmaxf(l, 1e-30f); else res1 = o / fmaxf(l, 1e-30f);
    }
    const bf16_t* gp = proj + tok * PROJ_LD + PC_GATE + head * 3;
    const float g0 = sigmoidf_(bf2f(gp[0])), g1 = sigmoidf_(bf2f(gp[1])), g2 = sigmoidf_(bf2f(gp[2]));
    const float oc = bf2f(ocmp[tok * 512 + head * 64 + lane]);
    onsa[tok * 512 + head * 64 + lane] = f2bf(g0 * oc + g1 * res0 + g2 * res1);
    wave_lds_sync();
  }
}

DEV void ph_mla_attn(const bf16_t* __restrict__ mq, const bf16_t* __restrict__ mkv, const bf16_t* __restrict__ kr, bf16_t* __restrict__ omla, char* lds) {
  WAVE_IDS
  float* P = (float*)(lds + wv * 1024); float* Q = P + 128;
  for (int item = gw; item < BATCH * 8 * SEQ; item += nw) {
    const int h = item & 7, t = (item >> 3) & (SEQ - 1), b = item >> 14;
    const size_t tok = (size_t)b * SEQ + t;
    Q[lane] = bf2f(mq[tok * 768 + h * 96 + lane]);
    if (lane < 32) Q[64 + lane] = bf2f(mq[tok * 768 + h * 96 + 64 + lane]);
    wave_lds_sync();
    float m = -1e30f, l = 0.f, o = 0.f;
    for (int nb = 0; nb <= (t >> 6); ++nb) {
      const int s = nb * 64 + lane;
      const bool valid = s <= t;
      const bf16_t* kp = mkv + ((size_t)b * SEQ + s) * 1024 + h * 128;
      const bf16_t* rp = kr + ((size_t)b * SEQ + s) * 32;
      float d = 0.f;
      for (int e = 0; e < 64; e += 8) {
        const uint4 kv = *(const uint4*)(kp + e);
        d += Q[e + 0] * __uint_as_float(kv.x << 16) + Q[e + 1] * __uint_as_float(kv.x & 0xffff0000u);
        d += Q[e + 2] * __uint_as_float(kv.y << 16) + Q[e + 3] * __uint_as_float(kv.y & 0xffff0000u);
        d += Q[e + 4] * __uint_as_float(kv.z << 16) + Q[e + 5] * __uint_as_float(kv.z & 0xffff0000u);
        d += Q[e + 6] * __uint_as_float(kv.w << 16) + Q[e + 7] * __uint_as_float(kv.w & 0xffff0000u);
      }
      for (int e = 0; e < 32; e += 8) {
        const uint4 kv = *(const uint4*)(rp + e);
        d += Q[64 + e + 0] * __uint_as_float(kv.x << 16) + Q[64 + e + 1] * __uint_as_float(kv.x & 0xffff0000u);
        d += Q[64 + e + 2] * __uint_as_float(kv.y << 16) + Q[64 + e + 3] * __uint_as_float(kv.y & 0xffff0000u);
        d += Q[64 + e + 4] * __uint_as_float(kv.z << 16) + Q[64 + e + 5] * __uint_as_float(kv.z & 0xffff0000u);
        d += Q[64 + e + 6] * __uint_as_float(kv.w << 16) + Q[64 + e + 7] * __uint_as_float(kv.w & 0xffff0000u);
      }
      const float lg = valid ? d : -1e30f;
      const float mn = fmaxf(m, wmaxf(lg));
      const float sc = exp2f(m - mn);
      const float pe = valid ? exp2f(lg - mn) : 0.f;
      l = l * sc + wsum(pe); m = mn;
      P[lane] = pe;
      wave_lds_sync();
      const bf16_t* vp = mkv + ((size_t)b * SEQ + nb * 64) * 1024 + h * 128 + 64 + lane;
      float acc = 0.f;
      for (int k = 0; k < 64; ++k) acc += P[k] * bf2f(vp[(size_t)k * 1024]);
      o = o * sc + acc;
      wave_lds_sync();
    }
    omla[tok * 512 + h * 64 + lane] = f2bf(o / fmaxf(l, 1e-30f));
    wave_lds_sync();
  }
}

DEV void wave_argmax(float& v, int& idx) {
#pragma unroll
  for (int o = 32; o > 0; o >>= 1) {
    const float ov = __shfl_xor(v, o); const int oi = __shfl_xor(idx, o);
    if (ov > v || (ov == v && oi < idx)) { v = ov; idx = oi; }
  }
}
DEV void ph_route(const bf16_t* __restrict__ pq, const bf16_t* __restrict__ subk, int* __restrict__ pidx, float* __restrict__ pw, char* lds) {
  WAVE_IDS
  float* Q = (float*)(lds + wv * 1024);
  float* TS = Q + 128;
  int* TI = (int*)(TS + 32);
  for (int item = gw; item < T * 8; item += nw) {
    const int h = item & 7, t = item >> 3;
    Q[lane] = bf2f(pq[(size_t)t * 1024 + h * 128 + lane]);
    Q[lane + 64] = bf2f(pq[(size_t)t * 1024 + h * 128 + 64 + lane]);
    wave_lds_sync();
    for (int p = 0; p < 2; ++p) {
      const bf16_t* kb = subk + (size_t)((h * 2 + p) * 128) * 64;
      float s0 = 0.f, s1 = 0.f;
      for (int e = 0; e < 64; ++e) { const float qv = Q[p * 64 + e]; s0 += qv * bf2f(kb[lane * 64 + e]); s1 += qv * bf2f(kb[(lane + 64) * 64 + e]); }
      for (int k = 0; k < 16; ++k) {
        float v = (s0 >= s1) ? s0 : s1; int idx = (s0 >= s1) ? lane : lane + 64;
        wave_argmax(v, idx);
        if (lane == 0) { TS[p * 16 + k] = v; TI[p * 16 + k] = idx; }
        if (idx == lane) s0 = -3e38f;
        if (idx == lane + 64) s1 = -3e38f;
      }
    }
    wave_lds_sync();
    float cv[4];
#pragma unroll
    for (int u = 0; u < 4; ++u) { const int f = lane + 64 * u; cv[u] = TS[f >> 4] + TS[16 + (f & 15)]; }
    int myexp = 0; float mybest = 0.f, best0 = 0.f, den = 0.f;
#pragma unroll
    for (int k = 0; k < 16; ++k) {
      float v = cv[0]; int idx = lane;
#pragma unroll
      for (int u = 1; u < 4; ++u) if (cv[u] > v) { v = cv[u]; idx = lane + 64 * u; }
      wave_argmax(v, idx);
#pragma unroll
      for (int u = 0; u < 4; ++u) if (idx == lane + 64 * u) cv[u] = -3e38f;
      if (k == 0) best0 = v;
      den += expf(v - best0);
      if (lane == k) { myexp = TI[idx >> 4] * 128 + TI[16 + (idx & 15)]; mybest = v; }
    }
    if (lane < 16) { pidx[(size_t)t * 128 + h * 16 + lane] = myexp; pw[(size_t)t * 128 + h * 16 + lane] = expf(mybest - best0) / den; }
    wave_lds_sync();
  }
}

DEV void ph_experts(const bf16_t* __restrict__ hn, const int* __restrict__ pidx, const float* __restrict__ pw,
                    const float* __restrict__ pu, const float* __restrict__ pv, const float* __restrict__ gfin, float* __restrict__ out) {
  WAVE_IDS
  for (int t = gw; t < T; t += nw) {
    float4 x[4], y[4];
#pragma unroll
    for (int j = 0; j < 4; ++j) {
      const uint2 r = ((const uint2*)(hn + (size_t)t * 1024))[j * 64 + lane];
      x[j] = make_float4(__uint_as_float(r.x << 16), __uint_as_float(r.x & 0xffff0000u), __uint_as_float(r.y << 16), __uint_as_float(r.y & 0xffff0000u));
      y[j] = make_float4(0.f, 0.f, 0.f, 0.f);
    }
    const int e0 = pidx[(size_t)t * 128 + lane], e1 = pidx[(size_t)t * 128 + 64 + lane];
    const float w0 = pw[(size_t)t * 128 + lane], w1 = pw[(size_t)t * 128 + 64 + lane];
    for (int s = 0; s < 128; ++s) {
      const int e = __shfl((s < 64) ? e0 : e1, s & 63);
      const float w = __shfl((s < 64) ? w0 : w1, s & 63);
      const float4* ur = (const float4*)(pu + (size_t)e * 1024);
      float d = 0.f;
#pragma unroll
      for (int j = 0; j < 4; ++j) { const float4 u = ur[j * 64 + lane]; d += u.x * x[j].x + u.y * x[j].y + u.z * x[j].z + u.w * x[j].w; }
      d = wsum(d);
      const float c = w * gelu_exact(d);
      const float4* vr = (const float4*)(pv + (size_t)e * 1024);
#pragma unroll
      for (int j = 0; j < 4; ++j) { const float4 v = vr[j * 64 + lane]; y[j].x += c * v.x; y[j].y += c * v.y; y[j].z += c * v.z; y[j].w += c * v.w; }
    }
    float4* o4 = (float4*)(out + (size_t)t * 1024);
    float ss = 0.f;
#pragma unroll
    for (int j = 0; j < 4; ++j) {
      const float4 hv = o4[j * 64 + lane];
      y[j].x += hv.x; y[j].y += hv.y; y[j].z += hv.z; y[j].w += hv.w;
      ss += y[j].x * y[j].x + y[j].y * y[j].y + y[j].z * y[j].z + y[j].w * y[j].w;
    }
    ss = wsum(ss);
    const float inv = rsqrtf(ss * (1.0f / 1024.0f) + 1e-6f);
#pragma unroll
    for (int j = 0; j < 4; ++j) {
      const float4 gg = ((const float4*)gfin)[j * 64 + lane];
      o4[j * 64 + lane] = make_float4(y[j].x * inv * gg.x, y[j].y * inv * gg.y, y[j].z * inv * gg.z, y[j].w * inv * gg.w);
    }
  }
}

struct Args { const float* in[23]; float* out; char* ws; };
constexpr int LDS_BYTES = 131072 + 4096;

__global__ __launch_bounds__(NTHR, 2) void mega(Args a) {
  extern __shared__ __attribute__((aligned(16))) char lds[];
  cg::grid_group grid = cg::this_grid();
  const float* x = a.in[0]; const float* ln_mix_g = a.in[1]; const float* w_in = a.in[2];
  const float* cmp_pos_k = a.in[3]; const float* cmp_pos_v = a.in[4];
  const float* cmp_k_w1 = a.in[5]; const float* cmp_k_w2 = a.in[6]; const float* cmp_v_w1 = a.in[7]; const float* cmp_v_w2 = a.in[8];
  const float* q_norm_g = a.in[9]; const float* kv_norm_g = a.in[10]; const float* w_uq = a.in[11]; const float* w_ukv = a.in[12];
  const float* w_bn = a.in[13]; const float* w_bm = a.in[14]; const float* w_out = a.in[15];
  const float* ln_ffn_g = a.in[16]; const float* w_query = a.in[17]; const float* sub_keys = a.in[18];
  const float* peer_u = a.in[19]; const float* peer_v = a.in[20]; const float* t5 = a.in[21]; const float* ln_final_g = a.in[22];
  float* out = a.out; char* ws = a.ws;
  bf16_t* WinT = (bf16_t*)(ws + WS_WIN); bf16_t* WbnT = (bf16_t*)(ws + WS_WBN); bf16_t* WbmT = (bf16_t*)(ws + WS_WBM);
  bf16_t* WoutT = (bf16_t*)(ws + WS_WOUT); bf16_t* WqT = (bf16_t*)(ws + WS_WQ);
  bf16_t* CkW1T = (bf16_t*)(ws + WS_CKW1); bf16_t* CvW1T = (bf16_t*)(ws + WS_CVW1); bf16_t* CkW2T = (bf16_t*)(ws + WS_CKW2); bf16_t* CvW2T = (bf16_t*)(ws + WS_CVW2);
  bf16_t* UqT = (bf16_t*)(ws + WS_UQ); bf16_t* UkvT = (bf16_t*)(ws + WS_UKV); bf16_t* SUBK = (bf16_t*)(ws + WS_SUBK);
  bf16_t* GATES = (bf16_t*)(ws + WS_GATES); bf16_t* PQ = (bf16_t*)(ws + WS_PQ);
  bf16_t* PROJ = (bf16_t*)(ws + WS_PROJ); bf16_t* MERGED = (bf16_t*)(ws + WS_MERGED);
  int* PIDX = (int*)(ws + WS_PIDX); float* PW = (float*)(ws + WS_PW);
  bf16_t* XN = (bf16_t*)(ws + WS_XN); bf16_t* MLAKV = (bf16_t*)(ws + WS_MLAKV); bf16_t* HN = (bf16_t*)(ws + WS_HN);
  bf16_t* MLAQ = (bf16_t*)(ws + WS_MLAQ); bf16_t* KROPE = (bf16_t*)(ws + WS_KROPE);
  bf16_t* KC = (bf16_t*)(ws + WS_KC); bf16_t* VC = (bf16_t*)(ws + WS_VC);
  bf16_t* ONSA = (bf16_t*)(ws + WS_ONSA); bf16_t* OMLA = (bf16_t*)(ws + WS_OMLA);
  bf16_t* CA = (bf16_t*)(ws + WS_CA); bf16_t* CA2 = (bf16_t*)(ws + WS_CA2); bf16_t* HID = (bf16_t*)(ws + WS_HID); bf16_t* HID2 = (bf16_t*)(ws + WS_HID2);
  bf16_t* CQN = (bf16_t*)(ws + WS_CQN); bf16_t* CKVN = (bf16_t*)(ws + WS_CKVN); bf16_t* OCMP = (bf16_t*)(ws + WS_OCMP);
  unsigned* SEL = (unsigned*)(ws + WS_SEL);
  float2* ROPE = (float2*)(ws + WS_ROPE);
  PG8_LAS unsigned char* glds = (PG8_LAS unsigned char*)lds;
  const int bid = blockIdx.x, G = gridDim.x;

  ph_convT<1>(w_in, 1024, IN_COLS, WinT, 3840, lds);
  ph_convT<0>(w_bn, 512, 1024, WbnT, 1024, lds);
  ph_convT<0>(w_bm, 512, 1024, WbmT, 1024, lds);
  ph_convT<0>(w_out, 1024, 1024, WoutT, 1024, lds);
  ph_convT<0>(w_query, 1024, 1024, WqT, 1024, lds);
  ph_convT<0>(cmp_k_w1, 2048, 256, CkW1T, 256, lds);
  ph_convT<0>(cmp_v_w1, 2048, 256, CvW1T, 256, lds);
  ph_convT<0>(cmp_k_w2, 256, 64, CkW2T, 64, lds);
  ph_convT<0>(cmp_v_w2, 256, 64, CvW2T, 64, lds);
  ph_convT<0>(w_uq, 256, 768, UqT, 768, lds);
  ph_convT<0>(w_ukv, 128, 1024, UkvT, 1024, lds);
  ph_conv_plain(sub_keys, SUBK, 16 * 128 * 64);
  ph_rope_table(ROPE);
  ph_rms1024(x, ln_mix_g, XN, T);
  grid.sync();
  { pg8::Gemm g{XN, WinT, T, 3840, 1024}; pg8::StaticOrder S; S.init(T, 3840, G, bid);
    pg8::EpiInProjF E{PROJ, GATES};
    pg8::gemm_phase<pg8::EpiInProjF, pg8::StaticOrder, PG8_ALIGN, PG8_SP2>(glds, g, S, E); }
  grid.sync();
  ph_rms_cols<4>(PROJ, PC_CQ, q_norm_g, CQN);
  ph_rms_cols<2>(PROJ, PC_CKV, kv_norm_g, CKVN);
  ph_rope_k(PROJ, KROPE);
  ph_cmp_gather(PROJ, cmp_pos_k, 0, CA);
  ph_cmp_gather(PROJ, cmp_pos_v, 1, CA2);
  grid.sync();
  { pg8::Gemm g{CA, CkW1T, 2048, 256, 2048}; pg8::StaticOrder S; S.init(2048, 256, G, bid);
    pg8::EpiBf16<1> E{HID, 256, nullptr, 0, 0, 1.f};
    pg8::gemm_phase<pg8::EpiBf16<1>, pg8::StaticOrder, PG8_ALIGN, PG8_SP2>(glds, g, S, E); }
  { pg8::Gemm g{CA2, CvW1T, 2048, 256, 2048}; pg8::StaticOrder S; S.init(2048, 256, G, (bid + 128) & 255);
    pg8::EpiBf16<1> E{HID2, 256, nullptr, 0, 0, 1.f};
    pg8::gemm_phase<pg8::EpiBf16<1>, pg8::StaticOrder, PG8_ALIGN, PG8_SP2>(glds, g, S, E); }
  { pg8::Gemm g{CQN, UqT, T, 768, 256}; pg8::StaticOrder S; S.init(T, 768, G, (bid + 64) & 255);
    pg8::EpiMlaQF E{MLAQ, ROPE};
    pg8::gemm_phase<pg8::EpiMlaQF, pg8::StaticOrder, PG8_ALIGN, PG8_SP2>(glds, g, S, E); }
  { pg8::Gemm g{CKVN, UkvT, T, 1024, 128}; pg8::StaticOrder S; S.init(T, 1024, G, bid);
    pg8::EpiBf16<0> E{MLAKV, 1024, nullptr, 0, 0, 1.f};
    pg8::gemm_phase<pg8::EpiBf16<0>, pg8::StaticOrder, PG8_ALIGN, PG8_SP2>(glds, g, S, E); }
  grid.sync();
  ph_gemm(HID, 256, CkW2T, 256, 2048, 64, 256, EpiCmpOut{KC}, lds);
  ph_gemm(HID2, 256, CvW2T, 256, 2048, 64, 256, EpiCmpOut{VC}, lds);
  grid.sync();
  ph_cmp_attn(PROJ, KC, VC, t5, OCMP, SEL, lds);
  ph_mla_attn(MLAQ, MLAKV, KROPE, OMLA, lds);
  grid.sync();
  ph_nsa_attn(PROJ, t5, OCMP, SEL, ONSA, lds);
  grid.sync();
  { pg8::Gemm g{ONSA, WbnT, T, 1024, 512}; pg8::StaticOrder S; S.init(T, 1024, G, bid);
    pg8::EpiMergeF<0> E{GATES, MERGED};
    pg8::gemm_phase<pg8::EpiMergeF<0>, pg8::StaticOrder, PG8_ALIGN, PG8_SP2>(glds, g, S, E); }
  { pg8::Gemm g{OMLA, WbmT, T, 1024, 512}; pg8::StaticOrder S; S.init(T, 1024, G, bid);
    pg8::EpiMergeF<1> E{GATES, MERGED};
    pg8::gemm_phase<pg8::EpiMergeF<1>, pg8::StaticOrder, PG8_ALIGN, PG8_SP2>(glds, g, S, E); }
  grid.sync();
  { pg8::Gemm g{MERGED, WoutT, T, 1024, 1024}; pg8::StaticOrder S; S.init(T, 1024, G, bid);
    pg8::EpiResidF E{x, out};
    pg8::gemm_phase<pg8::EpiResidF, pg8::StaticOrder, PG8_ALIGN, PG8_SP2>(glds, g, S, E); }
  grid.sync();
  ph_rms1024(out, ln_ffn_g, HN, T);
  grid.sync();
  { pg8::Gemm g{HN, WqT, T, 1024, 1024}; pg8::StaticOrder S; S.init(T, 1024, G, bid);
    pg8::EpiBf16<0> E{PQ, 1024, nullptr, 0, 0, 1.f};
    pg8::gemm_phase<pg8::EpiBf16<0>, pg8::StaticOrder, PG8_ALIGN, PG8_SP2>(glds, g, S, E); }
  grid.sync();
  ph_route(PQ, SUBK, PIDX, PW, lds);
  grid.sync();
  ph_experts(HN, PIDX, PW, peer_u, peer_v, ln_final_g, out);
}

extern "C" void kernel_launch(void* const* d_in, const int* in_sizes, int n_in, void* d_out, int out_size, void* d_ws, size_t ws_size, hipStream_t stream) {
  if (n_in != 23 || ws_size < 256 * MiB) { fprintf(stderr, "kernel_launch: unexpected n_in %d / ws_size %zu\n", n_in, ws_size); return; }
  static int grid_blocks = 0;
  if (!grid_blocks) {
    int dev = 0, cus = 0, per_cu = 0;
    (void)hipGetDevice(&dev);
    (void)hipDeviceGetAttribute(&cus, hipDeviceAttributeMultiprocessorCount, dev);
    if (hipFuncSetAttribute((const void*)mega, hipFuncAttributeMaxDynamicSharedMemorySize, LDS_BYTES) != hipSuccess) fprintf(stderr, "kernel_launch: hipFuncSetAttribute failed\n");
    (void)hipOccupancyMaxActiveBlocksPerMultiprocessor(&per_cu, (const void*)mega, NTHR, LDS_BYTES);
    if (per_cu < 1) { fprintf(stderr, "kernel_launch: occupancy query returned %d\n", per_cu); per_cu = 1; }
    if (per_cu > 2) per_cu = 2;
    grid_blocks = cus * per_cu;
    fprintf(stderr, "kernel_launch: cus %d per_cu %d grid %d ws %zu\n", cus, per_cu, grid_blocks, ws_size);
  }
  Args a{};
  for (int i = 0; i < 23; ++i) a.in[i] = (const float*)d_in[i];
  a.out = (float*)d_out; a.ws = (char*)d_ws;
  void* args[] = {&a};
  hipError_t e = hipLaunchCooperativeKernel((const void*)mega, dim3(grid_blocks), dim3(NTHR), args, LDS_BYTES, stream);
  if (e != hipSuccess) fprintf(stderr, "cooperative launch failed: %s (grid %d)\n", hipGetErrorString(e), grid_blocks);
}
```

```cpp
#include <hip/hip_runtime.h>
#include <stdint.h>
#include <cstdio>
#include <hip/hip_cooperative_groups.h>
namespace cg = cooperative_groups;

typedef unsigned short bf16_t;
#define DEV __device__ __forceinline__

constexpr int BATCH = 8, SEQ = 2048, DM = 1024, T = BATCH * SEQ;
constexpr int IN_COLS = 3768;
constexpr int PROJ_LD = 1792;
constexpr int PC_Q = 0, PC_KV = 512, PC_CQ = 1280, PC_CKV = 1536, PC_KR = 1664, PC_GATE = 1696;
constexpr int NC = 127;
constexpr size_t MiB = 1u << 20;

constexpr size_t WS_WIN = 1 * MiB;
constexpr size_t WS_WBN = 9 * MiB;
constexpr size_t WS_WBM = 10 * MiB;
constexpr size_t WS_WOUT = 11 * MiB;
constexpr size_t WS_WQ = 13 * MiB;
constexpr size_t WS_CKW1 = 15 * MiB;
constexpr size_t WS_CVW1 = 16 * MiB;
constexpr size_t WS_CKW2 = 17 * MiB;
constexpr size_t WS_CVW2 = 17 * MiB + 64 * 1024;
constexpr size_t WS_UQ = 17 * MiB + 256 * 1024;
constexpr size_t WS_UKV = 17 * MiB + 768 * 1024;
constexpr size_t WS_SUBK = 18 * MiB;
constexpr size_t WS_ROPE = 18 * MiB + 512 * 1024;
constexpr size_t WS_GATES = 20 * MiB;
constexpr size_t WS_PQ = 20 * MiB;
constexpr size_t WS_PROJ = 84 * MiB;
constexpr size_t WS_MERGED = 84 * MiB;
constexpr size_t WS_PIDX = 84 * MiB;
constexpr size_t WS_PW = 92 * MiB;
constexpr size_t WS_XN = 140 * MiB;
constexpr size_t WS_MLAKV = 140 * MiB;
constexpr size_t WS_HN = 140 * MiB;
constexpr size_t WS_MLAQ = 172 * MiB;
constexpr size_t WS_KROPE = 196 * MiB;
constexpr size_t WS_KC = 197 * MiB;
constexpr size_t WS_VC = 197 * MiB + 512 * 1024;
constexpr size_t WS_ONSA = 198 * MiB;
constexpr size_t WS_OMLA = 214 * MiB;
constexpr size_t WS_CA = 198 * MiB;
constexpr size_t WS_HID = 206 * MiB;
constexpr size_t WS_HID2 = 207 * MiB;
constexpr size_t WS_CA2 = 214 * MiB;
constexpr size_t WS_CQN = 230 * MiB;
constexpr size_t WS_CKVN = 238 * MiB;
constexpr size_t WS_OCMP = 230 * MiB;
constexpr size_t WS_SEL = 246 * MiB;

__device__ const unsigned char T5B[128] = {
  0, 1, 2, 3, 4, 5, 6, 7, 8, 9, 10, 11, 12, 13, 14, 15, 16, 16, 16, 17, 17, 18, 18, 18, 19, 19, 19, 20, 20, 20, 20, 21,
  21, 21, 21, 22, 22, 22, 22, 22, 23, 23, 23, 23, 23, 23, 24, 24, 24, 24, 24, 24, 25, 25, 25, 25, 25, 25, 25, 26, 26, 26, 26, 26,
  26, 26, 26, 27, 27, 27, 27, 27, 27, 27, 27, 27, 27, 28, 28, 28, 28, 28, 28, 28, 28, 28, 28, 29, 29, 29, 29, 29, 29, 29, 29, 29,
  29, 29, 29, 30, 30, 30, 30, 30, 30, 30, 30, 30, 30, 30, 30, 30, 30, 31, 31, 31, 31, 31, 31, 31, 31, 31, 31, 31, 31, 31, 31, 31};

DEV float bf2f(bf16_t v) { return __uint_as_float(((unsigned)v) << 16); }
DEV bf16_t f2bf(float f) { unsigned u = __float_as_uint(f); u += 0x7fffu + ((u >> 16) & 1u); return (bf16_t)(u >> 16); }
DEV float wsum(float v) {
#pragma unroll
  for (int o = 32; o > 0; o >>= 1) v += __shfl_xor(v, o);
  return v;
}
DEV float wmaxf(float v) {
#pragma unroll
  for (int o = 32; o > 0; o >>= 1) v = fmaxf(v, __shfl_xor(v, o));
  return v;
}
DEV float sigmoidf_(float x) { return 1.0f / (1.0f + expf(-x)); }
DEV float gelu_exact(float x) { return 0.5f * x * (1.0f + erff(x * 0.70710678118654752f)); }
DEV void wave_lds_sync() { asm volatile("s_waitcnt lgkmcnt(0)" ::: "memory"); __builtin_amdgcn_wave_barrier(); asm volatile("" ::: "memory"); }
DEV float t5bias(const float* t5, int head, int dist) { int d = dist < 127 ? dist : 127; d = d < 0 ? 0 : d; return t5[(int)T5B[d] * 8 + head]; }


namespace pg8 {
#define PG8_LAS __attribute__((address_space(3)))
typedef unsigned short bf16_t;
typedef short bf16x8 __attribute__((ext_vector_type(8)));
typedef float f32x4 __attribute__((ext_vector_type(4)));
typedef unsigned u32x4 __attribute__((ext_vector_type(4)));
constexpr int BM = 256, BK = 64, HALF = 128, HTB = HALF * BK * 2  , STAGE_BYTES = 8 * HTB, NXCD = 8, WGM = 8;

__host__ __device__ __forceinline__ int lds_byte(int r, int c) { const int st = (r >> 4) * 2 + (c >> 5), rr = r & 15, cc = c & 31, ob = rr * 64 + cc * 2; return st * 1024 + (ob ^ (((ob >> 9) & 1) << 5)); }
__host__ __device__ __forceinline__ void stage_rc(int b, int& R, int& C) { const int st = b / 1024, sb = b % 1024, swz = sb ^ (((sb >> 9) & 1) << 5); R = (st >> 1) * 16 + swz / 64; C = (st & 1) * 32 + (swz % 64) / 2; }
__host__ __device__ __forceinline__ int perm32(int rho) { const int n = rho >> 4, i = rho & 15; return 8 * (i >> 2) + 4 * n + (i & 3); }

struct Unit { int pm, pn; };
struct Gemm { const bf16_t* A; const bf16_t* Bt; int M, N, K; };

struct StaticOrder {
    int nM, nN, nwg, G, c;
    __host__ __device__ void init(int M, int N, int G_, int c_) { nM = M / BM; nN = N / BM; nwg = nM * nN; G = G_; c = c_; }
    __host__ __device__ bool next(int i, Unit& u) const {
        const long L = (long)i * G + c; if (L >= nwg) return false;
        int wgid = (int)L; { const int q = nwg / NXCD, r = nwg % NXCD, xcd = wgid % NXCD, off = wgid / NXCD; wgid = (xcd < r ? xcd * (q + 1) : r * (q + 1) + (xcd - r) * q) + off; }
        const int nig = WGM * nN, gid = wgid / nig, fm = gid * WGM, gsz = (nM - fm) < WGM ? (nM - fm) : WGM;
        u.pm = fm + ((wgid % nig) % gsz); u.pn = (wgid % nig) / gsz; return true;
    }
    __device__ __forceinline__ void a_ready(const Unit&) const {}
    __device__ __forceinline__ void done(const Unit&) const {}
};

__device__ __forceinline__ unsigned cvt_pk_bf16(float lo, float hi) { unsigned r; asm volatile("v_cvt_pk_bf16_f32 %0, %1, %2" : "=v"(r) : "v"(lo), "v"(hi)); return r; }
typedef float f32x2 __attribute__((ext_vector_type(2)));
__device__ __forceinline__ f32x2 gelu_pk(f32x2 v) {
    const f32x2 av = __builtin_elementwise_abs(v), d = av * 0.2316418882f + 1.0f;
    f32x2 t; t.x = __builtin_amdgcn_rcpf(d.x); t.y = __builtin_amdgcn_rcpf(d.y);
    f32x2 q = t * 0.5307027145f + (-0.7265760135f); q = q * t + 0.7107068705f; q = q * t + (-0.142248368f); q = q * t + 0.127414796f; q = q * t;
    const f32x2 s = (v * v) * (-0.72134752044f);
    f32x2 e; e.x = __builtin_amdgcn_exp2f(s.x); e.y = __builtin_amdgcn_exp2f(s.y);
    const f32x2 m = v * (q * e), r = v - m;
    f32x2 o; o.x = v.x < 0.f ? m.x : r.x; o.y = v.y < 0.f ? m.y : r.y; return o;
}

template <int ACT  > struct EpiBf16 {
    static constexpr bool PERM = true, AFTER_DRAIN = false; static_assert(ACT == 0 || ACT == 1, "EpiBf16: ACT is 0 (none) or 1 (gelu_pk)");
    bf16_t* O; int ldc; const float* bias; int split_cols; size_t split_stride; float scale0;
    __device__ __forceinline__ void operator()(const f32x4 (&acc)[2][2][4][2], const Unit& u, int wr, int wc, int fr, int fq) const {
        const int row0 = u.pm * BM + wr * 64 + fr; int colt = u.pn * BM; bf16_t* base = O;
        float sc = 1.f; if (split_cols) { const int t = colt / split_cols; base += (size_t)t * split_stride; colt -= t * split_cols; if (t == 0) sc = scale0; }
        const int col0 = colt + wc * 32 + 8 * fq, bcol0 = u.pn * BM + wc * 32 + 8 * fq;
        f32x4 bv[2][2];
#pragma unroll
        for (int bj = 0; bj < 2; ++bj)
#pragma unroll
            for (int n = 0; n < 2; ++n) bv[bj][n] = bias ? *(const f32x4*)(bias + bcol0 + bj * HALF + 4 * n) : (f32x4){0.f, 0.f, 0.f, 0.f};
#pragma unroll
        for (int ai = 0; ai < 2; ++ai)
#pragma unroll
            for (int m = 0; m < 4; ++m) { bf16_t* rowp = base + (size_t)(row0 + ai * HALF + m * 16) * ldc + col0;
#pragma unroll
                for (int bj = 0; bj < 2; ++bj) { f32x4 v0 = acc[ai][bj][m][0] + bv[bj][0], v1 = acc[ai][bj][m][1] + bv[bj][1];
                    if (ACT == 1) { f32x2 a = gelu_pk((f32x2){v0[0], v0[1]}), b = gelu_pk((f32x2){v0[2], v0[3]}), c = gelu_pk((f32x2){v1[0], v1[1]}), d = gelu_pk((f32x2){v1[2], v1[3]});
                        v0 = (f32x4){a.x, a.y, b.x, b.y}; v1 = (f32x4){c.x, c.y, d.x, d.y}; }
                    v0 = v0 * sc; v1 = v1 * sc; u32x4 w; w.x = cvt_pk_bf16(v0[0], v0[1]); w.y = cvt_pk_bf16(v0[2], v0[3]); w.z = cvt_pk_bf16(v1[0], v1[1]); w.w = cvt_pk_bf16(v1[2], v1[3]);
                    *(u32x4*)(rowp + bj * HALF) = w; } }
    }
};

struct PanelStats {
    unsigned* xbuf;
    unsigned* cnt;
    unsigned* tmo;
    int ntn; float eps;
    unsigned code;
    __device__ __forceinline__ bool run(const f32x4 (&v)[2][2][4][2], const Unit& u, int wr, int wc, int fr, int fq, PG8_LAS unsigned char* lds, int wid, int lane) const {
        typedef float f32x2v __attribute__((ext_vector_type(2)));
        PG8_LAS f32x2v* P = (PG8_LAS f32x2v*)lds;
        PG8_LAS f32x2v* S = (PG8_LAS f32x2v*)(lds + 8192);
        PG8_LAS unsigned* flag = (PG8_LAS unsigned*)(lds + 8192 + 2048);
#pragma unroll
        for (int ai = 0; ai < 2; ++ai)
#pragma unroll
            for (int m = 0; m < 4; ++m) {
                float s = 0.f;
#pragma unroll
                for (int bj = 0; bj < 2; ++bj)
#pragma unroll
                    for (int n = 0; n < 2; ++n) { const f32x4 x = v[ai][bj][m][n]; s += (x[0] + x[1]) + (x[2] + x[3]); }
                s += __shfl_xor(s, 16); s += __shfl_xor(s, 32);
                const float mw = s * (1.0f / 64.0f); float q = 0.f;
#pragma unroll
                for (int bj = 0; bj < 2; ++bj)
#pragma unroll
                    for (int n = 0; n < 2; ++n) { const f32x4 d = v[ai][bj][m][n] - mw; q += (d[0] * d[0] + d[1] * d[1]) + (d[2] * d[2] + d[3] * d[3]); }
                q += __shfl_xor(q, 16); q += __shfl_xor(q, 32);
                if (fq == 0) P[(ai * HALF + wr * 64 + m * 16 + fr) * 4 + wc] = (f32x2v){mw, q};
            }
        asm volatile("s_waitcnt lgkmcnt(0)" ::: "memory"); __builtin_amdgcn_s_barrier(); asm volatile("" ::: "memory");
#if defined(BROKEN_EXCHANGE_NO_WAIT)
#warning BROKEN CONTROL BUILD: the row-statistics exchange does not wait; results are wrong by design
        if (blockIdx.x >= 64) { const long long t0_ = clock64(); while (clock64() - t0_ < 60000) __builtin_amdgcn_s_sleep(8); }
#endif
        const int row = wid * 32 + (lane & 31);
        if (lane < 32) {
            const f32x2v a = P[row * 4 + 0], b = P[row * 4 + 1], c = P[row * 4 + 2], d = P[row * 4 + 3];
            const float mt = (a.x + b.x + c.x + d.x) * 0.25f;
            const float da = a.x - mt, db = b.x - mt, dc = c.x - mt, dd = d.x - mt;
            const float m2 = (a.y + b.y) + (c.y + d.y) + 64.0f * ((da * da + db * db) + (dc * dc + dd * dd));
            unsigned long long* slot = (unsigned long long*)xbuf + ((size_t)(u.pm * BM + row) * 4 + u.pn);
            __hip_atomic_store(slot, ((unsigned long long)__float_as_uint(m2) << 32) | __float_as_uint(mt), __ATOMIC_RELAXED, __HIP_MEMORY_SCOPE_AGENT);
        }
        asm volatile("s_waitcnt vmcnt(0)" ::: "memory");
        if (lane == 0) __hip_atomic_fetch_add(cnt + 64 * u.pm, 1u, __ATOMIC_RELAXED, __HIP_MEMORY_SCOPE_AGENT);
        if (wid == 0) {
            bool dead = false; const unsigned long long t0 = __builtin_amdgcn_s_memrealtime(); const unsigned want = 8u * (unsigned)ntn;
            for (;;) {
#if defined(BROKEN_EXCHANGE_NO_WAIT)
                break;
#endif
                if ((unsigned)__builtin_amdgcn_readfirstlane(__hip_atomic_load(cnt + 64 * u.pm, __ATOMIC_RELAXED, __HIP_MEMORY_SCOPE_AGENT)) >= want) break;
                if (__builtin_amdgcn_s_memrealtime() - t0 > 2000000ull) {
                    if (lane == 0) { unsigned expect = 0u; __hip_atomic_compare_exchange_strong(tmo + 1, &expect, code | (unsigned)(u.pm & 0xff), __ATOMIC_RELAXED, __ATOMIC_RELAXED, __HIP_MEMORY_SCOPE_AGENT);
                                     __hip_atomic_store(tmo, 1u, __ATOMIC_RELAXED, __HIP_MEMORY_SCOPE_AGENT); }
                    dead = true; break; }
                __builtin_amdgcn_s_sleep(2);
            }
            __builtin_amdgcn_fence(__ATOMIC_ACQUIRE, "agent");
            if (lane == 0) flag[0] = dead ? 1u : 0u;
        }
        asm volatile("s_waitcnt vmcnt(0) lgkmcnt(0)" ::: "memory"); __builtin_amdgcn_s_barrier(); asm volatile("" ::: "memory");
        const bool bad = flag[0] != 0u;
        if (lane < 32) {
            const unsigned long long* slot = (const unsigned long long*)xbuf + (size_t)(u.pm * BM + row) * 4; float mt[4], m2[4]; float ms = 0.f;
#pragma unroll
            for (int t = 0; t < 4; ++t) { if (t < ntn) { const unsigned long long w = __hip_atomic_load(slot + t, __ATOMIC_RELAXED, __HIP_MEMORY_SCOPE_AGENT); mt[t] = __uint_as_float((unsigned)w); m2[t] = __uint_as_float((unsigned)(w >> 32)); } else { mt[t] = 0.f; m2[t] = 0.f; } ms += mt[t]; }
            const float mean = ms / (float)ntn; float q = 0.f;
#pragma unroll
            for (int t = 0; t < 4; ++t) if (t < ntn) { const float dm = mt[t] - mean; q += m2[t] + 256.0f * dm * dm; }
            S[row] = (f32x2v){mean, 1.0f / sqrtf(q / (256.0f * (float)ntn) + eps)};
        }
        asm volatile("s_waitcnt lgkmcnt(0)" ::: "memory"); __builtin_amdgcn_s_barrier(); asm volatile("" ::: "memory");
        return bad;
    }
};
struct EpiLnRes {
    static constexpr bool PERM = false, AFTER_DRAIN = true;
    const float* base; float* out; int ldc; const float* bias; PanelStats st; unsigned poison;
    __device__ __forceinline__ void fused(f32x4 (&acc)[2][2][4][2], const Unit& u, int wr, int wc, int fr, int fq, PG8_LAS unsigned char* lds, int wid, int lane) const {
        typedef float f32x2v __attribute__((ext_vector_type(2)));
        const PG8_LAS f32x2v* S = (const PG8_LAS f32x2v*)(lds + 8192);
        const int col0 = u.pn * BM + wc * 32 + 4 * fq;
#pragma unroll
        for (int bj = 0; bj < 2; ++bj)
#pragma unroll
            for (int n = 0; n < 2; ++n) { const f32x4 bv = bias ? *(const f32x4*)(bias + col0 + bj * HALF + n * 16) : (f32x4){0.f, 0.f, 0.f, 0.f};
#pragma unroll
                for (int ai = 0; ai < 2; ++ai)
#pragma unroll
                    for (int m = 0; m < 4; ++m) acc[ai][bj][m][n] += bv; }
        f32x4 pre[4][2][2];
#pragma unroll
        for (int m = 0; m < 4; ++m) { const size_t off = (size_t)(u.pm * BM + wr * 64 + m * 16 + fr) * ldc + col0;
#pragma unroll
            for (int bj = 0; bj < 2; ++bj)
#pragma unroll
                for (int n = 0; n < 2; ++n) pre[m][bj][n] = *(const f32x4*)(base + off + bj * HALF + n * 16); }
        const bool bad = st.run(acc, u, wr, wc, fr, fq, lds, wid, lane) || poison != 0u;
        const float qnan = __builtin_nanf("");
#pragma unroll
        for (int ai = 0; ai < 2; ++ai)
#pragma unroll
            for (int m = 0; m < 4; ++m) { const int r = ai * HALF + wr * 64 + m * 16 + fr; const f32x2v sr = S[r]; const size_t off = (size_t)(u.pm * BM + r) * ldc + col0;
#pragma unroll
                for (int bj = 0; bj < 2; ++bj)
#pragma unroll
                    for (int n = 0; n < 2; ++n) { const f32x4 bs = ai == 0 ? pre[m][bj][n] : *(const f32x4*)(base + off + bj * HALF + n * 16); f32x4 o = bs + (acc[ai][bj][m][n] - sr.x) * sr.y;
                        if (bad) o = (f32x4){qnan, qnan, qnan, qnan}; *(f32x4*)(out + off + bj * HALF + n * 16) = o; }
                if (m & 1) asm volatile("" ::: "memory"); }
    }
};
struct EpiLnResLn {
    static constexpr bool PERM = false, AFTER_DRAIN = true;
    const float* base; float* out; bf16_t* xn; int ldc; const float* bias; PanelStats st1, st2; unsigned poison;
    __device__ __forceinline__ void fused(f32x4 (&acc)[2][2][4][2], const Unit& u, int wr, int wc, int fr, int fq, PG8_LAS unsigned char* lds, int wid, int lane) const {
        typedef float f32x2v __attribute__((ext_vector_type(2))); typedef unsigned u32x2v __attribute__((ext_vector_type(2)));
        const PG8_LAS f32x2v* S = (const PG8_LAS f32x2v*)(lds + 8192);
        const int col0 = u.pn * BM + wc * 32 + 4 * fq;
#pragma unroll
        for (int bj = 0; bj < 2; ++bj)
#pragma unroll
            for (int n = 0; n < 2; ++n) { const f32x4 bv = bias ? *(const f32x4*)(bias + col0 + bj * HALF + n * 16) : (f32x4){0.f, 0.f, 0.f, 0.f};
#pragma unroll
                for (int ai = 0; ai < 2; ++ai)
#pragma unroll
                    for (int m = 0; m < 4; ++m) acc[ai][bj][m][n] += bv; }
        bool bad = st1.run(acc, u, wr, wc, fr, fq, lds, wid, lane) || poison != 0u;
        const float qnan = __builtin_nanf("");
#pragma unroll
        for (int ai = 0; ai < 2; ++ai)
#pragma unroll
            for (int m = 0; m < 4; ++m) { const int r = ai * HALF + wr * 64 + m * 16 + fr; const f32x2v sr = S[r]; const size_t off = (size_t)(u.pm * BM + r) * ldc + col0;
#pragma unroll
                for (int bj = 0; bj < 2; ++bj)
#pragma unroll
                    for (int n = 0; n < 2; ++n) { const f32x4 bs = *(const f32x4*)(base + off + bj * HALF + n * 16); acc[ai][bj][m][n] = bs + (acc[ai][bj][m][n] - sr.x) * sr.y; }
                asm volatile("" : "+v"(acc[ai][0][m][0]), "+v"(acc[ai][0][m][1]), "+v"(acc[ai][1][m][0]), "+v"(acc[ai][1][m][1]));
                if (m & 1) asm volatile("" ::: "memory"); }
        const bool bad1 = bad;
        bad = st2.run(acc, u, wr, wc, fr, fq, lds, wid, lane) || bad;
#pragma unroll
        for (int ai = 0; ai < 2; ++ai)
#pragma unroll
            for (int m = 0; m < 4; ++m) { const int r = ai * HALF + wr * 64 + m * 16 + fr; const f32x2v sr = S[r]; const size_t off = (size_t)(u.pm * BM + r) * ldc + col0;
#pragma unroll
                for (int bj = 0; bj < 2; ++bj)
#pragma unroll
                    for (int n = 0; n < 2; ++n) { const f32x4 x1 = acc[ai][bj][m][n]; *(f32x4*)(out + off + bj * HALF + n * 16) = bad1 ? (f32x4){qnan, qnan, qnan, qnan} : x1;
                        const f32x4 o = (x1 - sr.x) * sr.y; u32x2v w; w.x = cvt_pk_bf16(o[0], o[1]); w.y = cvt_pk_bf16(o[2], o[3]);
                        if (bad) { w.x = 0x7fc07fc0u; w.y = 0x7fc07fc0u; } *(u32x2v*)(xn + off + bj * HALF + n * 16) = w; }
                asm volatile("" ::: "memory"); }
    }
};

template <class Epi, class Sched, bool ALIGN_EPI = false, bool SP2 = false>
__device__ __forceinline__ void gemm_phase(PG8_LAS unsigned char* lds, const Gemm g, const Sched& S, const Epi& E) {
    int tid = threadIdx.x; asm volatile("" : "+v"(tid));
    const int wid = __builtin_amdgcn_readfirstlane(tid >> 6), lane = tid & 63, wr = wid >> 2, wc = wid & 3, fr = lane & 15, fq = lane >> 4;
    int K = g.K; asm volatile("" : "+s"(K)); const int nt = K / BK;
    unsigned voffA[2], voffB[2];
#pragma unroll
    for (int i = 0; i < 2; ++i) { int R, C; stage_rc(tid * 16 + i * 8192, R, C); const int Rb = Epi::PERM ? ((R & ~31) + perm32(R & 31)) : R;
        voffA[i] = (unsigned)(R * K + C) * 2u; voffB[i] = (unsigned)(Rb * K + C) * 2u; }
    const size_t kstep = (size_t)(BK * 2);
    const size_t hstep = (size_t)HALF * K * 2;
    const size_t tstep = 2 * hstep;
    const unsigned ldsw = (unsigned)wid * 1024u;
    const int aoff = lds_byte(wr * 64 + fr, fq * 8), boff = lds_byte(wc * 32 + fr, fq * 8);
#define PG8_SA(b, h) (((b) * 2 + (h)) * HTB)
#define PG8_SB(b, h) ((4 + (b) * 2 + (h)) * HTB)
#define PG8_STAGE(bufoff, gbase, voff) do { _Pragma("unroll") for (int _i = 0; _i < 2; ++_i) \
        __builtin_amdgcn_global_load_lds((const unsigned*)((const char*)(gbase) + (voff)[_i]), (PG8_LAS unsigned*)(lds + (bufoff) + ldsw + _i * 8192), 16, 0, 0); } while (0)
#define PG8_LDA(dst, b, h) do { _Pragma("unroll") for (int m = 0; m < 4; ++m) _Pragma("unroll") for (int k = 0; k < 2; ++k) dst[m][k] = *(const PG8_LAS bf16x8*)(lds + PG8_SA(b, h) + aoff + m * 2048 + k * 1024); } while (0)
#define PG8_LDB(dst, b, h) do { _Pragma("unroll") for (int n = 0; n < 2; ++n) _Pragma("unroll") for (int k = 0; k < 2; ++k) dst[n][k] = *(const PG8_LAS bf16x8*)(lds + PG8_SB(b, h) + boff + n * 2048 + k * 1024); } while (0)
#define PG8_MMA(ai, bj, At, Bt) do { __builtin_amdgcn_s_setprio(1); _Pragma("unroll") for (int m = 0; m < 4; ++m) _Pragma("unroll") for (int n = 0; n < 2; ++n) _Pragma("unroll") for (int k = 0; k < 2; ++k) \
        acc[ai][bj][m][n] = __builtin_amdgcn_mfma_f32_16x16x32_bf16(Bt[n][k], At[m][k], acc[ai][bj][m][n], 0, 0, 0); __builtin_amdgcn_s_setprio(0); } while (0)
#define PG8_WAIT_V(n) asm volatile("s_waitcnt vmcnt(" #n ")" ::: "memory")
#define PG8_WAIT_L(n) asm volatile("s_waitcnt lgkmcnt(" #n ")" ::: "memory")
#define PG8_BAR __builtin_amdgcn_s_barrier()
#define PG8_SCHED __builtin_amdgcn_sched_barrier(0)
    Unit cur, nxt; int ui = 0;
    if (!S.next(0, cur)) return;
    f32x4 acc[2][2][4][2];
#pragma unroll
    for (int a = 0; a < 2; ++a)
#pragma unroll
        for (int b = 0; b < 2; ++b)
#pragma unroll
            for (int m = 0; m < 4; ++m)
#pragma unroll
                for (int n = 0; n < 2; ++n) acc[a][b][m][n] = (f32x4){0.f, 0.f, 0.f, 0.f};
    bf16x8 At[4][2], B0[2][2], B1[2][2];
    const char* cA = (const char*)g.A + (size_t)cur.pm * tstep; const char* cB = (const char*)g.Bt + (size_t)cur.pn * tstep;
    S.a_ready(cur);
    if constexpr (SP2) {
        PG8_STAGE(PG8_SB(0, 0), cB, voffB); PG8_STAGE(PG8_SB(0, 1), cB + hstep, voffB); PG8_STAGE(PG8_SA(0, 0), cA, voffA); PG8_STAGE(PG8_SA(0, 1), cA + hstep, voffA);
        if (wr == 1) PG8_BAR;
        PG8_WAIT_V(2); PG8_BAR;
        PG8_STAGE(PG8_SB(1, 0), cB + kstep, voffB); PG8_STAGE(PG8_SA(1, 0), cA + kstep, voffA); PG8_STAGE(PG8_SB(1, 1), cB + hstep + kstep, voffB);
        PG8_WAIT_V(6); PG8_BAR;
    } else {
        PG8_STAGE(PG8_SB(0, 0), cB, voffB); PG8_STAGE(PG8_SA(0, 0), cA, voffA); PG8_STAGE(PG8_SB(0, 1), cB + hstep, voffB); PG8_STAGE(PG8_SA(0, 1), cA + hstep, voffA);
        if (wr == 1) PG8_BAR;
        PG8_WAIT_V(4); PG8_BAR;
        PG8_STAGE(PG8_SB(1, 0), cB + kstep, voffB); PG8_STAGE(PG8_SA(1, 0), cA + kstep, voffA); PG8_STAGE(PG8_SB(1, 1), cB + hstep + kstep, voffB);
        PG8_WAIT_V(6); PG8_BAR;
    }
    for (;;) {
        const bool has_next = S.next(ui + 1, nxt);
        const char* nA = has_next ? (const char*)g.A + (size_t)nxt.pm * tstep : cA; const char* nB = has_next ? (const char*)g.Bt + (size_t)nxt.pn * tstep : cB;
        for (int t = 0; t < nt; t += 2) {
            const bool last = (t == nt - 2);
            const char* a1 = cA + (size_t)(t + 1) * kstep;
            const char* a2 = last ? nA : cA + (size_t)(t + 2) * kstep; const char* b2 = last ? nB : cB + (size_t)(t + 2) * kstep;
            const char* a3 = a2 + kstep; const char* b3 = b2 + kstep;
            if (last && has_next) S.a_ready(nxt);
            if constexpr (SP2) {
            PG8_LDB(B0, 0, 0); PG8_LDB(B1, 0, 1); PG8_SCHED; PG8_LDA(At, 0, 0); PG8_STAGE(PG8_SA(1, 1), a1 + hstep, voffA);
            PG8_WAIT_V(8); PG8_WAIT_L(0); PG8_BAR; PG8_MMA(0, 0, At, B0); PG8_MMA(0, 1, At, B1); PG8_BAR; PG8_SCHED;
            PG8_LDA(At, 0, 1); PG8_STAGE(PG8_SB(0, 0), b2, voffB); PG8_STAGE(PG8_SB(0, 1), b2 + hstep, voffB); PG8_STAGE(PG8_SA(0, 0), a2, voffA);
            PG8_WAIT_V(8); PG8_WAIT_L(0); PG8_BAR; PG8_MMA(1, 0, At, B0); PG8_MMA(1, 1, At, B1); PG8_BAR; PG8_SCHED;
            PG8_LDB(B0, 1, 0); PG8_LDB(B1, 1, 1); PG8_SCHED; PG8_LDA(At, 1, 0); PG8_STAGE(PG8_SA(0, 1), a2 + hstep, voffA);
            PG8_WAIT_V(8); PG8_WAIT_L(0); PG8_BAR; PG8_MMA(0, 0, At, B0); PG8_MMA(0, 1, At, B1); PG8_BAR; PG8_SCHED;
            PG8_LDA(At, 1, 1); PG8_STAGE(PG8_SB(1, 0), b3, voffB); PG8_STAGE(PG8_SB(1, 1), b3 + hstep, voffB); PG8_STAGE(PG8_SA(1, 0), a3, voffA);
            PG8_WAIT_V(8); PG8_WAIT_L(0); PG8_BAR; PG8_MMA(1, 0, At, B0); PG8_MMA(1, 1, At, B1); PG8_BAR; PG8_SCHED;
            } else {
            PG8_LDB(B0, 0, 0); PG8_SCHED; PG8_LDA(At, 0, 0); PG8_STAGE(PG8_SA(1, 1), a1 + hstep, voffA);
            PG8_WAIT_L(8); PG8_BAR; PG8_WAIT_L(0); PG8_MMA(0, 0, At, B0); PG8_BAR; PG8_SCHED;
            PG8_LDB(B1, 0, 1); PG8_STAGE(PG8_SB(0, 0), b2, voffB);
            PG8_BAR; PG8_WAIT_L(0); PG8_MMA(0, 1, At, B1); PG8_BAR;
            PG8_LDA(At, 0, 1); PG8_STAGE(PG8_SA(0, 0), a2, voffA);
            PG8_BAR; PG8_WAIT_L(0); PG8_MMA(1, 0, At, B0); PG8_BAR; PG8_SCHED;
            PG8_STAGE(PG8_SB(0, 1), b2 + hstep, voffB);
            PG8_WAIT_V(6); PG8_BAR; PG8_MMA(1, 1, At, B1); PG8_BAR;
            PG8_LDB(B0, 1, 0); PG8_SCHED; PG8_LDA(At, 1, 0); PG8_STAGE(PG8_SA(0, 1), a2 + hstep, voffA);
            PG8_WAIT_L(8); PG8_BAR; PG8_WAIT_L(0); PG8_MMA(0, 0, At, B0); PG8_BAR; PG8_SCHED;
            PG8_LDB(B1, 1, 1); PG8_STAGE(PG8_SB(1, 0), b3, voffB);
            PG8_BAR; PG8_WAIT_L(0); PG8_MMA(0, 1, At, B1); PG8_BAR;
            PG8_LDA(At, 1, 1); PG8_STAGE(PG8_SA(1, 0), a3, voffA);
            PG8_BAR; PG8_WAIT_L(0); PG8_MMA(1, 0, At, B0); PG8_BAR; PG8_SCHED;
            PG8_STAGE(PG8_SB(1, 1), b3 + hstep, voffB);
            PG8_WAIT_V(6); PG8_BAR; PG8_MMA(1, 1, At, B1); PG8_BAR;
            }
        }
        if constexpr (ALIGN_EPI) { if (wr == 0) PG8_BAR; }
        if constexpr (!Epi::AFTER_DRAIN) { E(acc, cur, wr, wc, fr, fq); S.done(cur); }
        if (!has_next) break;
#pragma unroll
        for (int a = 0; a < 2; ++a)
#pragma unroll
            for (int b = 0; b < 2; ++b)
#pragma unroll
                for (int m = 0; m < 4; ++m)
#pragma unroll
                    for (int n = 0; n < 2; ++n) acc[a][b][m][n] = (f32x4){0.f, 0.f, 0.f, 0.f};
        cur = nxt; cA = nA; cB = nB; ++ui;
        if constexpr (ALIGN_EPI) { if (wr == 1) PG8_BAR; }
    }
    PG8_WAIT_V(0);
    if constexpr (!ALIGN_EPI) { if (wr == 0) PG8_BAR; }
    PG8_BAR;
    if constexpr (Epi::AFTER_DRAIN) { E.fused(acc, cur, wr, wc, fr, fq, lds, wid, lane); S.done(cur); }
#undef PG8_SA
#undef PG8_SB
#undef PG8_STAGE
#undef PG8_LDA
#undef PG8_LDB
#undef PG8_MMA
#undef PG8_WAIT_V
#undef PG8_WAIT_L
#undef PG8_BAR
#undef PG8_SCHED
}
}

namespace pg8 {
constexpr float LOG2E = 1.4426950408889634f;
constexpr float QS_NSA = 0.125f * LOG2E;
constexpr float QS_MLA = 0.10206207261596575f * LOG2E;
__device__ __forceinline__ float fast_sigmoid(float x) { return __builtin_amdgcn_rcpf(1.0f + __builtin_amdgcn_exp2f(-LOG2E * x)); }
__device__ __forceinline__ float lo_bf(unsigned u) { return __uint_as_float(u << 16); }
__device__ __forceinline__ float hi_bf(unsigned u) { return __uint_as_float(u & 0xffff0000u); }
struct EpiInProjF {
    static constexpr bool PERM = true, AFTER_DRAIN = false;
    bf16_t* proj; bf16_t* gates;
    __device__ __forceinline__ void operator()(const f32x4 (&acc)[2][2][4][2], const Unit& u, int wr, int wc, int fr, int fq) const {
        const bool isg = u.pn >= 7;
        bf16_t* base = isg ? gates : proj; const int ld = isg ? 2048 : 1792; const int colt = isg ? (u.pn - 7) * BM : u.pn * BM;
        const float sc = (u.pn < 2) ? QS_NSA : 1.0f;
        const int row0 = u.pm * BM + wr * 64 + fr, col0 = colt + wc * 32 + 8 * fq;
#pragma unroll
        for (int ai = 0; ai < 2; ++ai)
#pragma unroll
            for (int m = 0; m < 4; ++m) { bf16_t* rowp = base + (size_t)(row0 + ai * HALF + m * 16) * ld + col0;
#pragma unroll
                for (int bj = 0; bj < 2; ++bj) { f32x4 v0 = acc[ai][bj][m][0], v1 = acc[ai][bj][m][1];
                    if (isg) {
#pragma unroll
                        for (int e = 0; e < 4; ++e) { v0[e] = fast_sigmoid(v0[e]); v1[e] = fast_sigmoid(v1[e]); } }
                    else { v0 = v0 * sc; v1 = v1 * sc; }
                    u32x4 w; w.x = cvt_pk_bf16(v0[0], v0[1]); w.y = cvt_pk_bf16(v0[2], v0[3]); w.z = cvt_pk_bf16(v1[0], v1[1]); w.w = cvt_pk_bf16(v1[2], v1[3]);
                    *(u32x4*)(rowp + bj * HALF) = w; } }
    }
};
template <int PASS> struct EpiMergeF {
    static constexpr bool PERM = true, AFTER_DRAIN = false;
    const bf16_t* gates; bf16_t* merged;
    __device__ __forceinline__ void operator()(const f32x4 (&acc)[2][2][4][2], const Unit& u, int wr, int wc, int fr, int fq) const {
        const int row0 = u.pm * BM + wr * 64 + fr, col0 = u.pn * BM + wc * 32 + 8 * fq;
#pragma unroll
        for (int ai = 0; ai < 2; ++ai)
#pragma unroll
            for (int m = 0; m < 4; ++m) { const size_t r = (size_t)(row0 + ai * HALF + m * 16);
#pragma unroll
                for (int bj = 0; bj < 2; ++bj) { const int c = col0 + bj * HALF;
                    const u32x4 g = *(const u32x4*)(gates + r * 2048 + PASS * 1024 + c);
                    f32x4 v0 = acc[ai][bj][m][0], v1 = acc[ai][bj][m][1];
                    v0[0] *= lo_bf(g.x); v0[1] *= hi_bf(g.x); v0[2] *= lo_bf(g.y); v0[3] *= hi_bf(g.y);
                    v1[0] *= lo_bf(g.z); v1[1] *= hi_bf(g.z); v1[2] *= lo_bf(g.w); v1[3] *= hi_bf(g.w);
                    if (PASS == 1) { const u32x4 o = *(const u32x4*)(merged + r * 1024 + c);
                        v0[0] += lo_bf(o.x); v0[1] += hi_bf(o.x); v0[2] += lo_bf(o.y); v0[3] += hi_bf(o.y);
                        v1[0] += lo_bf(o.z); v1[1] += hi_bf(o.z); v1[2] += lo_bf(o.w); v1[3] += hi_bf(o.w); }
                    u32x4 w; w.x = cvt_pk_bf16(v0[0], v0[1]); w.y = cvt_pk_bf16(v0[2], v0[3]); w.z = cvt_pk_bf16(v1[0], v1[1]); w.w = cvt_pk_bf16(v1[2], v1[3]);
                    *(u32x4*)(merged + r * 1024 + c) = w; } }
    }
};
struct EpiResidF {
    static constexpr bool PERM = false, AFTER_DRAIN = false;
    const float* x; float* h;
    __device__ __forceinline__ void operator()(const f32x4 (&acc)[2][2][4][2], const Unit& u, int wr, int wc, int fr, int fq) const {
        const int row0 = u.pm * BM + wr * 64 + fr, col0 = u.pn * BM + wc * 32 + 4 * fq;
#pragma unroll
        for (int ai = 0; ai < 2; ++ai)
#pragma unroll
            for (int m = 0; m < 4; ++m) { const size_t off = (size_t)(row0 + ai * HALF + m * 16) * 1024 + col0;
#pragma unroll
                for (int bj = 0; bj < 2; ++bj)
#pragma unroll
                    for (int n = 0; n < 2; ++n) { const f32x4 xv = *(const f32x4*)(x + off + bj * HALF + n * 16); *(f32x4*)(h + off + bj * HALF + n * 16) = xv + acc[ai][bj][m][n]; } }
    }
};
struct EpiMlaQF {
    static constexpr bool PERM = false, AFTER_DRAIN = false;
    bf16_t* q; const float2* cs;
    __device__ __forceinline__ void operator()(const f32x4 (&acc)[2][2][4][2], const Unit& u, int wr, int wc, int fr, int fq) const {
        const int row0 = u.pm * BM + wr * 64 + fr;
#pragma unroll
        for (int bj = 0; bj < 2; ++bj) {
            const int X = u.pn * BM + bj * HALF + wc * 32;
            const bool rope = (X % 96) == 64;
#pragma unroll
            for (int ai = 0; ai < 2; ++ai)
#pragma unroll
                for (int m = 0; m < 4; ++m) { const int r = row0 + ai * HALF + m * 16; const int pos = r & (SEQ - 1);
                    f32x4 v0 = acc[ai][bj][m][0], v1 = acc[ai][bj][m][1];
                    if (rope) {
#pragma unroll
                        for (int j = 0; j < 4; ++j) { const float2 c = cs[pos * 16 + 4 * fq + j]; const float x1 = v0[j], x2 = v1[j]; v0[j] = x1 * c.x - x2 * c.y; v1[j] = x2 * c.x + x1 * c.y; } }
                    v0 = v0 * QS_MLA; v1 = v1 * QS_MLA;
                    bf16_t* p = q + (size_t)r * 768 + X + 4 * fq;
                    uint2 w0, w1; w0.x = cvt_pk_bf16(v0[0], v0[1]); w0.y = cvt_pk_bf16(v0[2], v0[3]); w1.x = cvt_pk_bf16(v1[0], v1[1]); w1.y = cvt_pk_bf16(v1[2], v1[3]);
                    *(uint2*)p = w0; *(uint2*)(p + 16) = w1; }
        }
    }
};
}

#define PG8_SP2 true
#define PG8_ALIGN true
constexpr int NTHR = 512, NWV = NTHR / 64;
#define WAVE_IDS const int lane = threadIdx.x & 63, wv = threadIdx.x >> 6; const int gw = blockIdx.x * NWV + wv, nw = gridDim.x * NWV; (void)lane; (void)gw; (void)nw;

DEV void ph_rms1024(const float* __restrict__ src, const float* __restrict__ g, bf16_t* __restrict__ dst, int rows) {
  WAVE_IDS
  for (int r = gw; r < rows; r += nw) {
    const float4* s4 = (const float4*)(src + (size_t)r * 1024);
    float4 v[4]; float ss = 0.f;
#pragma unroll
    for (int j = 0; j < 4; ++j) { v[j] = s4[j * 64 + lane]; ss += v[j].x * v[j].x + v[j].y * v[j].y + v[j].z * v[j].z + v[j].w * v[j].w; }
    ss = wsum(ss);
    const float inv = rsqrtf(ss * (1.0f / 1024.0f) + 1e-6f);
#pragma unroll
    for (int j = 0; j < 4; ++j) {
      const float4 gg = ((const float4*)g)[j * 64 + lane];
      uint2 o;
      o.x = (unsigned)f2bf(v[j].x * inv * gg.x) | ((unsigned)f2bf(v[j].y * inv * gg.y) << 16);
      o.y = (unsigned)f2bf(v[j].z * inv * gg.z) | ((unsigned)f2bf(v[j].w * inv * gg.w) << 16);
      ((uint2*)(dst + (size_t)r * 1024))[j * 64 + lane] = o;
    }
  }
}
template <int PER> DEV void ph_rms_cols(const bf16_t* __restrict__ proj, int col0, const float* __restrict__ g, bf16_t* __restrict__ dst) {
  WAVE_IDS
  constexpr int W = 64 * PER;
  for (int r = gw; r < T; r += nw) {
    float v[PER]; float ss = 0.f;
#pragma unroll
    for (int j = 0; j < PER; ++j) { v[j] = bf2f(proj[(size_t)r * PROJ_LD + col0 + j * 64 + lane]); ss += v[j] * v[j]; }
    ss = wsum(ss);
    const float inv = rsqrtf(ss * (1.0f / W) + 1e-6f);
#pragma unroll
    for (int j = 0; j < PER; ++j) dst[(size_t)r * W + j * 64 + lane] = f2bf(v[j] * inv * g[j * 64 + lane]);
  }
}

DEV int win_src_col(int n) {
  if (n < 1280) return n;
  if (n < 1536) return 1304 + (n - 1280);
  if (n < 1664) return 1560 + (n - 1536);
  if (n < 1696) return 1688 + (n - 1664);
  if (n < 1720) return 1280 + (n - 1696);
  if (n < 1792) return -1;
  return 1720 + (n - 1792);
}
template <int MODE> DEV void ph_convT(const float* __restrict__ W, int K, int Nsrc, bf16_t* __restrict__ WT, int Nout, char* lds) {
  float (*t)[33] = (float (*)[33])lds;
  const int tx = threadIdx.x & 31, ty = threadIdx.x >> 5;
  const int ntn = (Nout + 31) / 32, ntk = K / 32;
  for (int tile = blockIdx.x; tile < ntn * ntk; tile += gridDim.x) {
    const int n0 = (tile % ntn) * 32, k0 = (tile / ntn) * 32;
#pragma unroll
    for (int i = 0; i < 2; ++i) {
      const int k = k0 + ty + 16 * i, n = n0 + tx;
      const int sc = (MODE == 1) ? win_src_col(n) : n;
      t[ty + 16 * i][tx] = (n < Nout && sc >= 0) ? W[(size_t)k * Nsrc + sc] : 0.f;
    }
    __syncthreads();
#pragma unroll
    for (int i = 0; i < 2; ++i) {
      const int n = n0 + ty + 16 * i, k = k0 + tx;
      if (n < Nout) WT[(size_t)n * K + k] = f2bf(t[tx][ty + 16 * i]);
    }
    __syncthreads();
  }
}
DEV void ph_conv_plain(const float* __restrict__ src, bf16_t* __restrict__ dst, int n) {
  for (int i = blockIdx.x * NTHR + threadIdx.x; i < n; i += gridDim.x * NTHR) dst[i] = f2bf(src[i]);
}

DEV void gemm_tile(const bf16_t* __restrict__ A, int lda, const bf16_t* __restrict__ Bt, int ldb, int m0, int n0, int K, float (&acc)[4][4], char* lds) {
  float (*sA)[132] = (float (*)[132])lds;
  float (*sB)[68] = (float (*)[68])(lds + 32 * 132 * 4);
  const int tid = threadIdx.x, ty = tid >> 4, tx = tid & 15;
  const int lr = tid >> 2, lk = (tid & 3) * 8;
  for (int k0 = 0; k0 < K; k0 += 32) {
    {
      const uint4 va = *(const uint4*)(A + (size_t)(m0 + lr) * lda + k0 + lk);
      const unsigned ua[4] = {va.x, va.y, va.z, va.w};
#pragma unroll
      for (int j = 0; j < 4; ++j) { sA[lk + 2 * j][lr] = __uint_as_float(ua[j] << 16); sA[lk + 2 * j + 1][lr] = __uint_as_float(ua[j] & 0xffff0000u); }
    }
    if (tid < 256) {
      const uint4 vb = *(const uint4*)(Bt + (size_t)(n0 + lr) * ldb + k0 + lk);
      const unsigned ub[4] = {vb.x, vb.y, vb.z, vb.w};
#pragma unroll
      for (int j = 0; j < 4; ++j) { sB[lk + 2 * j][lr] = __uint_as_float(ub[j] << 16); sB[lk + 2 * j + 1][lr] = __uint_as_float(ub[j] & 0xffff0000u); }
    }
    __syncthreads();
#pragma unroll 8
    for (int k = 0; k < 32; ++k) {
      const float4 a = *(const float4*)&sA[k][ty * 4];
      const float4 b = *(const float4*)&sB[k][tx * 4];
      const float av[4] = {a.x, a.y, a.z, a.w}, bv[4] = {b.x, b.y, b.z, b.w};
#pragma unroll
      for (int i = 0; i < 4; ++i)
#pragma unroll
        for (int j = 0; j < 4; ++j) acc[i][j] += av[i] * bv[j];
    }
    __syncthreads();
  }
}
struct EpiInProj { bf16_t* proj; bf16_t* gates;
  DEV void operator()(int m, int n, float v) const { if (n < PROJ_LD) proj[(size_t)m * PROJ_LD + n] = f2bf(v); else gates[(size_t)m * 2048 + (n - PROJ_LD)] = f2bf(sigmoidf_(v)); } };
struct EpiStore { bf16_t* dst; int ld;
  DEV void operator()(int m, int n, float v) const { dst[(size_t)m * ld + n] = f2bf(v); } };
struct EpiGelu { bf16_t* dst; int ld;
  DEV void operator()(int m, int n, float v) const { dst[(size_t)m * ld + n] = f2bf(gelu_exact(v)); } };
struct EpiCmpOut { bf16_t* dst;
  DEV void operator()(int m, int n, float v) const { if (m >= BATCH * NC * 2) return; const int g = m & 1, bc = m >> 1, b = bc / NC, c = bc % NC; dst[((size_t)(b * 2 + g) * 128 + c) * 64 + n] = f2bf(v); } };
struct EpiResid { const float* x; float* h;
  DEV void operator()(int m, int n, float v) const { const size_t i = (size_t)m * 1024 + n; h[i] = x[i] + v; } };

template <class Epi> DEV void ph_gemm(const bf16_t* A, int lda, const bf16_t* Bt, int ldb, int M, int N, int K, const Epi& epi, char* lds) {
  const int ntn = N / 64, ntm = M / 128;
  const int ty = threadIdx.x >> 4, tx = threadIdx.x & 15;
  for (int tile = blockIdx.x; tile < ntn * ntm; tile += gridDim.x) {
    const int m0 = (tile / ntn) * 128, n0 = (tile % ntn) * 64;
    float acc[4][4];
#pragma unroll
    for (int i = 0; i < 4; ++i)
#pragma unroll
      for (int j = 0; j < 4; ++j) acc[i][j] = 0.f;
    gemm_tile(A, lda, Bt, ldb, m0, n0, K, acc, lds);
#pragma unroll
    for (int i = 0; i < 4; ++i)
#pragma unroll
      for (int j = 0; j < 4; ++j) epi(m0 + ty * 4 + i, n0 + tx * 4 + j, acc[i][j]);
  }
}
DEV void ph_merge(const bf16_t* onsa, const bf16_t* omla, const bf16_t* wbn, const bf16_t* wbm, const bf16_t* gates, bf16_t* merged, char* lds) {
  const int ntn = 1024 / 64, ntm = T / 128;
  const int ty = threadIdx.x >> 4, tx = threadIdx.x & 15;
  for (int tile = blockIdx.x; tile < ntn * ntm; tile += gridDim.x) {
    const int m0 = (tile / ntn) * 128, n0 = (tile % ntn) * 64;
    float a1[4][4], a2[4][4];
#pragma unroll
    for (int i = 0; i < 4; ++i)
#pragma unroll
      for (int j = 0; j < 4; ++j) { a1[i][j] = 0.f; a2[i][j] = 0.f; }
    gemm_tile(onsa, 512, wbn, 512, m0, n0, 512, a1, lds);
    gemm_tile(omla, 512, wbm, 512, m0, n0, 512, a2, lds);
#pragma unroll
    for (int i = 0; i < 4; ++i)
#pragma unroll
      for (int j = 0; j < 4; ++j) {
        const int m = m0 + ty * 4 + i, n = n0 + tx * 4 + j;
        merged[(size_t)m * 1024 + n] = f2bf(bf2f(gates[(size_t)m * 2048 + n]) * a1[i][j] + bf2f(gates[(size_t)m * 2048 + 1024 + n]) * a2[i][j]);
      }
  }
}

DEV void ph_rope_table(float2* __restrict__ cs) {
  const int n = SEQ * 16;
  for (int i = blockIdx.x * NTHR + threadIdx.x; i < n; i += gridDim.x * NTHR) {
    const int j = i & 15, pos = i >> 4;
    const float inv_freq = powf(10000.0f, -(float)(2 * j) / 32.0f);
    const float ang = (float)pos * inv_freq;
    cs[i] = make_float2(cosf(ang), sinf(ang));
  }
}
DEV void ph_rope_k(const bf16_t* __restrict__ proj, bf16_t* __restrict__ kr) {
  const int n = T * 16;
  for (int i = blockIdx.x * NTHR + threadIdx.x; i < n; i += gridDim.x * NTHR) {
    const int j = i & 15, t = i >> 4;
    const float pos = (float)(t & (SEQ - 1));
    const float inv_freq = powf(10000.0f, -(float)(2 * j) / 32.0f);
    const float ang = pos * inv_freq, c = cosf(ang), s = sinf(ang);
    const float x1 = bf2f(proj[(size_t)t * PROJ_LD + PC_KR + j]), x2 = bf2f(proj[(size_t)t * PROJ_LD + PC_KR + 16 + j]);
    kr[(size_t)t * 32 + j] = f2bf(x1 * c - x2 * s); kr[(size_t)t * 32 + 16 + j] = f2bf(x2 * c + x1 * s);
  }
}
DEV void ph_cmp_gather(const bf16_t* __restrict__ proj, const float* __restrict__ pos, int which, bf16_t* __restrict__ ca) {
  const int n = 2048 * 2048;
  for (int i = blockIdx.x * NTHR + threadIdx.x; i < n; i += gridDim.x * NTHR) {
    const int e = i & 2047, row = i >> 11;
    float v = 0.f;
    if (row < BATCH * NC * 2) {
      const int g = row & 1, bc = row >> 1, b = bc / NC, c = bc % NC, l = e >> 6, d = e & 63;
      v = bf2f(proj[(size_t)(b * SEQ + 16 * c + l) * PROJ_LD + PC_KV + which * 128 + g * 64 + d]) + pos[e];
    }
    ca[i] = f2bf(v);
  }
}

DEV void ph_cmp_attn(const bf16_t* __restrict__ proj, const bf16_t* __restrict__ kc, const bf16_t* __restrict__ vc,
                     const float* __restrict__ t5, bf16_t* __restrict__ ocmp, unsigned* __restrict__ sel, char* lds) {
  WAVE_IDS
  float* P = (float*)(lds + wv * 1024); float* Q = P + 128;
  for (int item = gw; item < BATCH * 2 * SEQ; item += nw) {
    const int t = item & (SEQ - 1), bg = item >> 11, g = bg & 1, b = bg >> 1;
    const size_t tok = (size_t)b * SEQ + t;
    const int nvalid = (t >= 31) ? min(NC, (t - 31) / 16 + 1) : 0;
    const bf16_t* kcb = kc + (size_t)bg * 128 * 64;
    const bf16_t* vcb = vc + (size_t)bg * 128 * 64;
    float impacc = 0.f;
    for (int r = 0; r < 4; ++r) {
      const int head = g * 4 + r;
      Q[lane] = bf2f(proj[tok * PROJ_LD + PC_Q + head * 64 + lane]);
      wave_lds_sync();
      float lg[2];
#pragma unroll
      for (int u = 0; u < 2; ++u) {
        const int c = lane + 64 * u;
        float d = 0.f;
        if (c < nvalid) { const bf16_t* kr = kcb + c * 64; for (int e = 0; e < 64; ++e) d += Q[e] * bf2f(kr[e]); }
        lg[u] = (c < nvalid) ? d + 1.4426950408889634f * t5bias(t5, head, t - (16 * c + 31)) : -1e30f;
      }
      const float m = wmaxf(fmaxf(lg[0], lg[1]));
      const float e0 = (lane < nvalid) ? exp2f(lg[0] - m) : 0.f, e1 = (lane + 64 < nvalid) ? exp2f(lg[1] - m) : 0.f;
      const float s = wsum(e0 + e1);
      const float inv = (nvalid > 0) ? 1.0f / fmaxf(s, 1e-30f) : 0.f;
      P[lane] = e0 * inv; P[lane + 64] = e1 * inv;
      wave_lds_sync();
      float o = 0.f;
      for (int c = 0; c < nvalid; ++c) o += P[c] * bf2f(vcb[c * 64 + lane]);
      ocmp[tok * 512 + head * 64 + lane] = f2bf(o);
      if (lane < 32) { for (int c = 4 * lane - 1; c <= 4 * lane + 3; ++c) if (c >= 0 && c < NC) impacc += P[c]; }
      wave_lds_sync();
    }
    const int cur = t >> 6, n = lane;
    float score = (n > cur) ? -1.0f : ((n == 0 || n == cur || n == cur - 1) ? 1e4f : impacc);
    if (n >= 32) score = -2.0f;
    int rank = 0;
    for (int mth = 0; mth < 32; ++mth) { const float sm = __shfl(score, mth); rank += (sm > score || (sm == score && mth < n)) ? 1 : 0; }
    const unsigned long long bal = __ballot(n < 32 && rank < 16);
    if (lane == 0) sel[item] = (unsigned)bal;
  }
}

DEV void ph_nsa_attn(const bf16_t* __restrict__ proj, const float* __restrict__ t5, const bf16_t* __restrict__ ocmp,
                     const unsigned* __restrict__ sel, bf16_t* __restrict__ onsa, char* lds) {
  WAVE_IDS
  float* P = (float*)(lds + wv * 1024); float* Q = P + 128;
  for (int item = gw; item < BATCH * 2 * SEQ * 4; item += nw) {
    const int r = item & 3, t = (item >> 2) & (SEQ - 1), bg = item >> 13, g = bg & 1, b = bg >> 1;
    const int head = g * 4 + r, cur = t >> 6;
    const size_t tok = (size_t)b * SEQ + t;
    Q[lane] = bf2f(proj[tok * PROJ_LD + PC_Q + head * 64 + lane]);
    wave_lds_sync();
    const unsigned smask = sel[bg * SEQ + t];
    float res0 = 0.f, res1 = 0.f;
    for (int br = 0; br < 2; ++br) {
      float m = -1e30f, l = 0.f, o = 0.f;
      const int nb0 = (br == 0) ? 0 : max(0, cur - 8);
      for (int nb = nb0; nb <= cur; ++nb) {
        if (br == 0 && !((smask >> nb) & 1u)) continue;
        const int s = nb * 64 + lane, dist = t - s;
        const bool valid = (dist >= 0) && (br == 0 || dist < 512);
        const bf16_t* kp = proj + ((size_t)b * SEQ + s) * PROJ_LD + PC_KV + (2 + 2 * br) * 128 + g * 64;
        float d = 0.f;
        for (int e = 0; e < 64; e += 8) {
          const uint4 kv = *(const uint4*)(kp + e);
          d += Q[e + 0] * __uint_as_float(kv.x << 16) + Q[e + 1] * __uint_as_float(kv.x & 0xffff0000u);
          d += Q[e + 2] * __uint_as_float(kv.y << 16) + Q[e + 3] * __uint_as_float(kv.y & 0xffff0000u);
          d += Q[e + 4] * __uint_as_float(kv.z << 16) + Q[e + 5] * __uint_as_float(kv.z & 0xffff0000u);
          d += Q[e + 6] * __uint_as_float(kv.w << 16) + Q[e + 7] * __uint_as_float(kv.w & 0xffff0000u);
        }
        const float lg = valid ? d + 1.4426950408889634f * t5bias(t5, head, dist) : -1e30f;
        const float mn = fmaxf(m, wmaxf(lg));
        const float sc = exp2f(m - mn);
        const float pe = valid ? exp2f(lg - mn) : 0.f;
        l = l * sc + wsum(pe); m = mn;
        P[lane] = pe;
        wave_lds_sync();
        const bf16_t* vp = proj + ((size_t)b * SEQ + nb * 64) * PROJ_LD + PC_KV + (3 + 2 * br) * 128 + g * 64 + lane;
        float acc = 0.f;
        for (int k = 0; k < 64; ++k) acc += P[k] * bf2f(vp[(size_t)k * PROJ_LD]);
        o = o * sc + acc;
        wave_lds_sync();
      }
      if (br == 0) res0 = o / fmaxf(l, 1e-30f); else res1 = o / fmaxf(l, 1e-30f);
    }
    const bf16_t* gp = proj + tok * PROJ_LD + PC_GATE + head * 3;
    const float g0 = sigmoidf_(bf2f(gp[0])), g1 = sigmoidf_(bf2f(gp[1])), g2 = sigmoidf_(bf2f(gp[2]));
    const float oc = bf2f(ocmp[tok * 512 + head * 64 + lane]);
    onsa[tok * 512 + head * 64 + lane] = f2bf(g0 * oc + g1 * res0 + g2 * res1);
    wave_lds_sync();
  }
}

DEV void ph_mla_attn(const bf16_t* __restrict__ mq, const bf16_t* __restrict__ mkv, const bf16_t* __restrict__ kr, bf16_t* __restrict__ omla, char* lds) {
  WAVE_IDS
  float* P = (float*)(lds + wv * 1024); float* Q = P + 128;
  for (int item = gw; item < BATCH * 8 * SEQ; item += nw) {
    const int h = item & 7, t = (item >> 3) & (SEQ - 1), b = item >> 14;
    const size_t tok = (size_t)b * SEQ + t;
    Q[lane] = bf2f(mq[tok * 768 + h * 96 + lane]);
    if (lane < 32) Q[64 + lane] = bf2f(mq[tok * 768 + h * 96 + 64 + lane]);
    wave_lds_sync();
    float m = -1e30f, l = 0.f, o = 0.f;
    for (int nb = 0; nb <= (t >> 6); ++nb) {
      const int s = nb * 64 + lane;
      const bool valid = s <= t;
      const bf16_t* kp = mkv + ((size_t)b * SEQ + s) * 1024 + h * 128;
      const bf16_t* rp = kr + ((size_t)b * SEQ + s) * 32;
      float d = 0.f;
      for (int e = 0; e < 64; e += 8) {
        const uint4 kv = *(const uint4*)(kp + e);
        d += Q[e + 0] * __uint_as_float(kv.x << 16) + Q[e + 1] * __uint_as_float(kv.x & 0xffff0000u);
        d += Q[e + 2] * __uint_as_float(kv.y << 16) + Q[e + 3] * __uint_as_float(kv.y & 0xffff0000u);
        d += Q[e + 4] * __uint_as_float(kv.z << 16) + Q[e + 5] * __uint_as_float(kv.z & 0xffff0000u);
        d += Q[e + 6] * __uint_as_float(kv.w << 16) + Q[e + 7] * __uint_as_float(kv.w & 0xffff0000u);
      }
      for (int e = 0; e < 32; e += 8) {
        const uint4 kv = *(const uint4*)(rp + e);
        d += Q[64 + e + 0] * __uint_as_float(kv.x << 16) + Q[64 + e + 1] * __uint_as_float(kv.x & 0xffff0000u);
        d += Q[64 + e + 2] * __uint_as_float(kv.y << 16) + Q[64 + e + 3] * __uint_as_float(kv.y & 0xffff0000u);
        d += Q[64 + e + 4] * __uint_as_float(kv.z << 16) + Q[64 + e + 5] * __uint_as_float(kv.z & 0xffff0000u);
        d += Q[64 + e + 6] * __uint_as_float(kv.w << 16) + Q[64 + e + 7] * __uint_as_float(kv.w & 0xffff0000u);
      }
      const float lg = valid ? d : -1e30f;
      const float mn = fmaxf(m, wmaxf(lg));
      const float sc = exp2f(m - mn);
      const float pe = valid ? exp2f(lg - mn) : 0.f;
      l = l * sc + wsum(pe); m = mn;
      P[lane] = pe;
      wave_lds_sync();
      const bf16_t* vp = mkv + ((size_t)b * SEQ + nb * 64) * 1024 + h * 128 + 64 + lane;
      float acc = 0.f;
      for (int k = 0; k < 64; ++k) acc += P[k] * bf2f(vp[(size_t)k * 1024]);
      o = o * sc + acc;
      wave_lds_sync();
    }
    omla[tok * 512 + h * 64 + lane] = f2bf(o / fmaxf(l, 1e-30f));
    wave_lds_sync();
  }
}

DEV void wave_argmax(float& v, int& idx) {
#pragma unroll
  for (int o = 32; o > 0; o >>= 1) {
    const float ov = __shfl_xor(v, o); const int oi = __shfl_xor(idx, o);
    if (ov > v || (ov == v && oi < idx)) { v = ov; idx = oi; }
  }
}
DEV void ph_route(const bf16_t* __restrict__ pq, const bf16_t* __restrict__ subk, int* __restrict__ pidx, float* __restrict__ pw, char* lds) {
  WAVE_IDS
  float* Q = (float*)(lds + wv * 1024);
  float* TS = Q + 128;
  int* TI = (int*)(TS + 32);
  for (int item = gw; item < T * 8; item += nw) {
    const int h = item & 7, t = item >> 3;
    Q[lane] = bf2f(pq[(size_t)t * 1024 + h * 128 + lane]);
    Q[lane + 64] = bf2f(pq[(size_t)t * 1024 + h * 128 + 64 + lane]);
    wave_lds_sync();
    for (int p = 0; p < 2; ++p) {
      const bf16_t* kb = subk + (size_t)((h * 2 + p) * 128) * 64;
      float s0 = 0.f, s1 = 0.f;
      for (int e = 0; e < 64; ++e) { const float qv = Q[p * 64 + e]; s0 += qv * bf2f(kb[lane * 64 + e]); s1 += qv * bf2f(kb[(lane + 64) * 64 + e]); }
      for (int k = 0; k < 16; ++k) {
        float v = (s0 >= s1) ? s0 : s1; int idx = (s0 >= s1) ? lane : lane + 64;
        wave_argmax(v, idx);
        if (lane == 0) { TS[p * 16 + k] = v; TI[p * 16 + k] = idx; }
        if (idx == lane) s0 = -3e38f;
        if (idx == lane + 64) s1 = -3e38f;
      }
    }
    wave_lds_sync();
    float cv[4];
#pragma unroll
    for (int u = 0; u < 4; ++u) { const int f = lane + 64 * u; cv[u] = TS[f >> 4] + TS[16 + (f & 15)]; }
    int myexp = 0; float mybest = 0.f, best0 = 0.f, den = 0.f;
#pragma unroll
    for (int k = 0; k < 16; ++k) {
      float v = cv[0]; int idx = lane;
#pragma unroll
      for (int u = 1; u < 4; ++u) if (cv[u] > v) { v = cv[u]; idx = lane + 64 * u; }
      wave_argmax(v, idx);
#pragma unroll
      for (int u = 0; u < 4; ++u) if (idx == lane + 64 * u) cv[u] = -3e38f;
      if (k == 0) best0 = v;
      den += expf(v - best0);
      if (lane == k) { myexp = TI[idx >> 4] * 128 + TI[16 + (idx & 15)]; mybest = v; }
    }
    if (lane < 16) { pidx[(size_t)t * 128 + h * 16 + lane] = myexp; pw[(size_t)t * 128 + h * 16 + lane] = expf(mybest - best0) / den; }
    wave_lds_sync();
  }
}

DEV void ph_experts(const bf16_t* __restrict__ hn, const int* __restrict__ pidx, const float* __restrict__ pw,
                    const float* __restrict__ pu, const float* __restrict__ pv, const float* __restrict__ gfin, float* __restrict__ out) {
  WAVE_IDS
  for (int t = gw; t < T; t += nw) {
    float4 x[4], y[4];
#pragma unroll
    for (int j = 0; j < 4; ++j) {
      const uint2 r = ((const uint2*)(hn + (size_t)t * 1024))[j * 64 + lane];
      x[j] = make_float4(__uint_as_float(r.x << 16), __uint_as_float(r.x & 0xffff0000u), __uint_as_float(r.y << 16), __uint_as_float(r.y & 0xffff0000u));
      y[j] = make_float4(0.f, 0.f, 0.f, 0.f);
    }
    const int e0 = pidx[(size_t)t * 128 + lane], e1 = pidx[(size_t)t * 128 + 64 + lane];
    const float w0 = pw[(size_t)t * 128 + lane], w1 = pw[(size_t)t * 128 + 64 + lane];
    for (int s = 0; s < 128; ++s) {
      const int e = __shfl((s < 64) ? e0 : e1, s & 63);
      const float w = __shfl((s < 64) ? w0 : w1, s & 63);
      const float4* ur = (const float4*)(pu + (size_t)e * 1024);
      float d = 0.f;
#pragma unroll
      for (int j = 0; j < 4; ++j) { const float4 u = ur[j * 64 + lane]; d += u.x * x[j].x + u.y * x[j].y + u.z * x[j].z + u.w * x[j].w; }
      d = wsum(d);
      const float c = w * gelu_exact(d);
      const float4* vr = (const float4*)(pv + (size_t)e * 1024);
#pragma unroll
      for (int j = 0; j < 4; ++j) { const float4 v = vr[j * 64 + lane]; y[j].x += c * v.x; y[j].y += c * v.y; y[j].z += c * v.z; y[j].w += c * v.w; }
    }
    float4* o4 = (float4*)(out + (size_t)t * 1024);
    float ss = 0.f;
#pragma unroll
    for (int j = 0; j < 4; ++j) {
      const float4 hv = o4[j * 64 + lane];
      y[j].x += hv.x; y[j].y += hv.y; y[j].z += hv.z; y[j].w += hv.w;
      ss += y[j].x * y[j].x + y[j].y * y[j].y + y[j].z * y[j].z + y[j].w * y[j].w;
    }
    ss = wsum(ss);
    const float inv = rsqrtf(ss * (1.0f / 1024.0f) + 1e-6f);
#pragma unroll
    for (int j = 0; j < 4; ++j) {
      const float4 gg = ((const float4*)gfin)[j * 64 + lane];
      o4[j * 64 + lane] = make_float4(y[j].x * inv * gg.x, y[j].y * inv * gg.y, y[j].z * inv * gg.z, y[j].w * inv * gg.w);
    }
  }
}


namespace att {
#define LAS3 __attribute__((address_space(3)))
typedef LAS3 char* lptr;
typedef LAS3 const char* lcptr;
using bf16x8 = __attribute__((ext_vector_type(8))) short;
using s16x4 = __attribute__((ext_vector_type(4))) short;
using f32x16 = __attribute__((ext_vector_type(16))) float;
typedef short v4i16_t __attribute__((ext_vector_type(4)));
typedef unsigned u32x4 __attribute__((ext_vector_type(4)));
typedef float f32x4_t __attribute__((ext_vector_type(4)));
typedef float f32x2_t __attribute__((ext_vector_type(2)));
typedef __bf16 bf16x2_t __attribute__((ext_vector_type(2)));
constexpr float LOG2E = 1.4426950408889634f;
constexpr float THR = 6.0f;
constexpr float NEG_INF = -__builtin_huge_valf();
constexpr int SLOT = 20480, KOFF = 0, VOFF = 12288;
constexpr int L_WSF = 2 * SLOT;
constexpr int L_TB = L_WSF + 2048;
constexpr int L_SELM = L_TB + 4096;
constexpr int L_SC = L_SELM + 256;
constexpr int L_IMPQ = L_SC + 64 * 33 * 4;
constexpr int L_IMPL = L_IMPQ + 4 * 64 * 33 * 4;
constexpr int L_FIN = L_IMPQ;
constexpr int L_END = L_IMPL + 4 * 64 * 33 * 4;
static_assert(L_END <= 131072, "attention LDS map");

__device__ __forceinline__ int crow(int r, int hi) { return (r & 3) + 8 * (r >> 2) + 4 * hi; }
__device__ __forceinline__ s16x4 vtr(lcptr p) { return __builtin_bit_cast(s16x4, __builtin_amdgcn_ds_read_tr16_b64_v4i16((LAS3 v4i16_t*)p)); }
__device__ __forceinline__ unsigned cvtpk(float lo, float hi) { f32x2_t v = {lo, hi}; bf16x2_t b = __builtin_convertvector(v, bf16x2_t); return __builtin_bit_cast(unsigned, b); }
__device__ __forceinline__ float xmax(float v) { auto rr = __builtin_amdgcn_permlane32_swap(__float_as_uint(v), __float_as_uint(v), false, false); return fmaxf(__uint_as_float(rr[0]), __uint_as_float(rr[1])); }
__device__ __forceinline__ float xsum(float v) { auto rr = __builtin_amdgcn_permlane32_swap(__float_as_uint(v), __float_as_uint(v), false, false); return __uint_as_float(rr[0]) + __uint_as_float(rr[1]); }
__device__ __forceinline__ float ex2(float x) { return __builtin_amdgcn_exp2f(x); }

template <int ND0> __device__ __forceinline__ void qkt(f32x16& p0, f32x16& p1, lcptr kb, const bf16x8* qr) {
  p0 = f32x16{}; p1 = f32x16{};
#pragma unroll
  for (int d0 = 0; d0 < ND0; ++d0) {
    const bf16x8 b0 = *(const LAS3 bf16x8*)(kb + d0 * 2048);
    const bf16x8 b1 = *(const LAS3 bf16x8*)(kb + d0 * 2048 + 512);
    p0 = __builtin_amdgcn_mfma_f32_32x32x16_bf16(b0, qr[d0], p0, 0, 0, 0);
    p1 = __builtin_amdgcn_mfma_f32_32x32x16_bf16(b1, qr[d0], p1, 0, 0, 0);
  }
}
__device__ __forceinline__ void pv(f32x16 (&o)[2], lcptr vp, const unsigned (&pw)[16]) {
#pragma unroll
  for (int d0 = 0; d0 < 2; ++d0)
#pragma unroll
    for (int ks = 0; ks < 4; ++ks) {
      const s16x4 lo = vtr(vp + d0 * 4096 + ks * 1024), hi4 = vtr(vp + d0 * 4096 + ks * 1024 + 512);
      const bf16x8 vf = {lo[0], lo[1], lo[2], lo[3], hi4[0], hi4[1], hi4[2], hi4[3]};
      const unsigned pa4[4] = {pw[4 * ks], pw[4 * ks + 1], pw[4 * ks + 2], pw[4 * ks + 3]};
      o[d0] = __builtin_amdgcn_mfma_f32_32x32x16_bf16(__builtin_bit_cast(bf16x8, pa4), vf, o[d0], 0, 0, 0);
    }
}
__device__ __forceinline__ void softmax_step(f32x16& p0, f32x16& p1, float& m, float& l, f32x16 (&o)[2], LAS3 float* wsf, int r32, int hi, unsigned (&pw)[16]) {
  float rm = fmaxf(p0[0], p1[0]);
#pragma unroll
  for (int r = 1; r < 16; ++r) rm = fmaxf(rm, fmaxf(p0[r], p1[r]));
  rm = xmax(rm);
  if (__any(rm > m + THR)) {
    const float mn = fmaxf(m, rm);
    const float al = ex2(m - mn);
    m = mn; l *= al;
    if (hi == 0) wsf[r32] = al;
#pragma unroll
    for (int r = 0; r < 16; ++r) { const float f = wsf[crow(r, hi)]; o[0][r] *= f; o[1][r] *= f; }
  }
  float s = 0.f;
#pragma unroll
  for (int r = 0; r < 16; ++r) { p0[r] = ex2(p0[r] - m); p1[r] = ex2(p1[r] - m); s += p0[r] + p1[r]; }
  l += s;
#pragma unroll
  for (int i = 0; i < 8; ++i) { pw[i] = cvtpk(p0[2 * i], p0[2 * i + 1]); pw[8 + i] = cvtpk(p1[2 * i], p1[2 * i + 1]); }
}
struct KVSrc { const bf16_t* k; const bf16_t* v; int ldk, ldv; };
__device__ __forceinline__ void kv_issue(const KVSrc& s, int row0, u32x4& rk, u32x4& rv, int tid) {
  const int kv = tid & 63, ch = tid >> 6, ln = tid & 63;
  rk = *(const u32x4*)(s.k + (size_t)(row0 + kv) * s.ldk + ch * 8);
  rv = *(const u32x4*)(s.v + (size_t)(row0 + 16 * (ch & 3) + (ln >> 2)) * s.ldv + (ch >> 2) * 32 + (ln & 3) * 8);
}
__device__ __forceinline__ void kv_commit(lptr slot, const u32x4& rk, const u32x4& rv, int tid) {
  *(LAS3 u32x4*)(slot + KOFF + (tid >> 6) * 1024 + (tid & 63) * 16) = rk;
  *(LAS3 u32x4*)(slot + VOFF + tid * 16) = rv;
}
__device__ __forceinline__ void fin_set(LAS3 float* finl, const f32x16 (&o)[2], int lane) {
#pragma unroll
  for (int d0 = 0; d0 < 2; ++d0)
#pragma unroll
    for (int r = 0; r < 16; ++r) finl[(d0 * 16 + r) * 64 + lane] = o[d0][r];
}
__device__ __forceinline__ void fin_add(LAS3 float* finl, const f32x16 (&o)[2], const LAS3 float* wsf, int lane, int hi) {
#pragma unroll
  for (int r = 0; r < 16; ++r) { const float f = wsf[crow(r, hi)];
#pragma unroll
    for (int d0 = 0; d0 < 2; ++d0) finl[(d0 * 16 + r) * 64 + lane] += o[d0][r] * f; }
}
__device__ __forceinline__ void fin_store(const LAS3 float* finl, bf16_t* gout, size_t rowbase, int ld, int colbase, int lane) {
#pragma unroll
  for (int i = 0; i < 4; ++i) {
    const int q = i * 8 + (lane >> 3), ch = lane & 7;
    const int qh = (q >> 2) & 1, r = (q & 3) + 4 * (q >> 3), d0 = ch >> 2, dl = (ch & 3) * 8;
    const LAS3 float* p = finl + (d0 * 16 + r) * 64 + qh * 32 + dl;
    const f32x4_t x0 = *(const LAS3 f32x4_t*)p, x1 = *(const LAS3 f32x4_t*)(p + 4);
    u32x4 v; v.x = cvtpk(x0[0], x0[1]); v.y = cvtpk(x0[2], x0[3]); v.z = cvtpk(x1[0], x1[1]); v.w = cvtpk(x1[2], x1[3]);
    *(u32x4*)(gout + (rowbase + q) * (size_t)ld + colbase + ch * 8) = v;
  }
}

__device__ __forceinline__ void nsa_unit(int b, int g, int c, const bf16_t* __restrict__ proj, const bf16_t* __restrict__ kc, const bf16_t* __restrict__ vc, bf16_t* __restrict__ onsa, lptr lds) {
  int tid = threadIdx.x; asm volatile("" : "+v"(tid));
  const int lane = tid & 63, r32 = lane & 31, hi = lane >> 5;
  const int w = __builtin_amdgcn_readfirstlane(tid >> 6);
  const int rh = w >> 1, head = g * 4 + rh, tokl = 32 * (w & 1) + r32, t = 64 * c + tokl, bg = b * 2 + g;
  const size_t tok = (size_t)b * SEQ + t;
  LAS3 float* wsf = (LAS3 float*)(lds + L_WSF) + w * 64;
  const LAS3 float* tb = (const LAS3 float*)(lds + L_TB) + head * 128;
  LAS3 unsigned* selm = (LAS3 unsigned*)(lds + L_SELM);
  LAS3 float* sc = (LAS3 float*)(lds + L_SC);
  LAS3 float* impq = (LAS3 float*)(lds + L_IMPQ);
  LAS3 float* impl = (LAS3 float*)(lds + L_IMPL);
  const lcptr kb0 = (lcptr)lds + KOFF + hi * 1024 + r32 * 16;
  const lcptr vp0 = (lcptr)lds + VOFF + ((lane >> 4) & 1) * 32 + (lane & 3) * 8 + (4 * hi + ((lane & 15) >> 2)) * 64;
  bf16x8 qr[4];
#pragma unroll
  for (int d0 = 0; d0 < 4; ++d0) qr[d0] = *(const bf16x8*)(proj + tok * PROJ_LD + PC_Q + head * 64 + d0 * 16 + hi * 8);
  float gate[3];
#pragma unroll
  for (int j = 0; j < 3; ++j) gate[j] = 1.0f / (1.0f + ex2(-LOG2E * bf2f(proj[tok * PROJ_LD + PC_GATE + head * 3 + j])));
  LAS3 float* finl = (LAS3 float*)(lds + L_FIN) + w * 2048;
  f32x16 o[2]; unsigned pw[16];
  u32x4 rk, rv;
  {
    const KVSrc src{kc + (size_t)bg * 128 * 64, vc + (size_t)bg * 128 * 64, 64, 64};
    __syncthreads();
    kv_issue(src, 0, rk, rv, tid); kv_commit(lds, rk, rv, tid);
    kv_issue(src, 64, rk, rv, tid); kv_commit(lds + SLOT, rk, rv, tid);
    __syncthreads();
    f32x16 a0, a1, b0, b1;
    qkt<4>(a0, a1, kb0, qr); qkt<4>(b0, b1, kb0 + SLOT, qr);
    float rm = NEG_INF;
#pragma unroll
    for (int r = 0; r < 16; ++r) {
      const int cb = crow(r, hi);
      { const int d = t - 16 * cb - 31;          a0[r] = (d < 0) ? NEG_INF : a0[r] + ((d < 113) ? tb[d] : 0.f); }
      { const int d = t - 16 * (cb + 32) - 31;   a1[r] = (d < 0) ? NEG_INF : a1[r] + ((d < 113) ? tb[d] : 0.f); }
      { const int d = t - 16 * (cb + 64) - 31;   b0[r] = (d < 0) ? NEG_INF : b0[r] + ((d < 113) ? tb[d] : 0.f); }
      { const int d = t - 16 * (cb + 96) - 31;   b1[r] = (d < 0) ? NEG_INF : b1[r] + ((d < 113) ? tb[d] : 0.f); }
      rm = fmaxf(fmaxf(rm, fmaxf(a0[r], a1[r])), fmaxf(b0[r], b1[r]));
    }
    rm = xmax(rm);
    const float mref = (rm == NEG_INF) ? 0.f : rm;
    float s = 0.f;
#pragma unroll
    for (int r = 0; r < 16; ++r) { a0[r] = ex2(a0[r] - mref); a1[r] = ex2(a1[r] - mref); b0[r] = ex2(b0[r] - mref); b1[r] = ex2(b1[r] - mref); s += (a0[r] + a1[r]) + (b0[r] + b1[r]); }
    s = xsum(s);
    const float inv = (s > 0.f) ? 1.0f / s : 0.f;
#pragma unroll
    for (int r = 0; r < 16; ++r) { a0[r] *= inv; a1[r] *= inv; b0[r] *= inv; b1[r] *= inv; }
    { LAS3 float* iq = impq + (rh * 64 + tokl) * 33; LAS3 float* il = impl + (rh * 64 + tokl) * 33;
#pragma unroll
      for (int q4 = 0; q4 < 4; ++q4) {
        const int gi = 2 * q4 + hi;
        iq[gi] = (a0[4 * q4] + a0[4 * q4 + 1]) + (a0[4 * q4 + 2] + a0[4 * q4 + 3]);           il[gi] = a0[4 * q4 + 3];
        iq[8 + gi] = (a1[4 * q4] + a1[4 * q4 + 1]) + (a1[4 * q4 + 2] + a1[4 * q4 + 3]);       il[8 + gi] = a1[4 * q4 + 3];
        iq[16 + gi] = (b0[4 * q4] + b0[4 * q4 + 1]) + (b0[4 * q4 + 2] + b0[4 * q4 + 3]);      il[16 + gi] = b0[4 * q4 + 3];
        iq[24 + gi] = (b1[4 * q4] + b1[4 * q4 + 1]) + (b1[4 * q4 + 2] + b1[4 * q4 + 3]);      il[24 + gi] = b1[4 * q4 + 3];
      } }
    o[0] = f32x16{}; o[1] = f32x16{};
#pragma unroll
    for (int i = 0; i < 8; ++i) { pw[i] = cvtpk(a0[2 * i], a0[2 * i + 1]); pw[8 + i] = cvtpk(a1[2 * i], a1[2 * i + 1]); }
    pv(o, vp0, pw);
#pragma unroll
    for (int i = 0; i < 8; ++i) { pw[i] = cvtpk(b0[2 * i], b0[2 * i + 1]); pw[8 + i] = cvtpk(b1[2 * i], b1[2 * i + 1]); }
    pv(o, vp0 + SLOT, pw);
    if (hi == 0) wsf[r32] = gate[0];
#pragma unroll
    for (int r = 0; r < 16; ++r) { const float f = wsf[crow(r, hi)]; o[0][r] *= f; o[1][r] *= f; }
  }
  __syncthreads();
  const KVSrc ssrc{proj + (size_t)b * SEQ * PROJ_LD + PC_KV + 2 * 128 + g * 64, proj + (size_t)b * SEQ * PROJ_LD + PC_KV + 3 * 128 + g * 64, PROJ_LD, PROJ_LD};
  kv_issue(ssrc, 0, rk, rv, tid);
  {
    const int stok = tid >> 3, sub = tid & 7;
#pragma unroll
    for (int k = 0; k < 4; ++k) {
      const int n = sub * 4 + k;
      float imp = 0.f;
#pragma unroll
      for (int hh = 0; hh < 4; ++hh) imp += impq[(hh * 64 + stok) * 33 + n] + ((n > 0) ? impl[(hh * 64 + stok) * 33 + n - 1] : 0.f);
      sc[stok * 33 + n] = (n > c) ? -1.0f : ((n == 0 || n == c || n == c - 1) ? 1e4f : imp);
    }
    if (tid < 64) selm[tid] = 0u;
    __syncthreads();
#pragma unroll
    for (int k = 0; k < 4; ++k) {
      const int n = sub * 4 + k; const float sv = sc[stok * 33 + n]; int rank = 0;
      for (int mm = 0; mm < 32; ++mm) { const float sm = sc[stok * 33 + mm]; rank += (sm > sv || (sm == sv && mm < n)) ? 1 : 0; }
      if (rank < 16) atomicOr((unsigned*)(selm + stok), 1u << n);
    }
    __syncthreads();
  }
  const unsigned mysel = selm[tokl];
  fin_set(finl, o, lane);
#pragma unroll 1
  for (int br = 0; br < 2; ++br) {
    const KVSrc src = (br == 0) ? ssrc : KVSrc{proj + (size_t)b * SEQ * PROJ_LD + PC_KV + 4 * 128 + g * 64, proj + (size_t)b * SEQ * PROJ_LD + PC_KV + 5 * 128 + g * 64, PROJ_LD, PROJ_LD};
    const int n0 = (br == 0) ? 0 : ((c > 8) ? c - 8 : 0);
    if (br == 1) { __syncthreads(); kv_issue(src, n0 * 64, rk, rv, tid); }
    kv_commit(lds, rk, rv, tid);
    float m = -1e30f, l = 0.f;
    o[0] = f32x16{}; o[1] = f32x16{};
    int cur = 0;
#pragma unroll 1
    for (int n = n0; n <= c; ++n) {
      __syncthreads();
      if (n < c) kv_issue(src, (n + 1) * 64, rk, rv, tid);
      const bool mine = (br == 1) || ((mysel >> n) & 1u);
      if (__any(mine)) {
        f32x16 p0, p1;
        qkt<4>(p0, p1, kb0 + cur * SLOT, qr);
        if (n + 2 >= c) {
          const int dbase = t - 64 * n;
#pragma unroll
          for (int r = 0; r < 16; ++r) { const int d0_ = dbase - crow(r, hi), d1_ = d0_ - 32;
            p0[r] = (d0_ < 0) ? NEG_INF : p0[r] + ((d0_ < 113) ? tb[d0_] : 0.f);
            p1[r] = (d1_ < 0) ? NEG_INF : p1[r] + ((d1_ < 113) ? tb[d1_] : 0.f); }
        } else if (br == 1 && n + 8 == c) {
          const int dbase = t - 64 * n;
#pragma unroll
          for (int r = 0; r < 16; ++r) { const int d0_ = dbase - crow(r, hi), d1_ = d0_ - 32;
            if (d0_ >= 512) p0[r] = NEG_INF; if (d1_ >= 512) p1[r] = NEG_INF; }
        }
        if (!mine) {
#pragma unroll
          for (int r = 0; r < 16; ++r) { p0[r] = NEG_INF; p1[r] = NEG_INF; } }
        softmax_step(p0, p1, m, l, o, wsf, r32, hi, pw);
        pv(o, vp0 + cur * SLOT, pw);
      }
      if (n < c) kv_commit(lds + (cur ^ 1) * SLOT, rk, rv, tid);
      cur ^= 1;
    }
    l = xsum(l);
    const float gi = gate[1 + br] / fmaxf(l, 1e-30f);
    if (hi == 0) wsf[r32] = gi;
    fin_add(finl, o, wsf, lane, hi);
  }
  fin_store(finl, onsa, (size_t)b * SEQ + 64 * c + 32 * (w & 1), 512, head * 64, lane);
}

__device__ __forceinline__ void mla_unit(int b, int h, int qb, const bf16_t* __restrict__ mq, const bf16_t* __restrict__ mkv, const bf16_t* __restrict__ kr, bf16_t* __restrict__ omla, lptr lds) {
  int tid = threadIdx.x; asm volatile("" : "+v"(tid));
  const int lane = tid & 63, r32 = lane & 31, hi = lane >> 5;
  const int w = __builtin_amdgcn_readfirstlane(tid >> 6);
  const int q0 = 256 * qb, qw = q0 + 32 * w, qpos = qw + r32;
  const size_t tokq = (size_t)b * SEQ + qpos;
  LAS3 float* wsf = (LAS3 float*)(lds + L_WSF) + w * 64;
  const lcptr kb0 = (lcptr)lds + KOFF + hi * 1024 + r32 * 16;
  const lcptr vp0 = (lcptr)lds + VOFF + ((lane >> 4) & 1) * 32 + (lane & 3) * 8 + (4 * hi + ((lane & 15) >> 2)) * 64;
  bf16x8 qr[6];
#pragma unroll
  for (int d0 = 0; d0 < 6; ++d0) qr[d0] = *(const bf16x8*)(mq + tokq * 768 + h * 96 + d0 * 16 + hi * 8);
  const KVSrc src{mkv + (size_t)b * SEQ * 1024 + h * 128, mkv + (size_t)b * SEQ * 1024 + h * 128 + 64, 1024, 1024};
  const bf16_t* krb = kr + (size_t)b * SEQ * 32;
  const int NTL = 4 * (qb + 1);
  u32x4 rk, rv, rr = {0u, 0u, 0u, 0u};
  f32x16 o[2]; o[0] = f32x16{}; o[1] = f32x16{};
  unsigned pw[16];
  float m = -1e30f, l = 0.f;
  __syncthreads();
  kv_issue(src, 0, rk, rv, tid);
  if (tid < 256) rr = *(const u32x4*)(krb + (size_t)(tid & 63) * 32 + (tid >> 6) * 8);
  kv_commit(lds, rk, rv, tid);
  if (tid < 256) *(LAS3 u32x4*)(lds + KOFF + (8 + (tid >> 6)) * 1024 + (tid & 63) * 16) = rr;
  int cur = 0;
#pragma unroll 1
  for (int tl = 0; tl < NTL; ++tl) {
    __syncthreads();
    if (tl + 1 < NTL) { kv_issue(src, (tl + 1) * 64, rk, rv, tid); if (tid < 256) rr = *(const u32x4*)(krb + (size_t)((tl + 1) * 64 + (tid & 63)) * 32 + (tid >> 6) * 8); }
    if (64 * tl <= qw + 31) {
      f32x16 p0, p1;
      qkt<6>(p0, p1, kb0 + cur * SLOT, qr);
      if (64 * tl + 63 > qw) {
        const int dbase = qpos - 64 * tl;
#pragma unroll
        for (int r = 0; r < 16; ++r) { const int d0_ = dbase - crow(r, hi), d1_ = d0_ - 32; if (d0_ < 0) p0[r] = NEG_INF; if (d1_ < 0) p1[r] = NEG_INF; }
      }
      softmax_step(p0, p1, m, l, o, wsf, r32, hi, pw);
      pv(o, vp0 + cur * SLOT, pw);
    }
    if (tl + 1 < NTL) { kv_commit(lds + (cur ^ 1) * SLOT, rk, rv, tid); if (tid < 256) *(LAS3 u32x4*)(lds + (cur ^ 1) * SLOT + KOFF + (8 + (tid >> 6)) * 1024 + (tid & 63) * 16) = rr; }
    cur ^= 1;
  }
  l = xsum(l);
  if (hi == 0) wsf[r32] = 1.0f / fmaxf(l, 1e-30f);
#pragma unroll
  for (int r = 0; r < 16; ++r) { const float f = wsf[crow(r, hi)]; o[0][r] *= f; o[1][r] *= f; }
  LAS3 float* finl = (LAS3 float*)(lds + L_FIN) + w * 2048;
  fin_set(finl, o, lane);
  fin_store(finl, omla, (size_t)b * SEQ + qw, 512, h * 64, lane);
}

__device__ __forceinline__ void attn_phase(const bf16_t* proj, const bf16_t* kc, const bf16_t* vc, const float* t5, bf16_t* onsa,
                                           const bf16_t* mq, const bf16_t* mkv, const bf16_t* kr, bf16_t* omla, lptr lds) {
  const int tid = threadIdx.x;
  { LAS3 float* tb = (LAS3 float*)(lds + L_TB);
    for (int i = tid; i < 8 * 128; i += NTHR) { const int hd = i >> 7, d = i & 127; tb[i] = (t5[(int)T5B[d] * 8 + hd] - t5[31 * 8 + hd]) * LOG2E; } }
  const int G = gridDim.x, bx = blockIdx.x;
  for (int v = (G % 8 == 0) ? (bx % 8) * (G / 8) + bx / 8 : bx; v < 256; v += G) {
    const int bg = v >> 4, p = v & 15, bh = v >> 2, j = v & 3;
#pragma unroll 1
    for (int u = 0; u < 2; ++u) nsa_unit(bg >> 1, bg & 1, u ? p : 31 - p, proj, kc, vc, onsa, lds);
#pragma unroll 1
    for (int u = 0; u < 2; ++u) mla_unit(bh >> 3, bh & 7, u ? j : 7 - j, mq, mkv, kr, omla, lds);
  }
}
#undef LAS3
}

struct Args { const float* in[23]; float* out; char* ws; };
constexpr int LDS_BYTES = 131072 + 4096;

typedef const __attribute__((address_space(4))) Args* kargs_t;
DEV kargs_t KA() { kargs_t k = (kargs_t)__builtin_amdgcn_kernarg_segment_ptr(); asm volatile("" : "+s"(k)); return k; }
#define WSP(type, off) ((type*)(ws + (off)))

__global__ __launch_bounds__(NTHR, 2) void mega(Args a) {
  extern __shared__ __attribute__((aligned(16))) char lds[];
  cg::grid_group grid = cg::this_grid();
  PG8_LAS unsigned char* glds = (PG8_LAS unsigned char*)lds;
  const int bid = blockIdx.x, G = gridDim.x;
  (void)a;

  { kargs_t k = KA(); char* ws = k->ws;
    ph_convT<1>(k->in[2], 1024, IN_COLS, WSP(bf16_t, WS_WIN), 3840, lds);
    ph_convT<0>(k->in[13], 512, 1024, WSP(bf16_t, WS_WBN), 1024, lds);
    ph_convT<0>(k->in[14], 512, 1024, WSP(bf16_t, WS_WBM), 1024, lds);
    ph_convT<0>(k->in[15], 1024, 1024, WSP(bf16_t, WS_WOUT), 1024, lds);
    ph_convT<0>(k->in[17], 1024, 1024, WSP(bf16_t, WS_WQ), 1024, lds);
    ph_convT<0>(k->in[5], 2048, 256, WSP(bf16_t, WS_CKW1), 256, lds);
    ph_convT<0>(k->in[7], 2048, 256, WSP(bf16_t, WS_CVW1), 256, lds);
    ph_convT<0>(k->in[6], 256, 64, WSP(bf16_t, WS_CKW2), 64, lds);
    ph_convT<0>(k->in[8], 256, 64, WSP(bf16_t, WS_CVW2), 64, lds);
    ph_convT<0>(k->in[11], 256, 768, WSP(bf16_t, WS_UQ), 768, lds);
    ph_convT<0>(k->in[12], 128, 1024, WSP(bf16_t, WS_UKV), 1024, lds);
    ph_conv_plain(k->in[18], WSP(bf16_t, WS_SUBK), 16 * 128 * 64);
    ph_rope_table(WSP(float2, WS_ROPE));
    ph_rms1024(k->in[0], k->in[1], WSP(bf16_t, WS_XN), T); }
  grid.sync();
  { kargs_t k = KA(); char* ws = k->ws;
    pg8::Gemm g{WSP(bf16_t, WS_XN), WSP(bf16_t, WS_WIN), T, 3840, 1024}; pg8::StaticOrder S; S.init(T, 3840, G, bid);
    pg8::EpiInProjF E{WSP(bf16_t, WS_PROJ), WSP(bf16_t, WS_GATES)};
    pg8::gemm_phase<pg8::EpiInProjF, pg8::StaticOrder, PG8_ALIGN, PG8_SP2>(glds, g, S, E); }
  grid.sync();
  { kargs_t k = KA(); char* ws = k->ws;
    ph_rms_cols<4>(WSP(bf16_t, WS_PROJ), PC_CQ, k->in[9], WSP(bf16_t, WS_CQN));
    ph_rms_cols<2>(WSP(bf16_t, WS_PROJ), PC_CKV, k->in[10], WSP(bf16_t, WS_CKVN));
    ph_rope_k(WSP(bf16_t, WS_PROJ), WSP(bf16_t, WS_KROPE));
    ph_cmp_gather(WSP(bf16_t, WS_PROJ), k->in[3], 0, WSP(bf16_t, WS_CA));
    ph_cmp_gather(WSP(bf16_t, WS_PROJ), k->in[4], 1, WSP(bf16_t, WS_CA2)); }
  grid.sync();
  { kargs_t k = KA(); char* ws = k->ws;
    pg8::Gemm g{WSP(bf16_t, WS_CA), WSP(bf16_t, WS_CKW1), 2048, 256, 2048}; pg8::StaticOrder S; S.init(2048, 256, G, bid);
    pg8::EpiBf16<1> E{WSP(bf16_t, WS_HID), 256, nullptr, 0, 0, 1.f};
    pg8::gemm_phase<pg8::EpiBf16<1>, pg8::StaticOrder, PG8_ALIGN, PG8_SP2>(glds, g, S, E); }
  { kargs_t k = KA(); char* ws = k->ws;
    pg8::Gemm g{WSP(bf16_t, WS_CA2), WSP(bf16_t, WS_CVW1), 2048, 256, 2048}; pg8::StaticOrder S; S.init(2048, 256, G, (bid + 128) & 255);
    pg8::EpiBf16<1> E{WSP(bf16_t, WS_HID2), 256, nullptr, 0, 0, 1.f};
    pg8::gemm_phase<pg8::EpiBf16<1>, pg8::StaticOrder, PG8_ALIGN, PG8_SP2>(glds, g, S, E); }
  { kargs_t k = KA(); char* ws = k->ws;
    pg8::Gemm g{WSP(bf16_t, WS_CQN), WSP(bf16_t, WS_UQ), T, 768, 256}; pg8::StaticOrder S; S.init(T, 768, G, (bid + 64) & 255);
    pg8::EpiMlaQF E{WSP(bf16_t, WS_MLAQ), WSP(float2, WS_ROPE)};
    pg8::gemm_phase<pg8::EpiMlaQF, pg8::StaticOrder, PG8_ALIGN, PG8_SP2>(glds, g, S, E); }
  { kargs_t k = KA(); char* ws = k->ws;
    pg8::Gemm g{WSP(bf16_t, WS_CKVN), WSP(bf16_t, WS_UKV), T, 1024, 128}; pg8::StaticOrder S; S.init(T, 1024, G, bid);
    pg8::EpiBf16<0> E{WSP(bf16_t, WS_MLAKV), 1024, nullptr, 0, 0, 1.f};
    pg8::gemm_phase<pg8::EpiBf16<0>, pg8::StaticOrder, PG8_ALIGN, PG8_SP2>(glds, g, S, E); }
  grid.sync();
  { kargs_t k = KA(); char* ws = k->ws;
    ph_gemm(WSP(bf16_t, WS_HID), 256, WSP(bf16_t, WS_CKW2), 256, 2048, 64, 256, EpiCmpOut{WSP(bf16_t, WS_KC)}, lds);
    ph_gemm(WSP(bf16_t, WS_HID2), 256, WSP(bf16_t, WS_CVW2), 256, 2048, 64, 256, EpiCmpOut{WSP(bf16_t, WS_VC)}, lds); }
  grid.sync();
  { kargs_t k = KA(); char* ws = k->ws;
    att::attn_phase(WSP(bf16_t, WS_PROJ), WSP(bf16_t, WS_KC), WSP(bf16_t, WS_VC), k->in[21], WSP(bf16_t, WS_ONSA),
                    WSP(bf16_t, WS_MLAQ), WSP(bf16_t, WS_MLAKV), WSP(bf16_t, WS_KROPE), WSP(bf16_t, WS_OMLA), (att::lptr)lds); }
  grid.sync();
  { kargs_t k = KA(); char* ws = k->ws;
    pg8::Gemm g{WSP(bf16_t, WS_ONSA), WSP(bf16_t, WS_WBN), T, 1024, 512}; pg8::StaticOrder S; S.init(T, 1024, G, bid);
    pg8::EpiMergeF<0> E{WSP(bf16_t, WS_GATES), WSP(bf16_t, WS_MERGED)};
    pg8::gemm_phase<pg8::EpiMergeF<0>, pg8::StaticOrder, PG8_ALIGN, PG8_SP2>(glds, g, S, E); }
  { kargs_t k = KA(); char* ws = k->ws;
    pg8::Gemm g{WSP(bf16_t, WS_OMLA), WSP(bf16_t, WS_WBM), T, 1024, 512}; pg8::StaticOrder S; S.init(T, 1024, G, bid);
    pg8::EpiMergeF<1> E{WSP(bf16_t, WS_GATES), WSP(bf16_t, WS_MERGED)};
    pg8::gemm_phase<pg8::EpiMergeF<1>, pg8::StaticOrder, PG8_ALIGN, PG8_SP2>(glds, g, S, E); }
  grid.sync();
  { kargs_t k = KA(); char* ws = k->ws;
    pg8::Gemm g{WSP(bf16_t, WS_MERGED), WSP(bf16_t, WS_WOUT), T, 1024, 1024}; pg8::StaticOrder S; S.init(T, 1024, G, bid);
    pg8::EpiResidF E{k->in[0], k->out};
    pg8::gemm_phase<pg8::EpiResidF, pg8::StaticOrder, PG8_ALIGN, PG8_SP2>(glds, g, S, E); }
  grid.sync();
  { kargs_t k = KA(); char* ws = k->ws; ph_rms1024(k->out, k->in[16], WSP(bf16_t, WS_HN), T); }
  grid.sync();
  { kargs_t k = KA(); char* ws = k->ws;
    pg8::Gemm g{WSP(bf16_t, WS_HN), WSP(bf16_t, WS_WQ), T, 1024, 1024}; pg8::StaticOrder S; S.init(T, 1024, G, bid);
    pg8::EpiBf16<0> E{WSP(bf16_t, WS_PQ), 1024, nullptr, 0, 0, 1.f};
    pg8::gemm_phase<pg8::EpiBf16<0>, pg8::StaticOrder, PG8_ALIGN, PG8_SP2>(glds, g, S, E); }
  grid.sync();
  { kargs_t k = KA(); char* ws = k->ws; ph_route(WSP(bf16_t, WS_PQ), WSP(bf16_t, WS_SUBK), WSP(int, WS_PIDX), WSP(float, WS_PW), lds); }
  grid.sync();
  { kargs_t k = KA(); char* ws = k->ws; ph_experts(WSP(bf16_t, WS_HN), WSP(int, WS_PIDX), WSP(float, WS_PW), k->in[19], k->in[20], k->in[22], k->out); }
}

extern "C" void kernel_launch(void* const* d_in, const int* in_sizes, int n_in, void* d_out, int out_size, void* d_ws, size_t ws_size, hipStream_t stream) {
  if (n_in != 23 || ws_size < 256 * MiB) { fprintf(stderr, "kernel_launch: unexpected n_in %d / ws_size %zu\n", n_in, ws_size); return; }
  static int grid_blocks = 0;
  if (!grid_blocks) {
    int dev = 0, cus = 0, per_cu = 0;
    (void)hipGetDevice(&dev);
    (void)hipDeviceGetAttribute(&cus, hipDeviceAttributeMultiprocessorCount, dev);
    if (hipFuncSetAttribute((const void*)mega, hipFuncAttributeMaxDynamicSharedMemorySize, LDS_BYTES) != hipSuccess) fprintf(stderr, "kernel_launch: hipFuncSetAttribute failed\n");
    (void)hipOccupancyMaxActiveBlocksPerMultiprocessor(&per_cu, (const void*)mega, NTHR, LDS_BYTES);
    if (per_cu < 1) { fprintf(stderr, "kernel_launch: occupancy query returned %d\n", per_cu); per_cu = 1; }
    if (per_cu > 2) per_cu = 2;
    grid_blocks = cus * per_cu;
    fprintf(stderr, "kernel_launch: cus %d per_cu %d grid %d ws %zu\n", cus, per_cu, grid_blocks, ws_size);
  }
  Args a{};
  for (int i = 0; i < 23; ++i) a.in[i] = (const float*)d_in[i];
  a.out = (float*)d_out; a.ws = (char*)d_ws;
  void* args[] = {&a};
  hipError_t e = hipLaunchCooperativeKernel((const void*)mega, dim3(grid_blocks), dim3(NTHR), args, LDS_BYTES, stream);
  if (e != hipSuccess) fprintf(stderr, "cooperative launch failed: %s (grid %d)\n", hipGetErrorString(e), grid_blocks);
}
```

```cpp
#include <hip/hip_runtime.h>
#include <stdint.h>
#include <cstdio>
#include <hip/hip_cooperative_groups.h>
namespace cg = cooperative_groups;

typedef unsigned short bf16_t;
#define DEV __device__ __forceinline__

constexpr int BATCH = 8, SEQ = 2048, DM = 1024, T = BATCH * SEQ;
constexpr int IN_COLS = 3768;
constexpr int PROJ_LD = 1792;
constexpr int PC_Q = 0, PC_KV = 512, PC_CQ = 1280, PC_CKV = 1536, PC_KR = 1664, PC_GATE = 1696;
constexpr int NC = 127;
constexpr size_t MiB = 1u << 20;

constexpr size_t WS_WIN = 1 * MiB;
constexpr size_t WS_WBN = 9 * MiB;
constexpr size_t WS_WBM = 10 * MiB;
constexpr size_t WS_WOUT = 11 * MiB;
constexpr size_t WS_WQ = 13 * MiB;
constexpr size_t WS_CKW1 = 15 * MiB;
constexpr size_t WS_CVW1 = 16 * MiB;
constexpr size_t WS_CKW2 = 17 * MiB;
constexpr size_t WS_CVW2 = 17 * MiB + 64 * 1024;
constexpr size_t WS_UQ = 17 * MiB + 256 * 1024;
constexpr size_t WS_UKV = 17 * MiB + 768 * 1024;
constexpr size_t WS_SUBK = 18 * MiB;
constexpr size_t WS_ROPE = 18 * MiB + 512 * 1024;
constexpr size_t WS_GATES = 20 * MiB;
constexpr size_t WS_PQ = 20 * MiB;
constexpr size_t WS_PROJ = 84 * MiB;
constexpr size_t WS_MERGED = 84 * MiB;
constexpr size_t WS_PIDX = 84 * MiB;
constexpr size_t WS_U16 = 172 * MiB;
constexpr size_t WS_V16 = 204 * MiB;
constexpr size_t WS_PW = 92 * MiB;
constexpr size_t WS_XN = 140 * MiB;
constexpr size_t WS_MLAKV = 140 * MiB;
constexpr size_t WS_HN = 140 * MiB;
constexpr size_t WS_MLAQ = 172 * MiB;
constexpr size_t WS_KROPE = 196 * MiB;
constexpr size_t WS_KC = 197 * MiB;
constexpr size_t WS_VC = 197 * MiB + 512 * 1024;
constexpr size_t WS_ONSA = 198 * MiB;
constexpr size_t WS_OMLA = 214 * MiB;
constexpr size_t WS_CA = 198 * MiB;
constexpr size_t WS_HID = 206 * MiB;
constexpr size_t WS_HID2 = 207 * MiB;
constexpr size_t WS_CA2 = 214 * MiB;
constexpr size_t WS_CQN = 230 * MiB;
constexpr size_t WS_CKVN = 238 * MiB;
constexpr size_t WS_OCMP = 230 * MiB;
constexpr size_t WS_SEL = 246 * MiB;

__device__ const unsigned char T5B[128] = {
  0, 1, 2, 3, 4, 5, 6, 7, 8, 9, 10, 11, 12, 13, 14, 15, 16, 16, 16, 17, 17, 18, 18, 18, 19, 19, 19, 20, 20, 20, 20, 21,
  21, 21, 21, 22, 22, 22, 22, 22, 23, 23, 23, 23, 23, 23, 24, 24, 24, 24, 24, 24, 25, 25, 25, 25, 25, 25, 25, 26, 26, 26, 26, 26,
  26, 26, 26, 27, 27, 27, 27, 27, 27, 27, 27, 27, 27, 28, 28, 28, 28, 28, 28, 28, 28, 28, 28, 29, 29, 29, 29, 29, 29, 29, 29, 29,
  29, 29, 29, 30, 30, 30, 30, 30, 30, 30, 30, 30, 30, 30, 30, 30, 30, 31, 31, 31, 31, 31, 31, 31, 31, 31, 31, 31, 31, 31, 31, 31};

DEV float bf2f(bf16_t v) { return __uint_as_float(((unsigned)v) << 16); }
DEV bf16_t f2bf(float f) { unsigned u = __float_as_uint(f); u += 0x7fffu + ((u >> 16) & 1u); return (bf16_t)(u >> 16); }
DEV float wsum(float v) {
#pragma unroll
  for (int o = 32; o > 0; o >>= 1) v += __shfl_xor(v, o);
  return v;
}
DEV float wmaxf(float v) {
#pragma unroll
  for (int o = 32; o > 0; o >>= 1) v = fmaxf(v, __shfl_xor(v, o));
  return v;
}
DEV float sigmoidf_(float x) { return 1.0f / (1.0f + expf(-x)); }
DEV float gelu_exact(float x) { return 0.5f * x * (1.0f + erff(x * 0.70710678118654752f)); }
DEV void wave_lds_sync() { asm volatile("s_waitcnt lgkmcnt(0)" ::: "memory"); __builtin_amdgcn_wave_barrier(); asm volatile("" ::: "memory"); }
DEV float t5bias(const float* t5, int head, int dist) { int d = dist < 127 ? dist : 127; d = d < 0 ? 0 : d; return t5[(int)T5B[d] * 8 + head]; }


namespace pg8 {
#define PG8_LAS __attribute__((address_space(3)))
typedef unsigned short bf16_t;
typedef short bf16x8 __attribute__((ext_vector_type(8)));
typedef float f32x4 __attribute__((ext_vector_type(4)));
typedef unsigned u32x4 __attribute__((ext_vector_type(4)));
constexpr int BM = 256, BK = 64, HALF = 128, HTB = HALF * BK * 2  , STAGE_BYTES = 8 * HTB, NXCD = 8, WGM = 8;

__host__ __device__ __forceinline__ int lds_byte(int r, int c) { const int st = (r >> 4) * 2 + (c >> 5), rr = r & 15, cc = c & 31, ob = rr * 64 + cc * 2; return st * 1024 + (ob ^ (((ob >> 9) & 1) << 5)); }
__host__ __device__ __forceinline__ void stage_rc(int b, int& R, int& C) { const int st = b / 1024, sb = b % 1024, swz = sb ^ (((sb >> 9) & 1) << 5); R = (st >> 1) * 16 + swz / 64; C = (st & 1) * 32 + (swz % 64) / 2; }
__host__ __device__ __forceinline__ int perm32(int rho) { const int n = rho >> 4, i = rho & 15; return 8 * (i >> 2) + 4 * n + (i & 3); }

struct Unit { int pm, pn; };
struct Gemm { const bf16_t* A; const bf16_t* Bt; int M, N, K; };

struct StaticOrder {
    int nM, nN, nwg, G, c;
    __host__ __device__ void init(int M, int N, int G_, int c_) { nM = M / BM; nN = N / BM; nwg = nM * nN; G = G_; c = c_; }
    __host__ __device__ bool next(int i, Unit& u) const {
        const long L = (long)i * G + c; if (L >= nwg) return false;
        int wgid = (int)L; { const int q = nwg / NXCD, r = nwg % NXCD, xcd = wgid % NXCD, off = wgid / NXCD; wgid = (xcd < r ? xcd * (q + 1) : r * (q + 1) + (xcd - r) * q) + off; }
        const int nig = WGM * nN, gid = wgid / nig, fm = gid * WGM, gsz = (nM - fm) < WGM ? (nM - fm) : WGM;
        u.pm = fm + ((wgid % nig) % gsz); u.pn = (wgid % nig) / gsz; return true;
    }
    __device__ __forceinline__ void a_ready(const Unit&) const {}
    __device__ __forceinline__ void done(const Unit&) const {}
};

__device__ __forceinline__ unsigned cvt_pk_bf16(float lo, float hi) { unsigned r; asm volatile("v_cvt_pk_bf16_f32 %0, %1, %2" : "=v"(r) : "v"(lo), "v"(hi)); return r; }
typedef float f32x2 __attribute__((ext_vector_type(2)));
__device__ __forceinline__ f32x2 gelu_pk(f32x2 v) {
    const f32x2 av = __builtin_elementwise_abs(v), d = av * 0.2316418882f + 1.0f;
    f32x2 t; t.x = __builtin_amdgcn_rcpf(d.x); t.y = __builtin_amdgcn_rcpf(d.y);
    f32x2 q = t * 0.5307027145f + (-0.7265760135f); q = q * t + 0.7107068705f; q = q * t + (-0.142248368f); q = q * t + 0.127414796f; q = q * t;
    const f32x2 s = (v * v) * (-0.72134752044f);
    f32x2 e; e.x = __builtin_amdgcn_exp2f(s.x); e.y = __builtin_amdgcn_exp2f(s.y);
    const f32x2 m = v * (q * e), r = v - m;
    f32x2 o; o.x = v.x < 0.f ? m.x : r.x; o.y = v.y < 0.f ? m.y : r.y; return o;
}

template <int ACT  > struct EpiBf16 {
    static constexpr bool PERM = true, AFTER_DRAIN = false; static_assert(ACT == 0 || ACT == 1, "EpiBf16: ACT is 0 (none) or 1 (gelu_pk)");
    bf16_t* O; int ldc; const float* bias; int split_cols; size_t split_stride; float scale0;
    __device__ __forceinline__ void operator()(const f32x4 (&acc)[2][2][4][2], const Unit& u, int wr, int wc, int fr, int fq) const {
        const int row0 = u.pm * BM + wr * 64 + fr; int colt = u.pn * BM; bf16_t* base = O;
        float sc = 1.f; if (split_cols) { const int t = colt / split_cols; base += (size_t)t * split_stride; colt -= t * split_cols; if (t == 0) sc = scale0; }
        const int col0 = colt + wc * 32 + 8 * fq, bcol0 = u.pn * BM + wc * 32 + 8 * fq;
        f32x4 bv[2][2];
#pragma unroll
        for (int bj = 0; bj < 2; ++bj)
#pragma unroll
            for (int n = 0; n < 2; ++n) bv[bj][n] = bias ? *(const f32x4*)(bias + bcol0 + bj * HALF + 4 * n) : (f32x4){0.f, 0.f, 0.f, 0.f};
#pragma unroll
        for (int ai = 0; ai < 2; ++ai)
#pragma unroll
            for (int m = 0; m < 4; ++m) { bf16_t* rowp = base + (size_t)(row0 + ai * HALF + m * 16) * ldc + col0;
#pragma unroll
                for (int bj = 0; bj < 2; ++bj) { f32x4 v0 = acc[ai][bj][m][0] + bv[bj][0], v1 = acc[ai][bj][m][1] + bv[bj][1];
                    if (ACT == 1) { f32x2 a = gelu_pk((f32x2){v0[0], v0[1]}), b = gelu_pk((f32x2){v0[2], v0[3]}), c = gelu_pk((f32x2){v1[0], v1[1]}), d = gelu_pk((f32x2){v1[2], v1[3]});
                        v0 = (f32x4){a.x, a.y, b.x, b.y}; v1 = (f32x4){c.x, c.y, d.x, d.y}; }
                    v0 = v0 * sc; v1 = v1 * sc; u32x4 w; w.x = cvt_pk_bf16(v0[0], v0[1]); w.y = cvt_pk_bf16(v0[2], v0[3]); w.z = cvt_pk_bf16(v1[0], v1[1]); w.w = cvt_pk_bf16(v1[2], v1[3]);
                    *(u32x4*)(rowp + bj * HALF) = w; } }
    }
};

struct PanelStats {
    unsigned* xbuf;
    unsigned* cnt;
    unsigned* tmo;
    int ntn; float eps;
    unsigned code;
    __device__ __forceinline__ bool run(const f32x4 (&v)[2][2][4][2], const Unit& u, int wr, int wc, int fr, int fq, PG8_LAS unsigned char* lds, int wid, int lane) const {
        typedef float f32x2v __attribute__((ext_vector_type(2)));
        PG8_LAS f32x2v* P = (PG8_LAS f32x2v*)lds;
        PG8_LAS f32x2v* S = (PG8_LAS f32x2v*)(lds + 8192);
        PG8_LAS unsigned* flag = (PG8_LAS unsigned*)(lds + 8192 + 2048);
#pragma unroll
        for (int ai = 0; ai < 2; ++ai)
#pragma unroll
            for (int m = 0; m < 4; ++m) {
                float s = 0.f;
#pragma unroll
                for (int bj = 0; bj < 2; ++bj)
#pragma unroll
                    for (int n = 0; n < 2; ++n) { const f32x4 x = v[ai][bj][m][n]; s += (x[0] + x[1]) + (x[2] + x[3]); }
                s += __shfl_xor(s, 16); s += __shfl_xor(s, 32);
                const float mw = s * (1.0f / 64.0f); float q = 0.f;
#pragma unroll
                for (int bj = 0; bj < 2; ++bj)
#pragma unroll
                    for (int n = 0; n < 2; ++n) { const f32x4 d = v[ai][bj][m][n] - mw; q += (d[0] * d[0] + d[1] * d[1]) + (d[2] * d[2] + d[3] * d[3]); }
                q += __shfl_xor(q, 16); q += __shfl_xor(q, 32);
                if (fq == 0) P[(ai * HALF + wr * 64 + m * 16 + fr) * 4 + wc] = (f32x2v){mw, q};
            }
        asm volatile("s_waitcnt lgkmcnt(0)" ::: "memory"); __builtin_amdgcn_s_barrier(); asm volatile("" ::: "memory");
#if defined(BROKEN_EXCHANGE_NO_WAIT)
#warning BROKEN CONTROL BUILD: the row-statistics exchange does not wait; results are wrong by design
        if (blockIdx.x >= 64) { const long long t0_ = clock64(); while (clock64() - t0_ < 60000) __builtin_amdgcn_s_sleep(8); }
#endif
        const int row = wid * 32 + (lane & 31);
        if (lane < 32) {
            const f32x2v a = P[row * 4 + 0], b = P[row * 4 + 1], c = P[row * 4 + 2], d = P[row * 4 + 3];
            const float mt = (a.x + b.x + c.x + d.x) * 0.25f;
            const float da = a.x - mt, db = b.x - mt, dc = c.x - mt, dd = d.x - mt;
            const float m2 = (a.y + b.y) + (c.y + d.y) + 64.0f * ((da * da + db * db) + (dc * dc + dd * dd));
            unsigned long long* slot = (unsigned long long*)xbuf + ((size_t)(u.pm * BM + row) * 4 + u.pn);
            __hip_atomic_store(slot, ((unsigned long long)__float_as_uint(m2) << 32) | __float_as_uint(mt), __ATOMIC_RELAXED, __HIP_MEMORY_SCOPE_AGENT);
        }
        asm volatile("s_waitcnt vmcnt(0)" ::: "memory");
        if (lane == 0) __hip_atomic_fetch_add(cnt + 64 * u.pm, 1u, __ATOMIC_RELAXED, __HIP_MEMORY_SCOPE_AGENT);
        if (wid == 0) {
            bool dead = false; const unsigned long long t0 = __builtin_amdgcn_s_memrealtime(); const unsigned want = 8u * (unsigned)ntn;
            for (;;) {
#if defined(BROKEN_EXCHANGE_NO_WAIT)
                break;
#endif
                if ((unsigned)__builtin_amdgcn_readfirstlane(__hip_atomic_load(cnt + 64 * u.pm, __ATOMIC_RELAXED, __HIP_MEMORY_SCOPE_AGENT)) >= want) break;
                if (__builtin_amdgcn_s_memrealtime() - t0 > 2000000ull) {
                    if (lane == 0) { unsigned expect = 0u; __hip_atomic_compare_exchange_strong(tmo + 1, &expect, code | (unsigned)(u.pm & 0xff), __ATOMIC_RELAXED, __ATOMIC_RELAXED, __HIP_MEMORY_SCOPE_AGENT);
                                     __hip_atomic_store(tmo, 1u, __ATOMIC_RELAXED, __HIP_MEMORY_SCOPE_AGENT); }
                    dead = true; break; }
                __builtin_amdgcn_s_sleep(2);
            }
            __builtin_amdgcn_fence(__ATOMIC_ACQUIRE, "agent");
            if (lane == 0) flag[0] = dead ? 1u : 0u;
        }
        asm volatile("s_waitcnt vmcnt(0) lgkmcnt(0)" ::: "memory"); __builtin_amdgcn_s_barrier(); asm volatile("" ::: "memory");
        const bool bad = flag[0] != 0u;
        if (lane < 32) {
            const unsigned long long* slot = (const unsigned long long*)xbuf + (size_t)(u.pm * BM + row) * 4; float mt[4], m2[4]; float ms = 0.f;
#pragma unroll
            for (int t = 0; t < 4; ++t) { if (t < ntn) { const unsigned long long w = __hip_atomic_load(slot + t, __ATOMIC_RELAXED, __HIP_MEMORY_SCOPE_AGENT); mt[t] = __uint_as_float((unsigned)w); m2[t] = __uint_as_float((unsigned)(w >> 32)); } else { mt[t] = 0.f; m2[t] = 0.f; } ms += mt[t]; }
            const float mean = ms / (float)ntn; float q = 0.f;
#pragma unroll
            for (int t = 0; t < 4; ++t) if (t < ntn) { const float dm = mt[t] - mean; q += m2[t] + 256.0f * dm * dm; }
            S[row] = (f32x2v){mean, 1.0f / sqrtf(q / (256.0f * (float)ntn) + eps)};
        }
        asm volatile("s_waitcnt lgkmcnt(0)" ::: "memory"); __builtin_amdgcn_s_barrier(); asm volatile("" ::: "memory");
        return bad;
    }
};
struct EpiLnRes {
    static constexpr bool PERM = false, AFTER_DRAIN = true;
    const float* base; float* out; int ldc; const float* bias; PanelStats st; unsigned poison;
    __device__ __forceinline__ void fused(f32x4 (&acc)[2][2][4][2], const Unit& u, int wr, int wc, int fr, int fq, PG8_LAS unsigned char* lds, int wid, int lane) const {
        typedef float f32x2v __attribute__((ext_vector_type(2)));
        const PG8_LAS f32x2v* S = (const PG8_LAS f32x2v*)(lds + 8192);
        const int col0 = u.pn * BM + wc * 32 + 4 * fq;
#pragma unroll
        for (int bj = 0; bj < 2; ++bj)
#pragma unroll
            for (int n = 0; n < 2; ++n) { const f32x4 bv = bias ? *(const f32x4*)(bias + col0 + bj * HALF + n * 16) : (f32x4){0.f, 0.f, 0.f, 0.f};
#pragma unroll
                for (int ai = 0; ai < 2; ++ai)
#pragma unroll
                    for (int m = 0; m < 4; ++m) acc[ai][bj][m][n] += bv; }
        f32x4 pre[4][2][2];
#pragma unroll
        for (int m = 0; m < 4; ++m) { const size_t off = (size_t)(u.pm * BM + wr * 64 + m * 16 + fr) * ldc + col0;
#pragma unroll
            for (int bj = 0; bj < 2; ++bj)
#pragma unroll
                for (int n = 0; n < 2; ++n) pre[m][bj][n] = *(const f32x4*)(base + off + bj * HALF + n * 16); }
        const bool bad = st.run(acc, u, wr, wc, fr, fq, lds, wid, lane) || poison != 0u;
        const float qnan = __builtin_nanf("");
#pragma unroll
        for (int ai = 0; ai < 2; ++ai)
#pragma unroll
            for (int m = 0; m < 4; ++m) { const int r = ai * HALF + wr * 64 + m * 16 + fr; const f32x2v sr = S[r]; const size_t off = (size_t)(u.pm * BM + r) * ldc + col0;
#pragma unroll
                for (int bj = 0; bj < 2; ++bj)
#pragma unroll
                    for (int n = 0; n < 2; ++n) { const f32x4 bs = ai == 0 ? pre[m][bj][n] : *(const f32x4*)(base + off + bj * HALF + n * 16); f32x4 o = bs + (acc[ai][bj][m][n] - sr.x) * sr.y;
                        if (bad) o = (f32x4){qnan, qnan, qnan, qnan}; *(f32x4*)(out + off + bj * HALF + n * 16) = o; }
                if (m & 1) asm volatile("" ::: "memory"); }
    }
};
struct EpiLnResLn {
    static constexpr bool PERM = false, AFTER_DRAIN = true;
    const float* base; float* out; bf16_t* xn; int ldc; const float* bias; PanelStats st1, st2; unsigned poison;
    __device__ __forceinline__ void fused(f32x4 (&acc)[2][2][4][2], const Unit& u, int wr, int wc, int fr, int fq, PG8_LAS unsigned char* lds, int wid, int lane) const {
        typedef float f32x2v __attribute__((ext_vector_type(2))); typedef unsigned u32x2v __attribute__((ext_vector_type(2)));
        const PG8_LAS f32x2v* S = (const PG8_LAS f32x2v*)(lds + 8192);
        const int col0 = u.pn * BM + wc * 32 + 4 * fq;
#pragma unroll
        for (int bj = 0; bj < 2; ++bj)
#pragma unroll
            for (int n = 0; n < 2; ++n) { const f32x4 bv = bias ? *(const f32x4*)(bias + col0 + bj * HALF + n * 16) : (f32x4){0.f, 0.f, 0.f, 0.f};
#pragma unroll
                for (int ai = 0; ai < 2; ++ai)
#pragma unroll
                    for (int m = 0; m < 4; ++m) acc[ai][bj][m][n] += bv; }
        bool bad = st1.run(acc, u, wr, wc, fr, fq, lds, wid, lane) || poison != 0u;
        const float qnan = __builtin_nanf("");
#pragma unroll
        for (int ai = 0; ai < 2; ++ai)
#pragma unroll
            for (int m = 0; m < 4; ++m) { const int r = ai * HALF + wr * 64 + m * 16 + fr; const f32x2v sr = S[r]; const size_t off = (size_t)(u.pm * BM + r) * ldc + col0;
#pragma unroll
                for (int bj = 0; bj < 2; ++bj)
#pragma unroll
                    for (int n = 0; n < 2; ++n) { const f32x4 bs = *(const f32x4*)(base + off + bj * HALF + n * 16); acc[ai][bj][m][n] = bs + (acc[ai][bj][m][n] - sr.x) * sr.y; }
                asm volatile("" : "+v"(acc[ai][0][m][0]), "+v"(acc[ai][0][m][1]), "+v"(acc[ai][1][m][0]), "+v"(acc[ai][1][m][1]));
                if (m & 1) asm volatile("" ::: "memory"); }
        const bool bad1 = bad;
        bad = st2.run(acc, u, wr, wc, fr, fq, lds, wid, lane) || bad;
#pragma unroll
        for (int ai = 0; ai < 2; ++ai)
#pragma unroll
            for (int m = 0; m < 4; ++m) { const int r = ai * HALF + wr * 64 + m * 16 + fr; const f32x2v sr = S[r]; const size_t off = (size_t)(u.pm * BM + r) * ldc + col0;
#pragma unroll
                for (int bj = 0; bj < 2; ++bj)
#pragma unroll
                    for (int n = 0; n < 2; ++n) { const f32x4 x1 = acc[ai][bj][m][n]; *(f32x4*)(out + off + bj * HALF + n * 16) = bad1 ? (f32x4){qnan, qnan, qnan, qnan} : x1;
                        const f32x4 o = (x1 - sr.x) * sr.y; u32x2v w; w.x = cvt_pk_bf16(o[0], o[1]); w.y = cvt_pk_bf16(o[2], o[3]);
                        if (bad) { w.x = 0x7fc07fc0u; w.y = 0x7fc07fc0u; } *(u32x2v*)(xn + off + bj * HALF + n * 16) = w; }
                asm volatile("" ::: "memory"); }
    }
};

template <class Epi, class Sched, bool ALIGN_EPI = false, bool SP2 = false>
__device__ __forceinline__ void gemm_phase(PG8_LAS unsigned char* lds, const Gemm g, const Sched& S, const Epi& E) {
    int tid = threadIdx.x; asm volatile("" : "+v"(tid));
    const int wid = __builtin_amdgcn_readfirstlane(tid >> 6), lane = tid & 63, wr = wid >> 2, wc = wid & 3, fr = lane & 15, fq = lane >> 4;
    int K = g.K; asm volatile("" : "+s"(K)); const int nt = K / BK;
    unsigned voffA[2], voffB[2];
#pragma unroll
    for (int i = 0; i < 2; ++i) { int R, C; stage_rc(tid * 16 + i * 8192, R, C); const int Rb = Epi::PERM ? ((R & ~31) + perm32(R & 31)) : R;
        voffA[i] = (unsigned)(R * K + C) * 2u; voffB[i] = (unsigned)(Rb * K + C) * 2u; }
    const size_t kstep = (size_t)(BK * 2);
    const size_t hstep = (size_t)HALF * K * 2;
    const size_t tstep = 2 * hstep;
    const unsigned ldsw = (unsigned)wid * 1024u;
    const int aoff = lds_byte(wr * 64 + fr, fq * 8), boff = lds_byte(wc * 32 + fr, fq * 8);
#define PG8_SA(b, h) (((b) * 2 + (h)) * HTB)
#define PG8_SB(b, h) ((4 + (b) * 2 + (h)) * HTB)
#define PG8_STAGE(bufoff, gbase, voff) do { _Pragma("unroll") for (int _i = 0; _i < 2; ++_i) \
        __builtin_amdgcn_global_load_lds((const unsigned*)((const char*)(gbase) + (voff)[_i]), (PG8_LAS unsigned*)(lds + (bufoff) + ldsw + _i * 8192), 16, 0, 0); } while (0)
#define PG8_LDA(dst, b, h) do { _Pragma("unroll") for (int m = 0; m < 4; ++m) _Pragma("unroll") for (int k = 0; k < 2; ++k) dst[m][k] = *(const PG8_LAS bf16x8*)(lds + PG8_SA(b, h) + aoff + m * 2048 + k * 1024); } while (0)
#define PG8_LDB(dst, b, h) do { _Pragma("unroll") for (int n = 0; n < 2; ++n) _Pragma("unroll") for (int k = 0; k < 2; ++k) dst[n][k] = *(const PG8_LAS bf16x8*)(lds + PG8_SB(b, h) + boff + n * 2048 + k * 1024); } while (0)
#define PG8_MMA(ai, bj, At, Bt) do { __builtin_amdgcn_s_setprio(1); _Pragma("unroll") for (int m = 0; m < 4; ++m) _Pragma("unroll") for (int n = 0; n < 2; ++n) _Pragma("unroll") for (int k = 0; k < 2; ++k) \
        acc[ai][bj][m][n] = __builtin_amdgcn_mfma_f32_16x16x32_bf16(Bt[n][k], At[m][k], acc[ai][bj][m][n], 0, 0, 0); __builtin_amdgcn_s_setprio(0); } while (0)
#define PG8_WAIT_V(n) asm volatile("s_waitcnt vmcnt(" #n ")" ::: "memory")
#define PG8_WAIT_L(n) asm volatile("s_waitcnt lgkmcnt(" #n ")" ::: "memory")
#define PG8_BAR __builtin_amdgcn_s_barrier()
#define PG8_SCHED __builtin_amdgcn_sched_barrier(0)
    Unit cur, nxt; int ui = 0;
    if (!S.next(0, cur)) return;
    f32x4 acc[2][2][4][2];
#pragma unroll
    for (int a = 0; a < 2; ++a)
#pragma unroll
        for (int b = 0; b < 2; ++b)
#pragma unroll
            for (int m = 0; m < 4; ++m)
#pragma unroll
                for (int n = 0; n < 2; ++n) acc[a][b][m][n] = (f32x4){0.f, 0.f, 0.f, 0.f};
    bf16x8 At[4][2], B0[2][2], B1[2][2];
    const char* cA = (const char*)g.A + (size_t)cur.pm * tstep; const char* cB = (const char*)g.Bt + (size_t)cur.pn * tstep;
    S.a_ready(cur);
    if constexpr (SP2) {
        PG8_STAGE(PG8_SB(0, 0), cB, voffB); PG8_STAGE(PG8_SB(0, 1), cB + hstep, voffB); PG8_STAGE(PG8_SA(0, 0), cA, voffA); PG8_STAGE(PG8_SA(0, 1), cA + hstep, voffA);
        if (wr == 1) PG8_BAR;
        PG8_WAIT_V(2); PG8_BAR;
        PG8_STAGE(PG8_SB(1, 0), cB + kstep, voffB); PG8_STAGE(PG8_SA(1, 0), cA + kstep, voffA); PG8_STAGE(PG8_SB(1, 1), cB + hstep + kstep, voffB);
        PG8_WAIT_V(6); PG8_BAR;
    } else {
        PG8_STAGE(PG8_SB(0, 0), cB, voffB); PG8_STAGE(PG8_SA(0, 0), cA, voffA); PG8_STAGE(PG8_SB(0, 1), cB + hstep, voffB); PG8_STAGE(PG8_SA(0, 1), cA + hstep, voffA);
        if (wr == 1) PG8_BAR;
        PG8_WAIT_V(4); PG8_BAR;
        PG8_STAGE(PG8_SB(1, 0), cB + kstep, voffB); PG8_STAGE(PG8_SA(1, 0), cA + kstep, voffA); PG8_STAGE(PG8_SB(1, 1), cB + hstep + kstep, voffB);
        PG8_WAIT_V(6); PG8_BAR;
    }
    for (;;) {
        const bool has_next = S.next(ui + 1, nxt);
        const char* nA = has_next ? (const char*)g.A + (size_t)nxt.pm * tstep : cA; const char* nB = has_next ? (const char*)g.Bt + (size_t)nxt.pn * tstep : cB;
        for (int t = 0; t < nt; t += 2) {
            const bool last = (t == nt - 2);
            const char* a1 = cA + (size_t)(t + 1) * kstep;
            const char* a2 = last ? nA : cA + (size_t)(t + 2) * kstep; const char* b2 = last ? nB : cB + (size_t)(t + 2) * kstep;
            const char* a3 = a2 + kstep; const char* b3 = b2 + kstep;
            if (last && has_next) S.a_ready(nxt);
            if constexpr (SP2) {
            PG8_LDB(B0, 0, 0); PG8_LDB(B1, 0, 1); PG8_SCHED; PG8_LDA(At, 0, 0); PG8_STAGE(PG8_SA(1, 1), a1 + hstep, voffA);
            PG8_WAIT_V(8); PG8_WAIT_L(0); PG8_BAR; PG8_MMA(0, 0, At, B0); PG8_MMA(0, 1, At, B1); PG8_BAR; PG8_SCHED;
            PG8_LDA(At, 0, 1); PG8_STAGE(PG8_SB(0, 0), b2, voffB); PG8_STAGE(PG8_SB(0, 1), b2 + hstep, voffB); PG8_STAGE(PG8_SA(0, 0), a2, voffA);
            PG8_WAIT_V(8); PG8_WAIT_L(0); PG8_BAR; PG8_MMA(1, 0, At, B0); PG8_MMA(1, 1, At, B1); PG8_BAR; PG8_SCHED;
            PG8_LDB(B0, 1, 0); PG8_LDB(B1, 1, 1); PG8_SCHED; PG8_LDA(At, 1, 0); PG8_STAGE(PG8_SA(0, 1), a2 + hstep, voffA);
            PG8_WAIT_V(8); PG8_WAIT_L(0); PG8_BAR; PG8_MMA(0, 0, At, B0); PG8_MMA(0, 1, At, B1); PG8_BAR; PG8_SCHED;
            PG8_LDA(At, 1, 1); PG8_STAGE(PG8_SB(1, 0), b3, voffB); PG8_STAGE(PG8_SB(1, 1), b3 + hstep, voffB); PG8_STAGE(PG8_SA(1, 0), a3, voffA);
            PG8_WAIT_V(8); PG8_WAIT_L(0); PG8_BAR; PG8_MMA(1, 0, At, B0); PG8_MMA(1, 1, At, B1); PG8_BAR; PG8_SCHED;
            } else {
            PG8_LDB(B0, 0, 0); PG8_SCHED; PG8_LDA(At, 0, 0); PG8_STAGE(PG8_SA(1, 1), a1 + hstep, voffA);
            PG8_WAIT_L(8); PG8_BAR; PG8_WAIT_L(0); PG8_MMA(0, 0, At, B0); PG8_BAR; PG8_SCHED;
            PG8_LDB(B1, 0, 1); PG8_STAGE(PG8_SB(0, 0), b2, voffB);
            PG8_BAR; PG8_WAIT_L(0); PG8_MMA(0, 1, At, B1); PG8_BAR;
            PG8_LDA(At, 0, 1); PG8_STAGE(PG8_SA(0, 0), a2, voffA);
            PG8_BAR; PG8_WAIT_L(0); PG8_MMA(1, 0, At, B0); PG8_BAR; PG8_SCHED;
            PG8_STAGE(PG8_SB(0, 1), b2 + hstep, voffB);
            PG8_WAIT_V(6); PG8_BAR; PG8_MMA(1, 1, At, B1); PG8_BAR;
            PG8_LDB(B0, 1, 0); PG8_SCHED; PG8_LDA(At, 1, 0); PG8_STAGE(PG8_SA(0, 1), a2 + hstep, voffA);
            PG8_WAIT_L(8); PG8_BAR; PG8_WAIT_L(0); PG8_MMA(0, 0, At, B0); PG8_BAR; PG8_SCHED;
            PG8_LDB(B1, 1, 1); PG8_STAGE(PG8_SB(1, 0), b3, voffB);
            PG8_BAR; PG8_WAIT_L(0); PG8_MMA(0, 1, At, B1); PG8_BAR;
            PG8_LDA(At, 1, 1); PG8_STAGE(PG8_SA(1, 0), a3, voffA);
            PG8_BAR; PG8_WAIT_L(0); PG8_MMA(1, 0, At, B0); PG8_BAR; PG8_SCHED;
            PG8_STAGE(PG8_SB(1, 1), b3 + hstep, voffB);
            PG8_WAIT_V(6); PG8_BAR; PG8_MMA(1, 1, At, B1); PG8_BAR;
            }
        }
        if constexpr (ALIGN_EPI) { if (wr == 0) PG8_BAR; }
        if constexpr (!Epi::AFTER_DRAIN) { E(acc, cur, wr, wc, fr, fq); S.done(cur); }
        if (!has_next) break;
#pragma unroll
        for (int a = 0; a < 2; ++a)
#pragma unroll
            for (int b = 0; b < 2; ++b)
#pragma unroll
                for (int m = 0; m < 4; ++m)
#pragma unroll
                    for (int n = 0; n < 2; ++n) acc[a][b][m][n] = (f32x4){0.f, 0.f, 0.f, 0.f};
        cur = nxt; cA = nA; cB = nB; ++ui;
        if constexpr (ALIGN_EPI) { if (wr == 1) PG8_BAR; }
    }
    PG8_WAIT_V(0);
    if constexpr (!ALIGN_EPI) { if (wr == 0) PG8_BAR; }
    PG8_BAR;
    if constexpr (Epi::AFTER_DRAIN) { E.fused(acc, cur, wr, wc, fr, fq, lds, wid, lane); S.done(cur); }
#undef PG8_SA
#undef PG8_SB
#undef PG8_STAGE
#undef PG8_LDA
#undef PG8_LDB
#undef PG8_MMA
#undef PG8_WAIT_V
#undef PG8_WAIT_L
#undef PG8_BAR
#undef PG8_SCHED
}
}

namespace pg8 {
constexpr float LOG2E = 1.4426950408889634f;
constexpr float QS_NSA = 0.125f * LOG2E;
constexpr float QS_MLA = 0.10206207261596575f * LOG2E;
__device__ __forceinline__ float fast_sigmoid(float x) { return __builtin_amdgcn_rcpf(1.0f + __builtin_amdgcn_exp2f(-LOG2E * x)); }
__device__ __forceinline__ float lo_bf(unsigned u) { return __uint_as_float(u << 16); }
__device__ __forceinline__ float hi_bf(unsigned u) { return __uint_as_float(u & 0xffff0000u); }
struct EpiInProjF {
    static constexpr bool PERM = true, AFTER_DRAIN = false;
    bf16_t* proj; bf16_t* gates;
    __device__ __forceinline__ void operator()(const f32x4 (&acc)[2][2][4][2], const Unit& u, int wr, int wc, int fr, int fq) const {
        const bool isg = u.pn >= 7;
        bf16_t* base = isg ? gates : proj; const int ld = isg ? 2048 : 1792; const int colt = isg ? (u.pn - 7) * BM : u.pn * BM;
        const float sc = (u.pn < 2) ? QS_NSA : 1.0f;
        const int row0 = u.pm * BM + wr * 64 + fr, col0 = colt + wc * 32 + 8 * fq;
#pragma unroll
        for (int ai = 0; ai < 2; ++ai)
#pragma unroll
            for (int m = 0; m < 4; ++m) { bf16_t* rowp = base + (size_t)(row0 + ai * HALF + m * 16) * ld + col0;
#pragma unroll
                for (int bj = 0; bj < 2; ++bj) { f32x4 v0 = acc[ai][bj][m][0], v1 = acc[ai][bj][m][1];
                    if (isg) {
#pragma unroll
                        for (int e = 0; e < 4; ++e) { v0[e] = fast_sigmoid(v0[e]); v1[e] = fast_sigmoid(v1[e]); } }
                    else { v0 = v0 * sc; v1 = v1 * sc; }
                    u32x4 w; w.x = cvt_pk_bf16(v0[0], v0[1]); w.y = cvt_pk_bf16(v0[2], v0[3]); w.z = cvt_pk_bf16(v1[0], v1[1]); w.w = cvt_pk_bf16(v1[2], v1[3]);
                    *(u32x4*)(rowp + bj * HALF) = w; } }
    }
};
template <int PASS> struct EpiMergeF {
    static constexpr bool PERM = true, AFTER_DRAIN = false;
    const bf16_t* gates; bf16_t* merged;
    __device__ __forceinline__ void operator()(const f32x4 (&acc)[2][2][4][2], const Unit& u, int wr, int wc, int fr, int fq) const {
        const int row0 = u.pm * BM + wr * 64 + fr, col0 = u.pn * BM + wc * 32 + 8 * fq;
#pragma unroll
        for (int ai = 0; ai < 2; ++ai)
#pragma unroll
            for (int m = 0; m < 4; ++m) { const size_t r = (size_t)(row0 + ai * HALF + m * 16);
#pragma unroll
                for (int bj = 0; bj < 2; ++bj) { const int c = col0 + bj * HALF;
                    const u32x4 g = *(const u32x4*)(gates + r * 2048 + PASS * 1024 + c);
                    f32x4 v0 = acc[ai][bj][m][0], v1 = acc[ai][bj][m][1];
                    v0[0] *= lo_bf(g.x); v0[1] *= hi_bf(g.x); v0[2] *= lo_bf(g.y); v0[3] *= hi_bf(g.y);
                    v1[0] *= lo_bf(g.z); v1[1] *= hi_bf(g.z); v1[2] *= lo_bf(g.w); v1[3] *= hi_bf(g.w);
                    if (PASS == 1) { const u32x4 o = *(const u32x4*)(merged + r * 1024 + c);
                        v0[0] += lo_bf(o.x); v0[1] += hi_bf(o.x); v0[2] += lo_bf(o.y); v0[3] += hi_bf(o.y);
                        v1[0] += lo_bf(o.z); v1[1] += hi_bf(o.z); v1[2] += lo_bf(o.w); v1[3] += hi_bf(o.w); }
                    u32x4 w; w.x = cvt_pk_bf16(v0[0], v0[1]); w.y = cvt_pk_bf16(v0[2], v0[3]); w.z = cvt_pk_bf16(v1[0], v1[1]); w.w = cvt_pk_bf16(v1[2], v1[3]);
                    *(u32x4*)(merged + r * 1024 + c) = w; } }
    }
};
struct EpiResidF {
    static constexpr bool PERM = false, AFTER_DRAIN = false;
    const float* x; float* h;
    __device__ __forceinline__ void operator()(const f32x4 (&acc)[2][2][4][2], const Unit& u, int wr, int wc, int fr, int fq) const {
        const int row0 = u.pm * BM + wr * 64 + fr, col0 = u.pn * BM + wc * 32 + 4 * fq;
#pragma unroll
        for (int ai = 0; ai < 2; ++ai)
#pragma unroll
            for (int m = 0; m < 4; ++m) { const size_t off = (size_t)(row0 + ai * HALF + m * 16) * 1024 + col0;
#pragma unroll
                for (int bj = 0; bj < 2; ++bj)
#pragma unroll
                    for (int n = 0; n < 2; ++n) { const f32x4 xv = *(const f32x4*)(x + off + bj * HALF + n * 16); *(f32x4*)(h + off + bj * HALF + n * 16) = xv + acc[ai][bj][m][n]; } }
    }
};
struct EpiMlaQF {
    static constexpr bool PERM = false, AFTER_DRAIN = false;
    bf16_t* q; const float2* cs;
    __device__ __forceinline__ void operator()(const f32x4 (&acc)[2][2][4][2], const Unit& u, int wr, int wc, int fr, int fq) const {
        const int row0 = u.pm * BM + wr * 64 + fr;
#pragma unroll
        for (int bj = 0; bj < 2; ++bj) {
            const int X = u.pn * BM + bj * HALF + wc * 32;
            const bool rope = (X % 96) == 64;
#pragma unroll
            for (int ai = 0; ai < 2; ++ai)
#pragma unroll
                for (int m = 0; m < 4; ++m) { const int r = row0 + ai * HALF + m * 16; const int pos = r & (SEQ - 1);
                    f32x4 v0 = acc[ai][bj][m][0], v1 = acc[ai][bj][m][1];
                    if (rope) {
#pragma unroll
                        for (int j = 0; j < 4; ++j) { const float2 c = cs[pos * 16 + 4 * fq + j]; const float x1 = v0[j], x2 = v1[j]; v0[j] = x1 * c.x - x2 * c.y; v1[j] = x2 * c.x + x1 * c.y; } }
                    v0 = v0 * QS_MLA; v1 = v1 * QS_MLA;
                    bf16_t* p = q + (size_t)r * 768 + X + 4 * fq;
                    uint2 w0, w1; w0.x = cvt_pk_bf16(v0[0], v0[1]); w0.y = cvt_pk_bf16(v0[2], v0[3]); w1.x = cvt_pk_bf16(v1[0], v1[1]); w1.y = cvt_pk_bf16(v1[2], v1[3]);
                    *(uint2*)p = w0; *(uint2*)(p + 16) = w1; }
        }
    }
};
}

#define PG8_SP2 true
#define PG8_ALIGN true
constexpr int NTHR = 512, NWV = NTHR / 64;
#define WAVE_IDS const int lane = threadIdx.x & 63, wv = threadIdx.x >> 6; const int gw = blockIdx.x * NWV + wv, nw = gridDim.x * NWV; (void)lane; (void)gw; (void)nw;

DEV void ph_rms1024(const float* __restrict__ src, const float* __restrict__ g, bf16_t* __restrict__ dst, int rows) {
  WAVE_IDS
  for (int r = gw; r < rows; r += nw) {
    const float4* s4 = (const float4*)(src + (size_t)r * 1024);
    float4 v[4]; float ss = 0.f;
#pragma unroll
    for (int j = 0; j < 4; ++j) { v[j] = s4[j * 64 + lane]; ss += v[j].x * v[j].x + v[j].y * v[j].y + v[j].z * v[j].z + v[j].w * v[j].w; }
    ss = wsum(ss);
    const float inv = rsqrtf(ss * (1.0f / 1024.0f) + 1e-6f);
#pragma unroll
    for (int j = 0; j < 4; ++j) {
      const float4 gg = ((const float4*)g)[j * 64 + lane];
      uint2 o;
      o.x = (unsigned)f2bf(v[j].x * inv * gg.x) | ((unsigned)f2bf(v[j].y * inv * gg.y) << 16);
      o.y = (unsigned)f2bf(v[j].z * inv * gg.z) | ((unsigned)f2bf(v[j].w * inv * gg.w) << 16);
      ((uint2*)(dst + (size_t)r * 1024))[j * 64 + lane] = o;
    }
  }
}
template <int PER> DEV void ph_rms_cols(const bf16_t* __restrict__ proj, int col0, const float* __restrict__ g, bf16_t* __restrict__ dst) {
  WAVE_IDS
  constexpr int W = 64 * PER;
  for (int r = gw; r < T; r += nw) {
    float v[PER]; float ss = 0.f;
#pragma unroll
    for (int j = 0; j < PER; ++j) { v[j] = bf2f(proj[(size_t)r * PROJ_LD + col0 + j * 64 + lane]); ss += v[j] * v[j]; }
    ss = wsum(ss);
    const float inv = rsqrtf(ss * (1.0f / W) + 1e-6f);
#pragma unroll
    for (int j = 0; j < PER; ++j) dst[(size_t)r * W + j * 64 + lane] = f2bf(v[j] * inv * g[j * 64 + lane]);
  }
}

DEV int win_src_col(int n) {
  if (n < 1280) return n;
  if (n < 1536) return 1304 + (n - 1280);
  if (n < 1664) return 1560 + (n - 1536);
  if (n < 1696) return 1688 + (n - 1664);
  if (n < 1720) return 1280 + (n - 1696);
  if (n < 1792) return -1;
  return 1720 + (n - 1792);
}
template <int MODE> DEV void ph_convT(const float* __restrict__ W, int K, int Nsrc, bf16_t* __restrict__ WT, int Nout, char* lds) {
  float (*t)[33] = (float (*)[33])lds;
  const int tx = threadIdx.x & 31, ty = threadIdx.x >> 5;
  const int ntn = (Nout + 31) / 32, ntk = K / 32;
  for (int tile = blockIdx.x; tile < ntn * ntk; tile += gridDim.x) {
    const int n0 = (tile % ntn) * 32, k0 = (tile / ntn) * 32;
#pragma unroll
    for (int i = 0; i < 2; ++i) {
      const int k = k0 + ty + 16 * i, n = n0 + tx;
      const int sc = (MODE == 1) ? win_src_col(n) : n;
      t[ty + 16 * i][tx] = (n < Nout && sc >= 0) ? W[(size_t)k * Nsrc + sc] : 0.f;
    }
    __syncthreads();
#pragma unroll
    for (int i = 0; i < 2; ++i) {
      const int n = n0 + ty + 16 * i, k = k0 + tx;
      if (n < Nout) WT[(size_t)n * K + k] = f2bf(t[tx][ty + 16 * i]);
    }
    __syncthreads();
  }
}
DEV void ph_conv_plain(const float* __restrict__ src, bf16_t* __restrict__ dst, int n) {
  for (int i = blockIdx.x * NTHR + threadIdx.x; i < n; i += gridDim.x * NTHR) dst[i] = f2bf(src[i]);
}

DEV void gemm_tile(const bf16_t* __restrict__ A, int lda, const bf16_t* __restrict__ Bt, int ldb, int m0, int n0, int K, float (&acc)[4][4], char* lds) {
  float (*sA)[132] = (float (*)[132])lds;
  float (*sB)[68] = (float (*)[68])(lds + 32 * 132 * 4);
  const int tid = threadIdx.x, ty = tid >> 4, tx = tid & 15;
  const int lr = tid >> 2, lk = (tid & 3) * 8;
  for (int k0 = 0; k0 < K; k0 += 32) {
    {
      const uint4 va = *(const uint4*)(A + (size_t)(m0 + lr) * lda + k0 + lk);
      const unsigned ua[4] = {va.x, va.y, va.z, va.w};
#pragma unroll
      for (int j = 0; j < 4; ++j) { sA[lk + 2 * j][lr] = __uint_as_float(ua[j] << 16); sA[lk + 2 * j + 1][lr] = __uint_as_float(ua[j] & 0xffff0000u); }
    }
    if (tid < 256) {
      const uint4 vb = *(const uint4*)(Bt + (size_t)(n0 + lr) * ldb + k0 + lk);
      const unsigned ub[4] = {vb.x, vb.y, vb.z, vb.w};
#pragma unroll
      for (int j = 0; j < 4; ++j) { sB[lk + 2 * j][lr] = __uint_as_float(ub[j] << 16); sB[lk + 2 * j + 1][lr] = __uint_as_float(ub[j] & 0xffff0000u); }
    }
    __syncthreads();
#pragma unroll 8
    for (int k = 0; k < 32; ++k) {
      const float4 a = *(const float4*)&sA[k][ty * 4];
      const float4 b = *(const float4*)&sB[k][tx * 4];
      const float av[4] = {a.x, a.y, a.z, a.w}, bv[4] = {b.x, b.y, b.z, b.w};
#pragma unroll
      for (int i = 0; i < 4; ++i)
#pragma unroll
        for (int j = 0; j < 4; ++j) acc[i][j] += av[i] * bv[j];
    }
    __syncthreads();
  }
}
struct EpiInProj { bf16_t* proj; bf16_t* gates;
  DEV void operator()(int m, int n, float v) const { if (n < PROJ_LD) proj[(size_t)m * PROJ_LD + n] = f2bf(v); else gates[(size_t)m * 2048 + (n - PROJ_LD)] = f2bf(sigmoidf_(v)); } };
struct EpiStore { bf16_t* dst; int ld;
  DEV void operator()(int m, int n, float v) const { dst[(size_t)m * ld + n] = f2bf(v); } };
struct EpiGelu { bf16_t* dst; int ld;
  DEV void operator()(int m, int n, float v) const { dst[(size_t)m * ld + n] = f2bf(gelu_exact(v)); } };
struct EpiCmpOut { bf16_t* dst;
  DEV void operator()(int m, int n, float v) const { if (m >= BATCH * NC * 2) return; const int g = m & 1, bc = m >> 1, b = bc / NC, c = bc % NC; dst[((size_t)(b * 2 + g) * 128 + c) * 64 + n] = f2bf(v); } };
struct EpiResid { const float* x; float* h;
  DEV void operator()(int m, int n, float v) const { const size_t i = (size_t)m * 1024 + n; h[i] = x[i] + v; } };

template <class Epi> DEV void ph_gemm(const bf16_t* A, int lda, const bf16_t* Bt, int ldb, int M, int N, int K, const Epi& epi, char* lds) {
  const int ntn = N / 64, ntm = M / 128;
  const int ty = threadIdx.x >> 4, tx = threadIdx.x & 15;
  for (int tile = blockIdx.x; tile < ntn * ntm; tile += gridDim.x) {
    const int m0 = (tile / ntn) * 128, n0 = (tile % ntn) * 64;
    float acc[4][4];
#pragma unroll
    for (int i = 0; i < 4; ++i)
#pragma unroll
      for (int j = 0; j < 4; ++j) acc[i][j] = 0.f;
    gemm_tile(A, lda, Bt, ldb, m0, n0, K, acc, lds);
#pragma unroll
    for (int i = 0; i < 4; ++i)
#pragma unroll
      for (int j = 0; j < 4; ++j) epi(m0 + ty * 4 + i, n0 + tx * 4 + j, acc[i][j]);
  }
}
DEV void ph_merge(const bf16_t* onsa, const bf16_t* omla, const bf16_t* wbn, const bf16_t* wbm, const bf16_t* gates, bf16_t* merged, char* lds) {
  const int ntn = 1024 / 64, ntm = T / 128;
  const int ty = threadIdx.x >> 4, tx = threadIdx.x & 15;
  for (int tile = blockIdx.x; tile < ntn * ntm; tile += gridDim.x) {
    const int m0 = (tile / ntn) * 128, n0 = (tile % ntn) * 64;
    float a1[4][4], a2[4][4];
#pragma unroll
    for (int i = 0; i < 4; ++i)
#pragma unroll
      for (int j = 0; j < 4; ++j) { a1[i][j] = 0.f; a2[i][j] = 0.f; }
    gemm_tile(onsa, 512, wbn, 512, m0, n0, 512, a1, lds);
    gemm_tile(omla, 512, wbm, 512, m0, n0, 512, a2, lds);
#pragma unroll
    for (int i = 0; i < 4; ++i)
#pragma unroll
      for (int j = 0; j < 4; ++j) {
        const int m = m0 + ty * 4 + i, n = n0 + tx * 4 + j;
        merged[(size_t)m * 1024 + n] = f2bf(bf2f(gates[(size_t)m * 2048 + n]) * a1[i][j] + bf2f(gates[(size_t)m * 2048 + 1024 + n]) * a2[i][j]);
      }
  }
}

DEV void ph_rope_table(float2* __restrict__ cs) {
  const int n = SEQ * 16;
  for (int i = blockIdx.x * NTHR + threadIdx.x; i < n; i += gridDim.x * NTHR) {
    const int j = i & 15, pos = i >> 4;
    const float inv_freq = powf(10000.0f, -(float)(2 * j) / 32.0f);
    const float ang = (float)pos * inv_freq;
    cs[i] = make_float2(cosf(ang), sinf(ang));
  }
}
DEV void ph_rope_k(const bf16_t* __restrict__ proj, bf16_t* __restrict__ kr) {
  const int n = T * 16;
  for (int i = blockIdx.x * NTHR + threadIdx.x; i < n; i += gridDim.x * NTHR) {
    const int j = i & 15, t = i >> 4;
    const float pos = (float)(t & (SEQ - 1));
    const float inv_freq = powf(10000.0f, -(float)(2 * j) / 32.0f);
    const float ang = pos * inv_freq, c = cosf(ang), s = sinf(ang);
    const float x1 = bf2f(proj[(size_t)t * PROJ_LD + PC_KR + j]), x2 = bf2f(proj[(size_t)t * PROJ_LD + PC_KR + 16 + j]);
    kr[(size_t)t * 32 + j] = f2bf(x1 * c - x2 * s); kr[(size_t)t * 32 + 16 + j] = f2bf(x2 * c + x1 * s);
  }
}
DEV void ph_cmp_gather(const bf16_t* __restrict__ proj, const float* __restrict__ pos, int which, bf16_t* __restrict__ ca) {
  const int n = 2048 * 2048;
  for (int i = blockIdx.x * NTHR + threadIdx.x; i < n; i += gridDim.x * NTHR) {
    const int e = i & 2047, row = i >> 11;
    float v = 0.f;
    if (row < BATCH * NC * 2) {
      const int g = row & 1, bc = row >> 1, b = bc / NC, c = bc % NC, l = e >> 6, d = e & 63;
      v = bf2f(proj[(size_t)(b * SEQ + 16 * c + l) * PROJ_LD + PC_KV + which * 128 + g * 64 + d]) + pos[e];
    }
    ca[i] = f2bf(v);
  }
}

DEV void ph_cmp_attn(const bf16_t* __restrict__ proj, const bf16_t* __restrict__ kc, const bf16_t* __restrict__ vc,
                     const float* __restrict__ t5, bf16_t* __restrict__ ocmp, unsigned* __restrict__ sel, char* lds) {
  WAVE_IDS
  float* P = (float*)(lds + wv * 1024); float* Q = P + 128;
  for (int item = gw; item < BATCH * 2 * SEQ; item += nw) {
    const int t = item & (SEQ - 1), bg = item >> 11, g = bg & 1, b = bg >> 1;
    const size_t tok = (size_t)b * SEQ + t;
    const int nvalid = (t >= 31) ? min(NC, (t - 31) / 16 + 1) : 0;
    const bf16_t* kcb = kc + (size_t)bg * 128 * 64;
    const bf16_t* vcb = vc + (size_t)bg * 128 * 64;
    float impacc = 0.f;
    for (int r = 0; r < 4; ++r) {
      const int head = g * 4 + r;
      Q[lane] = bf2f(proj[tok * PROJ_LD + PC_Q + head * 64 + lane]);
      wave_lds_sync();
      float lg[2];
#pragma unroll
      for (int u = 0; u < 2; ++u) {
        const int c = lane + 64 * u;
        float d = 0.f;
        if (c < nvalid) { const bf16_t* kr = kcb + c * 64; for (int e = 0; e < 64; ++e) d += Q[e] * bf2f(kr[e]); }
        lg[u] = (c < nvalid) ? d + 1.4426950408889634f * t5bias(t5, head, t - (16 * c + 31)) : -1e30f;
      }
      const float m = wmaxf(fmaxf(lg[0], lg[1]));
      const float e0 = (lane < nvalid) ? exp2f(lg[0] - m) : 0.f, e1 = (lane + 64 < nvalid) ? exp2f(lg[1] - m) : 0.f;
      const float s = wsum(e0 + e1);
      const float inv = (nvalid > 0) ? 1.0f / fmaxf(s, 1e-30f) : 0.f;
      P[lane] = e0 * inv; P[lane + 64] = e1 * inv;
      wave_lds_sync();
      float o = 0.f;
      for (int c = 0; c < nvalid; ++c) o += P[c] * bf2f(vcb[c * 64 + lane]);
      ocmp[tok * 512 + head * 64 + lane] = f2bf(o);
      if (lane < 32) { for (int c = 4 * lane - 1; c <= 4 * lane + 3; ++c) if (c >= 0 && c < NC) impacc += P[c]; }
      wave_lds_sync();
    }
    const int cur = t >> 6, n = lane;
    float score = (n > cur) ? -1.0f : ((n == 0 || n == cur || n == cur - 1) ? 1e4f : impacc);
    if (n >= 32) score = -2.0f;
    int rank = 0;
    for (int mth = 0; mth < 32; ++mth) { const float sm = __shfl(score, mth); rank += (sm > score || (sm == score && mth < n)) ? 1 : 0; }
    const unsigned long long bal = __ballot(n < 32 && rank < 16);
    if (lane == 0) sel[item] = (unsigned)bal;
  }
}

DEV void ph_nsa_attn(const bf16_t* __restrict__ proj, const float* __restrict__ t5, const bf16_t* __restrict__ ocmp,
                     const unsigned* __restrict__ sel, bf16_t* __restrict__ onsa, char* lds) {
  WAVE_IDS
  float* P = (float*)(lds + wv * 1024); float* Q = P + 128;
  for (int item = gw; item < BATCH * 2 * SEQ * 4; item += nw) {
    const int r = item & 3, t = (item >> 2) & (SEQ - 1), bg = item >> 13, g = bg & 1, b = bg >> 1;
    const int head = g * 4 + r, cur = t >> 6;
    const size_t tok = (size_t)b * SEQ + t;
    Q[lane] = bf2f(proj[tok * PROJ_LD + PC_Q + head * 64 + lane]);
    wave_lds_sync();
    const unsigned smask = sel[bg * SEQ + t];
    float res0 = 0.f, res1 = 0.f;
    for (int br = 0; br < 2; ++br) {
      float m = -1e30f, l = 0.f, o = 0.f;
      const int nb0 = (br == 0) ? 0 : max(0, cur - 8);
      for (int nb = nb0; nb <= cur; ++nb) {
        if (br == 0 && !((smask >> nb) & 1u)) continue;
        const int s = nb * 64 + lane, dist = t - s;
        const bool valid = (dist >= 0) && (br == 0 || dist < 512);
        const bf16_t* kp = proj + ((size_t)b * SEQ + s) * PROJ_LD + PC_KV + (2 + 2 * br) * 128 + g * 64;
        float d = 0.f;
        for (int e = 0; e < 64; e += 8) {
          const uint4 kv = *(const uint4*)(kp + e);
          d += Q[e + 0] * __uint_as_float(kv.x << 16) + Q[e + 1] * __uint_as_float(kv.x & 0xffff0000u);
          d += Q[e + 2] * __uint_as_float(kv.y << 16) + Q[e + 3] * __uint_as_float(kv.y & 0xffff0000u);
          d += Q[e + 4] * __uint_as_float(kv.z << 16) + Q[e + 5] * __uint_as_float(kv.z & 0xffff0000u);
          d += Q[e + 6] * __uint_as_float(kv.w << 16) + Q[e + 7] * __uint_as_float(kv.w & 0xffff0000u);
        }
        const float lg = valid ? d + 1.4426950408889634f * t5bias(t5, head, dist) : -1e30f;
        const float mn = fmaxf(m, wmaxf(lg));
        const float sc = exp2f(m - mn);
        const float pe = valid ? exp2f(lg - mn) : 0.f;
        l = l * sc + wsum(pe); m = mn;
        P[lane] = pe;
        wave_lds_sync();
        const bf16_t* vp = proj + ((size_t)b * SEQ + nb * 64) * PROJ_LD + PC_KV + (3 + 2 * br) * 128 + g * 64 + lane;
        float acc = 0.f;
        for (int k = 0; k < 64; ++k) acc += P[k] * bf2f(vp[(size_t)k * PROJ_LD]);
        o = o * sc + acc;
        wave_lds_sync();
      }
      if (br == 0) res0 = o / fmaxf(l, 1e-30f); else res1 = o / fmaxf(l, 1e-30f);
    }
    const bf16_t* gp = proj + tok * PROJ_LD + PC_GATE + head * 3;
    const float g0 = sigmoidf_(bf2f(gp[0])), g1 = sigmoidf_(bf2f(gp[1])), g2 = sigmoidf_(bf2f(gp[2]));
    const float oc = bf2f(ocmp[tok * 512 + head * 64 + lane]);
    onsa[tok * 512 + head * 64 + lane] = f2bf(g0 * oc + g1 * res0 + g2 * res1);
    wave_lds_sync();
  }
}

DEV void ph_mla_attn(const bf16_t* __restrict__ mq, const bf16_t* __restrict__ mkv, const bf16_t* __restrict__ kr, bf16_t* __restrict__ omla, char* lds) {
  WAVE_IDS
  float* P = (float*)(lds + wv * 1024); float* Q = P + 128;
  for (int item = gw; item < BATCH * 8 * SEQ; item += nw) {
    const int h = item & 7, t = (item >> 3) & (SEQ - 1), b = item >> 14;
    const size_t tok = (size_t)b * SEQ + t;
    Q[lane] = bf2f(mq[tok * 768 + h * 96 + lane]);
    if (lane < 32) Q[64 + lane] = bf2f(mq[tok * 768 + h * 96 + 64 + lane]);
    wave_lds_sync();
    float m = -1e30f, l = 0.f, o = 0.f;
    for (int nb = 0; nb <= (t >> 6); ++nb) {
      const int s = nb * 64 + lane;
      const bool valid = s <= t;
      const bf16_t* kp = mkv + ((size_t)b * SEQ + s) * 1024 + h * 128;
      const bf16_t* rp = kr + ((size_t)b * SEQ + s) * 32;
      float d = 0.f;
      for (int e = 0; e < 64; e += 8) {
        const uint4 kv = *(const uint4*)(kp + e);
        d += Q[e + 0] * __uint_as_float(kv.x << 16) + Q[e + 1] * __uint_as_float(kv.x & 0xffff0000u);
        d += Q[e + 2] * __uint_as_float(kv.y << 16) + Q[e + 3] * __uint_as_float(kv.y & 0xffff0000u);
        d += Q[e + 4] * __uint_as_float(kv.z << 16) + Q[e + 5] * __uint_as_float(kv.z & 0xffff0000u);
        d += Q[e + 6] * __uint_as_float(kv.w << 16) + Q[e + 7] * __uint_as_float(kv.w & 0xffff0000u);
      }
      for (int e = 0; e < 32; e += 8) {
        const uint4 kv = *(const uint4*)(rp + e);
        d += Q[64 + e + 0] * __uint_as_float(kv.x << 16) + Q[64 + e + 1] * __uint_as_float(kv.x & 0xffff0000u);
        d += Q[64 + e + 2] * __uint_as_float(kv.y << 16) + Q[64 + e + 3] * __uint_as_float(kv.y & 0xffff0000u);
        d += Q[64 + e + 4] * __uint_as_float(kv.z << 16) + Q[64 + e + 5] * __uint_as_float(kv.z & 0xffff0000u);
        d += Q[64 + e + 6] * __uint_as_float(kv.w << 16) + Q[64 + e + 7] * __uint_as_float(kv.w & 0xffff0000u);
      }
      const float lg = valid ? d : -1e30f;
      const float mn = fmaxf(m, wmaxf(lg));
      const float sc = exp2f(m - mn);
      const float pe = valid ? exp2f(lg - mn) : 0.f;
      l = l * sc + wsum(pe); m = mn;
      P[lane] = pe;
      wave_lds_sync();
      const bf16_t* vp = mkv + ((size_t)b * SEQ + nb * 64) * 1024 + h * 128 + 64 + lane;
      float acc = 0.f;
      for (int k = 0; k < 64; ++k) acc += P[k] * bf2f(vp[(size_t)k * 1024]);
      o = o * sc + acc;
      wave_lds_sync();
    }
    omla[tok * 512 + h * 64 + lane] = f2bf(o / fmaxf(l, 1e-30f));
    wave_lds_sync();
  }
}

DEV void wave_argmax(float& v, int& idx) {
#pragma unroll
  for (int o = 32; o > 0; o >>= 1) {
    const float ov = __shfl_xor(v, o); const int oi = __shfl_xor(idx, o);
    if (ov > v || (ov == v && oi < idx)) { v = ov; idx = oi; }
  }
}
DEV void ph_route(const bf16_t* __restrict__ pq, const bf16_t* __restrict__ subk, int* __restrict__ pidx, float* __restrict__ pw, char* lds) {
  WAVE_IDS
  float* Q = (float*)(lds + wv * 1024);
  float* TS = Q + 128;
  int* TI = (int*)(TS + 32);
  for (int item = gw; item < T * 8; item += nw) {
    const int h = item & 7, t = item >> 3;
    Q[lane] = bf2f(pq[(size_t)t * 1024 + h * 128 + lane]);
    Q[lane + 64] = bf2f(pq[(size_t)t * 1024 + h * 128 + 64 + lane]);
    wave_lds_sync();
    for (int p = 0; p < 2; ++p) {
      const bf16_t* kb = subk + (size_t)((h * 2 + p) * 128) * 64;
      float s0 = 0.f, s1 = 0.f;
      for (int e = 0; e < 64; ++e) { const float qv = Q[p * 64 + e]; s0 += qv * bf2f(kb[lane * 64 + e]); s1 += qv * bf2f(kb[(lane + 64) * 64 + e]); }
      for (int k = 0; k < 16; ++k) {
        float v = (s0 >= s1) ? s0 : s1; int idx = (s0 >= s1) ? lane : lane + 64;
        wave_argmax(v, idx);
        if (lane == 0) { TS[p * 16 + k] = v; TI[p * 16 + k] = idx; }
        if (idx == lane) s0 = -3e38f;
        if (idx == lane + 64) s1 = -3e38f;
      }
    }
    wave_lds_sync();
    float cv[4];
#pragma unroll
    for (int u = 0; u < 4; ++u) { const int f = lane + 64 * u; cv[u] = TS[f >> 4] + TS[16 + (f & 15)]; }
    int myexp = 0; float mybest = 0.f, best0 = 0.f, den = 0.f;
#pragma unroll
    for (int k = 0; k < 16; ++k) {
      float v = cv[0]; int idx = lane;
#pragma unroll
      for (int u = 1; u < 4; ++u) if (cv[u] > v) { v = cv[u]; idx = lane + 64 * u; }
      wave_argmax(v, idx);
#pragma unroll
      for (int u = 0; u < 4; ++u) if (idx == lane + 64 * u) cv[u] = -3e38f;
      if (k == 0) best0 = v;
      den += expf(v - best0);
      if (lane == k) { myexp = TI[idx >> 4] * 128 + TI[16 + (idx & 15)]; mybest = v; }
    }
    if (lane < 16) { pidx[(size_t)t * 128 + h * 16 + lane] = myexp; pw[(size_t)t * 128 + h * 16 + lane] = expf(mybest - best0) / den; }
    wave_lds_sync();
  }
}

DEV void ph_experts(const bf16_t* __restrict__ hn, const int* __restrict__ pidx, const float* __restrict__ pw,
                    const float* __restrict__ pu, const float* __restrict__ pv, const float* __restrict__ gfin, float* __restrict__ out) {
  WAVE_IDS
  for (int t = gw; t < T; t += nw) {
    float4 x[4], y[4];
#pragma unroll
    for (int j = 0; j < 4; ++j) {
      const uint2 r = ((const uint2*)(hn + (size_t)t * 1024))[j * 64 + lane];
      x[j] = make_float4(__uint_as_float(r.x << 16), __uint_as_float(r.x & 0xffff0000u), __uint_as_float(r.y << 16), __uint_as_float(r.y & 0xffff0000u));
      y[j] = make_float4(0.f, 0.f, 0.f, 0.f);
    }
    const int e0 = pidx[(size_t)t * 128 + lane], e1 = pidx[(size_t)t * 128 + 64 + lane];
    const float w0 = pw[(size_t)t * 128 + lane], w1 = pw[(size_t)t * 128 + 64 + lane];
    for (int s = 0; s < 128; ++s) {
      const int e = __shfl((s < 64) ? e0 : e1, s & 63);
      const float w = __shfl((s < 64) ? w0 : w1, s & 63);
      const float4* ur = (const float4*)(pu + (size_t)e * 1024);
      float d = 0.f;
#pragma unroll
      for (int j = 0; j < 4; ++j) { const float4 u = ur[j * 64 + lane]; d += u.x * x[j].x + u.y * x[j].y + u.z * x[j].z + u.w * x[j].w; }
      d = wsum(d);
      const float c = w * gelu_exact(d);
      const float4* vr = (const float4*)(pv + (size_t)e * 1024);
#pragma unroll
      for (int j = 0; j < 4; ++j) { const float4 v = vr[j * 64 + lane]; y[j].x += c * v.x; y[j].y += c * v.y; y[j].z += c * v.z; y[j].w += c * v.w; }
    }
    float4* o4 = (float4*)(out + (size_t)t * 1024);
    float ss = 0.f;
#pragma unroll
    for (int j = 0; j < 4; ++j) {
      const float4 hv = o4[j * 64 + lane];
      y[j].x += hv.x; y[j].y += hv.y; y[j].z += hv.z; y[j].w += hv.w;
      ss += y[j].x * y[j].x + y[j].y * y[j].y + y[j].z * y[j].z + y[j].w * y[j].w;
    }
    ss = wsum(ss);
    const float inv = rsqrtf(ss * (1.0f / 1024.0f) + 1e-6f);
#pragma unroll
    for (int j = 0; j < 4; ++j) {
      const float4 gg = ((const float4*)gfin)[j * 64 + lane];
      o4[j * 64 + lane] = make_float4(y[j].x * inv * gg.x, y[j].y * inv * gg.y, y[j].z * inv * gg.z, y[j].w * inv * gg.w);
    }
  }
}


namespace att {
#define LAS3 __attribute__((address_space(3)))
typedef LAS3 char* lptr;
typedef LAS3 const char* lcptr;
using bf16x8 = __attribute__((ext_vector_type(8))) short;
using s16x4 = __attribute__((ext_vector_type(4))) short;
using f32x16 = __attribute__((ext_vector_type(16))) float;
typedef short v4i16_t __attribute__((ext_vector_type(4)));
typedef unsigned u32x4 __attribute__((ext_vector_type(4)));
typedef float f32x4_t __attribute__((ext_vector_type(4)));
typedef float f32x2_t __attribute__((ext_vector_type(2)));
typedef __bf16 bf16x2_t __attribute__((ext_vector_type(2)));
constexpr float LOG2E = 1.4426950408889634f;
constexpr float THR = 6.0f;
constexpr float NEG_INF = -__builtin_huge_valf();
constexpr int SLOT = 20480, KOFF = 0, VOFF = 12288;
constexpr int L_WSF = 2 * SLOT;
constexpr int L_TB = L_WSF + 2048;
constexpr int L_SELM = L_TB + 4096;
constexpr int L_SC = L_SELM + 256;
constexpr int L_IMPQ = L_SC + 64 * 33 * 4;
constexpr int L_IMPL = L_IMPQ + 4 * 64 * 33 * 4;
constexpr int L_FIN = L_IMPQ;
constexpr int L_END = L_IMPL + 4 * 64 * 33 * 4;
static_assert(L_END <= 131072, "attention LDS map");

__device__ __forceinline__ int crow(int r, int hi) { return (r & 3) + 8 * (r >> 2) + 4 * hi; }
__device__ __forceinline__ s16x4 vtr(lcptr p) { return __builtin_bit_cast(s16x4, __builtin_amdgcn_ds_read_tr16_b64_v4i16((LAS3 v4i16_t*)p)); }
__device__ __forceinline__ unsigned cvtpk(float lo, float hi) { f32x2_t v = {lo, hi}; bf16x2_t b = __builtin_convertvector(v, bf16x2_t); return __builtin_bit_cast(unsigned, b); }
__device__ __forceinline__ float xmax(float v) { auto rr = __builtin_amdgcn_permlane32_swap(__float_as_uint(v), __float_as_uint(v), false, false); return fmaxf(__uint_as_float(rr[0]), __uint_as_float(rr[1])); }
__device__ __forceinline__ float xsum(float v) { auto rr = __builtin_amdgcn_permlane32_swap(__float_as_uint(v), __float_as_uint(v), false, false); return __uint_as_float(rr[0]) + __uint_as_float(rr[1]); }
__device__ __forceinline__ float ex2(float x) { return __builtin_amdgcn_exp2f(x); }

template <int ND0> __device__ __forceinline__ void qkt(f32x16& p0, f32x16& p1, lcptr kb, const bf16x8* qr) {
  p0 = f32x16{}; p1 = f32x16{};
#pragma unroll
  for (int d0 = 0; d0 < ND0; ++d0) {
    const bf16x8 b0 = *(const LAS3 bf16x8*)(kb + d0 * 2048);
    const bf16x8 b1 = *(const LAS3 bf16x8*)(kb + d0 * 2048 + 512);
    p0 = __builtin_amdgcn_mfma_f32_32x32x16_bf16(b0, qr[d0], p0, 0, 0, 0);
    p1 = __builtin_amdgcn_mfma_f32_32x32x16_bf16(b1, qr[d0], p1, 0, 0, 0);
  }
}
__device__ __forceinline__ void pv(f32x16 (&o)[2], lcptr vp, const unsigned (&pw)[16]) {
#pragma unroll
  for (int d0 = 0; d0 < 2; ++d0)
#pragma unroll
    for (int ks = 0; ks < 4; ++ks) {
      const s16x4 lo = vtr(vp + d0 * 4096 + ks * 1024), hi4 = vtr(vp + d0 * 4096 + ks * 1024 + 512);
      const bf16x8 vf = {lo[0], lo[1], lo[2], lo[3], hi4[0], hi4[1], hi4[2], hi4[3]};
      const unsigned pa4[4] = {pw[4 * ks], pw[4 * ks + 1], pw[4 * ks + 2], pw[4 * ks + 3]};
      o[d0] = __builtin_amdgcn_mfma_f32_32x32x16_bf16(__builtin_bit_cast(bf16x8, pa4), vf, o[d0], 0, 0, 0);
    }
}
__device__ __forceinline__ void softmax_step(f32x16& p0, f32x16& p1, float& m, float& l, f32x16 (&o)[2], LAS3 float* wsf, int r32, int hi, unsigned (&pw)[16]) {
  float rm = fmaxf(p0[0], p1[0]);
#pragma unroll
  for (int r = 1; r < 16; ++r) rm = fmaxf(rm, fmaxf(p0[r], p1[r]));
  rm = xmax(rm);
  if (__any(rm > m + THR)) {
    const float mn = fmaxf(m, rm);
    const float al = ex2(m - mn);
    m = mn; l *= al;
    if (hi == 0) wsf[r32] = al;
#pragma unroll
    for (int r = 0; r < 16; ++r) { const float f = wsf[crow(r, hi)]; o[0][r] *= f; o[1][r] *= f; }
  }
  float s = 0.f;
#pragma unroll
  for (int r = 0; r < 16; ++r) { p0[r] = ex2(p0[r] - m); p1[r] = ex2(p1[r] - m); s += p0[r] + p1[r]; }
  l += s;
#pragma unroll
  for (int i = 0; i < 8; ++i) { pw[i] = cvtpk(p0[2 * i], p0[2 * i + 1]); pw[8 + i] = cvtpk(p1[2 * i], p1[2 * i + 1]); }
}
struct KVSrc { const bf16_t* k; const bf16_t* v; int ldk, ldv; };
__device__ __forceinline__ void kv_issue(const KVSrc& s, int row0, u32x4& rk, u32x4& rv, int tid) {
  const int kv = tid & 63, ch = tid >> 6, ln = tid & 63;
  rk = *(const u32x4*)(s.k + (size_t)(row0 + kv) * s.ldk + ch * 8);
  rv = *(const u32x4*)(s.v + (size_t)(row0 + 16 * (ch & 3) + (ln >> 2)) * s.ldv + (ch >> 2) * 32 + (ln & 3) * 8);
}
__device__ __forceinline__ void kv_commit(lptr slot, const u32x4& rk, const u32x4& rv, int tid) {
  *(LAS3 u32x4*)(slot + KOFF + (tid >> 6) * 1024 + (tid & 63) * 16) = rk;
  *(LAS3 u32x4*)(slot + VOFF + tid * 16) = rv;
}
__device__ __forceinline__ void fin_set(LAS3 float* finl, const f32x16 (&o)[2], int lane) {
#pragma unroll
  for (int d0 = 0; d0 < 2; ++d0)
#pragma unroll
    for (int r = 0; r < 16; ++r) finl[(d0 * 16 + r) * 64 + lane] = o[d0][r];
}
__device__ __forceinline__ void fin_add(LAS3 float* finl, const f32x16 (&o)[2], const LAS3 float* wsf, int lane, int hi) {
#pragma unroll
  for (int r = 0; r < 16; ++r) { const float f = wsf[crow(r, hi)];
#pragma unroll
    for (int d0 = 0; d0 < 2; ++d0) finl[(d0 * 16 + r) * 64 + lane] += o[d0][r] * f; }
}
__device__ __forceinline__ void fin_store(const LAS3 float* finl, bf16_t* gout, size_t rowbase, int ld, int colbase, int lane) {
#pragma unroll
  for (int i = 0; i < 4; ++i) {
    const int q = i * 8 + (lane >> 3), ch = lane & 7;
    const int qh = (q >> 2) & 1, r = (q & 3) + 4 * (q >> 3), d0 = ch >> 2, dl = (ch & 3) * 8;
    const LAS3 float* p = finl + (d0 * 16 + r) * 64 + qh * 32 + dl;
    const f32x4_t x0 = *(const LAS3 f32x4_t*)p, x1 = *(const LAS3 f32x4_t*)(p + 4);
    u32x4 v; v.x = cvtpk(x0[0], x0[1]); v.y = cvtpk(x0[2], x0[3]); v.z = cvtpk(x1[0], x1[1]); v.w = cvtpk(x1[2], x1[3]);
    *(u32x4*)(gout + (rowbase + q) * (size_t)ld + colbase + ch * 8) = v;
  }
}

__device__ __forceinline__ void nsa_unit(int b, int g, int c, const bf16_t* __restrict__ proj, const bf16_t* __restrict__ kc, const bf16_t* __restrict__ vc, bf16_t* __restrict__ onsa, lptr lds) {
  int tid = threadIdx.x; asm volatile("" : "+v"(tid));
  const int lane = tid & 63, r32 = lane & 31, hi = lane >> 5;
  const int w = __builtin_amdgcn_readfirstlane(tid >> 6);
  const int rh = w >> 1, head = g * 4 + rh, tokl = 32 * (w & 1) + r32, t = 64 * c + tokl, bg = b * 2 + g;
  const size_t tok = (size_t)b * SEQ + t;
  LAS3 float* wsf = (LAS3 float*)(lds + L_WSF) + w * 64;
  const LAS3 float* tb = (const LAS3 float*)(lds + L_TB) + head * 128;
  LAS3 unsigned* selm = (LAS3 unsigned*)(lds + L_SELM);
  LAS3 float* sc = (LAS3 float*)(lds + L_SC);
  LAS3 float* impq = (LAS3 float*)(lds + L_IMPQ);
  LAS3 float* impl = (LAS3 float*)(lds + L_IMPL);
  const lcptr kb0 = (lcptr)lds + KOFF + hi * 1024 + r32 * 16;
  const lcptr vp0 = (lcptr)lds + VOFF + ((lane >> 4) & 1) * 32 + (lane & 3) * 8 + (4 * hi + ((lane & 15) >> 2)) * 64;
  bf16x8 qr[4];
#pragma unroll
  for (int d0 = 0; d0 < 4; ++d0) qr[d0] = *(const bf16x8*)(proj + tok * PROJ_LD + PC_Q + head * 64 + d0 * 16 + hi * 8);
  float gate[3];
#pragma unroll
  for (int j = 0; j < 3; ++j) gate[j] = 1.0f / (1.0f + ex2(-LOG2E * bf2f(proj[tok * PROJ_LD + PC_GATE + head * 3 + j])));
  LAS3 float* finl = (LAS3 float*)(lds + L_FIN) + w * 2048;
  f32x16 o[2]; unsigned pw[16];
  u32x4 rk, rv;
  {
    const KVSrc src{kc + (size_t)bg * 128 * 64, vc + (size_t)bg * 128 * 64, 64, 64};
    __syncthreads();
    kv_issue(src, 0, rk, rv, tid); kv_commit(lds, rk, rv, tid);
    kv_issue(src, 64, rk, rv, tid); kv_commit(lds + SLOT, rk, rv, tid);
    __syncthreads();
    f32x16 a0, a1, b0, b1;
    qkt<4>(a0, a1, kb0, qr); qkt<4>(b0, b1, kb0 + SLOT, qr);
    float rm = NEG_INF;
#pragma unroll
    for (int r = 0; r < 16; ++r) {
      const int cb = crow(r, hi);
      { const int d = t - 16 * cb - 31;          a0[r] = (d < 0) ? NEG_INF : a0[r] + ((d < 113) ? tb[d] : 0.f); }
      { const int d = t - 16 * (cb + 32) - 31;   a1[r] = (d < 0) ? NEG_INF : a1[r] + ((d < 113) ? tb[d] : 0.f); }
      { const int d = t - 16 * (cb + 64) - 31;   b0[r] = (d < 0) ? NEG_INF : b0[r] + ((d < 113) ? tb[d] : 0.f); }
      { const int d = t - 16 * (cb + 96) - 31;   b1[r] = (d < 0) ? NEG_INF : b1[r] + ((d < 113) ? tb[d] : 0.f); }
      rm = fmaxf(fmaxf(rm, fmaxf(a0[r], a1[r])), fmaxf(b0[r], b1[r]));
    }
    rm = xmax(rm);
    const float mref = (rm == NEG_INF) ? 0.f : rm;
    float s = 0.f;
#pragma unroll
    for (int r = 0; r < 16; ++r) { a0[r] = ex2(a0[r] - mref); a1[r] = ex2(a1[r] - mref); b0[r] = ex2(b0[r] - mref); b1[r] = ex2(b1[r] - mref); s += (a0[r] + a1[r]) + (b0[r] + b1[r]); }
    s = xsum(s);
    const float inv = (s > 0.f) ? 1.0f / s : 0.f;
#pragma unroll
    for (int r = 0; r < 16; ++r) { a0[r] *= inv; a1[r] *= inv; b0[r] *= inv; b1[r] *= inv; }
    { LAS3 float* iq = impq + (rh * 64 + tokl) * 33; LAS3 float* il = impl + (rh * 64 + tokl) * 33;
#pragma unroll
      for (int q4 = 0; q4 < 4; ++q4) {
        const int gi = 2 * q4 + hi;
        iq[gi] = (a0[4 * q4] + a0[4 * q4 + 1]) + (a0[4 * q4 + 2] + a0[4 * q4 + 3]);           il[gi] = a0[4 * q4 + 3];
        iq[8 + gi] = (a1[4 * q4] + a1[4 * q4 + 1]) + (a1[4 * q4 + 2] + a1[4 * q4 + 3]);       il[8 + gi] = a1[4 * q4 + 3];
        iq[16 + gi] = (b0[4 * q4] + b0[4 * q4 + 1]) + (b0[4 * q4 + 2] + b0[4 * q4 + 3]);      il[16 + gi] = b0[4 * q4 + 3];
        iq[24 + gi] = (b1[4 * q4] + b1[4 * q4 + 1]) + (b1[4 * q4 + 2] + b1[4 * q4 + 3]);      il[24 + gi] = b1[4 * q4 + 3];
      } }
    o[0] = f32x16{}; o[1] = f32x16{};
#pragma unroll
    for (int i = 0; i < 8; ++i) { pw[i] = cvtpk(a0[2 * i], a0[2 * i + 1]); pw[8 + i] = cvtpk(a1[2 * i], a1[2 * i + 1]); }
    pv(o, vp0, pw);
#pragma unroll
    for (int i = 0; i < 8; ++i) { pw[i] = cvtpk(b0[2 * i], b0[2 * i + 1]); pw[8 + i] = cvtpk(b1[2 * i], b1[2 * i + 1]); }
    pv(o, vp0 + SLOT, pw);
    if (hi == 0) wsf[r32] = gate[0];
#pragma unroll
    for (int r = 0; r < 16; ++r) { const float f = wsf[crow(r, hi)]; o[0][r] *= f; o[1][r] *= f; }
  }
  __syncthreads();
  const KVSrc ssrc{proj + (size_t)b * SEQ * PROJ_LD + PC_KV + 2 * 128 + g * 64, proj + (size_t)b * SEQ * PROJ_LD + PC_KV + 3 * 128 + g * 64, PROJ_LD, PROJ_LD};
  kv_issue(ssrc, 0, rk, rv, tid);
  {
    const int stok = tid >> 3, sub = tid & 7;
#pragma unroll
    for (int k = 0; k < 4; ++k) {
      const int n = sub * 4 + k;
      float imp = 0.f;
#pragma unroll
      for (int hh = 0; hh < 4; ++hh) imp += impq[(hh * 64 + stok) * 33 + n] + ((n > 0) ? impl[(hh * 64 + stok) * 33 + n - 1] : 0.f);
      sc[stok * 33 + n] = (n > c) ? -1.0f : ((n == 0 || n == c || n == c - 1) ? 1e4f : imp);
    }
    if (tid < 64) selm[tid] = 0u;
    __syncthreads();
#pragma unroll
    for (int k = 0; k < 4; ++k) {
      const int n = sub * 4 + k; const float sv = sc[stok * 33 + n]; int rank = 0;
      for (int mm = 0; mm < 32; ++mm) { const float sm = sc[stok * 33 + mm]; rank += (sm > sv || (sm == sv && mm < n)) ? 1 : 0; }
      if (rank < 16) atomicOr((unsigned*)(selm + stok), 1u << n);
    }
    __syncthreads();
  }
  const unsigned mysel = selm[tokl];
  fin_set(finl, o, lane);
#pragma unroll 1
  for (int br = 0; br < 2; ++br) {
    const KVSrc src = (br == 0) ? ssrc : KVSrc{proj + (size_t)b * SEQ * PROJ_LD + PC_KV + 4 * 128 + g * 64, proj + (size_t)b * SEQ * PROJ_LD + PC_KV + 5 * 128 + g * 64, PROJ_LD, PROJ_LD};
    const int n0 = (br == 0) ? 0 : ((c > 8) ? c - 8 : 0);
    if (br == 1) { __syncthreads(); kv_issue(src, n0 * 64, rk, rv, tid); }
    kv_commit(lds, rk, rv, tid);
    float m = -1e30f, l = 0.f;
    o[0] = f32x16{}; o[1] = f32x16{};
    int cur = 0;
#pragma unroll 1
    for (int n = n0; n <= c; ++n) {
      __syncthreads();
      if (n < c) kv_issue(src, (n + 1) * 64, rk, rv, tid);
      const bool mine = (br == 1) || ((mysel >> n) & 1u);
      if (__any(mine)) {
        f32x16 p0, p1;
        qkt<4>(p0, p1, kb0 + cur * SLOT, qr);
        if (n + 2 >= c) {
          const int dbase = t - 64 * n;
#pragma unroll
          for (int r = 0; r < 16; ++r) { const int d0_ = dbase - crow(r, hi), d1_ = d0_ - 32;
            p0[r] = (d0_ < 0) ? NEG_INF : p0[r] + ((d0_ < 113) ? tb[d0_] : 0.f);
            p1[r] = (d1_ < 0) ? NEG_INF : p1[r] + ((d1_ < 113) ? tb[d1_] : 0.f); }
        } else if (br == 1 && n + 8 == c) {
          const int dbase = t - 64 * n;
#pragma unroll
          for (int r = 0; r < 16; ++r) { const int d0_ = dbase - crow(r, hi), d1_ = d0_ - 32;
            if (d0_ >= 512) p0[r] = NEG_INF; if (d1_ >= 512) p1[r] = NEG_INF; }
        }
        if (!mine) {
#pragma unroll
          for (int r = 0; r < 16; ++r) { p0[r] = NEG_INF; p1[r] = NEG_INF; } }
        softmax_step(p0, p1, m, l, o, wsf, r32, hi, pw);
        pv(o, vp0 + cur * SLOT, pw);
      }
      if (n < c) kv_commit(lds + (cur ^ 1) * SLOT, rk, rv, tid);
      cur ^= 1;
    }
    l = xsum(l);
    const float gi = gate[1 + br] / fmaxf(l, 1e-30f);
    if (hi == 0) wsf[r32] = gi;
    fin_add(finl, o, wsf, lane, hi);
  }
  fin_store(finl, onsa, (size_t)b * SEQ + 64 * c + 32 * (w & 1), 512, head * 64, lane);
}

__device__ __forceinline__ void mla_unit(int b, int h, int qb, const bf16_t* __restrict__ mq, const bf16_t* __restrict__ mkv, const bf16_t* __restrict__ kr, bf16_t* __restrict__ omla, lptr lds) {
  int tid = threadIdx.x; asm volatile("" : "+v"(tid));
  const int lane = tid & 63, r32 = lane & 31, hi = lane >> 5;
  const int w = __builtin_amdgcn_readfirstlane(tid >> 6);
  const int q0 = 256 * qb, qw = q0 + 32 * w, qpos = qw + r32;
  const size_t tokq = (size_t)b * SEQ + qpos;
  LAS3 float* wsf = (LAS3 float*)(lds + L_WSF) + w * 64;
  const lcptr kb0 = (lcptr)lds + KOFF + hi * 1024 + r32 * 16;
  const lcptr vp0 = (lcptr)lds + VOFF + ((lane >> 4) & 1) * 32 + (lane & 3) * 8 + (4 * hi + ((lane & 15) >> 2)) * 64;
  bf16x8 qr[6];
#pragma unroll
  for (int d0 = 0; d0 < 6; ++d0) qr[d0] = *(const bf16x8*)(mq + tokq * 768 + h * 96 + d0 * 16 + hi * 8);
  const KVSrc src{mkv + (size_t)b * SEQ * 1024 + h * 128, mkv + (size_t)b * SEQ * 1024 + h * 128 + 64, 1024, 1024};
  const bf16_t* krb = kr + (size_t)b * SEQ * 32;
  const int NTL = 4 * (qb + 1);
  u32x4 rk, rv, rr = {0u, 0u, 0u, 0u};
  f32x16 o[2]; o[0] = f32x16{}; o[1] = f32x16{};
  unsigned pw[16];
  float m = -1e30f, l = 0.f;
  __syncthreads();
  kv_issue(src, 0, rk, rv, tid);
  if (tid < 256) rr = *(const u32x4*)(krb + (size_t)(tid & 63) * 32 + (tid >> 6) * 8);
  kv_commit(lds, rk, rv, tid);
  if (tid < 256) *(LAS3 u32x4*)(lds + KOFF + (8 + (tid >> 6)) * 1024 + (tid & 63) * 16) = rr;
  int cur = 0;
#pragma unroll 1
  for (int tl = 0; tl < NTL; ++tl) {
    __syncthreads();
    if (tl + 1 < NTL) { kv_issue(src, (tl + 1) * 64, rk, rv, tid); if (tid < 256) rr = *(const u32x4*)(krb + (size_t)((tl + 1) * 64 + (tid & 63)) * 32 + (tid >> 6) * 8); }
    if (64 * tl <= qw + 31) {
      f32x16 p0, p1;
      qkt<6>(p0, p1, kb0 + cur * SLOT, qr);
      if (64 * tl + 63 > qw) {
        const int dbase = qpos - 64 * tl;
#pragma unroll
        for (int r = 0; r < 16; ++r) { const int d0_ = dbase - crow(r, hi), d1_ = d0_ - 32; if (d0_ < 0) p0[r] = NEG_INF; if (d1_ < 0) p1[r] = NEG_INF; }
      }
      softmax_step(p0, p1, m, l, o, wsf, r32, hi, pw);
      pv(o, vp0 + cur * SLOT, pw);
    }
    if (tl + 1 < NTL) { kv_commit(lds + (cur ^ 1) * SLOT, rk, rv, tid); if (tid < 256) *(LAS3 u32x4*)(lds + (cur ^ 1) * SLOT + KOFF + (8 + (tid >> 6)) * 1024 + (tid & 63) * 16) = rr; }
    cur ^= 1;
  }
  l = xsum(l);
  if (hi == 0) wsf[r32] = 1.0f / fmaxf(l, 1e-30f);
#pragma unroll
  for (int r = 0; r < 16; ++r) { const float f = wsf[crow(r, hi)]; o[0][r] *= f; o[1][r] *= f; }
  LAS3 float* finl = (LAS3 float*)(lds + L_FIN) + w * 2048;
  fin_set(finl, o, lane);
  fin_store(finl, omla, (size_t)b * SEQ + qw, 512, h * 64, lane);
}

__device__ __forceinline__ void attn_phase(const bf16_t* proj, const bf16_t* kc, const bf16_t* vc, const float* t5, bf16_t* onsa,
                                           const bf16_t* mq, const bf16_t* mkv, const bf16_t* kr, bf16_t* omla, lptr lds) {
  const int tid = threadIdx.x;
  { LAS3 float* tb = (LAS3 float*)(lds + L_TB);
    for (int i = tid; i < 8 * 128; i += NTHR) { const int hd = i >> 7, d = i & 127; tb[i] = (t5[(int)T5B[d] * 8 + hd] - t5[31 * 8 + hd]) * LOG2E; } }
  const int G = gridDim.x, bx = blockIdx.x;
  for (int v = (G % 8 == 0) ? (bx % 8) * (G / 8) + bx / 8 : bx; v < 256; v += G) {
    const int bg = v >> 4, p = v & 15, bh = v >> 2, j = v & 3;
#pragma unroll 1
    for (int u = 0; u < 2; ++u) nsa_unit(bg >> 1, bg & 1, u ? p : 31 - p, proj, kc, vc, onsa, lds);
#pragma unroll 1
    for (int u = 0; u < 2; ++u) mla_unit(bh >> 3, bh & 7, u ? j : 7 - j, mq, mkv, kr, omla, lds);
  }
}
#undef LAS3
}


namespace peer {
using bf16x8 = __attribute__((ext_vector_type(8))) short;
using f32x16 = __attribute__((ext_vector_type(16))) float;
typedef unsigned u32x4 __attribute__((ext_vector_type(4)));
typedef float f32x4_t __attribute__((ext_vector_type(4)));
typedef __bf16 bf16x2_t __attribute__((ext_vector_type(2)));
typedef float f32x2_t __attribute__((ext_vector_type(2)));
#define LAS3 __attribute__((address_space(3)))
__device__ __forceinline__ int crow(int r, int hi) { return (r & 3) + 8 * (r >> 2) + 4 * hi; }
__device__ __forceinline__ unsigned enc(float f) { const unsigned u = __float_as_uint(f); return u ^ ((unsigned)((int)u >> 31) | 0x80000000u); }
__device__ __forceinline__ float dec(unsigned k) { return __uint_as_float(k ^ (~(unsigned)((int)k >> 31) | 0x80000000u)); }
__device__ __forceinline__ unsigned umax(unsigned a, unsigned b) { return a > b ? a : b; }
__device__ __forceinline__ unsigned umin(unsigned a, unsigned b) { return a < b ? a : b; }
__device__ __forceinline__ unsigned cvtpk(float lo, float hi) { f32x2_t v = {lo, hi}; bf16x2_t b = __builtin_convertvector(v, bf16x2_t); return __builtin_bit_cast(unsigned, b); }
template <int B, int N> __device__ __forceinline__ void sort16(unsigned (&k)[N]) {
#pragma unroll
  for (int size = 2; size <= 16; size <<= 1)
#pragma unroll
    for (int stride = size >> 1; stride > 0; stride >>= 1)
#pragma unroll
      for (int i = 0; i < 16; ++i) { const int l = i ^ stride;
        if (l > i) { const bool desc = ((i & size) == 0); const unsigned a = k[B + i], b = k[B + l]; const unsigned mx = umax(a, b), mn = umin(a, b); k[B + i] = desc ? mx : mn; k[B + l] = desc ? mn : mx; } }
}
template <int A, int Bo, int N> __device__ __forceinline__ void merge16(unsigned (&k)[N]) {
#pragma unroll
  for (int i = 0; i < 16; ++i) k[A + i] = umax(k[A + i], k[Bo + 15 - i]);
#pragma unroll
  for (int stride = 8; stride > 0; stride >>= 1)
#pragma unroll
    for (int i = 0; i < 16; ++i) { const int l = i ^ stride; if (l > i) { const unsigned a = k[A + i], b = k[A + l]; k[A + i] = umax(a, b); k[A + l] = umin(a, b); } }
}
template <int N> __device__ __forceinline__ void top16_of_64(unsigned (&k)[N]) {
  sort16<0>(k); sort16<16>(k); sort16<32>(k); sort16<48>(k);
  merge16<0, 16>(k); merge16<32, 48>(k); merge16<0, 32>(k);
}

__device__ __forceinline__ void route_phase(const bf16_t* __restrict__ pq, const bf16_t* __restrict__ subk, unsigned* __restrict__ pack, LAS3 char* lds) {
  const int tid = threadIdx.x, lane = tid & 63, r32 = lane & 31, hi = lane >> 5, wv = tid >> 6;
  const int gw = blockIdx.x * NWV + wv, nw = gridDim.x * NWV;
  LAS3 unsigned char* myb = (LAS3 unsigned char*)lds + wv * 2560 + lane * 40;
#pragma unroll 1
  for (int item = gw; item < (T / 32) * 8; item += nw) {
    const int h = item & 7, t0 = (item >> 3) * 32;
    unsigned la[16], lb[16];
#pragma unroll
    for (int i = 0; i < 16; ++i) { la[i] = 0u; lb[i] = 0u; }
#pragma unroll 1
    for (int p = 0; p < 2; ++p) {
      f32x16 acc[4];
#pragma unroll
      for (int kt = 0; kt < 4; ++kt) acc[kt] = f32x16{};
#pragma unroll
      for (int kd = 0; kd < 4; ++kd) {
        const bf16x8 bq = *(const bf16x8*)(pq + (size_t)(t0 + r32) * 1024 + h * 128 + p * 64 + kd * 16 + hi * 8);
#pragma unroll
        for (int kt = 0; kt < 4; ++kt) {
          const bf16x8 ak = *(const bf16x8*)(subk + (size_t)((h * 2 + p) * 128 + kt * 32 + r32) * 64 + kd * 16 + hi * 8);
          acc[kt] = __builtin_amdgcn_mfma_f32_32x32x16_bf16(ak, bq, acc[kt], 0, 0, 0);
        }
      }
      unsigned k[64];
#pragma unroll
      for (int kt = 0; kt < 4; ++kt)
#pragma unroll
        for (int r = 0; r < 16; ++r) k[kt * 16 + r] = (enc(acc[kt][r]) & 0xFFFFFF80u) | (unsigned)(127 - (32 * kt + crow(r, hi)));
      top16_of_64(k);
#pragma unroll
      for (int i = 0; i < 16; ++i) { auto rr = __builtin_amdgcn_permlane32_swap(k[i], k[i], false, false); unsigned r0 = rr[0], r1 = rr[1]; asm volatile("" : "+v"(r0), "+v"(r1)); k[16 + i] = hi ? r0 : r1; }
      merge16<0, 16>(k);
#pragma unroll
      for (int i = 0; i < 16; ++i) { la[i] = (p == 0) ? k[i] : la[i]; lb[i] = (p == 0) ? lb[i] : k[i]; }
      __builtin_amdgcn_sched_barrier(0);
    }
#pragma unroll
    for (int i = 0; i < 4; ++i) {
      const unsigned wa = (127u - (la[4 * i] & 127u)) | ((127u - (la[4 * i + 1] & 127u)) << 8) | ((127u - (la[4 * i + 2] & 127u)) << 16) | ((127u - (la[4 * i + 3] & 127u)) << 24);
      const unsigned wb = (127u - (lb[4 * i] & 127u)) | ((127u - (lb[4 * i + 1] & 127u)) << 8) | ((127u - (lb[4 * i + 2] & 127u)) << 16) | ((127u - (lb[4 * i + 3] & 127u)) << 24);
      *(LAS3 unsigned*)(myb + 4 * i) = wa; *(LAS3 unsigned*)(myb + 16 + 4 * i) = wb;
    }
    float va[16], vb[16];
#pragma unroll
    for (int i = 0; i < 16; ++i) { va[i] = dec(la[i] & 0xFFFFFF80u); vb[i] = dec(lb[i] & 0xFFFFFF80u); }
    unsigned k[64];
#define PEER_CAND(n, i, j) k[n] = (enc(va[i] + vb[j]) & 0xFFFFFF00u) | (unsigned)(255 - ((i) * 16 + (j)))
    PEER_CAND(0, 0, 0); PEER_CAND(1, 0, 1); PEER_CAND(2, 0, 2); PEER_CAND(3, 0, 3); PEER_CAND(4, 0, 4); PEER_CAND(5, 0, 5);
    PEER_CAND(6, 0, 6); PEER_CAND(7, 0, 7); PEER_CAND(8, 0, 8); PEER_CAND(9, 0, 9); PEER_CAND(10, 0, 10); PEER_CAND(11, 0, 11);
    PEER_CAND(12, 0, 12); PEER_CAND(13, 0, 13); PEER_CAND(14, 0, 14); PEER_CAND(15, 0, 15); PEER_CAND(16, 1, 0); PEER_CAND(17, 1, 1);
    PEER_CAND(18, 1, 2); PEER_CAND(19, 1, 3); PEER_CAND(20, 1, 4); PEER_CAND(21, 1, 5); PEER_CAND(22, 1, 6); PEER_CAND(23, 1, 7);
    PEER_CAND(24, 2, 0); PEER_CAND(25, 2, 1); PEER_CAND(26, 2, 2); PEER_CAND(27, 2, 3); PEER_CAND(28, 2, 4); PEER_CAND(29, 3, 0);
    PEER_CAND(30, 3, 1); PEER_CAND(31, 3, 2); PEER_CAND(32, 3, 3); PEER_CAND(33, 4, 0); PEER_CAND(34, 4, 1); PEER_CAND(35, 4, 2);
    PEER_CAND(36, 5, 0); PEER_CAND(37, 5, 1); PEER_CAND(38, 6, 0); PEER_CAND(39, 6, 1); PEER_CAND(40, 7, 0); PEER_CAND(41, 7, 1);
    PEER_CAND(42, 8, 0); PEER_CAND(43, 9, 0); PEER_CAND(44, 10, 0); PEER_CAND(45, 11, 0); PEER_CAND(46, 12, 0); PEER_CAND(47, 13, 0);
    PEER_CAND(48, 14, 0); PEER_CAND(49, 15, 0);
#undef PEER_CAND
#pragma unroll
    for (int z = 50; z < 64; ++z) k[z] = 0u;
    top16_of_64(k);
    const float best0 = dec(k[0] & 0xFFFFFF00u);
    float ev[16]; float den = 0.f;
#pragma unroll
    for (int i = 0; i < 16; ++i) { ev[i] = __expf(dec(k[i] & 0xFFFFFF00u) - best0); den += ev[i]; }
    const float inv = 1.0f / den;
    unsigned outw[8];
#pragma unroll
    for (int i = 0; i < 8; ++i) {
      unsigned k_lo = k[i], k_hi = k[8 + i]; float e_lo = ev[i], e_hi = ev[8 + i];
      asm volatile("" : "+v"(k_lo), "+v"(k_hi), "+v"(e_lo), "+v"(e_hi));
      const unsigned kk = hi ? k_hi : k_lo; const float e = hi ? e_hi : e_lo;
      const unsigned f = 255u - (kk & 255u);
      const unsigned ia = myb[f >> 4], ib = myb[16 + (f & 15u)];
      outw[i] = (ia * 128u + ib) | (cvtpk(0.f, e * inv) & 0xFFFF0000u);
    }
    unsigned* dst = pack + (size_t)(t0 + r32) * 128 + h * 16 + hi * 8;
    *(u32x4*)dst = (u32x4){outw[0], outw[1], outw[2], outw[3]};
    *(u32x4*)(dst + 4) = (u32x4){outw[4], outw[5], outw[6], outw[7]};
  }
}

__device__ __forceinline__ void conv_tables(const float* __restrict__ u, const float* __restrict__ v, bf16_t* __restrict__ u16, bf16_t* __restrict__ v16) {
  const size_t n8 = (size_t)16384 * 1024 / 8;
  for (size_t i = (size_t)blockIdx.x * NTHR + threadIdx.x; i < 2 * n8; i += (size_t)gridDim.x * NTHR) {
    const bool second = i >= n8; const size_t j = second ? i - n8 : i;
    const float* s = (second ? v : u) + j * 8;
    const f32x4_t a = *(const f32x4_t*)s, b = *(const f32x4_t*)(s + 4);
    const u32x4 o = {cvtpk(a[0], a[1]), cvtpk(a[2], a[3]), cvtpk(b[0], b[1]), cvtpk(b[2], b[3])};
    *(u32x4*)((second ? v16 : u16) + j * 8) = o;
  }
}
__device__ __forceinline__ float dot2(unsigned a, unsigned b, float c) { return __builtin_amdgcn_fdot2_f32_bf16(__builtin_bit_cast(bf16x2_t, a), __builtin_bit_cast(bf16x2_t, b), c, false); }
__device__ __forceinline__ float gelu_fast(float v) {
  const float av = __builtin_fabsf(v), t = __builtin_amdgcn_rcpf(av * 0.2316418882f + 1.0f);
  float q = t * 0.5307027145f + (-0.7265760135f); q = q * t + 0.7107068705f; q = q * t + (-0.142248368f); q = q * t + 0.127414796f; q = q * t;
  const float e = __builtin_amdgcn_exp2f((v * v) * (-0.72134752044f));
  const float m = v * (q * e);
  return v < 0.f ? m : v - m;
}
__device__ __forceinline__ void experts_phase(const bf16_t* __restrict__ hn, const unsigned* __restrict__ pack, const bf16_t* __restrict__ u16, const bf16_t* __restrict__ v16,
                                              const float* __restrict__ gfin, float* __restrict__ out) {
  const int tid = threadIdx.x, lane = tid & 63, j16 = lane & 15, grp = lane >> 4, wv = tid >> 6;
  const int gw = blockIdx.x * NWV + wv, nw = gridDim.x * NWV;
#pragma unroll 1
  for (int t = gw; t < T; t += nw) {
    u32x4 hq[8];
#pragma unroll
    for (int seg = 0; seg < 8; ++seg) hq[seg] = *(const u32x4*)(hn + (size_t)t * 1024 + seg * 128 + j16 * 8);
    const unsigned pk0 = pack[(size_t)t * 128 + lane], pk1 = pack[(size_t)t * 128 + 64 + lane];
    float y[16];
#pragma unroll
    for (int i = 0; i < 16; ++i) y[i] = 0.f;
#pragma unroll 1
    for (int q = 0; q < 32; ++q) {
      const unsigned pkv = (unsigned)__shfl((int)(q < 16 ? pk0 : pk1), (4 * q + grp) & 63);
      const unsigned e = pkv & 0xFFFFu; const float wgt = __uint_as_float(pkv & 0xFFFF0000u);
      u32x4 ub[8], vb[8];
      const bf16_t* urow = u16 + (size_t)e * 1024 + j16 * 8;
#pragma unroll
      for (int seg = 0; seg < 8; ++seg) ub[seg] = *(const u32x4*)(urow + seg * 128);
#pragma unroll
      for (int x = 0; x < 4; ++x) {
        const unsigned ex = (unsigned)__builtin_amdgcn_readlane((int)e, 16 * x);
        const bf16_t* vrow = v16 + (size_t)ex * 1024 + lane * 8;
        vb[2 * x] = *(const u32x4*)vrow; vb[2 * x + 1] = *(const u32x4*)(vrow + 512);
      }
      float d = 0.f;
#pragma unroll
      for (int seg = 0; seg < 8; ++seg) { d = dot2(ub[seg].x, hq[seg].x, d); d = dot2(ub[seg].y, hq[seg].y, d); d = dot2(ub[seg].z, hq[seg].z, d); d = dot2(ub[seg].w, hq[seg].w, d); }
      d += __shfl_xor(d, 1); d += __shfl_xor(d, 2); d += __shfl_xor(d, 4); d += __shfl_xor(d, 8);
      const unsigned cb = cvtpk(wgt * gelu_fast(d), 0.f) & 0xFFFFu;
#pragma unroll
      for (int x = 0; x < 4; ++x) {
        const unsigned cl = (unsigned)__builtin_amdgcn_readlane((int)cb, 16 * x), ch = cl << 16;
#pragma unroll
        for (int hf = 0; hf < 2; ++hf) { const u32x4 vv = vb[2 * x + hf];
          y[hf * 8 + 0] = dot2(vv.x, cl, y[hf * 8 + 0]); y[hf * 8 + 1] = dot2(vv.x, ch, y[hf * 8 + 1]);
          y[hf * 8 + 2] = dot2(vv.y, cl, y[hf * 8 + 2]); y[hf * 8 + 3] = dot2(vv.y, ch, y[hf * 8 + 3]);
          y[hf * 8 + 4] = dot2(vv.z, cl, y[hf * 8 + 4]); y[hf * 8 + 5] = dot2(vv.z, ch, y[hf * 8 + 5]);
          y[hf * 8 + 6] = dot2(vv.w, cl, y[hf * 8 + 6]); y[hf * 8 + 7] = dot2(vv.w, ch, y[hf * 8 + 7]); }
      }
    }
    float ss = 0.f;
    f32x4_t r[4];
#pragma unroll
    for (int hf = 0; hf < 2; ++hf) {
      const float* hp = out + (size_t)t * 1024 + hf * 512 + lane * 8;
      const f32x4_t a = *(const f32x4_t*)hp, b = *(const f32x4_t*)(hp + 4);
      r[2 * hf] = (f32x4_t){a[0] + y[hf * 8 + 0], a[1] + y[hf * 8 + 1], a[2] + y[hf * 8 + 2], a[3] + y[hf * 8 + 3]};
      r[2 * hf + 1] = (f32x4_t){b[0] + y[hf * 8 + 4], b[1] + y[hf * 8 + 5], b[2] + y[hf * 8 + 6], b[3] + y[hf * 8 + 7]};
#pragma unroll
      for (int i = 0; i < 4; ++i) ss += r[2 * hf][i] * r[2 * hf][i] + r[2 * hf + 1][i] * r[2 * hf + 1][i];
    }
    ss = wsum(ss);
    const float inv = rsqrtf(ss * (1.0f / 1024.0f) + 1e-6f);
#pragma unroll
    for (int hf = 0; hf < 2; ++hf) {
      const float* gp = gfin + hf * 512 + lane * 8; float* op = out + (size_t)t * 1024 + hf * 512 + lane * 8;
      const f32x4_t g0 = *(const f32x4_t*)gp, g1 = *(const f32x4_t*)(gp + 4);
      *(f32x4_t*)op = r[2 * hf] * inv * g0; *(f32x4_t*)(op + 4) = r[2 * hf + 1] * inv * g1;
    }
  }
}
#undef LAS3
}

struct Args { const float* in[23]; float* out; char* ws; };
constexpr int LDS_BYTES = 131072 + 4096;

typedef const __attribute__((address_space(4))) Args* kargs_t;
DEV kargs_t KA() { kargs_t k = (kargs_t)__builtin_amdgcn_kernarg_segment_ptr(); asm volatile("" : "+s"(k)); return k; }
#define WSP(type, off) ((type*)(ws + (off)))

__global__ __launch_bounds__(NTHR, 2) void mega(Args a) {
  extern __shared__ __attribute__((aligned(16))) char lds[];
  cg::grid_group grid = cg::this_grid();
  PG8_LAS unsigned char* glds = (PG8_LAS unsigned char*)lds;
  const int bid = blockIdx.x, G = gridDim.x;
  (void)a;

  { kargs_t k = KA(); char* ws = k->ws;
    ph_convT<1>(k->in[2], 1024, IN_COLS, WSP(bf16_t, WS_WIN), 3840, lds);
    ph_convT<0>(k->in[13], 512, 1024, WSP(bf16_t, WS_WBN), 1024, lds);
    ph_convT<0>(k->in[14], 512, 1024, WSP(bf16_t, WS_WBM), 1024, lds);
    ph_convT<0>(k->in[15], 1024, 1024, WSP(bf16_t, WS_WOUT), 1024, lds);
    ph_convT<0>(k->in[17], 1024, 1024, WSP(bf16_t, WS_WQ), 1024, lds);
    ph_convT<0>(k->in[5], 2048, 256, WSP(bf16_t, WS_CKW1), 256, lds);
    ph_convT<0>(k->in[7], 2048, 256, WSP(bf16_t, WS_CVW1), 256, lds);
    ph_convT<0>(k->in[6], 256, 64, WSP(bf16_t, WS_CKW2), 64, lds);
    ph_convT<0>(k->in[8], 256, 64, WSP(bf16_t, WS_CVW2), 64, lds);
    ph_convT<0>(k->in[11], 256, 768, WSP(bf16_t, WS_UQ), 768, lds);
    ph_convT<0>(k->in[12], 128, 1024, WSP(bf16_t, WS_UKV), 1024, lds);
    ph_conv_plain(k->in[18], WSP(bf16_t, WS_SUBK), 16 * 128 * 64);
    ph_rope_table(WSP(float2, WS_ROPE));
    ph_rms1024(k->in[0], k->in[1], WSP(bf16_t, WS_XN), T); }
  grid.sync();
  { kargs_t k = KA(); char* ws = k->ws;
    pg8::Gemm g{WSP(bf16_t, WS_XN), WSP(bf16_t, WS_WIN), T, 3840, 1024}; pg8::StaticOrder S; S.init(T, 3840, G, bid);
    pg8::EpiInProjF E{WSP(bf16_t, WS_PROJ), WSP(bf16_t, WS_GATES)};
    pg8::gemm_phase<pg8::EpiInProjF, pg8::StaticOrder, PG8_ALIGN, PG8_SP2>(glds, g, S, E); }
  grid.sync();
  { kargs_t k = KA(); char* ws = k->ws;
    ph_rms_cols<4>(WSP(bf16_t, WS_PROJ), PC_CQ, k->in[9], WSP(bf16_t, WS_CQN));
    ph_rms_cols<2>(WSP(bf16_t, WS_PROJ), PC_CKV, k->in[10], WSP(bf16_t, WS_CKVN));
    ph_rope_k(WSP(bf16_t, WS_PROJ), WSP(bf16_t, WS_KROPE));
    ph_cmp_gather(WSP(bf16_t, WS_PROJ), k->in[3], 0, WSP(bf16_t, WS_CA));
    ph_cmp_gather(WSP(bf16_t, WS_PROJ), k->in[4], 1, WSP(bf16_t, WS_CA2)); }
  grid.sync();
  { kargs_t k = KA(); char* ws = k->ws;
    pg8::Gemm g{WSP(bf16_t, WS_CA), WSP(bf16_t, WS_CKW1), 2048, 256, 2048}; pg8::StaticOrder S; S.init(2048, 256, G, bid);
    pg8::EpiBf16<1> E{WSP(bf16_t, WS_HID), 256, nullptr, 0, 0, 1.f};
    pg8::gemm_phase<pg8::EpiBf16<1>, pg8::StaticOrder, PG8_ALIGN, PG8_SP2>(glds, g, S, E); }
  { kargs_t k = KA(); char* ws = k->ws;
    pg8::Gemm g{WSP(bf16_t, WS_CA2), WSP(bf16_t, WS_CVW1), 2048, 256, 2048}; pg8::StaticOrder S; S.init(2048, 256, G, (bid + 128) & 255);
    pg8::EpiBf16<1> E{WSP(bf16_t, WS_HID2), 256, nullptr, 0, 0, 1.f};
    pg8::gemm_phase<pg8::EpiBf16<1>, pg8::StaticOrder, PG8_ALIGN, PG8_SP2>(glds, g, S, E); }
  { kargs_t k = KA(); char* ws = k->ws;
    pg8::Gemm g{WSP(bf16_t, WS_CQN), WSP(bf16_t, WS_UQ), T, 768, 256}; pg8::StaticOrder S; S.init(T, 768, G, (bid + 64) & 255);
    pg8::EpiMlaQF E{WSP(bf16_t, WS_MLAQ), WSP(float2, WS_ROPE)};
    pg8::gemm_phase<pg8::EpiMlaQF, pg8::StaticOrder, PG8_ALIGN, PG8_SP2>(glds, g, S, E); }
  { kargs_t k = KA(); char* ws = k->ws;
    pg8::Gemm g{WSP(bf16_t, WS_CKVN), WSP(bf16_t, WS_UKV), T, 1024, 128}; pg8::StaticOrder S; S.init(T, 1024, G, bid);
    pg8::EpiBf16<0> E{WSP(bf16_t, WS_MLAKV), 1024, nullptr, 0, 0, 1.f};
    pg8::gemm_phase<pg8::EpiBf16<0>, pg8::StaticOrder, PG8_ALIGN, PG8_SP2>(glds, g, S, E); }
  grid.sync();
  { kargs_t k = KA(); char* ws = k->ws;
    ph_gemm(WSP(bf16_t, WS_HID), 256, WSP(bf16_t, WS_CKW2), 256, 2048, 64, 256, EpiCmpOut{WSP(bf16_t, WS_KC)}, lds);
    ph_gemm(WSP(bf16_t, WS_HID2), 256, WSP(bf16_t, WS_CVW2), 256, 2048, 64, 256, EpiCmpOut{WSP(bf16_t, WS_VC)}, lds); }
  grid.sync();
  { kargs_t k = KA(); char* ws = k->ws;
    att::attn_phase(WSP(bf16_t, WS_PROJ), WSP(bf16_t, WS_KC), WSP(bf16_t, WS_VC), k->in[21], WSP(bf16_t, WS_ONSA),
                    WSP(bf16_t, WS_MLAQ), WSP(bf16_t, WS_MLAKV), WSP(bf16_t, WS_KROPE), WSP(bf16_t, WS_OMLA), (att::lptr)lds); }
  grid.sync();
  { kargs_t k = KA(); char* ws = k->ws;
    pg8::Gemm g{WSP(bf16_t, WS_ONSA), WSP(bf16_t, WS_WBN), T, 1024, 512}; pg8::StaticOrder S; S.init(T, 1024, G, bid);
    pg8::EpiMergeF<0> E{WSP(bf16_t, WS_GATES), WSP(bf16_t, WS_MERGED)};
    pg8::gemm_phase<pg8::EpiMergeF<0>, pg8::StaticOrder, PG8_ALIGN, PG8_SP2>(glds, g, S, E); }
  { kargs_t k = KA(); char* ws = k->ws;
    pg8::Gemm g{WSP(bf16_t, WS_OMLA), WSP(bf16_t, WS_WBM), T, 1024, 512}; pg8::StaticOrder S; S.init(T, 1024, G, bid);
    pg8::EpiMergeF<1> E{WSP(bf16_t, WS_GATES), WSP(bf16_t, WS_MERGED)};
    pg8::gemm_phase<pg8::EpiMergeF<1>, pg8::StaticOrder, PG8_ALIGN, PG8_SP2>(glds, g, S, E); }
  grid.sync();
  { kargs_t k = KA(); char* ws = k->ws;
    pg8::Gemm g{WSP(bf16_t, WS_MERGED), WSP(bf16_t, WS_WOUT), T, 1024, 1024}; pg8::StaticOrder S; S.init(T, 1024, G, bid);
    pg8::EpiResidF E{k->in[0], k->out};
    pg8::gemm_phase<pg8::EpiResidF, pg8::StaticOrder, PG8_ALIGN, PG8_SP2>(glds, g, S, E); }
  grid.sync();
  { kargs_t k = KA(); char* ws = k->ws; ph_rms1024(k->out, k->in[16], WSP(bf16_t, WS_HN), T);
    peer::conv_tables(k->in[19], k->in[20], WSP(bf16_t, WS_U16), WSP(bf16_t, WS_V16)); }
  grid.sync();
  { kargs_t k = KA(); char* ws = k->ws;
    pg8::Gemm g{WSP(bf16_t, WS_HN), WSP(bf16_t, WS_WQ), T, 1024, 1024}; pg8::StaticOrder S; S.init(T, 1024, G, bid);
    pg8::EpiBf16<0> E{WSP(bf16_t, WS_PQ), 1024, nullptr, 0, 0, 1.f};
    pg8::gemm_phase<pg8::EpiBf16<0>, pg8::StaticOrder, PG8_ALIGN, PG8_SP2>(glds, g, S, E); }
  grid.sync();
  { kargs_t k = KA(); char* ws = k->ws; peer::route_phase(WSP(bf16_t, WS_PQ), WSP(bf16_t, WS_SUBK), WSP(unsigned, WS_PIDX), (__attribute__((address_space(3))) char*)lds); }
  grid.sync();
  { kargs_t k = KA(); char* ws = k->ws; peer::experts_phase(WSP(bf16_t, WS_HN), WSP(unsigned, WS_PIDX), WSP(bf16_t, WS_U16), WSP(bf16_t, WS_V16), k->in[22], k->out); }
}

extern "C" void kernel_launch(void* const* d_in, const int* in_sizes, int n_in, void* d_out, int out_size, void* d_ws, size_t ws_size, hipStream_t stream) {
  if (n_in != 23 || ws_size < 256 * MiB) { fprintf(stderr, "kernel_launch: unexpected n_in %d / ws_size %zu\n", n_in, ws_size); return; }
  static int grid_blocks = 0;
  if (!grid_blocks) {
    int dev = 0, cus = 0, per_cu = 0;
    (void)hipGetDevice(&dev);
    (void)hipDeviceGetAttribute(&cus, hipDeviceAttributeMultiprocessorCount, dev);
    if (hipFuncSetAttribute((const void*)mega, hipFuncAttributeMaxDynamicSharedMemorySize, LDS_BYTES) != hipSuccess) fprintf(stderr, "kernel_launch: hipFuncSetAttribute failed\n");
    (void)hipOccupancyMaxActiveBlocksPerMultiprocessor(&per_cu, (const void*)mega, NTHR, LDS_BYTES);
    if (per_cu < 1) { fprintf(stderr, "kernel_launch: occupancy query returned %d\n", per_cu); per_cu = 1; }
    if (per_cu > 2) per_cu = 2;
    grid_blocks = cus * per_cu;
    fprintf(stderr, "kernel_launch: cus %d per_cu %d grid %d ws %zu\n", cus, per_cu, grid_blocks, ws_size);
  }
  Args a{};
  for (int i = 0; i < 23; ++i) a.in[i] = (const float*)d_in[i];
  a.out = (float*)d_out; a.ws = (char*)d_ws;
  void* args[] = {&a};
  hipError_t e = hipLaunchCooperativeKernel((const void*)mega, dim3(grid_blocks), dim3(NTHR), args, LDS_BYTES, stream);
  if (e != hipSuccess) fprintf(stderr, "cooperative launch failed: %s (grid %d)\n", hipGetErrorString(e), grid_blocks);
}
```

```cpp
#include <hip/hip_runtime.h>
#include <stdint.h>
#include <cstdio>
#include <hip/hip_cooperative_groups.h>
namespace cg = cooperative_groups;

typedef unsigned short bf16_t;
#define DEV __device__ __forceinline__

constexpr int BATCH = 8, SEQ = 2048, DM = 1024, T = BATCH * SEQ;
constexpr int IN_COLS = 3768;
constexpr int PROJ_LD = 1792;
constexpr int PC_Q = 0, PC_KV = 512, PC_CQ = 1280, PC_CKV = 1536, PC_KR = 1664, PC_GATE = 1696;
constexpr int NC = 127;
constexpr size_t MiB = 1u << 20;

constexpr size_t WS_WIN = 1 * MiB;
constexpr size_t WS_WBN = 9 * MiB;
constexpr size_t WS_WBM = 10 * MiB;
constexpr size_t WS_WOUT = 11 * MiB;
constexpr size_t WS_WQ = 13 * MiB;
constexpr size_t WS_CKW1 = 15 * MiB;
constexpr size_t WS_CVW1 = 16 * MiB;
constexpr size_t WS_CKW2 = 17 * MiB;
constexpr size_t WS_CVW2 = 17 * MiB + 64 * 1024;
constexpr size_t WS_UQ = 17 * MiB + 256 * 1024;
constexpr size_t WS_UKV = 17 * MiB + 768 * 1024;
constexpr size_t WS_SUBK = 18 * MiB;
constexpr size_t WS_ROPE = 18 * MiB + 512 * 1024;
constexpr size_t WS_GATES = 20 * MiB;
constexpr size_t WS_PQ = 20 * MiB;
constexpr size_t WS_PROJ = 84 * MiB;
constexpr size_t WS_MERGED = 84 * MiB;
constexpr size_t WS_PIDX = 84 * MiB;
constexpr size_t WS_U16 = 172 * MiB;
constexpr size_t WS_V16 = 204 * MiB;
constexpr size_t WS_PW = 92 * MiB;
constexpr size_t WS_XN = 140 * MiB;
constexpr size_t WS_MLAKV = 140 * MiB;
constexpr size_t WS_HN = 140 * MiB;
constexpr size_t WS_MLAQ = 172 * MiB;
constexpr size_t WS_KROPE = 196 * MiB;
constexpr size_t WS_KC = 197 * MiB;
constexpr size_t WS_VC = 197 * MiB + 512 * 1024;
constexpr size_t WS_ONSA = 198 * MiB;
constexpr size_t WS_OMLA = 214 * MiB;
constexpr size_t WS_CA = 198 * MiB;
constexpr size_t WS_HID = 206 * MiB;
constexpr size_t WS_HID2 = 207 * MiB;
constexpr size_t WS_CA2 = 214 * MiB;
constexpr size_t WS_CQN = 230 * MiB;
constexpr size_t WS_CKVN = 238 * MiB;
constexpr size_t WS_OCMP = 230 * MiB;
constexpr size_t WS_SEL = 246 * MiB;

__device__ const unsigned char T5B[128] = {
  0, 1, 2, 3, 4, 5, 6, 7, 8, 9, 10, 11, 12, 13, 14, 15, 16, 16, 16, 17, 17, 18, 18, 18, 19, 19, 19, 20, 20, 20, 20, 21,
  21, 21, 21, 22, 22, 22, 22, 22, 23, 23, 23, 23, 23, 23, 24, 24, 24, 24, 24, 24, 25, 25, 25, 25, 25, 25, 25, 26, 26, 26, 26, 26,
  26, 26, 26, 27, 27, 27, 27, 27, 27, 27, 27, 27, 27, 28, 28, 28, 28, 28, 28, 28, 28, 28, 28, 29, 29, 29, 29, 29, 29, 29, 29, 29,
  29, 29, 29, 30, 30, 30, 30, 30, 30, 30, 30, 30, 30, 30, 30, 30, 30, 31, 31, 31, 31, 31, 31, 31, 31, 31, 31, 31, 31, 31, 31, 31};

DEV float bf2f(bf16_t v) { return __uint_as_float(((unsigned)v) << 16); }
DEV bf16_t f2bf(float f) { unsigned u = __float_as_uint(f); u += 0x7fffu + ((u >> 16) & 1u); return (bf16_t)(u >> 16); }
DEV float wsum(float v) {
#pragma unroll
  for (int o = 32; o > 0; o >>= 1) v += __shfl_xor(v, o);
  return v;
}
DEV float wmaxf(float v) {
#pragma unroll
  for (int o = 32; o > 0; o >>= 1) v = fmaxf(v, __shfl_xor(v, o));
  return v;
}
DEV float sigmoidf_(float x) { return 1.0f / (1.0f + expf(-x)); }
DEV float gelu_exact(float x) { return 0.5f * x * (1.0f + erff(x * 0.70710678118654752f)); }
DEV void wave_lds_sync() { asm volatile("s_waitcnt lgkmcnt(0)" ::: "memory"); __builtin_amdgcn_wave_barrier(); asm volatile("" ::: "memory"); }
DEV float t5bias(const float* t5, int head, int dist) { int d = dist < 127 ? dist : 127; d = d < 0 ? 0 : d; return t5[(int)T5B[d] * 8 + head]; }


namespace pg8 {
#define PG8_LAS __attribute__((address_space(3)))
typedef unsigned short bf16_t;
typedef short bf16x8 __attribute__((ext_vector_type(8)));
typedef float f32x4 __attribute__((ext_vector_type(4)));
typedef unsigned u32x4 __attribute__((ext_vector_type(4)));
constexpr int BM = 256, BK = 64, HALF = 128, HTB = HALF * BK * 2  , STAGE_BYTES = 8 * HTB, NXCD = 8, WGM = 8;

__host__ __device__ __forceinline__ int lds_byte(int r, int c) { const int st = (r >> 4) * 2 + (c >> 5), rr = r & 15, cc = c & 31, ob = rr * 64 + cc * 2; return st * 1024 + (ob ^ (((ob >> 9) & 1) << 5)); }
__host__ __device__ __forceinline__ void stage_rc(int b, int& R, int& C) { const int st = b / 1024, sb = b % 1024, swz = sb ^ (((sb >> 9) & 1) << 5); R = (st >> 1) * 16 + swz / 64; C = (st & 1) * 32 + (swz % 64) / 2; }
__host__ __device__ __forceinline__ int perm32(int rho) { const int n = rho >> 4, i = rho & 15; return 8 * (i >> 2) + 4 * n + (i & 3); }

struct Unit { int pm, pn; };
struct Gemm { const bf16_t* A; const bf16_t* Bt; int M, N, K; };

struct StaticOrder {
    int nM, nN, nwg, G, c;
    __host__ __device__ void init(int M, int N, int G_, int c_) { nM = M / BM; nN = N / BM; nwg = nM * nN; G = G_; c = c_; }
    __host__ __device__ bool next(int i, Unit& u) const {
        const long L = (long)i * G + c; if (L >= nwg) return false;
        int wgid = (int)L; { const int q = nwg / NXCD, r = nwg % NXCD, xcd = wgid % NXCD, off = wgid / NXCD; wgid = (xcd < r ? xcd * (q + 1) : r * (q + 1) + (xcd - r) * q) + off; }
        const int nig = WGM * nN, gid = wgid / nig, fm = gid * WGM, gsz = (nM - fm) < WGM ? (nM - fm) : WGM;
        u.pm = fm + ((wgid % nig) % gsz); u.pn = (wgid % nig) / gsz; return true;
    }
    __device__ __forceinline__ void a_ready(const Unit&) const {}
    __device__ __forceinline__ void done(const Unit&) const {}
};

__device__ __forceinline__ unsigned cvt_pk_bf16(float lo, float hi) { unsigned r; asm volatile("v_cvt_pk_bf16_f32 %0, %1, %2" : "=v"(r) : "v"(lo), "v"(hi)); return r; }
typedef float f32x2 __attribute__((ext_vector_type(2)));
__device__ __forceinline__ f32x2 gelu_pk(f32x2 v) {
    const f32x2 av = __builtin_elementwise_abs(v), d = av * 0.2316418882f + 1.0f;
    f32x2 t; t.x = __builtin_amdgcn_rcpf(d.x); t.y = __builtin_amdgcn_rcpf(d.y);
    f32x2 q = t * 0.5307027145f + (-0.7265760135f); q = q * t + 0.7107068705f; q = q * t + (-0.142248368f); q = q * t + 0.127414796f; q = q * t;
    const f32x2 s = (v * v) * (-0.72134752044f);
    f32x2 e; e.x = __builtin_amdgcn_exp2f(s.x); e.y = __builtin_amdgcn_exp2f(s.y);
    const f32x2 m = v * (q * e), r = v - m;
    f32x2 o; o.x = v.x < 0.f ? m.x : r.x; o.y = v.y < 0.f ? m.y : r.y; return o;
}

template <int ACT  > struct EpiBf16 {
    static constexpr bool PERM = true, AFTER_DRAIN = false; static_assert(ACT == 0 || ACT == 1, "EpiBf16: ACT is 0 (none) or 1 (gelu_pk)");
    bf16_t* O; int ldc; const float* bias; int split_cols; size_t split_stride; float scale0;
    __device__ __forceinline__ void operator()(const f32x4 (&acc)[2][2][4][2], const Unit& u, int wr, int wc, int fr, int fq) const {
        const int row0 = u.pm * BM + wr * 64 + fr; int colt = u.pn * BM; bf16_t* base = O;
        float sc = 1.f; if (split_cols) { const int t = colt / split_cols; base += (size_t)t * split_stride; colt -= t * split_cols; if (t == 0) sc = scale0; }
        const int col0 = colt + wc * 32 + 8 * fq, bcol0 = u.pn * BM + wc * 32 + 8 * fq;
        f32x4 bv[2][2];
#pragma unroll
        for (int bj = 0; bj < 2; ++bj)
#pragma unroll
            for (int n = 0; n < 2; ++n) bv[bj][n] = bias ? *(const f32x4*)(bias + bcol0 + bj * HALF + 4 * n) : (f32x4){0.f, 0.f, 0.f, 0.f};
#pragma unroll
        for (int ai = 0; ai < 2; ++ai)
#pragma unroll
            for (int m = 0; m < 4; ++m) { bf16_t* rowp = base + (size_t)(row0 + ai * HALF + m * 16) * ldc + col0;
#pragma unroll
                for (int bj = 0; bj < 2; ++bj) { f32x4 v0 = acc[ai][bj][m][0] + bv[bj][0], v1 = acc[ai][bj][m][1] + bv[bj][1];
                    if (ACT == 1) { f32x2 a = gelu_pk((f32x2){v0[0], v0[1]}), b = gelu_pk((f32x2){v0[2], v0[3]}), c = gelu_pk((f32x2){v1[0], v1[1]}), d = gelu_pk((f32x2){v1[2], v1[3]});
                        v0 = (f32x4){a.x, a.y, b.x, b.y}; v1 = (f32x4){c.x, c.y, d.x, d.y}; }
                    v0 = v0 * sc; v1 = v1 * sc; u32x4 w; w.x = cvt_pk_bf16(v0[0], v0[1]); w.y = cvt_pk_bf16(v0[2], v0[3]); w.z = cvt_pk_bf16(v1[0], v1[1]); w.w = cvt_pk_bf16(v1[2], v1[3]);
                    *(u32x4*)(rowp + bj * HALF) = w; } }
    }
};

struct PanelStats {
    unsigned* xbuf;
    unsigned* cnt;
    unsigned* tmo;
    int ntn; float eps;
    unsigned code;
    __device__ __forceinline__ bool run(const f32x4 (&v)[2][2][4][2], const Unit& u, int wr, int wc, int fr, int fq, PG8_LAS unsigned char* lds, int wid, int lane) const {
        typedef float f32x2v __attribute__((ext_vector_type(2)));
        PG8_LAS f32x2v* P = (PG8_LAS f32x2v*)lds;
        PG8_LAS f32x2v* S = (PG8_LAS f32x2v*)(lds + 8192);
        PG8_LAS unsigned* flag = (PG8_LAS unsigned*)(lds + 8192 + 2048);
#pragma unroll
        for (int ai = 0; ai < 2; ++ai)
#pragma unroll
            for (int m = 0; m < 4; ++m) {
                float s = 0.f;
#pragma unroll
                for (int bj = 0; bj < 2; ++bj)
#pragma unroll
                    for (int n = 0; n < 2; ++n) { const f32x4 x = v[ai][bj][m][n]; s += (x[0] + x[1]) + (x[2] + x[3]); }
                s += __shfl_xor(s, 16); s += __shfl_xor(s, 32);
                const float mw = s * (1.0f / 64.0f); float q = 0.f;
#pragma unroll
                for (int bj = 0; bj < 2; ++bj)
#pragma unroll
                    for (int n = 0; n < 2; ++n) { const f32x4 d = v[ai][bj][m][n] - mw; q += (d[0] * d[0] + d[1] * d[1]) + (d[2] * d[2] + d[3] * d[3]); }
                q += __shfl_xor(q, 16); q += __shfl_xor(q, 32);
                if (fq == 0) P[(ai * HALF + wr * 64 + m * 16 + fr) * 4 + wc] = (f32x2v){mw, q};
            }
        asm volatile("s_waitcnt lgkmcnt(0)" ::: "memory"); __builtin_amdgcn_s_barrier(); asm volatile("" ::: "memory");
#if defined(BROKEN_EXCHANGE_NO_WAIT)
#warning BROKEN CONTROL BUILD: the row-statistics exchange does not wait; results are wrong by design
        if (blockIdx.x >= 64) { const long long t0_ = clock64(); while (clock64() - t0_ < 60000) __builtin_amdgcn_s_sleep(8); }
#endif
        const int row = wid * 32 + (lane & 31);
        if (lane < 32) {
            const f32x2v a = P[row * 4 + 0], b = P[row * 4 + 1], c = P[row * 4 + 2], d = P[row * 4 + 3];
            const float mt = (a.x + b.x + c.x + d.x) * 0.25f;
            const float da = a.x - mt, db = b.x - mt, dc = c.x - mt, dd = d.x - mt;
            const float m2 = (a.y + b.y) + (c.y + d.y) + 64.0f * ((da * da + db * db) + (dc * dc + dd * dd));
            unsigned long long* slot = (unsigned long long*)xbuf + ((size_t)(u.pm * BM + row) * 4 + u.pn);
            __hip_atomic_store(slot, ((unsigned long long)__float_as_uint(m2) << 32) | __float_as_uint(mt), __ATOMIC_RELAXED, __HIP_MEMORY_SCOPE_AGENT);
        }
        asm volatile("s_waitcnt vmcnt(0)" ::: "memory");
        if (lane == 0) __hip_atomic_fetch_add(cnt + 64 * u.pm, 1u, __ATOMIC_RELAXED, __HIP_MEMORY_SCOPE_AGENT);
        if (wid == 0) {
            bool dead = false; const unsigned long long t0 = __builtin_amdgcn_s_memrealtime(); const unsigned want = 8u * (unsigned)ntn;
            for (;;) {
#if defined(BROKEN_EXCHANGE_NO_WAIT)
                break;
#endif
                if ((unsigned)__builtin_amdgcn_readfirstlane(__hip_atomic_load(cnt + 64 * u.pm, __ATOMIC_RELAXED, __HIP_MEMORY_SCOPE_AGENT)) >= want) break;
                if (__builtin_amdgcn_s_memrealtime() - t0 > 2000000ull) {
                    if (lane == 0) { unsigned expect = 0u; __hip_atomic_compare_exchange_strong(tmo + 1, &expect, code | (unsigned)(u.pm & 0xff), __ATOMIC_RELAXED, __ATOMIC_RELAXED, __HIP_MEMORY_SCOPE_AGENT);
                                     __hip_atomic_store(tmo, 1u, __ATOMIC_RELAXED, __HIP_MEMORY_SCOPE_AGENT); }
                    dead = true; break; }
                __builtin_amdgcn_s_sleep(2);
            }
            __builtin_amdgcn_fence(__ATOMIC_ACQUIRE, "agent");
            if (lane == 0) flag[0] = dead ? 1u : 0u;
        }
        asm volatile("s_waitcnt vmcnt(0) lgkmcnt(0)" ::: "memory"); __builtin_amdgcn_s_barrier(); asm volatile("" ::: "memory");
        const bool bad = flag[0] != 0u;
        if (lane < 32) {
            const unsigned long long* slot = (const unsigned long long*)xbuf + (size_t)(u.pm * BM + row) * 4; float mt[4], m2[4]; float ms = 0.f;
#pragma unroll
            for (int t = 0; t < 4; ++t) { if (t < ntn) { const unsigned long long w = __hip_atomic_load(slot + t, __ATOMIC_RELAXED, __HIP_MEMORY_SCOPE_AGENT); mt[t] = __uint_as_float((unsigned)w); m2[t] = __uint_as_float((unsigned)(w >> 32)); } else { mt[t] = 0.f; m2[t] = 0.f; } ms += mt[t]; }
            const float mean = ms / (float)ntn; float q = 0.f;
#pragma unroll
            for (int t = 0; t < 4; ++t) if (t < ntn) { const float dm = mt[t] - mean; q += m2[t] + 256.0f * dm * dm; }
            S[row] = (f32x2v){mean, 1.0f / sqrtf(q / (256.0f * (float)ntn) + eps)};
        }
        asm volatile("s_waitcnt lgkmcnt(0)" ::: "memory"); __builtin_amdgcn_s_barrier(); asm volatile("" ::: "memory");
        return bad;
    }
};
struct EpiLnRes {
    static constexpr bool PERM = false, AFTER_DRAIN = true;
    const float* base; float* out; int ldc; const float* bias; PanelStats st; unsigned poison;
    __device__ __forceinline__ void fused(f32x4 (&acc)[2][2][4][2], const Unit& u, int wr, int wc, int fr, int fq, PG8_LAS unsigned char* lds, int wid, int lane) const {
        typedef float f32x2v __attribute__((ext_vector_type(2)));
        const PG8_LAS f32x2v* S = (const PG8_LAS f32x2v*)(lds + 8192);
        const int col0 = u.pn * BM + wc * 32 + 4 * fq;
#pragma unroll
        for (int bj = 0; bj < 2; ++bj)
#pragma unroll
            for (int n = 0; n < 2; ++n) { const f32x4 bv = bias ? *(const f32x4*)(bias + col0 + bj * HALF + n * 16) : (f32x4){0.f, 0.f, 0.f, 0.f};
#pragma unroll
                for (int ai = 0; ai < 2; ++ai)
#pragma unroll
                    for (int m = 0; m < 4; ++m) acc[ai][bj][m][n] += bv; }
        f32x4 pre[4][2][2];
#pragma unroll
        for (int m = 0; m < 4; ++m) { const size_t off = (size_t)(u.pm * BM + wr * 64 + m * 16 + fr) * ldc + col0;
#pragma unroll
            for (int bj = 0; bj < 2; ++bj)
#pragma unroll
                for (int n = 0; n < 2; ++n) pre[m][bj][n] = *(const f32x4*)(base + off + bj * HALF + n * 16); }
        const bool bad = st.run(acc, u, wr, wc, fr, fq, lds, wid, lane) || poison != 0u;
        const float qnan = __builtin_nanf("");
#pragma unroll
        for (int ai = 0; ai < 2; ++ai)
#pragma unroll
            for (int m = 0; m < 4; ++m) { const int r = ai * HALF + wr * 64 + m * 16 + fr; const f32x2v sr = S[r]; const size_t off = (size_t)(u.pm * BM + r) * ldc + col0;
#pragma unroll
                for (int bj = 0; bj < 2; ++bj)
#pragma unroll
                    for (int n = 0; n < 2; ++n) { const f32x4 bs = ai == 0 ? pre[m][bj][n] : *(const f32x4*)(base + off + bj * HALF + n * 16); f32x4 o = bs + (acc[ai][bj][m][n] - sr.x) * sr.y;
                        if (bad) o = (f32x4){qnan, qnan, qnan, qnan}; *(f32x4*)(out + off + bj * HALF + n * 16) = o; }
                if (m & 1) asm volatile("" ::: "memory"); }
    }
};
struct EpiLnResLn {
    static constexpr bool PERM = false, AFTER_DRAIN = true;
    const float* base; float* out; bf16_t* xn; int ldc; const float* bias; PanelStats st1, st2; unsigned poison;
    __device__ __forceinline__ void fused(f32x4 (&acc)[2][2][4][2], const Unit& u, int wr, int wc, int fr, int fq, PG8_LAS unsigned char* lds, int wid, int lane) const {
        typedef float f32x2v __attribute__((ext_vector_type(2))); typedef unsigned u32x2v __attribute__((ext_vector_type(2)));
        const PG8_LAS f32x2v* S = (const PG8_LAS f32x2v*)(lds + 8192);
        const int col0 = u.pn * BM + wc * 32 + 4 * fq;
#pragma unroll
        for (int bj = 0; bj < 2; ++bj)
#pragma unroll
            for (int n = 0; n < 2; ++n) { const f32x4 bv = bias ? *(const f32x4*)(bias + col0 + bj * HALF + n * 16) : (f32x4){0.f, 0.f, 0.f, 0.f};
#pragma unroll
                for (int ai = 0; ai < 2; ++ai)
#pragma unroll
                    for (int m = 0; m < 4; ++m) acc[ai][bj][m][n] += bv; }
        bool bad = st1.run(acc, u, wr, wc, fr, fq, lds, wid, lane) || poison != 0u;
        const float qnan = __builtin_nanf("");
#pragma unroll
        for (int ai = 0; ai < 2; ++ai)
#pragma unroll
            for (int m = 0; m < 4; ++m) { const int r = ai * HALF + wr * 64 + m * 16 + fr; const f32x2v sr = S[r]; const size_t off = (size_t)(u.pm * BM + r) * ldc + col0;
#pragma unroll
                for (int bj = 0; bj < 2; ++bj)
#pragma unroll
                    for (int n = 0; n < 2; ++n) { const f32x4 bs = *(const f32x4*)(base + off + bj * HALF + n * 16); acc[ai][bj][m][n] = bs + (acc[ai][bj][m][n] - sr.x) * sr.y; }
                asm volatile("" : "+v"(acc[ai][0][m][0]), "+v"(acc[ai][0][m][1]), "+v"(acc[ai][1][m][0]), "+v"(acc[ai][1][m][1]));
                if (m & 1) asm volatile("" ::: "memory"); }
        const bool bad1 = bad;
        bad = st2.run(acc, u, wr, wc, fr, fq, lds, wid, lane) || bad;
#pragma unroll
        for (int ai = 0; ai < 2; ++ai)
#pragma unroll
            for (int m = 0; m < 4; ++m) { const int r = ai * HALF + wr * 64 + m * 16 + fr; const f32x2v sr = S[r]; const size_t off = (size_t)(u.pm * BM + r) * ldc + col0;
#pragma unroll
                for (int bj = 0; bj < 2; ++bj)
#pragma unroll
                    for (int n = 0; n < 2; ++n) { const f32x4 x1 = acc[ai][bj][m][n]; *(f32x4*)(out + off + bj * HALF + n * 16) = bad1 ? (f32x4){qnan, qnan, qnan, qnan} : x1;
                        const f32x4 o = (x1 - sr.x) * sr.y; u32x2v w; w.x = cvt_pk_bf16(o[0], o[1]); w.y = cvt_pk_bf16(o[2], o[3]);
                        if (bad) { w.x = 0x7fc07fc0u; w.y = 0x7fc07fc0u; } *(u32x2v*)(xn + off + bj * HALF + n * 16) = w; }
                asm volatile("" ::: "memory"); }
    }
};

template <class Epi, class Sched, bool ALIGN_EPI = false, bool SP2 = false>
__device__ __forceinline__ void gemm_phase(PG8_LAS unsigned char* lds, const Gemm g, const Sched& S, const Epi& E) {
    int tid = threadIdx.x; asm volatile("" : "+v"(tid));
    const int wid = __builtin_amdgcn_readfirstlane(tid >> 6), lane = tid & 63, wr = wid >> 2, wc = wid & 3, fr = lane & 15, fq = lane >> 4;
    int K = g.K; asm volatile("" : "+s"(K)); const int nt = K / BK;
    unsigned voffA[2], voffB[2];
#pragma unroll
    for (int i = 0; i < 2; ++i) { int R, C; stage_rc(tid * 16 + i * 8192, R, C); const int Rb = Epi::PERM ? ((R & ~31) + perm32(R & 31)) : R;
        voffA[i] = (unsigned)(R * K + C) * 2u; voffB[i] = (unsigned)(Rb * K + C) * 2u; }
    const size_t kstep = (size_t)(BK * 2);
    const size_t hstep = (size_t)HALF * K * 2;
    const size_t tstep = 2 * hstep;
    const unsigned ldsw = (unsigned)wid * 1024u;
    const int aoff = lds_byte(wr * 64 + fr, fq * 8), boff = lds_byte(wc * 32 + fr, fq * 8);
#define PG8_SA(b, h) (((b) * 2 + (h)) * HTB)
#define PG8_SB(b, h) ((4 + (b) * 2 + (h)) * HTB)
#define PG8_STAGE(bufoff, gbase, voff) do { _Pragma("unroll") for (int _i = 0; _i < 2; ++_i) \
        __builtin_amdgcn_global_load_lds((const unsigned*)((const char*)(gbase) + (voff)[_i]), (PG8_LAS unsigned*)(lds + (bufoff) + ldsw + _i * 8192), 16, 0, 0); } while (0)
#define PG8_LDA(dst, b, h) do { _Pragma("unroll") for (int m = 0; m < 4; ++m) _Pragma("unroll") for (int k = 0; k < 2; ++k) dst[m][k] = *(const PG8_LAS bf16x8*)(lds + PG8_SA(b, h) + aoff + m * 2048 + k * 1024); } while (0)
#define PG8_LDB(dst, b, h) do { _Pragma("unroll") for (int n = 0; n < 2; ++n) _Pragma("unroll") for (int k = 0; k < 2; ++k) dst[n][k] = *(const PG8_LAS bf16x8*)(lds + PG8_SB(b, h) + boff + n * 2048 + k * 1024); } while (0)
#define PG8_MMA(ai, bj, At, Bt) do { __builtin_amdgcn_s_setprio(1); _Pragma("unroll") for (int m = 0; m < 4; ++m) _Pragma("unroll") for (int n = 0; n < 2; ++n) _Pragma("unroll") for (int k = 0; k < 2; ++k) \
        acc[ai][bj][m][n] = __builtin_amdgcn_mfma_f32_16x16x32_bf16(Bt[n][k], At[m][k], acc[ai][bj][m][n], 0, 0, 0); __builtin_amdgcn_s_setprio(0); } while (0)
#define PG8_WAIT_V(n) asm volatile("s_waitcnt vmcnt(" #n ")" ::: "memory")
#define PG8_WAIT_L(n) asm volatile("s_waitcnt lgkmcnt(" #n ")" ::: "memory")
#define PG8_BAR __builtin_amdgcn_s_barrier()
#define PG8_SCHED __builtin_amdgcn_sched_barrier(0)
    Unit cur, nxt; int ui = 0;
    if (!S.next(0, cur)) return;
    f32x4 acc[2][2][4][2];
#pragma unroll
    for (int a = 0; a < 2; ++a)
#pragma unroll
        for (int b = 0; b < 2; ++b)
#pragma unroll
            for (int m = 0; m < 4; ++m)
#pragma unroll
                for (int n = 0; n < 2; ++n) acc[a][b][m][n] = (f32x4){0.f, 0.f, 0.f, 0.f};
    bf16x8 At[4][2], B0[2][2], B1[2][2];
    const char* cA = (const char*)g.A + (size_t)cur.pm * tstep; const char* cB = (const char*)g.Bt + (size_t)cur.pn * tstep;
    S.a_ready(cur);
    if constexpr (SP2) {
        PG8_STAGE(PG8_SB(0, 0), cB, voffB); PG8_STAGE(PG8_SB(0, 1), cB + hstep, voffB); PG8_STAGE(PG8_SA(0, 0), cA, voffA); PG8_STAGE(PG8_SA(0, 1), cA + hstep, voffA);
        if (wr == 1) PG8_BAR;
        PG8_WAIT_V(2); PG8_BAR;
        PG8_STAGE(PG8_SB(1, 0), cB + kstep, voffB); PG8_STAGE(PG8_SA(1, 0), cA + kstep, voffA); PG8_STAGE(PG8_SB(1, 1), cB + hstep + kstep, voffB);
        PG8_WAIT_V(6); PG8_BAR;
    } else {
        PG8_STAGE(PG8_SB(0, 0), cB, voffB); PG8_STAGE(PG8_SA(0, 0), cA, voffA); PG8_STAGE(PG8_SB(0, 1), cB + hstep, voffB); PG8_STAGE(PG8_SA(0, 1), cA + hstep, voffA);
        if (wr == 1) PG8_BAR;
        PG8_WAIT_V(4); PG8_BAR;
        PG8_STAGE(PG8_SB(1, 0), cB + kstep, voffB); PG8_STAGE(PG8_SA(1, 0), cA + kstep, voffA); PG8_STAGE(PG8_SB(1, 1), cB + hstep + kstep, voffB);
        PG8_WAIT_V(6); PG8_BAR;
    }
    for (;;) {
        const bool has_next = S.next(ui + 1, nxt);
        const char* nA = has_next ? (const char*)g.A + (size_t)nxt.pm * tstep : cA; const char* nB = has_next ? (const char*)g.Bt + (size_t)nxt.pn * tstep : cB;
        for (int t = 0; t < nt; t += 2) {
            const bool last = (t == nt - 2);
            const char* a1 = cA + (size_t)(t + 1) * kstep;
            const char* a2 = last ? nA : cA + (size_t)(t + 2) * kstep; const char* b2 = last ? nB : cB + (size_t)(t + 2) * kstep;
            const char* a3 = a2 + kstep; const char* b3 = b2 + kstep;
            if (last && has_next) S.a_ready(nxt);
            if constexpr (SP2) {
            PG8_LDB(B0, 0, 0); PG8_LDB(B1, 0, 1); PG8_SCHED; PG8_LDA(At, 0, 0); PG8_STAGE(PG8_SA(1, 1), a1 + hstep, voffA);
            PG8_WAIT_V(8); PG8_WAIT_L(0); PG8_BAR; PG8_MMA(0, 0, At, B0); PG8_MMA(0, 1, At, B1); PG8_BAR; PG8_SCHED;
            PG8_LDA(At, 0, 1); PG8_STAGE(PG8_SB(0, 0), b2, voffB); PG8_STAGE(PG8_SB(0, 1), b2 + hstep, voffB); PG8_STAGE(PG8_SA(0, 0), a2, voffA);
            PG8_WAIT_V(8); PG8_WAIT_L(0); PG8_BAR; PG8_MMA(1, 0, At, B0); PG8_MMA(1, 1, At, B1); PG8_BAR; PG8_SCHED;
            PG8_LDB(B0, 1, 0); PG8_LDB(B1, 1, 1); PG8_SCHED; PG8_LDA(At, 1, 0); PG8_STAGE(PG8_SA(0, 1), a2 + hstep, voffA);
            PG8_WAIT_V(8); PG8_WAIT_L(0); PG8_BAR; PG8_MMA(0, 0, At, B0); PG8_MMA(0, 1, At, B1); PG8_BAR; PG8_SCHED;
            PG8_LDA(At, 1, 1); PG8_STAGE(PG8_SB(1, 0), b3, voffB); PG8_STAGE(PG8_SB(1, 1), b3 + hstep, voffB); PG8_STAGE(PG8_SA(1, 0), a3, voffA);
            PG8_WAIT_V(8); PG8_WAIT_L(0); PG8_BAR; PG8_MMA(1, 0, At, B0); PG8_MMA(1, 1, At, B1); PG8_BAR; PG8_SCHED;
            } else {
            PG8_LDB(B0, 0, 0); PG8_SCHED; PG8_LDA(At, 0, 0); PG8_STAGE(PG8_SA(1, 1), a1 + hstep, voffA);
            PG8_WAIT_L(8); PG8_BAR; PG8_WAIT_L(0); PG8_MMA(0, 0, At, B0); PG8_BAR; PG8_SCHED;
            PG8_LDB(B1, 0, 1); PG8_STAGE(PG8_SB(0, 0), b2, voffB);
            PG8_BAR; PG8_WAIT_L(0); PG8_MMA(0, 1, At, B1); PG8_BAR;
            PG8_LDA(At, 0, 1); PG8_STAGE(PG8_SA(0, 0), a2, voffA);
            PG8_BAR; PG8_WAIT_L(0); PG8_MMA(1, 0, At, B0); PG8_BAR; PG8_SCHED;
            PG8_STAGE(PG8_SB(0, 1), b2 + hstep, voffB);
            PG8_WAIT_V(6); PG8_BAR; PG8_MMA(1, 1, At, B1); PG8_BAR;
            PG8_LDB(B0, 1, 0); PG8_SCHED; PG8_LDA(At, 1, 0); PG8_STAGE(PG8_SA(0, 1), a2 + hstep, voffA);
            PG8_WAIT_L(8); PG8_BAR; PG8_WAIT_L(0); PG8_MMA(0, 0, At, B0); PG8_BAR; PG8_SCHED;
            PG8_LDB(B1, 1, 1); PG8_STAGE(PG8_SB(1, 0), b3, voffB);
            PG8_BAR; PG8_WAIT_L(0); PG8_MMA(0, 1, At, B1); PG8_BAR;
            PG8_LDA(At, 1, 1); PG8_STAGE(PG8_SA(1, 0), a3, voffA);
            PG8_BAR; PG8_WAIT_L(0); PG8_MMA(1, 0, At, B0); PG8_BAR; PG8_SCHED;
            PG8_STAGE(PG8_SB(1, 1), b3 + hstep, voffB);
            PG8_WAIT_V(6); PG8_BAR; PG8_MMA(1, 1, At, B1); PG8_BAR;
            }
        }
        if constexpr (ALIGN_EPI) { if (wr == 0) PG8_BAR; }
        if constexpr (!Epi::AFTER_DRAIN) { E(acc, cur, wr, wc, fr, fq); S.done(cur); }
        if (!has_next) break;
#pragma unroll
        for (int a = 0; a < 2; ++a)
#pragma unroll
            for (int b = 0; b < 2; ++b)
#pragma unroll
                for (int m = 0; m < 4; ++m)
#pragma unroll
                    for (int n = 0; n < 2; ++n) acc[a][b][m][n] = (f32x4){0.f, 0.f, 0.f, 0.f};
        cur = nxt; cA = nA; cB = nB; ++ui;
        if constexpr (ALIGN_EPI) { if (wr == 1) PG8_BAR; }
    }
    PG8_WAIT_V(0);
    if constexpr (!ALIGN_EPI) { if (wr == 0) PG8_BAR; }
    PG8_BAR;
    if constexpr (Epi::AFTER_DRAIN) { E.fused(acc, cur, wr, wc, fr, fq, lds, wid, lane); S.done(cur); }
#undef PG8_SA
#undef PG8_SB
#undef PG8_STAGE
#undef PG8_LDA
#undef PG8_LDB
#undef PG8_MMA
#undef PG8_WAIT_V
#undef PG8_WAIT_L
#undef PG8_BAR
#undef PG8_SCHED
}
}

namespace pg8 {
constexpr float LOG2E = 1.4426950408889634f;
constexpr float QS_NSA = 0.125f * LOG2E;
constexpr float QS_MLA = 0.10206207261596575f * LOG2E;
__device__ __forceinline__ float fast_sigmoid(float x) { return __builtin_amdgcn_rcpf(1.0f + __builtin_amdgcn_exp2f(-LOG2E * x)); }
__device__ __forceinline__ float lo_bf(unsigned u) { return __uint_as_float(u << 16); }
__device__ __forceinline__ float hi_bf(unsigned u) { return __uint_as_float(u & 0xffff0000u); }
struct EpiInProjF {
    static constexpr bool PERM = true, AFTER_DRAIN = false;
    bf16_t* proj; bf16_t* gates;
    __device__ __forceinline__ void operator()(const f32x4 (&acc)[2][2][4][2], const Unit& u, int wr, int wc, int fr, int fq) const {
        const bool isg = u.pn >= 7;
        bf16_t* base = isg ? gates : proj; const int ld = isg ? 2048 : 1792; const int colt = isg ? (u.pn - 7) * BM : u.pn * BM;
        const float sc = (u.pn < 2) ? QS_NSA : 1.0f;
        const int row0 = u.pm * BM + wr * 64 + fr, col0 = colt + wc * 32 + 8 * fq;
#pragma unroll
        for (int ai = 0; ai < 2; ++ai)
#pragma unroll
            for (int m = 0; m < 4; ++m) { bf16_t* rowp = base + (size_t)(row0 + ai * HALF + m * 16) * ld + col0;
#pragma unroll
                for (int bj = 0; bj < 2; ++bj) { f32x4 v0 = acc[ai][bj][m][0], v1 = acc[ai][bj][m][1];
                    if (isg) {
#pragma unroll
                        for (int e = 0; e < 4; ++e) { v0[e] = fast_sigmoid(v0[e]); v1[e] = fast_sigmoid(v1[e]); } }
                    else { v0 = v0 * sc; v1 = v1 * sc; }
                    u32x4 w; w.x = cvt_pk_bf16(v0[0], v0[1]); w.y = cvt_pk_bf16(v0[2], v0[3]); w.z = cvt_pk_bf16(v1[0], v1[1]); w.w = cvt_pk_bf16(v1[2], v1[3]);
                    *(u32x4*)(rowp + bj * HALF) = w; } }
    }
};
template <int PASS> struct EpiMergeF {
    static constexpr bool PERM = true, AFTER_DRAIN = false;
    const bf16_t* gates; bf16_t* merged;
    __device__ __forceinline__ void operator()(const f32x4 (&acc)[2][2][4][2], const Unit& u, int wr, int wc, int fr, int fq) const {
        const int row0 = u.pm * BM + wr * 64 + fr, col0 = u.pn * BM + wc * 32 + 8 * fq;
#pragma unroll
        for (int ai = 0; ai < 2; ++ai)
#pragma unroll
            for (int m = 0; m < 4; ++m) { const size_t r = (size_t)(row0 + ai * HALF + m * 16);
#pragma unroll
                for (int bj = 0; bj < 2; ++bj) { const int c = col0 + bj * HALF;
                    const u32x4 g = *(const u32x4*)(gates + r * 2048 + PASS * 1024 + c);
                    f32x4 v0 = acc[ai][bj][m][0], v1 = acc[ai][bj][m][1];
                    v0[0] *= lo_bf(g.x); v0[1] *= hi_bf(g.x); v0[2] *= lo_bf(g.y); v0[3] *= hi_bf(g.y);
                    v1[0] *= lo_bf(g.z); v1[1] *= hi_bf(g.z); v1[2] *= lo_bf(g.w); v1[3] *= hi_bf(g.w);
                    if (PASS == 1) { const u32x4 o = *(const u32x4*)(merged + r * 1024 + c);
                        v0[0] += lo_bf(o.x); v0[1] += hi_bf(o.x); v0[2] += lo_bf(o.y); v0[3] += hi_bf(o.y);
                        v1[0] += lo_bf(o.z); v1[1] += hi_bf(o.z); v1[2] += lo_bf(o.w); v1[3] += hi_bf(o.w); }
                    u32x4 w; w.x = cvt_pk_bf16(v0[0], v0[1]); w.y = cvt_pk_bf16(v0[2], v0[3]); w.z = cvt_pk_bf16(v1[0], v1[1]); w.w = cvt_pk_bf16(v1[2], v1[3]);
                    *(u32x4*)(merged + r * 1024 + c) = w; } }
    }
};
struct EpiResidF {
    static constexpr bool PERM = false, AFTER_DRAIN = false;
    const float* x; float* h;
    __device__ __forceinline__ void operator()(const f32x4 (&acc)[2][2][4][2], const Unit& u, int wr, int wc, int fr, int fq) const {
        const int row0 = u.pm * BM + wr * 64 + fr, col0 = u.pn * BM + wc * 32 + 4 * fq;
#pragma unroll
        for (int ai = 0; ai < 2; ++ai)
#pragma unroll
            for (int m = 0; m < 4; ++m) { const size_t off = (size_t)(row0 + ai * HALF + m * 16) * 1024 + col0;
#pragma unroll
                for (int bj = 0; bj < 2; ++bj)
#pragma unroll
                    for (int n = 0; n < 2; ++n) { const f32x4 xv = *(const f32x4*)(x + off + bj * HALF + n * 16); *(f32x4*)(h + off + bj * HALF + n * 16) = xv + acc[ai][bj][m][n]; } }
    }
};
struct EpiMlaQF {
    static constexpr bool PERM = false, AFTER_DRAIN = false;
    bf16_t* q; const float2* cs;
    __device__ __forceinline__ void operator()(const f32x4 (&acc)[2][2][4][2], const Unit& u, int wr, int wc, int fr, int fq) const {
        const int row0 = u.pm * BM + wr * 64 + fr;
#pragma unroll
        for (int bj = 0; bj < 2; ++bj) {
            const int X = u.pn * BM + bj * HALF + wc * 32;
            const bool rope = (X % 96) == 64;
#pragma unroll
            for (int ai = 0; ai < 2; ++ai)
#pragma unroll
                for (int m = 0; m < 4; ++m) { const int r = row0 + ai * HALF + m * 16; const int pos = r & (SEQ - 1);
                    f32x4 v0 = acc[ai][bj][m][0], v1 = acc[ai][bj][m][1];
                    if (rope) {
#pragma unroll
                        for (int j = 0; j < 4; ++j) { const float2 c = cs[pos * 16 + 4 * fq + j]; const float x1 = v0[j], x2 = v1[j]; v0[j] = x1 * c.x - x2 * c.y; v1[j] = x2 * c.x + x1 * c.y; } }
                    v0 = v0 * QS_MLA; v1 = v1 * QS_MLA;
                    bf16_t* p = q + (size_t)r * 768 + X + 4 * fq;
                    uint2 w0, w1; w0.x = cvt_pk_bf16(v0[0], v0[1]); w0.y = cvt_pk_bf16(v0[2], v0[3]); w1.x = cvt_pk_bf16(v1[0], v1[1]); w1.y = cvt_pk_bf16(v1[2], v1[3]);
                    *(uint2*)p = w0; *(uint2*)(p + 16) = w1; }
        }
    }
};
}

#define PG8_SP2 true
#define PG8_ALIGN true
constexpr int NTHR = 512, NWV = NTHR / 64;
#define WAVE_IDS const int lane = threadIdx.x & 63, wv = threadIdx.x >> 6; const int gw = blockIdx.x * NWV + wv, nw = gridDim.x * NWV; (void)lane; (void)gw; (void)nw;

DEV void ph_rms1024(const float* __restrict__ src, const float* __restrict__ g, bf16_t* __restrict__ dst, int rows) {
  WAVE_IDS
  for (int r = gw; r < rows; r += nw) {
    const float4* s4 = (const float4*)(src + (size_t)r * 1024);
    float4 v[4]; float ss = 0.f;
#pragma unroll
    for (int j = 0; j < 4; ++j) { v[j] = s4[j * 64 + lane]; ss += v[j].x * v[j].x + v[j].y * v[j].y + v[j].z * v[j].z + v[j].w * v[j].w; }
    ss = wsum(ss);
    const float inv = rsqrtf(ss * (1.0f / 1024.0f) + 1e-6f);
#pragma unroll
    for (int j = 0; j < 4; ++j) {
      const float4 gg = ((const float4*)g)[j * 64 + lane];
      uint2 o;
      o.x = (unsigned)f2bf(v[j].x * inv * gg.x) | ((unsigned)f2bf(v[j].y * inv * gg.y) << 16);
      o.y = (unsigned)f2bf(v[j].z * inv * gg.z) | ((unsigned)f2bf(v[j].w * inv * gg.w) << 16);
      ((uint2*)(dst + (size_t)r * 1024))[j * 64 + lane] = o;
    }
  }
}
template <int PER> DEV void ph_rms_cols(const bf16_t* __restrict__ proj, int col0, const float* __restrict__ g, bf16_t* __restrict__ dst) {
  WAVE_IDS
  constexpr int W = 64 * PER;
  for (int r = gw; r < T; r += nw) {
    float v[PER]; float ss = 0.f;
#pragma unroll
    for (int j = 0; j < PER; ++j) { v[j] = bf2f(proj[(size_t)r * PROJ_LD + col0 + j * 64 + lane]); ss += v[j] * v[j]; }
    ss = wsum(ss);
    const float inv = rsqrtf(ss * (1.0f / W) + 1e-6f);
#pragma unroll
    for (int j = 0; j < PER; ++j) dst[(size_t)r * W + j * 64 + lane] = f2bf(v[j] * inv * g[j * 64 + lane]);
  }
}

DEV int win_src_col(int n) {
  if (n < 1280) return n;
  if (n < 1536) return 1304 + (n - 1280);
  if (n < 1664) return 1560 + (n - 1536);
  if (n < 1696) return 1688 + (n - 1664);
  if (n < 1720) return 1280 + (n - 1696);
  if (n < 1792) return -1;
  return 1720 + (n - 1792);
}
template <int MODE> DEV void ph_convT(const float* __restrict__ W, int K, int Nsrc, bf16_t* __restrict__ WT, int Nout, char* lds) {
  float (*t)[33] = (float (*)[33])lds;
  const int tx = threadIdx.x & 31, ty = threadIdx.x >> 5;
  const int ntn = (Nout + 31) / 32, ntk = K / 32;
  for (int tile = blockIdx.x; tile < ntn * ntk; tile += gridDim.x) {
    const int n0 = (tile % ntn) * 32, k0 = (tile / ntn) * 32;
#pragma unroll
    for (int i = 0; i < 2; ++i) {
      const int k = k0 + ty + 16 * i, n = n0 + tx;
      const int sc = (MODE == 1) ? win_src_col(n) : n;
      t[ty + 16 * i][tx] = (n < Nout && sc >= 0) ? W[(size_t)k * Nsrc + sc] : 0.f;
    }
    __syncthreads();
#pragma unroll
    for (int i = 0; i < 2; ++i) {
      const int n = n0 + ty + 16 * i, k = k0 + tx;
      if (n < Nout) WT[(size_t)n * K + k] = f2bf(t[tx][ty + 16 * i]);
    }
    __syncthreads();
  }
}
DEV void ph_conv_plain(const float* __restrict__ src, bf16_t* __restrict__ dst, int n) {
  for (int i = blockIdx.x * NTHR + threadIdx.x; i < n; i += gridDim.x * NTHR) dst[i] = f2bf(src[i]);
}

DEV void gemm_tile(const bf16_t* __restrict__ A, int lda, const bf16_t* __restrict__ Bt, int ldb, int m0, int n0, int K, float (&acc)[4][4], char* lds) {
  float (*sA)[132] = (float (*)[132])lds;
  float (*sB)[68] = (float (*)[68])(lds + 32 * 132 * 4);
  const int tid = threadIdx.x, ty = tid >> 4, tx = tid & 15;
  const int lr = tid >> 2, lk = (tid & 3) * 8;
  for (int k0 = 0; k0 < K; k0 += 32) {
    {
      const uint4 va = *(const uint4*)(A + (size_t)(m0 + lr) * lda + k0 + lk);
      const unsigned ua[4] = {va.x, va.y, va.z, va.w};
#pragma unroll
      for (int j = 0; j < 4; ++j) { sA[lk + 2 * j][lr] = __uint_as_float(ua[j] << 16); sA[lk + 2 * j + 1][lr] = __uint_as_float(ua[j] & 0xffff0000u); }
    }
    if (tid < 256) {
      const uint4 vb = *(const uint4*)(Bt + (size_t)(n0 + lr) * ldb + k0 + lk);
      const unsigned ub[4] = {vb.x, vb.y, vb.z, vb.w};
#pragma unroll
      for (int j = 0; j < 4; ++j) { sB[lk + 2 * j][lr] = __uint_as_float(ub[j] << 16); sB[lk + 2 * j + 1][lr] = __uint_as_float(ub[j] & 0xffff0000u); }
    }
    __syncthreads();
#pragma unroll 8
    for (int k = 0; k < 32; ++k) {
      const float4 a = *(const float4*)&sA[k][ty * 4];
      const float4 b = *(const float4*)&sB[k][tx * 4];
      const float av[4] = {a.x, a.y, a.z, a.w}, bv[4] = {b.x, b.y, b.z, b.w};
#pragma unroll
      for (int i = 0; i < 4; ++i)
#pragma unroll
        for (int j = 0; j < 4; ++j) acc[i][j] += av[i] * bv[j];
    }
    __syncthreads();
  }
}
struct EpiInProj { bf16_t* proj; bf16_t* gates;
  DEV void operator()(int m, int n, float v) const { if (n < PROJ_LD) proj[(size_t)m * PROJ_LD + n] = f2bf(v); else gates[(size_t)m * 2048 + (n - PROJ_LD)] = f2bf(sigmoidf_(v)); } };
struct EpiStore { bf16_t* dst; int ld;
  DEV void operator()(int m, int n, float v) const { dst[(size_t)m * ld + n] = f2bf(v); } };
struct EpiGelu { bf16_t* dst; int ld;
  DEV void operator()(int m, int n, float v) const { dst[(size_t)m * ld + n] = f2bf(gelu_exact(v)); } };
struct EpiCmpOut { bf16_t* dst;
  DEV void operator()(int m, int n, float v) const { if (m >= BATCH * NC * 2) return; const int g = m & 1, bc = m >> 1, b = bc / NC, c = bc % NC; dst[((size_t)(b * 2 + g) * 128 + c) * 64 + n] = f2bf(v); } };
struct EpiResid { const float* x; float* h;
  DEV void operator()(int m, int n, float v) const { const size_t i = (size_t)m * 1024 + n; h[i] = x[i] + v; } };

template <class Epi> DEV void ph_gemm(const bf16_t* A, int lda, const bf16_t* Bt, int ldb, int M, int N, int K, const Epi& epi, char* lds) {
  const int ntn = N / 64, ntm = M / 128;
  const int ty = threadIdx.x >> 4, tx = threadIdx.x & 15;
  for (int tile = blockIdx.x; tile < ntn * ntm; tile += gridDim.x) {
    const int m0 = (tile / ntn) * 128, n0 = (tile % ntn) * 64;
    float acc[4][4];
#pragma unroll
    for (int i = 0; i < 4; ++i)
#pragma unroll
      for (int j = 0; j < 4; ++j) acc[i][j] = 0.f;
    gemm_tile(A, lda, Bt, ldb, m0, n0, K, acc, lds);
#pragma unroll
    for (int i = 0; i < 4; ++i)
#pragma unroll
      for (int j = 0; j < 4; ++j) epi(m0 + ty * 4 + i, n0 + tx * 4 + j, acc[i][j]);
  }
}
DEV void ph_merge(const bf16_t* onsa, const bf16_t* omla, const bf16_t* wbn, const bf16_t* wbm, const bf16_t* gates, bf16_t* merged, char* lds) {
  const int ntn = 1024 / 64, ntm = T / 128;
  const int ty = threadIdx.x >> 4, tx = threadIdx.x & 15;
  for (int tile = blockIdx.x; tile < ntn * ntm; tile += gridDim.x) {
    const int m0 = (tile / ntn) * 128, n0 = (tile % ntn) * 64;
    float a1[4][4], a2[4][4];
#pragma unroll
    for (int i = 0; i < 4; ++i)
#pragma unroll
      for (int j = 0; j < 4; ++j) { a1[i][j] = 0.f; a2[i][j] = 0.f; }
    gemm_tile(onsa, 512, wbn, 512, m0, n0, 512, a1, lds);
    gemm_tile(omla, 512, wbm, 512, m0, n0, 512, a2, lds);
#pragma unroll
    for (int i = 0; i < 4; ++i)
#pragma unroll
      for (int j = 0; j < 4; ++j) {
        const int m = m0 + ty * 4 + i, n = n0 + tx * 4 + j;
        merged[(size_t)m * 1024 + n] = f2bf(bf2f(gates[(size_t)m * 2048 + n]) * a1[i][j] + bf2f(gates[(size_t)m * 2048 + 1024 + n]) * a2[i][j]);
      }
  }
}

DEV void ph_rope_table(float2* __restrict__ cs) {
  const int n = SEQ * 16;
  for (int i = blockIdx.x * NTHR + threadIdx.x; i < n; i += gridDim.x * NTHR) {
    const int j = i & 15, pos = i >> 4;
    const float inv_freq = powf(10000.0f, -(float)(2 * j) / 32.0f);
    const float ang = (float)pos * inv_freq;
    cs[i] = make_float2(cosf(ang), sinf(ang));
  }
}
DEV void ph_rope_k(const bf16_t* __restrict__ proj, bf16_t* __restrict__ kr) {
  const int n = T * 16;
  for (int i = blockIdx.x * NTHR + threadIdx.x; i < n; i += gridDim.x * NTHR) {
    const int j = i & 15, t = i >> 4;
    const float pos = (float)(t & (SEQ - 1));
    const float inv_freq = powf(10000.0f, -(float)(2 * j) / 32.0f);
    const float ang = pos * inv_freq, c = cosf(ang), s = sinf(ang);
    const float x1 = bf2f(proj[(size_t)t * PROJ_LD + PC_KR + j]), x2 = bf2f(proj[(size_t)t * PROJ_LD + PC_KR + 16 + j]);
    kr[(size_t)t * 32 + j] = f2bf(x1 * c - x2 * s); kr[(size_t)t * 32 + 16 + j] = f2bf(x2 * c + x1 * s);
  }
}
DEV void ph_cmp_gather(const bf16_t* __restrict__ proj, const float* __restrict__ pos, int which, bf16_t* __restrict__ ca) {
  const int n = 2048 * 2048;
  for (int i = blockIdx.x * NTHR + threadIdx.x; i < n; i += gridDim.x * NTHR) {
    const int e = i & 2047, row = i >> 11;
    float v = 0.f;
    if (row < BATCH * NC * 2) {
      const int g = row & 1, bc = row >> 1, b = bc / NC, c = bc % NC, l = e >> 6, d = e & 63;
      v = bf2f(proj[(size_t)(b * SEQ + 16 * c + l) * PROJ_LD + PC_KV + which * 128 + g * 64 + d]) + pos[e];
    }
    ca[i] = f2bf(v);
  }
}

DEV void ph_cmp_attn(const bf16_t* __restrict__ proj, const bf16_t* __restrict__ kc, const bf16_t* __restrict__ vc,
                     const float* __restrict__ t5, bf16_t* __restrict__ ocmp, unsigned* __restrict__ sel, char* lds) {
  WAVE_IDS
  float* P = (float*)(lds + wv * 1024); float* Q = P + 128;
  for (int item = gw; item < BATCH * 2 * SEQ; item += nw) {
    const int t = item & (SEQ - 1), bg = item >> 11, g = bg & 1, b = bg >> 1;
    const size_t tok = (size_t)b * SEQ + t;
    const int nvalid = (t >= 31) ? min(NC, (t - 31) / 16 + 1) : 0;
    const bf16_t* kcb = kc + (size_t)bg * 128 * 64;
    const bf16_t* vcb = vc + (size_t)bg * 128 * 64;
    float impacc = 0.f;
    for (int r = 0; r < 4; ++r) {
      const int head = g * 4 + r;
      Q[lane] = bf2f(proj[tok * PROJ_LD + PC_Q + head * 64 + lane]);
      wave_lds_sync();
      float lg[2];
#pragma unroll
      for (int u = 0; u < 2; ++u) {
        const int c = lane + 64 * u;
        float d = 0.f;
        if (c < nvalid) { const bf16_t* kr = kcb + c * 64; for (int e = 0; e < 64; ++e) d += Q[e] * bf2f(kr[e]); }
        lg[u] = (c < nvalid) ? d + 1.4426950408889634f * t5bias(t5, head, t - (16 * c + 31)) : -1e30f;
      }
      const float m = wmaxf(fmaxf(lg[0], lg[1]));
      const float e0 = (lane < nvalid) ? exp2f(lg[0] - m) : 0.f, e1 = (lane + 64 < nvalid) ? exp2f(lg[1] - m) : 0.f;
      const float s = wsum(e0 + e1);
      const float inv = (nvalid > 0) ? 1.0f / fmaxf(s, 1e-30f) : 0.f;
      P[lane] = e0 * inv; P[lane + 64] = e1 * inv;
      wave_lds_sync();
      float o = 0.f;
      for (int c = 0; c < nvalid; ++c) o += P[c] * bf2f(vcb[c * 64 + lane]);
      ocmp[tok * 512 + head * 64 + lane] = f2bf(o);
      if (lane < 32) { for (int c = 4 * lane - 1; c <= 4 * lane + 3; ++c) if (c >= 0 && c < NC) impacc += P[c]; }
      wave_lds_sync();
    }
    const int cur = t >> 6, n = lane;
    float score = (n > cur) ? -1.0f : ((n == 0 || n == cur || n == cur - 1) ? 1e4f : impacc);
    if (n >= 32) score = -2.0f;
    int rank = 0;
    for (int mth = 0; mth < 32; ++mth) { const float sm = __shfl(score, mth); rank += (sm > score || (sm == score && mth < n)) ? 1 : 0; }
    const unsigned long long bal = __ballot(n < 32 && rank < 16);
    if (lane == 0) sel[item] = (unsigned)bal;
  }
}

DEV void ph_nsa_attn(const bf16_t* __restrict__ proj, const float* __restrict__ t5, const bf16_t* __restrict__ ocmp,
                     const unsigned* __restrict__ sel, bf16_t* __restrict__ onsa, char* lds) {
  WAVE_IDS
  float* P = (float*)(lds + wv * 1024); float* Q = P + 128;
  for (int item = gw; item < BATCH * 2 * SEQ * 4; item += nw) {
    const int r = item & 3, t = (item >> 2) & (SEQ - 1), bg = item >> 13, g = bg & 1, b = bg >> 1;
    const int head = g * 4 + r, cur = t >> 6;
    const size_t tok = (size_t)b * SEQ + t;
    Q[lane] = bf2f(proj[tok * PROJ_LD + PC_Q + head * 64 + lane]);
    wave_lds_sync();
    const unsigned smask = sel[bg * SEQ + t];
    float res0 = 0.f, res1 = 0.f;
    for (int br = 0; br < 2; ++br) {
      float m = -1e30f, l = 0.f, o = 0.f;
      const int nb0 = (br == 0) ? 0 : max(0, cur - 8);
      for (int nb = nb0; nb <= cur; ++nb) {
        if (br == 0 && !((smask >> nb) & 1u)) continue;
        const int s = nb * 64 + lane, dist = t - s;
        const bool valid = (dist >= 0) && (br == 0 || dist < 512);
        const bf16_t* kp = proj + ((size_t)b * SEQ + s) * PROJ_LD + PC_KV + (2 + 2 * br) * 128 + g * 64;
        float d = 0.f;
        for (int e = 0; e < 64; e += 8) {
          const uint4 kv = *(const uint4*)(kp + e);
          d += Q[e + 0] * __uint_as_float(kv.x << 16) + Q[e + 1] * __uint_as_float(kv.x & 0xffff0000u);
          d += Q[e + 2] * __uint_as_float(kv.y << 16) + Q[e + 3] * __uint_as_float(kv.y & 0xffff0000u);
          d += Q[e + 4] * __uint_as_float(kv.z << 16) + Q[e + 5] * __uint_as_float(kv.z & 0xffff0000u);
          d += Q[e + 6] * __uint_as_float(kv.w << 16) + Q[e + 7] * __uint_as_float(kv.w & 0xffff0000u);
        }
        const float lg = valid ? d + 1.4426950408889634f * t5bias(t5, head, dist) : -1e30f;
        const float mn = fmaxf(m, wmaxf(lg));
        const float sc = exp2f(m - mn);
        const float pe = valid ? exp2f(lg - mn) : 0.f;
        l = l * sc + wsum(pe); m = mn;
        P[lane] = pe;
        wave_lds_sync();
        const bf16_t* vp = proj + ((size_t)b * SEQ + nb * 64) * PROJ_LD + PC_KV + (3 + 2 * br) * 128 + g * 64 + lane;
        float acc = 0.f;
        for (int k = 0; k < 64; ++k) acc += P[k] * bf2f(vp[(size_t)k * PROJ_LD]);
        o = o * sc + acc;
        wave_lds_sync();
      }
      if (br == 0) res0 = o / fmaxf(l, 1e-30f); else res1 = o / fmaxf(l, 1e-30f);
    }
    const bf16_t* gp = proj + tok * PROJ_LD + PC_GATE + head * 3;
    const float g0 = sigmoidf_(bf2f(gp[0])), g1 = sigmoidf_(bf2f(gp[1])), g2 = sigmoidf_(bf2f(gp[2]));
    const float oc = bf2f(ocmp[tok * 512 + head * 64 + lane]);
    onsa[tok * 512 + head * 64 + lane] = f2bf(g0 * oc + g1 * res0 + g2 * res1);
    wave_lds_sync();
  }
}

DEV void ph_mla_attn(const bf16_t* __restrict__ mq, const bf16_t* __restrict__ mkv, const bf16_t* __restrict__ kr, bf16_t* __restrict__ omla, char* lds) {
  WAVE_IDS
  float* P = (float*)(lds + wv * 1024); float* Q = P + 128;
  for (int item = gw; item < BATCH * 8 * SEQ; item += nw) {
    const int h = item & 7, t = (item >> 3) & (SEQ - 1), b = item >> 14;
    const size_t tok = (size_t)b * SEQ + t;
    Q[lane] = bf2f(mq[tok * 768 + h * 96 + lane]);
    if (lane < 32) Q[64 + lane] = bf2f(mq[tok * 768 + h * 96 + 64 + lane]);
    wave_lds_sync();
    float m = -1e30f, l = 0.f, o = 0.f;
    for (int nb = 0; nb <= (t >> 6); ++nb) {
      const int s = nb * 64 + lane;
      const bool valid = s <= t;
      const bf16_t* kp = mkv + ((size_t)b * SEQ + s) * 1024 + h * 128;
      const bf16_t* rp = kr + ((size_t)b * SEQ + s) * 32;
      float d = 0.f;
      for (int e = 0; e < 64; e += 8) {
        const uint4 kv = *(const uint4*)(kp + e);
        d += Q[e + 0] * __uint_as_float(kv.x << 16) + Q[e + 1] * __uint_as_float(kv.x & 0xffff0000u);
        d += Q[e + 2] * __uint_as_float(kv.y << 16) + Q[e + 3] * __uint_as_float(kv.y & 0xffff0000u);
        d += Q[e + 4] * __uint_as_float(kv.z << 16) + Q[e + 5] * __uint_as_float(kv.z & 0xffff0000u);
        d += Q[e + 6] * __uint_as_float(kv.w << 16) + Q[e + 7] * __uint_as_float(kv.w & 0xffff0000u);
      }
      for (int e = 0; e < 32; e += 8) {
        const uint4 kv = *(const uint4*)(rp + e);
        d += Q[64 + e + 0] * __uint_as_float(kv.x << 16) + Q[64 + e + 1] * __uint_as_float(kv.x & 0xffff0000u);
        d += Q[64 + e + 2] * __uint_as_float(kv.y << 16) + Q[64 + e + 3] * __uint_as_float(kv.y & 0xffff0000u);
        d += Q[64 + e + 4] * __uint_as_float(kv.z << 16) + Q[64 + e + 5] * __uint_as_float(kv.z & 0xffff0000u);
        d += Q[64 + e + 6] * __uint_as_float(kv.w << 16) + Q[64 + e + 7] * __uint_as_float(kv.w & 0xffff0000u);
      }
      const float lg = valid ? d : -1e30f;
      const float mn = fmaxf(m, wmaxf(lg));
      const float sc = exp2f(m - mn);
      const float pe = valid ? exp2f(lg - mn) : 0.f;
      l = l * sc + wsum(pe); m = mn;
      P[lane] = pe;
      wave_lds_sync();
      const bf16_t* vp = mkv + ((size_t)b * SEQ + nb * 64) * 1024 + h * 128 + 64 + lane;
      float acc = 0.f;
      for (int k = 0; k < 64; ++k) acc += P[k] * bf2f(vp[(size_t)k * 1024]);
      o = o * sc + acc;
      wave_lds_sync();
    }
    omla[tok * 512 + h * 64 + lane] = f2bf(o / fmaxf(l, 1e-30f));
    wave_lds_sync();
  }
}

DEV void wave_argmax(float& v, int& idx) {
#pragma unroll
  for (int o = 32; o > 0; o >>= 1) {
    const float ov = __shfl_xor(v, o); const int oi = __shfl_xor(idx, o);
    if (ov > v || (ov == v && oi < idx)) { v = ov; idx = oi; }
  }
}
DEV void ph_route(const bf16_t* __restrict__ pq, const bf16_t* __restrict__ subk, int* __restrict__ pidx, float* __restrict__ pw, char* lds) {
  WAVE_IDS
  float* Q = (float*)(lds + wv * 1024);
  float* TS = Q + 128;
  int* TI = (int*)(TS + 32);
  for (int item = gw; item < T * 8; item += nw) {
    const int h = item & 7, t = item >> 3;
    Q[lane] = bf2f(pq[(size_t)t * 1024 + h * 128 + lane]);
    Q[lane + 64] = bf2f(pq[(size_t)t * 1024 + h * 128 + 64 + lane]);
    wave_lds_sync();
    for (int p = 0; p < 2; ++p) {
      const bf16_t* kb = subk + (size_t)((h * 2 + p) * 128) * 64;
      float s0 = 0.f, s1 = 0.f;
      for (int e = 0; e < 64; ++e) { const float qv = Q[p * 64 + e]; s0 += qv * bf2f(kb[lane * 64 + e]); s1 += qv * bf2f(kb[(lane + 64) * 64 + e]); }
      for (int k = 0; k < 16; ++k) {
        float v = (s0 >= s1) ? s0 : s1; int idx = (s0 >= s1) ? lane : lane + 64;
        wave_argmax(v, idx);
        if (lane == 0) { TS[p * 16 + k] = v; TI[p * 16 + k] = idx; }
        if (idx == lane) s0 = -3e38f;
        if (idx == lane + 64) s1 = -3e38f;
      }
    }
    wave_lds_sync();
    float cv[4];
#pragma unroll
    for (int u = 0; u < 4; ++u) { const int f = lane + 64 * u; cv[u] = TS[f >> 4] + TS[16 + (f & 15)]; }
    int myexp = 0; float mybest = 0.f, best0 = 0.f, den = 0.f;
#pragma unroll
    for (int k = 0; k < 16; ++k) {
      float v = cv[0]; int idx = lane;
#pragma unroll
      for (int u = 1; u < 4; ++u) if (cv[u] > v) { v = cv[u]; idx = lane + 64 * u; }
      wave_argmax(v, idx);
#pragma unroll
      for (int u = 0; u < 4; ++u) if (idx == lane + 64 * u) cv[u] = -3e38f;
      if (k == 0) best0 = v;
      den += expf(v - best0);
      if (lane == k) { myexp = TI[idx >> 4] * 128 + TI[16 + (idx & 15)]; mybest = v; }
    }
    if (lane < 16) { pidx[(size_t)t * 128 + h * 16 + lane] = myexp; pw[(size_t)t * 128 + h * 16 + lane] = expf(mybest - best0) / den; }
    wave_lds_sync();
  }
}

DEV void ph_experts(const bf16_t* __restrict__ hn, const int* __restrict__ pidx, const float* __restrict__ pw,
                    const float* __restrict__ pu, const float* __restrict__ pv, const float* __restrict__ gfin, float* __restrict__ out) {
  WAVE_IDS
  for (int t = gw; t < T; t += nw) {
    float4 x[4], y[4];
#pragma unroll
    for (int j = 0; j < 4; ++j) {
      const uint2 r = ((const uint2*)(hn + (size_t)t * 1024))[j * 64 + lane];
      x[j] = make_float4(__uint_as_float(r.x << 16), __uint_as_float(r.x & 0xffff0000u), __uint_as_float(r.y << 16), __uint_as_float(r.y & 0xffff0000u));
      y[j] = make_float4(0.f, 0.f, 0.f, 0.f);
    }
    const int e0 = pidx[(size_t)t * 128 + lane], e1 = pidx[(size_t)t * 128 + 64 + lane];
    const float w0 = pw[(size_t)t * 128 + lane], w1 = pw[(size_t)t * 128 + 64 + lane];
    for (int s = 0; s < 128; ++s) {
      const int e = __shfl((s < 64) ? e0 : e1, s & 63);
      const float w = __shfl((s < 64) ? w0 : w1, s & 63);
      const float4* ur = (const float4*)(pu + (size_t)e * 1024);
      float d = 0.f;
#pragma unroll
      for (int j = 0; j < 4; ++j) { const float4 u = ur[j * 64 + lane]; d += u.x * x[j].x + u.y * x[j].y + u.z * x[j].z + u.w * x[j].w; }
      d = wsum(d);
      const float c = w * gelu_exact(d);
      const float4* vr = (const float4*)(pv + (size_t)e * 1024);
#pragma unroll
      for (int j = 0; j < 4; ++j) { const float4 v = vr[j * 64 + lane]; y[j].x += c * v.x; y[j].y += c * v.y; y[j].z += c * v.z; y[j].w += c * v.w; }
    }
    float4* o4 = (float4*)(out + (size_t)t * 1024);
    float ss = 0.f;
#pragma unroll
    for (int j = 0; j < 4; ++j) {
      const float4 hv = o4[j * 64 + lane];
      y[j].x += hv.x; y[j].y += hv.y; y[j].z += hv.z; y[j].w += hv.w;
      ss += y[j].x * y[j].x + y[j].y * y[j].y + y[j].z * y[j].z + y[j].w * y[j].w;
    }
    ss = wsum(ss);
    const float inv = rsqrtf(ss * (1.0f / 1024.0f) + 1e-6f);
#pragma unroll
    for (int j = 0; j < 4; ++j) {
      const float4 gg = ((const float4*)gfin)[j * 64 + lane];
      o4[j * 64 + lane] = make_float4(y[j].x * inv * gg.x, y[j].y * inv * gg.y, y[j].z * inv * gg.z, y[j].w * inv * gg.w);
    }
  }
}


namespace att {
#define LAS3 __attribute__((address_space(3)))
typedef LAS3 char* lptr;
typedef LAS3 const char* lcptr;
using bf16x8 = __attribute__((ext_vector_type(8))) short;
using s16x4 = __attribute__((ext_vector_type(4))) short;
using f32x16 = __attribute__((ext_vector_type(16))) float;
typedef short v4i16_t __attribute__((ext_vector_type(4)));
typedef unsigned u32x4 __attribute__((ext_vector_type(4)));
typedef float f32x4_t __attribute__((ext_vector_type(4)));
typedef float f32x2_t __attribute__((ext_vector_type(2)));
typedef __bf16 bf16x2_t __attribute__((ext_vector_type(2)));
constexpr float LOG2E = 1.4426950408889634f;
constexpr float THR = 6.0f;
constexpr float NEG_INF = -__builtin_huge_valf();
constexpr int SLOT = 20480, KOFF = 0, VOFF = 12288;
constexpr int L_WSF = 2 * SLOT;
constexpr int L_TB = L_WSF + 2048;
constexpr int L_SELM = L_TB + 4096;
constexpr int L_SC = L_SELM + 256;
constexpr int L_IMPQ = L_SC + 64 * 33 * 4;
constexpr int L_IMPL = L_IMPQ + 4 * 64 * 33 * 4;
constexpr int L_FIN = L_IMPQ;
constexpr int L_END = L_IMPL + 4 * 64 * 33 * 4;
static_assert(L_END <= 131072, "attention LDS map");

__device__ __forceinline__ int crow(int r, int hi) { return (r & 3) + 8 * (r >> 2) + 4 * hi; }
__device__ __forceinline__ s16x4 vtr(lcptr p) { return __builtin_bit_cast(s16x4, __builtin_amdgcn_ds_read_tr16_b64_v4i16((LAS3 v4i16_t*)p)); }
__device__ __forceinline__ unsigned cvtpk(float lo, float hi) { f32x2_t v = {lo, hi}; bf16x2_t b = __builtin_convertvector(v, bf16x2_t); return __builtin_bit_cast(unsigned, b); }
__device__ __forceinline__ float xmax(float v) { auto rr = __builtin_amdgcn_permlane32_swap(__float_as_uint(v), __float_as_uint(v), false, false); return fmaxf(__uint_as_float(rr[0]), __uint_as_float(rr[1])); }
__device__ __forceinline__ float xsum(float v) { auto rr = __builtin_amdgcn_permlane32_swap(__float_as_uint(v), __float_as_uint(v), false, false); return __uint_as_float(rr[0]) + __uint_as_float(rr[1]); }
__device__ __forceinline__ float ex2(float x) { return __builtin_amdgcn_exp2f(x); }

template <int ND0> __device__ __forceinline__ void qkt(f32x16& p0, f32x16& p1, lcptr kb, const bf16x8* qr) {
  p0 = f32x16{}; p1 = f32x16{};
#pragma unroll
  for (int d0 = 0; d0 < ND0; ++d0) {
    const bf16x8 b0 = *(const LAS3 bf16x8*)(kb + d0 * 2048);
    const bf16x8 b1 = *(const LAS3 bf16x8*)(kb + d0 * 2048 + 512);
    p0 = __builtin_amdgcn_mfma_f32_32x32x16_bf16(b0, qr[d0], p0, 0, 0, 0);
    p1 = __builtin_amdgcn_mfma_f32_32x32x16_bf16(b1, qr[d0], p1, 0, 0, 0);
  }
}
__device__ __forceinline__ void pv(f32x16 (&o)[2], lcptr vp, const unsigned (&pw)[16]) {
#pragma unroll
  for (int d0 = 0; d0 < 2; ++d0)
#pragma unroll
    for (int ks = 0; ks < 4; ++ks) {
      const s16x4 lo = vtr(vp + d0 * 4096 + ks * 1024), hi4 = vtr(vp + d0 * 4096 + ks * 1024 + 512);
      const bf16x8 vf = {lo[0], lo[1], lo[2], lo[3], hi4[0], hi4[1], hi4[2], hi4[3]};
      const unsigned pa4[4] = {pw[4 * ks], pw[4 * ks + 1], pw[4 * ks + 2], pw[4 * ks + 3]};
      o[d0] = __builtin_amdgcn_mfma_f32_32x32x16_bf16(__builtin_bit_cast(bf16x8, pa4), vf, o[d0], 0, 0, 0);
    }
}
__device__ __forceinline__ void softmax_step(f32x16& p0, f32x16& p1, float& m, float& l, f32x16 (&o)[2], LAS3 float* wsf, int r32, int hi, unsigned (&pw)[16]) {
  float rm = fmaxf(p0[0], p1[0]);
#pragma unroll
  for (int r = 1; r < 16; ++r) rm = fmaxf(rm, fmaxf(p0[r], p1[r]));
  rm = xmax(rm);
  if (__any(rm > m + THR)) {
    const float mn = fmaxf(m, rm);
    const float al = ex2(m - mn);
    m = mn; l *= al;
    if (hi == 0) wsf[r32] = al;
#pragma unroll
    for (int r = 0; r < 16; ++r) { const float f = wsf[crow(r, hi)]; o[0][r] *= f; o[1][r] *= f; }
  }
  float s = 0.f;
#pragma unroll
  for (int r = 0; r < 16; ++r) { p0[r] = ex2(p0[r] - m); p1[r] = ex2(p1[r] - m); s += p0[r] + p1[r]; }
  l += s;
#pragma unroll
  for (int i = 0; i < 8; ++i) { pw[i] = cvtpk(p0[2 * i], p0[2 * i + 1]); pw[8 + i] = cvtpk(p1[2 * i], p1[2 * i + 1]); }
}
struct KVSrc { const bf16_t* k; const bf16_t* v; int ldk, ldv; };
__device__ __forceinline__ void kv_issue(const KVSrc& s, int row0, u32x4& rk, u32x4& rv, int tid) {
  const int kv = tid & 63, ch = tid >> 6, ln = tid & 63;
  rk = *(const u32x4*)(s.k + (size_t)(row0 + kv) * s.ldk + ch * 8);
  rv = *(const u32x4*)(s.v + (size_t)(row0 + 16 * (ch & 3) + (ln >> 2)) * s.ldv + (ch >> 2) * 32 + (ln & 3) * 8);
}
__device__ __forceinline__ void kv_commit(lptr slot, const u32x4& rk, const u32x4& rv, int tid) {
  *(LAS3 u32x4*)(slot + KOFF + (tid >> 6) * 1024 + (tid & 63) * 16) = rk;
  *(LAS3 u32x4*)(slot + VOFF + tid * 16) = rv;
}
__device__ __forceinline__ void fin_set(LAS3 float* finl, const f32x16 (&o)[2], int lane) {
#pragma unroll
  for (int d0 = 0; d0 < 2; ++d0)
#pragma unroll
    for (int r = 0; r < 16; ++r) finl[(d0 * 16 + r) * 64 + lane] = o[d0][r];
}
__device__ __forceinline__ void fin_add(LAS3 float* finl, const f32x16 (&o)[2], const LAS3 float* wsf, int lane, int hi) {
#pragma unroll
  for (int r = 0; r < 16; ++r) { const float f = wsf[crow(r, hi)];
#pragma unroll
    for (int d0 = 0; d0 < 2; ++d0) finl[(d0 * 16 + r) * 64 + lane] += o[d0][r] * f; }
}
__device__ __forceinline__ void fin_store(const LAS3 float* finl, bf16_t* gout, size_t rowbase, int ld, int colbase, int lane) {
#pragma unroll
  for (int i = 0; i < 4; ++i) {
    const int q = i * 8 + (lane >> 3), ch = lane & 7;
    const int qh = (q >> 2) & 1, r = (q & 3) + 4 * (q >> 3), d0 = ch >> 2, dl = (ch & 3) * 8;
    const LAS3 float* p = finl + (d0 * 16 + r) * 64 + qh * 32 + dl;
    const f32x4_t x0 = *(const LAS3 f32x4_t*)p, x1 = *(const LAS3 f32x4_t*)(p + 4);
    u32x4 v; v.x = cvtpk(x0[0], x0[1]); v.y = cvtpk(x0[2], x0[3]); v.z = cvtpk(x1[0], x1[1]); v.w = cvtpk(x1[2], x1[3]);
    *(u32x4*)(gout + (rowbase + q) * (size_t)ld + colbase + ch * 8) = v;
  }
}

__device__ __forceinline__ void nsa_unit(int b, int g, int c, const bf16_t* __restrict__ proj, const bf16_t* __restrict__ kc, const bf16_t* __restrict__ vc, bf16_t* __restrict__ onsa, lptr lds) {
  int tid = threadIdx.x; asm volatile("" : "+v"(tid));
  const int lane = tid & 63, r32 = lane & 31, hi = lane >> 5;
  const int w = __builtin_amdgcn_readfirstlane(tid >> 6);
  const int rh = w >> 1, head = g * 4 + rh, tokl = 32 * (w & 1) + r32, t = 64 * c + tokl, bg = b * 2 + g;
  const size_t tok = (size_t)b * SEQ + t;
  LAS3 float* wsf = (LAS3 float*)(lds + L_WSF) + w * 64;
  const LAS3 float* tb = (const LAS3 float*)(lds + L_TB) + head * 128;
  LAS3 unsigned* selm = (LAS3 unsigned*)(lds + L_SELM);
  LAS3 float* sc = (LAS3 float*)(lds + L_SC);
  LAS3 float* impq = (LAS3 float*)(lds + L_IMPQ);
  LAS3 float* impl = (LAS3 float*)(lds + L_IMPL);
  const lcptr kb0 = (lcptr)lds + KOFF + hi * 1024 + r32 * 16;
  const lcptr vp0 = (lcptr)lds + VOFF + ((lane >> 4) & 1) * 32 + (lane & 3) * 8 + (4 * hi + ((lane & 15) >> 2)) * 64;
  bf16x8 qr[4];
#pragma unroll
  for (int d0 = 0; d0 < 4; ++d0) qr[d0] = *(const bf16x8*)(proj + tok * PROJ_LD + PC_Q + head * 64 + d0 * 16 + hi * 8);
  float gate[3];
#pragma unroll
  for (int j = 0; j < 3; ++j) gate[j] = 1.0f / (1.0f + ex2(-LOG2E * bf2f(proj[tok * PROJ_LD + PC_GATE + head * 3 + j])));
  LAS3 float* finl = (LAS3 float*)(lds + L_FIN) + w * 2048;
  f32x16 o[2]; unsigned pw[16];
  u32x4 rk, rv;
  {
    const KVSrc src{kc + (size_t)bg * 128 * 64, vc + (size_t)bg * 128 * 64, 64, 64};
    __syncthreads();
    kv_issue(src, 0, rk, rv, tid); kv_commit(lds, rk, rv, tid);
    kv_issue(src, 64, rk, rv, tid); kv_commit(lds + SLOT, rk, rv, tid);
    __syncthreads();
    f32x16 a0, a1, b0, b1;
    qkt<4>(a0, a1, kb0, qr); qkt<4>(b0, b1, kb0 + SLOT, qr);
    float rm = NEG_INF;
#pragma unroll
    for (int r = 0; r < 16; ++r) {
      const int cb = crow(r, hi);
      { const int d = t - 16 * cb - 31;          a0[r] = (d < 0) ? NEG_INF : a0[r] + ((d < 113) ? tb[d] : 0.f); }
      { const int d = t - 16 * (cb + 32) - 31;   a1[r] = (d < 0) ? NEG_INF : a1[r] + ((d < 113) ? tb[d] : 0.f); }
      { const int d = t - 16 * (cb + 64) - 31;   b0[r] = (d < 0) ? NEG_INF : b0[r] + ((d < 113) ? tb[d] : 0.f); }
      { const int d = t - 16 * (cb + 96) - 31;   b1[r] = (d < 0) ? NEG_INF : b1[r] + ((d < 113) ? tb[d] : 0.f); }
      rm = fmaxf(fmaxf(rm, fmaxf(a0[r], a1[r])), fmaxf(b0[r], b1[r]));
    }
    rm = xmax(rm);
    const float mref = (rm == NEG_INF) ? 0.f : rm;
    float s = 0.f;
#pragma unroll
    for (int r = 0; r < 16; ++r) { a0[r] = ex2(a0[r] - mref); a1[r] = ex2(a1[r] - mref); b0[r] = ex2(b0[r] - mref); b1[r] = ex2(b1[r] - mref); s += (a0[r] + a1[r]) + (b0[r] + b1[r]); }
    s = xsum(s);
    const float inv = (s > 0.f) ? 1.0f / s : 0.f;
#pragma unroll
    for (int r = 0; r < 16; ++r) { a0[r] *= inv; a1[r] *= inv; b0[r] *= inv; b1[r] *= inv; }
    { LAS3 float* iq = impq + (rh * 64 + tokl) * 33; LAS3 float* il = impl + (rh * 64 + tokl) * 33;
#pragma unroll
      for (int q4 = 0; q4 < 4; ++q4) {
        const int gi = 2 * q4 + hi;
        iq[gi] = (a0[4 * q4] + a0[4 * q4 + 1]) + (a0[4 * q4 + 2] + a0[4 * q4 + 3]);           il[gi] = a0[4 * q4 + 3];
        iq[8 + gi] = (a1[4 * q4] + a1[4 * q4 + 1]) + (a1[4 * q4 + 2] + a1[4 * q4 + 3]);       il[8 + gi] = a1[4 * q4 + 3];
        iq[16 + gi] = (b0[4 * q4] + b0[4 * q4 + 1]) + (b0[4 * q4 + 2] + b0[4 * q4 + 3]);      il[16 + gi] = b0[4 * q4 + 3];
        iq[24 + gi] = (b1[4 * q4] + b1[4 * q4 + 1]) + (b1[4 * q4 + 2] + b1[4 * q4 + 3]);      il[24 + gi] = b1[4 * q4 + 3];
      } }
    o[0] = f32x16{}; o[1] = f32x16{};
#pragma unroll
    for (int i = 0; i < 8; ++i) { pw[i] = cvtpk(a0[2 * i], a0[2 * i + 1]); pw[8 + i] = cvtpk(a1[2 * i], a1[2 * i + 1]); }
    pv(o, vp0, pw);
#pragma unroll
    for (int i = 0; i < 8; ++i) { pw[i] = cvtpk(b0[2 * i], b0[2 * i + 1]); pw[8 + i] = cvtpk(b1[2 * i], b1[2 * i + 1]); }
    pv(o, vp0 + SLOT, pw);
    if (hi == 0) wsf[r32] = gate[0];
#pragma unroll
    for (int r = 0; r < 16; ++r) { const float f = wsf[crow(r, hi)]; o[0][r] *= f; o[1][r] *= f; }
  }
  __syncthreads();
  const KVSrc ssrc{proj + (size_t)b * SEQ * PROJ_LD + PC_KV + 2 * 128 + g * 64, proj + (size_t)b * SEQ * PROJ_LD + PC_KV + 3 * 128 + g * 64, PROJ_LD, PROJ_LD};
  kv_issue(ssrc, 0, rk, rv, tid);
  {
    const int stok = tid >> 3, sub = tid & 7;
#pragma unroll
    for (int k = 0; k < 4; ++k) {
      const int n = sub * 4 + k;
      float imp = 0.f;
#pragma unroll
      for (int hh = 0; hh < 4; ++hh) imp += impq[(hh * 64 + stok) * 33 + n] + ((n > 0) ? impl[(hh * 64 + stok) * 33 + n - 1] : 0.f);
      sc[stok * 33 + n] = (n > c) ? -1.0f : ((n == 0 || n == c || n == c - 1) ? 1e4f : imp);
    }
    if (tid < 64) selm[tid] = 0u;
    __syncthreads();
#pragma unroll
    for (int k = 0; k < 4; ++k) {
      const int n = sub * 4 + k; const float sv = sc[stok * 33 + n]; int rank = 0;
      for (int mm = 0; mm < 32; ++mm) { const float sm = sc[stok * 33 + mm]; rank += (sm > sv || (sm == sv && mm < n)) ? 1 : 0; }
      if (rank < 16) atomicOr((unsigned*)(selm + stok), 1u << n);
    }
    __syncthreads();
  }
  const unsigned mysel = selm[tokl];
  fin_set(finl, o, lane);
#pragma unroll 1
  for (int br = 0; br < 2; ++br) {
    const KVSrc src = (br == 0) ? ssrc : KVSrc{proj + (size_t)b * SEQ * PROJ_LD + PC_KV + 4 * 128 + g * 64, proj + (size_t)b * SEQ * PROJ_LD + PC_KV + 5 * 128 + g * 64, PROJ_LD, PROJ_LD};
    const int n0 = (br == 0) ? 0 : ((c > 8) ? c - 8 : 0);
    if (br == 1) { __syncthreads(); kv_issue(src, n0 * 64, rk, rv, tid); }
    kv_commit(lds, rk, rv, tid);
    float m = -1e30f, l = 0.f;
    o[0] = f32x16{}; o[1] = f32x16{};
    int cur = 0;
#pragma unroll 1
    for (int n = n0; n <= c; ++n) {
      __syncthreads();
      if (n < c) kv_issue(src, (n + 1) * 64, rk, rv, tid);
      const bool mine = (br == 1) || ((mysel >> n) & 1u);
      if (__any(mine)) {
        f32x16 p0, p1;
        qkt<4>(p0, p1, kb0 + cur * SLOT, qr);
        if (n + 2 >= c) {
          const int dbase = t - 64 * n;
#pragma unroll
          for (int r = 0; r < 16; ++r) { const int d0_ = dbase - crow(r, hi), d1_ = d0_ - 32;
            p0[r] = (d0_ < 0) ? NEG_INF : p0[r] + ((d0_ < 113) ? tb[d0_] : 0.f);
            p1[r] = (d1_ < 0) ? NEG_INF : p1[r] + ((d1_ < 113) ? tb[d1_] : 0.f); }
        } else if (br == 1 && n + 8 == c) {
          const int dbase = t - 64 * n;
#pragma unroll
          for (int r = 0; r < 16; ++r) { const int d0_ = dbase - crow(r, hi), d1_ = d0_ - 32;
            if (d0_ >= 512) p0[r] = NEG_INF; if (d1_ >= 512) p1[r] = NEG_INF; }
        }
        if (!mine) {
#pragma unroll
          for (int r = 0; r < 16; ++r) { p0[r] = NEG_INF; p1[r] = NEG_INF; } }
        softmax_step(p0, p1, m, l, o, wsf, r32, hi, pw);
        pv(o, vp0 + cur * SLOT, pw);
      }
      if (n < c) kv_commit(lds + (cur ^ 1) * SLOT, rk, rv, tid);
      cur ^= 1;
    }
    l = xsum(l);
    const float gi = gate[1 + br] / fmaxf(l, 1e-30f);
    if (hi == 0) wsf[r32] = gi;
    fin_add(finl, o, wsf, lane, hi);
  }
  fin_store(finl, onsa, (size_t)b * SEQ + 64 * c + 32 * (w & 1), 512, head * 64, lane);
}

__device__ __forceinline__ void mla_unit(int b, int h, int qb, const bf16_t* __restrict__ mq, const bf16_t* __restrict__ mkv, const bf16_t* __restrict__ kr, bf16_t* __restrict__ omla, lptr lds) {
  int tid = threadIdx.x; asm volatile("" : "+v"(tid));
  const int lane = tid & 63, r32 = lane & 31, hi = lane >> 5;
  const int w = __builtin_amdgcn_readfirstlane(tid >> 6);
  const int q0 = 256 * qb, qw = q0 + 32 * w, qpos = qw + r32;
  const size_t tokq = (size_t)b * SEQ + qpos;
  LAS3 float* wsf = (LAS3 float*)(lds + L_WSF) + w * 64;
  const lcptr kb0 = (lcptr)lds + KOFF + hi * 1024 + r32 * 16;
  const lcptr vp0 = (lcptr)lds + VOFF + ((lane >> 4) & 1) * 32 + (lane & 3) * 8 + (4 * hi + ((lane & 15) >> 2)) * 64;
  bf16x8 qr[6];
#pragma unroll
  for (int d0 = 0; d0 < 6; ++d0) qr[d0] = *(const bf16x8*)(mq + tokq * 768 + h * 96 + d0 * 16 + hi * 8);
  const KVSrc src{mkv + (size_t)b * SEQ * 1024 + h * 128, mkv + (size_t)b * SEQ * 1024 + h * 128 + 64, 1024, 1024};
  const bf16_t* krb = kr + (size_t)b * SEQ * 32;
  const int NTL = 4 * (qb + 1);
  u32x4 rk, rv, rr = {0u, 0u, 0u, 0u};
  f32x16 o[2]; o[0] = f32x16{}; o[1] = f32x16{};
  unsigned pw[16];
  float m = -1e30f, l = 0.f;
  __syncthreads();
  kv_issue(src, 0, rk, rv, tid);
  if (tid < 256) rr = *(const u32x4*)(krb + (size_t)(tid & 63) * 32 + (tid >> 6) * 8);
  kv_commit(lds, rk, rv, tid);
  if (tid < 256) *(LAS3 u32x4*)(lds + KOFF + (8 + (tid >> 6)) * 1024 + (tid & 63) * 16) = rr;
  int cur = 0;
#pragma unroll 1
  for (int tl = 0; tl < NTL; ++tl) {
    __syncthreads();
    if (tl + 1 < NTL) { kv_issue(src, (tl + 1) * 64, rk, rv, tid); if (tid < 256) rr = *(const u32x4*)(krb + (size_t)((tl + 1) * 64 + (tid & 63)) * 32 + (tid >> 6) * 8); }
    if (64 * tl <= qw + 31) {
      f32x16 p0, p1;
      qkt<6>(p0, p1, kb0 + cur * SLOT, qr);
      if (64 * tl + 63 > qw) {
        const int dbase = qpos - 64 * tl;
#pragma unroll
        for (int r = 0; r < 16; ++r) { const int d0_ = dbase - crow(r, hi), d1_ = d0_ - 32; if (d0_ < 0) p0[r] = NEG_INF; if (d1_ < 0) p1[r] = NEG_INF; }
      }
      softmax_step(p0, p1, m, l, o, wsf, r32, hi, pw);
      pv(o, vp0 + cur * SLOT, pw);
    }
    if (tl + 1 < NTL) { kv_commit(lds + (cur ^ 1) * SLOT, rk, rv, tid); if (tid < 256) *(LAS3 u32x4*)(lds + (cur ^ 1) * SLOT + KOFF + (8 + (tid >> 6)) * 1024 + (tid & 63) * 16) = rr; }
    cur ^= 1;
  }
  l = xsum(l);
  if (hi == 0) wsf[r32] = 1.0f / fmaxf(l, 1e-30f);
#pragma unroll
  for (int r = 0; r < 16; ++r) { const float f = wsf[crow(r, hi)]; o[0][r] *= f; o[1][r] *= f; }
  LAS3 float* finl = (LAS3 float*)(lds + L_FIN) + w * 2048;
  fin_set(finl, o, lane);
  fin_store(finl, omla, (size_t)b * SEQ + qw, 512, h * 64, lane);
}

__device__ __forceinline__ void attn_phase(const bf16_t* proj, const bf16_t* kc, const bf16_t* vc, const float* t5, bf16_t* onsa,
                                           const bf16_t* mq, const bf16_t* mkv, const bf16_t* kr, bf16_t* omla, lptr lds) {
  const int tid = threadIdx.x;
  { LAS3 float* tb = (LAS3 float*)(lds + L_TB);
    for (int i = tid; i < 8 * 128; i += NTHR) { const int hd = i >> 7, d = i & 127; tb[i] = (t5[(int)T5B[d] * 8 + hd] - t5[31 * 8 + hd]) * LOG2E; } }
  const int G = gridDim.x, bx = blockIdx.x;
  for (int v = (G % 8 == 0) ? (bx % 8) * (G / 8) + bx / 8 : bx; v < 256; v += G) {
    const int bg = v >> 4, p = v & 15, bh = v >> 2, j = v & 3;
#pragma unroll 1
    for (int u = 0; u < 2; ++u) nsa_unit(bg >> 1, bg & 1, u ? p : 31 - p, proj, kc, vc, onsa, lds);
#pragma unroll 1
    for (int u = 0; u < 2; ++u) mla_unit(bh >> 3, bh & 7, u ? j : 7 - j, mq, mkv, kr, omla, lds);
  }
}
#undef LAS3
}


namespace peer {
using bf16x8 = __attribute__((ext_vector_type(8))) short;
using f32x16 = __attribute__((ext_vector_type(16))) float;
typedef unsigned u32x4 __attribute__((ext_vector_type(4)));
typedef float f32x4_t __attribute__((ext_vector_type(4)));
typedef __bf16 bf16x2_t __attribute__((ext_vector_type(2)));
typedef float f32x2_t __attribute__((ext_vector_type(2)));
#define LAS3 __attribute__((address_space(3)))
__device__ __forceinline__ int crow(int r, int hi) { return (r & 3) + 8 * (r >> 2) + 4 * hi; }
__device__ __forceinline__ unsigned enc(float f) { const unsigned u = __float_as_uint(f); return u ^ ((unsigned)((int)u >> 31) | 0x80000000u); }
__device__ __forceinline__ float dec(unsigned k) { return __uint_as_float(k ^ (~(unsigned)((int)k >> 31) | 0x80000000u)); }
__device__ __forceinline__ unsigned umax(unsigned a, unsigned b) { return a > b ? a : b; }
__device__ __forceinline__ unsigned umin(unsigned a, unsigned b) { return a < b ? a : b; }
__device__ __forceinline__ unsigned cvtpk(float lo, float hi) { f32x2_t v = {lo, hi}; bf16x2_t b = __builtin_convertvector(v, bf16x2_t); return __builtin_bit_cast(unsigned, b); }
template <int B, int N> __device__ __forceinline__ void sort16(unsigned (&k)[N]) {
#pragma unroll
  for (int size = 2; size <= 16; size <<= 1)
#pragma unroll
    for (int stride = size >> 1; stride > 0; stride >>= 1)
#pragma unroll
      for (int i = 0; i < 16; ++i) { const int l = i ^ stride;
        if (l > i) { const bool desc = ((i & size) == 0); const unsigned a = k[B + i], b = k[B + l]; const unsigned mx = umax(a, b), mn = umin(a, b); k[B + i] = desc ? mx : mn; k[B + l] = desc ? mn : mx; } }
}
template <int A, int Bo, int N> __device__ __forceinline__ void merge16(unsigned (&k)[N]) {
#pragma unroll
  for (int i = 0; i < 16; ++i) k[A + i] = umax(k[A + i], k[Bo + 15 - i]);
#pragma unroll
  for (int stride = 8; stride > 0; stride >>= 1)
#pragma unroll
    for (int i = 0; i < 16; ++i) { const int l = i ^ stride; if (l > i) { const unsigned a = k[A + i], b = k[A + l]; k[A + i] = umax(a, b); k[A + l] = umin(a, b); } }
}
template <int N> __device__ __forceinline__ void top16_of_64(unsigned (&k)[N]) {
  sort16<0>(k); sort16<16>(k); sort16<32>(k); sort16<48>(k);
  merge16<0, 16>(k); merge16<32, 48>(k); merge16<0, 32>(k);
}

__device__ __forceinline__ void route_phase(const bf16_t* __restrict__ pq, const bf16_t* __restrict__ subk, unsigned* __restrict__ pack, LAS3 char* lds) {
  const int tid = threadIdx.x, lane = tid & 63, r32 = lane & 31, hi = lane >> 5, wv = tid >> 6;
  const int gw = blockIdx.x * NWV + wv, nw = gridDim.x * NWV;
  LAS3 unsigned char* myb = (LAS3 unsigned char*)lds + wv * 2560 + lane * 40;
#pragma unroll 1
  for (int item = gw; item < (T / 32) * 8; item += nw) {
    const int h = item & 7, t0 = (item >> 3) * 32;
    unsigned la[16], lb[16];
#pragma unroll
    for (int i = 0; i < 16; ++i) { la[i] = 0u; lb[i] = 0u; }
#pragma unroll 1
    for (int p = 0; p < 2; ++p) {
      f32x16 acc[4];
#pragma unroll
      for (int kt = 0; kt < 4; ++kt) acc[kt] = f32x16{};
#pragma unroll
      for (int kd = 0; kd < 4; ++kd) {
        const bf16x8 bq = *(const bf16x8*)(pq + (size_t)(t0 + r32) * 1024 + h * 128 + p * 64 + kd * 16 + hi * 8);
#pragma unroll
        for (int kt = 0; kt < 4; ++kt) {
          const bf16x8 ak = *(const bf16x8*)(subk + (size_t)((h * 2 + p) * 128 + kt * 32 + r32) * 64 + kd * 16 + hi * 8);
          acc[kt] = __builtin_amdgcn_mfma_f32_32x32x16_bf16(ak, bq, acc[kt], 0, 0, 0);
        }
      }
      unsigned k[64];
#pragma unroll
      for (int kt = 0; kt < 4; ++kt)
#pragma unroll
        for (int r = 0; r < 16; ++r) k[kt * 16 + r] = (enc(acc[kt][r]) & 0xFFFFFF80u) | (unsigned)(127 - (32 * kt + crow(r, hi)));
      top16_of_64(k);
#pragma unroll
      for (int i = 0; i < 16; ++i) { auto rr = __builtin_amdgcn_permlane32_swap(k[i], k[i], false, false); unsigned r0 = rr[0], r1 = rr[1]; asm volatile("" : "+v"(r0), "+v"(r1)); k[16 + i] = hi ? r0 : r1; }
      merge16<0, 16>(k);
#pragma unroll
      for (int i = 0; i < 16; ++i) { la[i] = (p == 0) ? k[i] : la[i]; lb[i] = (p == 0) ? lb[i] : k[i]; }
      __builtin_amdgcn_sched_barrier(0);
    }
#pragma unroll
    for (int i = 0; i < 4; ++i) {
      const unsigned wa = (127u - (la[4 * i] & 127u)) | ((127u - (la[4 * i + 1] & 127u)) << 8) | ((127u - (la[4 * i + 2] & 127u)) << 16) | ((127u - (la[4 * i + 3] & 127u)) << 24);
      const unsigned wb = (127u - (lb[4 * i] & 127u)) | ((127u - (lb[4 * i + 1] & 127u)) << 8) | ((127u - (lb[4 * i + 2] & 127u)) << 16) | ((127u - (lb[4 * i + 3] & 127u)) << 24);
      *(LAS3 unsigned*)(myb + 4 * i) = wa; *(LAS3 unsigned*)(myb + 16 + 4 * i) = wb;
    }
    float va[16], vb[16];
#pragma unroll
    for (int i = 0; i < 16; ++i) { va[i] = dec(la[i] & 0xFFFFFF80u); vb[i] = dec(lb[i] & 0xFFFFFF80u); }
    unsigned k[64];
#define PEER_CAND(n, i, j) k[n] = (enc(va[i] + vb[j]) & 0xFFFFFF00u) | (unsigned)(255 - ((i) * 16 + (j)))
    PEER_CAND(0, 0, 0); PEER_CAND(1, 0, 1); PEER_CAND(2, 0, 2); PEER_CAND(3, 0, 3); PEER_CAND(4, 0, 4); PEER_CAND(5, 0, 5);
    PEER_CAND(6, 0, 6); PEER_CAND(7, 0, 7); PEER_CAND(8, 0, 8); PEER_CAND(9, 0, 9); PEER_CAND(10, 0, 10); PEER_CAND(11, 0, 11);
    PEER_CAND(12, 0, 12); PEER_CAND(13, 0, 13); PEER_CAND(14, 0, 14); PEER_CAND(15, 0, 15); PEER_CAND(16, 1, 0); PEER_CAND(17, 1, 1);
    PEER_CAND(18, 1, 2); PEER_CAND(19, 1, 3); PEER_CAND(20, 1, 4); PEER_CAND(21, 1, 5); PEER_CAND(22, 1, 6); PEER_CAND(23, 1, 7);
    PEER_CAND(24, 2, 0); PEER_CAND(25, 2, 1); PEER_CAND(26, 2, 2); PEER_CAND(27, 2, 3); PEER_CAND(28, 2, 4); PEER_CAND(29, 3, 0);
    PEER_CAND(30, 3, 1); PEER_CAND(31, 3, 2); PEER_CAND(32, 3, 3); PEER_CAND(33, 4, 0); PEER_CAND(34, 4, 1); PEER_CAND(35, 4, 2);
    PEER_CAND(36, 5, 0); PEER_CAND(37, 5, 1); PEER_CAND(38, 6, 0); PEER_CAND(39, 6, 1); PEER_CAND(40, 7, 0); PEER_CAND(41, 7, 1);
    PEER_CAND(42, 8, 0); PEER_CAND(43, 9, 0); PEER_CAND(44, 10, 0); PEER_CAND(45, 11, 0); PEER_CAND(46, 12, 0); PEER_CAND(47, 13, 0);
    PEER_CAND(48, 14, 0); PEER_CAND(49, 15, 0);
#undef PEER_CAND
#pragma unroll
    for (int z = 50; z < 64; ++z) k[z] = 0u;
    top16_of_64(k);
    const float best0 = dec(k[0] & 0xFFFFFF00u);
    float ev[16]; float den = 0.f;
#pragma unroll
    for (int i = 0; i < 16; ++i) { ev[i] = __expf(dec(k[i] & 0xFFFFFF00u) - best0); den += ev[i]; }
    const float inv = 1.0f / den;
    unsigned outw[8];
#pragma unroll
    for (int i = 0; i < 8; ++i) {
      unsigned k_lo = k[i], k_hi = k[8 + i]; float e_lo = ev[i], e_hi = ev[8 + i];
      asm volatile("" : "+v"(k_lo), "+v"(k_hi), "+v"(e_lo), "+v"(e_hi));
      const unsigned kk = hi ? k_hi : k_lo; const float e = hi ? e_hi : e_lo;
      const unsigned f = 255u - (kk & 255u);
      const unsigned ia = myb[f >> 4], ib = myb[16 + (f & 15u)];
      outw[i] = (ia * 128u + ib) | (cvtpk(0.f, e * inv) & 0xFFFF0000u);
    }
    unsigned* dst = pack + (size_t)(t0 + r32) * 128 + h * 16 + hi * 8;
    *(u32x4*)dst = (u32x4){outw[0], outw[1], outw[2], outw[3]};
    *(u32x4*)(dst + 4) = (u32x4){outw[4], outw[5], outw[6], outw[7]};
  }
}

__device__ __forceinline__ void conv_tables(const float* __restrict__ u, const float* __restrict__ v, bf16_t* __restrict__ u16, bf16_t* __restrict__ v16) {
  const size_t n8 = (size_t)16384 * 1024 / 8;
  for (size_t i = (size_t)blockIdx.x * NTHR + threadIdx.x; i < 2 * n8; i += (size_t)gridDim.x * NTHR) {
    const bool second = i >= n8; const size_t j = second ? i - n8 : i;
    const float* s = (second ? v : u) + j * 8;
    const f32x4_t a = *(const f32x4_t*)s, b = *(const f32x4_t*)(s + 4);
    const u32x4 o = {cvtpk(a[0], a[1]), cvtpk(a[2], a[3]), cvtpk(b[0], b[1]), cvtpk(b[2], b[3])};
    *(u32x4*)((second ? v16 : u16) + j * 8) = o;
  }
}
__device__ __forceinline__ float dot2(unsigned a, unsigned b, float c) { return __builtin_amdgcn_fdot2_f32_bf16(__builtin_bit_cast(bf16x2_t, a), __builtin_bit_cast(bf16x2_t, b), c, false); }
__device__ __forceinline__ float gelu_fast(float v) {
  const float av = __builtin_fabsf(v), t = __builtin_amdgcn_rcpf(av * 0.2316418882f + 1.0f);
  float q = t * 0.5307027145f + (-0.7265760135f); q = q * t + 0.7107068705f; q = q * t + (-0.142248368f); q = q * t + 0.127414796f; q = q * t;
  const float e = __builtin_amdgcn_exp2f((v * v) * (-0.72134752044f));
  const float m = v * (q * e);
  return v < 0.f ? m : v - m;
}
__device__ __forceinline__ void experts_phase(const bf16_t* __restrict__ hn, const unsigned* __restrict__ pack, const bf16_t* __restrict__ u16, const bf16_t* __restrict__ v16,
                                              const float* __restrict__ gfin, float* __restrict__ out) {
  const int tid = threadIdx.x, lane = tid & 63, j16 = lane & 15, grp = lane >> 4, wv = tid >> 6;
  const int gw = blockIdx.x * NWV + wv, nw = gridDim.x * NWV;
#pragma unroll 1
  for (int t = gw; t < T; t += nw) {
    u32x4 hq[8];
#pragma unroll
    for (int seg = 0; seg < 8; ++seg) hq[seg] = *(const u32x4*)(hn + (size_t)t * 1024 + seg * 128 + j16 * 8);
    const unsigned pk0 = pack[(size_t)t * 128 + lane], pk1 = pack[(size_t)t * 128 + 64 + lane];
    float y[16];
#pragma unroll
    for (int i = 0; i < 16; ++i) y[i] = 0.f;
#pragma unroll 1
    for (int q = 0; q < 32; ++q) {
      const unsigned pkv = (unsigned)__shfl((int)(q < 16 ? pk0 : pk1), (4 * q + grp) & 63);
      const unsigned e = pkv & 0xFFFFu; const float wgt = __uint_as_float(pkv & 0xFFFF0000u);
      u32x4 ub[8], vb[8];
      const bf16_t* urow = u16 + (size_t)e * 1024 + j16 * 8;
#pragma unroll
      for (int seg = 0; seg < 8; ++seg) ub[seg] = *(const u32x4*)(urow + seg * 128);
#pragma unroll
      for (int x = 0; x < 4; ++x) {
        const unsigned ex = (unsigned)__builtin_amdgcn_readlane((int)e, 16 * x);
        const bf16_t* vrow = v16 + (size_t)ex * 1024 + lane * 8;
        vb[2 * x] = *(const u32x4*)vrow; vb[2 * x + 1] = *(const u32x4*)(vrow + 512);
      }
      float d = 0.f;
#pragma unroll
      for (int seg = 0; seg < 8; ++seg) { d = dot2(ub[seg].x, hq[seg].x, d); d = dot2(ub[seg].y, hq[seg].y, d); d = dot2(ub[seg].z, hq[seg].z, d); d = dot2(ub[seg].w, hq[seg].w, d); }
      d += __shfl_xor(d, 1); d += __shfl_xor(d, 2); d += __shfl_xor(d, 4); d += __shfl_xor(d, 8);
      const unsigned cb = cvtpk(wgt * gelu_fast(d), 0.f) & 0xFFFFu;
#pragma unroll
      for (int x = 0; x < 4; ++x) {
        const unsigned cl = (unsigned)__builtin_amdgcn_readlane((int)cb, 16 * x), ch = cl << 16;
#pragma unroll
        for (int hf = 0; hf < 2; ++hf) { const u32x4 vv = vb[2 * x + hf];
          y[hf * 8 + 0] = dot2(vv.x, cl, y[hf * 8 + 0]); y[hf * 8 + 1] = dot2(vv.x, ch, y[hf * 8 + 1]);
          y[hf * 8 + 2] = dot2(vv.y, cl, y[hf * 8 + 2]); y[hf * 8 + 3] = dot2(vv.y, ch, y[hf * 8 + 3]);
          y[hf * 8 + 4] = dot2(vv.z, cl, y[hf * 8 + 4]); y[hf * 8 + 5] = dot2(vv.z, ch, y[hf * 8 + 5]);
          y[hf * 8 + 6] = dot2(vv.w, cl, y[hf * 8 + 6]); y[hf * 8 + 7] = dot2(vv.w, ch, y[hf * 8 + 7]); }
      }
    }
    float ss = 0.f;
    f32x4_t r[4];
#pragma unroll
    for (int hf = 0; hf < 2; ++hf) {
      const float* hp = out + (size_t)t * 1024 + hf * 512 + lane * 8;
      const f32x4_t a = *(const f32x4_t*)hp, b = *(const f32x4_t*)(hp + 4);
      r[2 * hf] = (f32x4_t){a[0] + y[hf * 8 + 0], a[1] + y[hf * 8 + 1], a[2] + y[hf * 8 + 2], a[3] + y[hf * 8 + 3]};
      r[2 * hf + 1] = (f32x4_t){b[0] + y[hf * 8 + 4], b[1] + y[hf * 8 + 5], b[2] + y[hf * 8 + 6], b[3] + y[hf * 8 + 7]};
#pragma unroll
      for (int i = 0; i < 4; ++i) ss += r[2 * hf][i] * r[2 * hf][i] + r[2 * hf + 1][i] * r[2 * hf + 1][i];
    }
    ss = wsum(ss);
    const float inv = rsqrtf(ss * (1.0f / 1024.0f) + 1e-6f);
#pragma unroll
    for (int hf = 0; hf < 2; ++hf) {
      const float* gp = gfin + hf * 512 + lane * 8; float* op = out + (size_t)t * 1024 + hf * 512 + lane * 8;
      const f32x4_t g0 = *(const f32x4_t*)gp, g1 = *(const f32x4_t*)(gp + 4);
      *(f32x4_t*)op = r[2 * hf] * inv * g0; *(f32x4_t*)(op + 4) = r[2 * hf + 1] * inv * g1;
    }
  }
}
#undef LAS3
}

#define XB_TMO      128
#define XB_XCNT(j)  (256  + 64 * (j))
#define XB_XSUB(j)  (1280 + 64 * (j))
#define XB_XGEN(j)  (2304 + 64 * (j))
#define XB_TOP      3328
#define XB_TOPGEN   3392
#define XCD_BAR_WORDS 3456
#define XB_SPIN_CAP (1u << 18)
#ifndef LAS
#define LAS __attribute__((address_space(3)))
#endif

__device__ __forceinline__ unsigned xb_ld(unsigned* p)              { return __hip_atomic_load(p, __ATOMIC_RELAXED, __HIP_MEMORY_SCOPE_AGENT); }
__device__ __forceinline__ unsigned xb_add(unsigned* p, unsigned v) { return __hip_atomic_fetch_add(p, v, __ATOMIC_RELAXED, __HIP_MEMORY_SCOPE_AGENT); }
__device__ __forceinline__ unsigned xb_xcc_id() { return (unsigned)__builtin_amdgcn_s_getreg((3 << 11) | 20) & 0xFu; }
#define XB_SPIN(cond, bar) do { unsigned _sp = 0; while (cond) { __builtin_amdgcn_s_sleep(1); \
    if ((++_sp & 255u) == 0u) { if (xb_ld(&(bar)[XB_TMO])) break; if (_sp > XB_SPIN_CAP) { atomicAdd(&(bar)[XB_TMO], 1u); break; } } } } while (0)

struct XcdBarrier {
    unsigned* bar; unsigned x;
    volatile LAS unsigned* st;
};

__device__ __forceinline__ XcdBarrier xcd_barrier_post(unsigned* bar, volatile LAS unsigned* st) {
    XcdBarrier b; b.bar = bar; b.x = xb_xcc_id(); b.st = st;
    if (threadIdx.x == 0) (void)xb_add(&bar[XB_XCNT(b.x)], 1u);
    return b;
}
__device__ __forceinline__ void xcd_barrier_complete(unsigned* bar, unsigned x, unsigned& nloc, unsigned& nx) {
    const unsigned G = gridDim.x * gridDim.y * gridDim.z;
    unsigned sum, cnt, mine, sp = 0u;
    for (;;) {
        sum = 0u; cnt = 0u; mine = 0u;
#pragma unroll
        for (unsigned j = 0; j < 16; ++j) { const unsigned c = xb_ld(&bar[XB_XCNT(j)]); sum += c; cnt += (c > 0u) ? 1u : 0u; mine = (j == x) ? c : mine; }
        if (sum == G) break;
        __builtin_amdgcn_s_sleep(1);
        if ((++sp & 255u) == 0u) { if (xb_ld(&bar[XB_TMO])) break; if (sp > XB_SPIN_CAP) { atomicAdd(&bar[XB_TMO], 1u); break; } }
    }
    nloc = mine > 0u ? mine : 1u; nx = cnt > 0u ? cnt : 1u;
}

__device__ __forceinline__ void xcd_barrier(const XcdBarrier& b) {
    asm volatile("s_waitcnt vmcnt(0)" ::: "memory");
    __syncthreads();
    if (threadIdx.x == 0) {
        unsigned* bar = b.bar;
        __builtin_amdgcn_s_waitcnt(0);
        unsigned nloc = b.st[0], nx = b.st[1];
        if (nloc == 0u) { xcd_barrier_complete(bar, b.x, nloc, nx); b.st[0] = nloc; b.st[1] = nx; }
        const unsigned old = xb_add(&bar[XB_XSUB(b.x)], 1u);
        const unsigned gen = old / nloc;
        if (old + 1u == (gen + 1u) * nloc) {
            __builtin_amdgcn_fence(__ATOMIC_RELEASE, "agent");
            asm volatile("s_waitcnt vmcnt(0)" ::: "memory");
            const unsigned og = xb_add(&bar[XB_TOP], 1u);
            const unsigned tg = og / nx;
            if (og + 1u == (tg + 1u) * nx) xb_add(&bar[XB_TOPGEN], 1u);
            else XB_SPIN(xb_ld(&bar[XB_TOPGEN]) == tg, bar);
            __builtin_amdgcn_fence(__ATOMIC_ACQUIRE, "agent");
            xb_add(&bar[XB_XGEN(b.x)], 1u);
            asm volatile("s_waitcnt vmcnt(0)" ::: "memory");
        } else {
            XB_SPIN(xb_ld(&bar[XB_XGEN(b.x)]) == gen, bar);
            __builtin_amdgcn_fence(__ATOMIC_ACQUIRE, "agent");
            asm volatile("s_waitcnt vmcnt(0)" ::: "memory");
        }
    }
    __syncthreads();
}

struct Args { const float* in[23]; float* out; char* ws; };
constexpr int LDS_BYTES = 131072 + 4096;

typedef const __attribute__((address_space(4))) Args* kargs_t;
DEV kargs_t KA() { kargs_t k = (kargs_t)__builtin_amdgcn_kernarg_segment_ptr(); asm volatile("" : "+s"(k)); return k; }
#define WSP(type, off) ((type*)(ws + (off)))

__global__ __launch_bounds__(NTHR, 2) void mega(Args a) {
  extern __shared__ __attribute__((aligned(16))) char lds[];
  cg::grid_group grid = cg::this_grid();
  PG8_LAS unsigned char* glds = (PG8_LAS unsigned char*)lds;
  const int bid = blockIdx.x, G = gridDim.x;
  (void)a;
  volatile LAS unsigned* bst = (volatile LAS unsigned*)((LAS char*)lds + LDS_BYTES - 16);
  if (threadIdx.x < 4) bst[threadIdx.x] = 0u;
  __syncthreads();
  XcdBarrier xbar; { kargs_t k = KA(); xbar = xcd_barrier_post((unsigned*)k->ws, bst); }

  { kargs_t k = KA(); char* ws = k->ws;
    ph_convT<1>(k->in[2], 1024, IN_COLS, WSP(bf16_t, WS_WIN), 3840, lds);
    ph_convT<0>(k->in[13], 512, 1024, WSP(bf16_t, WS_WBN), 1024, lds);
    ph_convT<0>(k->in[14], 512, 1024, WSP(bf16_t, WS_WBM), 1024, lds);
    ph_convT<0>(k->in[15], 1024, 1024, WSP(bf16_t, WS_WOUT), 1024, lds);
    ph_convT<0>(k->in[17], 1024, 1024, WSP(bf16_t, WS_WQ), 1024, lds);
    ph_convT<0>(k->in[5], 2048, 256, WSP(bf16_t, WS_CKW1), 256, lds);
    ph_convT<0>(k->in[7], 2048, 256, WSP(bf16_t, WS_CVW1), 256, lds);
    ph_convT<0>(k->in[6], 256, 64, WSP(bf16_t, WS_CKW2), 64, lds);
    ph_convT<0>(k->in[8], 256, 64, WSP(bf16_t, WS_CVW2), 64, lds);
    ph_convT<0>(k->in[11], 256, 768, WSP(bf16_t, WS_UQ), 768, lds);
    ph_convT<0>(k->in[12], 128, 1024, WSP(bf16_t, WS_UKV), 1024, lds);
    ph_conv_plain(k->in[18], WSP(bf16_t, WS_SUBK), 16 * 128 * 64);
    ph_rope_table(WSP(float2, WS_ROPE));
    ph_rms1024(k->in[0], k->in[1], WSP(bf16_t, WS_XN), T); }
  grid.sync();
  { kargs_t k = KA(); char* ws = k->ws;
    pg8::Gemm g{WSP(bf16_t, WS_XN), WSP(bf16_t, WS_WIN), T, 3840, 1024}; pg8::StaticOrder S; S.init(T, 3840, G, bid);
    pg8::EpiInProjF E{WSP(bf16_t, WS_PROJ), WSP(bf16_t, WS_GATES)};
    pg8::gemm_phase<pg8::EpiInProjF, pg8::StaticOrder, PG8_ALIGN, PG8_SP2>(glds, g, S, E); }
  xcd_barrier(xbar);
  { kargs_t k = KA(); char* ws = k->ws;
    ph_rms_cols<4>(WSP(bf16_t, WS_PROJ), PC_CQ, k->in[9], WSP(bf16_t, WS_CQN));
    ph_rms_cols<2>(WSP(bf16_t, WS_PROJ), PC_CKV, k->in[10], WSP(bf16_t, WS_CKVN));
    ph_rope_k(WSP(bf16_t, WS_PROJ), WSP(bf16_t, WS_KROPE));
    ph_cmp_gather(WSP(bf16_t, WS_PROJ), k->in[3], 0, WSP(bf16_t, WS_CA));
    ph_cmp_gather(WSP(bf16_t, WS_PROJ), k->in[4], 1, WSP(bf16_t, WS_CA2)); }
  xcd_barrier(xbar);
  { kargs_t k = KA(); char* ws = k->ws;
    pg8::Gemm g{WSP(bf16_t, WS_CA), WSP(bf16_t, WS_CKW1), 2048, 256, 2048}; pg8::StaticOrder S; S.init(2048, 256, G, bid);
    pg8::EpiBf16<1> E{WSP(bf16_t, WS_HID), 256, nullptr, 0, 0, 1.f};
    pg8::gemm_phase<pg8::EpiBf16<1>, pg8::StaticOrder, PG8_ALIGN, PG8_SP2>(glds, g, S, E); }
  { kargs_t k = KA(); char* ws = k->ws;
    pg8::Gemm g{WSP(bf16_t, WS_CA2), WSP(bf16_t, WS_CVW1), 2048, 256, 2048}; pg8::StaticOrder S; S.init(2048, 256, G, (bid + 128) & 255);
    pg8::EpiBf16<1> E{WSP(bf16_t, WS_HID2), 256, nullptr, 0, 0, 1.f};
    pg8::gemm_phase<pg8::EpiBf16<1>, pg8::StaticOrder, PG8_ALIGN, PG8_SP2>(glds, g, S, E); }
  { kargs_t k = KA(); char* ws = k->ws;
    pg8::Gemm g{WSP(bf16_t, WS_CQN), WSP(bf16_t, WS_UQ), T, 768, 256}; pg8::StaticOrder S; S.init(T, 768, G, (bid + 64) & 255);
    pg8::EpiMlaQF E{WSP(bf16_t, WS_MLAQ), WSP(float2, WS_ROPE)};
    pg8::gemm_phase<pg8::EpiMlaQF, pg8::StaticOrder, PG8_ALIGN, PG8_SP2>(glds, g, S, E); }
  { kargs_t k = KA(); char* ws = k->ws;
    pg8::Gemm g{WSP(bf16_t, WS_CKVN), WSP(bf16_t, WS_UKV), T, 1024, 128}; pg8::StaticOrder S; S.init(T, 1024, G, bid);
    pg8::EpiBf16<0> E{WSP(bf16_t, WS_MLAKV), 1024, nullptr, 0, 0, 1.f};
    pg8::gemm_phase<pg8::EpiBf16<0>, pg8::StaticOrder, PG8_ALIGN, PG8_SP2>(glds, g, S, E); }
  xcd_barrier(xbar);
  { kargs_t k = KA(); char* ws = k->ws;
    ph_gemm(WSP(bf16_t, WS_HID), 256, WSP(bf16_t, WS_CKW2), 256, 2048, 64, 256, EpiCmpOut{WSP(bf16_t, WS_KC)}, lds);
    ph_gemm(WSP(bf16_t, WS_HID2), 256, WSP(bf16_t, WS_CVW2), 256, 2048, 64, 256, EpiCmpOut{WSP(bf16_t, WS_VC)}, lds); }
  xcd_barrier(xbar);
  { kargs_t k = KA(); char* ws = k->ws;
    att::attn_phase(WSP(bf16_t, WS_PROJ), WSP(bf16_t, WS_KC), WSP(bf16_t, WS_VC), k->in[21], WSP(bf16_t, WS_ONSA),
                    WSP(bf16_t, WS_MLAQ), WSP(bf16_t, WS_MLAKV), WSP(bf16_t, WS_KROPE), WSP(bf16_t, WS_OMLA), (att::lptr)lds); }
  xcd_barrier(xbar);
  { kargs_t k = KA(); char* ws = k->ws;
    pg8::Gemm g{WSP(bf16_t, WS_ONSA), WSP(bf16_t, WS_WBN), T, 1024, 512}; pg8::StaticOrder S; S.init(T, 1024, G, bid);
    pg8::EpiMergeF<0> E{WSP(bf16_t, WS_GATES), WSP(bf16_t, WS_MERGED)};
    pg8::gemm_phase<pg8::EpiMergeF<0>, pg8::StaticOrder, PG8_ALIGN, PG8_SP2>(glds, g, S, E); }
  { kargs_t k = KA(); char* ws = k->ws;
    pg8::Gemm g{WSP(bf16_t, WS_OMLA), WSP(bf16_t, WS_WBM), T, 1024, 512}; pg8::StaticOrder S; S.init(T, 1024, G, bid);
    pg8::EpiMergeF<1> E{WSP(bf16_t, WS_GATES), WSP(bf16_t, WS_MERGED)};
    pg8::gemm_phase<pg8::EpiMergeF<1>, pg8::StaticOrder, PG8_ALIGN, PG8_SP2>(glds, g, S, E); }
  xcd_barrier(xbar);
  { kargs_t k = KA(); char* ws = k->ws;
    pg8::Gemm g{WSP(bf16_t, WS_MERGED), WSP(bf16_t, WS_WOUT), T, 1024, 1024}; pg8::StaticOrder S; S.init(T, 1024, G, bid);
    pg8::EpiResidF E{k->in[0], k->out};
    pg8::gemm_phase<pg8::EpiResidF, pg8::StaticOrder, PG8_ALIGN, PG8_SP2>(glds, g, S, E); }
  xcd_barrier(xbar);
  { kargs_t k = KA(); char* ws = k->ws; ph_rms1024(k->out, k->in[16], WSP(bf16_t, WS_HN), T);
    peer::conv_tables(k->in[19], k->in[20], WSP(bf16_t, WS_U16), WSP(bf16_t, WS_V16)); }
  xcd_barrier(xbar);
  { kargs_t k = KA(); char* ws = k->ws;
    pg8::Gemm g{WSP(bf16_t, WS_HN), WSP(bf16_t, WS_WQ), T, 1024, 1024}; pg8::StaticOrder S; S.init(T, 1024, G, bid);
    pg8::EpiBf16<0> E{WSP(bf16_t, WS_PQ), 1024, nullptr, 0, 0, 1.f};
    pg8::gemm_phase<pg8::EpiBf16<0>, pg8::StaticOrder, PG8_ALIGN, PG8_SP2>(glds, g, S, E); }
  xcd_barrier(xbar);
  { kargs_t k = KA(); char* ws = k->ws; peer::route_phase(WSP(bf16_t, WS_PQ), WSP(bf16_t, WS_SUBK), WSP(unsigned, WS_PIDX), (__attribute__((address_space(3))) char*)lds); }
  xcd_barrier(xbar);
  { kargs_t k = KA(); char* ws = k->ws; peer::experts_phase(WSP(bf16_t, WS_HN), WSP(unsigned, WS_PIDX), WSP(bf16_t, WS_U16), WSP(bf16_t, WS_V16), k->in[22], k->out); }
}

extern "C" void kernel_launch(void* const* d_in, const int* in_sizes, int n_in, void* d_out, int out_size, void* d_ws, size_t ws_size, hipStream_t stream) {
  if (n_in != 23 || ws_size < 256 * MiB) { fprintf(stderr, "kernel_launch: unexpected n_in %d / ws_size %zu\n", n_in, ws_size); return; }
  static int grid_blocks = 0;
  if (!grid_blocks) {
    int dev = 0, cus = 0, per_cu = 0;
    (void)hipGetDevice(&dev);
    (void)hipDeviceGetAttribute(&cus, hipDeviceAttributeMultiprocessorCount, dev);
    if (hipFuncSetAttribute((const void*)mega, hipFuncAttributeMaxDynamicSharedMemorySize, LDS_BYTES) != hipSuccess) fprintf(stderr, "kernel_launch: hipFuncSetAttribute failed\n");
    (void)hipOccupancyMaxActiveBlocksPerMultiprocessor(&per_cu, (const void*)mega, NTHR, LDS_BYTES);
    if (per_cu < 1) { fprintf(stderr, "kernel_launch: occupancy query returned %d\n", per_cu); per_cu = 1; }
    if (per_cu > 2) per_cu = 2;
    grid_blocks = cus * per_cu;
    fprintf(stderr, "kernel_launch: cus %d per_cu %d grid %d ws %zu\n", cus, per_cu, grid_blocks, ws_size);
  }
  if (hipMemsetAsync(d_ws, 0, 65536, stream) != hipSuccess) fprintf(stderr, "kernel_launch: hipMemsetAsync failed\n");
  Args a{};
  for (int i = 0; i < 23; ++i) a.in[i] = (const float*)d_in[i];
  a.out = (float*)d_out; a.ws = (char*)d_ws;
  void* args[] = {&a};
  hipError_t e = hipLaunchCooperativeKernel((const void*)mega, dim3(grid_blocks), dim3(NTHR), args, LDS_BYTES, stream);
  if (e != hipSuccess) fprintf(stderr, "cooperative launch failed: %s (grid %d)\n", hipGetErrorString(e), grid_blocks);
}
```

```cpp
#include <hip/hip_runtime.h>
#include <stdint.h>
#include <cstdio>
#include <hip/hip_cooperative_groups.h>
namespace cg = cooperative_groups;

typedef unsigned short bf16_t;
#define DEV __device__ __forceinline__

constexpr int BATCH = 8, SEQ = 2048, DM = 1024, T = BATCH * SEQ;
constexpr int IN_COLS = 3768;
constexpr int PROJ_LD = 1792;
constexpr int PC_Q = 0, PC_KV = 512, PC_CQ = 1280, PC_CKV = 1536, PC_KR = 1664, PC_GATE = 1696;
constexpr int NC = 127;
constexpr size_t MiB = 1u << 20;

constexpr size_t WS_WIN = 1 * MiB;
constexpr size_t WS_WBN = 9 * MiB;
constexpr size_t WS_WBM = 10 * MiB;
constexpr size_t WS_WOUT = 11 * MiB;
constexpr size_t WS_WQ = 13 * MiB;
constexpr size_t WS_CKW1 = 15 * MiB;
constexpr size_t WS_CVW1 = 16 * MiB;
constexpr size_t WS_CKW2 = 17 * MiB;
constexpr size_t WS_CVW2 = 17 * MiB + 64 * 1024;
constexpr size_t WS_UQ = 17 * MiB + 256 * 1024;
constexpr size_t WS_UKV = 17 * MiB + 768 * 1024;
constexpr size_t WS_SUBK = 18 * MiB;
constexpr size_t WS_ROPE = 18 * MiB + 512 * 1024;
constexpr size_t WS_GATES = 20 * MiB;
constexpr size_t WS_PQ = 20 * MiB;
constexpr size_t WS_PROJ = 84 * MiB;
constexpr size_t WS_MERGED = 84 * MiB;
constexpr size_t WS_PIDX = 84 * MiB;
constexpr size_t WS_U8 = 172 * MiB;
constexpr size_t WS_V8 = 188 * MiB;
constexpr size_t WS_SU = 204 * MiB;
constexpr size_t WS_PW = 92 * MiB;
constexpr size_t WS_XN = 140 * MiB;
constexpr size_t WS_MLAKV = 140 * MiB;
constexpr size_t WS_HN = 140 * MiB;
constexpr size_t WS_MLAQ = 172 * MiB;
constexpr size_t WS_KROPE = 196 * MiB;
constexpr size_t WS_KC = 197 * MiB;
constexpr size_t WS_VC = 197 * MiB + 512 * 1024;
constexpr size_t WS_ONSA = 198 * MiB;
constexpr size_t WS_OMLA = 214 * MiB;
constexpr size_t WS_CA = 198 * MiB;
constexpr size_t WS_HID = 206 * MiB;
constexpr size_t WS_HID2 = 207 * MiB;
constexpr size_t WS_CA2 = 214 * MiB;
constexpr size_t WS_CQN = 230 * MiB;
constexpr size_t WS_CKVN = 238 * MiB;
constexpr size_t WS_OCMP = 230 * MiB;
constexpr size_t WS_SEL = 246 * MiB;

__device__ const unsigned char T5B[128] = {
  0, 1, 2, 3, 4, 5, 6, 7, 8, 9, 10, 11, 12, 13, 14, 15, 16, 16, 16, 17, 17, 18, 18, 18, 19, 19, 19, 20, 20, 20, 20, 21,
  21, 21, 21, 22, 22, 22, 22, 22, 23, 23, 23, 23, 23, 23, 24, 24, 24, 24, 24, 24, 25, 25, 25, 25, 25, 25, 25, 26, 26, 26, 26, 26,
  26, 26, 26, 27, 27, 27, 27, 27, 27, 27, 27, 27, 27, 28, 28, 28, 28, 28, 28, 28, 28, 28, 28, 29, 29, 29, 29, 29, 29, 29, 29, 29,
  29, 29, 29, 30, 30, 30, 30, 30, 30, 30, 30, 30, 30, 30, 30, 30, 30, 31, 31, 31, 31, 31, 31, 31, 31, 31, 31, 31, 31, 31, 31, 31};

DEV float bf2f(bf16_t v) { return __uint_as_float(((unsigned)v) << 16); }
DEV bf16_t f2bf(float f) { unsigned u = __float_as_uint(f); u += 0x7fffu + ((u >> 16) & 1u); return (bf16_t)(u >> 16); }
DEV float wsum(float v) {
#pragma unroll
  for (int o = 32; o > 0; o >>= 1) v += __shfl_xor(v, o);
  return v;
}
DEV float wmaxf(float v) {
#pragma unroll
  for (int o = 32; o > 0; o >>= 1) v = fmaxf(v, __shfl_xor(v, o));
  return v;
}
DEV float sigmoidf_(float x) { return 1.0f / (1.0f + expf(-x)); }
DEV float gelu_exact(float x) { return 0.5f * x * (1.0f + erff(x * 0.70710678118654752f)); }
DEV void wave_lds_sync() { asm volatile("s_waitcnt lgkmcnt(0)" ::: "memory"); __builtin_amdgcn_wave_barrier(); asm volatile("" ::: "memory"); }
DEV float t5bias(const float* t5, int head, int dist) { int d = dist < 127 ? dist : 127; d = d < 0 ? 0 : d; return t5[(int)T5B[d] * 8 + head]; }


namespace pg8 {
#define PG8_LAS __attribute__((address_space(3)))
typedef unsigned short bf16_t;
typedef short bf16x8 __attribute__((ext_vector_type(8)));
typedef float f32x4 __attribute__((ext_vector_type(4)));
typedef unsigned u32x4 __attribute__((ext_vector_type(4)));
constexpr int BM = 256, BK = 64, HALF = 128, HTB = HALF * BK * 2  , STAGE_BYTES = 8 * HTB, NXCD = 8, WGM = 8;

__host__ __device__ __forceinline__ int lds_byte(int r, int c) { const int st = (r >> 4) * 2 + (c >> 5), rr = r & 15, cc = c & 31, ob = rr * 64 + cc * 2; return st * 1024 + (ob ^ (((ob >> 9) & 1) << 5)); }
__host__ __device__ __forceinline__ void stage_rc(int b, int& R, int& C) { const int st = b / 1024, sb = b % 1024, swz = sb ^ (((sb >> 9) & 1) << 5); R = (st >> 1) * 16 + swz / 64; C = (st & 1) * 32 + (swz % 64) / 2; }
__host__ __device__ __forceinline__ int perm32(int rho) { const int n = rho >> 4, i = rho & 15; return 8 * (i >> 2) + 4 * n + (i & 3); }

struct Unit { int pm, pn; };
struct Gemm { const bf16_t* A; const bf16_t* Bt; int M, N, K; };

struct StaticOrder {
    int nM, nN, nwg, G, c;
    __host__ __device__ void init(int M, int N, int G_, int c_) { nM = M / BM; nN = N / BM; nwg = nM * nN; G = G_; c = c_; }
    __host__ __device__ bool next(int i, Unit& u) const {
        const long L = (long)i * G + c; if (L >= nwg) return false;
        int wgid = (int)L; { const int q = nwg / NXCD, r = nwg % NXCD, xcd = wgid % NXCD, off = wgid / NXCD; wgid = (xcd < r ? xcd * (q + 1) : r * (q + 1) + (xcd - r) * q) + off; }
        const int nig = WGM * nN, gid = wgid / nig, fm = gid * WGM, gsz = (nM - fm) < WGM ? (nM - fm) : WGM;
        u.pm = fm + ((wgid % nig) % gsz); u.pn = (wgid % nig) / gsz; return true;
    }
    __device__ __forceinline__ void a_ready(const Unit&) const {}
    __device__ __forceinline__ void done(const Unit&) const {}
};

__device__ __forceinline__ unsigned cvt_pk_bf16(float lo, float hi) { unsigned r; asm volatile("v_cvt_pk_bf16_f32 %0, %1, %2" : "=v"(r) : "v"(lo), "v"(hi)); return r; }
typedef float f32x2 __attribute__((ext_vector_type(2)));
__device__ __forceinline__ f32x2 gelu_pk(f32x2 v) {
    const f32x2 av = __builtin_elementwise_abs(v), d = av * 0.2316418882f + 1.0f;
    f32x2 t; t.x = __builtin_amdgcn_rcpf(d.x); t.y = __builtin_amdgcn_rcpf(d.y);
    f32x2 q = t * 0.5307027145f + (-0.7265760135f); q = q * t + 0.7107068705f; q = q * t + (-0.142248368f); q = q * t + 0.127414796f; q = q * t;
    const f32x2 s = (v * v) * (-0.72134752044f);
    f32x2 e; e.x = __builtin_amdgcn_exp2f(s.x); e.y = __builtin_amdgcn_exp2f(s.y);
    const f32x2 m = v * (q * e), r = v - m;
    f32x2 o; o.x = v.x < 0.f ? m.x : r.x; o.y = v.y < 0.f ? m.y : r.y; return o;
}

template <int ACT  > struct EpiBf16 {
    static constexpr bool PERM = true, AFTER_DRAIN = false; static_assert(ACT == 0 || ACT == 1, "EpiBf16: ACT is 0 (none) or 1 (gelu_pk)");
    bf16_t* O; int ldc; const float* bias; int split_cols; size_t split_stride; float scale0;
    __device__ __forceinline__ void operator()(const f32x4 (&acc)[2][2][4][2], const Unit& u, int wr, int wc, int fr, int fq) const {
        const int row0 = u.pm * BM + wr * 64 + fr; int colt = u.pn * BM; bf16_t* base = O;
        float sc = 1.f; if (split_cols) { const int t = colt / split_cols; base += (size_t)t * split_stride; colt -= t * split_cols; if (t == 0) sc = scale0; }
        const int col0 = colt + wc * 32 + 8 * fq, bcol0 = u.pn * BM + wc * 32 + 8 * fq;
        f32x4 bv[2][2];
#pragma unroll
        for (int bj = 0; bj < 2; ++bj)
#pragma unroll
            for (int n = 0; n < 2; ++n) bv[bj][n] = bias ? *(const f32x4*)(bias + bcol0 + bj * HALF + 4 * n) : (f32x4){0.f, 0.f, 0.f, 0.f};
#pragma unroll
        for (int ai = 0; ai < 2; ++ai)
#pragma unroll
            for (int m = 0; m < 4; ++m) { bf16_t* rowp = base + (size_t)(row0 + ai * HALF + m * 16) * ldc + col0;
#pragma unroll
                for (int bj = 0; bj < 2; ++bj) { f32x4 v0 = acc[ai][bj][m][0] + bv[bj][0], v1 = acc[ai][bj][m][1] + bv[bj][1];
                    if (ACT == 1) { f32x2 a = gelu_pk((f32x2){v0[0], v0[1]}), b = gelu_pk((f32x2){v0[2], v0[3]}), c = gelu_pk((f32x2){v1[0], v1[1]}), d = gelu_pk((f32x2){v1[2], v1[3]});
                        v0 = (f32x4){a.x, a.y, b.x, b.y}; v1 = (f32x4){c.x, c.y, d.x, d.y}; }
                    v0 = v0 * sc; v1 = v1 * sc; u32x4 w; w.x = cvt_pk_bf16(v0[0], v0[1]); w.y = cvt_pk_bf16(v0[2], v0[3]); w.z = cvt_pk_bf16(v1[0], v1[1]); w.w = cvt_pk_bf16(v1[2], v1[3]);
                    *(u32x4*)(rowp + bj * HALF) = w; } }
    }
};

struct PanelStats {
    unsigned* xbuf;
    unsigned* cnt;
    unsigned* tmo;
    int ntn; float eps;
    unsigned code;
    __device__ __forceinline__ bool run(const f32x4 (&v)[2][2][4][2], const Unit& u, int wr, int wc, int fr, int fq, PG8_LAS unsigned char* lds, int wid, int lane) const {
        typedef float f32x2v __attribute__((ext_vector_type(2)));
        PG8_LAS f32x2v* P = (PG8_LAS f32x2v*)lds;
        PG8_LAS f32x2v* S = (PG8_LAS f32x2v*)(lds + 8192);
        PG8_LAS unsigned* flag = (PG8_LAS unsigned*)(lds + 8192 + 2048);
#pragma unroll
        for (int ai = 0; ai < 2; ++ai)
#pragma unroll
            for (int m = 0; m < 4; ++m) {
                float s = 0.f;
#pragma unroll
                for (int bj = 0; bj < 2; ++bj)
#pragma unroll
                    for (int n = 0; n < 2; ++n) { const f32x4 x = v[ai][bj][m][n]; s += (x[0] + x[1]) + (x[2] + x[3]); }
                s += __shfl_xor(s, 16); s += __shfl_xor(s, 32);
                const float mw = s * (1.0f / 64.0f); float q = 0.f;
#pragma unroll
                for (int bj = 0; bj < 2; ++bj)
#pragma unroll
                    for (int n = 0; n < 2; ++n) { const f32x4 d = v[ai][bj][m][n] - mw; q += (d[0] * d[0] + d[1] * d[1]) + (d[2] * d[2] + d[3] * d[3]); }
                q += __shfl_xor(q, 16); q += __shfl_xor(q, 32);
                if (fq == 0) P[(ai * HALF + wr * 64 + m * 16 + fr) * 4 + wc] = (f32x2v){mw, q};
            }
        asm volatile("s_waitcnt lgkmcnt(0)" ::: "memory"); __builtin_amdgcn_s_barrier(); asm volatile("" ::: "memory");
#if defined(BROKEN_EXCHANGE_NO_WAIT)
#warning BROKEN CONTROL BUILD: the row-statistics exchange does not wait; results are wrong by design
        if (blockIdx.x >= 64) { const long long t0_ = clock64(); while (clock64() - t0_ < 60000) __builtin_amdgcn_s_sleep(8); }
#endif
        const int row = wid * 32 + (lane & 31);
        if (lane < 32) {
            const f32x2v a = P[row * 4 + 0], b = P[row * 4 + 1], c = P[row * 4 + 2], d = P[row * 4 + 3];
            const float mt = (a.x + b.x + c.x + d.x) * 0.25f;
            const float da = a.x - mt, db = b.x - mt, dc = c.x - mt, dd = d.x - mt;
            const float m2 = (a.y + b.y) + (c.y + d.y) + 64.0f * ((da * da + db * db) + (dc * dc + dd * dd));
            unsigned long long* slot = (unsigned long long*)xbuf + ((size_t)(u.pm * BM + row) * 4 + u.pn);
            __hip_atomic_store(slot, ((unsigned long long)__float_as_uint(m2) << 32) | __float_as_uint(mt), __ATOMIC_RELAXED, __HIP_MEMORY_SCOPE_AGENT);
        }
        asm volatile("s_waitcnt vmcnt(0)" ::: "memory");
        if (lane == 0) __hip_atomic_fetch_add(cnt + 64 * u.pm, 1u, __ATOMIC_RELAXED, __HIP_MEMORY_SCOPE_AGENT);
        if (wid == 0) {
            bool dead = false; const unsigned long long t0 = __builtin_amdgcn_s_memrealtime(); const unsigned want = 8u * (unsigned)ntn;
            for (;;) {
#if defined(BROKEN_EXCHANGE_NO_WAIT)
                break;
#endif
                if ((unsigned)__builtin_amdgcn_readfirstlane(__hip_atomic_load(cnt + 64 * u.pm, __ATOMIC_RELAXED, __HIP_MEMORY_SCOPE_AGENT)) >= want) break;
                if (__builtin_amdgcn_s_memrealtime() - t0 > 2000000ull) {
                    if (lane == 0) { unsigned expect = 0u; __hip_atomic_compare_exchange_strong(tmo + 1, &expect, code | (unsigned)(u.pm & 0xff), __ATOMIC_RELAXED, __ATOMIC_RELAXED, __HIP_MEMORY_SCOPE_AGENT);
                                     __hip_atomic_store(tmo, 1u, __ATOMIC_RELAXED, __HIP_MEMORY_SCOPE_AGENT); }
                    dead = true; break; }
                __builtin_amdgcn_s_sleep(2);
            }
            __builtin_amdgcn_fence(__ATOMIC_ACQUIRE, "agent");
            if (lane == 0) flag[0] = dead ? 1u : 0u;
        }
        asm volatile("s_waitcnt vmcnt(0) lgkmcnt(0)" ::: "memory"); __builtin_amdgcn_s_barrier(); asm volatile("" ::: "memory");
        const bool bad = flag[0] != 0u;
        if (lane < 32) {
            const unsigned long long* slot = (const unsigned long long*)xbuf + (size_t)(u.pm * BM + row) * 4; float mt[4], m2[4]; float ms = 0.f;
#pragma unroll
            for (int t = 0; t < 4; ++t) { if (t < ntn) { const unsigned long long w = __hip_atomic_load(slot + t, __ATOMIC_RELAXED, __HIP_MEMORY_SCOPE_AGENT); mt[t] = __uint_as_float((unsigned)w); m2[t] = __uint_as_float((unsigned)(w >> 32)); } else { mt[t] = 0.f; m2[t] = 0.f; } ms += mt[t]; }
            const float mean = ms / (float)ntn; float q = 0.f;
#pragma unroll
            for (int t = 0; t < 4; ++t) if (t < ntn) { const float dm = mt[t] - mean; q += m2[t] + 256.0f * dm * dm; }
            S[row] = (f32x2v){mean, 1.0f / sqrtf(q / (256.0f * (float)ntn) + eps)};
        }
        asm volatile("s_waitcnt lgkmcnt(0)" ::: "memory"); __builtin_amdgcn_s_barrier(); asm volatile("" ::: "memory");
        return bad;
    }
};
struct EpiLnRes {
    static constexpr bool PERM = false, AFTER_DRAIN = true;
    const float* base; float* out; int ldc; const float* bias; PanelStats st; unsigned poison;
    __device__ __forceinline__ void fused(f32x4 (&acc)[2][2][4][2], const Unit& u, int wr, int wc, int fr, int fq, PG8_LAS unsigned char* lds, int wid, int lane) const {
        typedef float f32x2v __attribute__((ext_vector_type(2)));
        const PG8_LAS f32x2v* S = (const PG8_LAS f32x2v*)(lds + 8192);
        const int col0 = u.pn * BM + wc * 32 + 4 * fq;
#pragma unroll
        for (int bj = 0; bj < 2; ++bj)
#pragma unroll
            for (int n = 0; n < 2; ++n) { const f32x4 bv = bias ? *(const f32x4*)(bias + col0 + bj * HALF + n * 16) : (f32x4){0.f, 0.f, 0.f, 0.f};
#pragma unroll
                for (int ai = 0; ai < 2; ++ai)
#pragma unroll
                    for (int m = 0; m < 4; ++m) acc[ai][bj][m][n] += bv; }
        f32x4 pre[4][2][2];
#pragma unroll
        for (int m = 0; m < 4; ++m) { const size_t off = (size_t)(u.pm * BM + wr * 64 + m * 16 + fr) * ldc + col0;
#pragma unroll
            for (int bj = 0; bj < 2; ++bj)
#pragma unroll
                for (int n = 0; n < 2; ++n) pre[m][bj][n] = *(const f32x4*)(base + off + bj * HALF + n * 16); }
        const bool bad = st.run(acc, u, wr, wc, fr, fq, lds, wid, lane) || poison != 0u;
        const float qnan = __builtin_nanf("");
#pragma unroll
        for (int ai = 0; ai < 2; ++ai)
#pragma unroll
            for (int m = 0; m < 4; ++m) { const int r = ai * HALF + wr * 64 + m * 16 + fr; const f32x2v sr = S[r]; const size_t off = (size_t)(u.pm * BM + r) * ldc + col0;
#pragma unroll
                for (int bj = 0; bj < 2; ++bj)
#pragma unroll
                    for (int n = 0; n < 2; ++n) { const f32x4 bs = ai == 0 ? pre[m][bj][n] : *(const f32x4*)(base + off + bj * HALF + n * 16); f32x4 o = bs + (acc[ai][bj][m][n] - sr.x) * sr.y;
                        if (bad) o = (f32x4){qnan, qnan, qnan, qnan}; *(f32x4*)(out + off + bj * HALF + n * 16) = o; }
                if (m & 1) asm volatile("" ::: "memory"); }
    }
};
struct EpiLnResLn {
    static constexpr bool PERM = false, AFTER_DRAIN = true;
    const float* base; float* out; bf16_t* xn; int ldc; const float* bias; PanelStats st1, st2; unsigned poison;
    __device__ __forceinline__ void fused(f32x4 (&acc)[2][2][4][2], const Unit& u, int wr, int wc, int fr, int fq, PG8_LAS unsigned char* lds, int wid, int lane) const {
        typedef float f32x2v __attribute__((ext_vector_type(2))); typedef unsigned u32x2v __attribute__((ext_vector_type(2)));
        const PG8_LAS f32x2v* S = (const PG8_LAS f32x2v*)(lds + 8192);
        const int col0 = u.pn * BM + wc * 32 + 4 * fq;
#pragma unroll
        for (int bj = 0; bj < 2; ++bj)
#pragma unroll
            for (int n = 0; n < 2; ++n) { const f32x4 bv = bias ? *(const f32x4*)(bias + col0 + bj * HALF + n * 16) : (f32x4){0.f, 0.f, 0.f, 0.f};
#pragma unroll
                for (int ai = 0; ai < 2; ++ai)
#pragma unroll
                    for (int m = 0; m < 4; ++m) acc[ai][bj][m][n] += bv; }
        bool bad = st1.run(acc, u, wr, wc, fr, fq, lds, wid, lane) || poison != 0u;
        const float qnan = __builtin_nanf("");
#pragma unroll
        for (int ai = 0; ai < 2; ++ai)
#pragma unroll
            for (int m = 0; m < 4; ++m) { const int r = ai * HALF + wr * 64 + m * 16 + fr; const f32x2v sr = S[r]; const size_t off = (size_t)(u.pm * BM + r) * ldc + col0;
#pragma unroll
                for (int bj = 0; bj < 2; ++bj)
#pragma unroll
                    for (int n = 0; n < 2; ++n) { const f32x4 bs = *(const f32x4*)(base + off + bj * HALF + n * 16); acc[ai][bj][m][n] = bs + (acc[ai][bj][m][n] - sr.x) * sr.y; }
                asm volatile("" : "+v"(acc[ai][0][m][0]), "+v"(acc[ai][0][m][1]), "+v"(acc[ai][1][m][0]), "+v"(acc[ai][1][m][1]));
                if (m & 1) asm volatile("" ::: "memory"); }
        const bool bad1 = bad;
        bad = st2.run(acc, u, wr, wc, fr, fq, lds, wid, lane) || bad;
#pragma unroll
        for (int ai = 0; ai < 2; ++ai)
#pragma unroll
            for (int m = 0; m < 4; ++m) { const int r = ai * HALF + wr * 64 + m * 16 + fr; const f32x2v sr = S[r]; const size_t off = (size_t)(u.pm * BM + r) * ldc + col0;
#pragma unroll
                for (int bj = 0; bj < 2; ++bj)
#pragma unroll
                    for (int n = 0; n < 2; ++n) { const f32x4 x1 = acc[ai][bj][m][n]; *(f32x4*)(out + off + bj * HALF + n * 16) = bad1 ? (f32x4){qnan, qnan, qnan, qnan} : x1;
                        const f32x4 o = (x1 - sr.x) * sr.y; u32x2v w; w.x = cvt_pk_bf16(o[0], o[1]); w.y = cvt_pk_bf16(o[2], o[3]);
                        if (bad) { w.x = 0x7fc07fc0u; w.y = 0x7fc07fc0u; } *(u32x2v*)(xn + off + bj * HALF + n * 16) = w; }
                asm volatile("" ::: "memory"); }
    }
};

template <class Epi, class Sched, bool ALIGN_EPI = false, bool SP2 = false>
__device__ __forceinline__ void gemm_phase(PG8_LAS unsigned char* lds, const Gemm g, const Sched& S, const Epi& E) {
    int tid = threadIdx.x; asm volatile("" : "+v"(tid));
    const int wid = __builtin_amdgcn_readfirstlane(tid >> 6), lane = tid & 63, wr = wid >> 2, wc = wid & 3, fr = lane & 15, fq = lane >> 4;
    int K = g.K; asm volatile("" : "+s"(K)); const int nt = K / BK;
    unsigned voffA[2], voffB[2];
#pragma unroll
    for (int i = 0; i < 2; ++i) { int R, C; stage_rc(tid * 16 + i * 8192, R, C); const int Rb = Epi::PERM ? ((R & ~31) + perm32(R & 31)) : R;
        voffA[i] = (unsigned)(R * K + C) * 2u; voffB[i] = (unsigned)(Rb * K + C) * 2u; }
    const size_t kstep = (size_t)(BK * 2);
    const size_t hstep = (size_t)HALF * K * 2;
    const size_t tstep = 2 * hstep;
    const unsigned ldsw = (unsigned)wid * 1024u;
    const int aoff = lds_byte(wr * 64 + fr, fq * 8), boff = lds_byte(wc * 32 + fr, fq * 8);
#define PG8_SA(b, h) (((b) * 2 + (h)) * HTB)
#define PG8_SB(b, h) ((4 + (b) * 2 + (h)) * HTB)
#define PG8_STAGE(bufoff, gbase, voff) do { _Pragma("unroll") for (int _i = 0; _i < 2; ++_i) \
        __builtin_amdgcn_global_load_lds((const unsigned*)((const char*)(gbase) + (voff)[_i]), (PG8_LAS unsigned*)(lds + (bufoff) + ldsw + _i * 8192), 16, 0, 0); } while (0)
#define PG8_LDA(dst, b, h) do { _Pragma("unroll") for (int m = 0; m < 4; ++m) _Pragma("unroll") for (int k = 0; k < 2; ++k) dst[m][k] = *(const PG8_LAS bf16x8*)(lds + PG8_SA(b, h) + aoff + m * 2048 + k * 1024); } while (0)
#define PG8_LDB(dst, b, h) do { _Pragma("unroll") for (int n = 0; n < 2; ++n) _Pragma("unroll") for (int k = 0; k < 2; ++k) dst[n][k] = *(const PG8_LAS bf16x8*)(lds + PG8_SB(b, h) + boff + n * 2048 + k * 1024); } while (0)
#define PG8_MMA(ai, bj, At, Bt) do { __builtin_amdgcn_s_setprio(1); _Pragma("unroll") for (int m = 0; m < 4; ++m) _Pragma("unroll") for (int n = 0; n < 2; ++n) _Pragma("unroll") for (int k = 0; k < 2; ++k) \
        acc[ai][bj][m][n] = __builtin_amdgcn_mfma_f32_16x16x32_bf16(Bt[n][k], At[m][k], acc[ai][bj][m][n], 0, 0, 0); __builtin_amdgcn_s_setprio(0); } while (0)
#define PG8_WAIT_V(n) asm volatile("s_waitcnt vmcnt(" #n ")" ::: "memory")
#define PG8_WAIT_L(n) asm volatile("s_waitcnt lgkmcnt(" #n ")" ::: "memory")
#define PG8_BAR __builtin_amdgcn_s_barrier()
#define PG8_SCHED __builtin_amdgcn_sched_barrier(0)
    Unit cur, nxt; int ui = 0;
    if (!S.next(0, cur)) return;
    f32x4 acc[2][2][4][2];
#pragma unroll
    for (int a = 0; a < 2; ++a)
#pragma unroll
        for (int b = 0; b < 2; ++b)
#pragma unroll
            for (int m = 0; m < 4; ++m)
#pragma unroll
                for (int n = 0; n < 2; ++n) acc[a][b][m][n] = (f32x4){0.f, 0.f, 0.f, 0.f};
    bf16x8 At[4][2], B0[2][2], B1[2][2];
    const char* cA = (const char*)g.A + (size_t)cur.pm * tstep; const char* cB = (const char*)g.Bt + (size_t)cur.pn * tstep;
    S.a_ready(cur);
    if constexpr (SP2) {
        PG8_STAGE(PG8_SB(0, 0), cB, voffB); PG8_STAGE(PG8_SB(0, 1), cB + hstep, voffB); PG8_STAGE(PG8_SA(0, 0), cA, voffA); PG8_STAGE(PG8_SA(0, 1), cA + hstep, voffA);
        if (wr == 1) PG8_BAR;
        PG8_WAIT_V(2); PG8_BAR;
        PG8_STAGE(PG8_SB(1, 0), cB + kstep, voffB); PG8_STAGE(PG8_SA(1, 0), cA + kstep, voffA); PG8_STAGE(PG8_SB(1, 1), cB + hstep + kstep, voffB);
        PG8_WAIT_V(6); PG8_BAR;
    } else {
        PG8_STAGE(PG8_SB(0, 0), cB, voffB); PG8_STAGE(PG8_SA(0, 0), cA, voffA); PG8_STAGE(PG8_SB(0, 1), cB + hstep, voffB); PG8_STAGE(PG8_SA(0, 1), cA + hstep, voffA);
        if (wr == 1) PG8_BAR;
        PG8_WAIT_V(4); PG8_BAR;
        PG8_STAGE(PG8_SB(1, 0), cB + kstep, voffB); PG8_STAGE(PG8_SA(1, 0), cA + kstep, voffA); PG8_STAGE(PG8_SB(1, 1), cB + hstep + kstep, voffB);
        PG8_WAIT_V(6); PG8_BAR;
    }
    for (;;) {
        const bool has_next = S.next(ui + 1, nxt);
        const char* nA = has_next ? (const char*)g.A + (size_t)nxt.pm * tstep : cA; const char* nB = has_next ? (const char*)g.Bt + (size_t)nxt.pn * tstep : cB;
        for (int t = 0; t < nt; t += 2) {
            const bool last = (t == nt - 2);
            const char* a1 = cA + (size_t)(t + 1) * kstep;
            const char* a2 = last ? nA : cA + (size_t)(t + 2) * kstep; const char* b2 = last ? nB : cB + (size_t)(t + 2) * kstep;
            const char* a3 = a2 + kstep; const char* b3 = b2 + kstep;
            if (last && has_next) S.a_ready(nxt);
            if constexpr (SP2) {
            PG8_LDB(B0, 0, 0); PG8_LDB(B1, 0, 1); PG8_SCHED; PG8_LDA(At, 0, 0); PG8_STAGE(PG8_SA(1, 1), a1 + hstep, voffA);
            PG8_WAIT_V(8); PG8_WAIT_L(0); PG8_BAR; PG8_MMA(0, 0, At, B0); PG8_MMA(0, 1, At, B1); PG8_BAR; PG8_SCHED;
            PG8_LDA(At, 0, 1); PG8_STAGE(PG8_SB(0, 0), b2, voffB); PG8_STAGE(PG8_SB(0, 1), b2 + hstep, voffB); PG8_STAGE(PG8_SA(0, 0), a2, voffA);
            PG8_WAIT_V(8); PG8_WAIT_L(0); PG8_BAR; PG8_MMA(1, 0, At, B0); PG8_MMA(1, 1, At, B1); PG8_BAR; PG8_SCHED;
            PG8_LDB(B0, 1, 0); PG8_LDB(B1, 1, 1); PG8_SCHED; PG8_LDA(At, 1, 0); PG8_STAGE(PG8_SA(0, 1), a2 + hstep, voffA);
            PG8_WAIT_V(8); PG8_WAIT_L(0); PG8_BAR; PG8_MMA(0, 0, At, B0); PG8_MMA(0, 1, At, B1); PG8_BAR; PG8_SCHED;
            PG8_LDA(At, 1, 1); PG8_STAGE(PG8_SB(1, 0), b3, voffB); PG8_STAGE(PG8_SB(1, 1), b3 + hstep, voffB); PG8_STAGE(PG8_SA(1, 0), a3, voffA);
            PG8_WAIT_V(8); PG8_WAIT_L(0); PG8_BAR; PG8_MMA(1, 0, At, B0); PG8_MMA(1, 1, At, B1); PG8_BAR; PG8_SCHED;
            } else {
            PG8_LDB(B0, 0, 0); PG8_SCHED; PG8_LDA(At, 0, 0); PG8_STAGE(PG8_SA(1, 1), a1 + hstep, voffA);
            PG8_WAIT_L(8); PG8_BAR; PG8_WAIT_L(0); PG8_MMA(0, 0, At, B0); PG8_BAR; PG8_SCHED;
            PG8_LDB(B1, 0, 1); PG8_STAGE(PG8_SB(0, 0), b2, voffB);
            PG8_BAR; PG8_WAIT_L(0); PG8_MMA(0, 1, At, B1); PG8_BAR;
            PG8_LDA(At, 0, 1); PG8_STAGE(PG8_SA(0, 0), a2, voffA);
            PG8_BAR; PG8_WAIT_L(0); PG8_MMA(1, 0, At, B0); PG8_BAR; PG8_SCHED;
            PG8_STAGE(PG8_SB(0, 1), b2 + hstep, voffB);
            PG8_WAIT_V(6); PG8_BAR; PG8_MMA(1, 1, At, B1); PG8_BAR;
            PG8_LDB(B0, 1, 0); PG8_SCHED; PG8_LDA(At, 1, 0); PG8_STAGE(PG8_SA(0, 1), a2 + hstep, voffA);
            PG8_WAIT_L(8); PG8_BAR; PG8_WAIT_L(0); PG8_MMA(0, 0, At, B0); PG8_BAR; PG8_SCHED;
            PG8_LDB(B1, 1, 1); PG8_STAGE(PG8_SB(1, 0), b3, voffB);
            PG8_BAR; PG8_WAIT_L(0); PG8_MMA(0, 1, At, B1); PG8_BAR;
            PG8_LDA(At, 1, 1); PG8_STAGE(PG8_SA(1, 0), a3, voffA);
            PG8_BAR; PG8_WAIT_L(0); PG8_MMA(1, 0, At, B0); PG8_BAR; PG8_SCHED;
            PG8_STAGE(PG8_SB(1, 1), b3 + hstep, voffB);
            PG8_WAIT_V(6); PG8_BAR; PG8_MMA(1, 1, At, B1); PG8_BAR;
            }
        }
        if constexpr (ALIGN_EPI) { if (wr == 0) PG8_BAR; }
        if constexpr (!Epi::AFTER_DRAIN) { E(acc, cur, wr, wc, fr, fq); S.done(cur); }
        if (!has_next) break;
#pragma unroll
        for (int a = 0; a < 2; ++a)
#pragma unroll
            for (int b = 0; b < 2; ++b)
#pragma unroll
                for (int m = 0; m < 4; ++m)
#pragma unroll
                    for (int n = 0; n < 2; ++n) acc[a][b][m][n] = (f32x4){0.f, 0.f, 0.f, 0.f};
        cur = nxt; cA = nA; cB = nB; ++ui;
        if constexpr (ALIGN_EPI) { if (wr == 1) PG8_BAR; }
    }
    PG8_WAIT_V(0);
    if constexpr (!ALIGN_EPI) { if (wr == 0) PG8_BAR; }
    PG8_BAR;
    if constexpr (Epi::AFTER_DRAIN) { E.fused(acc, cur, wr, wc, fr, fq, lds, wid, lane); S.done(cur); }
#undef PG8_SA
#undef PG8_SB
#undef PG8_STAGE
#undef PG8_LDA
#undef PG8_LDB
#undef PG8_MMA
#undef PG8_WAIT_V
#undef PG8_WAIT_L
#undef PG8_BAR
#undef PG8_SCHED
}
}

namespace pg8 {
constexpr float LOG2E = 1.4426950408889634f;
constexpr float QS_NSA = 0.125f * LOG2E;
constexpr float QS_MLA = 0.10206207261596575f * LOG2E;
__device__ __forceinline__ float fast_sigmoid(float x) { return __builtin_amdgcn_rcpf(1.0f + __builtin_amdgcn_exp2f(-LOG2E * x)); }
__device__ __forceinline__ float lo_bf(unsigned u) { return __uint_as_float(u << 16); }
__device__ __forceinline__ float hi_bf(unsigned u) { return __uint_as_float(u & 0xffff0000u); }
struct EpiInProjF {
    static constexpr bool PERM = true, AFTER_DRAIN = false;
    bf16_t* proj; bf16_t* gates;
    __device__ __forceinline__ void operator()(const f32x4 (&acc)[2][2][4][2], const Unit& u, int wr, int wc, int fr, int fq) const {
        const bool isg = u.pn >= 7;
        bf16_t* base = isg ? gates : proj; const int ld = isg ? 2048 : 1792; const int colt = isg ? (u.pn - 7) * BM : u.pn * BM;
        const float sc = (u.pn < 2) ? QS_NSA : 1.0f;
        const int row0 = u.pm * BM + wr * 64 + fr, col0 = colt + wc * 32 + 8 * fq;
#pragma unroll
        for (int ai = 0; ai < 2; ++ai)
#pragma unroll
            for (int m = 0; m < 4; ++m) { bf16_t* rowp = base + (size_t)(row0 + ai * HALF + m * 16) * ld + col0;
#pragma unroll
                for (int bj = 0; bj < 2; ++bj) { f32x4 v0 = acc[ai][bj][m][0], v1 = acc[ai][bj][m][1];
                    if (isg) {
#pragma unroll
                        for (int e = 0; e < 4; ++e) { v0[e] = fast_sigmoid(v0[e]); v1[e] = fast_sigmoid(v1[e]); } }
                    else { v0 = v0 * sc; v1 = v1 * sc; }
                    u32x4 w; w.x = cvt_pk_bf16(v0[0], v0[1]); w.y = cvt_pk_bf16(v0[2], v0[3]); w.z = cvt_pk_bf16(v1[0], v1[1]); w.w = cvt_pk_bf16(v1[2], v1[3]);
                    *(u32x4*)(rowp + bj * HALF) = w; } }
    }
};
template <int PASS> struct EpiMergeF {
    static constexpr bool PERM = true, AFTER_DRAIN = false;
    const bf16_t* gates; bf16_t* merged;
    __device__ __forceinline__ void operator()(const f32x4 (&acc)[2][2][4][2], const Unit& u, int wr, int wc, int fr, int fq) const {
        const int row0 = u.pm * BM + wr * 64 + fr, col0 = u.pn * BM + wc * 32 + 8 * fq;
#pragma unroll
        for (int ai = 0; ai < 2; ++ai)
#pragma unroll
            for (int m = 0; m < 4; ++m) { const size_t r = (size_t)(row0 + ai * HALF + m * 16);
#pragma unroll
                for (int bj = 0; bj < 2; ++bj) { const int c = col0 + bj * HALF;
                    const u32x4 g = *(const u32x4*)(gates + r * 2048 + PASS * 1024 + c);
                    f32x4 v0 = acc[ai][bj][m][0], v1 = acc[ai][bj][m][1];
                    v0[0] *= lo_bf(g.x); v0[1] *= hi_bf(g.x); v0[2] *= lo_bf(g.y); v0[3] *= hi_bf(g.y);
                    v1[0] *= lo_bf(g.z); v1[1] *= hi_bf(g.z); v1[2] *= lo_bf(g.w); v1[3] *= hi_bf(g.w);
                    if (PASS == 1) { const u32x4 o = *(const u32x4*)(merged + r * 1024 + c);
                        v0[0] += lo_bf(o.x); v0[1] += hi_bf(o.x); v0[2] += lo_bf(o.y); v0[3] += hi_bf(o.y);
                        v1[0] += lo_bf(o.z); v1[1] += hi_bf(o.z); v1[2] += lo_bf(o.w); v1[3] += hi_bf(o.w); }
                    u32x4 w; w.x = cvt_pk_bf16(v0[0], v0[1]); w.y = cvt_pk_bf16(v0[2], v0[3]); w.z = cvt_pk_bf16(v1[0], v1[1]); w.w = cvt_pk_bf16(v1[2], v1[3]);
                    *(u32x4*)(merged + r * 1024 + c) = w; } }
    }
};
struct EpiResidF {
    static constexpr bool PERM = false, AFTER_DRAIN = false;
    const float* x; float* h;
    __device__ __forceinline__ void operator()(const f32x4 (&acc)[2][2][4][2], const Unit& u, int wr, int wc, int fr, int fq) const {
        const int row0 = u.pm * BM + wr * 64 + fr, col0 = u.pn * BM + wc * 32 + 4 * fq;
#pragma unroll
        for (int ai = 0; ai < 2; ++ai)
#pragma unroll
            for (int m = 0; m < 4; ++m) { const size_t off = (size_t)(row0 + ai * HALF + m * 16) * 1024 + col0;
#pragma unroll
                for (int bj = 0; bj < 2; ++bj)
#pragma unroll
                    for (int n = 0; n < 2; ++n) { const f32x4 xv = *(const f32x4*)(x + off + bj * HALF + n * 16); *(f32x4*)(h + off + bj * HALF + n * 16) = xv + acc[ai][bj][m][n]; } }
    }
};
struct EpiMlaQF {
    static constexpr bool PERM = false, AFTER_DRAIN = false;
    bf16_t* q; const float2* cs;
    __device__ __forceinline__ void operator()(const f32x4 (&acc)[2][2][4][2], const Unit& u, int wr, int wc, int fr, int fq) const {
        const int row0 = u.pm * BM + wr * 64 + fr;
#pragma unroll
        for (int bj = 0; bj < 2; ++bj) {
            const int X = u.pn * BM + bj * HALF + wc * 32;
            const bool rope = (X % 96) == 64;
#pragma unroll
            for (int ai = 0; ai < 2; ++ai)
#pragma unroll
                for (int m = 0; m < 4; ++m) { const int r = row0 + ai * HALF + m * 16; const int pos = r & (SEQ - 1);
                    f32x4 v0 = acc[ai][bj][m][0], v1 = acc[ai][bj][m][1];
                    if (rope) {
#pragma unroll
                        for (int j = 0; j < 4; ++j) { const float2 c = cs[pos * 16 + 4 * fq + j]; const float x1 = v0[j], x2 = v1[j]; v0[j] = x1 * c.x - x2 * c.y; v1[j] = x2 * c.x + x1 * c.y; } }
                    v0 = v0 * QS_MLA; v1 = v1 * QS_MLA;
                    bf16_t* p = q + (size_t)r * 768 + X + 4 * fq;
                    uint2 w0, w1; w0.x = cvt_pk_bf16(v0[0], v0[1]); w0.y = cvt_pk_bf16(v0[2], v0[3]); w1.x = cvt_pk_bf16(v1[0], v1[1]); w1.y = cvt_pk_bf16(v1[2], v1[3]);
                    *(uint2*)p = w0; *(uint2*)(p + 16) = w1; }
        }
    }
};
}

#define PG8_SP2 true
#define PG8_ALIGN true
constexpr int NTHR = 512, NWV = NTHR / 64;
#define WAVE_IDS const int lane = threadIdx.x & 63, wv = threadIdx.x >> 6; const int gw = blockIdx.x * NWV + wv, nw = gridDim.x * NWV; (void)lane; (void)gw; (void)nw;

DEV void ph_rms1024(const float* __restrict__ src, const float* __restrict__ g, bf16_t* __restrict__ dst, int rows) {
  WAVE_IDS
  for (int r = gw; r < rows; r += nw) {
    const float4* s4 = (const float4*)(src + (size_t)r * 1024);
    float4 v[4]; float ss = 0.f;
#pragma unroll
    for (int j = 0; j < 4; ++j) { v[j] = s4[j * 64 + lane]; ss += v[j].x * v[j].x + v[j].y * v[j].y + v[j].z * v[j].z + v[j].w * v[j].w; }
    ss = wsum(ss);
    const float inv = rsqrtf(ss * (1.0f / 1024.0f) + 1e-6f);
#pragma unroll
    for (int j = 0; j < 4; ++j) {
      const float4 gg = ((const float4*)g)[j * 64 + lane];
      uint2 o;
      o.x = (unsigned)f2bf(v[j].x * inv * gg.x) | ((unsigned)f2bf(v[j].y * inv * gg.y) << 16);
      o.y = (unsigned)f2bf(v[j].z * inv * gg.z) | ((unsigned)f2bf(v[j].w * inv * gg.w) << 16);
      ((uint2*)(dst + (size_t)r * 1024))[j * 64 + lane] = o;
    }
  }
}
template <int PER> DEV void ph_rms_cols(const bf16_t* __restrict__ proj, int col0, const float* __restrict__ g, bf16_t* __restrict__ dst) {
  WAVE_IDS
  constexpr int W = 64 * PER;
  for (int r = gw; r < T; r += nw) {
    float v[PER]; float ss = 0.f;
#pragma unroll
    for (int j = 0; j < PER; ++j) { v[j] = bf2f(proj[(size_t)r * PROJ_LD + col0 + j * 64 + lane]); ss += v[j] * v[j]; }
    ss = wsum(ss);
    const float inv = rsqrtf(ss * (1.0f / W) + 1e-6f);
#pragma unroll
    for (int j = 0; j < PER; ++j) dst[(size_t)r * W + j * 64 + lane] = f2bf(v[j] * inv * g[j * 64 + lane]);
  }
}

DEV int win_src_col(int n) {
  if (n < 1280) return n;
  if (n < 1536) return 1304 + (n - 1280);
  if (n < 1664) return 1560 + (n - 1536);
  if (n < 1696) return 1688 + (n - 1664);
  if (n < 1720) return 1280 + (n - 1696);
  if (n < 1792) return -1;
  return 1720 + (n - 1792);
}
template <int MODE> DEV void ph_convT(const float* __restrict__ W, int K, int Nsrc, bf16_t* __restrict__ WT, int Nout, char* lds) {
  float (*t)[33] = (float (*)[33])lds;
  const int tx = threadIdx.x & 31, ty = threadIdx.x >> 5;
  const int ntn = (Nout + 31) / 32, ntk = K / 32;
  for (int tile = blockIdx.x; tile < ntn * ntk; tile += gridDim.x) {
    const int n0 = (tile % ntn) * 32, k0 = (tile / ntn) * 32;
#pragma unroll
    for (int i = 0; i < 2; ++i) {
      const int k = k0 + ty + 16 * i, n = n0 + tx;
      const int sc = (MODE == 1) ? win_src_col(n) : n;
      t[ty + 16 * i][tx] = (n < Nout && sc >= 0) ? W[(size_t)k * Nsrc + sc] : 0.f;
    }
    __syncthreads();
#pragma unroll
    for (int i = 0; i < 2; ++i) {
      const int n = n0 + ty + 16 * i, k = k0 + tx;
      if (n < Nout) WT[(size_t)n * K + k] = f2bf(t[tx][ty + 16 * i]);
    }
    __syncthreads();
  }
}
DEV void ph_conv_plain(const float* __restrict__ src, bf16_t* __restrict__ dst, int n) {
  for (int i = blockIdx.x * NTHR + threadIdx.x; i < n; i += gridDim.x * NTHR) dst[i] = f2bf(src[i]);
}

DEV void gemm_tile(const bf16_t* __restrict__ A, int lda, const bf16_t* __restrict__ Bt, int ldb, int m0, int n0, int K, float (&acc)[4][4], char* lds) {
  float (*sA)[132] = (float (*)[132])lds;
  float (*sB)[68] = (float (*)[68])(lds + 32 * 132 * 4);
  const int tid = threadIdx.x, ty = tid >> 4, tx = tid & 15;
  const int lr = tid >> 2, lk = (tid & 3) * 8;
  for (int k0 = 0; k0 < K; k0 += 32) {
    {
      const uint4 va = *(const uint4*)(A + (size_t)(m0 + lr) * lda + k0 + lk);
      const unsigned ua[4] = {va.x, va.y, va.z, va.w};
#pragma unroll
      for (int j = 0; j < 4; ++j) { sA[lk + 2 * j][lr] = __uint_as_float(ua[j] << 16); sA[lk + 2 * j + 1][lr] = __uint_as_float(ua[j] & 0xffff0000u); }
    }
    if (tid < 256) {
      const uint4 vb = *(const uint4*)(Bt + (size_t)(n0 + lr) * ldb + k0 + lk);
      const unsigned ub[4] = {vb.x, vb.y, vb.z, vb.w};
#pragma unroll
      for (int j = 0; j < 4; ++j) { sB[lk + 2 * j][lr] = __uint_as_float(ub[j] << 16); sB[lk + 2 * j + 1][lr] = __uint_as_float(ub[j] & 0xffff0000u); }
    }
    __syncthreads();
#pragma unroll 8
    for (int k = 0; k < 32; ++k) {
      const float4 a = *(const float4*)&sA[k][ty * 4];
      const float4 b = *(const float4*)&sB[k][tx * 4];
      const float av[4] = {a.x, a.y, a.z, a.w}, bv[4] = {b.x, b.y, b.z, b.w};
#pragma unroll
      for (int i = 0; i < 4; ++i)
#pragma unroll
        for (int j = 0; j < 4; ++j) acc[i][j] += av[i] * bv[j];
    }
    __syncthreads();
  }
}
struct EpiInProj { bf16_t* proj; bf16_t* gates;
  DEV void operator()(int m, int n, float v) const { if (n < PROJ_LD) proj[(size_t)m * PROJ_LD + n] = f2bf(v); else gates[(size_t)m * 2048 + (n - PROJ_LD)] = f2bf(sigmoidf_(v)); } };
struct EpiStore { bf16_t* dst; int ld;
  DEV void operator()(int m, int n, float v) const { dst[(size_t)m * ld + n] = f2bf(v); } };
struct EpiGelu { bf16_t* dst; int ld;
  DEV void operator()(int m, int n, float v) const { dst[(size_t)m * ld + n] = f2bf(gelu_exact(v)); } };
struct EpiCmpOut { bf16_t* dst;
  DEV void operator()(int m, int n, float v) const { if (m >= BATCH * NC * 2) return; const int g = m & 1, bc = m >> 1, b = bc / NC, c = bc % NC; dst[((size_t)(b * 2 + g) * 128 + c) * 64 + n] = f2bf(v); } };
struct EpiResid { const float* x; float* h;
  DEV void operator()(int m, int n, float v) const { const size_t i = (size_t)m * 1024 + n; h[i] = x[i] + v; } };

template <class Epi> DEV void ph_gemm(const bf16_t* A, int lda, const bf16_t* Bt, int ldb, int M, int N, int K, const Epi& epi, char* lds) {
  const int ntn = N / 64, ntm = M / 128;
  const int ty = threadIdx.x >> 4, tx = threadIdx.x & 15;
  for (int tile = blockIdx.x; tile < ntn * ntm; tile += gridDim.x) {
    const int m0 = (tile / ntn) * 128, n0 = (tile % ntn) * 64;
    float acc[4][4];
#pragma unroll
    for (int i = 0; i < 4; ++i)
#pragma unroll
      for (int j = 0; j < 4; ++j) acc[i][j] = 0.f;
    gemm_tile(A, lda, Bt, ldb, m0, n0, K, acc, lds);
#pragma unroll
    for (int i = 0; i < 4; ++i)
#pragma unroll
      for (int j = 0; j < 4; ++j) epi(m0 + ty * 4 + i, n0 + tx * 4 + j, acc[i][j]);
  }
}
DEV void ph_merge(const bf16_t* onsa, const bf16_t* omla, const bf16_t* wbn, const bf16_t* wbm, const bf16_t* gates, bf16_t* merged, char* lds) {
  const int ntn = 1024 / 64, ntm = T / 128;
  const int ty = threadIdx.x >> 4, tx = threadIdx.x & 15;
  for (int tile = blockIdx.x; tile < ntn * ntm; tile += gridDim.x) {
    const int m0 = (tile / ntn) * 128, n0 = (tile % ntn) * 64;
    float a1[4][4], a2[4][4];
#pragma unroll
    for (int i = 0; i < 4; ++i)
#pragma unroll
      for (int j = 0; j < 4; ++j) { a1[i][j] = 0.f; a2[i][j] = 0.f; }
    gemm_tile(onsa, 512, wbn, 512, m0, n0, 512, a1, lds);
    gemm_tile(omla, 512, wbm, 512, m0, n0, 512, a2, lds);
#pragma unroll
    for (int i = 0; i < 4; ++i)
#pragma unroll
      for (int j = 0; j < 4; ++j) {
        const int m = m0 + ty * 4 + i, n = n0 + tx * 4 + j;
        merged[(size_t)m * 1024 + n] = f2bf(bf2f(gates[(size_t)m * 2048 + n]) * a1[i][j] + bf2f(gates[(size_t)m * 2048 + 1024 + n]) * a2[i][j]);
      }
  }
}

DEV void ph_rope_table(float2* __restrict__ cs) {
  const int n = SEQ * 16;
  for (int i = blockIdx.x * NTHR + threadIdx.x; i < n; i += gridDim.x * NTHR) {
    const int j = i & 15, pos = i >> 4;
    const float inv_freq = powf(10000.0f, -(float)(2 * j) / 32.0f);
    const float ang = (float)pos * inv_freq;
    cs[i] = make_float2(cosf(ang), sinf(ang));
  }
}
DEV void ph_rope_k(const bf16_t* __restrict__ proj, bf16_t* __restrict__ kr) {
  const int n = T * 16;
  for (int i = blockIdx.x * NTHR + threadIdx.x; i < n; i += gridDim.x * NTHR) {
    const int j = i & 15, t = i >> 4;
    const float pos = (float)(t & (SEQ - 1));
    const float inv_freq = powf(10000.0f, -(float)(2 * j) / 32.0f);
    const float ang = pos * inv_freq, c = cosf(ang), s = sinf(ang);
    const float x1 = bf2f(proj[(size_t)t * PROJ_LD + PC_KR + j]), x2 = bf2f(proj[(size_t)t * PROJ_LD + PC_KR + 16 + j]);
    kr[(size_t)t * 32 + j] = f2bf(x1 * c - x2 * s); kr[(size_t)t * 32 + 16 + j] = f2bf(x2 * c + x1 * s);
  }
}
DEV void ph_cmp_gather(const bf16_t* __restrict__ proj, const float* __restrict__ pos, int which, bf16_t* __restrict__ ca) {
  const int n = 2048 * 2048;
  for (int i = blockIdx.x * NTHR + threadIdx.x; i < n; i += gridDim.x * NTHR) {
    const int e = i & 2047, row = i >> 11;
    float v = 0.f;
    if (row < BATCH * NC * 2) {
      const int g = row & 1, bc = row >> 1, b = bc / NC, c = bc % NC, l = e >> 6, d = e & 63;
      v = bf2f(proj[(size_t)(b * SEQ + 16 * c + l) * PROJ_LD + PC_KV + which * 128 + g * 64 + d]) + pos[e];
    }
    ca[i] = f2bf(v);
  }
}

DEV void ph_cmp_attn(const bf16_t* __restrict__ proj, const bf16_t* __restrict__ kc, const bf16_t* __restrict__ vc,
                     const float* __restrict__ t5, bf16_t* __restrict__ ocmp, unsigned* __restrict__ sel, char* lds) {
  WAVE_IDS
  float* P = (float*)(lds + wv * 1024); float* Q = P + 128;
  for (int item = gw; item < BATCH * 2 * SEQ; item += nw) {
    const int t = item & (SEQ - 1), bg = item >> 11, g = bg & 1, b = bg >> 1;
    const size_t tok = (size_t)b * SEQ + t;
    const int nvalid = (t >= 31) ? min(NC, (t - 31) / 16 + 1) : 0;
    const bf16_t* kcb = kc + (size_t)bg * 128 * 64;
    const bf16_t* vcb = vc + (size_t)bg * 128 * 64;
    float impacc = 0.f;
    for (int r = 0; r < 4; ++r) {
      const int head = g * 4 + r;
      Q[lane] = bf2f(proj[tok * PROJ_LD + PC_Q + head * 64 + lane]);
      wave_lds_sync();
      float lg[2];
#pragma unroll
      for (int u = 0; u < 2; ++u) {
        const int c = lane + 64 * u;
        float d = 0.f;
        if (c < nvalid) { const bf16_t* kr = kcb + c * 64; for (int e = 0; e < 64; ++e) d += Q[e] * bf2f(kr[e]); }
        lg[u] = (c < nvalid) ? d + 1.4426950408889634f * t5bias(t5, head, t - (16 * c + 31)) : -1e30f;
      }
      const float m = wmaxf(fmaxf(lg[0], lg[1]));
      const float e0 = (lane < nvalid) ? exp2f(lg[0] - m) : 0.f, e1 = (lane + 64 < nvalid) ? exp2f(lg[1] - m) : 0.f;
      const float s = wsum(e0 + e1);
      const float inv = (nvalid > 0) ? 1.0f / fmaxf(s, 1e-30f) : 0.f;
      P[lane] = e0 * inv; P[lane + 64] = e1 * inv;
      wave_lds_sync();
      float o = 0.f;
      for (int c = 0; c < nvalid; ++c) o += P[c] * bf2f(vcb[c * 64 + lane]);
      ocmp[tok * 512 + head * 64 + lane] = f2bf(o);
      if (lane < 32) { for (int c = 4 * lane - 1; c <= 4 * lane + 3; ++c) if (c >= 0 && c < NC) impacc += P[c]; }
      wave_lds_sync();
    }
    const int cur = t >> 6, n = lane;
    float score = (n > cur) ? -1.0f : ((n == 0 || n == cur || n == cur - 1) ? 1e4f : impacc);
    if (n >= 32) score = -2.0f;
    int rank = 0;
    for (int mth = 0; mth < 32; ++mth) { const float sm = __shfl(score, mth); rank += (sm > score || (sm == score && mth < n)) ? 1 : 0; }
    const unsigned long long bal = __ballot(n < 32 && rank < 16);
    if (lane == 0) sel[item] = (unsigned)bal;
  }
}

DEV void ph_nsa_attn(const bf16_t* __restrict__ proj, const float* __restrict__ t5, const bf16_t* __restrict__ ocmp,
                     const unsigned* __restrict__ sel, bf16_t* __restrict__ onsa, char* lds) {
  WAVE_IDS
  float* P = (float*)(lds + wv * 1024); float* Q = P + 128;
  for (int item = gw; item < BATCH * 2 * SEQ * 4; item += nw) {
    const int r = item & 3, t = (item >> 2) & (SEQ - 1), bg = item >> 13, g = bg & 1, b = bg >> 1;
    const int head = g * 4 + r, cur = t >> 6;
    const size_t tok = (size_t)b * SEQ + t;
    Q[lane] = bf2f(proj[tok * PROJ_LD + PC_Q + head * 64 + lane]);
    wave_lds_sync();
    const unsigned smask = sel[bg * SEQ + t];
    float res0 = 0.f, res1 = 0.f;
    for (int br = 0; br < 2; ++br) {
      float m = -1e30f, l = 0.f, o = 0.f;
      const int nb0 = (br == 0) ? 0 : max(0, cur - 8);
      for (int nb = nb0; nb <= cur; ++nb) {
        if (br == 0 && !((smask >> nb) & 1u)) continue;
        const int s = nb * 64 + lane, dist = t - s;
        const bool valid = (dist >= 0) && (br == 0 || dist < 512);
        const bf16_t* kp = proj + ((size_t)b * SEQ + s) * PROJ_LD + PC_KV + (2 + 2 * br) * 128 + g * 64;
        float d = 0.f;
        for (int e = 0; e < 64; e += 8) {
          const uint4 kv = *(const uint4*)(kp + e);
          d += Q[e + 0] * __uint_as_float(kv.x << 16) + Q[e + 1] * __uint_as_float(kv.x & 0xffff0000u);
          d += Q[e + 2] * __uint_as_float(kv.y << 16) + Q[e + 3] * __uint_as_float(kv.y & 0xffff0000u);
          d += Q[e + 4] * __uint_as_float(kv.z << 16) + Q[e + 5] * __uint_as_float(kv.z & 0xffff0000u);
          d += Q[e + 6] * __uint_as_float(kv.w << 16) + Q[e + 7] * __uint_as_float(kv.w & 0xffff0000u);
        }
        const float lg = valid ? d + 1.4426950408889634f * t5bias(t5, head, dist) : -1e30f;
        const float mn = fmaxf(m, wmaxf(lg));
        const float sc = exp2f(m - mn);
        const float pe = valid ? exp2f(lg - mn) : 0.f;
        l = l * sc + wsum(pe); m = mn;
        P[lane] = pe;
        wave_lds_sync();
        const bf16_t* vp = proj + ((size_t)b * SEQ + nb * 64) * PROJ_LD + PC_KV + (3 + 2 * br) * 128 + g * 64 + lane;
        float acc = 0.f;
        for (int k = 0; k < 64; ++k) acc += P[k] * bf2f(vp[(size_t)k * PROJ_LD]);
        o = o * sc + acc;
        wave_lds_sync();
      }
      if (br == 0) res0 = o / fmaxf(l, 1e-30f); else res1 = o / fmaxf(l, 1e-30f);
    }
    const bf16_t* gp = proj + tok * PROJ_LD + PC_GATE + head * 3;
    const float g0 = sigmoidf_(bf2f(gp[0])), g1 = sigmoidf_(bf2f(gp[1])), g2 = sigmoidf_(bf2f(gp[2]));
    const float oc = bf2f(ocmp[tok * 512 + head * 64 + lane]);
    onsa[tok * 512 + head * 64 + lane] = f2bf(g0 * oc + g1 * res0 + g2 * res1);
    wave_lds_sync();
  }
}

DEV void ph_mla_attn(const bf16_t* __restrict__ mq, const bf16_t* __restrict__ mkv, const bf16_t* __restrict__ kr, bf16_t* __restrict__ omla, char* lds) {
  WAVE_IDS
  float* P = (float*)(lds + wv * 1024); float* Q = P + 128;
  for (int item = gw; item < BATCH * 8 * SEQ; item += nw) {
    const int h = item & 7, t = (item >> 3) & (SEQ - 1), b = item >> 14;
    const size_t tok = (size_t)b * SEQ + t;
    Q[lane] = bf2f(mq[tok * 768 + h * 96 + lane]);
    if (lane < 32) Q[64 + lane] = bf2f(mq[tok * 768 + h * 96 + 64 + lane]);
    wave_lds_sync();
    float m = -1e30f, l = 0.f, o = 0.f;
    for (int nb = 0; nb <= (t >> 6); ++nb) {
      const int s = nb * 64 + lane;
      const bool valid = s <= t;
      const bf16_t* kp = mkv + ((size_t)b * SEQ + s) * 1024 + h * 128;
      const bf16_t* rp = kr + ((size_t)b * SEQ + s) * 32;
      float d = 0.f;
      for (int e = 0; e < 64; e += 8) {
        const uint4 kv = *(const uint4*)(kp + e);
        d += Q[e + 0] * __uint_as_float(kv.x << 16) + Q[e + 1] * __uint_as_float(kv.x & 0xffff0000u);
        d += Q[e + 2] * __uint_as_float(kv.y << 16) + Q[e + 3] * __uint_as_float(kv.y & 0xffff0000u);
        d += Q[e + 4] * __uint_as_float(kv.z << 16) + Q[e + 5] * __uint_as_float(kv.z & 0xffff0000u);
        d += Q[e + 6] * __uint_as_float(kv.w << 16) + Q[e + 7] * __uint_as_float(kv.w & 0xffff0000u);
      }
      for (int e = 0; e < 32; e += 8) {
        const uint4 kv = *(const uint4*)(rp + e);
        d += Q[64 + e + 0] * __uint_as_float(kv.x << 16) + Q[64 + e + 1] * __uint_as_float(kv.x & 0xffff0000u);
        d += Q[64 + e + 2] * __uint_as_float(kv.y << 16) + Q[64 + e + 3] * __uint_as_float(kv.y & 0xffff0000u);
        d += Q[64 + e + 4] * __uint_as_float(kv.z << 16) + Q[64 + e + 5] * __uint_as_float(kv.z & 0xffff0000u);
        d += Q[64 + e + 6] * __uint_as_float(kv.w << 16) + Q[64 + e + 7] * __uint_as_float(kv.w & 0xffff0000u);
      }
      const float lg = valid ? d : -1e30f;
      const float mn = fmaxf(m, wmaxf(lg));
      const float sc = exp2f(m - mn);
      const float pe = valid ? exp2f(lg - mn) : 0.f;
      l = l * sc + wsum(pe); m = mn;
      P[lane] = pe;
      wave_lds_sync();
      const bf16_t* vp = mkv + ((size_t)b * SEQ + nb * 64) * 1024 + h * 128 + 64 + lane;
      float acc = 0.f;
      for (int k = 0; k < 64; ++k) acc += P[k] * bf2f(vp[(size_t)k * 1024]);
      o = o * sc + acc;
      wave_lds_sync();
    }
    omla[tok * 512 + h * 64 + lane] = f2bf(o / fmaxf(l, 1e-30f));
    wave_lds_sync();
  }
}

DEV void wave_argmax(float& v, int& idx) {
#pragma unroll
  for (int o = 32; o > 0; o >>= 1) {
    const float ov = __shfl_xor(v, o); const int oi = __shfl_xor(idx, o);
    if (ov > v || (ov == v && oi < idx)) { v = ov; idx = oi; }
  }
}
DEV void ph_route(const bf16_t* __restrict__ pq, const bf16_t* __restrict__ subk, int* __restrict__ pidx, float* __restrict__ pw, char* lds) {
  WAVE_IDS
  float* Q = (float*)(lds + wv * 1024);
  float* TS = Q + 128;
  int* TI = (int*)(TS + 32);
  for (int item = gw; item < T * 8; item += nw) {
    const int h = item & 7, t = item >> 3;
    Q[lane] = bf2f(pq[(size_t)t * 1024 + h * 128 + lane]);
    Q[lane + 64] = bf2f(pq[(size_t)t * 1024 + h * 128 + 64 + lane]);
    wave_lds_sync();
    for (int p = 0; p < 2; ++p) {
      const bf16_t* kb = subk + (size_t)((h * 2 + p) * 128) * 64;
      float s0 = 0.f, s1 = 0.f;
      for (int e = 0; e < 64; ++e) { const float qv = Q[p * 64 + e]; s0 += qv * bf2f(kb[lane * 64 + e]); s1 += qv * bf2f(kb[(lane + 64) * 64 + e]); }
      for (int k = 0; k < 16; ++k) {
        float v = (s0 >= s1) ? s0 : s1; int idx = (s0 >= s1) ? lane : lane + 64;
        wave_argmax(v, idx);
        if (lane == 0) { TS[p * 16 + k] = v; TI[p * 16 + k] = idx; }
        if (idx == lane) s0 = -3e38f;
        if (idx == lane + 64) s1 = -3e38f;
      }
    }
    wave_lds_sync();
    float cv[4];
#pragma unroll
    for (int u = 0; u < 4; ++u) { const int f = lane + 64 * u; cv[u] = TS[f >> 4] + TS[16 + (f & 15)]; }
    int myexp = 0; float mybest = 0.f, best0 = 0.f, den = 0.f;
#pragma unroll
    for (int k = 0; k < 16; ++k) {
      float v = cv[0]; int idx = lane;
#pragma unroll
      for (int u = 1; u < 4; ++u) if (cv[u] > v) { v = cv[u]; idx = lane + 64 * u; }
      wave_argmax(v, idx);
#pragma unroll
      for (int u = 0; u < 4; ++u) if (idx == lane + 64 * u) cv[u] = -3e38f;
      if (k == 0) best0 = v;
      den += expf(v - best0);
      if (lane == k) { myexp = TI[idx >> 4] * 128 + TI[16 + (idx & 15)]; mybest = v; }
    }
    if (lane < 16) { pidx[(size_t)t * 128 + h * 16 + lane] = myexp; pw[(size_t)t * 128 + h * 16 + lane] = expf(mybest - best0) / den; }
    wave_lds_sync();
  }
}

DEV void ph_experts(const bf16_t* __restrict__ hn, const int* __restrict__ pidx, const float* __restrict__ pw,
                    const float* __restrict__ pu, const float* __restrict__ pv, const float* __restrict__ gfin, float* __restrict__ out) {
  WAVE_IDS
  for (int t = gw; t < T; t += nw) {
    float4 x[4], y[4];
#pragma unroll
    for (int j = 0; j < 4; ++j) {
      const uint2 r = ((const uint2*)(hn + (size_t)t * 1024))[j * 64 + lane];
      x[j] = make_float4(__uint_as_float(r.x << 16), __uint_as_float(r.x & 0xffff0000u), __uint_as_float(r.y << 16), __uint_as_float(r.y & 0xffff0000u));
      y[j] = make_float4(0.f, 0.f, 0.f, 0.f);
    }
    const int e0 = pidx[(size_t)t * 128 + lane], e1 = pidx[(size_t)t * 128 + 64 + lane];
    const float w0 = pw[(size_t)t * 128 + lane], w1 = pw[(size_t)t * 128 + 64 + lane];
    for (int s = 0; s < 128; ++s) {
      const int e = __shfl((s < 64) ? e0 : e1, s & 63);
      const float w = __shfl((s < 64) ? w0 : w1, s & 63);
      const float4* ur = (const float4*)(pu + (size_t)e * 1024);
      float d = 0.f;
#pragma unroll
      for (int j = 0; j < 4; ++j) { const float4 u = ur[j * 64 + lane]; d += u.x * x[j].x + u.y * x[j].y + u.z * x[j].z + u.w * x[j].w; }
      d = wsum(d);
      const float c = w * gelu_exact(d);
      const float4* vr = (const float4*)(pv + (size_t)e * 1024);
#pragma unroll
      for (int j = 0; j < 4; ++j) { const float4 v = vr[j * 64 + lane]; y[j].x += c * v.x; y[j].y += c * v.y; y[j].z += c * v.z; y[j].w += c * v.w; }
    }
    float4* o4 = (float4*)(out + (size_t)t * 1024);
    float ss = 0.f;
#pragma unroll
    for (int j = 0; j < 4; ++j) {
      const float4 hv = o4[j * 64 + lane];
      y[j].x += hv.x; y[j].y += hv.y; y[j].z += hv.z; y[j].w += hv.w;
      ss += y[j].x * y[j].x + y[j].y * y[j].y + y[j].z * y[j].z + y[j].w * y[j].w;
    }
    ss = wsum(ss);
    const float inv = rsqrtf(ss * (1.0f / 1024.0f) + 1e-6f);
#pragma unroll
    for (int j = 0; j < 4; ++j) {
      const float4 gg = ((const float4*)gfin)[j * 64 + lane];
      o4[j * 64 + lane] = make_float4(y[j].x * inv * gg.x, y[j].y * inv * gg.y, y[j].z * inv * gg.z, y[j].w * inv * gg.w);
    }
  }
}


namespace att {
#define LAS3 __attribute__((address_space(3)))
typedef LAS3 char* lptr;
typedef LAS3 const char* lcptr;
using bf16x8 = __attribute__((ext_vector_type(8))) short;
using s16x4 = __attribute__((ext_vector_type(4))) short;
using f32x16 = __attribute__((ext_vector_type(16))) float;
typedef short v4i16_t __attribute__((ext_vector_type(4)));
typedef unsigned u32x4 __attribute__((ext_vector_type(4)));
typedef float f32x4_t __attribute__((ext_vector_type(4)));
typedef float f32x2_t __attribute__((ext_vector_type(2)));
typedef __bf16 bf16x2_t __attribute__((ext_vector_type(2)));
constexpr float LOG2E = 1.4426950408889634f;
constexpr float THR = 6.0f;
constexpr float NEG_INF = -__builtin_huge_valf();
constexpr int SLOT = 20480, KOFF = 0, VOFF = 12288;
constexpr int L_WSF = 2 * SLOT;
constexpr int L_TB = L_WSF + 2048;
constexpr int L_SELM = L_TB + 4096;
constexpr int L_SC = L_SELM + 256;
constexpr int L_IMPQ = L_SC + 64 * 33 * 4;
constexpr int L_IMPL = L_IMPQ + 4 * 64 * 33 * 4;
constexpr int L_FIN = L_IMPQ;
constexpr int L_END = L_IMPL + 4 * 64 * 33 * 4;
static_assert(L_END <= 131072, "attention LDS map");

__device__ __forceinline__ int crow(int r, int hi) { return (r & 3) + 8 * (r >> 2) + 4 * hi; }
__device__ __forceinline__ s16x4 vtr(lcptr p) { return __builtin_bit_cast(s16x4, __builtin_amdgcn_ds_read_tr16_b64_v4i16((LAS3 v4i16_t*)p)); }
__device__ __forceinline__ unsigned cvtpk(float lo, float hi) { f32x2_t v = {lo, hi}; bf16x2_t b = __builtin_convertvector(v, bf16x2_t); return __builtin_bit_cast(unsigned, b); }
__device__ __forceinline__ float xmax(float v) { auto rr = __builtin_amdgcn_permlane32_swap(__float_as_uint(v), __float_as_uint(v), false, false); return fmaxf(__uint_as_float(rr[0]), __uint_as_float(rr[1])); }
__device__ __forceinline__ float xsum(float v) { auto rr = __builtin_amdgcn_permlane32_swap(__float_as_uint(v), __float_as_uint(v), false, false); return __uint_as_float(rr[0]) + __uint_as_float(rr[1]); }
__device__ __forceinline__ float ex2(float x) { return __builtin_amdgcn_exp2f(x); }

template <int ND0> __device__ __forceinline__ void qkt(f32x16& p0, f32x16& p1, lcptr kb, const bf16x8* qr) {
  p0 = f32x16{}; p1 = f32x16{};
#pragma unroll
  for (int d0 = 0; d0 < ND0; ++d0) {
    const bf16x8 b0 = *(const LAS3 bf16x8*)(kb + d0 * 2048);
    const bf16x8 b1 = *(const LAS3 bf16x8*)(kb + d0 * 2048 + 512);
    p0 = __builtin_amdgcn_mfma_f32_32x32x16_bf16(b0, qr[d0], p0, 0, 0, 0);
    p1 = __builtin_amdgcn_mfma_f32_32x32x16_bf16(b1, qr[d0], p1, 0, 0, 0);
  }
}
__device__ __forceinline__ void pv(f32x16 (&o)[2], lcptr vp, const unsigned (&pw)[16]) {
#pragma unroll
  for (int d0 = 0; d0 < 2; ++d0)
#pragma unroll
    for (int ks = 0; ks < 4; ++ks) {
      const s16x4 lo = vtr(vp + d0 * 4096 + ks * 1024), hi4 = vtr(vp + d0 * 4096 + ks * 1024 + 512);
      const bf16x8 vf = {lo[0], lo[1], lo[2], lo[3], hi4[0], hi4[1], hi4[2], hi4[3]};
      const unsigned pa4[4] = {pw[4 * ks], pw[4 * ks + 1], pw[4 * ks + 2], pw[4 * ks + 3]};
      o[d0] = __builtin_amdgcn_mfma_f32_32x32x16_bf16(__builtin_bit_cast(bf16x8, pa4), vf, o[d0], 0, 0, 0);
    }
}
__device__ __forceinline__ void softmax_step(f32x16& p0, f32x16& p1, float& m, float& l, f32x16 (&o)[2], LAS3 float* wsf, int r32, int hi, unsigned (&pw)[16]) {
  float rm = fmaxf(p0[0], p1[0]);
#pragma unroll
  for (int r = 1; r < 16; ++r) rm = fmaxf(rm, fmaxf(p0[r], p1[r]));
  rm = xmax(rm);
  if (__any(rm > m + THR)) {
    const float mn = fmaxf(m, rm);
    const float al = ex2(m - mn);
    m = mn; l *= al;
    if (hi == 0) wsf[r32] = al;
#pragma unroll
    for (int r = 0; r < 16; ++r) { const float f = wsf[crow(r, hi)]; o[0][r] *= f; o[1][r] *= f; }
  }
  float s = 0.f;
#pragma unroll
  for (int r = 0; r < 16; ++r) { p0[r] = ex2(p0[r] - m); p1[r] = ex2(p1[r] - m); s += p0[r] + p1[r]; }
  l += s;
#pragma unroll
  for (int i = 0; i < 8; ++i) { pw[i] = cvtpk(p0[2 * i], p0[2 * i + 1]); pw[8 + i] = cvtpk(p1[2 * i], p1[2 * i + 1]); }
}
struct KVSrc { const bf16_t* k; const bf16_t* v; int ldk, ldv; };
__device__ __forceinline__ void kv_issue(const KVSrc& s, int row0, u32x4& rk, u32x4& rv, int tid) {
  const int kv = tid & 63, ch = tid >> 6, ln = tid & 63;
  rk = *(const u32x4*)(s.k + (size_t)(row0 + kv) * s.ldk + ch * 8);
  rv = *(const u32x4*)(s.v + (size_t)(row0 + 16 * (ch & 3) + (ln >> 2)) * s.ldv + (ch >> 2) * 32 + (ln & 3) * 8);
}
__device__ __forceinline__ void kv_commit(lptr slot, const u32x4& rk, const u32x4& rv, int tid) {
  *(LAS3 u32x4*)(slot + KOFF + (tid >> 6) * 1024 + (tid & 63) * 16) = rk;
  *(LAS3 u32x4*)(slot + VOFF + tid * 16) = rv;
}
__device__ __forceinline__ void fin_set(LAS3 float* finl, const f32x16 (&o)[2], int lane) {
#pragma unroll
  for (int d0 = 0; d0 < 2; ++d0)
#pragma unroll
    for (int r = 0; r < 16; ++r) finl[(d0 * 16 + r) * 64 + lane] = o[d0][r];
}
__device__ __forceinline__ void fin_add(LAS3 float* finl, const f32x16 (&o)[2], const LAS3 float* wsf, int lane, int hi) {
#pragma unroll
  for (int r = 0; r < 16; ++r) { const float f = wsf[crow(r, hi)];
#pragma unroll
    for (int d0 = 0; d0 < 2; ++d0) finl[(d0 * 16 + r) * 64 + lane] += o[d0][r] * f; }
}
__device__ __forceinline__ void fin_store(const LAS3 float* finl, bf16_t* gout, size_t rowbase, int ld, int colbase, int lane) {
#pragma unroll
  for (int i = 0; i < 4; ++i) {
    const int q = i * 8 + (lane >> 3), ch = lane & 7;
    const int qh = (q >> 2) & 1, r = (q & 3) + 4 * (q >> 3), d0 = ch >> 2, dl = (ch & 3) * 8;
    const LAS3 float* p = finl + (d0 * 16 + r) * 64 + qh * 32 + dl;
    const f32x4_t x0 = *(const LAS3 f32x4_t*)p, x1 = *(const LAS3 f32x4_t*)(p + 4);
    u32x4 v; v.x = cvtpk(x0[0], x0[1]); v.y = cvtpk(x0[2], x0[3]); v.z = cvtpk(x1[0], x1[1]); v.w = cvtpk(x1[2], x1[3]);
    *(u32x4*)(gout + (rowbase + q) * (size_t)ld + colbase + ch * 8) = v;
  }
}

__device__ __forceinline__ void nsa_unit(int b, int g, int c, const bf16_t* __restrict__ proj, const bf16_t* __restrict__ kc, const bf16_t* __restrict__ vc, bf16_t* __restrict__ onsa, lptr lds) {
  int tid = threadIdx.x; asm volatile("" : "+v"(tid));
  const int lane = tid & 63, r32 = lane & 31, hi = lane >> 5;
  const int w = __builtin_amdgcn_readfirstlane(tid >> 6);
  const int rh = w >> 1, head = g * 4 + rh, tokl = 32 * (w & 1) + r32, t = 64 * c + tokl, bg = b * 2 + g;
  const size_t tok = (size_t)b * SEQ + t;
  LAS3 float* wsf = (LAS3 float*)(lds + L_WSF) + w * 64;
  const LAS3 float* tb = (const LAS3 float*)(lds + L_TB) + head * 128;
  LAS3 unsigned* selm = (LAS3 unsigned*)(lds + L_SELM);
  LAS3 float* sc = (LAS3 float*)(lds + L_SC);
  LAS3 float* impq = (LAS3 float*)(lds + L_IMPQ);
  LAS3 float* impl = (LAS3 float*)(lds + L_IMPL);
  const lcptr kb0 = (lcptr)lds + KOFF + hi * 1024 + r32 * 16;
  const lcptr vp0 = (lcptr)lds + VOFF + ((lane >> 4) & 1) * 32 + (lane & 3) * 8 + (4 * hi + ((lane & 15) >> 2)) * 64;
  bf16x8 qr[4];
#pragma unroll
  for (int d0 = 0; d0 < 4; ++d0) qr[d0] = *(const bf16x8*)(proj + tok * PROJ_LD + PC_Q + head * 64 + d0 * 16 + hi * 8);
  float gate[3];
#pragma unroll
  for (int j = 0; j < 3; ++j) gate[j] = 1.0f / (1.0f + ex2(-LOG2E * bf2f(proj[tok * PROJ_LD + PC_GATE + head * 3 + j])));
  LAS3 float* finl = (LAS3 float*)(lds + L_FIN) + w * 2048;
  f32x16 o[2]; unsigned pw[16];
  u32x4 rk, rv;
  {
    const KVSrc src{kc + (size_t)bg * 128 * 64, vc + (size_t)bg * 128 * 64, 64, 64};
    __syncthreads();
    kv_issue(src, 0, rk, rv, tid); kv_commit(lds, rk, rv, tid);
    kv_issue(src, 64, rk, rv, tid); kv_commit(lds + SLOT, rk, rv, tid);
    __syncthreads();
    f32x16 a0, a1, b0, b1;
    qkt<4>(a0, a1, kb0, qr); qkt<4>(b0, b1, kb0 + SLOT, qr);
    float rm = NEG_INF;
#pragma unroll
    for (int r = 0; r < 16; ++r) {
      const int cb = crow(r, hi);
      { const int d = t - 16 * cb - 31;          a0[r] = (d < 0) ? NEG_INF : a0[r] + ((d < 113) ? tb[d] : 0.f); }
      { const int d = t - 16 * (cb + 32) - 31;   a1[r] = (d < 0) ? NEG_INF : a1[r] + ((d < 113) ? tb[d] : 0.f); }
      { const int d = t - 16 * (cb + 64) - 31;   b0[r] = (d < 0) ? NEG_INF : b0[r] + ((d < 113) ? tb[d] : 0.f); }
      { const int d = t - 16 * (cb + 96) - 31;   b1[r] = (d < 0) ? NEG_INF : b1[r] + ((d < 113) ? tb[d] : 0.f); }
      rm = fmaxf(fmaxf(rm, fmaxf(a0[r], a1[r])), fmaxf(b0[r], b1[r]));
    }
    rm = xmax(rm);
    const float mref = (rm == NEG_INF) ? 0.f : rm;
    float s = 0.f;
#pragma unroll
    for (int r = 0; r < 16; ++r) { a0[r] = ex2(a0[r] - mref); a1[r] = ex2(a1[r] - mref); b0[r] = ex2(b0[r] - mref); b1[r] = ex2(b1[r] - mref); s += (a0[r] + a1[r]) + (b0[r] + b1[r]); }
    s = xsum(s);
    const float inv = (s > 0.f) ? 1.0f / s : 0.f;
#pragma unroll
    for (int r = 0; r < 16; ++r) { a0[r] *= inv; a1[r] *= inv; b0[r] *= inv; b1[r] *= inv; }
    { LAS3 float* iq = impq + (rh * 64 + tokl) * 33; LAS3 float* il = impl + (rh * 64 + tokl) * 33;
#pragma unroll
      for (int q4 = 0; q4 < 4; ++q4) {
        const int gi = 2 * q4 + hi;
        iq[gi] = (a0[4 * q4] + a0[4 * q4 + 1]) + (a0[4 * q4 + 2] + a0[4 * q4 + 3]);           il[gi] = a0[4 * q4 + 3];
        iq[8 + gi] = (a1[4 * q4] + a1[4 * q4 + 1]) + (a1[4 * q4 + 2] + a1[4 * q4 + 3]);       il[8 + gi] = a1[4 * q4 + 3];
        iq[16 + gi] = (b0[4 * q4] + b0[4 * q4 + 1]) + (b0[4 * q4 + 2] + b0[4 * q4 + 3]);      il[16 + gi] = b0[4 * q4 + 3];
        iq[24 + gi] = (b1[4 * q4] + b1[4 * q4 + 1]) + (b1[4 * q4 + 2] + b1[4 * q4 + 3]);      il[24 + gi] = b1[4 * q4 + 3];
      } }
    o[0] = f32x16{}; o[1] = f32x16{};
#pragma unroll
    for (int i = 0; i < 8; ++i) { pw[i] = cvtpk(a0[2 * i], a0[2 * i + 1]); pw[8 + i] = cvtpk(a1[2 * i], a1[2 * i + 1]); }
    pv(o, vp0, pw);
#pragma unroll
    for (int i = 0; i < 8; ++i) { pw[i] = cvtpk(b0[2 * i], b0[2 * i + 1]); pw[8 + i] = cvtpk(b1[2 * i], b1[2 * i + 1]); }
    pv(o, vp0 + SLOT, pw);
    if (hi == 0) wsf[r32] = gate[0];
#pragma unroll
    for (int r = 0; r < 16; ++r) { const float f = wsf[crow(r, hi)]; o[0][r] *= f; o[1][r] *= f; }
  }
  __syncthreads();
  const KVSrc ssrc{proj + (size_t)b * SEQ * PROJ_LD + PC_KV + 2 * 128 + g * 64, proj + (size_t)b * SEQ * PROJ_LD + PC_KV + 3 * 128 + g * 64, PROJ_LD, PROJ_LD};
  kv_issue(ssrc, 0, rk, rv, tid);
  {
    const int stok = tid >> 3, sub = tid & 7;
#pragma unroll
    for (int k = 0; k < 4; ++k) {
      const int n = sub * 4 + k;
      float imp = 0.f;
#pragma unroll
      for (int hh = 0; hh < 4; ++hh) imp += impq[(hh * 64 + stok) * 33 + n] + ((n > 0) ? impl[(hh * 64 + stok) * 33 + n - 1] : 0.f);
      sc[stok * 33 + n] = (n > c) ? -1.0f : ((n == 0 || n == c || n == c - 1) ? 1e4f : imp);
    }
    if (tid < 64) selm[tid] = 0u;
    __syncthreads();
#pragma unroll
    for (int k = 0; k < 4; ++k) {
      const int n = sub * 4 + k; const float sv = sc[stok * 33 + n]; int rank = 0;
      for (int mm = 0; mm < 32; ++mm) { const float sm = sc[stok * 33 + mm]; rank += (sm > sv || (sm == sv && mm < n)) ? 1 : 0; }
      if (rank < 16) atomicOr((unsigned*)(selm + stok), 1u << n);
    }
    __syncthreads();
  }
  const unsigned mysel = selm[tokl];
  fin_set(finl, o, lane);
#pragma unroll 1
  for (int br = 0; br < 2; ++br) {
    const KVSrc src = (br == 0) ? ssrc : KVSrc{proj + (size_t)b * SEQ * PROJ_LD + PC_KV + 4 * 128 + g * 64, proj + (size_t)b * SEQ * PROJ_LD + PC_KV + 5 * 128 + g * 64, PROJ_LD, PROJ_LD};
    const int n0 = (br == 0) ? 0 : ((c > 8) ? c - 8 : 0);
    if (br == 1) { __syncthreads(); kv_issue(src, n0 * 64, rk, rv, tid); }
    kv_commit(lds, rk, rv, tid);
    float m = -1e30f, l = 0.f;
    o[0] = f32x16{}; o[1] = f32x16{};
    int cur = 0;
#pragma unroll 1
    for (int n = n0; n <= c; ++n) {
      __syncthreads();
      if (n < c) kv_issue(src, (n + 1) * 64, rk, rv, tid);
      const bool mine = (br == 1) || ((mysel >> n) & 1u);
      if (__any(mine)) {
        f32x16 p0, p1;
        qkt<4>(p0, p1, kb0 + cur * SLOT, qr);
        if (n + 2 >= c) {
          const int dbase = t - 64 * n;
#pragma unroll
          for (int r = 0; r < 16; ++r) { const int d0_ = dbase - crow(r, hi), d1_ = d0_ - 32;
            p0[r] = (d0_ < 0) ? NEG_INF : p0[r] + ((d0_ < 113) ? tb[d0_] : 0.f);
            p1[r] = (d1_ < 0) ? NEG_INF : p1[r] + ((d1_ < 113) ? tb[d1_] : 0.f); }
        } else if (br == 1 && n + 8 == c) {
          const int dbase = t - 64 * n;
#pragma unroll
          for (int r = 0; r < 16; ++r) { const int d0_ = dbase - crow(r, hi), d1_ = d0_ - 32;
            if (d0_ >= 512) p0[r] = NEG_INF; if (d1_ >= 512) p1[r] = NEG_INF; }
        }
        if (!mine) {
#pragma unroll
          for (int r = 0; r < 16; ++r) { p0[r] = NEG_INF; p1[r] = NEG_INF; } }
        softmax_step(p0, p1, m, l, o, wsf, r32, hi, pw);
        pv(o, vp0 + cur * SLOT, pw);
      }
      if (n < c) kv_commit(lds + (cur ^ 1) * SLOT, rk, rv, tid);
      cur ^= 1;
    }
    l = xsum(l);
    const float gi = gate[1 + br] / fmaxf(l, 1e-30f);
    if (hi == 0) wsf[r32] = gi;
    fin_add(finl, o, wsf, lane, hi);
  }
  fin_store(finl, onsa, (size_t)b * SEQ + 64 * c + 32 * (w & 1), 512, head * 64, lane);
}

__device__ __forceinline__ void mla_unit(int b, int h, int qb, const bf16_t* __restrict__ mq, const bf16_t* __restrict__ mkv, const bf16_t* __restrict__ kr, bf16_t* __restrict__ omla, lptr lds) {
  int tid = threadIdx.x; asm volatile("" : "+v"(tid));
  const int lane = tid & 63, r32 = lane & 31, hi = lane >> 5;
  const int w = __builtin_amdgcn_readfirstlane(tid >> 6);
  const int q0 = 256 * qb, qw = q0 + 32 * w, qpos = qw + r32;
  const size_t tokq = (size_t)b * SEQ + qpos;
  LAS3 float* wsf = (LAS3 float*)(lds + L_WSF) + w * 64;
  const lcptr kb0 = (lcptr)lds + KOFF + hi * 1024 + r32 * 16;
  const lcptr vp0 = (lcptr)lds + VOFF + ((lane >> 4) & 1) * 32 + (lane & 3) * 8 + (4 * hi + ((lane & 15) >> 2)) * 64;
  bf16x8 qr[6];
#pragma unroll
  for (int d0 = 0; d0 < 6; ++d0) qr[d0] = *(const bf16x8*)(mq + tokq * 768 + h * 96 + d0 * 16 + hi * 8);
  const KVSrc src{mkv + (size_t)b * SEQ * 1024 + h * 128, mkv + (size_t)b * SEQ * 1024 + h * 128 + 64, 1024, 1024};
  const bf16_t* krb = kr + (size_t)b * SEQ * 32;
  const int NTL = 4 * (qb + 1);
  u32x4 rk, rv, rr = {0u, 0u, 0u, 0u};
  f32x16 o[2]; o[0] = f32x16{}; o[1] = f32x16{};
  unsigned pw[16];
  float m = -1e30f, l = 0.f;
  __syncthreads();
  kv_issue(src, 0, rk, rv, tid);
  if (tid < 256) rr = *(const u32x4*)(krb + (size_t)(tid & 63) * 32 + (tid >> 6) * 8);
  kv_commit(lds, rk, rv, tid);
  if (tid < 256) *(LAS3 u32x4*)(lds + KOFF + (8 + (tid >> 6)) * 1024 + (tid & 63) * 16) = rr;
  int cur = 0;
#pragma unroll 1
  for (int tl = 0; tl < NTL; ++tl) {
    __syncthreads();
    if (tl + 1 < NTL) { kv_issue(src, (tl + 1) * 64, rk, rv, tid); if (tid < 256) rr = *(const u32x4*)(krb + (size_t)((tl + 1) * 64 + (tid & 63)) * 32 + (tid >> 6) * 8); }
    if (64 * tl <= qw + 31) {
      f32x16 p0, p1;
      qkt<6>(p0, p1, kb0 + cur * SLOT, qr);
      if (64 * tl + 63 > qw) {
        const int dbase = qpos - 64 * tl;
#pragma unroll
        for (int r = 0; r < 16; ++r) { const int d0_ = dbase - crow(r, hi), d1_ = d0_ - 32; if (d0_ < 0) p0[r] = NEG_INF; if (d1_ < 0) p1[r] = NEG_INF; }
      }
      softmax_step(p0, p1, m, l, o, wsf, r32, hi, pw);
      pv(o, vp0 + cur * SLOT, pw);
    }
    if (tl + 1 < NTL) { kv_commit(lds + (cur ^ 1) * SLOT, rk, rv, tid); if (tid < 256) *(LAS3 u32x4*)(lds + (cur ^ 1) * SLOT + KOFF + (8 + (tid >> 6)) * 1024 + (tid & 63) * 16) = rr; }
    cur ^= 1;
  }
  l = xsum(l);
  if (hi == 0) wsf[r32] = 1.0f / fmaxf(l, 1e-30f);
#pragma unroll
  for (int r = 0; r < 16; ++r) { const float f = wsf[crow(r, hi)]; o[0][r] *= f; o[1][r] *= f; }
  LAS3 float* finl = (LAS3 float*)(lds + L_FIN) + w * 2048;
  fin_set(finl, o, lane);
  fin_store(finl, omla, (size_t)b * SEQ + qw, 512, h * 64, lane);
}

__device__ __forceinline__ void attn_phase(const bf16_t* proj, const bf16_t* kc, const bf16_t* vc, const float* t5, bf16_t* onsa,
                                           const bf16_t* mq, const bf16_t* mkv, const bf16_t* kr, bf16_t* omla, lptr lds) {
  const int tid = threadIdx.x;
  { LAS3 float* tb = (LAS3 float*)(lds + L_TB);
    for (int i = tid; i < 8 * 128; i += NTHR) { const int hd = i >> 7, d = i & 127; tb[i] = (t5[(int)T5B[d] * 8 + hd] - t5[31 * 8 + hd]) * LOG2E; } }
  const int G = gridDim.x, bx = blockIdx.x;
  for (int v = (G % 8 == 0) ? (bx % 8) * (G / 8) + bx / 8 : bx; v < 256; v += G) {
    const int bg = v >> 4, p = v & 15, bh = v >> 2, j = v & 3;
#pragma unroll 1
    for (int u = 0; u < 2; ++u) nsa_unit(bg >> 1, bg & 1, u ? p : 31 - p, proj, kc, vc, onsa, lds);
#pragma unroll 1
    for (int u = 0; u < 2; ++u) mla_unit(bh >> 3, bh & 7, u ? j : 7 - j, mq, mkv, kr, omla, lds);
  }
}
#undef LAS3
}


namespace peer {
using bf16x8 = __attribute__((ext_vector_type(8))) short;
using f32x16 = __attribute__((ext_vector_type(16))) float;
typedef unsigned u32x4 __attribute__((ext_vector_type(4)));
typedef float f32x4_t __attribute__((ext_vector_type(4)));
typedef __bf16 bf16x2_t __attribute__((ext_vector_type(2)));
typedef float f32x2_t __attribute__((ext_vector_type(2)));
#define LAS3 __attribute__((address_space(3)))
__device__ __forceinline__ int crow(int r, int hi) { return (r & 3) + 8 * (r >> 2) + 4 * hi; }
__device__ __forceinline__ unsigned enc(float f) { const unsigned u = __float_as_uint(f); return u ^ ((unsigned)((int)u >> 31) | 0x80000000u); }
__device__ __forceinline__ float dec(unsigned k) { return __uint_as_float(k ^ (~(unsigned)((int)k >> 31) | 0x80000000u)); }
__device__ __forceinline__ unsigned umax(unsigned a, unsigned b) { return a > b ? a : b; }
__device__ __forceinline__ unsigned umin(unsigned a, unsigned b) { return a < b ? a : b; }
__device__ __forceinline__ unsigned cvtpk(float lo, float hi) { f32x2_t v = {lo, hi}; bf16x2_t b = __builtin_convertvector(v, bf16x2_t); return __builtin_bit_cast(unsigned, b); }
template <int B, int N> __device__ __forceinline__ void sort16(unsigned (&k)[N]) {
#pragma unroll
  for (int size = 2; size <= 16; size <<= 1)
#pragma unroll
    for (int stride = size >> 1; stride > 0; stride >>= 1)
#pragma unroll
      for (int i = 0; i < 16; ++i) { const int l = i ^ stride;
        if (l > i) { const bool desc = ((i & size) == 0); const unsigned a = k[B + i], b = k[B + l]; const unsigned mx = umax(a, b), mn = umin(a, b); k[B + i] = desc ? mx : mn; k[B + l] = desc ? mn : mx; } }
}
template <int A, int Bo, int N> __device__ __forceinline__ void merge16(unsigned (&k)[N]) {
#pragma unroll
  for (int i = 0; i < 16; ++i) k[A + i] = umax(k[A + i], k[Bo + 15 - i]);
#pragma unroll
  for (int stride = 8; stride > 0; stride >>= 1)
#pragma unroll
    for (int i = 0; i < 16; ++i) { const int l = i ^ stride; if (l > i) { const unsigned a = k[A + i], b = k[A + l]; k[A + i] = umax(a, b); k[A + l] = umin(a, b); } }
}
template <int N> __device__ __forceinline__ void top16_of_64(unsigned (&k)[N]) {
  sort16<0>(k); sort16<16>(k); sort16<32>(k); sort16<48>(k);
  merge16<0, 16>(k); merge16<32, 48>(k); merge16<0, 32>(k);
}

__device__ __forceinline__ void route_phase(const bf16_t* __restrict__ pq, const bf16_t* __restrict__ subk, unsigned* __restrict__ pack, LAS3 char* lds) {
  const int tid = threadIdx.x, lane = tid & 63, r32 = lane & 31, hi = lane >> 5, wv = tid >> 6;
  const int gw = blockIdx.x * NWV + wv, nw = gridDim.x * NWV;
  LAS3 unsigned char* myb = (LAS3 unsigned char*)lds + wv * 2560 + lane * 40;
#pragma unroll 1
  for (int item = gw; item < (T / 32) * 8; item += nw) {
    const int h = item & 7, t0 = (item >> 3) * 32;
    unsigned la[16], lb[16];
#pragma unroll
    for (int i = 0; i < 16; ++i) { la[i] = 0u; lb[i] = 0u; }
#pragma unroll 1
    for (int p = 0; p < 2; ++p) {
      f32x16 acc[4];
#pragma unroll
      for (int kt = 0; kt < 4; ++kt) acc[kt] = f32x16{};
#pragma unroll
      for (int kd = 0; kd < 4; ++kd) {
        const bf16x8 bq = *(const bf16x8*)(pq + (size_t)(t0 + r32) * 1024 + h * 128 + p * 64 + kd * 16 + hi * 8);
#pragma unroll
        for (int kt = 0; kt < 4; ++kt) {
          const bf16x8 ak = *(const bf16x8*)(subk + (size_t)((h * 2 + p) * 128 + kt * 32 + r32) * 64 + kd * 16 + hi * 8);
          acc[kt] = __builtin_amdgcn_mfma_f32_32x32x16_bf16(ak, bq, acc[kt], 0, 0, 0);
        }
      }
      unsigned k[64];
#pragma unroll
      for (int kt = 0; kt < 4; ++kt)
#pragma unroll
        for (int r = 0; r < 16; ++r) k[kt * 16 + r] = (enc(acc[kt][r]) & 0xFFFFFF80u) | (unsigned)(127 - (32 * kt + crow(r, hi)));
      top16_of_64(k);
#pragma unroll
      for (int i = 0; i < 16; ++i) { auto rr = __builtin_amdgcn_permlane32_swap(k[i], k[i], false, false); unsigned r0 = rr[0], r1 = rr[1]; asm volatile("" : "+v"(r0), "+v"(r1)); k[16 + i] = hi ? r0 : r1; }
      merge16<0, 16>(k);
#pragma unroll
      for (int i = 0; i < 16; ++i) { la[i] = (p == 0) ? k[i] : la[i]; lb[i] = (p == 0) ? lb[i] : k[i]; }
      __builtin_amdgcn_sched_barrier(0);
    }
#pragma unroll
    for (int i = 0; i < 4; ++i) {
      const unsigned wa = (127u - (la[4 * i] & 127u)) | ((127u - (la[4 * i + 1] & 127u)) << 8) | ((127u - (la[4 * i + 2] & 127u)) << 16) | ((127u - (la[4 * i + 3] & 127u)) << 24);
      const unsigned wb = (127u - (lb[4 * i] & 127u)) | ((127u - (lb[4 * i + 1] & 127u)) << 8) | ((127u - (lb[4 * i + 2] & 127u)) << 16) | ((127u - (lb[4 * i + 3] & 127u)) << 24);
      *(LAS3 unsigned*)(myb + 4 * i) = wa; *(LAS3 unsigned*)(myb + 16 + 4 * i) = wb;
    }
    float va[16], vb[16];
#pragma unroll
    for (int i = 0; i < 16; ++i) { va[i] = dec(la[i] & 0xFFFFFF80u); vb[i] = dec(lb[i] & 0xFFFFFF80u); }
    unsigned k[64];
#define PEER_CAND(n, i, j) k[n] = (enc(va[i] + vb[j]) & 0xFFFFFF00u) | (unsigned)(255 - ((i) * 16 + (j)))
    PEER_CAND(0, 0, 0); PEER_CAND(1, 0, 1); PEER_CAND(2, 0, 2); PEER_CAND(3, 0, 3); PEER_CAND(4, 0, 4); PEER_CAND(5, 0, 5);
    PEER_CAND(6, 0, 6); PEER_CAND(7, 0, 7); PEER_CAND(8, 0, 8); PEER_CAND(9, 0, 9); PEER_CAND(10, 0, 10); PEER_CAND(11, 0, 11);
    PEER_CAND(12, 0, 12); PEER_CAND(13, 0, 13); PEER_CAND(14, 0, 14); PEER_CAND(15, 0, 15); PEER_CAND(16, 1, 0); PEER_CAND(17, 1, 1);
    PEER_CAND(18, 1, 2); PEER_CAND(19, 1, 3); PEER_CAND(20, 1, 4); PEER_CAND(21, 1, 5); PEER_CAND(22, 1, 6); PEER_CAND(23, 1, 7);
    PEER_CAND(24, 2, 0); PEER_CAND(25, 2, 1); PEER_CAND(26, 2, 2); PEER_CAND(27, 2, 3); PEER_CAND(28, 2, 4); PEER_CAND(29, 3, 0);
    PEER_CAND(30, 3, 1); PEER_CAND(31, 3, 2); PEER_CAND(32, 3, 3); PEER_CAND(33, 4, 0); PEER_CAND(34, 4, 1); PEER_CAND(35, 4, 2);
    PEER_CAND(36, 5, 0); PEER_CAND(37, 5, 1); PEER_CAND(38, 6, 0); PEER_CAND(39, 6, 1); PEER_CAND(40, 7, 0); PEER_CAND(41, 7, 1);
    PEER_CAND(42, 8, 0); PEER_CAND(43, 9, 0); PEER_CAND(44, 10, 0); PEER_CAND(45, 11, 0); PEER_CAND(46, 12, 0); PEER_CAND(47, 13, 0);
    PEER_CAND(48, 14, 0); PEER_CAND(49, 15, 0);
#undef PEER_CAND
#pragma unroll
    for (int z = 50; z < 64; ++z) k[z] = 0u;
    top16_of_64(k);
    const float best0 = dec(k[0] & 0xFFFFFF00u);
    float ev[16]; float den = 0.f;
#pragma unroll
    for (int i = 0; i < 16; ++i) { ev[i] = __expf(dec(k[i] & 0xFFFFFF00u) - best0); den += ev[i]; }
    const float inv = 1.0f / den;
    unsigned outw[8];
#pragma unroll
    for (int i = 0; i < 8; ++i) {
      unsigned k_lo = k[i], k_hi = k[8 + i]; float e_lo = ev[i], e_hi = ev[8 + i];
      asm volatile("" : "+v"(k_lo), "+v"(k_hi), "+v"(e_lo), "+v"(e_hi));
      const unsigned kk = hi ? k_hi : k_lo; const float e = hi ? e_hi : e_lo;
      const unsigned f = 255u - (kk & 255u);
      const unsigned ia = myb[f >> 4], ib = myb[16 + (f & 15u)];
      outw[i] = (ia * 128u + ib) | (cvtpk(0.f, e * inv) & 0xFFFF0000u);
    }
    unsigned* dst = pack + (size_t)(t0 + r32) * 128 + h * 16 + hi * 8;
    *(u32x4*)dst = (u32x4){outw[0], outw[1], outw[2], outw[3]};
    *(u32x4*)(dst + 4) = (u32x4){outw[4], outw[5], outw[6], outw[7]};
  }
}

__device__ __forceinline__ void conv_tables(const float* __restrict__ u, const float* __restrict__ v, unsigned* __restrict__ u8, float* __restrict__ su, unsigned* __restrict__ v8) {
  const int tid = threadIdx.x, lane = tid & 63, wv = tid >> 6;
  const int gw = blockIdx.x * NWV + wv, nw = gridDim.x * NWV;
  for (int e = gw; e < 16384; e += nw) {
    const f32x4_t* ur = (const f32x4_t*)(u + (size_t)e * 1024) + lane * 4;
    f32x4_t a[4]; float mx = 0.f;
#pragma unroll
    for (int i = 0; i < 4; ++i) { a[i] = ur[i]; mx = fmaxf(mx, fmaxf(fmaxf(fabsf(a[i][0]), fabsf(a[i][1])), fmaxf(fabsf(a[i][2]), fabsf(a[i][3])))); }
    mx = wmaxf(mx);
    const float sc = fmaxf(mx, 1e-30f) * (1.0f / 127.0f), isc = 1.0f / sc;
    u32x4 o;
#pragma unroll
    for (int i = 0; i < 4; ++i) {
      const int q0 = (int)rintf(a[i][0] * isc), q1 = (int)rintf(a[i][1] * isc), q2 = (int)rintf(a[i][2] * isc), q3 = (int)rintf(a[i][3] * isc);
      o[i] = (unsigned)(q0 & 255) | ((unsigned)(q1 & 255) << 8) | ((unsigned)(q2 & 255) << 16) | ((unsigned)(q3 & 255) << 24);
    }
    *(u32x4*)(u8 + (size_t)e * 256 + lane * 4) = o;
    if (lane == 0) su[e] = sc;
    const f32x4_t* vr = (const f32x4_t*)(v + (size_t)e * 1024) + lane * 4;
    u32x4 ov;
#pragma unroll
    for (int i = 0; i < 4; ++i) { const f32x4_t b = vr[i]; unsigned w = 0u; w = __builtin_amdgcn_cvt_pk_fp8_f32(2.0f * b[0], 2.0f * b[1], w, false); w = __builtin_amdgcn_cvt_pk_fp8_f32(2.0f * b[2], 2.0f * b[3], w, true); ov[i] = w; }
    *(u32x4*)(v8 + (size_t)e * 256 + lane * 4) = ov;
  }
}
__device__ __forceinline__ float gelu_fast(float v) {
  const float av = __builtin_fabsf(v), t = __builtin_amdgcn_rcpf(av * 0.2316418882f + 1.0f);
  float q = t * 0.5307027145f + (-0.7265760135f); q = q * t + 0.7107068705f; q = q * t + (-0.142248368f); q = q * t + 0.127414796f; q = q * t;
  const float e = __builtin_amdgcn_exp2f((v * v) * (-0.72134752044f));
  const float m = v * (q * e);
  return v < 0.f ? m : v - m;
}
struct ExpBuf { u32x4 ub[4]; u32x4 vb[4]; float sue; unsigned pkv; };
__device__ __forceinline__ void exp_issue(ExpBuf& B, int q, unsigned pk0, unsigned pk1, const unsigned* __restrict__ u8, const float* __restrict__ su, const unsigned* __restrict__ v8, int lane, int j16, int grp) {
  B.pkv = (unsigned)__shfl((int)(q < 16 ? pk0 : pk1), (4 * q + grp) & 63);
  const unsigned e = B.pkv & 0xFFFFu;
  const unsigned* urow = u8 + (size_t)e * 256 + j16 * 4;
#pragma unroll
  for (int seg = 0; seg < 4; ++seg) B.ub[seg] = *(const u32x4*)(urow + seg * 64);
  B.sue = su[e];
#pragma unroll
  for (int x = 0; x < 4; ++x) { const unsigned ex = (unsigned)__builtin_amdgcn_readlane((int)e, 16 * x); B.vb[x] = *(const u32x4*)(v8 + (size_t)ex * 256 + lane * 4); }
}
__device__ __forceinline__ void exp_consume(const ExpBuf& B, const u32x4 (&hq)[4], float sh, f32x2_t (&y)[8]) {
  int acc = 0;
#pragma unroll
  for (int seg = 0; seg < 4; ++seg) { acc = __builtin_amdgcn_sdot4((int)B.ub[seg].x, (int)hq[seg].x, acc, false); acc = __builtin_amdgcn_sdot4((int)B.ub[seg].y, (int)hq[seg].y, acc, false);
                                      acc = __builtin_amdgcn_sdot4((int)B.ub[seg].z, (int)hq[seg].z, acc, false); acc = __builtin_amdgcn_sdot4((int)B.ub[seg].w, (int)hq[seg].w, acc, false); }
  acc += __shfl_xor(acc, 1); acc += __shfl_xor(acc, 2); acc += __shfl_xor(acc, 4); acc += __shfl_xor(acc, 8);
  const float d = (float)acc * (B.sue * sh);
  const float c = 0.5f * __uint_as_float(B.pkv & 0xFFFF0000u) * gelu_fast(d);
#pragma unroll
  for (int x = 0; x < 4; ++x) {
    const float cx = __uint_as_float((unsigned)__builtin_amdgcn_readlane((int)__float_as_uint(c), 16 * x));
    const f32x2_t c2 = {cx, cx};
#pragma unroll
    for (int i = 0; i < 4; ++i) {
      const unsigned w = B.vb[x][i];
      y[2 * i] = __builtin_elementwise_fma(__builtin_amdgcn_cvt_pk_f32_fp8(w, false), c2, y[2 * i]);
      y[2 * i + 1] = __builtin_elementwise_fma(__builtin_amdgcn_cvt_pk_f32_fp8(w, true), c2, y[2 * i + 1]);
    }
  }
}
__device__ __forceinline__ void experts_phase(const bf16_t* __restrict__ hn, const unsigned* __restrict__ pack, const unsigned* __restrict__ u8, const float* __restrict__ su, const unsigned* __restrict__ v8,
                                              const float* __restrict__ gfin, float* __restrict__ out) {
  const int tid = threadIdx.x, lane = tid & 63, j16 = lane & 15, grp = lane >> 4, wv = tid >> 6;
  const int gw = blockIdx.x * NWV + wv, nw = gridDim.x * NWV;
#pragma unroll 1
  for (int t = gw; t < T; t += nw) {
    u32x4 hraw[8];
#pragma unroll
    for (int seg = 0; seg < 4; ++seg) { const bf16_t* hp = hn + (size_t)t * 1024 + seg * 256 + j16 * 16; hraw[2 * seg] = *(const u32x4*)hp; hraw[2 * seg + 1] = *(const u32x4*)(hp + 8); }
    float mx = 0.f;
#pragma unroll
    for (int i = 0; i < 8; ++i)
#pragma unroll
      for (int j = 0; j < 4; ++j) { const unsigned w = hraw[i][j]; mx = fmaxf(mx, fmaxf(fabsf(__uint_as_float(w << 16)), fabsf(__uint_as_float(w & 0xffff0000u)))); }
    mx = wmaxf(mx);
    const float sh = fmaxf(mx, 1e-30f) * (1.0f / 127.0f), ish = 1.0f / sh;
    u32x4 hq[4];
#pragma unroll
    for (int seg = 0; seg < 4; ++seg)
#pragma unroll
      for (int j = 0; j < 4; ++j) {
        const unsigned w0 = hraw[2 * seg + (j >> 1)][(2 * j) & 3], w1 = hraw[2 * seg + (j >> 1)][(2 * j + 1) & 3];
        const int q0 = (int)rintf(__uint_as_float(w0 << 16) * ish), q1 = (int)rintf(__uint_as_float(w0 & 0xffff0000u) * ish);
        const int q2 = (int)rintf(__uint_as_float(w1 << 16) * ish), q3 = (int)rintf(__uint_as_float(w1 & 0xffff0000u) * ish);
        hq[seg][j] = (unsigned)(q0 & 255) | ((unsigned)(q1 & 255) << 8) | ((unsigned)(q2 & 255) << 16) | ((unsigned)(q3 & 255) << 24);
      }
    const unsigned pk0 = pack[(size_t)t * 128 + lane], pk1 = pack[(size_t)t * 128 + 64 + lane];
    f32x2_t y[8];
#pragma unroll
    for (int i = 0; i < 8; ++i) y[i] = (f32x2_t){0.f, 0.f};
    ExpBuf A, Bb;
    exp_issue(A, 0, pk0, pk1, u8, su, v8, lane, j16, grp);
#pragma unroll 1
    for (int q = 0; q < 32; q += 2) {
      exp_issue(Bb, q + 1, pk0, pk1, u8, su, v8, lane, j16, grp);
      exp_consume(A, hq, sh, y);
      if (q + 2 < 32) exp_issue(A, q + 2, pk0, pk1, u8, su, v8, lane, j16, grp);
      exp_consume(Bb, hq, sh, y);
    }
    float ss = 0.f;
    f32x4_t r[4];
    const float* hp = out + (size_t)t * 1024 + lane * 16;
#pragma unroll
    for (int i = 0; i < 4; ++i) {
      const f32x4_t a = *(const f32x4_t*)(hp + 4 * i);
      r[i] = (f32x4_t){a[0] + y[2 * i][0], a[1] + y[2 * i][1], a[2] + y[2 * i + 1][0], a[3] + y[2 * i + 1][1]};
      ss += (r[i][0] * r[i][0] + r[i][1] * r[i][1]) + (r[i][2] * r[i][2] + r[i][3] * r[i][3]);
    }
    ss = wsum(ss);
    const float inv = rsqrtf(ss * (1.0f / 1024.0f) + 1e-6f);
    float* op = out + (size_t)t * 1024 + lane * 16; const float* gp = gfin + lane * 16;
#pragma unroll
    for (int i = 0; i < 4; ++i) { const f32x4_t g = *(const f32x4_t*)(gp + 4 * i); *(f32x4_t*)(op + 4 * i) = r[i] * inv * g; }
  }
}
#undef LAS3
}

#define XB_TMO      128
#define XB_XCNT(j)  (256  + 64 * (j))
#define XB_XSUB(j)  (1280 + 64 * (j))
#define XB_XGEN(j)  (2304 + 64 * (j))
#define XB_TOP      3328
#define XB_TOPGEN   3392
#define XCD_BAR_WORDS 3456
#define XB_SPIN_CAP (1u << 18)
#ifndef LAS
#define LAS __attribute__((address_space(3)))
#endif

__device__ __forceinline__ unsigned xb_ld(unsigned* p)              { return __hip_atomic_load(p, __ATOMIC_RELAXED, __HIP_MEMORY_SCOPE_AGENT); }
__device__ __forceinline__ unsigned xb_add(unsigned* p, unsigned v) { return __hip_atomic_fetch_add(p, v, __ATOMIC_RELAXED, __HIP_MEMORY_SCOPE_AGENT); }
__device__ __forceinline__ unsigned xb_xcc_id() { return (unsigned)__builtin_amdgcn_s_getreg((3 << 11) | 20) & 0xFu; }
#define XB_SPIN(cond, bar) do { unsigned _sp = 0; while (cond) { __builtin_amdgcn_s_sleep(1); \
    if ((++_sp & 255u) == 0u) { if (xb_ld(&(bar)[XB_TMO])) break; if (_sp > XB_SPIN_CAP) { atomicAdd(&(bar)[XB_TMO], 1u); break; } } } } while (0)

struct XcdBarrier {
    unsigned* bar; unsigned x;
    volatile LAS unsigned* st;
};

__device__ __forceinline__ XcdBarrier xcd_barrier_post(unsigned* bar, volatile LAS unsigned* st) {
    XcdBarrier b; b.bar = bar; b.x = xb_xcc_id(); b.st = st;
    if (threadIdx.x == 0) (void)xb_add(&bar[XB_XCNT(b.x)], 1u);
    return b;
}
__device__ __forceinline__ void xcd_barrier_complete(unsigned* bar, unsigned x, unsigned& nloc, unsigned& nx) {
    const unsigned G = gridDim.x * gridDim.y * gridDim.z;
    unsigned sum, cnt, mine, sp = 0u;
    for (;;) {
        sum = 0u; cnt = 0u; mine = 0u;
#pragma unroll
        for (unsigned j = 0; j < 16; ++j) { const unsigned c = xb_ld(&bar[XB_XCNT(j)]); sum += c; cnt += (c > 0u) ? 1u : 0u; mine = (j == x) ? c : mine; }
        if (sum == G) break;
        __builtin_amdgcn_s_sleep(1);
        if ((++sp & 255u) == 0u) { if (xb_ld(&bar[XB_TMO])) break; if (sp > XB_SPIN_CAP) { atomicAdd(&bar[XB_TMO], 1u); break; } }
    }
    nloc = mine > 0u ? mine : 1u; nx = cnt > 0u ? cnt : 1u;
}

__device__ __forceinline__ void xcd_barrier(const XcdBarrier& b) {
    asm volatile("s_waitcnt vmcnt(0)" ::: "memory");
    __syncthreads();
    if (threadIdx.x == 0) {
        unsigned* bar = b.bar;
        __builtin_amdgcn_s_waitcnt(0);
        unsigned nloc = b.st[0], nx = b.st[1];
        if (nloc == 0u) { xcd_barrier_complete(bar, b.x, nloc, nx); b.st[0] = nloc; b.st[1] = nx; }
        const unsigned old = xb_add(&bar[XB_XSUB(b.x)], 1u);
        const unsigned gen = old / nloc;
        if (old + 1u == (gen + 1u) * nloc) {
            __builtin_amdgcn_fence(__ATOMIC_RELEASE, "agent");
            asm volatile("s_waitcnt vmcnt(0)" ::: "memory");
            const unsigned og = xb_add(&bar[XB_TOP], 1u);
            const unsigned tg = og / nx;
            if (og + 1u == (tg + 1u) * nx) xb_add(&bar[XB_TOPGEN], 1u);
            else XB_SPIN(xb_ld(&bar[XB_TOPGEN]) == tg, bar);
            __builtin_amdgcn_fence(__ATOMIC_ACQUIRE, "agent");
            xb_add(&bar[XB_XGEN(b.x)], 1u);
            asm volatile("s_waitcnt vmcnt(0)" ::: "memory");
        } else {
            XB_SPIN(xb_ld(&bar[XB_XGEN(b.x)]) == gen, bar);
            __builtin_amdgcn_fence(__ATOMIC_ACQUIRE, "agent");
            asm volatile("s_waitcnt vmcnt(0)" ::: "memory");
        }
    }
    __syncthreads();
}

struct Args { const float* in[23]; float* out; char* ws; };
constexpr int LDS_BYTES = 131072 + 4096;

typedef const __attribute__((address_space(4))) Args* kargs_t;
DEV kargs_t KA() { kargs_t k = (kargs_t)__builtin_amdgcn_kernarg_segment_ptr(); asm volatile("" : "+s"(k)); return k; }
#define WSP(type, off) ((type*)(ws + (off)))

__global__ __launch_bounds__(NTHR, 2) void mega(Args a) {
  extern __shared__ __attribute__((aligned(16))) char lds[];
  cg::grid_group grid = cg::this_grid();
  PG8_LAS unsigned char* glds = (PG8_LAS unsigned char*)lds;
  const int bid = blockIdx.x, G = gridDim.x;
  (void)a;
  volatile LAS unsigned* bst = (volatile LAS unsigned*)((LAS char*)lds + LDS_BYTES - 16);
  if (threadIdx.x < 4) bst[threadIdx.x] = 0u;
  __syncthreads();
  XcdBarrier xbar; { kargs_t k = KA(); xbar = xcd_barrier_post((unsigned*)k->ws, bst); }

  { kargs_t k = KA(); char* ws = k->ws;
    ph_convT<1>(k->in[2], 1024, IN_COLS, WSP(bf16_t, WS_WIN), 3840, lds);
    ph_convT<0>(k->in[13], 512, 1024, WSP(bf16_t, WS_WBN), 1024, lds);
    ph_convT<0>(k->in[14], 512, 1024, WSP(bf16_t, WS_WBM), 1024, lds);
    ph_convT<0>(k->in[15], 1024, 1024, WSP(bf16_t, WS_WOUT), 1024, lds);
    ph_convT<0>(k->in[17], 1024, 1024, WSP(bf16_t, WS_WQ), 1024, lds);
    ph_convT<0>(k->in[5], 2048, 256, WSP(bf16_t, WS_CKW1), 256, lds);
    ph_convT<0>(k->in[7], 2048, 256, WSP(bf16_t, WS_CVW1), 256, lds);
    ph_convT<0>(k->in[6], 256, 64, WSP(bf16_t, WS_CKW2), 64, lds);
    ph_convT<0>(k->in[8], 256, 64, WSP(bf16_t, WS_CVW2), 64, lds);
    ph_convT<0>(k->in[11], 256, 768, WSP(bf16_t, WS_UQ), 768, lds);
    ph_convT<0>(k->in[12], 128, 1024, WSP(bf16_t, WS_UKV), 1024, lds);
    ph_conv_plain(k->in[18], WSP(bf16_t, WS_SUBK), 16 * 128 * 64);
    ph_rope_table(WSP(float2, WS_ROPE));
    ph_rms1024(k->in[0], k->in[1], WSP(bf16_t, WS_XN), T); }
  grid.sync();
  { kargs_t k = KA(); char* ws = k->ws;
    pg8::Gemm g{WSP(bf16_t, WS_XN), WSP(bf16_t, WS_WIN), T, 3840, 1024}; pg8::StaticOrder S; S.init(T, 3840, G, bid);
    pg8::EpiInProjF E{WSP(bf16_t, WS_PROJ), WSP(bf16_t, WS_GATES)};
    pg8::gemm_phase<pg8::EpiInProjF, pg8::StaticOrder, PG8_ALIGN, PG8_SP2>(glds, g, S, E); }
  xcd_barrier(xbar);
  { kargs_t k = KA(); char* ws = k->ws;
    ph_rms_cols<4>(WSP(bf16_t, WS_PROJ), PC_CQ, k->in[9], WSP(bf16_t, WS_CQN));
    ph_rms_cols<2>(WSP(bf16_t, WS_PROJ), PC_CKV, k->in[10], WSP(bf16_t, WS_CKVN));
    ph_rope_k(WSP(bf16_t, WS_PROJ), WSP(bf16_t, WS_KROPE));
    ph_cmp_gather(WSP(bf16_t, WS_PROJ), k->in[3], 0, WSP(bf16_t, WS_CA));
    ph_cmp_gather(WSP(bf16_t, WS_PROJ), k->in[4], 1, WSP(bf16_t, WS_CA2)); }
  xcd_barrier(xbar);
  { kargs_t k = KA(); char* ws = k->ws;
    pg8::Gemm g{WSP(bf16_t, WS_CA), WSP(bf16_t, WS_CKW1), 2048, 256, 2048}; pg8::StaticOrder S; S.init(2048, 256, G, bid);
    pg8::EpiBf16<1> E{WSP(bf16_t, WS_HID), 256, nullptr, 0, 0, 1.f};
    pg8::gemm_phase<pg8::EpiBf16<1>, pg8::StaticOrder, PG8_ALIGN, PG8_SP2>(glds, g, S, E); }
  { kargs_t k = KA(); char* ws = k->ws;
    pg8::Gemm g{WSP(bf16_t, WS_CA2), WSP(bf16_t, WS_CVW1), 2048, 256, 2048}; pg8::StaticOrder S; S.init(2048, 256, G, (bid + 128) & 255);
    pg8::EpiBf16<1> E{WSP(bf16_t, WS_HID2), 256, nullptr, 0, 0, 1.f};
    pg8::gemm_phase<pg8::EpiBf16<1>, pg8::StaticOrder, PG8_ALIGN, PG8_SP2>(glds, g, S, E); }
  { kargs_t k = KA(); char* ws = k->ws;
    pg8::Gemm g{WSP(bf16_t, WS_CQN), WSP(bf16_t, WS_UQ), T, 768, 256}; pg8::StaticOrder S; S.init(T, 768, G, (bid + 64) & 255);
    pg8::EpiMlaQF E{WSP(bf16_t, WS_MLAQ), WSP(float2, WS_ROPE)};
    pg8::gemm_phase<pg8::EpiMlaQF, pg8::StaticOrder, PG8_ALIGN, PG8_SP2>(glds, g, S, E); }
  { kargs_t k = KA(); char* ws = k->ws;
    pg8::Gemm g{WSP(bf16_t, WS_CKVN), WSP(bf16_t, WS_UKV), T, 1024, 128}; pg8::StaticOrder S; S.init(T, 1024, G, bid);
    pg8::EpiBf16<0> E{WSP(bf16_t, WS_MLAKV), 1024, nullptr, 0, 0, 1.f};
    pg8::gemm_phase<pg8::EpiBf16<0>, pg8::StaticOrder, PG8_ALIGN, PG8_SP2>(glds, g, S, E); }
  xcd_barrier(xbar);
  { kargs_t k = KA(); char* ws = k->ws;
    ph_gemm(WSP(bf16_t, WS_HID), 256, WSP(bf16_t, WS_CKW2), 256, 2048, 64, 256, EpiCmpOut{WSP(bf16_t, WS_KC)}, lds);
    ph_gemm(WSP(bf16_t, WS_HID2), 256, WSP(bf16_t, WS_CVW2), 256, 2048, 64, 256, EpiCmpOut{WSP(bf16_t, WS_VC)}, lds); }
  xcd_barrier(xbar);
  { kargs_t k = KA(); char* ws = k->ws;
    att::attn_phase(WSP(bf16_t, WS_PROJ), WSP(bf16_t, WS_KC), WSP(bf16_t, WS_VC), k->in[21], WSP(bf16_t, WS_ONSA),
                    WSP(bf16_t, WS_MLAQ), WSP(bf16_t, WS_MLAKV), WSP(bf16_t, WS_KROPE), WSP(bf16_t, WS_OMLA), (att::lptr)lds); }
  xcd_barrier(xbar);
  { kargs_t k = KA(); char* ws = k->ws;
    pg8::Gemm g{WSP(bf16_t, WS_ONSA), WSP(bf16_t, WS_WBN), T, 1024, 512}; pg8::StaticOrder S; S.init(T, 1024, G, bid);
    pg8::EpiMergeF<0> E{WSP(bf16_t, WS_GATES), WSP(bf16_t, WS_MERGED)};
    pg8::gemm_phase<pg8::EpiMergeF<0>, pg8::StaticOrder, PG8_ALIGN, PG8_SP2>(glds, g, S, E); }
  { kargs_t k = KA(); char* ws = k->ws;
    pg8::Gemm g{WSP(bf16_t, WS_OMLA), WSP(bf16_t, WS_WBM), T, 1024, 512}; pg8::StaticOrder S; S.init(T, 1024, G, bid);
    pg8::EpiMergeF<1> E{WSP(bf16_t, WS_GATES), WSP(bf16_t, WS_MERGED)};
    pg8::gemm_phase<pg8::EpiMergeF<1>, pg8::StaticOrder, PG8_ALIGN, PG8_SP2>(glds, g, S, E); }
  xcd_barrier(xbar);
  { kargs_t k = KA(); char* ws = k->ws;
    pg8::Gemm g{WSP(bf16_t, WS_MERGED), WSP(bf16_t, WS_WOUT), T, 1024, 1024}; pg8::StaticOrder S; S.init(T, 1024, G, bid);
    pg8::EpiResidF E{k->in[0], k->out};
    pg8::gemm_phase<pg8::EpiResidF, pg8::StaticOrder, PG8_ALIGN, PG8_SP2>(glds, g, S, E); }
  xcd_barrier(xbar);
  { kargs_t k = KA(); char* ws = k->ws; ph_rms1024(k->out, k->in[16], WSP(bf16_t, WS_HN), T);
    peer::conv_tables(k->in[19], k->in[20], WSP(unsigned, WS_U8), WSP(float, WS_SU), WSP(unsigned, WS_V8)); }
  xcd_barrier(xbar);
  { kargs_t k = KA(); char* ws = k->ws;
    pg8::Gemm g{WSP(bf16_t, WS_HN), WSP(bf16_t, WS_WQ), T, 1024, 1024}; pg8::StaticOrder S; S.init(T, 1024, G, bid);
    pg8::EpiBf16<0> E{WSP(bf16_t, WS_PQ), 1024, nullptr, 0, 0, 1.f};
    pg8::gemm_phase<pg8::EpiBf16<0>, pg8::StaticOrder, PG8_ALIGN, PG8_SP2>(glds, g, S, E); }
  xcd_barrier(xbar);
  { kargs_t k = KA(); char* ws = k->ws; peer::route_phase(WSP(bf16_t, WS_PQ), WSP(bf16_t, WS_SUBK), WSP(unsigned, WS_PIDX), (__attribute__((address_space(3))) char*)lds); }
  xcd_barrier(xbar);
  { kargs_t k = KA(); char* ws = k->ws; peer::experts_phase(WSP(bf16_t, WS_HN), WSP(unsigned, WS_PIDX), WSP(unsigned, WS_U8), WSP(float, WS_SU), WSP(unsigned, WS_V8), k->in[22], k->out); }
}

extern "C" void kernel_launch(void* const* d_in, const int* in_sizes, int n_in, void* d_out, int out_size, void* d_ws, size_t ws_size, hipStream_t stream) {
  if (n_in != 23 || ws_size < 256 * MiB) { fprintf(stderr, "kernel_launch: unexpected n_in %d / ws_size %zu\n", n_in, ws_size); return; }
  static int grid_blocks = 0;
  if (!grid_blocks) {
    int dev = 0, cus = 0, per_cu = 0;
    (void)hipGetDevice(&dev);
    (void)hipDeviceGetAttribute(&cus, hipDeviceAttributeMultiprocessorCount, dev);
    if (hipFuncSetAttribute((const void*)mega, hipFuncAttributeMaxDynamicSharedMemorySize, LDS_BYTES) != hipSuccess) fprintf(stderr, "kernel_launch: hipFuncSetAttribute failed\n");
    (void)hipOccupancyMaxActiveBlocksPerMultiprocessor(&per_cu, (const void*)mega, NTHR, LDS_BYTES);
    if (per_cu < 1) { fprintf(stderr, "kernel_launch: occupancy query returned %d\n", per_cu); per_cu = 1; }
    if (per_cu > 2) per_cu = 2;
    grid_blocks = cus * per_cu;
    fprintf(stderr, "kernel_launch: cus %d per_cu %d grid %d ws %zu\n", cus, per_cu, grid_blocks, ws_size);
  }
  if (hipMemsetAsync(d_ws, 0, 65536, stream) != hipSuccess) fprintf(stderr, "kernel_launch: hipMemsetAsync failed\n");
  Args a{};
  for (int i = 0; i < 23; ++i) a.in[i] = (const float*)d_in[i];
  a.out = (float*)d_out; a.ws = (char*)d_ws;
  void* args[] = {&a};
  hipError_t e = hipLaunchCooperativeKernel((const void*)mega, dim3(grid_blocks), dim3(NTHR), args, LDS_BYTES, stream);
  if (e != hipSuccess) fprintf(stderr, "cooperative launch failed: %s (grid %d)\n", hipGetErrorString(e), grid_blocks);
}
```

```cpp
#include <hip/hip_runtime.h>
#include <stdint.h>
#include <cstdio>
#include <hip/hip_cooperative_groups.h>
namespace cg = cooperative_groups;

typedef unsigned short bf16_t;
#define DEV __device__ __forceinline__

constexpr int BATCH = 8, SEQ = 2048, DM = 1024, T = BATCH * SEQ;
constexpr int IN_COLS = 3768;
constexpr int PROJ_LD = 1792;
constexpr int PC_Q = 0, PC_KV = 512, PC_CQ = 1280, PC_CKV = 1536, PC_KR = 1664, PC_GATE = 1696;
constexpr int NC = 127;
constexpr size_t MiB = 1u << 20;

constexpr size_t WS_WIN = 1 * MiB;
constexpr size_t WS_WBN = 9 * MiB;
constexpr size_t WS_WBM = 10 * MiB;
constexpr size_t WS_WOUT = 11 * MiB;
constexpr size_t WS_WQ = 13 * MiB;
constexpr size_t WS_CKW1 = 15 * MiB;
constexpr size_t WS_CVW1 = 16 * MiB;
constexpr size_t WS_CKW2 = 17 * MiB;
constexpr size_t WS_CVW2 = 17 * MiB + 128 * 1024;
constexpr size_t WS_UQ = 17 * MiB + 256 * 1024;
constexpr size_t WS_UKV = 17 * MiB + 768 * 1024;
constexpr size_t WS_SUBK = 18 * MiB;
constexpr size_t WS_ROPE = 18 * MiB + 512 * 1024;
constexpr size_t WS_GATES = 20 * MiB;
constexpr size_t WS_PQ = 20 * MiB;
constexpr size_t WS_PROJ = 84 * MiB;
constexpr size_t WS_MERGED = 84 * MiB;
constexpr size_t WS_PIDX = 84 * MiB;
constexpr size_t WS_U8 = 172 * MiB;
constexpr size_t WS_V8 = 188 * MiB;
constexpr size_t WS_SU = 204 * MiB;
constexpr size_t WS_SH = 204 * MiB + 65536;
constexpr size_t WS_HN8 = 205 * MiB;
constexpr size_t WS_CO = 221 * MiB;
constexpr size_t WS_SSQ = 229 * MiB;
constexpr int CTL_QA = 4096, CTL_QB = 4096 + 512;
constexpr size_t WS_PW = 92 * MiB;
constexpr size_t WS_XN = 140 * MiB;
constexpr size_t WS_MLAKV = 140 * MiB;
constexpr size_t WS_HN = 140 * MiB;
constexpr size_t WS_MLAQ = 172 * MiB;
constexpr size_t WS_KROPE = 196 * MiB;
constexpr size_t WS_KC = 197 * MiB;
constexpr size_t WS_VC = 197 * MiB + 512 * 1024;
constexpr size_t WS_ONSA = 198 * MiB;
constexpr size_t WS_OMLA = 214 * MiB;
constexpr size_t WS_CA = 198 * MiB;
constexpr size_t WS_HID = 206 * MiB;
constexpr size_t WS_HID2 = 207 * MiB;
constexpr size_t WS_CA2 = 214 * MiB;
constexpr size_t WS_CQN = 230 * MiB;
constexpr size_t WS_CKVN = 238 * MiB;
constexpr size_t WS_OCMP = 230 * MiB;
constexpr size_t WS_SEL = 246 * MiB;

__device__ const unsigned char T5B[128] = {
  0, 1, 2, 3, 4, 5, 6, 7, 8, 9, 10, 11, 12, 13, 14, 15, 16, 16, 16, 17, 17, 18, 18, 18, 19, 19, 19, 20, 20, 20, 20, 21,
  21, 21, 21, 22, 22, 22, 22, 22, 23, 23, 23, 23, 23, 23, 24, 24, 24, 24, 24, 24, 25, 25, 25, 25, 25, 25, 25, 26, 26, 26, 26, 26,
  26, 26, 26, 27, 27, 27, 27, 27, 27, 27, 27, 27, 27, 28, 28, 28, 28, 28, 28, 28, 28, 28, 28, 29, 29, 29, 29, 29, 29, 29, 29, 29,
  29, 29, 29, 30, 30, 30, 30, 30, 30, 30, 30, 30, 30, 30, 30, 30, 30, 31, 31, 31, 31, 31, 31, 31, 31, 31, 31, 31, 31, 31, 31, 31};

DEV float bf2f(bf16_t v) { return __uint_as_float(((unsigned)v) << 16); }
DEV bf16_t f2bf(float f) { unsigned u = __float_as_uint(f); u += 0x7fffu + ((u >> 16) & 1u); return (bf16_t)(u >> 16); }
DEV float wsum(float v) {
#pragma unroll
  for (int o = 32; o > 0; o >>= 1) v += __shfl_xor(v, o);
  return v;
}
DEV float wmaxf(float v) {
#pragma unroll
  for (int o = 32; o > 0; o >>= 1) v = fmaxf(v, __shfl_xor(v, o));
  return v;
}
DEV float sigmoidf_(float x) { return 1.0f / (1.0f + expf(-x)); }
DEV float gelu_exact(float x) { return 0.5f * x * (1.0f + erff(x * 0.70710678118654752f)); }
DEV void wave_lds_sync() { asm volatile("s_waitcnt lgkmcnt(0)" ::: "memory"); __builtin_amdgcn_wave_barrier(); asm volatile("" ::: "memory"); }
DEV float t5bias(const float* t5, int head, int dist) { int d = dist < 127 ? dist : 127; d = d < 0 ? 0 : d; return t5[(int)T5B[d] * 8 + head]; }


namespace pg8 {
#define PG8_LAS __attribute__((address_space(3)))
typedef unsigned short bf16_t;
typedef short bf16x8 __attribute__((ext_vector_type(8)));
typedef float f32x4 __attribute__((ext_vector_type(4)));
typedef unsigned u32x4 __attribute__((ext_vector_type(4)));
constexpr int BM = 256, BK = 64, HALF = 128, HTB = HALF * BK * 2  , STAGE_BYTES = 8 * HTB, NXCD = 8, WGM = 8;

__host__ __device__ __forceinline__ int lds_byte(int r, int c) { const int st = (r >> 4) * 2 + (c >> 5), rr = r & 15, cc = c & 31, ob = rr * 64 + cc * 2; return st * 1024 + (ob ^ (((ob >> 9) & 1) << 5)); }
__host__ __device__ __forceinline__ void stage_rc(int b, int& R, int& C) { const int st = b / 1024, sb = b % 1024, swz = sb ^ (((sb >> 9) & 1) << 5); R = (st >> 1) * 16 + swz / 64; C = (st & 1) * 32 + (swz % 64) / 2; }
__host__ __device__ __forceinline__ int perm32(int rho) { const int n = rho >> 4, i = rho & 15; return 8 * (i >> 2) + 4 * n + (i & 3); }

struct Unit { int pm, pn; };
struct Gemm { const bf16_t* A; const bf16_t* Bt; int M, N, K; };

struct StaticOrder {
    int nM, nN, nwg, G, c;
    __host__ __device__ void init(int M, int N, int G_, int c_) { nM = M / BM; nN = N / BM; nwg = nM * nN; G = G_; c = c_; }
    __host__ __device__ bool next(int i, Unit& u) const {
        const long L = (long)i * G + c; if (L >= nwg) return false;
        int wgid = (int)L; { const int q = nwg / NXCD, r = nwg % NXCD, xcd = wgid % NXCD, off = wgid / NXCD; wgid = (xcd < r ? xcd * (q + 1) : r * (q + 1) + (xcd - r) * q) + off; }
        const int nig = WGM * nN, gid = wgid / nig, fm = gid * WGM, gsz = (nM - fm) < WGM ? (nM - fm) : WGM;
        u.pm = fm + ((wgid % nig) % gsz); u.pn = (wgid % nig) / gsz; return true;
    }
    __device__ __forceinline__ void a_ready(const Unit&) const {}
    __device__ __forceinline__ void done(const Unit&) const {}
};

__device__ __forceinline__ unsigned cvt_pk_bf16(float lo, float hi) { unsigned r; asm volatile("v_cvt_pk_bf16_f32 %0, %1, %2" : "=v"(r) : "v"(lo), "v"(hi)); return r; }
typedef float f32x2 __attribute__((ext_vector_type(2)));
__device__ __forceinline__ f32x2 gelu_pk(f32x2 v) {
    const f32x2 av = __builtin_elementwise_abs(v), d = av * 0.2316418882f + 1.0f;
    f32x2 t; t.x = __builtin_amdgcn_rcpf(d.x); t.y = __builtin_amdgcn_rcpf(d.y);
    f32x2 q = t * 0.5307027145f + (-0.7265760135f); q = q * t + 0.7107068705f; q = q * t + (-0.142248368f); q = q * t + 0.127414796f; q = q * t;
    const f32x2 s = (v * v) * (-0.72134752044f);
    f32x2 e; e.x = __builtin_amdgcn_exp2f(s.x); e.y = __builtin_amdgcn_exp2f(s.y);
    const f32x2 m = v * (q * e), r = v - m;
    f32x2 o; o.x = v.x < 0.f ? m.x : r.x; o.y = v.y < 0.f ? m.y : r.y; return o;
}

template <int ACT  > struct EpiBf16 {
    static constexpr bool PERM = true, AFTER_DRAIN = false; static_assert(ACT == 0 || ACT == 1, "EpiBf16: ACT is 0 (none) or 1 (gelu_pk)");
    bf16_t* O; int ldc; const float* bias; int split_cols; size_t split_stride; float scale0;
    __device__ __forceinline__ void operator()(const f32x4 (&acc)[2][2][4][2], const Unit& u, int wr, int wc, int fr, int fq) const {
        const int row0 = u.pm * BM + wr * 64 + fr; int colt = u.pn * BM; bf16_t* base = O;
        float sc = 1.f; if (split_cols) { const int t = colt / split_cols; base += (size_t)t * split_stride; colt -= t * split_cols; if (t == 0) sc = scale0; }
        const int col0 = colt + wc * 32 + 8 * fq, bcol0 = u.pn * BM + wc * 32 + 8 * fq;
        f32x4 bv[2][2];
#pragma unroll
        for (int bj = 0; bj < 2; ++bj)
#pragma unroll
            for (int n = 0; n < 2; ++n) bv[bj][n] = bias ? *(const f32x4*)(bias + bcol0 + bj * HALF + 4 * n) : (f32x4){0.f, 0.f, 0.f, 0.f};
#pragma unroll
        for (int ai = 0; ai < 2; ++ai)
#pragma unroll
            for (int m = 0; m < 4; ++m) { bf16_t* rowp = base + (size_t)(row0 + ai * HALF + m * 16) * ldc + col0;
#pragma unroll
                for (int bj = 0; bj < 2; ++bj) { f32x4 v0 = acc[ai][bj][m][0] + bv[bj][0], v1 = acc[ai][bj][m][1] + bv[bj][1];
                    if (ACT == 1) { f32x2 a = gelu_pk((f32x2){v0[0], v0[1]}), b = gelu_pk((f32x2){v0[2], v0[3]}), c = gelu_pk((f32x2){v1[0], v1[1]}), d = gelu_pk((f32x2){v1[2], v1[3]});
                        v0 = (f32x4){a.x, a.y, b.x, b.y}; v1 = (f32x4){c.x, c.y, d.x, d.y}; }
                    v0 = v0 * sc; v1 = v1 * sc; u32x4 w; w.x = cvt_pk_bf16(v0[0], v0[1]); w.y = cvt_pk_bf16(v0[2], v0[3]); w.z = cvt_pk_bf16(v1[0], v1[1]); w.w = cvt_pk_bf16(v1[2], v1[3]);
                    *(u32x4*)(rowp + bj * HALF) = w; } }
    }
};

struct PanelStats {
    unsigned* xbuf;
    unsigned* cnt;
    unsigned* tmo;
    int ntn; float eps;
    unsigned code;
    __device__ __forceinline__ bool run(const f32x4 (&v)[2][2][4][2], const Unit& u, int wr, int wc, int fr, int fq, PG8_LAS unsigned char* lds, int wid, int lane) const {
        typedef float f32x2v __attribute__((ext_vector_type(2)));
        PG8_LAS f32x2v* P = (PG8_LAS f32x2v*)lds;
        PG8_LAS f32x2v* S = (PG8_LAS f32x2v*)(lds + 8192);
        PG8_LAS unsigned* flag = (PG8_LAS unsigned*)(lds + 8192 + 2048);
#pragma unroll
        for (int ai = 0; ai < 2; ++ai)
#pragma unroll
            for (int m = 0; m < 4; ++m) {
                float s = 0.f;
#pragma unroll
                for (int bj = 0; bj < 2; ++bj)
#pragma unroll
                    for (int n = 0; n < 2; ++n) { const f32x4 x = v[ai][bj][m][n]; s += (x[0] + x[1]) + (x[2] + x[3]); }
                s += __shfl_xor(s, 16); s += __shfl_xor(s, 32);
                const float mw = s * (1.0f / 64.0f); float q = 0.f;
#pragma unroll
                for (int bj = 0; bj < 2; ++bj)
#pragma unroll
                    for (int n = 0; n < 2; ++n) { const f32x4 d = v[ai][bj][m][n] - mw; q += (d[0] * d[0] + d[1] * d[1]) + (d[2] * d[2] + d[3] * d[3]); }
                q += __shfl_xor(q, 16); q += __shfl_xor(q, 32);
                if (fq == 0) P[(ai * HALF + wr * 64 + m * 16 + fr) * 4 + wc] = (f32x2v){mw, q};
            }
        asm volatile("s_waitcnt lgkmcnt(0)" ::: "memory"); __builtin_amdgcn_s_barrier(); asm volatile("" ::: "memory");
#if defined(BROKEN_EXCHANGE_NO_WAIT)
#warning BROKEN CONTROL BUILD: the row-statistics exchange does not wait; results are wrong by design
        if (blockIdx.x >= 64) { const long long t0_ = clock64(); while (clock64() - t0_ < 60000) __builtin_amdgcn_s_sleep(8); }
#endif
        const int row = wid * 32 + (lane & 31);
        if (lane < 32) {
            const f32x2v a = P[row * 4 + 0], b = P[row * 4 + 1], c = P[row * 4 + 2], d = P[row * 4 + 3];
            const float mt = (a.x + b.x + c.x + d.x) * 0.25f;
            const float da = a.x - mt, db = b.x - mt, dc = c.x - mt, dd = d.x - mt;
            const float m2 = (a.y + b.y) + (c.y + d.y) + 64.0f * ((da * da + db * db) + (dc * dc + dd * dd));
            unsigned long long* slot = (unsigned long long*)xbuf + ((size_t)(u.pm * BM + row) * 4 + u.pn);
            __hip_atomic_store(slot, ((unsigned long long)__float_as_uint(m2) << 32) | __float_as_uint(mt), __ATOMIC_RELAXED, __HIP_MEMORY_SCOPE_AGENT);
        }
        asm volatile("s_waitcnt vmcnt(0)" ::: "memory");
        if (lane == 0) __hip_atomic_fetch_add(cnt + 64 * u.pm, 1u, __ATOMIC_RELAXED, __HIP_MEMORY_SCOPE_AGENT);
        if (wid == 0) {
            bool dead = false; const unsigned long long t0 = __builtin_amdgcn_s_memrealtime(); const unsigned want = 8u * (unsigned)ntn;
            for (;;) {
#if defined(BROKEN_EXCHANGE_NO_WAIT)
                break;
#endif
                if ((unsigned)__builtin_amdgcn_readfirstlane(__hip_atomic_load(cnt + 64 * u.pm, __ATOMIC_RELAXED, __HIP_MEMORY_SCOPE_AGENT)) >= want) break;
                if (__builtin_amdgcn_s_memrealtime() - t0 > 2000000ull) {
                    if (lane == 0) { unsigned expect = 0u; __hip_atomic_compare_exchange_strong(tmo + 1, &expect, code | (unsigned)(u.pm & 0xff), __ATOMIC_RELAXED, __ATOMIC_RELAXED, __HIP_MEMORY_SCOPE_AGENT);
                                     __hip_atomic_store(tmo, 1u, __ATOMIC_RELAXED, __HIP_MEMORY_SCOPE_AGENT); }
                    dead = true; break; }
                __builtin_amdgcn_s_sleep(2);
            }
            __builtin_amdgcn_fence(__ATOMIC_ACQUIRE, "agent");
            if (lane == 0) flag[0] = dead ? 1u : 0u;
        }
        asm volatile("s_waitcnt vmcnt(0) lgkmcnt(0)" ::: "memory"); __builtin_amdgcn_s_barrier(); asm volatile("" ::: "memory");
        const bool bad = flag[0] != 0u;
        if (lane < 32) {
            const unsigned long long* slot = (const unsigned long long*)xbuf + (size_t)(u.pm * BM + row) * 4; float mt[4], m2[4]; float ms = 0.f;
#pragma unroll
            for (int t = 0; t < 4; ++t) { if (t < ntn) { const unsigned long long w = __hip_atomic_load(slot + t, __ATOMIC_RELAXED, __HIP_MEMORY_SCOPE_AGENT); mt[t] = __uint_as_float((unsigned)w); m2[t] = __uint_as_float((unsigned)(w >> 32)); } else { mt[t] = 0.f; m2[t] = 0.f; } ms += mt[t]; }
            const float mean = ms / (float)ntn; float q = 0.f;
#pragma unroll
            for (int t = 0; t < 4; ++t) if (t < ntn) { const float dm = mt[t] - mean; q += m2[t] + 256.0f * dm * dm; }
            S[row] = (f32x2v){mean, 1.0f / sqrtf(q / (256.0f * (float)ntn) + eps)};
        }
        asm volatile("s_waitcnt lgkmcnt(0)" ::: "memory"); __builtin_amdgcn_s_barrier(); asm volatile("" ::: "memory");
        return bad;
    }
};
struct EpiLnRes {
    static constexpr bool PERM = false, AFTER_DRAIN = true;
    const float* base; float* out; int ldc; const float* bias; PanelStats st; unsigned poison;
    __device__ __forceinline__ void fused(f32x4 (&acc)[2][2][4][2], const Unit& u, int wr, int wc, int fr, int fq, PG8_LAS unsigned char* lds, int wid, int lane) const {
        typedef float f32x2v __attribute__((ext_vector_type(2)));
        const PG8_LAS f32x2v* S = (const PG8_LAS f32x2v*)(lds + 8192);
        const int col0 = u.pn * BM + wc * 32 + 4 * fq;
#pragma unroll
        for (int bj = 0; bj < 2; ++bj)
#pragma unroll
            for (int n = 0; n < 2; ++n) { const f32x4 bv = bias ? *(const f32x4*)(bias + col0 + bj * HALF + n * 16) : (f32x4){0.f, 0.f, 0.f, 0.f};
#pragma unroll
                for (int ai = 0; ai < 2; ++ai)
#pragma unroll
                    for (int m = 0; m < 4; ++m) acc[ai][bj][m][n] += bv; }
        f32x4 pre[4][2][2];
#pragma unroll
        for (int m = 0; m < 4; ++m) { const size_t off = (size_t)(u.pm * BM + wr * 64 + m * 16 + fr) * ldc + col0;
#pragma unroll
            for (int bj = 0; bj < 2; ++bj)
#pragma unroll
                for (int n = 0; n < 2; ++n) pre[m][bj][n] = *(const f32x4*)(base + off + bj * HALF + n * 16); }
        const bool bad = st.run(acc, u, wr, wc, fr, fq, lds, wid, lane) || poison != 0u;
        const float qnan = __builtin_nanf("");
#pragma unroll
        for (int ai = 0; ai < 2; ++ai)
#pragma unroll
            for (int m = 0; m < 4; ++m) { const int r = ai * HALF + wr * 64 + m * 16 + fr; const f32x2v sr = S[r]; const size_t off = (size_t)(u.pm * BM + r) * ldc + col0;
#pragma unroll
                for (int bj = 0; bj < 2; ++bj)
#pragma unroll
                    for (int n = 0; n < 2; ++n) { const f32x4 bs = ai == 0 ? pre[m][bj][n] : *(const f32x4*)(base + off + bj * HALF + n * 16); f32x4 o = bs + (acc[ai][bj][m][n] - sr.x) * sr.y;
                        if (bad) o = (f32x4){qnan, qnan, qnan, qnan}; *(f32x4*)(out + off + bj * HALF + n * 16) = o; }
                if (m & 1) asm volatile("" ::: "memory"); }
    }
};
struct EpiLnResLn {
    static constexpr bool PERM = false, AFTER_DRAIN = true;
    const float* base; float* out; bf16_t* xn; int ldc; const float* bias; PanelStats st1, st2; unsigned poison;
    __device__ __forceinline__ void fused(f32x4 (&acc)[2][2][4][2], const Unit& u, int wr, int wc, int fr, int fq, PG8_LAS unsigned char* lds, int wid, int lane) const {
        typedef float f32x2v __attribute__((ext_vector_type(2))); typedef unsigned u32x2v __attribute__((ext_vector_type(2)));
        const PG8_LAS f32x2v* S = (const PG8_LAS f32x2v*)(lds + 8192);
        const int col0 = u.pn * BM + wc * 32 + 4 * fq;
#pragma unroll
        for (int bj = 0; bj < 2; ++bj)
#pragma unroll
            for (int n = 0; n < 2; ++n) { const f32x4 bv = bias ? *(const f32x4*)(bias + col0 + bj * HALF + n * 16) : (f32x4){0.f, 0.f, 0.f, 0.f};
#pragma unroll
                for (int ai = 0; ai < 2; ++ai)
#pragma unroll
                    for (int m = 0; m < 4; ++m) acc[ai][bj][m][n] += bv; }
        bool bad = st1.run(acc, u, wr, wc, fr, fq, lds, wid, lane) || poison != 0u;
        const float qnan = __builtin_nanf("");
#pragma unroll
        for (int ai = 0; ai < 2; ++ai)
#pragma unroll
            for (int m = 0; m < 4; ++m) { const int r = ai * HALF + wr * 64 + m * 16 + fr; const f32x2v sr = S[r]; const size_t off = (size_t)(u.pm * BM + r) * ldc + col0;
#pragma unroll
                for (int bj = 0; bj < 2; ++bj)
#pragma unroll
                    for (int n = 0; n < 2; ++n) { const f32x4 bs = *(const f32x4*)(base + off + bj * HALF + n * 16); acc[ai][bj][m][n] = bs + (acc[ai][bj][m][n] - sr.x) * sr.y; }
                asm volatile("" : "+v"(acc[ai][0][m][0]), "+v"(acc[ai][0][m][1]), "+v"(acc[ai][1][m][0]), "+v"(acc[ai][1][m][1]));
                if (m & 1) asm volatile("" ::: "memory"); }
        const bool bad1 = bad;
        bad = st2.run(acc, u, wr, wc, fr, fq, lds, wid, lane) || bad;
#pragma unroll
        for (int ai = 0; ai < 2; ++ai)
#pragma unroll
            for (int m = 0; m < 4; ++m) { const int r = ai * HALF + wr * 64 + m * 16 + fr; const f32x2v sr = S[r]; const size_t off = (size_t)(u.pm * BM + r) * ldc + col0;
#pragma unroll
                for (int bj = 0; bj < 2; ++bj)
#pragma unroll
                    for (int n = 0; n < 2; ++n) { const f32x4 x1 = acc[ai][bj][m][n]; *(f32x4*)(out + off + bj * HALF + n * 16) = bad1 ? (f32x4){qnan, qnan, qnan, qnan} : x1;
                        const f32x4 o = (x1 - sr.x) * sr.y; u32x2v w; w.x = cvt_pk_bf16(o[0], o[1]); w.y = cvt_pk_bf16(o[2], o[3]);
                        if (bad) { w.x = 0x7fc07fc0u; w.y = 0x7fc07fc0u; } *(u32x2v*)(xn + off + bj * HALF + n * 16) = w; }
                asm volatile("" ::: "memory"); }
    }
};

template <class Epi, class Sched, bool ALIGN_EPI = false, bool SP2 = false>
__device__ __forceinline__ void gemm_phase(PG8_LAS unsigned char* lds, const Gemm g, const Sched& S, const Epi& E) {
    int tid = threadIdx.x; asm volatile("" : "+v"(tid));
    const int wid = __builtin_amdgcn_readfirstlane(tid >> 6), lane = tid & 63, wr = wid >> 2, wc = wid & 3, fr = lane & 15, fq = lane >> 4;
    int K = g.K; asm volatile("" : "+s"(K)); const int nt = K / BK;
    unsigned voffA[2], voffB[2];
#pragma unroll
    for (int i = 0; i < 2; ++i) { int R, C; stage_rc(tid * 16 + i * 8192, R, C); const int Rb = Epi::PERM ? ((R & ~31) + perm32(R & 31)) : R;
        voffA[i] = (unsigned)(R * K + C) * 2u; voffB[i] = (unsigned)(Rb * K + C) * 2u; }
    const size_t kstep = (size_t)(BK * 2);
    const size_t hstep = (size_t)HALF * K * 2;
    const size_t tstep = 2 * hstep;
    const unsigned ldsw = (unsigned)wid * 1024u;
    const int aoff = lds_byte(wr * 64 + fr, fq * 8), boff = lds_byte(wc * 32 + fr, fq * 8);
#define PG8_SA(b, h) (((b) * 2 + (h)) * HTB)
#define PG8_SB(b, h) ((4 + (b) * 2 + (h)) * HTB)
#define PG8_STAGE(bufoff, gbase, voff) do { _Pragma("unroll") for (int _i = 0; _i < 2; ++_i) \
        __builtin_amdgcn_global_load_lds((const unsigned*)((const char*)(gbase) + (voff)[_i]), (PG8_LAS unsigned*)(lds + (bufoff) + ldsw + _i * 8192), 16, 0, 0); } while (0)
#define PG8_LDA(dst, b, h) do { _Pragma("unroll") for (int m = 0; m < 4; ++m) _Pragma("unroll") for (int k = 0; k < 2; ++k) dst[m][k] = *(const PG8_LAS bf16x8*)(lds + PG8_SA(b, h) + aoff + m * 2048 + k * 1024); } while (0)
#define PG8_LDB(dst, b, h) do { _Pragma("unroll") for (int n = 0; n < 2; ++n) _Pragma("unroll") for (int k = 0; k < 2; ++k) dst[n][k] = *(const PG8_LAS bf16x8*)(lds + PG8_SB(b, h) + boff + n * 2048 + k * 1024); } while (0)
#define PG8_MMA(ai, bj, At, Bt) do { __builtin_amdgcn_s_setprio(1); _Pragma("unroll") for (int m = 0; m < 4; ++m) _Pragma("unroll") for (int n = 0; n < 2; ++n) _Pragma("unroll") for (int k = 0; k < 2; ++k) \
        acc[ai][bj][m][n] = __builtin_amdgcn_mfma_f32_16x16x32_bf16(Bt[n][k], At[m][k], acc[ai][bj][m][n], 0, 0, 0); __builtin_amdgcn_s_setprio(0); } while (0)
#define PG8_WAIT_V(n) asm volatile("s_waitcnt vmcnt(" #n ")" ::: "memory")
#define PG8_WAIT_L(n) asm volatile("s_waitcnt lgkmcnt(" #n ")" ::: "memory")
#define PG8_BAR __builtin_amdgcn_s_barrier()
#define PG8_SCHED __builtin_amdgcn_sched_barrier(0)
    Unit cur, nxt; int ui = 0;
    if (!S.next(0, cur)) return;
    f32x4 acc[2][2][4][2];
#pragma unroll
    for (int a = 0; a < 2; ++a)
#pragma unroll
        for (int b = 0; b < 2; ++b)
#pragma unroll
            for (int m = 0; m < 4; ++m)
#pragma unroll
                for (int n = 0; n < 2; ++n) acc[a][b][m][n] = (f32x4){0.f, 0.f, 0.f, 0.f};
    bf16x8 At[4][2], B0[2][2], B1[2][2];
    const char* cA = (const char*)g.A + (size_t)cur.pm * tstep; const char* cB = (const char*)g.Bt + (size_t)cur.pn * tstep;
    S.a_ready(cur);
    if constexpr (SP2) {
        PG8_STAGE(PG8_SB(0, 0), cB, voffB); PG8_STAGE(PG8_SB(0, 1), cB + hstep, voffB); PG8_STAGE(PG8_SA(0, 0), cA, voffA); PG8_STAGE(PG8_SA(0, 1), cA + hstep, voffA);
        if (wr == 1) PG8_BAR;
        PG8_WAIT_V(2); PG8_BAR;
        PG8_STAGE(PG8_SB(1, 0), cB + kstep, voffB); PG8_STAGE(PG8_SA(1, 0), cA + kstep, voffA); PG8_STAGE(PG8_SB(1, 1), cB + hstep + kstep, voffB);
        PG8_WAIT_V(6); PG8_BAR;
    } else {
        PG8_STAGE(PG8_SB(0, 0), cB, voffB); PG8_STAGE(PG8_SA(0, 0), cA, voffA); PG8_STAGE(PG8_SB(0, 1), cB + hstep, voffB); PG8_STAGE(PG8_SA(0, 1), cA + hstep, voffA);
        if (wr == 1) PG8_BAR;
        PG8_WAIT_V(4); PG8_BAR;
        PG8_STAGE(PG8_SB(1, 0), cB + kstep, voffB); PG8_STAGE(PG8_SA(1, 0), cA + kstep, voffA); PG8_STAGE(PG8_SB(1, 1), cB + hstep + kstep, voffB);
        PG8_WAIT_V(6); PG8_BAR;
    }
    for (;;) {
        const bool has_next = S.next(ui + 1, nxt);
        const char* nA = has_next ? (const char*)g.A + (size_t)nxt.pm * tstep : cA; const char* nB = has_next ? (const char*)g.Bt + (size_t)nxt.pn * tstep : cB;
        for (int t = 0; t < nt; t += 2) {
            const bool last = (t == nt - 2);
            const char* a1 = cA + (size_t)(t + 1) * kstep;
            const char* a2 = last ? nA : cA + (size_t)(t + 2) * kstep; const char* b2 = last ? nB : cB + (size_t)(t + 2) * kstep;
            const char* a3 = a2 + kstep; const char* b3 = b2 + kstep;
            if (last && has_next) S.a_ready(nxt);
            if constexpr (SP2) {
            PG8_LDB(B0, 0, 0); PG8_LDB(B1, 0, 1); PG8_SCHED; PG8_LDA(At, 0, 0); PG8_STAGE(PG8_SA(1, 1), a1 + hstep, voffA);
            PG8_WAIT_V(8); PG8_WAIT_L(0); PG8_BAR; PG8_MMA(0, 0, At, B0); PG8_MMA(0, 1, At, B1); PG8_BAR; PG8_SCHED;
            PG8_LDA(At, 0, 1); PG8_STAGE(PG8_SB(0, 0), b2, voffB); PG8_STAGE(PG8_SB(0, 1), b2 + hstep, voffB); PG8_STAGE(PG8_SA(0, 0), a2, voffA);
            PG8_WAIT_V(8); PG8_WAIT_L(0); PG8_BAR; PG8_MMA(1, 0, At, B0); PG8_MMA(1, 1, At, B1); PG8_BAR; PG8_SCHED;
            PG8_LDB(B0, 1, 0); PG8_LDB(B1, 1, 1); PG8_SCHED; PG8_LDA(At, 1, 0); PG8_STAGE(PG8_SA(0, 1), a2 + hstep, voffA);
            PG8_WAIT_V(8); PG8_WAIT_L(0); PG8_BAR; PG8_MMA(0, 0, At, B0); PG8_MMA(0, 1, At, B1); PG8_BAR; PG8_SCHED;
            PG8_LDA(At, 1, 1); PG8_STAGE(PG8_SB(1, 0), b3, voffB); PG8_STAGE(PG8_SB(1, 1), b3 + hstep, voffB); PG8_STAGE(PG8_SA(1, 0), a3, voffA);
            PG8_WAIT_V(8); PG8_WAIT_L(0); PG8_BAR; PG8_MMA(1, 0, At, B0); PG8_MMA(1, 1, At, B1); PG8_BAR; PG8_SCHED;
            } else {
            PG8_LDB(B0, 0, 0); PG8_SCHED; PG8_LDA(At, 0, 0); PG8_STAGE(PG8_SA(1, 1), a1 + hstep, voffA);
            PG8_WAIT_L(8); PG8_BAR; PG8_WAIT_L(0); PG8_MMA(0, 0, At, B0); PG8_BAR; PG8_SCHED;
            PG8_LDB(B1, 0, 1); PG8_STAGE(PG8_SB(0, 0), b2, voffB);
            PG8_BAR; PG8_WAIT_L(0); PG8_MMA(0, 1, At, B1); PG8_BAR;
            PG8_LDA(At, 0, 1); PG8_STAGE(PG8_SA(0, 0), a2, voffA);
            PG8_BAR; PG8_WAIT_L(0); PG8_MMA(1, 0, At, B0); PG8_BAR; PG8_SCHED;
            PG8_STAGE(PG8_SB(0, 1), b2 + hstep, voffB);
            PG8_WAIT_V(6); PG8_BAR; PG8_MMA(1, 1, At, B1); PG8_BAR;
            PG8_LDB(B0, 1, 0); PG8_SCHED; PG8_LDA(At, 1, 0); PG8_STAGE(PG8_SA(0, 1), a2 + hstep, voffA);
            PG8_WAIT_L(8); PG8_BAR; PG8_WAIT_L(0); PG8_MMA(0, 0, At, B0); PG8_BAR; PG8_SCHED;
            PG8_LDB(B1, 1, 1); PG8_STAGE(PG8_SB(1, 0), b3, voffB);
            PG8_BAR; PG8_WAIT_L(0); PG8_MMA(0, 1, At, B1); PG8_BAR;
            PG8_LDA(At, 1, 1); PG8_STAGE(PG8_SA(1, 0), a3, voffA);
            PG8_BAR; PG8_WAIT_L(0); PG8_MMA(1, 0, At, B0); PG8_BAR; PG8_SCHED;
            PG8_STAGE(PG8_SB(1, 1), b3 + hstep, voffB);
            PG8_WAIT_V(6); PG8_BAR; PG8_MMA(1, 1, At, B1); PG8_BAR;
            }
        }
        if constexpr (ALIGN_EPI) { if (wr == 0) PG8_BAR; }
        if constexpr (!Epi::AFTER_DRAIN) { E(acc, cur, wr, wc, fr, fq); S.done(cur); }
        if (!has_next) break;
#pragma unroll
        for (int a = 0; a < 2; ++a)
#pragma unroll
            for (int b = 0; b < 2; ++b)
#pragma unroll
                for (int m = 0; m < 4; ++m)
#pragma unroll
                    for (int n = 0; n < 2; ++n) acc[a][b][m][n] = (f32x4){0.f, 0.f, 0.f, 0.f};
        cur = nxt; cA = nA; cB = nB; ++ui;
        if constexpr (ALIGN_EPI) { if (wr == 1) PG8_BAR; }
    }
    PG8_WAIT_V(0);
    if constexpr (!ALIGN_EPI) { if (wr == 0) PG8_BAR; }
    PG8_BAR;
    if constexpr (Epi::AFTER_DRAIN) { E.fused(acc, cur, wr, wc, fr, fq, lds, wid, lane); S.done(cur); }
#undef PG8_SA
#undef PG8_SB
#undef PG8_STAGE
#undef PG8_LDA
#undef PG8_LDB
#undef PG8_MMA
#undef PG8_WAIT_V
#undef PG8_WAIT_L
#undef PG8_BAR
#undef PG8_SCHED
}
}

namespace pg8 {
constexpr float LOG2E = 1.4426950408889634f;
constexpr float QS_NSA = 0.125f * LOG2E;
constexpr float QS_MLA = 0.10206207261596575f * LOG2E;
__device__ __forceinline__ float fast_sigmoid(float x) { return __builtin_amdgcn_rcpf(1.0f + __builtin_amdgcn_exp2f(-LOG2E * x)); }
__device__ __forceinline__ float lo_bf(unsigned u) { return __uint_as_float(u << 16); }
__device__ __forceinline__ float hi_bf(unsigned u) { return __uint_as_float(u & 0xffff0000u); }
struct EpiInProjF {
    static constexpr bool PERM = true, AFTER_DRAIN = false;
    bf16_t* proj; bf16_t* gates;
    __device__ __forceinline__ void operator()(const f32x4 (&acc)[2][2][4][2], const Unit& u, int wr, int wc, int fr, int fq) const {
        const bool isg = u.pn >= 7;
        bf16_t* base = isg ? gates : proj; const int ld = isg ? 2048 : 1792; const int colt = isg ? (u.pn - 7) * BM : u.pn * BM;
        const float sc = (u.pn < 2) ? QS_NSA : 1.0f;
        const int row0 = u.pm * BM + wr * 64 + fr, col0 = colt + wc * 32 + 8 * fq;
#pragma unroll
        for (int ai = 0; ai < 2; ++ai)
#pragma unroll
            for (int m = 0; m < 4; ++m) { bf16_t* rowp = base + (size_t)(row0 + ai * HALF + m * 16) * ld + col0;
#pragma unroll
                for (int bj = 0; bj < 2; ++bj) { f32x4 v0 = acc[ai][bj][m][0], v1 = acc[ai][bj][m][1];
                    if (isg) {
#pragma unroll
                        for (int e = 0; e < 4; ++e) { v0[e] = fast_sigmoid(v0[e]); v1[e] = fast_sigmoid(v1[e]); } }
                    else { v0 = v0 * sc; v1 = v1 * sc; }
                    u32x4 w; w.x = cvt_pk_bf16(v0[0], v0[1]); w.y = cvt_pk_bf16(v0[2], v0[3]); w.z = cvt_pk_bf16(v1[0], v1[1]); w.w = cvt_pk_bf16(v1[2], v1[3]);
                    *(u32x4*)(rowp + bj * HALF) = w; } }
    }
};
template <int PASS> struct EpiMergeF {
    static constexpr bool PERM = true, AFTER_DRAIN = false;
    const bf16_t* gates; bf16_t* merged;
    __device__ __forceinline__ void operator()(const f32x4 (&acc)[2][2][4][2], const Unit& u, int wr, int wc, int fr, int fq) const {
        const int row0 = u.pm * BM + wr * 64 + fr, col0 = u.pn * BM + wc * 32 + 8 * fq;
#pragma unroll
        for (int ai = 0; ai < 2; ++ai)
#pragma unroll
            for (int m = 0; m < 4; ++m) { const size_t r = (size_t)(row0 + ai * HALF + m * 16);
#pragma unroll
                for (int bj = 0; bj < 2; ++bj) { const int c = col0 + bj * HALF;
                    const u32x4 g = *(const u32x4*)(gates + r * 2048 + PASS * 1024 + c);
                    f32x4 v0 = acc[ai][bj][m][0], v1 = acc[ai][bj][m][1];
                    v0[0] *= lo_bf(g.x); v0[1] *= hi_bf(g.x); v0[2] *= lo_bf(g.y); v0[3] *= hi_bf(g.y);
                    v1[0] *= lo_bf(g.z); v1[1] *= hi_bf(g.z); v1[2] *= lo_bf(g.w); v1[3] *= hi_bf(g.w);
                    if (PASS == 1) { const u32x4 o = *(const u32x4*)(merged + r * 1024 + c);
                        v0[0] += lo_bf(o.x); v0[1] += hi_bf(o.x); v0[2] += lo_bf(o.y); v0[3] += hi_bf(o.y);
                        v1[0] += lo_bf(o.z); v1[1] += hi_bf(o.z); v1[2] += lo_bf(o.w); v1[3] += hi_bf(o.w); }
                    u32x4 w; w.x = cvt_pk_bf16(v0[0], v0[1]); w.y = cvt_pk_bf16(v0[2], v0[3]); w.z = cvt_pk_bf16(v1[0], v1[1]); w.w = cvt_pk_bf16(v1[2], v1[3]);
                    *(u32x4*)(merged + r * 1024 + c) = w; } }
    }
};
struct EpiCmpOutF {
    static constexpr bool PERM = true, AFTER_DRAIN = false;
    bf16_t* dst;
    __device__ __forceinline__ void operator()(const f32x4 (&acc)[2][2][4][2], const Unit& u, int wr, int wc, int fr, int fq) const {
        if (wc >= 2) return;
        const int row0 = u.pm * BM + wr * 64 + fr, col0 = wc * 32 + 8 * fq;
#pragma unroll
        for (int ai = 0; ai < 2; ++ai)
#pragma unroll
            for (int m = 0; m < 4; ++m) { const int r = row0 + ai * HALF + m * 16;
                if (r < BATCH * NC * 2) { const int g = r & 1, bc = r >> 1, b = bc / NC, c = bc % NC;
                    const f32x4 v0 = acc[ai][0][m][0], v1 = acc[ai][0][m][1];
                    u32x4 w; w.x = cvt_pk_bf16(v0[0], v0[1]); w.y = cvt_pk_bf16(v0[2], v0[3]); w.z = cvt_pk_bf16(v1[0], v1[1]); w.w = cvt_pk_bf16(v1[2], v1[3]);
                    *(u32x4*)(dst + ((size_t)(b * 2 + g) * 128 + c) * 64 + col0) = w; } }
    }
};
struct EpiResidF {
    static constexpr bool PERM = false, AFTER_DRAIN = false;
    const float* x; float* h;
    __device__ __forceinline__ void operator()(const f32x4 (&acc)[2][2][4][2], const Unit& u, int wr, int wc, int fr, int fq) const {
        const int row0 = u.pm * BM + wr * 64 + fr, col0 = u.pn * BM + wc * 32 + 4 * fq;
#pragma unroll
        for (int ai = 0; ai < 2; ++ai)
#pragma unroll
            for (int m = 0; m < 4; ++m) { const size_t off = (size_t)(row0 + ai * HALF + m * 16) * 1024 + col0;
#pragma unroll
                for (int bj = 0; bj < 2; ++bj)
#pragma unroll
                    for (int n = 0; n < 2; ++n) { const f32x4 xv = *(const f32x4*)(x + off + bj * HALF + n * 16); *(f32x4*)(h + off + bj * HALF + n * 16) = xv + acc[ai][bj][m][n]; } }
    }
};
struct EpiMlaQF {
    static constexpr bool PERM = false, AFTER_DRAIN = false;
    bf16_t* q; const float2* cs;
    __device__ __forceinline__ void operator()(const f32x4 (&acc)[2][2][4][2], const Unit& u, int wr, int wc, int fr, int fq) const {
        const int row0 = u.pm * BM + wr * 64 + fr;
#pragma unroll
        for (int bj = 0; bj < 2; ++bj) {
            const int X = u.pn * BM + bj * HALF + wc * 32;
            const bool rope = (X % 96) == 64;
#pragma unroll
            for (int ai = 0; ai < 2; ++ai)
#pragma unroll
                for (int m = 0; m < 4; ++m) { const int r = row0 + ai * HALF + m * 16; const int pos = r & (SEQ - 1);
                    f32x4 v0 = acc[ai][bj][m][0], v1 = acc[ai][bj][m][1];
                    if (rope) {
#pragma unroll
                        for (int j = 0; j < 4; ++j) { const float2 c = cs[pos * 16 + 4 * fq + j]; const float x1 = v0[j], x2 = v1[j]; v0[j] = x1 * c.x - x2 * c.y; v1[j] = x2 * c.x + x1 * c.y; } }
                    v0 = v0 * QS_MLA; v1 = v1 * QS_MLA;
                    bf16_t* p = q + (size_t)r * 768 + X + 4 * fq;
                    uint2 w0, w1; w0.x = cvt_pk_bf16(v0[0], v0[1]); w0.y = cvt_pk_bf16(v0[2], v0[3]); w1.x = cvt_pk_bf16(v1[0], v1[1]); w1.y = cvt_pk_bf16(v1[2], v1[3]);
                    *(uint2*)p = w0; *(uint2*)(p + 16) = w1; }
        }
    }
};
}

#define PG8_SP2 true
#define PG8_ALIGN true
constexpr int NTHR = 512, NWV = NTHR / 64;
#define WAVE_IDS const int lane = threadIdx.x & 63, wv = threadIdx.x >> 6; const int gw = blockIdx.x * NWV + wv, nw = gridDim.x * NWV; (void)lane; (void)gw; (void)nw;

template <bool Q8> DEV void ph_rms1024(const float* __restrict__ src, const float* __restrict__ g, bf16_t* __restrict__ dst, int rows, unsigned* __restrict__ q8 = nullptr, float* __restrict__ qs = nullptr) {
  WAVE_IDS
  float4 gg[4];
#pragma unroll
  for (int j = 0; j < 4; ++j) gg[j] = ((const float4*)g)[j * 64 + lane];
  float4 nx[4];
  if (gw < rows) {
#pragma unroll
    for (int j = 0; j < 4; ++j) nx[j] = ((const float4*)(src + (size_t)gw * 1024))[j * 64 + lane]; }
  for (int r = gw; r < rows; r += nw) {
    float4 v[4]; float ss = 0.f;
#pragma unroll
    for (int j = 0; j < 4; ++j) { v[j] = nx[j]; ss += v[j].x * v[j].x + v[j].y * v[j].y + v[j].z * v[j].z + v[j].w * v[j].w; }
    if (r + nw < rows) {
#pragma unroll
      for (int j = 0; j < 4; ++j) nx[j] = ((const float4*)(src + (size_t)(r + nw) * 1024))[j * 64 + lane]; }
    ss = wsum(ss);
    const float inv = rsqrtf(ss * (1.0f / 1024.0f) + 1e-6f);
    float mx = 0.f;
#pragma unroll
    for (int j = 0; j < 4; ++j) {
      v[j].x *= inv * gg[j].x; v[j].y *= inv * gg[j].y; v[j].z *= inv * gg[j].z; v[j].w *= inv * gg[j].w;
      uint2 o;
      o.x = (unsigned)f2bf(v[j].x) | ((unsigned)f2bf(v[j].y) << 16);
      o.y = (unsigned)f2bf(v[j].z) | ((unsigned)f2bf(v[j].w) << 16);
      ((uint2*)(dst + (size_t)r * 1024))[j * 64 + lane] = o;
      if (Q8) mx = fmaxf(mx, fmaxf(fmaxf(fabsf(v[j].x), fabsf(v[j].y)), fmaxf(fabsf(v[j].z), fabsf(v[j].w))));
    }
    if (Q8) {
      mx = wmaxf(mx);
      const float sc = fmaxf(mx, 1e-30f) * (1.0f / 127.0f), isc = 1.0f / sc;
#pragma unroll
      for (int j = 0; j < 4; ++j) {
        const int q0 = (int)rintf(v[j].x * isc), q1 = (int)rintf(v[j].y * isc), q2 = (int)rintf(v[j].z * isc), q3 = (int)rintf(v[j].w * isc);
        q8[(size_t)r * 256 + j * 64 + lane] = (unsigned)(q0 & 255) | ((unsigned)(q1 & 255) << 8) | ((unsigned)(q2 & 255) << 16) | ((unsigned)(q3 & 255) << 24);
      }
      if (lane == 0) qs[r] = sc;
    }
  }
}
template <int PER> DEV void ph_rms_cols(const bf16_t* __restrict__ proj, int col0, const float* __restrict__ g, bf16_t* __restrict__ dst) {
  WAVE_IDS
  constexpr int W = 64 * PER;
  for (int r = gw; r < T; r += nw) {
    float v[PER]; float ss = 0.f;
#pragma unroll
    for (int j = 0; j < PER; ++j) { v[j] = bf2f(proj[(size_t)r * PROJ_LD + col0 + j * 64 + lane]); ss += v[j] * v[j]; }
    ss = wsum(ss);
    const float inv = rsqrtf(ss * (1.0f / W) + 1e-6f);
#pragma unroll
    for (int j = 0; j < PER; ++j) dst[(size_t)r * W + j * 64 + lane] = f2bf(v[j] * inv * g[j * 64 + lane]);
  }
}

DEV int win_src_col(int n) {
  if (n < 1280) return n;
  if (n < 1536) return 1304 + (n - 1280);
  if (n < 1664) return 1560 + (n - 1536);
  if (n < 1696) return 1688 + (n - 1664);
  if (n < 1720) return 1280 + (n - 1696);
  if (n < 1792) return -1;
  return 1720 + (n - 1792);
}
template <int MODE> DEV void tr_item(const float* __restrict__ W, int K, int Nsrc, bf16_t* __restrict__ WT, int Nblk, int Nvalid, __attribute__((address_space(3))) float* scr, int item, int lane) {
  const int kb = item / Nblk, nb = item % Nblk, k0 = 64 * kb, n0 = 32 * nb;
  const int n = n0 + (lane & 31);
  const int sc = (MODE == 1) ? win_src_col(n) : ((n < Nvalid) ? n : -1);
#pragma unroll 8
  for (int i = 0; i < 32; ++i) { const int kk = 2 * i + (lane >> 5); scr[kk * 33 + (lane & 31)] = (sc >= 0) ? W[(size_t)(k0 + kk) * Nsrc + sc] : 0.f; }
  asm volatile("s_waitcnt lgkmcnt(0)" ::: "memory");
  const int c = lane & 7;
#pragma unroll
  for (int j = 0; j < 4; ++j) { const int nn = (lane >> 3) + 8 * j; const __attribute__((address_space(3))) float* sp = scr + (8 * c) * 33 + nn;
    uint4 o;
    o.x = (unsigned)f2bf(sp[0 * 33]) | ((unsigned)f2bf(sp[1 * 33]) << 16); o.y = (unsigned)f2bf(sp[2 * 33]) | ((unsigned)f2bf(sp[3 * 33]) << 16);
    o.z = (unsigned)f2bf(sp[4 * 33]) | ((unsigned)f2bf(sp[5 * 33]) << 16); o.w = (unsigned)f2bf(sp[6 * 33]) | ((unsigned)f2bf(sp[7 * 33]) << 16);
    *(uint4*)(WT + (size_t)(n0 + nn) * K + k0 + 8 * c) = o; }
  asm volatile("s_waitcnt lgkmcnt(0)" ::: "memory");
}
DEV void ph_conv_plain(const float* __restrict__ src, bf16_t* __restrict__ dst, int n) {
  for (int i = blockIdx.x * NTHR + threadIdx.x; i < n; i += gridDim.x * NTHR) dst[i] = f2bf(src[i]);
}

DEV void gemm_tile(const bf16_t* __restrict__ A, int lda, const bf16_t* __restrict__ Bt, int ldb, int m0, int n0, int K, float (&acc)[4][4], char* lds) {
  float (*sA)[132] = (float (*)[132])lds;
  float (*sB)[68] = (float (*)[68])(lds + 32 * 132 * 4);
  const int tid = threadIdx.x, ty = tid >> 4, tx = tid & 15;
  const int lr = tid >> 2, lk = (tid & 3) * 8;
  for (int k0 = 0; k0 < K; k0 += 32) {
    {
      const uint4 va = *(const uint4*)(A + (size_t)(m0 + lr) * lda + k0 + lk);
      const unsigned ua[4] = {va.x, va.y, va.z, va.w};
#pragma unroll
      for (int j = 0; j < 4; ++j) { sA[lk + 2 * j][lr] = __uint_as_float(ua[j] << 16); sA[lk + 2 * j + 1][lr] = __uint_as_float(ua[j] & 0xffff0000u); }
    }
    if (tid < 256) {
      const uint4 vb = *(const uint4*)(Bt + (size_t)(n0 + lr) * ldb + k0 + lk);
      const unsigned ub[4] = {vb.x, vb.y, vb.z, vb.w};
#pragma unroll
      for (int j = 0; j < 4; ++j) { sB[lk + 2 * j][lr] = __uint_as_float(ub[j] << 16); sB[lk + 2 * j + 1][lr] = __uint_as_float(ub[j] & 0xffff0000u); }
    }
    __syncthreads();
#pragma unroll 8
    for (int k = 0; k < 32; ++k) {
      const float4 a = *(const float4*)&sA[k][ty * 4];
      const float4 b = *(const float4*)&sB[k][tx * 4];
      const float av[4] = {a.x, a.y, a.z, a.w}, bv[4] = {b.x, b.y, b.z, b.w};
#pragma unroll
      for (int i = 0; i < 4; ++i)
#pragma unroll
        for (int j = 0; j < 4; ++j) acc[i][j] += av[i] * bv[j];
    }
    __syncthreads();
  }
}
struct EpiInProj { bf16_t* proj; bf16_t* gates;
  DEV void operator()(int m, int n, float v) const { if (n < PROJ_LD) proj[(size_t)m * PROJ_LD + n] = f2bf(v); else gates[(size_t)m * 2048 + (n - PROJ_LD)] = f2bf(sigmoidf_(v)); } };
struct EpiStore { bf16_t* dst; int ld;
  DEV void operator()(int m, int n, float v) const { dst[(size_t)m * ld + n] = f2bf(v); } };
struct EpiGelu { bf16_t* dst; int ld;
  DEV void operator()(int m, int n, float v) const { dst[(size_t)m * ld + n] = f2bf(gelu_exact(v)); } };
struct EpiCmpOut { bf16_t* dst;
  DEV void operator()(int m, int n, float v) const { if (m >= BATCH * NC * 2) return; const int g = m & 1, bc = m >> 1, b = bc / NC, c = bc % NC; dst[((size_t)(b * 2 + g) * 128 + c) * 64 + n] = f2bf(v); } };
struct EpiResid { const float* x; float* h;
  DEV void operator()(int m, int n, float v) const { const size_t i = (size_t)m * 1024 + n; h[i] = x[i] + v; } };

template <class Epi> DEV void ph_gemm(const bf16_t* A, int lda, const bf16_t* Bt, int ldb, int M, int N, int K, const Epi& epi, char* lds) {
  const int ntn = N / 64, ntm = M / 128;
  const int ty = threadIdx.x >> 4, tx = threadIdx.x & 15;
  for (int tile = blockIdx.x; tile < ntn * ntm; tile += gridDim.x) {
    const int m0 = (tile / ntn) * 128, n0 = (tile % ntn) * 64;
    float acc[4][4];
#pragma unroll
    for (int i = 0; i < 4; ++i)
#pragma unroll
      for (int j = 0; j < 4; ++j) acc[i][j] = 0.f;
    gemm_tile(A, lda, Bt, ldb, m0, n0, K, acc, lds);
#pragma unroll
    for (int i = 0; i < 4; ++i)
#pragma unroll
      for (int j = 0; j < 4; ++j) epi(m0 + ty * 4 + i, n0 + tx * 4 + j, acc[i][j]);
  }
}
DEV void ph_merge(const bf16_t* onsa, const bf16_t* omla, const bf16_t* wbn, const bf16_t* wbm, const bf16_t* gates, bf16_t* merged, char* lds) {
  const int ntn = 1024 / 64, ntm = T / 128;
  const int ty = threadIdx.x >> 4, tx = threadIdx.x & 15;
  for (int tile = blockIdx.x; tile < ntn * ntm; tile += gridDim.x) {
    const int m0 = (tile / ntn) * 128, n0 = (tile % ntn) * 64;
    float a1[4][4], a2[4][4];
#pragma unroll
    for (int i = 0; i < 4; ++i)
#pragma unroll
      for (int j = 0; j < 4; ++j) { a1[i][j] = 0.f; a2[i][j] = 0.f; }
    gemm_tile(onsa, 512, wbn, 512, m0, n0, 512, a1, lds);
    gemm_tile(omla, 512, wbm, 512, m0, n0, 512, a2, lds);
#pragma unroll
    for (int i = 0; i < 4; ++i)
#pragma unroll
      for (int j = 0; j < 4; ++j) {
        const int m = m0 + ty * 4 + i, n = n0 + tx * 4 + j;
        merged[(size_t)m * 1024 + n] = f2bf(bf2f(gates[(size_t)m * 2048 + n]) * a1[i][j] + bf2f(gates[(size_t)m * 2048 + 1024 + n]) * a2[i][j]);
      }
  }
}

DEV void ph_rope_table(float2* __restrict__ cs) {
  const int n = SEQ * 16;
  for (int i = blockIdx.x * NTHR + threadIdx.x; i < n; i += gridDim.x * NTHR) {
    const int j = i & 15, pos = i >> 4;
    const float inv_freq = __builtin_amdgcn_exp2f(-(float)(2 * j) * (13.287712379549449f / 32.0f));
    const float rev = (float)pos * inv_freq * 0.15915494309189535f;
    const float fr = rev - floorf(rev);
    cs[i] = make_float2(__builtin_amdgcn_cosf(fr), __builtin_amdgcn_sinf(fr));
  }
}
DEV void ph_rope_k(const bf16_t* __restrict__ proj, bf16_t* __restrict__ kr) {
  const int n = T * 16;
  for (int i = blockIdx.x * NTHR + threadIdx.x; i < n; i += gridDim.x * NTHR) {
    const int j = i & 15, t = i >> 4;
    const float pos = (float)(t & (SEQ - 1));
    const float inv_freq = powf(10000.0f, -(float)(2 * j) / 32.0f);
    const float ang = pos * inv_freq, c = cosf(ang), s = sinf(ang);
    const float x1 = bf2f(proj[(size_t)t * PROJ_LD + PC_KR + j]), x2 = bf2f(proj[(size_t)t * PROJ_LD + PC_KR + 16 + j]);
    kr[(size_t)t * 32 + j] = f2bf(x1 * c - x2 * s); kr[(size_t)t * 32 + 16 + j] = f2bf(x2 * c + x1 * s);
  }
}
DEV void ph_cmp_gather(const bf16_t* __restrict__ proj, const float* __restrict__ pos, int which, bf16_t* __restrict__ ca) {
  const int n = 2048 * 2048;
  for (int i = blockIdx.x * NTHR + threadIdx.x; i < n; i += gridDim.x * NTHR) {
    const int e = i & 2047, row = i >> 11;
    float v = 0.f;
    if (row < BATCH * NC * 2) {
      const int g = row & 1, bc = row >> 1, b = bc / NC, c = bc % NC, l = e >> 6, d = e & 63;
      v = bf2f(proj[(size_t)(b * SEQ + 16 * c + l) * PROJ_LD + PC_KV + which * 128 + g * 64 + d]) + pos[e];
    }
    ca[i] = f2bf(v);
  }
}

DEV void ph_cmp_attn(const bf16_t* __restrict__ proj, const bf16_t* __restrict__ kc, const bf16_t* __restrict__ vc,
                     const float* __restrict__ t5, bf16_t* __restrict__ ocmp, unsigned* __restrict__ sel, char* lds) {
  WAVE_IDS
  float* P = (float*)(lds + wv * 1024); float* Q = P + 128;
  for (int item = gw; item < BATCH * 2 * SEQ; item += nw) {
    const int t = item & (SEQ - 1), bg = item >> 11, g = bg & 1, b = bg >> 1;
    const size_t tok = (size_t)b * SEQ + t;
    const int nvalid = (t >= 31) ? min(NC, (t - 31) / 16 + 1) : 0;
    const bf16_t* kcb = kc + (size_t)bg * 128 * 64;
    const bf16_t* vcb = vc + (size_t)bg * 128 * 64;
    float impacc = 0.f;
    for (int r = 0; r < 4; ++r) {
      const int head = g * 4 + r;
      Q[lane] = bf2f(proj[tok * PROJ_LD + PC_Q + head * 64 + lane]);
      wave_lds_sync();
      float lg[2];
#pragma unroll
      for (int u = 0; u < 2; ++u) {
        const int c = lane + 64 * u;
        float d = 0.f;
        if (c < nvalid) { const bf16_t* kr = kcb + c * 64; for (int e = 0; e < 64; ++e) d += Q[e] * bf2f(kr[e]); }
        lg[u] = (c < nvalid) ? d + 1.4426950408889634f * t5bias(t5, head, t - (16 * c + 31)) : -1e30f;
      }
      const float m = wmaxf(fmaxf(lg[0], lg[1]));
      const float e0 = (lane < nvalid) ? exp2f(lg[0] - m) : 0.f, e1 = (lane + 64 < nvalid) ? exp2f(lg[1] - m) : 0.f;
      const float s = wsum(e0 + e1);
      const float inv = (nvalid > 0) ? 1.0f / fmaxf(s, 1e-30f) : 0.f;
      P[lane] = e0 * inv; P[lane + 64] = e1 * inv;
      wave_lds_sync();
      float o = 0.f;
      for (int c = 0; c < nvalid; ++c) o += P[c] * bf2f(vcb[c * 64 + lane]);
      ocmp[tok * 512 + head * 64 + lane] = f2bf(o);
      if (lane < 32) { for (int c = 4 * lane - 1; c <= 4 * lane + 3; ++c) if (c >= 0 && c < NC) impacc += P[c]; }
      wave_lds_sync();
    }
    const int cur = t >> 6, n = lane;
    float score = (n > cur) ? -1.0f : ((n == 0 || n == cur || n == cur - 1) ? 1e4f : impacc);
    if (n >= 32) score = -2.0f;
    int rank = 0;
    for (int mth = 0; mth < 32; ++mth) { const float sm = __shfl(score, mth); rank += (sm > score || (sm == score && mth < n)) ? 1 : 0; }
    const unsigned long long bal = __ballot(n < 32 && rank < 16);
    if (lane == 0) sel[item] = (unsigned)bal;
  }
}

DEV void ph_nsa_attn(const bf16_t* __restrict__ proj, const float* __restrict__ t5, const bf16_t* __restrict__ ocmp,
                     const unsigned* __restrict__ sel, bf16_t* __restrict__ onsa, char* lds) {
  WAVE_IDS
  float* P = (float*)(lds + wv * 1024); float* Q = P + 128;
  for (int item = gw; item < BATCH * 2 * SEQ * 4; item += nw) {
    const int r = item & 3, t = (item >> 2) & (SEQ - 1), bg = item >> 13, g = bg & 1, b = bg >> 1;
    const int head = g * 4 + r, cur = t >> 6;
    const size_t tok = (size_t)b * SEQ + t;
    Q[lane] = bf2f(proj[tok * PROJ_LD + PC_Q + head * 64 + lane]);
    wave_lds_sync();
    const unsigned smask = sel[bg * SEQ + t];
    float res0 = 0.f, res1 = 0.f;
    for (int br = 0; br < 2; ++br) {
      float m = -1e30f, l = 0.f, o = 0.f;
      const int nb0 = (br == 0) ? 0 : max(0, cur - 8);
      for (int nb = nb0; nb <= cur; ++nb) {
        if (br == 0 && !((smask >> nb) & 1u)) continue;
        const int s = nb * 64 + lane, dist = t - s;
        const bool valid = (dist >= 0) && (br == 0 || dist < 512);
        const bf16_t* kp = proj + ((size_t)b * SEQ + s) * PROJ_LD + PC_KV + (2 + 2 * br) * 128 + g * 64;
        float d = 0.f;
        for (int e = 0; e < 64; e += 8) {
          const uint4 kv = *(const uint4*)(kp + e);
          d += Q[e + 0] * __uint_as_float(kv.x << 16) + Q[e + 1] * __uint_as_float(kv.x & 0xffff0000u);
          d += Q[e + 2] * __uint_as_float(kv.y << 16) + Q[e + 3] * __uint_as_float(kv.y & 0xffff0000u);
          d += Q[e + 4] * __uint_as_float(kv.z << 16) + Q[e + 5] * __uint_as_float(kv.z & 0xffff0000u);
          d += Q[e + 6] * __uint_as_float(kv.w << 16) + Q[e + 7] * __uint_as_float(kv.w & 0xffff0000u);
        }
        const float lg = valid ? d + 1.4426950408889634f * t5bias(t5, head, dist) : -1e30f;
        const float mn = fmaxf(m, wmaxf(lg));
        const float sc = exp2f(m - mn);
        const float pe = valid ? exp2f(lg - mn) : 0.f;
        l = l * sc + wsum(pe); m = mn;
        P[lane] = pe;
        wave_lds_sync();
        const bf16_t* vp = proj + ((size_t)b * SEQ + nb * 64) * PROJ_LD + PC_KV + (3 + 2 * br) * 128 + g * 64 + lane;
        float acc = 0.f;
        for (int k = 0; k < 64; ++k) acc += P[k] * bf2f(vp[(size_t)k * PROJ_LD]);
        o = o * sc + acc;
        wave_lds_sync();
      }
      if (br == 0) res0 = o / fmaxf(l, 1e-30f); else res1 = o / fmaxf(l, 1e-30f);
    }
    const bf16_t* gp = proj + tok * PROJ_LD + PC_GATE + head * 3;
    const float g0 = sigmoidf_(bf2f(gp[0])), g1 = sigmoidf_(bf2f(gp[1])), g2 = sigmoidf_(bf2f(gp[2]));
    const float oc = bf2f(ocmp[tok * 512 + head * 64 + lane]);
    onsa[tok * 512 + head * 64 + lane] = f2bf(g0 * oc + g1 * res0 + g2 * res1);
    wave_lds_sync();
  }
}

DEV void ph_mla_attn(const bf16_t* __restrict__ mq, const bf16_t* __restrict__ mkv, const bf16_t* __restrict__ kr, bf16_t* __restrict__ omla, char* lds) {
  WAVE_IDS
  float* P = (float*)(lds + wv * 1024); float* Q = P + 128;
  for (int item = gw; item < BATCH * 8 * SEQ; item += nw) {
    const int h = item & 7, t = (item >> 3) & (SEQ - 1), b = item >> 14;
    const size_t tok = (size_t)b * SEQ + t;
    Q[lane] = bf2f(mq[tok * 768 + h * 96 + lane]);
    if (lane < 32) Q[64 + lane] = bf2f(mq[tok * 768 + h * 96 + 64 + lane]);
    wave_lds_sync();
    float m = -1e30f, l = 0.f, o = 0.f;
    for (int nb = 0; nb <= (t >> 6); ++nb) {
      const int s = nb * 64 + lane;
      const bool valid = s <= t;
      const bf16_t* kp = mkv + ((size_t)b * SEQ + s) * 1024 + h * 128;
      const bf16_t* rp = kr + ((size_t)b * SEQ + s) * 32;
      float d = 0.f;
      for (int e = 0; e < 64; e += 8) {
        const uint4 kv = *(const uint4*)(kp + e);
        d += Q[e + 0] * __uint_as_float(kv.x << 16) + Q[e + 1] * __uint_as_float(kv.x & 0xffff0000u);
        d += Q[e + 2] * __uint_as_float(kv.y << 16) + Q[e + 3] * __uint_as_float(kv.y & 0xffff0000u);
        d += Q[e + 4] * __uint_as_float(kv.z << 16) + Q[e + 5] * __uint_as_float(kv.z & 0xffff0000u);
        d += Q[e + 6] * __uint_as_float(kv.w << 16) + Q[e + 7] * __uint_as_float(kv.w & 0xffff0000u);
      }
      for (int e = 0; e < 32; e += 8) {
        const uint4 kv = *(const uint4*)(rp + e);
        d += Q[64 + e + 0] * __uint_as_float(kv.x << 16) + Q[64 + e + 1] * __uint_as_float(kv.x & 0xffff0000u);
        d += Q[64 + e + 2] * __uint_as_float(kv.y << 16) + Q[64 + e + 3] * __uint_as_float(kv.y & 0xffff0000u);
        d += Q[64 + e + 4] * __uint_as_float(kv.z << 16) + Q[64 + e + 5] * __uint_as_float(kv.z & 0xffff0000u);
        d += Q[64 + e + 6] * __uint_as_float(kv.w << 16) + Q[64 + e + 7] * __uint_as_float(kv.w & 0xffff0000u);
      }
      const float lg = valid ? d : -1e30f;
      const float mn = fmaxf(m, wmaxf(lg));
      const float sc = exp2f(m - mn);
      const float pe = valid ? exp2f(lg - mn) : 0.f;
      l = l * sc + wsum(pe); m = mn;
      P[lane] = pe;
      wave_lds_sync();
      const bf16_t* vp = mkv + ((size_t)b * SEQ + nb * 64) * 1024 + h * 128 + 64 + lane;
      float acc = 0.f;
      for (int k = 0; k < 64; ++k) acc += P[k] * bf2f(vp[(size_t)k * 1024]);
      o = o * sc + acc;
      wave_lds_sync();
    }
    omla[tok * 512 + h * 64 + lane] = f2bf(o / fmaxf(l, 1e-30f));
    wave_lds_sync();
  }
}

DEV void wave_argmax(float& v, int& idx) {
#pragma unroll
  for (int o = 32; o > 0; o >>= 1) {
    const float ov = __shfl_xor(v, o); const int oi = __shfl_xor(idx, o);
    if (ov > v || (ov == v && oi < idx)) { v = ov; idx = oi; }
  }
}
DEV void ph_route(const bf16_t* __restrict__ pq, const bf16_t* __restrict__ subk, int* __restrict__ pidx, float* __restrict__ pw, char* lds) {
  WAVE_IDS
  float* Q = (float*)(lds + wv * 1024);
  float* TS = Q + 128;
  int* TI = (int*)(TS + 32);
  for (int item = gw; item < T * 8; item += nw) {
    const int h = item & 7, t = item >> 3;
    Q[lane] = bf2f(pq[(size_t)t * 1024 + h * 128 + lane]);
    Q[lane + 64] = bf2f(pq[(size_t)t * 1024 + h * 128 + 64 + lane]);
    wave_lds_sync();
    for (int p = 0; p < 2; ++p) {
      const bf16_t* kb = subk + (size_t)((h * 2 + p) * 128) * 64;
      float s0 = 0.f, s1 = 0.f;
      for (int e = 0; e < 64; ++e) { const float qv = Q[p * 64 + e]; s0 += qv * bf2f(kb[lane * 64 + e]); s1 += qv * bf2f(kb[(lane + 64) * 64 + e]); }
      for (int k = 0; k < 16; ++k) {
        float v = (s0 >= s1) ? s0 : s1; int idx = (s0 >= s1) ? lane : lane + 64;
        wave_argmax(v, idx);
        if (lane == 0) { TS[p * 16 + k] = v; TI[p * 16 + k] = idx; }
        if (idx == lane) s0 = -3e38f;
        if (idx == lane + 64) s1 = -3e38f;
      }
    }
    wave_lds_sync();
    float cv[4];
#pragma unroll
    for (int u = 0; u < 4; ++u) { const int f = lane + 64 * u; cv[u] = TS[f >> 4] + TS[16 + (f & 15)]; }
    int myexp = 0; float mybest = 0.f, best0 = 0.f, den = 0.f;
#pragma unroll
    for (int k = 0; k < 16; ++k) {
      float v = cv[0]; int idx = lane;
#pragma unroll
      for (int u = 1; u < 4; ++u) if (cv[u] > v) { v = cv[u]; idx = lane + 64 * u; }
      wave_argmax(v, idx);
#pragma unroll
      for (int u = 0; u < 4; ++u) if (idx == lane + 64 * u) cv[u] = -3e38f;
      if (k == 0) best0 = v;
      den += expf(v - best0);
      if (lane == k) { myexp = TI[idx >> 4] * 128 + TI[16 + (idx & 15)]; mybest = v; }
    }
    if (lane < 16) { pidx[(size_t)t * 128 + h * 16 + lane] = myexp; pw[(size_t)t * 128 + h * 16 + lane] = expf(mybest - best0) / den; }
    wave_lds_sync();
  }
}

DEV void ph_experts(const bf16_t* __restrict__ hn, const int* __restrict__ pidx, const float* __restrict__ pw,
                    const float* __restrict__ pu, const float* __restrict__ pv, const float* __restrict__ gfin, float* __restrict__ out) {
  WAVE_IDS
  for (int t = gw; t < T; t += nw) {
    float4 x[4], y[4];
#pragma unroll
    for (int j = 0; j < 4; ++j) {
      const uint2 r = ((const uint2*)(hn + (size_t)t * 1024))[j * 64 + lane];
      x[j] = make_float4(__uint_as_float(r.x << 16), __uint_as_float(r.x & 0xffff0000u), __uint_as_float(r.y << 16), __uint_as_float(r.y & 0xffff0000u));
      y[j] = make_float4(0.f, 0.f, 0.f, 0.f);
    }
    const int e0 = pidx[(size_t)t * 128 + lane], e1 = pidx[(size_t)t * 128 + 64 + lane];
    const float w0 = pw[(size_t)t * 128 + lane], w1 = pw[(size_t)t * 128 + 64 + lane];
    for (int s = 0; s < 128; ++s) {
      const int e = __shfl((s < 64) ? e0 : e1, s & 63);
      const float w = __shfl((s < 64) ? w0 : w1, s & 63);
      const float4* ur = (const float4*)(pu + (size_t)e * 1024);
      float d = 0.f;
#pragma unroll
      for (int j = 0; j < 4; ++j) { const float4 u = ur[j * 64 + lane]; d += u.x * x[j].x + u.y * x[j].y + u.z * x[j].z + u.w * x[j].w; }
      d = wsum(d);
      const float c = w * gelu_exact(d);
      const float4* vr = (const float4*)(pv + (size_t)e * 1024);
#pragma unroll
      for (int j = 0; j < 4; ++j) { const float4 v = vr[j * 64 + lane]; y[j].x += c * v.x; y[j].y += c * v.y; y[j].z += c * v.z; y[j].w += c * v.w; }
    }
    float4* o4 = (float4*)(out + (size_t)t * 1024);
    float ss = 0.f;
#pragma unroll
    for (int j = 0; j < 4; ++j) {
      const float4 hv = o4[j * 64 + lane];
      y[j].x += hv.x; y[j].y += hv.y; y[j].z += hv.z; y[j].w += hv.w;
      ss += y[j].x * y[j].x + y[j].y * y[j].y + y[j].z * y[j].z + y[j].w * y[j].w;
    }
    ss = wsum(ss);
    const float inv = rsqrtf(ss * (1.0f / 1024.0f) + 1e-6f);
#pragma unroll
    for (int j = 0; j < 4; ++j) {
      const float4 gg = ((const float4*)gfin)[j * 64 + lane];
      o4[j * 64 + lane] = make_float4(y[j].x * inv * gg.x, y[j].y * inv * gg.y, y[j].z * inv * gg.z, y[j].w * inv * gg.w);
    }
  }
}


namespace att {
#define LAS3 __attribute__((address_space(3)))
typedef LAS3 char* lptr;
typedef LAS3 const char* lcptr;
using bf16x8 = __attribute__((ext_vector_type(8))) short;
using s16x4 = __attribute__((ext_vector_type(4))) short;
using f32x16 = __attribute__((ext_vector_type(16))) float;
typedef short v4i16_t __attribute__((ext_vector_type(4)));
typedef unsigned u32x4 __attribute__((ext_vector_type(4)));
typedef float f32x4_t __attribute__((ext_vector_type(4)));
typedef float f32x2_t __attribute__((ext_vector_type(2)));
typedef __bf16 bf16x2_t __attribute__((ext_vector_type(2)));
constexpr float LOG2E = 1.4426950408889634f;
constexpr float THR = 6.0f;
constexpr float NEG_INF = -__builtin_huge_valf();
constexpr int SLOT = 20480, KOFF = 0, VOFF = 12288;
constexpr int L_WSF = 2 * SLOT;
constexpr int L_TB = L_WSF + 2048;
constexpr int L_SELM = L_TB + 4096;
constexpr int L_SC = L_SELM + 256;
constexpr int L_IMPQ = L_SC + 64 * 33 * 4;
constexpr int L_IMPL = L_IMPQ + 4 * 64 * 33 * 4;
constexpr int L_FIN = L_IMPQ;
constexpr int L_END = L_IMPL + 4 * 64 * 33 * 4;
static_assert(L_END <= 131072, "attention LDS map");

__device__ __forceinline__ int crow(int r, int hi) { return (r & 3) + 8 * (r >> 2) + 4 * hi; }
__device__ __forceinline__ s16x4 vtr(lcptr p) { return __builtin_bit_cast(s16x4, __builtin_amdgcn_ds_read_tr16_b64_v4i16((LAS3 v4i16_t*)p)); }
__device__ __forceinline__ unsigned cvtpk(float lo, float hi) { f32x2_t v = {lo, hi}; bf16x2_t b = __builtin_convertvector(v, bf16x2_t); return __builtin_bit_cast(unsigned, b); }
__device__ __forceinline__ float xmax(float v) { auto rr = __builtin_amdgcn_permlane32_swap(__float_as_uint(v), __float_as_uint(v), false, false); return fmaxf(__uint_as_float(rr[0]), __uint_as_float(rr[1])); }
__device__ __forceinline__ float xsum(float v) { auto rr = __builtin_amdgcn_permlane32_swap(__float_as_uint(v), __float_as_uint(v), false, false); return __uint_as_float(rr[0]) + __uint_as_float(rr[1]); }
__device__ __forceinline__ float ex2(float x) { return __builtin_amdgcn_exp2f(x); }

template <int ND0> __device__ __forceinline__ void qkt(f32x16& p0, f32x16& p1, lcptr kb, const bf16x8* qr) {
  p0 = f32x16{}; p1 = f32x16{};
#pragma unroll
  for (int d0 = 0; d0 < ND0; ++d0) {
    const bf16x8 b0 = *(const LAS3 bf16x8*)(kb + d0 * 2048);
    const bf16x8 b1 = *(const LAS3 bf16x8*)(kb + d0 * 2048 + 512);
    p0 = __builtin_amdgcn_mfma_f32_32x32x16_bf16(b0, qr[d0], p0, 0, 0, 0);
    p1 = __builtin_amdgcn_mfma_f32_32x32x16_bf16(b1, qr[d0], p1, 0, 0, 0);
  }
}
__device__ __forceinline__ void pv(f32x16 (&o)[2], lcptr vp, const unsigned (&pw)[16]) {
#pragma unroll
  for (int d0 = 0; d0 < 2; ++d0)
#pragma unroll
    for (int ks = 0; ks < 4; ++ks) {
      const s16x4 lo = vtr(vp + d0 * 4096 + ks * 1024), hi4 = vtr(vp + d0 * 4096 + ks * 1024 + 512);
      const bf16x8 vf = {lo[0], lo[1], lo[2], lo[3], hi4[0], hi4[1], hi4[2], hi4[3]};
      const unsigned pa4[4] = {pw[4 * ks], pw[4 * ks + 1], pw[4 * ks + 2], pw[4 * ks + 3]};
      o[d0] = __builtin_amdgcn_mfma_f32_32x32x16_bf16(__builtin_bit_cast(bf16x8, pa4), vf, o[d0], 0, 0, 0);
    }
}
__device__ __forceinline__ void softmax_step(f32x16& p0, f32x16& p1, float& m, float& l, f32x16 (&o)[2], LAS3 float* wsf, int r32, int hi, unsigned (&pw)[16]) {
  float rm = fmaxf(p0[0], p1[0]);
#pragma unroll
  for (int r = 1; r < 16; ++r) rm = fmaxf(rm, fmaxf(p0[r], p1[r]));
  rm = xmax(rm);
  if (__any(rm > m + THR)) {
    const float mn = fmaxf(m, rm);
    const float al = ex2(m - mn);
    m = mn; l *= al;
    if (hi == 0) wsf[r32] = al;
#pragma unroll
    for (int r = 0; r < 16; ++r) { const float f = wsf[crow(r, hi)]; o[0][r] *= f; o[1][r] *= f; }
  }
  float s = 0.f;
#pragma unroll
  for (int r = 0; r < 16; ++r) { p0[r] = ex2(p0[r] - m); p1[r] = ex2(p1[r] - m); s += p0[r] + p1[r]; }
  l += s;
#pragma unroll
  for (int i = 0; i < 8; ++i) { pw[i] = cvtpk(p0[2 * i], p0[2 * i + 1]); pw[8 + i] = cvtpk(p1[2 * i], p1[2 * i + 1]); }
}
struct KVSrc { const bf16_t* k; const bf16_t* v; int ldk, ldv; };
__device__ __forceinline__ void kv_issue(const KVSrc& s, int row0, u32x4& rk, u32x4& rv, int tid) {
  const int kv = tid & 63, ch = tid >> 6, ln = tid & 63;
  rk = *(const u32x4*)(s.k + (size_t)(row0 + kv) * s.ldk + ch * 8);
  rv = *(const u32x4*)(s.v + (size_t)(row0 + 16 * (ch & 3) + (ln >> 2)) * s.ldv + (ch >> 2) * 32 + (ln & 3) * 8);
}
__device__ __forceinline__ void kv_commit(lptr slot, const u32x4& rk, const u32x4& rv, int tid) {
  *(LAS3 u32x4*)(slot + KOFF + (tid >> 6) * 1024 + (tid & 63) * 16) = rk;
  *(LAS3 u32x4*)(slot + VOFF + tid * 16) = rv;
}
__device__ __forceinline__ void fin_set(LAS3 float* finl, const f32x16 (&o)[2], int lane) {
#pragma unroll
  for (int d0 = 0; d0 < 2; ++d0)
#pragma unroll
    for (int r = 0; r < 16; ++r) finl[(d0 * 16 + r) * 64 + lane] = o[d0][r];
}
__device__ __forceinline__ void fin_add(LAS3 float* finl, const f32x16 (&o)[2], const LAS3 float* wsf, int lane, int hi) {
#pragma unroll
  for (int r = 0; r < 16; ++r) { const float f = wsf[crow(r, hi)];
#pragma unroll
    for (int d0 = 0; d0 < 2; ++d0) finl[(d0 * 16 + r) * 64 + lane] += o[d0][r] * f; }
}
__device__ __forceinline__ void fin_store(const LAS3 float* finl, bf16_t* gout, size_t rowbase, int ld, int colbase, int lane) {
#pragma unroll
  for (int i = 0; i < 4; ++i) {
    const int q = i * 8 + (lane >> 3), ch = lane & 7;
    const int qh = (q >> 2) & 1, r = (q & 3) + 4 * (q >> 3), d0 = ch >> 2, dl = (ch & 3) * 8;
    const LAS3 float* p = finl + (d0 * 16 + r) * 64 + qh * 32 + dl;
    const f32x4_t x0 = *(const LAS3 f32x4_t*)p, x1 = *(const LAS3 f32x4_t*)(p + 4);
    u32x4 v; v.x = cvtpk(x0[0], x0[1]); v.y = cvtpk(x0[2], x0[3]); v.z = cvtpk(x1[0], x1[1]); v.w = cvtpk(x1[2], x1[3]);
    *(u32x4*)(gout + (rowbase + q) * (size_t)ld + colbase + ch * 8) = v;
  }
}

__device__ __forceinline__ void nsa_unit(int b, int g, int c, const bf16_t* __restrict__ proj, const bf16_t* __restrict__ kc, const bf16_t* __restrict__ vc, bf16_t* __restrict__ onsa, lptr lds) {
  int tid = threadIdx.x; asm volatile("" : "+v"(tid));
  const int lane = tid & 63, r32 = lane & 31, hi = lane >> 5;
  const int w = __builtin_amdgcn_readfirstlane(tid >> 6);
  const int rh = w >> 1, head = g * 4 + rh, tokl = 32 * (w & 1) + r32, t = 64 * c + tokl, bg = b * 2 + g;
  const size_t tok = (size_t)b * SEQ + t;
  LAS3 float* wsf = (LAS3 float*)(lds + L_WSF) + w * 64;
  const LAS3 float* tb = (const LAS3 float*)(lds + L_TB) + head * 128;
  LAS3 unsigned* selm = (LAS3 unsigned*)(lds + L_SELM);
  LAS3 float* sc = (LAS3 float*)(lds + L_SC);
  LAS3 float* impq = (LAS3 float*)(lds + L_IMPQ);
  LAS3 float* impl = (LAS3 float*)(lds + L_IMPL);
  const lcptr kb0 = (lcptr)lds + KOFF + hi * 1024 + r32 * 16;
  const lcptr vp0 = (lcptr)lds + VOFF + ((lane >> 4) & 1) * 32 + (lane & 3) * 8 + (4 * hi + ((lane & 15) >> 2)) * 64;
  bf16x8 qr[4];
#pragma unroll
  for (int d0 = 0; d0 < 4; ++d0) qr[d0] = *(const bf16x8*)(proj + tok * PROJ_LD + PC_Q + head * 64 + d0 * 16 + hi * 8);
  float gate[3];
#pragma unroll
  for (int j = 0; j < 3; ++j) gate[j] = 1.0f / (1.0f + ex2(-LOG2E * bf2f(proj[tok * PROJ_LD + PC_GATE + head * 3 + j])));
  LAS3 float* finl = (LAS3 float*)(lds + L_FIN) + w * 2048;
  f32x16 o[2]; unsigned pw[16];
  u32x4 rk, rv;
  {
    const KVSrc src{kc + (size_t)bg * 128 * 64, vc + (size_t)bg * 128 * 64, 64, 64};
    __syncthreads();
    kv_issue(src, 0, rk, rv, tid); kv_commit(lds, rk, rv, tid);
    kv_issue(src, 64, rk, rv, tid); kv_commit(lds + SLOT, rk, rv, tid);
    __syncthreads();
    f32x16 a0, a1, b0, b1;
    qkt<4>(a0, a1, kb0, qr); qkt<4>(b0, b1, kb0 + SLOT, qr);
    float rm = NEG_INF;
#pragma unroll
    for (int r = 0; r < 16; ++r) {
      const int cb = crow(r, hi);
      { const int d = t - 16 * cb - 31;          a0[r] = (d < 0) ? NEG_INF : a0[r] + ((d < 113) ? tb[d] : 0.f); }
      { const int d = t - 16 * (cb + 32) - 31;   a1[r] = (d < 0) ? NEG_INF : a1[r] + ((d < 113) ? tb[d] : 0.f); }
      { const int d = t - 16 * (cb + 64) - 31;   b0[r] = (d < 0) ? NEG_INF : b0[r] + ((d < 113) ? tb[d] : 0.f); }
      { const int d = t - 16 * (cb + 96) - 31;   b1[r] = (d < 0) ? NEG_INF : b1[r] + ((d < 113) ? tb[d] : 0.f); }
      rm = fmaxf(fmaxf(rm, fmaxf(a0[r], a1[r])), fmaxf(b0[r], b1[r]));
    }
    rm = xmax(rm);
    const float mref = (rm == NEG_INF) ? 0.f : rm;
    float s = 0.f;
#pragma unroll
    for (int r = 0; r < 16; ++r) { a0[r] = ex2(a0[r] - mref); a1[r] = ex2(a1[r] - mref); b0[r] = ex2(b0[r] - mref); b1[r] = ex2(b1[r] - mref); s += (a0[r] + a1[r]) + (b0[r] + b1[r]); }
    s = xsum(s);
    const float inv = (s > 0.f) ? 1.0f / s : 0.f;
#pragma unroll
    for (int r = 0; r < 16; ++r) { a0[r] *= inv; a1[r] *= inv; b0[r] *= inv; b1[r] *= inv; }
    { LAS3 float* iq = impq + (rh * 64 + tokl) * 33; LAS3 float* il = impl + (rh * 64 + tokl) * 33;
#pragma unroll
      for (int q4 = 0; q4 < 4; ++q4) {
        const int gi = 2 * q4 + hi;
        iq[gi] = (a0[4 * q4] + a0[4 * q4 + 1]) + (a0[4 * q4 + 2] + a0[4 * q4 + 3]);           il[gi] = a0[4 * q4 + 3];
        iq[8 + gi] = (a1[4 * q4] + a1[4 * q4 + 1]) + (a1[4 * q4 + 2] + a1[4 * q4 + 3]);       il[8 + gi] = a1[4 * q4 + 3];
        iq[16 + gi] = (b0[4 * q4] + b0[4 * q4 + 1]) + (b0[4 * q4 + 2] + b0[4 * q4 + 3]);      il[16 + gi] = b0[4 * q4 + 3];
        iq[24 + gi] = (b1[4 * q4] + b1[4 * q4 + 1]) + (b1[4 * q4 + 2] + b1[4 * q4 + 3]);      il[24 + gi] = b1[4 * q4 + 3];
      } }
    o[0] = f32x16{}; o[1] = f32x16{};
#pragma unroll
    for (int i = 0; i < 8; ++i) { pw[i] = cvtpk(a0[2 * i], a0[2 * i + 1]); pw[8 + i] = cvtpk(a1[2 * i], a1[2 * i + 1]); }
    pv(o, vp0, pw);
#pragma unroll
    for (int i = 0; i < 8; ++i) { pw[i] = cvtpk(b0[2 * i], b0[2 * i + 1]); pw[8 + i] = cvtpk(b1[2 * i], b1[2 * i + 1]); }
    pv(o, vp0 + SLOT, pw);
    if (hi == 0) wsf[r32] = gate[0];
#pragma unroll
    for (int r = 0; r < 16; ++r) { const float f = wsf[crow(r, hi)]; o[0][r] *= f; o[1][r] *= f; }
  }
  __syncthreads();
  const KVSrc ssrc{proj + (size_t)b * SEQ * PROJ_LD + PC_KV + 2 * 128 + g * 64, proj + (size_t)b * SEQ * PROJ_LD + PC_KV + 3 * 128 + g * 64, PROJ_LD, PROJ_LD};
  kv_issue(ssrc, 0, rk, rv, tid);
  {
    const int stok = tid >> 3, sub = tid & 7;
#pragma unroll
    for (int k = 0; k < 4; ++k) {
      const int n = sub * 4 + k;
      float imp = 0.f;
#pragma unroll
      for (int hh = 0; hh < 4; ++hh) imp += impq[(hh * 64 + stok) * 33 + n] + ((n > 0) ? impl[(hh * 64 + stok) * 33 + n - 1] : 0.f);
      sc[stok * 33 + n] = (n > c) ? -1.0f : ((n == 0 || n == c || n == c - 1) ? 1e4f : imp);
    }
    if (tid < 64) selm[tid] = 0u;
    __syncthreads();
#pragma unroll
    for (int k = 0; k < 4; ++k) {
      const int n = sub * 4 + k; const float sv = sc[stok * 33 + n]; int rank = 0;
      for (int mm = 0; mm < 32; ++mm) { const float sm = sc[stok * 33 + mm]; rank += (sm > sv || (sm == sv && mm < n)) ? 1 : 0; }
      if (rank < 16) atomicOr((unsigned*)(selm + stok), 1u << n);
    }
    __syncthreads();
  }
  const unsigned mysel = selm[tokl];
  fin_set(finl, o, lane);
#pragma unroll 1
  for (int br = 0; br < 2; ++br) {
    const KVSrc src = (br == 0) ? ssrc : KVSrc{proj + (size_t)b * SEQ * PROJ_LD + PC_KV + 4 * 128 + g * 64, proj + (size_t)b * SEQ * PROJ_LD + PC_KV + 5 * 128 + g * 64, PROJ_LD, PROJ_LD};
    const int n0 = (br == 0) ? 0 : ((c > 8) ? c - 8 : 0);
    if (br == 1) { __syncthreads(); kv_issue(src, n0 * 64, rk, rv, tid); }
    kv_commit(lds, rk, rv, tid);
    float m = -1e30f, l = 0.f;
    o[0] = f32x16{}; o[1] = f32x16{};
    int cur = 0;
#pragma unroll 1
    for (int n = n0; n <= c; ++n) {
      __syncthreads();
      if (n < c) kv_issue(src, (n + 1) * 64, rk, rv, tid);
      const bool mine = (br == 1) || ((mysel >> n) & 1u);
      if (__any(mine)) {
        f32x16 p0, p1;
        qkt<4>(p0, p1, kb0 + cur * SLOT, qr);
        if (n + 2 >= c) {
          const int dbase = t - 64 * n;
#pragma unroll
          for (int r = 0; r < 16; ++r) { const int d0_ = dbase - crow(r, hi), d1_ = d0_ - 32;
            p0[r] = (d0_ < 0) ? NEG_INF : p0[r] + ((d0_ < 113) ? tb[d0_] : 0.f);
            p1[r] = (d1_ < 0) ? NEG_INF : p1[r] + ((d1_ < 113) ? tb[d1_] : 0.f); }
        } else if (br == 1 && n + 8 == c) {
          const int dbase = t - 64 * n;
#pragma unroll
          for (int r = 0; r < 16; ++r) { const int d0_ = dbase - crow(r, hi), d1_ = d0_ - 32;
            if (d0_ >= 512) p0[r] = NEG_INF; if (d1_ >= 512) p1[r] = NEG_INF; }
        }
        if (!mine) {
#pragma unroll
          for (int r = 0; r < 16; ++r) { p0[r] = NEG_INF; p1[r] = NEG_INF; } }
        softmax_step(p0, p1, m, l, o, wsf, r32, hi, pw);
        pv(o, vp0 + cur * SLOT, pw);
      }
      if (n < c) kv_commit(lds + (cur ^ 1) * SLOT, rk, rv, tid);
      cur ^= 1;
    }
    l = xsum(l);
    const float gi = gate[1 + br] / fmaxf(l, 1e-30f);
    if (hi == 0) wsf[r32] = gi;
    fin_add(finl, o, wsf, lane, hi);
  }
  fin_store(finl, onsa, (size_t)b * SEQ + 64 * c + 32 * (w & 1), 512, head * 64, lane);
}

__device__ __forceinline__ void mla_unit(int b, int h, int qb, const bf16_t* __restrict__ mq, const bf16_t* __restrict__ mkv, const bf16_t* __restrict__ kr, bf16_t* __restrict__ omla, lptr lds) {
  int tid = threadIdx.x; asm volatile("" : "+v"(tid));
  const int lane = tid & 63, r32 = lane & 31, hi = lane >> 5;
  const int w = __builtin_amdgcn_readfirstlane(tid >> 6);
  const int q0 = 256 * qb, qw = q0 + 32 * w, qpos = qw + r32;
  const size_t tokq = (size_t)b * SEQ + qpos;
  LAS3 float* wsf = (LAS3 float*)(lds + L_WSF) + w * 64;
  const lcptr kb0 = (lcptr)lds + KOFF + hi * 1024 + r32 * 16;
  const lcptr vp0 = (lcptr)lds + VOFF + ((lane >> 4) & 1) * 32 + (lane & 3) * 8 + (4 * hi + ((lane & 15) >> 2)) * 64;
  bf16x8 qr[6];
#pragma unroll
  for (int d0 = 0; d0 < 6; ++d0) qr[d0] = *(const bf16x8*)(mq + tokq * 768 + h * 96 + d0 * 16 + hi * 8);
  const KVSrc src{mkv + (size_t)b * SEQ * 1024 + h * 128, mkv + (size_t)b * SEQ * 1024 + h * 128 + 64, 1024, 1024};
  const bf16_t* krb = kr + (size_t)b * SEQ * 32;
  const int NTL = 4 * (qb + 1);
  u32x4 rk, rv, rr = {0u, 0u, 0u, 0u};
  f32x16 o[2]; o[0] = f32x16{}; o[1] = f32x16{};
  unsigned pw[16];
  float m = -1e30f, l = 0.f;
  __syncthreads();
  kv_issue(src, 0, rk, rv, tid);
  if (tid < 256) rr = *(const u32x4*)(krb + (size_t)(tid & 63) * 32 + (tid >> 6) * 8);
  kv_commit(lds, rk, rv, tid);
  if (tid < 256) *(LAS3 u32x4*)(lds + KOFF + (8 + (tid >> 6)) * 1024 + (tid & 63) * 16) = rr;
  int cur = 0;
#pragma unroll 1
  for (int tl = 0; tl < NTL; ++tl) {
    __syncthreads();
    if (tl + 1 < NTL) { kv_issue(src, (tl + 1) * 64, rk, rv, tid); if (tid < 256) rr = *(const u32x4*)(krb + (size_t)((tl + 1) * 64 + (tid & 63)) * 32 + (tid >> 6) * 8); }
    if (64 * tl <= qw + 31) {
      f32x16 p0, p1;
      qkt<6>(p0, p1, kb0 + cur * SLOT, qr);
      if (64 * tl + 63 > qw) {
        const int dbase = qpos - 64 * tl;
#pragma unroll
        for (int r = 0; r < 16; ++r) { const int d0_ = dbase - crow(r, hi), d1_ = d0_ - 32; if (d0_ < 0) p0[r] = NEG_INF; if (d1_ < 0) p1[r] = NEG_INF; }
      }
      softmax_step(p0, p1, m, l, o, wsf, r32, hi, pw);
      pv(o, vp0 + cur * SLOT, pw);
    }
    if (tl + 1 < NTL) { kv_commit(lds + (cur ^ 1) * SLOT, rk, rv, tid); if (tid < 256) *(LAS3 u32x4*)(lds + (cur ^ 1) * SLOT + KOFF + (8 + (tid >> 6)) * 1024 + (tid & 63) * 16) = rr; }
    cur ^= 1;
  }
  l = xsum(l);
  if (hi == 0) wsf[r32] = 1.0f / fmaxf(l, 1e-30f);
#pragma unroll
  for (int r = 0; r < 16; ++r) { const float f = wsf[crow(r, hi)]; o[0][r] *= f; o[1][r] *= f; }
  LAS3 float* finl = (LAS3 float*)(lds + L_FIN) + w * 2048;
  fin_set(finl, o, lane);
  fin_store(finl, omla, (size_t)b * SEQ + qw, 512, h * 64, lane);
}

__device__ __forceinline__ void attn_phase(const bf16_t* proj, const bf16_t* kc, const bf16_t* vc, const float* t5, bf16_t* onsa,
                                           const bf16_t* mq, const bf16_t* mkv, const bf16_t* kr, bf16_t* omla, lptr lds) {
  const int tid = threadIdx.x;
  { LAS3 float* tb = (LAS3 float*)(lds + L_TB);
    for (int i = tid; i < 8 * 128; i += NTHR) { const int hd = i >> 7, d = i & 127; tb[i] = (t5[(int)T5B[d] * 8 + hd] - t5[31 * 8 + hd]) * LOG2E; } }
  const int G = gridDim.x, bx = blockIdx.x;
  for (int v = (G % 8 == 0) ? (bx % 8) * (G / 8) + bx / 8 : bx; v < 256; v += G) {
    const int bg = v >> 4, p = v & 15, bh = v >> 2, j = v & 3;
#pragma unroll 1
    for (int u = 0; u < 2; ++u) nsa_unit(bg >> 1, bg & 1, u ? p : 31 - p, proj, kc, vc, onsa, lds);
#pragma unroll 1
    for (int u = 0; u < 2; ++u) mla_unit(bh >> 3, bh & 7, u ? j : 7 - j, mq, mkv, kr, omla, lds);
  }
}
#undef LAS3
}


namespace peer {
using bf16x8 = __attribute__((ext_vector_type(8))) short;
using f32x16 = __attribute__((ext_vector_type(16))) float;
typedef unsigned u32x4 __attribute__((ext_vector_type(4)));
typedef float f32x4_t __attribute__((ext_vector_type(4)));
typedef __bf16 bf16x2_t __attribute__((ext_vector_type(2)));
typedef float f32x2_t __attribute__((ext_vector_type(2)));
#define LAS3 __attribute__((address_space(3)))
__device__ __forceinline__ int crow(int r, int hi) { return (r & 3) + 8 * (r >> 2) + 4 * hi; }
__device__ __forceinline__ unsigned enc(float f) { const unsigned u = __float_as_uint(f); return u ^ ((unsigned)((int)u >> 31) | 0x80000000u); }
__device__ __forceinline__ float dec(unsigned k) { return __uint_as_float(k ^ (~(unsigned)((int)k >> 31) | 0x80000000u)); }
__device__ __forceinline__ unsigned umax(unsigned a, unsigned b) { return a > b ? a : b; }
__device__ __forceinline__ unsigned umin(unsigned a, unsigned b) { return a < b ? a : b; }
__device__ __forceinline__ unsigned cvtpk(float lo, float hi) { f32x2_t v = {lo, hi}; bf16x2_t b = __builtin_convertvector(v, bf16x2_t); return __builtin_bit_cast(unsigned, b); }
template <int B, int N> __device__ __forceinline__ void sort16(unsigned (&k)[N]) {
#pragma unroll
  for (int size = 2; size <= 16; size <<= 1)
#pragma unroll
    for (int stride = size >> 1; stride > 0; stride >>= 1)
#pragma unroll
      for (int i = 0; i < 16; ++i) { const int l = i ^ stride;
        if (l > i) { const bool desc = ((i & size) == 0); const unsigned a = k[B + i], b = k[B + l]; const unsigned mx = umax(a, b), mn = umin(a, b); k[B + i] = desc ? mx : mn; k[B + l] = desc ? mn : mx; } }
}
template <int A, int Bo, int N> __device__ __forceinline__ void merge16(unsigned (&k)[N]) {
#pragma unroll
  for (int i = 0; i < 16; ++i) k[A + i] = umax(k[A + i], k[Bo + 15 - i]);
#pragma unroll
  for (int stride = 8; stride > 0; stride >>= 1)
#pragma unroll
    for (int i = 0; i < 16; ++i) { const int l = i ^ stride; if (l > i) { const unsigned a = k[A + i], b = k[A + l]; k[A + i] = umax(a, b); k[A + l] = umin(a, b); } }
}
template <int N> __device__ __forceinline__ void top16_of_64(unsigned (&k)[N]) {
  sort16<0>(k); sort16<16>(k); sort16<32>(k); sort16<48>(k);
  merge16<0, 16>(k); merge16<32, 48>(k); merge16<0, 32>(k);
}

__device__ __forceinline__ void route_phase(const bf16_t* __restrict__ pq, const bf16_t* __restrict__ subk, unsigned* __restrict__ pack, LAS3 char* lds) {
  const int tid = threadIdx.x, lane = tid & 63, r32 = lane & 31, hi = lane >> 5, wv = tid >> 6;
  const int gw = blockIdx.x * NWV + wv, nw = gridDim.x * NWV;
  LAS3 unsigned char* myb = (LAS3 unsigned char*)lds + wv * 2560 + lane * 40;
#pragma unroll 1
  for (int item = gw; item < (T / 32) * 8; item += nw) {
    const int h = item & 7, t0 = (item >> 3) * 32;
    unsigned la[16], lb[16];
#pragma unroll
    for (int i = 0; i < 16; ++i) { la[i] = 0u; lb[i] = 0u; }
#pragma unroll 1
    for (int p = 0; p < 2; ++p) {
      f32x16 acc[4];
#pragma unroll
      for (int kt = 0; kt < 4; ++kt) acc[kt] = f32x16{};
#pragma unroll
      for (int kd = 0; kd < 4; ++kd) {
        const bf16x8 bq = *(const bf16x8*)(pq + (size_t)(t0 + r32) * 1024 + h * 128 + p * 64 + kd * 16 + hi * 8);
#pragma unroll
        for (int kt = 0; kt < 4; ++kt) {
          const bf16x8 ak = *(const bf16x8*)(subk + (size_t)((h * 2 + p) * 128 + kt * 32 + r32) * 64 + kd * 16 + hi * 8);
          acc[kt] = __builtin_amdgcn_mfma_f32_32x32x16_bf16(ak, bq, acc[kt], 0, 0, 0);
        }
      }
      unsigned k[64];
#pragma unroll
      for (int kt = 0; kt < 4; ++kt)
#pragma unroll
        for (int r = 0; r < 16; ++r) k[kt * 16 + r] = (enc(acc[kt][r]) & 0xFFFFFF80u) | (unsigned)(127 - (32 * kt + crow(r, hi)));
      top16_of_64(k);
#pragma unroll
      for (int i = 0; i < 16; ++i) { auto rr = __builtin_amdgcn_permlane32_swap(k[i], k[i], false, false); unsigned r0 = rr[0], r1 = rr[1]; asm volatile("" : "+v"(r0), "+v"(r1)); k[16 + i] = hi ? r0 : r1; }
      merge16<0, 16>(k);
#pragma unroll
      for (int i = 0; i < 16; ++i) { la[i] = (p == 0) ? k[i] : la[i]; lb[i] = (p == 0) ? lb[i] : k[i]; }
      __builtin_amdgcn_sched_barrier(0);
    }
#pragma unroll
    for (int i = 0; i < 4; ++i) {
      const unsigned wa = (127u - (la[4 * i] & 127u)) | ((127u - (la[4 * i + 1] & 127u)) << 8) | ((127u - (la[4 * i + 2] & 127u)) << 16) | ((127u - (la[4 * i + 3] & 127u)) << 24);
      const unsigned wb = (127u - (lb[4 * i] & 127u)) | ((127u - (lb[4 * i + 1] & 127u)) << 8) | ((127u - (lb[4 * i + 2] & 127u)) << 16) | ((127u - (lb[4 * i + 3] & 127u)) << 24);
      *(LAS3 unsigned*)(myb + 4 * i) = wa; *(LAS3 unsigned*)(myb + 16 + 4 * i) = wb;
    }
    float va[16], vb[16];
#pragma unroll
    for (int i = 0; i < 16; ++i) { va[i] = dec(la[i] & 0xFFFFFF80u); vb[i] = dec(lb[i] & 0xFFFFFF80u); }
    unsigned k[64];
#define PEER_CAND(n, i, j) k[n] = (enc(va[i] + vb[j]) & 0xFFFFFF00u) | (unsigned)(255 - ((i) * 16 + (j)))
    PEER_CAND(0, 0, 0); PEER_CAND(1, 0, 1); PEER_CAND(2, 0, 2); PEER_CAND(3, 0, 3); PEER_CAND(4, 0, 4); PEER_CAND(5, 0, 5);
    PEER_CAND(6, 0, 6); PEER_CAND(7, 0, 7); PEER_CAND(8, 0, 8); PEER_CAND(9, 0, 9); PEER_CAND(10, 0, 10); PEER_CAND(11, 0, 11);
    PEER_CAND(12, 0, 12); PEER_CAND(13, 0, 13); PEER_CAND(14, 0, 14); PEER_CAND(15, 0, 15); PEER_CAND(16, 1, 0); PEER_CAND(17, 1, 1);
    PEER_CAND(18, 1, 2); PEER_CAND(19, 1, 3); PEER_CAND(20, 1, 4); PEER_CAND(21, 1, 5); PEER_CAND(22, 1, 6); PEER_CAND(23, 1, 7);
    PEER_CAND(24, 2, 0); PEER_CAND(25, 2, 1); PEER_CAND(26, 2, 2); PEER_CAND(27, 2, 3); PEER_CAND(28, 2, 4); PEER_CAND(29, 3, 0);
    PEER_CAND(30, 3, 1); PEER_CAND(31, 3, 2); PEER_CAND(32, 3, 3); PEER_CAND(33, 4, 0); PEER_CAND(34, 4, 1); PEER_CAND(35, 4, 2);
    PEER_CAND(36, 5, 0); PEER_CAND(37, 5, 1); PEER_CAND(38, 6, 0); PEER_CAND(39, 6, 1); PEER_CAND(40, 7, 0); PEER_CAND(41, 7, 1);
    PEER_CAND(42, 8, 0); PEER_CAND(43, 9, 0); PEER_CAND(44, 10, 0); PEER_CAND(45, 11, 0); PEER_CAND(46, 12, 0); PEER_CAND(47, 13, 0);
    PEER_CAND(48, 14, 0); PEER_CAND(49, 15, 0);
#undef PEER_CAND
#pragma unroll
    for (int z = 50; z < 64; ++z) k[z] = 0u;
    top16_of_64(k);
    const float best0 = dec(k[0] & 0xFFFFFF00u);
    float ev[16]; float den = 0.f;
#pragma unroll
    for (int i = 0; i < 16; ++i) { ev[i] = __expf(dec(k[i] & 0xFFFFFF00u) - best0); den += ev[i]; }
    const float inv = 1.0f / den;
    unsigned outw[8];
#pragma unroll
    for (int i = 0; i < 8; ++i) {
      unsigned k_lo = k[i], k_hi = k[8 + i]; float e_lo = ev[i], e_hi = ev[8 + i];
      asm volatile("" : "+v"(k_lo), "+v"(k_hi), "+v"(e_lo), "+v"(e_hi));
      const unsigned kk = hi ? k_hi : k_lo; const float e = hi ? e_hi : e_lo;
      const unsigned f = 255u - (kk & 255u);
      const unsigned ia = myb[f >> 4], ib = myb[16 + (f & 15u)];
      outw[i] = (ia * 128u + ib) | (cvtpk(0.f, e * inv) & 0xFFFF0000u);
    }
    unsigned* dst = pack + (size_t)(t0 + r32) * 128 + h * 16 + hi * 8;
    *(u32x4*)dst = (u32x4){outw[0], outw[1], outw[2], outw[3]};
    *(u32x4*)(dst + 4) = (u32x4){outw[4], outw[5], outw[6], outw[7]};
  }
}

__device__ __forceinline__ void conv_tables(const float* __restrict__ u, const float* __restrict__ v, unsigned* __restrict__ u8, float* __restrict__ su, unsigned* __restrict__ v8) {
  const int tid = threadIdx.x, lane = tid & 63, wv = tid >> 6;
  const int gw = blockIdx.x * NWV + wv, nw = gridDim.x * NWV;
  for (int e = gw; e < 16384; e += nw) {
    const f32x4_t* ur = (const f32x4_t*)(u + (size_t)e * 1024) + lane * 4;
    f32x4_t a[4]; float mx = 0.f;
#pragma unroll
    for (int i = 0; i < 4; ++i) { a[i] = ur[i]; mx = fmaxf(mx, fmaxf(fmaxf(fabsf(a[i][0]), fabsf(a[i][1])), fmaxf(fabsf(a[i][2]), fabsf(a[i][3])))); }
    mx = wmaxf(mx);
    const float sc = fmaxf(mx, 1e-30f) * (1.0f / 127.0f), isc = 1.0f / sc;
    u32x4 o;
#pragma unroll
    for (int i = 0; i < 4; ++i) {
      const int q0 = (int)rintf(a[i][0] * isc), q1 = (int)rintf(a[i][1] * isc), q2 = (int)rintf(a[i][2] * isc), q3 = (int)rintf(a[i][3] * isc);
      o[i] = (unsigned)(q0 & 255) | ((unsigned)(q1 & 255) << 8) | ((unsigned)(q2 & 255) << 16) | ((unsigned)(q3 & 255) << 24);
    }
    *(u32x4*)(u8 + (size_t)e * 256 + lane * 4) = o;
    if (lane == 0) su[e] = sc;
    const f32x4_t* vr = (const f32x4_t*)(v + (size_t)e * 1024) + lane * 4;
    u32x4 ov;
#pragma unroll
    for (int i = 0; i < 4; ++i) { const f32x4_t b = vr[i]; unsigned w = 0u; w = __builtin_amdgcn_cvt_pk_fp8_f32(2.0f * b[0], 2.0f * b[1], w, false); w = __builtin_amdgcn_cvt_pk_fp8_f32(2.0f * b[2], 2.0f * b[3], w, true); ov[i] = w; }
    *(u32x4*)(v8 + ((size_t)(lane >> 3) * 16384 + e) * 32 + (lane & 7) * 4) = ov;
  }
}
__device__ __forceinline__ float gelu_fast(float v) {
  const float av = __builtin_fabsf(v), t = __builtin_amdgcn_rcpf(av * 0.2316418882f + 1.0f);
  float q = t * 0.5307027145f + (-0.7265760135f); q = q * t + 0.7107068705f; q = q * t + (-0.142248368f); q = q * t + 0.127414796f; q = q * t;
  const float e = __builtin_amdgcn_exp2f((v * v) * (-0.72134752044f));
  const float m = v * (q * e);
  return v < 0.f ? m : v - m;
}
__device__ __forceinline__ unsigned xcc_id() { return (unsigned)__builtin_amdgcn_s_getreg((3 << 11) | 20) & 7u; }
struct ABuf { unsigned w[4], meta[4]; u32x4 ub[4][4]; float sue[4]; };
__device__ __forceinline__ void expA_issue(ABuf& B, int k0, int n, const LAS3 unsigned* list, const unsigned* __restrict__ u8, const float* __restrict__ su, int j16) {
#pragma unroll
  for (int q = 0; q < 4; ++q) {
    const int k = (k0 + 32 * q < n) ? k0 + 32 * q : k0;
    B.w[q] = list[2 * k]; B.meta[q] = list[2 * k + 1];
    const unsigned e = B.w[q] & 0xFFFFu;
    const unsigned* urow = u8 + (size_t)e * 256 + j16 * 4;
#pragma unroll
    for (int seg = 0; seg < 4; ++seg) B.ub[q][seg] = *(const u32x4*)(urow + seg * 64);
    B.sue[q] = su[e];
  }
}
__device__ __forceinline__ void expA_consume(const ABuf& B, int k0, int n, const LAS3 char* hl, const LAS3 float* shl, float* __restrict__ co, int t0, int j16) {
#pragma unroll
  for (int q = 0; q < 4; ++q) {
    const int tokl = (int)(B.meta[q] >> 8), slot = (int)(B.meta[q] & 255u);
    const LAS3 char* hrow = hl + tokl * 1024 + j16 * 16;
    int acc = 0;
#pragma unroll
    for (int seg = 0; seg < 4; ++seg) { const u32x4 hq = *(const LAS3 u32x4*)(hrow + seg * 256);
      acc = __builtin_amdgcn_sdot4((int)B.ub[q][seg].x, (int)hq.x, acc, false); acc = __builtin_amdgcn_sdot4((int)B.ub[q][seg].y, (int)hq.y, acc, false);
      acc = __builtin_amdgcn_sdot4((int)B.ub[q][seg].z, (int)hq.z, acc, false); acc = __builtin_amdgcn_sdot4((int)B.ub[q][seg].w, (int)hq.w, acc, false); }
    acc += __shfl_xor(acc, 1); acc += __shfl_xor(acc, 2); acc += __shfl_xor(acc, 4); acc += __shfl_xor(acc, 8);
    const float d = (float)acc * (B.sue[q] * shl[tokl]);
    const float c = 0.5f * __uint_as_float(B.w[q] & 0xFFFF0000u) * gelu_fast(d);
    if (j16 == 0 && k0 + 32 * q < n) co[(size_t)(t0 + tokl) * 128 + slot] = c;
  }
}
__device__ __forceinline__ void expA_item(int item, int xs, const unsigned* __restrict__ pack, const unsigned* __restrict__ hn8, const float* __restrict__ shp, const unsigned* __restrict__ u8, const float* __restrict__ su,
                                          float* __restrict__ co, LAS3 char* lds, int tid) {
  const int lane = tid & 63, j16 = lane & 15, grp = lane >> 4, wv = tid >> 6;
  LAS3 char* hl = lds + 1024;
  LAS3 float* shl = (LAS3 float*)(lds + 1024 + 65536);
  LAS3 unsigned* cnt = (LAS3 unsigned*)(lds + 16);
  LAS3 unsigned* list = (LAS3 unsigned*)(lds + 1024 + 65536 + 256);
  const int t0 = item * 64;
#pragma unroll
  for (int i = 0; i < 8; ++i) { const int idx = tid + 512 * i; *(LAS3 u32x4*)(hl + idx * 16) = *(const u32x4*)(hn8 + (size_t)t0 * 256 + idx * 4); }
  if (tid < 64) shl[tid] = shp[t0 + tid];
  {
    const int tokl = tid >> 3, sb = (tid & 7) * 16;
    u32x4 pw[4];
#pragma unroll
    for (int i = 0; i < 4; ++i) pw[i] = *(const u32x4*)(pack + (size_t)(t0 + tokl) * 128 + sb + 4 * i);
#pragma unroll
    for (int j = 0; j < 16; ++j) { const unsigned w = pw[j >> 2][j & 3];
      if (((w & 0xFFFFu) >> 11) == (unsigned)xs) { const unsigned pos = __hip_atomic_fetch_add(cnt, 1u, __ATOMIC_RELAXED, __HIP_MEMORY_SCOPE_WORKGROUP); list[2 * pos] = w; list[2 * pos + 1] = (unsigned)((tokl << 8) | (sb + j)); } }
  }
  __syncthreads();
  const int n = (int)cnt[0];
  const int gidx = wv * 4 + grp;
  ABuf A, Bb;
  if (gidx < n) expA_issue(A, gidx, n, list, u8, su, j16);
#pragma unroll 1
  for (int k0 = gidx; k0 < n; k0 += 256) {
    if (k0 + 128 < n) expA_issue(Bb, k0 + 128, n, list, u8, su, j16);
    expA_consume(A, k0, n, hl, shl, co, t0, j16);
    if (k0 + 256 < n) expA_issue(A, k0 + 256, n, list, u8, su, j16);
    if (k0 + 128 < n) expA_consume(Bb, k0 + 128, n, hl, shl, co, t0, j16);
  }
}
struct BBuf { u32x4 vv[16]; f32x4_t h[4]; };
__device__ __forceinline__ void expB_issue(BBuf& B, unsigned pk0, unsigned pk1, const unsigned* __restrict__ vbase, const float* __restrict__ hp, int r8) {
#pragma unroll
  for (int i = 0; i < 16; ++i) { const unsigned e = (unsigned)__shfl((int)(i < 8 ? pk0 : pk1), (8 * i + r8) & 63) & 0xFFFFu; B.vv[i] = *(const u32x4*)(vbase + (size_t)e * 32); }
#pragma unroll
  for (int w = 0; w < 4; ++w) B.h[w] = *(const f32x4_t*)(hp + 4 * w);
}
__device__ __forceinline__ void expB_consume(const BBuf& B, float co0, float co1, float* __restrict__ hp, float* __restrict__ ssqp, int lane, int r8) {
  f32x2_t y[8];
#pragma unroll
  for (int i = 0; i < 8; ++i) y[i] = (f32x2_t){0.f, 0.f};
#pragma unroll
  for (int i = 0; i < 16; ++i) {
    const float cv = __shfl(i < 8 ? co0 : co1, (8 * i + r8) & 63);
    const f32x2_t c2 = {cv, cv};
#pragma unroll
    for (int w = 0; w < 4; ++w) {
      y[2 * w] = __builtin_elementwise_fma(__builtin_amdgcn_cvt_pk_f32_fp8(B.vv[i][w], false), c2, y[2 * w]);
      y[2 * w + 1] = __builtin_elementwise_fma(__builtin_amdgcn_cvt_pk_f32_fp8(B.vv[i][w], true), c2, y[2 * w + 1]);
    }
  }
#pragma unroll
  for (int i = 0; i < 8; ++i) {
    float a = y[i][0], b = y[i][1];
    a += __shfl_xor(a, 8); b += __shfl_xor(b, 8); a += __shfl_xor(a, 16); b += __shfl_xor(b, 16); a += __shfl_xor(a, 32); b += __shfl_xor(b, 32);
    y[i][0] = a; y[i][1] = b;
  }
  float ss = 0.f;
  if (r8 == 0) {
#pragma unroll
    for (int w = 0; w < 4; ++w) {
      const f32x4_t a = B.h[w];
      const f32x4_t z = {a[0] + y[2 * w][0], a[1] + y[2 * w][1], a[2] + y[2 * w + 1][0], a[3] + y[2 * w + 1][1]};
      *(f32x4_t*)(hp + 4 * w) = z;
      ss += (z[0] * z[0] + z[1] * z[1]) + (z[2] * z[2] + z[3] * z[3]);
    }
  }
  ss += __shfl_xor(ss, 1); ss += __shfl_xor(ss, 2); ss += __shfl_xor(ss, 4);
  if (lane == 0) *ssqp = ss;
}
__device__ __forceinline__ void expB_item(int item, int xs, const unsigned* __restrict__ pack, const float* __restrict__ co, const unsigned* __restrict__ v8, float* __restrict__ out, float* __restrict__ ssq, int tid) {
  const int lane = tid & 63, wv = tid >> 6, r8 = lane >> 3, c8 = lane & 7;
  const int t0 = item * 64 + wv * 8;
  unsigned pk0[8], pk1[8]; float co0[8], co1[8];
#pragma unroll
  for (int i = 0; i < 8; ++i) { pk0[i] = pack[(size_t)(t0 + i) * 128 + lane]; pk1[i] = pack[(size_t)(t0 + i) * 128 + 64 + lane]; co0[i] = co[(size_t)(t0 + i) * 128 + lane]; co1[i] = co[(size_t)(t0 + i) * 128 + 64 + lane]; }
  const unsigned* vbase = v8 + (size_t)xs * 16384 * 32 + c8 * 4;
  float* hp0 = out + (size_t)t0 * 1024 + xs * 128 + c8 * 16;
  BBuf A, Bb;
  expB_issue(A, pk0[0], pk1[0], vbase, hp0, r8);
#pragma unroll
  for (int i = 0; i < 8; i += 2) {
    expB_issue(Bb, pk0[i + 1], pk1[i + 1], vbase, hp0 + (size_t)(i + 1) * 1024, r8);
    expB_consume(A, co0[i], co1[i], hp0 + (size_t)i * 1024, ssq + (size_t)xs * T + t0 + i, lane, r8);
    if (i + 2 < 8) expB_issue(A, pk0[i + 2], pk1[i + 2], vbase, hp0 + (size_t)(i + 2) * 1024, r8);
    expB_consume(Bb, co0[i + 1], co1[i + 1], hp0 + (size_t)(i + 1) * 1024, ssq + (size_t)xs * T + t0 + i + 1, lane, r8);
  }
}
template <int PASS> __device__ __forceinline__ void experts_sliced(const unsigned* __restrict__ pack, const unsigned* __restrict__ hn8, const float* __restrict__ shp, const unsigned* __restrict__ u8, const float* __restrict__ su,
                                                                    float* __restrict__ co, const unsigned* __restrict__ v8, float* __restrict__ out, float* __restrict__ ssq, unsigned* __restrict__ ctr, LAS3 char* lds) {
  int tid = threadIdx.x; asm volatile("" : "+v"(tid));
  LAS3 volatile int* lw = (LAS3 volatile int*)lds;
  const int xme = (int)xcc_id();
#pragma unroll 1
  for (int s8 = 0; s8 < 8; ++s8) {
    const int xs = (xme + s8) & 7;
#pragma unroll 1
    for (;;) {
      __syncthreads();
      if (tid == 0) { lw[0] = (int)atomicAdd(ctr + 64 * xs, 1u); lw[4] = 0; }
      __syncthreads();
      const int item = lw[0];
      if (item >= T / 64) break;
      if (PASS == 0) expA_item(item, xs, pack, hn8, shp, u8, su, co, lds, tid);
      else expB_item(item, xs, pack, co, v8, out, ssq, tid);
    }
  }
}
__device__ __forceinline__ void experts_norm(const float* __restrict__ ssq, const float* __restrict__ gfin, float* __restrict__ out) {
  const int tid = threadIdx.x, lane = tid & 63, wv = tid >> 6;
  const int gw = blockIdx.x * NWV + wv, nw = gridDim.x * NWV;
  for (int t = gw; t < T; t += nw) {
    float ss = 0.f;
#pragma unroll
    for (int x = 0; x < 8; ++x) ss += ssq[(size_t)x * T + t];
    const float inv = rsqrtf(ss * (1.0f / 1024.0f) + 1e-6f);
    float* op = out + (size_t)t * 1024 + lane * 16; const float* gp = gfin + lane * 16;
#pragma unroll
    for (int i = 0; i < 4; ++i) { const f32x4_t z = *(const f32x4_t*)(op + 4 * i), g = *(const f32x4_t*)(gp + 4 * i); *(f32x4_t*)(op + 4 * i) = z * inv * g; }
  }
}
#undef LAS3
}

#define XB_TMO      128
#define XB_XCNT(j)  (256  + 64 * (j))
#define XB_XSUB(j)  (1280 + 64 * (j))
#define XB_XGEN(j)  (2304 + 64 * (j))
#define XB_TOP      3328
#define XB_TOPGEN   3392
#define XCD_BAR_WORDS 3456
#define XB_SPIN_CAP (1u << 18)
#ifndef LAS
#define LAS __attribute__((address_space(3)))
#endif

__device__ __forceinline__ unsigned xb_ld(unsigned* p)              { return __hip_atomic_load(p, __ATOMIC_RELAXED, __HIP_MEMORY_SCOPE_AGENT); }
__device__ __forceinline__ unsigned xb_add(unsigned* p, unsigned v) { return __hip_atomic_fetch_add(p, v, __ATOMIC_RELAXED, __HIP_MEMORY_SCOPE_AGENT); }
__device__ __forceinline__ unsigned xb_xcc_id() { return (unsigned)__builtin_amdgcn_s_getreg((3 << 11) | 20) & 0xFu; }
#define XB_SPIN(cond, bar) do { unsigned _sp = 0; while (cond) { __builtin_amdgcn_s_sleep(1); \
    if ((++_sp & 255u) == 0u) { if (xb_ld(&(bar)[XB_TMO])) break; if (_sp > XB_SPIN_CAP) { atomicAdd(&(bar)[XB_TMO], 1u); break; } } } } while (0)

struct XcdBarrier {
    unsigned* bar; unsigned x;
    volatile LAS unsigned* st;
};

__device__ __forceinline__ XcdBarrier xcd_barrier_post(unsigned* bar, volatile LAS unsigned* st) {
    XcdBarrier b; b.bar = bar; b.x = xb_xcc_id(); b.st = st;
    if (threadIdx.x == 0) (void)xb_add(&bar[XB_XCNT(b.x)], 1u);
    return b;
}
__device__ __forceinline__ void xcd_barrier_complete(unsigned* bar, unsigned x, unsigned& nloc, unsigned& nx) {
    const unsigned G = gridDim.x * gridDim.y * gridDim.z;
    unsigned sum, cnt, mine, sp = 0u;
    for (;;) {
        sum = 0u; cnt = 0u; mine = 0u;
#pragma unroll
        for (unsigned j = 0; j < 16; ++j) { const unsigned c = xb_ld(&bar[XB_XCNT(j)]); sum += c; cnt += (c > 0u) ? 1u : 0u; mine = (j == x) ? c : mine; }
        if (sum == G) break;
        __builtin_amdgcn_s_sleep(1);
        if ((++sp & 255u) == 0u) { if (xb_ld(&bar[XB_TMO])) break; if (sp > XB_SPIN_CAP) { atomicAdd(&bar[XB_TMO], 1u); break; } }
    }
    nloc = mine > 0u ? mine : 1u; nx = cnt > 0u ? cnt : 1u;
}

__device__ __forceinline__ void xcd_barrier(const XcdBarrier& b) {
    asm volatile("s_waitcnt vmcnt(0)" ::: "memory");
    __syncthreads();
    if (threadIdx.x == 0) {
        unsigned* bar = b.bar;
        __builtin_amdgcn_s_waitcnt(0);
        unsigned nloc = b.st[0], nx = b.st[1];
        if (nloc == 0u) { xcd_barrier_complete(bar, b.x, nloc, nx); b.st[0] = nloc; b.st[1] = nx; }
        const unsigned old = xb_add(&bar[XB_XSUB(b.x)], 1u);
        const unsigned gen = old / nloc;
        if (old + 1u == (gen + 1u) * nloc) {
            __builtin_amdgcn_fence(__ATOMIC_RELEASE, "agent");
            asm volatile("s_waitcnt vmcnt(0)" ::: "memory");
            const unsigned og = xb_add(&bar[XB_TOP], 1u);
            const unsigned tg = og / nx;
            if (og + 1u == (tg + 1u) * nx) xb_add(&bar[XB_TOPGEN], 1u);
            else XB_SPIN(xb_ld(&bar[XB_TOPGEN]) == tg, bar);
            __builtin_amdgcn_fence(__ATOMIC_ACQUIRE, "agent");
            xb_add(&bar[XB_XGEN(b.x)], 1u);
            asm volatile("s_waitcnt vmcnt(0)" ::: "memory");
        } else {
            XB_SPIN(xb_ld(&bar[XB_XGEN(b.x)]) == gen, bar);
            __builtin_amdgcn_fence(__ATOMIC_ACQUIRE, "agent");
            asm volatile("s_waitcnt vmcnt(0)" ::: "memory");
        }
    }
    __syncthreads();
}

struct Args { const float* in[23]; float* out; char* ws; };
constexpr int LDS_BYTES = 131072 + 4096;

typedef const __attribute__((address_space(4))) Args* kargs_t;
DEV kargs_t KA() { kargs_t k = (kargs_t)__builtin_amdgcn_kernarg_segment_ptr(); asm volatile("" : "+s"(k)); return k; }
#define WSP(type, off) ((type*)(ws + (off)))

__global__ __launch_bounds__(NTHR, 2) void mega(Args a) {
  extern __shared__ __attribute__((aligned(16))) char lds[];
  cg::grid_group grid = cg::this_grid();
  PG8_LAS unsigned char* glds = (PG8_LAS unsigned char*)lds;
  const int bid = blockIdx.x, G = gridDim.x;
  (void)a;
  volatile LAS unsigned* bst = (volatile LAS unsigned*)((LAS char*)lds + LDS_BYTES - 16);
  if (threadIdx.x < 4) bst[threadIdx.x] = 0u;
  __syncthreads();
  XcdBarrier xbar; { kargs_t k = KA(); xbar = xcd_barrier_post((unsigned*)k->ws, bst); }

  { kargs_t k = KA(); char* ws = k->ws;
    { const int lane_ = threadIdx.x & 63, wv_ = threadIdx.x >> 6, gw_ = bid * NWV + wv_, nw_ = G * NWV;
      __attribute__((address_space(3))) float* scr = (__attribute__((address_space(3))) float*)((__attribute__((address_space(3))) char*)lds + wv_ * 8448);
      constexpr int I_IN = 16 * 120, I_BR = 8 * 32, I_SQ = 16 * 32, I_C1 = 32 * 8, I_C2 = 4 * 8, I_UQ = 4 * 24, I_UKV = 2 * 32;
      constexpr int NITEMS = I_IN + 2 * I_BR + 2 * I_SQ + 2 * I_C1 + 2 * I_C2 + I_UQ + I_UKV;
      for (int it = gw_; it < NITEMS; it += nw_) {
        int r = it;
        if (r < I_IN) { tr_item<1>(k->in[2], 1024, IN_COLS, WSP(bf16_t, WS_WIN), 120, 3840, scr, r, lane_); continue; } r -= I_IN;
        if (r < I_BR) { tr_item<0>(k->in[13], 512, 1024, WSP(bf16_t, WS_WBN), 32, 1024, scr, r, lane_); continue; } r -= I_BR;
        if (r < I_BR) { tr_item<0>(k->in[14], 512, 1024, WSP(bf16_t, WS_WBM), 32, 1024, scr, r, lane_); continue; } r -= I_BR;
        if (r < I_SQ) { tr_item<0>(k->in[15], 1024, 1024, WSP(bf16_t, WS_WOUT), 32, 1024, scr, r, lane_); continue; } r -= I_SQ;
        if (r < I_SQ) { tr_item<0>(k->in[17], 1024, 1024, WSP(bf16_t, WS_WQ), 32, 1024, scr, r, lane_); continue; } r -= I_SQ;
        if (r < I_C1) { tr_item<0>(k->in[5], 2048, 256, WSP(bf16_t, WS_CKW1), 8, 256, scr, r, lane_); continue; } r -= I_C1;
        if (r < I_C1) { tr_item<0>(k->in[7], 2048, 256, WSP(bf16_t, WS_CVW1), 8, 256, scr, r, lane_); continue; } r -= I_C1;
        if (r < I_C2) { tr_item<0>(k->in[6], 256, 64, WSP(bf16_t, WS_CKW2), 8, 64, scr, r, lane_); continue; } r -= I_C2;
        if (r < I_C2) { tr_item<0>(k->in[8], 256, 64, WSP(bf16_t, WS_CVW2), 8, 64, scr, r, lane_); continue; } r -= I_C2;
        if (r < I_UQ) { tr_item<0>(k->in[11], 256, 768, WSP(bf16_t, WS_UQ), 24, 768, scr, r, lane_); continue; } r -= I_UQ;
        tr_item<0>(k->in[12], 128, 1024, WSP(bf16_t, WS_UKV), 32, 1024, scr, r, lane_);
      } }
    ph_conv_plain(k->in[18], WSP(bf16_t, WS_SUBK), 16 * 128 * 64);
    ph_rope_table(WSP(float2, WS_ROPE));
    ph_rms1024<false>(k->in[0], k->in[1], WSP(bf16_t, WS_XN), T); }
  grid.sync();
  { kargs_t k = KA(); char* ws = k->ws;
    pg8::Gemm g{WSP(bf16_t, WS_XN), WSP(bf16_t, WS_WIN), T, 3840, 1024}; pg8::StaticOrder S; S.init(T, 3840, G, bid);
    pg8::EpiInProjF E{WSP(bf16_t, WS_PROJ), WSP(bf16_t, WS_GATES)};
    pg8::gemm_phase<pg8::EpiInProjF, pg8::StaticOrder, PG8_ALIGN, PG8_SP2>(glds, g, S, E); }
  xcd_barrier(xbar);
  { kargs_t k = KA(); char* ws = k->ws;
    ph_rms_cols<4>(WSP(bf16_t, WS_PROJ), PC_CQ, k->in[9], WSP(bf16_t, WS_CQN));
    ph_rms_cols<2>(WSP(bf16_t, WS_PROJ), PC_CKV, k->in[10], WSP(bf16_t, WS_CKVN));
    ph_rope_k(WSP(bf16_t, WS_PROJ), WSP(bf16_t, WS_KROPE));
    ph_cmp_gather(WSP(bf16_t, WS_PROJ), k->in[3], 0, WSP(bf16_t, WS_CA));
    ph_cmp_gather(WSP(bf16_t, WS_PROJ), k->in[4], 1, WSP(bf16_t, WS_CA2)); }
  xcd_barrier(xbar);
  { kargs_t k = KA(); char* ws = k->ws;
    pg8::Gemm g{WSP(bf16_t, WS_CA), WSP(bf16_t, WS_CKW1), 2048, 256, 2048}; pg8::StaticOrder S; S.init(2048, 256, G, bid);
    pg8::EpiBf16<1> E{WSP(bf16_t, WS_HID), 256, nullptr, 0, 0, 1.f};
    pg8::gemm_phase<pg8::EpiBf16<1>, pg8::StaticOrder, PG8_ALIGN, PG8_SP2>(glds, g, S, E); }
  { kargs_t k = KA(); char* ws = k->ws;
    pg8::Gemm g{WSP(bf16_t, WS_CA2), WSP(bf16_t, WS_CVW1), 2048, 256, 2048}; pg8::StaticOrder S; S.init(2048, 256, G, (bid + 128) & 255);
    pg8::EpiBf16<1> E{WSP(bf16_t, WS_HID2), 256, nullptr, 0, 0, 1.f};
    pg8::gemm_phase<pg8::EpiBf16<1>, pg8::StaticOrder, PG8_ALIGN, PG8_SP2>(glds, g, S, E); }
  { kargs_t k = KA(); char* ws = k->ws;
    pg8::Gemm g{WSP(bf16_t, WS_CQN), WSP(bf16_t, WS_UQ), T, 768, 256}; pg8::StaticOrder S; S.init(T, 768, G, (bid + 64) & 255);
    pg8::EpiMlaQF E{WSP(bf16_t, WS_MLAQ), WSP(float2, WS_ROPE)};
    pg8::gemm_phase<pg8::EpiMlaQF, pg8::StaticOrder, PG8_ALIGN, PG8_SP2>(glds, g, S, E); }
  { kargs_t k = KA(); char* ws = k->ws;
    pg8::Gemm g{WSP(bf16_t, WS_CKVN), WSP(bf16_t, WS_UKV), T, 1024, 128}; pg8::StaticOrder S; S.init(T, 1024, G, bid);
    pg8::EpiBf16<0> E{WSP(bf16_t, WS_MLAKV), 1024, nullptr, 0, 0, 1.f};
    pg8::gemm_phase<pg8::EpiBf16<0>, pg8::StaticOrder, PG8_ALIGN, PG8_SP2>(glds, g, S, E); }
  xcd_barrier(xbar);
  { kargs_t k = KA(); char* ws = k->ws;
    pg8::Gemm g{WSP(bf16_t, WS_HID), WSP(bf16_t, WS_CKW2), 2048, 256, 256}; pg8::StaticOrder S; S.init(2048, 256, G, bid);
    pg8::EpiCmpOutF E{WSP(bf16_t, WS_KC)};
    pg8::gemm_phase<pg8::EpiCmpOutF, pg8::StaticOrder, PG8_ALIGN, PG8_SP2>(glds, g, S, E); }
  { kargs_t k = KA(); char* ws = k->ws;
    pg8::Gemm g{WSP(bf16_t, WS_HID2), WSP(bf16_t, WS_CVW2), 2048, 256, 256}; pg8::StaticOrder S; S.init(2048, 256, G, (bid + 128) & 255);
    pg8::EpiCmpOutF E{WSP(bf16_t, WS_VC)};
    pg8::gemm_phase<pg8::EpiCmpOutF, pg8::StaticOrder, PG8_ALIGN, PG8_SP2>(glds, g, S, E); }
  xcd_barrier(xbar);
  { kargs_t k = KA(); char* ws = k->ws;
    att::attn_phase(WSP(bf16_t, WS_PROJ), WSP(bf16_t, WS_KC), WSP(bf16_t, WS_VC), k->in[21], WSP(bf16_t, WS_ONSA),
                    WSP(bf16_t, WS_MLAQ), WSP(bf16_t, WS_MLAKV), WSP(bf16_t, WS_KROPE), WSP(bf16_t, WS_OMLA), (att::lptr)lds); }
  xcd_barrier(xbar);
  { kargs_t k = KA(); char* ws = k->ws;
    pg8::Gemm g{WSP(bf16_t, WS_ONSA), WSP(bf16_t, WS_WBN), T, 1024, 512}; pg8::StaticOrder S; S.init(T, 1024, G, bid);
    pg8::EpiMergeF<0> E{WSP(bf16_t, WS_GATES), WSP(bf16_t, WS_MERGED)};
    pg8::gemm_phase<pg8::EpiMergeF<0>, pg8::StaticOrder, PG8_ALIGN, PG8_SP2>(glds, g, S, E); }
  { kargs_t k = KA(); char* ws = k->ws;
    pg8::Gemm g{WSP(bf16_t, WS_OMLA), WSP(bf16_t, WS_WBM), T, 1024, 512}; pg8::StaticOrder S; S.init(T, 1024, G, bid);
    pg8::EpiMergeF<1> E{WSP(bf16_t, WS_GATES), WSP(bf16_t, WS_MERGED)};
    pg8::gemm_phase<pg8::EpiMergeF<1>, pg8::StaticOrder, PG8_ALIGN, PG8_SP2>(glds, g, S, E); }
  xcd_barrier(xbar);
  { kargs_t k = KA(); char* ws = k->ws;
    pg8::Gemm g{WSP(bf16_t, WS_MERGED), WSP(bf16_t, WS_WOUT), T, 1024, 1024}; pg8::StaticOrder S; S.init(T, 1024, G, bid);
    pg8::EpiResidF E{k->in[0], k->out};
    pg8::gemm_phase<pg8::EpiResidF, pg8::StaticOrder, PG8_ALIGN, PG8_SP2>(glds, g, S, E); }
  xcd_barrier(xbar);
  { kargs_t k = KA(); char* ws = k->ws; ph_rms1024<true>(k->out, k->in[16], WSP(bf16_t, WS_HN), T, WSP(unsigned, WS_HN8), WSP(float, WS_SH));
    peer::conv_tables(k->in[19], k->in[20], WSP(unsigned, WS_U8), WSP(float, WS_SU), WSP(unsigned, WS_V8)); }
  xcd_barrier(xbar);
  { kargs_t k = KA(); char* ws = k->ws;
    pg8::Gemm g{WSP(bf16_t, WS_HN), WSP(bf16_t, WS_WQ), T, 1024, 1024}; pg8::StaticOrder S; S.init(T, 1024, G, bid);
    pg8::EpiBf16<0> E{WSP(bf16_t, WS_PQ), 1024, nullptr, 0, 0, 1.f};
    pg8::gemm_phase<pg8::EpiBf16<0>, pg8::StaticOrder, PG8_ALIGN, PG8_SP2>(glds, g, S, E); }
  xcd_barrier(xbar);
  { kargs_t k = KA(); char* ws = k->ws; peer::route_phase(WSP(bf16_t, WS_PQ), WSP(bf16_t, WS_SUBK), WSP(unsigned, WS_PIDX), (__attribute__((address_space(3))) char*)lds); }
  xcd_barrier(xbar);
  { kargs_t k = KA(); char* ws = k->ws;
    peer::experts_sliced<0>(WSP(unsigned, WS_PIDX), WSP(unsigned, WS_HN8), WSP(float, WS_SH), WSP(unsigned, WS_U8), WSP(float, WS_SU), WSP(float, WS_CO), WSP(unsigned, WS_V8), k->out, WSP(float, WS_SSQ),
                            (unsigned*)ws + CTL_QA, (__attribute__((address_space(3))) char*)lds); }
  xcd_barrier(xbar);
  { kargs_t k = KA(); char* ws = k->ws;
    peer::experts_sliced<1>(WSP(unsigned, WS_PIDX), WSP(unsigned, WS_HN8), WSP(float, WS_SH), WSP(unsigned, WS_U8), WSP(float, WS_SU), WSP(float, WS_CO), WSP(unsigned, WS_V8), k->out, WSP(float, WS_SSQ),
                            (unsigned*)ws + CTL_QB, (__attribute__((address_space(3))) char*)lds); }
  xcd_barrier(xbar);
  { kargs_t k = KA(); char* ws = k->ws; peer::experts_norm(WSP(float, WS_SSQ), k->in[22], k->out); }
}

extern "C" void kernel_launch(void* const* d_in, const int* in_sizes, int n_in, void* d_out, int out_size, void* d_ws, size_t ws_size, hipStream_t stream) {
  if (n_in != 23 || ws_size < 256 * MiB) { fprintf(stderr, "kernel_launch: unexpected n_in %d / ws_size %zu\n", n_in, ws_size); return; }
  static int grid_blocks = 0;
  if (!grid_blocks) {
    int dev = 0, cus = 0, per_cu = 0;
    (void)hipGetDevice(&dev);
    (void)hipDeviceGetAttribute(&cus, hipDeviceAttributeMultiprocessorCount, dev);
    if (hipFuncSetAttribute((const void*)mega, hipFuncAttributeMaxDynamicSharedMemorySize, LDS_BYTES) != hipSuccess) fprintf(stderr, "kernel_launch: hipFuncSetAttribute failed\n");
    (void)hipOccupancyMaxActiveBlocksPerMultiprocessor(&per_cu, (const void*)mega, NTHR, LDS_BYTES);
    if (per_cu < 1) { fprintf(stderr, "kernel_launch: occupancy query returned %d\n", per_cu); per_cu = 1; }
    if (per_cu > 2) per_cu = 2;
    grid_blocks = cus * per_cu;
    fprintf(stderr, "kernel_launch: cus %d per_cu %d grid %d ws %zu\n", cus, per_cu, grid_blocks, ws_size);
  }
  if (hipMemsetAsync(d_ws, 0, 65536, stream) != hipSuccess) fprintf(stderr, "kernel_launch: hipMemsetAsync failed\n");
  Args a{};
  for (int i = 0; i < 23; ++i) a.in[i] = (const float*)d_in[i];
  a.out = (float*)d_out; a.ws = (char*)d_ws;
  void* args[] = {&a};
  hipError_t e = hipLaunchCooperativeKernel((const void*)mega, dim3(grid_blocks), dim3(NTHR), args, LDS_BYTES, stream);
  if (e != hipSuccess) fprintf(stderr, "cooperative launch failed: %s (grid %d)\n", hipGetErrorString(e), grid_blocks);
}
```

```cpp
#include <hip/hip_runtime.h>
#include <stdint.h>
#include <cstdio>
#include <hip/hip_cooperative_groups.h>
namespace cg = cooperative_groups;

typedef unsigned short bf16_t;
#define DEV __device__ __forceinline__

constexpr int BATCH = 8, SEQ = 2048, DM = 1024, T = BATCH * SEQ;
constexpr int IN_COLS = 3768;
constexpr int PROJ_LD = 1792;
constexpr int PC_Q = 0, PC_KV = 512, PC_CQ = 1280, PC_CKV = 1536, PC_KR = 1664, PC_GATE = 1696;
constexpr int NC = 127;
constexpr size_t MiB = 1u << 20;

constexpr size_t WS_WIN = 1 * MiB;
constexpr size_t WS_WBN = 9 * MiB;
constexpr size_t WS_WBM = 10 * MiB;
constexpr size_t WS_WOUT = 11 * MiB;
constexpr size_t WS_WQ = 13 * MiB;
constexpr size_t WS_CKW1 = 15 * MiB;
constexpr size_t WS_CVW1 = 16 * MiB;
constexpr size_t WS_CKW2 = 17 * MiB;
constexpr size_t WS_CVW2 = 17 * MiB + 128 * 1024;
constexpr size_t WS_UQ = 17 * MiB + 256 * 1024;
constexpr size_t WS_UKV = 17 * MiB + 768 * 1024;
constexpr size_t WS_SUBK = 18 * MiB;
constexpr size_t WS_ROPE = 18 * MiB + 512 * 1024;
constexpr size_t WS_GATES = 20 * MiB;
constexpr size_t WS_PQ = 20 * MiB;
constexpr size_t WS_PROJ = 84 * MiB;
constexpr size_t WS_MERGED = 84 * MiB;
constexpr size_t WS_PIDX = 84 * MiB;
constexpr size_t WS_U8 = 172 * MiB;
constexpr size_t WS_V8 = 188 * MiB;
constexpr size_t WS_SU = 204 * MiB;
constexpr size_t WS_SH = 204 * MiB + 65536;
constexpr size_t WS_HN8 = 205 * MiB;
constexpr size_t WS_CO = 221 * MiB;
constexpr size_t WS_SSQ = 229 * MiB;
constexpr int CTL_QA = 4096, CTL_QB = 4096 + 512;
constexpr size_t WS_PW = 92 * MiB;
constexpr size_t WS_XN = 140 * MiB;
constexpr size_t WS_MLAKV = 140 * MiB;
constexpr size_t WS_HN = 140 * MiB;
constexpr size_t WS_MLAQ = 172 * MiB;
constexpr size_t WS_KROPE = 196 * MiB;
constexpr size_t WS_KC = 197 * MiB;
constexpr size_t WS_VC = 197 * MiB + 512 * 1024;
constexpr size_t WS_ONSA = 198 * MiB;
constexpr size_t WS_OMLA = 214 * MiB;
constexpr size_t WS_SLAB = 198 * MiB;
constexpr size_t WS_CPOS = 18 * MiB + 768 * 1024;
constexpr size_t WS_CA = 198 * MiB;
constexpr size_t WS_HID = 206 * MiB;
constexpr size_t WS_HID2 = 207 * MiB;
constexpr size_t WS_CA2 = 214 * MiB;
constexpr size_t WS_CQN = 230 * MiB;
constexpr size_t WS_CKVN = 238 * MiB;
constexpr size_t WS_OCMP = 230 * MiB;
constexpr size_t WS_SEL = 246 * MiB;

__device__ const unsigned char T5B[128] = {
  0, 1, 2, 3, 4, 5, 6, 7, 8, 9, 10, 11, 12, 13, 14, 15, 16, 16, 16, 17, 17, 18, 18, 18, 19, 19, 19, 20, 20, 20, 20, 21,
  21, 21, 21, 22, 22, 22, 22, 22, 23, 23, 23, 23, 23, 23, 24, 24, 24, 24, 24, 24, 25, 25, 25, 25, 25, 25, 25, 26, 26, 26, 26, 26,
  26, 26, 26, 27, 27, 27, 27, 27, 27, 27, 27, 27, 27, 28, 28, 28, 28, 28, 28, 28, 28, 28, 28, 29, 29, 29, 29, 29, 29, 29, 29, 29,
  29, 29, 29, 30, 30, 30, 30, 30, 30, 30, 30, 30, 30, 30, 30, 30, 30, 31, 31, 31, 31, 31, 31, 31, 31, 31, 31, 31, 31, 31, 31, 31};

DEV float bf2f(bf16_t v) { return __uint_as_float(((unsigned)v) << 16); }
DEV bf16_t f2bf(float f) { unsigned u = __float_as_uint(f); u += 0x7fffu + ((u >> 16) & 1u); return (bf16_t)(u >> 16); }
DEV float wsum(float v) {
#pragma unroll
  for (int o = 32; o > 0; o >>= 1) v += __shfl_xor(v, o);
  return v;
}
DEV float wmaxf(float v) {
#pragma unroll
  for (int o = 32; o > 0; o >>= 1) v = fmaxf(v, __shfl_xor(v, o));
  return v;
}
DEV float sigmoidf_(float x) { return 1.0f / (1.0f + expf(-x)); }
DEV float gelu_exact(float x) { return 0.5f * x * (1.0f + erff(x * 0.70710678118654752f)); }
DEV void wave_lds_sync() { asm volatile("s_waitcnt lgkmcnt(0)" ::: "memory"); __builtin_amdgcn_wave_barrier(); asm volatile("" ::: "memory"); }
DEV float t5bias(const float* t5, int head, int dist) { int d = dist < 127 ? dist : 127; d = d < 0 ? 0 : d; return t5[(int)T5B[d] * 8 + head]; }


namespace pg8 {
#define PG8_LAS __attribute__((address_space(3)))
typedef unsigned short bf16_t;
typedef short bf16x8 __attribute__((ext_vector_type(8)));
typedef float f32x4 __attribute__((ext_vector_type(4)));
typedef unsigned u32x4 __attribute__((ext_vector_type(4)));
constexpr int BM = 256, BK = 64, HALF = 128, HTB = HALF * BK * 2  , STAGE_BYTES = 8 * HTB, NXCD = 8, WGM = 8;

__host__ __device__ __forceinline__ int lds_byte(int r, int c) { const int st = (r >> 4) * 2 + (c >> 5), rr = r & 15, cc = c & 31, ob = rr * 64 + cc * 2; return st * 1024 + (ob ^ (((ob >> 9) & 1) << 5)); }
__host__ __device__ __forceinline__ void stage_rc(int b, int& R, int& C) { const int st = b / 1024, sb = b % 1024, swz = sb ^ (((sb >> 9) & 1) << 5); R = (st >> 1) * 16 + swz / 64; C = (st & 1) * 32 + (swz % 64) / 2; }
__host__ __device__ __forceinline__ int perm32(int rho) { const int n = rho >> 4, i = rho & 15; return 8 * (i >> 2) + 4 * n + (i & 3); }

struct Unit { int pm, pn; };
struct Gemm { const bf16_t* A; const bf16_t* Bt; int M, N, K;
    unsigned pitchA = 0, pitchB = 0, kstepA = 0, kstepB = 0; size_t hstepA = 0, hstepB = 0, tA_pm = 0, tA_pn = 0, tB_pn = 0; int nt = 0; };

struct StaticOrder {
    int nM, nN, nwg, G, c;
    __host__ __device__ void init(int M, int N, int G_, int c_) { nM = M / BM; nN = N / BM; nwg = nM * nN; G = G_; c = c_; }
    __host__ __device__ bool next(int i, Unit& u) const {
        const long L = (long)i * G + c; if (L >= nwg) return false;
        int wgid = (int)L; { const int q = nwg / NXCD, r = nwg % NXCD, xcd = wgid % NXCD, off = wgid / NXCD; wgid = (xcd < r ? xcd * (q + 1) : r * (q + 1) + (xcd - r) * q) + off; }
        const int nig = WGM * nN, gid = wgid / nig, fm = gid * WGM, gsz = (nM - fm) < WGM ? (nM - fm) : WGM;
        u.pm = fm + ((wgid % nig) % gsz); u.pn = (wgid % nig) / gsz; return true;
    }
    __device__ __forceinline__ void a_ready(const Unit&) const {}
    __device__ __forceinline__ void done(const Unit&) const {}
};

__device__ __forceinline__ unsigned cvt_pk_bf16(float lo, float hi) { unsigned r; asm volatile("v_cvt_pk_bf16_f32 %0, %1, %2" : "=v"(r) : "v"(lo), "v"(hi)); return r; }
typedef float f32x2 __attribute__((ext_vector_type(2)));
__device__ __forceinline__ f32x2 gelu_pk(f32x2 v) {
    const f32x2 av = __builtin_elementwise_abs(v), d = av * 0.2316418882f + 1.0f;
    f32x2 t; t.x = __builtin_amdgcn_rcpf(d.x); t.y = __builtin_amdgcn_rcpf(d.y);
    f32x2 q = t * 0.5307027145f + (-0.7265760135f); q = q * t + 0.7107068705f; q = q * t + (-0.142248368f); q = q * t + 0.127414796f; q = q * t;
    const f32x2 s = (v * v) * (-0.72134752044f);
    f32x2 e; e.x = __builtin_amdgcn_exp2f(s.x); e.y = __builtin_amdgcn_exp2f(s.y);
    const f32x2 m = v * (q * e), r = v - m;
    f32x2 o; o.x = v.x < 0.f ? m.x : r.x; o.y = v.y < 0.f ? m.y : r.y; return o;
}

template <int ACT  > struct EpiBf16 {
    static constexpr bool PERM = true, AFTER_DRAIN = false; static_assert(ACT == 0 || ACT == 1, "EpiBf16: ACT is 0 (none) or 1 (gelu_pk)");
    bf16_t* O; int ldc; const float* bias; int split_cols; size_t split_stride; float scale0;
    __device__ __forceinline__ void operator()(const f32x4 (&acc)[2][2][4][2], const Unit& u, int wr, int wc, int fr, int fq) const {
        const int row0 = u.pm * BM + wr * 64 + fr; int colt = u.pn * BM; bf16_t* base = O;
        float sc = 1.f; if (split_cols) { const int t = colt / split_cols; base += (size_t)t * split_stride; colt -= t * split_cols; if (t == 0) sc = scale0; }
        const int col0 = colt + wc * 32 + 8 * fq, bcol0 = u.pn * BM + wc * 32 + 8 * fq;
        f32x4 bv[2][2];
#pragma unroll
        for (int bj = 0; bj < 2; ++bj)
#pragma unroll
            for (int n = 0; n < 2; ++n) bv[bj][n] = bias ? *(const f32x4*)(bias + bcol0 + bj * HALF + 4 * n) : (f32x4){0.f, 0.f, 0.f, 0.f};
#pragma unroll
        for (int ai = 0; ai < 2; ++ai)
#pragma unroll
            for (int m = 0; m < 4; ++m) { bf16_t* rowp = base + (size_t)(row0 + ai * HALF + m * 16) * ldc + col0;
#pragma unroll
                for (int bj = 0; bj < 2; ++bj) { f32x4 v0 = acc[ai][bj][m][0] + bv[bj][0], v1 = acc[ai][bj][m][1] + bv[bj][1];
                    if (ACT == 1) { f32x2 a = gelu_pk((f32x2){v0[0], v0[1]}), b = gelu_pk((f32x2){v0[2], v0[3]}), c = gelu_pk((f32x2){v1[0], v1[1]}), d = gelu_pk((f32x2){v1[2], v1[3]});
                        v0 = (f32x4){a.x, a.y, b.x, b.y}; v1 = (f32x4){c.x, c.y, d.x, d.y}; }
                    v0 = v0 * sc; v1 = v1 * sc; u32x4 w; w.x = cvt_pk_bf16(v0[0], v0[1]); w.y = cvt_pk_bf16(v0[2], v0[3]); w.z = cvt_pk_bf16(v1[0], v1[1]); w.w = cvt_pk_bf16(v1[2], v1[3]);
                    *(u32x4*)(rowp + bj * HALF) = w; } }
    }
};

struct PanelStats {
    unsigned* xbuf;
    unsigned* cnt;
    unsigned* tmo;
    int ntn; float eps;
    unsigned code;
    __device__ __forceinline__ bool run(const f32x4 (&v)[2][2][4][2], const Unit& u, int wr, int wc, int fr, int fq, PG8_LAS unsigned char* lds, int wid, int lane) const {
        typedef float f32x2v __attribute__((ext_vector_type(2)));
        PG8_LAS f32x2v* P = (PG8_LAS f32x2v*)lds;
        PG8_LAS f32x2v* S = (PG8_LAS f32x2v*)(lds + 8192);
        PG8_LAS unsigned* flag = (PG8_LAS unsigned*)(lds + 8192 + 2048);
#pragma unroll
        for (int ai = 0; ai < 2; ++ai)
#pragma unroll
            for (int m = 0; m < 4; ++m) {
                float s = 0.f;
#pragma unroll
                for (int bj = 0; bj < 2; ++bj)
#pragma unroll
                    for (int n = 0; n < 2; ++n) { const f32x4 x = v[ai][bj][m][n]; s += (x[0] + x[1]) + (x[2] + x[3]); }
                s += __shfl_xor(s, 16); s += __shfl_xor(s, 32);
                const float mw = s * (1.0f / 64.0f); float q = 0.f;
#pragma unroll
                for (int bj = 0; bj < 2; ++bj)
#pragma unroll
                    for (int n = 0; n < 2; ++n) { const f32x4 d = v[ai][bj][m][n] - mw; q += (d[0] * d[0] + d[1] * d[1]) + (d[2] * d[2] + d[3] * d[3]); }
                q += __shfl_xor(q, 16); q += __shfl_xor(q, 32);
                if (fq == 0) P[(ai * HALF + wr * 64 + m * 16 + fr) * 4 + wc] = (f32x2v){mw, q};
            }
        asm volatile("s_waitcnt lgkmcnt(0)" ::: "memory"); __builtin_amdgcn_s_barrier(); asm volatile("" ::: "memory");
#if defined(BROKEN_EXCHANGE_NO_WAIT)
#warning BROKEN CONTROL BUILD: the row-statistics exchange does not wait; results are wrong by design
        if (blockIdx.x >= 64) { const long long t0_ = clock64(); while (clock64() - t0_ < 60000) __builtin_amdgcn_s_sleep(8); }
#endif
        const int row = wid * 32 + (lane & 31);
        if (lane < 32) {
            const f32x2v a = P[row * 4 + 0], b = P[row * 4 + 1], c = P[row * 4 + 2], d = P[row * 4 + 3];
            const float mt = (a.x + b.x + c.x + d.x) * 0.25f;
            const float da = a.x - mt, db = b.x - mt, dc = c.x - mt, dd = d.x - mt;
            const float m2 = (a.y + b.y) + (c.y + d.y) + 64.0f * ((da * da + db * db) + (dc * dc + dd * dd));
            unsigned long long* slot = (unsigned long long*)xbuf + ((size_t)(u.pm * BM + row) * 4 + u.pn);
            __hip_atomic_store(slot, ((unsigned long long)__float_as_uint(m2) << 32) | __float_as_uint(mt), __ATOMIC_RELAXED, __HIP_MEMORY_SCOPE_AGENT);
        }
        asm volatile("s_waitcnt vmcnt(0)" ::: "memory");
        if (lane == 0) __hip_atomic_fetch_add(cnt + 64 * u.pm, 1u, __ATOMIC_RELAXED, __HIP_MEMORY_SCOPE_AGENT);
        if (wid == 0) {
            bool dead = false; const unsigned long long t0 = __builtin_amdgcn_s_memrealtime(); const unsigned want = 8u * (unsigned)ntn;
            for (;;) {
#if defined(BROKEN_EXCHANGE_NO_WAIT)
                break;
#endif
                if ((unsigned)__builtin_amdgcn_readfirstlane(__hip_atomic_load(cnt + 64 * u.pm, __ATOMIC_RELAXED, __HIP_MEMORY_SCOPE_AGENT)) >= want) break;
                if (__builtin_amdgcn_s_memrealtime() - t0 > 2000000ull) {
                    if (lane == 0) { unsigned expect = 0u; __hip_atomic_compare_exchange_strong(tmo + 1, &expect, code | (unsigned)(u.pm & 0xff), __ATOMIC_RELAXED, __ATOMIC_RELAXED, __HIP_MEMORY_SCOPE_AGENT);
                                     __hip_atomic_store(tmo, 1u, __ATOMIC_RELAXED, __HIP_MEMORY_SCOPE_AGENT); }
                    dead = true; break; }
                __builtin_amdgcn_s_sleep(2);
            }
            __builtin_amdgcn_fence(__ATOMIC_ACQUIRE, "agent");
            if (lane == 0) flag[0] = dead ? 1u : 0u;
        }
        asm volatile("s_waitcnt vmcnt(0) lgkmcnt(0)" ::: "memory"); __builtin_amdgcn_s_barrier(); asm volatile("" ::: "memory");
        const bool bad = flag[0] != 0u;
        if (lane < 32) {
            const unsigned long long* slot = (const unsigned long long*)xbuf + (size_t)(u.pm * BM + row) * 4; float mt[4], m2[4]; float ms = 0.f;
#pragma unroll
            for (int t = 0; t < 4; ++t) { if (t < ntn) { const unsigned long long w = __hip_atomic_load(slot + t, __ATOMIC_RELAXED, __HIP_MEMORY_SCOPE_AGENT); mt[t] = __uint_as_float((unsigned)w); m2[t] = __uint_as_float((unsigned)(w >> 32)); } else { mt[t] = 0.f; m2[t] = 0.f; } ms += mt[t]; }
            const float mean = ms / (float)ntn; float q = 0.f;
#pragma unroll
            for (int t = 0; t < 4; ++t) if (t < ntn) { const float dm = mt[t] - mean; q += m2[t] + 256.0f * dm * dm; }
            S[row] = (f32x2v){mean, 1.0f / sqrtf(q / (256.0f * (float)ntn) + eps)};
        }
        asm volatile("s_waitcnt lgkmcnt(0)" ::: "memory"); __builtin_amdgcn_s_barrier(); asm volatile("" ::: "memory");
        return bad;
    }
};
struct EpiLnRes {
    static constexpr bool PERM = false, AFTER_DRAIN = true;
    const float* base; float* out; int ldc; const float* bias; PanelStats st; unsigned poison;
    __device__ __forceinline__ void fused(f32x4 (&acc)[2][2][4][2], const Unit& u, int wr, int wc, int fr, int fq, PG8_LAS unsigned char* lds, int wid, int lane) const {
        typedef float f32x2v __attribute__((ext_vector_type(2)));
        const PG8_LAS f32x2v* S = (const PG8_LAS f32x2v*)(lds + 8192);
        const int col0 = u.pn * BM + wc * 32 + 4 * fq;
#pragma unroll
        for (int bj = 0; bj < 2; ++bj)
#pragma unroll
            for (int n = 0; n < 2; ++n) { const f32x4 bv = bias ? *(const f32x4*)(bias + col0 + bj * HALF + n * 16) : (f32x4){0.f, 0.f, 0.f, 0.f};
#pragma unroll
                for (int ai = 0; ai < 2; ++ai)
#pragma unroll
                    for (int m = 0; m < 4; ++m) acc[ai][bj][m][n] += bv; }
        f32x4 pre[4][2][2];
#pragma unroll
        for (int m = 0; m < 4; ++m) { const size_t off = (size_t)(u.pm * BM + wr * 64 + m * 16 + fr) * ldc + col0;
#pragma unroll
            for (int bj = 0; bj < 2; ++bj)
#pragma unroll
                for (int n = 0; n < 2; ++n) pre[m][bj][n] = *(const f32x4*)(base + off + bj * HALF + n * 16); }
        const bool bad = st.run(acc, u, wr, wc, fr, fq, lds, wid, lane) || poison != 0u;
        const float qnan = __builtin_nanf("");
#pragma unroll
        for (int ai = 0; ai < 2; ++ai)
#pragma unroll
            for (int m = 0; m < 4; ++m) { const int r = ai * HALF + wr * 64 + m * 16 + fr; const f32x2v sr = S[r]; const size_t off = (size_t)(u.pm * BM + r) * ldc + col0;
#pragma unroll
                for (int bj = 0; bj < 2; ++bj)
#pragma unroll
                    for (int n = 0; n < 2; ++n) { const f32x4 bs = ai == 0 ? pre[m][bj][n] : *(const f32x4*)(base + off + bj * HALF + n * 16); f32x4 o = bs + (acc[ai][bj][m][n] - sr.x) * sr.y;
                        if (bad) o = (f32x4){qnan, qnan, qnan, qnan}; *(f32x4*)(out + off + bj * HALF + n * 16) = o; }
                if (m & 1) asm volatile("" ::: "memory"); }
    }
};
struct EpiLnResLn {
    static constexpr bool PERM = false, AFTER_DRAIN = true;
    const float* base; float* out; bf16_t* xn; int ldc; const float* bias; PanelStats st1, st2; unsigned poison;
    __device__ __forceinline__ void fused(f32x4 (&acc)[2][2][4][2], const Unit& u, int wr, int wc, int fr, int fq, PG8_LAS unsigned char* lds, int wid, int lane) const {
        typedef float f32x2v __attribute__((ext_vector_type(2))); typedef unsigned u32x2v __attribute__((ext_vector_type(2)));
        const PG8_LAS f32x2v* S = (const PG8_LAS f32x2v*)(lds + 8192);
        const int col0 = u.pn * BM + wc * 32 + 4 * fq;
#pragma unroll
        for (int bj = 0; bj < 2; ++bj)
#pragma unroll
            for (int n = 0; n < 2; ++n) { const f32x4 bv = bias ? *(const f32x4*)(bias + col0 + bj * HALF + n * 16) : (f32x4){0.f, 0.f, 0.f, 0.f};
#pragma unroll
                for (int ai = 0; ai < 2; ++ai)
#pragma unroll
                    for (int m = 0; m < 4; ++m) acc[ai][bj][m][n] += bv; }
        bool bad = st1.run(acc, u, wr, wc, fr, fq, lds, wid, lane) || poison != 0u;
        const float qnan = __builtin_nanf("");
#pragma unroll
        for (int ai = 0; ai < 2; ++ai)
#pragma unroll
            for (int m = 0; m < 4; ++m) { const int r = ai * HALF + wr * 64 + m * 16 + fr; const f32x2v sr = S[r]; const size_t off = (size_t)(u.pm * BM + r) * ldc + col0;
#pragma unroll
                for (int bj = 0; bj < 2; ++bj)
#pragma unroll
                    for (int n = 0; n < 2; ++n) { const f32x4 bs = *(const f32x4*)(base + off + bj * HALF + n * 16); acc[ai][bj][m][n] = bs + (acc[ai][bj][m][n] - sr.x) * sr.y; }
                asm volatile("" : "+v"(acc[ai][0][m][0]), "+v"(acc[ai][0][m][1]), "+v"(acc[ai][1][m][0]), "+v"(acc[ai][1][m][1]));
                if (m & 1) asm volatile("" ::: "memory"); }
        const bool bad1 = bad;
        bad = st2.run(acc, u, wr, wc, fr, fq, lds, wid, lane) || bad;
#pragma unroll
        for (int ai = 0; ai < 2; ++ai)
#pragma unroll
            for (int m = 0; m < 4; ++m) { const int r = ai * HALF + wr * 64 + m * 16 + fr; const f32x2v sr = S[r]; const size_t off = (size_t)(u.pm * BM + r) * ldc + col0;
#pragma unroll
                for (int bj = 0; bj < 2; ++bj)
#pragma unroll
                    for (int n = 0; n < 2; ++n) { const f32x4 x1 = acc[ai][bj][m][n]; *(f32x4*)(out + off + bj * HALF + n * 16) = bad1 ? (f32x4){qnan, qnan, qnan, qnan} : x1;
                        const f32x4 o = (x1 - sr.x) * sr.y; u32x2v w; w.x = cvt_pk_bf16(o[0], o[1]); w.y = cvt_pk_bf16(o[2], o[3]);
                        if (bad) { w.x = 0x7fc07fc0u; w.y = 0x7fc07fc0u; } *(u32x2v*)(xn + off + bj * HALF + n * 16) = w; }
                asm volatile("" ::: "memory"); }
    }
};

template <class Epi, class Sched, bool ALIGN_EPI = false, bool SP2 = false>
__device__ __forceinline__ void gemm_phase(PG8_LAS unsigned char* lds, const Gemm g, const Sched& S, const Epi& E) {
    int tid = threadIdx.x; asm volatile("" : "+v"(tid));
    const int wid = __builtin_amdgcn_readfirstlane(tid >> 6), lane = tid & 63, wr = wid >> 2, wc = wid & 3, fr = lane & 15, fq = lane >> 4;
    int K = g.K; asm volatile("" : "+s"(K)); const int nt = g.nt ? g.nt : K / BK;
    const unsigned pitchA = g.pitchA ? g.pitchA : (unsigned)K * 2u, pitchB = g.pitchB ? g.pitchB : (unsigned)K * 2u;
    unsigned voffA[2], voffB[2];
#pragma unroll
    for (int i = 0; i < 2; ++i) { int R, C; stage_rc(tid * 16 + i * 8192, R, C); const int Rb = Epi::PERM ? ((R & ~31) + perm32(R & 31)) : R;
        voffA[i] = (unsigned)R * pitchA + (unsigned)C * 2u; voffB[i] = (unsigned)Rb * pitchB + (unsigned)C * 2u; }
    const size_t kstepA = g.kstepA ? g.kstepA : (size_t)(BK * 2), kstepB = g.kstepB ? g.kstepB : (size_t)(BK * 2);
    const size_t hstepA = g.hstepA ? g.hstepA : (size_t)HALF * K * 2, hstepB = g.hstepB ? g.hstepB : (size_t)HALF * K * 2;
    const size_t tA_pm = g.tA_pm ? g.tA_pm : (size_t)BM * K * 2, tA_pn = g.tA_pn, tB_pn = g.tB_pn ? g.tB_pn : (size_t)BM * K * 2;
    const unsigned ldsw = (unsigned)wid * 1024u;
    const int aoff = lds_byte(wr * 64 + fr, fq * 8), boff = lds_byte(wc * 32 + fr, fq * 8);
#define PG8_SA(b, h) (((b) * 2 + (h)) * HTB)
#define PG8_SB(b, h) ((4 + (b) * 2 + (h)) * HTB)
#define PG8_STAGE(bufoff, gbase, voff) do { _Pragma("unroll") for (int _i = 0; _i < 2; ++_i) \
        __builtin_amdgcn_global_load_lds((const unsigned*)((const char*)(gbase) + (voff)[_i]), (PG8_LAS unsigned*)(lds + (bufoff) + ldsw + _i * 8192), 16, 0, 0); } while (0)
#define PG8_LDA(dst, b, h) do { _Pragma("unroll") for (int m = 0; m < 4; ++m) _Pragma("unroll") for (int k = 0; k < 2; ++k) dst[m][k] = *(const PG8_LAS bf16x8*)(lds + PG8_SA(b, h) + aoff + m * 2048 + k * 1024); } while (0)
#define PG8_LDB(dst, b, h) do { _Pragma("unroll") for (int n = 0; n < 2; ++n) _Pragma("unroll") for (int k = 0; k < 2; ++k) dst[n][k] = *(const PG8_LAS bf16x8*)(lds + PG8_SB(b, h) + boff + n * 2048 + k * 1024); } while (0)
#define PG8_MMA(ai, bj, At, Bt) do { __builtin_amdgcn_s_setprio(1); _Pragma("unroll") for (int m = 0; m < 4; ++m) _Pragma("unroll") for (int n = 0; n < 2; ++n) _Pragma("unroll") for (int k = 0; k < 2; ++k) \
        acc[ai][bj][m][n] = __builtin_amdgcn_mfma_f32_16x16x32_bf16(Bt[n][k], At[m][k], acc[ai][bj][m][n], 0, 0, 0); __builtin_amdgcn_s_setprio(0); } while (0)
#define PG8_WAIT_V(n) asm volatile("s_waitcnt vmcnt(" #n ")" ::: "memory")
#define PG8_WAIT_L(n) asm volatile("s_waitcnt lgkmcnt(" #n ")" ::: "memory")
#define PG8_BAR __builtin_amdgcn_s_barrier()
#define PG8_SCHED __builtin_amdgcn_sched_barrier(0)
    Unit cur, nxt; int ui = 0;
    if (!S.next(0, cur)) return;
    f32x4 acc[2][2][4][2];
#pragma unroll
    for (int a = 0; a < 2; ++a)
#pragma unroll
        for (int b = 0; b < 2; ++b)
#pragma unroll
            for (int m = 0; m < 4; ++m)
#pragma unroll
                for (int n = 0; n < 2; ++n) acc[a][b][m][n] = (f32x4){0.f, 0.f, 0.f, 0.f};
    bf16x8 At[4][2], B0[2][2], B1[2][2];
    const char* cA = (const char*)g.A + (size_t)cur.pm * tA_pm + (size_t)cur.pn * tA_pn; const char* cB = (const char*)g.Bt + (size_t)cur.pn * tB_pn;
    S.a_ready(cur);
    if constexpr (SP2) {
        PG8_STAGE(PG8_SB(0, 0), cB, voffB); PG8_STAGE(PG8_SB(0, 1), cB + hstepB, voffB); PG8_STAGE(PG8_SA(0, 0), cA, voffA); PG8_STAGE(PG8_SA(0, 1), cA + hstepA, voffA);
        if (wr == 1) PG8_BAR;
        PG8_WAIT_V(2); PG8_BAR;
        PG8_STAGE(PG8_SB(1, 0), cB + kstepB, voffB); PG8_STAGE(PG8_SA(1, 0), cA + kstepA, voffA); PG8_STAGE(PG8_SB(1, 1), cB + hstepB + kstepB, voffB);
        PG8_WAIT_V(6); PG8_BAR;
    } else {
        PG8_STAGE(PG8_SB(0, 0), cB, voffB); PG8_STAGE(PG8_SA(0, 0), cA, voffA); PG8_STAGE(PG8_SB(0, 1), cB + hstepB, voffB); PG8_STAGE(PG8_SA(0, 1), cA + hstepA, voffA);
        if (wr == 1) PG8_BAR;
        PG8_WAIT_V(4); PG8_BAR;
        PG8_STAGE(PG8_SB(1, 0), cB + kstepB, voffB); PG8_STAGE(PG8_SA(1, 0), cA + kstepA, voffA); PG8_STAGE(PG8_SB(1, 1), cB + hstepB + kstepB, voffB);
        PG8_WAIT_V(6); PG8_BAR;
    }
    for (;;) {
        const bool has_next = S.next(ui + 1, nxt);
        const char* nA = has_next ? (const char*)g.A + (size_t)nxt.pm * tA_pm + (size_t)nxt.pn * tA_pn : cA; const char* nB = has_next ? (const char*)g.Bt + (size_t)nxt.pn * tB_pn : cB;
        for (int t = 0; t < nt; t += 2) {
            const bool last = (t == nt - 2);
            const char* a1 = cA + (size_t)(t + 1) * kstepA;
            const char* a2 = last ? nA : cA + (size_t)(t + 2) * kstepA; const char* b2 = last ? nB : cB + (size_t)(t + 2) * kstepB;
            const char* a3 = a2 + kstepA; const char* b3 = b2 + kstepB;
            if (last && has_next) S.a_ready(nxt);
            if constexpr (SP2) {
            PG8_LDB(B0, 0, 0); PG8_LDB(B1, 0, 1); PG8_SCHED; PG8_LDA(At, 0, 0); PG8_STAGE(PG8_SA(1, 1), a1 + hstepA, voffA);
            PG8_WAIT_V(8); PG8_WAIT_L(0); PG8_BAR; PG8_MMA(0, 0, At, B0); PG8_MMA(0, 1, At, B1); PG8_BAR; PG8_SCHED;
            PG8_LDA(At, 0, 1); PG8_STAGE(PG8_SB(0, 0), b2, voffB); PG8_STAGE(PG8_SB(0, 1), b2 + hstepB, voffB); PG8_STAGE(PG8_SA(0, 0), a2, voffA);
            PG8_WAIT_V(8); PG8_WAIT_L(0); PG8_BAR; PG8_MMA(1, 0, At, B0); PG8_MMA(1, 1, At, B1); PG8_BAR; PG8_SCHED;
            PG8_LDB(B0, 1, 0); PG8_LDB(B1, 1, 1); PG8_SCHED; PG8_LDA(At, 1, 0); PG8_STAGE(PG8_SA(0, 1), a2 + hstepA, voffA);
            PG8_WAIT_V(8); PG8_WAIT_L(0); PG8_BAR; PG8_MMA(0, 0, At, B0); PG8_MMA(0, 1, At, B1); PG8_BAR; PG8_SCHED;
            PG8_LDA(At, 1, 1); PG8_STAGE(PG8_SB(1, 0), b3, voffB); PG8_STAGE(PG8_SB(1, 1), b3 + hstepB, voffB); PG8_STAGE(PG8_SA(1, 0), a3, voffA);
            PG8_WAIT_V(8); PG8_WAIT_L(0); PG8_BAR; PG8_MMA(1, 0, At, B0); PG8_MMA(1, 1, At, B1); PG8_BAR; PG8_SCHED;
            } else {
            PG8_LDB(B0, 0, 0); PG8_SCHED; PG8_LDA(At, 0, 0); PG8_STAGE(PG8_SA(1, 1), a1 + hstepA, voffA);
            PG8_WAIT_L(8); PG8_BAR; PG8_WAIT_L(0); PG8_MMA(0, 0, At, B0); PG8_BAR; PG8_SCHED;
            PG8_LDB(B1, 0, 1); PG8_STAGE(PG8_SB(0, 0), b2, voffB);
            PG8_BAR; PG8_WAIT_L(0); PG8_MMA(0, 1, At, B1); PG8_BAR;
            PG8_LDA(At, 0, 1); PG8_STAGE(PG8_SA(0, 0), a2, voffA);
            PG8_BAR; PG8_WAIT_L(0); PG8_MMA(1, 0, At, B0); PG8_BAR; PG8_SCHED;
            PG8_STAGE(PG8_SB(0, 1), b2 + hstepB, voffB);
            PG8_WAIT_V(6); PG8_BAR; PG8_MMA(1, 1, At, B1); PG8_BAR;
            PG8_LDB(B0, 1, 0); PG8_SCHED; PG8_LDA(At, 1, 0); PG8_STAGE(PG8_SA(0, 1), a2 + hstepA, voffA);
            PG8_WAIT_L(8); PG8_BAR; PG8_WAIT_L(0); PG8_MMA(0, 0, At, B0); PG8_BAR; PG8_SCHED;
            PG8_LDB(B1, 1, 1); PG8_STAGE(PG8_SB(1, 0), b3, voffB);
            PG8_BAR; PG8_WAIT_L(0); PG8_MMA(0, 1, At, B1); PG8_BAR;
            PG8_LDA(At, 1, 1); PG8_STAGE(PG8_SA(1, 0), a3, voffA);
            PG8_BAR; PG8_WAIT_L(0); PG8_MMA(1, 0, At, B0); PG8_BAR; PG8_SCHED;
            PG8_STAGE(PG8_SB(1, 1), b3 + hstepB, voffB);
            PG8_WAIT_V(6); PG8_BAR; PG8_MMA(1, 1, At, B1); PG8_BAR;
            }
        }
        if constexpr (ALIGN_EPI) { if (wr == 0) PG8_BAR; }
        if constexpr (!Epi::AFTER_DRAIN) { E(acc, cur, wr, wc, fr, fq); S.done(cur); }
        if (!has_next) break;
#pragma unroll
        for (int a = 0; a < 2; ++a)
#pragma unroll
            for (int b = 0; b < 2; ++b)
#pragma unroll
                for (int m = 0; m < 4; ++m)
#pragma unroll
                    for (int n = 0; n < 2; ++n) acc[a][b][m][n] = (f32x4){0.f, 0.f, 0.f, 0.f};
        cur = nxt; cA = nA; cB = nB; ++ui;
        if constexpr (ALIGN_EPI) { if (wr == 1) PG8_BAR; }
    }
    PG8_WAIT_V(0);
    if constexpr (!ALIGN_EPI) { if (wr == 0) PG8_BAR; }
    PG8_BAR;
    if constexpr (Epi::AFTER_DRAIN) { E.fused(acc, cur, wr, wc, fr, fq, lds, wid, lane); S.done(cur); }
#undef PG8_SA
#undef PG8_SB
#undef PG8_STAGE
#undef PG8_LDA
#undef PG8_LDB
#undef PG8_MMA
#undef PG8_WAIT_V
#undef PG8_WAIT_L
#undef PG8_BAR
#undef PG8_SCHED
}
}

namespace pg8 {
constexpr float LOG2E = 1.4426950408889634f;
constexpr float QS_NSA = 0.125f * LOG2E;
constexpr float QS_MLA = 0.10206207261596575f * LOG2E;
__device__ __forceinline__ float fast_sigmoid(float x) { return __builtin_amdgcn_rcpf(1.0f + __builtin_amdgcn_exp2f(-LOG2E * x)); }
__device__ __forceinline__ float lo_bf(unsigned u) { return __uint_as_float(u << 16); }
__device__ __forceinline__ float hi_bf(unsigned u) { return __uint_as_float(u & 0xffff0000u); }
struct EpiInProjF {
    static constexpr bool PERM = true, AFTER_DRAIN = false;
    bf16_t* proj; bf16_t* gates;
    __device__ __forceinline__ void operator()(const f32x4 (&acc)[2][2][4][2], const Unit& u, int wr, int wc, int fr, int fq) const {
        const bool isg = u.pn >= 7;
        bf16_t* base = isg ? gates : proj; const int ld = isg ? 2048 : 1792; const int colt = isg ? (u.pn - 7) * BM : u.pn * BM;
        const float sc = (u.pn < 2) ? QS_NSA : 1.0f;
        const int row0 = u.pm * BM + wr * 64 + fr, col0 = colt + wc * 32 + 8 * fq;
#pragma unroll
        for (int ai = 0; ai < 2; ++ai)
#pragma unroll
            for (int m = 0; m < 4; ++m) { bf16_t* rowp = base + (size_t)(row0 + ai * HALF + m * 16) * ld + col0;
#pragma unroll
                for (int bj = 0; bj < 2; ++bj) { f32x4 v0 = acc[ai][bj][m][0], v1 = acc[ai][bj][m][1];
                    if (isg) {
#pragma unroll
                        for (int e = 0; e < 4; ++e) { v0[e] = fast_sigmoid(v0[e]); v1[e] = fast_sigmoid(v1[e]); } }
                    else { v0 = v0 * sc; v1 = v1 * sc; }
                    u32x4 w; w.x = cvt_pk_bf16(v0[0], v0[1]); w.y = cvt_pk_bf16(v0[2], v0[3]); w.z = cvt_pk_bf16(v1[0], v1[1]); w.w = cvt_pk_bf16(v1[2], v1[3]);
                    *(u32x4*)(rowp + bj * HALF) = w; } }
    }
};
template <int PASS> struct EpiMergeF {
    static constexpr bool PERM = true, AFTER_DRAIN = false;
    const bf16_t* gates; bf16_t* merged;
    __device__ __forceinline__ void operator()(const f32x4 (&acc)[2][2][4][2], const Unit& u, int wr, int wc, int fr, int fq) const {
        const int row0 = u.pm * BM + wr * 64 + fr, col0 = u.pn * BM + wc * 32 + 8 * fq;
#pragma unroll
        for (int ai = 0; ai < 2; ++ai)
#pragma unroll
            for (int m = 0; m < 4; ++m) { const size_t r = (size_t)(row0 + ai * HALF + m * 16);
#pragma unroll
                for (int bj = 0; bj < 2; ++bj) { const int c = col0 + bj * HALF;
                    const u32x4 g = *(const u32x4*)(gates + r * 2048 + PASS * 1024 + c);
                    f32x4 v0 = acc[ai][bj][m][0], v1 = acc[ai][bj][m][1];
                    v0[0] *= lo_bf(g.x); v0[1] *= hi_bf(g.x); v0[2] *= lo_bf(g.y); v0[3] *= hi_bf(g.y);
                    v1[0] *= lo_bf(g.z); v1[1] *= hi_bf(g.z); v1[2] *= lo_bf(g.w); v1[3] *= hi_bf(g.w);
                    if (PASS == 1) { const u32x4 o = *(const u32x4*)(merged + r * 1024 + c);
                        v0[0] += lo_bf(o.x); v0[1] += hi_bf(o.x); v0[2] += lo_bf(o.y); v0[3] += hi_bf(o.y);
                        v1[0] += lo_bf(o.z); v1[1] += hi_bf(o.z); v1[2] += lo_bf(o.w); v1[3] += hi_bf(o.w); }
                    u32x4 w; w.x = cvt_pk_bf16(v0[0], v0[1]); w.y = cvt_pk_bf16(v0[2], v0[3]); w.z = cvt_pk_bf16(v1[0], v1[1]); w.w = cvt_pk_bf16(v1[2], v1[3]);
                    *(u32x4*)(merged + r * 1024 + c) = w; } }
    }
};
struct EpiCmpOutF {
    static constexpr bool PERM = true, AFTER_DRAIN = false;
    bf16_t* dst;
    __device__ __forceinline__ void operator()(const f32x4 (&acc)[2][2][4][2], const Unit& u, int wr, int wc, int fr, int fq) const {
        if (wc >= 2) return;
        const int row0 = u.pm * BM + wr * 64 + fr, col0 = wc * 32 + 8 * fq;
#pragma unroll
        for (int ai = 0; ai < 2; ++ai)
#pragma unroll
            for (int m = 0; m < 4; ++m) { const int r = row0 + ai * HALF + m * 16;
                if (r < BATCH * NC * 2) { const int g = r & 1, bc = r >> 1, b = bc / NC, c = bc % NC;
                    const f32x4 v0 = acc[ai][0][m][0], v1 = acc[ai][0][m][1];
                    u32x4 w; w.x = cvt_pk_bf16(v0[0], v0[1]); w.y = cvt_pk_bf16(v0[2], v0[3]); w.z = cvt_pk_bf16(v1[0], v1[1]); w.w = cvt_pk_bf16(v1[2], v1[3]);
                    *(u32x4*)(dst + ((size_t)(b * 2 + g) * 128 + c) * 64 + col0) = w; } }
    }
};
struct EpiSlabF {
    static constexpr bool PERM = false, AFTER_DRAIN = false;
    float* slab;
    __device__ __forceinline__ void operator()(const f32x4 (&acc)[2][2][4][2], const Unit& u, int wr, int wc, int fr, int fq) const {
        const int row0 = u.pm * BM + wr * 64 + fr, col0 = wc * 32 + 4 * fq;
        float* base = slab + (size_t)u.pn * 2048 * 256;
#pragma unroll
        for (int ai = 0; ai < 2; ++ai)
#pragma unroll
            for (int m = 0; m < 4; ++m) { float* rowp = base + (size_t)(row0 + ai * HALF + m * 16) * 256 + col0;
#pragma unroll
                for (int bj = 0; bj < 2; ++bj)
#pragma unroll
                    for (int n = 0; n < 2; ++n) *(f32x4*)(rowp + bj * HALF + n * 16) = acc[ai][bj][m][n]; }
    }
};
struct EpiResidF {
    static constexpr bool PERM = false, AFTER_DRAIN = false;
    const float* x; float* h;
    __device__ __forceinline__ void operator()(const f32x4 (&acc)[2][2][4][2], const Unit& u, int wr, int wc, int fr, int fq) const {
        const int row0 = u.pm * BM + wr * 64 + fr, col0 = u.pn * BM + wc * 32 + 4 * fq;
#pragma unroll
        for (int ai = 0; ai < 2; ++ai)
#pragma unroll
            for (int m = 0; m < 4; ++m) { const size_t off = (size_t)(row0 + ai * HALF + m * 16) * 1024 + col0;
#pragma unroll
                for (int bj = 0; bj < 2; ++bj)
#pragma unroll
                    for (int n = 0; n < 2; ++n) { const f32x4 xv = *(const f32x4*)(x + off + bj * HALF + n * 16); *(f32x4*)(h + off + bj * HALF + n * 16) = xv + acc[ai][bj][m][n]; } }
    }
};
struct EpiMlaQF {
    static constexpr bool PERM = false, AFTER_DRAIN = false;
    bf16_t* q; const float2* cs;
    __device__ __forceinline__ void operator()(const f32x4 (&acc)[2][2][4][2], const Unit& u, int wr, int wc, int fr, int fq) const {
        const int row0 = u.pm * BM + wr * 64 + fr;
#pragma unroll
        for (int bj = 0; bj < 2; ++bj) {
            const int X = u.pn * BM + bj * HALF + wc * 32;
            const bool rope = (X % 96) == 64;
#pragma unroll
            for (int ai = 0; ai < 2; ++ai)
#pragma unroll
                for (int m = 0; m < 4; ++m) { const int r = row0 + ai * HALF + m * 16; const int pos = r & (SEQ - 1);
                    f32x4 v0 = acc[ai][bj][m][0], v1 = acc[ai][bj][m][1];
                    if (rope) {
#pragma unroll
                        for (int j = 0; j < 4; ++j) { const float2 c = cs[pos * 16 + 4 * fq + j]; const float x1 = v0[j], x2 = v1[j]; v0[j] = x1 * c.x - x2 * c.y; v1[j] = x2 * c.x + x1 * c.y; } }
                    v0 = v0 * QS_MLA; v1 = v1 * QS_MLA;
                    bf16_t* p = q + (size_t)r * 768 + X + 4 * fq;
                    uint2 w0, w1; w0.x = cvt_pk_bf16(v0[0], v0[1]); w0.y = cvt_pk_bf16(v0[2], v0[3]); w1.x = cvt_pk_bf16(v1[0], v1[1]); w1.y = cvt_pk_bf16(v1[2], v1[3]);
                    *(uint2*)p = w0; *(uint2*)(p + 16) = w1; }
        }
    }
};
}

#define PG8_SP2 true
#define PG8_ALIGN true
constexpr int NTHR = 512, NWV = NTHR / 64;
#define WAVE_IDS const int lane = threadIdx.x & 63, wv = threadIdx.x >> 6; const int gw = blockIdx.x * NWV + wv, nw = gridDim.x * NWV; (void)lane; (void)gw; (void)nw;

template <bool Q8> DEV void ph_rms1024(const float* __restrict__ src, const float* __restrict__ g, bf16_t* __restrict__ dst, int rows, unsigned* __restrict__ q8 = nullptr, float* __restrict__ qs = nullptr, int gw_o = -1, int nw_o = 0) {
  const int lane = threadIdx.x & 63; const int gw = (gw_o >= 0) ? gw_o : (int)(blockIdx.x * NWV + (threadIdx.x >> 6)); const int nw = (gw_o >= 0) ? nw_o : (int)(gridDim.x * NWV);
  float4 gg[4];
#pragma unroll
  for (int j = 0; j < 4; ++j) gg[j] = ((const float4*)g)[j * 64 + lane];
  float4 nx[4];
  if (gw < rows) {
#pragma unroll
    for (int j = 0; j < 4; ++j) nx[j] = ((const float4*)(src + (size_t)gw * 1024))[j * 64 + lane]; }
  for (int r = gw; r < rows; r += nw) {
    float4 v[4]; float ss = 0.f;
#pragma unroll
    for (int j = 0; j < 4; ++j) { v[j] = nx[j]; ss += v[j].x * v[j].x + v[j].y * v[j].y + v[j].z * v[j].z + v[j].w * v[j].w; }
    if (r + nw < rows) {
#pragma unroll
      for (int j = 0; j < 4; ++j) nx[j] = ((const float4*)(src + (size_t)(r + nw) * 1024))[j * 64 + lane]; }
    ss = wsum(ss);
    const float inv = rsqrtf(ss * (1.0f / 1024.0f) + 1e-6f);
    float mx = 0.f;
#pragma unroll
    for (int j = 0; j < 4; ++j) {
      v[j].x *= inv * gg[j].x; v[j].y *= inv * gg[j].y; v[j].z *= inv * gg[j].z; v[j].w *= inv * gg[j].w;
      uint2 o;
      o.x = (unsigned)f2bf(v[j].x) | ((unsigned)f2bf(v[j].y) << 16);
      o.y = (unsigned)f2bf(v[j].z) | ((unsigned)f2bf(v[j].w) << 16);
      ((uint2*)(dst + (size_t)r * 1024))[j * 64 + lane] = o;
      if (Q8) mx = fmaxf(mx, fmaxf(fmaxf(fabsf(v[j].x), fabsf(v[j].y)), fmaxf(fabsf(v[j].z), fabsf(v[j].w))));
    }
    if (Q8) {
      mx = wmaxf(mx);
      const float sc = fmaxf(mx, 1e-30f) * (1.0f / 127.0f), isc = 1.0f / sc;
#pragma unroll
      for (int j = 0; j < 4; ++j) {
        const int q0 = (int)rintf(v[j].x * isc), q1 = (int)rintf(v[j].y * isc), q2 = (int)rintf(v[j].z * isc), q3 = (int)rintf(v[j].w * isc);
        q8[(size_t)r * 256 + j * 64 + lane] = (unsigned)(q0 & 255) | ((unsigned)(q1 & 255) << 8) | ((unsigned)(q2 & 255) << 16) | ((unsigned)(q3 & 255) << 24);
      }
      if (lane == 0) qs[r] = sc;
    }
  }
}
template <int PER> DEV void ph_rms_cols(const bf16_t* __restrict__ proj, int col0, const float* __restrict__ g, bf16_t* __restrict__ dst) {
  WAVE_IDS
  constexpr int W = 64 * PER;
  for (int r = gw; r < T; r += nw) {
    float v[PER]; float ss = 0.f;
#pragma unroll
    for (int j = 0; j < PER; ++j) { v[j] = bf2f(proj[(size_t)r * PROJ_LD + col0 + j * 64 + lane]); ss += v[j] * v[j]; }
    ss = wsum(ss);
    const float inv = rsqrtf(ss * (1.0f / W) + 1e-6f);
#pragma unroll
    for (int j = 0; j < PER; ++j) dst[(size_t)r * W + j * 64 + lane] = f2bf(v[j] * inv * g[j * 64 + lane]);
  }
}

DEV int win_src_col(int n) {
  if (n < 1280) return n;
  if (n < 1536) return 1304 + (n - 1280);
  if (n < 1664) return 1560 + (n - 1536);
  if (n < 1696) return 1688 + (n - 1664);
  if (n < 1720) return 1280 + (n - 1696);
  if (n < 1792) return -1;
  return 1720 + (n - 1792);
}
template <int MODE> DEV void tr_item(const float* __restrict__ W, int K, int Nsrc, bf16_t* __restrict__ WT, int Nblk, int Nvalid, __attribute__((address_space(3))) float* scr, int item, int lane) {
  const int kb = item / Nblk, nb = item % Nblk, k0 = 64 * kb, n0 = 32 * nb;
  const int n = n0 + (lane & 31);
  const int sc = (MODE == 1) ? win_src_col(n) : ((n < Nvalid) ? n : -1);
  float tv[32];
#pragma unroll
  for (int i = 0; i < 32; ++i) { const int kk = 2 * i + (lane >> 5); tv[i] = (sc >= 0) ? W[(size_t)(k0 + kk) * Nsrc + sc] : 0.f; }
#pragma unroll
  for (int i = 0; i < 32; ++i) { const int kk = 2 * i + (lane >> 5); scr[kk * 33 + (lane & 31)] = tv[i]; }
  asm volatile("s_waitcnt lgkmcnt(0)" ::: "memory");
  const int c = lane & 7;
#pragma unroll
  for (int j = 0; j < 4; ++j) { const int nn = (lane >> 3) + 8 * j; const __attribute__((address_space(3))) float* sp = scr + (8 * c) * 33 + nn;
    uint4 o;
    o.x = (unsigned)f2bf(sp[0 * 33]) | ((unsigned)f2bf(sp[1 * 33]) << 16); o.y = (unsigned)f2bf(sp[2 * 33]) | ((unsigned)f2bf(sp[3 * 33]) << 16);
    o.z = (unsigned)f2bf(sp[4 * 33]) | ((unsigned)f2bf(sp[5 * 33]) << 16); o.w = (unsigned)f2bf(sp[6 * 33]) | ((unsigned)f2bf(sp[7 * 33]) << 16);
    *(uint4*)(WT + (size_t)(n0 + nn) * K + k0 + 8 * c) = o; }
  asm volatile("s_waitcnt lgkmcnt(0)" ::: "memory");
}
DEV void ph_conv_plain(const float* __restrict__ src, bf16_t* __restrict__ dst, int n) {
  for (int i = blockIdx.x * NTHR + threadIdx.x; i < n; i += gridDim.x * NTHR) dst[i] = f2bf(src[i]);
}

DEV void gemm_tile(const bf16_t* __restrict__ A, int lda, const bf16_t* __restrict__ Bt, int ldb, int m0, int n0, int K, float (&acc)[4][4], char* lds) {
  float (*sA)[132] = (float (*)[132])lds;
  float (*sB)[68] = (float (*)[68])(lds + 32 * 132 * 4);
  const int tid = threadIdx.x, ty = tid >> 4, tx = tid & 15;
  const int lr = tid >> 2, lk = (tid & 3) * 8;
  for (int k0 = 0; k0 < K; k0 += 32) {
    {
      const uint4 va = *(const uint4*)(A + (size_t)(m0 + lr) * lda + k0 + lk);
      const unsigned ua[4] = {va.x, va.y, va.z, va.w};
#pragma unroll
      for (int j = 0; j < 4; ++j) { sA[lk + 2 * j][lr] = __uint_as_float(ua[j] << 16); sA[lk + 2 * j + 1][lr] = __uint_as_float(ua[j] & 0xffff0000u); }
    }
    if (tid < 256) {
      const uint4 vb = *(const uint4*)(Bt + (size_t)(n0 + lr) * ldb + k0 + lk);
      const unsigned ub[4] = {vb.x, vb.y, vb.z, vb.w};
#pragma unroll
      for (int j = 0; j < 4; ++j) { sB[lk + 2 * j][lr] = __uint_as_float(ub[j] << 16); sB[lk + 2 * j + 1][lr] = __uint_as_float(ub[j] & 0xffff0000u); }
    }
    __syncthreads();
#pragma unroll 8
    for (int k = 0; k < 32; ++k) {
      const float4 a = *(const float4*)&sA[k][ty * 4];
      const float4 b = *(const float4*)&sB[k][tx * 4];
      const float av[4] = {a.x, a.y, a.z, a.w}, bv[4] = {b.x, b.y, b.z, b.w};
#pragma unroll
      for (int i = 0; i < 4; ++i)
#pragma unroll
        for (int j = 0; j < 4; ++j) acc[i][j] += av[i] * bv[j];
    }
    __syncthreads();
  }
}
struct EpiInProj { bf16_t* proj; bf16_t* gates;
  DEV void operator()(int m, int n, float v) const { if (n < PROJ_LD) proj[(size_t)m * PROJ_LD + n] = f2bf(v); else gates[(size_t)m * 2048 + (n - PROJ_LD)] = f2bf(sigmoidf_(v)); } };
struct EpiStore { bf16_t* dst; int ld;
  DEV void operator()(int m, int n, float v) const { dst[(size_t)m * ld + n] = f2bf(v); } };
struct EpiGelu { bf16_t* dst; int ld;
  DEV void operator()(int m, int n, float v) const { dst[(size_t)m * ld + n] = f2bf(gelu_exact(v)); } };
struct EpiCmpOut { bf16_t* dst;
  DEV void operator()(int m, int n, float v) const { if (m >= BATCH * NC * 2) return; const int g = m & 1, bc = m >> 1, b = bc / NC, c = bc % NC; dst[((size_t)(b * 2 + g) * 128 + c) * 64 + n] = f2bf(v); } };
struct EpiResid { const float* x; float* h;
  DEV void operator()(int m, int n, float v) const { const size_t i = (size_t)m * 1024 + n; h[i] = x[i] + v; } };

template <class Epi> DEV void ph_gemm(const bf16_t* A, int lda, const bf16_t* Bt, int ldb, int M, int N, int K, const Epi& epi, char* lds) {
  const int ntn = N / 64, ntm = M / 128;
  const int ty = threadIdx.x >> 4, tx = threadIdx.x & 15;
  for (int tile = blockIdx.x; tile < ntn * ntm; tile += gridDim.x) {
    const int m0 = (tile / ntn) * 128, n0 = (tile % ntn) * 64;
    float acc[4][4];
#pragma unroll
    for (int i = 0; i < 4; ++i)
#pragma unroll
      for (int j = 0; j < 4; ++j) acc[i][j] = 0.f;
    gemm_tile(A, lda, Bt, ldb, m0, n0, K, acc, lds);
#pragma unroll
    for (int i = 0; i < 4; ++i)
#pragma unroll
      for (int j = 0; j < 4; ++j) epi(m0 + ty * 4 + i, n0 + tx * 4 + j, acc[i][j]);
  }
}
DEV void ph_merge(const bf16_t* onsa, const bf16_t* omla, const bf16_t* wbn, const bf16_t* wbm, const bf16_t* gates, bf16_t* merged, char* lds) {
  const int ntn = 1024 / 64, ntm = T / 128;
  const int ty = threadIdx.x >> 4, tx = threadIdx.x & 15;
  for (int tile = blockIdx.x; tile < ntn * ntm; tile += gridDim.x) {
    const int m0 = (tile / ntn) * 128, n0 = (tile % ntn) * 64;
    float a1[4][4], a2[4][4];
#pragma unroll
    for (int i = 0; i < 4; ++i)
#pragma unroll
      for (int j = 0; j < 4; ++j) { a1[i][j] = 0.f; a2[i][j] = 0.f; }
    gemm_tile(onsa, 512, wbn, 512, m0, n0, 512, a1, lds);
    gemm_tile(omla, 512, wbm, 512, m0, n0, 512, a2, lds);
#pragma unroll
    for (int i = 0; i < 4; ++i)
#pragma unroll
      for (int j = 0; j < 4; ++j) {
        const int m = m0 + ty * 4 + i, n = n0 + tx * 4 + j;
        merged[(size_t)m * 1024 + n] = f2bf(bf2f(gates[(size_t)m * 2048 + n]) * a1[i][j] + bf2f(gates[(size_t)m * 2048 + 1024 + n]) * a2[i][j]);
      }
  }
}

DEV void rope_entry(float2* __restrict__ cs, int i) {
  const int j = i & 15, pos = i >> 4;
  const float inv_freq = __builtin_amdgcn_exp2f(-(float)(2 * j) * (13.287712379549449f / 32.0f));
  const float rev = (float)pos * inv_freq * 0.15915494309189535f;
  const float fr = rev - floorf(rev);
  cs[i] = make_float2(__builtin_amdgcn_cosf(fr), __builtin_amdgcn_sinf(fr));
}
DEV void ph_rope_table(float2* __restrict__ cs) {
  const int n = SEQ * 16;
  for (int i = blockIdx.x * NTHR + threadIdx.x; i < n; i += gridDim.x * NTHR) {
    const int j = i & 15, pos = i >> 4;
    const float inv_freq = __builtin_amdgcn_exp2f(-(float)(2 * j) * (13.287712379549449f / 32.0f));
    const float rev = (float)pos * inv_freq * 0.15915494309189535f;
    const float fr = rev - floorf(rev);
    cs[i] = make_float2(__builtin_amdgcn_cosf(fr), __builtin_amdgcn_sinf(fr));
  }
}
DEV void ph_rope_k(const bf16_t* __restrict__ proj, bf16_t* __restrict__ kr) {
  const int n = T * 16;
  for (int i = blockIdx.x * NTHR + threadIdx.x; i < n; i += gridDim.x * NTHR) {
    const int j = i & 15, t = i >> 4;
    const float pos = (float)(t & (SEQ - 1));
    const float inv_freq = powf(10000.0f, -(float)(2 * j) / 32.0f);
    const float ang = pos * inv_freq, c = cosf(ang), s = sinf(ang);
    const float x1 = bf2f(proj[(size_t)t * PROJ_LD + PC_KR + j]), x2 = bf2f(proj[(size_t)t * PROJ_LD + PC_KR + 16 + j]);
    kr[(size_t)t * 32 + j] = f2bf(x1 * c - x2 * s); kr[(size_t)t * 32 + 16 + j] = f2bf(x2 * c + x1 * s);
  }
}
DEV void ph_cmp_gather(const bf16_t* __restrict__ proj, const float* __restrict__ pos, int which, bf16_t* __restrict__ ca) {
  const int n = 2048 * 2048;
  for (int i = blockIdx.x * NTHR + threadIdx.x; i < n; i += gridDim.x * NTHR) {
    const int e = i & 2047, row = i >> 11;
    float v = 0.f;
    if (row < BATCH * NC * 2) {
      const int g = row & 1, bc = row >> 1, b = bc / NC, c = bc % NC, l = e >> 6, d = e & 63;
      v = bf2f(proj[(size_t)(b * SEQ + 16 * c + l) * PROJ_LD + PC_KV + which * 128 + g * 64 + d]) + pos[e];
    }
    ca[i] = f2bf(v);
  }
}

DEV void ph_cmp_attn(const bf16_t* __restrict__ proj, const bf16_t* __restrict__ kc, const bf16_t* __restrict__ vc,
                     const float* __restrict__ t5, bf16_t* __restrict__ ocmp, unsigned* __restrict__ sel, char* lds) {
  WAVE_IDS
  float* P = (float*)(lds + wv * 1024); float* Q = P + 128;
  for (int item = gw; item < BATCH * 2 * SEQ; item += nw) {
    const int t = item & (SEQ - 1), bg = item >> 11, g = bg & 1, b = bg >> 1;
    const size_t tok = (size_t)b * SEQ + t;
    const int nvalid = (t >= 31) ? min(NC, (t - 31) / 16 + 1) : 0;
    const bf16_t* kcb = kc + (size_t)bg * 128 * 64;
    const bf16_t* vcb = vc + (size_t)bg * 128 * 64;
    float impacc = 0.f;
    for (int r = 0; r < 4; ++r) {
      const int head = g * 4 + r;
      Q[lane] = bf2f(proj[tok * PROJ_LD + PC_Q + head * 64 + lane]);
      wave_lds_sync();
      float lg[2];
#pragma unroll
      for (int u = 0; u < 2; ++u) {
        const int c = lane + 64 * u;
        float d = 0.f;
        if (c < nvalid) { const bf16_t* kr = kcb + c * 64; for (int e = 0; e < 64; ++e) d += Q[e] * bf2f(kr[e]); }
        lg[u] = (c < nvalid) ? d + 1.4426950408889634f * t5bias(t5, head, t - (16 * c + 31)) : -1e30f;
      }
      const float m = wmaxf(fmaxf(lg[0], lg[1]));
      const float e0 = (lane < nvalid) ? exp2f(lg[0] - m) : 0.f, e1 = (lane + 64 < nvalid) ? exp2f(lg[1] - m) : 0.f;
      const float s = wsum(e0 + e1);
      const float inv = (nvalid > 0) ? 1.0f / fmaxf(s, 1e-30f) : 0.f;
      P[lane] = e0 * inv; P[lane + 64] = e1 * inv;
      wave_lds_sync();
      float o = 0.f;
      for (int c = 0; c < nvalid; ++c) o += P[c] * bf2f(vcb[c * 64 + lane]);
      ocmp[tok * 512 + head * 64 + lane] = f2bf(o);
      if (lane < 32) { for (int c = 4 * lane - 1; c <= 4 * lane + 3; ++c) if (c >= 0 && c < NC) impacc += P[c]; }
      wave_lds_sync();
    }
    const int cur = t >> 6, n = lane;
    float score = (n > cur) ? -1.0f : ((n == 0 || n == cur || n == cur - 1) ? 1e4f : impacc);
    if (n >= 32) score = -2.0f;
    int rank = 0;
    for (int mth = 0; mth < 32; ++mth) { const float sm = __shfl(score, mth); rank += (sm > score || (sm == score && mth < n)) ? 1 : 0; }
    const unsigned long long bal = __ballot(n < 32 && rank < 16);
    if (lane == 0) sel[item] = (unsigned)bal;
  }
}

DEV void ph_nsa_attn(const bf16_t* __restrict__ proj, const float* __restrict__ t5, const bf16_t* __restrict__ ocmp,
                     const unsigned* __restrict__ sel, bf16_t* __restrict__ onsa, char* lds) {
  WAVE_IDS
  float* P = (float*)(lds + wv * 1024); float* Q = P + 128;
  for (int item = gw; item < BATCH * 2 * SEQ * 4; item += nw) {
    const int r = item & 3, t = (item >> 2) & (SEQ - 1), bg = item >> 13, g = bg & 1, b = bg >> 1;
    const int head = g * 4 + r, cur = t >> 6;
    const size_t tok = (size_t)b * SEQ + t;
    Q[lane] = bf2f(proj[tok * PROJ_LD + PC_Q + head * 64 + lane]);
    wave_lds_sync();
    const unsigned smask = sel[bg * SEQ + t];
    float res0 = 0.f, res1 = 0.f;
    for (int br = 0; br < 2; ++br) {
      float m = -1e30f, l = 0.f, o = 0.f;
      const int nb0 = (br == 0) ? 0 : max(0, cur - 8);
      for (int nb = nb0; nb <= cur; ++nb) {
        if (br == 0 && !((smask >> nb) & 1u)) continue;
        const int s = nb * 64 + lane, dist = t - s;
        const bool valid = (dist >= 0) && (br == 0 || dist < 512);
        const bf16_t* kp = proj + ((size_t)b * SEQ + s) * PROJ_LD + PC_KV + (2 + 2 * br) * 128 + g * 64;
        float d = 0.f;
        for (int e = 0; e < 64; e += 8) {
          const uint4 kv = *(const uint4*)(kp + e);
          d += Q[e + 0] * __uint_as_float(kv.x << 16) + Q[e + 1] * __uint_as_float(kv.x & 0xffff0000u);
          d += Q[e + 2] * __uint_as_float(kv.y << 16) + Q[e + 3] * __uint_as_float(kv.y & 0xffff0000u);
          d += Q[e + 4] * __uint_as_float(kv.z << 16) + Q[e + 5] * __uint_as_float(kv.z & 0xffff0000u);
          d += Q[e + 6] * __uint_as_float(kv.w << 16) + Q[e + 7] * __uint_as_float(kv.w & 0xffff0000u);
        }
        const float lg = valid ? d + 1.4426950408889634f * t5bias(t5, head, dist) : -1e30f;
        const float mn = fmaxf(m, wmaxf(lg));
        const float sc = exp2f(m - mn);
        const float pe = valid ? exp2f(lg - mn) : 0.f;
        l = l * sc + wsum(pe); m = mn;
        P[lane] = pe;
        wave_lds_sync();
        const bf16_t* vp = proj + ((size_t)b * SEQ + nb * 64) * PROJ_LD + PC_KV + (3 + 2 * br) * 128 + g * 64 + lane;
        float acc = 0.f;
        for (int k = 0; k < 64; ++k) acc += P[k] * bf2f(vp[(size_t)k * PROJ_LD]);
        o = o * sc + acc;
        wave_lds_sync();
      }
      if (br == 0) res0 = o / fmaxf(l, 1e-30f); else res1 = o / fmaxf(l, 1e-30f);
    }
    const bf16_t* gp = proj + tok * PROJ_LD + PC_GATE + head * 3;
    const float g0 = sigmoidf_(bf2f(gp[0])), g1 = sigmoidf_(bf2f(gp[1])), g2 = sigmoidf_(bf2f(gp[2]));
    const float oc = bf2f(ocmp[tok * 512 + head * 64 + lane]);
    onsa[tok * 512 + head * 64 + lane] = f2bf(g0 * oc + g1 * res0 + g2 * res1);
    wave_lds_sync();
  }
}

DEV void ph_mla_attn(const bf16_t* __restrict__ mq, const bf16_t* __restrict__ mkv, const bf16_t* __restrict__ kr, bf16_t* __restrict__ omla, char* lds) {
  WAVE_IDS
  float* P = (float*)(lds + wv * 1024); float* Q = P + 128;
  for (int item = gw; item < BATCH * 8 * SEQ; item += nw) {
    const int h = item & 7, t = (item >> 3) & (SEQ - 1), b = item >> 14;
    const size_t tok = (size_t)b * SEQ + t;
    Q[lane] = bf2f(mq[tok * 768 + h * 96 + lane]);
    if (lane < 32) Q[64 + lane] = bf2f(mq[tok * 768 + h * 96 + 64 + lane]);
    wave_lds_sync();
    float m = -1e30f, l = 0.f, o = 0.f;
    for (int nb = 0; nb <= (t >> 6); ++nb) {
      const int s = nb * 64 + lane;
      const bool valid = s <= t;
      const bf16_t* kp = mkv + ((size_t)b * SEQ + s) * 1024 + h * 128;
      const bf16_t* rp = kr + ((size_t)b * SEQ + s) * 32;
      float d = 0.f;
      for (int e = 0; e < 64; e += 8) {
        const uint4 kv = *(const uint4*)(kp + e);
        d += Q[e + 0] * __uint_as_float(kv.x << 16) + Q[e + 1] * __uint_as_float(kv.x & 0xffff0000u);
        d += Q[e + 2] * __uint_as_float(kv.y << 16) + Q[e + 3] * __uint_as_float(kv.y & 0xffff0000u);
        d += Q[e + 4] * __uint_as_float(kv.z << 16) + Q[e + 5] * __uint_as_float(kv.z & 0xffff0000u);
        d += Q[e + 6] * __uint_as_float(kv.w << 16) + Q[e + 7] * __uint_as_float(kv.w & 0xffff0000u);
      }
      for (int e = 0; e < 32; e += 8) {
        const uint4 kv = *(const uint4*)(rp + e);
        d += Q[64 + e + 0] * __uint_as_float(kv.x << 16) + Q[64 + e + 1] * __uint_as_float(kv.x & 0xffff0000u);
        d += Q[64 + e + 2] * __uint_as_float(kv.y << 16) + Q[64 + e + 3] * __uint_as_float(kv.y & 0xffff0000u);
        d += Q[64 + e + 4] * __uint_as_float(kv.z << 16) + Q[64 + e + 5] * __uint_as_float(kv.z & 0xffff0000u);
        d += Q[64 + e + 6] * __uint_as_float(kv.w << 16) + Q[64 + e + 7] * __uint_as_float(kv.w & 0xffff0000u);
      }
      const float lg = valid ? d : -1e30f;
      const float mn = fmaxf(m, wmaxf(lg));
      const float sc = exp2f(m - mn);
      const float pe = valid ? exp2f(lg - mn) : 0.f;
      l = l * sc + wsum(pe); m = mn;
      P[lane] = pe;
      wave_lds_sync();
      const bf16_t* vp = mkv + ((size_t)b * SEQ + nb * 64) * 1024 + h * 128 + 64 + lane;
      float acc = 0.f;
      for (int k = 0; k < 64; ++k) acc += P[k] * bf2f(vp[(size_t)k * 1024]);
      o = o * sc + acc;
      wave_lds_sync();
    }
    omla[tok * 512 + h * 64 + lane] = f2bf(o / fmaxf(l, 1e-30f));
    wave_lds_sync();
  }
}

DEV void wave_argmax(float& v, int& idx) {
#pragma unroll
  for (int o = 32; o > 0; o >>= 1) {
    const float ov = __shfl_xor(v, o); const int oi = __shfl_xor(idx, o);
    if (ov > v || (ov == v && oi < idx)) { v = ov; idx = oi; }
  }
}
DEV void ph_route(const bf16_t* __restrict__ pq, const bf16_t* __restrict__ subk, int* __restrict__ pidx, float* __restrict__ pw, char* lds) {
  WAVE_IDS
  float* Q = (float*)(lds + wv * 1024);
  float* TS = Q + 128;
  int* TI = (int*)(TS + 32);
  for (int item = gw; item < T * 8; item += nw) {
    const int h = item & 7, t = item >> 3;
    Q[lane] = bf2f(pq[(size_t)t * 1024 + h * 128 + lane]);
    Q[lane + 64] = bf2f(pq[(size_t)t * 1024 + h * 128 + 64 + lane]);
    wave_lds_sync();
    for (int p = 0; p < 2; ++p) {
      const bf16_t* kb = subk + (size_t)((h * 2 + p) * 128) * 64;
      float s0 = 0.f, s1 = 0.f;
      for (int e = 0; e < 64; ++e) { const float qv = Q[p * 64 + e]; s0 += qv * bf2f(kb[lane * 64 + e]); s1 += qv * bf2f(kb[(lane + 64) * 64 + e]); }
      for (int k = 0; k < 16; ++k) {
        float v = (s0 >= s1) ? s0 : s1; int idx = (s0 >= s1) ? lane : lane + 64;
        wave_argmax(v, idx);
        if (lane == 0) { TS[p * 16 + k] = v; TI[p * 16 + k] = idx; }
        if (idx == lane) s0 = -3e38f;
        if (idx == lane + 64) s1 = -3e38f;
      }
    }
    wave_lds_sync();
    float cv[4];
#pragma unroll
    for (int u = 0; u < 4; ++u) { const int f = lane + 64 * u; cv[u] = TS[f >> 4] + TS[16 + (f & 15)]; }
    int myexp = 0; float mybest = 0.f, best0 = 0.f, den = 0.f;
#pragma unroll
    for (int k = 0; k < 16; ++k) {
      float v = cv[0]; int idx = lane;
#pragma unroll
      for (int u = 1; u < 4; ++u) if (cv[u] > v) { v = cv[u]; idx = lane + 64 * u; }
      wave_argmax(v, idx);
#pragma unroll
      for (int u = 0; u < 4; ++u) if (idx == lane + 64 * u) cv[u] = -3e38f;
      if (k == 0) best0 = v;
      den += expf(v - best0);
      if (lane == k) { myexp = TI[idx >> 4] * 128 + TI[16 + (idx & 15)]; mybest = v; }
    }
    if (lane < 16) { pidx[(size_t)t * 128 + h * 16 + lane] = myexp; pw[(size_t)t * 128 + h * 16 + lane] = expf(mybest - best0) / den; }
    wave_lds_sync();
  }
}

DEV void ph_experts(const bf16_t* __restrict__ hn, const int* __restrict__ pidx, const float* __restrict__ pw,
                    const float* __restrict__ pu, const float* __restrict__ pv, const float* __restrict__ gfin, float* __restrict__ out) {
  WAVE_IDS
  for (int t = gw; t < T; t += nw) {
    float4 x[4], y[4];
#pragma unroll
    for (int j = 0; j < 4; ++j) {
      const uint2 r = ((const uint2*)(hn + (size_t)t * 1024))[j * 64 + lane];
      x[j] = make_float4(__uint_as_float(r.x << 16), __uint_as_float(r.x & 0xffff0000u), __uint_as_float(r.y << 16), __uint_as_float(r.y & 0xffff0000u));
      y[j] = make_float4(0.f, 0.f, 0.f, 0.f);
    }
    const int e0 = pidx[(size_t)t * 128 + lane], e1 = pidx[(size_t)t * 128 + 64 + lane];
    const float w0 = pw[(size_t)t * 128 + lane], w1 = pw[(size_t)t * 128 + 64 + lane];
    for (int s = 0; s < 128; ++s) {
      const int e = __shfl((s < 64) ? e0 : e1, s & 63);
      const float w = __shfl((s < 64) ? w0 : w1, s & 63);
      const float4* ur = (const float4*)(pu + (size_t)e * 1024);
      float d = 0.f;
#pragma unroll
      for (int j = 0; j < 4; ++j) { const float4 u = ur[j * 64 + lane]; d += u.x * x[j].x + u.y * x[j].y + u.z * x[j].z + u.w * x[j].w; }
      d = wsum(d);
      const float c = w * gelu_exact(d);
      const float4* vr = (const float4*)(pv + (size_t)e * 1024);
#pragma unroll
      for (int j = 0; j < 4; ++j) { const float4 v = vr[j * 64 + lane]; y[j].x += c * v.x; y[j].y += c * v.y; y[j].z += c * v.z; y[j].w += c * v.w; }
    }
    float4* o4 = (float4*)(out + (size_t)t * 1024);
    float ss = 0.f;
#pragma unroll
    for (int j = 0; j < 4; ++j) {
      const float4 hv = o4[j * 64 + lane];
      y[j].x += hv.x; y[j].y += hv.y; y[j].z += hv.z; y[j].w += hv.w;
      ss += y[j].x * y[j].x + y[j].y * y[j].y + y[j].z * y[j].z + y[j].w * y[j].w;
    }
    ss = wsum(ss);
    const float inv = rsqrtf(ss * (1.0f / 1024.0f) + 1e-6f);
#pragma unroll
    for (int j = 0; j < 4; ++j) {
      const float4 gg = ((const float4*)gfin)[j * 64 + lane];
      o4[j * 64 + lane] = make_float4(y[j].x * inv * gg.x, y[j].y * inv * gg.y, y[j].z * inv * gg.z, y[j].w * inv * gg.w);
    }
  }
}


namespace att {
#define LAS3 __attribute__((address_space(3)))
typedef LAS3 char* lptr;
typedef LAS3 const char* lcptr;
using bf16x8 = __attribute__((ext_vector_type(8))) short;
using s16x4 = __attribute__((ext_vector_type(4))) short;
using f32x16 = __attribute__((ext_vector_type(16))) float;
typedef short v4i16_t __attribute__((ext_vector_type(4)));
typedef unsigned u32x4 __attribute__((ext_vector_type(4)));
typedef float f32x4_t __attribute__((ext_vector_type(4)));
typedef float f32x2_t __attribute__((ext_vector_type(2)));
typedef __bf16 bf16x2_t __attribute__((ext_vector_type(2)));
constexpr float LOG2E = 1.4426950408889634f;
constexpr float THR = 6.0f;
constexpr float NEG_INF = -__builtin_huge_valf();
constexpr int SLOT = 20480, KOFF = 0, VOFF = 12288;
constexpr int L_WSF = 2 * SLOT;
constexpr int L_TB = L_WSF + 2048;
constexpr int L_SELM = L_TB + 4096;
constexpr int L_SC = L_SELM + 256;
constexpr int L_IMPQ = L_SC + 64 * 33 * 4;
constexpr int L_IMPL = L_IMPQ + 4 * 64 * 33 * 4;
constexpr int L_FIN = L_IMPQ;
constexpr int L_END = L_IMPL + 4 * 64 * 33 * 4;
static_assert(L_END <= 131072, "attention LDS map");

__device__ __forceinline__ int crow(int r, int hi) { return (r & 3) + 8 * (r >> 2) + 4 * hi; }
__device__ __forceinline__ s16x4 vtr(lcptr p) { return __builtin_bit_cast(s16x4, __builtin_amdgcn_ds_read_tr16_b64_v4i16((LAS3 v4i16_t*)p)); }
__device__ __forceinline__ unsigned cvtpk(float lo, float hi) { f32x2_t v = {lo, hi}; bf16x2_t b = __builtin_convertvector(v, bf16x2_t); return __builtin_bit_cast(unsigned, b); }
__device__ __forceinline__ float xmax(float v) { auto rr = __builtin_amdgcn_permlane32_swap(__float_as_uint(v), __float_as_uint(v), false, false); return fmaxf(__uint_as_float(rr[0]), __uint_as_float(rr[1])); }
__device__ __forceinline__ float xsum(float v) { auto rr = __builtin_amdgcn_permlane32_swap(__float_as_uint(v), __float_as_uint(v), false, false); return __uint_as_float(rr[0]) + __uint_as_float(rr[1]); }
__device__ __forceinline__ float ex2(float x) { return __builtin_amdgcn_exp2f(x); }

template <int ND0> __device__ __forceinline__ void qkt(f32x16& p0, f32x16& p1, lcptr kb, const bf16x8* qr) {
  p0 = f32x16{}; p1 = f32x16{};
#pragma unroll
  for (int d0 = 0; d0 < ND0; ++d0) {
    const bf16x8 b0 = *(const LAS3 bf16x8*)(kb + d0 * 2048);
    const bf16x8 b1 = *(const LAS3 bf16x8*)(kb + d0 * 2048 + 512);
    p0 = __builtin_amdgcn_mfma_f32_32x32x16_bf16(b0, qr[d0], p0, 0, 0, 0);
    p1 = __builtin_amdgcn_mfma_f32_32x32x16_bf16(b1, qr[d0], p1, 0, 0, 0);
  }
}
__device__ __forceinline__ void pv(f32x16 (&o)[2], lcptr vp, const unsigned (&pw)[16]) {
#pragma unroll
  for (int d0 = 0; d0 < 2; ++d0)
#pragma unroll
    for (int ks = 0; ks < 4; ++ks) {
      const s16x4 lo = vtr(vp + d0 * 4096 + ks * 1024), hi4 = vtr(vp + d0 * 4096 + ks * 1024 + 512);
      const bf16x8 vf = {lo[0], lo[1], lo[2], lo[3], hi4[0], hi4[1], hi4[2], hi4[3]};
      const unsigned pa4[4] = {pw[4 * ks], pw[4 * ks + 1], pw[4 * ks + 2], pw[4 * ks + 3]};
      o[d0] = __builtin_amdgcn_mfma_f32_32x32x16_bf16(__builtin_bit_cast(bf16x8, pa4), vf, o[d0], 0, 0, 0);
    }
}
__device__ __forceinline__ void softmax_step(f32x16& p0, f32x16& p1, float& m, float& l, f32x16 (&o)[2], LAS3 float* wsf, int r32, int hi, unsigned (&pw)[16]) {
  float rm = fmaxf(p0[0], p1[0]);
#pragma unroll
  for (int r = 1; r < 16; ++r) rm = fmaxf(rm, fmaxf(p0[r], p1[r]));
  rm = xmax(rm);
  if (__any(rm > m + THR)) {
    const float mn = fmaxf(m, rm);
    const float al = ex2(m - mn);
    m = mn; l *= al;
    if (hi == 0) wsf[r32] = al;
#pragma unroll
    for (int r = 0; r < 16; ++r) { const float f = wsf[crow(r, hi)]; o[0][r] *= f; o[1][r] *= f; }
  }
  float s = 0.f;
#pragma unroll
  for (int r = 0; r < 16; ++r) { p0[r] = ex2(p0[r] - m); p1[r] = ex2(p1[r] - m); s += p0[r] + p1[r]; }
  l += s;
#pragma unroll
  for (int i = 0; i < 8; ++i) { pw[i] = cvtpk(p0[2 * i], p0[2 * i + 1]); pw[8 + i] = cvtpk(p1[2 * i], p1[2 * i + 1]); }
}
struct KVSrc { const bf16_t* k; const bf16_t* v; int ldk, ldv; };
__device__ __forceinline__ void kv_issue(const KVSrc& s, int row0, u32x4& rk, u32x4& rv, int tid) {
  const int kv = tid & 63, ch = tid >> 6, ln = tid & 63;
  rk = *(const u32x4*)(s.k + (size_t)(row0 + kv) * s.ldk + ch * 8);
  rv = *(const u32x4*)(s.v + (size_t)(row0 + 16 * (ch & 3) + (ln >> 2)) * s.ldv + (ch >> 2) * 32 + (ln & 3) * 8);
}
__device__ __forceinline__ void kv_commit(lptr slot, const u32x4& rk, const u32x4& rv, int tid) {
  *(LAS3 u32x4*)(slot + KOFF + (tid >> 6) * 1024 + (tid & 63) * 16) = rk;
  *(LAS3 u32x4*)(slot + VOFF + tid * 16) = rv;
}
__device__ __forceinline__ void fin_set(LAS3 float* finl, const f32x16 (&o)[2], int lane) {
#pragma unroll
  for (int d0 = 0; d0 < 2; ++d0)
#pragma unroll
    for (int r = 0; r < 16; ++r) finl[(d0 * 16 + r) * 64 + lane] = o[d0][r];
}
__device__ __forceinline__ void fin_add(LAS3 float* finl, const f32x16 (&o)[2], const LAS3 float* wsf, int lane, int hi) {
#pragma unroll
  for (int r = 0; r < 16; ++r) { const float f = wsf[crow(r, hi)];
#pragma unroll
    for (int d0 = 0; d0 < 2; ++d0) finl[(d0 * 16 + r) * 64 + lane] += o[d0][r] * f; }
}
__device__ __forceinline__ void fin_store(const LAS3 float* finl, bf16_t* gout, size_t rowbase, int ld, int colbase, int lane) {
#pragma unroll
  for (int i = 0; i < 4; ++i) {
    const int q = i * 8 + (lane >> 3), ch = lane & 7;
    const int qh = (q >> 2) & 1, r = (q & 3) + 4 * (q >> 3), d0 = ch >> 2, dl = (ch & 3) * 8;
    const LAS3 float* p = finl + (d0 * 16 + r) * 64 + qh * 32 + dl;
    const f32x4_t x0 = *(const LAS3 f32x4_t*)p, x1 = *(const LAS3 f32x4_t*)(p + 4);
    u32x4 v; v.x = cvtpk(x0[0], x0[1]); v.y = cvtpk(x0[2], x0[3]); v.z = cvtpk(x1[0], x1[1]); v.w = cvtpk(x1[2], x1[3]);
    *(u32x4*)(gout + (rowbase + q) * (size_t)ld + colbase + ch * 8) = v;
  }
}

__device__ __forceinline__ void nsa_unit(int b, int g, int c, const bf16_t* __restrict__ proj, const bf16_t* __restrict__ kc, const bf16_t* __restrict__ vc, bf16_t* __restrict__ onsa, lptr lds) {
  int tid = threadIdx.x; asm volatile("" : "+v"(tid));
  const int lane = tid & 63, r32 = lane & 31, hi = lane >> 5;
  const int w = __builtin_amdgcn_readfirstlane(tid >> 6);
  const int rh = w >> 1, head = g * 4 + rh, tokl = 32 * (w & 1) + r32, t = 64 * c + tokl, bg = b * 2 + g;
  const size_t tok = (size_t)b * SEQ + t;
  LAS3 float* wsf = (LAS3 float*)(lds + L_WSF) + w * 64;
  const LAS3 float* tb = (const LAS3 float*)(lds + L_TB) + head * 128;
  LAS3 unsigned* selm = (LAS3 unsigned*)(lds + L_SELM);
  LAS3 float* sc = (LAS3 float*)(lds + L_SC);
  LAS3 float* impq = (LAS3 float*)(lds + L_IMPQ);
  LAS3 float* impl = (LAS3 float*)(lds + L_IMPL);
  const lcptr kb0 = (lcptr)lds + KOFF + hi * 1024 + r32 * 16;
  const lcptr vp0 = (lcptr)lds + VOFF + ((lane >> 4) & 1) * 32 + (lane & 3) * 8 + (4 * hi + ((lane & 15) >> 2)) * 64;
  bf16x8 qr[4];
#pragma unroll
  for (int d0 = 0; d0 < 4; ++d0) qr[d0] = *(const bf16x8*)(proj + tok * PROJ_LD + PC_Q + head * 64 + d0 * 16 + hi * 8);
  float gate[3];
#pragma unroll
  for (int j = 0; j < 3; ++j) gate[j] = 1.0f / (1.0f + ex2(-LOG2E * bf2f(proj[tok * PROJ_LD + PC_GATE + head * 3 + j])));
  LAS3 float* finl = (LAS3 float*)(lds + L_FIN) + w * 2048;
  f32x16 o[2]; unsigned pw[16];
  u32x4 rk, rv;
  {
    const KVSrc src{kc + (size_t)bg * 128 * 64, vc + (size_t)bg * 128 * 64, 64, 64};
    __syncthreads();
    kv_issue(src, 0, rk, rv, tid); kv_commit(lds, rk, rv, tid);
    kv_issue(src, 64, rk, rv, tid); kv_commit(lds + SLOT, rk, rv, tid);
    __syncthreads();
    f32x16 a0, a1, b0, b1;
    qkt<4>(a0, a1, kb0, qr); qkt<4>(b0, b1, kb0 + SLOT, qr);
    float rm = NEG_INF;
#pragma unroll
    for (int r = 0; r < 16; ++r) {
      const int cb = crow(r, hi);
      { const int d = t - 16 * cb - 31;          a0[r] = (d < 0) ? NEG_INF : a0[r] + ((d < 113) ? tb[d] : 0.f); }
      { const int d = t - 16 * (cb + 32) - 31;   a1[r] = (d < 0) ? NEG_INF : a1[r] + ((d < 113) ? tb[d] : 0.f); }
      { const int d = t - 16 * (cb + 64) - 31;   b0[r] = (d < 0) ? NEG_INF : b0[r] + ((d < 113) ? tb[d] : 0.f); }
      { const int d = t - 16 * (cb + 96) - 31;   b1[r] = (d < 0) ? NEG_INF : b1[r] + ((d < 113) ? tb[d] : 0.f); }
      rm = fmaxf(fmaxf(rm, fmaxf(a0[r], a1[r])), fmaxf(b0[r], b1[r]));
    }
    rm = xmax(rm);
    const float mref = (rm == NEG_INF) ? 0.f : rm;
    float s = 0.f;
#pragma unroll
    for (int r = 0; r < 16; ++r) { a0[r] = ex2(a0[r] - mref); a1[r] = ex2(a1[r] - mref); b0[r] = ex2(b0[r] - mref); b1[r] = ex2(b1[r] - mref); s += (a0[r] + a1[r]) + (b0[r] + b1[r]); }
    s = xsum(s);
    const float inv = (s > 0.f) ? 1.0f / s : 0.f;
#pragma unroll
    for (int r = 0; r < 16; ++r) { a0[r] *= inv; a1[r] *= inv; b0[r] *= inv; b1[r] *= inv; }
    { LAS3 float* iq = impq + (rh * 64 + tokl) * 33; LAS3 float* il = impl + (rh * 64 + tokl) * 33;
#pragma unroll
      for (int q4 = 0; q4 < 4; ++q4) {
        const int gi = 2 * q4 + hi;
        iq[gi] = (a0[4 * q4] + a0[4 * q4 + 1]) + (a0[4 * q4 + 2] + a0[4 * q4 + 3]);           il[gi] = a0[4 * q4 + 3];
        iq[8 + gi] = (a1[4 * q4] + a1[4 * q4 + 1]) + (a1[4 * q4 + 2] + a1[4 * q4 + 3]);       il[8 + gi] = a1[4 * q4 + 3];
        iq[16 + gi] = (b0[4 * q4] + b0[4 * q4 + 1]) + (b0[4 * q4 + 2] + b0[4 * q4 + 3]);      il[16 + gi] = b0[4 * q4 + 3];
        iq[24 + gi] = (b1[4 * q4] + b1[4 * q4 + 1]) + (b1[4 * q4 + 2] + b1[4 * q4 + 3]);      il[24 + gi] = b1[4 * q4 + 3];
      } }
    o[0] = f32x16{}; o[1] = f32x16{};
#pragma unroll
    for (int i = 0; i < 8; ++i) { pw[i] = cvtpk(a0[2 * i], a0[2 * i + 1]); pw[8 + i] = cvtpk(a1[2 * i], a1[2 * i + 1]); }
    pv(o, vp0, pw);
#pragma unroll
    for (int i = 0; i < 8; ++i) { pw[i] = cvtpk(b0[2 * i], b0[2 * i + 1]); pw[8 + i] = cvtpk(b1[2 * i], b1[2 * i + 1]); }
    pv(o, vp0 + SLOT, pw);
    if (hi == 0) wsf[r32] = gate[0];
#pragma unroll
    for (int r = 0; r < 16; ++r) { const float f = wsf[crow(r, hi)]; o[0][r] *= f; o[1][r] *= f; }
  }
  __syncthreads();
  const KVSrc ssrc{proj + (size_t)b * SEQ * PROJ_LD + PC_KV + 2 * 128 + g * 64, proj + (size_t)b * SEQ * PROJ_LD + PC_KV + 3 * 128 + g * 64, PROJ_LD, PROJ_LD};
  kv_issue(ssrc, 0, rk, rv, tid);
  {
    const int stok = tid >> 3, sub = tid & 7;
#pragma unroll
    for (int k = 0; k < 4; ++k) {
      const int n = sub * 4 + k;
      float imp = 0.f;
#pragma unroll
      for (int hh = 0; hh < 4; ++hh) imp += impq[(hh * 64 + stok) * 33 + n] + ((n > 0) ? impl[(hh * 64 + stok) * 33 + n - 1] : 0.f);
      sc[stok * 33 + n] = (n > c) ? -1.0f : ((n == 0 || n == c || n == c - 1) ? 1e4f : imp);
    }
    if (tid < 64) selm[tid] = 0u;
    __syncthreads();
#pragma unroll
    for (int k = 0; k < 4; ++k) {
      const int n = sub * 4 + k; const float sv = sc[stok * 33 + n]; int rank = 0;
      for (int mm = 0; mm < 32; ++mm) { const float sm = sc[stok * 33 + mm]; rank += (sm > sv || (sm == sv && mm < n)) ? 1 : 0; }
      if (rank < 16) atomicOr((unsigned*)(selm + stok), 1u << n);
    }
    __syncthreads();
  }
  const unsigned mysel = selm[tokl];
  fin_set(finl, o, lane);
#pragma unroll 1
  for (int br = 0; br < 2; ++br) {
    const KVSrc src = (br == 0) ? ssrc : KVSrc{proj + (size_t)b * SEQ * PROJ_LD + PC_KV + 4 * 128 + g * 64, proj + (size_t)b * SEQ * PROJ_LD + PC_KV + 5 * 128 + g * 64, PROJ_LD, PROJ_LD};
    const int n0 = (br == 0) ? 0 : ((c > 8) ? c - 8 : 0);
    if (br == 1) { __syncthreads(); kv_issue(src, n0 * 64, rk, rv, tid); }
    kv_commit(lds, rk, rv, tid);
    float m = -1e30f, l = 0.f;
    o[0] = f32x16{}; o[1] = f32x16{};
    int cur = 0;
#pragma unroll 1
    for (int n = n0; n <= c; ++n) {
      __syncthreads();
      if (n < c) kv_issue(src, (n + 1) * 64, rk, rv, tid);
      const bool mine = (br == 1) || ((mysel >> n) & 1u);
      if (__any(mine)) {
        f32x16 p0, p1;
        qkt<4>(p0, p1, kb0 + cur * SLOT, qr);
        if (n + 2 >= c) {
          const int dbase = t - 64 * n;
#pragma unroll
          for (int r = 0; r < 16; ++r) { const int d0_ = dbase - crow(r, hi), d1_ = d0_ - 32;
            p0[r] = (d0_ < 0) ? NEG_INF : p0[r] + ((d0_ < 113) ? tb[d0_] : 0.f);
            p1[r] = (d1_ < 0) ? NEG_INF : p1[r] + ((d1_ < 113) ? tb[d1_] : 0.f); }
        } else if (br == 1 && n + 8 == c) {
          const int dbase = t - 64 * n;
#pragma unroll
          for (int r = 0; r < 16; ++r) { const int d0_ = dbase - crow(r, hi), d1_ = d0_ - 32;
            if (d0_ >= 512) p0[r] = NEG_INF; if (d1_ >= 512) p1[r] = NEG_INF; }
        }
        if (!mine) {
#pragma unroll
          for (int r = 0; r < 16; ++r) { p0[r] = NEG_INF; p1[r] = NEG_INF; } }
        softmax_step(p0, p1, m, l, o, wsf, r32, hi, pw);
        pv(o, vp0 + cur * SLOT, pw);
      }
      if (n < c) kv_commit(lds + (cur ^ 1) * SLOT, rk, rv, tid);
      cur ^= 1;
    }
    l = xsum(l);
    const float gi = gate[1 + br] / fmaxf(l, 1e-30f);
    if (hi == 0) wsf[r32] = gi;
    fin_add(finl, o, wsf, lane, hi);
  }
  fin_store(finl, onsa, (size_t)b * SEQ + 64 * c + 32 * (w & 1), 512, head * 64, lane);
}

__device__ __forceinline__ void mla_unit(int b, int h, int qb, const bf16_t* __restrict__ mq, const bf16_t* __restrict__ mkv, const bf16_t* __restrict__ kr, bf16_t* __restrict__ omla, lptr lds) {
  int tid = threadIdx.x; asm volatile("" : "+v"(tid));
  const int lane = tid & 63, r32 = lane & 31, hi = lane >> 5;
  const int w = __builtin_amdgcn_readfirstlane(tid >> 6);
  const int q0 = 256 * qb, qw = q0 + 32 * w, qpos = qw + r32;
  const size_t tokq = (size_t)b * SEQ + qpos;
  LAS3 float* wsf = (LAS3 float*)(lds + L_WSF) + w * 64;
  const lcptr kb0 = (lcptr)lds + KOFF + hi * 1024 + r32 * 16;
  const lcptr vp0 = (lcptr)lds + VOFF + ((lane >> 4) & 1) * 32 + (lane & 3) * 8 + (4 * hi + ((lane & 15) >> 2)) * 64;
  bf16x8 qr[6];
#pragma unroll
  for (int d0 = 0; d0 < 6; ++d0) qr[d0] = *(const bf16x8*)(mq + tokq * 768 + h * 96 + d0 * 16 + hi * 8);
  const KVSrc src{mkv + (size_t)b * SEQ * 1024 + h * 128, mkv + (size_t)b * SEQ * 1024 + h * 128 + 64, 1024, 1024};
  const bf16_t* krb = kr + (size_t)b * SEQ * 32;
  const int NTL = 4 * (qb + 1);
  u32x4 rk, rv, rr = {0u, 0u, 0u, 0u};
  f32x16 o[2]; o[0] = f32x16{}; o[1] = f32x16{};
  unsigned pw[16];
  float m = -1e30f, l = 0.f;
  __syncthreads();
  kv_issue(src, 0, rk, rv, tid);
  if (tid < 256) rr = *(const u32x4*)(krb + (size_t)(tid & 63) * 32 + (tid >> 6) * 8);
  kv_commit(lds, rk, rv, tid);
  if (tid < 256) *(LAS3 u32x4*)(lds + KOFF + (8 + (tid >> 6)) * 1024 + (tid & 63) * 16) = rr;
  int cur = 0;
#pragma unroll 1
  for (int tl = 0; tl < NTL; ++tl) {
    __syncthreads();
    if (tl + 1 < NTL) { kv_issue(src, (tl + 1) * 64, rk, rv, tid); if (tid < 256) rr = *(const u32x4*)(krb + (size_t)((tl + 1) * 64 + (tid & 63)) * 32 + (tid >> 6) * 8); }
    if (64 * tl <= qw + 31) {
      f32x16 p0, p1;
      qkt<6>(p0, p1, kb0 + cur * SLOT, qr);
      if (64 * tl + 63 > qw) {
        const int dbase = qpos - 64 * tl;
#pragma unroll
        for (int r = 0; r < 16; ++r) { const int d0_ = dbase - crow(r, hi), d1_ = d0_ - 32; if (d0_ < 0) p0[r] = NEG_INF; if (d1_ < 0) p1[r] = NEG_INF; }
      }
      softmax_step(p0, p1, m, l, o, wsf, r32, hi, pw);
      pv(o, vp0 + cur * SLOT, pw);
    }
    if (tl + 1 < NTL) { kv_commit(lds + (cur ^ 1) * SLOT, rk, rv, tid); if (tid < 256) *(LAS3 u32x4*)(lds + (cur ^ 1) * SLOT + KOFF + (8 + (tid >> 6)) * 1024 + (tid & 63) * 16) = rr; }
    cur ^= 1;
  }
  l = xsum(l);
  if (hi == 0) wsf[r32] = 1.0f / fmaxf(l, 1e-30f);
#pragma unroll
  for (int r = 0; r < 16; ++r) { const float f = wsf[crow(r, hi)]; o[0][r] *= f; o[1][r] *= f; }
  LAS3 float* finl = (LAS3 float*)(lds + L_FIN) + w * 2048;
  fin_set(finl, o, lane);
  fin_store(finl, omla, (size_t)b * SEQ + qw, 512, h * 64, lane);
}

__device__ __forceinline__ void attn_phase(const bf16_t* proj, const bf16_t* kc, const bf16_t* vc, const float* t5, bf16_t* onsa,
                                           const bf16_t* mq, const bf16_t* mkv, const bf16_t* kr, bf16_t* omla, lptr lds) {
  const int tid = threadIdx.x;
  { LAS3 float* tb = (LAS3 float*)(lds + L_TB);
    for (int i = tid; i < 8 * 128; i += NTHR) { const int hd = i >> 7, d = i & 127; tb[i] = (t5[(int)T5B[d] * 8 + hd] - t5[31 * 8 + hd]) * LOG2E; } }
  const int G = gridDim.x, bx = blockIdx.x;
  for (int v = (G % 8 == 0) ? (bx % 8) * (G / 8) + bx / 8 : bx; v < 256; v += G) {
    const int bg = v >> 4, p = v & 15, bh = v >> 2, j = v & 3;
#pragma unroll 1
    for (int u = 0; u < 2; ++u) nsa_unit(bg >> 1, bg & 1, u ? p : 31 - p, proj, kc, vc, onsa, lds);
#pragma unroll 1
    for (int u = 0; u < 2; ++u) mla_unit(bh >> 3, bh & 7, u ? j : 7 - j, mq, mkv, kr, omla, lds);
  }
}
#undef LAS3
}


namespace peer {
using bf16x8 = __attribute__((ext_vector_type(8))) short;
using f32x16 = __attribute__((ext_vector_type(16))) float;
typedef unsigned u32x4 __attribute__((ext_vector_type(4)));
typedef float f32x4_t __attribute__((ext_vector_type(4)));
typedef __bf16 bf16x2_t __attribute__((ext_vector_type(2)));
typedef float f32x2_t __attribute__((ext_vector_type(2)));
#define LAS3 __attribute__((address_space(3)))
__device__ __forceinline__ int crow(int r, int hi) { return (r & 3) + 8 * (r >> 2) + 4 * hi; }
__device__ __forceinline__ unsigned enc(float f) { const unsigned u = __float_as_uint(f); return u ^ ((unsigned)((int)u >> 31) | 0x80000000u); }
__device__ __forceinline__ float dec(unsigned k) { return __uint_as_float(k ^ (~(unsigned)((int)k >> 31) | 0x80000000u)); }
__device__ __forceinline__ unsigned umax(unsigned a, unsigned b) { return a > b ? a : b; }
__device__ __forceinline__ unsigned umin(unsigned a, unsigned b) { return a < b ? a : b; }
__device__ __forceinline__ unsigned cvtpk(float lo, float hi) { f32x2_t v = {lo, hi}; bf16x2_t b = __builtin_convertvector(v, bf16x2_t); return __builtin_bit_cast(unsigned, b); }
template <int B, int N> __device__ __forceinline__ void sort16(unsigned (&k)[N]) {
#pragma unroll
  for (int size = 2; size <= 16; size <<= 1)
#pragma unroll
    for (int stride = size >> 1; stride > 0; stride >>= 1)
#pragma unroll
      for (int i = 0; i < 16; ++i) { const int l = i ^ stride;
        if (l > i) { const bool desc = ((i & size) == 0); const unsigned a = k[B + i], b = k[B + l]; const unsigned mx = umax(a, b), mn = umin(a, b); k[B + i] = desc ? mx : mn; k[B + l] = desc ? mn : mx; } }
}
template <int A, int Bo, int N> __device__ __forceinline__ void merge16(unsigned (&k)[N]) {
#pragma unroll
  for (int i = 0; i < 16; ++i) k[A + i] = umax(k[A + i], k[Bo + 15 - i]);
#pragma unroll
  for (int stride = 8; stride > 0; stride >>= 1)
#pragma unroll
    for (int i = 0; i < 16; ++i) { const int l = i ^ stride; if (l > i) { const unsigned a = k[A + i], b = k[A + l]; k[A + i] = umax(a, b); k[A + l] = umin(a, b); } }
}
template <int N> __device__ __forceinline__ void top16_of_64(unsigned (&k)[N]) {
  sort16<0>(k); sort16<16>(k); sort16<32>(k); sort16<48>(k);
  merge16<0, 16>(k); merge16<32, 48>(k); merge16<0, 32>(k);
}

__device__ __forceinline__ void route_phase(const bf16_t* __restrict__ pq, const bf16_t* __restrict__ subk, unsigned* __restrict__ pack, LAS3 char* lds) {
  const int tid = threadIdx.x, lane = tid & 63, r32 = lane & 31, hi = lane >> 5, wv = tid >> 6;
  const int gw = blockIdx.x * NWV + wv, nw = gridDim.x * NWV;
  LAS3 unsigned char* myb = (LAS3 unsigned char*)lds + wv * 2560 + lane * 40;
#pragma unroll 1
  for (int item = gw; item < (T / 32) * 8; item += nw) {
    const int h = item & 7, t0 = (item >> 3) * 32;
    unsigned la[16], lb[16];
#pragma unroll
    for (int i = 0; i < 16; ++i) { la[i] = 0u; lb[i] = 0u; }
#pragma unroll 1
    for (int p = 0; p < 2; ++p) {
      f32x16 acc[4];
#pragma unroll
      for (int kt = 0; kt < 4; ++kt) acc[kt] = f32x16{};
#pragma unroll
      for (int kd = 0; kd < 4; ++kd) {
        const bf16x8 bq = *(const bf16x8*)(pq + (size_t)(t0 + r32) * 1024 + h * 128 + p * 64 + kd * 16 + hi * 8);
#pragma unroll
        for (int kt = 0; kt < 4; ++kt) {
          const bf16x8 ak = *(const bf16x8*)(subk + (size_t)((h * 2 + p) * 128 + kt * 32 + r32) * 64 + kd * 16 + hi * 8);
          acc[kt] = __builtin_amdgcn_mfma_f32_32x32x16_bf16(ak, bq, acc[kt], 0, 0, 0);
        }
      }
      unsigned k[64];
#pragma unroll
      for (int kt = 0; kt < 4; ++kt)
#pragma unroll
        for (int r = 0; r < 16; ++r) k[kt * 16 + r] = (enc(acc[kt][r]) & 0xFFFFFF80u) | (unsigned)(127 - (32 * kt + crow(r, hi)));
      top16_of_64(k);
#pragma unroll
      for (int i = 0; i < 16; ++i) { auto rr = __builtin_amdgcn_permlane32_swap(k[i], k[i], false, false); unsigned r0 = rr[0], r1 = rr[1]; asm volatile("" : "+v"(r0), "+v"(r1)); k[16 + i] = hi ? r0 : r1; }
      merge16<0, 16>(k);
#pragma unroll
      for (int i = 0; i < 16; ++i) { la[i] = (p == 0) ? k[i] : la[i]; lb[i] = (p == 0) ? lb[i] : k[i]; }
      __builtin_amdgcn_sched_barrier(0);
    }
#pragma unroll
    for (int i = 0; i < 4; ++i) {
      const unsigned wa = (127u - (la[4 * i] & 127u)) | ((127u - (la[4 * i + 1] & 127u)) << 8) | ((127u - (la[4 * i + 2] & 127u)) << 16) | ((127u - (la[4 * i + 3] & 127u)) << 24);
      const unsigned wb = (127u - (lb[4 * i] & 127u)) | ((127u - (lb[4 * i + 1] & 127u)) << 8) | ((127u - (lb[4 * i + 2] & 127u)) << 16) | ((127u - (lb[4 * i + 3] & 127u)) << 24);
      *(LAS3 unsigned*)(myb + 4 * i) = wa; *(LAS3 unsigned*)(myb + 16 + 4 * i) = wb;
    }
    float va[16], vb[16];
#pragma unroll
    for (int i = 0; i < 16; ++i) { va[i] = dec(la[i] & 0xFFFFFF80u); vb[i] = dec(lb[i] & 0xFFFFFF80u); }
    unsigned k[64];
#define PEER_CAND(n, i, j) k[n] = (enc(va[i] + vb[j]) & 0xFFFFFF00u) | (unsigned)(255 - ((i) * 16 + (j)))
    PEER_CAND(0, 0, 0); PEER_CAND(1, 0, 1); PEER_CAND(2, 0, 2); PEER_CAND(3, 0, 3); PEER_CAND(4, 0, 4); PEER_CAND(5, 0, 5);
    PEER_CAND(6, 0, 6); PEER_CAND(7, 0, 7); PEER_CAND(8, 0, 8); PEER_CAND(9, 0, 9); PEER_CAND(10, 0, 10); PEER_CAND(11, 0, 11);
    PEER_CAND(12, 0, 12); PEER_CAND(13, 0, 13); PEER_CAND(14, 0, 14); PEER_CAND(15, 0, 15); PEER_CAND(16, 1, 0); PEER_CAND(17, 1, 1);
    PEER_CAND(18, 1, 2); PEER_CAND(19, 1, 3); PEER_CAND(20, 1, 4); PEER_CAND(21, 1, 5); PEER_CAND(22, 1, 6); PEER_CAND(23, 1, 7);
    PEER_CAND(24, 2, 0); PEER_CAND(25, 2, 1); PEER_CAND(26, 2, 2); PEER_CAND(27, 2, 3); PEER_CAND(28, 2, 4); PEER_CAND(29, 3, 0);
    PEER_CAND(30, 3, 1); PEER_CAND(31, 3, 2); PEER_CAND(32, 3, 3); PEER_CAND(33, 4, 0); PEER_CAND(34, 4, 1); PEER_CAND(35, 4, 2);
    PEER_CAND(36, 5, 0); PEER_CAND(37, 5, 1); PEER_CAND(38, 6, 0); PEER_CAND(39, 6, 1); PEER_CAND(40, 7, 0); PEER_CAND(41, 7, 1);
    PEER_CAND(42, 8, 0); PEER_CAND(43, 9, 0); PEER_CAND(44, 10, 0); PEER_CAND(45, 11, 0); PEER_CAND(46, 12, 0); PEER_CAND(47, 13, 0);
    PEER_CAND(48, 14, 0); PEER_CAND(49, 15, 0);
#undef PEER_CAND
#pragma unroll
    for (int z = 50; z < 64; ++z) k[z] = 0u;
    top16_of_64(k);
    const float best0 = dec(k[0] & 0xFFFFFF00u);
    float ev[16]; float den = 0.f;
#pragma unroll
    for (int i = 0; i < 16; ++i) { ev[i] = __expf(dec(k[i] & 0xFFFFFF00u) - best0); den += ev[i]; }
    const float inv = 1.0f / den;
    unsigned outw[8];
#pragma unroll
    for (int i = 0; i < 8; ++i) {
      unsigned k_lo = k[i], k_hi = k[8 + i]; float e_lo = ev[i], e_hi = ev[8 + i];
      asm volatile("" : "+v"(k_lo), "+v"(k_hi), "+v"(e_lo), "+v"(e_hi));
      const unsigned kk = hi ? k_hi : k_lo; const float e = hi ? e_hi : e_lo;
      const unsigned f = 255u - (kk & 255u);
      const unsigned ia = myb[f >> 4], ib = myb[16 + (f & 15u)];
      outw[i] = (ia * 128u + ib) | (cvtpk(0.f, e * inv) & 0xFFFF0000u);
    }
    unsigned* dst = pack + (size_t)(t0 + r32) * 128 + h * 16 + hi * 8;
    *(u32x4*)dst = (u32x4){outw[0], outw[1], outw[2], outw[3]};
    *(u32x4*)(dst + 4) = (u32x4){outw[4], outw[5], outw[6], outw[7]};
  }
}

__device__ __forceinline__ void conv_tables(const float* __restrict__ u, const float* __restrict__ v, unsigned* __restrict__ u8, float* __restrict__ su, unsigned* __restrict__ v8) {
  const int tid = threadIdx.x, lane = tid & 63, wv = tid >> 6;
  const int gw = blockIdx.x * NWV + wv, nw = gridDim.x * NWV;
  for (int e = gw; e < 16384; e += nw) {
    const f32x4_t* ur = (const f32x4_t*)(u + (size_t)e * 1024) + lane * 4;
    f32x4_t a[4]; float mx = 0.f;
#pragma unroll
    for (int i = 0; i < 4; ++i) { a[i] = ur[i]; mx = fmaxf(mx, fmaxf(fmaxf(fabsf(a[i][0]), fabsf(a[i][1])), fmaxf(fabsf(a[i][2]), fabsf(a[i][3])))); }
    mx = wmaxf(mx);
    const float sc = fmaxf(mx, 1e-30f) * (1.0f / 127.0f), isc = 1.0f / sc;
    u32x4 o;
#pragma unroll
    for (int i = 0; i < 4; ++i) {
      const int q0 = (int)rintf(a[i][0] * isc), q1 = (int)rintf(a[i][1] * isc), q2 = (int)rintf(a[i][2] * isc), q3 = (int)rintf(a[i][3] * isc);
      o[i] = (unsigned)(q0 & 255) | ((unsigned)(q1 & 255) << 8) | ((unsigned)(q2 & 255) << 16) | ((unsigned)(q3 & 255) << 24);
    }
    *(u32x4*)(u8 + (size_t)e * 256 + lane * 4) = o;
    if (lane == 0) su[e] = sc;
    const f32x4_t* vr = (const f32x4_t*)(v + (size_t)e * 1024) + lane * 4;
    u32x4 ov;
#pragma unroll
    for (int i = 0; i < 4; ++i) { const f32x4_t b = vr[i]; unsigned w = 0u; w = __builtin_amdgcn_cvt_pk_fp8_f32(2.0f * b[0], 2.0f * b[1], w, false); w = __builtin_amdgcn_cvt_pk_fp8_f32(2.0f * b[2], 2.0f * b[3], w, true); ov[i] = w; }
    *(u32x4*)(v8 + ((size_t)(lane >> 3) * 16384 + e) * 32 + (lane & 7) * 4) = ov;
  }
}
__device__ __forceinline__ float gelu_fast(float v) {
  const float av = __builtin_fabsf(v), t = __builtin_amdgcn_rcpf(av * 0.2316418882f + 1.0f);
  float q = t * 0.5307027145f + (-0.7265760135f); q = q * t + 0.7107068705f; q = q * t + (-0.142248368f); q = q * t + 0.127414796f; q = q * t;
  const float e = __builtin_amdgcn_exp2f((v * v) * (-0.72134752044f));
  const float m = v * (q * e);
  return v < 0.f ? m : v - m;
}
__device__ __forceinline__ unsigned xcc_id() { return (unsigned)__builtin_amdgcn_s_getreg((3 << 11) | 20) & 7u; }
struct ABuf { unsigned w[4], meta[4]; u32x4 ub[4][4]; float sue[4]; };
__device__ __forceinline__ void expA_issue(ABuf& B, int k0, int n, const LAS3 unsigned* list, const unsigned* __restrict__ u8, const float* __restrict__ su, int j16) {
#pragma unroll
  for (int q = 0; q < 4; ++q) {
    const int k = (k0 + 32 * q < n) ? k0 + 32 * q : k0;
    B.w[q] = list[2 * k]; B.meta[q] = list[2 * k + 1];
    const unsigned e = B.w[q] & 0xFFFFu;
    const unsigned* urow = u8 + (size_t)e * 256 + j16 * 4;
#pragma unroll
    for (int seg = 0; seg < 4; ++seg) B.ub[q][seg] = *(const u32x4*)(urow + seg * 64);
    B.sue[q] = su[e];
  }
}
__device__ __forceinline__ void expA_consume(const ABuf& B, int k0, int n, const LAS3 char* hl, const LAS3 float* shl, float* __restrict__ co, int t0, int j16) {
#pragma unroll
  for (int q = 0; q < 4; ++q) {
    const int tokl = (int)(B.meta[q] >> 8), slot = (int)(B.meta[q] & 255u);
    const LAS3 char* hrow = hl + tokl * 1024 + j16 * 16;
    int acc = 0;
#pragma unroll
    for (int seg = 0; seg < 4; ++seg) { const u32x4 hq = *(const LAS3 u32x4*)(hrow + seg * 256);
      acc = __builtin_amdgcn_sdot4((int)B.ub[q][seg].x, (int)hq.x, acc, false); acc = __builtin_amdgcn_sdot4((int)B.ub[q][seg].y, (int)hq.y, acc, false);
      acc = __builtin_amdgcn_sdot4((int)B.ub[q][seg].z, (int)hq.z, acc, false); acc = __builtin_amdgcn_sdot4((int)B.ub[q][seg].w, (int)hq.w, acc, false); }
    acc += __shfl_xor(acc, 1); acc += __shfl_xor(acc, 2); acc += __shfl_xor(acc, 4); acc += __shfl_xor(acc, 8);
    const float d = (float)acc * (B.sue[q] * shl[tokl]);
    const float c = 0.5f * __uint_as_float(B.w[q] & 0xFFFF0000u) * gelu_fast(d);
    if (j16 == 0 && k0 + 32 * q < n) co[(size_t)(t0 + tokl) * 128 + slot] = c;
  }
}
__device__ __forceinline__ void expA_item(int item, int xs, const unsigned* __restrict__ pack, const unsigned* __restrict__ hn8, const float* __restrict__ shp, const unsigned* __restrict__ u8, const float* __restrict__ su,
                                          float* __restrict__ co, LAS3 char* lds, int tid) {
  const int lane = tid & 63, j16 = lane & 15, grp = lane >> 4, wv = tid >> 6;
  LAS3 char* hl = lds + 1024;
  LAS3 float* shl = (LAS3 float*)(lds + 1024 + 65536);
  LAS3 unsigned* cnt = (LAS3 unsigned*)(lds + 16);
  LAS3 unsigned* list = (LAS3 unsigned*)(lds + 1024 + 65536 + 256);
  const int t0 = item * 64;
#pragma unroll
  for (int i = 0; i < 8; ++i) { const int idx = tid + 512 * i; *(LAS3 u32x4*)(hl + idx * 16) = *(const u32x4*)(hn8 + (size_t)t0 * 256 + idx * 4); }
  if (tid < 64) shl[tid] = shp[t0 + tid];
  {
    const int tokl = tid >> 3, sb = (tid & 7) * 16;
    u32x4 pw[4];
#pragma unroll
    for (int i = 0; i < 4; ++i) pw[i] = *(const u32x4*)(pack + (size_t)(t0 + tokl) * 128 + sb + 4 * i);
#pragma unroll
    for (int j = 0; j < 16; ++j) { const unsigned w = pw[j >> 2][j & 3];
      if (((w & 0xFFFFu) >> 11) == (unsigned)xs) { const unsigned pos = __hip_atomic_fetch_add(cnt, 1u, __ATOMIC_RELAXED, __HIP_MEMORY_SCOPE_WORKGROUP); list[2 * pos] = w; list[2 * pos + 1] = (unsigned)((tokl << 8) | (sb + j)); } }
  }
  __syncthreads();
  const int n = (int)cnt[0];
  const int gidx = wv * 4 + grp;
  ABuf A, Bb;
  if (gidx < n) expA_issue(A, gidx, n, list, u8, su, j16);
#pragma unroll 1
  for (int k0 = gidx; k0 < n; k0 += 256) {
    if (k0 + 128 < n) expA_issue(Bb, k0 + 128, n, list, u8, su, j16);
    expA_consume(A, k0, n, hl, shl, co, t0, j16);
    if (k0 + 256 < n) expA_issue(A, k0 + 256, n, list, u8, su, j16);
    if (k0 + 128 < n) expA_consume(Bb, k0 + 128, n, hl, shl, co, t0, j16);
  }
}
struct BBuf { u32x4 vv[16]; f32x4_t h[4]; };
__device__ __forceinline__ void expB_issue(BBuf& B, unsigned pk0, unsigned pk1, const unsigned* __restrict__ vbase, const float* __restrict__ hp, int r8) {
#pragma unroll
  for (int i = 0; i < 16; ++i) { const unsigned e = (unsigned)__shfl((int)(i < 8 ? pk0 : pk1), (8 * i + r8) & 63) & 0xFFFFu; B.vv[i] = *(const u32x4*)(vbase + (size_t)e * 32); }
#pragma unroll
  for (int w = 0; w < 4; ++w) B.h[w] = *(const f32x4_t*)(hp + 4 * w);
}
__device__ __forceinline__ void expB_consume(const BBuf& B, float co0, float co1, float* __restrict__ hp, float* __restrict__ ssqp, int lane, int r8) {
  f32x2_t y[8];
#pragma unroll
  for (int i = 0; i < 8; ++i) y[i] = (f32x2_t){0.f, 0.f};
#pragma unroll
  for (int i = 0; i < 16; ++i) {
    const float cv = __shfl(i < 8 ? co0 : co1, (8 * i + r8) & 63);
    const f32x2_t c2 = {cv, cv};
#pragma unroll
    for (int w = 0; w < 4; ++w) {
      y[2 * w] = __builtin_elementwise_fma(__builtin_amdgcn_cvt_pk_f32_fp8(B.vv[i][w], false), c2, y[2 * w]);
      y[2 * w + 1] = __builtin_elementwise_fma(__builtin_amdgcn_cvt_pk_f32_fp8(B.vv[i][w], true), c2, y[2 * w + 1]);
    }
  }
#pragma unroll
  for (int i = 0; i < 8; ++i) {
    float a = y[i][0], b = y[i][1];
    a += __shfl_xor(a, 8); b += __shfl_xor(b, 8); a += __shfl_xor(a, 16); b += __shfl_xor(b, 16); a += __shfl_xor(a, 32); b += __shfl_xor(b, 32);
    y[i][0] = a; y[i][1] = b;
  }
  float ss = 0.f;
  if (r8 == 0) {
#pragma unroll
    for (int w = 0; w < 4; ++w) {
      const f32x4_t a = B.h[w];
      const f32x4_t z = {a[0] + y[2 * w][0], a[1] + y[2 * w][1], a[2] + y[2 * w + 1][0], a[3] + y[2 * w + 1][1]};
      *(f32x4_t*)(hp + 4 * w) = z;
      ss += (z[0] * z[0] + z[1] * z[1]) + (z[2] * z[2] + z[3] * z[3]);
    }
  }
  ss += __shfl_xor(ss, 1); ss += __shfl_xor(ss, 2); ss += __shfl_xor(ss, 4);
  if (lane == 0) *ssqp = ss;
}
__device__ __forceinline__ void expB_item(int item, int xs, const unsigned* __restrict__ pack, const float* __restrict__ co, const unsigned* __restrict__ v8, float* __restrict__ out, float* __restrict__ ssq, int tid) {
  const int lane = tid & 63, wv = tid >> 6, r8 = lane >> 3, c8 = lane & 7;
  const int t0 = item * 64 + wv * 8;
  unsigned pk0[8], pk1[8]; float co0[8], co1[8];
#pragma unroll
  for (int i = 0; i < 8; ++i) { pk0[i] = pack[(size_t)(t0 + i) * 128 + lane]; pk1[i] = pack[(size_t)(t0 + i) * 128 + 64 + lane]; co0[i] = co[(size_t)(t0 + i) * 128 + lane]; co1[i] = co[(size_t)(t0 + i) * 128 + 64 + lane]; }
  const unsigned* vbase = v8 + (size_t)xs * 16384 * 32 + c8 * 4;
  float* hp0 = out + (size_t)t0 * 1024 + xs * 128 + c8 * 16;
  BBuf A, Bb;
  expB_issue(A, pk0[0], pk1[0], vbase, hp0, r8);
#pragma unroll
  for (int i = 0; i < 8; i += 2) {
    expB_issue(Bb, pk0[i + 1], pk1[i + 1], vbase, hp0 + (size_t)(i + 1) * 1024, r8);
    expB_consume(A, co0[i], co1[i], hp0 + (size_t)i * 1024, ssq + (size_t)xs * T + t0 + i, lane, r8);
    if (i + 2 < 8) expB_issue(A, pk0[i + 2], pk1[i + 2], vbase, hp0 + (size_t)(i + 2) * 1024, r8);
    expB_consume(Bb, co0[i + 1], co1[i + 1], hp0 + (size_t)(i + 1) * 1024, ssq + (size_t)xs * T + t0 + i + 1, lane, r8);
  }
}
template <int PASS> __device__ __forceinline__ void experts_sliced(const unsigned* __restrict__ pack, const unsigned* __restrict__ hn8, const float* __restrict__ shp, const unsigned* __restrict__ u8, const float* __restrict__ su,
                                                                    float* __restrict__ co, const unsigned* __restrict__ v8, float* __restrict__ out, float* __restrict__ ssq, unsigned* __restrict__ ctr, LAS3 char* lds) {
  int tid = threadIdx.x; asm volatile("" : "+v"(tid));
  LAS3 volatile int* lw = (LAS3 volatile int*)lds;
  const int xme = (int)xcc_id();
#pragma unroll 1
  for (int s8 = 0; s8 < 8; ++s8) {
    const int xs = (xme + s8) & 7;
#pragma unroll 1
    for (;;) {
      __syncthreads();
      if (tid == 0) { lw[0] = (int)atomicAdd(ctr + 64 * xs, 1u); lw[4] = 0; }
      __syncthreads();
      const int item = lw[0];
      if (item >= T / 64) break;
      if (PASS == 0) expA_item(item, xs, pack, hn8, shp, u8, su, co, lds, tid);
      else expB_item(item, xs, pack, co, v8, out, ssq, tid);
    }
  }
}
__device__ __forceinline__ void experts_norm(const float* __restrict__ ssq, const float* __restrict__ gfin, float* __restrict__ out) {
  const int tid = threadIdx.x, lane = tid & 63, wv = tid >> 6;
  const int gw = blockIdx.x * NWV + wv, nw = gridDim.x * NWV;
  for (int t = gw; t < T; t += nw) {
    float ss = 0.f;
#pragma unroll
    for (int x = 0; x < 8; ++x) ss += ssq[(size_t)x * T + t];
    const float inv = rsqrtf(ss * (1.0f / 1024.0f) + 1e-6f);
    float* op = out + (size_t)t * 1024 + lane * 16; const float* gp = gfin + lane * 16;
#pragma unroll
    for (int i = 0; i < 4; ++i) { const f32x4_t z = *(const f32x4_t*)(op + 4 * i), g = *(const f32x4_t*)(gp + 4 * i); *(f32x4_t*)(op + 4 * i) = z * inv * g; }
  }
}
#undef LAS3
}

namespace prep {
typedef unsigned u32x2_t __attribute__((ext_vector_type(2)));
typedef float f32x4_t __attribute__((ext_vector_type(4)));
typedef unsigned u32x4 __attribute__((ext_vector_type(4)));
using bf16x8 = __attribute__((ext_vector_type(8))) short;
using f32x16 = __attribute__((ext_vector_type(16))) float;
__device__ __forceinline__ unsigned pk2(float lo, float hi) { return (unsigned)f2bf(lo) | ((unsigned)f2bf(hi) << 16); }
__device__ __forceinline__ void latent_rows(const bf16_t* __restrict__ proj, const float* __restrict__ gq, const float* __restrict__ gkv, const float2* __restrict__ cs,
                                            bf16_t* __restrict__ cqn, bf16_t* __restrict__ ckvn, bf16_t* __restrict__ krope, int wave_id, int nwaves, int lane) {
  const f32x4_t g4 = *(const f32x4_t*)(gq + lane * 4);
  const float2 g2 = *(const float2*)(gkv + lane * 2);
  for (int r = wave_id; r < T; r += nwaves) {
    const bf16_t* row = proj + (size_t)r * PROJ_LD;
    const u32x2_t q = *(const u32x2_t*)(row + PC_CQ + lane * 4);
    const unsigned kv = *(const unsigned*)(row + PC_CKV + lane * 2);
    const unsigned short kr0 = row[PC_KR + (lane & 15)], kr1 = row[PC_KR + 16 + (lane & 15)];
    const float q0 = __uint_as_float(q.x << 16), q1 = __uint_as_float(q.x & 0xffff0000u), q2 = __uint_as_float(q.y << 16), q3 = __uint_as_float(q.y & 0xffff0000u);
    const float k0 = __uint_as_float(kv << 16), k1 = __uint_as_float(kv & 0xffff0000u);
    float sq = (q0 * q0 + q1 * q1) + (q2 * q2 + q3 * q3), sk = k0 * k0 + k1 * k1;
#pragma unroll
    for (int o = 32; o > 0; o >>= 1) { sq += __shfl_xor(sq, o); sk += __shfl_xor(sk, o); }
    const float iq = rsqrtf(sq * (1.0f / 256.0f) + 1e-6f), ik = rsqrtf(sk * (1.0f / 128.0f) + 1e-6f);
    u32x2_t oq; oq.x = pk2(q0 * iq * g4[0], q1 * iq * g4[1]); oq.y = pk2(q2 * iq * g4[2], q3 * iq * g4[3]);
    *(u32x2_t*)(cqn + (size_t)r * 256 + lane * 4) = oq;
    *(unsigned*)(ckvn + (size_t)r * 128 + lane * 2) = pk2(k0 * ik * g2.x, k1 * ik * g2.y);
    if (lane < 16) {
      const float2 c = cs[(r & (SEQ - 1)) * 16 + lane];
      const float x1 = bf2f(kr0), x2 = bf2f(kr1);
      krope[(size_t)r * 32 + lane] = f2bf(x1 * c.x - x2 * c.y); krope[(size_t)r * 32 + 16 + lane] = f2bf(x2 * c.x + x1 * c.y);
    }
  }
}
__device__ __forceinline__ void cmp_bias(const float* __restrict__ posk, const float* __restrict__ posv, const bf16_t* __restrict__ w1k, const bf16_t* __restrict__ w1v, float* __restrict__ cpos, int wave_id, int nwaves, int lane) {
  for (int o = wave_id; o < 512; o += nwaves) {
    const int tab = o >> 8, n = o & 255;
    const float* pos = tab ? posv : posk; const bf16_t* w = (tab ? w1v : w1k) + (size_t)n * 2048;
    float acc = 0.f;
#pragma unroll
    for (int i = 0; i < 4; ++i) { const int k = (i * 64 + lane) * 8;
      const u32x4 wv = *(const u32x4*)(w + k); const f32x4_t p0 = *(const f32x4_t*)(pos + k), p1 = *(const f32x4_t*)(pos + k + 4);
      acc += p0[0] * __uint_as_float(wv.x << 16) + p0[1] * __uint_as_float(wv.x & 0xffff0000u) + p0[2] * __uint_as_float(wv.y << 16) + p0[3] * __uint_as_float(wv.y & 0xffff0000u);
      acc += p1[0] * __uint_as_float(wv.z << 16) + p1[1] * __uint_as_float(wv.z & 0xffff0000u) + p1[2] * __uint_as_float(wv.w << 16) + p1[3] * __uint_as_float(wv.w & 0xffff0000u); }
    acc = wsum(acc);
    if (lane == 0) cpos[o] = acc;
  }
}
__device__ __forceinline__ void cmp_l2(const float* __restrict__ slab, const float* __restrict__ cpos, const bf16_t* __restrict__ w2t, bf16_t* __restrict__ outkc, int item, int lane) {
  const int r32 = lane & 31, hi = lane >> 5, m0 = item * 32;
  f32x16 acc0 = f32x16{}, acc1 = f32x16{};
#pragma unroll 2
  for (int ks = 0; ks < 16; ++ks) {
    const int k = ks * 16 + hi * 8;
    f32x4_t a0 = *(const f32x4_t*)(cpos + k), a1 = *(const f32x4_t*)(cpos + k + 4);
#pragma unroll
    for (int sp = 0; sp < 4; ++sp) { const float* p = slab + ((size_t)sp * 2048 + m0 + r32) * 256 + k; a0 += *(const f32x4_t*)p; a1 += *(const f32x4_t*)(p + 4); }
    u32x4 aw;
    aw.x = pk2(peer::gelu_fast(a0[0]), peer::gelu_fast(a0[1])); aw.y = pk2(peer::gelu_fast(a0[2]), peer::gelu_fast(a0[3]));
    aw.z = pk2(peer::gelu_fast(a1[0]), peer::gelu_fast(a1[1])); aw.w = pk2(peer::gelu_fast(a1[2]), peer::gelu_fast(a1[3]));
    const bf16x8 af = __builtin_bit_cast(bf16x8, aw);
    const bf16x8 b0 = *(const bf16x8*)(w2t + (size_t)r32 * 256 + k), b1 = *(const bf16x8*)(w2t + (size_t)(32 + r32) * 256 + k);
    acc0 = __builtin_amdgcn_mfma_f32_32x32x16_bf16(af, b0, acc0, 0, 0, 0);
    acc1 = __builtin_amdgcn_mfma_f32_32x32x16_bf16(af, b1, acc1, 0, 0, 0);
  }
#pragma unroll
  for (int r = 0; r < 16; ++r) {
    const int m = m0 + (r & 3) + 8 * (r >> 2) + 4 * hi;
    const bool pad = (m & 127) == 127;
    outkc[(size_t)m * 64 + r32] = pad ? (bf16_t)0 : f2bf(acc0[r]);
    outkc[(size_t)m * 64 + 32 + r32] = pad ? (bf16_t)0 : f2bf(acc1[r]);
  }
}
}

#define XB_TMO      128
#define XB_XCNT(j)  (256  + 64 * (j))
#define XB_XSUB(j)  (1280 + 64 * (j))
#define XB_XGEN(j)  (2304 + 64 * (j))
#define XB_TOP      3328
#define XB_TOPGEN   3392
#define XCD_BAR_WORDS 3456
#define XB_SPIN_CAP (1u << 18)
#ifndef LAS
#define LAS __attribute__((address_space(3)))
#endif

__device__ __forceinline__ unsigned xb_ld(unsigned* p)              { return __hip_atomic_load(p, __ATOMIC_RELAXED, __HIP_MEMORY_SCOPE_AGENT); }
__device__ __forceinline__ unsigned xb_add(unsigned* p, unsigned v) { return __hip_atomic_fetch_add(p, v, __ATOMIC_RELAXED, __HIP_MEMORY_SCOPE_AGENT); }
__device__ __forceinline__ unsigned xb_xcc_id() { return (unsigned)__builtin_amdgcn_s_getreg((3 << 11) | 20) & 0xFu; }
#define XB_SPIN(cond, bar) do { unsigned _sp = 0; while (cond) { __builtin_amdgcn_s_sleep(1); \
    if ((++_sp & 255u) == 0u) { if (xb_ld(&(bar)[XB_TMO])) break; if (_sp > XB_SPIN_CAP) { atomicAdd(&(bar)[XB_TMO], 1u); break; } } } } while (0)

struct XcdBarrier {
    unsigned* bar; unsigned x;
    volatile LAS unsigned* st;
};

__device__ __forceinline__ XcdBarrier xcd_barrier_post(unsigned* bar, volatile LAS unsigned* st) {
    XcdBarrier b; b.bar = bar; b.x = xb_xcc_id(); b.st = st;
    if (threadIdx.x == 0) (void)xb_add(&bar[XB_XCNT(b.x)], 1u);
    return b;
}
__device__ __forceinline__ void xcd_barrier_complete(unsigned* bar, unsigned x, unsigned& nloc, unsigned& nx) {
    const unsigned G = gridDim.x * gridDim.y * gridDim.z;
    unsigned sum, cnt, mine, sp = 0u;
    for (;;) {
        sum = 0u; cnt = 0u; mine = 0u;
#pragma unroll
        for (unsigned j = 0; j < 16; ++j) { const unsigned c = xb_ld(&bar[XB_XCNT(j)]); sum += c; cnt += (c > 0u) ? 1u : 0u; mine = (j == x) ? c : mine; }
        if (sum == G) break;
        __builtin_amdgcn_s_sleep(1);
        if ((++sp & 255u) == 0u) { if (xb_ld(&bar[XB_TMO])) break; if (sp > XB_SPIN_CAP) { atomicAdd(&bar[XB_TMO], 1u); break; } }
    }
    nloc = mine > 0u ? mine : 1u; nx = cnt > 0u ? cnt : 1u;
}

__device__ __forceinline__ void xcd_barrier(const XcdBarrier& b) {
    asm volatile("s_waitcnt vmcnt(0)" ::: "memory");
    __syncthreads();
    if (threadIdx.x == 0) {
        unsigned* bar = b.bar;
        __builtin_amdgcn_s_waitcnt(0);
        unsigned nloc = b.st[0], nx = b.st[1];
        if (nloc == 0u) { xcd_barrier_complete(bar, b.x, nloc, nx); b.st[0] = nloc; b.st[1] = nx; }
        const unsigned old = xb_add(&bar[XB_XSUB(b.x)], 1u);
        const unsigned gen = old / nloc;
        if (old + 1u == (gen + 1u) * nloc) {
            __builtin_amdgcn_fence(__ATOMIC_RELEASE, "agent");
            asm volatile("s_waitcnt vmcnt(0)" ::: "memory");
            const unsigned og = xb_add(&bar[XB_TOP], 1u);
            const unsigned tg = og / nx;
            if (og + 1u == (tg + 1u) * nx) xb_add(&bar[XB_TOPGEN], 1u);
            else XB_SPIN(xb_ld(&bar[XB_TOPGEN]) == tg, bar);
            __builtin_amdgcn_fence(__ATOMIC_ACQUIRE, "agent");
            xb_add(&bar[XB_XGEN(b.x)], 1u);
            asm volatile("s_waitcnt vmcnt(0)" ::: "memory");
        } else {
            XB_SPIN(xb_ld(&bar[XB_XGEN(b.x)]) == gen, bar);
            __builtin_amdgcn_fence(__ATOMIC_ACQUIRE, "agent");
            asm volatile("s_waitcnt vmcnt(0)" ::: "memory");
        }
    }
    __syncthreads();
}

struct Args { const float* in[23]; float* out; char* ws; };
constexpr int LDS_BYTES = 131072 + 4096;

typedef const __attribute__((address_space(4))) Args* kargs_t;
DEV kargs_t KA() { kargs_t k = (kargs_t)__builtin_amdgcn_kernarg_segment_ptr(); asm volatile("" : "+s"(k)); return k; }
#define WSP(type, off) ((type*)(ws + (off)))

__global__ __launch_bounds__(NTHR, 2) void mega(Args a) {
  extern __shared__ __attribute__((aligned(16))) char lds[];
  cg::grid_group grid = cg::this_grid();
  PG8_LAS unsigned char* glds = (PG8_LAS unsigned char*)lds;
  const int bid = blockIdx.x, G = gridDim.x;
  (void)a;
  volatile LAS unsigned* bst = (volatile LAS unsigned*)((LAS char*)lds + LDS_BYTES - 16);
  if (threadIdx.x < 4) bst[threadIdx.x] = 0u;
  __syncthreads();
  XcdBarrier xbar; { kargs_t k = KA(); xbar = xcd_barrier_post((unsigned*)k->ws, bst); }

  { kargs_t k = KA(); char* ws = k->ws;
    const int wv0_ = threadIdx.x >> 6;
    if (wv0_ < 4) { const int lane_ = threadIdx.x & 63, wv_ = wv0_, gw_ = bid * 4 + wv_, nw_ = G * 4;
      __attribute__((address_space(3))) float* scr = (__attribute__((address_space(3))) float*)((__attribute__((address_space(3))) char*)lds + wv_ * 8448);
      constexpr int I_IN = 16 * 120, I_BR = 8 * 32, I_SQ = 16 * 32, I_C1 = 32 * 8, I_C2 = 4 * 8, I_UQ = 4 * 24, I_UKV = 2 * 32;
      constexpr int NITEMS = I_IN + 2 * I_BR + 2 * I_SQ + 2 * I_C1 + 2 * I_C2 + I_UQ + I_UKV;
      for (int it = gw_; it < NITEMS; it += nw_) {
        int r = it;
        if (r < I_IN) { tr_item<1>(k->in[2], 1024, IN_COLS, WSP(bf16_t, WS_WIN), 120, 3840, scr, r, lane_); continue; } r -= I_IN;
        if (r < I_BR) { tr_item<0>(k->in[13], 512, 1024, WSP(bf16_t, WS_WBN), 32, 1024, scr, r, lane_); continue; } r -= I_BR;
        if (r < I_BR) { tr_item<0>(k->in[14], 512, 1024, WSP(bf16_t, WS_WBM), 32, 1024, scr, r, lane_); continue; } r -= I_BR;
        if (r < I_SQ) { tr_item<0>(k->in[15], 1024, 1024, WSP(bf16_t, WS_WOUT), 32, 1024, scr, r, lane_); continue; } r -= I_SQ;
        if (r < I_SQ) { tr_item<0>(k->in[17], 1024, 1024, WSP(bf16_t, WS_WQ), 32, 1024, scr, r, lane_); continue; } r -= I_SQ;
        if (r < I_C1) { tr_item<0>(k->in[5], 2048, 256, WSP(bf16_t, WS_CKW1), 8, 256, scr, r, lane_); continue; } r -= I_C1;
        if (r < I_C1) { tr_item<0>(k->in[7], 2048, 256, WSP(bf16_t, WS_CVW1), 8, 256, scr, r, lane_); continue; } r -= I_C1;
        if (r < I_C2) { tr_item<0>(k->in[6], 256, 64, WSP(bf16_t, WS_CKW2), 8, 64, scr, r, lane_); continue; } r -= I_C2;
        if (r < I_C2) { tr_item<0>(k->in[8], 256, 64, WSP(bf16_t, WS_CVW2), 8, 64, scr, r, lane_); continue; } r -= I_C2;
        if (r < I_UQ) { tr_item<0>(k->in[11], 256, 768, WSP(bf16_t, WS_UQ), 24, 768, scr, r, lane_); continue; } r -= I_UQ;
        tr_item<0>(k->in[12], 128, 1024, WSP(bf16_t, WS_UKV), 32, 1024, scr, r, lane_);
      }
      for (int i = gw_ * 64 + lane_; i < 16 * 128 * 64; i += nw_ * 64) WSP(bf16_t, WS_SUBK)[i] = f2bf(k->in[18][i]);
      for (int i = gw_ * 64 + lane_; i < SEQ * 16; i += nw_ * 64) rope_entry(WSP(float2, WS_ROPE), i);
    } else ph_rms1024<false>(k->in[0], k->in[1], WSP(bf16_t, WS_XN), T, nullptr, nullptr, bid * 4 + (wv0_ - 4), G * 4); }
  grid.sync();
  { kargs_t k = KA(); char* ws = k->ws;
    pg8::Gemm g{WSP(bf16_t, WS_XN), WSP(bf16_t, WS_WIN), T, 3840, 1024}; pg8::StaticOrder S; S.init(T, 3840, G, bid);
    pg8::EpiInProjF E{WSP(bf16_t, WS_PROJ), WSP(bf16_t, WS_GATES)};
    pg8::gemm_phase<pg8::EpiInProjF, pg8::StaticOrder, PG8_ALIGN, PG8_SP2>(glds, g, S, E); }
  xcd_barrier(xbar);
  { kargs_t k = KA(); char* ws = k->ws;
    const int lane_ = threadIdx.x & 63, wv_ = threadIdx.x >> 6;
    if (G >= 128 && bid < 64) {
      const int tab = bid >> 5;
      pg8::Gemm g{WSP(bf16_t, WS_PROJ) + PC_KV + tab * 128, WSP(bf16_t, tab ? WS_CVW1 : WS_CKW1), 2048, 1024, 512};
      g.pitchA = 16u * PROJ_LD * 2u; g.kstepA = PROJ_LD * 2u; g.hstepA = 128; g.tA_pm = (size_t)SEQ * PROJ_LD * 2; g.tA_pn = (size_t)8 * PROJ_LD * 2;
      g.pitchB = 4096u; g.kstepB = 128u; g.hstepB = (size_t)128 * 4096; g.tB_pn = 1024; g.nt = 8;
      pg8::StaticOrder S; S.init(2048, 1024, 32, bid & 31);
      pg8::EpiSlabF E{WSP(float, WS_SLAB) + (size_t)tab * 4 * 2048 * 256};
      pg8::gemm_phase<pg8::EpiSlabF, pg8::StaticOrder, PG8_ALIGN, PG8_SP2>(glds, g, S, E);
    } else {
      const int nb = (G >= 128) ? G - 64 : G, b0 = (G >= 128) ? bid - 64 : bid;
      prep::cmp_bias(k->in[3], k->in[4], WSP(bf16_t, WS_CKW1), WSP(bf16_t, WS_CVW1), WSP(float, WS_CPOS), b0 * NWV + wv_, nb * NWV, lane_);
      prep::latent_rows(WSP(bf16_t, WS_PROJ), k->in[9], k->in[10], WSP(float2, WS_ROPE), WSP(bf16_t, WS_CQN), WSP(bf16_t, WS_CKVN), WSP(bf16_t, WS_KROPE), b0 * NWV + wv_, nb * NWV, lane_);
    } }
  xcd_barrier(xbar);
  { kargs_t k = KA(); char* ws = k->ws;
    pg8::Gemm g{WSP(bf16_t, WS_CQN), WSP(bf16_t, WS_UQ), T, 768, 256}; pg8::StaticOrder S; S.init(T, 768, G, (bid + 64) & 255);
    pg8::EpiMlaQF E{WSP(bf16_t, WS_MLAQ), WSP(float2, WS_ROPE)};
    pg8::gemm_phase<pg8::EpiMlaQF, pg8::StaticOrder, PG8_ALIGN, PG8_SP2>(glds, g, S, E); }
  { kargs_t k = KA(); char* ws = k->ws;
    pg8::Gemm g{WSP(bf16_t, WS_CKVN), WSP(bf16_t, WS_UKV), T, 1024, 128}; pg8::StaticOrder S; S.init(T, 1024, G, bid);
    pg8::EpiBf16<0> E{WSP(bf16_t, WS_MLAKV), 1024, nullptr, 0, 0, 1.f};
    pg8::gemm_phase<pg8::EpiBf16<0>, pg8::StaticOrder, PG8_ALIGN, PG8_SP2>(glds, g, S, E); }
  { kargs_t k = KA(); char* ws = k->ws;
    const int lane_ = threadIdx.x & 63, wv_ = threadIdx.x >> 6;
    for (int it = (G - 1 - bid) * NWV + wv_; it < 128; it += G * NWV) {
      const int tab = it >> 6;
      prep::cmp_l2(WSP(float, WS_SLAB) + (size_t)tab * 4 * 2048 * 256, WSP(float, WS_CPOS) + tab * 256, WSP(bf16_t, tab ? WS_CVW2 : WS_CKW2), WSP(bf16_t, tab ? WS_VC : WS_KC), it & 63, lane_);
    } }
  xcd_barrier(xbar);
  { kargs_t k = KA(); char* ws = k->ws;
    att::attn_phase(WSP(bf16_t, WS_PROJ), WSP(bf16_t, WS_KC), WSP(bf16_t, WS_VC), k->in[21], WSP(bf16_t, WS_ONSA),
                    WSP(bf16_t, WS_MLAQ), WSP(bf16_t, WS_MLAKV), WSP(bf16_t, WS_KROPE), WSP(bf16_t, WS_OMLA), (att::lptr)lds); }
  xcd_barrier(xbar);
  { kargs_t k = KA(); char* ws = k->ws;
    pg8::Gemm g{WSP(bf16_t, WS_ONSA), WSP(bf16_t, WS_WBN), T, 1024, 512}; pg8::StaticOrder S; S.init(T, 1024, G, bid);
    pg8::EpiMergeF<0> E{WSP(bf16_t, WS_GATES), WSP(bf16_t, WS_MERGED)};
    pg8::gemm_phase<pg8::EpiMergeF<0>, pg8::StaticOrder, PG8_ALIGN, PG8_SP2>(glds, g, S, E); }
  { kargs_t k = KA(); char* ws = k->ws;
    pg8::Gemm g{WSP(bf16_t, WS_OMLA), WSP(bf16_t, WS_WBM), T, 1024, 512}; pg8::StaticOrder S; S.init(T, 1024, G, bid);
    pg8::EpiMergeF<1> E{WSP(bf16_t, WS_GATES), WSP(bf16_t, WS_MERGED)};
    pg8::gemm_phase<pg8::EpiMergeF<1>, pg8::StaticOrder, PG8_ALIGN, PG8_SP2>(glds, g, S, E); }
  xcd_barrier(xbar);
  { kargs_t k = KA(); char* ws = k->ws;
    pg8::Gemm g{WSP(bf16_t, WS_MERGED), WSP(bf16_t, WS_WOUT), T, 1024, 1024}; pg8::StaticOrder S; S.init(T, 1024, G, bid);
    pg8::EpiResidF E{k->in[0], k->out};
    pg8::gemm_phase<pg8::EpiResidF, pg8::StaticOrder, PG8_ALIGN, PG8_SP2>(glds, g, S, E); }
  xcd_barrier(xbar);
  { kargs_t k = KA(); char* ws = k->ws; ph_rms1024<true>(k->out, k->in[16], WSP(bf16_t, WS_HN), T, WSP(unsigned, WS_HN8), WSP(float, WS_SH));
    peer::conv_tables(k->in[19], k->in[20], WSP(unsigned, WS_U8), WSP(float, WS_SU), WSP(unsigned, WS_V8)); }
  xcd_barrier(xbar);
  { kargs_t k = KA(); char* ws = k->ws;
    pg8::Gemm g{WSP(bf16_t, WS_HN), WSP(bf16_t, WS_WQ), T, 1024, 1024}; pg8::StaticOrder S; S.init(T, 1024, G, bid);
    pg8::EpiBf16<0> E{WSP(bf16_t, WS_PQ), 1024, nullptr, 0, 0, 1.f};
    pg8::gemm_phase<pg8::EpiBf16<0>, pg8::StaticOrder, PG8_ALIGN, PG8_SP2>(glds, g, S, E); }
  xcd_barrier(xbar);
  { kargs_t k = KA(); char* ws = k->ws; peer::route_phase(WSP(bf16_t, WS_PQ), WSP(bf16_t, WS_SUBK), WSP(unsigned, WS_PIDX), (__attribute__((address_space(3))) char*)lds); }
  xcd_barrier(xbar);
  { kargs_t k = KA(); char* ws = k->ws;
    peer::experts_sliced<0>(WSP(unsigned, WS_PIDX), WSP(unsigned, WS_HN8), WSP(float, WS_SH), WSP(unsigned, WS_U8), WSP(float, WS_SU), WSP(float, WS_CO), WSP(unsigned, WS_V8), k->out, WSP(float, WS_SSQ),
                            (unsigned*)ws + CTL_QA, (__attribute__((address_space(3))) char*)lds); }
  xcd_barrier(xbar);
  { kargs_t k = KA(); char* ws = k->ws;
    peer::experts_sliced<1>(WSP(unsigned, WS_PIDX), WSP(unsigned, WS_HN8), WSP(float, WS_SH), WSP(unsigned, WS_U8), WSP(float, WS_SU), WSP(float, WS_CO), WSP(unsigned, WS_V8), k->out, WSP(float, WS_SSQ),
                            (unsigned*)ws + CTL_QB, (__attribute__((address_space(3))) char*)lds); }
  xcd_barrier(xbar);
  { kargs_t k = KA(); char* ws = k->ws; peer::experts_norm(WSP(float, WS_SSQ), k->in[22], k->out); }
}

extern "C" void kernel_launch(void* const* d_in, const int* in_sizes, int n_in, void* d_out, int out_size, void* d_ws, size_t ws_size, hipStream_t stream) {
  if (n_in != 23 || ws_size < 256 * MiB) { fprintf(stderr, "kernel_launch: unexpected n_in %d / ws_size %zu\n", n_in, ws_size); return; }
  static int grid_blocks = 0;
  if (!grid_blocks) {
    int dev = 0, cus = 0, per_cu = 0;
    (void)hipGetDevice(&dev);
    (void)hipDeviceGetAttribute(&cus, hipDeviceAttributeMultiprocessorCount, dev);
    if (hipFuncSetAttribute((const void*)mega, hipFuncAttributeMaxDynamicSharedMemorySize, LDS_BYTES) != hipSuccess) fprintf(stderr, "kernel_launch: hipFuncSetAttribute failed\n");
    (void)hipOccupancyMaxActiveBlocksPerMultiprocessor(&per_cu, (const void*)mega, NTHR, LDS_BYTES);
    if (per_cu < 1) { fprintf(stderr, "kernel_launch: occupancy query returned %d\n", per_cu); per_cu = 1; }
    if (per_cu > 2) per_cu = 2;
    grid_blocks = cus * per_cu;
    fprintf(stderr, "kernel_launch: cus %d per_cu %d grid %d ws %zu\n", cus, per_cu, grid_blocks, ws_size);
  }
  if (hipMemsetAsync(d_ws, 0, 65536, stream) != hipSuccess) fprintf(stderr, "kernel_launch: hipMemsetAsync failed\n");
  Args a{};
  for (int i = 0; i < 23; ++i) a.in[i] = (const float*)d_in[i];
  a.out = (float*)d_out; a.ws = (char*)d_ws;
  void* args[] = {&a};
  hipError_t e = hipLaunchCooperativeKernel((const void*)mega, dim3(grid_blocks), dim3(NTHR), args, LDS_BYTES, stream);
  if (e != hipSuccess) fprintf(stderr, "cooperative launch failed: %s (grid %d)\n", hipGetErrorString(e), grid_blocks);
}
```

```cpp
#include <hip/hip_runtime.h>
#include <stdint.h>
#include <cstdio>
#include <hip/hip_cooperative_groups.h>
namespace cg = cooperative_groups;

typedef unsigned short bf16_t;
#define DEV __device__ __forceinline__

constexpr int BATCH = 8, SEQ = 2048, DM = 1024, T = BATCH * SEQ;
constexpr int IN_COLS = 3768;
constexpr int PROJ_LD = 1792;
constexpr int PC_Q = 0, PC_KV = 512, PC_CQ = 1280, PC_CKV = 1536, PC_KR = 1664, PC_GATE = 1696;
constexpr int NC = 127;
constexpr size_t MiB = 1u << 20;

constexpr size_t WS_WIN = 1 * MiB;
constexpr size_t WS_WBN = 9 * MiB;
constexpr size_t WS_WBM = 10 * MiB;
constexpr size_t WS_WOUT = 11 * MiB;
constexpr size_t WS_WQ = 13 * MiB;
constexpr size_t WS_CKW1 = 15 * MiB;
constexpr size_t WS_CVW1 = 16 * MiB;
constexpr size_t WS_CKW2 = 17 * MiB;
constexpr size_t WS_CVW2 = 17 * MiB + 128 * 1024;
constexpr size_t WS_UQ = 17 * MiB + 256 * 1024;
constexpr size_t WS_UKV = 17 * MiB + 768 * 1024;
constexpr size_t WS_SUBK = 18 * MiB;
constexpr size_t WS_ROPE = 18 * MiB + 512 * 1024;
constexpr size_t WS_GATES = 20 * MiB;
constexpr size_t WS_PQ = 20 * MiB;
constexpr size_t WS_PROJ = 84 * MiB;
constexpr size_t WS_MERGED = 84 * MiB;
constexpr size_t WS_PIDX = 84 * MiB;
constexpr size_t WS_U8 = 172 * MiB;
constexpr size_t WS_V8 = 188 * MiB;
constexpr size_t WS_SU = 204 * MiB;
constexpr size_t WS_SH = 204 * MiB + 65536;
constexpr size_t WS_HN8 = 205 * MiB;
constexpr size_t WS_CO = 221 * MiB;
constexpr size_t WS_SSQ = 229 * MiB;
constexpr int CTL_QA = 4096, CTL_QB = 4096 + 512;
constexpr size_t WS_PW = 92 * MiB;
constexpr size_t WS_XN = 140 * MiB;
constexpr size_t WS_MLAKV = 140 * MiB;
constexpr size_t WS_HN = 140 * MiB;
constexpr size_t WS_MLAQ = 172 * MiB;
constexpr size_t WS_KROPE = 196 * MiB;
constexpr size_t WS_KC = 197 * MiB;
constexpr size_t WS_VC = 197 * MiB + 512 * 1024;
constexpr size_t WS_ONSA = 198 * MiB;
constexpr size_t WS_OMLA = 214 * MiB;
constexpr size_t WS_SLAB = 198 * MiB;
constexpr size_t WS_CPOS = 18 * MiB + 768 * 1024;
constexpr size_t WS_CA = 198 * MiB;
constexpr size_t WS_HID = 206 * MiB;
constexpr size_t WS_HID2 = 207 * MiB;
constexpr size_t WS_CA2 = 214 * MiB;
constexpr size_t WS_CQN = 230 * MiB;
constexpr size_t WS_CKVN = 238 * MiB;
constexpr size_t WS_OCMP = 230 * MiB;
constexpr size_t WS_SEL = 246 * MiB;

__device__ const unsigned char T5B[128] = {
  0, 1, 2, 3, 4, 5, 6, 7, 8, 9, 10, 11, 12, 13, 14, 15, 16, 16, 16, 17, 17, 18, 18, 18, 19, 19, 19, 20, 20, 20, 20, 21,
  21, 21, 21, 22, 22, 22, 22, 22, 23, 23, 23, 23, 23, 23, 24, 24, 24, 24, 24, 24, 25, 25, 25, 25, 25, 25, 25, 26, 26, 26, 26, 26,
  26, 26, 26, 27, 27, 27, 27, 27, 27, 27, 27, 27, 27, 28, 28, 28, 28, 28, 28, 28, 28, 28, 28, 29, 29, 29, 29, 29, 29, 29, 29, 29,
  29, 29, 29, 30, 30, 30, 30, 30, 30, 30, 30, 30, 30, 30, 30, 30, 30, 31, 31, 31, 31, 31, 31, 31, 31, 31, 31, 31, 31, 31, 31, 31};

DEV float bf2f(bf16_t v) { return __uint_as_float(((unsigned)v) << 16); }
DEV bf16_t f2bf(float f) { unsigned u = __float_as_uint(f); u += 0x7fffu + ((u >> 16) & 1u); return (bf16_t)(u >> 16); }
template <int CTRL> DEV int dpp_i(int v) { return __builtin_amdgcn_update_dpp(0, v, CTRL, 0xF, 0xF, true); }
template <int CTRL> DEV float dpp_f(float v) { return __uint_as_float((unsigned)__builtin_amdgcn_update_dpp(0, (int)__float_as_uint(v), CTRL, 0xF, 0xF, true)); }
DEV int sum16_i(int v) { v += dpp_i<0xB1>(v); v += dpp_i<0x4E>(v); v += dpp_i<0x141>(v); v += dpp_i<0x140>(v); return v; }
DEV float sum16_f(float v) { v += dpp_f<0xB1>(v); v += dpp_f<0x4E>(v); v += dpp_f<0x141>(v); v += dpp_f<0x140>(v); return v; }
DEV float max16_f(float v) { v = fmaxf(v, dpp_f<0xB1>(v)); v = fmaxf(v, dpp_f<0x4E>(v)); v = fmaxf(v, dpp_f<0x141>(v)); v = fmaxf(v, dpp_f<0x140>(v)); return v; }
DEV float rl_f(float v, int l) { return __uint_as_float((unsigned)__builtin_amdgcn_readlane((int)__float_as_uint(v), l)); }
DEV float wsum(float v) { v = sum16_f(v); return (rl_f(v, 0) + rl_f(v, 16)) + (rl_f(v, 32) + rl_f(v, 48)); }
DEV float wmaxf(float v) { v = max16_f(v); return fmaxf(fmaxf(rl_f(v, 0), rl_f(v, 16)), fmaxf(rl_f(v, 32), rl_f(v, 48))); }
DEV float sigmoidf_(float x) { return 1.0f / (1.0f + expf(-x)); }
DEV float gelu_exact(float x) { return 0.5f * x * (1.0f + erff(x * 0.70710678118654752f)); }
DEV void wave_lds_sync() { asm volatile("s_waitcnt lgkmcnt(0)" ::: "memory"); __builtin_amdgcn_wave_barrier(); asm volatile("" ::: "memory"); }
DEV float t5bias(const float* t5, int head, int dist) { int d = dist < 127 ? dist : 127; d = d < 0 ? 0 : d; return t5[(int)T5B[d] * 8 + head]; }


namespace pg8 {
#define PG8_LAS __attribute__((address_space(3)))
typedef unsigned short bf16_t;
typedef short bf16x8 __attribute__((ext_vector_type(8)));
typedef float f32x4 __attribute__((ext_vector_type(4)));
typedef unsigned u32x4 __attribute__((ext_vector_type(4)));
constexpr int BM = 256, BK = 64, HALF = 128, HTB = HALF * BK * 2  , STAGE_BYTES = 8 * HTB, NXCD = 8, WGM = 8;

__host__ __device__ __forceinline__ int lds_byte(int r, int c) { const int st = (r >> 4) * 2 + (c >> 5), rr = r & 15, cc = c & 31, ob = rr * 64 + cc * 2; return st * 1024 + (ob ^ (((ob >> 9) & 1) << 5)); }
__host__ __device__ __forceinline__ void stage_rc(int b, int& R, int& C) { const int st = b / 1024, sb = b % 1024, swz = sb ^ (((sb >> 9) & 1) << 5); R = (st >> 1) * 16 + swz / 64; C = (st & 1) * 32 + (swz % 64) / 2; }
__host__ __device__ __forceinline__ int perm32(int rho) { const int n = rho >> 4, i = rho & 15; return 8 * (i >> 2) + 4 * n + (i & 3); }

struct Unit { int pm, pn; };
struct Gemm { const bf16_t* A; const bf16_t* Bt; int M, N, K;
    unsigned pitchA = 0, pitchB = 0, kstepA = 0, kstepB = 0; size_t hstepA = 0, hstepB = 0, tA_pm = 0, tA_pn = 0, tB_pn = 0; int nt = 0; };

struct StaticOrder {
    int nM, nN, nwg, G, c;
    __host__ __device__ void init(int M, int N, int G_, int c_) { nM = M / BM; nN = N / BM; nwg = nM * nN; G = G_; c = c_; }
    __host__ __device__ bool next(int i, Unit& u) const {
        const long L = (long)i * G + c; if (L >= nwg) return false;
        int wgid = (int)L; { const int q = nwg / NXCD, r = nwg % NXCD, xcd = wgid % NXCD, off = wgid / NXCD; wgid = (xcd < r ? xcd * (q + 1) : r * (q + 1) + (xcd - r) * q) + off; }
        const int nig = WGM * nN, gid = wgid / nig, fm = gid * WGM, gsz = (nM - fm) < WGM ? (nM - fm) : WGM;
        u.pm = fm + ((wgid % nig) % gsz); u.pn = (wgid % nig) / gsz; return true;
    }
    __device__ __forceinline__ void a_ready(const Unit&) const {}
    __device__ __forceinline__ void done(const Unit&) const {}
};

__device__ __forceinline__ unsigned cvt_pk_bf16(float lo, float hi) { unsigned r; asm volatile("v_cvt_pk_bf16_f32 %0, %1, %2" : "=v"(r) : "v"(lo), "v"(hi)); return r; }
typedef float f32x2 __attribute__((ext_vector_type(2)));
__device__ __forceinline__ f32x2 gelu_pk(f32x2 v) {
    const f32x2 av = __builtin_elementwise_abs(v), d = av * 0.2316418882f + 1.0f;
    f32x2 t; t.x = __builtin_amdgcn_rcpf(d.x); t.y = __builtin_amdgcn_rcpf(d.y);
    f32x2 q = t * 0.5307027145f + (-0.7265760135f); q = q * t + 0.7107068705f; q = q * t + (-0.142248368f); q = q * t + 0.127414796f; q = q * t;
    const f32x2 s = (v * v) * (-0.72134752044f);
    f32x2 e; e.x = __builtin_amdgcn_exp2f(s.x); e.y = __builtin_amdgcn_exp2f(s.y);
    const f32x2 m = v * (q * e), r = v - m;
    f32x2 o; o.x = v.x < 0.f ? m.x : r.x; o.y = v.y < 0.f ? m.y : r.y; return o;
}

template <int ACT  > struct EpiBf16 {
    static constexpr bool PERM = true, AFTER_DRAIN = false; static_assert(ACT == 0 || ACT == 1, "EpiBf16: ACT is 0 (none) or 1 (gelu_pk)");
    bf16_t* O; int ldc; const float* bias; int split_cols; size_t split_stride; float scale0;
    __device__ __forceinline__ void operator()(const f32x4 (&acc)[2][2][4][2], const Unit& u, int wr, int wc, int fr, int fq) const {
        const int row0 = u.pm * BM + wr * 64 + fr; int colt = u.pn * BM; bf16_t* base = O;
        float sc = 1.f; if (split_cols) { const int t = colt / split_cols; base += (size_t)t * split_stride; colt -= t * split_cols; if (t == 0) sc = scale0; }
        const int col0 = colt + wc * 32 + 8 * fq, bcol0 = u.pn * BM + wc * 32 + 8 * fq;
        f32x4 bv[2][2];
#pragma unroll
        for (int bj = 0; bj < 2; ++bj)
#pragma unroll
            for (int n = 0; n < 2; ++n) bv[bj][n] = bias ? *(const f32x4*)(bias + bcol0 + bj * HALF + 4 * n) : (f32x4){0.f, 0.f, 0.f, 0.f};
#pragma unroll
        for (int ai = 0; ai < 2; ++ai)
#pragma unroll
            for (int m = 0; m < 4; ++m) { bf16_t* rowp = base + (size_t)(row0 + ai * HALF + m * 16) * ldc + col0;
#pragma unroll
                for (int bj = 0; bj < 2; ++bj) { f32x4 v0 = acc[ai][bj][m][0] + bv[bj][0], v1 = acc[ai][bj][m][1] + bv[bj][1];
                    if (ACT == 1) { f32x2 a = gelu_pk((f32x2){v0[0], v0[1]}), b = gelu_pk((f32x2){v0[2], v0[3]}), c = gelu_pk((f32x2){v1[0], v1[1]}), d = gelu_pk((f32x2){v1[2], v1[3]});
                        v0 = (f32x4){a.x, a.y, b.x, b.y}; v1 = (f32x4){c.x, c.y, d.x, d.y}; }
                    v0 = v0 * sc; v1 = v1 * sc; u32x4 w; w.x = cvt_pk_bf16(v0[0], v0[1]); w.y = cvt_pk_bf16(v0[2], v0[3]); w.z = cvt_pk_bf16(v1[0], v1[1]); w.w = cvt_pk_bf16(v1[2], v1[3]);
                    *(u32x4*)(rowp + bj * HALF) = w; } }
    }
};

struct PanelStats {
    unsigned* xbuf;
    unsigned* cnt;
    unsigned* tmo;
    int ntn; float eps;
    unsigned code;
    __device__ __forceinline__ bool run(const f32x4 (&v)[2][2][4][2], const Unit& u, int wr, int wc, int fr, int fq, PG8_LAS unsigned char* lds, int wid, int lane) const {
        typedef float f32x2v __attribute__((ext_vector_type(2)));
        PG8_LAS f32x2v* P = (PG8_LAS f32x2v*)lds;
        PG8_LAS f32x2v* S = (PG8_LAS f32x2v*)(lds + 8192);
        PG8_LAS unsigned* flag = (PG8_LAS unsigned*)(lds + 8192 + 2048);
#pragma unroll
        for (int ai = 0; ai < 2; ++ai)
#pragma unroll
            for (int m = 0; m < 4; ++m) {
                float s = 0.f;
#pragma unroll
                for (int bj = 0; bj < 2; ++bj)
#pragma unroll
                    for (int n = 0; n < 2; ++n) { const f32x4 x = v[ai][bj][m][n]; s += (x[0] + x[1]) + (x[2] + x[3]); }
                s += __shfl_xor(s, 16); s += __shfl_xor(s, 32);
                const float mw = s * (1.0f / 64.0f); float q = 0.f;
#pragma unroll
                for (int bj = 0; bj < 2; ++bj)
#pragma unroll
                    for (int n = 0; n < 2; ++n) { const f32x4 d = v[ai][bj][m][n] - mw; q += (d[0] * d[0] + d[1] * d[1]) + (d[2] * d[2] + d[3] * d[3]); }
                q += __shfl_xor(q, 16); q += __shfl_xor(q, 32);
                if (fq == 0) P[(ai * HALF + wr * 64 + m * 16 + fr) * 4 + wc] = (f32x2v){mw, q};
            }
        asm volatile("s_waitcnt lgkmcnt(0)" ::: "memory"); __builtin_amdgcn_s_barrier(); asm volatile("" ::: "memory");
#if defined(BROKEN_EXCHANGE_NO_WAIT)
#warning BROKEN CONTROL BUILD: the row-statistics exchange does not wait; results are wrong by design
        if (blockIdx.x >= 64) { const long long t0_ = clock64(); while (clock64() - t0_ < 60000) __builtin_amdgcn_s_sleep(8); }
#endif
        const int row = wid * 32 + (lane & 31);
        if (lane < 32) {
            const f32x2v a = P[row * 4 + 0], b = P[row * 4 + 1], c = P[row * 4 + 2], d = P[row * 4 + 3];
            const float mt = (a.x + b.x + c.x + d.x) * 0.25f;
            const float da = a.x - mt, db = b.x - mt, dc = c.x - mt, dd = d.x - mt;
            const float m2 = (a.y + b.y) + (c.y + d.y) + 64.0f * ((da * da + db * db) + (dc * dc + dd * dd));
            unsigned long long* slot = (unsigned long long*)xbuf + ((size_t)(u.pm * BM + row) * 4 + u.pn);
            __hip_atomic_store(slot, ((unsigned long long)__float_as_uint(m2) << 32) | __float_as_uint(mt), __ATOMIC_RELAXED, __HIP_MEMORY_SCOPE_AGENT);
        }
        asm volatile("s_waitcnt vmcnt(0)" ::: "memory");
        if (lane == 0) __hip_atomic_fetch_add(cnt + 64 * u.pm, 1u, __ATOMIC_RELAXED, __HIP_MEMORY_SCOPE_AGENT);
        if (wid == 0) {
            bool dead = false; const unsigned long long t0 = __builtin_amdgcn_s_memrealtime(); const unsigned want = 8u * (unsigned)ntn;
            for (;;) {
#if defined(BROKEN_EXCHANGE_NO_WAIT)
                break;
#endif
                if ((unsigned)__builtin_amdgcn_readfirstlane(__hip_atomic_load(cnt + 64 * u.pm, __ATOMIC_RELAXED, __HIP_MEMORY_SCOPE_AGENT)) >= want) break;
                if (__builtin_amdgcn_s_memrealtime() - t0 > 2000000ull) {
                    if (lane == 0) { unsigned expect = 0u; __hip_atomic_compare_exchange_strong(tmo + 1, &expect, code | (unsigned)(u.pm & 0xff), __ATOMIC_RELAXED, __ATOMIC_RELAXED, __HIP_MEMORY_SCOPE_AGENT);
                                     __hip_atomic_store(tmo, 1u, __ATOMIC_RELAXED, __HIP_MEMORY_SCOPE_AGENT); }
                    dead = true; break; }
                __builtin_amdgcn_s_sleep(2);
            }
            __builtin_amdgcn_fence(__ATOMIC_ACQUIRE, "agent");
            if (lane == 0) flag[0] = dead ? 1u : 0u;
        }
        asm volatile("s_waitcnt vmcnt(0) lgkmcnt(0)" ::: "memory"); __builtin_amdgcn_s_barrier(); asm volatile("" ::: "memory");
        const bool bad = flag[0] != 0u;
        if (lane < 32) {
            const unsigned long long* slot = (const unsigned long long*)xbuf + (size_t)(u.pm * BM + row) * 4; float mt[4], m2[4]; float ms = 0.f;
#pragma unroll
            for (int t = 0; t < 4; ++t) { if (t < ntn) { const unsigned long long w = __hip_atomic_load(slot + t, __ATOMIC_RELAXED, __HIP_MEMORY_SCOPE_AGENT); mt[t] = __uint_as_float((unsigned)w); m2[t] = __uint_as_float((unsigned)(w >> 32)); } else { mt[t] = 0.f; m2[t] = 0.f; } ms += mt[t]; }
            const float mean = ms / (float)ntn; float q = 0.f;
#pragma unroll
            for (int t = 0; t < 4; ++t) if (t < ntn) { const float dm = mt[t] - mean; q += m2[t] + 256.0f * dm * dm; }
            S[row] = (f32x2v){mean, 1.0f / sqrtf(q / (256.0f * (float)ntn) + eps)};
        }
        asm volatile("s_waitcnt lgkmcnt(0)" ::: "memory"); __builtin_amdgcn_s_barrier(); asm volatile("" ::: "memory");
        return bad;
    }
};
struct EpiLnRes {
    static constexpr bool PERM = false, AFTER_DRAIN = true;
    const float* base; float* out; int ldc; const float* bias; PanelStats st; unsigned poison;
    __device__ __forceinline__ void fused(f32x4 (&acc)[2][2][4][2], const Unit& u, int wr, int wc, int fr, int fq, PG8_LAS unsigned char* lds, int wid, int lane) const {
        typedef float f32x2v __attribute__((ext_vector_type(2)));
        const PG8_LAS f32x2v* S = (const PG8_LAS f32x2v*)(lds + 8192);
        const int col0 = u.pn * BM + wc * 32 + 4 * fq;
#pragma unroll
        for (int bj = 0; bj < 2; ++bj)
#pragma unroll
            for (int n = 0; n < 2; ++n) { const f32x4 bv = bias ? *(const f32x4*)(bias + col0 + bj * HALF + n * 16) : (f32x4){0.f, 0.f, 0.f, 0.f};
#pragma unroll
                for (int ai = 0; ai < 2; ++ai)
#pragma unroll
                    for (int m = 0; m < 4; ++m) acc[ai][bj][m][n] += bv; }
        f32x4 pre[4][2][2];
#pragma unroll
        for (int m = 0; m < 4; ++m) { const size_t off = (size_t)(u.pm * BM + wr * 64 + m * 16 + fr) * ldc + col0;
#pragma unroll
            for (int bj = 0; bj < 2; ++bj)
#pragma unroll
                for (int n = 0; n < 2; ++n) pre[m][bj][n] = *(const f32x4*)(base + off + bj * HALF + n * 16); }
        const bool bad = st.run(acc, u, wr, wc, fr, fq, lds, wid, lane) || poison != 0u;
        const float qnan = __builtin_nanf("");
#pragma unroll
        for (int ai = 0; ai < 2; ++ai)
#pragma unroll
            for (int m = 0; m < 4; ++m) { const int r = ai * HALF + wr * 64 + m * 16 + fr; const f32x2v sr = S[r]; const size_t off = (size_t)(u.pm * BM + r) * ldc + col0;
#pragma unroll
                for (int bj = 0; bj < 2; ++bj)
#pragma unroll
                    for (int n = 0; n < 2; ++n) { const f32x4 bs = ai == 0 ? pre[m][bj][n] : *(const f32x4*)(base + off + bj * HALF + n * 16); f32x4 o = bs + (acc[ai][bj][m][n] - sr.x) * sr.y;
                        if (bad) o = (f32x4){qnan, qnan, qnan, qnan}; *(f32x4*)(out + off + bj * HALF + n * 16) = o; }
                if (m & 1) asm volatile("" ::: "memory"); }
    }
};
struct EpiLnResLn {
    static constexpr bool PERM = false, AFTER_DRAIN = true;
    const float* base; float* out; bf16_t* xn; int ldc; const float* bias; PanelStats st1, st2; unsigned poison;
    __device__ __forceinline__ void fused(f32x4 (&acc)[2][2][4][2], const Unit& u, int wr, int wc, int fr, int fq, PG8_LAS unsigned char* lds, int wid, int lane) const {
        typedef float f32x2v __attribute__((ext_vector_type(2))); typedef unsigned u32x2v __attribute__((ext_vector_type(2)));
        const PG8_LAS f32x2v* S = (const PG8_LAS f32x2v*)(lds + 8192);
        const int col0 = u.pn * BM + wc * 32 + 4 * fq;
#pragma unroll
        for (int bj = 0; bj < 2; ++bj)
#pragma unroll
            for (int n = 0; n < 2; ++n) { const f32x4 bv = bias ? *(const f32x4*)(bias + col0 + bj * HALF + n * 16) : (f32x4){0.f, 0.f, 0.f, 0.f};
#pragma unroll
                for (int ai = 0; ai < 2; ++ai)
#pragma unroll
                    for (int m = 0; m < 4; ++m) acc[ai][bj][m][n] += bv; }
        bool bad = st1.run(acc, u, wr, wc, fr, fq, lds, wid, lane) || poison != 0u;
        const float qnan = __builtin_nanf("");
#pragma unroll
        for (int ai = 0; ai < 2; ++ai)
#pragma unroll
            for (int m = 0; m < 4; ++m) { const int r = ai * HALF + wr * 64 + m * 16 + fr; const f32x2v sr = S[r]; const size_t off = (size_t)(u.pm * BM + r) * ldc + col0;
#pragma unroll
                for (int bj = 0; bj < 2; ++bj)
#pragma unroll
                    for (int n = 0; n < 2; ++n) { const f32x4 bs = *(const f32x4*)(base + off + bj * HALF + n * 16); acc[ai][bj][m][n] = bs + (acc[ai][bj][m][n] - sr.x) * sr.y; }
                asm volatile("" : "+v"(acc[ai][0][m][0]), "+v"(acc[ai][0][m][1]), "+v"(acc[ai][1][m][0]), "+v"(acc[ai][1][m][1]));
                if (m & 1) asm volatile("" ::: "memory"); }
        const bool bad1 = bad;
        bad = st2.run(acc, u, wr, wc, fr, fq, lds, wid, lane) || bad;
#pragma unroll
        for (int ai = 0; ai < 2; ++ai)
#pragma unroll
            for (int m = 0; m < 4; ++m) { const int r = ai * HALF + wr * 64 + m * 16 + fr; const f32x2v sr = S[r]; const size_t off = (size_t)(u.pm * BM + r) * ldc + col0;
#pragma unroll
                for (int bj = 0; bj < 2; ++bj)
#pragma unroll
                    for (int n = 0; n < 2; ++n) { const f32x4 x1 = acc[ai][bj][m][n]; *(f32x4*)(out + off + bj * HALF + n * 16) = bad1 ? (f32x4){qnan, qnan, qnan, qnan} : x1;
                        const f32x4 o = (x1 - sr.x) * sr.y; u32x2v w; w.x = cvt_pk_bf16(o[0], o[1]); w.y = cvt_pk_bf16(o[2], o[3]);
                        if (bad) { w.x = 0x7fc07fc0u; w.y = 0x7fc07fc0u; } *(u32x2v*)(xn + off + bj * HALF + n * 16) = w; }
                asm volatile("" ::: "memory"); }
    }
};

template <class Epi, class Sched, bool ALIGN_EPI = false, bool SP2 = false>
__device__ __forceinline__ void gemm_phase(PG8_LAS unsigned char* lds, const Gemm g, const Sched& S, const Epi& E) {
    int tid = threadIdx.x; asm volatile("" : "+v"(tid));
    const int wid = __builtin_amdgcn_readfirstlane(tid >> 6), lane = tid & 63, wr = wid >> 2, wc = wid & 3, fr = lane & 15, fq = lane >> 4;
    int K = g.K; asm volatile("" : "+s"(K)); const int nt = g.nt ? g.nt : K / BK;
    const unsigned pitchA = g.pitchA ? g.pitchA : (unsigned)K * 2u, pitchB = g.pitchB ? g.pitchB : (unsigned)K * 2u;
    unsigned voffA[2], voffB[2];
#pragma unroll
    for (int i = 0; i < 2; ++i) { int R, C; stage_rc(tid * 16 + i * 8192, R, C); const int Rb = Epi::PERM ? ((R & ~31) + perm32(R & 31)) : R;
        voffA[i] = (unsigned)R * pitchA + (unsigned)C * 2u; voffB[i] = (unsigned)Rb * pitchB + (unsigned)C * 2u; }
    const size_t kstepA = g.kstepA ? g.kstepA : (size_t)(BK * 2), kstepB = g.kstepB ? g.kstepB : (size_t)(BK * 2);
    const size_t hstepA = g.hstepA ? g.hstepA : (size_t)HALF * K * 2, hstepB = g.hstepB ? g.hstepB : (size_t)HALF * K * 2;
    const size_t tA_pm = g.tA_pm ? g.tA_pm : (size_t)BM * K * 2, tA_pn = g.tA_pn, tB_pn = g.tB_pn ? g.tB_pn : (size_t)BM * K * 2;
    const unsigned ldsw = (unsigned)wid * 1024u;
    const int aoff = lds_byte(wr * 64 + fr, fq * 8), boff = lds_byte(wc * 32 + fr, fq * 8);
#define PG8_SA(b, h) (((b) * 2 + (h)) * HTB)
#define PG8_SB(b, h) ((4 + (b) * 2 + (h)) * HTB)
#define PG8_STAGE(bufoff, gbase, voff) do { _Pragma("unroll") for (int _i = 0; _i < 2; ++_i) \
        __builtin_amdgcn_global_load_lds((const unsigned*)((const char*)(gbase) + (voff)[_i]), (PG8_LAS unsigned*)(lds + (bufoff) + ldsw + _i * 8192), 16, 0, 0); } while (0)
#define PG8_LDA(dst, b, h) do { _Pragma("unroll") for (int m = 0; m < 4; ++m) _Pragma("unroll") for (int k = 0; k < 2; ++k) dst[m][k] = *(const PG8_LAS bf16x8*)(lds + PG8_SA(b, h) + aoff + m * 2048 + k * 1024); } while (0)
#define PG8_LDB(dst, b, h) do { _Pragma("unroll") for (int n = 0; n < 2; ++n) _Pragma("unroll") for (int k = 0; k < 2; ++k) dst[n][k] = *(const PG8_LAS bf16x8*)(lds + PG8_SB(b, h) + boff + n * 2048 + k * 1024); } while (0)
#define PG8_MMA(ai, bj, At, Bt) do { __builtin_amdgcn_s_setprio(1); _Pragma("unroll") for (int m = 0; m < 4; ++m) _Pragma("unroll") for (int n = 0; n < 2; ++n) _Pragma("unroll") for (int k = 0; k < 2; ++k) \
        acc[ai][bj][m][n] = __builtin_amdgcn_mfma_f32_16x16x32_bf16(Bt[n][k], At[m][k], acc[ai][bj][m][n], 0, 0, 0); __builtin_amdgcn_s_setprio(0); } while (0)
#define PG8_WAIT_V(n) asm volatile("s_waitcnt vmcnt(" #n ")" ::: "memory")
#define PG8_WAIT_L(n) asm volatile("s_waitcnt lgkmcnt(" #n ")" ::: "memory")
#define PG8_BAR __builtin_amdgcn_s_barrier()
#define PG8_SCHED __builtin_amdgcn_sched_barrier(0)
    Unit cur, nxt; int ui = 0;
    if (!S.next(0, cur)) return;
    f32x4 acc[2][2][4][2];
#pragma unroll
    for (int a = 0; a < 2; ++a)
#pragma unroll
        for (int b = 0; b < 2; ++b)
#pragma unroll
            for (int m = 0; m < 4; ++m)
#pragma unroll
                for (int n = 0; n < 2; ++n) acc[a][b][m][n] = (f32x4){0.f, 0.f, 0.f, 0.f};
    bf16x8 At[4][2], B0[2][2], B1[2][2];
    const char* cA = (const char*)g.A + (size_t)cur.pm * tA_pm + (size_t)cur.pn * tA_pn; const char* cB = (const char*)g.Bt + (size_t)cur.pn * tB_pn;
    S.a_ready(cur);
    if constexpr (SP2) {
        PG8_STAGE(PG8_SB(0, 0), cB, voffB); PG8_STAGE(PG8_SB(0, 1), cB + hstepB, voffB); PG8_STAGE(PG8_SA(0, 0), cA, voffA); PG8_STAGE(PG8_SA(0, 1), cA + hstepA, voffA);
        if (wr == 1) PG8_BAR;
        PG8_WAIT_V(2); PG8_BAR;
        PG8_STAGE(PG8_SB(1, 0), cB + kstepB, voffB); PG8_STAGE(PG8_SA(1, 0), cA + kstepA, voffA); PG8_STAGE(PG8_SB(1, 1), cB + hstepB + kstepB, voffB);
        PG8_WAIT_V(6); PG8_BAR;
    } else {
        PG8_STAGE(PG8_SB(0, 0), cB, voffB); PG8_STAGE(PG8_SA(0, 0), cA, voffA); PG8_STAGE(PG8_SB(0, 1), cB + hstepB, voffB); PG8_STAGE(PG8_SA(0, 1), cA + hstepA, voffA);
        if (wr == 1) PG8_BAR;
        PG8_WAIT_V(4); PG8_BAR;
        PG8_STAGE(PG8_SB(1, 0), cB + kstepB, voffB); PG8_STAGE(PG8_SA(1, 0), cA + kstepA, voffA); PG8_STAGE(PG8_SB(1, 1), cB + hstepB + kstepB, voffB);
        PG8_WAIT_V(6); PG8_BAR;
    }
    for (;;) {
        const bool has_next = S.next(ui + 1, nxt);
        const char* nA = has_next ? (const char*)g.A + (size_t)nxt.pm * tA_pm + (size_t)nxt.pn * tA_pn : cA; const char* nB = has_next ? (const char*)g.Bt + (size_t)nxt.pn * tB_pn : cB;
        for (int t = 0; t < nt; t += 2) {
            const bool last = (t == nt - 2);
            const char* a1 = cA + (size_t)(t + 1) * kstepA;
            const char* a2 = last ? nA : cA + (size_t)(t + 2) * kstepA; const char* b2 = last ? nB : cB + (size_t)(t + 2) * kstepB;
            const char* a3 = a2 + kstepA; const char* b3 = b2 + kstepB;
            if (last && has_next) S.a_ready(nxt);
            if constexpr (SP2) {
            PG8_LDB(B0, 0, 0); PG8_LDB(B1, 0, 1); PG8_SCHED; PG8_LDA(At, 0, 0); PG8_STAGE(PG8_SA(1, 1), a1 + hstepA, voffA);
            PG8_WAIT_V(8); PG8_WAIT_L(0); PG8_BAR; PG8_MMA(0, 0, At, B0); PG8_MMA(0, 1, At, B1); PG8_BAR; PG8_SCHED;
            PG8_LDA(At, 0, 1); PG8_STAGE(PG8_SB(0, 0), b2, voffB); PG8_STAGE(PG8_SB(0, 1), b2 + hstepB, voffB); PG8_STAGE(PG8_SA(0, 0), a2, voffA);
            PG8_WAIT_V(8); PG8_WAIT_L(0); PG8_BAR; PG8_MMA(1, 0, At, B0); PG8_MMA(1, 1, At, B1); PG8_BAR; PG8_SCHED;
            PG8_LDB(B0, 1, 0); PG8_LDB(B1, 1, 1); PG8_SCHED; PG8_LDA(At, 1, 0); PG8_STAGE(PG8_SA(0, 1), a2 + hstepA, voffA);
            PG8_WAIT_V(8); PG8_WAIT_L(0); PG8_BAR; PG8_MMA(0, 0, At, B0); PG8_MMA(0, 1, At, B1); PG8_BAR; PG8_SCHED;
            PG8_LDA(At, 1, 1); PG8_STAGE(PG8_SB(1, 0), b3, voffB); PG8_STAGE(PG8_SB(1, 1), b3 + hstepB, voffB); PG8_STAGE(PG8_SA(1, 0), a3, voffA);
            PG8_WAIT_V(8); PG8_WAIT_L(0); PG8_BAR; PG8_MMA(1, 0, At, B0); PG8_MMA(1, 1, At, B1); PG8_BAR; PG8_SCHED;
            } else {
            PG8_LDB(B0, 0, 0); PG8_SCHED; PG8_LDA(At, 0, 0); PG8_STAGE(PG8_SA(1, 1), a1 + hstepA, voffA);
            PG8_WAIT_L(8); PG8_BAR; PG8_WAIT_L(0); PG8_MMA(0, 0, At, B0); PG8_BAR; PG8_SCHED;
            PG8_LDB(B1, 0, 1); PG8_STAGE(PG8_SB(0, 0), b2, voffB);
            PG8_BAR; PG8_WAIT_L(0); PG8_MMA(0, 1, At, B1); PG8_BAR;
            PG8_LDA(At, 0, 1); PG8_STAGE(PG8_SA(0, 0), a2, voffA);
            PG8_BAR; PG8_WAIT_L(0); PG8_MMA(1, 0, At, B0); PG8_BAR; PG8_SCHED;
            PG8_STAGE(PG8_SB(0, 1), b2 + hstepB, voffB);
            PG8_WAIT_V(6); PG8_BAR; PG8_MMA(1, 1, At, B1); PG8_BAR;
            PG8_LDB(B0, 1, 0); PG8_SCHED; PG8_LDA(At, 1, 0); PG8_STAGE(PG8_SA(0, 1), a2 + hstepA, voffA);
            PG8_WAIT_L(8); PG8_BAR; PG8_WAIT_L(0); PG8_MMA(0, 0, At, B0); PG8_BAR; PG8_SCHED;
            PG8_LDB(B1, 1, 1); PG8_STAGE(PG8_SB(1, 0), b3, voffB);
            PG8_BAR; PG8_WAIT_L(0); PG8_MMA(0, 1, At, B1); PG8_BAR;
            PG8_LDA(At, 1, 1); PG8_STAGE(PG8_SA(1, 0), a3, voffA);
            PG8_BAR; PG8_WAIT_L(0); PG8_MMA(1, 0, At, B0); PG8_BAR; PG8_SCHED;
            PG8_STAGE(PG8_SB(1, 1), b3 + hstepB, voffB);
            PG8_WAIT_V(6); PG8_BAR; PG8_MMA(1, 1, At, B1); PG8_BAR;
            }
        }
        if constexpr (ALIGN_EPI) { if (wr == 0) PG8_BAR; }
        if constexpr (!Epi::AFTER_DRAIN) { E(acc, cur, wr, wc, fr, fq); S.done(cur); }
        if (!has_next) break;
#pragma unroll
        for (int a = 0; a < 2; ++a)
#pragma unroll
            for (int b = 0; b < 2; ++b)
#pragma unroll
                for (int m = 0; m < 4; ++m)
#pragma unroll
                    for (int n = 0; n < 2; ++n) acc[a][b][m][n] = (f32x4){0.f, 0.f, 0.f, 0.f};
        cur = nxt; cA = nA; cB = nB; ++ui;
        if constexpr (ALIGN_EPI) { if (wr == 1) PG8_BAR; }
    }
    PG8_WAIT_V(0);
    if constexpr (!ALIGN_EPI) { if (wr == 0) PG8_BAR; }
    PG8_BAR;
    if constexpr (Epi::AFTER_DRAIN) { E.fused(acc, cur, wr, wc, fr, fq, lds, wid, lane); S.done(cur); }
#undef PG8_SA
#undef PG8_SB
#undef PG8_STAGE
#undef PG8_LDA
#undef PG8_LDB
#undef PG8_MMA
#undef PG8_WAIT_V
#undef PG8_WAIT_L
#undef PG8_BAR
#undef PG8_SCHED
}
}

namespace pg8 {
constexpr float LOG2E = 1.4426950408889634f;
constexpr float QS_NSA = 0.125f * LOG2E;
constexpr float QS_MLA = 0.10206207261596575f * LOG2E;
__device__ __forceinline__ float fast_sigmoid(float x) { return __builtin_amdgcn_rcpf(1.0f + __builtin_amdgcn_exp2f(-LOG2E * x)); }
__device__ __forceinline__ float lo_bf(unsigned u) { return __uint_as_float(u << 16); }
__device__ __forceinline__ float hi_bf(unsigned u) { return __uint_as_float(u & 0xffff0000u); }
struct EpiInProjF {
    static constexpr bool PERM = true, AFTER_DRAIN = false;
    bf16_t* proj; bf16_t* gates;
    __device__ __forceinline__ void operator()(const f32x4 (&acc)[2][2][4][2], const Unit& u, int wr, int wc, int fr, int fq) const {
        const bool isg = u.pn >= 7;
        bf16_t* base = isg ? gates : proj; const int ld = isg ? 2048 : 1792; const int colt = isg ? (u.pn - 7) * BM : u.pn * BM;
        const float sc = (u.pn < 2) ? QS_NSA : 1.0f;
        const int row0 = u.pm * BM + wr * 64 + fr, col0 = colt + wc * 32 + 8 * fq;
#pragma unroll
        for (int ai = 0; ai < 2; ++ai)
#pragma unroll
            for (int m = 0; m < 4; ++m) { bf16_t* rowp = base + (size_t)(row0 + ai * HALF + m * 16) * ld + col0;
#pragma unroll
                for (int bj = 0; bj < 2; ++bj) { f32x4 v0 = acc[ai][bj][m][0], v1 = acc[ai][bj][m][1];
                    if (isg) {
#pragma unroll
                        for (int e = 0; e < 4; ++e) { v0[e] = fast_sigmoid(v0[e]); v1[e] = fast_sigmoid(v1[e]); } }
                    else { v0 = v0 * sc; v1 = v1 * sc; }
                    u32x4 w; w.x = cvt_pk_bf16(v0[0], v0[1]); w.y = cvt_pk_bf16(v0[2], v0[3]); w.z = cvt_pk_bf16(v1[0], v1[1]); w.w = cvt_pk_bf16(v1[2], v1[3]);
                    *(u32x4*)(rowp + bj * HALF) = w; } }
    }
};
template <int PASS> struct EpiMergeF {
    static constexpr bool PERM = true, AFTER_DRAIN = false;
    const bf16_t* gates; bf16_t* merged;
    __device__ __forceinline__ void operator()(const f32x4 (&acc)[2][2][4][2], const Unit& u, int wr, int wc, int fr, int fq) const {
        const int row0 = u.pm * BM + wr * 64 + fr, col0 = u.pn * BM + wc * 32 + 8 * fq;
#pragma unroll
        for (int ai = 0; ai < 2; ++ai)
#pragma unroll
            for (int m = 0; m < 4; ++m) { const size_t r = (size_t)(row0 + ai * HALF + m * 16);
#pragma unroll
                for (int bj = 0; bj < 2; ++bj) { const int c = col0 + bj * HALF;
                    const u32x4 g = *(const u32x4*)(gates + r * 2048 + PASS * 1024 + c);
                    f32x4 v0 = acc[ai][bj][m][0], v1 = acc[ai][bj][m][1];
                    v0[0] *= lo_bf(g.x); v0[1] *= hi_bf(g.x); v0[2] *= lo_bf(g.y); v0[3] *= hi_bf(g.y);
                    v1[0] *= lo_bf(g.z); v1[1] *= hi_bf(g.z); v1[2] *= lo_bf(g.w); v1[3] *= hi_bf(g.w);
                    if (PASS == 1) { const u32x4 o = *(const u32x4*)(merged + r * 1024 + c);
                        v0[0] += lo_bf(o.x); v0[1] += hi_bf(o.x); v0[2] += lo_bf(o.y); v0[3] += hi_bf(o.y);
                        v1[0] += lo_bf(o.z); v1[1] += hi_bf(o.z); v1[2] += lo_bf(o.w); v1[3] += hi_bf(o.w); }
                    u32x4 w; w.x = cvt_pk_bf16(v0[0], v0[1]); w.y = cvt_pk_bf16(v0[2], v0[3]); w.z = cvt_pk_bf16(v1[0], v1[1]); w.w = cvt_pk_bf16(v1[2], v1[3]);
                    *(u32x4*)(merged + r * 1024 + c) = w; } }
    }
};
struct EpiCmpOutF {
    static constexpr bool PERM = true, AFTER_DRAIN = false;
    bf16_t* dst;
    __device__ __forceinline__ void operator()(const f32x4 (&acc)[2][2][4][2], const Unit& u, int wr, int wc, int fr, int fq) const {
        if (wc >= 2) return;
        const int row0 = u.pm * BM + wr * 64 + fr, col0 = wc * 32 + 8 * fq;
#pragma unroll
        for (int ai = 0; ai < 2; ++ai)
#pragma unroll
            for (int m = 0; m < 4; ++m) { const int r = row0 + ai * HALF + m * 16;
                if (r < BATCH * NC * 2) { const int g = r & 1, bc = r >> 1, b = bc / NC, c = bc % NC;
                    const f32x4 v0 = acc[ai][0][m][0], v1 = acc[ai][0][m][1];
                    u32x4 w; w.x = cvt_pk_bf16(v0[0], v0[1]); w.y = cvt_pk_bf16(v0[2], v0[3]); w.z = cvt_pk_bf16(v1[0], v1[1]); w.w = cvt_pk_bf16(v1[2], v1[3]);
                    *(u32x4*)(dst + ((size_t)(b * 2 + g) * 128 + c) * 64 + col0) = w; } }
    }
};
struct EpiSlabF {
    static constexpr bool PERM = false, AFTER_DRAIN = false;
    float* slab;
    __device__ __forceinline__ void operator()(const f32x4 (&acc)[2][2][4][2], const Unit& u, int wr, int wc, int fr, int fq) const {
        const int row0 = u.pm * BM + wr * 64 + fr, col0 = wc * 32 + 4 * fq;
        float* base = slab + (size_t)u.pn * 2048 * 256;
#pragma unroll
        for (int ai = 0; ai < 2; ++ai)
#pragma unroll
            for (int m = 0; m < 4; ++m) { float* rowp = base + (size_t)(row0 + ai * HALF + m * 16) * 256 + col0;
#pragma unroll
                for (int bj = 0; bj < 2; ++bj)
#pragma unroll
                    for (int n = 0; n < 2; ++n) *(f32x4*)(rowp + bj * HALF + n * 16) = acc[ai][bj][m][n]; }
    }
};
struct EpiResidF {
    static constexpr bool PERM = false, AFTER_DRAIN = false;
    const float* x; float* h;
    __device__ __forceinline__ void operator()(const f32x4 (&acc)[2][2][4][2], const Unit& u, int wr, int wc, int fr, int fq) const {
        const int row0 = u.pm * BM + wr * 64 + fr, col0 = u.pn * BM + wc * 32 + 4 * fq;
#pragma unroll
        for (int ai = 0; ai < 2; ++ai)
#pragma unroll
            for (int m = 0; m < 4; ++m) { const size_t off = (size_t)(row0 + ai * HALF + m * 16) * 1024 + col0;
#pragma unroll
                for (int bj = 0; bj < 2; ++bj)
#pragma unroll
                    for (int n = 0; n < 2; ++n) { const f32x4 xv = *(const f32x4*)(x + off + bj * HALF + n * 16); *(f32x4*)(h + off + bj * HALF + n * 16) = xv + acc[ai][bj][m][n]; } }
    }
};
struct EpiMlaQF {
    static constexpr bool PERM = false, AFTER_DRAIN = false;
    bf16_t* q; const float2* cs;
    __device__ __forceinline__ void operator()(const f32x4 (&acc)[2][2][4][2], const Unit& u, int wr, int wc, int fr, int fq) const {
        const int row0 = u.pm * BM + wr * 64 + fr;
#pragma unroll
        for (int bj = 0; bj < 2; ++bj) {
            const int X = u.pn * BM + bj * HALF + wc * 32;
            const bool rope = (X % 96) == 64;
#pragma unroll
            for (int ai = 0; ai < 2; ++ai)
#pragma unroll
                for (int m = 0; m < 4; ++m) { const int r = row0 + ai * HALF + m * 16; const int pos = r & (SEQ - 1);
                    f32x4 v0 = acc[ai][bj][m][0], v1 = acc[ai][bj][m][1];
                    if (rope) {
#pragma unroll
                        for (int j = 0; j < 4; ++j) { const float2 c = cs[pos * 16 + 4 * fq + j]; const float x1 = v0[j], x2 = v1[j]; v0[j] = x1 * c.x - x2 * c.y; v1[j] = x2 * c.x + x1 * c.y; } }
                    v0 = v0 * QS_MLA; v1 = v1 * QS_MLA;
                    bf16_t* p = q + (size_t)r * 768 + X + 4 * fq;
                    uint2 w0, w1; w0.x = cvt_pk_bf16(v0[0], v0[1]); w0.y = cvt_pk_bf16(v0[2], v0[3]); w1.x = cvt_pk_bf16(v1[0], v1[1]); w1.y = cvt_pk_bf16(v1[2], v1[3]);
                    *(uint2*)p = w0; *(uint2*)(p + 16) = w1; }
        }
    }
};
}

#define PG8_SP2 true
#define PG8_ALIGN true
constexpr int NTHR = 512, NWV = NTHR / 64;
#define WAVE_IDS const int lane = threadIdx.x & 63, wv = threadIdx.x >> 6; const int gw = blockIdx.x * NWV + wv, nw = gridDim.x * NWV; (void)lane; (void)gw; (void)nw;

template <bool Q8> DEV void ph_rms1024(const float* __restrict__ src, const float* __restrict__ g, bf16_t* __restrict__ dst, int rows, unsigned* __restrict__ q8 = nullptr, float* __restrict__ qs = nullptr, int gw_o = -1, int nw_o = 0) {
  const int lane = threadIdx.x & 63; const int gw = (gw_o >= 0) ? gw_o : (int)(blockIdx.x * NWV + (threadIdx.x >> 6)); const int nw = (gw_o >= 0) ? nw_o : (int)(gridDim.x * NWV);
  float4 gg[4];
#pragma unroll
  for (int j = 0; j < 4; ++j) gg[j] = ((const float4*)g)[j * 64 + lane];
  float4 nx[4];
  if (gw < rows) {
#pragma unroll
    for (int j = 0; j < 4; ++j) nx[j] = ((const float4*)(src + (size_t)gw * 1024))[j * 64 + lane]; }
  for (int r = gw; r < rows; r += nw) {
    float4 v[4]; float ss = 0.f;
#pragma unroll
    for (int j = 0; j < 4; ++j) { v[j] = nx[j]; ss += v[j].x * v[j].x + v[j].y * v[j].y + v[j].z * v[j].z + v[j].w * v[j].w; }
    if (r + nw < rows) {
#pragma unroll
      for (int j = 0; j < 4; ++j) nx[j] = ((const float4*)(src + (size_t)(r + nw) * 1024))[j * 64 + lane]; }
    ss = wsum(ss);
    const float inv = rsqrtf(ss * (1.0f / 1024.0f) + 1e-6f);
    float mx = 0.f;
#pragma unroll
    for (int j = 0; j < 4; ++j) {
      v[j].x *= inv * gg[j].x; v[j].y *= inv * gg[j].y; v[j].z *= inv * gg[j].z; v[j].w *= inv * gg[j].w;
      uint2 o;
      o.x = (unsigned)f2bf(v[j].x) | ((unsigned)f2bf(v[j].y) << 16);
      o.y = (unsigned)f2bf(v[j].z) | ((unsigned)f2bf(v[j].w) << 16);
      ((uint2*)(dst + (size_t)r * 1024))[j * 64 + lane] = o;
      if (Q8) mx = fmaxf(mx, fmaxf(fmaxf(fabsf(v[j].x), fabsf(v[j].y)), fmaxf(fabsf(v[j].z), fabsf(v[j].w))));
    }
    if (Q8) {
      mx = wmaxf(mx);
      const float sc = fmaxf(mx, 1e-30f) * (1.0f / 127.0f), isc = 1.0f / sc;
#pragma unroll
      for (int j = 0; j < 4; ++j) {
        const int q0 = (int)rintf(v[j].x * isc), q1 = (int)rintf(v[j].y * isc), q2 = (int)rintf(v[j].z * isc), q3 = (int)rintf(v[j].w * isc);
        q8[(size_t)r * 256 + j * 64 + lane] = (unsigned)(q0 & 255) | ((unsigned)(q1 & 255) << 8) | ((unsigned)(q2 & 255) << 16) | ((unsigned)(q3 & 255) << 24);
      }
      if (lane == 0) qs[r] = sc;
    }
  }
}
template <int PER> DEV void ph_rms_cols(const bf16_t* __restrict__ proj, int col0, const float* __restrict__ g, bf16_t* __restrict__ dst) {
  WAVE_IDS
  constexpr int W = 64 * PER;
  for (int r = gw; r < T; r += nw) {
    float v[PER]; float ss = 0.f;
#pragma unroll
    for (int j = 0; j < PER; ++j) { v[j] = bf2f(proj[(size_t)r * PROJ_LD + col0 + j * 64 + lane]); ss += v[j] * v[j]; }
    ss = wsum(ss);
    const float inv = rsqrtf(ss * (1.0f / W) + 1e-6f);
#pragma unroll
    for (int j = 0; j < PER; ++j) dst[(size_t)r * W + j * 64 + lane] = f2bf(v[j] * inv * g[j * 64 + lane]);
  }
}

DEV int win_src_col(int n) {
  if (n < 1280) return n;
  if (n < 1536) return 1304 + (n - 1280);
  if (n < 1664) return 1560 + (n - 1536);
  if (n < 1696) return 1688 + (n - 1664);
  if (n < 1720) return 1280 + (n - 1696);
  if (n < 1792) return -1;
  return 1720 + (n - 1792);
}
template <int MODE> DEV void tr_item(const float* __restrict__ W, int K, int Nsrc, bf16_t* __restrict__ WT, int Nblk, int Nvalid, __attribute__((address_space(3))) float* scr, int item, int lane) {
  const int kb = item / Nblk, nb = item % Nblk, k0 = 64 * kb, n0 = 32 * nb;
  const int n = n0 + (lane & 31);
  const int sc = (MODE == 1) ? win_src_col(n) : ((n < Nvalid) ? n : -1);
  float tv[32];
#pragma unroll
  for (int i = 0; i < 32; ++i) { const int kk = 2 * i + (lane >> 5); tv[i] = (sc >= 0) ? W[(size_t)(k0 + kk) * Nsrc + sc] : 0.f; }
#pragma unroll
  for (int i = 0; i < 32; ++i) { const int kk = 2 * i + (lane >> 5); scr[kk * 33 + (lane & 31)] = tv[i]; }
  asm volatile("s_waitcnt lgkmcnt(0)" ::: "memory");
  const int c = lane & 7;
#pragma unroll
  for (int j = 0; j < 4; ++j) { const int nn = (lane >> 3) + 8 * j; const __attribute__((address_space(3))) float* sp = scr + (8 * c) * 33 + nn;
    uint4 o;
    o.x = (unsigned)f2bf(sp[0 * 33]) | ((unsigned)f2bf(sp[1 * 33]) << 16); o.y = (unsigned)f2bf(sp[2 * 33]) | ((unsigned)f2bf(sp[3 * 33]) << 16);
    o.z = (unsigned)f2bf(sp[4 * 33]) | ((unsigned)f2bf(sp[5 * 33]) << 16); o.w = (unsigned)f2bf(sp[6 * 33]) | ((unsigned)f2bf(sp[7 * 33]) << 16);
    *(uint4*)(WT + (size_t)(n0 + nn) * K + k0 + 8 * c) = o; }
  asm volatile("s_waitcnt lgkmcnt(0)" ::: "memory");
}
DEV void ph_conv_plain(const float* __restrict__ src, bf16_t* __restrict__ dst, int n) {
  for (int i = blockIdx.x * NTHR + threadIdx.x; i < n; i += gridDim.x * NTHR) dst[i] = f2bf(src[i]);
}

DEV void gemm_tile(const bf16_t* __restrict__ A, int lda, const bf16_t* __restrict__ Bt, int ldb, int m0, int n0, int K, float (&acc)[4][4], char* lds) {
  float (*sA)[132] = (float (*)[132])lds;
  float (*sB)[68] = (float (*)[68])(lds + 32 * 132 * 4);
  const int tid = threadIdx.x, ty = tid >> 4, tx = tid & 15;
  const int lr = tid >> 2, lk = (tid & 3) * 8;
  for (int k0 = 0; k0 < K; k0 += 32) {
    {
      const uint4 va = *(const uint4*)(A + (size_t)(m0 + lr) * lda + k0 + lk);
      const unsigned ua[4] = {va.x, va.y, va.z, va.w};
#pragma unroll
      for (int j = 0; j < 4; ++j) { sA[lk + 2 * j][lr] = __uint_as_float(ua[j] << 16); sA[lk + 2 * j + 1][lr] = __uint_as_float(ua[j] & 0xffff0000u); }
    }
    if (tid < 256) {
      const uint4 vb = *(const uint4*)(Bt + (size_t)(n0 + lr) * ldb + k0 + lk);
      const unsigned ub[4] = {vb.x, vb.y, vb.z, vb.w};
#pragma unroll
      for (int j = 0; j < 4; ++j) { sB[lk + 2 * j][lr] = __uint_as_float(ub[j] << 16); sB[lk + 2 * j + 1][lr] = __uint_as_float(ub[j] & 0xffff0000u); }
    }
    __syncthreads();
#pragma unroll 8
    for (int k = 0; k < 32; ++k) {
      const float4 a = *(const float4*)&sA[k][ty * 4];
      const float4 b = *(const float4*)&sB[k][tx * 4];
      const float av[4] = {a.x, a.y, a.z, a.w}, bv[4] = {b.x, b.y, b.z, b.w};
#pragma unroll
      for (int i = 0; i < 4; ++i)
#pragma unroll
        for (int j = 0; j < 4; ++j) acc[i][j] += av[i] * bv[j];
    }
    __syncthreads();
  }
}
struct EpiInProj { bf16_t* proj; bf16_t* gates;
  DEV void operator()(int m, int n, float v) const { if (n < PROJ_LD) proj[(size_t)m * PROJ_LD + n] = f2bf(v); else gates[(size_t)m * 2048 + (n - PROJ_LD)] = f2bf(sigmoidf_(v)); } };
struct EpiStore { bf16_t* dst; int ld;
  DEV void operator()(int m, int n, float v) const { dst[(size_t)m * ld + n] = f2bf(v); } };
struct EpiGelu { bf16_t* dst; int ld;
  DEV void operator()(int m, int n, float v) const { dst[(size_t)m * ld + n] = f2bf(gelu_exact(v)); } };
struct EpiCmpOut { bf16_t* dst;
  DEV void operator()(int m, int n, float v) const { if (m >= BATCH * NC * 2) return; const int g = m & 1, bc = m >> 1, b = bc / NC, c = bc % NC; dst[((size_t)(b * 2 + g) * 128 + c) * 64 + n] = f2bf(v); } };
struct EpiResid { const float* x; float* h;
  DEV void operator()(int m, int n, float v) const { const size_t i = (size_t)m * 1024 + n; h[i] = x[i] + v; } };

template <class Epi> DEV void ph_gemm(const bf16_t* A, int lda, const bf16_t* Bt, int ldb, int M, int N, int K, const Epi& epi, char* lds) {
  const int ntn = N / 64, ntm = M / 128;
  const int ty = threadIdx.x >> 4, tx = threadIdx.x & 15;
  for (int tile = blockIdx.x; tile < ntn * ntm; tile += gridDim.x) {
    const int m0 = (tile / ntn) * 128, n0 = (tile % ntn) * 64;
    float acc[4][4];
#pragma unroll
    for (int i = 0; i < 4; ++i)
#pragma unroll
      for (int j = 0; j < 4; ++j) acc[i][j] = 0.f;
    gemm_tile(A, lda, Bt, ldb, m0, n0, K, acc, lds);
#pragma unroll
    for (int i = 0; i < 4; ++i)
#pragma unroll
      for (int j = 0; j < 4; ++j) epi(m0 + ty * 4 + i, n0 + tx * 4 + j, acc[i][j]);
  }
}
DEV void ph_merge(const bf16_t* onsa, const bf16_t* omla, const bf16_t* wbn, const bf16_t* wbm, const bf16_t* gates, bf16_t* merged, char* lds) {
  const int ntn = 1024 / 64, ntm = T / 128;
  const int ty = threadIdx.x >> 4, tx = threadIdx.x & 15;
  for (int tile = blockIdx.x; tile < ntn * ntm; tile += gridDim.x) {
    const int m0 = (tile / ntn) * 128, n0 = (tile % ntn) * 64;
    float a1[4][4], a2[4][4];
#pragma unroll
    for (int i = 0; i < 4; ++i)
#pragma unroll
      for (int j = 0; j < 4; ++j) { a1[i][j] = 0.f; a2[i][j] = 0.f; }
    gemm_tile(onsa, 512, wbn, 512, m0, n0, 512, a1, lds);
    gemm_tile(omla, 512, wbm, 512, m0, n0, 512, a2, lds);
#pragma unroll
    for (int i = 0; i < 4; ++i)
#pragma unroll
      for (int j = 0; j < 4; ++j) {
        const int m = m0 + ty * 4 + i, n = n0 + tx * 4 + j;
        merged[(size_t)m * 1024 + n] = f2bf(bf2f(gates[(size_t)m * 2048 + n]) * a1[i][j] + bf2f(gates[(size_t)m * 2048 + 1024 + n]) * a2[i][j]);
      }
  }
}

DEV void rope_entry(float2* __restrict__ cs, int i) {
  const int j = i & 15, pos = i >> 4;
  const float inv_freq = __builtin_amdgcn_exp2f(-(float)(2 * j) * (13.287712379549449f / 32.0f));
  const float rev = (float)pos * inv_freq * 0.15915494309189535f;
  const float fr = rev - floorf(rev);
  cs[i] = make_float2(__builtin_amdgcn_cosf(fr), __builtin_amdgcn_sinf(fr));
}
DEV void ph_rope_table(float2* __restrict__ cs) {
  const int n = SEQ * 16;
  for (int i = blockIdx.x * NTHR + threadIdx.x; i < n; i += gridDim.x * NTHR) {
    const int j = i & 15, pos = i >> 4;
    const float inv_freq = __builtin_amdgcn_exp2f(-(float)(2 * j) * (13.287712379549449f / 32.0f));
    const float rev = (float)pos * inv_freq * 0.15915494309189535f;
    const float fr = rev - floorf(rev);
    cs[i] = make_float2(__builtin_amdgcn_cosf(fr), __builtin_amdgcn_sinf(fr));
  }
}
DEV void ph_rope_k(const bf16_t* __restrict__ proj, bf16_t* __restrict__ kr) {
  const int n = T * 16;
  for (int i = blockIdx.x * NTHR + threadIdx.x; i < n; i += gridDim.x * NTHR) {
    const int j = i & 15, t = i >> 4;
    const float pos = (float)(t & (SEQ - 1));
    const float inv_freq = powf(10000.0f, -(float)(2 * j) / 32.0f);
    const float ang = pos * inv_freq, c = cosf(ang), s = sinf(ang);
    const float x1 = bf2f(proj[(size_t)t * PROJ_LD + PC_KR + j]), x2 = bf2f(proj[(size_t)t * PROJ_LD + PC_KR + 16 + j]);
    kr[(size_t)t * 32 + j] = f2bf(x1 * c - x2 * s); kr[(size_t)t * 32 + 16 + j] = f2bf(x2 * c + x1 * s);
  }
}
DEV void ph_cmp_gather(const bf16_t* __restrict__ proj, const float* __restrict__ pos, int which, bf16_t* __restrict__ ca) {
  const int n = 2048 * 2048;
  for (int i = blockIdx.x * NTHR + threadIdx.x; i < n; i += gridDim.x * NTHR) {
    const int e = i & 2047, row = i >> 11;
    float v = 0.f;
    if (row < BATCH * NC * 2) {
      const int g = row & 1, bc = row >> 1, b = bc / NC, c = bc % NC, l = e >> 6, d = e & 63;
      v = bf2f(proj[(size_t)(b * SEQ + 16 * c + l) * PROJ_LD + PC_KV + which * 128 + g * 64 + d]) + pos[e];
    }
    ca[i] = f2bf(v);
  }
}

DEV void ph_cmp_attn(const bf16_t* __restrict__ proj, const bf16_t* __restrict__ kc, const bf16_t* __restrict__ vc,
                     const float* __restrict__ t5, bf16_t* __restrict__ ocmp, unsigned* __restrict__ sel, char* lds) {
  WAVE_IDS
  float* P = (float*)(lds + wv * 1024); float* Q = P + 128;
  for (int item = gw; item < BATCH * 2 * SEQ; item += nw) {
    const int t = item & (SEQ - 1), bg = item >> 11, g = bg & 1, b = bg >> 1;
    const size_t tok = (size_t)b * SEQ + t;
    const int nvalid = (t >= 31) ? min(NC, (t - 31) / 16 + 1) : 0;
    const bf16_t* kcb = kc + (size_t)bg * 128 * 64;
    const bf16_t* vcb = vc + (size_t)bg * 128 * 64;
    float impacc = 0.f;
    for (int r = 0; r < 4; ++r) {
      const int head = g * 4 + r;
      Q[lane] = bf2f(proj[tok * PROJ_LD + PC_Q + head * 64 + lane]);
      wave_lds_sync();
      float lg[2];
#pragma unroll
      for (int u = 0; u < 2; ++u) {
        const int c = lane + 64 * u;
        float d = 0.f;
        if (c < nvalid) { const bf16_t* kr = kcb + c * 64; for (int e = 0; e < 64; ++e) d += Q[e] * bf2f(kr[e]); }
        lg[u] = (c < nvalid) ? d + 1.4426950408889634f * t5bias(t5, head, t - (16 * c + 31)) : -1e30f;
      }
      const float m = wmaxf(fmaxf(lg[0], lg[1]));
      const float e0 = (lane < nvalid) ? exp2f(lg[0] - m) : 0.f, e1 = (lane + 64 < nvalid) ? exp2f(lg[1] - m) : 0.f;
      const float s = wsum(e0 + e1);
      const float inv = (nvalid > 0) ? 1.0f / fmaxf(s, 1e-30f) : 0.f;
      P[lane] = e0 * inv; P[lane + 64] = e1 * inv;
      wave_lds_sync();
      float o = 0.f;
      for (int c = 0; c < nvalid; ++c) o += P[c] * bf2f(vcb[c * 64 + lane]);
      ocmp[tok * 512 + head * 64 + lane] = f2bf(o);
      if (lane < 32) { for (int c = 4 * lane - 1; c <= 4 * lane + 3; ++c) if (c >= 0 && c < NC) impacc += P[c]; }
      wave_lds_sync();
    }
    const int cur = t >> 6, n = lane;
    float score = (n > cur) ? -1.0f : ((n == 0 || n == cur || n == cur - 1) ? 1e4f : impacc);
    if (n >= 32) score = -2.0f;
    int rank = 0;
    for (int mth = 0; mth < 32; ++mth) { const float sm = __shfl(score, mth); rank += (sm > score || (sm == score && mth < n)) ? 1 : 0; }
    const unsigned long long bal = __ballot(n < 32 && rank < 16);
    if (lane == 0) sel[item] = (unsigned)bal;
  }
}

DEV void ph_nsa_attn(const bf16_t* __restrict__ proj, const float* __restrict__ t5, const bf16_t* __restrict__ ocmp,
                     const unsigned* __restrict__ sel, bf16_t* __restrict__ onsa, char* lds) {
  WAVE_IDS
  float* P = (float*)(lds + wv * 1024); float* Q = P + 128;
  for (int item = gw; item < BATCH * 2 * SEQ * 4; item += nw) {
    const int r = item & 3, t = (item >> 2) & (SEQ - 1), bg = item >> 13, g = bg & 1, b = bg >> 1;
    const int head = g * 4 + r, cur = t >> 6;
    const size_t tok = (size_t)b * SEQ + t;
    Q[lane] = bf2f(proj[tok * PROJ_LD + PC_Q + head * 64 + lane]);
    wave_lds_sync();
    const unsigned smask = sel[bg * SEQ + t];
    float res0 = 0.f, res1 = 0.f;
    for (int br = 0; br < 2; ++br) {
      float m = -1e30f, l = 0.f, o = 0.f;
      const int nb0 = (br == 0) ? 0 : max(0, cur - 8);
      for (int nb = nb0; nb <= cur; ++nb) {
        if (br == 0 && !((smask >> nb) & 1u)) continue;
        const int s = nb * 64 + lane, dist = t - s;
        const bool valid = (dist >= 0) && (br == 0 || dist < 512);
        const bf16_t* kp = proj + ((size_t)b * SEQ + s) * PROJ_LD + PC_KV + (2 + 2 * br) * 128 + g * 64;
        float d = 0.f;
        for (int e = 0; e < 64; e += 8) {
          const uint4 kv = *(const uint4*)(kp + e);
          d += Q[e + 0] * __uint_as_float(kv.x << 16) + Q[e + 1] * __uint_as_float(kv.x & 0xffff0000u);
          d += Q[e + 2] * __uint_as_float(kv.y << 16) + Q[e + 3] * __uint_as_float(kv.y & 0xffff0000u);
          d += Q[e + 4] * __uint_as_float(kv.z << 16) + Q[e + 5] * __uint_as_float(kv.z & 0xffff0000u);
          d += Q[e + 6] * __uint_as_float(kv.w << 16) + Q[e + 7] * __uint_as_float(kv.w & 0xffff0000u);
        }
        const float lg = valid ? d + 1.4426950408889634f * t5bias(t5, head, dist) : -1e30f;
        const float mn = fmaxf(m, wmaxf(lg));
        const float sc = exp2f(m - mn);
        const float pe = valid ? exp2f(lg - mn) : 0.f;
        l = l * sc + wsum(pe); m = mn;
        P[lane] = pe;
        wave_lds_sync();
        const bf16_t* vp = proj + ((size_t)b * SEQ + nb * 64) * PROJ_LD + PC_KV + (3 + 2 * br) * 128 + g * 64 + lane;
        float acc = 0.f;
        for (int k = 0; k < 64; ++k) acc += P[k] * bf2f(vp[(size_t)k * PROJ_LD]);
        o = o * sc + acc;
        wave_lds_sync();
      }
      if (br == 0) res0 = o / fmaxf(l, 1e-30f); else res1 = o / fmaxf(l, 1e-30f);
    }
    const bf16_t* gp = proj + tok * PROJ_LD + PC_GATE + head * 3;
    const float g0 = sigmoidf_(bf2f(gp[0])), g1 = sigmoidf_(bf2f(gp[1])), g2 = sigmoidf_(bf2f(gp[2]));
    const float oc = bf2f(ocmp[tok * 512 + head * 64 + lane]);
    onsa[tok * 512 + head * 64 + lane] = f2bf(g0 * oc + g1 * res0 + g2 * res1);
    wave_lds_sync();
  }
}

DEV void ph_mla_attn(const bf16_t* __restrict__ mq, const bf16_t* __restrict__ mkv, const bf16_t* __restrict__ kr, bf16_t* __restrict__ omla, char* lds) {
  WAVE_IDS
  float* P = (float*)(lds + wv * 1024); float* Q = P + 128;
  for (int item = gw; item < BATCH * 8 * SEQ; item += nw) {
    const int h = item & 7, t = (item >> 3) & (SEQ - 1), b = item >> 14;
    const size_t tok = (size_t)b * SEQ + t;
    Q[lane] = bf2f(mq[tok * 768 + h * 96 + lane]);
    if (lane < 32) Q[64 + lane] = bf2f(mq[tok * 768 + h * 96 + 64 + lane]);
    wave_lds_sync();
    float m = -1e30f, l = 0.f, o = 0.f;
    for (int nb = 0; nb <= (t >> 6); ++nb) {
      const int s = nb * 64 + lane;
      const bool valid = s <= t;
      const bf16_t* kp = mkv + ((size_t)b * SEQ + s) * 1024 + h * 128;
      const bf16_t* rp = kr + ((size_t)b * SEQ + s) * 32;
      float d = 0.f;
      for (int e = 0; e < 64; e += 8) {
        const uint4 kv = *(const uint4*)(kp + e);
        d += Q[e + 0] * __uint_as_float(kv.x << 16) + Q[e + 1] * __uint_as_float(kv.x & 0xffff0000u);
        d += Q[e + 2] * __uint_as_float(kv.y << 16) + Q[e + 3] * __uint_as_float(kv.y & 0xffff0000u);
        d += Q[e + 4] * __uint_as_float(kv.z << 16) + Q[e + 5] * __uint_as_float(kv.z & 0xffff0000u);
        d += Q[e + 6] * __uint_as_float(kv.w << 16) + Q[e + 7] * __uint_as_float(kv.w & 0xffff0000u);
      }
      for (int e = 0; e < 32; e += 8) {
        const uint4 kv = *(const uint4*)(rp + e);
        d += Q[64 + e + 0] * __uint_as_float(kv.x << 16) + Q[64 + e + 1] * __uint_as_float(kv.x & 0xffff0000u);
        d += Q[64 + e + 2] * __uint_as_float(kv.y << 16) + Q[64 + e + 3] * __uint_as_float(kv.y & 0xffff0000u);
        d += Q[64 + e + 4] * __uint_as_float(kv.z << 16) + Q[64 + e + 5] * __uint_as_float(kv.z & 0xffff0000u);
        d += Q[64 + e + 6] * __uint_as_float(kv.w << 16) + Q[64 + e + 7] * __uint_as_float(kv.w & 0xffff0000u);
      }
      const float lg = valid ? d : -1e30f;
      const float mn = fmaxf(m, wmaxf(lg));
      const float sc = exp2f(m - mn);
      const float pe = valid ? exp2f(lg - mn) : 0.f;
      l = l * sc + wsum(pe); m = mn;
      P[lane] = pe;
      wave_lds_sync();
      const bf16_t* vp = mkv + ((size_t)b * SEQ + nb * 64) * 1024 + h * 128 + 64 + lane;
      float acc = 0.f;
      for (int k = 0; k < 64; ++k) acc += P[k] * bf2f(vp[(size_t)k * 1024]);
      o = o * sc + acc;
      wave_lds_sync();
    }
    omla[tok * 512 + h * 64 + lane] = f2bf(o / fmaxf(l, 1e-30f));
    wave_lds_sync();
  }
}

DEV void wave_argmax(float& v, int& idx) {
#pragma unroll
  for (int o = 32; o > 0; o >>= 1) {
    const float ov = __shfl_xor(v, o); const int oi = __shfl_xor(idx, o);
    if (ov > v || (ov == v && oi < idx)) { v = ov; idx = oi; }
  }
}
DEV void ph_route(const bf16_t* __restrict__ pq, const bf16_t* __restrict__ subk, int* __restrict__ pidx, float* __restrict__ pw, char* lds) {
  WAVE_IDS
  float* Q = (float*)(lds + wv * 1024);
  float* TS = Q + 128;
  int* TI = (int*)(TS + 32);
  for (int item = gw; item < T * 8; item += nw) {
    const int h = item & 7, t = item >> 3;
    Q[lane] = bf2f(pq[(size_t)t * 1024 + h * 128 + lane]);
    Q[lane + 64] = bf2f(pq[(size_t)t * 1024 + h * 128 + 64 + lane]);
    wave_lds_sync();
    for (int p = 0; p < 2; ++p) {
      const bf16_t* kb = subk + (size_t)((h * 2 + p) * 128) * 64;
      float s0 = 0.f, s1 = 0.f;
      for (int e = 0; e < 64; ++e) { const float qv = Q[p * 64 + e]; s0 += qv * bf2f(kb[lane * 64 + e]); s1 += qv * bf2f(kb[(lane + 64) * 64 + e]); }
      for (int k = 0; k < 16; ++k) {
        float v = (s0 >= s1) ? s0 : s1; int idx = (s0 >= s1) ? lane : lane + 64;
        wave_argmax(v, idx);
        if (lane == 0) { TS[p * 16 + k] = v; TI[p * 16 + k] = idx; }
        if (idx == lane) s0 = -3e38f;
        if (idx == lane + 64) s1 = -3e38f;
      }
    }
    wave_lds_sync();
    float cv[4];
#pragma unroll
    for (int u = 0; u < 4; ++u) { const int f = lane + 64 * u; cv[u] = TS[f >> 4] + TS[16 + (f & 15)]; }
    int myexp = 0; float mybest = 0.f, best0 = 0.f, den = 0.f;
#pragma unroll
    for (int k = 0; k < 16; ++k) {
      float v = cv[0]; int idx = lane;
#pragma unroll
      for (int u = 1; u < 4; ++u) if (cv[u] > v) { v = cv[u]; idx = lane + 64 * u; }
      wave_argmax(v, idx);
#pragma unroll
      for (int u = 0; u < 4; ++u) if (idx == lane + 64 * u) cv[u] = -3e38f;
      if (k == 0) best0 = v;
      den += expf(v - best0);
      if (lane == k) { myexp = TI[idx >> 4] * 128 + TI[16 + (idx & 15)]; mybest = v; }
    }
    if (lane < 16) { pidx[(size_t)t * 128 + h * 16 + lane] = myexp; pw[(size_t)t * 128 + h * 16 + lane] = expf(mybest - best0) / den; }
    wave_lds_sync();
  }
}

DEV void ph_experts(const bf16_t* __restrict__ hn, const int* __restrict__ pidx, const float* __restrict__ pw,
                    const float* __restrict__ pu, const float* __restrict__ pv, const float* __restrict__ gfin, float* __restrict__ out) {
  WAVE_IDS
  for (int t = gw; t < T; t += nw) {
    float4 x[4], y[4];
#pragma unroll
    for (int j = 0; j < 4; ++j) {
      const uint2 r = ((const uint2*)(hn + (size_t)t * 1024))[j * 64 + lane];
      x[j] = make_float4(__uint_as_float(r.x << 16), __uint_as_float(r.x & 0xffff0000u), __uint_as_float(r.y << 16), __uint_as_float(r.y & 0xffff0000u));
      y[j] = make_float4(0.f, 0.f, 0.f, 0.f);
    }
    const int e0 = pidx[(size_t)t * 128 + lane], e1 = pidx[(size_t)t * 128 + 64 + lane];
    const float w0 = pw[(size_t)t * 128 + lane], w1 = pw[(size_t)t * 128 + 64 + lane];
    for (int s = 0; s < 128; ++s) {
      const int e = __shfl((s < 64) ? e0 : e1, s & 63);
      const float w = __shfl((s < 64) ? w0 : w1, s & 63);
      const float4* ur = (const float4*)(pu + (size_t)e * 1024);
      float d = 0.f;
#pragma unroll
      for (int j = 0; j < 4; ++j) { const float4 u = ur[j * 64 + lane]; d += u.x * x[j].x + u.y * x[j].y + u.z * x[j].z + u.w * x[j].w; }
      d = wsum(d);
      const float c = w * gelu_exact(d);
      const float4* vr = (const float4*)(pv + (size_t)e * 1024);
#pragma unroll
      for (int j = 0; j < 4; ++j) { const float4 v = vr[j * 64 + lane]; y[j].x += c * v.x; y[j].y += c * v.y; y[j].z += c * v.z; y[j].w += c * v.w; }
    }
    float4* o4 = (float4*)(out + (size_t)t * 1024);
    float ss = 0.f;
#pragma unroll
    for (int j = 0; j < 4; ++j) {
      const float4 hv = o4[j * 64 + lane];
      y[j].x += hv.x; y[j].y += hv.y; y[j].z += hv.z; y[j].w += hv.w;
      ss += y[j].x * y[j].x + y[j].y * y[j].y + y[j].z * y[j].z + y[j].w * y[j].w;
    }
    ss = wsum(ss);
    const float inv = rsqrtf(ss * (1.0f / 1024.0f) + 1e-6f);
#pragma unroll
    for (int j = 0; j < 4; ++j) {
      const float4 gg = ((const float4*)gfin)[j * 64 + lane];
      o4[j * 64 + lane] = make_float4(y[j].x * inv * gg.x, y[j].y * inv * gg.y, y[j].z * inv * gg.z, y[j].w * inv * gg.w);
    }
  }
}


namespace att {
#define LAS3 __attribute__((address_space(3)))
typedef LAS3 char* lptr;
typedef LAS3 const char* lcptr;
using bf16x8 = __attribute__((ext_vector_type(8))) short;
using s16x4 = __attribute__((ext_vector_type(4))) short;
using f32x16 = __attribute__((ext_vector_type(16))) float;
typedef short v4i16_t __attribute__((ext_vector_type(4)));
typedef unsigned u32x4 __attribute__((ext_vector_type(4)));
typedef float f32x4_t __attribute__((ext_vector_type(4)));
typedef float f32x2_t __attribute__((ext_vector_type(2)));
typedef __bf16 bf16x2_t __attribute__((ext_vector_type(2)));
constexpr float LOG2E = 1.4426950408889634f;
constexpr float THR = 8.0f;
constexpr float NEG_INF = -__builtin_huge_valf();
constexpr int SLOT = 20480, KOFF = 0, VOFF = 12288;
constexpr int L_WSF = 2 * SLOT;
constexpr int L_TB = L_WSF + 2048;
constexpr int L_ST = L_TB + 8 * 320 * 4;
constexpr int L_SELM = L_ST + 768;
constexpr int L_SC = L_SELM + 256;
constexpr int L_IMPQ = L_SC + 64 * 33 * 4;
constexpr int L_IMPL = L_IMPQ + 4 * 64 * 33 * 4;
constexpr int L_FIN = L_IMPQ;
constexpr int L_END = L_IMPL + 4 * 64 * 33 * 4;
static_assert(L_END <= 131072, "attention LDS map");

__device__ __forceinline__ int crow(int r, int hi) { return (r & 3) + 8 * (r >> 2) + 4 * hi; }
__device__ __forceinline__ s16x4 vtr(lcptr p) { return __builtin_bit_cast(s16x4, __builtin_amdgcn_ds_read_tr16_b64_v4i16((LAS3 v4i16_t*)p)); }
__device__ __forceinline__ unsigned cvtpk(float lo, float hi) { f32x2_t v = {lo, hi}; bf16x2_t b = __builtin_convertvector(v, bf16x2_t); return __builtin_bit_cast(unsigned, b); }
__device__ __forceinline__ float xmax(float v) { auto rr = __builtin_amdgcn_permlane32_swap(__float_as_uint(v), __float_as_uint(v), false, false); return fmaxf(__uint_as_float(rr[0]), __uint_as_float(rr[1])); }
__device__ __forceinline__ float xsum(float v) { auto rr = __builtin_amdgcn_permlane32_swap(__float_as_uint(v), __float_as_uint(v), false, false); return __uint_as_float(rr[0]) + __uint_as_float(rr[1]); }
__device__ __forceinline__ float ex2(float x) { return __builtin_amdgcn_exp2f(x); }

template <int ND0> __device__ __forceinline__ void qkt(f32x16& p0, f32x16& p1, lcptr kb, const bf16x8* qr) {
  p0 = f32x16{}; p1 = f32x16{};
  __builtin_amdgcn_s_setprio(1);
#pragma unroll
  for (int d0 = 0; d0 < ND0; ++d0) {
    const bf16x8 b0 = *(const LAS3 bf16x8*)(kb + d0 * 2048);
    const bf16x8 b1 = *(const LAS3 bf16x8*)(kb + d0 * 2048 + 512);
    p0 = __builtin_amdgcn_mfma_f32_32x32x16_bf16(b0, qr[d0], p0, 0, 0, 0);
    p1 = __builtin_amdgcn_mfma_f32_32x32x16_bf16(b1, qr[d0], p1, 0, 0, 0);
  }
  __builtin_amdgcn_s_setprio(0);
}
template <int ND0> __device__ __forceinline__ void qkt_init(f32x16& p0, f32x16& p1, lcptr kb, const bf16x8* qr, const f32x16& c0, const f32x16& c1) {
  p0 = c0; p1 = c1;
  __builtin_amdgcn_s_setprio(1);
#pragma unroll
  for (int d0 = 0; d0 < ND0; ++d0) {
    const bf16x8 b0 = *(const LAS3 bf16x8*)(kb + d0 * 2048);
    const bf16x8 b1 = *(const LAS3 bf16x8*)(kb + d0 * 2048 + 512);
    p0 = __builtin_amdgcn_mfma_f32_32x32x16_bf16(b0, qr[d0], p0, 0, 0, 0);
    p1 = __builtin_amdgcn_mfma_f32_32x32x16_bf16(b1, qr[d0], p1, 0, 0, 0);
  }
  __builtin_amdgcn_s_setprio(0);
}
__device__ __forceinline__ void pv(f32x16 (&o)[2], lcptr vp, const unsigned (&pw)[16]) {
  __builtin_amdgcn_s_setprio(1);
#pragma unroll
  for (int d0 = 0; d0 < 2; ++d0)
#pragma unroll
    for (int ks = 0; ks < 4; ++ks) {
      const s16x4 lo = vtr(vp + d0 * 4096 + ks * 1024), hi4 = vtr(vp + d0 * 4096 + ks * 1024 + 512);
      const bf16x8 vf = {lo[0], lo[1], lo[2], lo[3], hi4[0], hi4[1], hi4[2], hi4[3]};
      const unsigned pa4[4] = {pw[4 * ks], pw[4 * ks + 1], pw[4 * ks + 2], pw[4 * ks + 3]};
      o[d0] = __builtin_amdgcn_mfma_f32_32x32x16_bf16(__builtin_bit_cast(bf16x8, pa4), vf, o[d0], 0, 0, 0);
    }
  __builtin_amdgcn_s_setprio(0);
}
__device__ __forceinline__ void softmax_step(f32x16& p0, f32x16& p1, float& m, float& l, f32x16 (&o)[2], LAS3 float* wsf, int r32, int hi, unsigned (&pw)[16]) {
  float rm = fmaxf(p0[0], p1[0]);
#pragma unroll
  for (int r = 1; r < 16; ++r) rm = fmaxf(rm, fmaxf(p0[r], p1[r]));
  rm = xmax(rm);
  if (__any(rm > m + THR)) {
    const float mn = fmaxf(m, rm);
    const float al = ex2(m - mn);
    m = mn; l *= al;
    if (hi == 0) wsf[r32] = al;
#pragma unroll
    for (int r = 0; r < 16; ++r) { const float f = wsf[crow(r, hi)]; o[0][r] *= f; o[1][r] *= f; }
  }
  float s = 0.f;
#pragma unroll
  for (int r = 0; r < 16; ++r) { p0[r] = ex2(p0[r] - m); p1[r] = ex2(p1[r] - m); s += p0[r] + p1[r]; }
  l += s;
#pragma unroll
  for (int i = 0; i < 8; ++i) { pw[i] = cvtpk(p0[2 * i], p0[2 * i + 1]); pw[8 + i] = cvtpk(p1[2 * i], p1[2 * i + 1]); }
}
struct KVSrc { const bf16_t* k; const bf16_t* v; int ldk, ldv; };
__device__ __forceinline__ void kv_issue(const KVSrc& s, int row0, u32x4& rk, u32x4& rv, int tid) {
  const int kv = tid & 63, ch = tid >> 6, ln = tid & 63;
  rk = *(const u32x4*)(s.k + (size_t)(row0 + kv) * s.ldk + ch * 8);
  rv = *(const u32x4*)(s.v + (size_t)(row0 + 16 * (ch & 3) + (ln >> 2)) * s.ldv + (ch >> 2) * 32 + (ln & 3) * 8);
}
__device__ __forceinline__ void kv_commit(lptr slot, const u32x4& rk, const u32x4& rv, int tid) {
  *(LAS3 u32x4*)(slot + KOFF + (tid >> 6) * 1024 + (tid & 63) * 16) = rk;
  *(LAS3 u32x4*)(slot + VOFF + tid * 16) = rv;
}
__device__ __forceinline__ void fin_set(LAS3 float* finl, const f32x16 (&o)[2], int lane) {
#pragma unroll
  for (int d0 = 0; d0 < 2; ++d0)
#pragma unroll
    for (int r = 0; r < 16; ++r) finl[(d0 * 16 + r) * 64 + lane] = o[d0][r];
}
__device__ __forceinline__ void fin_add(LAS3 float* finl, const f32x16 (&o)[2], const LAS3 float* wsf, int lane, int hi) {
#pragma unroll
  for (int r = 0; r < 16; ++r) { const float f = wsf[crow(r, hi)];
#pragma unroll
    for (int d0 = 0; d0 < 2; ++d0) finl[(d0 * 16 + r) * 64 + lane] += o[d0][r] * f; }
}
__device__ __forceinline__ void fin_store(const LAS3 float* finl, bf16_t* gout, size_t rowbase, int ld, int colbase, int lane) {
#pragma unroll
  for (int i = 0; i < 4; ++i) {
    const int q = i * 8 + (lane >> 3), ch = lane & 7;
    const int qh = (q >> 2) & 1, r = (q & 3) + 4 * (q >> 3), d0 = ch >> 2, dl = (ch & 3) * 8;
    const LAS3 float* p = finl + (d0 * 16 + r) * 64 + qh * 32 + dl;
    const f32x4_t x0 = *(const LAS3 f32x4_t*)p, x1 = *(const LAS3 f32x4_t*)(p + 4);
    u32x4 v; v.x = cvtpk(x0[0], x0[1]); v.y = cvtpk(x0[2], x0[3]); v.z = cvtpk(x1[0], x1[1]); v.w = cvtpk(x1[2], x1[3]);
    *(u32x4*)(gout + (rowbase + q) * (size_t)ld + colbase + ch * 8) = v;
  }
}

__device__ __forceinline__ void nsa_unit(int b, int g, int c, const bf16_t* __restrict__ proj, const bf16_t* __restrict__ kc, const bf16_t* __restrict__ vc, bf16_t* __restrict__ onsa, lptr lds) {
  int tid = threadIdx.x; asm volatile("" : "+v"(tid));
  const int lane = tid & 63, r32 = lane & 31, hi = lane >> 5;
  const int w = __builtin_amdgcn_readfirstlane(tid >> 6);
  const int rh = w >> 1, head = g * 4 + rh, tokl = 32 * (w & 1) + r32, t = 64 * c + tokl, bg = b * 2 + g;
  const size_t tok = (size_t)b * SEQ + t;
  LAS3 float* wsf = (LAS3 float*)(lds + L_WSF) + w * 64;
  const LAS3 float* tb = (const LAS3 float*)(lds + L_TB) + head * 320 + 64;
  const LAS3 float* stp = (const LAS3 float*)(lds + L_ST);
  LAS3 unsigned* selm = (LAS3 unsigned*)(lds + L_SELM);
  LAS3 float* sc = (LAS3 float*)(lds + L_SC);
  LAS3 float* impq = (LAS3 float*)(lds + L_IMPQ);
  LAS3 float* impl = (LAS3 float*)(lds + L_IMPL);
  const lcptr kb0 = (lcptr)lds + KOFF + hi * 1024 + r32 * 16;
  const lcptr vp0 = (lcptr)lds + VOFF + ((lane >> 4) & 1) * 32 + (lane & 3) * 8 + (4 * hi + ((lane & 15) >> 2)) * 64;
  bf16x8 qr[4];
#pragma unroll
  for (int d0 = 0; d0 < 4; ++d0) qr[d0] = *(const bf16x8*)(proj + tok * PROJ_LD + PC_Q + head * 64 + d0 * 16 + hi * 8);
  float gate[3];
#pragma unroll
  for (int j = 0; j < 3; ++j) gate[j] = 1.0f / (1.0f + ex2(-LOG2E * bf2f(proj[tok * PROJ_LD + PC_GATE + head * 3 + j])));
  LAS3 float* finl = (LAS3 float*)(lds + L_FIN) + w * 2048;
  f32x16 o[2]; unsigned pw[16];
  u32x4 rk, rv;
  {
    const KVSrc src{kc + (size_t)bg * 128 * 64, vc + (size_t)bg * 128 * 64, 64, 64};
    __syncthreads();
    kv_issue(src, 0, rk, rv, tid); kv_commit(lds, rk, rv, tid);
    kv_issue(src, 64, rk, rv, tid); kv_commit(lds + SLOT, rk, rv, tid);
    __syncthreads();
    f32x16 a0, a1, b0, b1;
    qkt<4>(a0, a1, kb0, qr); qkt<4>(b0, b1, kb0 + SLOT, qr);
    float rm = NEG_INF;
#pragma unroll
    for (int r = 0; r < 16; ++r) {
      const int cb = crow(r, hi);
      { const int d = t - 16 * cb - 31;          a0[r] = (d < 0) ? NEG_INF : a0[r] + ((d < 113) ? tb[d] : 0.f); }
      { const int d = t - 16 * (cb + 32) - 31;   a1[r] = (d < 0) ? NEG_INF : a1[r] + ((d < 113) ? tb[d] : 0.f); }
      { const int d = t - 16 * (cb + 64) - 31;   b0[r] = (d < 0) ? NEG_INF : b0[r] + ((d < 113) ? tb[d] : 0.f); }
      { const int d = t - 16 * (cb + 96) - 31;   b1[r] = (d < 0) ? NEG_INF : b1[r] + ((d < 113) ? tb[d] : 0.f); }
      rm = fmaxf(fmaxf(rm, fmaxf(a0[r], a1[r])), fmaxf(b0[r], b1[r]));
    }
    rm = xmax(rm);
    const float mref = (rm == NEG_INF) ? 0.f : rm;
    float s = 0.f;
#pragma unroll
    for (int r = 0; r < 16; ++r) { a0[r] = ex2(a0[r] - mref); a1[r] = ex2(a1[r] - mref); b0[r] = ex2(b0[r] - mref); b1[r] = ex2(b1[r] - mref); s += (a0[r] + a1[r]) + (b0[r] + b1[r]); }
    s = xsum(s);
    const float inv = (s > 0.f) ? 1.0f / s : 0.f;
#pragma unroll
    for (int r = 0; r < 16; ++r) { a0[r] *= inv; a1[r] *= inv; b0[r] *= inv; b1[r] *= inv; }
    { LAS3 float* iq = impq + (rh * 64 + tokl) * 33; LAS3 float* il = impl + (rh * 64 + tokl) * 33;
#pragma unroll
      for (int q4 = 0; q4 < 4; ++q4) {
        const int gi = 2 * q4 + hi;
        iq[gi] = (a0[4 * q4] + a0[4 * q4 + 1]) + (a0[4 * q4 + 2] + a0[4 * q4 + 3]);           il[gi] = a0[4 * q4 + 3];
        iq[8 + gi] = (a1[4 * q4] + a1[4 * q4 + 1]) + (a1[4 * q4 + 2] + a1[4 * q4 + 3]);       il[8 + gi] = a1[4 * q4 + 3];
        iq[16 + gi] = (b0[4 * q4] + b0[4 * q4 + 1]) + (b0[4 * q4 + 2] + b0[4 * q4 + 3]);      il[16 + gi] = b0[4 * q4 + 3];
        iq[24 + gi] = (b1[4 * q4] + b1[4 * q4 + 1]) + (b1[4 * q4 + 2] + b1[4 * q4 + 3]);      il[24 + gi] = b1[4 * q4 + 3];
      } }
    o[0] = f32x16{}; o[1] = f32x16{};
#pragma unroll
    for (int i = 0; i < 8; ++i) { pw[i] = cvtpk(a0[2 * i], a0[2 * i + 1]); pw[8 + i] = cvtpk(a1[2 * i], a1[2 * i + 1]); }
    pv(o, vp0, pw);
#pragma unroll
    for (int i = 0; i < 8; ++i) { pw[i] = cvtpk(b0[2 * i], b0[2 * i + 1]); pw[8 + i] = cvtpk(b1[2 * i], b1[2 * i + 1]); }
    pv(o, vp0 + SLOT, pw);
    if (hi == 0) wsf[r32] = gate[0];
#pragma unroll
    for (int r = 0; r < 16; ++r) { const float f = wsf[crow(r, hi)]; o[0][r] *= f; o[1][r] *= f; }
  }
  __syncthreads();
  const KVSrc ssrc{proj + (size_t)b * SEQ * PROJ_LD + PC_KV + 2 * 128 + g * 64, proj + (size_t)b * SEQ * PROJ_LD + PC_KV + 3 * 128 + g * 64, PROJ_LD, PROJ_LD};
  kv_issue(ssrc, 0, rk, rv, tid);
  {
    const int stok = tid >> 3, sub = tid & 7;
#pragma unroll
    for (int k = 0; k < 4; ++k) {
      const int n = sub * 4 + k;
      float imp = 0.f;
#pragma unroll
      for (int hh = 0; hh < 4; ++hh) imp += impq[(hh * 64 + stok) * 33 + n] + ((n > 0) ? impl[(hh * 64 + stok) * 33 + n - 1] : 0.f);
      sc[stok * 33 + n] = (n > c) ? -1.0f : ((n == 0 || n == c || n == c - 1) ? 1e4f : imp);
    }
    if (tid < 64) selm[tid] = 0u;
    __syncthreads();
#pragma unroll
    for (int k = 0; k < 4; ++k) {
      const int n = sub * 4 + k; const float sv = sc[stok * 33 + n]; int rank = 0;
      for (int mm = 0; mm < 32; ++mm) { const float sm = sc[stok * 33 + mm]; rank += (sm > sv || (sm == sv && mm < n)) ? 1 : 0; }
      if (rank < 16) atomicOr((unsigned*)(selm + stok), 1u << n);
    }
    __syncthreads();
  }
  const unsigned mysel = selm[tokl];
  fin_set(finl, o, lane);
#pragma unroll 1
  for (int br = 0; br < 2; ++br) {
    const KVSrc src = (br == 0) ? ssrc : KVSrc{proj + (size_t)b * SEQ * PROJ_LD + PC_KV + 4 * 128 + g * 64, proj + (size_t)b * SEQ * PROJ_LD + PC_KV + 5 * 128 + g * 64, PROJ_LD, PROJ_LD};
    const int n0 = (br == 0) ? 0 : ((c > 8) ? c - 8 : 0);
    if (br == 1) { __syncthreads(); kv_issue(src, n0 * 64, rk, rv, tid); }
    kv_commit(lds, rk, rv, tid);
    float m = -1e30f, l = 0.f;
    o[0] = f32x16{}; o[1] = f32x16{};
    int cur = 0;
#pragma unroll 1
    for (int n = n0; n <= c; ++n) {
      __syncthreads();
      if (n < c) kv_issue(src, (n + 1) * 64, rk, rv, tid);
      const bool mine = (br == 1) || ((mysel >> n) & 1u);
      if (__any(mine)) {
        f32x16 p0, p1;
        if (n + 2 >= c) {
          const LAS3 float* bp = tb + (t - 64 * n) - 4 * hi - 63;
          f32x16 c0, c1;
#pragma unroll
          for (int r = 0; r < 16; ++r) { c0[r] = bp[63 - ((r & 3) + 8 * (r >> 2))]; c1[r] = bp[31 - ((r & 3) + 8 * (r >> 2))]; }
          qkt_init<4>(p0, p1, kb0 + cur * SLOT, qr, c0, c1);
        } else if (br == 1 && n + 8 == c) {
          const LAS3 float* bp = stp + (607 - (t - 64 * n)) + 4 * hi;
          f32x16 c0, c1;
#pragma unroll
          for (int r = 0; r < 16; ++r) { c0[r] = bp[(r & 3) + 8 * (r >> 2)]; c1[r] = bp[32 + (r & 3) + 8 * (r >> 2)]; }
          qkt_init<4>(p0, p1, kb0 + cur * SLOT, qr, c0, c1);
        } else qkt<4>(p0, p1, kb0 + cur * SLOT, qr);
        if (!mine) {
#pragma unroll
          for (int r = 0; r < 16; ++r) { p0[r] = NEG_INF; p1[r] = NEG_INF; } }
        softmax_step(p0, p1, m, l, o, wsf, r32, hi, pw);
        pv(o, vp0 + cur * SLOT, pw);
      }
      if (n < c) kv_commit(lds + (cur ^ 1) * SLOT, rk, rv, tid);
      cur ^= 1;
    }
    l = xsum(l);
    const float gi = gate[1 + br] / fmaxf(l, 1e-30f);
    if (hi == 0) wsf[r32] = gi;
    fin_add(finl, o, wsf, lane, hi);
  }
  fin_store(finl, onsa, (size_t)b * SEQ + 64 * c + 32 * (w & 1), 512, head * 64, lane);
}

__device__ __forceinline__ void mla_unit(int b, int h, int qb, const bf16_t* __restrict__ mq, const bf16_t* __restrict__ mkv, const bf16_t* __restrict__ kr, bf16_t* __restrict__ omla, lptr lds) {
  int tid = threadIdx.x; asm volatile("" : "+v"(tid));
  const int lane = tid & 63, r32 = lane & 31, hi = lane >> 5;
  const int w = __builtin_amdgcn_readfirstlane(tid >> 6);
  const int q0 = 256 * qb, qw = q0 + 32 * w, qpos = qw + r32;
  const size_t tokq = (size_t)b * SEQ + qpos;
  LAS3 float* wsf = (LAS3 float*)(lds + L_WSF) + w * 64;
  const lcptr kb0 = (lcptr)lds + KOFF + hi * 1024 + r32 * 16;
  const lcptr vp0 = (lcptr)lds + VOFF + ((lane >> 4) & 1) * 32 + (lane & 3) * 8 + (4 * hi + ((lane & 15) >> 2)) * 64;
  const LAS3 float* stp = (const LAS3 float*)(lds + L_ST);
  bf16x8 qr[6];
#pragma unroll
  for (int d0 = 0; d0 < 6; ++d0) qr[d0] = *(const bf16x8*)(mq + tokq * 768 + h * 96 + d0 * 16 + hi * 8);
  const KVSrc src{mkv + (size_t)b * SEQ * 1024 + h * 128, mkv + (size_t)b * SEQ * 1024 + h * 128 + 64, 1024, 1024};
  const bf16_t* krb = kr + (size_t)b * SEQ * 32;
  const int NTL = 4 * (qb + 1);
  u32x4 rk, rv, rr = {0u, 0u, 0u, 0u};
  f32x16 o[2]; o[0] = f32x16{}; o[1] = f32x16{};
  unsigned pw[16];
  float m = -1e30f, l = 0.f;
  __syncthreads();
  kv_issue(src, 0, rk, rv, tid);
  if (tid < 256) rr = *(const u32x4*)(krb + (size_t)(tid & 63) * 32 + (tid >> 6) * 8);
  kv_commit(lds, rk, rv, tid);
  if (tid < 256) *(LAS3 u32x4*)(lds + KOFF + (8 + (tid >> 6)) * 1024 + (tid & 63) * 16) = rr;
  int cur = 0;
#pragma unroll 1
  for (int tl = 0; tl < NTL; ++tl) {
    __syncthreads();
    if (tl + 1 < NTL) { kv_issue(src, (tl + 1) * 64, rk, rv, tid); if (tid < 256) rr = *(const u32x4*)(krb + (size_t)((tl + 1) * 64 + (tid & 63)) * 32 + (tid >> 6) * 8); }
    if (64 * tl <= qw + 31) {
      f32x16 p0, p1;
      if (64 * tl + 63 > qw) {
        const LAS3 float* bp = stp + 96 + (qpos - 64 * tl) - 4 * hi - 63;
        f32x16 c0, c1;
#pragma unroll
        for (int r = 0; r < 16; ++r) { c0[r] = bp[63 - ((r & 3) + 8 * (r >> 2))]; c1[r] = bp[31 - ((r & 3) + 8 * (r >> 2))]; }
        qkt_init<6>(p0, p1, kb0 + cur * SLOT, qr, c0, c1);
      } else qkt<6>(p0, p1, kb0 + cur * SLOT, qr);
      softmax_step(p0, p1, m, l, o, wsf, r32, hi, pw);
      pv(o, vp0 + cur * SLOT, pw);
    }
    if (tl + 1 < NTL) { kv_commit(lds + (cur ^ 1) * SLOT, rk, rv, tid); if (tid < 256) *(LAS3 u32x4*)(lds + (cur ^ 1) * SLOT + KOFF + (8 + (tid >> 6)) * 1024 + (tid & 63) * 16) = rr; }
    cur ^= 1;
  }
  l = xsum(l);
  if (hi == 0) wsf[r32] = 1.0f / fmaxf(l, 1e-30f);
#pragma unroll
  for (int r = 0; r < 16; ++r) { const float f = wsf[crow(r, hi)]; o[0][r] *= f; o[1][r] *= f; }
  LAS3 float* finl = (LAS3 float*)(lds + L_FIN) + w * 2048;
  fin_set(finl, o, lane);
  fin_store(finl, omla, (size_t)b * SEQ + qw, 512, h * 64, lane);
}

__device__ __forceinline__ void attn_phase(const bf16_t* proj, const bf16_t* kc, const bf16_t* vc, const float* t5, bf16_t* onsa,
                                           const bf16_t* mq, const bf16_t* mkv, const bf16_t* kr, bf16_t* omla, lptr lds) {
  const int tid = threadIdx.x;
  { LAS3 float* tb = (LAS3 float*)(lds + L_TB);
    for (int i = tid; i < 8 * 320; i += NTHR) { const int hd = i / 320, d = i % 320 - 64; tb[i] = (d < 0) ? NEG_INF : ((d < 113) ? (t5[(int)T5B[d] * 8 + hd] - t5[31 * 8 + hd]) * LOG2E : 0.f); }
    LAS3 float* st = (LAS3 float*)(lds + L_ST);
    for (int i = tid; i < 192; i += NTHR) st[i] = (i < 96) ? NEG_INF : 0.f; }
  const int G = gridDim.x, bx = blockIdx.x;
  for (int v = (G % 8 == 0) ? (bx % 8) * (G / 8) + bx / 8 : bx; v < 256; v += G) {
    const int bg = v >> 4, p = v & 15, bh = v >> 2, j = v & 3;
#pragma unroll 1
    for (int u = 0; u < 2; ++u) nsa_unit(bg >> 1, bg & 1, u ? p : 31 - p, proj, kc, vc, onsa, lds);
#pragma unroll 1
    for (int u = 0; u < 2; ++u) mla_unit(bh >> 3, bh & 7, u ? j : 7 - j, mq, mkv, kr, omla, lds);
  }
}
#undef LAS3
}


namespace peer {
using bf16x8 = __attribute__((ext_vector_type(8))) short;
using f32x16 = __attribute__((ext_vector_type(16))) float;
typedef unsigned u32x4 __attribute__((ext_vector_type(4)));
typedef float f32x4_t __attribute__((ext_vector_type(4)));
typedef __bf16 bf16x2_t __attribute__((ext_vector_type(2)));
typedef float f32x2_t __attribute__((ext_vector_type(2)));
#define LAS3 __attribute__((address_space(3)))
__device__ __forceinline__ int crow(int r, int hi) { return (r & 3) + 8 * (r >> 2) + 4 * hi; }
__device__ __forceinline__ unsigned enc(float f) { const unsigned u = __float_as_uint(f); return u ^ ((unsigned)((int)u >> 31) | 0x80000000u); }
__device__ __forceinline__ float dec(unsigned k) { return __uint_as_float(k ^ (~(unsigned)((int)k >> 31) | 0x80000000u)); }
__device__ __forceinline__ unsigned umax(unsigned a, unsigned b) { return a > b ? a : b; }
__device__ __forceinline__ unsigned umin(unsigned a, unsigned b) { return a < b ? a : b; }
__device__ __forceinline__ unsigned cvtpk(float lo, float hi) { f32x2_t v = {lo, hi}; bf16x2_t b = __builtin_convertvector(v, bf16x2_t); return __builtin_bit_cast(unsigned, b); }
template <int B, int N> __device__ __forceinline__ void sort16(unsigned (&k)[N]) {
#pragma unroll
  for (int size = 2; size <= 16; size <<= 1)
#pragma unroll
    for (int stride = size >> 1; stride > 0; stride >>= 1)
#pragma unroll
      for (int i = 0; i < 16; ++i) { const int l = i ^ stride;
        if (l > i) { const bool desc = ((i & size) == 0); const unsigned a = k[B + i], b = k[B + l]; const unsigned mx = umax(a, b), mn = umin(a, b); k[B + i] = desc ? mx : mn; k[B + l] = desc ? mn : mx; } }
}
template <int A, int Bo, int N> __device__ __forceinline__ void merge16(unsigned (&k)[N]) {
#pragma unroll
  for (int i = 0; i < 16; ++i) k[A + i] = umax(k[A + i], k[Bo + 15 - i]);
#pragma unroll
  for (int stride = 8; stride > 0; stride >>= 1)
#pragma unroll
    for (int i = 0; i < 16; ++i) { const int l = i ^ stride; if (l > i) { const unsigned a = k[A + i], b = k[A + l]; k[A + i] = umax(a, b); k[A + l] = umin(a, b); } }
}
template <int N> __device__ __forceinline__ void top16_of_64(unsigned (&k)[N]) {
  sort16<0>(k); sort16<16>(k); sort16<32>(k); sort16<48>(k);
  merge16<0, 16>(k); merge16<32, 48>(k); merge16<0, 32>(k);
}

__device__ __forceinline__ void route_phase(const bf16_t* __restrict__ pq, const bf16_t* __restrict__ subk, unsigned* __restrict__ pack, LAS3 char* lds) {
  const int tid = threadIdx.x, lane = tid & 63, r32 = lane & 31, hi = lane >> 5, wv = tid >> 6;
  const int gw = blockIdx.x * NWV + wv, nw = gridDim.x * NWV;
  LAS3 unsigned char* myb = (LAS3 unsigned char*)lds + wv * 2560 + lane * 40;
#pragma unroll 1
  for (int item = gw; item < (T / 32) * 8; item += nw) {
    const int h = item & 7, t0 = (item >> 3) * 32;
    unsigned la[16], lb[16];
#pragma unroll
    for (int i = 0; i < 16; ++i) { la[i] = 0u; lb[i] = 0u; }
#pragma unroll 1
    for (int p = 0; p < 2; ++p) {
      f32x16 acc[4];
#pragma unroll
      for (int kt = 0; kt < 4; ++kt) acc[kt] = f32x16{};
#pragma unroll
      for (int kd = 0; kd < 4; ++kd) {
        const bf16x8 bq = *(const bf16x8*)(pq + (size_t)(t0 + r32) * 1024 + h * 128 + p * 64 + kd * 16 + hi * 8);
#pragma unroll
        for (int kt = 0; kt < 4; ++kt) {
          const bf16x8 ak = *(const bf16x8*)(subk + (size_t)((h * 2 + p) * 128 + kt * 32 + r32) * 64 + kd * 16 + hi * 8);
          acc[kt] = __builtin_amdgcn_mfma_f32_32x32x16_bf16(ak, bq, acc[kt], 0, 0, 0);
        }
      }
      unsigned k[64];
#pragma unroll
      for (int kt = 0; kt < 4; ++kt)
#pragma unroll
        for (int r = 0; r < 16; ++r) k[kt * 16 + r] = (enc(acc[kt][r]) & 0xFFFFFF80u) | (unsigned)(127 - (32 * kt + crow(r, hi)));
      top16_of_64(k);
#pragma unroll
      for (int i = 0; i < 16; ++i) { auto rr = __builtin_amdgcn_permlane32_swap(k[i], k[i], false, false); unsigned r0 = rr[0], r1 = rr[1]; asm volatile("" : "+v"(r0), "+v"(r1)); k[16 + i] = hi ? r0 : r1; }
      merge16<0, 16>(k);
#pragma unroll
      for (int i = 0; i < 16; ++i) { la[i] = (p == 0) ? k[i] : la[i]; lb[i] = (p == 0) ? lb[i] : k[i]; }
      __builtin_amdgcn_sched_barrier(0);
    }
#pragma unroll
    for (int i = 0; i < 4; ++i) {
      const unsigned wa = (127u - (la[4 * i] & 127u)) | ((127u - (la[4 * i + 1] & 127u)) << 8) | ((127u - (la[4 * i + 2] & 127u)) << 16) | ((127u - (la[4 * i + 3] & 127u)) << 24);
      const unsigned wb = (127u - (lb[4 * i] & 127u)) | ((127u - (lb[4 * i + 1] & 127u)) << 8) | ((127u - (lb[4 * i + 2] & 127u)) << 16) | ((127u - (lb[4 * i + 3] & 127u)) << 24);
      *(LAS3 unsigned*)(myb + 4 * i) = wa; *(LAS3 unsigned*)(myb + 16 + 4 * i) = wb;
    }
    float va[16], vb[16];
#pragma unroll
    for (int i = 0; i < 16; ++i) { va[i] = dec(la[i] & 0xFFFFFF80u); vb[i] = dec(lb[i] & 0xFFFFFF80u); }
    unsigned k[64];
#define PEER_CAND(n, i, j) k[n] = (enc(va[i] + vb[j]) & 0xFFFFFF00u) | (unsigned)(255 - ((i) * 16 + (j)))
    PEER_CAND(0, 0, 0); PEER_CAND(1, 0, 1); PEER_CAND(2, 0, 2); PEER_CAND(3, 0, 3); PEER_CAND(4, 0, 4); PEER_CAND(5, 0, 5);
    PEER_CAND(6, 0, 6); PEER_CAND(7, 0, 7); PEER_CAND(8, 0, 8); PEER_CAND(9, 0, 9); PEER_CAND(10, 0, 10); PEER_CAND(11, 0, 11);
    PEER_CAND(12, 0, 12); PEER_CAND(13, 0, 13); PEER_CAND(14, 0, 14); PEER_CAND(15, 0, 15); PEER_CAND(16, 1, 0); PEER_CAND(17, 1, 1);
    PEER_CAND(18, 1, 2); PEER_CAND(19, 1, 3); PEER_CAND(20, 1, 4); PEER_CAND(21, 1, 5); PEER_CAND(22, 1, 6); PEER_CAND(23, 1, 7);
    PEER_CAND(24, 2, 0); PEER_CAND(25, 2, 1); PEER_CAND(26, 2, 2); PEER_CAND(27, 2, 3); PEER_CAND(28, 2, 4); PEER_CAND(29, 3, 0);
    PEER_CAND(30, 3, 1); PEER_CAND(31, 3, 2); PEER_CAND(32, 3, 3); PEER_CAND(33, 4, 0); PEER_CAND(34, 4, 1); PEER_CAND(35, 4, 2);
    PEER_CAND(36, 5, 0); PEER_CAND(37, 5, 1); PEER_CAND(38, 6, 0); PEER_CAND(39, 6, 1); PEER_CAND(40, 7, 0); PEER_CAND(41, 7, 1);
    PEER_CAND(42, 8, 0); PEER_CAND(43, 9, 0); PEER_CAND(44, 10, 0); PEER_CAND(45, 11, 0); PEER_CAND(46, 12, 0); PEER_CAND(47, 13, 0);
    PEER_CAND(48, 14, 0); PEER_CAND(49, 15, 0);
#undef PEER_CAND
#pragma unroll
    for (int z = 50; z < 64; ++z) k[z] = 0u;
    top16_of_64(k);
    const float best0 = dec(k[0] & 0xFFFFFF00u);
    float ev[16]; float den = 0.f;
#pragma unroll
    for (int i = 0; i < 16; ++i) { ev[i] = __expf(dec(k[i] & 0xFFFFFF00u) - best0); den += ev[i]; }
    const float inv = 1.0f / den;
    unsigned outw[8];
#pragma unroll
    for (int i = 0; i < 8; ++i) {
      unsigned k_lo = k[i], k_hi = k[8 + i]; float e_lo = ev[i], e_hi = ev[8 + i];
      asm volatile("" : "+v"(k_lo), "+v"(k_hi), "+v"(e_lo), "+v"(e_hi));
      const unsigned kk = hi ? k_hi : k_lo; const float e = hi ? e_hi : e_lo;
      const unsigned f = 255u - (kk & 255u);
      const unsigned ia = myb[f >> 4], ib = myb[16 + (f & 15u)];
      outw[i] = (ia * 128u + ib) | (cvtpk(0.f, e * inv) & 0xFFFF0000u);
    }
    unsigned* dst = pack + (size_t)(t0 + r32) * 128 + h * 16 + hi * 8;
    *(u32x4*)dst = (u32x4){outw[0], outw[1], outw[2], outw[3]};
    *(u32x4*)(dst + 4) = (u32x4){outw[4], outw[5], outw[6], outw[7]};
  }
}

__device__ __forceinline__ void conv_tables(const float* __restrict__ u, const float* __restrict__ v, unsigned* __restrict__ u8, float* __restrict__ su, unsigned* __restrict__ v8) {
  const int tid = threadIdx.x, lane = tid & 63, wv = tid >> 6;
  const int gw = blockIdx.x * NWV + wv, nw = gridDim.x * NWV;
  for (int e = gw; e < 16384; e += nw) {
    const f32x4_t* ur = (const f32x4_t*)(u + (size_t)e * 1024) + lane * 4;
    f32x4_t a[4]; float mx = 0.f;
#pragma unroll
    for (int i = 0; i < 4; ++i) { a[i] = ur[i]; mx = fmaxf(mx, fmaxf(fmaxf(fabsf(a[i][0]), fabsf(a[i][1])), fmaxf(fabsf(a[i][2]), fabsf(a[i][3])))); }
    mx = wmaxf(mx);
    const float sc = fmaxf(mx, 1e-30f) * (1.0f / 127.0f), isc = 1.0f / sc;
    u32x4 o;
#pragma unroll
    for (int i = 0; i < 4; ++i) {
      const int q0 = (int)rintf(a[i][0] * isc), q1 = (int)rintf(a[i][1] * isc), q2 = (int)rintf(a[i][2] * isc), q3 = (int)rintf(a[i][3] * isc);
      o[i] = (unsigned)(q0 & 255) | ((unsigned)(q1 & 255) << 8) | ((unsigned)(q2 & 255) << 16) | ((unsigned)(q3 & 255) << 24);
    }
    *(u32x4*)(u8 + (size_t)e * 256 + lane * 4) = o;
    if (lane == 0) su[e] = sc;
    const f32x4_t* vr = (const f32x4_t*)(v + (size_t)e * 1024) + lane * 4;
    u32x4 ov;
#pragma unroll
    for (int i = 0; i < 4; ++i) { const f32x4_t b = vr[i]; unsigned w = 0u; w = __builtin_amdgcn_cvt_pk_fp8_f32(2.0f * b[0], 2.0f * b[1], w, false); w = __builtin_amdgcn_cvt_pk_fp8_f32(2.0f * b[2], 2.0f * b[3], w, true); ov[i] = w; }
    *(u32x4*)(v8 + ((size_t)(lane >> 3) * 16384 + e) * 32 + (lane & 7) * 4) = ov;
  }
}
__device__ __forceinline__ float gelu_fast(float v) {
  const float av = __builtin_fabsf(v), t = __builtin_amdgcn_rcpf(av * 0.2316418882f + 1.0f);
  float q = t * 0.5307027145f + (-0.7265760135f); q = q * t + 0.7107068705f; q = q * t + (-0.142248368f); q = q * t + 0.127414796f; q = q * t;
  const float e = __builtin_amdgcn_exp2f((v * v) * (-0.72134752044f));
  const float m = v * (q * e);
  return v < 0.f ? m : v - m;
}
__device__ __forceinline__ unsigned xcc_id() { return (unsigned)__builtin_amdgcn_s_getreg((3 << 11) | 20) & 7u; }
struct ABuf { unsigned w[4], meta[4]; u32x4 ub[4][4]; float sue[4]; };
__device__ __forceinline__ void expA_issue(ABuf& B, int k0, int n, const LAS3 unsigned* list, const unsigned* __restrict__ u8, const float* __restrict__ su, int j16) {
#pragma unroll
  for (int q = 0; q < 4; ++q) {
    const int k = (k0 + 32 * q < n) ? k0 + 32 * q : k0;
    B.w[q] = list[2 * k]; B.meta[q] = list[2 * k + 1];
    const unsigned e = B.w[q] & 0xFFFFu;
    const unsigned* urow = u8 + (size_t)e * 256 + j16 * 4;
#pragma unroll
    for (int seg = 0; seg < 4; ++seg) B.ub[q][seg] = *(const u32x4*)(urow + seg * 64);
    B.sue[q] = su[e];
  }
}
__device__ __forceinline__ f32x4_t gelu_fast4(f32x4_t v) {
  f32x4_t t;
#pragma unroll
  for (int i = 0; i < 4; ++i) t[i] = __builtin_amdgcn_rcpf(__builtin_fabsf(v[i]) * 0.2316418882f + 1.0f);
  f32x4_t q = t * 0.5307027145f + (-0.7265760135f); q = q * t + 0.7107068705f; q = q * t + (-0.142248368f); q = q * t + 0.127414796f; q = q * t;
  f32x4_t e;
#pragma unroll
  for (int i = 0; i < 4; ++i) e[i] = __builtin_amdgcn_exp2f((v[i] * v[i]) * (-0.72134752044f));
  const f32x4_t m = v * (q * e);
  f32x4_t r;
#pragma unroll
  for (int i = 0; i < 4; ++i) r[i] = v[i] < 0.f ? m[i] : v[i] - m[i];
  return r;
}
__device__ __forceinline__ void expA_consume(const ABuf& B, int k0, int n, const LAS3 char* hl, const LAS3 float* shl, float* __restrict__ co, int t0, int j16) {
  int acc[4]; float sc[4];
#pragma unroll
  for (int q = 0; q < 4; ++q) {
    const int tokl = (int)(B.meta[q] >> 8);
    const LAS3 char* hrow = hl + tokl * 1024 + j16 * 16;
    int a0 = 0, a1 = 0, a2 = 0, a3 = 0;
#pragma unroll
    for (int seg = 0; seg < 4; ++seg) { const u32x4 hq = *(const LAS3 u32x4*)(hrow + seg * 256);
      a0 = __builtin_amdgcn_sdot4((int)B.ub[q][seg].x, (int)hq.x, a0, false); a1 = __builtin_amdgcn_sdot4((int)B.ub[q][seg].y, (int)hq.y, a1, false);
      a2 = __builtin_amdgcn_sdot4((int)B.ub[q][seg].z, (int)hq.z, a2, false); a3 = __builtin_amdgcn_sdot4((int)B.ub[q][seg].w, (int)hq.w, a3, false); }
    acc[q] = (a0 + a1) + (a2 + a3);
    sc[q] = B.sue[q] * shl[tokl];
  }
#pragma unroll
  for (int q = 0; q < 4; ++q) acc[q] += dpp_i<0xB1>(acc[q]);
#pragma unroll
  for (int q = 0; q < 4; ++q) acc[q] += dpp_i<0x4E>(acc[q]);
#pragma unroll
  for (int q = 0; q < 4; ++q) acc[q] += dpp_i<0x141>(acc[q]);
#pragma unroll
  for (int q = 0; q < 4; ++q) acc[q] += dpp_i<0x140>(acc[q]);
  const f32x4_t d = {(float)acc[0] * sc[0], (float)acc[1] * sc[1], (float)acc[2] * sc[2], (float)acc[3] * sc[3]};
  const f32x4_t g = gelu_fast4(d);
#pragma unroll
  for (int q = 0; q < 4; ++q) {
    const int tokl = (int)(B.meta[q] >> 8), slot = (int)(B.meta[q] & 255u);
    const float c = 0.5f * __uint_as_float(B.w[q] & 0xFFFF0000u) * g[q];
    if (j16 == 0 && k0 + 32 * q < n) co[(size_t)(t0 + tokl) * 128 + slot] = c;
  }
}
__device__ __forceinline__ void expA_item(int item, int xs, const unsigned* __restrict__ pack, const unsigned* __restrict__ hn8, const float* __restrict__ shp, const unsigned* __restrict__ u8, const float* __restrict__ su,
                                          float* __restrict__ co, LAS3 char* lds, int tid) {
  const int lane = tid & 63, j16 = lane & 15, grp = lane >> 4, wv = tid >> 6;
  LAS3 char* hl = lds + 1024;
  LAS3 float* shl = (LAS3 float*)(lds + 1024 + 65536);
  LAS3 unsigned* cnt = (LAS3 unsigned*)(lds + 16);
  LAS3 unsigned* list = (LAS3 unsigned*)(lds + 1024 + 65536 + 256);
  const int t0 = item * 64;
  const int tokl = tid >> 3, sb = (tid & 7) * 16;
  u32x4 pw[4], hst[8];
#pragma unroll
  for (int i = 0; i < 4; ++i) pw[i] = *(const u32x4*)(pack + (size_t)(t0 + tokl) * 128 + sb + 4 * i);
#pragma unroll
  for (int i = 0; i < 8; ++i) hst[i] = *(const u32x4*)(hn8 + (size_t)t0 * 256 + (tid + 512 * i) * 4);
  const float shv = (tid < 64) ? shp[t0 + tid] : 0.f;
#pragma unroll
  for (int i = 0; i < 8; ++i) *(LAS3 u32x4*)(hl + (tid + 512 * i) * 16) = hst[i];
  if (tid < 64) shl[tid] = shv;
  {
#pragma unroll
    for (int j = 0; j < 16; ++j) { const unsigned w = pw[j >> 2][j & 3];
      if (((w & 0xFFFFu) >> 11) == (unsigned)xs) { const unsigned pos = __hip_atomic_fetch_add(cnt, 1u, __ATOMIC_RELAXED, __HIP_MEMORY_SCOPE_WORKGROUP); list[2 * pos] = w; list[2 * pos + 1] = (unsigned)((tokl << 8) | (sb + j)); } }
  }
  __syncthreads();
  const int n = (int)cnt[0];
  const int gidx = wv * 4 + grp;
  ABuf A, Bb;
  if (gidx < n) expA_issue(A, gidx, n, list, u8, su, j16);
#pragma unroll 1
  for (int k0 = gidx; k0 < n; k0 += 256) {
    if (k0 + 128 < n) expA_issue(Bb, k0 + 128, n, list, u8, su, j16);
    expA_consume(A, k0, n, hl, shl, co, t0, j16);
    if (k0 + 256 < n) expA_issue(A, k0 + 256, n, list, u8, su, j16);
    if (k0 + 128 < n) expA_consume(Bb, k0 + 128, n, hl, shl, co, t0, j16);
  }
}
struct BBuf { u32x4 vv[8]; f32x4_t c[2]; };
__device__ __forceinline__ void expB_issue(BBuf& B, const LAS3 unsigned* pkl, const LAS3 float* col, int sg8, const unsigned* __restrict__ vbase) {
  const u32x4 p0 = *(const LAS3 u32x4*)(pkl + sg8 * 8), p1 = *(const LAS3 u32x4*)(pkl + sg8 * 8 + 4);
  B.c[0] = *(const LAS3 f32x4_t*)(col + sg8 * 8); B.c[1] = *(const LAS3 f32x4_t*)(col + sg8 * 8 + 4);
#pragma unroll
  for (int j = 0; j < 4; ++j) { B.vv[j] = *(const u32x4*)(vbase + (size_t)(p0[j] & 0xFFFFu) * 32); B.vv[4 + j] = *(const u32x4*)(vbase + (size_t)(p1[j] & 0xFFFFu) * 32); }
}
__device__ __forceinline__ void expB_consume(const BBuf& B, f32x2_t (&y)[8]) {
#pragma unroll
  for (int j = 0; j < 8; ++j) {
    const float cv = B.c[j >> 2][j & 3];
    const f32x2_t c2 = {cv, cv};
#pragma unroll
    for (int w = 0; w < 4; ++w) {
      y[2 * w] = __builtin_elementwise_fma(__builtin_amdgcn_cvt_pk_f32_fp8(B.vv[j][w], false), c2, y[2 * w]);
      y[2 * w + 1] = __builtin_elementwise_fma(__builtin_amdgcn_cvt_pk_f32_fp8(B.vv[j][w], true), c2, y[2 * w + 1]);
    }
  }
}
__device__ __forceinline__ void expB_item(int item, int xs, const unsigned* __restrict__ pack, const float* __restrict__ co, const unsigned* __restrict__ v8, float* __restrict__ out, float* __restrict__ ssq, LAS3 char* lds, int tid) {
  const int lane = tid & 63, wv = tid >> 6, r8 = lane >> 3, c8 = lane & 7;
  const int t0 = item * 64 + wv * 8;
  LAS3 unsigned* pkw = (LAS3 unsigned*)(lds + 1024 + wv * 8192);
  LAS3 float* cow = (LAS3 float*)(lds + 1024 + wv * 8192 + 4096);
  {
    u32x4 a[4]; f32x4_t b[4];
#pragma unroll
    for (int i = 0; i < 4; ++i) { a[i] = *(const u32x4*)(pack + (size_t)t0 * 128 + (lane + 64 * i) * 4); b[i] = *(const f32x4_t*)(co + (size_t)t0 * 128 + (lane + 64 * i) * 4); }
#pragma unroll
    for (int i = 0; i < 4; ++i) { *(LAS3 u32x4*)(pkw + (lane + 64 * i) * 4) = a[i]; *(LAS3 f32x4_t*)(cow + (lane + 64 * i) * 4) = b[i]; }
  }
  float* hp = out + (size_t)(t0 + r8) * 1024 + xs * 128 + c8 * 16;
  f32x4_t h[4];
#pragma unroll
  for (int w = 0; w < 4; ++w) h[w] = *(const f32x4_t*)(hp + 4 * w);
  wave_lds_sync();
  const LAS3 unsigned* pkl = pkw + r8 * 128; const LAS3 float* col = cow + r8 * 128;
  const unsigned* vbase = v8 + (size_t)xs * 16384 * 32 + c8 * 4;
  f32x2_t y[8];
#pragma unroll
  for (int i = 0; i < 8; ++i) y[i] = (f32x2_t){0.f, 0.f};
  BBuf A, Bb;
  expB_issue(A, pkl, col, 0, vbase);
#pragma unroll 1
  for (int sg = 0; sg < 16; sg += 2) {
    expB_issue(Bb, pkl, col, sg + 1, vbase);
    expB_consume(A, y);
    if (sg + 2 < 16) expB_issue(A, pkl, col, sg + 2, vbase);
    expB_consume(Bb, y);
  }
  float ss = 0.f;
#pragma unroll
  for (int w = 0; w < 4; ++w) {
    const f32x4_t z = {h[w][0] + y[2 * w][0], h[w][1] + y[2 * w][1], h[w][2] + y[2 * w + 1][0], h[w][3] + y[2 * w + 1][1]};
    *(f32x4_t*)(hp + 4 * w) = z;
    ss += (z[0] * z[0] + z[1] * z[1]) + (z[2] * z[2] + z[3] * z[3]);
  }
  ss += dpp_f<0xB1>(ss); ss += dpp_f<0x4E>(ss); ss += dpp_f<0x141>(ss);
  if (c8 == 0) ssq[(size_t)xs * T + t0 + r8] = ss;
  wave_lds_sync();
}
template <int PASS> __device__ __forceinline__ void experts_sliced(const unsigned* __restrict__ pack, const unsigned* __restrict__ hn8, const float* __restrict__ shp, const unsigned* __restrict__ u8, const float* __restrict__ su,
                                                                    float* __restrict__ co, const unsigned* __restrict__ v8, float* __restrict__ out, float* __restrict__ ssq, unsigned* __restrict__ ctr, LAS3 char* lds) {
  int tid = threadIdx.x; asm volatile("" : "+v"(tid));
  LAS3 volatile int* lw = (LAS3 volatile int*)lds;
  const int xme = (int)xcc_id();
#pragma unroll 1
  for (int s8 = 0; s8 < 8; ++s8) {
    const int xs = (xme + s8) & 7;
    int nxt = 0;
    if (tid == 0) nxt = (int)atomicAdd(ctr + 64 * xs, 1u);
#pragma unroll 1
    for (;;) {
      __syncthreads();
      if (tid == 0) { lw[0] = nxt; lw[4] = 0; }
      __syncthreads();
      const int item = lw[0];
      if (item >= T / 64) break;
      if (tid == 0) nxt = (int)atomicAdd(ctr + 64 * xs, 1u);
      if (PASS == 0) expA_item(item, xs, pack, hn8, shp, u8, su, co, lds, tid);
      else expB_item(item, xs, pack, co, v8, out, ssq, lds, tid);
    }
  }
}
__device__ __forceinline__ void experts_norm(const float* __restrict__ ssq, const float* __restrict__ gfin, float* __restrict__ out) {
  const int tid = threadIdx.x, lane = tid & 63, wv = tid >> 6;
  const int gw = blockIdx.x * NWV + wv, nw = gridDim.x * NWV;
  for (int t = gw; t < T; t += nw) {
    float ss = 0.f;
#pragma unroll
    for (int x = 0; x < 8; ++x) ss += ssq[(size_t)x * T + t];
    const float inv = rsqrtf(ss * (1.0f / 1024.0f) + 1e-6f);
    float* op = out + (size_t)t * 1024 + lane * 16; const float* gp = gfin + lane * 16;
#pragma unroll
    for (int i = 0; i < 4; ++i) { const f32x4_t z = *(const f32x4_t*)(op + 4 * i), g = *(const f32x4_t*)(gp + 4 * i); *(f32x4_t*)(op + 4 * i) = z * inv * g; }
  }
}
#undef LAS3
}

namespace prep {
typedef unsigned u32x2_t __attribute__((ext_vector_type(2)));
typedef float f32x4_t __attribute__((ext_vector_type(4)));
typedef unsigned u32x4 __attribute__((ext_vector_type(4)));
using bf16x8 = __attribute__((ext_vector_type(8))) short;
using f32x16 = __attribute__((ext_vector_type(16))) float;
__device__ __forceinline__ unsigned pk2(float lo, float hi) { return (unsigned)f2bf(lo) | ((unsigned)f2bf(hi) << 16); }
__device__ __forceinline__ void latent_rows(const bf16_t* __restrict__ proj, const float* __restrict__ gq, const float* __restrict__ gkv, const float2* __restrict__ cs,
                                            bf16_t* __restrict__ cqn, bf16_t* __restrict__ ckvn, bf16_t* __restrict__ krope, int wave_id, int nwaves, int lane) {
  const f32x4_t g4 = *(const f32x4_t*)(gq + lane * 4);
  const float2 g2 = *(const float2*)(gkv + lane * 2);
  for (int r = wave_id; r < T; r += nwaves) {
    const bf16_t* row = proj + (size_t)r * PROJ_LD;
    const u32x2_t q = *(const u32x2_t*)(row + PC_CQ + lane * 4);
    const unsigned kv = *(const unsigned*)(row + PC_CKV + lane * 2);
    const unsigned short kr0 = row[PC_KR + (lane & 15)], kr1 = row[PC_KR + 16 + (lane & 15)];
    const float q0 = __uint_as_float(q.x << 16), q1 = __uint_as_float(q.x & 0xffff0000u), q2 = __uint_as_float(q.y << 16), q3 = __uint_as_float(q.y & 0xffff0000u);
    const float k0 = __uint_as_float(kv << 16), k1 = __uint_as_float(kv & 0xffff0000u);
    float sq = (q0 * q0 + q1 * q1) + (q2 * q2 + q3 * q3), sk = k0 * k0 + k1 * k1;
    sq = wsum(sq); sk = wsum(sk);
    const float iq = rsqrtf(sq * (1.0f / 256.0f) + 1e-6f), ik = rsqrtf(sk * (1.0f / 128.0f) + 1e-6f);
    u32x2_t oq; oq.x = pk2(q0 * iq * g4[0], q1 * iq * g4[1]); oq.y = pk2(q2 * iq * g4[2], q3 * iq * g4[3]);
    *(u32x2_t*)(cqn + (size_t)r * 256 + lane * 4) = oq;
    *(unsigned*)(ckvn + (size_t)r * 128 + lane * 2) = pk2(k0 * ik * g2.x, k1 * ik * g2.y);
    if (lane < 16) {
      const float2 c = cs[(r & (SEQ - 1)) * 16 + lane];
      const float x1 = bf2f(kr0), x2 = bf2f(kr1);
      krope[(size_t)r * 32 + lane] = f2bf(x1 * c.x - x2 * c.y); krope[(size_t)r * 32 + 16 + lane] = f2bf(x2 * c.x + x1 * c.y);
    }
  }
}
__device__ __forceinline__ void cmp_bias(const float* __restrict__ posk, const float* __restrict__ posv, const bf16_t* __restrict__ w1k, const bf16_t* __restrict__ w1v, float* __restrict__ cpos, int wave_id, int nwaves, int lane) {
  for (int o = wave_id; o < 512; o += nwaves) {
    const int tab = o >> 8, n = o & 255;
    const float* pos = tab ? posv : posk; const bf16_t* w = (tab ? w1v : w1k) + (size_t)n * 2048;
    float acc = 0.f;
#pragma unroll
    for (int i = 0; i < 4; ++i) { const int k = (i * 64 + lane) * 8;
      const u32x4 wv = *(const u32x4*)(w + k); const f32x4_t p0 = *(const f32x4_t*)(pos + k), p1 = *(const f32x4_t*)(pos + k + 4);
      acc += p0[0] * __uint_as_float(wv.x << 16) + p0[1] * __uint_as_float(wv.x & 0xffff0000u) + p0[2] * __uint_as_float(wv.y << 16) + p0[3] * __uint_as_float(wv.y & 0xffff0000u);
      acc += p1[0] * __uint_as_float(wv.z << 16) + p1[1] * __uint_as_float(wv.z & 0xffff0000u) + p1[2] * __uint_as_float(wv.w << 16) + p1[3] * __uint_as_float(wv.w & 0xffff0000u); }
    acc = wsum(acc);
    if (lane == 0) cpos[o] = acc;
  }
}
__device__ __forceinline__ void cmp_l2(const float* __restrict__ slab, const float* __restrict__ cpos, const bf16_t* __restrict__ w2t, bf16_t* __restrict__ outkc, int item, int lane) {
  const int r32 = lane & 31, hi = lane >> 5, m0 = item * 32;
  f32x16 acc0 = f32x16{}, acc1 = f32x16{};
#pragma unroll 2
  for (int ks = 0; ks < 16; ++ks) {
    const int k = ks * 16 + hi * 8;
    f32x4_t a0 = *(const f32x4_t*)(cpos + k), a1 = *(const f32x4_t*)(cpos + k + 4);
#pragma unroll
    for (int sp = 0; sp < 4; ++sp) { const float* p = slab + ((size_t)sp * 2048 + m0 + r32) * 256 + k; a0 += *(const f32x4_t*)p; a1 += *(const f32x4_t*)(p + 4); }
    u32x4 aw;
    aw.x = pk2(peer::gelu_fast(a0[0]), peer::gelu_fast(a0[1])); aw.y = pk2(peer::gelu_fast(a0[2]), peer::gelu_fast(a0[3]));
    aw.z = pk2(peer::gelu_fast(a1[0]), peer::gelu_fast(a1[1])); aw.w = pk2(peer::gelu_fast(a1[2]), peer::gelu_fast(a1[3]));
    const bf16x8 af = __builtin_bit_cast(bf16x8, aw);
    const bf16x8 b0 = *(const bf16x8*)(w2t + (size_t)r32 * 256 + k), b1 = *(const bf16x8*)(w2t + (size_t)(32 + r32) * 256 + k);
    acc0 = __builtin_amdgcn_mfma_f32_32x32x16_bf16(af, b0, acc0, 0, 0, 0);
    acc1 = __builtin_amdgcn_mfma_f32_32x32x16_bf16(af, b1, acc1, 0, 0, 0);
  }
#pragma unroll
  for (int r = 0; r < 16; ++r) {
    const int m = m0 + (r & 3) + 8 * (r >> 2) + 4 * hi;
    const bool pad = (m & 127) == 127;
    outkc[(size_t)m * 64 + r32] = pad ? (bf16_t)0 : f2bf(acc0[r]);
    outkc[(size_t)m * 64 + 32 + r32] = pad ? (bf16_t)0 : f2bf(acc1[r]);
  }
}
}

#define XB_TMO      128
#define XB_XCNT(j)  (256  + 64 * (j))
#define XB_XSUB(j)  (1280 + 64 * (j))
#define XB_XGEN(j)  (2304 + 64 * (j))
#define XB_TOP      3328
#define XB_TOPGEN   3392
#define XCD_BAR_WORDS 3456
#define XB_SPIN_CAP (1u << 18)
#ifndef LAS
#define LAS __attribute__((address_space(3)))
#endif

__device__ __forceinline__ unsigned xb_ld(unsigned* p)              { return __hip_atomic_load(p, __ATOMIC_RELAXED, __HIP_MEMORY_SCOPE_AGENT); }
__device__ __forceinline__ unsigned xb_add(unsigned* p, unsigned v) { return __hip_atomic_fetch_add(p, v, __ATOMIC_RELAXED, __HIP_MEMORY_SCOPE_AGENT); }
__device__ __forceinline__ unsigned xb_xcc_id() { return (unsigned)__builtin_amdgcn_s_getreg((3 << 11) | 20) & 0xFu; }
#define XB_SPIN(cond, bar) do { unsigned _sp = 0; while (cond) { __builtin_amdgcn_s_sleep(1); \
    if ((++_sp & 255u) == 0u) { if (xb_ld(&(bar)[XB_TMO])) break; if (_sp > XB_SPIN_CAP) { atomicAdd(&(bar)[XB_TMO], 1u); break; } } } } while (0)

struct XcdBarrier {
    unsigned* bar; unsigned x;
    volatile LAS unsigned* st;
};

__device__ __forceinline__ XcdBarrier xcd_barrier_post(unsigned* bar, volatile LAS unsigned* st) {
    XcdBarrier b; b.bar = bar; b.x = xb_xcc_id(); b.st = st;
    if (threadIdx.x == 0) (void)xb_add(&bar[XB_XCNT(b.x)], 1u);
    return b;
}
__device__ __forceinline__ void xcd_barrier_complete(unsigned* bar, unsigned x, unsigned& nloc, unsigned& nx) {
    const unsigned G = gridDim.x * gridDim.y * gridDim.z;
    unsigned sum, cnt, mine, sp = 0u;
    for (;;) {
        sum = 0u; cnt = 0u; mine = 0u;
#pragma unroll
        for (unsigned j = 0; j < 16; ++j) { const unsigned c = xb_ld(&bar[XB_XCNT(j)]); sum += c; cnt += (c > 0u) ? 1u : 0u; mine = (j == x) ? c : mine; }
        if (sum == G) break;
        __builtin_amdgcn_s_sleep(1);
        if ((++sp & 255u) == 0u) { if (xb_ld(&bar[XB_TMO])) break; if (sp > XB_SPIN_CAP) { atomicAdd(&bar[XB_TMO], 1u); break; } }
    }
    nloc = mine > 0u ? mine : 1u; nx = cnt > 0u ? cnt : 1u;
}

__device__ __forceinline__ void xcd_barrier(const XcdBarrier& b) {
    asm volatile("s_waitcnt vmcnt(0)" ::: "memory");
    __syncthreads();
    if (threadIdx.x == 0) {
        unsigned* bar = b.bar;
        __builtin_amdgcn_s_waitcnt(0);
        unsigned nloc = b.st[0], nx = b.st[1];
        if (nloc == 0u) { xcd_barrier_complete(bar, b.x, nloc, nx); b.st[0] = nloc; b.st[1] = nx; }
        const unsigned old = xb_add(&bar[XB_XSUB(b.x)], 1u);
        const unsigned gen = old / nloc;
        if (old + 1u == (gen + 1u) * nloc) {
            __builtin_amdgcn_fence(__ATOMIC_RELEASE, "agent");
            asm volatile("s_waitcnt vmcnt(0)" ::: "memory");
            const unsigned og = xb_add(&bar[XB_TOP], 1u);
            const unsigned tg = og / nx;
            if (og + 1u == (tg + 1u) * nx) xb_add(&bar[XB_TOPGEN], 1u);
            else XB_SPIN(xb_ld(&bar[XB_TOPGEN]) == tg, bar);
            __builtin_amdgcn_fence(__ATOMIC_ACQUIRE, "agent");
            xb_add(&bar[XB_XGEN(b.x)], 1u);
            asm volatile("s_waitcnt vmcnt(0)" ::: "memory");
        } else {
            XB_SPIN(xb_ld(&bar[XB_XGEN(b.x)]) == gen, bar);
            __builtin_amdgcn_fence(__ATOMIC_ACQUIRE, "agent");
            asm volatile("s_waitcnt vmcnt(0)" ::: "memory");
        }
    }
    __syncthreads();
}

struct Args { const float* in[23]; float* out; char* ws; };
constexpr int LDS_BYTES = 131072 + 4096;

typedef const __attribute__((address_space(4))) Args* kargs_t;
DEV kargs_t KA() { kargs_t k = (kargs_t)__builtin_amdgcn_kernarg_segment_ptr(); asm volatile("" : "+s"(k)); return k; }
#define WSP(type, off) ((type*)(ws + (off)))

__global__ __launch_bounds__(NTHR, 2) void mega(Args a) {
  extern __shared__ __attribute__((aligned(16))) char lds[];
  cg::grid_group grid = cg::this_grid();
  PG8_LAS unsigned char* glds = (PG8_LAS unsigned char*)lds;
  const int bid = blockIdx.x, G = gridDim.x;
  (void)a;
  volatile LAS unsigned* bst = (volatile LAS unsigned*)((LAS char*)lds + LDS_BYTES - 16);
  if (threadIdx.x < 4) bst[threadIdx.x] = 0u;
  __syncthreads();
  XcdBarrier xbar; { kargs_t k = KA(); xbar = xcd_barrier_post((unsigned*)k->ws, bst); }

  { kargs_t k = KA(); char* ws = k->ws;
    const int wv0_ = threadIdx.x >> 6;
    if (wv0_ < 4) { const int lane_ = threadIdx.x & 63, wv_ = wv0_, gw_ = bid * 4 + wv_, nw_ = G * 4;
      __attribute__((address_space(3))) float* scr = (__attribute__((address_space(3))) float*)((__attribute__((address_space(3))) char*)lds + wv_ * 8448);
      constexpr int I_IN = 16 * 120, I_BR = 8 * 32, I_SQ = 16 * 32, I_C1 = 32 * 8, I_C2 = 4 * 8, I_UQ = 4 * 24, I_UKV = 2 * 32;
      constexpr int NITEMS = I_IN + 2 * I_BR + 2 * I_SQ + 2 * I_C1 + 2 * I_C2 + I_UQ + I_UKV;
      for (int it = gw_; it < NITEMS; it += nw_) {
        int r = it;
        if (r < I_IN) { tr_item<1>(k->in[2], 1024, IN_COLS, WSP(bf16_t, WS_WIN), 120, 3840, scr, r, lane_); continue; } r -= I_IN;
        if (r < I_BR) { tr_item<0>(k->in[13], 512, 1024, WSP(bf16_t, WS_WBN), 32, 1024, scr, r, lane_); continue; } r -= I_BR;
        if (r < I_BR) { tr_item<0>(k->in[14], 512, 1024, WSP(bf16_t, WS_WBM), 32, 1024, scr, r, lane_); continue; } r -= I_BR;
        if (r < I_SQ) { tr_item<0>(k->in[15], 1024, 1024, WSP(bf16_t, WS_WOUT), 32, 1024, scr, r, lane_); continue; } r -= I_SQ;
        if (r < I_SQ) { tr_item<0>(k->in[17], 1024, 1024, WSP(bf16_t, WS_WQ), 32, 1024, scr, r, lane_); continue; } r -= I_SQ;
        if (r < I_C1) { tr_item<0>(k->in[5], 2048, 256, WSP(bf16_t, WS_CKW1), 8, 256, scr, r, lane_); continue; } r -= I_C1;
        if (r < I_C1) { tr_item<0>(k->in[7], 2048, 256, WSP(bf16_t, WS_CVW1), 8, 256, scr, r, lane_); continue; } r -= I_C1;
        if (r < I_C2) { tr_item<0>(k->in[6], 256, 64, WSP(bf16_t, WS_CKW2), 8, 64, scr, r, lane_); continue; } r -= I_C2;
        if (r < I_C2) { tr_item<0>(k->in[8], 256, 64, WSP(bf16_t, WS_CVW2), 8, 64, scr, r, lane_); continue; } r -= I_C2;
        if (r < I_UQ) { tr_item<0>(k->in[11], 256, 768, WSP(bf16_t, WS_UQ), 24, 768, scr, r, lane_); continue; } r -= I_UQ;
        tr_item<0>(k->in[12], 128, 1024, WSP(bf16_t, WS_UKV), 32, 1024, scr, r, lane_);
      }
      for (int i = gw_ * 64 + lane_; i < 16 * 128 * 64; i += nw_ * 64) WSP(bf16_t, WS_SUBK)[i] = f2bf(k->in[18][i]);
      for (int i = gw_ * 64 + lane_; i < SEQ * 16; i += nw_ * 64) rope_entry(WSP(float2, WS_ROPE), i);
    } else ph_rms1024<false>(k->in[0], k->in[1], WSP(bf16_t, WS_XN), T, nullptr, nullptr, bid * 4 + (wv0_ - 4), G * 4); }
  grid.sync();
  { kargs_t k = KA(); char* ws = k->ws;
    pg8::Gemm g{WSP(bf16_t, WS_XN), WSP(bf16_t, WS_WIN), T, 3840, 1024}; pg8::StaticOrder S; S.init(T, 3840, G, bid);
    pg8::EpiInProjF E{WSP(bf16_t, WS_PROJ), WSP(bf16_t, WS_GATES)};
    pg8::gemm_phase<pg8::EpiInProjF, pg8::StaticOrder, PG8_ALIGN, PG8_SP2>(glds, g, S, E); }
  xcd_barrier(xbar);
  { kargs_t k = KA(); char* ws = k->ws;
    const int lane_ = threadIdx.x & 63, wv_ = threadIdx.x >> 6;
    if (G >= 128 && bid < 64) {
      const int tab = bid >> 5;
      pg8::Gemm g{WSP(bf16_t, WS_PROJ) + PC_KV + tab * 128, WSP(bf16_t, tab ? WS_CVW1 : WS_CKW1), 2048, 1024, 512};
      g.pitchA = 16u * PROJ_LD * 2u; g.kstepA = PROJ_LD * 2u; g.hstepA = 128; g.tA_pm = (size_t)SEQ * PROJ_LD * 2; g.tA_pn = (size_t)8 * PROJ_LD * 2;
      g.pitchB = 4096u; g.kstepB = 128u; g.hstepB = (size_t)128 * 4096; g.tB_pn = 1024; g.nt = 8;
      pg8::StaticOrder S; S.init(2048, 1024, 32, bid & 31);
      pg8::EpiSlabF E{WSP(float, WS_SLAB) + (size_t)tab * 4 * 2048 * 256};
      pg8::gemm_phase<pg8::EpiSlabF, pg8::StaticOrder, PG8_ALIGN, PG8_SP2>(glds, g, S, E);
    } else {
      const int nb = (G >= 128) ? G - 64 : G, b0 = (G >= 128) ? bid - 64 : bid;
      prep::cmp_bias(k->in[3], k->in[4], WSP(bf16_t, WS_CKW1), WSP(bf16_t, WS_CVW1), WSP(float, WS_CPOS), b0 * NWV + wv_, nb * NWV, lane_);
      prep::latent_rows(WSP(bf16_t, WS_PROJ), k->in[9], k->in[10], WSP(float2, WS_ROPE), WSP(bf16_t, WS_CQN), WSP(bf16_t, WS_CKVN), WSP(bf16_t, WS_KROPE), b0 * NWV + wv_, nb * NWV, lane_);
    } }
  xcd_barrier(xbar);
  { kargs_t k = KA(); char* ws = k->ws;
    pg8::Gemm g{WSP(bf16_t, WS_CQN), WSP(bf16_t, WS_UQ), T, 768, 256}; pg8::StaticOrder S; S.init(T, 768, G, (bid + 64) & 255);
    pg8::EpiMlaQF E{WSP(bf16_t, WS_MLAQ), WSP(float2, WS_ROPE)};
    pg8::gemm_phase<pg8::EpiMlaQF, pg8::StaticOrder, PG8_ALIGN, PG8_SP2>(glds, g, S, E); }
  { kargs_t k = KA(); char* ws = k->ws;
    pg8::Gemm g{WSP(bf16_t, WS_CKVN), WSP(bf16_t, WS_UKV), T, 1024, 128}; pg8::StaticOrder S; S.init(T, 1024, G, bid);
    pg8::EpiBf16<0> E{WSP(bf16_t, WS_MLAKV), 1024, nullptr, 0, 0, 1.f};
    pg8::gemm_phase<pg8::EpiBf16<0>, pg8::StaticOrder, PG8_ALIGN, PG8_SP2>(glds, g, S, E); }
  { kargs_t k = KA(); char* ws = k->ws;
    const int lane_ = threadIdx.x & 63, wv_ = threadIdx.x >> 6;
    for (int it = (G - 1 - bid) * NWV + wv_; it < 128; it += G * NWV) {
      const int tab = it >> 6;
      prep::cmp_l2(WSP(float, WS_SLAB) + (size_t)tab * 4 * 2048 * 256, WSP(float, WS_CPOS) + tab * 256, WSP(bf16_t, tab ? WS_CVW2 : WS_CKW2), WSP(bf16_t, tab ? WS_VC : WS_KC), it & 63, lane_);
    } }
  xcd_barrier(xbar);
  { kargs_t k = KA(); char* ws = k->ws;
    att::attn_phase(WSP(bf16_t, WS_PROJ), WSP(bf16_t, WS_KC), WSP(bf16_t, WS_VC), k->in[21], WSP(bf16_t, WS_ONSA),
                    WSP(bf16_t, WS_MLAQ), WSP(bf16_t, WS_MLAKV), WSP(bf16_t, WS_KROPE), WSP(bf16_t, WS_OMLA), (att::lptr)lds); }
  xcd_barrier(xbar);
  { kargs_t k = KA(); char* ws = k->ws;
    pg8::Gemm g{WSP(bf16_t, WS_ONSA), WSP(bf16_t, WS_WBN), T, 1024, 512}; pg8::StaticOrder S; S.init(T, 1024, G, bid);
    pg8::EpiMergeF<0> E{WSP(bf16_t, WS_GATES), WSP(bf16_t, WS_MERGED)};
    pg8::gemm_phase<pg8::EpiMergeF<0>, pg8::StaticOrder, PG8_ALIGN, PG8_SP2>(glds, g, S, E); }
  { kargs_t k = KA(); char* ws = k->ws;
    pg8::Gemm g{WSP(bf16_t, WS_OMLA), WSP(bf16_t, WS_WBM), T, 1024, 512}; pg8::StaticOrder S; S.init(T, 1024, G, bid);
    pg8::EpiMergeF<1> E{WSP(bf16_t, WS_GATES), WSP(bf16_t, WS_MERGED)};
    pg8::gemm_phase<pg8::EpiMergeF<1>, pg8::StaticOrder, PG8_ALIGN, PG8_SP2>(glds, g, S, E); }
  xcd_barrier(xbar);
  { kargs_t k = KA(); char* ws = k->ws;
    pg8::Gemm g{WSP(bf16_t, WS_MERGED), WSP(bf16_t, WS_WOUT), T, 1024, 1024}; pg8::StaticOrder S; S.init(T, 1024, G, bid);
    pg8::EpiResidF E{k->in[0], k->out};
    pg8::gemm_phase<pg8::EpiResidF, pg8::StaticOrder, PG8_ALIGN, PG8_SP2>(glds, g, S, E); }
  xcd_barrier(xbar);
  { kargs_t k = KA(); char* ws = k->ws; ph_rms1024<true>(k->out, k->in[16], WSP(bf16_t, WS_HN), T, WSP(unsigned, WS_HN8), WSP(float, WS_SH));
    peer::conv_tables(k->in[19], k->in[20], WSP(unsigned, WS_U8), WSP(float, WS_SU), WSP(unsigned, WS_V8)); }
  xcd_barrier(xbar);
  { kargs_t k = KA(); char* ws = k->ws;
    pg8::Gemm g{WSP(bf16_t, WS_HN), WSP(bf16_t, WS_WQ), T, 1024, 1024}; pg8::StaticOrder S; S.init(T, 1024, G, bid);
    pg8::EpiBf16<0> E{WSP(bf16_t, WS_PQ), 1024, nullptr, 0, 0, 1.f};
    pg8::gemm_phase<pg8::EpiBf16<0>, pg8::StaticOrder, PG8_ALIGN, PG8_SP2>(glds, g, S, E); }
  xcd_barrier(xbar);
  { kargs_t k = KA(); char* ws = k->ws; peer::route_phase(WSP(bf16_t, WS_PQ), WSP(bf16_t, WS_SUBK), WSP(unsigned, WS_PIDX), (__attribute__((address_space(3))) char*)lds); }
  xcd_barrier(xbar);
  { kargs_t k = KA(); char* ws = k->ws;
    peer::experts_sliced<0>(WSP(unsigned, WS_PIDX), WSP(unsigned, WS_HN8), WSP(float, WS_SH), WSP(unsigned, WS_U8), WSP(float, WS_SU), WSP(float, WS_CO), WSP(unsigned, WS_V8), k->out, WSP(float, WS_SSQ),
                            (unsigned*)ws + CTL_QA, (__attribute__((address_space(3))) char*)lds); }
  xcd_barrier(xbar);
  { kargs_t k = KA(); char* ws = k->ws;
    peer::experts_sliced<1>(WSP(unsigned, WS_PIDX), WSP(unsigned, WS_HN8), WSP(float, WS_SH), WSP(unsigned, WS_U8), WSP(float, WS_SU), WSP(float, WS_CO), WSP(unsigned, WS_V8), k->out, WSP(float, WS_SSQ),
                            (unsigned*)ws + CTL_QB, (__attribute__((address_space(3))) char*)lds); }
  xcd_barrier(xbar);
  { kargs_t k = KA(); char* ws = k->ws; peer::experts_norm(WSP(float, WS_SSQ), k->in[22], k->out); }
}

extern "C" void kernel_launch(void* const* d_in, const int* in_sizes, int n_in, void* d_out, int out_size, void* d_ws, size_t ws_size, hipStream_t stream) {
  if (n_in != 23 || ws_size < 256 * MiB) { fprintf(stderr, "kernel_launch: unexpected n_in %d / ws_size %zu\n", n_in, ws_size); return; }
  static int grid_blocks = 0;
  if (!grid_blocks) {
    int dev = 0, cus = 0, per_cu = 0;
    (void)hipGetDevice(&dev);
    (void)hipDeviceGetAttribute(&cus, hipDeviceAttributeMultiprocessorCount, dev);
    if (hipFuncSetAttribute((const void*)mega, hipFuncAttributeMaxDynamicSharedMemorySize, LDS_BYTES) != hipSuccess) fprintf(stderr, "kernel_launch: hipFuncSetAttribute failed\n");
    (void)hipOccupancyMaxActiveBlocksPerMultiprocessor(&per_cu, (const void*)mega, NTHR, LDS_BYTES);
    if (per_cu < 1) { fprintf(stderr, "kernel_launch: occupancy query returned %d\n", per_cu); per_cu = 1; }
    if (per_cu > 2) per_cu = 2;
    grid_blocks = cus * per_cu;
    fprintf(stderr, "kernel_launch: cus %d per_cu %d grid %d ws %zu\n", cus, per_cu, grid_blocks, ws_size);
  }
  if (hipMemsetAsync(d_ws, 0, 65536, stream) != hipSuccess) fprintf(stderr, "kernel_launch: hipMemsetAsync failed\n");
  Args a{};
  for (int i = 0; i < 23; ++i) a.in[i] = (const float*)d_in[i];
  a.out = (float*)d_out; a.ws = (char*)d_ws;
  void* args[] = {&a};
  hipError_t e = hipLaunchCooperativeKernel((const void*)mega, dim3(grid_blocks), dim3(NTHR), args, LDS_BYTES, stream);
  if (e != hipSuccess) fprintf(stderr, "cooperative launch failed: %s (grid %d)\n", hipGetErrorString(e), grid_blocks);
}
```

```cpp
#include <hip/hip_runtime.h>
#include <stdint.h>
#include <cstdio>
#include <hip/hip_cooperative_groups.h>
namespace cg = cooperative_groups;

typedef unsigned short bf16_t;
#define DEV __device__ __forceinline__

constexpr int BATCH = 8, SEQ = 2048, DM = 1024, T = BATCH * SEQ;
constexpr int IN_COLS = 3768;
constexpr int PROJ_LD = 1792;
constexpr int PC_Q = 0, PC_KV = 512, PC_CQ = 1280, PC_CKV = 1536, PC_KR = 1664, PC_GATE = 1696;
constexpr int NC = 127;
constexpr size_t MiB = 1u << 20;

constexpr size_t WS_WIN = 1 * MiB;
constexpr size_t WS_WBN = 9 * MiB;
constexpr size_t WS_WBM = 10 * MiB;
constexpr size_t WS_WOUT = 11 * MiB;
constexpr size_t WS_WQ = 13 * MiB;
constexpr size_t WS_CKW1 = 15 * MiB;
constexpr size_t WS_CVW1 = 16 * MiB;
constexpr size_t WS_CKW2 = 17 * MiB;
constexpr size_t WS_CVW2 = 17 * MiB + 128 * 1024;
constexpr size_t WS_UQ = 17 * MiB + 256 * 1024;
constexpr size_t WS_UKV = 17 * MiB + 768 * 1024;
constexpr size_t WS_SUBK = 18 * MiB;
constexpr size_t WS_ROPE = 18 * MiB + 512 * 1024;
constexpr size_t WS_GATES = 20 * MiB;
constexpr size_t WS_PQ = 20 * MiB;
constexpr size_t WS_OB = 52 * MiB;
constexpr size_t WS_PROJ = 84 * MiB;
constexpr size_t WS_MERGED = 84 * MiB;
constexpr size_t WS_PIDX = 84 * MiB;
constexpr size_t WS_U8 = 172 * MiB;
constexpr size_t WS_V8 = 188 * MiB;
constexpr size_t WS_SU = 204 * MiB;
constexpr size_t WS_SH = 204 * MiB + 65536;
constexpr size_t WS_HN8 = 205 * MiB;
constexpr size_t WS_CO = 221 * MiB;
constexpr size_t WS_SSQ = 229 * MiB;
constexpr int CTL_QA = 4096, CTL_QB = 4096 + 512;
constexpr size_t WS_PW = 92 * MiB;
constexpr size_t WS_XN = 140 * MiB;
constexpr size_t WS_MLAKV = 140 * MiB;
constexpr size_t WS_HN = 140 * MiB;
constexpr size_t WS_MLAQ = 172 * MiB;
constexpr size_t WS_KROPE = 196 * MiB;
constexpr size_t WS_KC = 197 * MiB;
constexpr size_t WS_VC = 197 * MiB + 512 * 1024;
constexpr size_t WS_ONSA = 198 * MiB;
constexpr size_t WS_OMLA = 214 * MiB;
constexpr size_t WS_SLAB = 198 * MiB;
constexpr size_t WS_CPOS = 18 * MiB + 768 * 1024;
constexpr size_t WS_CA = 198 * MiB;
constexpr size_t WS_HID = 206 * MiB;
constexpr size_t WS_HID2 = 207 * MiB;
constexpr size_t WS_CA2 = 214 * MiB;
constexpr size_t WS_CQN = 230 * MiB;
constexpr size_t WS_CKVN = 238 * MiB;
constexpr size_t WS_OCMP = 230 * MiB;
constexpr size_t WS_SEL = 246 * MiB;

__device__ const unsigned char T5B[128] = {
  0, 1, 2, 3, 4, 5, 6, 7, 8, 9, 10, 11, 12, 13, 14, 15, 16, 16, 16, 17, 17, 18, 18, 18, 19, 19, 19, 20, 20, 20, 20, 21,
  21, 21, 21, 22, 22, 22, 22, 22, 23, 23, 23, 23, 23, 23, 24, 24, 24, 24, 24, 24, 25, 25, 25, 25, 25, 25, 25, 26, 26, 26, 26, 26,
  26, 26, 26, 27, 27, 27, 27, 27, 27, 27, 27, 27, 27, 28, 28, 28, 28, 28, 28, 28, 28, 28, 28, 29, 29, 29, 29, 29, 29, 29, 29, 29,
  29, 29, 29, 30, 30, 30, 30, 30, 30, 30, 30, 30, 30, 30, 30, 30, 30, 31, 31, 31, 31, 31, 31, 31, 31, 31, 31, 31, 31, 31, 31, 31};

DEV float bf2f(bf16_t v) { return __uint_as_float(((unsigned)v) << 16); }
DEV bf16_t f2bf(float f) { unsigned u = __float_as_uint(f); u += 0x7fffu + ((u >> 16) & 1u); return (bf16_t)(u >> 16); }
template <int CTRL> DEV int dpp_i(int v) { return __builtin_amdgcn_update_dpp(0, v, CTRL, 0xF, 0xF, true); }
template <int CTRL> DEV float dpp_f(float v) { return __uint_as_float((unsigned)__builtin_amdgcn_update_dpp(0, (int)__float_as_uint(v), CTRL, 0xF, 0xF, true)); }
DEV int sum16_i(int v) { v += dpp_i<0xB1>(v); v += dpp_i<0x4E>(v); v += dpp_i<0x141>(v); v += dpp_i<0x140>(v); return v; }
DEV float sum16_f(float v) { v += dpp_f<0xB1>(v); v += dpp_f<0x4E>(v); v += dpp_f<0x141>(v); v += dpp_f<0x140>(v); return v; }
DEV float max16_f(float v) { v = fmaxf(v, dpp_f<0xB1>(v)); v = fmaxf(v, dpp_f<0x4E>(v)); v = fmaxf(v, dpp_f<0x141>(v)); v = fmaxf(v, dpp_f<0x140>(v)); return v; }
DEV float rl_f(float v, int l) { return __uint_as_float((unsigned)__builtin_amdgcn_readlane((int)__float_as_uint(v), l)); }
DEV float wsum(float v) { v = sum16_f(v); return (rl_f(v, 0) + rl_f(v, 16)) + (rl_f(v, 32) + rl_f(v, 48)); }
DEV float wmaxf(float v) { v = max16_f(v); return fmaxf(fmaxf(rl_f(v, 0), rl_f(v, 16)), fmaxf(rl_f(v, 32), rl_f(v, 48))); }
DEV float sigmoidf_(float x) { return 1.0f / (1.0f + expf(-x)); }
DEV float gelu_exact(float x) { return 0.5f * x * (1.0f + erff(x * 0.70710678118654752f)); }
DEV void wave_lds_sync() { asm volatile("s_waitcnt lgkmcnt(0)" ::: "memory"); __builtin_amdgcn_wave_barrier(); asm volatile("" ::: "memory"); }
DEV float t5bias(const float* t5, int head, int dist) { int d = dist < 127 ? dist : 127; d = d < 0 ? 0 : d; return t5[(int)T5B[d] * 8 + head]; }


namespace pg8 {
#define PG8_LAS __attribute__((address_space(3)))
typedef unsigned short bf16_t;
typedef short bf16x8 __attribute__((ext_vector_type(8)));
typedef float f32x4 __attribute__((ext_vector_type(4)));
typedef unsigned u32x4 __attribute__((ext_vector_type(4)));
constexpr int BM = 256, BK = 64, HALF = 128, HTB = HALF * BK * 2  , STAGE_BYTES = 8 * HTB, NXCD = 8, WGM = 8;

__host__ __device__ __forceinline__ int lds_byte(int r, int c) { const int st = (r >> 4) * 2 + (c >> 5), rr = r & 15, cc = c & 31, ob = rr * 64 + cc * 2; return st * 1024 + (ob ^ (((ob >> 9) & 1) << 5)); }
__host__ __device__ __forceinline__ void stage_rc(int b, int& R, int& C) { const int st = b / 1024, sb = b % 1024, swz = sb ^ (((sb >> 9) & 1) << 5); R = (st >> 1) * 16 + swz / 64; C = (st & 1) * 32 + (swz % 64) / 2; }
__host__ __device__ __forceinline__ int perm32(int rho) { const int n = rho >> 4, i = rho & 15; return 8 * (i >> 2) + 4 * n + (i & 3); }

struct Unit { int pm, pn; };
struct Gemm { const bf16_t* A; const bf16_t* Bt; int M, N, K;
    unsigned pitchA = 0, pitchB = 0, kstepA = 0, kstepB = 0; size_t hstepA = 0, hstepB = 0, tA_pm = 0, tA_pn = 0, tB_pn = 0; int nt = 0; };

struct StaticOrder {
    int nM, nN, nwg, G, c;
    __host__ __device__ void init(int M, int N, int G_, int c_) { nM = M / BM; nN = N / BM; nwg = nM * nN; G = G_; c = c_; }
    __host__ __device__ bool next(int i, Unit& u) const {
        const long L = (long)i * G + c; if (L >= nwg) return false;
        int wgid = (int)L; { const int q = nwg / NXCD, r = nwg % NXCD, xcd = wgid % NXCD, off = wgid / NXCD; wgid = (xcd < r ? xcd * (q + 1) : r * (q + 1) + (xcd - r) * q) + off; }
        const int nig = WGM * nN, gid = wgid / nig, fm = gid * WGM, gsz = (nM - fm) < WGM ? (nM - fm) : WGM;
        u.pm = fm + ((wgid % nig) % gsz); u.pn = (wgid % nig) / gsz; return true;
    }
    __device__ __forceinline__ void a_ready(const Unit&) const {}
    __device__ __forceinline__ void done(const Unit&) const {}
};

__device__ __forceinline__ unsigned cvt_pk_bf16(float lo, float hi) { unsigned r; asm volatile("v_cvt_pk_bf16_f32 %0, %1, %2" : "=v"(r) : "v"(lo), "v"(hi)); return r; }
typedef float f32x2 __attribute__((ext_vector_type(2)));
__device__ __forceinline__ f32x2 gelu_pk(f32x2 v) {
    const f32x2 av = __builtin_elementwise_abs(v), d = av * 0.2316418882f + 1.0f;
    f32x2 t; t.x = __builtin_amdgcn_rcpf(d.x); t.y = __builtin_amdgcn_rcpf(d.y);
    f32x2 q = t * 0.5307027145f + (-0.7265760135f); q = q * t + 0.7107068705f; q = q * t + (-0.142248368f); q = q * t + 0.127414796f; q = q * t;
    const f32x2 s = (v * v) * (-0.72134752044f);
    f32x2 e; e.x = __builtin_amdgcn_exp2f(s.x); e.y = __builtin_amdgcn_exp2f(s.y);
    const f32x2 m = v * (q * e), r = v - m;
    f32x2 o; o.x = v.x < 0.f ? m.x : r.x; o.y = v.y < 0.f ? m.y : r.y; return o;
}

template <int ACT  > struct EpiBf16 {
    static constexpr bool PERM = true, AFTER_DRAIN = false; static_assert(ACT == 0 || ACT == 1, "EpiBf16: ACT is 0 (none) or 1 (gelu_pk)");
    bf16_t* O; int ldc; const float* bias; int split_cols; size_t split_stride; float scale0;
    __device__ __forceinline__ void operator()(const f32x4 (&acc)[2][2][4][2], const Unit& u, int wr, int wc, int fr, int fq) const {
        const int row0 = u.pm * BM + wr * 64 + fr; int colt = u.pn * BM; bf16_t* base = O;
        float sc = 1.f; if (split_cols) { const int t = colt / split_cols; base += (size_t)t * split_stride; colt -= t * split_cols; if (t == 0) sc = scale0; }
        const int col0 = colt + wc * 32 + 8 * fq, bcol0 = u.pn * BM + wc * 32 + 8 * fq;
        f32x4 bv[2][2];
#pragma unroll
        for (int bj = 0; bj < 2; ++bj)
#pragma unroll
            for (int n = 0; n < 2; ++n) bv[bj][n] = bias ? *(const f32x4*)(bias + bcol0 + bj * HALF + 4 * n) : (f32x4){0.f, 0.f, 0.f, 0.f};
#pragma unroll
        for (int ai = 0; ai < 2; ++ai)
#pragma unroll
            for (int m = 0; m < 4; ++m) { bf16_t* rowp = base + (size_t)(row0 + ai * HALF + m * 16) * ldc + col0;
#pragma unroll
                for (int bj = 0; bj < 2; ++bj) { f32x4 v0 = acc[ai][bj][m][0] + bv[bj][0], v1 = acc[ai][bj][m][1] + bv[bj][1];
                    if (ACT == 1) { f32x2 a = gelu_pk((f32x2){v0[0], v0[1]}), b = gelu_pk((f32x2){v0[2], v0[3]}), c = gelu_pk((f32x2){v1[0], v1[1]}), d = gelu_pk((f32x2){v1[2], v1[3]});
                        v0 = (f32x4){a.x, a.y, b.x, b.y}; v1 = (f32x4){c.x, c.y, d.x, d.y}; }
                    v0 = v0 * sc; v1 = v1 * sc; u32x4 w; w.x = cvt_pk_bf16(v0[0], v0[1]); w.y = cvt_pk_bf16(v0[2], v0[3]); w.z = cvt_pk_bf16(v1[0], v1[1]); w.w = cvt_pk_bf16(v1[2], v1[3]);
                    *(u32x4*)(rowp + bj * HALF) = w; } }
    }
};

struct PanelStats {
    unsigned* xbuf;
    unsigned* cnt;
    unsigned* tmo;
    int ntn; float eps;
    unsigned code;
    __device__ __forceinline__ bool run(const f32x4 (&v)[2][2][4][2], const Unit& u, int wr, int wc, int fr, int fq, PG8_LAS unsigned char* lds, int wid, int lane) const {
        typedef float f32x2v __attribute__((ext_vector_type(2)));
        PG8_LAS f32x2v* P = (PG8_LAS f32x2v*)lds;
        PG8_LAS f32x2v* S = (PG8_LAS f32x2v*)(lds + 8192);
        PG8_LAS unsigned* flag = (PG8_LAS unsigned*)(lds + 8192 + 2048);
#pragma unroll
        for (int ai = 0; ai < 2; ++ai)
#pragma unroll
            for (int m = 0; m < 4; ++m) {
                float s = 0.f;
#pragma unroll
                for (int bj = 0; bj < 2; ++bj)
#pragma unroll
                    for (int n = 0; n < 2; ++n) { const f32x4 x = v[ai][bj][m][n]; s += (x[0] + x[1]) + (x[2] + x[3]); }
                s += __shfl_xor(s, 16); s += __shfl_xor(s, 32);
                const float mw = s * (1.0f / 64.0f); float q = 0.f;
#pragma unroll
                for (int bj = 0; bj < 2; ++bj)
#pragma unroll
                    for (int n = 0; n < 2; ++n) { const f32x4 d = v[ai][bj][m][n] - mw; q += (d[0] * d[0] + d[1] * d[1]) + (d[2] * d[2] + d[3] * d[3]); }
                q += __shfl_xor(q, 16); q += __shfl_xor(q, 32);
                if (fq == 0) P[(ai * HALF + wr * 64 + m * 16 + fr) * 4 + wc] = (f32x2v){mw, q};
            }
        asm volatile("s_waitcnt lgkmcnt(0)" ::: "memory"); __builtin_amdgcn_s_barrier(); asm volatile("" ::: "memory");
#if defined(BROKEN_EXCHANGE_NO_WAIT)
#warning BROKEN CONTROL BUILD: the row-statistics exchange does not wait; results are wrong by design
        if (blockIdx.x >= 64) { const long long t0_ = clock64(); while (clock64() - t0_ < 60000) __builtin_amdgcn_s_sleep(8); }
#endif
        const int row = wid * 32 + (lane & 31);
        if (lane < 32) {
            const f32x2v a = P[row * 4 + 0], b = P[row * 4 + 1], c = P[row * 4 + 2], d = P[row * 4 + 3];
            const float mt = (a.x + b.x + c.x + d.x) * 0.25f;
            const float da = a.x - mt, db = b.x - mt, dc = c.x - mt, dd = d.x - mt;
            const float m2 = (a.y + b.y) + (c.y + d.y) + 64.0f * ((da * da + db * db) + (dc * dc + dd * dd));
            unsigned long long* slot = (unsigned long long*)xbuf + ((size_t)(u.pm * BM + row) * 4 + u.pn);
            __hip_atomic_store(slot, ((unsigned long long)__float_as_uint(m2) << 32) | __float_as_uint(mt), __ATOMIC_RELAXED, __HIP_MEMORY_SCOPE_AGENT);
        }
        asm volatile("s_waitcnt vmcnt(0)" ::: "memory");
        if (lane == 0) __hip_atomic_fetch_add(cnt + 64 * u.pm, 1u, __ATOMIC_RELAXED, __HIP_MEMORY_SCOPE_AGENT);
        if (wid == 0) {
            bool dead = false; const unsigned long long t0 = __builtin_amdgcn_s_memrealtime(); const unsigned want = 8u * (unsigned)ntn;
            for (;;) {
#if defined(BROKEN_EXCHANGE_NO_WAIT)
                break;
#endif
                if ((unsigned)__builtin_amdgcn_readfirstlane(__hip_atomic_load(cnt + 64 * u.pm, __ATOMIC_RELAXED, __HIP_MEMORY_SCOPE_AGENT)) >= want) break;
                if (__builtin_amdgcn_s_memrealtime() - t0 > 2000000ull) {
                    if (lane == 0) { unsigned expect = 0u; __hip_atomic_compare_exchange_strong(tmo + 1, &expect, code | (unsigned)(u.pm & 0xff), __ATOMIC_RELAXED, __ATOMIC_RELAXED, __HIP_MEMORY_SCOPE_AGENT);
                                     __hip_atomic_store(tmo, 1u, __ATOMIC_RELAXED, __HIP_MEMORY_SCOPE_AGENT); }
                    dead = true; break; }
                __builtin_amdgcn_s_sleep(2);
            }
            __builtin_amdgcn_fence(__ATOMIC_ACQUIRE, "agent");
            if (lane == 0) flag[0] = dead ? 1u : 0u;
        }
        asm volatile("s_waitcnt vmcnt(0) lgkmcnt(0)" ::: "memory"); __builtin_amdgcn_s_barrier(); asm volatile("" ::: "memory");
        const bool bad = flag[0] != 0u;
        if (lane < 32) {
            const unsigned long long* slot = (const unsigned long long*)xbuf + (size_t)(u.pm * BM + row) * 4; float mt[4], m2[4]; float ms = 0.f;
#pragma unroll
            for (int t = 0; t < 4; ++t) { if (t < ntn) { const unsigned long long w = __hip_atomic_load(slot + t, __ATOMIC_RELAXED, __HIP_MEMORY_SCOPE_AGENT); mt[t] = __uint_as_float((unsigned)w); m2[t] = __uint_as_float((unsigned)(w >> 32)); } else { mt[t] = 0.f; m2[t] = 0.f; } ms += mt[t]; }
            const float mean = ms / (float)ntn; float q = 0.f;
#pragma unroll
            for (int t = 0; t < 4; ++t) if (t < ntn) { const float dm = mt[t] - mean; q += m2[t] + 256.0f * dm * dm; }
            S[row] = (f32x2v){mean, 1.0f / sqrtf(q / (256.0f * (float)ntn) + eps)};
        }
        asm volatile("s_waitcnt lgkmcnt(0)" ::: "memory"); __builtin_amdgcn_s_barrier(); asm volatile("" ::: "memory");
        return bad;
    }
};
struct EpiLnRes {
    static constexpr bool PERM = false, AFTER_DRAIN = true;
    const float* base; float* out; int ldc; const float* bias; PanelStats st; unsigned poison;
    __device__ __forceinline__ void fused(f32x4 (&acc)[2][2][4][2], const Unit& u, int wr, int wc, int fr, int fq, PG8_LAS unsigned char* lds, int wid, int lane) const {
        typedef float f32x2v __attribute__((ext_vector_type(2)));
        const PG8_LAS f32x2v* S = (const PG8_LAS f32x2v*)(lds + 8192);
        const int col0 = u.pn * BM + wc * 32 + 4 * fq;
#pragma unroll
        for (int bj = 0; bj < 2; ++bj)
#pragma unroll
            for (int n = 0; n < 2; ++n) { const f32x4 bv = bias ? *(const f32x4*)(bias + col0 + bj * HALF + n * 16) : (f32x4){0.f, 0.f, 0.f, 0.f};
#pragma unroll
                for (int ai = 0; ai < 2; ++ai)
#pragma unroll
                    for (int m = 0; m < 4; ++m) acc[ai][bj][m][n] += bv; }
        f32x4 pre[4][2][2];
#pragma unroll
        for (int m = 0; m < 4; ++m) { const size_t off = (size_t)(u.pm * BM + wr * 64 + m * 16 + fr) * ldc + col0;
#pragma unroll
            for (int bj = 0; bj < 2; ++bj)
#pragma unroll
                for (int n = 0; n < 2; ++n) pre[m][bj][n] = *(const f32x4*)(base + off + bj * HALF + n * 16); }
        const bool bad = st.run(acc, u, wr, wc, fr, fq, lds, wid, lane) || poison != 0u;
        const float qnan = __builtin_nanf("");
#pragma unroll
        for (int ai = 0; ai < 2; ++ai)
#pragma unroll
            for (int m = 0; m < 4; ++m) { const int r = ai * HALF + wr * 64 + m * 16 + fr; const f32x2v sr = S[r]; const size_t off = (size_t)(u.pm * BM + r) * ldc + col0;
#pragma unroll
                for (int bj = 0; bj < 2; ++bj)
#pragma unroll
                    for (int n = 0; n < 2; ++n) { const f32x4 bs = ai == 0 ? pre[m][bj][n] : *(const f32x4*)(base + off + bj * HALF + n * 16); f32x4 o = bs + (acc[ai][bj][m][n] - sr.x) * sr.y;
                        if (bad) o = (f32x4){qnan, qnan, qnan, qnan}; *(f32x4*)(out + off + bj * HALF + n * 16) = o; }
                if (m & 1) asm volatile("" ::: "memory"); }
    }
};
struct EpiLnResLn {
    static constexpr bool PERM = false, AFTER_DRAIN = true;
    const float* base; float* out; bf16_t* xn; int ldc; const float* bias; PanelStats st1, st2; unsigned poison;
    __device__ __forceinline__ void fused(f32x4 (&acc)[2][2][4][2], const Unit& u, int wr, int wc, int fr, int fq, PG8_LAS unsigned char* lds, int wid, int lane) const {
        typedef float f32x2v __attribute__((ext_vector_type(2))); typedef unsigned u32x2v __attribute__((ext_vector_type(2)));
        const PG8_LAS f32x2v* S = (const PG8_LAS f32x2v*)(lds + 8192);
        const int col0 = u.pn * BM + wc * 32 + 4 * fq;
#pragma unroll
        for (int bj = 0; bj < 2; ++bj)
#pragma unroll
            for (int n = 0; n < 2; ++n) { const f32x4 bv = bias ? *(const f32x4*)(bias + col0 + bj * HALF + n * 16) : (f32x4){0.f, 0.f, 0.f, 0.f};
#pragma unroll
                for (int ai = 0; ai < 2; ++ai)
#pragma unroll
                    for (int m = 0; m < 4; ++m) acc[ai][bj][m][n] += bv; }
        bool bad = st1.run(acc, u, wr, wc, fr, fq, lds, wid, lane) || poison != 0u;
        const float qnan = __builtin_nanf("");
#pragma unroll
        for (int ai = 0; ai < 2; ++ai)
#pragma unroll
            for (int m = 0; m < 4; ++m) { const int r = ai * HALF + wr * 64 + m * 16 + fr; const f32x2v sr = S[r]; const size_t off = (size_t)(u.pm * BM + r) * ldc + col0;
#pragma unroll
                for (int bj = 0; bj < 2; ++bj)
#pragma unroll
                    for (int n = 0; n < 2; ++n) { const f32x4 bs = *(const f32x4*)(base + off + bj * HALF + n * 16); acc[ai][bj][m][n] = bs + (acc[ai][bj][m][n] - sr.x) * sr.y; }
                asm volatile("" : "+v"(acc[ai][0][m][0]), "+v"(acc[ai][0][m][1]), "+v"(acc[ai][1][m][0]), "+v"(acc[ai][1][m][1]));
                if (m & 1) asm volatile("" ::: "memory"); }
        const bool bad1 = bad;
        bad = st2.run(acc, u, wr, wc, fr, fq, lds, wid, lane) || bad;
#pragma unroll
        for (int ai = 0; ai < 2; ++ai)
#pragma unroll
            for (int m = 0; m < 4; ++m) { const int r = ai * HALF + wr * 64 + m * 16 + fr; const f32x2v sr = S[r]; const size_t off = (size_t)(u.pm * BM + r) * ldc + col0;
#pragma unroll
                for (int bj = 0; bj < 2; ++bj)
#pragma unroll
                    for (int n = 0; n < 2; ++n) { const f32x4 x1 = acc[ai][bj][m][n]; *(f32x4*)(out + off + bj * HALF + n * 16) = bad1 ? (f32x4){qnan, qnan, qnan, qnan} : x1;
                        const f32x4 o = (x1 - sr.x) * sr.y; u32x2v w; w.x = cvt_pk_bf16(o[0], o[1]); w.y = cvt_pk_bf16(o[2], o[3]);
                        if (bad) { w.x = 0x7fc07fc0u; w.y = 0x7fc07fc0u; } *(u32x2v*)(xn + off + bj * HALF + n * 16) = w; }
                asm volatile("" ::: "memory"); }
    }
};

template <class Epi, class Sched, bool ALIGN_EPI = false, bool SP2 = false>
__device__ __forceinline__ void gemm_phase(PG8_LAS unsigned char* lds, const Gemm g, const Sched& S, const Epi& E) {
    int tid = threadIdx.x; asm volatile("" : "+v"(tid));
    const int wid = __builtin_amdgcn_readfirstlane(tid >> 6), lane = tid & 63, wr = wid >> 2, wc = wid & 3, fr = lane & 15, fq = lane >> 4;
    int K = g.K; asm volatile("" : "+s"(K)); const int nt = g.nt ? g.nt : K / BK;
    const unsigned pitchA = g.pitchA ? g.pitchA : (unsigned)K * 2u, pitchB = g.pitchB ? g.pitchB : (unsigned)K * 2u;
    unsigned voffA[2], voffB[2];
#pragma unroll
    for (int i = 0; i < 2; ++i) { int R, C; stage_rc(tid * 16 + i * 8192, R, C); const int Rb = Epi::PERM ? ((R & ~31) + perm32(R & 31)) : R;
        voffA[i] = (unsigned)R * pitchA + (unsigned)C * 2u; voffB[i] = (unsigned)Rb * pitchB + (unsigned)C * 2u; }
    const size_t kstepA = g.kstepA ? g.kstepA : (size_t)(BK * 2), kstepB = g.kstepB ? g.kstepB : (size_t)(BK * 2);
    const size_t hstepA = g.hstepA ? g.hstepA : (size_t)HALF * K * 2, hstepB = g.hstepB ? g.hstepB : (size_t)HALF * K * 2;
    const size_t tA_pm = g.tA_pm ? g.tA_pm : (size_t)BM * K * 2, tA_pn = g.tA_pn, tB_pn = g.tB_pn ? g.tB_pn : (size_t)BM * K * 2;
    const unsigned ldsw = (unsigned)wid * 1024u;
    const int aoff = lds_byte(wr * 64 + fr, fq * 8), boff = lds_byte(wc * 32 + fr, fq * 8);
#define PG8_SA(b, h) (((b) * 2 + (h)) * HTB)
#define PG8_SB(b, h) ((4 + (b) * 2 + (h)) * HTB)
#define PG8_STAGE(bufoff, gbase, voff) do { _Pragma("unroll") for (int _i = 0; _i < 2; ++_i) \
        __builtin_amdgcn_global_load_lds((const unsigned*)((const char*)(gbase) + (voff)[_i]), (PG8_LAS unsigned*)(lds + (bufoff) + ldsw + _i * 8192), 16, 0, 0); } while (0)
#define PG8_LDA(dst, b, h) do { _Pragma("unroll") for (int m = 0; m < 4; ++m) _Pragma("unroll") for (int k = 0; k < 2; ++k) dst[m][k] = *(const PG8_LAS bf16x8*)(lds + PG8_SA(b, h) + aoff + m * 2048 + k * 1024); } while (0)
#define PG8_LDB(dst, b, h) do { _Pragma("unroll") for (int n = 0; n < 2; ++n) _Pragma("unroll") for (int k = 0; k < 2; ++k) dst[n][k] = *(const PG8_LAS bf16x8*)(lds + PG8_SB(b, h) + boff + n * 2048 + k * 1024); } while (0)
#define PG8_MMA(ai, bj, At, Bt) do { __builtin_amdgcn_s_setprio(1); _Pragma("unroll") for (int m = 0; m < 4; ++m) _Pragma("unroll") for (int n = 0; n < 2; ++n) _Pragma("unroll") for (int k = 0; k < 2; ++k) \
        acc[ai][bj][m][n] = __builtin_amdgcn_mfma_f32_16x16x32_bf16(Bt[n][k], At[m][k], acc[ai][bj][m][n], 0, 0, 0); __builtin_amdgcn_s_setprio(0); } while (0)
#define PG8_WAIT_V(n) asm volatile("s_waitcnt vmcnt(" #n ")" ::: "memory")
#define PG8_WAIT_L(n) asm volatile("s_waitcnt lgkmcnt(" #n ")" ::: "memory")
#define PG8_BAR __builtin_amdgcn_s_barrier()
#define PG8_SCHED __builtin_amdgcn_sched_barrier(0)
    Unit cur, nxt; int ui = 0;
    if (!S.next(0, cur)) return;
    f32x4 acc[2][2][4][2];
#pragma unroll
    for (int a = 0; a < 2; ++a)
#pragma unroll
        for (int b = 0; b < 2; ++b)
#pragma unroll
            for (int m = 0; m < 4; ++m)
#pragma unroll
                for (int n = 0; n < 2; ++n) acc[a][b][m][n] = (f32x4){0.f, 0.f, 0.f, 0.f};
    bf16x8 At[4][2], B0[2][2], B1[2][2];
    const char* cA = (const char*)g.A + (size_t)cur.pm * tA_pm + (size_t)cur.pn * tA_pn; const char* cB = (const char*)g.Bt + (size_t)cur.pn * tB_pn;
    S.a_ready(cur);
    if constexpr (SP2) {
        PG8_STAGE(PG8_SB(0, 0), cB, voffB); PG8_STAGE(PG8_SB(0, 1), cB + hstepB, voffB); PG8_STAGE(PG8_SA(0, 0), cA, voffA); PG8_STAGE(PG8_SA(0, 1), cA + hstepA, voffA);
        if (wr == 1) PG8_BAR;
        PG8_WAIT_V(2); PG8_BAR;
        PG8_STAGE(PG8_SB(1, 0), cB + kstepB, voffB); PG8_STAGE(PG8_SA(1, 0), cA + kstepA, voffA); PG8_STAGE(PG8_SB(1, 1), cB + hstepB + kstepB, voffB);
        PG8_WAIT_V(6); PG8_BAR;
    } else {
        PG8_STAGE(PG8_SB(0, 0), cB, voffB); PG8_STAGE(PG8_SA(0, 0), cA, voffA); PG8_STAGE(PG8_SB(0, 1), cB + hstepB, voffB); PG8_STAGE(PG8_SA(0, 1), cA + hstepA, voffA);
        if (wr == 1) PG8_BAR;
        PG8_WAIT_V(4); PG8_BAR;
        PG8_STAGE(PG8_SB(1, 0), cB + kstepB, voffB); PG8_STAGE(PG8_SA(1, 0), cA + kstepA, voffA); PG8_STAGE(PG8_SB(1, 1), cB + hstepB + kstepB, voffB);
        PG8_WAIT_V(6); PG8_BAR;
    }
    for (;;) {
        const bool has_next = S.next(ui + 1, nxt);
        const char* nA = has_next ? (const char*)g.A + (size_t)nxt.pm * tA_pm + (size_t)nxt.pn * tA_pn : cA; const char* nB = has_next ? (const char*)g.Bt + (size_t)nxt.pn * tB_pn : cB;
        for (int t = 0; t < nt; t += 2) {
            const bool last = (t == nt - 2);
            const char* a1 = cA + (size_t)(t + 1) * kstepA;
            const char* a2 = last ? nA : cA + (size_t)(t + 2) * kstepA; const char* b2 = last ? nB : cB + (size_t)(t + 2) * kstepB;
            const char* a3 = a2 + kstepA; const char* b3 = b2 + kstepB;
            if (last && has_next) S.a_ready(nxt);
            if constexpr (SP2) {
            PG8_LDB(B0, 0, 0); PG8_LDB(B1, 0, 1); PG8_SCHED; PG8_LDA(At, 0, 0); PG8_STAGE(PG8_SA(1, 1), a1 + hstepA, voffA);
            PG8_WAIT_V(8); PG8_WAIT_L(0); PG8_BAR; PG8_MMA(0, 0, At, B0); PG8_MMA(0, 1, At, B1); PG8_BAR; PG8_SCHED;
            PG8_LDA(At, 0, 1); PG8_STAGE(PG8_SB(0, 0), b2, voffB); PG8_STAGE(PG8_SB(0, 1), b2 + hstepB, voffB); PG8_STAGE(PG8_SA(0, 0), a2, voffA);
            PG8_WAIT_V(8); PG8_WAIT_L(0); PG8_BAR; PG8_MMA(1, 0, At, B0); PG8_MMA(1, 1, At, B1); PG8_BAR; PG8_SCHED;
            PG8_LDB(B0, 1, 0); PG8_LDB(B1, 1, 1); PG8_SCHED; PG8_LDA(At, 1, 0); PG8_STAGE(PG8_SA(0, 1), a2 + hstepA, voffA);
            PG8_WAIT_V(8); PG8_WAIT_L(0); PG8_BAR; PG8_MMA(0, 0, At, B0); PG8_MMA(0, 1, At, B1); PG8_BAR; PG8_SCHED;
            PG8_LDA(At, 1, 1); PG8_STAGE(PG8_SB(1, 0), b3, voffB); PG8_STAGE(PG8_SB(1, 1), b3 + hstepB, voffB); PG8_STAGE(PG8_SA(1, 0), a3, voffA);
            PG8_WAIT_V(8); PG8_WAIT_L(0); PG8_BAR; PG8_MMA(1, 0, At, B0); PG8_MMA(1, 1, At, B1); PG8_BAR; PG8_SCHED;
            } else {
            PG8_LDB(B0, 0, 0); PG8_SCHED; PG8_LDA(At, 0, 0); PG8_STAGE(PG8_SA(1, 1), a1 + hstepA, voffA);
            PG8_WAIT_L(8); PG8_BAR; PG8_WAIT_L(0); PG8_MMA(0, 0, At, B0); PG8_BAR; PG8_SCHED;
            PG8_LDB(B1, 0, 1); PG8_STAGE(PG8_SB(0, 0), b2, voffB);
            PG8_BAR; PG8_WAIT_L(0); PG8_MMA(0, 1, At, B1); PG8_BAR;
            PG8_LDA(At, 0, 1); PG8_STAGE(PG8_SA(0, 0), a2, voffA);
            PG8_BAR; PG8_WAIT_L(0); PG8_MMA(1, 0, At, B0); PG8_BAR; PG8_SCHED;
            PG8_STAGE(PG8_SB(0, 1), b2 + hstepB, voffB);
            PG8_WAIT_V(6); PG8_BAR; PG8_MMA(1, 1, At, B1); PG8_BAR;
            PG8_LDB(B0, 1, 0); PG8_SCHED; PG8_LDA(At, 1, 0); PG8_STAGE(PG8_SA(0, 1), a2 + hstepA, voffA);
            PG8_WAIT_L(8); PG8_BAR; PG8_WAIT_L(0); PG8_MMA(0, 0, At, B0); PG8_BAR; PG8_SCHED;
            PG8_LDB(B1, 1, 1); PG8_STAGE(PG8_SB(1, 0), b3, voffB);
            PG8_BAR; PG8_WAIT_L(0); PG8_MMA(0, 1, At, B1); PG8_BAR;
            PG8_LDA(At, 1, 1); PG8_STAGE(PG8_SA(1, 0), a3, voffA);
            PG8_BAR; PG8_WAIT_L(0); PG8_MMA(1, 0, At, B0); PG8_BAR; PG8_SCHED;
            PG8_STAGE(PG8_SB(1, 1), b3 + hstepB, voffB);
            PG8_WAIT_V(6); PG8_BAR; PG8_MMA(1, 1, At, B1); PG8_BAR;
            }
        }
        if constexpr (ALIGN_EPI) { if (wr == 0) PG8_BAR; }
        if constexpr (!Epi::AFTER_DRAIN) { E(acc, cur, wr, wc, fr, fq); S.done(cur); }
        if (!has_next) break;
#pragma unroll
        for (int a = 0; a < 2; ++a)
#pragma unroll
            for (int b = 0; b < 2; ++b)
#pragma unroll
                for (int m = 0; m < 4; ++m)
#pragma unroll
                    for (int n = 0; n < 2; ++n) acc[a][b][m][n] = (f32x4){0.f, 0.f, 0.f, 0.f};
        cur = nxt; cA = nA; cB = nB; ++ui;
        if constexpr (ALIGN_EPI) { if (wr == 1) PG8_BAR; }
    }
    PG8_WAIT_V(0);
    if constexpr (!ALIGN_EPI) { if (wr == 0) PG8_BAR; }
    PG8_BAR;
    if constexpr (Epi::AFTER_DRAIN) { E.fused(acc, cur, wr, wc, fr, fq, lds, wid, lane); S.done(cur); }
#undef PG8_SA
#undef PG8_SB
#undef PG8_STAGE
#undef PG8_LDA
#undef PG8_LDB
#undef PG8_MMA
#undef PG8_WAIT_V
#undef PG8_WAIT_L
#undef PG8_BAR
#undef PG8_SCHED
}
}

namespace pg8 {
constexpr float LOG2E = 1.4426950408889634f;
constexpr float QS_NSA = 0.125f * LOG2E;
constexpr float QS_MLA = 0.10206207261596575f * LOG2E;
__device__ __forceinline__ float fast_sigmoid(float x) { return __builtin_amdgcn_rcpf(1.0f + __builtin_amdgcn_exp2f(-LOG2E * x)); }
__device__ __forceinline__ float lo_bf(unsigned u) { return __uint_as_float(u << 16); }
__device__ __forceinline__ float hi_bf(unsigned u) { return __uint_as_float(u & 0xffff0000u); }
struct EpiInProjF {
    static constexpr bool PERM = true, AFTER_DRAIN = false;
    bf16_t* proj; unsigned char* gates;
    __device__ __forceinline__ void operator()(const f32x4 (&acc)[2][2][4][2], const Unit& u, int wr, int wc, int fr, int fq) const {
        const bool isg = u.pn >= 7;
        bf16_t* base = proj; const int ld = 1792; const int colt = isg ? (u.pn - 7) * BM : u.pn * BM;
        const float sc = (u.pn < 2) ? QS_NSA : 1.0f;
        const int row0 = u.pm * BM + wr * 64 + fr, col0 = colt + wc * 32 + 8 * fq;
#pragma unroll
        for (int ai = 0; ai < 2; ++ai)
#pragma unroll
            for (int m = 0; m < 4; ++m) { bf16_t* rowp = base + (size_t)(row0 + ai * HALF + m * 16) * ld + col0;
#pragma unroll
                for (int bj = 0; bj < 2; ++bj) { f32x4 v0 = acc[ai][bj][m][0], v1 = acc[ai][bj][m][1];
                    if (isg) {
                        unsigned q[8];
#pragma unroll
                        for (int e = 0; e < 4; ++e) { q[e] = (unsigned)(fast_sigmoid(v0[e]) * 255.0f + 0.5f); q[4 + e] = (unsigned)(fast_sigmoid(v1[e]) * 255.0f + 0.5f); }
                        uint2 w; w.x = q[0] | (q[1] << 8) | (q[2] << 16) | (q[3] << 24); w.y = q[4] | (q[5] << 8) | (q[6] << 16) | (q[7] << 24);
                        *(uint2*)(gates + (size_t)(row0 + ai * HALF + m * 16) * 2048 + col0 + bj * HALF) = w;
                    } else { v0 = v0 * sc; v1 = v1 * sc;
                        u32x4 w; w.x = cvt_pk_bf16(v0[0], v0[1]); w.y = cvt_pk_bf16(v0[2], v0[3]); w.z = cvt_pk_bf16(v1[0], v1[1]); w.w = cvt_pk_bf16(v1[2], v1[3]);
                        *(u32x4*)(rowp + bj * HALF) = w; } } }
    }
};
template <int PASS> struct EpiMergeF {
    static constexpr bool PERM = true, AFTER_DRAIN = false;
    const unsigned char* gates; bf16_t* merged;
    __device__ __forceinline__ void operator()(const f32x4 (&acc)[2][2][4][2], const Unit& u, int wr, int wc, int fr, int fq) const {
        const int row0 = u.pm * BM + wr * 64 + fr, col0 = u.pn * BM + wc * 32 + 8 * fq;
#pragma unroll
        for (int ai = 0; ai < 2; ++ai)
#pragma unroll
            for (int m = 0; m < 4; ++m) { const size_t r = (size_t)(row0 + ai * HALF + m * 16);
#pragma unroll
                for (int bj = 0; bj < 2; ++bj) { const int c = col0 + bj * HALF;
                    const uint2 g = *(const uint2*)(gates + r * 2048 + PASS * 1024 + c);
                    f32x4 v0 = acc[ai][bj][m][0] * (1.0f / 255.0f), v1 = acc[ai][bj][m][1] * (1.0f / 255.0f);
                    v0[0] *= (float)(g.x & 255u); v0[1] *= (float)((g.x >> 8) & 255u); v0[2] *= (float)((g.x >> 16) & 255u); v0[3] *= (float)(g.x >> 24);
                    v1[0] *= (float)(g.y & 255u); v1[1] *= (float)((g.y >> 8) & 255u); v1[2] *= (float)((g.y >> 16) & 255u); v1[3] *= (float)(g.y >> 24);
                    if (PASS == 1) { const u32x4 o = *(const u32x4*)(merged + r * 1024 + c);
                        v0[0] += lo_bf(o.x); v0[1] += hi_bf(o.x); v0[2] += lo_bf(o.y); v0[3] += hi_bf(o.y);
                        v1[0] += lo_bf(o.z); v1[1] += hi_bf(o.z); v1[2] += lo_bf(o.w); v1[3] += hi_bf(o.w); }
                    u32x4 w; w.x = cvt_pk_bf16(v0[0], v0[1]); w.y = cvt_pk_bf16(v0[2], v0[3]); w.z = cvt_pk_bf16(v1[0], v1[1]); w.w = cvt_pk_bf16(v1[2], v1[3]);
                    *(u32x4*)(merged + r * 1024 + c) = w; } }
    }
};
struct EpiCmpOutF {
    static constexpr bool PERM = true, AFTER_DRAIN = false;
    bf16_t* dst;
    __device__ __forceinline__ void operator()(const f32x4 (&acc)[2][2][4][2], const Unit& u, int wr, int wc, int fr, int fq) const {
        if (wc >= 2) return;
        const int row0 = u.pm * BM + wr * 64 + fr, col0 = wc * 32 + 8 * fq;
#pragma unroll
        for (int ai = 0; ai < 2; ++ai)
#pragma unroll
            for (int m = 0; m < 4; ++m) { const int r = row0 + ai * HALF + m * 16;
                if (r < BATCH * NC * 2) { const int g = r & 1, bc = r >> 1, b = bc / NC, c = bc % NC;
                    const f32x4 v0 = acc[ai][0][m][0], v1 = acc[ai][0][m][1];
                    u32x4 w; w.x = cvt_pk_bf16(v0[0], v0[1]); w.y = cvt_pk_bf16(v0[2], v0[3]); w.z = cvt_pk_bf16(v1[0], v1[1]); w.w = cvt_pk_bf16(v1[2], v1[3]);
                    *(u32x4*)(dst + ((size_t)(b * 2 + g) * 128 + c) * 64 + col0) = w; } }
    }
};
struct EpiSlabF {
    static constexpr bool PERM = false, AFTER_DRAIN = false;
    float* slab;
    __device__ __forceinline__ void operator()(const f32x4 (&acc)[2][2][4][2], const Unit& u, int wr, int wc, int fr, int fq) const {
        const int row0 = u.pm * BM + wr * 64 + fr, col0 = wc * 32 + 4 * fq;
        float* base = slab + (size_t)u.pn * 2048 * 256;
#pragma unroll
        for (int ai = 0; ai < 2; ++ai)
#pragma unroll
            for (int m = 0; m < 4; ++m) { float* rowp = base + (size_t)(row0 + ai * HALF + m * 16) * 256 + col0;
#pragma unroll
                for (int bj = 0; bj < 2; ++bj)
#pragma unroll
                    for (int n = 0; n < 2; ++n) *(f32x4*)(rowp + bj * HALF + n * 16) = acc[ai][bj][m][n]; }
    }
};
struct EpiResidF {
    static constexpr bool PERM = false, AFTER_DRAIN = false;
    const float* x; float* h;
    __device__ __forceinline__ void operator()(const f32x4 (&acc)[2][2][4][2], const Unit& u, int wr, int wc, int fr, int fq) const {
        const int row0 = u.pm * BM + wr * 64 + fr, col0 = u.pn * BM + wc * 32 + 4 * fq;
#pragma unroll
        for (int ai = 0; ai < 2; ++ai)
#pragma unroll
            for (int m = 0; m < 4; ++m) { const size_t off = (size_t)(row0 + ai * HALF + m * 16) * 1024 + col0;
#pragma unroll
                for (int bj = 0; bj < 2; ++bj)
#pragma unroll
                    for (int n = 0; n < 2; ++n) { const f32x4 xv = *(const f32x4*)(x + off + bj * HALF + n * 16); *(f32x4*)(h + off + bj * HALF + n * 16) = xv + acc[ai][bj][m][n]; } }
    }
};
struct EpiMlaQF {
    static constexpr bool PERM = false, AFTER_DRAIN = false;
    bf16_t* q; const float2* cs;
    __device__ __forceinline__ void operator()(const f32x4 (&acc)[2][2][4][2], const Unit& u, int wr, int wc, int fr, int fq) const {
        const int row0 = u.pm * BM + wr * 64 + fr;
#pragma unroll
        for (int bj = 0; bj < 2; ++bj) {
            const int X = u.pn * BM + bj * HALF + wc * 32;
            const bool rope = (X % 96) == 64;
#pragma unroll
            for (int ai = 0; ai < 2; ++ai)
#pragma unroll
                for (int m = 0; m < 4; ++m) { const int r = row0 + ai * HALF + m * 16; const int pos = r & (SEQ - 1);
                    f32x4 v0 = acc[ai][bj][m][0], v1 = acc[ai][bj][m][1];
                    if (rope) {
#pragma unroll
                        for (int j = 0; j < 4; ++j) { const float2 c = cs[pos * 16 + 4 * fq + j]; const float x1 = v0[j], x2 = v1[j]; v0[j] = x1 * c.x - x2 * c.y; v1[j] = x2 * c.x + x1 * c.y; } }
                    v0 = v0 * QS_MLA; v1 = v1 * QS_MLA;
                    bf16_t* p = q + (size_t)r * 768 + X + 4 * fq;
                    uint2 w0, w1; w0.x = cvt_pk_bf16(v0[0], v0[1]); w0.y = cvt_pk_bf16(v0[2], v0[3]); w1.x = cvt_pk_bf16(v1[0], v1[1]); w1.y = cvt_pk_bf16(v1[2], v1[3]);
                    *(uint2*)p = w0; *(uint2*)(p + 16) = w1; }
        }
    }
};
}

#define PG8_SP2 true
#define PG8_ALIGN true
constexpr int NTHR = 512, NWV = NTHR / 64;
#define WAVE_IDS const int lane = threadIdx.x & 63, wv = threadIdx.x >> 6; const int gw = blockIdx.x * NWV + wv, nw = gridDim.x * NWV; (void)lane; (void)gw; (void)nw;

template <bool Q8> DEV void ph_rms1024(const float* __restrict__ src, const float* __restrict__ g, bf16_t* __restrict__ dst, int rows, unsigned* __restrict__ q8 = nullptr, float* __restrict__ qs = nullptr, int gw_o = -1, int nw_o = 0, const bf16_t* __restrict__ add = nullptr) {
  const int lane = threadIdx.x & 63; const int gw = (gw_o >= 0) ? gw_o : (int)(blockIdx.x * NWV + (threadIdx.x >> 6)); const int nw = (gw_o >= 0) ? nw_o : (int)(gridDim.x * NWV);
  float4 gg[4];
#pragma unroll
  for (int j = 0; j < 4; ++j) gg[j] = ((const float4*)g)[j * 64 + lane];
  float4 nx[4]; uint2 na[4];
  if (gw < rows) {
#pragma unroll
    for (int j = 0; j < 4; ++j) { nx[j] = ((const float4*)(src + (size_t)gw * 1024))[j * 64 + lane]; if (add) na[j] = ((const uint2*)(add + (size_t)gw * 1024))[j * 64 + lane]; } }
  for (int r = gw; r < rows; r += nw) {
    float4 v[4]; float ss = 0.f;
#pragma unroll
    for (int j = 0; j < 4; ++j) { v[j] = nx[j];
      if (add) { v[j].x += __uint_as_float(na[j].x << 16); v[j].y += __uint_as_float(na[j].x & 0xffff0000u); v[j].z += __uint_as_float(na[j].y << 16); v[j].w += __uint_as_float(na[j].y & 0xffff0000u); }
      ss += v[j].x * v[j].x + v[j].y * v[j].y + v[j].z * v[j].z + v[j].w * v[j].w; }
    if (r + nw < rows) {
#pragma unroll
      for (int j = 0; j < 4; ++j) { nx[j] = ((const float4*)(src + (size_t)(r + nw) * 1024))[j * 64 + lane]; if (add) na[j] = ((const uint2*)(add + (size_t)(r + nw) * 1024))[j * 64 + lane]; } }
    ss = wsum(ss);
    const float inv = rsqrtf(ss * (1.0f / 1024.0f) + 1e-6f);
    float mx = 0.f;
#pragma unroll
    for (int j = 0; j < 4; ++j) {
      v[j].x *= inv * gg[j].x; v[j].y *= inv * gg[j].y; v[j].z *= inv * gg[j].z; v[j].w *= inv * gg[j].w;
      uint2 o;
      o.x = (unsigned)f2bf(v[j].x) | ((unsigned)f2bf(v[j].y) << 16);
      o.y = (unsigned)f2bf(v[j].z) | ((unsigned)f2bf(v[j].w) << 16);
      ((uint2*)(dst + (size_t)r * 1024))[j * 64 + lane] = o;
      if (Q8) mx = fmaxf(mx, fmaxf(fmaxf(fabsf(v[j].x), fabsf(v[j].y)), fmaxf(fabsf(v[j].z), fabsf(v[j].w))));
    }
    if (Q8) {
      mx = wmaxf(mx);
      const float sc = fmaxf(mx, 1e-30f) * (1.0f / 127.0f), isc = 1.0f / sc;
#pragma unroll
      for (int j = 0; j < 4; ++j) {
        const int q0 = (int)rintf(v[j].x * isc), q1 = (int)rintf(v[j].y * isc), q2 = (int)rintf(v[j].z * isc), q3 = (int)rintf(v[j].w * isc);
        q8[(size_t)r * 256 + j * 64 + lane] = (unsigned)(q0 & 255) | ((unsigned)(q1 & 255) << 8) | ((unsigned)(q2 & 255) << 16) | ((unsigned)(q3 & 255) << 24);
      }
      if (lane == 0) qs[r] = sc;
    }
  }
}
template <int PER> DEV void ph_rms_cols(const bf16_t* __restrict__ proj, int col0, const float* __restrict__ g, bf16_t* __restrict__ dst) {
  WAVE_IDS
  constexpr int W = 64 * PER;
  for (int r = gw; r < T; r += nw) {
    float v[PER]; float ss = 0.f;
#pragma unroll
    for (int j = 0; j < PER; ++j) { v[j] = bf2f(proj[(size_t)r * PROJ_LD + col0 + j * 64 + lane]); ss += v[j] * v[j]; }
    ss = wsum(ss);
    const float inv = rsqrtf(ss * (1.0f / W) + 1e-6f);
#pragma unroll
    for (int j = 0; j < PER; ++j) dst[(size_t)r * W + j * 64 + lane] = f2bf(v[j] * inv * g[j * 64 + lane]);
  }
}

DEV int win_src_col(int n) {
  if (n < 1280) return n;
  if (n < 1536) return 1304 + (n - 1280);
  if (n < 1664) return 1560 + (n - 1536);
  if (n < 1696) return 1688 + (n - 1664);
  if (n < 1720) return 1280 + (n - 1696);
  if (n < 1792) return -1;
  return 1720 + (n - 1792);
}
template <int MODE> DEV void tr_item(const float* __restrict__ W, int K, int Nsrc, bf16_t* __restrict__ WT, int Nblk, int Nvalid, __attribute__((address_space(3))) float* scr, int item, int lane) {
  const int kb = item / Nblk, nb = item % Nblk, k0 = 64 * kb, n0 = 32 * nb;
  const int n = n0 + (lane & 31);
  const int sc = (MODE == 1) ? win_src_col(n) : ((n < Nvalid) ? n : -1);
  float tv[32];
#pragma unroll
  for (int i = 0; i < 32; ++i) { const int kk = 2 * i + (lane >> 5); tv[i] = (sc >= 0) ? W[(size_t)(k0 + kk) * Nsrc + sc] : 0.f; }
#pragma unroll
  for (int i = 0; i < 32; ++i) { const int kk = 2 * i + (lane >> 5); scr[kk * 33 + (lane & 31)] = tv[i]; }
  asm volatile("s_waitcnt lgkmcnt(0)" ::: "memory");
  const int c = lane & 7;
#pragma unroll
  for (int j = 0; j < 4; ++j) { const int nn = (lane >> 3) + 8 * j; const __attribute__((address_space(3))) float* sp = scr + (8 * c) * 33 + nn;
    uint4 o;
    o.x = (unsigned)f2bf(sp[0 * 33]) | ((unsigned)f2bf(sp[1 * 33]) << 16); o.y = (unsigned)f2bf(sp[2 * 33]) | ((unsigned)f2bf(sp[3 * 33]) << 16);
    o.z = (unsigned)f2bf(sp[4 * 33]) | ((unsigned)f2bf(sp[5 * 33]) << 16); o.w = (unsigned)f2bf(sp[6 * 33]) | ((unsigned)f2bf(sp[7 * 33]) << 16);
    *(uint4*)(WT + (size_t)(n0 + nn) * K + k0 + 8 * c) = o; }
  asm volatile("s_waitcnt lgkmcnt(0)" ::: "memory");
}
DEV void ph_conv_plain(const float* __restrict__ src, bf16_t* __restrict__ dst, int n) {
  for (int i = blockIdx.x * NTHR + threadIdx.x; i < n; i += gridDim.x * NTHR) dst[i] = f2bf(src[i]);
}

DEV void gemm_tile(const bf16_t* __restrict__ A, int lda, const bf16_t* __restrict__ Bt, int ldb, int m0, int n0, int K, float (&acc)[4][4], char* lds) {
  float (*sA)[132] = (float (*)[132])lds;
  float (*sB)[68] = (float (*)[68])(lds + 32 * 132 * 4);
  const int tid = threadIdx.x, ty = tid >> 4, tx = tid & 15;
  const int lr = tid >> 2, lk = (tid & 3) * 8;
  for (int k0 = 0; k0 < K; k0 += 32) {
    {
      const uint4 va = *(const uint4*)(A + (size_t)(m0 + lr) * lda + k0 + lk);
      const unsigned ua[4] = {va.x, va.y, va.z, va.w};
#pragma unroll
      for (int j = 0; j < 4; ++j) { sA[lk + 2 * j][lr] = __uint_as_float(ua[j] << 16); sA[lk + 2 * j + 1][lr] = __uint_as_float(ua[j] & 0xffff0000u); }
    }
    if (tid < 256) {
      const uint4 vb = *(const uint4*)(Bt + (size_t)(n0 + lr) * ldb + k0 + lk);
      const unsigned ub[4] = {vb.x, vb.y, vb.z, vb.w};
#pragma unroll
      for (int j = 0; j < 4; ++j) { sB[lk + 2 * j][lr] = __uint_as_float(ub[j] << 16); sB[lk + 2 * j + 1][lr] = __uint_as_float(ub[j] & 0xffff0000u); }
    }
    __syncthreads();
#pragma unroll 8
    for (int k = 0; k < 32; ++k) {
      const float4 a = *(const float4*)&sA[k][ty * 4];
      const float4 b = *(const float4*)&sB[k][tx * 4];
      const float av[4] = {a.x, a.y, a.z, a.w}, bv[4] = {b.x, b.y, b.z, b.w};
#pragma unroll
      for (int i = 0; i < 4; ++i)
#pragma unroll
        for (int j = 0; j < 4; ++j) acc[i][j] += av[i] * bv[j];
    }
    __syncthreads();
  }
}
struct EpiInProj { bf16_t* proj; bf16_t* gates;
  DEV void operator()(int m, int n, float v) const { if (n < PROJ_LD) proj[(size_t)m * PROJ_LD + n] = f2bf(v); else gates[(size_t)m * 2048 + (n - PROJ_LD)] = f2bf(sigmoidf_(v)); } };
struct EpiStore { bf16_t* dst; int ld;
  DEV void operator()(int m, int n, float v) const { dst[(size_t)m * ld + n] = f2bf(v); } };
struct EpiGelu { bf16_t* dst; int ld;
  DEV void operator()(int m, int n, float v) const { dst[(size_t)m * ld + n] = f2bf(gelu_exact(v)); } };
struct EpiCmpOut { bf16_t* dst;
  DEV void operator()(int m, int n, float v) const { if (m >= BATCH * NC * 2) return; const int g = m & 1, bc = m >> 1, b = bc / NC, c = bc % NC; dst[((size_t)(b * 2 + g) * 128 + c) * 64 + n] = f2bf(v); } };
struct EpiResid { const float* x; float* h;
  DEV void operator()(int m, int n, float v) const { const size_t i = (size_t)m * 1024 + n; h[i] = x[i] + v; } };

template <class Epi> DEV void ph_gemm(const bf16_t* A, int lda, const bf16_t* Bt, int ldb, int M, int N, int K, const Epi& epi, char* lds) {
  const int ntn = N / 64, ntm = M / 128;
  const int ty = threadIdx.x >> 4, tx = threadIdx.x & 15;
  for (int tile = blockIdx.x; tile < ntn * ntm; tile += gridDim.x) {
    const int m0 = (tile / ntn) * 128, n0 = (tile % ntn) * 64;
    float acc[4][4];
#pragma unroll
    for (int i = 0; i < 4; ++i)
#pragma unroll
      for (int j = 0; j < 4; ++j) acc[i][j] = 0.f;
    gemm_tile(A, lda, Bt, ldb, m0, n0, K, acc, lds);
#pragma unroll
    for (int i = 0; i < 4; ++i)
#pragma unroll
      for (int j = 0; j < 4; ++j) epi(m0 + ty * 4 + i, n0 + tx * 4 + j, acc[i][j]);
  }
}
DEV void ph_merge(const bf16_t* onsa, const bf16_t* omla, const bf16_t* wbn, const bf16_t* wbm, const bf16_t* gates, bf16_t* merged, char* lds) {
  const int ntn = 1024 / 64, ntm = T / 128;
  const int ty = threadIdx.x >> 4, tx = threadIdx.x & 15;
  for (int tile = blockIdx.x; tile < ntn * ntm; tile += gridDim.x) {
    const int m0 = (tile / ntn) * 128, n0 = (tile % ntn) * 64;
    float a1[4][4], a2[4][4];
#pragma unroll
    for (int i = 0; i < 4; ++i)
#pragma unroll
      for (int j = 0; j < 4; ++j) { a1[i][j] = 0.f; a2[i][j] = 0.f; }
    gemm_tile(onsa, 512, wbn, 512, m0, n0, 512, a1, lds);
    gemm_tile(omla, 512, wbm, 512, m0, n0, 512, a2, lds);
#pragma unroll
    for (int i = 0; i < 4; ++i)
#pragma unroll
      for (int j = 0; j < 4; ++j) {
        const int m = m0 + ty * 4 + i, n = n0 + tx * 4 + j;
        merged[(size_t)m * 1024 + n] = f2bf(bf2f(gates[(size_t)m * 2048 + n]) * a1[i][j] + bf2f(gates[(size_t)m * 2048 + 1024 + n]) * a2[i][j]);
      }
  }
}

DEV void rope_entry(float2* __restrict__ cs, int i) {
  const int j = i & 15, pos = i >> 4;
  const float inv_freq = __builtin_amdgcn_exp2f(-(float)(2 * j) * (13.287712379549449f / 32.0f));
  const float rev = (float)pos * inv_freq * 0.15915494309189535f;
  const float fr = rev - floorf(rev);
  cs[i] = make_float2(__builtin_amdgcn_cosf(fr), __builtin_amdgcn_sinf(fr));
}
DEV void ph_rope_table(float2* __restrict__ cs) {
  const int n = SEQ * 16;
  for (int i = blockIdx.x * NTHR + threadIdx.x; i < n; i += gridDim.x * NTHR) {
    const int j = i & 15, pos = i >> 4;
    const float inv_freq = __builtin_amdgcn_exp2f(-(float)(2 * j) * (13.287712379549449f / 32.0f));
    const float rev = (float)pos * inv_freq * 0.15915494309189535f;
    const float fr = rev - floorf(rev);
    cs[i] = make_float2(__builtin_amdgcn_cosf(fr), __builtin_amdgcn_sinf(fr));
  }
}
DEV void ph_rope_k(const bf16_t* __restrict__ proj, bf16_t* __restrict__ kr) {
  const int n = T * 16;
  for (int i = blockIdx.x * NTHR + threadIdx.x; i < n; i += gridDim.x * NTHR) {
    const int j = i & 15, t = i >> 4;
    const float pos = (float)(t & (SEQ - 1));
    const float inv_freq = powf(10000.0f, -(float)(2 * j) / 32.0f);
    const float ang = pos * inv_freq, c = cosf(ang), s = sinf(ang);
    const float x1 = bf2f(proj[(size_t)t * PROJ_LD + PC_KR + j]), x2 = bf2f(proj[(size_t)t * PROJ_LD + PC_KR + 16 + j]);
    kr[(size_t)t * 32 + j] = f2bf(x1 * c - x2 * s); kr[(size_t)t * 32 + 16 + j] = f2bf(x2 * c + x1 * s);
  }
}
DEV void ph_cmp_gather(const bf16_t* __restrict__ proj, const float* __restrict__ pos, int which, bf16_t* __restrict__ ca) {
  const int n = 2048 * 2048;
  for (int i = blockIdx.x * NTHR + threadIdx.x; i < n; i += gridDim.x * NTHR) {
    const int e = i & 2047, row = i >> 11;
    float v = 0.f;
    if (row < BATCH * NC * 2) {
      const int g = row & 1, bc = row >> 1, b = bc / NC, c = bc % NC, l = e >> 6, d = e & 63;
      v = bf2f(proj[(size_t)(b * SEQ + 16 * c + l) * PROJ_LD + PC_KV + which * 128 + g * 64 + d]) + pos[e];
    }
    ca[i] = f2bf(v);
  }
}

DEV void ph_cmp_attn(const bf16_t* __restrict__ proj, const bf16_t* __restrict__ kc, const bf16_t* __restrict__ vc,
                     const float* __restrict__ t5, bf16_t* __restrict__ ocmp, unsigned* __restrict__ sel, char* lds) {
  WAVE_IDS
  float* P = (float*)(lds + wv * 1024); float* Q = P + 128;
  for (int item = gw; item < BATCH * 2 * SEQ; item += nw) {
    const int t = item & (SEQ - 1), bg = item >> 11, g = bg & 1, b = bg >> 1;
    const size_t tok = (size_t)b * SEQ + t;
    const int nvalid = (t >= 31) ? min(NC, (t - 31) / 16 + 1) : 0;
    const bf16_t* kcb = kc + (size_t)bg * 128 * 64;
    const bf16_t* vcb = vc + (size_t)bg * 128 * 64;
    float impacc = 0.f;
    for (int r = 0; r < 4; ++r) {
      const int head = g * 4 + r;
      Q[lane] = bf2f(proj[tok * PROJ_LD + PC_Q + head * 64 + lane]);
      wave_lds_sync();
      float lg[2];
#pragma unroll
      for (int u = 0; u < 2; ++u) {
        const int c = lane + 64 * u;
        float d = 0.f;
        if (c < nvalid) { const bf16_t* kr = kcb + c * 64; for (int e = 0; e < 64; ++e) d += Q[e] * bf2f(kr[e]); }
        lg[u] = (c < nvalid) ? d + 1.4426950408889634f * t5bias(t5, head, t - (16 * c + 31)) : -1e30f;
      }
      const float m = wmaxf(fmaxf(lg[0], lg[1]));
      const float e0 = (lane < nvalid) ? exp2f(lg[0] - m) : 0.f, e1 = (lane + 64 < nvalid) ? exp2f(lg[1] - m) : 0.f;
      const float s = wsum(e0 + e1);
      const float inv = (nvalid > 0) ? 1.0f / fmaxf(s, 1e-30f) : 0.f;
      P[lane] = e0 * inv; P[lane + 64] = e1 * inv;
      wave_lds_sync();
      float o = 0.f;
      for (int c = 0; c < nvalid; ++c) o += P[c] * bf2f(vcb[c * 64 + lane]);
      ocmp[tok * 512 + head * 64 + lane] = f2bf(o);
      if (lane < 32) { for (int c = 4 * lane - 1; c <= 4 * lane + 3; ++c) if (c >= 0 && c < NC) impacc += P[c]; }
      wave_lds_sync();
    }
    const int cur = t >> 6, n = lane;
    float score = (n > cur) ? -1.0f : ((n == 0 || n == cur || n == cur - 1) ? 1e4f : impacc);
    if (n >= 32) score = -2.0f;
    int rank = 0;
    for (int mth = 0; mth < 32; ++mth) { const float sm = __shfl(score, mth); rank += (sm > score || (sm == score && mth < n)) ? 1 : 0; }
    const unsigned long long bal = __ballot(n < 32 && rank < 16);
    if (lane == 0) sel[item] = (unsigned)bal;
  }
}

DEV void ph_nsa_attn(const bf16_t* __restrict__ proj, const float* __restrict__ t5, const bf16_t* __restrict__ ocmp,
                     const unsigned* __restrict__ sel, bf16_t* __restrict__ onsa, char* lds) {
  WAVE_IDS
  float* P = (float*)(lds + wv * 1024); float* Q = P + 128;
  for (int item = gw; item < BATCH * 2 * SEQ * 4; item += nw) {
    const int r = item & 3, t = (item >> 2) & (SEQ - 1), bg = item >> 13, g = bg & 1, b = bg >> 1;
    const int head = g * 4 + r, cur = t >> 6;
    const size_t tok = (size_t)b * SEQ + t;
    Q[lane] = bf2f(proj[tok * PROJ_LD + PC_Q + head * 64 + lane]);
    wave_lds_sync();
    const unsigned smask = sel[bg * SEQ + t];
    float res0 = 0.f, res1 = 0.f;
    for (int br = 0; br < 2; ++br) {
      float m = -1e30f, l = 0.f, o = 0.f;
      const int nb0 = (br == 0) ? 0 : max(0, cur - 8);
      for (int nb = nb0; nb <= cur; ++nb) {
        if (br == 0 && !((smask >> nb) & 1u)) continue;
        const int s = nb * 64 + lane, dist = t - s;
        const bool valid = (dist >= 0) && (br == 0 || dist < 512);
        const bf16_t* kp = proj + ((size_t)b * SEQ + s) * PROJ_LD + PC_KV + (2 + 2 * br) * 128 + g * 64;
        float d = 0.f;
        for (int e = 0; e < 64; e += 8) {
          const uint4 kv = *(const uint4*)(kp + e);
          d += Q[e + 0] * __uint_as_float(kv.x << 16) + Q[e + 1] * __uint_as_float(kv.x & 0xffff0000u);
          d += Q[e + 2] * __uint_as_float(kv.y << 16) + Q[e + 3] * __uint_as_float(kv.y & 0xffff0000u);
          d += Q[e + 4] * __uint_as_float(kv.z << 16) + Q[e + 5] * __uint_as_float(kv.z & 0xffff0000u);
          d += Q[e + 6] * __uint_as_float(kv.w << 16) + Q[e + 7] * __uint_as_float(kv.w & 0xffff0000u);
        }
        const float lg = valid ? d + 1.4426950408889634f * t5bias(t5, head, dist) : -1e30f;
        const float mn = fmaxf(m, wmaxf(lg));
        const float sc = exp2f(m - mn);
        const float pe = valid ? exp2f(lg - mn) : 0.f;
        l = l * sc + wsum(pe); m = mn;
        P[lane] = pe;
        wave_lds_sync();
        const bf16_t* vp = proj + ((size_t)b * SEQ + nb * 64) * PROJ_LD + PC_KV + (3 + 2 * br) * 128 + g * 64 + lane;
        float acc = 0.f;
        for (int k = 0; k < 64; ++k) acc += P[k] * bf2f(vp[(size_t)k * PROJ_LD]);
        o = o * sc + acc;
        wave_lds_sync();
      }
      if (br == 0) res0 = o / fmaxf(l, 1e-30f); else res1 = o / fmaxf(l, 1e-30f);
    }
    const bf16_t* gp = proj + tok * PROJ_LD + PC_GATE + head * 3;
    const float g0 = sigmoidf_(bf2f(gp[0])), g1 = sigmoidf_(bf2f(gp[1])), g2 = sigmoidf_(bf2f(gp[2]));
    const float oc = bf2f(ocmp[tok * 512 + head * 64 + lane]);
    onsa[tok * 512 + head * 64 + lane] = f2bf(g0 * oc + g1 * res0 + g2 * res1);
    wave_lds_sync();
  }
}

DEV void ph_mla_attn(const bf16_t* __restrict__ mq, const bf16_t* __restrict__ mkv, const bf16_t* __restrict__ kr, bf16_t* __restrict__ omla, char* lds) {
  WAVE_IDS
  float* P = (float*)(lds + wv * 1024); float* Q = P + 128;
  for (int item = gw; item < BATCH * 8 * SEQ; item += nw) {
    const int h = item & 7, t = (item >> 3) & (SEQ - 1), b = item >> 14;
    const size_t tok = (size_t)b * SEQ + t;
    Q[lane] = bf2f(mq[tok * 768 + h * 96 + lane]);
    if (lane < 32) Q[64 + lane] = bf2f(mq[tok * 768 + h * 96 + 64 + lane]);
    wave_lds_sync();
    float m = -1e30f, l = 0.f, o = 0.f;
    for (int nb = 0; nb <= (t >> 6); ++nb) {
      const int s = nb * 64 + lane;
      const bool valid = s <= t;
      const bf16_t* kp = mkv + ((size_t)b * SEQ + s) * 1024 + h * 128;
      const bf16_t* rp = kr + ((size_t)b * SEQ + s) * 32;
      float d = 0.f;
      for (int e = 0; e < 64; e += 8) {
        const uint4 kv = *(const uint4*)(kp + e);
        d += Q[e + 0] * __uint_as_float(kv.x << 16) + Q[e + 1] * __uint_as_float(kv.x & 0xffff0000u);
        d += Q[e + 2] * __uint_as_float(kv.y << 16) + Q[e + 3] * __uint_as_float(kv.y & 0xffff0000u);
        d += Q[e + 4] * __uint_as_float(kv.z << 16) + Q[e + 5] * __uint_as_float(kv.z & 0xffff0000u);
        d += Q[e + 6] * __uint_as_float(kv.w << 16) + Q[e + 7] * __uint_as_float(kv.w & 0xffff0000u);
      }
      for (int e = 0; e < 32; e += 8) {
        const uint4 kv = *(const uint4*)(rp + e);
        d += Q[64 + e + 0] * __uint_as_float(kv.x << 16) + Q[64 + e + 1] * __uint_as_float(kv.x & 0xffff0000u);
        d += Q[64 + e + 2] * __uint_as_float(kv.y << 16) + Q[64 + e + 3] * __uint_as_float(kv.y & 0xffff0000u);
        d += Q[64 + e + 4] * __uint_as_float(kv.z << 16) + Q[64 + e + 5] * __uint_as_float(kv.z & 0xffff0000u);
        d += Q[64 + e + 6] * __uint_as_float(kv.w << 16) + Q[64 + e + 7] * __uint_as_float(kv.w & 0xffff0000u);
      }
      const float lg = valid ? d : -1e30f;
      const float mn = fmaxf(m, wmaxf(lg));
      const float sc = exp2f(m - mn);
      const float pe = valid ? exp2f(lg - mn) : 0.f;
      l = l * sc + wsum(pe); m = mn;
      P[lane] = pe;
      wave_lds_sync();
      const bf16_t* vp = mkv + ((size_t)b * SEQ + nb * 64) * 1024 + h * 128 + 64 + lane;
      float acc = 0.f;
      for (int k = 0; k < 64; ++k) acc += P[k] * bf2f(vp[(size_t)k * 1024]);
      o = o * sc + acc;
      wave_lds_sync();
    }
    omla[tok * 512 + h * 64 + lane] = f2bf(o / fmaxf(l, 1e-30f));
    wave_lds_sync();
  }
}

DEV void wave_argmax(float& v, int& idx) {
#pragma unroll
  for (int o = 32; o > 0; o >>= 1) {
    const float ov = __shfl_xor(v, o); const int oi = __shfl_xor(idx, o);
    if (ov > v || (ov == v && oi < idx)) { v = ov; idx = oi; }
  }
}
DEV void ph_route(const bf16_t* __restrict__ pq, const bf16_t* __restrict__ subk, int* __restrict__ pidx, float* __restrict__ pw, char* lds) {
  WAVE_IDS
  float* Q = (float*)(lds + wv * 1024);
  float* TS = Q + 128;
  int* TI = (int*)(TS + 32);
  for (int item = gw; item < T * 8; item += nw) {
    const int h = item & 7, t = item >> 3;
    Q[lane] = bf2f(pq[(size_t)t * 1024 + h * 128 + lane]);
    Q[lane + 64] = bf2f(pq[(size_t)t * 1024 + h * 128 + 64 + lane]);
    wave_lds_sync();
    for (int p = 0; p < 2; ++p) {
      const bf16_t* kb = subk + (size_t)((h * 2 + p) * 128) * 64;
      float s0 = 0.f, s1 = 0.f;
      for (int e = 0; e < 64; ++e) { const float qv = Q[p * 64 + e]; s0 += qv * bf2f(kb[lane * 64 + e]); s1 += qv * bf2f(kb[(lane + 64) * 64 + e]); }
      for (int k = 0; k < 16; ++k) {
        float v = (s0 >= s1) ? s0 : s1; int idx = (s0 >= s1) ? lane : lane + 64;
        wave_argmax(v, idx);
        if (lane == 0) { TS[p * 16 + k] = v; TI[p * 16 + k] = idx; }
        if (idx == lane) s0 = -3e38f;
        if (idx == lane + 64) s1 = -3e38f;
      }
    }
    wave_lds_sync();
    float cv[4];
#pragma unroll
    for (int u = 0; u < 4; ++u) { const int f = lane + 64 * u; cv[u] = TS[f >> 4] + TS[16 + (f & 15)]; }
    int myexp = 0; float mybest = 0.f, best0 = 0.f, den = 0.f;
#pragma unroll
    for (int k = 0; k < 16; ++k) {
      float v = cv[0]; int idx = lane;
#pragma unroll
      for (int u = 1; u < 4; ++u) if (cv[u] > v) { v = cv[u]; idx = lane + 64 * u; }
      wave_argmax(v, idx);
#pragma unroll
      for (int u = 0; u < 4; ++u) if (idx == lane + 64 * u) cv[u] = -3e38f;
      if (k == 0) best0 = v;
      den += expf(v - best0);
      if (lane == k) { myexp = TI[idx >> 4] * 128 + TI[16 + (idx & 15)]; mybest = v; }
    }
    if (lane < 16) { pidx[(size_t)t * 128 + h * 16 + lane] = myexp; pw[(size_t)t * 128 + h * 16 + lane] = expf(mybest - best0) / den; }
    wave_lds_sync();
  }
}

DEV void ph_experts(const bf16_t* __restrict__ hn, const int* __restrict__ pidx, const float* __restrict__ pw,
                    const float* __restrict__ pu, const float* __restrict__ pv, const float* __restrict__ gfin, float* __restrict__ out) {
  WAVE_IDS
  for (int t = gw; t < T; t += nw) {
    float4 x[4], y[4];
#pragma unroll
    for (int j = 0; j < 4; ++j) {
      const uint2 r = ((const uint2*)(hn + (size_t)t * 1024))[j * 64 + lane];
      x[j] = make_float4(__uint_as_float(r.x << 16), __uint_as_float(r.x & 0xffff0000u), __uint_as_float(r.y << 16), __uint_as_float(r.y & 0xffff0000u));
      y[j] = make_float4(0.f, 0.f, 0.f, 0.f);
    }
    const int e0 = pidx[(size_t)t * 128 + lane], e1 = pidx[(size_t)t * 128 + 64 + lane];
    const float w0 = pw[(size_t)t * 128 + lane], w1 = pw[(size_t)t * 128 + 64 + lane];
    for (int s = 0; s < 128; ++s) {
      const int e = __shfl((s < 64) ? e0 : e1, s & 63);
      const float w = __shfl((s < 64) ? w0 : w1, s & 63);
      const float4* ur = (const float4*)(pu + (size_t)e * 1024);
      float d = 0.f;
#pragma unroll
      for (int j = 0; j < 4; ++j) { const float4 u = ur[j * 64 + lane]; d += u.x * x[j].x + u.y * x[j].y + u.z * x[j].z + u.w * x[j].w; }
      d = wsum(d);
      const float c = w * gelu_exact(d);
      const float4* vr = (const float4*)(pv + (size_t)e * 1024);
#pragma unroll
      for (int j = 0; j < 4; ++j) { const float4 v = vr[j * 64 + lane]; y[j].x += c * v.x; y[j].y += c * v.y; y[j].z += c * v.z; y[j].w += c * v.w; }
    }
    float4* o4 = (float4*)(out + (size_t)t * 1024);
    float ss = 0.f;
#pragma unroll
    for (int j = 0; j < 4; ++j) {
      const float4 hv = o4[j * 64 + lane];
      y[j].x += hv.x; y[j].y += hv.y; y[j].z += hv.z; y[j].w += hv.w;
      ss += y[j].x * y[j].x + y[j].y * y[j].y + y[j].z * y[j].z + y[j].w * y[j].w;
    }
    ss = wsum(ss);
    const float inv = rsqrtf(ss * (1.0f / 1024.0f) + 1e-6f);
#pragma unroll
    for (int j = 0; j < 4; ++j) {
      const float4 gg = ((const float4*)gfin)[j * 64 + lane];
      o4[j * 64 + lane] = make_float4(y[j].x * inv * gg.x, y[j].y * inv * gg.y, y[j].z * inv * gg.z, y[j].w * inv * gg.w);
    }
  }
}


namespace att {
#define LAS3 __attribute__((address_space(3)))
typedef LAS3 char* lptr;
typedef LAS3 const char* lcptr;
using bf16x8 = __attribute__((ext_vector_type(8))) short;
using s16x4 = __attribute__((ext_vector_type(4))) short;
using f32x16 = __attribute__((ext_vector_type(16))) float;
typedef short v4i16_t __attribute__((ext_vector_type(4)));
typedef unsigned u32x4 __attribute__((ext_vector_type(4)));
typedef float f32x4_t __attribute__((ext_vector_type(4)));
typedef float f32x2_t __attribute__((ext_vector_type(2)));
typedef __bf16 bf16x2_t __attribute__((ext_vector_type(2)));
constexpr float LOG2E = 1.4426950408889634f;
constexpr float THR = 8.0f;
constexpr float NEG_INF = -__builtin_huge_valf();
constexpr int SLOT = 20480, KOFF = 0, VOFF = 12288;
constexpr int L_WSF = 2 * SLOT;
constexpr int L_TB = L_WSF + 2048;
constexpr int L_ST = L_TB + 8 * 320 * 4;
constexpr int L_SELM = L_ST + 768;
constexpr int L_SC = L_SELM + 256;
constexpr int L_IMPQ = L_SC + 64 * 33 * 4;
constexpr int L_IMPL = L_IMPQ + 4 * 64 * 33 * 4;
constexpr int L_FIN = L_IMPQ;
constexpr int L_END = L_IMPL + 4 * 64 * 33 * 4;
static_assert(L_END <= 131072, "attention LDS map");

__device__ __forceinline__ int crow(int r, int hi) { return (r & 3) + 8 * (r >> 2) + 4 * hi; }
__device__ __forceinline__ s16x4 vtr(lcptr p) { return __builtin_bit_cast(s16x4, __builtin_amdgcn_ds_read_tr16_b64_v4i16((LAS3 v4i16_t*)p)); }
__device__ __forceinline__ unsigned cvtpk(float lo, float hi) { f32x2_t v = {lo, hi}; bf16x2_t b = __builtin_convertvector(v, bf16x2_t); return __builtin_bit_cast(unsigned, b); }
__device__ __forceinline__ float xmax(float v) { auto rr = __builtin_amdgcn_permlane32_swap(__float_as_uint(v), __float_as_uint(v), false, false); return fmaxf(__uint_as_float(rr[0]), __uint_as_float(rr[1])); }
__device__ __forceinline__ float xsum(float v) { auto rr = __builtin_amdgcn_permlane32_swap(__float_as_uint(v), __float_as_uint(v), false, false); return __uint_as_float(rr[0]) + __uint_as_float(rr[1]); }
__device__ __forceinline__ float ex2(float x) { return __builtin_amdgcn_exp2f(x); }

template <int ND0> __device__ __forceinline__ void qkt(f32x16& p0, f32x16& p1, lcptr kb, const bf16x8* qr) {
  p0 = f32x16{}; p1 = f32x16{};
  __builtin_amdgcn_s_setprio(1);
#pragma unroll
  for (int d0 = 0; d0 < ND0; ++d0) {
    const bf16x8 b0 = *(const LAS3 bf16x8*)(kb + d0 * 2048);
    const bf16x8 b1 = *(const LAS3 bf16x8*)(kb + d0 * 2048 + 512);
    p0 = __builtin_amdgcn_mfma_f32_32x32x16_bf16(b0, qr[d0], p0, 0, 0, 0);
    p1 = __builtin_amdgcn_mfma_f32_32x32x16_bf16(b1, qr[d0], p1, 0, 0, 0);
  }
  __builtin_amdgcn_s_setprio(0);
}
template <int ND0> __device__ __forceinline__ void qkt_init(f32x16& p0, f32x16& p1, lcptr kb, const bf16x8* qr, const f32x16& c0, const f32x16& c1) {
  p0 = c0; p1 = c1;
  __builtin_amdgcn_s_setprio(1);
#pragma unroll
  for (int d0 = 0; d0 < ND0; ++d0) {
    const bf16x8 b0 = *(const LAS3 bf16x8*)(kb + d0 * 2048);
    const bf16x8 b1 = *(const LAS3 bf16x8*)(kb + d0 * 2048 + 512);
    p0 = __builtin_amdgcn_mfma_f32_32x32x16_bf16(b0, qr[d0], p0, 0, 0, 0);
    p1 = __builtin_amdgcn_mfma_f32_32x32x16_bf16(b1, qr[d0], p1, 0, 0, 0);
  }
  __builtin_amdgcn_s_setprio(0);
}
__device__ __forceinline__ void pv(f32x16 (&o)[2], lcptr vp, const unsigned (&pw)[16]) {
  __builtin_amdgcn_s_setprio(1);
#pragma unroll
  for (int d0 = 0; d0 < 2; ++d0)
#pragma unroll
    for (int ks = 0; ks < 4; ++ks) {
      const s16x4 lo = vtr(vp + d0 * 4096 + ks * 1024), hi4 = vtr(vp + d0 * 4096 + ks * 1024 + 512);
      const bf16x8 vf = {lo[0], lo[1], lo[2], lo[3], hi4[0], hi4[1], hi4[2], hi4[3]};
      const unsigned pa4[4] = {pw[4 * ks], pw[4 * ks + 1], pw[4 * ks + 2], pw[4 * ks + 3]};
      o[d0] = __builtin_amdgcn_mfma_f32_32x32x16_bf16(__builtin_bit_cast(bf16x8, pa4), vf, o[d0], 0, 0, 0);
    }
  __builtin_amdgcn_s_setprio(0);
}
__device__ __forceinline__ void softmax_step(f32x16& p0, f32x16& p1, float& m, float& l, f32x16 (&o)[2], LAS3 float* wsf, int r32, int hi, unsigned (&pw)[16]) {
  float rm = fmaxf(p0[0], p1[0]);
#pragma unroll
  for (int r = 1; r < 16; ++r) rm = fmaxf(rm, fmaxf(p0[r], p1[r]));
  rm = xmax(rm);
  if (__any(rm > m + THR)) {
    const float mn = fmaxf(m, rm);
    const float al = ex2(m - mn);
    m = mn; l *= al;
    if (hi == 0) wsf[r32] = al;
#pragma unroll
    for (int r = 0; r < 16; ++r) { const float f = wsf[crow(r, hi)]; o[0][r] *= f; o[1][r] *= f; }
  }
  float s = 0.f;
#pragma unroll
  for (int r = 0; r < 16; ++r) { p0[r] = ex2(p0[r] - m); p1[r] = ex2(p1[r] - m); s += p0[r] + p1[r]; }
  l += s;
#pragma unroll
  for (int i = 0; i < 8; ++i) { pw[i] = cvtpk(p0[2 * i], p0[2 * i + 1]); pw[8 + i] = cvtpk(p1[2 * i], p1[2 * i + 1]); }
}
struct KVSrc { const bf16_t* k; const bf16_t* v; int ldk, ldv; };
__device__ __forceinline__ void kv_issue(const KVSrc& s, int row0, u32x4& rk, u32x4& rv, int tid) {
  const int kv = tid & 63, ch = tid >> 6, ln = tid & 63;
  rk = *(const u32x4*)(s.k + (size_t)(row0 + kv) * s.ldk + ch * 8);
  rv = *(const u32x4*)(s.v + (size_t)(row0 + 16 * (ch & 3) + (ln >> 2)) * s.ldv + (ch >> 2) * 32 + (ln & 3) * 8);
}
__device__ __forceinline__ void kv_commit(lptr slot, const u32x4& rk, const u32x4& rv, int tid) {
  *(LAS3 u32x4*)(slot + KOFF + (tid >> 6) * 1024 + (tid & 63) * 16) = rk;
  *(LAS3 u32x4*)(slot + VOFF + tid * 16) = rv;
}
__device__ __forceinline__ void fin_set(LAS3 float* finl, const f32x16 (&o)[2], int lane) {
#pragma unroll
  for (int d0 = 0; d0 < 2; ++d0)
#pragma unroll
    for (int r = 0; r < 16; ++r) finl[(d0 * 16 + r) * 64 + lane] = o[d0][r];
}
__device__ __forceinline__ void fin_add(LAS3 float* finl, const f32x16 (&o)[2], const LAS3 float* wsf, int lane, int hi) {
#pragma unroll
  for (int r = 0; r < 16; ++r) { const float f = wsf[crow(r, hi)];
#pragma unroll
    for (int d0 = 0; d0 < 2; ++d0) finl[(d0 * 16 + r) * 64 + lane] += o[d0][r] * f; }
}
__device__ __forceinline__ void fin_store(const LAS3 float* finl, bf16_t* gout, size_t rowbase, int ld, int colbase, int lane) {
#pragma unroll
  for (int i = 0; i < 4; ++i) {
    const int q = i * 8 + (lane >> 3), ch = lane & 7;
    const int qh = (q >> 2) & 1, r = (q & 3) + 4 * (q >> 3), d0 = ch >> 2, dl = (ch & 3) * 8;
    const LAS3 float* p = finl + (d0 * 16 + r) * 64 + qh * 32 + dl;
    const f32x4_t x0 = *(const LAS3 f32x4_t*)p, x1 = *(const LAS3 f32x4_t*)(p + 4);
    u32x4 v; v.x = cvtpk(x0[0], x0[1]); v.y = cvtpk(x0[2], x0[3]); v.z = cvtpk(x1[0], x1[1]); v.w = cvtpk(x1[2], x1[3]);
    *(u32x4*)(gout + (rowbase + q) * (size_t)ld + colbase + ch * 8) = v;
  }
}

__device__ __forceinline__ void nsa_unit(int b, int g, int c, const bf16_t* __restrict__ proj, const bf16_t* __restrict__ kc, const bf16_t* __restrict__ vc, bf16_t* __restrict__ onsa, lptr lds) {
  int tid = threadIdx.x; asm volatile("" : "+v"(tid));
  const int lane = tid & 63, r32 = lane & 31, hi = lane >> 5;
  const int w = __builtin_amdgcn_readfirstlane(tid >> 6);
  const int rh = w >> 1, head = g * 4 + rh, tokl = 32 * (w & 1) + r32, t = 64 * c + tokl, bg = b * 2 + g;
  const size_t tok = (size_t)b * SEQ + t;
  LAS3 float* wsf = (LAS3 float*)(lds + L_WSF) + w * 64;
  const LAS3 float* tb = (const LAS3 float*)(lds + L_TB) + head * 320 + 64;
  const LAS3 float* stp = (const LAS3 float*)(lds + L_ST);
  LAS3 unsigned* selm = (LAS3 unsigned*)(lds + L_SELM);
  LAS3 float* sc = (LAS3 float*)(lds + L_SC);
  LAS3 float* impq = (LAS3 float*)(lds + L_IMPQ);
  LAS3 float* impl = (LAS3 float*)(lds + L_IMPL);
  const lcptr kb0 = (lcptr)lds + KOFF + hi * 1024 + r32 * 16;
  const lcptr vp0 = (lcptr)lds + VOFF + ((lane >> 4) & 1) * 32 + (lane & 3) * 8 + (4 * hi + ((lane & 15) >> 2)) * 64;
  bf16x8 qr[4];
#pragma unroll
  for (int d0 = 0; d0 < 4; ++d0) qr[d0] = *(const bf16x8*)(proj + tok * PROJ_LD + PC_Q + head * 64 + d0 * 16 + hi * 8);
  float gate[3];
#pragma unroll
  for (int j = 0; j < 3; ++j) gate[j] = 1.0f / (1.0f + ex2(-LOG2E * bf2f(proj[tok * PROJ_LD + PC_GATE + head * 3 + j])));
  LAS3 float* finl = (LAS3 float*)(lds + L_FIN) + w * 2048;
  f32x16 o[2]; unsigned pw[16];
  u32x4 rk, rv;
  {
    const KVSrc src{kc + (size_t)bg * 128 * 64, vc + (size_t)bg * 128 * 64, 64, 64};
    __syncthreads();
    kv_issue(src, 0, rk, rv, tid); kv_commit(lds, rk, rv, tid);
    kv_issue(src, 64, rk, rv, tid); kv_commit(lds + SLOT, rk, rv, tid);
    __syncthreads();
    f32x16 a0, a1, b0, b1;
    qkt<4>(a0, a1, kb0, qr); qkt<4>(b0, b1, kb0 + SLOT, qr);
    float rm = NEG_INF;
#pragma unroll
    for (int r = 0; r < 16; ++r) {
      const int cb = crow(r, hi);
      { const int d = t - 16 * cb - 31;          a0[r] = (d < 0) ? NEG_INF : a0[r] + ((d < 113) ? tb[d] : 0.f); }
      { const int d = t - 16 * (cb + 32) - 31;   a1[r] = (d < 0) ? NEG_INF : a1[r] + ((d < 113) ? tb[d] : 0.f); }
      { const int d = t - 16 * (cb + 64) - 31;   b0[r] = (d < 0) ? NEG_INF : b0[r] + ((d < 113) ? tb[d] : 0.f); }
      { const int d = t - 16 * (cb + 96) - 31;   b1[r] = (d < 0) ? NEG_INF : b1[r] + ((d < 113) ? tb[d] : 0.f); }
      rm = fmaxf(fmaxf(rm, fmaxf(a0[r], a1[r])), fmaxf(b0[r], b1[r]));
    }
    rm = xmax(rm);
    const float mref = (rm == NEG_INF) ? 0.f : rm;
    float s = 0.f;
#pragma unroll
    for (int r = 0; r < 16; ++r) { a0[r] = ex2(a0[r] - mref); a1[r] = ex2(a1[r] - mref); b0[r] = ex2(b0[r] - mref); b1[r] = ex2(b1[r] - mref); s += (a0[r] + a1[r]) + (b0[r] + b1[r]); }
    s = xsum(s);
    const float inv = (s > 0.f) ? 1.0f / s : 0.f;
#pragma unroll
    for (int r = 0; r < 16; ++r) { a0[r] *= inv; a1[r] *= inv; b0[r] *= inv; b1[r] *= inv; }
    { LAS3 float* iq = impq + (rh * 64 + tokl) * 33; LAS3 float* il = impl + (rh * 64 + tokl) * 33;
#pragma unroll
      for (int q4 = 0; q4 < 4; ++q4) {
        const int gi = 2 * q4 + hi;
        iq[gi] = (a0[4 * q4] + a0[4 * q4 + 1]) + (a0[4 * q4 + 2] + a0[4 * q4 + 3]);           il[gi] = a0[4 * q4 + 3];
        iq[8 + gi] = (a1[4 * q4] + a1[4 * q4 + 1]) + (a1[4 * q4 + 2] + a1[4 * q4 + 3]);       il[8 + gi] = a1[4 * q4 + 3];
        iq[16 + gi] = (b0[4 * q4] + b0[4 * q4 + 1]) + (b0[4 * q4 + 2] + b0[4 * q4 + 3]);      il[16 + gi] = b0[4 * q4 + 3];
        iq[24 + gi] = (b1[4 * q4] + b1[4 * q4 + 1]) + (b1[4 * q4 + 2] + b1[4 * q4 + 3]);      il[24 + gi] = b1[4 * q4 + 3];
      } }
    o[0] = f32x16{}; o[1] = f32x16{};
#pragma unroll
    for (int i = 0; i < 8; ++i) { pw[i] = cvtpk(a0[2 * i], a0[2 * i + 1]); pw[8 + i] = cvtpk(a1[2 * i], a1[2 * i + 1]); }
    pv(o, vp0, pw);
#pragma unroll
    for (int i = 0; i < 8; ++i) { pw[i] = cvtpk(b0[2 * i], b0[2 * i + 1]); pw[8 + i] = cvtpk(b1[2 * i], b1[2 * i + 1]); }
    pv(o, vp0 + SLOT, pw);
    if (hi == 0) wsf[r32] = gate[0];
#pragma unroll
    for (int r = 0; r < 16; ++r) { const float f = wsf[crow(r, hi)]; o[0][r] *= f; o[1][r] *= f; }
  }
  __syncthreads();
  const KVSrc ssrc{proj + (size_t)b * SEQ * PROJ_LD + PC_KV + 2 * 128 + g * 64, proj + (size_t)b * SEQ * PROJ_LD + PC_KV + 3 * 128 + g * 64, PROJ_LD, PROJ_LD};
  kv_issue(ssrc, 0, rk, rv, tid);
  {
    const int stok = tid >> 3, sub = tid & 7;
#pragma unroll
    for (int k = 0; k < 4; ++k) {
      const int n = sub * 4 + k;
      float imp = 0.f;
#pragma unroll
      for (int hh = 0; hh < 4; ++hh) imp += impq[(hh * 64 + stok) * 33 + n] + ((n > 0) ? impl[(hh * 64 + stok) * 33 + n - 1] : 0.f);
      sc[stok * 33 + n] = (n > c) ? -1.0f : ((n == 0 || n == c || n == c - 1) ? 1e4f : imp);
    }
    if (tid < 64) selm[tid] = 0u;
    __syncthreads();
#pragma unroll
    for (int k = 0; k < 4; ++k) {
      const int n = sub * 4 + k; const float sv = sc[stok * 33 + n]; int rank = 0;
      for (int mm = 0; mm < 32; ++mm) { const float sm = sc[stok * 33 + mm]; rank += (sm > sv || (sm == sv && mm < n)) ? 1 : 0; }
      if (rank < 16) atomicOr((unsigned*)(selm + stok), 1u << n);
    }
    __syncthreads();
  }
  const unsigned mysel = selm[tokl];
  fin_set(finl, o, lane);
#pragma unroll 1
  for (int br = 0; br < 2; ++br) {
    const KVSrc src = (br == 0) ? ssrc : KVSrc{proj + (size_t)b * SEQ * PROJ_LD + PC_KV + 4 * 128 + g * 64, proj + (size_t)b * SEQ * PROJ_LD + PC_KV + 5 * 128 + g * 64, PROJ_LD, PROJ_LD};
    const int n0 = (br == 0) ? 0 : ((c > 8) ? c - 8 : 0);
    if (br == 1) { __syncthreads(); kv_issue(src, n0 * 64, rk, rv, tid); }
    kv_commit(lds, rk, rv, tid);
    float m = -1e30f, l = 0.f;
    o[0] = f32x16{}; o[1] = f32x16{};
    int cur = 0;
#pragma unroll 1
    for (int n = n0; n <= c; ++n) {
      __syncthreads();
      if (n < c) kv_issue(src, (n + 1) * 64, rk, rv, tid);
      const bool mine = (br == 1) || ((mysel >> n) & 1u);
      if (__any(mine)) {
        f32x16 p0, p1;
        if (n + 2 >= c) {
          const LAS3 float* bp = tb + (t - 64 * n) - 4 * hi - 63;
          f32x16 c0, c1;
#pragma unroll
          for (int r = 0; r < 16; ++r) { c0[r] = bp[63 - ((r & 3) + 8 * (r >> 2))]; c1[r] = bp[31 - ((r & 3) + 8 * (r >> 2))]; }
          qkt_init<4>(p0, p1, kb0 + cur * SLOT, qr, c0, c1);
        } else if (br == 1 && n + 8 == c) {
          const LAS3 float* bp = stp + (607 - (t - 64 * n)) + 4 * hi;
          f32x16 c0, c1;
#pragma unroll
          for (int r = 0; r < 16; ++r) { c0[r] = bp[(r & 3) + 8 * (r >> 2)]; c1[r] = bp[32 + (r & 3) + 8 * (r >> 2)]; }
          qkt_init<4>(p0, p1, kb0 + cur * SLOT, qr, c0, c1);
        } else qkt<4>(p0, p1, kb0 + cur * SLOT, qr);
        if (!mine) {
#pragma unroll
          for (int r = 0; r < 16; ++r) { p0[r] = NEG_INF; p1[r] = NEG_INF; } }
        softmax_step(p0, p1, m, l, o, wsf, r32, hi, pw);
        pv(o, vp0 + cur * SLOT, pw);
      }
      if (n < c) kv_commit(lds + (cur ^ 1) * SLOT, rk, rv, tid);
      cur ^= 1;
    }
    l = xsum(l);
    const float gi = gate[1 + br] / fmaxf(l, 1e-30f);
    if (hi == 0) wsf[r32] = gi;
    fin_add(finl, o, wsf, lane, hi);
  }
  fin_store(finl, onsa, (size_t)b * SEQ + 64 * c + 32 * (w & 1), 512, head * 64, lane);
}

__device__ __forceinline__ void mla_unit(int b, int h, int qb, const bf16_t* __restrict__ mq, const bf16_t* __restrict__ mkv, const bf16_t* __restrict__ kr, bf16_t* __restrict__ omla, lptr lds) {
  int tid = threadIdx.x; asm volatile("" : "+v"(tid));
  const int lane = tid & 63, r32 = lane & 31, hi = lane >> 5;
  const int w = __builtin_amdgcn_readfirstlane(tid >> 6);
  const int q0 = 256 * qb, qw = q0 + 32 * w, qpos = qw + r32;
  const size_t tokq = (size_t)b * SEQ + qpos;
  LAS3 float* wsf = (LAS3 float*)(lds + L_WSF) + w * 64;
  const lcptr kb0 = (lcptr)lds + KOFF + hi * 1024 + r32 * 16;
  const lcptr vp0 = (lcptr)lds + VOFF + ((lane >> 4) & 1) * 32 + (lane & 3) * 8 + (4 * hi + ((lane & 15) >> 2)) * 64;
  const LAS3 float* stp = (const LAS3 float*)(lds + L_ST);
  bf16x8 qr[6];
#pragma unroll
  for (int d0 = 0; d0 < 6; ++d0) qr[d0] = *(const bf16x8*)(mq + tokq * 768 + h * 96 + d0 * 16 + hi * 8);
  const KVSrc src{mkv + (size_t)b * SEQ * 1024 + h * 128, mkv + (size_t)b * SEQ * 1024 + h * 128 + 64, 1024, 1024};
  const bf16_t* krb = kr + (size_t)b * SEQ * 32;
  const int NTL = 4 * (qb + 1);
  u32x4 rk, rv, rr = {0u, 0u, 0u, 0u};
  f32x16 o[2]; o[0] = f32x16{}; o[1] = f32x16{};
  unsigned pw[16];
  float m = -1e30f, l = 0.f;
  __syncthreads();
  kv_issue(src, 0, rk, rv, tid);
  if (tid < 256) rr = *(const u32x4*)(krb + (size_t)(tid & 63) * 32 + (tid >> 6) * 8);
  kv_commit(lds, rk, rv, tid);
  if (tid < 256) *(LAS3 u32x4*)(lds + KOFF + (8 + (tid >> 6)) * 1024 + (tid & 63) * 16) = rr;
  int cur = 0;
#pragma unroll 1
  for (int tl = 0; tl < NTL; ++tl) {
    __syncthreads();
    if (tl + 1 < NTL) { kv_issue(src, (tl + 1) * 64, rk, rv, tid); if (tid < 256) rr = *(const u32x4*)(krb + (size_t)((tl + 1) * 64 + (tid & 63)) * 32 + (tid >> 6) * 8); }
    if (64 * tl <= qw + 31) {
      f32x16 p0, p1;
      if (64 * tl + 63 > qw) {
        const LAS3 float* bp = stp + 96 + (qpos - 64 * tl) - 4 * hi - 63;
        f32x16 c0, c1;
#pragma unroll
        for (int r = 0; r < 16; ++r) { c0[r] = bp[63 - ((r & 3) + 8 * (r >> 2))]; c1[r] = bp[31 - ((r & 3) + 8 * (r >> 2))]; }
        qkt_init<6>(p0, p1, kb0 + cur * SLOT, qr, c0, c1);
      } else qkt<6>(p0, p1, kb0 + cur * SLOT, qr);
      softmax_step(p0, p1, m, l, o, wsf, r32, hi, pw);
      pv(o, vp0 + cur * SLOT, pw);
    }
    if (tl + 1 < NTL) { kv_commit(lds + (cur ^ 1) * SLOT, rk, rv, tid); if (tid < 256) *(LAS3 u32x4*)(lds + (cur ^ 1) * SLOT + KOFF + (8 + (tid >> 6)) * 1024 + (tid & 63) * 16) = rr; }
    cur ^= 1;
  }
  l = xsum(l);
  if (hi == 0) wsf[r32] = 1.0f / fmaxf(l, 1e-30f);
#pragma unroll
  for (int r = 0; r < 16; ++r) { const float f = wsf[crow(r, hi)]; o[0][r] *= f; o[1][r] *= f; }
  LAS3 float* finl = (LAS3 float*)(lds + L_FIN) + w * 2048;
  fin_set(finl, o, lane);
  fin_store(finl, omla, (size_t)b * SEQ + qw, 512, h * 64, lane);
}

__device__ __forceinline__ void attn_phase(const bf16_t* proj, const bf16_t* kc, const bf16_t* vc, const float* t5, bf16_t* onsa,
                                           const bf16_t* mq, const bf16_t* mkv, const bf16_t* kr, bf16_t* omla, lptr lds) {
  const int tid = threadIdx.x;
  { LAS3 float* tb = (LAS3 float*)(lds + L_TB);
    for (int i = tid; i < 8 * 320; i += NTHR) { const int hd = i / 320, d = i % 320 - 64; tb[i] = (d < 0) ? NEG_INF : ((d < 113) ? (t5[(int)T5B[d] * 8 + hd] - t5[31 * 8 + hd]) * LOG2E : 0.f); }
    LAS3 float* st = (LAS3 float*)(lds + L_ST);
    for (int i = tid; i < 192; i += NTHR) st[i] = (i < 96) ? NEG_INF : 0.f; }
  const int G = gridDim.x, bx = blockIdx.x;
  for (int v = (G % 8 == 0) ? (bx % 8) * (G / 8) + bx / 8 : bx; v < 256; v += G) {
    const int bg = v >> 4, p = v & 15, bh = v >> 2, j = v & 3;
#pragma unroll 1
    for (int u = 0; u < 2; ++u) nsa_unit(bg >> 1, bg & 1, u ? p : 31 - p, proj, kc, vc, onsa, lds);
#pragma unroll 1
    for (int u = 0; u < 2; ++u) mla_unit(bh >> 3, bh & 7, u ? j : 7 - j, mq, mkv, kr, omla, lds);
  }
}
#undef LAS3
}


namespace peer {
using bf16x8 = __attribute__((ext_vector_type(8))) short;
using f32x16 = __attribute__((ext_vector_type(16))) float;
typedef unsigned u32x4 __attribute__((ext_vector_type(4)));
typedef float f32x4_t __attribute__((ext_vector_type(4)));
typedef __bf16 bf16x2_t __attribute__((ext_vector_type(2)));
typedef float f32x2_t __attribute__((ext_vector_type(2)));
#define LAS3 __attribute__((address_space(3)))
__device__ __forceinline__ int crow(int r, int hi) { return (r & 3) + 8 * (r >> 2) + 4 * hi; }
__device__ __forceinline__ unsigned enc(float f) { const unsigned u = __float_as_uint(f); return u ^ ((unsigned)((int)u >> 31) | 0x80000000u); }
__device__ __forceinline__ float dec(unsigned k) { return __uint_as_float(k ^ (~(unsigned)((int)k >> 31) | 0x80000000u)); }
__device__ __forceinline__ unsigned umax(unsigned a, unsigned b) { return a > b ? a : b; }
__device__ __forceinline__ unsigned umin(unsigned a, unsigned b) { return a < b ? a : b; }
__device__ __forceinline__ unsigned cvtpk(float lo, float hi) { f32x2_t v = {lo, hi}; bf16x2_t b = __builtin_convertvector(v, bf16x2_t); return __builtin_bit_cast(unsigned, b); }
template <int B, int N> __device__ __forceinline__ void sort16(unsigned (&k)[N]) {
#pragma unroll
  for (int size = 2; size <= 16; size <<= 1)
#pragma unroll
    for (int stride = size >> 1; stride > 0; stride >>= 1)
#pragma unroll
      for (int i = 0; i < 16; ++i) { const int l = i ^ stride;
        if (l > i) { const bool desc = ((i & size) == 0); const unsigned a = k[B + i], b = k[B + l]; const unsigned mx = umax(a, b), mn = umin(a, b); k[B + i] = desc ? mx : mn; k[B + l] = desc ? mn : mx; } }
}
template <int A, int Bo, int N> __device__ __forceinline__ void merge16(unsigned (&k)[N]) {
#pragma unroll
  for (int i = 0; i < 16; ++i) k[A + i] = umax(k[A + i], k[Bo + 15 - i]);
#pragma unroll
  for (int stride = 8; stride > 0; stride >>= 1)
#pragma unroll
    for (int i = 0; i < 16; ++i) { const int l = i ^ stride; if (l > i) { const unsigned a = k[A + i], b = k[A + l]; k[A + i] = umax(a, b); k[A + l] = umin(a, b); } }
}
template <int N> __device__ __forceinline__ void top16_of_64(unsigned (&k)[N]) {
  sort16<0>(k); sort16<16>(k); sort16<32>(k); sort16<48>(k);
  merge16<0, 16>(k); merge16<32, 48>(k); merge16<0, 32>(k);
}

__device__ __forceinline__ void route_phase(const bf16_t* __restrict__ pq, const bf16_t* __restrict__ subk, unsigned* __restrict__ pack, LAS3 char* lds) {
  const int tid = threadIdx.x, lane = tid & 63, r32 = lane & 31, hi = lane >> 5, wv = tid >> 6;
  const int gw = blockIdx.x * NWV + wv, nw = gridDim.x * NWV;
  LAS3 unsigned char* myb = (LAS3 unsigned char*)lds + wv * 2560 + lane * 40;
#pragma unroll 1
  for (int item = gw; item < (T / 32) * 8; item += nw) {
    const int h = item & 7, t0 = (item >> 3) * 32;
    unsigned la[16], lb[16];
#pragma unroll
    for (int i = 0; i < 16; ++i) { la[i] = 0u; lb[i] = 0u; }
#pragma unroll 1
    for (int p = 0; p < 2; ++p) {
      f32x16 acc[4];
#pragma unroll
      for (int kt = 0; kt < 4; ++kt) acc[kt] = f32x16{};
#pragma unroll
      for (int kd = 0; kd < 4; ++kd) {
        const bf16x8 bq = *(const bf16x8*)(pq + (size_t)(t0 + r32) * 1024 + h * 128 + p * 64 + kd * 16 + hi * 8);
#pragma unroll
        for (int kt = 0; kt < 4; ++kt) {
          const bf16x8 ak = *(const bf16x8*)(subk + (size_t)((h * 2 + p) * 128 + kt * 32 + r32) * 64 + kd * 16 + hi * 8);
          acc[kt] = __builtin_amdgcn_mfma_f32_32x32x16_bf16(ak, bq, acc[kt], 0, 0, 0);
        }
      }
      unsigned k[64];
#pragma unroll
      for (int kt = 0; kt < 4; ++kt)
#pragma unroll
        for (int r = 0; r < 16; ++r) k[kt * 16 + r] = (enc(acc[kt][r]) & 0xFFFFFF80u) | (unsigned)(127 - (32 * kt + crow(r, hi)));
      top16_of_64(k);
#pragma unroll
      for (int i = 0; i < 16; ++i) { auto rr = __builtin_amdgcn_permlane32_swap(k[i], k[i], false, false); unsigned r0 = rr[0], r1 = rr[1]; asm volatile("" : "+v"(r0), "+v"(r1)); k[16 + i] = hi ? r0 : r1; }
      merge16<0, 16>(k);
#pragma unroll
      for (int i = 0; i < 16; ++i) { la[i] = (p == 0) ? k[i] : la[i]; lb[i] = (p == 0) ? lb[i] : k[i]; }
      __builtin_amdgcn_sched_barrier(0);
    }
#pragma unroll
    for (int i = 0; i < 4; ++i) {
      const unsigned wa = (127u - (la[4 * i] & 127u)) | ((127u - (la[4 * i + 1] & 127u)) << 8) | ((127u - (la[4 * i + 2] & 127u)) << 16) | ((127u - (la[4 * i + 3] & 127u)) << 24);
      const unsigned wb = (127u - (lb[4 * i] & 127u)) | ((127u - (lb[4 * i + 1] & 127u)) << 8) | ((127u - (lb[4 * i + 2] & 127u)) << 16) | ((127u - (lb[4 * i + 3] & 127u)) << 24);
      *(LAS3 unsigned*)(myb + 4 * i) = wa; *(LAS3 unsigned*)(myb + 16 + 4 * i) = wb;
    }
    float va[16], vb[16];
#pragma unroll
    for (int i = 0; i < 16; ++i) { va[i] = dec(la[i] & 0xFFFFFF80u); vb[i] = dec(lb[i] & 0xFFFFFF80u); }
    unsigned k[64];
#define PEER_CAND(n, i, j) k[n] = (enc(va[i] + vb[j]) & 0xFFFFFF00u) | (unsigned)(255 - ((i) * 16 + (j)))
    PEER_CAND(0, 0, 0); PEER_CAND(1, 0, 1); PEER_CAND(2, 0, 2); PEER_CAND(3, 0, 3); PEER_CAND(4, 0, 4); PEER_CAND(5, 0, 5);
    PEER_CAND(6, 0, 6); PEER_CAND(7, 0, 7); PEER_CAND(8, 0, 8); PEER_CAND(9, 0, 9); PEER_CAND(10, 0, 10); PEER_CAND(11, 0, 11);
    PEER_CAND(12, 0, 12); PEER_CAND(13, 0, 13); PEER_CAND(14, 0, 14); PEER_CAND(15, 0, 15); PEER_CAND(16, 1, 0); PEER_CAND(17, 1, 1);
    PEER_CAND(18, 1, 2); PEER_CAND(19, 1, 3); PEER_CAND(20, 1, 4); PEER_CAND(21, 1, 5); PEER_CAND(22, 1, 6); PEER_CAND(23, 1, 7);
    PEER_CAND(24, 2, 0); PEER_CAND(25, 2, 1); PEER_CAND(26, 2, 2); PEER_CAND(27, 2, 3); PEER_CAND(28, 2, 4); PEER_CAND(29, 3, 0);
    PEER_CAND(30, 3, 1); PEER_CAND(31, 3, 2); PEER_CAND(32, 3, 3); PEER_CAND(33, 4, 0); PEER_CAND(34, 4, 1); PEER_CAND(35, 4, 2);
    PEER_CAND(36, 5, 0); PEER_CAND(37, 5, 1); PEER_CAND(38, 6, 0); PEER_CAND(39, 6, 1); PEER_CAND(40, 7, 0); PEER_CAND(41, 7, 1);
    PEER_CAND(42, 8, 0); PEER_CAND(43, 9, 0); PEER_CAND(44, 10, 0); PEER_CAND(45, 11, 0); PEER_CAND(46, 12, 0); PEER_CAND(47, 13, 0);
    PEER_CAND(48, 14, 0); PEER_CAND(49, 15, 0);
#undef PEER_CAND
#pragma unroll
    for (int z = 50; z < 64; ++z) k[z] = 0u;
    top16_of_64(k);
    const float best0 = dec(k[0] & 0xFFFFFF00u);
    float ev[16]; float den = 0.f;
#pragma unroll
    for (int i = 0; i < 16; ++i) { ev[i] = __expf(dec(k[i] & 0xFFFFFF00u) - best0); den += ev[i]; }
    const float inv = 1.0f / den;
    unsigned outw[8];
#pragma unroll
    for (int i = 0; i < 8; ++i) {
      unsigned k_lo = k[i], k_hi = k[8 + i]; float e_lo = ev[i], e_hi = ev[8 + i];
      asm volatile("" : "+v"(k_lo), "+v"(k_hi), "+v"(e_lo), "+v"(e_hi));
      const unsigned kk = hi ? k_hi : k_lo; const float e = hi ? e_hi : e_lo;
      const unsigned f = 255u - (kk & 255u);
      const unsigned ia = myb[f >> 4], ib = myb[16 + (f & 15u)];
      outw[i] = (ia * 128u + ib) | (cvtpk(0.f, e * inv) & 0xFFFF0000u);
    }
    unsigned* dst = pack + (size_t)(t0 + r32) * 128 + h * 16 + hi * 8;
    *(u32x4*)dst = (u32x4){outw[0], outw[1], outw[2], outw[3]};
    *(u32x4*)(dst + 4) = (u32x4){outw[4], outw[5], outw[6], outw[7]};
  }
}

__device__ __forceinline__ void conv_tables(const float* __restrict__ u, const float* __restrict__ v, unsigned* __restrict__ u8, float* __restrict__ su, unsigned* __restrict__ v8) {
  const int tid = threadIdx.x, lane = tid & 63, wv = tid >> 6;
  const int gw = blockIdx.x * NWV + wv, nw = gridDim.x * NWV;
  for (int e = gw; e < 16384; e += nw) {
    const f32x4_t* ur = (const f32x4_t*)(u + (size_t)e * 1024) + lane * 4;
    f32x4_t a[4]; float mx = 0.f;
#pragma unroll
    for (int i = 0; i < 4; ++i) { a[i] = ur[i]; mx = fmaxf(mx, fmaxf(fmaxf(fabsf(a[i][0]), fabsf(a[i][1])), fmaxf(fabsf(a[i][2]), fabsf(a[i][3])))); }
    mx = wmaxf(mx);
    const float sc = fmaxf(mx, 1e-30f) * (1.0f / 127.0f), isc = 1.0f / sc;
    u32x4 o;
#pragma unroll
    for (int i = 0; i < 4; ++i) {
      const int q0 = (int)rintf(a[i][0] * isc), q1 = (int)rintf(a[i][1] * isc), q2 = (int)rintf(a[i][2] * isc), q3 = (int)rintf(a[i][3] * isc);
      o[i] = (unsigned)(q0 & 255) | ((unsigned)(q1 & 255) << 8) | ((unsigned)(q2 & 255) << 16) | ((unsigned)(q3 & 255) << 24);
    }
    *(u32x4*)(u8 + (size_t)e * 256 + lane * 4) = o;
    if (lane == 0) su[e] = sc;
    const f32x4_t* vr = (const f32x4_t*)(v + (size_t)e * 1024) + lane * 4;
    u32x4 ov;
#pragma unroll
    for (int i = 0; i < 4; ++i) { const f32x4_t b = vr[i]; unsigned w = 0u; w = __builtin_amdgcn_cvt_pk_fp8_f32(2.0f * b[0], 2.0f * b[1], w, false); w = __builtin_amdgcn_cvt_pk_fp8_f32(2.0f * b[2], 2.0f * b[3], w, true); ov[i] = w; }
    *(u32x4*)(v8 + ((size_t)(lane >> 3) * 16384 + e) * 32 + (lane & 7) * 4) = ov;
  }
}
__device__ __forceinline__ float gelu_fast(float v) {
  const float av = __builtin_fabsf(v), t = __builtin_amdgcn_rcpf(av * 0.2316418882f + 1.0f);
  float q = t * 0.5307027145f + (-0.7265760135f); q = q * t + 0.7107068705f; q = q * t + (-0.142248368f); q = q * t + 0.127414796f; q = q * t;
  const float e = __builtin_amdgcn_exp2f((v * v) * (-0.72134752044f));
  const float m = v * (q * e);
  return v < 0.f ? m : v - m;
}
__device__ __forceinline__ unsigned xcc_id() { return (unsigned)__builtin_amdgcn_s_getreg((3 << 11) | 20) & 7u; }
struct ABuf { unsigned w[4], meta[4]; u32x4 ub[4][4]; float sue[4]; };
__device__ __forceinline__ void expA_issue(ABuf& B, int k0, int n, const LAS3 unsigned* list, const unsigned* __restrict__ u8, const float* __restrict__ su, int j16) {
#pragma unroll
  for (int q = 0; q < 4; ++q) {
    const int k = (k0 + 32 * q < n) ? k0 + 32 * q : k0;
    B.w[q] = list[2 * k]; B.meta[q] = list[2 * k + 1];
    const unsigned e = B.w[q] & 0xFFFFu;
    const unsigned* urow = u8 + (size_t)e * 256 + j16 * 4;
#pragma unroll
    for (int seg = 0; seg < 4; ++seg) B.ub[q][seg] = *(const u32x4*)(urow + seg * 64);
    B.sue[q] = su[e];
  }
}
__device__ __forceinline__ f32x4_t gelu_fast4(f32x4_t v) {
  f32x4_t t;
#pragma unroll
  for (int i = 0; i < 4; ++i) t[i] = __builtin_amdgcn_rcpf(__builtin_fabsf(v[i]) * 0.2316418882f + 1.0f);
  f32x4_t q = t * 0.5307027145f + (-0.7265760135f); q = q * t + 0.7107068705f; q = q * t + (-0.142248368f); q = q * t + 0.127414796f; q = q * t;
  f32x4_t e;
#pragma unroll
  for (int i = 0; i < 4; ++i) e[i] = __builtin_amdgcn_exp2f((v[i] * v[i]) * (-0.72134752044f));
  const f32x4_t m = v * (q * e);
  f32x4_t r;
#pragma unroll
  for (int i = 0; i < 4; ++i) r[i] = v[i] < 0.f ? m[i] : v[i] - m[i];
  return r;
}
__device__ __forceinline__ void expA_consume(const ABuf& B, int k0, int n, const LAS3 char* hl, const LAS3 float* shl, float* __restrict__ co, int t0, int j16) {
  int acc[4]; float sc[4];
#pragma unroll
  for (int q = 0; q < 4; ++q) {
    const int tokl = (int)(B.meta[q] >> 8);
    const LAS3 char* hrow = hl + tokl * 1024 + j16 * 16;
    int a0 = 0, a1 = 0, a2 = 0, a3 = 0;
#pragma unroll
    for (int seg = 0; seg < 4; ++seg) { const u32x4 hq = *(const LAS3 u32x4*)(hrow + seg * 256);
      a0 = __builtin_amdgcn_sdot4((int)B.ub[q][seg].x, (int)hq.x, a0, false); a1 = __builtin_amdgcn_sdot4((int)B.ub[q][seg].y, (int)hq.y, a1, false);
      a2 = __builtin_amdgcn_sdot4((int)B.ub[q][seg].z, (int)hq.z, a2, false); a3 = __builtin_amdgcn_sdot4((int)B.ub[q][seg].w, (int)hq.w, a3, false); }
    acc[q] = (a0 + a1) + (a2 + a3);
    sc[q] = B.sue[q] * shl[tokl];
  }
#pragma unroll
  for (int q = 0; q < 4; ++q) acc[q] += dpp_i<0xB1>(acc[q]);
#pragma unroll
  for (int q = 0; q < 4; ++q) acc[q] += dpp_i<0x4E>(acc[q]);
#pragma unroll
  for (int q = 0; q < 4; ++q) acc[q] += dpp_i<0x141>(acc[q]);
#pragma unroll
  for (int q = 0; q < 4; ++q) acc[q] += dpp_i<0x140>(acc[q]);
  const f32x4_t d = {(float)acc[0] * sc[0], (float)acc[1] * sc[1], (float)acc[2] * sc[2], (float)acc[3] * sc[3]};
  const f32x4_t g = gelu_fast4(d);
#pragma unroll
  for (int q = 0; q < 4; ++q) {
    const int tokl = (int)(B.meta[q] >> 8), slot = (int)(B.meta[q] & 255u);
    const float c = 0.5f * __uint_as_float(B.w[q] & 0xFFFF0000u) * g[q];
    if (j16 == 0 && k0 + 32 * q < n) co[(size_t)(t0 + tokl) * 128 + slot] = c;
  }
}
__device__ __forceinline__ void expA_item(int item, int xs, const unsigned* __restrict__ pack, const unsigned* __restrict__ hn8, const float* __restrict__ shp, const unsigned* __restrict__ u8, const float* __restrict__ su,
                                          float* __restrict__ co, LAS3 char* lds, int tid) {
  const int lane = tid & 63, j16 = lane & 15, grp = lane >> 4, wv = tid >> 6;
  LAS3 char* hl = lds + 1024;
  LAS3 float* shl = (LAS3 float*)(lds + 1024 + 65536);
  LAS3 unsigned* cnt = (LAS3 unsigned*)(lds + 16);
  LAS3 unsigned* list = (LAS3 unsigned*)(lds + 1024 + 65536 + 256);
  const int t0 = item * 64;
  const int tokl = tid >> 3, sb = (tid & 7) * 16;
  u32x4 pw[4], hst[8];
#pragma unroll
  for (int i = 0; i < 4; ++i) pw[i] = *(const u32x4*)(pack + (size_t)(t0 + tokl) * 128 + sb + 4 * i);
#pragma unroll
  for (int i = 0; i < 8; ++i) hst[i] = *(const u32x4*)(hn8 + (size_t)t0 * 256 + (tid + 512 * i) * 4);
  const float shv = (tid < 64) ? shp[t0 + tid] : 0.f;
#pragma unroll
  for (int i = 0; i < 8; ++i) *(LAS3 u32x4*)(hl + (tid + 512 * i) * 16) = hst[i];
  if (tid < 64) shl[tid] = shv;
  {
#pragma unroll
    for (int j = 0; j < 16; ++j) { const unsigned w = pw[j >> 2][j & 3];
      if (((w & 0xFFFFu) >> 11) == (unsigned)xs) { const unsigned pos = __hip_atomic_fetch_add(cnt, 1u, __ATOMIC_RELAXED, __HIP_MEMORY_SCOPE_WORKGROUP); list[2 * pos] = w; list[2 * pos + 1] = (unsigned)((tokl << 8) | (sb + j)); } }
  }
  __syncthreads();
  const int n = (int)cnt[0];
  const int gidx = wv * 4 + grp;
  ABuf A, Bb;
  if (gidx < n) expA_issue(A, gidx, n, list, u8, su, j16);
#pragma unroll 1
  for (int k0 = gidx; k0 < n; k0 += 256) {
    if (k0 + 128 < n) expA_issue(Bb, k0 + 128, n, list, u8, su, j16);
    expA_consume(A, k0, n, hl, shl, co, t0, j16);
    if (k0 + 256 < n) expA_issue(A, k0 + 256, n, list, u8, su, j16);
    if (k0 + 128 < n) expA_consume(Bb, k0 + 128, n, hl, shl, co, t0, j16);
  }
}
struct BBuf { u32x4 vv[8]; f32x4_t c[2]; };
__device__ __forceinline__ void expB_issue(BBuf& B, const LAS3 unsigned* pkl, const LAS3 float* col, int sg8, const unsigned* __restrict__ vbase) {
  const u32x4 p0 = *(const LAS3 u32x4*)(pkl + sg8 * 8), p1 = *(const LAS3 u32x4*)(pkl + sg8 * 8 + 4);
  B.c[0] = *(const LAS3 f32x4_t*)(col + sg8 * 8); B.c[1] = *(const LAS3 f32x4_t*)(col + sg8 * 8 + 4);
#pragma unroll
  for (int j = 0; j < 4; ++j) { B.vv[j] = *(const u32x4*)(vbase + (size_t)(p0[j] & 0xFFFFu) * 32); B.vv[4 + j] = *(const u32x4*)(vbase + (size_t)(p1[j] & 0xFFFFu) * 32); }
}
__device__ __forceinline__ void expB_consume(const BBuf& B, f32x2_t (&y)[8]) {
#pragma unroll
  for (int j = 0; j < 8; ++j) {
    const float cv = B.c[j >> 2][j & 3];
    const f32x2_t c2 = {cv, cv};
#pragma unroll
    for (int w = 0; w < 4; ++w) {
      y[2 * w] = __builtin_elementwise_fma(__builtin_amdgcn_cvt_pk_f32_fp8(B.vv[j][w], false), c2, y[2 * w]);
      y[2 * w + 1] = __builtin_elementwise_fma(__builtin_amdgcn_cvt_pk_f32_fp8(B.vv[j][w], true), c2, y[2 * w + 1]);
    }
  }
}
__device__ __forceinline__ void expB_item(int item, int xs, const unsigned* __restrict__ pack, const float* __restrict__ co, const unsigned* __restrict__ v8, float* __restrict__ out, float* __restrict__ ssq, LAS3 char* lds, int tid,
                                          const float* __restrict__ xin, const bf16_t* __restrict__ ob) {
  const int lane = tid & 63, wv = tid >> 6, r8 = lane >> 3, c8 = lane & 7;
  const int t0 = item * 64 + wv * 8;
  LAS3 unsigned* pkw = (LAS3 unsigned*)(lds + 1024 + wv * 8192);
  LAS3 float* cow = (LAS3 float*)(lds + 1024 + wv * 8192 + 4096);
  {
    u32x4 a[4]; f32x4_t b[4];
#pragma unroll
    for (int i = 0; i < 4; ++i) { a[i] = *(const u32x4*)(pack + (size_t)t0 * 128 + (lane + 64 * i) * 4); b[i] = *(const f32x4_t*)(co + (size_t)t0 * 128 + (lane + 64 * i) * 4); }
#pragma unroll
    for (int i = 0; i < 4; ++i) { *(LAS3 u32x4*)(pkw + (lane + 64 * i) * 4) = a[i]; *(LAS3 f32x4_t*)(cow + (lane + 64 * i) * 4) = b[i]; }
  }
  const size_t hoff = (size_t)(t0 + r8) * 1024 + xs * 128 + c8 * 16;
  float* hp = out + hoff;
  f32x4_t h[4];
  { const u32x4 o0 = *(const u32x4*)(ob + hoff), o1 = *(const u32x4*)(ob + hoff + 8);
#pragma unroll
    for (int w = 0; w < 4; ++w) h[w] = *(const f32x4_t*)(xin + hoff + 4 * w);
    h[0] += (f32x4_t){__uint_as_float(o0.x << 16), __uint_as_float(o0.x & 0xffff0000u), __uint_as_float(o0.y << 16), __uint_as_float(o0.y & 0xffff0000u)};
    h[1] += (f32x4_t){__uint_as_float(o0.z << 16), __uint_as_float(o0.z & 0xffff0000u), __uint_as_float(o0.w << 16), __uint_as_float(o0.w & 0xffff0000u)};
    h[2] += (f32x4_t){__uint_as_float(o1.x << 16), __uint_as_float(o1.x & 0xffff0000u), __uint_as_float(o1.y << 16), __uint_as_float(o1.y & 0xffff0000u)};
    h[3] += (f32x4_t){__uint_as_float(o1.z << 16), __uint_as_float(o1.z & 0xffff0000u), __uint_as_float(o1.w << 16), __uint_as_float(o1.w & 0xffff0000u)}; }
  wave_lds_sync();
  const LAS3 unsigned* pkl = pkw + r8 * 128; const LAS3 float* col = cow + r8 * 128;
  const unsigned* vbase = v8 + (size_t)xs * 16384 * 32 + c8 * 4;
  f32x2_t y[8];
#pragma unroll
  for (int i = 0; i < 8; ++i) y[i] = (f32x2_t){0.f, 0.f};
  BBuf A, Bb;
  expB_issue(A, pkl, col, 0, vbase);
#pragma unroll 1
  for (int sg = 0; sg < 16; sg += 2) {
    expB_issue(Bb, pkl, col, sg + 1, vbase);
    expB_consume(A, y);
    if (sg + 2 < 16) expB_issue(A, pkl, col, sg + 2, vbase);
    expB_consume(Bb, y);
  }
  float ss = 0.f;
#pragma unroll
  for (int w = 0; w < 4; ++w) {
    const f32x4_t z = {h[w][0] + y[2 * w][0], h[w][1] + y[2 * w][1], h[w][2] + y[2 * w + 1][0], h[w][3] + y[2 * w + 1][1]};
    *(f32x4_t*)(hp + 4 * w) = z;
    ss += (z[0] * z[0] + z[1] * z[1]) + (z[2] * z[2] + z[3] * z[3]);
  }
  ss += dpp_f<0xB1>(ss); ss += dpp_f<0x4E>(ss); ss += dpp_f<0x141>(ss);
  if (c8 == 0) ssq[(size_t)xs * T + t0 + r8] = ss;
  wave_lds_sync();
}
template <int PASS> __device__ __forceinline__ void experts_sliced(const unsigned* __restrict__ pack, const unsigned* __restrict__ hn8, const float* __restrict__ shp, const unsigned* __restrict__ u8, const float* __restrict__ su,
                                                                    float* __restrict__ co, const unsigned* __restrict__ v8, float* __restrict__ out, float* __restrict__ ssq, unsigned* __restrict__ ctr, LAS3 char* lds,
                                                                    const float* __restrict__ xin = nullptr, const bf16_t* __restrict__ ob = nullptr) {
  int tid = threadIdx.x; asm volatile("" : "+v"(tid));
  LAS3 volatile int* lw = (LAS3 volatile int*)lds;
  const int xme = (int)xcc_id();
#pragma unroll 1
  for (int s8 = 0; s8 < 8; ++s8) {
    const int xs = (xme + s8) & 7;
    int nxt = 0;
    if (tid == 0) nxt = (int)atomicAdd(ctr + 64 * xs, 1u);
#pragma unroll 1
    for (;;) {
      __syncthreads();
      if (tid == 0) { lw[0] = nxt; lw[4] = 0; }
      __syncthreads();
      const int item = lw[0];
      if (item >= T / 64) break;
      if (tid == 0) nxt = (int)atomicAdd(ctr + 64 * xs, 1u);
      if (PASS == 0) expA_item(item, xs, pack, hn8, shp, u8, su, co, lds, tid);
      else expB_item(item, xs, pack, co, v8, out, ssq, lds, tid, xin, ob);
    }
  }
}
__device__ __forceinline__ void experts_norm(const float* __restrict__ ssq, const float* __restrict__ gfin, float* __restrict__ out) {
  const int tid = threadIdx.x, lane = tid & 63, wv = tid >> 6;
  const int gw = blockIdx.x * NWV + wv, nw = gridDim.x * NWV;
  for (int t = gw; t < T; t += nw) {
    float ss = 0.f;
#pragma unroll
    for (int x = 0; x < 8; ++x) ss += ssq[(size_t)x * T + t];
    const float inv = rsqrtf(ss * (1.0f / 1024.0f) + 1e-6f);
    float* op = out + (size_t)t * 1024 + lane * 16; const float* gp = gfin + lane * 16;
#pragma unroll
    for (int i = 0; i < 4; ++i) { const f32x4_t z = *(const f32x4_t*)(op + 4 * i), g = *(const f32x4_t*)(gp + 4 * i); *(f32x4_t*)(op + 4 * i) = z * inv * g; }
  }
}
#undef LAS3
}

namespace prep {
typedef unsigned u32x2_t __attribute__((ext_vector_type(2)));
typedef float f32x4_t __attribute__((ext_vector_type(4)));
typedef unsigned u32x4 __attribute__((ext_vector_type(4)));
using bf16x8 = __attribute__((ext_vector_type(8))) short;
using f32x16 = __attribute__((ext_vector_type(16))) float;
__device__ __forceinline__ unsigned pk2(float lo, float hi) { return (unsigned)f2bf(lo) | ((unsigned)f2bf(hi) << 16); }
__device__ __forceinline__ void latent_rows(const bf16_t* __restrict__ proj, const float* __restrict__ gq, const float* __restrict__ gkv, const float2* __restrict__ cs,
                                            bf16_t* __restrict__ cqn, bf16_t* __restrict__ ckvn, bf16_t* __restrict__ krope, int wave_id, int nwaves, int lane) {
  const f32x4_t g4 = *(const f32x4_t*)(gq + lane * 4);
  const float2 g2 = *(const float2*)(gkv + lane * 2);
  for (int r = wave_id; r < T; r += nwaves) {
    const bf16_t* row = proj + (size_t)r * PROJ_LD;
    const u32x2_t q = *(const u32x2_t*)(row + PC_CQ + lane * 4);
    const unsigned kv = *(const unsigned*)(row + PC_CKV + lane * 2);
    const unsigned short kr0 = row[PC_KR + (lane & 15)], kr1 = row[PC_KR + 16 + (lane & 15)];
    const float q0 = __uint_as_float(q.x << 16), q1 = __uint_as_float(q.x & 0xffff0000u), q2 = __uint_as_float(q.y << 16), q3 = __uint_as_float(q.y & 0xffff0000u);
    const float k0 = __uint_as_float(kv << 16), k1 = __uint_as_float(kv & 0xffff0000u);
    float sq = (q0 * q0 + q1 * q1) + (q2 * q2 + q3 * q3), sk = k0 * k0 + k1 * k1;
    sq = wsum(sq); sk = wsum(sk);
    const float iq = rsqrtf(sq * (1.0f / 256.0f) + 1e-6f), ik = rsqrtf(sk * (1.0f / 128.0f) + 1e-6f);
    u32x2_t oq; oq.x = pk2(q0 * iq * g4[0], q1 * iq * g4[1]); oq.y = pk2(q2 * iq * g4[2], q3 * iq * g4[3]);
    *(u32x2_t*)(cqn + (size_t)r * 256 + lane * 4) = oq;
    *(unsigned*)(ckvn + (size_t)r * 128 + lane * 2) = pk2(k0 * ik * g2.x, k1 * ik * g2.y);
    if (lane < 16) {
      const float2 c = cs[(r & (SEQ - 1)) * 16 + lane];
      const float x1 = bf2f(kr0), x2 = bf2f(kr1);
      krope[(size_t)r * 32 + lane] = f2bf(x1 * c.x - x2 * c.y); krope[(size_t)r * 32 + 16 + lane] = f2bf(x2 * c.x + x1 * c.y);
    }
  }
}
__device__ __forceinline__ void cmp_bias(const float* __restrict__ posk, const float* __restrict__ posv, const bf16_t* __restrict__ w1k, const bf16_t* __restrict__ w1v, float* __restrict__ cpos, int wave_id, int nwaves, int lane) {
  for (int o = wave_id; o < 512; o += nwaves) {
    const int tab = o >> 8, n = o & 255;
    const float* pos = tab ? posv : posk; const bf16_t* w = (tab ? w1v : w1k) + (size_t)n * 2048;
    float acc = 0.f;
#pragma unroll
    for (int i = 0; i < 4; ++i) { const int k = (i * 64 + lane) * 8;
      const u32x4 wv = *(const u32x4*)(w + k); const f32x4_t p0 = *(const f32x4_t*)(pos + k), p1 = *(const f32x4_t*)(pos + k + 4);
      acc += p0[0] * __uint_as_float(wv.x << 16) + p0[1] * __uint_as_float(wv.x & 0xffff0000u) + p0[2] * __uint_as_float(wv.y << 16) + p0[3] * __uint_as_float(wv.y & 0xffff0000u);
      acc += p1[0] * __uint_as_float(wv.z << 16) + p1[1] * __uint_as_float(wv.z & 0xffff0000u) + p1[2] * __uint_as_float(wv.w << 16) + p1[3] * __uint_as_float(wv.w & 0xffff0000u); }
    acc = wsum(acc);
    if (lane == 0) cpos[o] = acc;
  }
}
__device__ __forceinline__ void cmp_l2(const float* __restrict__ slab, const float* __restrict__ cpos, const bf16_t* __restrict__ w2t, bf16_t* __restrict__ outkc, int item, int lane) {
  const int r32 = lane & 31, hi = lane >> 5, m0 = item * 32;
  f32x16 acc0 = f32x16{}, acc1 = f32x16{};
  f32x4_t sa[2][8]; f32x4_t cp[2][2]; bf16x8 wb[2][2];
#define CMPL2_LOAD(buf, ks_) do { const int k_ = (ks_) * 16 + hi * 8; \
    cp[buf][0] = *(const f32x4_t*)(cpos + k_); cp[buf][1] = *(const f32x4_t*)(cpos + k_ + 4); \
    _Pragma("unroll") for (int sp = 0; sp < 4; ++sp) { const float* p_ = slab + ((size_t)sp * 2048 + m0 + r32) * 256 + k_; sa[buf][2 * sp] = *(const f32x4_t*)p_; sa[buf][2 * sp + 1] = *(const f32x4_t*)(p_ + 4); } \
    wb[buf][0] = *(const bf16x8*)(w2t + (size_t)r32 * 256 + k_); wb[buf][1] = *(const bf16x8*)(w2t + (size_t)(32 + r32) * 256 + k_); } while (0)
#define CMPL2_MMA(buf) do { f32x4_t a0 = cp[buf][0], a1 = cp[buf][1]; \
    _Pragma("unroll") for (int sp = 0; sp < 4; ++sp) { a0 += sa[buf][2 * sp]; a1 += sa[buf][2 * sp + 1]; } \
    u32x4 aw; aw.x = pk2(peer::gelu_fast(a0[0]), peer::gelu_fast(a0[1])); aw.y = pk2(peer::gelu_fast(a0[2]), peer::gelu_fast(a0[3])); \
    aw.z = pk2(peer::gelu_fast(a1[0]), peer::gelu_fast(a1[1])); aw.w = pk2(peer::gelu_fast(a1[2]), peer::gelu_fast(a1[3])); \
    const bf16x8 af = __builtin_bit_cast(bf16x8, aw); \
    acc0 = __builtin_amdgcn_mfma_f32_32x32x16_bf16(af, wb[buf][0], acc0, 0, 0, 0); acc1 = __builtin_amdgcn_mfma_f32_32x32x16_bf16(af, wb[buf][1], acc1, 0, 0, 0); } while (0)
  CMPL2_LOAD(0, 0);
#pragma unroll 1
  for (int ks = 0; ks < 16; ks += 2) {
    CMPL2_LOAD(1, ks + 1);
    CMPL2_MMA(0);
    if (ks + 2 < 16) CMPL2_LOAD(0, ks + 2);
    CMPL2_MMA(1);
  }
#undef CMPL2_LOAD
#undef CMPL2_MMA
#pragma unroll
  for (int r = 0; r < 16; ++r) {
    const int m = m0 + (r & 3) + 8 * (r >> 2) + 4 * hi;
    const bool pad = (m & 127) == 127;
    outkc[(size_t)m * 64 + r32] = pad ? (bf16_t)0 : f2bf(acc0[r]);
    outkc[(size_t)m * 64 + 32 + r32] = pad ? (bf16_t)0 : f2bf(acc1[r]);
  }
}
}

#define XB_TMO      128
#define XB_XCNT(j)  (256  + 64 * (j))
#define XB_XSUB(j)  (1280 + 64 * (j))
#define XB_XGEN(j)  (2304 + 64 * (j))
#define XB_TOP      3328
#define XB_TOPGEN   3392
#define XCD_BAR_WORDS 3456
#define XB_SPIN_CAP (1u << 18)
#ifndef LAS
#define LAS __attribute__((address_space(3)))
#endif

__device__ __forceinline__ unsigned xb_ld(unsigned* p)              { return __hip_atomic_load(p, __ATOMIC_RELAXED, __HIP_MEMORY_SCOPE_AGENT); }
__device__ __forceinline__ unsigned xb_add(unsigned* p, unsigned v) { return __hip_atomic_fetch_add(p, v, __ATOMIC_RELAXED, __HIP_MEMORY_SCOPE_AGENT); }
__device__ __forceinline__ unsigned xb_xcc_id() { return (unsigned)__builtin_amdgcn_s_getreg((3 << 11) | 20) & 0xFu; }
#define XB_SPIN(cond, bar) do { unsigned _sp = 0; while (cond) { __builtin_amdgcn_s_sleep(1); \
    if ((++_sp & 255u) == 0u) { if (xb_ld(&(bar)[XB_TMO])) break; if (_sp > XB_SPIN_CAP) { atomicAdd(&(bar)[XB_TMO], 1u); break; } } } } while (0)

struct XcdBarrier {
    unsigned* bar; unsigned x;
    volatile LAS unsigned* st;
};

__device__ __forceinline__ XcdBarrier xcd_barrier_post(unsigned* bar, volatile LAS unsigned* st) {
    XcdBarrier b; b.bar = bar; b.x = xb_xcc_id(); b.st = st;
    if (threadIdx.x == 0) (void)xb_add(&bar[XB_XCNT(b.x)], 1u);
    return b;
}
__device__ __forceinline__ void xcd_barrier_complete(unsigned* bar, unsigned x, unsigned& nloc, unsigned& nx) {
    const unsigned G = gridDim.x * gridDim.y * gridDim.z;
    unsigned sum, cnt, mine, sp = 0u;
    for (;;) {
        sum = 0u; cnt = 0u; mine = 0u;
#pragma unroll
        for (unsigned j = 0; j < 16; ++j) { const unsigned c = xb_ld(&bar[XB_XCNT(j)]); sum += c; cnt += (c > 0u) ? 1u : 0u; mine = (j == x) ? c : mine; }
        if (sum == G) break;
        __builtin_amdgcn_s_sleep(1);
        if ((++sp & 255u) == 0u) { if (xb_ld(&bar[XB_TMO])) break; if (sp > XB_SPIN_CAP) { atomicAdd(&bar[XB_TMO], 1u); break; } }
    }
    nloc = mine > 0u ? mine : 1u; nx = cnt > 0u ? cnt : 1u;
}

__device__ __forceinline__ void xcd_barrier(const XcdBarrier& b) {
    asm volatile("s_waitcnt vmcnt(0)" ::: "memory");
    __syncthreads();
    if (threadIdx.x == 0) {
        unsigned* bar = b.bar;
        __builtin_amdgcn_s_waitcnt(0);
        unsigned nloc = b.st[0], nx = b.st[1];
        if (nloc == 0u) { xcd_barrier_complete(bar, b.x, nloc, nx); b.st[0] = nloc; b.st[1] = nx; }
        const unsigned old = xb_add(&bar[XB_XSUB(b.x)], 1u);
        const unsigned gen = old / nloc;
        if (old + 1u == (gen + 1u) * nloc) {
            __builtin_amdgcn_fence(__ATOMIC_RELEASE, "agent");
            asm volatile("s_waitcnt vmcnt(0)" ::: "memory");
            const unsigned og = xb_add(&bar[XB_TOP], 1u);
            const unsigned tg = og / nx;
            if (og + 1u == (tg + 1u) * nx) xb_add(&bar[XB_TOPGEN], 1u);
            else XB_SPIN(xb_ld(&bar[XB_TOPGEN]) == tg, bar);
            __builtin_amdgcn_fence(__ATOMIC_ACQUIRE, "agent");
            xb_add(&bar[XB_XGEN(b.x)], 1u);
            asm volatile("s_waitcnt vmcnt(0)" ::: "memory");
        } else {
            XB_SPIN(xb_ld(&bar[XB_XGEN(b.x)]) == gen, bar);
            __builtin_amdgcn_fence(__ATOMIC_ACQUIRE, "agent");
            asm volatile("s_waitcnt vmcnt(0)" ::: "memory");
        }
    }
    __syncthreads();
}

struct Args { const float* in[23]; float* out; char* ws; };
constexpr int LDS_BYTES = 131072 + 4096;

typedef const __attribute__((address_space(4))) Args* kargs_t;
DEV kargs_t KA() { kargs_t k = (kargs_t)__builtin_amdgcn_kernarg_segment_ptr(); asm volatile("" : "+s"(k)); return k; }
#define WSP(type, off) ((type*)(ws + (off)))

__global__ __launch_bounds__(NTHR, 2) void mega(Args a) {
  extern __shared__ __attribute__((aligned(16))) char lds[];
  cg::grid_group grid = cg::this_grid();
  PG8_LAS unsigned char* glds = (PG8_LAS unsigned char*)lds;
  const int bid = blockIdx.x, G = gridDim.x;
  (void)a;
  volatile LAS unsigned* bst = (volatile LAS unsigned*)((LAS char*)lds + LDS_BYTES - 16);
  if (threadIdx.x < 4) bst[threadIdx.x] = 0u;
  __syncthreads();
  XcdBarrier xbar; { kargs_t k = KA(); xbar = xcd_barrier_post((unsigned*)k->ws, bst); }

  { kargs_t k = KA(); char* ws = k->ws;
    const int wv0_ = threadIdx.x >> 6;
    if (wv0_ < 4) { const int lane_ = threadIdx.x & 63, wv_ = wv0_, gw_ = bid * 4 + wv_, nw_ = G * 4;
      __attribute__((address_space(3))) float* scr = (__attribute__((address_space(3))) float*)((__attribute__((address_space(3))) char*)lds + wv_ * 8448);
      constexpr int I_IN = 16 * 120, I_BR = 8 * 32, I_SQ = 16 * 32, I_C1 = 32 * 8, I_C2 = 4 * 8, I_UQ = 4 * 24, I_UKV = 2 * 32;
      constexpr int NITEMS = I_IN + 2 * I_BR + 2 * I_SQ + 2 * I_C1 + 2 * I_C2 + I_UQ + I_UKV;
      for (int it = gw_; it < NITEMS; it += nw_) {
        int r = it;
        if (r < I_IN) { tr_item<1>(k->in[2], 1024, IN_COLS, WSP(bf16_t, WS_WIN), 120, 3840, scr, r, lane_); continue; } r -= I_IN;
        if (r < I_BR) { tr_item<0>(k->in[13], 512, 1024, WSP(bf16_t, WS_WBN), 32, 1024, scr, r, lane_); continue; } r -= I_BR;
        if (r < I_BR) { tr_item<0>(k->in[14], 512, 1024, WSP(bf16_t, WS_WBM), 32, 1024, scr, r, lane_); continue; } r -= I_BR;
        if (r < I_SQ) { tr_item<0>(k->in[15], 1024, 1024, WSP(bf16_t, WS_WOUT), 32, 1024, scr, r, lane_); continue; } r -= I_SQ;
        if (r < I_SQ) { tr_item<0>(k->in[17], 1024, 1024, WSP(bf16_t, WS_WQ), 32, 1024, scr, r, lane_); continue; } r -= I_SQ;
        if (r < I_C1) { tr_item<0>(k->in[5], 2048, 256, WSP(bf16_t, WS_CKW1), 8, 256, scr, r, lane_); continue; } r -= I_C1;
        if (r < I_C1) { tr_item<0>(k->in[7], 2048, 256, WSP(bf16_t, WS_CVW1), 8, 256, scr, r, lane_); continue; } r -= I_C1;
        if (r < I_C2) { tr_item<0>(k->in[6], 256, 64, WSP(bf16_t, WS_CKW2), 8, 64, scr, r, lane_); continue; } r -= I_C2;
        if (r < I_C2) { tr_item<0>(k->in[8], 256, 64, WSP(bf16_t, WS_CVW2), 8, 64, scr, r, lane_); continue; } r -= I_C2;
        if (r < I_UQ) { tr_item<0>(k->in[11], 256, 768, WSP(bf16_t, WS_UQ), 24, 768, scr, r, lane_); continue; } r -= I_UQ;
        tr_item<0>(k->in[12], 128, 1024, WSP(bf16_t, WS_UKV), 32, 1024, scr, r, lane_);
      }
      for (int i = gw_ * 64 + lane_; i < 16 * 128 * 64; i += nw_ * 64) WSP(bf16_t, WS_SUBK)[i] = f2bf(k->in[18][i]);
      for (int i = gw_ * 64 + lane_; i < SEQ * 16; i += nw_ * 64) rope_entry(WSP(float2, WS_ROPE), i);
    } else ph_rms1024<false>(k->in[0], k->in[1], WSP(bf16_t, WS_XN), T, nullptr, nullptr, bid * 4 + (wv0_ - 4), G * 4); }
  grid.sync();
  { kargs_t k = KA(); char* ws = k->ws;
    pg8::Gemm g{WSP(bf16_t, WS_XN), WSP(bf16_t, WS_WIN), T, 3840, 1024}; pg8::StaticOrder S; S.init(T, 3840, G, bid);
    pg8::EpiInProjF E{WSP(bf16_t, WS_PROJ), WSP(unsigned char, WS_GATES)};
    pg8::gemm_phase<pg8::EpiInProjF, pg8::StaticOrder, PG8_ALIGN, PG8_SP2>(glds, g, S, E); }
  xcd_barrier(xbar);
  { kargs_t k = KA(); char* ws = k->ws;
    const int lane_ = threadIdx.x & 63, wv_ = threadIdx.x >> 6;
    if (G >= 128 && bid < 64) {
      const int tab = bid >> 5;
      pg8::Gemm g{WSP(bf16_t, WS_PROJ) + PC_KV + tab * 128, WSP(bf16_t, tab ? WS_CVW1 : WS_CKW1), 2048, 1024, 512};
      g.pitchA = 16u * PROJ_LD * 2u; g.kstepA = PROJ_LD * 2u; g.hstepA = 128; g.tA_pm = (size_t)SEQ * PROJ_LD * 2; g.tA_pn = (size_t)8 * PROJ_LD * 2;
      g.pitchB = 4096u; g.kstepB = 128u; g.hstepB = (size_t)128 * 4096; g.tB_pn = 1024; g.nt = 8;
      pg8::StaticOrder S; S.init(2048, 1024, 32, bid & 31);
      pg8::EpiSlabF E{WSP(float, WS_SLAB) + (size_t)tab * 4 * 2048 * 256};
      pg8::gemm_phase<pg8::EpiSlabF, pg8::StaticOrder, PG8_ALIGN, PG8_SP2>(glds, g, S, E);
    } else {
      const int nb = (G >= 128) ? G - 64 : G, b0 = (G >= 128) ? bid - 64 : bid;
      prep::cmp_bias(k->in[3], k->in[4], WSP(bf16_t, WS_CKW1), WSP(bf16_t, WS_CVW1), WSP(float, WS_CPOS), b0 * NWV + wv_, nb * NWV, lane_);
      prep::latent_rows(WSP(bf16_t, WS_PROJ), k->in[9], k->in[10], WSP(float2, WS_ROPE), WSP(bf16_t, WS_CQN), WSP(bf16_t, WS_CKVN), WSP(bf16_t, WS_KROPE), b0 * NWV + wv_, nb * NWV, lane_);
    } }
  xcd_barrier(xbar);
  { kargs_t k = KA(); char* ws = k->ws;
    pg8::Gemm g{WSP(bf16_t, WS_CQN), WSP(bf16_t, WS_UQ), T, 768, 256}; pg8::StaticOrder S; S.init(T, 768, G, (bid + 64) & 255);
    pg8::EpiMlaQF E{WSP(bf16_t, WS_MLAQ), WSP(float2, WS_ROPE)};
    pg8::gemm_phase<pg8::EpiMlaQF, pg8::StaticOrder, PG8_ALIGN, PG8_SP2>(glds, g, S, E); }
  { kargs_t k = KA(); char* ws = k->ws;
    pg8::Gemm g{WSP(bf16_t, WS_CKVN), WSP(bf16_t, WS_UKV), T, 1024, 128}; pg8::StaticOrder S; S.init(T, 1024, G, bid);
    pg8::EpiBf16<0> E{WSP(bf16_t, WS_MLAKV), 1024, nullptr, 0, 0, 1.f};
    pg8::gemm_phase<pg8::EpiBf16<0>, pg8::StaticOrder, PG8_ALIGN, PG8_SP2>(glds, g, S, E); }
  { kargs_t k = KA(); char* ws = k->ws;
    const int lane_ = threadIdx.x & 63, wv_ = threadIdx.x >> 6;
    for (int it = (wv_ == 0) ? (G - 1 - bid) : 128; it < 128; it += G) {
      const int tab = it >> 6;
      prep::cmp_l2(WSP(float, WS_SLAB) + (size_t)tab * 4 * 2048 * 256, WSP(float, WS_CPOS) + tab * 256, WSP(bf16_t, tab ? WS_CVW2 : WS_CKW2), WSP(bf16_t, tab ? WS_VC : WS_KC), it & 63, lane_);
    } }
  xcd_barrier(xbar);
  { kargs_t k = KA(); char* ws = k->ws;
    att::attn_phase(WSP(bf16_t, WS_PROJ), WSP(bf16_t, WS_KC), WSP(bf16_t, WS_VC), k->in[21], WSP(bf16_t, WS_ONSA),
                    WSP(bf16_t, WS_MLAQ), WSP(bf16_t, WS_MLAKV), WSP(bf16_t, WS_KROPE), WSP(bf16_t, WS_OMLA), (att::lptr)lds); }
  xcd_barrier(xbar);
  { kargs_t k = KA(); char* ws = k->ws;
    pg8::Gemm g{WSP(bf16_t, WS_ONSA), WSP(bf16_t, WS_WBN), T, 1024, 512}; pg8::StaticOrder S; S.init(T, 1024, G, bid);
    pg8::EpiMergeF<0> E{WSP(unsigned char, WS_GATES), WSP(bf16_t, WS_MERGED)};
    pg8::gemm_phase<pg8::EpiMergeF<0>, pg8::StaticOrder, PG8_ALIGN, PG8_SP2>(glds, g, S, E); }
  { kargs_t k = KA(); char* ws = k->ws;
    pg8::Gemm g{WSP(bf16_t, WS_OMLA), WSP(bf16_t, WS_WBM), T, 1024, 512}; pg8::StaticOrder S; S.init(T, 1024, G, bid);
    pg8::EpiMergeF<1> E{WSP(unsigned char, WS_GATES), WSP(bf16_t, WS_MERGED)};
    pg8::gemm_phase<pg8::EpiMergeF<1>, pg8::StaticOrder, PG8_ALIGN, PG8_SP2>(glds, g, S, E); }
  xcd_barrier(xbar);
  { kargs_t k = KA(); char* ws = k->ws;
    pg8::Gemm g{WSP(bf16_t, WS_MERGED), WSP(bf16_t, WS_WOUT), T, 1024, 1024}; pg8::StaticOrder S; S.init(T, 1024, G, bid);
    pg8::EpiBf16<0> E{WSP(bf16_t, WS_OB), 1024, nullptr, 0, 0, 1.f};
    pg8::gemm_phase<pg8::EpiBf16<0>, pg8::StaticOrder, PG8_ALIGN, PG8_SP2>(glds, g, S, E); }
  xcd_barrier(xbar);
  { kargs_t k = KA(); char* ws = k->ws; ph_rms1024<true>(k->in[0], k->in[16], WSP(bf16_t, WS_HN), T, WSP(unsigned, WS_HN8), WSP(float, WS_SH), -1, 0, WSP(bf16_t, WS_OB));
    peer::conv_tables(k->in[19], k->in[20], WSP(unsigned, WS_U8), WSP(float, WS_SU), WSP(unsigned, WS_V8)); }
  xcd_barrier(xbar);
  { kargs_t k = KA(); char* ws = k->ws;
    pg8::Gemm g{WSP(bf16_t, WS_HN), WSP(bf16_t, WS_WQ), T, 1024, 1024}; pg8::StaticOrder S; S.init(T, 1024, G, bid);
    pg8::EpiBf16<0> E{WSP(bf16_t, WS_PQ), 1024, nullptr, 0, 0, 1.f};
    pg8::gemm_phase<pg8::EpiBf16<0>, pg8::StaticOrder, PG8_ALIGN, PG8_SP2>(glds, g, S, E); }
  xcd_barrier(xbar);
  { kargs_t k = KA(); char* ws = k->ws; peer::route_phase(WSP(bf16_t, WS_PQ), WSP(bf16_t, WS_SUBK), WSP(unsigned, WS_PIDX), (__attribute__((address_space(3))) char*)lds); }
  xcd_barrier(xbar);
  { kargs_t k = KA(); char* ws = k->ws;
    peer::experts_sliced<0>(WSP(unsigned, WS_PIDX), WSP(unsigned, WS_HN8), WSP(float, WS_SH), WSP(unsigned, WS_U8), WSP(float, WS_SU), WSP(float, WS_CO), WSP(unsigned, WS_V8), k->out, WSP(float, WS_SSQ),
                            (unsigned*)ws + CTL_QA, (__attribute__((address_space(3))) char*)lds); }
  xcd_barrier(xbar);
  { kargs_t k = KA(); char* ws = k->ws;
    peer::experts_sliced<1>(WSP(unsigned, WS_PIDX), WSP(unsigned, WS_HN8), WSP(float, WS_SH), WSP(unsigned, WS_U8), WSP(float, WS_SU), WSP(float, WS_CO), WSP(unsigned, WS_V8), k->out, WSP(float, WS_SSQ),
                            (unsigned*)ws + CTL_QB, (__attribute__((address_space(3))) char*)lds, k->in[0], WSP(bf16_t, WS_OB)); }
  xcd_barrier(xbar);
  { kargs_t k = KA(); char* ws = k->ws; peer::experts_norm(WSP(float, WS_SSQ), k->in[22], k->out); }
}

extern "C" void kernel_launch(void* const* d_in, const int* in_sizes, int n_in, void* d_out, int out_size, void* d_ws, size_t ws_size, hipStream_t stream) {
  if (n_in != 23 || ws_size < 256 * MiB) { fprintf(stderr, "kernel_launch: unexpected n_in %d / ws_size %zu\n", n_in, ws_size); return; }
  static int grid_blocks = 0;
  if (!grid_blocks) {
    int dev = 0, cus = 0, per_cu = 0;
    (void)hipGetDevice(&dev);
    (void)hipDeviceGetAttribute(&cus, hipDeviceAttributeMultiprocessorCount, dev);
    if (hipFuncSetAttribute((const void*)mega, hipFuncAttributeMaxDynamicSharedMemorySize, LDS_BYTES) != hipSuccess) fprintf(stderr, "kernel_launch: hipFuncSetAttribute failed\n");
    (void)hipOccupancyMaxActiveBlocksPerMultiprocessor(&per_cu, (const void*)mega, NTHR, LDS_BYTES);
    if (per_cu < 1) { fprintf(stderr, "kernel_launch: occupancy query returned %d\n", per_cu); per_cu = 1; }
    if (per_cu > 2) per_cu = 2;
    grid_blocks = cus * per_cu;
    fprintf(stderr, "kernel_launch: cus %d per_cu %d grid %d ws %zu\n", cus, per_cu, grid_blocks, ws_size);
  }
  if (hipMemsetAsync(d_ws, 0, 65536, stream) != hipSuccess) fprintf(stderr, "kernel_launch: hipMemsetAsync failed\n");
  Args a{};
  for (int i = 0; i < 23; ++i) a.in[i] = (const float*)d_in[i];
  a.out = (float*)d_out; a.ws = (char*)d_ws;
  void* args[] = {&a};
  hipError_t e = hipLaunchCooperativeKernel((const void*)mega, dim3(grid_blocks), dim3(NTHR), args, LDS_BYTES, stream);
  if (e != hipSuccess) fprintf(stderr, "cooperative launch failed: %s (grid %d)\n", hipGetErrorString(e), grid_blocks);
}
```

```cpp
#include <hip/hip_runtime.h>
#include <stdint.h>
#include <cstdio>
#include <hip/hip_cooperative_groups.h>
namespace cg = cooperative_groups;

typedef unsigned short bf16_t;
#define DEV __device__ __forceinline__

constexpr int BATCH = 8, SEQ = 2048, DM = 1024, T = BATCH * SEQ;
constexpr int IN_COLS = 3768;
constexpr int PROJ_LD = 1792;
constexpr int PC_Q = 0, PC_KV = 512, PC_CQ = 1280, PC_CKV = 1536, PC_KR = 1664, PC_GATE = 1696;
constexpr int NC = 127;
constexpr size_t MiB = 1u << 20;

constexpr size_t WS_WIN = 1 * MiB;
constexpr size_t WS_WBN = 9 * MiB;
constexpr size_t WS_WBM = 10 * MiB;
constexpr size_t WS_WOUT = 11 * MiB;
constexpr size_t WS_WQ = 13 * MiB;
constexpr size_t WS_CKW1 = 15 * MiB;
constexpr size_t WS_CVW1 = 16 * MiB;
constexpr size_t WS_CKW2 = 17 * MiB;
constexpr size_t WS_CVW2 = 17 * MiB + 128 * 1024;
constexpr size_t WS_UQ = 17 * MiB + 256 * 1024;
constexpr size_t WS_UKV = 17 * MiB + 768 * 1024;
constexpr size_t WS_SUBK = 18 * MiB;
constexpr size_t WS_ROPE = 18 * MiB + 512 * 1024;
constexpr size_t WS_GATES = 20 * MiB;
constexpr size_t WS_PQ = 20 * MiB;
constexpr size_t WS_ZB = 20 * MiB;
constexpr size_t WS_OB = 52 * MiB;
constexpr size_t WS_PROJ = 84 * MiB;
constexpr size_t WS_MERGED = 84 * MiB;
constexpr size_t WS_PIDX = 84 * MiB;
constexpr size_t WS_U8 = 172 * MiB;
constexpr size_t WS_V8 = 188 * MiB;
constexpr size_t WS_SU = 204 * MiB;
constexpr size_t WS_SH = 204 * MiB + 65536;
constexpr size_t WS_HN8 = 205 * MiB;
constexpr size_t WS_CO = 221 * MiB;
constexpr size_t WS_SSQ = 229 * MiB;
constexpr int CTL_QA = 4096, CTL_QB = 4096 + 512;
constexpr size_t WS_PW = 92 * MiB;
constexpr size_t WS_XN = 140 * MiB;
constexpr size_t WS_MLAKV = 140 * MiB;
constexpr size_t WS_HN = 140 * MiB;
constexpr size_t WS_MLAQ = 172 * MiB;
constexpr size_t WS_KROPE = 196 * MiB;
constexpr size_t WS_KC = 197 * MiB;
constexpr size_t WS_VC = 197 * MiB + 512 * 1024;
constexpr size_t WS_ONSA = 198 * MiB;
constexpr size_t WS_OMLA = 214 * MiB;
constexpr size_t WS_SLAB = 198 * MiB;
constexpr size_t WS_CPOS = 18 * MiB + 768 * 1024;
constexpr size_t WS_CA = 198 * MiB;
constexpr size_t WS_HID = 206 * MiB;
constexpr size_t WS_HID2 = 207 * MiB;
constexpr size_t WS_CA2 = 214 * MiB;
constexpr size_t WS_CQN = 230 * MiB;
constexpr size_t WS_CKVN = 238 * MiB;
constexpr size_t WS_OCMP = 230 * MiB;
constexpr size_t WS_SEL = 246 * MiB;

__device__ const unsigned char T5B[128] = {
  0, 1, 2, 3, 4, 5, 6, 7, 8, 9, 10, 11, 12, 13, 14, 15, 16, 16, 16, 17, 17, 18, 18, 18, 19, 19, 19, 20, 20, 20, 20, 21,
  21, 21, 21, 22, 22, 22, 22, 22, 23, 23, 23, 23, 23, 23, 24, 24, 24, 24, 24, 24, 25, 25, 25, 25, 25, 25, 25, 26, 26, 26, 26, 26,
  26, 26, 26, 27, 27, 27, 27, 27, 27, 27, 27, 27, 27, 28, 28, 28, 28, 28, 28, 28, 28, 28, 28, 29, 29, 29, 29, 29, 29, 29, 29, 29,
  29, 29, 29, 30, 30, 30, 30, 30, 30, 30, 30, 30, 30, 30, 30, 30, 30, 31, 31, 31, 31, 31, 31, 31, 31, 31, 31, 31, 31, 31, 31, 31};

DEV float bf2f(bf16_t v) { return __uint_as_float(((unsigned)v) << 16); }
DEV bf16_t f2bf(float f) { unsigned u = __float_as_uint(f); u += 0x7fffu + ((u >> 16) & 1u); return (bf16_t)(u >> 16); }
template <int CTRL> DEV int dpp_i(int v) { return __builtin_amdgcn_update_dpp(0, v, CTRL, 0xF, 0xF, true); }
template <int CTRL> DEV float dpp_f(float v) { return __uint_as_float((unsigned)__builtin_amdgcn_update_dpp(0, (int)__float_as_uint(v), CTRL, 0xF, 0xF, true)); }
DEV int sum16_i(int v) { v += dpp_i<0xB1>(v); v += dpp_i<0x4E>(v); v += dpp_i<0x141>(v); v += dpp_i<0x140>(v); return v; }
DEV float sum16_f(float v) { v += dpp_f<0xB1>(v); v += dpp_f<0x4E>(v); v += dpp_f<0x141>(v); v += dpp_f<0x140>(v); return v; }
DEV float max16_f(float v) { v = fmaxf(v, dpp_f<0xB1>(v)); v = fmaxf(v, dpp_f<0x4E>(v)); v = fmaxf(v, dpp_f<0x141>(v)); v = fmaxf(v, dpp_f<0x140>(v)); return v; }
DEV float rl_f(float v, int l) { return __uint_as_float((unsigned)__builtin_amdgcn_readlane((int)__float_as_uint(v), l)); }
DEV float wsum(float v) { v = sum16_f(v); return (rl_f(v, 0) + rl_f(v, 16)) + (rl_f(v, 32) + rl_f(v, 48)); }
DEV float wmaxf(float v) { v = max16_f(v); return fmaxf(fmaxf(rl_f(v, 0), rl_f(v, 16)), fmaxf(rl_f(v, 32), rl_f(v, 48))); }
DEV float sigmoidf_(float x) { return 1.0f / (1.0f + expf(-x)); }
DEV float gelu_exact(float x) { return 0.5f * x * (1.0f + erff(x * 0.70710678118654752f)); }
DEV void wave_lds_sync() { asm volatile("s_waitcnt lgkmcnt(0)" ::: "memory"); __builtin_amdgcn_wave_barrier(); asm volatile("" ::: "memory"); }
DEV float t5bias(const float* t5, int head, int dist) { int d = dist < 127 ? dist : 127; d = d < 0 ? 0 : d; return t5[(int)T5B[d] * 8 + head]; }


namespace pg8 {
#define PG8_LAS __attribute__((address_space(3)))
typedef unsigned short bf16_t;
typedef short bf16x8 __attribute__((ext_vector_type(8)));
typedef float f32x4 __attribute__((ext_vector_type(4)));
typedef unsigned u32x4 __attribute__((ext_vector_type(4)));
constexpr int BM = 256, BK = 64, HALF = 128, HTB = HALF * BK * 2  , STAGE_BYTES = 8 * HTB, NXCD = 8, WGM = 8;

__host__ __device__ __forceinline__ int lds_byte(int r, int c) { const int st = (r >> 4) * 2 + (c >> 5), rr = r & 15, cc = c & 31, ob = rr * 64 + cc * 2; return st * 1024 + (ob ^ (((ob >> 9) & 1) << 5)); }
__host__ __device__ __forceinline__ void stage_rc(int b, int& R, int& C) { const int st = b / 1024, sb = b % 1024, swz = sb ^ (((sb >> 9) & 1) << 5); R = (st >> 1) * 16 + swz / 64; C = (st & 1) * 32 + (swz % 64) / 2; }
__host__ __device__ __forceinline__ int perm32(int rho) { const int n = rho >> 4, i = rho & 15; return 8 * (i >> 2) + 4 * n + (i & 3); }

struct Unit { int pm, pn; };
struct Gemm { const bf16_t* A; const bf16_t* Bt; int M, N, K;
    unsigned pitchA = 0, pitchB = 0, kstepA = 0, kstepB = 0; size_t hstepA = 0, hstepB = 0, tA_pm = 0, tA_pn = 0, tB_pn = 0; int nt = 0; };

struct StaticOrder {
    int nM, nN, nwg, G, c;
    __host__ __device__ void init(int M, int N, int G_, int c_) { nM = M / BM; nN = N / BM; nwg = nM * nN; G = G_; c = c_; }
    __host__ __device__ bool next(int i, Unit& u) const {
        const long L = (long)i * G + c; if (L >= nwg) return false;
        int wgid = (int)L; { const int q = nwg / NXCD, r = nwg % NXCD, xcd = wgid % NXCD, off = wgid / NXCD; wgid = (xcd < r ? xcd * (q + 1) : r * (q + 1) + (xcd - r) * q) + off; }
        const int nig = WGM * nN, gid = wgid / nig, fm = gid * WGM, gsz = (nM - fm) < WGM ? (nM - fm) : WGM;
        u.pm = fm + ((wgid % nig) % gsz); u.pn = (wgid % nig) / gsz; return true;
    }
    __device__ __forceinline__ void a_ready(const Unit&) const {}
    __device__ __forceinline__ void done(const Unit&) const {}
};

__device__ __forceinline__ unsigned cvt_pk_bf16(float lo, float hi) { unsigned r; asm volatile("v_cvt_pk_bf16_f32 %0, %1, %2" : "=v"(r) : "v"(lo), "v"(hi)); return r; }
typedef float f32x2 __attribute__((ext_vector_type(2)));
__device__ __forceinline__ f32x2 gelu_pk(f32x2 v) {
    const f32x2 av = __builtin_elementwise_abs(v), d = av * 0.2316418882f + 1.0f;
    f32x2 t; t.x = __builtin_amdgcn_rcpf(d.x); t.y = __builtin_amdgcn_rcpf(d.y);
    f32x2 q = t * 0.5307027145f + (-0.7265760135f); q = q * t + 0.7107068705f; q = q * t + (-0.142248368f); q = q * t + 0.127414796f; q = q * t;
    const f32x2 s = (v * v) * (-0.72134752044f);
    f32x2 e; e.x = __builtin_amdgcn_exp2f(s.x); e.y = __builtin_amdgcn_exp2f(s.y);
    const f32x2 m = v * (q * e), r = v - m;
    f32x2 o; o.x = v.x < 0.f ? m.x : r.x; o.y = v.y < 0.f ? m.y : r.y; return o;
}

template <int ACT  > struct EpiBf16 {
    static constexpr bool PERM = true, AFTER_DRAIN = false; static_assert(ACT == 0 || ACT == 1, "EpiBf16: ACT is 0 (none) or 1 (gelu_pk)");
    bf16_t* O; int ldc; const float* bias; int split_cols; size_t split_stride; float scale0;
    __device__ __forceinline__ void operator()(const f32x4 (&acc)[2][2][4][2], const Unit& u, int wr, int wc, int fr, int fq) const {
        const int row0 = u.pm * BM + wr * 64 + fr; int colt = u.pn * BM; bf16_t* base = O;
        float sc = 1.f; if (split_cols) { const int t = colt / split_cols; base += (size_t)t * split_stride; colt -= t * split_cols; if (t == 0) sc = scale0; }
        const int col0 = colt + wc * 32 + 8 * fq, bcol0 = u.pn * BM + wc * 32 + 8 * fq;
        f32x4 bv[2][2];
#pragma unroll
        for (int bj = 0; bj < 2; ++bj)
#pragma unroll
            for (int n = 0; n < 2; ++n) bv[bj][n] = bias ? *(const f32x4*)(bias + bcol0 + bj * HALF + 4 * n) : (f32x4){0.f, 0.f, 0.f, 0.f};
#pragma unroll
        for (int ai = 0; ai < 2; ++ai)
#pragma unroll
            for (int m = 0; m < 4; ++m) { bf16_t* rowp = base + (size_t)(row0 + ai * HALF + m * 16) * ldc + col0;
#pragma unroll
                for (int bj = 0; bj < 2; ++bj) { f32x4 v0 = acc[ai][bj][m][0] + bv[bj][0], v1 = acc[ai][bj][m][1] + bv[bj][1];
                    if (ACT == 1) { f32x2 a = gelu_pk((f32x2){v0[0], v0[1]}), b = gelu_pk((f32x2){v0[2], v0[3]}), c = gelu_pk((f32x2){v1[0], v1[1]}), d = gelu_pk((f32x2){v1[2], v1[3]});
                        v0 = (f32x4){a.x, a.y, b.x, b.y}; v1 = (f32x4){c.x, c.y, d.x, d.y}; }
                    v0 = v0 * sc; v1 = v1 * sc; u32x4 w; w.x = cvt_pk_bf16(v0[0], v0[1]); w.y = cvt_pk_bf16(v0[2], v0[3]); w.z = cvt_pk_bf16(v1[0], v1[1]); w.w = cvt_pk_bf16(v1[2], v1[3]);
                    *(u32x4*)(rowp + bj * HALF) = w; } }
    }
};

struct PanelStats {
    unsigned* xbuf;
    unsigned* cnt;
    unsigned* tmo;
    int ntn; float eps;
    unsigned code;
    __device__ __forceinline__ bool run(const f32x4 (&v)[2][2][4][2], const Unit& u, int wr, int wc, int fr, int fq, PG8_LAS unsigned char* lds, int wid, int lane) const {
        typedef float f32x2v __attribute__((ext_vector_type(2)));
        PG8_LAS f32x2v* P = (PG8_LAS f32x2v*)lds;
        PG8_LAS f32x2v* S = (PG8_LAS f32x2v*)(lds + 8192);
        PG8_LAS unsigned* flag = (PG8_LAS unsigned*)(lds + 8192 + 2048);
#pragma unroll
        for (int ai = 0; ai < 2; ++ai)
#pragma unroll
            for (int m = 0; m < 4; ++m) {
                float s = 0.f;
#pragma unroll
                for (int bj = 0; bj < 2; ++bj)
#pragma unroll
                    for (int n = 0; n < 2; ++n) { const f32x4 x = v[ai][bj][m][n]; s += (x[0] + x[1]) + (x[2] + x[3]); }
                s += __shfl_xor(s, 16); s += __shfl_xor(s, 32);
                const float mw = s * (1.0f / 64.0f); float q = 0.f;
#pragma unroll
                for (int bj = 0; bj < 2; ++bj)
#pragma unroll
                    for (int n = 0; n < 2; ++n) { const f32x4 d = v[ai][bj][m][n] - mw; q += (d[0] * d[0] + d[1] * d[1]) + (d[2] * d[2] + d[3] * d[3]); }
                q += __shfl_xor(q, 16); q += __shfl_xor(q, 32);
                if (fq == 0) P[(ai * HALF + wr * 64 + m * 16 + fr) * 4 + wc] = (f32x2v){mw, q};
            }
        asm volatile("s_waitcnt lgkmcnt(0)" ::: "memory"); __builtin_amdgcn_s_barrier(); asm volatile("" ::: "memory");
#if defined(BROKEN_EXCHANGE_NO_WAIT)
#warning BROKEN CONTROL BUILD: the row-statistics exchange does not wait; results are wrong by design
        if (blockIdx.x >= 64) { const long long t0_ = clock64(); while (clock64() - t0_ < 60000) __builtin_amdgcn_s_sleep(8); }
#endif
        const int row = wid * 32 + (lane & 31);
        if (lane < 32) {
            const f32x2v a = P[row * 4 + 0], b = P[row * 4 + 1], c = P[row * 4 + 2], d = P[row * 4 + 3];
            const float mt = (a.x + b.x + c.x + d.x) * 0.25f;
            const float da = a.x - mt, db = b.x - mt, dc = c.x - mt, dd = d.x - mt;
            const float m2 = (a.y + b.y) + (c.y + d.y) + 64.0f * ((da * da + db * db) + (dc * dc + dd * dd));
            unsigned long long* slot = (unsigned long long*)xbuf + ((size_t)(u.pm * BM + row) * 4 + u.pn);
            __hip_atomic_store(slot, ((unsigned long long)__float_as_uint(m2) << 32) | __float_as_uint(mt), __ATOMIC_RELAXED, __HIP_MEMORY_SCOPE_AGENT);
        }
        asm volatile("s_waitcnt vmcnt(0)" ::: "memory");
        if (lane == 0) __hip_atomic_fetch_add(cnt + 64 * u.pm, 1u, __ATOMIC_RELAXED, __HIP_MEMORY_SCOPE_AGENT);
        if (wid == 0) {
            bool dead = false; const unsigned long long t0 = __builtin_amdgcn_s_memrealtime(); const unsigned want = 8u * (unsigned)ntn;
            for (;;) {
#if defined(BROKEN_EXCHANGE_NO_WAIT)
                break;
#endif
                if ((unsigned)__builtin_amdgcn_readfirstlane(__hip_atomic_load(cnt + 64 * u.pm, __ATOMIC_RELAXED, __HIP_MEMORY_SCOPE_AGENT)) >= want) break;
                if (__builtin_amdgcn_s_memrealtime() - t0 > 2000000ull) {
                    if (lane == 0) { unsigned expect = 0u; __hip_atomic_compare_exchange_strong(tmo + 1, &expect, code | (unsigned)(u.pm & 0xff), __ATOMIC_RELAXED, __ATOMIC_RELAXED, __HIP_MEMORY_SCOPE_AGENT);
                                     __hip_atomic_store(tmo, 1u, __ATOMIC_RELAXED, __HIP_MEMORY_SCOPE_AGENT); }
                    dead = true; break; }
                __builtin_amdgcn_s_sleep(2);
            }
            __builtin_amdgcn_fence(__ATOMIC_ACQUIRE, "agent");
            if (lane == 0) flag[0] = dead ? 1u : 0u;
        }
        asm volatile("s_waitcnt vmcnt(0) lgkmcnt(0)" ::: "memory"); __builtin_amdgcn_s_barrier(); asm volatile("" ::: "memory");
        const bool bad = flag[0] != 0u;
        if (lane < 32) {
            const unsigned long long* slot = (const unsigned long long*)xbuf + (size_t)(u.pm * BM + row) * 4; float mt[4], m2[4]; float ms = 0.f;
#pragma unroll
            for (int t = 0; t < 4; ++t) { if (t < ntn) { const unsigned long long w = __hip_atomic_load(slot + t, __ATOMIC_RELAXED, __HIP_MEMORY_SCOPE_AGENT); mt[t] = __uint_as_float((unsigned)w); m2[t] = __uint_as_float((unsigned)(w >> 32)); } else { mt[t] = 0.f; m2[t] = 0.f; } ms += mt[t]; }
            const float mean = ms / (float)ntn; float q = 0.f;
#pragma unroll
            for (int t = 0; t < 4; ++t) if (t < ntn) { const float dm = mt[t] - mean; q += m2[t] + 256.0f * dm * dm; }
            S[row] = (f32x2v){mean, 1.0f / sqrtf(q / (256.0f * (float)ntn) + eps)};
        }
        asm volatile("s_waitcnt lgkmcnt(0)" ::: "memory"); __builtin_amdgcn_s_barrier(); asm volatile("" ::: "memory");
        return bad;
    }
};
struct EpiLnRes {
    static constexpr bool PERM = false, AFTER_DRAIN = true;
    const float* base; float* out; int ldc; const float* bias; PanelStats st; unsigned poison;
    __device__ __forceinline__ void fused(f32x4 (&acc)[2][2][4][2], const Unit& u, int wr, int wc, int fr, int fq, PG8_LAS unsigned char* lds, int wid, int lane) const {
        typedef float f32x2v __attribute__((ext_vector_type(2)));
        const PG8_LAS f32x2v* S = (const PG8_LAS f32x2v*)(lds + 8192);
        const int col0 = u.pn * BM + wc * 32 + 4 * fq;
#pragma unroll
        for (int bj = 0; bj < 2; ++bj)
#pragma unroll
            for (int n = 0; n < 2; ++n) { const f32x4 bv = bias ? *(const f32x4*)(bias + col0 + bj * HALF + n * 16) : (f32x4){0.f, 0.f, 0.f, 0.f};
#pragma unroll
                for (int ai = 0; ai < 2; ++ai)
#pragma unroll
                    for (int m = 0; m < 4; ++m) acc[ai][bj][m][n] += bv; }
        f32x4 pre[4][2][2];
#pragma unroll
        for (int m = 0; m < 4; ++m) { const size_t off = (size_t)(u.pm * BM + wr * 64 + m * 16 + fr) * ldc + col0;
#pragma unroll
            for (int bj = 0; bj < 2; ++bj)
#pragma unroll
                for (int n = 0; n < 2; ++n) pre[m][bj][n] = *(const f32x4*)(base + off + bj * HALF + n * 16); }
        const bool bad = st.run(acc, u, wr, wc, fr, fq, lds, wid, lane) || poison != 0u;
        const float qnan = __builtin_nanf("");
#pragma unroll
        for (int ai = 0; ai < 2; ++ai)
#pragma unroll
            for (int m = 0; m < 4; ++m) { const int r = ai * HALF + wr * 64 + m * 16 + fr; const f32x2v sr = S[r]; const size_t off = (size_t)(u.pm * BM + r) * ldc + col0;
#pragma unroll
                for (int bj = 0; bj < 2; ++bj)
#pragma unroll
                    for (int n = 0; n < 2; ++n) { const f32x4 bs = ai == 0 ? pre[m][bj][n] : *(const f32x4*)(base + off + bj * HALF + n * 16); f32x4 o = bs + (acc[ai][bj][m][n] - sr.x) * sr.y;
                        if (bad) o = (f32x4){qnan, qnan, qnan, qnan}; *(f32x4*)(out + off + bj * HALF + n * 16) = o; }
                if (m & 1) asm volatile("" ::: "memory"); }
    }
};
struct EpiLnResLn {
    static constexpr bool PERM = false, AFTER_DRAIN = true;
    const float* base; float* out; bf16_t* xn; int ldc; const float* bias; PanelStats st1, st2; unsigned poison;
    __device__ __forceinline__ void fused(f32x4 (&acc)[2][2][4][2], const Unit& u, int wr, int wc, int fr, int fq, PG8_LAS unsigned char* lds, int wid, int lane) const {
        typedef float f32x2v __attribute__((ext_vector_type(2))); typedef unsigned u32x2v __attribute__((ext_vector_type(2)));
        const PG8_LAS f32x2v* S = (const PG8_LAS f32x2v*)(lds + 8192);
        const int col0 = u.pn * BM + wc * 32 + 4 * fq;
#pragma unroll
        for (int bj = 0; bj < 2; ++bj)
#pragma unroll
            for (int n = 0; n < 2; ++n) { const f32x4 bv = bias ? *(const f32x4*)(bias + col0 + bj * HALF + n * 16) : (f32x4){0.f, 0.f, 0.f, 0.f};
#pragma unroll
                for (int ai = 0; ai < 2; ++ai)
#pragma unroll
                    for (int m = 0; m < 4; ++m) acc[ai][bj][m][n] += bv; }
        bool bad = st1.run(acc, u, wr, wc, fr, fq, lds, wid, lane) || poison != 0u;
        const float qnan = __builtin_nanf("");
#pragma unroll
        for (int ai = 0; ai < 2; ++ai)
#pragma unroll
            for (int m = 0; m < 4; ++m) { const int r = ai * HALF + wr * 64 + m * 16 + fr; const f32x2v sr = S[r]; const size_t off = (size_t)(u.pm * BM + r) * ldc + col0;
#pragma unroll
                for (int bj = 0; bj < 2; ++bj)
#pragma unroll
                    for (int n = 0; n < 2; ++n) { const f32x4 bs = *(const f32x4*)(base + off + bj * HALF + n * 16); acc[ai][bj][m][n] = bs + (acc[ai][bj][m][n] - sr.x) * sr.y; }
                asm volatile("" : "+v"(acc[ai][0][m][0]), "+v"(acc[ai][0][m][1]), "+v"(acc[ai][1][m][0]), "+v"(acc[ai][1][m][1]));
                if (m & 1) asm volatile("" ::: "memory"); }
        const bool bad1 = bad;
        bad = st2.run(acc, u, wr, wc, fr, fq, lds, wid, lane) || bad;
#pragma unroll
        for (int ai = 0; ai < 2; ++ai)
#pragma unroll
            for (int m = 0; m < 4; ++m) { const int r = ai * HALF + wr * 64 + m * 16 + fr; const f32x2v sr = S[r]; const size_t off = (size_t)(u.pm * BM + r) * ldc + col0;
#pragma unroll
                for (int bj = 0; bj < 2; ++bj)
#pragma unroll
                    for (int n = 0; n < 2; ++n) { const f32x4 x1 = acc[ai][bj][m][n]; *(f32x4*)(out + off + bj * HALF + n * 16) = bad1 ? (f32x4){qnan, qnan, qnan, qnan} : x1;
                        const f32x4 o = (x1 - sr.x) * sr.y; u32x2v w; w.x = cvt_pk_bf16(o[0], o[1]); w.y = cvt_pk_bf16(o[2], o[3]);
                        if (bad) { w.x = 0x7fc07fc0u; w.y = 0x7fc07fc0u; } *(u32x2v*)(xn + off + bj * HALF + n * 16) = w; }
                asm volatile("" ::: "memory"); }
    }
};

template <class Epi, class Sched, bool ALIGN_EPI = false, bool SP2 = false>
__device__ __forceinline__ void gemm_phase(PG8_LAS unsigned char* lds, const Gemm g, const Sched& S, const Epi& E) {
    int tid = threadIdx.x; asm volatile("" : "+v"(tid));
    const int wid = __builtin_amdgcn_readfirstlane(tid >> 6), lane = tid & 63, wr = wid >> 2, wc = wid & 3, fr = lane & 15, fq = lane >> 4;
    int K = g.K; asm volatile("" : "+s"(K)); const int nt = g.nt ? g.nt : K / BK;
    const unsigned pitchA = g.pitchA ? g.pitchA : (unsigned)K * 2u, pitchB = g.pitchB ? g.pitchB : (unsigned)K * 2u;
    unsigned voffA[2], voffB[2];
#pragma unroll
    for (int i = 0; i < 2; ++i) { int R, C; stage_rc(tid * 16 + i * 8192, R, C); const int Rb = Epi::PERM ? ((R & ~31) + perm32(R & 31)) : R;
        voffA[i] = (unsigned)R * pitchA + (unsigned)C * 2u; voffB[i] = (unsigned)Rb * pitchB + (unsigned)C * 2u; }
    const size_t kstepA = g.kstepA ? g.kstepA : (size_t)(BK * 2), kstepB = g.kstepB ? g.kstepB : (size_t)(BK * 2);
    const size_t hstepA = g.hstepA ? g.hstepA : (size_t)HALF * K * 2, hstepB = g.hstepB ? g.hstepB : (size_t)HALF * K * 2;
    const size_t tA_pm = g.tA_pm ? g.tA_pm : (size_t)BM * K * 2, tA_pn = g.tA_pn, tB_pn = g.tB_pn ? g.tB_pn : (size_t)BM * K * 2;
    const unsigned ldsw = (unsigned)wid * 1024u;
    const int aoff = lds_byte(wr * 64 + fr, fq * 8), boff = lds_byte(wc * 32 + fr, fq * 8);
#define PG8_SA(b, h) (((b) * 2 + (h)) * HTB)
#define PG8_SB(b, h) ((4 + (b) * 2 + (h)) * HTB)
#define PG8_STAGE(bufoff, gbase, voff) do { _Pragma("unroll") for (int _i = 0; _i < 2; ++_i) \
        __builtin_amdgcn_global_load_lds((const unsigned*)((const char*)(gbase) + (voff)[_i]), (PG8_LAS unsigned*)(lds + (bufoff) + ldsw + _i * 8192), 16, 0, 0); } while (0)
#define PG8_LDA(dst, b, h) do { _Pragma("unroll") for (int m = 0; m < 4; ++m) _Pragma("unroll") for (int k = 0; k < 2; ++k) dst[m][k] = *(const PG8_LAS bf16x8*)(lds + PG8_SA(b, h) + aoff + m * 2048 + k * 1024); } while (0)
#define PG8_LDB(dst, b, h) do { _Pragma("unroll") for (int n = 0; n < 2; ++n) _Pragma("unroll") for (int k = 0; k < 2; ++k) dst[n][k] = *(const PG8_LAS bf16x8*)(lds + PG8_SB(b, h) + boff + n * 2048 + k * 1024); } while (0)
#define PG8_MMA(ai, bj, At, Bt) do { __builtin_amdgcn_s_setprio(1); _Pragma("unroll") for (int m = 0; m < 4; ++m) _Pragma("unroll") for (int n = 0; n < 2; ++n) _Pragma("unroll") for (int k = 0; k < 2; ++k) \
        acc[ai][bj][m][n] = __builtin_amdgcn_mfma_f32_16x16x32_bf16(Bt[n][k], At[m][k], acc[ai][bj][m][n], 0, 0, 0); __builtin_amdgcn_s_setprio(0); } while (0)
#define PG8_WAIT_V(n) asm volatile("s_waitcnt vmcnt(" #n ")" ::: "memory")
#define PG8_WAIT_L(n) asm volatile("s_waitcnt lgkmcnt(" #n ")" ::: "memory")
#define PG8_BAR __builtin_amdgcn_s_barrier()
#define PG8_SCHED __builtin_amdgcn_sched_barrier(0)
    Unit cur, nxt; int ui = 0;
    if (!S.next(0, cur)) return;
    f32x4 acc[2][2][4][2];
#pragma unroll
    for (int a = 0; a < 2; ++a)
#pragma unroll
        for (int b = 0; b < 2; ++b)
#pragma unroll
            for (int m = 0; m < 4; ++m)
#pragma unroll
                for (int n = 0; n < 2; ++n) acc[a][b][m][n] = (f32x4){0.f, 0.f, 0.f, 0.f};
    bf16x8 At[4][2], B0[2][2], B1[2][2];
    const char* cA = (const char*)g.A + (size_t)cur.pm * tA_pm + (size_t)cur.pn * tA_pn; const char* cB = (const char*)g.Bt + (size_t)cur.pn * tB_pn;
    S.a_ready(cur);
    if constexpr (SP2) {
        PG8_STAGE(PG8_SB(0, 0), cB, voffB); PG8_STAGE(PG8_SB(0, 1), cB + hstepB, voffB); PG8_STAGE(PG8_SA(0, 0), cA, voffA); PG8_STAGE(PG8_SA(0, 1), cA + hstepA, voffA);
        if (wr == 1) PG8_BAR;
        PG8_WAIT_V(2); PG8_BAR;
        PG8_STAGE(PG8_SB(1, 0), cB + kstepB, voffB); PG8_STAGE(PG8_SA(1, 0), cA + kstepA, voffA); PG8_STAGE(PG8_SB(1, 1), cB + hstepB + kstepB, voffB);
        PG8_WAIT_V(6); PG8_BAR;
    } else {
        PG8_STAGE(PG8_SB(0, 0), cB, voffB); PG8_STAGE(PG8_SA(0, 0), cA, voffA); PG8_STAGE(PG8_SB(0, 1), cB + hstepB, voffB); PG8_STAGE(PG8_SA(0, 1), cA + hstepA, voffA);
        if (wr == 1) PG8_BAR;
        PG8_WAIT_V(4); PG8_BAR;
        PG8_STAGE(PG8_SB(1, 0), cB + kstepB, voffB); PG8_STAGE(PG8_SA(1, 0), cA + kstepA, voffA); PG8_STAGE(PG8_SB(1, 1), cB + hstepB + kstepB, voffB);
        PG8_WAIT_V(6); PG8_BAR;
    }
    for (;;) {
        const bool has_next = S.next(ui + 1, nxt);
        const char* nA = has_next ? (const char*)g.A + (size_t)nxt.pm * tA_pm + (size_t)nxt.pn * tA_pn : cA; const char* nB = has_next ? (const char*)g.Bt + (size_t)nxt.pn * tB_pn : cB;
        for (int t = 0; t < nt; t += 2) {
            const bool last = (t == nt - 2);
            const char* a1 = cA + (size_t)(t + 1) * kstepA;
            const char* a2 = last ? nA : cA + (size_t)(t + 2) * kstepA; const char* b2 = last ? nB : cB + (size_t)(t + 2) * kstepB;
            const char* a3 = a2 + kstepA; const char* b3 = b2 + kstepB;
            if (last && has_next) S.a_ready(nxt);
            if constexpr (SP2) {
            PG8_LDB(B0, 0, 0); PG8_LDB(B1, 0, 1); PG8_SCHED; PG8_LDA(At, 0, 0); PG8_STAGE(PG8_SA(1, 1), a1 + hstepA, voffA);
            PG8_WAIT_V(8); PG8_WAIT_L(0); PG8_BAR; PG8_MMA(0, 0, At, B0); PG8_MMA(0, 1, At, B1); PG8_BAR; PG8_SCHED;
            PG8_LDA(At, 0, 1); PG8_STAGE(PG8_SB(0, 0), b2, voffB); PG8_STAGE(PG8_SB(0, 1), b2 + hstepB, voffB); PG8_STAGE(PG8_SA(0, 0), a2, voffA);
            PG8_WAIT_V(8); PG8_WAIT_L(0); PG8_BAR; PG8_MMA(1, 0, At, B0); PG8_MMA(1, 1, At, B1); PG8_BAR; PG8_SCHED;
            PG8_LDB(B0, 1, 0); PG8_LDB(B1, 1, 1); PG8_SCHED; PG8_LDA(At, 1, 0); PG8_STAGE(PG8_SA(0, 1), a2 + hstepA, voffA);
            PG8_WAIT_V(8); PG8_WAIT_L(0); PG8_BAR; PG8_MMA(0, 0, At, B0); PG8_MMA(0, 1, At, B1); PG8_BAR; PG8_SCHED;
            PG8_LDA(At, 1, 1); PG8_STAGE(PG8_SB(1, 0), b3, voffB); PG8_STAGE(PG8_SB(1, 1), b3 + hstepB, voffB); PG8_STAGE(PG8_SA(1, 0), a3, voffA);
            PG8_WAIT_V(8); PG8_WAIT_L(0); PG8_BAR; PG8_MMA(1, 0, At, B0); PG8_MMA(1, 1, At, B1); PG8_BAR; PG8_SCHED;
            } else {
            PG8_LDB(B0, 0, 0); PG8_SCHED; PG8_LDA(At, 0, 0); PG8_STAGE(PG8_SA(1, 1), a1 + hstepA, voffA);
            PG8_WAIT_L(8); PG8_BAR; PG8_WAIT_L(0); PG8_MMA(0, 0, At, B0); PG8_BAR; PG8_SCHED;
            PG8_LDB(B1, 0, 1); PG8_STAGE(PG8_SB(0, 0), b2, voffB);
            PG8_BAR; PG8_WAIT_L(0); PG8_MMA(0, 1, At, B1); PG8_BAR;
            PG8_LDA(At, 0, 1); PG8_STAGE(PG8_SA(0, 0), a2, voffA);
            PG8_BAR; PG8_WAIT_L(0); PG8_MMA(1, 0, At, B0); PG8_BAR; PG8_SCHED;
            PG8_STAGE(PG8_SB(0, 1), b2 + hstepB, voffB);
            PG8_WAIT_V(6); PG8_BAR; PG8_MMA(1, 1, At, B1); PG8_BAR;
            PG8_LDB(B0, 1, 0); PG8_SCHED; PG8_LDA(At, 1, 0); PG8_STAGE(PG8_SA(0, 1), a2 + hstepA, voffA);
            PG8_WAIT_L(8); PG8_BAR; PG8_WAIT_L(0); PG8_MMA(0, 0, At, B0); PG8_BAR; PG8_SCHED;
            PG8_LDB(B1, 1, 1); PG8_STAGE(PG8_SB(1, 0), b3, voffB);
            PG8_BAR; PG8_WAIT_L(0); PG8_MMA(0, 1, At, B1); PG8_BAR;
            PG8_LDA(At, 1, 1); PG8_STAGE(PG8_SA(1, 0), a3, voffA);
            PG8_BAR; PG8_WAIT_L(0); PG8_MMA(1, 0, At, B0); PG8_BAR; PG8_SCHED;
            PG8_STAGE(PG8_SB(1, 1), b3 + hstepB, voffB);
            PG8_WAIT_V(6); PG8_BAR; PG8_MMA(1, 1, At, B1); PG8_BAR;
            }
        }
        if constexpr (ALIGN_EPI) { if (wr == 0) PG8_BAR; }
        if constexpr (!Epi::AFTER_DRAIN) { E(acc, cur, wr, wc, fr, fq); S.done(cur); }
        if (!has_next) break;
#pragma unroll
        for (int a = 0; a < 2; ++a)
#pragma unroll
            for (int b = 0; b < 2; ++b)
#pragma unroll
                for (int m = 0; m < 4; ++m)
#pragma unroll
                    for (int n = 0; n < 2; ++n) acc[a][b][m][n] = (f32x4){0.f, 0.f, 0.f, 0.f};
        cur = nxt; cA = nA; cB = nB; ++ui;
        if constexpr (ALIGN_EPI) { if (wr == 1) PG8_BAR; }
    }
    PG8_WAIT_V(0);
    if constexpr (!ALIGN_EPI) { if (wr == 0) PG8_BAR; }
    PG8_BAR;
    if constexpr (Epi::AFTER_DRAIN) { E.fused(acc, cur, wr, wc, fr, fq, lds, wid, lane); S.done(cur); }
#undef PG8_SA
#undef PG8_SB
#undef PG8_STAGE
#undef PG8_LDA
#undef PG8_LDB
#undef PG8_MMA
#undef PG8_WAIT_V
#undef PG8_WAIT_L
#undef PG8_BAR
#undef PG8_SCHED
}
}

namespace pg8 {
constexpr float LOG2E = 1.4426950408889634f;
constexpr float QS_NSA = 0.125f * LOG2E;
constexpr float QS_MLA = 0.10206207261596575f * LOG2E;
__device__ __forceinline__ float fast_sigmoid(float x) { return __builtin_amdgcn_rcpf(1.0f + __builtin_amdgcn_exp2f(-LOG2E * x)); }
__device__ __forceinline__ float lo_bf(unsigned u) { return __uint_as_float(u << 16); }
__device__ __forceinline__ float hi_bf(unsigned u) { return __uint_as_float(u & 0xffff0000u); }
struct EpiInProjF {
    static constexpr bool PERM = true, AFTER_DRAIN = false;
    bf16_t* proj; unsigned char* gates;
    __device__ __forceinline__ void operator()(const f32x4 (&acc)[2][2][4][2], const Unit& u, int wr, int wc, int fr, int fq) const {
        const bool isg = u.pn >= 7;
        bf16_t* base = proj; const int ld = 1792; const int colt = isg ? (u.pn - 7) * BM : u.pn * BM;
        const float sc = (u.pn < 2) ? QS_NSA : 1.0f;
        const int row0 = u.pm * BM + wr * 64 + fr, col0 = colt + wc * 32 + 8 * fq;
#pragma unroll
        for (int ai = 0; ai < 2; ++ai)
#pragma unroll
            for (int m = 0; m < 4; ++m) { bf16_t* rowp = base + (size_t)(row0 + ai * HALF + m * 16) * ld + col0;
#pragma unroll
                for (int bj = 0; bj < 2; ++bj) { f32x4 v0 = acc[ai][bj][m][0], v1 = acc[ai][bj][m][1];
                    if (isg) {
                        unsigned q[8];
#pragma unroll
                        for (int e = 0; e < 4; ++e) { q[e] = (unsigned)(fast_sigmoid(v0[e]) * 255.0f + 0.5f); q[4 + e] = (unsigned)(fast_sigmoid(v1[e]) * 255.0f + 0.5f); }
                        uint2 w; w.x = q[0] | (q[1] << 8) | (q[2] << 16) | (q[3] << 24); w.y = q[4] | (q[5] << 8) | (q[6] << 16) | (q[7] << 24);
                        *(uint2*)(gates + (size_t)(row0 + ai * HALF + m * 16) * 2048 + col0 + bj * HALF) = w;
                    } else { v0 = v0 * sc; v1 = v1 * sc;
                        u32x4 w; w.x = cvt_pk_bf16(v0[0], v0[1]); w.y = cvt_pk_bf16(v0[2], v0[3]); w.z = cvt_pk_bf16(v1[0], v1[1]); w.w = cvt_pk_bf16(v1[2], v1[3]);
                        *(u32x4*)(rowp + bj * HALF) = w; } } }
    }
};
template <int PASS> struct EpiMergeF {
    static constexpr bool PERM = true, AFTER_DRAIN = false;
    const unsigned char* gates; bf16_t* merged;
    __device__ __forceinline__ void operator()(const f32x4 (&acc)[2][2][4][2], const Unit& u, int wr, int wc, int fr, int fq) const {
        const int row0 = u.pm * BM + wr * 64 + fr, col0 = u.pn * BM + wc * 32 + 8 * fq;
#pragma unroll
        for (int ai = 0; ai < 2; ++ai)
#pragma unroll
            for (int m = 0; m < 4; ++m) { const size_t r = (size_t)(row0 + ai * HALF + m * 16);
#pragma unroll
                for (int bj = 0; bj < 2; ++bj) { const int c = col0 + bj * HALF;
                    const uint2 g = *(const uint2*)(gates + r * 2048 + PASS * 1024 + c);
                    f32x4 v0 = acc[ai][bj][m][0] * (1.0f / 255.0f), v1 = acc[ai][bj][m][1] * (1.0f / 255.0f);
                    v0[0] *= (float)(g.x & 255u); v0[1] *= (float)((g.x >> 8) & 255u); v0[2] *= (float)((g.x >> 16) & 255u); v0[3] *= (float)(g.x >> 24);
                    v1[0] *= (float)(g.y & 255u); v1[1] *= (float)((g.y >> 8) & 255u); v1[2] *= (float)((g.y >> 16) & 255u); v1[3] *= (float)(g.y >> 24);
                    if (PASS == 1) { const u32x4 o = *(const u32x4*)(merged + r * 1024 + c);
                        v0[0] += lo_bf(o.x); v0[1] += hi_bf(o.x); v0[2] += lo_bf(o.y); v0[3] += hi_bf(o.y);
                        v1[0] += lo_bf(o.z); v1[1] += hi_bf(o.z); v1[2] += lo_bf(o.w); v1[3] += hi_bf(o.w); }
                    u32x4 w; w.x = cvt_pk_bf16(v0[0], v0[1]); w.y = cvt_pk_bf16(v0[2], v0[3]); w.z = cvt_pk_bf16(v1[0], v1[1]); w.w = cvt_pk_bf16(v1[2], v1[3]);
                    *(u32x4*)(merged + r * 1024 + c) = w; } }
    }
};
struct EpiCmpOutF {
    static constexpr bool PERM = true, AFTER_DRAIN = false;
    bf16_t* dst;
    __device__ __forceinline__ void operator()(const f32x4 (&acc)[2][2][4][2], const Unit& u, int wr, int wc, int fr, int fq) const {
        if (wc >= 2) return;
        const int row0 = u.pm * BM + wr * 64 + fr, col0 = wc * 32 + 8 * fq;
#pragma unroll
        for (int ai = 0; ai < 2; ++ai)
#pragma unroll
            for (int m = 0; m < 4; ++m) { const int r = row0 + ai * HALF + m * 16;
                if (r < BATCH * NC * 2) { const int g = r & 1, bc = r >> 1, b = bc / NC, c = bc % NC;
                    const f32x4 v0 = acc[ai][0][m][0], v1 = acc[ai][0][m][1];
                    u32x4 w; w.x = cvt_pk_bf16(v0[0], v0[1]); w.y = cvt_pk_bf16(v0[2], v0[3]); w.z = cvt_pk_bf16(v1[0], v1[1]); w.w = cvt_pk_bf16(v1[2], v1[3]);
                    *(u32x4*)(dst + ((size_t)(b * 2 + g) * 128 + c) * 64 + col0) = w; } }
    }
};
struct EpiSlabF {
    static constexpr bool PERM = false, AFTER_DRAIN = false;
    float* slab;
    __device__ __forceinline__ void operator()(const f32x4 (&acc)[2][2][4][2], const Unit& u, int wr, int wc, int fr, int fq) const {
        const int row0 = u.pm * BM + wr * 64 + fr, col0 = wc * 32 + 4 * fq;
        float* base = slab + (size_t)u.pn * 2048 * 256;
#pragma unroll
        for (int ai = 0; ai < 2; ++ai)
#pragma unroll
            for (int m = 0; m < 4; ++m) { float* rowp = base + (size_t)(row0 + ai * HALF + m * 16) * 256 + col0;
#pragma unroll
                for (int bj = 0; bj < 2; ++bj)
#pragma unroll
                    for (int n = 0; n < 2; ++n) *(f32x4*)(rowp + bj * HALF + n * 16) = acc[ai][bj][m][n]; }
    }
};
struct EpiResidF {
    static constexpr bool PERM = false, AFTER_DRAIN = false;
    const float* x; float* h;
    __device__ __forceinline__ void operator()(const f32x4 (&acc)[2][2][4][2], const Unit& u, int wr, int wc, int fr, int fq) const {
        const int row0 = u.pm * BM + wr * 64 + fr, col0 = u.pn * BM + wc * 32 + 4 * fq;
#pragma unroll
        for (int ai = 0; ai < 2; ++ai)
#pragma unroll
            for (int m = 0; m < 4; ++m) { const size_t off = (size_t)(row0 + ai * HALF + m * 16) * 1024 + col0;
#pragma unroll
                for (int bj = 0; bj < 2; ++bj)
#pragma unroll
                    for (int n = 0; n < 2; ++n) { const f32x4 xv = *(const f32x4*)(x + off + bj * HALF + n * 16); *(f32x4*)(h + off + bj * HALF + n * 16) = xv + acc[ai][bj][m][n]; } }
    }
};
struct EpiMlaQF {
    static constexpr bool PERM = false, AFTER_DRAIN = false;
    bf16_t* q; const float2* cs;
    __device__ __forceinline__ void operator()(const f32x4 (&acc)[2][2][4][2], const Unit& u, int wr, int wc, int fr, int fq) const {
        const int row0 = u.pm * BM + wr * 64 + fr;
#pragma unroll
        for (int bj = 0; bj < 2; ++bj) {
            const int X = u.pn * BM + bj * HALF + wc * 32;
            const bool rope = (X % 96) == 64;
#pragma unroll
            for (int ai = 0; ai < 2; ++ai)
#pragma unroll
                for (int m = 0; m < 4; ++m) { const int r = row0 + ai * HALF + m * 16; const int pos = r & (SEQ - 1);
                    f32x4 v0 = acc[ai][bj][m][0], v1 = acc[ai][bj][m][1];
                    if (rope) {
#pragma unroll
                        for (int j = 0; j < 4; ++j) { const float2 c = cs[pos * 16 + 4 * fq + j]; const float x1 = v0[j], x2 = v1[j]; v0[j] = x1 * c.x - x2 * c.y; v1[j] = x2 * c.x + x1 * c.y; } }
                    v0 = v0 * QS_MLA; v1 = v1 * QS_MLA;
                    bf16_t* p = q + (size_t)r * 768 + X + 4 * fq;
                    uint2 w0, w1; w0.x = cvt_pk_bf16(v0[0], v0[1]); w0.y = cvt_pk_bf16(v0[2], v0[3]); w1.x = cvt_pk_bf16(v1[0], v1[1]); w1.y = cvt_pk_bf16(v1[2], v1[3]);
                    *(uint2*)p = w0; *(uint2*)(p + 16) = w1; }
        }
    }
};
}

#define PG8_SP2 true
#define PG8_ALIGN true
constexpr int NTHR = 512, NWV = NTHR / 64;
#define WAVE_IDS const int lane = threadIdx.x & 63, wv = threadIdx.x >> 6; const int gw = blockIdx.x * NWV + wv, nw = gridDim.x * NWV; (void)lane; (void)gw; (void)nw;

template <bool Q8> DEV void ph_rms1024(const float* __restrict__ src, const float* __restrict__ g, bf16_t* __restrict__ dst, int rows, unsigned* __restrict__ q8 = nullptr, float* __restrict__ qs = nullptr, int gw_o = -1, int nw_o = 0, const bf16_t* __restrict__ add = nullptr) {
  const int lane = threadIdx.x & 63; const int gw = (gw_o >= 0) ? gw_o : (int)(blockIdx.x * NWV + (threadIdx.x >> 6)); const int nw = (gw_o >= 0) ? nw_o : (int)(gridDim.x * NWV);
  float4 gg[4];
#pragma unroll
  for (int j = 0; j < 4; ++j) gg[j] = ((const float4*)g)[j * 64 + lane];
  float4 nx[4]; uint2 na[4];
  if (gw < rows) {
#pragma unroll
    for (int j = 0; j < 4; ++j) { nx[j] = ((const float4*)(src + (size_t)gw * 1024))[j * 64 + lane]; if (add) na[j] = ((const uint2*)(add + (size_t)gw * 1024))[j * 64 + lane]; } }
  for (int r = gw; r < rows; r += nw) {
    float4 v[4]; float ss = 0.f;
#pragma unroll
    for (int j = 0; j < 4; ++j) { v[j] = nx[j];
      if (add) { v[j].x += __uint_as_float(na[j].x << 16); v[j].y += __uint_as_float(na[j].x & 0xffff0000u); v[j].z += __uint_as_float(na[j].y << 16); v[j].w += __uint_as_float(na[j].y & 0xffff0000u); }
      ss += v[j].x * v[j].x + v[j].y * v[j].y + v[j].z * v[j].z + v[j].w * v[j].w; }
    if (r + nw < rows) {
#pragma unroll
      for (int j = 0; j < 4; ++j) { nx[j] = ((const float4*)(src + (size_t)(r + nw) * 1024))[j * 64 + lane]; if (add) na[j] = ((const uint2*)(add + (size_t)(r + nw) * 1024))[j * 64 + lane]; } }
    ss = wsum(ss);
    const float inv = rsqrtf(ss * (1.0f / 1024.0f) + 1e-6f);
    float mx = 0.f;
#pragma unroll
    for (int j = 0; j < 4; ++j) {
      v[j].x *= inv * gg[j].x; v[j].y *= inv * gg[j].y; v[j].z *= inv * gg[j].z; v[j].w *= inv * gg[j].w;
      uint2 o;
      o.x = (unsigned)f2bf(v[j].x) | ((unsigned)f2bf(v[j].y) << 16);
      o.y = (unsigned)f2bf(v[j].z) | ((unsigned)f2bf(v[j].w) << 16);
      ((uint2*)(dst + (size_t)r * 1024))[j * 64 + lane] = o;
      if (Q8) mx = fmaxf(mx, fmaxf(fmaxf(fabsf(v[j].x), fabsf(v[j].y)), fmaxf(fabsf(v[j].z), fabsf(v[j].w))));
    }
    if (Q8) {
      mx = wmaxf(mx);
      const float sc = fmaxf(mx, 1e-30f) * (1.0f / 127.0f), isc = 1.0f / sc;
#pragma unroll
      for (int j = 0; j < 4; ++j) {
        const int q0 = (int)rintf(v[j].x * isc), q1 = (int)rintf(v[j].y * isc), q2 = (int)rintf(v[j].z * isc), q3 = (int)rintf(v[j].w * isc);
        q8[(size_t)r * 256 + j * 64 + lane] = (unsigned)(q0 & 255) | ((unsigned)(q1 & 255) << 8) | ((unsigned)(q2 & 255) << 16) | ((unsigned)(q3 & 255) << 24);
      }
      if (lane == 0) qs[r] = sc;
    }
  }
}
template <int PER> DEV void ph_rms_cols(const bf16_t* __restrict__ proj, int col0, const float* __restrict__ g, bf16_t* __restrict__ dst) {
  WAVE_IDS
  constexpr int W = 64 * PER;
  for (int r = gw; r < T; r += nw) {
    float v[PER]; float ss = 0.f;
#pragma unroll
    for (int j = 0; j < PER; ++j) { v[j] = bf2f(proj[(size_t)r * PROJ_LD + col0 + j * 64 + lane]); ss += v[j] * v[j]; }
    ss = wsum(ss);
    const float inv = rsqrtf(ss * (1.0f / W) + 1e-6f);
#pragma unroll
    for (int j = 0; j < PER; ++j) dst[(size_t)r * W + j * 64 + lane] = f2bf(v[j] * inv * g[j * 64 + lane]);
  }
}

DEV int win_src_col(int n) {
  if (n < 1280) return n;
  if (n < 1536) return 1304 + (n - 1280);
  if (n < 1664) return 1560 + (n - 1536);
  if (n < 1696) return 1688 + (n - 1664);
  if (n < 1720) return 1280 + (n - 1696);
  if (n < 1792) return -1;
  return 1720 + (n - 1792);
}
template <int MODE> DEV void tr_item(const float* __restrict__ W, int K, int Nsrc, bf16_t* __restrict__ WT, int Nblk, int Nvalid, __attribute__((address_space(3))) float* scr, int item, int lane) {
  const int kb = item / Nblk, nb = item % Nblk, k0 = 64 * kb, n0 = 32 * nb;
  const int n = n0 + (lane & 31);
  const int sc = (MODE == 1) ? win_src_col(n) : ((n < Nvalid) ? n : -1);
  float tv[32];
#pragma unroll
  for (int i = 0; i < 32; ++i) { const int kk = 2 * i + (lane >> 5); tv[i] = (sc >= 0) ? W[(size_t)(k0 + kk) * Nsrc + sc] : 0.f; }
#pragma unroll
  for (int i = 0; i < 32; ++i) { const int kk = 2 * i + (lane >> 5); scr[kk * 33 + (lane & 31)] = tv[i]; }
  asm volatile("s_waitcnt lgkmcnt(0)" ::: "memory");
  const int c = lane & 7;
#pragma unroll
  for (int j = 0; j < 4; ++j) { const int nn = (lane >> 3) + 8 * j; const __attribute__((address_space(3))) float* sp = scr + (8 * c) * 33 + nn;
    uint4 o;
    o.x = (unsigned)f2bf(sp[0 * 33]) | ((unsigned)f2bf(sp[1 * 33]) << 16); o.y = (unsigned)f2bf(sp[2 * 33]) | ((unsigned)f2bf(sp[3 * 33]) << 16);
    o.z = (unsigned)f2bf(sp[4 * 33]) | ((unsigned)f2bf(sp[5 * 33]) << 16); o.w = (unsigned)f2bf(sp[6 * 33]) | ((unsigned)f2bf(sp[7 * 33]) << 16);
    *(uint4*)(WT + (size_t)(n0 + nn) * K + k0 + 8 * c) = o; }
  asm volatile("s_waitcnt lgkmcnt(0)" ::: "memory");
}
DEV void ph_conv_plain(const float* __restrict__ src, bf16_t* __restrict__ dst, int n) {
  for (int i = blockIdx.x * NTHR + threadIdx.x; i < n; i += gridDim.x * NTHR) dst[i] = f2bf(src[i]);
}

DEV void gemm_tile(const bf16_t* __restrict__ A, int lda, const bf16_t* __restrict__ Bt, int ldb, int m0, int n0, int K, float (&acc)[4][4], char* lds) {
  float (*sA)[132] = (float (*)[132])lds;
  float (*sB)[68] = (float (*)[68])(lds + 32 * 132 * 4);
  const int tid = threadIdx.x, ty = tid >> 4, tx = tid & 15;
  const int lr = tid >> 2, lk = (tid & 3) * 8;
  for (int k0 = 0; k0 < K; k0 += 32) {
    {
      const uint4 va = *(const uint4*)(A + (size_t)(m0 + lr) * lda + k0 + lk);
      const unsigned ua[4] = {va.x, va.y, va.z, va.w};
#pragma unroll
      for (int j = 0; j < 4; ++j) { sA[lk + 2 * j][lr] = __uint_as_float(ua[j] << 16); sA[lk + 2 * j + 1][lr] = __uint_as_float(ua[j] & 0xffff0000u); }
    }
    if (tid < 256) {
      const uint4 vb = *(const uint4*)(Bt + (size_t)(n0 + lr) * ldb + k0 + lk);
      const unsigned ub[4] = {vb.x, vb.y, vb.z, vb.w};
#pragma unroll
      for (int j = 0; j < 4; ++j) { sB[lk + 2 * j][lr] = __uint_as_float(ub[j] << 16); sB[lk + 2 * j + 1][lr] = __uint_as_float(ub[j] & 0xffff0000u); }
    }
    __syncthreads();
#pragma unroll 8
    for (int k = 0; k < 32; ++k) {
      const float4 a = *(const float4*)&sA[k][ty * 4];
      const float4 b = *(const float4*)&sB[k][tx * 4];
      const float av[4] = {a.x, a.y, a.z, a.w}, bv[4] = {b.x, b.y, b.z, b.w};
#pragma unroll
      for (int i = 0; i < 4; ++i)
#pragma unroll
        for (int j = 0; j < 4; ++j) acc[i][j] += av[i] * bv[j];
    }
    __syncthreads();
  }
}
struct EpiInProj { bf16_t* proj; bf16_t* gates;
  DEV void operator()(int m, int n, float v) const { if (n < PROJ_LD) proj[(size_t)m * PROJ_LD + n] = f2bf(v); else gates[(size_t)m * 2048 + (n - PROJ_LD)] = f2bf(sigmoidf_(v)); } };
struct EpiStore { bf16_t* dst; int ld;
  DEV void operator()(int m, int n, float v) const { dst[(size_t)m * ld + n] = f2bf(v); } };
struct EpiGelu { bf16_t* dst; int ld;
  DEV void operator()(int m, int n, float v) const { dst[(size_t)m * ld + n] = f2bf(gelu_exact(v)); } };
struct EpiCmpOut { bf16_t* dst;
  DEV void operator()(int m, int n, float v) const { if (m >= BATCH * NC * 2) return; const int g = m & 1, bc = m >> 1, b = bc / NC, c = bc % NC; dst[((size_t)(b * 2 + g) * 128 + c) * 64 + n] = f2bf(v); } };
struct EpiResid { const float* x; float* h;
  DEV void operator()(int m, int n, float v) const { const size_t i = (size_t)m * 1024 + n; h[i] = x[i] + v; } };

template <class Epi> DEV void ph_gemm(const bf16_t* A, int lda, const bf16_t* Bt, int ldb, int M, int N, int K, const Epi& epi, char* lds) {
  const int ntn = N / 64, ntm = M / 128;
  const int ty = threadIdx.x >> 4, tx = threadIdx.x & 15;
  for (int tile = blockIdx.x; tile < ntn * ntm; tile += gridDim.x) {
    const int m0 = (tile / ntn) * 128, n0 = (tile % ntn) * 64;
    float acc[4][4];
#pragma unroll
    for (int i = 0; i < 4; ++i)
#pragma unroll
      for (int j = 0; j < 4; ++j) acc[i][j] = 0.f;
    gemm_tile(A, lda, Bt, ldb, m0, n0, K, acc, lds);
#pragma unroll
    for (int i = 0; i < 4; ++i)
#pragma unroll
      for (int j = 0; j < 4; ++j) epi(m0 + ty * 4 + i, n0 + tx * 4 + j, acc[i][j]);
  }
}
DEV void ph_merge(const bf16_t* onsa, const bf16_t* omla, const bf16_t* wbn, const bf16_t* wbm, const bf16_t* gates, bf16_t* merged, char* lds) {
  const int ntn = 1024 / 64, ntm = T / 128;
  const int ty = threadIdx.x >> 4, tx = threadIdx.x & 15;
  for (int tile = blockIdx.x; tile < ntn * ntm; tile += gridDim.x) {
    const int m0 = (tile / ntn) * 128, n0 = (tile % ntn) * 64;
    float a1[4][4], a2[4][4];
#pragma unroll
    for (int i = 0; i < 4; ++i)
#pragma unroll
      for (int j = 0; j < 4; ++j) { a1[i][j] = 0.f; a2[i][j] = 0.f; }
    gemm_tile(onsa, 512, wbn, 512, m0, n0, 512, a1, lds);
    gemm_tile(omla, 512, wbm, 512, m0, n0, 512, a2, lds);
#pragma unroll
    for (int i = 0; i < 4; ++i)
#pragma unroll
      for (int j = 0; j < 4; ++j) {
        const int m = m0 + ty * 4 + i, n = n0 + tx * 4 + j;
        merged[(size_t)m * 1024 + n] = f2bf(bf2f(gates[(size_t)m * 2048 + n]) * a1[i][j] + bf2f(gates[(size_t)m * 2048 + 1024 + n]) * a2[i][j]);
      }
  }
}

DEV void rope_entry(float2* __restrict__ cs, int i) {
  const int j = i & 15, pos = i >> 4;
  const float inv_freq = __builtin_amdgcn_exp2f(-(float)(2 * j) * (13.287712379549449f / 32.0f));
  const float rev = (float)pos * inv_freq * 0.15915494309189535f;
  const float fr = rev - floorf(rev);
  cs[i] = make_float2(__builtin_amdgcn_cosf(fr), __builtin_amdgcn_sinf(fr));
}
DEV void ph_rope_table(float2* __restrict__ cs) {
  const int n = SEQ * 16;
  for (int i = blockIdx.x * NTHR + threadIdx.x; i < n; i += gridDim.x * NTHR) {
    const int j = i & 15, pos = i >> 4;
    const float inv_freq = __builtin_amdgcn_exp2f(-(float)(2 * j) * (13.287712379549449f / 32.0f));
    const float rev = (float)pos * inv_freq * 0.15915494309189535f;
    const float fr = rev - floorf(rev);
    cs[i] = make_float2(__builtin_amdgcn_cosf(fr), __builtin_amdgcn_sinf(fr));
  }
}
DEV void ph_rope_k(const bf16_t* __restrict__ proj, bf16_t* __restrict__ kr) {
  const int n = T * 16;
  for (int i = blockIdx.x * NTHR + threadIdx.x; i < n; i += gridDim.x * NTHR) {
    const int j = i & 15, t = i >> 4;
    const float pos = (float)(t & (SEQ - 1));
    const float inv_freq = powf(10000.0f, -(float)(2 * j) / 32.0f);
    const float ang = pos * inv_freq, c = cosf(ang), s = sinf(ang);
    const float x1 = bf2f(proj[(size_t)t * PROJ_LD + PC_KR + j]), x2 = bf2f(proj[(size_t)t * PROJ_LD + PC_KR + 16 + j]);
    kr[(size_t)t * 32 + j] = f2bf(x1 * c - x2 * s); kr[(size_t)t * 32 + 16 + j] = f2bf(x2 * c + x1 * s);
  }
}
DEV void ph_cmp_gather(const bf16_t* __restrict__ proj, const float* __restrict__ pos, int which, bf16_t* __restrict__ ca) {
  const int n = 2048 * 2048;
  for (int i = blockIdx.x * NTHR + threadIdx.x; i < n; i += gridDim.x * NTHR) {
    const int e = i & 2047, row = i >> 11;
    float v = 0.f;
    if (row < BATCH * NC * 2) {
      const int g = row & 1, bc = row >> 1, b = bc / NC, c = bc % NC, l = e >> 6, d = e & 63;
      v = bf2f(proj[(size_t)(b * SEQ + 16 * c + l) * PROJ_LD + PC_KV + which * 128 + g * 64 + d]) + pos[e];
    }
    ca[i] = f2bf(v);
  }
}

DEV void ph_cmp_attn(const bf16_t* __restrict__ proj, const bf16_t* __restrict__ kc, const bf16_t* __restrict__ vc,
                     const float* __restrict__ t5, bf16_t* __restrict__ ocmp, unsigned* __restrict__ sel, char* lds) {
  WAVE_IDS
  float* P = (float*)(lds + wv * 1024); float* Q = P + 128;
  for (int item = gw; item < BATCH * 2 * SEQ; item += nw) {
    const int t = item & (SEQ - 1), bg = item >> 11, g = bg & 1, b = bg >> 1;
    const size_t tok = (size_t)b * SEQ + t;
    const int nvalid = (t >= 31) ? min(NC, (t - 31) / 16 + 1) : 0;
    const bf16_t* kcb = kc + (size_t)bg * 128 * 64;
    const bf16_t* vcb = vc + (size_t)bg * 128 * 64;
    float impacc = 0.f;
    for (int r = 0; r < 4; ++r) {
      const int head = g * 4 + r;
      Q[lane] = bf2f(proj[tok * PROJ_LD + PC_Q + head * 64 + lane]);
      wave_lds_sync();
      float lg[2];
#pragma unroll
      for (int u = 0; u < 2; ++u) {
        const int c = lane + 64 * u;
        float d = 0.f;
        if (c < nvalid) { const bf16_t* kr = kcb + c * 64; for (int e = 0; e < 64; ++e) d += Q[e] * bf2f(kr[e]); }
        lg[u] = (c < nvalid) ? d + 1.4426950408889634f * t5bias(t5, head, t - (16 * c + 31)) : -1e30f;
      }
      const float m = wmaxf(fmaxf(lg[0], lg[1]));
      const float e0 = (lane < nvalid) ? exp2f(lg[0] - m) : 0.f, e1 = (lane + 64 < nvalid) ? exp2f(lg[1] - m) : 0.f;
      const float s = wsum(e0 + e1);
      const float inv = (nvalid > 0) ? 1.0f / fmaxf(s, 1e-30f) : 0.f;
      P[lane] = e0 * inv; P[lane + 64] = e1 * inv;
      wave_lds_sync();
      float o = 0.f;
      for (int c = 0; c < nvalid; ++c) o += P[c] * bf2f(vcb[c * 64 + lane]);
      ocmp[tok * 512 + head * 64 + lane] = f2bf(o);
      if (lane < 32) { for (int c = 4 * lane - 1; c <= 4 * lane + 3; ++c) if (c >= 0 && c < NC) impacc += P[c]; }
      wave_lds_sync();
    }
    const int cur = t >> 6, n = lane;
    float score = (n > cur) ? -1.0f : ((n == 0 || n == cur || n == cur - 1) ? 1e4f : impacc);
    if (n >= 32) score = -2.0f;
    int rank = 0;
    for (int mth = 0; mth < 32; ++mth) { const float sm = __shfl(score, mth); rank += (sm > score || (sm == score && mth < n)) ? 1 : 0; }
    const unsigned long long bal = __ballot(n < 32 && rank < 16);
    if (lane == 0) sel[item] = (unsigned)bal;
  }
}

DEV void ph_nsa_attn(const bf16_t* __restrict__ proj, const float* __restrict__ t5, const bf16_t* __restrict__ ocmp,
                     const unsigned* __restrict__ sel, bf16_t* __restrict__ onsa, char* lds) {
  WAVE_IDS
  float* P = (float*)(lds + wv * 1024); float* Q = P + 128;
  for (int item = gw; item < BATCH * 2 * SEQ * 4; item += nw) {
    const int r = item & 3, t = (item >> 2) & (SEQ - 1), bg = item >> 13, g = bg & 1, b = bg >> 1;
    const int head = g * 4 + r, cur = t >> 6;
    const size_t tok = (size_t)b * SEQ + t;
    Q[lane] = bf2f(proj[tok * PROJ_LD + PC_Q + head * 64 + lane]);
    wave_lds_sync();
    const unsigned smask = sel[bg * SEQ + t];
    float res0 = 0.f, res1 = 0.f;
    for (int br = 0; br < 2; ++br) {
      float m = -1e30f, l = 0.f, o = 0.f;
      const int nb0 = (br == 0) ? 0 : max(0, cur - 8);
      for (int nb = nb0; nb <= cur; ++nb) {
        if (br == 0 && !((smask >> nb) & 1u)) continue;
        const int s = nb * 64 + lane, dist = t - s;
        const bool valid = (dist >= 0) && (br == 0 || dist < 512);
        const bf16_t* kp = proj + ((size_t)b * SEQ + s) * PROJ_LD + PC_KV + (2 + 2 * br) * 128 + g * 64;
        float d = 0.f;
        for (int e = 0; e < 64; e += 8) {
          const uint4 kv = *(const uint4*)(kp + e);
          d += Q[e + 0] * __uint_as_float(kv.x << 16) + Q[e + 1] * __uint_as_float(kv.x & 0xffff0000u);
          d += Q[e + 2] * __uint_as_float(kv.y << 16) + Q[e + 3] * __uint_as_float(kv.y & 0xffff0000u);
          d += Q[e + 4] * __uint_as_float(kv.z << 16) + Q[e + 5] * __uint_as_float(kv.z & 0xffff0000u);
          d += Q[e + 6] * __uint_as_float(kv.w << 16) + Q[e + 7] * __uint_as_float(kv.w & 0xffff0000u);
        }
        const float lg = valid ? d + 1.4426950408889634f * t5bias(t5, head, dist) : -1e30f;
        const float mn = fmaxf(m, wmaxf(lg));
        const float sc = exp2f(m - mn);
        const float pe = valid ? exp2f(lg - mn) : 0.f;
        l = l * sc + wsum(pe); m = mn;
        P[lane] = pe;
        wave_lds_sync();
        const bf16_t* vp = proj + ((size_t)b * SEQ + nb * 64) * PROJ_LD + PC_KV + (3 + 2 * br) * 128 + g * 64 + lane;
        float acc = 0.f;
        for (int k = 0; k < 64; ++k) acc += P[k] * bf2f(vp[(size_t)k * PROJ_LD]);
        o = o * sc + acc;
        wave_lds_sync();
      }
      if (br == 0) res0 = o / fmaxf(l, 1e-30f); else res1 = o / fmaxf(l, 1e-30f);
    }
    const bf16_t* gp = proj + tok * PROJ_LD + PC_GATE + head * 3;
    const float g0 = sigmoidf_(bf2f(gp[0])), g1 = sigmoidf_(bf2f(gp[1])), g2 = sigmoidf_(bf2f(gp[2]));
    const float oc = bf2f(ocmp[tok * 512 + head * 64 + lane]);
    onsa[tok * 512 + head * 64 + lane] = f2bf(g0 * oc + g1 * res0 + g2 * res1);
    wave_lds_sync();
  }
}

DEV void ph_mla_attn(const bf16_t* __restrict__ mq, const bf16_t* __restrict__ mkv, const bf16_t* __restrict__ kr, bf16_t* __restrict__ omla, char* lds) {
  WAVE_IDS
  float* P = (float*)(lds + wv * 1024); float* Q = P + 128;
  for (int item = gw; item < BATCH * 8 * SEQ; item += nw) {
    const int h = item & 7, t = (item >> 3) & (SEQ - 1), b = item >> 14;
    const size_t tok = (size_t)b * SEQ + t;
    Q[lane] = bf2f(mq[tok * 768 + h * 96 + lane]);
    if (lane < 32) Q[64 + lane] = bf2f(mq[tok * 768 + h * 96 + 64 + lane]);
    wave_lds_sync();
    float m = -1e30f, l = 0.f, o = 0.f;
    for (int nb = 0; nb <= (t >> 6); ++nb) {
      const int s = nb * 64 + lane;
      const bool valid = s <= t;
      const bf16_t* kp = mkv + ((size_t)b * SEQ + s) * 1024 + h * 128;
      const bf16_t* rp = kr + ((size_t)b * SEQ + s) * 32;
      float d = 0.f;
      for (int e = 0; e < 64; e += 8) {
        const uint4 kv = *(const uint4*)(kp + e);
        d += Q[e + 0] * __uint_as_float(kv.x << 16) + Q[e + 1] * __uint_as_float(kv.x & 0xffff0000u);
        d += Q[e + 2] * __uint_as_float(kv.y << 16) + Q[e + 3] * __uint_as_float(kv.y & 0xffff0000u);
        d += Q[e + 4] * __uint_as_float(kv.z << 16) + Q[e + 5] * __uint_as_float(kv.z & 0xffff0000u);
        d += Q[e + 6] * __uint_as_float(kv.w << 16) + Q[e + 7] * __uint_as_float(kv.w & 0xffff0000u);
      }
      for (int e = 0; e < 32; e += 8) {
        const uint4 kv = *(const uint4*)(rp + e);
        d += Q[64 + e + 0] * __uint_as_float(kv.x << 16) + Q[64 + e + 1] * __uint_as_float(kv.x & 0xffff0000u);
        d += Q[64 + e + 2] * __uint_as_float(kv.y << 16) + Q[64 + e + 3] * __uint_as_float(kv.y & 0xffff0000u);
        d += Q[64 + e + 4] * __uint_as_float(kv.z << 16) + Q[64 + e + 5] * __uint_as_float(kv.z & 0xffff0000u);
        d += Q[64 + e + 6] * __uint_as_float(kv.w << 16) + Q[64 + e + 7] * __uint_as_float(kv.w & 0xffff0000u);
      }
      const float lg = valid ? d : -1e30f;
      const float mn = fmaxf(m, wmaxf(lg));
      const float sc = exp2f(m - mn);
      const float pe = valid ? exp2f(lg - mn) : 0.f;
      l = l * sc + wsum(pe); m = mn;
      P[lane] = pe;
      wave_lds_sync();
      const bf16_t* vp = mkv + ((size_t)b * SEQ + nb * 64) * 1024 + h * 128 + 64 + lane;
      float acc = 0.f;
      for (int k = 0; k < 64; ++k) acc += P[k] * bf2f(vp[(size_t)k * 1024]);
      o = o * sc + acc;
      wave_lds_sync();
    }
    omla[tok * 512 + h * 64 + lane] = f2bf(o / fmaxf(l, 1e-30f));
    wave_lds_sync();
  }
}

DEV void wave_argmax(float& v, int& idx) {
#pragma unroll
  for (int o = 32; o > 0; o >>= 1) {
    const float ov = __shfl_xor(v, o); const int oi = __shfl_xor(idx, o);
    if (ov > v || (ov == v && oi < idx)) { v = ov; idx = oi; }
  }
}
DEV void ph_route(const bf16_t* __restrict__ pq, const bf16_t* __restrict__ subk, int* __restrict__ pidx, float* __restrict__ pw, char* lds) {
  WAVE_IDS
  float* Q = (float*)(lds + wv * 1024);
  float* TS = Q + 128;
  int* TI = (int*)(TS + 32);
  for (int item = gw; item < T * 8; item += nw) {
    const int h = item & 7, t = item >> 3;
    Q[lane] = bf2f(pq[(size_t)t * 1024 + h * 128 + lane]);
    Q[lane + 64] = bf2f(pq[(size_t)t * 1024 + h * 128 + 64 + lane]);
    wave_lds_sync();
    for (int p = 0; p < 2; ++p) {
      const bf16_t* kb = subk + (size_t)((h * 2 + p) * 128) * 64;
      float s0 = 0.f, s1 = 0.f;
      for (int e = 0; e < 64; ++e) { const float qv = Q[p * 64 + e]; s0 += qv * bf2f(kb[lane * 64 + e]); s1 += qv * bf2f(kb[(lane + 64) * 64 + e]); }
      for (int k = 0; k < 16; ++k) {
        float v = (s0 >= s1) ? s0 : s1; int idx = (s0 >= s1) ? lane : lane + 64;
        wave_argmax(v, idx);
        if (lane == 0) { TS[p * 16 + k] = v; TI[p * 16 + k] = idx; }
        if (idx == lane) s0 = -3e38f;
        if (idx == lane + 64) s1 = -3e38f;
      }
    }
    wave_lds_sync();
    float cv[4];
#pragma unroll
    for (int u = 0; u < 4; ++u) { const int f = lane + 64 * u; cv[u] = TS[f >> 4] + TS[16 + (f & 15)]; }
    int myexp = 0; float mybest = 0.f, best0 = 0.f, den = 0.f;
#pragma unroll
    for (int k = 0; k < 16; ++k) {
      float v = cv[0]; int idx = lane;
#pragma unroll
      for (int u = 1; u < 4; ++u) if (cv[u] > v) { v = cv[u]; idx = lane + 64 * u; }
      wave_argmax(v, idx);
#pragma unroll
      for (int u = 0; u < 4; ++u) if (idx == lane + 64 * u) cv[u] = -3e38f;
      if (k == 0) best0 = v;
      den += expf(v - best0);
      if (lane == k) { myexp = TI[idx >> 4] * 128 + TI[16 + (idx & 15)]; mybest = v; }
    }
    if (lane < 16) { pidx[(size_t)t * 128 + h * 16 + lane] = myexp; pw[(size_t)t * 128 + h * 16 + lane] = expf(mybest - best0) / den; }
    wave_lds_sync();
  }
}

DEV void ph_experts(const bf16_t* __restrict__ hn, const int* __restrict__ pidx, const float* __restrict__ pw,
                    const float* __restrict__ pu, const float* __restrict__ pv, const float* __restrict__ gfin, float* __restrict__ out) {
  WAVE_IDS
  for (int t = gw; t < T; t += nw) {
    float4 x[4], y[4];
#pragma unroll
    for (int j = 0; j < 4; ++j) {
      const uint2 r = ((const uint2*)(hn + (size_t)t * 1024))[j * 64 + lane];
      x[j] = make_float4(__uint_as_float(r.x << 16), __uint_as_float(r.x & 0xffff0000u), __uint_as_float(r.y << 16), __uint_as_float(r.y & 0xffff0000u));
      y[j] = make_float4(0.f, 0.f, 0.f, 0.f);
    }
    const int e0 = pidx[(size_t)t * 128 + lane], e1 = pidx[(size_t)t * 128 + 64 + lane];
    const float w0 = pw[(size_t)t * 128 + lane], w1 = pw[(size_t)t * 128 + 64 + lane];
    for (int s = 0; s < 128; ++s) {
      const int e = __shfl((s < 64) ? e0 : e1, s & 63);
      const float w = __shfl((s < 64) ? w0 : w1, s & 63);
      const float4* ur = (const float4*)(pu + (size_t)e * 1024);
      float d = 0.f;
#pragma unroll
      for (int j = 0; j < 4; ++j) { const float4 u = ur[j * 64 + lane]; d += u.x * x[j].x + u.y * x[j].y + u.z * x[j].z + u.w * x[j].w; }
      d = wsum(d);
      const float c = w * gelu_exact(d);
      const float4* vr = (const float4*)(pv + (size_t)e * 1024);
#pragma unroll
      for (int j = 0; j < 4; ++j) { const float4 v = vr[j * 64 + lane]; y[j].x += c * v.x; y[j].y += c * v.y; y[j].z += c * v.z; y[j].w += c * v.w; }
    }
    float4* o4 = (float4*)(out + (size_t)t * 1024);
    float ss = 0.f;
#pragma unroll
    for (int j = 0; j < 4; ++j) {
      const float4 hv = o4[j * 64 + lane];
      y[j].x += hv.x; y[j].y += hv.y; y[j].z += hv.z; y[j].w += hv.w;
      ss += y[j].x * y[j].x + y[j].y * y[j].y + y[j].z * y[j].z + y[j].w * y[j].w;
    }
    ss = wsum(ss);
    const float inv = rsqrtf(ss * (1.0f / 1024.0f) + 1e-6f);
#pragma unroll
    for (int j = 0; j < 4; ++j) {
      const float4 gg = ((const float4*)gfin)[j * 64 + lane];
      o4[j * 64 + lane] = make_float4(y[j].x * inv * gg.x, y[j].y * inv * gg.y, y[j].z * inv * gg.z, y[j].w * inv * gg.w);
    }
  }
}


namespace att {
#define LAS3 __attribute__((address_space(3)))
typedef LAS3 char* lptr;
typedef LAS3 const char* lcptr;
using bf16x8 = __attribute__((ext_vector_type(8))) short;
using s16x4 = __attribute__((ext_vector_type(4))) short;
using f32x16 = __attribute__((ext_vector_type(16))) float;
typedef short v4i16_t __attribute__((ext_vector_type(4)));
typedef unsigned u32x4 __attribute__((ext_vector_type(4)));
typedef float f32x4_t __attribute__((ext_vector_type(4)));
typedef float f32x2_t __attribute__((ext_vector_type(2)));
typedef __bf16 bf16x2_t __attribute__((ext_vector_type(2)));
constexpr float LOG2E = 1.4426950408889634f;
constexpr float THR = 8.0f;
constexpr float NEG_INF = -__builtin_huge_valf();
constexpr int SLOT = 20480, KOFF = 0, VOFF = 12288;
constexpr int L_WSF = 2 * SLOT;
constexpr int L_TB = L_WSF + 2048;
constexpr int L_ST = L_TB + 8 * 320 * 4;
constexpr int L_SELM = L_ST + 768;
constexpr int L_SC = L_SELM + 256;
constexpr int L_IMPQ = L_SC + 64 * 33 * 4;
constexpr int L_IMPL = L_IMPQ + 4 * 64 * 33 * 4;
constexpr int L_FIN = L_IMPQ;
constexpr int L_END = L_IMPL + 4 * 64 * 33 * 4;
static_assert(L_END <= 131072, "attention LDS map");

__device__ __forceinline__ int crow(int r, int hi) { return (r & 3) + 8 * (r >> 2) + 4 * hi; }
__device__ __forceinline__ s16x4 vtr(lcptr p) { return __builtin_bit_cast(s16x4, __builtin_amdgcn_ds_read_tr16_b64_v4i16((LAS3 v4i16_t*)p)); }
__device__ __forceinline__ unsigned cvtpk(float lo, float hi) { f32x2_t v = {lo, hi}; bf16x2_t b = __builtin_convertvector(v, bf16x2_t); return __builtin_bit_cast(unsigned, b); }
__device__ __forceinline__ float xmax(float v) { auto rr = __builtin_amdgcn_permlane32_swap(__float_as_uint(v), __float_as_uint(v), false, false); return fmaxf(__uint_as_float(rr[0]), __uint_as_float(rr[1])); }
__device__ __forceinline__ float xsum(float v) { auto rr = __builtin_amdgcn_permlane32_swap(__float_as_uint(v), __float_as_uint(v), false, false); return __uint_as_float(rr[0]) + __uint_as_float(rr[1]); }
__device__ __forceinline__ float ex2(float x) { return __builtin_amdgcn_exp2f(x); }

template <int ND0> __device__ __forceinline__ void qkt(f32x16& p0, f32x16& p1, lcptr kb, const bf16x8* qr) {
  p0 = f32x16{}; p1 = f32x16{};
  __builtin_amdgcn_s_setprio(1);
#pragma unroll
  for (int d0 = 0; d0 < ND0; ++d0) {
    const bf16x8 b0 = *(const LAS3 bf16x8*)(kb + d0 * 2048);
    const bf16x8 b1 = *(const LAS3 bf16x8*)(kb + d0 * 2048 + 512);
    p0 = __builtin_amdgcn_mfma_f32_32x32x16_bf16(b0, qr[d0], p0, 0, 0, 0);
    p1 = __builtin_amdgcn_mfma_f32_32x32x16_bf16(b1, qr[d0], p1, 0, 0, 0);
  }
  __builtin_amdgcn_s_setprio(0);
}
template <int ND0> __device__ __forceinline__ void qkt_init(f32x16& p0, f32x16& p1, lcptr kb, const bf16x8* qr, const f32x16& c0, const f32x16& c1) {
  p0 = c0; p1 = c1;
  __builtin_amdgcn_s_setprio(1);
#pragma unroll
  for (int d0 = 0; d0 < ND0; ++d0) {
    const bf16x8 b0 = *(const LAS3 bf16x8*)(kb + d0 * 2048);
    const bf16x8 b1 = *(const LAS3 bf16x8*)(kb + d0 * 2048 + 512);
    p0 = __builtin_amdgcn_mfma_f32_32x32x16_bf16(b0, qr[d0], p0, 0, 0, 0);
    p1 = __builtin_amdgcn_mfma_f32_32x32x16_bf16(b1, qr[d0], p1, 0, 0, 0);
  }
  __builtin_amdgcn_s_setprio(0);
}
__device__ __forceinline__ void pv(f32x16 (&o)[2], lcptr vp, const unsigned (&pw)[16]) {
  __builtin_amdgcn_s_setprio(1);
#pragma unroll
  for (int d0 = 0; d0 < 2; ++d0)
#pragma unroll
    for (int ks = 0; ks < 4; ++ks) {
      const s16x4 lo = vtr(vp + d0 * 4096 + ks * 1024), hi4 = vtr(vp + d0 * 4096 + ks * 1024 + 512);
      const bf16x8 vf = {lo[0], lo[1], lo[2], lo[3], hi4[0], hi4[1], hi4[2], hi4[3]};
      const unsigned pa4[4] = {pw[4 * ks], pw[4 * ks + 1], pw[4 * ks + 2], pw[4 * ks + 3]};
      o[d0] = __builtin_amdgcn_mfma_f32_32x32x16_bf16(__builtin_bit_cast(bf16x8, pa4), vf, o[d0], 0, 0, 0);
    }
  __builtin_amdgcn_s_setprio(0);
}
__device__ __forceinline__ void softmax_step(f32x16& p0, f32x16& p1, float& m, float& l, f32x16 (&o)[2], LAS3 float* wsf, int r32, int hi, unsigned (&pw)[16]) {
  float rm = fmaxf(p0[0], p1[0]);
#pragma unroll
  for (int r = 1; r < 16; ++r) rm = fmaxf(rm, fmaxf(p0[r], p1[r]));
  rm = xmax(rm);
  if (__any(rm > m + THR)) {
    const float mn = fmaxf(m, rm);
    const float al = ex2(m - mn);
    m = mn; l *= al;
    if (hi == 0) wsf[r32] = al;
#pragma unroll
    for (int r = 0; r < 16; ++r) { const float f = wsf[crow(r, hi)]; o[0][r] *= f; o[1][r] *= f; }
  }
  float s = 0.f;
#pragma unroll
  for (int r = 0; r < 16; ++r) { p0[r] = ex2(p0[r] - m); p1[r] = ex2(p1[r] - m); s += p0[r] + p1[r]; }
  l += s;
#pragma unroll
  for (int i = 0; i < 8; ++i) { pw[i] = cvtpk(p0[2 * i], p0[2 * i + 1]); pw[8 + i] = cvtpk(p1[2 * i], p1[2 * i + 1]); }
}
struct KVSrc { const bf16_t* k; const bf16_t* v; int ldk, ldv; };
__device__ __forceinline__ void kv_issue(const KVSrc& s, int row0, u32x4& rk, u32x4& rv, int tid) {
  const int kv = tid & 63, ch = tid >> 6, ln = tid & 63;
  rk = *(const u32x4*)(s.k + (size_t)(row0 + kv) * s.ldk + ch * 8);
  rv = *(const u32x4*)(s.v + (size_t)(row0 + 16 * (ch & 3) + (ln >> 2)) * s.ldv + (ch >> 2) * 32 + (ln & 3) * 8);
}
__device__ __forceinline__ void kv_commit(lptr slot, const u32x4& rk, const u32x4& rv, int tid) {
  *(LAS3 u32x4*)(slot + KOFF + (tid >> 6) * 1024 + (tid & 63) * 16) = rk;
  *(LAS3 u32x4*)(slot + VOFF + tid * 16) = rv;
}
__device__ __forceinline__ void fin_set(LAS3 float* finl, const f32x16 (&o)[2], int lane) {
#pragma unroll
  for (int d0 = 0; d0 < 2; ++d0)
#pragma unroll
    for (int r = 0; r < 16; ++r) finl[(d0 * 16 + r) * 64 + lane] = o[d0][r];
}
__device__ __forceinline__ void fin_add(LAS3 float* finl, const f32x16 (&o)[2], const LAS3 float* wsf, int lane, int hi) {
#pragma unroll
  for (int r = 0; r < 16; ++r) { const float f = wsf[crow(r, hi)];
#pragma unroll
    for (int d0 = 0; d0 < 2; ++d0) finl[(d0 * 16 + r) * 64 + lane] += o[d0][r] * f; }
}
__device__ __forceinline__ void fin_store(const LAS3 float* finl, bf16_t* gout, size_t rowbase, int ld, int colbase, int lane) {
#pragma unroll
  for (int i = 0; i < 4; ++i) {
    const int q = i * 8 + (lane >> 3), ch = lane & 7;
    const int qh = (q >> 2) & 1, r = (q & 3) + 4 * (q >> 3), d0 = ch >> 2, dl = (ch & 3) * 8;
    const LAS3 float* p = finl + (d0 * 16 + r) * 64 + qh * 32 + dl;
    const f32x4_t x0 = *(const LAS3 f32x4_t*)p, x1 = *(const LAS3 f32x4_t*)(p + 4);
    u32x4 v; v.x = cvtpk(x0[0], x0[1]); v.y = cvtpk(x0[2], x0[3]); v.z = cvtpk(x1[0], x1[1]); v.w = cvtpk(x1[2], x1[3]);
    *(u32x4*)(gout + (rowbase + q) * (size_t)ld + colbase + ch * 8) = v;
  }
}

__device__ __forceinline__ void nsa_unit(int b, int g, int c, const bf16_t* __restrict__ proj, const bf16_t* __restrict__ kc, const bf16_t* __restrict__ vc, bf16_t* __restrict__ onsa, lptr lds) {
  int tid = threadIdx.x; asm volatile("" : "+v"(tid));
  const int lane = tid & 63, r32 = lane & 31, hi = lane >> 5;
  const int w = __builtin_amdgcn_readfirstlane(tid >> 6);
  const int rh = w >> 1, head = g * 4 + rh, tokl = 32 * (w & 1) + r32, t = 64 * c + tokl, bg = b * 2 + g;
  const size_t tok = (size_t)b * SEQ + t;
  LAS3 float* wsf = (LAS3 float*)(lds + L_WSF) + w * 64;
  const LAS3 float* tb = (const LAS3 float*)(lds + L_TB) + head * 320 + 64;
  const LAS3 float* stp = (const LAS3 float*)(lds + L_ST);
  LAS3 unsigned* selm = (LAS3 unsigned*)(lds + L_SELM);
  LAS3 float* sc = (LAS3 float*)(lds + L_SC);
  LAS3 float* impq = (LAS3 float*)(lds + L_IMPQ);
  LAS3 float* impl = (LAS3 float*)(lds + L_IMPL);
  const lcptr kb0 = (lcptr)lds + KOFF + hi * 1024 + r32 * 16;
  const lcptr vp0 = (lcptr)lds + VOFF + ((lane >> 4) & 1) * 32 + (lane & 3) * 8 + (4 * hi + ((lane & 15) >> 2)) * 64;
  bf16x8 qr[4];
#pragma unroll
  for (int d0 = 0; d0 < 4; ++d0) qr[d0] = *(const bf16x8*)(proj + tok * PROJ_LD + PC_Q + head * 64 + d0 * 16 + hi * 8);
  float gate[3];
#pragma unroll
  for (int j = 0; j < 3; ++j) gate[j] = 1.0f / (1.0f + ex2(-LOG2E * bf2f(proj[tok * PROJ_LD + PC_GATE + head * 3 + j])));
  LAS3 float* finl = (LAS3 float*)(lds + L_FIN) + w * 2048;
  f32x16 o[2]; unsigned pw[16];
  u32x4 rk, rv;
  {
    const KVSrc src{kc + (size_t)bg * 128 * 64, vc + (size_t)bg * 128 * 64, 64, 64};
    __syncthreads();
    kv_issue(src, 0, rk, rv, tid); kv_commit(lds, rk, rv, tid);
    kv_issue(src, 64, rk, rv, tid); kv_commit(lds + SLOT, rk, rv, tid);
    __syncthreads();
    f32x16 a0, a1, b0, b1;
    const int twmin = 64 * c + 32 * (w & 1), twmax = twmin + 31;
    const bool live0 = true, live1 = (16 * 32 + 31 <= twmax), live2 = (16 * 64 + 31 <= twmax), live3 = (16 * 96 + 31 <= twmax);
    qkt<4>(a0, a1, kb0, qr);
    if (live2) qkt<4>(b0, b1, kb0 + SLOT, qr); else { b0 = f32x16{}; b1 = f32x16{}; }
    float rm = NEG_INF;
#define CMP_QUARTER(P, QTR, LIVE) do { if (LIVE) { \
      if (!(16 * (32 * (QTR) + 31) + 31 + 112 < twmin)) { \
        _Pragma("unroll") for (int r = 0; r < 16; ++r) { int d_ = t - 16 * (32 * (QTR) + crow(r, hi)) - 31; d_ = d_ < -64 ? -64 : (d_ > 255 ? 255 : d_); P[r] += tb[d_]; } } \
      _Pragma("unroll") for (int r = 0; r < 16; ++r) rm = fmaxf(rm, P[r]); } } while (0)
    CMP_QUARTER(a0, 0, live0); CMP_QUARTER(a1, 1, live1); CMP_QUARTER(b0, 2, live2); CMP_QUARTER(b1, 3, live3);
#undef CMP_QUARTER
    rm = xmax(rm);
    const float mref = (rm == NEG_INF) ? 0.f : rm;
    float s = 0.f;
#define CMP_EXP(P, LIVE) do { if (LIVE) { _Pragma("unroll") for (int r = 0; r < 16; ++r) { P[r] = ex2(P[r] - mref); s += P[r]; } } else { _Pragma("unroll") for (int r = 0; r < 16; ++r) P[r] = 0.f; } } while (0)
    CMP_EXP(a0, live0); CMP_EXP(a1, live1); CMP_EXP(b0, live2); CMP_EXP(b1, live3);
#undef CMP_EXP
    s = xsum(s);
    const float inv = (s > 0.f) ? 1.0f / s : 0.f;
#pragma unroll
    for (int r = 0; r < 16; ++r) { a0[r] *= inv; a1[r] *= inv; b0[r] *= inv; b1[r] *= inv; }
    { LAS3 float* iq = impq + (rh * 64 + tokl) * 33; LAS3 float* il = impl + (rh * 64 + tokl) * 33;
#pragma unroll
      for (int q4 = 0; q4 < 4; ++q4) {
        const int gi = 2 * q4 + hi;
        iq[gi] = (a0[4 * q4] + a0[4 * q4 + 1]) + (a0[4 * q4 + 2] + a0[4 * q4 + 3]);           il[gi] = a0[4 * q4 + 3];
        iq[8 + gi] = (a1[4 * q4] + a1[4 * q4 + 1]) + (a1[4 * q4 + 2] + a1[4 * q4 + 3]);       il[8 + gi] = a1[4 * q4 + 3];
        iq[16 + gi] = (b0[4 * q4] + b0[4 * q4 + 1]) + (b0[4 * q4 + 2] + b0[4 * q4 + 3]);      il[16 + gi] = b0[4 * q4 + 3];
        iq[24 + gi] = (b1[4 * q4] + b1[4 * q4 + 1]) + (b1[4 * q4 + 2] + b1[4 * q4 + 3]);      il[24 + gi] = b1[4 * q4 + 3];
      } }
    o[0] = f32x16{}; o[1] = f32x16{};
#pragma unroll
    for (int i = 0; i < 8; ++i) { pw[i] = cvtpk(a0[2 * i], a0[2 * i + 1]); pw[8 + i] = cvtpk(a1[2 * i], a1[2 * i + 1]); }
    pv(o, vp0, pw);
    if (live2) {
#pragma unroll
      for (int i = 0; i < 8; ++i) { pw[i] = cvtpk(b0[2 * i], b0[2 * i + 1]); pw[8 + i] = cvtpk(b1[2 * i], b1[2 * i + 1]); }
      pv(o, vp0 + SLOT, pw); }
    if (hi == 0) wsf[r32] = gate[0];
#pragma unroll
    for (int r = 0; r < 16; ++r) { const float f = wsf[crow(r, hi)]; o[0][r] *= f; o[1][r] *= f; }
  }
  __syncthreads();
  const KVSrc ssrc{proj + (size_t)b * SEQ * PROJ_LD + PC_KV + 2 * 128 + g * 64, proj + (size_t)b * SEQ * PROJ_LD + PC_KV + 3 * 128 + g * 64, PROJ_LD, PROJ_LD};
  kv_issue(ssrc, 0, rk, rv, tid);
  {
    const int stok = tid >> 3, sub = tid & 7;
#pragma unroll
    for (int k = 0; k < 4; ++k) {
      const int n = sub * 4 + k;
      float imp = 0.f;
#pragma unroll
      for (int hh = 0; hh < 4; ++hh) imp += impq[(hh * 64 + stok) * 33 + n] + ((n > 0) ? impl[(hh * 64 + stok) * 33 + n - 1] : 0.f);
      sc[stok * 33 + n] = (n > c) ? -1.0f : ((n == 0 || n == c || n == c - 1) ? 1e4f : imp);
    }
    if (tid < 64) selm[tid] = 0u;
    __syncthreads();
    float srow[32];
#pragma unroll
    for (int mm = 0; mm < 32; ++mm) srow[mm] = sc[stok * 33 + mm];
    unsigned bits = 0u;
#pragma unroll
    for (int k = 0; k < 4; ++k) {
      const int n = sub * 4 + k; const float sv = sc[stok * 33 + n]; int rank = 0;
#pragma unroll
      for (int mm = 0; mm < 32; ++mm) rank += (srow[mm] > sv || (srow[mm] == sv && mm < n)) ? 1 : 0;
      if (rank < 16) bits |= 1u << n;
    }
    if (bits) atomicOr((unsigned*)(selm + stok), bits);
    __syncthreads();
  }
  const unsigned mysel = selm[tokl];
  fin_set(finl, o, lane);
#pragma unroll 1
  for (int br = 0; br < 2; ++br) {
    const KVSrc src = (br == 0) ? ssrc : KVSrc{proj + (size_t)b * SEQ * PROJ_LD + PC_KV + 4 * 128 + g * 64, proj + (size_t)b * SEQ * PROJ_LD + PC_KV + 5 * 128 + g * 64, PROJ_LD, PROJ_LD};
    const int n0 = (br == 0) ? 0 : ((c > 8) ? c - 8 : 0);
    if (br == 1) { __syncthreads(); kv_issue(src, n0 * 64, rk, rv, tid); }
    kv_commit(lds, rk, rv, tid);
    float m = -1e30f, l = 0.f;
    o[0] = f32x16{}; o[1] = f32x16{};
    int cur = 0;
#pragma unroll 1
    for (int n = n0; n <= c; ++n) {
      __syncthreads();
      if (n < c) kv_issue(src, (n + 1) * 64, rk, rv, tid);
      const bool mine = (br == 1) || ((mysel >> n) & 1u);
      if (__any(mine)) {
        f32x16 p0, p1;
        if (n + 2 >= c) {
          const LAS3 float* bp = tb + (t - 64 * n) - 4 * hi - 63;
          f32x16 c0, c1;
#pragma unroll
          for (int r = 0; r < 16; ++r) { c0[r] = bp[63 - ((r & 3) + 8 * (r >> 2))]; c1[r] = bp[31 - ((r & 3) + 8 * (r >> 2))]; }
          qkt_init<4>(p0, p1, kb0 + cur * SLOT, qr, c0, c1);
        } else if (br == 1 && n + 8 == c) {
          const LAS3 float* bp = stp + (607 - (t - 64 * n)) + 4 * hi;
          f32x16 c0, c1;
#pragma unroll
          for (int r = 0; r < 16; ++r) { c0[r] = bp[(r & 3) + 8 * (r >> 2)]; c1[r] = bp[32 + (r & 3) + 8 * (r >> 2)]; }
          qkt_init<4>(p0, p1, kb0 + cur * SLOT, qr, c0, c1);
        } else qkt<4>(p0, p1, kb0 + cur * SLOT, qr);
        if (!mine) {
#pragma unroll
          for (int r = 0; r < 16; ++r) { p0[r] = NEG_INF; p1[r] = NEG_INF; } }
        softmax_step(p0, p1, m, l, o, wsf, r32, hi, pw);
        pv(o, vp0 + cur * SLOT, pw);
      }
      if (n < c) kv_commit(lds + (cur ^ 1) * SLOT, rk, rv, tid);
      cur ^= 1;
    }
    l = xsum(l);
    const float gi = gate[1 + br] / fmaxf(l, 1e-30f);
    if (hi == 0) wsf[r32] = gi;
    fin_add(finl, o, wsf, lane, hi);
  }
  fin_store(finl, onsa, (size_t)b * SEQ + 64 * c + 32 * (w & 1), 512, head * 64, lane);
}

__device__ __forceinline__ void mla_unit(int b, int h, int qb, const bf16_t* __restrict__ mq, const bf16_t* __restrict__ mkv, const bf16_t* __restrict__ kr, bf16_t* __restrict__ omla, lptr lds) {
  int tid = threadIdx.x; asm volatile("" : "+v"(tid));
  const int lane = tid & 63, r32 = lane & 31, hi = lane >> 5;
  const int w = __builtin_amdgcn_readfirstlane(tid >> 6);
  const int q0 = 256 * qb, qw = q0 + 32 * w, qpos = qw + r32;
  const size_t tokq = (size_t)b * SEQ + qpos;
  LAS3 float* wsf = (LAS3 float*)(lds + L_WSF) + w * 64;
  const lcptr kb0 = (lcptr)lds + KOFF + hi * 1024 + r32 * 16;
  const lcptr vp0 = (lcptr)lds + VOFF + ((lane >> 4) & 1) * 32 + (lane & 3) * 8 + (4 * hi + ((lane & 15) >> 2)) * 64;
  const LAS3 float* stp = (const LAS3 float*)(lds + L_ST);
  bf16x8 qr[6];
#pragma unroll
  for (int d0 = 0; d0 < 6; ++d0) qr[d0] = *(const bf16x8*)(mq + tokq * 768 + h * 96 + d0 * 16 + hi * 8);
  const KVSrc src{mkv + (size_t)b * SEQ * 1024 + h * 128, mkv + (size_t)b * SEQ * 1024 + h * 128 + 64, 1024, 1024};
  const bf16_t* krb = kr + (size_t)b * SEQ * 32;
  const int NTL = 4 * (qb + 1);
  u32x4 rk, rv, rr = {0u, 0u, 0u, 0u};
  f32x16 o[2]; o[0] = f32x16{}; o[1] = f32x16{};
  unsigned pw[16];
  float m = -1e30f, l = 0.f;
  __syncthreads();
  kv_issue(src, 0, rk, rv, tid);
  if (tid < 256) rr = *(const u32x4*)(krb + (size_t)(tid & 63) * 32 + (tid >> 6) * 8);
  kv_commit(lds, rk, rv, tid);
  if (tid < 256) *(LAS3 u32x4*)(lds + KOFF + (8 + (tid >> 6)) * 1024 + (tid & 63) * 16) = rr;
  int cur = 0;
#pragma unroll 1
  for (int tl = 0; tl < NTL; ++tl) {
    __syncthreads();
    if (tl + 1 < NTL) { kv_issue(src, (tl + 1) * 64, rk, rv, tid); if (tid < 256) rr = *(const u32x4*)(krb + (size_t)((tl + 1) * 64 + (tid & 63)) * 32 + (tid >> 6) * 8); }
    if (64 * tl <= qw + 31) {
      f32x16 p0, p1;
      if (64 * tl + 63 > qw) {
        const LAS3 float* bp = stp + 96 + (qpos - 64 * tl) - 4 * hi - 63;
        f32x16 c0, c1;
#pragma unroll
        for (int r = 0; r < 16; ++r) { c0[r] = bp[63 - ((r & 3) + 8 * (r >> 2))]; c1[r] = bp[31 - ((r & 3) + 8 * (r >> 2))]; }
        qkt_init<6>(p0, p1, kb0 + cur * SLOT, qr, c0, c1);
      } else qkt<6>(p0, p1, kb0 + cur * SLOT, qr);
      softmax_step(p0, p1, m, l, o, wsf, r32, hi, pw);
      pv(o, vp0 + cur * SLOT, pw);
    }
    if (tl + 1 < NTL) { kv_commit(lds + (cur ^ 1) * SLOT, rk, rv, tid); if (tid < 256) *(LAS3 u32x4*)(lds + (cur ^ 1) * SLOT + KOFF + (8 + (tid >> 6)) * 1024 + (tid & 63) * 16) = rr; }
    cur ^= 1;
  }
  l = xsum(l);
  if (hi == 0) wsf[r32] = 1.0f / fmaxf(l, 1e-30f);
#pragma unroll
  for (int r = 0; r < 16; ++r) { const float f = wsf[crow(r, hi)]; o[0][r] *= f; o[1][r] *= f; }
  LAS3 float* finl = (LAS3 float*)(lds + L_FIN) + w * 2048;
  fin_set(finl, o, lane);
  fin_store(finl, omla, (size_t)b * SEQ + qw, 512, h * 64, lane);
}

__device__ __forceinline__ void attn_phase(const bf16_t* proj, const bf16_t* kc, const bf16_t* vc, const float* t5, bf16_t* onsa,
                                           const bf16_t* mq, const bf16_t* mkv, const bf16_t* kr, bf16_t* omla, lptr lds) {
  const int tid = threadIdx.x;
  { LAS3 float* tb = (LAS3 float*)(lds + L_TB);
    for (int i = tid; i < 8 * 320; i += NTHR) { const int hd = i / 320, d = i % 320 - 64; tb[i] = (d < 0) ? NEG_INF : ((d < 113) ? (t5[(int)T5B[d] * 8 + hd] - t5[31 * 8 + hd]) * LOG2E : 0.f); }
    LAS3 float* st = (LAS3 float*)(lds + L_ST);
    for (int i = tid; i < 192; i += NTHR) st[i] = (i < 96) ? NEG_INF : 0.f; }
  const int G = gridDim.x, bx = blockIdx.x;
  for (int v = (G % 8 == 0) ? (bx % 8) * (G / 8) + bx / 8 : bx; v < 256; v += G) {
    const int bg = v >> 4, p = v & 15, bh = v >> 2, j = v & 3;
#pragma unroll 1
    for (int u = 0; u < 2; ++u) nsa_unit(bg >> 1, bg & 1, u ? p : 31 - p, proj, kc, vc, onsa, lds);
#pragma unroll 1
    for (int u = 0; u < 2; ++u) mla_unit(bh >> 3, bh & 7, u ? j : 7 - j, mq, mkv, kr, omla, lds);
  }
}
#undef LAS3
}


namespace peer {
using bf16x8 = __attribute__((ext_vector_type(8))) short;
using f32x16 = __attribute__((ext_vector_type(16))) float;
typedef unsigned u32x4 __attribute__((ext_vector_type(4)));
typedef float f32x4_t __attribute__((ext_vector_type(4)));
typedef __bf16 bf16x2_t __attribute__((ext_vector_type(2)));
typedef float f32x2_t __attribute__((ext_vector_type(2)));
#define LAS3 __attribute__((address_space(3)))
__device__ __forceinline__ int crow(int r, int hi) { return (r & 3) + 8 * (r >> 2) + 4 * hi; }
__device__ __forceinline__ unsigned enc(float f) { const unsigned u = __float_as_uint(f); return u ^ ((unsigned)((int)u >> 31) | 0x80000000u); }
__device__ __forceinline__ float dec(unsigned k) { return __uint_as_float(k ^ (~(unsigned)((int)k >> 31) | 0x80000000u)); }
__device__ __forceinline__ unsigned umax(unsigned a, unsigned b) { return a > b ? a : b; }
__device__ __forceinline__ unsigned umin(unsigned a, unsigned b) { return a < b ? a : b; }
__device__ __forceinline__ unsigned cvtpk(float lo, float hi) { f32x2_t v = {lo, hi}; bf16x2_t b = __builtin_convertvector(v, bf16x2_t); return __builtin_bit_cast(unsigned, b); }
template <int B, int N> __device__ __forceinline__ void sort16(unsigned (&k)[N]) {
#pragma unroll
  for (int size = 2; size <= 16; size <<= 1)
#pragma unroll
    for (int stride = size >> 1; stride > 0; stride >>= 1)
#pragma unroll
      for (int i = 0; i < 16; ++i) { const int l = i ^ stride;
        if (l > i) { const bool desc = ((i & size) == 0); const unsigned a = k[B + i], b = k[B + l]; const unsigned mx = umax(a, b), mn = umin(a, b); k[B + i] = desc ? mx : mn; k[B + l] = desc ? mn : mx; } }
}
template <int A, int Bo, int N> __device__ __forceinline__ void merge16(unsigned (&k)[N]) {
#pragma unroll
  for (int i = 0; i < 16; ++i) k[A + i] = umax(k[A + i], k[Bo + 15 - i]);
#pragma unroll
  for (int stride = 8; stride > 0; stride >>= 1)
#pragma unroll
    for (int i = 0; i < 16; ++i) { const int l = i ^ stride; if (l > i) { const unsigned a = k[A + i], b = k[A + l]; k[A + i] = umax(a, b); k[A + l] = umin(a, b); } }
}
template <int N> __device__ __forceinline__ void top16_of_64(unsigned (&k)[N]) {
  sort16<0>(k); sort16<16>(k); sort16<32>(k); sort16<48>(k);
  merge16<0, 16>(k); merge16<32, 48>(k); merge16<0, 32>(k);
}

__device__ __forceinline__ void route_phase(const bf16_t* __restrict__ pq, const bf16_t* __restrict__ subk, unsigned* __restrict__ pack, LAS3 char* lds) {
  const int tid = threadIdx.x, lane = tid & 63, r32 = lane & 31, hi = lane >> 5, wv = tid >> 6;
  const int gw = blockIdx.x * NWV + wv, nw = gridDim.x * NWV;
  LAS3 unsigned char* myb = (LAS3 unsigned char*)lds + wv * 2560 + lane * 40;
#pragma unroll 1
  for (int item = gw; item < (T / 32) * 8; item += nw) {
    const int h = item & 7, t0 = (item >> 3) * 32;
    unsigned la[16], lb[16];
#pragma unroll
    for (int i = 0; i < 16; ++i) { la[i] = 0u; lb[i] = 0u; }
#pragma unroll 1
    for (int p = 0; p < 2; ++p) {
      f32x16 acc[4];
#pragma unroll
      for (int kt = 0; kt < 4; ++kt) acc[kt] = f32x16{};
#pragma unroll
      for (int kd = 0; kd < 4; ++kd) {
        const bf16x8 bq = *(const bf16x8*)(pq + (size_t)(t0 + r32) * 1024 + h * 128 + p * 64 + kd * 16 + hi * 8);
#pragma unroll
        for (int kt = 0; kt < 4; ++kt) {
          const bf16x8 ak = *(const bf16x8*)(subk + (size_t)((h * 2 + p) * 128 + kt * 32 + r32) * 64 + kd * 16 + hi * 8);
          acc[kt] = __builtin_amdgcn_mfma_f32_32x32x16_bf16(ak, bq, acc[kt], 0, 0, 0);
        }
      }
      unsigned k[64];
#pragma unroll
      for (int kt = 0; kt < 4; ++kt)
#pragma unroll
        for (int r = 0; r < 16; ++r) k[kt * 16 + r] = (enc(acc[kt][r]) & 0xFFFFFF80u) | (unsigned)(127 - (32 * kt + crow(r, hi)));
      top16_of_64(k);
#pragma unroll
      for (int i = 0; i < 16; ++i) { auto rr = __builtin_amdgcn_permlane32_swap(k[i], k[i], false, false); unsigned r0 = rr[0], r1 = rr[1]; asm volatile("" : "+v"(r0), "+v"(r1)); k[16 + i] = hi ? r0 : r1; }
      merge16<0, 16>(k);
#pragma unroll
      for (int i = 0; i < 16; ++i) { la[i] = (p == 0) ? k[i] : la[i]; lb[i] = (p == 0) ? lb[i] : k[i]; }
      __builtin_amdgcn_sched_barrier(0);
    }
#pragma unroll
    for (int i = 0; i < 4; ++i) {
      const unsigned wa = (127u - (la[4 * i] & 127u)) | ((127u - (la[4 * i + 1] & 127u)) << 8) | ((127u - (la[4 * i + 2] & 127u)) << 16) | ((127u - (la[4 * i + 3] & 127u)) << 24);
      const unsigned wb = (127u - (lb[4 * i] & 127u)) | ((127u - (lb[4 * i + 1] & 127u)) << 8) | ((127u - (lb[4 * i + 2] & 127u)) << 16) | ((127u - (lb[4 * i + 3] & 127u)) << 24);
      *(LAS3 unsigned*)(myb + 4 * i) = wa; *(LAS3 unsigned*)(myb + 16 + 4 * i) = wb;
    }
    float va[16], vb[16];
#pragma unroll
    for (int i = 0; i < 16; ++i) { va[i] = dec(la[i] & 0xFFFFFF80u); vb[i] = dec(lb[i] & 0xFFFFFF80u); }
    unsigned k[64];
#define PEER_CAND(n, i, j) k[n] = (enc(va[i] + vb[j]) & 0xFFFFFF00u) | (unsigned)(255 - ((i) * 16 + (j)))
    PEER_CAND(0, 0, 0); PEER_CAND(1, 0, 1); PEER_CAND(2, 0, 2); PEER_CAND(3, 0, 3); PEER_CAND(4, 0, 4); PEER_CAND(5, 0, 5);
    PEER_CAND(6, 0, 6); PEER_CAND(7, 0, 7); PEER_CAND(8, 0, 8); PEER_CAND(9, 0, 9); PEER_CAND(10, 0, 10); PEER_CAND(11, 0, 11);
    PEER_CAND(12, 0, 12); PEER_CAND(13, 0, 13); PEER_CAND(14, 0, 14); PEER_CAND(15, 0, 15); PEER_CAND(16, 1, 0); PEER_CAND(17, 1, 1);
    PEER_CAND(18, 1, 2); PEER_CAND(19, 1, 3); PEER_CAND(20, 1, 4); PEER_CAND(21, 1, 5); PEER_CAND(22, 1, 6); PEER_CAND(23, 1, 7);
    PEER_CAND(24, 2, 0); PEER_CAND(25, 2, 1); PEER_CAND(26, 2, 2); PEER_CAND(27, 2, 3); PEER_CAND(28, 2, 4); PEER_CAND(29, 3, 0);
    PEER_CAND(30, 3, 1); PEER_CAND(31, 3, 2); PEER_CAND(32, 3, 3); PEER_CAND(33, 4, 0); PEER_CAND(34, 4, 1); PEER_CAND(35, 4, 2);
    PEER_CAND(36, 5, 0); PEER_CAND(37, 5, 1); PEER_CAND(38, 6, 0); PEER_CAND(39, 6, 1); PEER_CAND(40, 7, 0); PEER_CAND(41, 7, 1);
    PEER_CAND(42, 8, 0); PEER_CAND(43, 9, 0); PEER_CAND(44, 10, 0); PEER_CAND(45, 11, 0); PEER_CAND(46, 12, 0); PEER_CAND(47, 13, 0);
    PEER_CAND(48, 14, 0); PEER_CAND(49, 15, 0);
#undef PEER_CAND
#pragma unroll
    for (int z = 50; z < 64; ++z) k[z] = 0u;
    top16_of_64(k);
    const float best0 = dec(k[0] & 0xFFFFFF00u);
    float ev[16]; float den = 0.f;
#pragma unroll
    for (int i = 0; i < 16; ++i) { ev[i] = __expf(dec(k[i] & 0xFFFFFF00u) - best0); den += ev[i]; }
    const float inv = 1.0f / den;
    unsigned outw[8];
#pragma unroll
    for (int i = 0; i < 8; ++i) {
      unsigned k_lo = k[i], k_hi = k[8 + i]; float e_lo = ev[i], e_hi = ev[8 + i];
      asm volatile("" : "+v"(k_lo), "+v"(k_hi), "+v"(e_lo), "+v"(e_hi));
      const unsigned kk = hi ? k_hi : k_lo; const float e = hi ? e_hi : e_lo;
      const unsigned f = 255u - (kk & 255u);
      const unsigned ia = myb[f >> 4], ib = myb[16 + (f & 15u)];
      outw[i] = (ia * 128u + ib) | (cvtpk(0.f, e * inv) & 0xFFFF0000u);
    }
    unsigned* dst = pack + (size_t)(t0 + r32) * 128 + h * 16 + hi * 8;
    *(u32x4*)dst = (u32x4){outw[0], outw[1], outw[2], outw[3]};
    *(u32x4*)(dst + 4) = (u32x4){outw[4], outw[5], outw[6], outw[7]};
  }
}

__device__ __forceinline__ void conv_tables(const float* __restrict__ u, const float* __restrict__ v, unsigned* __restrict__ u8, float* __restrict__ su, unsigned* __restrict__ v8) {
  const int tid = threadIdx.x, lane = tid & 63, wv = tid >> 6;
  const int gw = blockIdx.x * NWV + wv, nw = gridDim.x * NWV;
  for (int e = gw; e < 16384; e += nw) {
    const f32x4_t* ur = (const f32x4_t*)(u + (size_t)e * 1024) + lane * 4;
    f32x4_t a[4]; float mx = 0.f;
#pragma unroll
    for (int i = 0; i < 4; ++i) { a[i] = ur[i]; mx = fmaxf(mx, fmaxf(fmaxf(fabsf(a[i][0]), fabsf(a[i][1])), fmaxf(fabsf(a[i][2]), fabsf(a[i][3])))); }
    mx = wmaxf(mx);
    const float sc = fmaxf(mx, 1e-30f) * (1.0f / 127.0f), isc = 1.0f / sc;
    u32x4 o;
#pragma unroll
    for (int i = 0; i < 4; ++i) {
      const int q0 = (int)rintf(a[i][0] * isc), q1 = (int)rintf(a[i][1] * isc), q2 = (int)rintf(a[i][2] * isc), q3 = (int)rintf(a[i][3] * isc);
      o[i] = (unsigned)(q0 & 255) | ((unsigned)(q1 & 255) << 8) | ((unsigned)(q2 & 255) << 16) | ((unsigned)(q3 & 255) << 24);
    }
    *(u32x4*)(u8 + (size_t)e * 256 + lane * 4) = o;
    if (lane == 0) su[e] = sc;
    const f32x4_t* vr = (const f32x4_t*)(v + (size_t)e * 1024) + lane * 4;
    u32x4 ov;
#pragma unroll
    for (int i = 0; i < 4; ++i) { const f32x4_t b = vr[i]; unsigned w = 0u; w = __builtin_amdgcn_cvt_pk_fp8_f32(2.0f * b[0], 2.0f * b[1], w, false); w = __builtin_amdgcn_cvt_pk_fp8_f32(2.0f * b[2], 2.0f * b[3], w, true); ov[i] = w; }
    *(u32x4*)(v8 + ((size_t)(lane >> 3) * 16384 + e) * 32 + (lane & 7) * 4) = ov;
  }
}
__device__ __forceinline__ float gelu_fast(float v) {
  const float av = __builtin_fabsf(v), t = __builtin_amdgcn_rcpf(av * 0.2316418882f + 1.0f);
  float q = t * 0.5307027145f + (-0.7265760135f); q = q * t + 0.7107068705f; q = q * t + (-0.142248368f); q = q * t + 0.127414796f; q = q * t;
  const float e = __builtin_amdgcn_exp2f((v * v) * (-0.72134752044f));
  const float m = v * (q * e);
  return v < 0.f ? m : v - m;
}
__device__ __forceinline__ unsigned xcc_id() { return (unsigned)__builtin_amdgcn_s_getreg((3 << 11) | 20) & 7u; }
struct ABuf { unsigned w, meta; u32x4 ub[8]; float sue; };
__device__ __forceinline__ void expA_issue(ABuf& B, int k0, int n, const LAS3 unsigned* list, const unsigned* __restrict__ u8, const float* __restrict__ su, int j8) {
  const int k = (k0 < n) ? k0 : 0;
  B.w = list[2 * k]; B.meta = list[2 * k + 1];
  const unsigned e = B.w & 0xFFFFu;
  const unsigned* urow = u8 + (size_t)e * 256 + j8 * 4;
#pragma unroll
  for (int seg = 0; seg < 8; ++seg) B.ub[seg] = *(const u32x4*)(urow + seg * 32);
  B.sue = su[e];
}
__device__ __forceinline__ void expA_consume(const ABuf& B, int k0, int n, const LAS3 char* hl, const LAS3 float* shl, float* __restrict__ co, int t0, int j8) {
  const int tokl = (int)(B.meta >> 8), slot = (int)(B.meta & 255u);
  const LAS3 char* hrow = hl + tokl * 1024 + j8 * 16;
  int a0 = 0, a1 = 0, a2 = 0, a3 = 0;
#pragma unroll
  for (int seg = 0; seg < 8; ++seg) { const u32x4 hq = *(const LAS3 u32x4*)(hrow + seg * 128);
    a0 = __builtin_amdgcn_sdot4((int)B.ub[seg].x, (int)hq.x, a0, false); a1 = __builtin_amdgcn_sdot4((int)B.ub[seg].y, (int)hq.y, a1, false);
    a2 = __builtin_amdgcn_sdot4((int)B.ub[seg].z, (int)hq.z, a2, false); a3 = __builtin_amdgcn_sdot4((int)B.ub[seg].w, (int)hq.w, a3, false); }
  int acc = (a0 + a1) + (a2 + a3);
  acc += dpp_i<0xB1>(acc); acc += dpp_i<0x4E>(acc); acc += dpp_i<0x141>(acc);
  const float d = (float)acc * (B.sue * shl[tokl]);
  const float c = 0.5f * __uint_as_float(B.w & 0xFFFF0000u) * gelu_fast(d);
  if (j8 == 0 && k0 < n) co[(size_t)(t0 + tokl) * 128 + slot] = c;
}
struct AStage { u32x4 pw[4], hst[8]; float shv; };
__device__ __forceinline__ void expA_stage(AStage& S, int item, const unsigned* __restrict__ pack, const unsigned* __restrict__ hn8, const float* __restrict__ shp, int tid) {
  const int t0 = item * 64, tokl = tid >> 3, sb = (tid & 7) * 16;
#pragma unroll
  for (int i = 0; i < 4; ++i) S.pw[i] = *(const u32x4*)(pack + (size_t)(t0 + tokl) * 128 + sb + 4 * i);
#pragma unroll
  for (int i = 0; i < 8; ++i) S.hst[i] = *(const u32x4*)(hn8 + (size_t)t0 * 256 + (tid + 512 * i) * 4);
  S.shv = (tid < 64) ? shp[t0 + tid] : 0.f;
}
__device__ __forceinline__ void expA_item(AStage& S, int item, int nitem, int xs, const unsigned* __restrict__ pack, const unsigned* __restrict__ hn8, const float* __restrict__ shp, const unsigned* __restrict__ u8, const float* __restrict__ su,
                                          float* __restrict__ co, LAS3 char* lds, int tid) {
  const int lane = tid & 63, wv = tid >> 6;
  LAS3 char* hl = lds + 1024;
  LAS3 float* shl = (LAS3 float*)(lds + 1024 + 65536);
  LAS3 unsigned* cnt = (LAS3 unsigned*)(lds + 16);
  LAS3 unsigned* list = (LAS3 unsigned*)(lds + 1024 + 65536 + 256);
  const int t0 = item * 64;
  const int tokl = tid >> 3, sb = (tid & 7) * 16;
#pragma unroll
  for (int i = 0; i < 8; ++i) *(LAS3 u32x4*)(hl + (tid + 512 * i) * 16) = S.hst[i];
  if (tid < 64) shl[tid] = S.shv;
  {
    unsigned long long mk[16]; int tot = 0; int off[16];
#pragma unroll
    for (int j = 0; j < 16; ++j) { const unsigned w = S.pw[j >> 2][j & 3]; mk[j] = __ballot(((w & 0xFFFFu) >> 11) == (unsigned)xs); off[j] = tot; tot += __builtin_popcountll(mk[j]); }
    int base = 0;
    if (lane == 0) base = (int)__hip_atomic_fetch_add(cnt, (unsigned)tot, __ATOMIC_RELAXED, __HIP_MEMORY_SCOPE_WORKGROUP);
    base = __builtin_amdgcn_readfirstlane(base);
#pragma unroll
    for (int j = 0; j < 16; ++j) { const unsigned w = S.pw[j >> 2][j & 3];
      if (((w & 0xFFFFu) >> 11) == (unsigned)xs) { const int pos = base + off[j] + (int)__builtin_amdgcn_mbcnt_hi((unsigned)(mk[j] >> 32), __builtin_amdgcn_mbcnt_lo((unsigned)mk[j], 0u));
        list[2 * pos] = w; list[2 * pos + 1] = (unsigned)((tokl << 8) | (sb + j)); } }
  }
  if (nitem < T / 64) expA_stage(S, nitem, pack, hn8, shp, tid);
  __syncthreads();
  const int n = (int)cnt[0];
  const int j8 = lane & 7, gidx = wv * 8 + (lane >> 3);
  ABuf A, Bb;
  expA_issue(A, gidx, n, list, u8, su, j8);
#pragma unroll 1
  for (int k0 = gidx; k0 < n; k0 += 128) {
    expA_issue(Bb, k0 + 64, n, list, u8, su, j8);
    expA_consume(A, k0, n, hl, shl, co, t0, j8);
    expA_issue(A, k0 + 128, n, list, u8, su, j8);
    expA_consume(Bb, k0 + 64, n, hl, shl, co, t0, j8);
  }
}
struct BBuf { u32x4 vv[8]; f32x4_t c[2]; };
__device__ __forceinline__ void expB_issue(BBuf& B, const LAS3 unsigned* pkl, const LAS3 float* col, int sg8, const unsigned* __restrict__ vbase) {
  const u32x4 p0 = *(const LAS3 u32x4*)(pkl + sg8 * 8), p1 = *(const LAS3 u32x4*)(pkl + sg8 * 8 + 4);
  B.c[0] = *(const LAS3 f32x4_t*)(col + sg8 * 8); B.c[1] = *(const LAS3 f32x4_t*)(col + sg8 * 8 + 4);
#pragma unroll
  for (int j = 0; j < 4; ++j) { B.vv[j] = *(const u32x4*)(vbase + (size_t)(p0[j] & 0xFFFFu) * 32); B.vv[4 + j] = *(const u32x4*)(vbase + (size_t)(p1[j] & 0xFFFFu) * 32); }
}
__device__ __forceinline__ void expB_consume(const BBuf& B, f32x2_t (&y)[8]) {
#pragma unroll
  for (int j = 0; j < 8; ++j) {
    const float cv = B.c[j >> 2][j & 3];
    const f32x2_t c2 = {cv, cv};
#pragma unroll
    for (int w = 0; w < 4; ++w) {
      y[2 * w] = __builtin_elementwise_fma(__builtin_amdgcn_cvt_pk_f32_fp8(B.vv[j][w], false), c2, y[2 * w]);
      y[2 * w + 1] = __builtin_elementwise_fma(__builtin_amdgcn_cvt_pk_f32_fp8(B.vv[j][w], true), c2, y[2 * w + 1]);
    }
  }
}
__device__ __forceinline__ void expB_item(int item, int xs, const unsigned* __restrict__ pack, const float* __restrict__ co, const unsigned* __restrict__ v8, bf16_t* __restrict__ zb, float* __restrict__ ssq, LAS3 char* lds, int tid,
                                          const float* __restrict__ xin, const bf16_t* __restrict__ ob) {
  const int lane = tid & 63, wv = tid >> 6, r8 = lane >> 3, c8 = lane & 7;
  const int t0 = item * 64 + wv * 8;
  LAS3 unsigned* pkw = (LAS3 unsigned*)(lds + 1024 + wv * 8192);
  LAS3 float* cow = (LAS3 float*)(lds + 1024 + wv * 8192 + 4096);
  {
    u32x4 a[4]; f32x4_t b[4];
#pragma unroll
    for (int i = 0; i < 4; ++i) { a[i] = *(const u32x4*)(pack + (size_t)t0 * 128 + (lane + 64 * i) * 4); b[i] = *(const f32x4_t*)(co + (size_t)t0 * 128 + (lane + 64 * i) * 4); }
#pragma unroll
    for (int i = 0; i < 4; ++i) { *(LAS3 u32x4*)(pkw + (lane + 64 * i) * 4) = a[i]; *(LAS3 f32x4_t*)(cow + (lane + 64 * i) * 4) = b[i]; }
  }
  const size_t hoff = (size_t)(t0 + r8) * 1024 + xs * 128 + c8 * 16;
  f32x4_t h[4];
  { const u32x4 o0 = *(const u32x4*)(ob + hoff), o1 = *(const u32x4*)(ob + hoff + 8);
#pragma unroll
    for (int w = 0; w < 4; ++w) h[w] = *(const f32x4_t*)(xin + hoff + 4 * w);
    h[0] += (f32x4_t){__uint_as_float(o0.x << 16), __uint_as_float(o0.x & 0xffff0000u), __uint_as_float(o0.y << 16), __uint_as_float(o0.y & 0xffff0000u)};
    h[1] += (f32x4_t){__uint_as_float(o0.z << 16), __uint_as_float(o0.z & 0xffff0000u), __uint_as_float(o0.w << 16), __uint_as_float(o0.w & 0xffff0000u)};
    h[2] += (f32x4_t){__uint_as_float(o1.x << 16), __uint_as_float(o1.x & 0xffff0000u), __uint_as_float(o1.y << 16), __uint_as_float(o1.y & 0xffff0000u)};
    h[3] += (f32x4_t){__uint_as_float(o1.z << 16), __uint_as_float(o1.z & 0xffff0000u), __uint_as_float(o1.w << 16), __uint_as_float(o1.w & 0xffff0000u)}; }
  wave_lds_sync();
  const LAS3 unsigned* pkl = pkw + r8 * 128; const LAS3 float* col = cow + r8 * 128;
  const unsigned* vbase = v8 + (size_t)xs * 16384 * 32 + c8 * 4;
  f32x2_t y[8];
#pragma unroll
  for (int i = 0; i < 8; ++i) y[i] = (f32x2_t){0.f, 0.f};
  BBuf A, Bb;
  expB_issue(A, pkl, col, 0, vbase);
#pragma unroll 1
  for (int sg = 0; sg < 16; sg += 2) {
    expB_issue(Bb, pkl, col, sg + 1, vbase);
    expB_consume(A, y);
    if (sg + 2 < 16) expB_issue(A, pkl, col, sg + 2, vbase);
    expB_consume(Bb, y);
  }
  float ss = 0.f; unsigned zw[8];
#pragma unroll
  for (int w = 0; w < 4; ++w) {
    const f32x4_t z = {h[w][0] + y[2 * w][0], h[w][1] + y[2 * w][1], h[w][2] + y[2 * w + 1][0], h[w][3] + y[2 * w + 1][1]};
    zw[2 * w] = cvtpk(z[0], z[1]); zw[2 * w + 1] = cvtpk(z[2], z[3]);
    ss += (z[0] * z[0] + z[1] * z[1]) + (z[2] * z[2] + z[3] * z[3]);
  }
  *(u32x4*)(zb + hoff) = (u32x4){zw[0], zw[1], zw[2], zw[3]}; *(u32x4*)(zb + hoff + 8) = (u32x4){zw[4], zw[5], zw[6], zw[7]};
  ss += dpp_f<0xB1>(ss); ss += dpp_f<0x4E>(ss); ss += dpp_f<0x141>(ss);
  if (c8 == 0) ssq[(size_t)xs * T + t0 + r8] = ss;
  wave_lds_sync();
}
template <int PASS> __device__ __forceinline__ void experts_sliced(const unsigned* __restrict__ pack, const unsigned* __restrict__ hn8, const float* __restrict__ shp, const unsigned* __restrict__ u8, const float* __restrict__ su,
                                                                    float* __restrict__ co, const unsigned* __restrict__ v8, float* __restrict__ out, float* __restrict__ ssq, unsigned* __restrict__ ctr, LAS3 char* lds,
                                                                    const float* __restrict__ xin = nullptr, const bf16_t* __restrict__ ob = nullptr) {
  int tid = threadIdx.x; asm volatile("" : "+v"(tid));
  LAS3 volatile int* lw = (LAS3 volatile int*)lds;
  const int xme = (int)xcc_id();
#pragma unroll 1
  for (int s8 = 0; s8 < 8; ++s8) {
    const int xs = (xme + s8) & 7;
    if (PASS == 0) {
      int nxt = 0;
      if (tid == 0) nxt = (int)atomicAdd(ctr + 64 * xs, 1u);
      __syncthreads();
      if (tid == 0) lw[0] = nxt;
      __syncthreads();
      int item = lw[0];
      if (item >= T / 64) continue;
      if (tid == 0) nxt = (int)atomicAdd(ctr + 64 * xs, 1u);
      AStage SA;
      expA_stage(SA, item, pack, hn8, shp, tid);
#pragma unroll 1
      for (;;) {
        __syncthreads();
        if (tid == 0) { lw[0] = nxt; lw[4] = 0; }
        __syncthreads();
        const int nitem = lw[0];
        if (tid == 0) nxt = (int)atomicAdd(ctr + 64 * xs, 1u);
        expA_item(SA, item, nitem, xs, pack, hn8, shp, u8, su, co, lds, tid);
        if (nitem >= T / 64) break;
        item = nitem;
      }
    } else {
      int nxt = 0;
      if (tid == 0) nxt = (int)atomicAdd(ctr + 64 * xs, 1u);
#pragma unroll 1
      for (;;) {
        __syncthreads();
        if (tid == 0) lw[0] = nxt;
        __syncthreads();
        const int item = lw[0];
        if (item >= T / 64) break;
        if (tid == 0) nxt = (int)atomicAdd(ctr + 64 * xs, 1u);
        expB_item(item, xs, pack, co, v8, (bf16_t*)out, ssq, lds, tid, xin, ob);
      }
    }
  }
}
__device__ __forceinline__ void experts_norm(const float* __restrict__ ssq, const float* __restrict__ gfin, const bf16_t* __restrict__ zb, float* __restrict__ out) {
  const int tid = threadIdx.x, lane = tid & 63, wv = tid >> 6;
  const int gw = blockIdx.x * NWV + wv, nw = gridDim.x * NWV;
  for (int t = gw; t < T; t += nw) {
    float ss = 0.f;
#pragma unroll
    for (int x = 0; x < 8; ++x) ss += ssq[(size_t)x * T + t];
    const float inv = rsqrtf(ss * (1.0f / 1024.0f) + 1e-6f);
    float* op = out + (size_t)t * 1024 + lane * 16; const float* gp = gfin + lane * 16;
    const u32x4 z0 = *(const u32x4*)(zb + (size_t)t * 1024 + lane * 16), z1 = *(const u32x4*)(zb + (size_t)t * 1024 + lane * 16 + 8);
    const unsigned zz[8] = {z0.x, z0.y, z0.z, z0.w, z1.x, z1.y, z1.z, z1.w};
#pragma unroll
    for (int i = 0; i < 4; ++i) { const f32x4_t z = {__uint_as_float(zz[2 * i] << 16), __uint_as_float(zz[2 * i] & 0xffff0000u), __uint_as_float(zz[2 * i + 1] << 16), __uint_as_float(zz[2 * i + 1] & 0xffff0000u)};
      const f32x4_t g = *(const f32x4_t*)(gp + 4 * i); *(f32x4_t*)(op + 4 * i) = z * inv * g; }
  }
}
#undef LAS3
}

namespace prep {
typedef unsigned u32x2_t __attribute__((ext_vector_type(2)));
typedef float f32x4_t __attribute__((ext_vector_type(4)));
typedef unsigned u32x4 __attribute__((ext_vector_type(4)));
using bf16x8 = __attribute__((ext_vector_type(8))) short;
using f32x16 = __attribute__((ext_vector_type(16))) float;
__device__ __forceinline__ unsigned pk2(float lo, float hi) { return (unsigned)f2bf(lo) | ((unsigned)f2bf(hi) << 16); }
__device__ __forceinline__ void latent_rows(const bf16_t* __restrict__ proj, const float* __restrict__ gq, const float* __restrict__ gkv, const float2* __restrict__ cs,
                                            bf16_t* __restrict__ cqn, bf16_t* __restrict__ ckvn, bf16_t* __restrict__ krope, int wave_id, int nwaves, int lane) {
  const f32x4_t g4 = *(const f32x4_t*)(gq + lane * 4);
  const float2 g2 = *(const float2*)(gkv + lane * 2);
  for (int r = wave_id; r < T; r += nwaves) {
    const bf16_t* row = proj + (size_t)r * PROJ_LD;
    const u32x2_t q = *(const u32x2_t*)(row + PC_CQ + lane * 4);
    const unsigned kv = *(const unsigned*)(row + PC_CKV + lane * 2);
    const unsigned short kr0 = row[PC_KR + (lane & 15)], kr1 = row[PC_KR + 16 + (lane & 15)];
    const float q0 = __uint_as_float(q.x << 16), q1 = __uint_as_float(q.x & 0xffff0000u), q2 = __uint_as_float(q.y << 16), q3 = __uint_as_float(q.y & 0xffff0000u);
    const float k0 = __uint_as_float(kv << 16), k1 = __uint_as_float(kv & 0xffff0000u);
    float sq = (q0 * q0 + q1 * q1) + (q2 * q2 + q3 * q3), sk = k0 * k0 + k1 * k1;
    sq = wsum(sq); sk = wsum(sk);
    const float iq = rsqrtf(sq * (1.0f / 256.0f) + 1e-6f), ik = rsqrtf(sk * (1.0f / 128.0f) + 1e-6f);
    u32x2_t oq; oq.x = pk2(q0 * iq * g4[0], q1 * iq * g4[1]); oq.y = pk2(q2 * iq * g4[2], q3 * iq * g4[3]);
    *(u32x2_t*)(cqn + (size_t)r * 256 + lane * 4) = oq;
    *(unsigned*)(ckvn + (size_t)r * 128 + lane * 2) = pk2(k0 * ik * g2.x, k1 * ik * g2.y);
    if (lane < 16) {
      const float2 c = cs[(r & (SEQ - 1)) * 16 + lane];
      const float x1 = bf2f(kr0), x2 = bf2f(kr1);
      krope[(size_t)r * 32 + lane] = f2bf(x1 * c.x - x2 * c.y); krope[(size_t)r * 32 + 16 + lane] = f2bf(x2 * c.x + x1 * c.y);
    }
  }
}
__device__ __forceinline__ void cmp_bias(const float* __restrict__ posk, const float* __restrict__ posv, const bf16_t* __restrict__ w1k, const bf16_t* __restrict__ w1v, float* __restrict__ cpos, int wave_id, int nwaves, int lane) {
  for (int o = wave_id; o < 512; o += nwaves) {
    const int tab = o >> 8, n = o & 255;
    const float* pos = tab ? posv : posk; const bf16_t* w = (tab ? w1v : w1k) + (size_t)n * 2048;
    float acc = 0.f;
#pragma unroll
    for (int i = 0; i < 4; ++i) { const int k = (i * 64 + lane) * 8;
      const u32x4 wv = *(const u32x4*)(w + k); const f32x4_t p0 = *(const f32x4_t*)(pos + k), p1 = *(const f32x4_t*)(pos + k + 4);
      acc += p0[0] * __uint_as_float(wv.x << 16) + p0[1] * __uint_as_float(wv.x & 0xffff0000u) + p0[2] * __uint_as_float(wv.y << 16) + p0[3] * __uint_as_float(wv.y & 0xffff0000u);
      acc += p1[0] * __uint_as_float(wv.z << 16) + p1[1] * __uint_as_float(wv.z & 0xffff0000u) + p1[2] * __uint_as_float(wv.w << 16) + p1[3] * __uint_as_float(wv.w & 0xffff0000u); }
    acc = wsum(acc);
    if (lane == 0) cpos[o] = acc;
  }
}
__device__ __forceinline__ void cmp_l2(const float* __restrict__ slab, const float* __restrict__ cpos, const bf16_t* __restrict__ w2t, bf16_t* __restrict__ outkc, int item, int lane) {
  const int r32 = lane & 31, hi = lane >> 5, m0 = item * 32;
  f32x16 acc0 = f32x16{}, acc1 = f32x16{};
  f32x4_t sa[2][8]; f32x4_t cp[2][2]; bf16x8 wb[2][2];
#define CMPL2_LOAD(buf, ks_) do { const int k_ = (ks_) * 16 + hi * 8; \
    cp[buf][0] = *(const f32x4_t*)(cpos + k_); cp[buf][1] = *(const f32x4_t*)(cpos + k_ + 4); \
    _Pragma("unroll") for (int sp = 0; sp < 4; ++sp) { const float* p_ = slab + ((size_t)sp * 2048 + m0 + r32) * 256 + k_; sa[buf][2 * sp] = *(const f32x4_t*)p_; sa[buf][2 * sp + 1] = *(const f32x4_t*)(p_ + 4); } \
    wb[buf][0] = *(const bf16x8*)(w2t + (size_t)r32 * 256 + k_); wb[buf][1] = *(const bf16x8*)(w2t + (size_t)(32 + r32) * 256 + k_); } while (0)
#define CMPL2_MMA(buf) do { f32x4_t a0 = cp[buf][0], a1 = cp[buf][1]; \
    _Pragma("unroll") for (int sp = 0; sp < 4; ++sp) { a0 += sa[buf][2 * sp]; a1 += sa[buf][2 * sp + 1]; } \
    u32x4 aw; aw.x = pk2(peer::gelu_fast(a0[0]), peer::gelu_fast(a0[1])); aw.y = pk2(peer::gelu_fast(a0[2]), peer::gelu_fast(a0[3])); \
    aw.z = pk2(peer::gelu_fast(a1[0]), peer::gelu_fast(a1[1])); aw.w = pk2(peer::gelu_fast(a1[2]), peer::gelu_fast(a1[3])); \
    const bf16x8 af = __builtin_bit_cast(bf16x8, aw); \
    acc0 = __builtin_amdgcn_mfma_f32_32x32x16_bf16(af, wb[buf][0], acc0, 0, 0, 0); acc1 = __builtin_amdgcn_mfma_f32_32x32x16_bf16(af, wb[buf][1], acc1, 0, 0, 0); } while (0)
  CMPL2_LOAD(0, 0);
#pragma unroll 1
  for (int ks = 0; ks < 16; ks += 2) {
    CMPL2_LOAD(1, ks + 1);
    CMPL2_MMA(0);
    if (ks + 2 < 16) CMPL2_LOAD(0, ks + 2);
    CMPL2_MMA(1);
  }
#undef CMPL2_LOAD
#undef CMPL2_MMA
#pragma unroll
  for (int r = 0; r < 16; ++r) {
    const int m = m0 + (r & 3) + 8 * (r >> 2) + 4 * hi;
    const bool pad = (m & 127) == 127;
    outkc[(size_t)m * 64 + r32] = pad ? (bf16_t)0 : f2bf(acc0[r]);
    outkc[(size_t)m * 64 + 32 + r32] = pad ? (bf16_t)0 : f2bf(acc1[r]);
  }
}
}

#define XB_TMO      128
#define XB_XCNT(j)  (256  + 64 * (j))
#define XB_XSUB(j)  (1280 + 64 * (j))
#define XB_XGEN(j)  (2304 + 64 * (j))
#define XB_TOP      3328
#define XB_TOPGEN   3392
#define XCD_BAR_WORDS 3456
#define XB_SPIN_CAP (1u << 18)
#ifndef LAS
#define LAS __attribute__((address_space(3)))
#endif

__device__ __forceinline__ unsigned xb_ld(unsigned* p)              { return __hip_atomic_load(p, __ATOMIC_RELAXED, __HIP_MEMORY_SCOPE_AGENT); }
__device__ __forceinline__ unsigned xb_add(unsigned* p, unsigned v) { return __hip_atomic_fetch_add(p, v, __ATOMIC_RELAXED, __HIP_MEMORY_SCOPE_AGENT); }
__device__ __forceinline__ unsigned xb_xcc_id() { return (unsigned)__builtin_amdgcn_s_getreg((3 << 11) | 20) & 0xFu; }
#define XB_SPIN(cond, bar) do { unsigned _sp = 0; while (cond) { __builtin_amdgcn_s_sleep(1); \
    if ((++_sp & 255u) == 0u) { if (xb_ld(&(bar)[XB_TMO])) break; if (_sp > XB_SPIN_CAP) { atomicAdd(&(bar)[XB_TMO], 1u); break; } } } } while (0)

struct XcdBarrier {
    unsigned* bar; unsigned x;
    volatile LAS unsigned* st;
};

__device__ __forceinline__ XcdBarrier xcd_barrier_post(unsigned* bar, volatile LAS unsigned* st) {
    XcdBarrier b; b.bar = bar; b.x = xb_xcc_id(); b.st = st;
    if (threadIdx.x == 0) (void)xb_add(&bar[XB_XCNT(b.x)], 1u);
    return b;
}
__device__ __forceinline__ void xcd_barrier_complete(unsigned* bar, unsigned x, unsigned& nloc, unsigned& nx) {
    const unsigned G = gridDim.x * gridDim.y * gridDim.z;
    unsigned sum, cnt, mine, sp = 0u;
    for (;;) {
        sum = 0u; cnt = 0u; mine = 0u;
#pragma unroll
        for (unsigned j = 0; j < 16; ++j) { const unsigned c = xb_ld(&bar[XB_XCNT(j)]); sum += c; cnt += (c > 0u) ? 1u : 0u; mine = (j == x) ? c : mine; }
        if (sum == G) break;
        __builtin_amdgcn_s_sleep(1);
        if ((++sp & 255u) == 0u) { if (xb_ld(&bar[XB_TMO])) break; if (sp > XB_SPIN_CAP) { atomicAdd(&bar[XB_TMO], 1u); break; } }
    }
    nloc = mine > 0u ? mine : 1u; nx = cnt > 0u ? cnt : 1u;
}

__device__ __forceinline__ void xcd_barrier(const XcdBarrier& b) {
    asm volatile("s_waitcnt vmcnt(0)" ::: "memory");
    __syncthreads();
    if (threadIdx.x == 0) {
        unsigned* bar = b.bar;
        __builtin_amdgcn_s_waitcnt(0);
        unsigned nloc = b.st[0], nx = b.st[1];
        if (nloc == 0u) { xcd_barrier_complete(bar, b.x, nloc, nx); b.st[0] = nloc; b.st[1] = nx; }
        const unsigned old = xb_add(&bar[XB_XSUB(b.x)], 1u);
        const unsigned gen = old / nloc;
        if (old + 1u == (gen + 1u) * nloc) {
            __builtin_amdgcn_fence(__ATOMIC_RELEASE, "agent");
            asm volatile("s_waitcnt vmcnt(0)" ::: "memory");
            const unsigned og = xb_add(&bar[XB_TOP], 1u);
            const unsigned tg = og / nx;
            if (og + 1u == (tg + 1u) * nx) xb_add(&bar[XB_TOPGEN], 1u);
            else XB_SPIN(xb_ld(&bar[XB_TOPGEN]) == tg, bar);
            __builtin_amdgcn_fence(__ATOMIC_ACQUIRE, "agent");
            xb_add(&bar[XB_XGEN(b.x)], 1u);
            asm volatile("s_waitcnt vmcnt(0)" ::: "memory");
        } else {
            XB_SPIN(xb_ld(&bar[XB_XGEN(b.x)]) == gen, bar);
            __builtin_amdgcn_fence(__ATOMIC_ACQUIRE, "agent");
            asm volatile("s_waitcnt vmcnt(0)" ::: "memory");
        }
    }
    __syncthreads();
}

struct Args { const float* in[23]; float* out; char* ws; };
constexpr int LDS_BYTES = 131072 + 4096;

typedef const __attribute__((address_space(4))) Args* kargs_t;
DEV kargs_t KA() { kargs_t k = (kargs_t)__builtin_amdgcn_kernarg_segment_ptr(); asm volatile("" : "+s"(k)); return k; }
#define WSP(type, off) ((type*)(ws + (off)))

__global__ __launch_bounds__(NTHR, 2) void mega(Args a) {
  extern __shared__ __attribute__((aligned(16))) char lds[];
  cg::grid_group grid = cg::this_grid();
  PG8_LAS unsigned char* glds = (PG8_LAS unsigned char*)lds;
  const int bid = blockIdx.x, G = gridDim.x;
  (void)a;
  volatile LAS unsigned* bst = (volatile LAS unsigned*)((LAS char*)lds + LDS_BYTES - 16);
  if (threadIdx.x < 4) bst[threadIdx.x] = 0u;
  __syncthreads();
  XcdBarrier xbar; { kargs_t k = KA(); xbar = xcd_barrier_post((unsigned*)k->ws, bst); }

  { kargs_t k = KA(); char* ws = k->ws;
    const int wv0_ = threadIdx.x >> 6;
    if (wv0_ < 4) { const int lane_ = threadIdx.x & 63, wv_ = wv0_, gw_ = bid * 4 + wv_, nw_ = G * 4;
      __attribute__((address_space(3))) float* scr = (__attribute__((address_space(3))) float*)((__attribute__((address_space(3))) char*)lds + wv_ * 8448);
      constexpr int I_IN = 16 * 120, I_BR = 8 * 32, I_SQ = 16 * 32, I_C1 = 32 * 8, I_C2 = 4 * 8, I_UQ = 4 * 24, I_UKV = 2 * 32;
      constexpr int NITEMS = I_IN + 2 * I_BR + 2 * I_SQ + 2 * I_C1 + 2 * I_C2 + I_UQ + I_UKV;
      for (int it = gw_; it < NITEMS; it += nw_) {
        int r = it;
        if (r < I_IN) { tr_item<1>(k->in[2], 1024, IN_COLS, WSP(bf16_t, WS_WIN), 120, 3840, scr, r, lane_); continue; } r -= I_IN;
        if (r < I_BR) { tr_item<0>(k->in[13], 512, 1024, WSP(bf16_t, WS_WBN), 32, 1024, scr, r, lane_); continue; } r -= I_BR;
        if (r < I_BR) { tr_item<0>(k->in[14], 512, 1024, WSP(bf16_t, WS_WBM), 32, 1024, scr, r, lane_); continue; } r -= I_BR;
        if (r < I_SQ) { tr_item<0>(k->in[15], 1024, 1024, WSP(bf16_t, WS_WOUT), 32, 1024, scr, r, lane_); continue; } r -= I_SQ;
        if (r < I_SQ) { tr_item<0>(k->in[17], 1024, 1024, WSP(bf16_t, WS_WQ), 32, 1024, scr, r, lane_); continue; } r -= I_SQ;
        if (r < I_C1) { tr_item<0>(k->in[5], 2048, 256, WSP(bf16_t, WS_CKW1), 8, 256, scr, r, lane_); continue; } r -= I_C1;
        if (r < I_C1) { tr_item<0>(k->in[7], 2048, 256, WSP(bf16_t, WS_CVW1), 8, 256, scr, r, lane_); continue; } r -= I_C1;
        if (r < I_C2) { tr_item<0>(k->in[6], 256, 64, WSP(bf16_t, WS_CKW2), 8, 64, scr, r, lane_); continue; } r -= I_C2;
        if (r < I_C2) { tr_item<0>(k->in[8], 256, 64, WSP(bf16_t, WS_CVW2), 8, 64, scr, r, lane_); continue; } r -= I_C2;
        if (r < I_UQ) { tr_item<0>(k->in[11], 256, 768, WSP(bf16_t, WS_UQ), 24, 768, scr, r, lane_); continue; } r -= I_UQ;
        tr_item<0>(k->in[12], 128, 1024, WSP(bf16_t, WS_UKV), 32, 1024, scr, r, lane_);
      }
      for (int i = gw_ * 64 + lane_; i < 16 * 128 * 64; i += nw_ * 64) WSP(bf16_t, WS_SUBK)[i] = f2bf(k->in[18][i]);
      for (int i = gw_ * 64 + lane_; i < SEQ * 16; i += nw_ * 64) rope_entry(WSP(float2, WS_ROPE), i);
    } else ph_rms1024<false>(k->in[0], k->in[1], WSP(bf16_t, WS_XN), T, nullptr, nullptr, bid * 4 + (wv0_ - 4), G * 4); }
  grid.sync();
  { kargs_t k = KA(); char* ws = k->ws;
    pg8::Gemm g{WSP(bf16_t, WS_XN), WSP(bf16_t, WS_WIN), T, 3840, 1024}; pg8::StaticOrder S; S.init(T, 3840, G, bid);
    pg8::EpiInProjF E{WSP(bf16_t, WS_PROJ), WSP(unsigned char, WS_GATES)};
    pg8::gemm_phase<pg8::EpiInProjF, pg8::StaticOrder, PG8_ALIGN, PG8_SP2>(glds, g, S, E); }
  xcd_barrier(xbar);
  { kargs_t k = KA(); char* ws = k->ws;
    const int lane_ = threadIdx.x & 63, wv_ = threadIdx.x >> 6;
    if (G >= 128 && bid < 64) {
      const int tab = bid >> 5;
      pg8::Gemm g{WSP(bf16_t, WS_PROJ) + PC_KV + tab * 128, WSP(bf16_t, tab ? WS_CVW1 : WS_CKW1), 2048, 1024, 512};
      g.pitchA = 16u * PROJ_LD * 2u; g.kstepA = PROJ_LD * 2u; g.hstepA = 128; g.tA_pm = (size_t)SEQ * PROJ_LD * 2; g.tA_pn = (size_t)8 * PROJ_LD * 2;
      g.pitchB = 4096u; g.kstepB = 128u; g.hstepB = (size_t)128 * 4096; g.tB_pn = 1024; g.nt = 8;
      pg8::StaticOrder S; S.init(2048, 1024, 32, bid & 31);
      pg8::EpiSlabF E{WSP(float, WS_SLAB) + (size_t)tab * 4 * 2048 * 256};
      pg8::gemm_phase<pg8::EpiSlabF, pg8::StaticOrder, PG8_ALIGN, PG8_SP2>(glds, g, S, E);
    } else {
      const int nb = (G >= 128) ? G - 64 : G, b0 = (G >= 128) ? bid - 64 : bid;
      prep::cmp_bias(k->in[3], k->in[4], WSP(bf16_t, WS_CKW1), WSP(bf16_t, WS_CVW1), WSP(float, WS_CPOS), b0 * NWV + wv_, nb * NWV, lane_);
      prep::latent_rows(WSP(bf16_t, WS_PROJ), k->in[9], k->in[10], WSP(float2, WS_ROPE), WSP(bf16_t, WS_CQN), WSP(bf16_t, WS_CKVN), WSP(bf16_t, WS_KROPE), b0 * NWV + wv_, nb * NWV, lane_);
    } }
  xcd_barrier(xbar);
  { kargs_t k = KA(); char* ws = k->ws;
    pg8::Gemm g{WSP(bf16_t, WS_CQN), WSP(bf16_t, WS_UQ), T, 768, 256}; pg8::StaticOrder S; S.init(T, 768, G, (bid + 64) & 255);
    pg8::EpiMlaQF E{WSP(bf16_t, WS_MLAQ), WSP(float2, WS_ROPE)};
    pg8::gemm_phase<pg8::EpiMlaQF, pg8::StaticOrder, PG8_ALIGN, PG8_SP2>(glds, g, S, E); }
  { kargs_t k = KA(); char* ws = k->ws;
    pg8::Gemm g{WSP(bf16_t, WS_CKVN), WSP(bf16_t, WS_UKV), T, 1024, 128}; pg8::StaticOrder S; S.init(T, 1024, G, bid);
    pg8::EpiBf16<0> E{WSP(bf16_t, WS_MLAKV), 1024, nullptr, 0, 0, 1.f};
    pg8::gemm_phase<pg8::EpiBf16<0>, pg8::StaticOrder, PG8_ALIGN, PG8_SP2>(glds, g, S, E); }
  { kargs_t k = KA(); char* ws = k->ws;
    const int lane_ = threadIdx.x & 63, wv_ = threadIdx.x >> 6;
    for (int it = (wv_ == 0) ? (G - 1 - bid) : 128; it < 128; it += G) {
      const int tab = it >> 6;
      prep::cmp_l2(WSP(float, WS_SLAB) + (size_t)tab * 4 * 2048 * 256, WSP(float, WS_CPOS) + tab * 256, WSP(bf16_t, tab ? WS_CVW2 : WS_CKW2), WSP(bf16_t, tab ? WS_VC : WS_KC), it & 63, lane_);
    } }
  xcd_barrier(xbar);
  { kargs_t k = KA(); char* ws = k->ws;
    att::attn_phase(WSP(bf16_t, WS_PROJ), WSP(bf16_t, WS_KC), WSP(bf16_t, WS_VC), k->in[21], WSP(bf16_t, WS_ONSA),
                    WSP(bf16_t, WS_MLAQ), WSP(bf16_t, WS_MLAKV), WSP(bf16_t, WS_KROPE), WSP(bf16_t, WS_OMLA), (att::lptr)lds); }
  xcd_barrier(xbar);
  { kargs_t k = KA(); char* ws = k->ws;
    pg8::Gemm g{WSP(bf16_t, WS_ONSA), WSP(bf16_t, WS_WBN), T, 1024, 512}; pg8::StaticOrder S; S.init(T, 1024, G, bid);
    pg8::EpiMergeF<0> E{WSP(unsigned char, WS_GATES), WSP(bf16_t, WS_MERGED)};
    pg8::gemm_phase<pg8::EpiMergeF<0>, pg8::StaticOrder, PG8_ALIGN, PG8_SP2>(glds, g, S, E); }
  { kargs_t k = KA(); char* ws = k->ws;
    pg8::Gemm g{WSP(bf16_t, WS_OMLA), WSP(bf16_t, WS_WBM), T, 1024, 512}; pg8::StaticOrder S; S.init(T, 1024, G, bid);
    pg8::EpiMergeF<1> E{WSP(unsigned char, WS_GATES), WSP(bf16_t, WS_MERGED)};
    pg8::gemm_phase<pg8::EpiMergeF<1>, pg8::StaticOrder, PG8_ALIGN, PG8_SP2>(glds, g, S, E); }
  xcd_barrier(xbar);
  { kargs_t k = KA(); char* ws = k->ws;
    pg8::Gemm g{WSP(bf16_t, WS_MERGED), WSP(bf16_t, WS_WOUT), T, 1024, 1024}; pg8::StaticOrder S; S.init(T, 1024, G, bid);
    pg8::EpiBf16<0> E{WSP(bf16_t, WS_OB), 1024, nullptr, 0, 0, 1.f};
    pg8::gemm_phase<pg8::EpiBf16<0>, pg8::StaticOrder, PG8_ALIGN, PG8_SP2>(glds, g, S, E); }
  xcd_barrier(xbar);
  { kargs_t k = KA(); char* ws = k->ws; ph_rms1024<true>(k->in[0], k->in[16], WSP(bf16_t, WS_HN), T, WSP(unsigned, WS_HN8), WSP(float, WS_SH), -1, 0, WSP(bf16_t, WS_OB));
    peer::conv_tables(k->in[19], k->in[20], WSP(unsigned, WS_U8), WSP(float, WS_SU), WSP(unsigned, WS_V8)); }
  xcd_barrier(xbar);
  { kargs_t k = KA(); char* ws = k->ws;
    pg8::Gemm g{WSP(bf16_t, WS_HN), WSP(bf16_t, WS_WQ), T, 1024, 1024}; pg8::StaticOrder S; S.init(T, 1024, G, bid);
    pg8::EpiBf16<0> E{WSP(bf16_t, WS_PQ), 1024, nullptr, 0, 0, 1.f};
    pg8::gemm_phase<pg8::EpiBf16<0>, pg8::StaticOrder, PG8_ALIGN, PG8_SP2>(glds, g, S, E); }
  xcd_barrier(xbar);
  { kargs_t k = KA(); char* ws = k->ws; peer::route_phase(WSP(bf16_t, WS_PQ), WSP(bf16_t, WS_SUBK), WSP(unsigned, WS_PIDX), (__attribute__((address_space(3))) char*)lds); }
  xcd_barrier(xbar);
  { kargs_t k = KA(); char* ws = k->ws;
    peer::experts_sliced<0>(WSP(unsigned, WS_PIDX), WSP(unsigned, WS_HN8), WSP(float, WS_SH), WSP(unsigned, WS_U8), WSP(float, WS_SU), WSP(float, WS_CO), WSP(unsigned, WS_V8), k->out, WSP(float, WS_SSQ),
                            (unsigned*)ws + CTL_QA, (__attribute__((address_space(3))) char*)lds); }
  xcd_barrier(xbar);
  { kargs_t k = KA(); char* ws = k->ws;
    peer::experts_sliced<1>(WSP(unsigned, WS_PIDX), WSP(unsigned, WS_HN8), WSP(float, WS_SH), WSP(unsigned, WS_U8), WSP(float, WS_SU), WSP(float, WS_CO), WSP(unsigned, WS_V8), (float*)WSP(bf16_t, WS_ZB), WSP(float, WS_SSQ),
                            (unsigned*)ws + CTL_QB, (__attribute__((address_space(3))) char*)lds, k->in[0], WSP(bf16_t, WS_OB)); }
  xcd_barrier(xbar);
  { kargs_t k = KA(); char* ws = k->ws; peer::experts_norm(WSP(float, WS_SSQ), k->in[22], WSP(bf16_t, WS_ZB), k->out); }
}

extern "C" void kernel_launch(void* const* d_in, const int* in_sizes, int n_in, void* d_out, int out_size, void* d_ws, size_t ws_size, hipStream_t stream) {
  if (n_in != 23 || ws_size < 256 * MiB) { fprintf(stderr, "kernel_launch: unexpected n_in %d / ws_size %zu\n", n_in, ws_size); return; }
  static int grid_blocks = 0;
  if (!grid_blocks) {
    int dev = 0, cus = 0, per_cu = 0;
    (void)hipGetDevice(&dev);
    (void)hipDeviceGetAttribute(&cus, hipDeviceAttributeMultiprocessorCount, dev);
    if (hipFuncSetAttribute((const void*)mega, hipFuncAttributeMaxDynamicSharedMemorySize, LDS_BYTES) != hipSuccess) fprintf(stderr, "kernel_launch: hipFuncSetAttribute failed\n");
    (void)hipOccupancyMaxActiveBlocksPerMultiprocessor(&per_cu, (const void*)mega, NTHR, LDS_BYTES);
    if (per_cu < 1) { fprintf(stderr, "kernel_launch: occupancy query returned %d\n", per_cu); per_cu = 1; }
    if (per_cu > 2) per_cu = 2;
    grid_blocks = cus * per_cu;
    fprintf(stderr, "kernel_launch: cus %d per_cu %d grid %d ws %zu\n", cus, per_cu, grid_blocks, ws_size);
  }
  if (hipMemsetAsync(d_ws, 0, 65536, stream) != hipSuccess) fprintf(stderr, "kernel_launch: hipMemsetAsync failed\n");
  Args a{};
  for (int i = 0; i < 23; ++i) a.in[i] = (const float*)d_in[i];
  a.out = (float*)d_out; a.ws = (char*)d_ws;
  void* args[] = {&a};
  hipError_t e = hipLaunchCooperativeKernel((const void*)mega, dim3(grid_blocks), dim3(NTHR), args, LDS_BYTES, stream);
  if (e != hipSuccess) fprintf(stderr, "cooperative launch failed: %s (grid %d)\n", hipGetErrorString(e), grid_blocks);
}
```

```cpp
#include <hip/hip_runtime.h>
#include <stdint.h>
#include <cstdio>
#include <hip/hip_cooperative_groups.h>
namespace cg = cooperative_groups;

typedef unsigned short bf16_t;
#define DEV __device__ __forceinline__

constexpr int BATCH = 8, SEQ = 2048, DM = 1024, T = BATCH * SEQ;
constexpr int IN_COLS = 3768;
constexpr int PROJ_LD = 1792;
constexpr int PC_Q = 0, PC_KV = 512, PC_CQ = 1280, PC_CKV = 1536, PC_KR = 1664, PC_GATE = 1696;
constexpr int NC = 127;
constexpr size_t MiB = 1u << 20;

constexpr size_t WS_WIN = 1 * MiB;
constexpr size_t WS_WBN = 9 * MiB;
constexpr size_t WS_WBM = 10 * MiB;
constexpr size_t WS_WOUT = 11 * MiB;
constexpr size_t WS_WQ = 13 * MiB;
constexpr size_t WS_CKW1 = 15 * MiB;
constexpr size_t WS_CVW1 = 16 * MiB;
constexpr size_t WS_CKW2 = 17 * MiB;
constexpr size_t WS_CVW2 = 17 * MiB + 128 * 1024;
constexpr size_t WS_UQ = 17 * MiB + 256 * 1024;
constexpr size_t WS_UKV = 17 * MiB + 768 * 1024;
constexpr size_t WS_SUBK = 18 * MiB;
constexpr size_t WS_ROPE = 18 * MiB + 512 * 1024;
constexpr size_t WS_GATES = 20 * MiB;
constexpr size_t WS_PQ = 20 * MiB;
constexpr size_t WS_ZB = 20 * MiB;
constexpr size_t WS_OB = 52 * MiB;
constexpr size_t WS_PROJ = 84 * MiB;
constexpr size_t WS_MERGED = 84 * MiB;
constexpr size_t WS_PIDX = 84 * MiB;
constexpr size_t WS_U8 = 172 * MiB;
constexpr size_t WS_V8 = 188 * MiB;
constexpr size_t WS_SU = 204 * MiB;
constexpr size_t WS_SH = 204 * MiB + 65536;
constexpr size_t WS_HN8 = 205 * MiB;
constexpr size_t WS_CO = 221 * MiB;
constexpr size_t WS_SSQ = 229 * MiB;
constexpr int CTL_QA = 4096, CTL_QB = 4096 + 512;
constexpr size_t WS_PW = 92 * MiB;
constexpr size_t WS_XN = 140 * MiB;
constexpr size_t WS_MLAKV = 140 * MiB;
constexpr size_t WS_HN = 140 * MiB;
constexpr size_t WS_MLAQ = 172 * MiB;
constexpr size_t WS_KROPE = 196 * MiB;
constexpr size_t WS_KC = 197 * MiB;
constexpr size_t WS_VC = 197 * MiB + 512 * 1024;
constexpr size_t WS_ONSA = 198 * MiB;
constexpr size_t WS_OMLA = 214 * MiB;
constexpr size_t WS_SLAB = 198 * MiB;
constexpr size_t WS_CPOS = 18 * MiB + 768 * 1024;
constexpr size_t WS_CA = 198 * MiB;
constexpr size_t WS_HID = 206 * MiB;
constexpr size_t WS_HID2 = 207 * MiB;
constexpr size_t WS_CA2 = 214 * MiB;
constexpr size_t WS_CQN = 230 * MiB;
constexpr size_t WS_CKVN = 238 * MiB;
constexpr size_t WS_OCMP = 230 * MiB;
constexpr size_t WS_SEL = 246 * MiB;

__device__ const unsigned char T5B[128] = {
  0, 1, 2, 3, 4, 5, 6, 7, 8, 9, 10, 11, 12, 13, 14, 15, 16, 16, 16, 17, 17, 18, 18, 18, 19, 19, 19, 20, 20, 20, 20, 21,
  21, 21, 21, 22, 22, 22, 22, 22, 23, 23, 23, 23, 23, 23, 24, 24, 24, 24, 24, 24, 25, 25, 25, 25, 25, 25, 25, 26, 26, 26, 26, 26,
  26, 26, 26, 27, 27, 27, 27, 27, 27, 27, 27, 27, 27, 28, 28, 28, 28, 28, 28, 28, 28, 28, 28, 29, 29, 29, 29, 29, 29, 29, 29, 29,
  29, 29, 29, 30, 30, 30, 30, 30, 30, 30, 30, 30, 30, 30, 30, 30, 30, 31, 31, 31, 31, 31, 31, 31, 31, 31, 31, 31, 31, 31, 31, 31};

DEV float bf2f(bf16_t v) { return __uint_as_float(((unsigned)v) << 16); }
DEV bf16_t f2bf(float f) { unsigned u = __float_as_uint(f); u += 0x7fffu + ((u >> 16) & 1u); return (bf16_t)(u >> 16); }
template <int CTRL> DEV int dpp_i(int v) { return __builtin_amdgcn_update_dpp(0, v, CTRL, 0xF, 0xF, true); }
template <int CTRL> DEV float dpp_f(float v) { return __uint_as_float((unsigned)__builtin_amdgcn_update_dpp(0, (int)__float_as_uint(v), CTRL, 0xF, 0xF, true)); }
DEV int sum16_i(int v) { v += dpp_i<0xB1>(v); v += dpp_i<0x4E>(v); v += dpp_i<0x141>(v); v += dpp_i<0x140>(v); return v; }
DEV float sum16_f(float v) { v += dpp_f<0xB1>(v); v += dpp_f<0x4E>(v); v += dpp_f<0x141>(v); v += dpp_f<0x140>(v); return v; }
DEV float max16_f(float v) { v = fmaxf(v, dpp_f<0xB1>(v)); v = fmaxf(v, dpp_f<0x4E>(v)); v = fmaxf(v, dpp_f<0x141>(v)); v = fmaxf(v, dpp_f<0x140>(v)); return v; }
DEV float rl_f(float v, int l) { return __uint_as_float((unsigned)__builtin_amdgcn_readlane((int)__float_as_uint(v), l)); }
DEV float wsum(float v) { v = sum16_f(v); return (rl_f(v, 0) + rl_f(v, 16)) + (rl_f(v, 32) + rl_f(v, 48)); }
DEV float wmaxf(float v) { v = max16_f(v); return fmaxf(fmaxf(rl_f(v, 0), rl_f(v, 16)), fmaxf(rl_f(v, 32), rl_f(v, 48))); }
DEV float sigmoidf_(float x) { return 1.0f / (1.0f + expf(-x)); }
DEV float gelu_exact(float x) { return 0.5f * x * (1.0f + erff(x * 0.70710678118654752f)); }
DEV void wave_lds_sync() { asm volatile("s_waitcnt lgkmcnt(0)" ::: "memory"); __builtin_amdgcn_wave_barrier(); asm volatile("" ::: "memory"); }
DEV float t5bias(const float* t5, int head, int dist) { int d = dist < 127 ? dist : 127; d = d < 0 ? 0 : d; return t5[(int)T5B[d] * 8 + head]; }


namespace pg8 {
#define PG8_LAS __attribute__((address_space(3)))
typedef unsigned short bf16_t;
typedef short bf16x8 __attribute__((ext_vector_type(8)));
typedef float f32x4 __attribute__((ext_vector_type(4)));
typedef unsigned u32x4 __attribute__((ext_vector_type(4)));
constexpr int BM = 256, BK = 64, HALF = 128, HTB = HALF * BK * 2  , STAGE_BYTES = 8 * HTB, NXCD = 8, WGM = 8;

__host__ __device__ __forceinline__ int lds_byte(int r, int c) { const int st = (r >> 4) * 2 + (c >> 5), rr = r & 15, cc = c & 31, ob = rr * 64 + cc * 2; return st * 1024 + (ob ^ (((ob >> 9) & 1) << 5)); }
__host__ __device__ __forceinline__ void stage_rc(int b, int& R, int& C) { const int st = b / 1024, sb = b % 1024, swz = sb ^ (((sb >> 9) & 1) << 5); R = (st >> 1) * 16 + swz / 64; C = (st & 1) * 32 + (swz % 64) / 2; }
__host__ __device__ __forceinline__ int perm32(int rho) { const int n = rho >> 4, i = rho & 15; return 8 * (i >> 2) + 4 * n + (i & 3); }

struct Unit { int pm, pn; };
struct Gemm { const bf16_t* A; const bf16_t* Bt; int M, N, K;
    unsigned pitchA = 0, pitchB = 0, kstepA = 0, kstepB = 0; size_t hstepA = 0, hstepB = 0, tA_pm = 0, tA_pn = 0, tB_pn = 0; int nt = 0; };

struct StaticOrder {
    int nM, nN, nwg, G, c;
    __host__ __device__ void init(int M, int N, int G_, int c_) { nM = M / BM; nN = N / BM; nwg = nM * nN; G = G_; c = c_; }
    __host__ __device__ bool next(int i, Unit& u) const {
        const long L = (long)i * G + c; if (L >= nwg) return false;
        int wgid = (int)L; { const int q = nwg / NXCD, r = nwg % NXCD, xcd = wgid % NXCD, off = wgid / NXCD; wgid = (xcd < r ? xcd * (q + 1) : r * (q + 1) + (xcd - r) * q) + off; }
        const int nig = WGM * nN, gid = wgid / nig, fm = gid * WGM, gsz = (nM - fm) < WGM ? (nM - fm) : WGM;
        u.pm = fm + ((wgid % nig) % gsz); u.pn = (wgid % nig) / gsz; return true;
    }
    __device__ __forceinline__ void a_ready(const Unit&) const {}
    __device__ __forceinline__ void done(const Unit&) const {}
};

__device__ __forceinline__ unsigned cvt_pk_bf16(float lo, float hi) { unsigned r; asm volatile("v_cvt_pk_bf16_f32 %0, %1, %2" : "=v"(r) : "v"(lo), "v"(hi)); return r; }
typedef float f32x2 __attribute__((ext_vector_type(2)));
__device__ __forceinline__ f32x2 gelu_pk(f32x2 v) {
    const f32x2 av = __builtin_elementwise_abs(v), d = av * 0.2316418882f + 1.0f;
    f32x2 t; t.x = __builtin_amdgcn_rcpf(d.x); t.y = __builtin_amdgcn_rcpf(d.y);
    f32x2 q = t * 0.5307027145f + (-0.7265760135f); q = q * t + 0.7107068705f; q = q * t + (-0.142248368f); q = q * t + 0.127414796f; q = q * t;
    const f32x2 s = (v * v) * (-0.72134752044f);
    f32x2 e; e.x = __builtin_amdgcn_exp2f(s.x); e.y = __builtin_amdgcn_exp2f(s.y);
    const f32x2 m = v * (q * e), r = v - m;
    f32x2 o; o.x = v.x < 0.f ? m.x : r.x; o.y = v.y < 0.f ? m.y : r.y; return o;
}

template <int ACT  > struct EpiBf16 {
    static constexpr bool PERM = true, AFTER_DRAIN = false, MIDK = false; static_assert(ACT == 0 || ACT == 1, "EpiBf16: ACT is 0 (none) or 1 (gelu_pk)");
    bf16_t* O; int ldc; const float* bias; int split_cols; size_t split_stride; float scale0;
    __device__ __forceinline__ void operator()(const f32x4 (&acc)[2][2][4][2], const Unit& u, int wr, int wc, int fr, int fq) const {
        const int row0 = u.pm * BM + wr * 64 + fr; int colt = u.pn * BM; bf16_t* base = O;
        float sc = 1.f; if (split_cols) { const int t = colt / split_cols; base += (size_t)t * split_stride; colt -= t * split_cols; if (t == 0) sc = scale0; }
        const int col0 = colt + wc * 32 + 8 * fq, bcol0 = u.pn * BM + wc * 32 + 8 * fq;
        f32x4 bv[2][2];
#pragma unroll
        for (int bj = 0; bj < 2; ++bj)
#pragma unroll
            for (int n = 0; n < 2; ++n) bv[bj][n] = bias ? *(const f32x4*)(bias + bcol0 + bj * HALF + 4 * n) : (f32x4){0.f, 0.f, 0.f, 0.f};
#pragma unroll
        for (int ai = 0; ai < 2; ++ai)
#pragma unroll
            for (int m = 0; m < 4; ++m) { bf16_t* rowp = base + (size_t)(row0 + ai * HALF + m * 16) * ldc + col0;
#pragma unroll
                for (int bj = 0; bj < 2; ++bj) { f32x4 v0 = acc[ai][bj][m][0] + bv[bj][0], v1 = acc[ai][bj][m][1] + bv[bj][1];
                    if (ACT == 1) { f32x2 a = gelu_pk((f32x2){v0[0], v0[1]}), b = gelu_pk((f32x2){v0[2], v0[3]}), c = gelu_pk((f32x2){v1[0], v1[1]}), d = gelu_pk((f32x2){v1[2], v1[3]});
                        v0 = (f32x4){a.x, a.y, b.x, b.y}; v1 = (f32x4){c.x, c.y, d.x, d.y}; }
                    v0 = v0 * sc; v1 = v1 * sc; u32x4 w; w.x = cvt_pk_bf16(v0[0], v0[1]); w.y = cvt_pk_bf16(v0[2], v0[3]); w.z = cvt_pk_bf16(v1[0], v1[1]); w.w = cvt_pk_bf16(v1[2], v1[3]);
                    *(u32x4*)(rowp + bj * HALF) = w; } }
    }
};

struct PanelStats {
    unsigned* xbuf;
    unsigned* cnt;
    unsigned* tmo;
    int ntn; float eps;
    unsigned code;
    __device__ __forceinline__ bool run(const f32x4 (&v)[2][2][4][2], const Unit& u, int wr, int wc, int fr, int fq, PG8_LAS unsigned char* lds, int wid, int lane) const {
        typedef float f32x2v __attribute__((ext_vector_type(2)));
        PG8_LAS f32x2v* P = (PG8_LAS f32x2v*)lds;
        PG8_LAS f32x2v* S = (PG8_LAS f32x2v*)(lds + 8192);
        PG8_LAS unsigned* flag = (PG8_LAS unsigned*)(lds + 8192 + 2048);
#pragma unroll
        for (int ai = 0; ai < 2; ++ai)
#pragma unroll
            for (int m = 0; m < 4; ++m) {
                float s = 0.f;
#pragma unroll
                for (int bj = 0; bj < 2; ++bj)
#pragma unroll
                    for (int n = 0; n < 2; ++n) { const f32x4 x = v[ai][bj][m][n]; s += (x[0] + x[1]) + (x[2] + x[3]); }
                s += __shfl_xor(s, 16); s += __shfl_xor(s, 32);
                const float mw = s * (1.0f / 64.0f); float q = 0.f;
#pragma unroll
                for (int bj = 0; bj < 2; ++bj)
#pragma unroll
                    for (int n = 0; n < 2; ++n) { const f32x4 d = v[ai][bj][m][n] - mw; q += (d[0] * d[0] + d[1] * d[1]) + (d[2] * d[2] + d[3] * d[3]); }
                q += __shfl_xor(q, 16); q += __shfl_xor(q, 32);
                if (fq == 0) P[(ai * HALF + wr * 64 + m * 16 + fr) * 4 + wc] = (f32x2v){mw, q};
            }
        asm volatile("s_waitcnt lgkmcnt(0)" ::: "memory"); __builtin_amdgcn_s_barrier(); asm volatile("" ::: "memory");
#if defined(BROKEN_EXCHANGE_NO_WAIT)
#warning BROKEN CONTROL BUILD: the row-statistics exchange does not wait; results are wrong by design
        if (blockIdx.x >= 64) { const long long t0_ = clock64(); while (clock64() - t0_ < 60000) __builtin_amdgcn_s_sleep(8); }
#endif
        const int row = wid * 32 + (lane & 31);
        if (lane < 32) {
            const f32x2v a = P[row * 4 + 0], b = P[row * 4 + 1], c = P[row * 4 + 2], d = P[row * 4 + 3];
            const float mt = (a.x + b.x + c.x + d.x) * 0.25f;
            const float da = a.x - mt, db = b.x - mt, dc = c.x - mt, dd = d.x - mt;
            const float m2 = (a.y + b.y) + (c.y + d.y) + 64.0f * ((da * da + db * db) + (dc * dc + dd * dd));
            unsigned long long* slot = (unsigned long long*)xbuf + ((size_t)(u.pm * BM + row) * 4 + u.pn);
            __hip_atomic_store(slot, ((unsigned long long)__float_as_uint(m2) << 32) | __float_as_uint(mt), __ATOMIC_RELAXED, __HIP_MEMORY_SCOPE_AGENT);
        }
        asm volatile("s_waitcnt vmcnt(0)" ::: "memory");
        if (lane == 0) __hip_atomic_fetch_add(cnt + 64 * u.pm, 1u, __ATOMIC_RELAXED, __HIP_MEMORY_SCOPE_AGENT);
        if (wid == 0) {
            bool dead = false; const unsigned long long t0 = __builtin_amdgcn_s_memrealtime(); const unsigned want = 8u * (unsigned)ntn;
            for (;;) {
#if defined(BROKEN_EXCHANGE_NO_WAIT)
                break;
#endif
                if ((unsigned)__builtin_amdgcn_readfirstlane(__hip_atomic_load(cnt + 64 * u.pm, __ATOMIC_RELAXED, __HIP_MEMORY_SCOPE_AGENT)) >= want) break;
                if (__builtin_amdgcn_s_memrealtime() - t0 > 2000000ull) {
                    if (lane == 0) { unsigned expect = 0u; __hip_atomic_compare_exchange_strong(tmo + 1, &expect, code | (unsigned)(u.pm & 0xff), __ATOMIC_RELAXED, __ATOMIC_RELAXED, __HIP_MEMORY_SCOPE_AGENT);
                                     __hip_atomic_store(tmo, 1u, __ATOMIC_RELAXED, __HIP_MEMORY_SCOPE_AGENT); }
                    dead = true; break; }
                __builtin_amdgcn_s_sleep(2);
            }
            __builtin_amdgcn_fence(__ATOMIC_ACQUIRE, "agent");
            if (lane == 0) flag[0] = dead ? 1u : 0u;
        }
        asm volatile("s_waitcnt vmcnt(0) lgkmcnt(0)" ::: "memory"); __builtin_amdgcn_s_barrier(); asm volatile("" ::: "memory");
        const bool bad = flag[0] != 0u;
        if (lane < 32) {
            const unsigned long long* slot = (const unsigned long long*)xbuf + (size_t)(u.pm * BM + row) * 4; float mt[4], m2[4]; float ms = 0.f;
#pragma unroll
            for (int t = 0; t < 4; ++t) { if (t < ntn) { const unsigned long long w = __hip_atomic_load(slot + t, __ATOMIC_RELAXED, __HIP_MEMORY_SCOPE_AGENT); mt[t] = __uint_as_float((unsigned)w); m2[t] = __uint_as_float((unsigned)(w >> 32)); } else { mt[t] = 0.f; m2[t] = 0.f; } ms += mt[t]; }
            const float mean = ms / (float)ntn; float q = 0.f;
#pragma unroll
            for (int t = 0; t < 4; ++t) if (t < ntn) { const float dm = mt[t] - mean; q += m2[t] + 256.0f * dm * dm; }
            S[row] = (f32x2v){mean, 1.0f / sqrtf(q / (256.0f * (float)ntn) + eps)};
        }
        asm volatile("s_waitcnt lgkmcnt(0)" ::: "memory"); __builtin_amdgcn_s_barrier(); asm volatile("" ::: "memory");
        return bad;
    }
};
struct EpiLnRes {
    static constexpr bool PERM = false, AFTER_DRAIN = true, MIDK = false;
    const float* base; float* out; int ldc; const float* bias; PanelStats st; unsigned poison;
    __device__ __forceinline__ void fused(f32x4 (&acc)[2][2][4][2], const Unit& u, int wr, int wc, int fr, int fq, PG8_LAS unsigned char* lds, int wid, int lane) const {
        typedef float f32x2v __attribute__((ext_vector_type(2)));
        const PG8_LAS f32x2v* S = (const PG8_LAS f32x2v*)(lds + 8192);
        const int col0 = u.pn * BM + wc * 32 + 4 * fq;
#pragma unroll
        for (int bj = 0; bj < 2; ++bj)
#pragma unroll
            for (int n = 0; n < 2; ++n) { const f32x4 bv = bias ? *(const f32x4*)(bias + col0 + bj * HALF + n * 16) : (f32x4){0.f, 0.f, 0.f, 0.f};
#pragma unroll
                for (int ai = 0; ai < 2; ++ai)
#pragma unroll
                    for (int m = 0; m < 4; ++m) acc[ai][bj][m][n] += bv; }
        f32x4 pre[4][2][2];
#pragma unroll
        for (int m = 0; m < 4; ++m) { const size_t off = (size_t)(u.pm * BM + wr * 64 + m * 16 + fr) * ldc + col0;
#pragma unroll
            for (int bj = 0; bj < 2; ++bj)
#pragma unroll
                for (int n = 0; n < 2; ++n) pre[m][bj][n] = *(const f32x4*)(base + off + bj * HALF + n * 16); }
        const bool bad = st.run(acc, u, wr, wc, fr, fq, lds, wid, lane) || poison != 0u;
        const float qnan = __builtin_nanf("");
#pragma unroll
        for (int ai = 0; ai < 2; ++ai)
#pragma unroll
            for (int m = 0; m < 4; ++m) { const int r = ai * HALF + wr * 64 + m * 16 + fr; const f32x2v sr = S[r]; const size_t off = (size_t)(u.pm * BM + r) * ldc + col0;
#pragma unroll
                for (int bj = 0; bj < 2; ++bj)
#pragma unroll
                    for (int n = 0; n < 2; ++n) { const f32x4 bs = ai == 0 ? pre[m][bj][n] : *(const f32x4*)(base + off + bj * HALF + n * 16); f32x4 o = bs + (acc[ai][bj][m][n] - sr.x) * sr.y;
                        if (bad) o = (f32x4){qnan, qnan, qnan, qnan}; *(f32x4*)(out + off + bj * HALF + n * 16) = o; }
                if (m & 1) asm volatile("" ::: "memory"); }
    }
};
struct EpiLnResLn {
    static constexpr bool PERM = false, AFTER_DRAIN = true, MIDK = false;
    const float* base; float* out; bf16_t* xn; int ldc; const float* bias; PanelStats st1, st2; unsigned poison;
    __device__ __forceinline__ void fused(f32x4 (&acc)[2][2][4][2], const Unit& u, int wr, int wc, int fr, int fq, PG8_LAS unsigned char* lds, int wid, int lane) const {
        typedef float f32x2v __attribute__((ext_vector_type(2))); typedef unsigned u32x2v __attribute__((ext_vector_type(2)));
        const PG8_LAS f32x2v* S = (const PG8_LAS f32x2v*)(lds + 8192);
        const int col0 = u.pn * BM + wc * 32 + 4 * fq;
#pragma unroll
        for (int bj = 0; bj < 2; ++bj)
#pragma unroll
            for (int n = 0; n < 2; ++n) { const f32x4 bv = bias ? *(const f32x4*)(bias + col0 + bj * HALF + n * 16) : (f32x4){0.f, 0.f, 0.f, 0.f};
#pragma unroll
                for (int ai = 0; ai < 2; ++ai)
#pragma unroll
                    for (int m = 0; m < 4; ++m) acc[ai][bj][m][n] += bv; }
        bool bad = st1.run(acc, u, wr, wc, fr, fq, lds, wid, lane) || poison != 0u;
        const float qnan = __builtin_nanf("");
#pragma unroll
        for (int ai = 0; ai < 2; ++ai)
#pragma unroll
            for (int m = 0; m < 4; ++m) { const int r = ai * HALF + wr * 64 + m * 16 + fr; const f32x2v sr = S[r]; const size_t off = (size_t)(u.pm * BM + r) * ldc + col0;
#pragma unroll
                for (int bj = 0; bj < 2; ++bj)
#pragma unroll
                    for (int n = 0; n < 2; ++n) { const f32x4 bs = *(const f32x4*)(base + off + bj * HALF + n * 16); acc[ai][bj][m][n] = bs + (acc[ai][bj][m][n] - sr.x) * sr.y; }
                asm volatile("" : "+v"(acc[ai][0][m][0]), "+v"(acc[ai][0][m][1]), "+v"(acc[ai][1][m][0]), "+v"(acc[ai][1][m][1]));
                if (m & 1) asm volatile("" ::: "memory"); }
        const bool bad1 = bad;
        bad = st2.run(acc, u, wr, wc, fr, fq, lds, wid, lane) || bad;
#pragma unroll
        for (int ai = 0; ai < 2; ++ai)
#pragma unroll
            for (int m = 0; m < 4; ++m) { const int r = ai * HALF + wr * 64 + m * 16 + fr; const f32x2v sr = S[r]; const size_t off = (size_t)(u.pm * BM + r) * ldc + col0;
#pragma unroll
                for (int bj = 0; bj < 2; ++bj)
#pragma unroll
                    for (int n = 0; n < 2; ++n) { const f32x4 x1 = acc[ai][bj][m][n]; *(f32x4*)(out + off + bj * HALF + n * 16) = bad1 ? (f32x4){qnan, qnan, qnan, qnan} : x1;
                        const f32x4 o = (x1 - sr.x) * sr.y; u32x2v w; w.x = cvt_pk_bf16(o[0], o[1]); w.y = cvt_pk_bf16(o[2], o[3]);
                        if (bad) { w.x = 0x7fc07fc0u; w.y = 0x7fc07fc0u; } *(u32x2v*)(xn + off + bj * HALF + n * 16) = w; }
                asm volatile("" ::: "memory"); }
    }
};

template <class Epi, class Sched, bool ALIGN_EPI = false, bool SP2 = false>
__device__ __forceinline__ void gemm_phase(PG8_LAS unsigned char* lds, const Gemm g, const Sched& S, const Epi& E) {
    int tid = threadIdx.x; asm volatile("" : "+v"(tid));
    const int wid = __builtin_amdgcn_readfirstlane(tid >> 6), lane = tid & 63, wr = wid >> 2, wc = wid & 3, fr = lane & 15, fq = lane >> 4;
    int K = g.K; asm volatile("" : "+s"(K)); const int nt = g.nt ? g.nt : K / BK;
    const unsigned pitchA = g.pitchA ? g.pitchA : (unsigned)K * 2u, pitchB = g.pitchB ? g.pitchB : (unsigned)K * 2u;
    unsigned voffA[2], voffB[2];
#pragma unroll
    for (int i = 0; i < 2; ++i) { int R, C; stage_rc(tid * 16 + i * 8192, R, C); const int Rb = Epi::PERM ? ((R & ~31) + perm32(R & 31)) : R;
        voffA[i] = (unsigned)R * pitchA + (unsigned)C * 2u; voffB[i] = (unsigned)Rb * pitchB + (unsigned)C * 2u; }
    const size_t kstepA = g.kstepA ? g.kstepA : (size_t)(BK * 2), kstepB = g.kstepB ? g.kstepB : (size_t)(BK * 2);
    const size_t hstepA = g.hstepA ? g.hstepA : (size_t)HALF * K * 2, hstepB = g.hstepB ? g.hstepB : (size_t)HALF * K * 2;
    const size_t tA_pm = g.tA_pm ? g.tA_pm : (size_t)BM * K * 2, tA_pn = g.tA_pn, tB_pn = g.tB_pn ? g.tB_pn : (size_t)BM * K * 2;
    const unsigned ldsw = (unsigned)wid * 1024u;
    const int aoff = lds_byte(wr * 64 + fr, fq * 8), boff = lds_byte(wc * 32 + fr, fq * 8);
#define PG8_SA(b, h) (((b) * 2 + (h)) * HTB)
#define PG8_SB(b, h) ((4 + (b) * 2 + (h)) * HTB)
#define PG8_STAGE(bufoff, gbase, voff) do { _Pragma("unroll") for (int _i = 0; _i < 2; ++_i) \
        __builtin_amdgcn_global_load_lds((const unsigned*)((const char*)(gbase) + (voff)[_i]), (PG8_LAS unsigned*)(lds + (bufoff) + ldsw + _i * 8192), 16, 0, 0); } while (0)
#define PG8_LDA(dst, b, h) do { _Pragma("unroll") for (int m = 0; m < 4; ++m) _Pragma("unroll") for (int k = 0; k < 2; ++k) dst[m][k] = *(const PG8_LAS bf16x8*)(lds + PG8_SA(b, h) + aoff + m * 2048 + k * 1024); } while (0)
#define PG8_LDB(dst, b, h) do { _Pragma("unroll") for (int n = 0; n < 2; ++n) _Pragma("unroll") for (int k = 0; k < 2; ++k) dst[n][k] = *(const PG8_LAS bf16x8*)(lds + PG8_SB(b, h) + boff + n * 2048 + k * 1024); } while (0)
#define PG8_MMA(ai, bj, At, Bt) do { __builtin_amdgcn_s_setprio(1); _Pragma("unroll") for (int m = 0; m < 4; ++m) _Pragma("unroll") for (int n = 0; n < 2; ++n) _Pragma("unroll") for (int k = 0; k < 2; ++k) \
        acc[ai][bj][m][n] = __builtin_amdgcn_mfma_f32_16x16x32_bf16(Bt[n][k], At[m][k], acc[ai][bj][m][n], 0, 0, 0); __builtin_amdgcn_s_setprio(0); } while (0)
#define PG8_WAIT_V(n) asm volatile("s_waitcnt vmcnt(" #n ")" ::: "memory")
#define PG8_WAIT_L(n) asm volatile("s_waitcnt lgkmcnt(" #n ")" ::: "memory")
#define PG8_BAR __builtin_amdgcn_s_barrier()
#define PG8_SCHED __builtin_amdgcn_sched_barrier(0)
    Unit cur, nxt; int ui = 0;
    if (!S.next(0, cur)) return;
    f32x4 acc[2][2][4][2];
#pragma unroll
    for (int a = 0; a < 2; ++a)
#pragma unroll
        for (int b = 0; b < 2; ++b)
#pragma unroll
            for (int m = 0; m < 4; ++m)
#pragma unroll
                for (int n = 0; n < 2; ++n) acc[a][b][m][n] = (f32x4){0.f, 0.f, 0.f, 0.f};
    bf16x8 At[4][2], B0[2][2], B1[2][2];
    const char* cA = (const char*)g.A + (size_t)cur.pm * tA_pm + (size_t)cur.pn * tA_pn; const char* cB = (const char*)g.Bt + (size_t)cur.pn * tB_pn;
    S.a_ready(cur);
    if constexpr (SP2) {
        PG8_STAGE(PG8_SB(0, 0), cB, voffB); PG8_STAGE(PG8_SB(0, 1), cB + hstepB, voffB); PG8_STAGE(PG8_SA(0, 0), cA, voffA); PG8_STAGE(PG8_SA(0, 1), cA + hstepA, voffA);
        if (wr == 1) PG8_BAR;
        PG8_WAIT_V(2); PG8_BAR;
        PG8_STAGE(PG8_SB(1, 0), cB + kstepB, voffB); PG8_STAGE(PG8_SA(1, 0), cA + kstepA, voffA); PG8_STAGE(PG8_SB(1, 1), cB + hstepB + kstepB, voffB);
        PG8_WAIT_V(6); PG8_BAR;
    } else {
        PG8_STAGE(PG8_SB(0, 0), cB, voffB); PG8_STAGE(PG8_SA(0, 0), cA, voffA); PG8_STAGE(PG8_SB(0, 1), cB + hstepB, voffB); PG8_STAGE(PG8_SA(0, 1), cA + hstepA, voffA);
        if (wr == 1) PG8_BAR;
        PG8_WAIT_V(4); PG8_BAR;
        PG8_STAGE(PG8_SB(1, 0), cB + kstepB, voffB); PG8_STAGE(PG8_SA(1, 0), cA + kstepA, voffA); PG8_STAGE(PG8_SB(1, 1), cB + hstepB + kstepB, voffB);
        PG8_WAIT_V(6); PG8_BAR;
    }
    for (;;) {
        const bool has_next = S.next(ui + 1, nxt);
        const char* nA = has_next ? (const char*)g.A + (size_t)nxt.pm * tA_pm + (size_t)nxt.pn * tA_pn : cA; const char* nB = has_next ? (const char*)g.Bt + (size_t)nxt.pn * tB_pn : cB;
        for (int t = 0; t < nt; t += 2) {
            if constexpr (Epi::MIDK) { if (t == (nt >> 1)) E.midk(acc, cur, wr, wc, fr, fq); }
            const bool last = (t == nt - 2);
            const char* a1 = cA + (size_t)(t + 1) * kstepA;
            const char* a2 = last ? nA : cA + (size_t)(t + 2) * kstepA; const char* b2 = last ? nB : cB + (size_t)(t + 2) * kstepB;
            const char* a3 = a2 + kstepA; const char* b3 = b2 + kstepB;
            if (last && has_next) S.a_ready(nxt);
            if constexpr (SP2) {
            PG8_LDB(B0, 0, 0); PG8_LDB(B1, 0, 1); PG8_SCHED; PG8_LDA(At, 0, 0); PG8_STAGE(PG8_SA(1, 1), a1 + hstepA, voffA);
            PG8_WAIT_V(8); PG8_WAIT_L(0); PG8_BAR; PG8_MMA(0, 0, At, B0); PG8_MMA(0, 1, At, B1); PG8_BAR; PG8_SCHED;
            PG8_LDA(At, 0, 1); PG8_STAGE(PG8_SB(0, 0), b2, voffB); PG8_STAGE(PG8_SB(0, 1), b2 + hstepB, voffB); PG8_STAGE(PG8_SA(0, 0), a2, voffA);
            PG8_WAIT_V(8); PG8_WAIT_L(0); PG8_BAR; PG8_MMA(1, 0, At, B0); PG8_MMA(1, 1, At, B1); PG8_BAR; PG8_SCHED;
            PG8_LDB(B0, 1, 0); PG8_LDB(B1, 1, 1); PG8_SCHED; PG8_LDA(At, 1, 0); PG8_STAGE(PG8_SA(0, 1), a2 + hstepA, voffA);
            PG8_WAIT_V(8); PG8_WAIT_L(0); PG8_BAR; PG8_MMA(0, 0, At, B0); PG8_MMA(0, 1, At, B1); PG8_BAR; PG8_SCHED;
            PG8_LDA(At, 1, 1); PG8_STAGE(PG8_SB(1, 0), b3, voffB); PG8_STAGE(PG8_SB(1, 1), b3 + hstepB, voffB); PG8_STAGE(PG8_SA(1, 0), a3, voffA);
            PG8_WAIT_V(8); PG8_WAIT_L(0); PG8_BAR; PG8_MMA(1, 0, At, B0); PG8_MMA(1, 1, At, B1); PG8_BAR; PG8_SCHED;
            } else {
            PG8_LDB(B0, 0, 0); PG8_SCHED; PG8_LDA(At, 0, 0); PG8_STAGE(PG8_SA(1, 1), a1 + hstepA, voffA);
            PG8_WAIT_L(8); PG8_BAR; PG8_WAIT_L(0); PG8_MMA(0, 0, At, B0); PG8_BAR; PG8_SCHED;
            PG8_LDB(B1, 0, 1); PG8_STAGE(PG8_SB(0, 0), b2, voffB);
            PG8_BAR; PG8_WAIT_L(0); PG8_MMA(0, 1, At, B1); PG8_BAR;
            PG8_LDA(At, 0, 1); PG8_STAGE(PG8_SA(0, 0), a2, voffA);
            PG8_BAR; PG8_WAIT_L(0); PG8_MMA(1, 0, At, B0); PG8_BAR; PG8_SCHED;
            PG8_STAGE(PG8_SB(0, 1), b2 + hstepB, voffB);
            PG8_WAIT_V(6); PG8_BAR; PG8_MMA(1, 1, At, B1); PG8_BAR;
            PG8_LDB(B0, 1, 0); PG8_SCHED; PG8_LDA(At, 1, 0); PG8_STAGE(PG8_SA(0, 1), a2 + hstepA, voffA);
            PG8_WAIT_L(8); PG8_BAR; PG8_WAIT_L(0); PG8_MMA(0, 0, At, B0); PG8_BAR; PG8_SCHED;
            PG8_LDB(B1, 1, 1); PG8_STAGE(PG8_SB(1, 0), b3, voffB);
            PG8_BAR; PG8_WAIT_L(0); PG8_MMA(0, 1, At, B1); PG8_BAR;
            PG8_LDA(At, 1, 1); PG8_STAGE(PG8_SA(1, 0), a3, voffA);
            PG8_BAR; PG8_WAIT_L(0); PG8_MMA(1, 0, At, B0); PG8_BAR; PG8_SCHED;
            PG8_STAGE(PG8_SB(1, 1), b3 + hstepB, voffB);
            PG8_WAIT_V(6); PG8_BAR; PG8_MMA(1, 1, At, B1); PG8_BAR;
            }
        }
        if constexpr (ALIGN_EPI) { if (wr == 0) PG8_BAR; }
        if constexpr (!Epi::AFTER_DRAIN) { E(acc, cur, wr, wc, fr, fq); S.done(cur); }
        if (!has_next) break;
#pragma unroll
        for (int a = 0; a < 2; ++a)
#pragma unroll
            for (int b = 0; b < 2; ++b)
#pragma unroll
                for (int m = 0; m < 4; ++m)
#pragma unroll
                    for (int n = 0; n < 2; ++n) acc[a][b][m][n] = (f32x4){0.f, 0.f, 0.f, 0.f};
        cur = nxt; cA = nA; cB = nB; ++ui;
        if constexpr (ALIGN_EPI) { if (wr == 1) PG8_BAR; }
    }
    PG8_WAIT_V(0);
    if constexpr (!ALIGN_EPI) { if (wr == 0) PG8_BAR; }
    PG8_BAR;
    if constexpr (Epi::AFTER_DRAIN) { E.fused(acc, cur, wr, wc, fr, fq, lds, wid, lane); S.done(cur); }
#undef PG8_SA
#undef PG8_SB
#undef PG8_STAGE
#undef PG8_LDA
#undef PG8_LDB
#undef PG8_MMA
#undef PG8_WAIT_V
#undef PG8_WAIT_L
#undef PG8_BAR
#undef PG8_SCHED
}
}

namespace pg8 {
constexpr float LOG2E = 1.4426950408889634f;
constexpr float QS_NSA = 0.125f * LOG2E;
constexpr float QS_MLA = 0.10206207261596575f * LOG2E;
__device__ __forceinline__ float fast_sigmoid(float x) { return __builtin_amdgcn_rcpf(1.0f + __builtin_amdgcn_exp2f(-LOG2E * x)); }
__device__ __forceinline__ float lo_bf(unsigned u) { return __uint_as_float(u << 16); }
__device__ __forceinline__ float hi_bf(unsigned u) { return __uint_as_float(u & 0xffff0000u); }
struct EpiInProjF {
    static constexpr bool PERM = true, AFTER_DRAIN = false, MIDK = false;
    bf16_t* proj; unsigned char* gates;
    __device__ __forceinline__ void operator()(const f32x4 (&acc)[2][2][4][2], const Unit& u, int wr, int wc, int fr, int fq) const {
        const bool isg = u.pn >= 7;
        bf16_t* base = proj; const int ld = 1792; const int colt = isg ? (u.pn - 7) * BM : u.pn * BM;
        const float sc = (u.pn < 2) ? QS_NSA : 1.0f;
        const int row0 = u.pm * BM + wr * 64 + fr, col0 = colt + wc * 32 + 8 * fq;
#pragma unroll
        for (int ai = 0; ai < 2; ++ai)
#pragma unroll
            for (int m = 0; m < 4; ++m) { bf16_t* rowp = base + (size_t)(row0 + ai * HALF + m * 16) * ld + col0;
#pragma unroll
                for (int bj = 0; bj < 2; ++bj) { f32x4 v0 = acc[ai][bj][m][0], v1 = acc[ai][bj][m][1];
                    if (isg) {
                        unsigned q[8];
#pragma unroll
                        for (int e = 0; e < 4; ++e) { q[e] = (unsigned)(fast_sigmoid(v0[e]) * 255.0f + 0.5f); q[4 + e] = (unsigned)(fast_sigmoid(v1[e]) * 255.0f + 0.5f); }
                        uint2 w; w.x = q[0] | (q[1] << 8) | (q[2] << 16) | (q[3] << 24); w.y = q[4] | (q[5] << 8) | (q[6] << 16) | (q[7] << 24);
                        *(uint2*)(gates + (size_t)(row0 + ai * HALF + m * 16) * 2048 + col0 + bj * HALF) = w;
                    } else { v0 = v0 * sc; v1 = v1 * sc;
                        u32x4 w; w.x = cvt_pk_bf16(v0[0], v0[1]); w.y = cvt_pk_bf16(v0[2], v0[3]); w.z = cvt_pk_bf16(v1[0], v1[1]); w.w = cvt_pk_bf16(v1[2], v1[3]);
                        *(u32x4*)(rowp + bj * HALF) = w; } } }
    }
};
template <int PASS> struct EpiMergeF {
    static constexpr bool PERM = true, AFTER_DRAIN = false, MIDK = false;
    const unsigned char* gates; bf16_t* merged;
    __device__ __forceinline__ void operator()(const f32x4 (&acc)[2][2][4][2], const Unit& u, int wr, int wc, int fr, int fq) const {
        const int row0 = u.pm * BM + wr * 64 + fr, col0 = u.pn * BM + wc * 32 + 8 * fq;
#pragma unroll
        for (int ai = 0; ai < 2; ++ai)
#pragma unroll
            for (int m = 0; m < 4; ++m) { const size_t r = (size_t)(row0 + ai * HALF + m * 16);
#pragma unroll
                for (int bj = 0; bj < 2; ++bj) { const int c = col0 + bj * HALF;
                    const uint2 g = *(const uint2*)(gates + r * 2048 + PASS * 1024 + c);
                    f32x4 v0 = acc[ai][bj][m][0] * (1.0f / 255.0f), v1 = acc[ai][bj][m][1] * (1.0f / 255.0f);
                    v0[0] *= (float)(g.x & 255u); v0[1] *= (float)((g.x >> 8) & 255u); v0[2] *= (float)((g.x >> 16) & 255u); v0[3] *= (float)(g.x >> 24);
                    v1[0] *= (float)(g.y & 255u); v1[1] *= (float)((g.y >> 8) & 255u); v1[2] *= (float)((g.y >> 16) & 255u); v1[3] *= (float)(g.y >> 24);
                    if (PASS == 1) { const u32x4 o = *(const u32x4*)(merged + r * 1024 + c);
                        v0[0] += lo_bf(o.x); v0[1] += hi_bf(o.x); v0[2] += lo_bf(o.y); v0[3] += hi_bf(o.y);
                        v1[0] += lo_bf(o.z); v1[1] += hi_bf(o.z); v1[2] += lo_bf(o.w); v1[3] += hi_bf(o.w); }
                    u32x4 w; w.x = cvt_pk_bf16(v0[0], v0[1]); w.y = cvt_pk_bf16(v0[2], v0[3]); w.z = cvt_pk_bf16(v1[0], v1[1]); w.w = cvt_pk_bf16(v1[2], v1[3]);
                    *(u32x4*)(merged + r * 1024 + c) = w; } }
    }
};
struct EpiMergeFusedF {
    static constexpr bool PERM = true, AFTER_DRAIN = false, MIDK = true;
    const unsigned char* gates; bf16_t* merged;
    __device__ __forceinline__ void midk(f32x4 (&acc)[2][2][4][2], const Unit& u, int wr, int wc, int fr, int fq) const {
        asm volatile("" : "+v"(fr), "+v"(fq));
        const int row0 = u.pm * BM + wr * 64 + fr, col0 = u.pn * BM + wc * 32 + 8 * fq;
#pragma unroll
        for (int ai = 0; ai < 2; ++ai)
#pragma unroll
            for (int m = 0; m < 4; ++m) { const size_t r = (size_t)(row0 + ai * HALF + m * 16);
#pragma unroll
                for (int bj = 0; bj < 2; ++bj) { const int c = col0 + bj * HALF;
                    const uint2 g0 = *(const uint2*)(gates + r * 2048 + c), g1 = *(const uint2*)(gates + r * 2048 + 1024 + c);
#pragma unroll
                    for (int e = 0; e < 4; ++e) {
                        const float a0 = (float)((g0.x >> (8 * e)) & 255u), b0 = fmaxf((float)((g1.x >> (8 * e)) & 255u), 1.0f);
                        const float a1 = (float)((g0.y >> (8 * e)) & 255u), b1 = fmaxf((float)((g1.y >> (8 * e)) & 255u), 1.0f);
                        acc[ai][bj][m][0][e] *= a0 * __builtin_amdgcn_rcpf(b0); acc[ai][bj][m][1][e] *= a1 * __builtin_amdgcn_rcpf(b1); }
                    asm volatile("" ::: "memory"); } }
    }
    __device__ __forceinline__ void operator()(const f32x4 (&acc)[2][2][4][2], const Unit& u, int wr, int wc, int fr, int fq) const {
        const int row0 = u.pm * BM + wr * 64 + fr, col0 = u.pn * BM + wc * 32 + 8 * fq;
#pragma unroll
        for (int ai = 0; ai < 2; ++ai)
#pragma unroll
            for (int m = 0; m < 4; ++m) { const size_t r = (size_t)(row0 + ai * HALF + m * 16);
#pragma unroll
                for (int bj = 0; bj < 2; ++bj) { const int c = col0 + bj * HALF;
                    const uint2 g1 = *(const uint2*)(gates + r * 2048 + 1024 + c);
                    f32x4 v0 = acc[ai][bj][m][0] * (1.0f / 255.0f), v1 = acc[ai][bj][m][1] * (1.0f / 255.0f);
#pragma unroll
                    for (int e = 0; e < 4; ++e) { v0[e] *= fmaxf((float)((g1.x >> (8 * e)) & 255u), 1.0f); v1[e] *= fmaxf((float)((g1.y >> (8 * e)) & 255u), 1.0f); }
                    u32x4 w; w.x = cvt_pk_bf16(v0[0], v0[1]); w.y = cvt_pk_bf16(v0[2], v0[3]); w.z = cvt_pk_bf16(v1[0], v1[1]); w.w = cvt_pk_bf16(v1[2], v1[3]);
                    *(u32x4*)(merged + r * 1024 + c) = w; } }
    }
};
struct EpiCmpOutF {
    static constexpr bool PERM = true, AFTER_DRAIN = false, MIDK = false;
    bf16_t* dst;
    __device__ __forceinline__ void operator()(const f32x4 (&acc)[2][2][4][2], const Unit& u, int wr, int wc, int fr, int fq) const {
        if (wc >= 2) return;
        const int row0 = u.pm * BM + wr * 64 + fr, col0 = wc * 32 + 8 * fq;
#pragma unroll
        for (int ai = 0; ai < 2; ++ai)
#pragma unroll
            for (int m = 0; m < 4; ++m) { const int r = row0 + ai * HALF + m * 16;
                if (r < BATCH * NC * 2) { const int g = r & 1, bc = r >> 1, b = bc / NC, c = bc % NC;
                    const f32x4 v0 = acc[ai][0][m][0], v1 = acc[ai][0][m][1];
                    u32x4 w; w.x = cvt_pk_bf16(v0[0], v0[1]); w.y = cvt_pk_bf16(v0[2], v0[3]); w.z = cvt_pk_bf16(v1[0], v1[1]); w.w = cvt_pk_bf16(v1[2], v1[3]);
                    *(u32x4*)(dst + ((size_t)(b * 2 + g) * 128 + c) * 64 + col0) = w; } }
    }
};
struct EpiSlabF {
    static constexpr bool PERM = false, AFTER_DRAIN = false, MIDK = false;
    float* slab;
    __device__ __forceinline__ void operator()(const f32x4 (&acc)[2][2][4][2], const Unit& u, int wr, int wc, int fr, int fq) const {
        const int row0 = u.pm * BM + wr * 64 + fr, col0 = wc * 32 + 4 * fq;
        float* base = slab + (size_t)u.pn * 2048 * 256;
#pragma unroll
        for (int ai = 0; ai < 2; ++ai)
#pragma unroll
            for (int m = 0; m < 4; ++m) { float* rowp = base + (size_t)(row0 + ai * HALF + m * 16) * 256 + col0;
#pragma unroll
                for (int bj = 0; bj < 2; ++bj)
#pragma unroll
                    for (int n = 0; n < 2; ++n) *(f32x4*)(rowp + bj * HALF + n * 16) = acc[ai][bj][m][n]; }
    }
};
struct EpiResidF {
    static constexpr bool PERM = false, AFTER_DRAIN = false, MIDK = false;
    const float* x; float* h;
    __device__ __forceinline__ void operator()(const f32x4 (&acc)[2][2][4][2], const Unit& u, int wr, int wc, int fr, int fq) const {
        const int row0 = u.pm * BM + wr * 64 + fr, col0 = u.pn * BM + wc * 32 + 4 * fq;
#pragma unroll
        for (int ai = 0; ai < 2; ++ai)
#pragma unroll
            for (int m = 0; m < 4; ++m) { const size_t off = (size_t)(row0 + ai * HALF + m * 16) * 1024 + col0;
#pragma unroll
                for (int bj = 0; bj < 2; ++bj)
#pragma unroll
                    for (int n = 0; n < 2; ++n) { const f32x4 xv = *(const f32x4*)(x + off + bj * HALF + n * 16); *(f32x4*)(h + off + bj * HALF + n * 16) = xv + acc[ai][bj][m][n]; } }
    }
};
struct EpiMlaQF {
    static constexpr bool PERM = false, AFTER_DRAIN = false, MIDK = false;
    bf16_t* q; const float2* cs;
    __device__ __forceinline__ void operator()(const f32x4 (&acc)[2][2][4][2], const Unit& u, int wr, int wc, int fr, int fq) const {
        const int row0 = u.pm * BM + wr * 64 + fr;
#pragma unroll
        for (int bj = 0; bj < 2; ++bj) {
            const int X = u.pn * BM + bj * HALF + wc * 32;
            const bool rope = (X % 96) == 64;
#pragma unroll
            for (int ai = 0; ai < 2; ++ai)
#pragma unroll
                for (int m = 0; m < 4; ++m) { const int r = row0 + ai * HALF + m * 16; const int pos = r & (SEQ - 1);
                    f32x4 v0 = acc[ai][bj][m][0], v1 = acc[ai][bj][m][1];
                    if (rope) {
#pragma unroll
                        for (int j = 0; j < 4; ++j) { const float2 c = cs[pos * 16 + 4 * fq + j]; const float x1 = v0[j], x2 = v1[j]; v0[j] = x1 * c.x - x2 * c.y; v1[j] = x2 * c.x + x1 * c.y; } }
                    v0 = v0 * QS_MLA; v1 = v1 * QS_MLA;
                    bf16_t* p = q + (size_t)r * 768 + X + 4 * fq;
                    uint2 w0, w1; w0.x = cvt_pk_bf16(v0[0], v0[1]); w0.y = cvt_pk_bf16(v0[2], v0[3]); w1.x = cvt_pk_bf16(v1[0], v1[1]); w1.y = cvt_pk_bf16(v1[2], v1[3]);
                    *(uint2*)p = w0; *(uint2*)(p + 16) = w1; }
        }
    }
};
}

#define PG8_SP2 true
#define PG8_ALIGN true
constexpr int NTHR = 512, NWV = NTHR / 64;
#define WAVE_IDS const int lane = threadIdx.x & 63, wv = threadIdx.x >> 6; const int gw = blockIdx.x * NWV + wv, nw = gridDim.x * NWV; (void)lane; (void)gw; (void)nw;

template <bool Q8> DEV void ph_rms1024(const float* __restrict__ src, const float* __restrict__ g, bf16_t* __restrict__ dst, int rows, unsigned* __restrict__ q8 = nullptr, float* __restrict__ qs = nullptr, int gw_o = -1, int nw_o = 0, const bf16_t* __restrict__ add = nullptr) {
  const int lane = threadIdx.x & 63; const int gw = (gw_o >= 0) ? gw_o : (int)(blockIdx.x * NWV + (threadIdx.x >> 6)); const int nw = (gw_o >= 0) ? nw_o : (int)(gridDim.x * NWV);
  float4 gg[4];
#pragma unroll
  for (int j = 0; j < 4; ++j) gg[j] = ((const float4*)g)[j * 64 + lane];
  float4 nx[4]; uint2 na[4];
  if (gw < rows) {
#pragma unroll
    for (int j = 0; j < 4; ++j) { nx[j] = ((const float4*)(src + (size_t)gw * 1024))[j * 64 + lane]; if (add) na[j] = ((const uint2*)(add + (size_t)gw * 1024))[j * 64 + lane]; } }
  for (int r = gw; r < rows; r += nw) {
    float4 v[4]; float ss = 0.f;
#pragma unroll
    for (int j = 0; j < 4; ++j) { v[j] = nx[j];
      if (add) { v[j].x += __uint_as_float(na[j].x << 16); v[j].y += __uint_as_float(na[j].x & 0xffff0000u); v[j].z += __uint_as_float(na[j].y << 16); v[j].w += __uint_as_float(na[j].y & 0xffff0000u); }
      ss += v[j].x * v[j].x + v[j].y * v[j].y + v[j].z * v[j].z + v[j].w * v[j].w; }
    if (r + nw < rows) {
#pragma unroll
      for (int j = 0; j < 4; ++j) { nx[j] = ((const float4*)(src + (size_t)(r + nw) * 1024))[j * 64 + lane]; if (add) na[j] = ((const uint2*)(add + (size_t)(r + nw) * 1024))[j * 64 + lane]; } }
    ss = wsum(ss);
    const float inv = rsqrtf(ss * (1.0f / 1024.0f) + 1e-6f);
    float mx = 0.f;
#pragma unroll
    for (int j = 0; j < 4; ++j) {
      v[j].x *= inv * gg[j].x; v[j].y *= inv * gg[j].y; v[j].z *= inv * gg[j].z; v[j].w *= inv * gg[j].w;
      uint2 o;
      o.x = (unsigned)f2bf(v[j].x) | ((unsigned)f2bf(v[j].y) << 16);
      o.y = (unsigned)f2bf(v[j].z) | ((unsigned)f2bf(v[j].w) << 16);
      ((uint2*)(dst + (size_t)r * 1024))[j * 64 + lane] = o;
      if (Q8) mx = fmaxf(mx, fmaxf(fmaxf(fabsf(v[j].x), fabsf(v[j].y)), fmaxf(fabsf(v[j].z), fabsf(v[j].w))));
    }
    if (Q8) {
      mx = wmaxf(mx);
      const float sc = fmaxf(mx, 1e-30f) * (1.0f / 127.0f), isc = 1.0f / sc;
#pragma unroll
      for (int j = 0; j < 4; ++j) {
        const int q0 = (int)rintf(v[j].x * isc), q1 = (int)rintf(v[j].y * isc), q2 = (int)rintf(v[j].z * isc), q3 = (int)rintf(v[j].w * isc);
        q8[(size_t)r * 256 + j * 64 + lane] = (unsigned)(q0 & 255) | ((unsigned)(q1 & 255) << 8) | ((unsigned)(q2 & 255) << 16) | ((unsigned)(q3 & 255) << 24);
      }
      if (lane == 0) qs[r] = sc;
    }
  }
}
DEV int win_src_col(int n) {
  if (n < 1280) return n;
  if (n < 1536) return 1304 + (n - 1280);
  if (n < 1664) return 1560 + (n - 1536);
  if (n < 1696) return 1688 + (n - 1664);
  if (n < 1720) return 1280 + (n - 1696);
  if (n < 1792) return -1;
  return 1720 + (n - 1792);
}
template <int MODE> DEV void tr_item(const float* __restrict__ W, int K, int Nsrc, bf16_t* __restrict__ WT, int Nblk, int Nvalid, __attribute__((address_space(3))) float* scr, int item, int lane, int pitch = 0, int koff = 0) {
  if (pitch == 0) pitch = K;
  const int kb = item / Nblk, nb = item % Nblk, k0 = 64 * kb, n0 = 32 * nb;
  const int n = n0 + (lane & 31);
  const int sc = (MODE == 1) ? win_src_col(n) : ((n < Nvalid) ? n : -1);
  float tv[32];
#pragma unroll
  for (int i = 0; i < 32; ++i) { const int kk = 2 * i + (lane >> 5); tv[i] = (sc >= 0) ? W[(size_t)(k0 + kk) * Nsrc + sc] : 0.f; }
#pragma unroll
  for (int i = 0; i < 32; ++i) { const int kk = 2 * i + (lane >> 5); scr[kk * 33 + (lane & 31)] = tv[i]; }
  asm volatile("s_waitcnt lgkmcnt(0)" ::: "memory");
  const int c = lane & 7;
#pragma unroll
  for (int j = 0; j < 4; ++j) { const int nn = (lane >> 3) + 8 * j; const __attribute__((address_space(3))) float* sp = scr + (8 * c) * 33 + nn;
    uint4 o;
    o.x = (unsigned)f2bf(sp[0 * 33]) | ((unsigned)f2bf(sp[1 * 33]) << 16); o.y = (unsigned)f2bf(sp[2 * 33]) | ((unsigned)f2bf(sp[3 * 33]) << 16);
    o.z = (unsigned)f2bf(sp[4 * 33]) | ((unsigned)f2bf(sp[5 * 33]) << 16); o.w = (unsigned)f2bf(sp[6 * 33]) | ((unsigned)f2bf(sp[7 * 33]) << 16);
    *(uint4*)(WT + (size_t)(n0 + nn) * pitch + koff + k0 + 8 * c) = o; }
  asm volatile("s_waitcnt lgkmcnt(0)" ::: "memory");
}
DEV void rope_entry(float2* __restrict__ cs, int i) {
  const int j = i & 15, pos = i >> 4;
  const float inv_freq = __builtin_amdgcn_exp2f(-(float)(2 * j) * (13.287712379549449f / 32.0f));
  const float rev = (float)pos * inv_freq * 0.15915494309189535f;
  const float fr = rev - floorf(rev);
  cs[i] = make_float2(__builtin_amdgcn_cosf(fr), __builtin_amdgcn_sinf(fr));
}
namespace att {
#define LAS3 __attribute__((address_space(3)))
typedef LAS3 char* lptr;
typedef LAS3 const char* lcptr;
using bf16x8 = __attribute__((ext_vector_type(8))) short;
using s16x4 = __attribute__((ext_vector_type(4))) short;
using f32x16 = __attribute__((ext_vector_type(16))) float;
typedef short v4i16_t __attribute__((ext_vector_type(4)));
typedef unsigned u32x4 __attribute__((ext_vector_type(4)));
typedef float f32x4_t __attribute__((ext_vector_type(4)));
typedef float f32x2_t __attribute__((ext_vector_type(2)));
typedef __bf16 bf16x2_t __attribute__((ext_vector_type(2)));
constexpr float LOG2E = 1.4426950408889634f;
constexpr float THR = 8.0f;
constexpr float NEG_INF = -__builtin_huge_valf();
constexpr int SLOT = 20480, KOFF = 0, VOFF = 12288;
constexpr int L_WSF = 2 * SLOT;
constexpr int L_TB = L_WSF + 2048;
constexpr int L_ST = L_TB + 8 * 320 * 4;
constexpr int L_SELM = L_ST + 768;
constexpr int L_SC = L_SELM + 256;
constexpr int L_IMPQ = L_SC + 64 * 33 * 4;
constexpr int L_IMPL = L_IMPQ + 4 * 64 * 33 * 4;
constexpr int L_FIN = L_IMPQ;
constexpr int L_END = L_IMPL + 4 * 64 * 33 * 4;
static_assert(L_END <= 131072, "attention LDS map");

__device__ __forceinline__ int crow(int r, int hi) { return (r & 3) + 8 * (r >> 2) + 4 * hi; }
__device__ __forceinline__ s16x4 vtr(lcptr p) { return __builtin_bit_cast(s16x4, __builtin_amdgcn_ds_read_tr16_b64_v4i16((LAS3 v4i16_t*)p)); }
__device__ __forceinline__ unsigned cvtpk(float lo, float hi) { f32x2_t v = {lo, hi}; bf16x2_t b = __builtin_convertvector(v, bf16x2_t); return __builtin_bit_cast(unsigned, b); }
__device__ __forceinline__ float xmax(float v) { auto rr = __builtin_amdgcn_permlane32_swap(__float_as_uint(v), __float_as_uint(v), false, false); return fmaxf(__uint_as_float(rr[0]), __uint_as_float(rr[1])); }
__device__ __forceinline__ float xsum(float v) { auto rr = __builtin_amdgcn_permlane32_swap(__float_as_uint(v), __float_as_uint(v), false, false); return __uint_as_float(rr[0]) + __uint_as_float(rr[1]); }
__device__ __forceinline__ float ex2(float x) { return __builtin_amdgcn_exp2f(x); }

template <int ND0> __device__ __forceinline__ void qkt(f32x16& p0, f32x16& p1, lcptr kb, const bf16x8* qr) {
  p0 = f32x16{}; p1 = f32x16{};
  __builtin_amdgcn_s_setprio(1);
#pragma unroll
  for (int d0 = 0; d0 < ND0; ++d0) {
    const bf16x8 b0 = *(const LAS3 bf16x8*)(kb + d0 * 2048);
    const bf16x8 b1 = *(const LAS3 bf16x8*)(kb + d0 * 2048 + 512);
    p0 = __builtin_amdgcn_mfma_f32_32x32x16_bf16(b0, qr[d0], p0, 0, 0, 0);
    p1 = __builtin_amdgcn_mfma_f32_32x32x16_bf16(b1, qr[d0], p1, 0, 0, 0);
  }
  __builtin_amdgcn_s_setprio(0);
}
template <int ND0> __device__ __forceinline__ void qkt_init(f32x16& p0, f32x16& p1, lcptr kb, const bf16x8* qr, const f32x16& c0, const f32x16& c1) {
  p0 = c0; p1 = c1;
  __builtin_amdgcn_s_setprio(1);
#pragma unroll
  for (int d0 = 0; d0 < ND0; ++d0) {
    const bf16x8 b0 = *(const LAS3 bf16x8*)(kb + d0 * 2048);
    const bf16x8 b1 = *(const LAS3 bf16x8*)(kb + d0 * 2048 + 512);
    p0 = __builtin_amdgcn_mfma_f32_32x32x16_bf16(b0, qr[d0], p0, 0, 0, 0);
    p1 = __builtin_amdgcn_mfma_f32_32x32x16_bf16(b1, qr[d0], p1, 0, 0, 0);
  }
  __builtin_amdgcn_s_setprio(0);
}
__device__ __forceinline__ void pv(f32x16 (&o)[2], lcptr vp, const unsigned (&pw)[16]) {
  __builtin_amdgcn_s_setprio(1);
#pragma unroll
  for (int d0 = 0; d0 < 2; ++d0)
#pragma unroll
    for (int ks = 0; ks < 4; ++ks) {
      const s16x4 lo = vtr(vp + d0 * 4096 + ks * 1024), hi4 = vtr(vp + d0 * 4096 + ks * 1024 + 512);
      const bf16x8 vf = {lo[0], lo[1], lo[2], lo[3], hi4[0], hi4[1], hi4[2], hi4[3]};
      const unsigned pa4[4] = {pw[4 * ks], pw[4 * ks + 1], pw[4 * ks + 2], pw[4 * ks + 3]};
      o[d0] = __builtin_amdgcn_mfma_f32_32x32x16_bf16(__builtin_bit_cast(bf16x8, pa4), vf, o[d0], 0, 0, 0);
    }
  __builtin_amdgcn_s_setprio(0);
}
__device__ __forceinline__ void softmax_step(f32x16& p0, f32x16& p1, float& m, float& l, f32x16 (&o)[2], LAS3 float* wsf, int r32, int hi, unsigned (&pw)[16]) {
  float rm = fmaxf(p0[0], p1[0]);
#pragma unroll
  for (int r = 1; r < 16; ++r) rm = fmaxf(rm, fmaxf(p0[r], p1[r]));
  rm = xmax(rm);
  if (__any(rm > m + THR)) {
    const float mn = fmaxf(m, rm);
    const float al = ex2(m - mn);
    m = mn; l *= al;
    if (hi == 0) wsf[r32] = al;
#pragma unroll
    for (int r = 0; r < 16; ++r) { const float f = wsf[crow(r, hi)]; o[0][r] *= f; o[1][r] *= f; }
  }
  float s = 0.f;
#pragma unroll
  for (int r = 0; r < 16; ++r) { p0[r] = ex2(p0[r] - m); p1[r] = ex2(p1[r] - m); s += p0[r] + p1[r]; }
  l += s;
#pragma unroll
  for (int i = 0; i < 8; ++i) { pw[i] = cvtpk(p0[2 * i], p0[2 * i + 1]); pw[8 + i] = cvtpk(p1[2 * i], p1[2 * i + 1]); }
}
struct KVSrc { const bf16_t* k; const bf16_t* v; int ldk, ldv; };
__device__ __forceinline__ void kv_issue(const KVSrc& s, int row0, u32x4& rk, u32x4& rv, int tid) {
  const int kv = tid & 63, ch = tid >> 6, ln = tid & 63;
  rk = *(const u32x4*)(s.k + (size_t)(row0 + kv) * s.ldk + ch * 8);
  rv = *(const u32x4*)(s.v + (size_t)(row0 + 16 * (ch & 3) + (ln >> 2)) * s.ldv + (ch >> 2) * 32 + (ln & 3) * 8);
}
__device__ __forceinline__ void kv_commit(lptr slot, const u32x4& rk, const u32x4& rv, int tid) {
  *(LAS3 u32x4*)(slot + KOFF + (tid >> 6) * 1024 + (tid & 63) * 16) = rk;
  *(LAS3 u32x4*)(slot + VOFF + tid * 16) = rv;
}
__device__ __forceinline__ void fin_set(LAS3 float* finl, const f32x16 (&o)[2], int lane) {
#pragma unroll
  for (int d0 = 0; d0 < 2; ++d0)
#pragma unroll
    for (int r = 0; r < 16; ++r) finl[(d0 * 16 + r) * 64 + lane] = o[d0][r];
}
__device__ __forceinline__ void fin_add(LAS3 float* finl, const f32x16 (&o)[2], const LAS3 float* wsf, int lane, int hi) {
#pragma unroll
  for (int r = 0; r < 16; ++r) { const float f = wsf[crow(r, hi)];
#pragma unroll
    for (int d0 = 0; d0 < 2; ++d0) finl[(d0 * 16 + r) * 64 + lane] += o[d0][r] * f; }
}
__device__ __forceinline__ void fin_store(const LAS3 float* finl, bf16_t* gout, size_t rowbase, int ld, int colbase, int lane) {
#pragma unroll
  for (int i = 0; i < 4; ++i) {
    const int q = i * 8 + (lane >> 3), ch = lane & 7;
    const int qh = (q >> 2) & 1, r = (q & 3) + 4 * (q >> 3), d0 = ch >> 2, dl = (ch & 3) * 8;
    const LAS3 float* p = finl + (d0 * 16 + r) * 64 + qh * 32 + dl;
    const f32x4_t x0 = *(const LAS3 f32x4_t*)p, x1 = *(const LAS3 f32x4_t*)(p + 4);
    u32x4 v; v.x = cvtpk(x0[0], x0[1]); v.y = cvtpk(x0[2], x0[3]); v.z = cvtpk(x1[0], x1[1]); v.w = cvtpk(x1[2], x1[3]);
    *(u32x4*)(gout + (rowbase + q) * (size_t)ld + colbase + ch * 8) = v;
  }
}

__device__ __forceinline__ void nsa_unit(int b, int g, int c, const bf16_t* __restrict__ proj, const bf16_t* __restrict__ kc, const bf16_t* __restrict__ vc, bf16_t* __restrict__ onsa, lptr lds) {
  int tid = threadIdx.x; asm volatile("" : "+v"(tid));
  const int lane = tid & 63, r32 = lane & 31, hi = lane >> 5;
  const int w = __builtin_amdgcn_readfirstlane(tid >> 6);
  const int rh = w >> 1, head = g * 4 + rh, tokl = 32 * (w & 1) + r32, t = 64 * c + tokl, bg = b * 2 + g;
  const size_t tok = (size_t)b * SEQ + t;
  LAS3 float* wsf = (LAS3 float*)(lds + L_WSF) + w * 64;
  const LAS3 float* tb = (const LAS3 float*)(lds + L_TB) + head * 320 + 64;
  const LAS3 float* stp = (const LAS3 float*)(lds + L_ST);
  LAS3 unsigned* selm = (LAS3 unsigned*)(lds + L_SELM);
  LAS3 float* sc = (LAS3 float*)(lds + L_SC);
  LAS3 float* impq = (LAS3 float*)(lds + L_IMPQ);
  LAS3 float* impl = (LAS3 float*)(lds + L_IMPL);
  const lcptr kb0 = (lcptr)lds + KOFF + hi * 1024 + r32 * 16;
  const lcptr vp0 = (lcptr)lds + VOFF + ((lane >> 4) & 1) * 32 + (lane & 3) * 8 + (4 * hi + ((lane & 15) >> 2)) * 64;
  bf16x8 qr[4];
#pragma unroll
  for (int d0 = 0; d0 < 4; ++d0) qr[d0] = *(const bf16x8*)(proj + tok * PROJ_LD + PC_Q + head * 64 + d0 * 16 + hi * 8);
  float gate[3];
#pragma unroll
  for (int j = 0; j < 3; ++j) gate[j] = 1.0f / (1.0f + ex2(-LOG2E * bf2f(proj[tok * PROJ_LD + PC_GATE + head * 3 + j])));
  LAS3 float* finl = (LAS3 float*)(lds + L_FIN) + w * 2048;
  f32x16 o[2]; unsigned pw[16];
  u32x4 rk, rv;
  {
    const KVSrc src{kc + (size_t)bg * 128 * 64, vc + (size_t)bg * 128 * 64, 64, 64};
    __syncthreads();
    kv_issue(src, 0, rk, rv, tid); kv_commit(lds, rk, rv, tid);
    kv_issue(src, 64, rk, rv, tid); kv_commit(lds + SLOT, rk, rv, tid);
    __syncthreads();
    f32x16 a0, a1, b0, b1;
    const int twmin = 64 * c + 32 * (w & 1), twmax = twmin + 31;
    const bool live0 = true, live1 = (16 * 32 + 31 <= twmax), live2 = (16 * 64 + 31 <= twmax), live3 = (16 * 96 + 31 <= twmax);
    qkt<4>(a0, a1, kb0, qr);
    if (live2) qkt<4>(b0, b1, kb0 + SLOT, qr); else { b0 = f32x16{}; b1 = f32x16{}; }
    float rm = NEG_INF;
#define CMP_QUARTER(P, QTR, LIVE) do { if (LIVE) { \
      if (!(16 * (32 * (QTR) + 31) + 31 + 112 < twmin)) { \
        _Pragma("unroll") for (int r = 0; r < 16; ++r) { int d_ = t - 16 * (32 * (QTR) + crow(r, hi)) - 31; d_ = d_ < -64 ? -64 : (d_ > 255 ? 255 : d_); P[r] += tb[d_]; } } \
      _Pragma("unroll") for (int r = 0; r < 16; ++r) rm = fmaxf(rm, P[r]); } } while (0)
    CMP_QUARTER(a0, 0, live0); CMP_QUARTER(a1, 1, live1); CMP_QUARTER(b0, 2, live2); CMP_QUARTER(b1, 3, live3);
#undef CMP_QUARTER
    rm = xmax(rm);
    const float mref = (rm == NEG_INF) ? 0.f : rm;
    float s = 0.f;
#define CMP_EXP(P, LIVE) do { if (LIVE) { _Pragma("unroll") for (int r = 0; r < 16; ++r) { P[r] = ex2(P[r] - mref); s += P[r]; } } else { _Pragma("unroll") for (int r = 0; r < 16; ++r) P[r] = 0.f; } } while (0)
    CMP_EXP(a0, live0); CMP_EXP(a1, live1); CMP_EXP(b0, live2); CMP_EXP(b1, live3);
#undef CMP_EXP
    s = xsum(s);
    const float inv = (s > 0.f) ? 1.0f / s : 0.f;
#pragma unroll
    for (int r = 0; r < 16; ++r) { a0[r] *= inv; a1[r] *= inv; b0[r] *= inv; b1[r] *= inv; }
    { LAS3 float* iq = impq + (rh * 64 + tokl) * 33; LAS3 float* il = impl + (rh * 64 + tokl) * 33;
#pragma unroll
      for (int q4 = 0; q4 < 4; ++q4) {
        const int gi = 2 * q4 + hi;
        iq[gi] = (a0[4 * q4] + a0[4 * q4 + 1]) + (a0[4 * q4 + 2] + a0[4 * q4 + 3]);           il[gi] = a0[4 * q4 + 3];
        iq[8 + gi] = (a1[4 * q4] + a1[4 * q4 + 1]) + (a1[4 * q4 + 2] + a1[4 * q4 + 3]);       il[8 + gi] = a1[4 * q4 + 3];
        iq[16 + gi] = (b0[4 * q4] + b0[4 * q4 + 1]) + (b0[4 * q4 + 2] + b0[4 * q4 + 3]);      il[16 + gi] = b0[4 * q4 + 3];
        iq[24 + gi] = (b1[4 * q4] + b1[4 * q4 + 1]) + (b1[4 * q4 + 2] + b1[4 * q4 + 3]);      il[24 + gi] = b1[4 * q4 + 3];
      } }
    o[0] = f32x16{}; o[1] = f32x16{};
#pragma unroll
    for (int i = 0; i < 8; ++i) { pw[i] = cvtpk(a0[2 * i], a0[2 * i + 1]); pw[8 + i] = cvtpk(a1[2 * i], a1[2 * i + 1]); }
    pv(o, vp0, pw);
    if (live2) {
#pragma unroll
      for (int i = 0; i < 8; ++i) { pw[i] = cvtpk(b0[2 * i], b0[2 * i + 1]); pw[8 + i] = cvtpk(b1[2 * i], b1[2 * i + 1]); }
      pv(o, vp0 + SLOT, pw); }
    if (hi == 0) wsf[r32] = gate[0];
#pragma unroll
    for (int r = 0; r < 16; ++r) { const float f = wsf[crow(r, hi)]; o[0][r] *= f; o[1][r] *= f; }
  }
  __syncthreads();
  const KVSrc ssrc{proj + (size_t)b * SEQ * PROJ_LD + PC_KV + 2 * 128 + g * 64, proj + (size_t)b * SEQ * PROJ_LD + PC_KV + 3 * 128 + g * 64, PROJ_LD, PROJ_LD};
  kv_issue(ssrc, 0, rk, rv, tid);
  {
    const int stok = tid >> 3, sub = tid & 7;
#pragma unroll
    for (int k = 0; k < 4; ++k) {
      const int n = sub * 4 + k;
      float imp = 0.f;
#pragma unroll
      for (int hh = 0; hh < 4; ++hh) imp += impq[(hh * 64 + stok) * 33 + n] + ((n > 0) ? impl[(hh * 64 + stok) * 33 + n - 1] : 0.f);
      sc[stok * 33 + n] = (n > c) ? -1.0f : ((n == 0 || n == c || n == c - 1) ? 1e4f : imp);
    }
    if (tid < 64) selm[tid] = 0u;
    __syncthreads();
    float srow[32];
#pragma unroll
    for (int mm = 0; mm < 32; ++mm) srow[mm] = sc[stok * 33 + mm];
    unsigned bits = 0u;
#pragma unroll
    for (int k = 0; k < 4; ++k) {
      const int n = sub * 4 + k; const float sv = sc[stok * 33 + n]; int rank = 0;
#pragma unroll
      for (int mm = 0; mm < 32; ++mm) rank += (srow[mm] > sv || (srow[mm] == sv && mm < n)) ? 1 : 0;
      if (rank < 16) bits |= 1u << n;
    }
    if (bits) atomicOr((unsigned*)(selm + stok), bits);
    __syncthreads();
  }
  const unsigned mysel = selm[tokl];
  fin_set(finl, o, lane);
#pragma unroll 1
  for (int br = 0; br < 2; ++br) {
    const KVSrc src = (br == 0) ? ssrc : KVSrc{proj + (size_t)b * SEQ * PROJ_LD + PC_KV + 4 * 128 + g * 64, proj + (size_t)b * SEQ * PROJ_LD + PC_KV + 5 * 128 + g * 64, PROJ_LD, PROJ_LD};
    const int n0 = (br == 0) ? 0 : ((c > 8) ? c - 8 : 0);
    if (br == 1) { __syncthreads(); kv_issue(src, n0 * 64, rk, rv, tid); }
    kv_commit(lds, rk, rv, tid);
    float m = -1e30f, l = 0.f;
    o[0] = f32x16{}; o[1] = f32x16{};
    int cur = 0;
#pragma unroll 1
    for (int n = n0; n <= c; ++n) {
      __syncthreads();
      if (n < c) kv_issue(src, (n + 1) * 64, rk, rv, tid);
      const bool mine = (br == 1) || ((mysel >> n) & 1u);
      if (__any(mine)) {
        f32x16 p0, p1;
        if (n + 2 >= c) {
          const LAS3 float* bp = tb + (t - 64 * n) - 4 * hi - 63;
          f32x16 c0, c1;
#pragma unroll
          for (int r = 0; r < 16; ++r) { c0[r] = bp[63 - ((r & 3) + 8 * (r >> 2))]; c1[r] = bp[31 - ((r & 3) + 8 * (r >> 2))]; }
          qkt_init<4>(p0, p1, kb0 + cur * SLOT, qr, c0, c1);
        } else if (br == 1 && n + 8 == c) {
          const LAS3 float* bp = stp + (607 - (t - 64 * n)) + 4 * hi;
          f32x16 c0, c1;
#pragma unroll
          for (int r = 0; r < 16; ++r) { c0[r] = bp[(r & 3) + 8 * (r >> 2)]; c1[r] = bp[32 + (r & 3) + 8 * (r >> 2)]; }
          qkt_init<4>(p0, p1, kb0 + cur * SLOT, qr, c0, c1);
        } else qkt<4>(p0, p1, kb0 + cur * SLOT, qr);
        if (!mine) {
#pragma unroll
          for (int r = 0; r < 16; ++r) { p0[r] = NEG_INF; p1[r] = NEG_INF; } }
        softmax_step(p0, p1, m, l, o, wsf, r32, hi, pw);
        pv(o, vp0 + cur * SLOT, pw);
      }
      if (n < c) kv_commit(lds + (cur ^ 1) * SLOT, rk, rv, tid);
      cur ^= 1;
    }
    l = xsum(l);
    const float gi = gate[1 + br] / fmaxf(l, 1e-30f);
    if (hi == 0) wsf[r32] = gi;
    fin_add(finl, o, wsf, lane, hi);
  }
  fin_store(finl, onsa, (size_t)b * SEQ + 64 * c + 32 * (w & 1), 1024, head * 64, lane);
}

__device__ __forceinline__ void mla_unit(int b, int h, int qb, const bf16_t* __restrict__ mq, const bf16_t* __restrict__ mkv, const bf16_t* __restrict__ kr, bf16_t* __restrict__ omla, lptr lds) {
  int tid = threadIdx.x; asm volatile("" : "+v"(tid));
  const int lane = tid & 63, r32 = lane & 31, hi = lane >> 5;
  const int w = __builtin_amdgcn_readfirstlane(tid >> 6);
  const int q0 = 256 * qb, qw = q0 + 32 * w, qpos = qw + r32;
  const size_t tokq = (size_t)b * SEQ + qpos;
  LAS3 float* wsf = (LAS3 float*)(lds + L_WSF) + w * 64;
  const lcptr kb0 = (lcptr)lds + KOFF + hi * 1024 + r32 * 16;
  const lcptr vp0 = (lcptr)lds + VOFF + ((lane >> 4) & 1) * 32 + (lane & 3) * 8 + (4 * hi + ((lane & 15) >> 2)) * 64;
  const LAS3 float* stp = (const LAS3 float*)(lds + L_ST);
  bf16x8 qr[6];
#pragma unroll
  for (int d0 = 0; d0 < 6; ++d0) qr[d0] = *(const bf16x8*)(mq + tokq * 768 + h * 96 + d0 * 16 + hi * 8);
  const KVSrc src{mkv + (size_t)b * SEQ * 1024 + h * 128, mkv + (size_t)b * SEQ * 1024 + h * 128 + 64, 1024, 1024};
  const bf16_t* krb = kr + (size_t)b * SEQ * 32;
  const int NTL = 4 * (qb + 1);
  u32x4 rk, rv, rr = {0u, 0u, 0u, 0u};
  f32x16 o[2]; o[0] = f32x16{}; o[1] = f32x16{};
  unsigned pw[16];
  float m = -1e30f, l = 0.f;
  __syncthreads();
  kv_issue(src, 0, rk, rv, tid);
  if (tid < 256) rr = *(const u32x4*)(krb + (size_t)(tid & 63) * 32 + (tid >> 6) * 8);
  kv_commit(lds, rk, rv, tid);
  if (tid < 256) *(LAS3 u32x4*)(lds + KOFF + (8 + (tid >> 6)) * 1024 + (tid & 63) * 16) = rr;
  int cur = 0;
#pragma unroll 1
  for (int tl = 0; tl < NTL; ++tl) {
    __syncthreads();
    if (tl + 1 < NTL) { kv_issue(src, (tl + 1) * 64, rk, rv, tid); if (tid < 256) rr = *(const u32x4*)(krb + (size_t)((tl + 1) * 64 + (tid & 63)) * 32 + (tid >> 6) * 8); }
    if (64 * tl <= qw + 31) {
      f32x16 p0, p1;
      if (64 * tl + 63 > qw) {
        const LAS3 float* bp = stp + 96 + (qpos - 64 * tl) - 4 * hi - 63;
        f32x16 c0, c1;
#pragma unroll
        for (int r = 0; r < 16; ++r) { c0[r] = bp[63 - ((r & 3) + 8 * (r >> 2))]; c1[r] = bp[31 - ((r & 3) + 8 * (r >> 2))]; }
        qkt_init<6>(p0, p1, kb0 + cur * SLOT, qr, c0, c1);
      } else qkt<6>(p0, p1, kb0 + cur * SLOT, qr);
      softmax_step(p0, p1, m, l, o, wsf, r32, hi, pw);
      pv(o, vp0 + cur * SLOT, pw);
    }
    if (tl + 1 < NTL) { kv_commit(lds + (cur ^ 1) * SLOT, rk, rv, tid); if (tid < 256) *(LAS3 u32x4*)(lds + (cur ^ 1) * SLOT + KOFF + (8 + (tid >> 6)) * 1024 + (tid & 63) * 16) = rr; }
    cur ^= 1;
  }
  l = xsum(l);
  if (hi == 0) wsf[r32] = 1.0f / fmaxf(l, 1e-30f);
#pragma unroll
  for (int r = 0; r < 16; ++r) { const float f = wsf[crow(r, hi)]; o[0][r] *= f; o[1][r] *= f; }
  LAS3 float* finl = (LAS3 float*)(lds + L_FIN) + w * 2048;
  fin_set(finl, o, lane);
  fin_store(finl, omla, (size_t)b * SEQ + qw, 1024, 512 + h * 64, lane);
}

__device__ __forceinline__ void attn_phase(const bf16_t* proj, const bf16_t* kc, const bf16_t* vc, const float* t5, bf16_t* onsa,
                                           const bf16_t* mq, const bf16_t* mkv, const bf16_t* kr, bf16_t* omla, lptr lds) {
  const int tid = threadIdx.x;
  { LAS3 float* tb = (LAS3 float*)(lds + L_TB);
    for (int i = tid; i < 8 * 320; i += NTHR) { const int hd = i / 320, d = i % 320 - 64; tb[i] = (d < 0) ? NEG_INF : ((d < 113) ? (t5[(int)T5B[d] * 8 + hd] - t5[31 * 8 + hd]) * LOG2E : 0.f); }
    LAS3 float* st = (LAS3 float*)(lds + L_ST);
    for (int i = tid; i < 192; i += NTHR) st[i] = (i < 96) ? NEG_INF : 0.f; }
  const int G = gridDim.x, bx = blockIdx.x;
  for (int v = (G % 8 == 0) ? (bx % 8) * (G / 8) + bx / 8 : bx; v < 256; v += G) {
    const int bg = v >> 4, p = v & 15, bh = v >> 2, j = v & 3;
#pragma unroll 1
    for (int u = 0; u < 2; ++u) nsa_unit(bg >> 1, bg & 1, u ? p : 31 - p, proj, kc, vc, onsa, lds);
#pragma unroll 1
    for (int u = 0; u < 2; ++u) mla_unit(bh >> 3, bh & 7, u ? j : 7 - j, mq, mkv, kr, omla, lds);
  }
}
#undef LAS3
}


namespace peer {
using bf16x8 = __attribute__((ext_vector_type(8))) short;
using f32x16 = __attribute__((ext_vector_type(16))) float;
typedef unsigned u32x4 __attribute__((ext_vector_type(4)));
typedef float f32x4_t __attribute__((ext_vector_type(4)));
typedef __bf16 bf16x2_t __attribute__((ext_vector_type(2)));
typedef float f32x2_t __attribute__((ext_vector_type(2)));
#define LAS3 __attribute__((address_space(3)))
__device__ __forceinline__ int crow(int r, int hi) { return (r & 3) + 8 * (r >> 2) + 4 * hi; }
__device__ __forceinline__ unsigned enc(float f) { const unsigned u = __float_as_uint(f); return u ^ ((unsigned)((int)u >> 31) | 0x80000000u); }
__device__ __forceinline__ float dec(unsigned k) { return __uint_as_float(k ^ (~(unsigned)((int)k >> 31) | 0x80000000u)); }
__device__ __forceinline__ unsigned umax(unsigned a, unsigned b) { return a > b ? a : b; }
__device__ __forceinline__ unsigned umin(unsigned a, unsigned b) { return a < b ? a : b; }
__device__ __forceinline__ unsigned cvtpk(float lo, float hi) { f32x2_t v = {lo, hi}; bf16x2_t b = __builtin_convertvector(v, bf16x2_t); return __builtin_bit_cast(unsigned, b); }
template <int B, int N> __device__ __forceinline__ void sort16(unsigned (&k)[N]) {
#pragma unroll
  for (int size = 2; size <= 16; size <<= 1)
#pragma unroll
    for (int stride = size >> 1; stride > 0; stride >>= 1)
#pragma unroll
      for (int i = 0; i < 16; ++i) { const int l = i ^ stride;
        if (l > i) { const bool desc = ((i & size) == 0); const unsigned a = k[B + i], b = k[B + l]; const unsigned mx = umax(a, b), mn = umin(a, b); k[B + i] = desc ? mx : mn; k[B + l] = desc ? mn : mx; } }
}
template <int A, int Bo, int N> __device__ __forceinline__ void merge16(unsigned (&k)[N]) {
#pragma unroll
  for (int i = 0; i < 16; ++i) k[A + i] = umax(k[A + i], k[Bo + 15 - i]);
#pragma unroll
  for (int stride = 8; stride > 0; stride >>= 1)
#pragma unroll
    for (int i = 0; i < 16; ++i) { const int l = i ^ stride; if (l > i) { const unsigned a = k[A + i], b = k[A + l]; k[A + i] = umax(a, b); k[A + l] = umin(a, b); } }
}
template <int N> __device__ __forceinline__ void top16_of_64(unsigned (&k)[N]) {
  sort16<0>(k); sort16<16>(k); sort16<32>(k); sort16<48>(k);
  merge16<0, 16>(k); merge16<32, 48>(k); merge16<0, 32>(k);
}

__device__ __forceinline__ void route_phase(const bf16_t* __restrict__ pq, const bf16_t* __restrict__ subk, unsigned* __restrict__ pack, LAS3 char* lds) {
  const int tid = threadIdx.x, lane = tid & 63, r32 = lane & 31, hi = lane >> 5, wv = tid >> 6;
  const int gw = blockIdx.x * NWV + wv, nw = gridDim.x * NWV;
  LAS3 unsigned char* myb = (LAS3 unsigned char*)lds + wv * 2560 + lane * 40;
#pragma unroll 1
  for (int item = gw; item < (T / 32) * 8; item += nw) {
    const int h = item & 7, t0 = (item >> 3) * 32;
    unsigned la[16], lb[16];
#pragma unroll
    for (int i = 0; i < 16; ++i) { la[i] = 0u; lb[i] = 0u; }
#pragma unroll 1
    for (int p = 0; p < 2; ++p) {
      f32x16 acc[4];
#pragma unroll
      for (int kt = 0; kt < 4; ++kt) acc[kt] = f32x16{};
#pragma unroll
      for (int kd = 0; kd < 4; ++kd) {
        const bf16x8 bq = *(const bf16x8*)(pq + (size_t)(t0 + r32) * 1024 + h * 128 + p * 64 + kd * 16 + hi * 8);
#pragma unroll
        for (int kt = 0; kt < 4; ++kt) {
          const bf16x8 ak = *(const bf16x8*)(subk + (size_t)((h * 2 + p) * 128 + kt * 32 + r32) * 64 + kd * 16 + hi * 8);
          acc[kt] = __builtin_amdgcn_mfma_f32_32x32x16_bf16(ak, bq, acc[kt], 0, 0, 0);
        }
      }
      unsigned k[64];
#pragma unroll
      for (int kt = 0; kt < 4; ++kt)
#pragma unroll
        for (int r = 0; r < 16; ++r) k[kt * 16 + r] = (enc(acc[kt][r]) & 0xFFFFFF80u) | (unsigned)(127 - (32 * kt + crow(r, hi)));
      top16_of_64(k);
#pragma unroll
      for (int i = 0; i < 16; ++i) { auto rr = __builtin_amdgcn_permlane32_swap(k[i], k[i], false, false); unsigned r0 = rr[0], r1 = rr[1]; asm volatile("" : "+v"(r0), "+v"(r1)); k[16 + i] = hi ? r0 : r1; }
      merge16<0, 16>(k);
#pragma unroll
      for (int i = 0; i < 16; ++i) { la[i] = (p == 0) ? k[i] : la[i]; lb[i] = (p == 0) ? lb[i] : k[i]; }
      __builtin_amdgcn_sched_barrier(0);
    }
#pragma unroll
    for (int i = 0; i < 4; ++i) {
      const unsigned wa = (127u - (la[4 * i] & 127u)) | ((127u - (la[4 * i + 1] & 127u)) << 8) | ((127u - (la[4 * i + 2] & 127u)) << 16) | ((127u - (la[4 * i + 3] & 127u)) << 24);
      const unsigned wb = (127u - (lb[4 * i] & 127u)) | ((127u - (lb[4 * i + 1] & 127u)) << 8) | ((127u - (lb[4 * i + 2] & 127u)) << 16) | ((127u - (lb[4 * i + 3] & 127u)) << 24);
      *(LAS3 unsigned*)(myb + 4 * i) = wa; *(LAS3 unsigned*)(myb + 16 + 4 * i) = wb;
    }
    float va[16], vb[16];
#pragma unroll
    for (int i = 0; i < 16; ++i) { va[i] = dec(la[i] & 0xFFFFFF80u); vb[i] = dec(lb[i] & 0xFFFFFF80u); }
    unsigned k[64];
#define PEER_CAND(n, i, j) k[n] = (enc(va[i] + vb[j]) & 0xFFFFFF00u) | (unsigned)(255 - ((i) * 16 + (j)))
    PEER_CAND(0, 0, 0); PEER_CAND(1, 0, 1); PEER_CAND(2, 0, 2); PEER_CAND(3, 0, 3); PEER_CAND(4, 0, 4); PEER_CAND(5, 0, 5);
    PEER_CAND(6, 0, 6); PEER_CAND(7, 0, 7); PEER_CAND(8, 0, 8); PEER_CAND(9, 0, 9); PEER_CAND(10, 0, 10); PEER_CAND(11, 0, 11);
    PEER_CAND(12, 0, 12); PEER_CAND(13, 0, 13); PEER_CAND(14, 0, 14); PEER_CAND(15, 0, 15); PEER_CAND(16, 1, 0); PEER_CAND(17, 1, 1);
    PEER_CAND(18, 1, 2); PEER_CAND(19, 1, 3); PEER_CAND(20, 1, 4); PEER_CAND(21, 1, 5); PEER_CAND(22, 1, 6); PEER_CAND(23, 1, 7);
    PEER_CAND(24, 2, 0); PEER_CAND(25, 2, 1); PEER_CAND(26, 2, 2); PEER_CAND(27, 2, 3); PEER_CAND(28, 2, 4); PEER_CAND(29, 3, 0);
    PEER_CAND(30, 3, 1); PEER_CAND(31, 3, 2); PEER_CAND(32, 3, 3); PEER_CAND(33, 4, 0); PEER_CAND(34, 4, 1); PEER_CAND(35, 4, 2);
    PEER_CAND(36, 5, 0); PEER_CAND(37, 5, 1); PEER_CAND(38, 6, 0); PEER_CAND(39, 6, 1); PEER_CAND(40, 7, 0); PEER_CAND(41, 7, 1);
    PEER_CAND(42, 8, 0); PEER_CAND(43, 9, 0); PEER_CAND(44, 10, 0); PEER_CAND(45, 11, 0); PEER_CAND(46, 12, 0); PEER_CAND(47, 13, 0);
    PEER_CAND(48, 14, 0); PEER_CAND(49, 15, 0);
#undef PEER_CAND
#pragma unroll
    for (int z = 50; z < 64; ++z) k[z] = 0u;
    top16_of_64(k);
    const float best0 = dec(k[0] & 0xFFFFFF00u);
    float ev[16]; float den = 0.f;
#pragma unroll
    for (int i = 0; i < 16; ++i) { ev[i] = __expf(dec(k[i] & 0xFFFFFF00u) - best0); den += ev[i]; }
    const float inv = 1.0f / den;
    unsigned outw[8];
#pragma unroll
    for (int i = 0; i < 8; ++i) {
      unsigned k_lo = k[i], k_hi = k[8 + i]; float e_lo = ev[i], e_hi = ev[8 + i];
      asm volatile("" : "+v"(k_lo), "+v"(k_hi), "+v"(e_lo), "+v"(e_hi));
      const unsigned kk = hi ? k_hi : k_lo; const float e = hi ? e_hi : e_lo;
      const unsigned f = 255u - (kk & 255u);
      const unsigned ia = myb[f >> 4], ib = myb[16 + (f & 15u)];
      outw[i] = (ia * 128u + ib) | (cvtpk(0.f, e * inv) & 0xFFFF0000u);
    }
    unsigned* dst = pack + (size_t)(t0 + r32) * 128 + h * 16 + hi * 8;
    *(u32x4*)dst = (u32x4){outw[0], outw[1], outw[2], outw[3]};
    *(u32x4*)(dst + 4) = (u32x4){outw[4], outw[5], outw[6], outw[7]};
  }
}

__device__ __forceinline__ void conv_tables(const float* __restrict__ u, const float* __restrict__ v, unsigned* __restrict__ u8, float* __restrict__ su, unsigned* __restrict__ v8) {
  const int tid = threadIdx.x, lane = tid & 63, wv = tid >> 6;
  const int gw = blockIdx.x * NWV + wv, nw = gridDim.x * NWV;
  for (int e = gw; e < 16384; e += nw) {
    const f32x4_t* ur = (const f32x4_t*)(u + (size_t)e * 1024) + lane * 4;
    f32x4_t a[4]; float mx = 0.f;
#pragma unroll
    for (int i = 0; i < 4; ++i) { a[i] = ur[i]; mx = fmaxf(mx, fmaxf(fmaxf(fabsf(a[i][0]), fabsf(a[i][1])), fmaxf(fabsf(a[i][2]), fabsf(a[i][3])))); }
    mx = wmaxf(mx);
    const float sc = fmaxf(mx, 1e-30f) * (1.0f / 127.0f), isc = 1.0f / sc;
    u32x4 o;
#pragma unroll
    for (int i = 0; i < 4; ++i) {
      const int q0 = (int)rintf(a[i][0] * isc), q1 = (int)rintf(a[i][1] * isc), q2 = (int)rintf(a[i][2] * isc), q3 = (int)rintf(a[i][3] * isc);
      o[i] = (unsigned)(q0 & 255) | ((unsigned)(q1 & 255) << 8) | ((unsigned)(q2 & 255) << 16) | ((unsigned)(q3 & 255) << 24);
    }
    *(u32x4*)(u8 + (size_t)e * 256 + lane * 4) = o;
    if (lane == 0) su[e] = sc;
    const f32x4_t* vr = (const f32x4_t*)(v + (size_t)e * 1024) + lane * 4;
    u32x4 ov;
#pragma unroll
    for (int i = 0; i < 4; ++i) { const f32x4_t b = vr[i]; unsigned w = 0u; w = __builtin_amdgcn_cvt_pk_fp8_f32(2.0f * b[0], 2.0f * b[1], w, false); w = __builtin_amdgcn_cvt_pk_fp8_f32(2.0f * b[2], 2.0f * b[3], w, true); ov[i] = w; }
    *(u32x4*)(v8 + ((size_t)(lane >> 3) * 16384 + e) * 32 + (lane & 7) * 4) = ov;
  }
}
__device__ __forceinline__ float gelu_fast(float v) {
  const float av = __builtin_fabsf(v), t = __builtin_amdgcn_rcpf(av * 0.2316418882f + 1.0f);
  float q = t * 0.5307027145f + (-0.7265760135f); q = q * t + 0.7107068705f; q = q * t + (-0.142248368f); q = q * t + 0.127414796f; q = q * t;
  const float e = __builtin_amdgcn_exp2f((v * v) * (-0.72134752044f));
  const float m = v * (q * e);
  return v < 0.f ? m : v - m;
}
__device__ __forceinline__ unsigned xcc_id() { return (unsigned)__builtin_amdgcn_s_getreg((3 << 11) | 20) & 7u; }
struct ABuf { unsigned w, meta; u32x4 ub[8]; float sue; };
__device__ __forceinline__ void expA_issue(ABuf& B, int k0, int n, const LAS3 unsigned* list, const unsigned* __restrict__ u8, const float* __restrict__ su, int j8) {
  const int k = (k0 < n) ? k0 : 0;
  B.w = list[2 * k]; B.meta = list[2 * k + 1];
  const unsigned e = B.w & 0xFFFFu;
  const unsigned* urow = u8 + (size_t)e * 256 + j8 * 4;
#pragma unroll
  for (int seg = 0; seg < 8; ++seg) B.ub[seg] = *(const u32x4*)(urow + seg * 32);
  B.sue = su[e];
}
__device__ __forceinline__ void expA_consume(const ABuf& B, int k0, int n, const LAS3 char* hl, const LAS3 float* shl, float* __restrict__ co, int t0, int j8) {
  const int tokl = (int)(B.meta >> 8), slot = (int)(B.meta & 255u);
  const LAS3 char* hrow = hl + tokl * 1024 + j8 * 16;
  int a0 = 0, a1 = 0, a2 = 0, a3 = 0;
#pragma unroll
  for (int seg = 0; seg < 8; ++seg) { const u32x4 hq = *(const LAS3 u32x4*)(hrow + seg * 128);
    a0 = __builtin_amdgcn_sdot4((int)B.ub[seg].x, (int)hq.x, a0, false); a1 = __builtin_amdgcn_sdot4((int)B.ub[seg].y, (int)hq.y, a1, false);
    a2 = __builtin_amdgcn_sdot4((int)B.ub[seg].z, (int)hq.z, a2, false); a3 = __builtin_amdgcn_sdot4((int)B.ub[seg].w, (int)hq.w, a3, false); }
  int acc = (a0 + a1) + (a2 + a3);
  acc += dpp_i<0xB1>(acc); acc += dpp_i<0x4E>(acc); acc += dpp_i<0x141>(acc);
  const float d = (float)acc * (B.sue * shl[tokl]);
  const float c = 0.5f * __uint_as_float(B.w & 0xFFFF0000u) * gelu_fast(d);
  if (j8 == 0 && k0 < n) co[(size_t)(t0 + tokl) * 128 + slot] = c;
}
struct AStage { u32x4 pw[4], hst[8]; float shv; };
__device__ __forceinline__ void expA_stage(AStage& S, int item, const unsigned* __restrict__ pack, const unsigned* __restrict__ hn8, const float* __restrict__ shp, int tid) {
  const int t0 = item * 64, tokl = tid >> 3, sb = (tid & 7) * 16;
#pragma unroll
  for (int i = 0; i < 4; ++i) S.pw[i] = *(const u32x4*)(pack + (size_t)(t0 + tokl) * 128 + sb + 4 * i);
#pragma unroll
  for (int i = 0; i < 8; ++i) S.hst[i] = *(const u32x4*)(hn8 + (size_t)t0 * 256 + (tid + 512 * i) * 4);
  S.shv = (tid < 64) ? shp[t0 + tid] : 0.f;
}
__device__ __forceinline__ void expA_item(AStage& S, int item, int nitem, int xs, const unsigned* __restrict__ pack, const unsigned* __restrict__ hn8, const float* __restrict__ shp, const unsigned* __restrict__ u8, const float* __restrict__ su,
                                          float* __restrict__ co, LAS3 char* lds, int tid) {
  const int lane = tid & 63, wv = tid >> 6;
  LAS3 char* hl = lds + 1024;
  LAS3 float* shl = (LAS3 float*)(lds + 1024 + 65536);
  LAS3 unsigned* cnt = (LAS3 unsigned*)(lds + 16);
  LAS3 unsigned* list = (LAS3 unsigned*)(lds + 1024 + 65536 + 256);
  const int t0 = item * 64;
  const int tokl = tid >> 3, sb = (tid & 7) * 16;
#pragma unroll
  for (int i = 0; i < 8; ++i) *(LAS3 u32x4*)(hl + (tid + 512 * i) * 16) = S.hst[i];
  if (tid < 64) shl[tid] = S.shv;
  {
    unsigned long long mk[16]; int tot = 0; int off[16];
#pragma unroll
    for (int j = 0; j < 16; ++j) { const unsigned w = S.pw[j >> 2][j & 3]; mk[j] = __ballot(((w & 0xFFFFu) >> 11) == (unsigned)xs); off[j] = tot; tot += __builtin_popcountll(mk[j]); }
    int base = 0;
    if (lane == 0) base = (int)__hip_atomic_fetch_add(cnt, (unsigned)tot, __ATOMIC_RELAXED, __HIP_MEMORY_SCOPE_WORKGROUP);
    base = __builtin_amdgcn_readfirstlane(base);
#pragma unroll
    for (int j = 0; j < 16; ++j) { const unsigned w = S.pw[j >> 2][j & 3];
      if (((w & 0xFFFFu) >> 11) == (unsigned)xs) { const int pos = base + off[j] + (int)__builtin_amdgcn_mbcnt_hi((unsigned)(mk[j] >> 32), __builtin_amdgcn_mbcnt_lo((unsigned)mk[j], 0u));
        list[2 * pos] = w; list[2 * pos + 1] = (unsigned)((tokl << 8) | (sb + j)); } }
  }
  if (nitem < T / 64) expA_stage(S, nitem, pack, hn8, shp, tid);
  __syncthreads();
  const int n = (int)cnt[0];
  const int j8 = lane & 7, gidx = wv * 8 + (lane >> 3);
  ABuf A, Bb;
  expA_issue(A, gidx, n, list, u8, su, j8);
#pragma unroll 1
  for (int k0 = gidx; k0 < n; k0 += 128) {
    expA_issue(Bb, k0 + 64, n, list, u8, su, j8);
    expA_consume(A, k0, n, hl, shl, co, t0, j8);
    expA_issue(A, k0 + 128, n, list, u8, su, j8);
    expA_consume(Bb, k0 + 64, n, hl, shl, co, t0, j8);
  }
}
struct BBuf { u32x4 vv[8]; f32x4_t c[2]; };
__device__ __forceinline__ void expB_issue(BBuf& B, const LAS3 unsigned* pkl, const LAS3 float* col, int sg8, const unsigned* __restrict__ vbase) {
  const u32x4 p0 = *(const LAS3 u32x4*)(pkl + sg8 * 8), p1 = *(const LAS3 u32x4*)(pkl + sg8 * 8 + 4);
  B.c[0] = *(const LAS3 f32x4_t*)(col + sg8 * 8); B.c[1] = *(const LAS3 f32x4_t*)(col + sg8 * 8 + 4);
#pragma unroll
  for (int j = 0; j < 4; ++j) { B.vv[j] = *(const u32x4*)(vbase + (size_t)(p0[j] & 0xFFFFu) * 32); B.vv[4 + j] = *(const u32x4*)(vbase + (size_t)(p1[j] & 0xFFFFu) * 32); }
}
__device__ __forceinline__ void expB_consume(const BBuf& B, f32x2_t (&y)[8]) {
#pragma unroll
  for (int j = 0; j < 8; ++j) {
    const float cv = B.c[j >> 2][j & 3];
    const f32x2_t c2 = {cv, cv};
#pragma unroll
    for (int w = 0; w < 4; ++w) {
      y[2 * w] = __builtin_elementwise_fma(__builtin_amdgcn_cvt_pk_f32_fp8(B.vv[j][w], false), c2, y[2 * w]);
      y[2 * w + 1] = __builtin_elementwise_fma(__builtin_amdgcn_cvt_pk_f32_fp8(B.vv[j][w], true), c2, y[2 * w + 1]);
    }
  }
}
__device__ __forceinline__ void expB_item(int item, int xs, const unsigned* __restrict__ pack, const float* __restrict__ co, const unsigned* __restrict__ v8, bf16_t* __restrict__ zb, float* __restrict__ ssq, LAS3 char* lds, int tid,
                                          const float* __restrict__ xin, const bf16_t* __restrict__ ob) {
  const int lane = tid & 63, wv = tid >> 6, r8 = lane >> 3, c8 = lane & 7;
  const int t0 = item * 64 + wv * 8;
  LAS3 unsigned* pkw = (LAS3 unsigned*)(lds + 1024 + wv * 8192);
  LAS3 float* cow = (LAS3 float*)(lds + 1024 + wv * 8192 + 4096);
  {
    u32x4 a[4]; f32x4_t b[4];
#pragma unroll
    for (int i = 0; i < 4; ++i) { a[i] = *(const u32x4*)(pack + (size_t)t0 * 128 + (lane + 64 * i) * 4); b[i] = *(const f32x4_t*)(co + (size_t)t0 * 128 + (lane + 64 * i) * 4); }
#pragma unroll
    for (int i = 0; i < 4; ++i) { *(LAS3 u32x4*)(pkw + (lane + 64 * i) * 4) = a[i]; *(LAS3 f32x4_t*)(cow + (lane + 64 * i) * 4) = b[i]; }
  }
  const size_t hoff = (size_t)(t0 + r8) * 1024 + xs * 128 + c8 * 16;
  f32x4_t h[4];
  { const u32x4 o0 = *(const u32x4*)(ob + hoff), o1 = *(const u32x4*)(ob + hoff + 8);
#pragma unroll
    for (int w = 0; w < 4; ++w) h[w] = *(const f32x4_t*)(xin + hoff + 4 * w);
    h[0] += (f32x4_t){__uint_as_float(o0.x << 16), __uint_as_float(o0.x & 0xffff0000u), __uint_as_float(o0.y << 16), __uint_as_float(o0.y & 0xffff0000u)};
    h[1] += (f32x4_t){__uint_as_float(o0.z << 16), __uint_as_float(o0.z & 0xffff0000u), __uint_as_float(o0.w << 16), __uint_as_float(o0.w & 0xffff0000u)};
    h[2] += (f32x4_t){__uint_as_float(o1.x << 16), __uint_as_float(o1.x & 0xffff0000u), __uint_as_float(o1.y << 16), __uint_as_float(o1.y & 0xffff0000u)};
    h[3] += (f32x4_t){__uint_as_float(o1.z << 16), __uint_as_float(o1.z & 0xffff0000u), __uint_as_float(o1.w << 16), __uint_as_float(o1.w & 0xffff0000u)}; }
  wave_lds_sync();
  const LAS3 unsigned* pkl = pkw + r8 * 128; const LAS3 float* col = cow + r8 * 128;
  const unsigned* vbase = v8 + (size_t)xs * 16384 * 32 + c8 * 4;
  f32x2_t y[8];
#pragma unroll
  for (int i = 0; i < 8; ++i) y[i] = (f32x2_t){0.f, 0.f};
  BBuf A, Bb;
  expB_issue(A, pkl, col, 0, vbase);
#pragma unroll 1
  for (int sg = 0; sg < 16; sg += 2) {
    expB_issue(Bb, pkl, col, sg + 1, vbase);
    expB_consume(A, y);
    if (sg + 2 < 16) expB_issue(A, pkl, col, sg + 2, vbase);
    expB_consume(Bb, y);
  }
  float ss = 0.f; unsigned zw[8];
#pragma unroll
  for (int w = 0; w < 4; ++w) {
    const f32x4_t z = {h[w][0] + y[2 * w][0], h[w][1] + y[2 * w][1], h[w][2] + y[2 * w + 1][0], h[w][3] + y[2 * w + 1][1]};
    zw[2 * w] = cvtpk(z[0], z[1]); zw[2 * w + 1] = cvtpk(z[2], z[3]);
    ss += (z[0] * z[0] + z[1] * z[1]) + (z[2] * z[2] + z[3] * z[3]);
  }
  *(u32x4*)(zb + hoff) = (u32x4){zw[0], zw[1], zw[2], zw[3]}; *(u32x4*)(zb + hoff + 8) = (u32x4){zw[4], zw[5], zw[6], zw[7]};
  ss += dpp_f<0xB1>(ss); ss += dpp_f<0x4E>(ss); ss += dpp_f<0x141>(ss);
  if (c8 == 0) ssq[(size_t)xs * T + t0 + r8] = ss;
  wave_lds_sync();
}
template <int PASS> __device__ __forceinline__ void experts_sliced(const unsigned* __restrict__ pack, const unsigned* __restrict__ hn8, const float* __restrict__ shp, const unsigned* __restrict__ u8, const float* __restrict__ su,
                                                                    float* __restrict__ co, const unsigned* __restrict__ v8, float* __restrict__ out, float* __restrict__ ssq, unsigned* __restrict__ ctr, LAS3 char* lds,
                                                                    const float* __restrict__ xin = nullptr, const bf16_t* __restrict__ ob = nullptr) {
  int tid = threadIdx.x; asm volatile("" : "+v"(tid));
  LAS3 volatile int* lw = (LAS3 volatile int*)lds;
  const int xme = (int)xcc_id();
#pragma unroll 1
  for (int s8 = 0; s8 < 8; ++s8) {
    const int xs = (xme + s8) & 7;
    if (PASS == 0) {
      int nxt = 0;
      if (tid == 0) nxt = (int)atomicAdd(ctr + 64 * xs, 1u);
      __syncthreads();
      if (tid == 0) lw[0] = nxt;
      __syncthreads();
      int item = lw[0];
      if (item >= T / 64) continue;
      if (tid == 0) nxt = (int)atomicAdd(ctr + 64 * xs, 1u);
      AStage SA;
      expA_stage(SA, item, pack, hn8, shp, tid);
#pragma unroll 1
      for (;;) {
        __syncthreads();
        if (tid == 0) { lw[0] = nxt; lw[4] = 0; }
        __syncthreads();
        const int nitem = lw[0];
        if (tid == 0) nxt = (int)atomicAdd(ctr + 64 * xs, 1u);
        expA_item(SA, item, nitem, xs, pack, hn8, shp, u8, su, co, lds, tid);
        if (nitem >= T / 64) break;
        item = nitem;
      }
    } else {
      int nxt = 0;
      if (tid == 0) nxt = (int)atomicAdd(ctr + 64 * xs, 1u);
#pragma unroll 1
      for (;;) {
        __syncthreads();
        if (tid == 0) lw[0] = nxt;
        __syncthreads();
        const int item = lw[0];
        if (item >= T / 64) break;
        if (tid == 0) nxt = (int)atomicAdd(ctr + 64 * xs, 1u);
        expB_item(item, xs, pack, co, v8, (bf16_t*)out, ssq, lds, tid, xin, ob);
      }
    }
  }
}
__device__ __forceinline__ void experts_norm(const float* __restrict__ ssq, const float* __restrict__ gfin, const bf16_t* __restrict__ zb, float* __restrict__ out) {
  const int tid = threadIdx.x, lane = tid & 63, wv = tid >> 6;
  const int gw = blockIdx.x * NWV + wv, nw = gridDim.x * NWV;
  for (int t = gw; t < T; t += nw) {
    float ss = 0.f;
#pragma unroll
    for (int x = 0; x < 8; ++x) ss += ssq[(size_t)x * T + t];
    const float inv = rsqrtf(ss * (1.0f / 1024.0f) + 1e-6f);
    float* op = out + (size_t)t * 1024 + lane * 16; const float* gp = gfin + lane * 16;
    const u32x4 z0 = *(const u32x4*)(zb + (size_t)t * 1024 + lane * 16), z1 = *(const u32x4*)(zb + (size_t)t * 1024 + lane * 16 + 8);
    const unsigned zz[8] = {z0.x, z0.y, z0.z, z0.w, z1.x, z1.y, z1.z, z1.w};
#pragma unroll
    for (int i = 0; i < 4; ++i) { const f32x4_t z = {__uint_as_float(zz[2 * i] << 16), __uint_as_float(zz[2 * i] & 0xffff0000u), __uint_as_float(zz[2 * i + 1] << 16), __uint_as_float(zz[2 * i + 1] & 0xffff0000u)};
      const f32x4_t g = *(const f32x4_t*)(gp + 4 * i); *(f32x4_t*)(op + 4 * i) = z * inv * g; }
  }
}
#undef LAS3
}

namespace prep {
typedef unsigned u32x2_t __attribute__((ext_vector_type(2)));
typedef float f32x4_t __attribute__((ext_vector_type(4)));
typedef unsigned u32x4 __attribute__((ext_vector_type(4)));
using bf16x8 = __attribute__((ext_vector_type(8))) short;
using f32x16 = __attribute__((ext_vector_type(16))) float;
__device__ __forceinline__ unsigned pk2(float lo, float hi) { return (unsigned)f2bf(lo) | ((unsigned)f2bf(hi) << 16); }
__device__ __forceinline__ void latent_rows(const bf16_t* __restrict__ proj, const float* __restrict__ gq, const float* __restrict__ gkv, const float2* __restrict__ cs,
                                            bf16_t* __restrict__ cqn, bf16_t* __restrict__ ckvn, bf16_t* __restrict__ krope, int wave_id, int nwaves, int lane) {
  const f32x4_t g4 = *(const f32x4_t*)(gq + lane * 4);
  const float2 g2 = *(const float2*)(gkv + lane * 2);
  for (int r = wave_id; r < T; r += nwaves) {
    const bf16_t* row = proj + (size_t)r * PROJ_LD;
    const u32x2_t q = *(const u32x2_t*)(row + PC_CQ + lane * 4);
    const unsigned kv = *(const unsigned*)(row + PC_CKV + lane * 2);
    const unsigned short kr0 = row[PC_KR + (lane & 15)], kr1 = row[PC_KR + 16 + (lane & 15)];
    const float q0 = __uint_as_float(q.x << 16), q1 = __uint_as_float(q.x & 0xffff0000u), q2 = __uint_as_float(q.y << 16), q3 = __uint_as_float(q.y & 0xffff0000u);
    const float k0 = __uint_as_float(kv << 16), k1 = __uint_as_float(kv & 0xffff0000u);
    float sq = (q0 * q0 + q1 * q1) + (q2 * q2 + q3 * q3), sk = k0 * k0 + k1 * k1;
    sq = wsum(sq); sk = wsum(sk);
    const float iq = rsqrtf(sq * (1.0f / 256.0f) + 1e-6f), ik = rsqrtf(sk * (1.0f / 128.0f) + 1e-6f);
    u32x2_t oq; oq.x = pk2(q0 * iq * g4[0], q1 * iq * g4[1]); oq.y = pk2(q2 * iq * g4[2], q3 * iq * g4[3]);
    *(u32x2_t*)(cqn + (size_t)r * 256 + lane * 4) = oq;
    *(unsigned*)(ckvn + (size_t)r * 128 + lane * 2) = pk2(k0 * ik * g2.x, k1 * ik * g2.y);
    if (lane < 16) {
      const float2 c = cs[(r & (SEQ - 1)) * 16 + lane];
      const float x1 = bf2f(kr0), x2 = bf2f(kr1);
      krope[(size_t)r * 32 + lane] = f2bf(x1 * c.x - x2 * c.y); krope[(size_t)r * 32 + 16 + lane] = f2bf(x2 * c.x + x1 * c.y);
    }
  }
}
__device__ __forceinline__ void cmp_bias(const float* __restrict__ posk, const float* __restrict__ posv, const bf16_t* __restrict__ w1k, const bf16_t* __restrict__ w1v, float* __restrict__ cpos, int wave_id, int nwaves, int lane) {
  for (int o = wave_id; o < 512; o += nwaves) {
    const int tab = o >> 8, n = o & 255;
    const float* pos = tab ? posv : posk; const bf16_t* w = (tab ? w1v : w1k) + (size_t)n * 2048;
    float acc = 0.f;
#pragma unroll
    for (int i = 0; i < 4; ++i) { const int k = (i * 64 + lane) * 8;
      const u32x4 wv = *(const u32x4*)(w + k); const f32x4_t p0 = *(const f32x4_t*)(pos + k), p1 = *(const f32x4_t*)(pos + k + 4);
      acc += p0[0] * __uint_as_float(wv.x << 16) + p0[1] * __uint_as_float(wv.x & 0xffff0000u) + p0[2] * __uint_as_float(wv.y << 16) + p0[3] * __uint_as_float(wv.y & 0xffff0000u);
      acc += p1[0] * __uint_as_float(wv.z << 16) + p1[1] * __uint_as_float(wv.z & 0xffff0000u) + p1[2] * __uint_as_float(wv.w << 16) + p1[3] * __uint_as_float(wv.w & 0xffff0000u); }
    acc = wsum(acc);
    if (lane == 0) cpos[o] = acc;
  }
}
__device__ __forceinline__ void cmp_l2(const float* __restrict__ slab, const float* __restrict__ cpos, const bf16_t* __restrict__ w2t, bf16_t* __restrict__ outkc, int item, int lane) {
  const int r32 = lane & 31, hi = lane >> 5, m0 = item * 32;
  f32x16 acc0 = f32x16{}, acc1 = f32x16{};
  f32x4_t sa[2][8]; f32x4_t cp[2][2]; bf16x8 wb[2][2];
#define CMPL2_LOAD(buf, ks_) do { const int k_ = (ks_) * 16 + hi * 8; \
    cp[buf][0] = *(const f32x4_t*)(cpos + k_); cp[buf][1] = *(const f32x4_t*)(cpos + k_ + 4); \
    _Pragma("unroll") for (int sp = 0; sp < 4; ++sp) { const float* p_ = slab + ((size_t)sp * 2048 + m0 + r32) * 256 + k_; sa[buf][2 * sp] = *(const f32x4_t*)p_; sa[buf][2 * sp + 1] = *(const f32x4_t*)(p_ + 4); } \
    wb[buf][0] = *(const bf16x8*)(w2t + (size_t)r32 * 256 + k_); wb[buf][1] = *(const bf16x8*)(w2t + (size_t)(32 + r32) * 256 + k_); } while (0)
#define CMPL2_MMA(buf) do { f32x4_t a0 = cp[buf][0], a1 = cp[buf][1]; \
    _Pragma("unroll") for (int sp = 0; sp < 4; ++sp) { a0 += sa[buf][2 * sp]; a1 += sa[buf][2 * sp + 1]; } \
    u32x4 aw; aw.x = pk2(peer::gelu_fast(a0[0]), peer::gelu_fast(a0[1])); aw.y = pk2(peer::gelu_fast(a0[2]), peer::gelu_fast(a0[3])); \
    aw.z = pk2(peer::gelu_fast(a1[0]), peer::gelu_fast(a1[1])); aw.w = pk2(peer::gelu_fast(a1[2]), peer::gelu_fast(a1[3])); \
    const bf16x8 af = __builtin_bit_cast(bf16x8, aw); \
    acc0 = __builtin_amdgcn_mfma_f32_32x32x16_bf16(af, wb[buf][0], acc0, 0, 0, 0); acc1 = __builtin_amdgcn_mfma_f32_32x32x16_bf16(af, wb[buf][1], acc1, 0, 0, 0); } while (0)
  CMPL2_LOAD(0, 0);
#pragma unroll 1
  for (int ks = 0; ks < 16; ks += 2) {
    CMPL2_LOAD(1, ks + 1);
    CMPL2_MMA(0);
    if (ks + 2 < 16) CMPL2_LOAD(0, ks + 2);
    CMPL2_MMA(1);
  }
#undef CMPL2_LOAD
#undef CMPL2_MMA
#pragma unroll
  for (int r = 0; r < 16; ++r) {
    const int m = m0 + (r & 3) + 8 * (r >> 2) + 4 * hi;
    const bool pad = (m & 127) == 127;
    outkc[(size_t)m * 64 + r32] = pad ? (bf16_t)0 : f2bf(acc0[r]);
    outkc[(size_t)m * 64 + 32 + r32] = pad ? (bf16_t)0 : f2bf(acc1[r]);
  }
}
}

#define XB_TMO      128
#define XB_XCNT(j)  (256  + 64 * (j))
#define XB_XSUB(j)  (1280 + 64 * (j))
#define XB_XGEN(j)  (2304 + 64 * (j))
#define XB_TOP      3328
#define XB_TOPGEN   3392
#define XCD_BAR_WORDS 3456
#define XB_SPIN_CAP (1u << 18)
#ifndef LAS
#define LAS __attribute__((address_space(3)))
#endif

__device__ __forceinline__ unsigned xb_ld(unsigned* p)              { return __hip_atomic_load(p, __ATOMIC_RELAXED, __HIP_MEMORY_SCOPE_AGENT); }
__device__ __forceinline__ unsigned xb_add(unsigned* p, unsigned v) { return __hip_atomic_fetch_add(p, v, __ATOMIC_RELAXED, __HIP_MEMORY_SCOPE_AGENT); }
__device__ __forceinline__ unsigned xb_xcc_id() { return (unsigned)__builtin_amdgcn_s_getreg((3 << 11) | 20) & 0xFu; }
#define XB_SPIN(cond, bar) do { unsigned _sp = 0; while (cond) { __builtin_amdgcn_s_sleep(1); \
    if ((++_sp & 255u) == 0u) { if (xb_ld(&(bar)[XB_TMO])) break; if (_sp > XB_SPIN_CAP) { atomicAdd(&(bar)[XB_TMO], 1u); break; } } } } while (0)

struct XcdBarrier {
    unsigned* bar; unsigned x;
    volatile LAS unsigned* st;
};

__device__ __forceinline__ XcdBarrier xcd_barrier_post(unsigned* bar, volatile LAS unsigned* st) {
    XcdBarrier b; b.bar = bar; b.x = xb_xcc_id(); b.st = st;
    if (threadIdx.x == 0) (void)xb_add(&bar[XB_XCNT(b.x)], 1u);
    return b;
}
__device__ __forceinline__ void xcd_barrier_complete(unsigned* bar, unsigned x, unsigned& nloc, unsigned& nx) {
    const unsigned G = gridDim.x * gridDim.y * gridDim.z;
    unsigned sum, cnt, mine, sp = 0u;
    for (;;) {
        sum = 0u; cnt = 0u; mine = 0u;
#pragma unroll
        for (unsigned j = 0; j < 16; ++j) { const unsigned c = xb_ld(&bar[XB_XCNT(j)]); sum += c; cnt += (c > 0u) ? 1u : 0u; mine = (j == x) ? c : mine; }
        if (sum == G) break;
        __builtin_amdgcn_s_sleep(1);
        if ((++sp & 255u) == 0u) { if (xb_ld(&bar[XB_TMO])) break; if (sp > XB_SPIN_CAP) { atomicAdd(&bar[XB_TMO], 1u); break; } }
    }
    nloc = mine > 0u ? mine : 1u; nx = cnt > 0u ? cnt : 1u;
}

__device__ __forceinline__ void xcd_barrier(const XcdBarrier& b) {
    asm volatile("s_waitcnt vmcnt(0)" ::: "memory");
    __syncthreads();
    if (threadIdx.x == 0) {
        unsigned* bar = b.bar;
        __builtin_amdgcn_s_waitcnt(0);
        unsigned nloc = b.st[0], nx = b.st[1];
        if (nloc == 0u) { xcd_barrier_complete(bar, b.x, nloc, nx); b.st[0] = nloc; b.st[1] = nx; }
        const unsigned old = xb_add(&bar[XB_XSUB(b.x)], 1u);
        const unsigned gen = old / nloc;
        if (old + 1u == (gen + 1u) * nloc) {
            __builtin_amdgcn_fence(__ATOMIC_RELEASE, "agent");
            asm volatile("s_waitcnt vmcnt(0)" ::: "memory");
            const unsigned og = xb_add(&bar[XB_TOP], 1u);
            const unsigned tg = og / nx;
            if (og + 1u == (tg + 1u) * nx) xb_add(&bar[XB_TOPGEN], 1u);
            else XB_SPIN(xb_ld(&bar[XB_TOPGEN]) == tg, bar);
            __builtin_amdgcn_fence(__ATOMIC_ACQUIRE, "agent");
            xb_add(&bar[XB_XGEN(b.x)], 1u);
            asm volatile("s_waitcnt vmcnt(0)" ::: "memory");
        } else {
            XB_SPIN(xb_ld(&bar[XB_XGEN(b.x)]) == gen, bar);
            __builtin_amdgcn_fence(__ATOMIC_ACQUIRE, "agent");
            asm volatile("s_waitcnt vmcnt(0)" ::: "memory");
        }
    }
    __syncthreads();
}

struct Args { const float* in[23]; float* out; char* ws; };
constexpr int LDS_BYTES = 131072 + 4096;

typedef const __attribute__((address_space(4))) Args* kargs_t;
DEV kargs_t KA() { kargs_t k = (kargs_t)__builtin_amdgcn_kernarg_segment_ptr(); asm volatile("" : "+s"(k)); return k; }
#define WSP(type, off) ((type*)(ws + (off)))

__global__ __launch_bounds__(NTHR, 2) void mega(Args a) {
  extern __shared__ __attribute__((aligned(16))) char lds[];
  cg::grid_group grid = cg::this_grid();
  PG8_LAS unsigned char* glds = (PG8_LAS unsigned char*)lds;
  const int bid = blockIdx.x, G = gridDim.x;
  (void)a;
  volatile LAS unsigned* bst = (volatile LAS unsigned*)((LAS char*)lds + LDS_BYTES - 16);
  if (threadIdx.x < 4) bst[threadIdx.x] = 0u;
  __syncthreads();
  XcdBarrier xbar; { kargs_t k = KA(); xbar = xcd_barrier_post((unsigned*)k->ws, bst); }

  { kargs_t k = KA(); char* ws = k->ws;
    const int wv0_ = threadIdx.x >> 6;
    if (wv0_ < 4) { const int lane_ = threadIdx.x & 63, wv_ = wv0_, gw_ = bid * 4 + wv_, nw_ = G * 4;
      __attribute__((address_space(3))) float* scr = (__attribute__((address_space(3))) float*)((__attribute__((address_space(3))) char*)lds + wv_ * 8448);
      constexpr int I_IN = 16 * 120, I_BR = 8 * 32, I_SQ = 16 * 32, I_C1 = 32 * 8, I_C2 = 4 * 8, I_UQ = 4 * 24, I_UKV = 2 * 32;
      constexpr int NITEMS = I_IN + 2 * I_BR + 2 * I_SQ + 2 * I_C1 + 2 * I_C2 + I_UQ + I_UKV;
      for (int it = gw_; it < NITEMS; it += nw_) {
        int r = it;
        if (r < I_IN) { tr_item<1>(k->in[2], 1024, IN_COLS, WSP(bf16_t, WS_WIN), 120, 3840, scr, r, lane_); continue; } r -= I_IN;
        if (r < I_BR) { tr_item<0>(k->in[13], 512, 1024, WSP(bf16_t, WS_WBN), 32, 1024, scr, r, lane_, 1024, 0); continue; } r -= I_BR;
        if (r < I_BR) { tr_item<0>(k->in[14], 512, 1024, WSP(bf16_t, WS_WBN), 32, 1024, scr, r, lane_, 1024, 512); continue; } r -= I_BR;
        if (r < I_SQ) { tr_item<0>(k->in[15], 1024, 1024, WSP(bf16_t, WS_WOUT), 32, 1024, scr, r, lane_); continue; } r -= I_SQ;
        if (r < I_SQ) { tr_item<0>(k->in[17], 1024, 1024, WSP(bf16_t, WS_WQ), 32, 1024, scr, r, lane_); continue; } r -= I_SQ;
        if (r < I_C1) { tr_item<0>(k->in[5], 2048, 256, WSP(bf16_t, WS_CKW1), 8, 256, scr, r, lane_); continue; } r -= I_C1;
        if (r < I_C1) { tr_item<0>(k->in[7], 2048, 256, WSP(bf16_t, WS_CVW1), 8, 256, scr, r, lane_); continue; } r -= I_C1;
        if (r < I_C2) { tr_item<0>(k->in[6], 256, 64, WSP(bf16_t, WS_CKW2), 8, 64, scr, r, lane_); continue; } r -= I_C2;
        if (r < I_C2) { tr_item<0>(k->in[8], 256, 64, WSP(bf16_t, WS_CVW2), 8, 64, scr, r, lane_); continue; } r -= I_C2;
        if (r < I_UQ) { tr_item<0>(k->in[11], 256, 768, WSP(bf16_t, WS_UQ), 24, 768, scr, r, lane_); continue; } r -= I_UQ;
        tr_item<0>(k->in[12], 128, 1024, WSP(bf16_t, WS_UKV), 32, 1024, scr, r, lane_);
      }
      for (int i = gw_ * 64 + lane_; i < 16 * 128 * 64; i += nw_ * 64) WSP(bf16_t, WS_SUBK)[i] = f2bf(k->in[18][i]);
      for (int i = gw_ * 64 + lane_; i < SEQ * 16; i += nw_ * 64) rope_entry(WSP(float2, WS_ROPE), i);
    } else ph_rms1024<false>(k->in[0], k->in[1], WSP(bf16_t, WS_XN), T, nullptr, nullptr, bid * 4 + (wv0_ - 4), G * 4); }
  grid.sync();
  { kargs_t k = KA(); char* ws = k->ws;
    pg8::Gemm g{WSP(bf16_t, WS_XN), WSP(bf16_t, WS_WIN), T, 3840, 1024}; pg8::StaticOrder S; S.init(T, 3840, G, bid);
    pg8::EpiInProjF E{WSP(bf16_t, WS_PROJ), WSP(unsigned char, WS_GATES)};
    pg8::gemm_phase<pg8::EpiInProjF, pg8::StaticOrder, PG8_ALIGN, PG8_SP2>(glds, g, S, E); }
  xcd_barrier(xbar);
  { kargs_t k = KA(); char* ws = k->ws;
    const int lane_ = threadIdx.x & 63, wv_ = threadIdx.x >> 6;
    if (G >= 128 && bid < 64) {
      const int tab = bid >> 5;
      pg8::Gemm g{WSP(bf16_t, WS_PROJ) + PC_KV + tab * 128, WSP(bf16_t, tab ? WS_CVW1 : WS_CKW1), 2048, 1024, 512};
      g.pitchA = 16u * PROJ_LD * 2u; g.kstepA = PROJ_LD * 2u; g.hstepA = 128; g.tA_pm = (size_t)SEQ * PROJ_LD * 2; g.tA_pn = (size_t)8 * PROJ_LD * 2;
      g.pitchB = 4096u; g.kstepB = 128u; g.hstepB = (size_t)128 * 4096; g.tB_pn = 1024; g.nt = 8;
      pg8::StaticOrder S; S.init(2048, 1024, 32, bid & 31);
      pg8::EpiSlabF E{WSP(float, WS_SLAB) + (size_t)tab * 4 * 2048 * 256};
      pg8::gemm_phase<pg8::EpiSlabF, pg8::StaticOrder, PG8_ALIGN, PG8_SP2>(glds, g, S, E);
    } else {
      const int nb = (G >= 128) ? G - 64 : G, b0 = (G >= 128) ? bid - 64 : bid;
      prep::cmp_bias(k->in[3], k->in[4], WSP(bf16_t, WS_CKW1), WSP(bf16_t, WS_CVW1), WSP(float, WS_CPOS), b0 * NWV + wv_, nb * NWV, lane_);
      prep::latent_rows(WSP(bf16_t, WS_PROJ), k->in[9], k->in[10], WSP(float2, WS_ROPE), WSP(bf16_t, WS_CQN), WSP(bf16_t, WS_CKVN), WSP(bf16_t, WS_KROPE), b0 * NWV + wv_, nb * NWV, lane_);
    } }
  xcd_barrier(xbar);
  { kargs_t k = KA(); char* ws = k->ws;
    pg8::Gemm g{WSP(bf16_t, WS_CQN), WSP(bf16_t, WS_UQ), T, 768, 256}; pg8::StaticOrder S; S.init(T, 768, G, (bid + 64) & 255);
    pg8::EpiMlaQF E{WSP(bf16_t, WS_MLAQ), WSP(float2, WS_ROPE)};
    pg8::gemm_phase<pg8::EpiMlaQF, pg8::StaticOrder, PG8_ALIGN, PG8_SP2>(glds, g, S, E); }
  { kargs_t k = KA(); char* ws = k->ws;
    pg8::Gemm g{WSP(bf16_t, WS_CKVN), WSP(bf16_t, WS_UKV), T, 1024, 128}; pg8::StaticOrder S; S.init(T, 1024, G, bid);
    pg8::EpiBf16<0> E{WSP(bf16_t, WS_MLAKV), 1024, nullptr, 0, 0, 1.f};
    pg8::gemm_phase<pg8::EpiBf16<0>, pg8::StaticOrder, PG8_ALIGN, PG8_SP2>(glds, g, S, E); }
  { kargs_t k = KA(); char* ws = k->ws;
    const int lane_ = threadIdx.x & 63, wv_ = threadIdx.x >> 6;
    for (int it = (wv_ == 0) ? (G - 1 - bid) : 128; it < 128; it += G) {
      const int tab = it >> 6;
      prep::cmp_l2(WSP(float, WS_SLAB) + (size_t)tab * 4 * 2048 * 256, WSP(float, WS_CPOS) + tab * 256, WSP(bf16_t, tab ? WS_CVW2 : WS_CKW2), WSP(bf16_t, tab ? WS_VC : WS_KC), it & 63, lane_);
    } }
  xcd_barrier(xbar);
  { kargs_t k = KA(); char* ws = k->ws;
    att::attn_phase(WSP(bf16_t, WS_PROJ), WSP(bf16_t, WS_KC), WSP(bf16_t, WS_VC), k->in[21], WSP(bf16_t, WS_ONSA),
                    WSP(bf16_t, WS_MLAQ), WSP(bf16_t, WS_MLAKV), WSP(bf16_t, WS_KROPE), WSP(bf16_t, WS_ONSA), (att::lptr)lds); }
  xcd_barrier(xbar);
  { kargs_t k = KA(); char* ws = k->ws;
    pg8::Gemm g{WSP(bf16_t, WS_ONSA), WSP(bf16_t, WS_WBN), T, 1024, 1024}; pg8::StaticOrder S; S.init(T, 1024, G, bid);
    pg8::EpiMergeFusedF E{WSP(unsigned char, WS_GATES), WSP(bf16_t, WS_MERGED)};
    pg8::gemm_phase<pg8::EpiMergeFusedF, pg8::StaticOrder, PG8_ALIGN, PG8_SP2>(glds, g, S, E); }
  xcd_barrier(xbar);
  { kargs_t k = KA(); char* ws = k->ws;
    pg8::Gemm g{WSP(bf16_t, WS_MERGED), WSP(bf16_t, WS_WOUT), T, 1024, 1024}; pg8::StaticOrder S; S.init(T, 1024, G, bid);
    pg8::EpiBf16<0> E{WSP(bf16_t, WS_OB), 1024, nullptr, 0, 0, 1.f};
    pg8::gemm_phase<pg8::EpiBf16<0>, pg8::StaticOrder, PG8_ALIGN, PG8_SP2>(glds, g, S, E); }
  xcd_barrier(xbar);
  { kargs_t k = KA(); char* ws = k->ws; ph_rms1024<true>(k->in[0], k->in[16], WSP(bf16_t, WS_HN), T, WSP(unsigned, WS_HN8), WSP(float, WS_SH), -1, 0, WSP(bf16_t, WS_OB));
    peer::conv_tables(k->in[19], k->in[20], WSP(unsigned, WS_U8), WSP(float, WS_SU), WSP(unsigned, WS_V8)); }
  xcd_barrier(xbar);
  { kargs_t k = KA(); char* ws = k->ws;
    pg8::Gemm g{WSP(bf16_t, WS_HN), WSP(bf16_t, WS_WQ), T, 1024, 1024}; pg8::StaticOrder S; S.init(T, 1024, G, bid);
    pg8::EpiBf16<0> E{WSP(bf16_t, WS_PQ), 1024, nullptr, 0, 0, 1.f};
    pg8::gemm_phase<pg8::EpiBf16<0>, pg8::StaticOrder, PG8_ALIGN, PG8_SP2>(glds, g, S, E); }
  xcd_barrier(xbar);
  { kargs_t k = KA(); char* ws = k->ws; peer::route_phase(WSP(bf16_t, WS_PQ), WSP(bf16_t, WS_SUBK), WSP(unsigned, WS_PIDX), (__attribute__((address_space(3))) char*)lds); }
  xcd_barrier(xbar);
  { kargs_t k = KA(); char* ws = k->ws;
    peer::experts_sliced<0>(WSP(unsigned, WS_PIDX), WSP(unsigned, WS_HN8), WSP(float, WS_SH), WSP(unsigned, WS_U8), WSP(float, WS_SU), WSP(float, WS_CO), WSP(unsigned, WS_V8), k->out, WSP(float, WS_SSQ),
                            (unsigned*)ws + CTL_QA, (__attribute__((address_space(3))) char*)lds); }
  xcd_barrier(xbar);
  { kargs_t k = KA(); char* ws = k->ws;
    peer::experts_sliced<1>(WSP(unsigned, WS_PIDX), WSP(unsigned, WS_HN8), WSP(float, WS_SH), WSP(unsigned, WS_U8), WSP(float, WS_SU), WSP(float, WS_CO), WSP(unsigned, WS_V8), (float*)WSP(bf16_t, WS_ZB), WSP(float, WS_SSQ),
                            (unsigned*)ws + CTL_QB, (__attribute__((address_space(3))) char*)lds, k->in[0], WSP(bf16_t, WS_OB)); }
  xcd_barrier(xbar);
  { kargs_t k = KA(); char* ws = k->ws; peer::experts_norm(WSP(float, WS_SSQ), k->in[22], WSP(bf16_t, WS_ZB), k->out); }
}

extern "C" void kernel_launch(void* const* d_in, const int* in_sizes, int n_in, void* d_out, int out_size, void* d_ws, size_t ws_size, hipStream_t stream) {
  if (n_in != 23 || ws_size < 256 * MiB) { fprintf(stderr, "kernel_launch: unexpected n_in %d / ws_size %zu\n", n_in, ws_size); return; }
  static int grid_blocks = 0;
  if (!grid_blocks) {
    int dev = 0, cus = 0, per_cu = 0;
    (void)hipGetDevice(&dev);
    (void)hipDeviceGetAttribute(&cus, hipDeviceAttributeMultiprocessorCount, dev);
    if (hipFuncSetAttribute((const void*)mega, hipFuncAttributeMaxDynamicSharedMemorySize, LDS_BYTES) != hipSuccess) fprintf(stderr, "kernel_launch: hipFuncSetAttribute failed\n");
    (void)hipOccupancyMaxActiveBlocksPerMultiprocessor(&per_cu, (const void*)mega, NTHR, LDS_BYTES);
    if (per_cu < 1) { fprintf(stderr, "kernel_launch: occupancy query returned %d\n", per_cu); per_cu = 1; }
    if (per_cu > 2) per_cu = 2;
    grid_blocks = cus * per_cu;
    fprintf(stderr, "kernel_launch: cus %d per_cu %d grid %d ws %zu\n", cus, per_cu, grid_blocks, ws_size);
  }
  if (hipMemsetAsync(d_ws, 0, 65536, stream) != hipSuccess) fprintf(stderr, "kernel_launch: hipMemsetAsync failed\n");
  Args a{};
  for (int i = 0; i < 23; ++i) a.in[i] = (const float*)d_in[i];
  a.out = (float*)d_out; a.ws = (char*)d_ws;
  void* args[] = {&a};
  hipError_t e = hipLaunchCooperativeKernel((const void*)mega, dim3(grid_blocks), dim3(NTHR), args, LDS_BYTES, stream);
  if (e != hipSuccess) fprintf(stderr, "cooperative launch failed: %s (grid %d)\n", hipGetErrorString(e), grid_blocks);
}
```

```cpp
#include <hip/hip_runtime.h>
#include <stdint.h>
#include <cstdio>
#include <hip/hip_cooperative_groups.h>
namespace cg = cooperative_groups;

typedef unsigned short bf16_t;
#define DEV __device__ __forceinline__

constexpr int BATCH = 8, SEQ = 2048, DM = 1024, T = BATCH * SEQ;
constexpr int IN_COLS = 3768;
constexpr int PROJ_LD = 1792;
constexpr int PC_Q = 0, PC_KV = 512, PC_CQ = 1280, PC_CKV = 1536, PC_KR = 1664, PC_GATE = 1696;
constexpr int NC = 127;
constexpr size_t MiB = 1u << 20;

constexpr size_t WS_WIN = 1 * MiB;
constexpr size_t WS_WBN = 9 * MiB;
constexpr size_t WS_WBM = 10 * MiB;
constexpr size_t WS_WOUT = 11 * MiB;
constexpr size_t WS_WQ = 13 * MiB;
constexpr size_t WS_CKW1 = 15 * MiB;
constexpr size_t WS_CVW1 = 16 * MiB;
constexpr size_t WS_CKW2 = 17 * MiB;
constexpr size_t WS_CVW2 = 17 * MiB + 128 * 1024;
constexpr size_t WS_UQ = 17 * MiB + 256 * 1024;
constexpr size_t WS_UKV = 17 * MiB + 768 * 1024;
constexpr size_t WS_SUBK = 18 * MiB;
constexpr size_t WS_ROPE = 18 * MiB + 512 * 1024;
constexpr size_t WS_GATES = 20 * MiB;
constexpr size_t WS_PQ = 20 * MiB;
constexpr size_t WS_ZB = 20 * MiB;
constexpr size_t WS_OB = 52 * MiB;
constexpr size_t WS_PROJ = 84 * MiB;
constexpr size_t WS_MERGED = 84 * MiB;
constexpr size_t WS_PIDX = 84 * MiB;
constexpr size_t WS_U8 = 172 * MiB;
constexpr size_t WS_V8 = 188 * MiB;
constexpr size_t WS_SU = 204 * MiB;
constexpr size_t WS_SH = 204 * MiB + 65536;
constexpr size_t WS_HN8 = 205 * MiB;
constexpr size_t WS_CO = 221 * MiB;
constexpr size_t WS_SSQ = 229 * MiB;
constexpr int CTL_QA = 4096, CTL_QB = 4096 + 512;
constexpr size_t WS_PW = 92 * MiB;
constexpr size_t WS_XN = 140 * MiB;
constexpr size_t WS_MLAKV = 140 * MiB;
constexpr size_t WS_HN = 140 * MiB;
constexpr size_t WS_MLAQ = 172 * MiB;
constexpr size_t WS_KROPE = 196 * MiB;
constexpr size_t WS_KC = 197 * MiB;
constexpr size_t WS_VC = 197 * MiB + 512 * 1024;
constexpr size_t WS_ONSA = 198 * MiB;
constexpr size_t WS_OMLA = 214 * MiB;
constexpr size_t WS_SLAB = 198 * MiB;
constexpr size_t WS_CPOS = 18 * MiB + 768 * 1024;
constexpr size_t WS_CA = 198 * MiB;
constexpr size_t WS_HID = 206 * MiB;
constexpr size_t WS_HID2 = 207 * MiB;
constexpr size_t WS_CA2 = 214 * MiB;
constexpr size_t WS_CQN = 230 * MiB;
constexpr size_t WS_CKVN = 238 * MiB;
constexpr size_t WS_OCMP = 230 * MiB;
constexpr size_t WS_SEL = 246 * MiB;

__device__ const unsigned char T5B[128] = {
  0, 1, 2, 3, 4, 5, 6, 7, 8, 9, 10, 11, 12, 13, 14, 15, 16, 16, 16, 17, 17, 18, 18, 18, 19, 19, 19, 20, 20, 20, 20, 21,
  21, 21, 21, 22, 22, 22, 22, 22, 23, 23, 23, 23, 23, 23, 24, 24, 24, 24, 24, 24, 25, 25, 25, 25, 25, 25, 25, 26, 26, 26, 26, 26,
  26, 26, 26, 27, 27, 27, 27, 27, 27, 27, 27, 27, 27, 28, 28, 28, 28, 28, 28, 28, 28, 28, 28, 29, 29, 29, 29, 29, 29, 29, 29, 29,
  29, 29, 29, 30, 30, 30, 30, 30, 30, 30, 30, 30, 30, 30, 30, 30, 30, 31, 31, 31, 31, 31, 31, 31, 31, 31, 31, 31, 31, 31, 31, 31};

DEV float bf2f(bf16_t v) { return __uint_as_float(((unsigned)v) << 16); }
DEV bf16_t f2bf(float f) { unsigned u = __float_as_uint(f); u += 0x7fffu + ((u >> 16) & 1u); return (bf16_t)(u >> 16); }
template <int CTRL> DEV int dpp_i(int v) { return __builtin_amdgcn_update_dpp(0, v, CTRL, 0xF, 0xF, true); }
template <int CTRL> DEV float dpp_f(float v) { return __uint_as_float((unsigned)__builtin_amdgcn_update_dpp(0, (int)__float_as_uint(v), CTRL, 0xF, 0xF, true)); }
DEV int sum16_i(int v) { v += dpp_i<0xB1>(v); v += dpp_i<0x4E>(v); v += dpp_i<0x141>(v); v += dpp_i<0x140>(v); return v; }
DEV float sum16_f(float v) { v += dpp_f<0xB1>(v); v += dpp_f<0x4E>(v); v += dpp_f<0x141>(v); v += dpp_f<0x140>(v); return v; }
DEV float max16_f(float v) { v = fmaxf(v, dpp_f<0xB1>(v)); v = fmaxf(v, dpp_f<0x4E>(v)); v = fmaxf(v, dpp_f<0x141>(v)); v = fmaxf(v, dpp_f<0x140>(v)); return v; }
DEV float rl_f(float v, int l) { return __uint_as_float((unsigned)__builtin_amdgcn_readlane((int)__float_as_uint(v), l)); }
DEV float wsum(float v) { v = sum16_f(v); return (rl_f(v, 0) + rl_f(v, 16)) + (rl_f(v, 32) + rl_f(v, 48)); }
DEV float wmaxf(float v) { v = max16_f(v); return fmaxf(fmaxf(rl_f(v, 0), rl_f(v, 16)), fmaxf(rl_f(v, 32), rl_f(v, 48))); }
DEV float sigmoidf_(float x) { return 1.0f / (1.0f + expf(-x)); }
DEV float gelu_exact(float x) { return 0.5f * x * (1.0f + erff(x * 0.70710678118654752f)); }
DEV void wave_lds_sync() { asm volatile("s_waitcnt lgkmcnt(0)" ::: "memory"); __builtin_amdgcn_wave_barrier(); asm volatile("" ::: "memory"); }
DEV float t5bias(const float* t5, int head, int dist) { int d = dist < 127 ? dist : 127; d = d < 0 ? 0 : d; return t5[(int)T5B[d] * 8 + head]; }


namespace pg8 {
#define PG8_LAS __attribute__((address_space(3)))
typedef unsigned short bf16_t;
typedef short bf16x8 __attribute__((ext_vector_type(8)));
typedef float f32x4 __attribute__((ext_vector_type(4)));
typedef unsigned u32x4 __attribute__((ext_vector_type(4)));
constexpr int BM = 256, BK = 64, HALF = 128, HTB = HALF * BK * 2  , STAGE_BYTES = 8 * HTB, NXCD = 8, WGM = 8;

__host__ __device__ __forceinline__ int lds_byte(int r, int c) { const int st = (r >> 4) * 2 + (c >> 5), rr = r & 15, cc = c & 31, ob = rr * 64 + cc * 2; return st * 1024 + (ob ^ (((ob >> 9) & 1) << 5)); }
__host__ __device__ __forceinline__ void stage_rc(int b, int& R, int& C) { const int st = b / 1024, sb = b % 1024, swz = sb ^ (((sb >> 9) & 1) << 5); R = (st >> 1) * 16 + swz / 64; C = (st & 1) * 32 + (swz % 64) / 2; }
__host__ __device__ __forceinline__ int perm32(int rho) { const int n = rho >> 4, i = rho & 15; return 8 * (i >> 2) + 4 * n + (i & 3); }

struct Unit { int pm, pn; };
struct Gemm { const bf16_t* A; const bf16_t* Bt; int M, N, K;
    unsigned pitchA = 0, pitchB = 0, kstepA = 0, kstepB = 0; size_t hstepA = 0, hstepB = 0, tA_pm = 0, tA_pn = 0, tB_pn = 0; int nt = 0; };

struct StaticOrder {
    int nM, nN, nwg, G, c;
    __host__ __device__ void init(int M, int N, int G_, int c_) { nM = M / BM; nN = N / BM; nwg = nM * nN; G = G_; c = c_; }
    __host__ __device__ bool next(int i, Unit& u) const {
        const long L = (long)i * G + c; if (L >= nwg) return false;
        int wgid = (int)L; { const int q = nwg / NXCD, r = nwg % NXCD, xcd = wgid % NXCD, off = wgid / NXCD; wgid = (xcd < r ? xcd * (q + 1) : r * (q + 1) + (xcd - r) * q) + off; }
        const int nig = WGM * nN, gid = wgid / nig, fm = gid * WGM, gsz = (nM - fm) < WGM ? (nM - fm) : WGM;
        u.pm = fm + ((wgid % nig) % gsz); u.pn = (wgid % nig) / gsz; return true;
    }
    __device__ __forceinline__ void a_ready(const Unit&) const {}
    __device__ __forceinline__ void done(const Unit&) const {}
};

__device__ __forceinline__ unsigned cvt_pk_bf16(float lo, float hi) { unsigned r; asm volatile("v_cvt_pk_bf16_f32 %0, %1, %2" : "=v"(r) : "v"(lo), "v"(hi)); return r; }
typedef float f32x2 __attribute__((ext_vector_type(2)));
__device__ __forceinline__ f32x2 gelu_pk(f32x2 v) {
    const f32x2 av = __builtin_elementwise_abs(v), d = av * 0.2316418882f + 1.0f;
    f32x2 t; t.x = __builtin_amdgcn_rcpf(d.x); t.y = __builtin_amdgcn_rcpf(d.y);
    f32x2 q = t * 0.5307027145f + (-0.7265760135f); q = q * t + 0.7107068705f; q = q * t + (-0.142248368f); q = q * t + 0.127414796f; q = q * t;
    const f32x2 s = (v * v) * (-0.72134752044f);
    f32x2 e; e.x = __builtin_amdgcn_exp2f(s.x); e.y = __builtin_amdgcn_exp2f(s.y);
    const f32x2 m = v * (q * e), r = v - m;
    f32x2 o; o.x = v.x < 0.f ? m.x : r.x; o.y = v.y < 0.f ? m.y : r.y; return o;
}

template <int ACT  > struct EpiBf16 {
    static constexpr bool PERM = true, AFTER_DRAIN = false, MIDK = false; static_assert(ACT == 0 || ACT == 1, "EpiBf16: ACT is 0 (none) or 1 (gelu_pk)");
    bf16_t* O; int ldc; const float* bias; int split_cols; size_t split_stride; float scale0;
    __device__ __forceinline__ void operator()(const f32x4 (&acc)[2][2][4][2], const Unit& u, int wr, int wc, int fr, int fq) const {
        const int row0 = u.pm * BM + wr * 64 + fr; int colt = u.pn * BM; bf16_t* base = O;
        float sc = 1.f; if (split_cols) { const int t = colt / split_cols; base += (size_t)t * split_stride; colt -= t * split_cols; if (t == 0) sc = scale0; }
        const int col0 = colt + wc * 32 + 8 * fq, bcol0 = u.pn * BM + wc * 32 + 8 * fq;
        f32x4 bv[2][2];
#pragma unroll
        for (int bj = 0; bj < 2; ++bj)
#pragma unroll
            for (int n = 0; n < 2; ++n) bv[bj][n] = bias ? *(const f32x4*)(bias + bcol0 + bj * HALF + 4 * n) : (f32x4){0.f, 0.f, 0.f, 0.f};
#pragma unroll
        for (int ai = 0; ai < 2; ++ai)
#pragma unroll
            for (int m = 0; m < 4; ++m) { bf16_t* rowp = base + (size_t)(row0 + ai * HALF + m * 16) * ldc + col0;
#pragma unroll
                for (int bj = 0; bj < 2; ++bj) { f32x4 v0 = acc[ai][bj][m][0] + bv[bj][0], v1 = acc[ai][bj][m][1] + bv[bj][1];
                    if (ACT == 1) { f32x2 a = gelu_pk((f32x2){v0[0], v0[1]}), b = gelu_pk((f32x2){v0[2], v0[3]}), c = gelu_pk((f32x2){v1[0], v1[1]}), d = gelu_pk((f32x2){v1[2], v1[3]});
                        v0 = (f32x4){a.x, a.y, b.x, b.y}; v1 = (f32x4){c.x, c.y, d.x, d.y}; }
                    v0 = v0 * sc; v1 = v1 * sc; u32x4 w; w.x = cvt_pk_bf16(v0[0], v0[1]); w.y = cvt_pk_bf16(v0[2], v0[3]); w.z = cvt_pk_bf16(v1[0], v1[1]); w.w = cvt_pk_bf16(v1[2], v1[3]);
                    *(u32x4*)(rowp + bj * HALF) = w; } }
    }
};

struct PanelStats {
    unsigned* xbuf;
    unsigned* cnt;
    unsigned* tmo;
    int ntn; float eps;
    unsigned code;
    __device__ __forceinline__ bool run(const f32x4 (&v)[2][2][4][2], const Unit& u, int wr, int wc, int fr, int fq, PG8_LAS unsigned char* lds, int wid, int lane) const {
        typedef float f32x2v __attribute__((ext_vector_type(2)));
        PG8_LAS f32x2v* P = (PG8_LAS f32x2v*)lds;
        PG8_LAS f32x2v* S = (PG8_LAS f32x2v*)(lds + 8192);
        PG8_LAS unsigned* flag = (PG8_LAS unsigned*)(lds + 8192 + 2048);
#pragma unroll
        for (int ai = 0; ai < 2; ++ai)
#pragma unroll
            for (int m = 0; m < 4; ++m) {
                float s = 0.f;
#pragma unroll
                for (int bj = 0; bj < 2; ++bj)
#pragma unroll
                    for (int n = 0; n < 2; ++n) { const f32x4 x = v[ai][bj][m][n]; s += (x[0] + x[1]) + (x[2] + x[3]); }
                s += __shfl_xor(s, 16); s += __shfl_xor(s, 32);
                const float mw = s * (1.0f / 64.0f); float q = 0.f;
#pragma unroll
                for (int bj = 0; bj < 2; ++bj)
#pragma unroll
                    for (int n = 0; n < 2; ++n) { const f32x4 d = v[ai][bj][m][n] - mw; q += (d[0] * d[0] + d[1] * d[1]) + (d[2] * d[2] + d[3] * d[3]); }
                q += __shfl_xor(q, 16); q += __shfl_xor(q, 32);
                if (fq == 0) P[(ai * HALF + wr * 64 + m * 16 + fr) * 4 + wc] = (f32x2v){mw, q};
            }
        asm volatile("s_waitcnt lgkmcnt(0)" ::: "memory"); __builtin_amdgcn_s_barrier(); asm volatile("" ::: "memory");
#if defined(BROKEN_EXCHANGE_NO_WAIT)
#warning BROKEN CONTROL BUILD: the row-statistics exchange does not wait; results are wrong by design
        if (blockIdx.x >= 64) { const long long t0_ = clock64(); while (clock64() - t0_ < 60000) __builtin_amdgcn_s_sleep(8); }
#endif
        const int row = wid * 32 + (lane & 31);
        if (lane < 32) {
            const f32x2v a = P[row * 4 + 0], b = P[row * 4 + 1], c = P[row * 4 + 2], d = P[row * 4 + 3];
            const float mt = (a.x + b.x + c.x + d.x) * 0.25f;
            const float da = a.x - mt, db = b.x - mt, dc = c.x - mt, dd = d.x - mt;
            const float m2 = (a.y + b.y) + (c.y + d.y) + 64.0f * ((da * da + db * db) + (dc * dc + dd * dd));
            unsigned long long* slot = (unsigned long long*)xbuf + ((size_t)(u.pm * BM + row) * 4 + u.pn);
            __hip_atomic_store(slot, ((unsigned long long)__float_as_uint(m2) << 32) | __float_as_uint(mt), __ATOMIC_RELAXED, __HIP_MEMORY_SCOPE_AGENT);
        }
        asm volatile("s_waitcnt vmcnt(0)" ::: "memory");
        if (lane == 0) __hip_atomic_fetch_add(cnt + 64 * u.pm, 1u, __ATOMIC_RELAXED, __HIP_MEMORY_SCOPE_AGENT);
        if (wid == 0) {
            bool dead = false; const unsigned long long t0 = __builtin_amdgcn_s_memrealtime(); const unsigned want = 8u * (unsigned)ntn;
            for (;;) {
#if defined(BROKEN_EXCHANGE_NO_WAIT)
                break;
#endif
                if ((unsigned)__builtin_amdgcn_readfirstlane(__hip_atomic_load(cnt + 64 * u.pm, __ATOMIC_RELAXED, __HIP_MEMORY_SCOPE_AGENT)) >= want) break;
                if (__builtin_amdgcn_s_memrealtime() - t0 > 2000000ull) {
                    if (lane == 0) { unsigned expect = 0u; __hip_atomic_compare_exchange_strong(tmo + 1, &expect, code | (unsigned)(u.pm & 0xff), __ATOMIC_RELAXED, __ATOMIC_RELAXED, __HIP_MEMORY_SCOPE_AGENT);
                                     __hip_atomic_store(tmo, 1u, __ATOMIC_RELAXED, __HIP_MEMORY_SCOPE_AGENT); }
                    dead = true; break; }
                __builtin_amdgcn_s_sleep(2);
            }
            __builtin_amdgcn_fence(__ATOMIC_ACQUIRE, "agent");
            if (lane == 0) flag[0] = dead ? 1u : 0u;
        }
        asm volatile("s_waitcnt vmcnt(0) lgkmcnt(0)" ::: "memory"); __builtin_amdgcn_s_barrier(); asm volatile("" ::: "memory");
        const bool bad = flag[0] != 0u;
        if (lane < 32) {
            const unsigned long long* slot = (const unsigned long long*)xbuf + (size_t)(u.pm * BM + row) * 4; float mt[4], m2[4]; float ms = 0.f;
#pragma unroll
            for (int t = 0; t < 4; ++t) { if (t < ntn) { const unsigned long long w = __hip_atomic_load(slot + t, __ATOMIC_RELAXED, __HIP_MEMORY_SCOPE_AGENT); mt[t] = __uint_as_float((unsigned)w); m2[t] = __uint_as_float((unsigned)(w >> 32)); } else { mt[t] = 0.f; m2[t] = 0.f; } ms += mt[t]; }
            const float mean = ms / (float)ntn; float q = 0.f;
#pragma unroll
            for (int t = 0; t < 4; ++t) if (t < ntn) { const float dm = mt[t] - mean; q += m2[t] + 256.0f * dm * dm; }
            S[row] = (f32x2v){mean, 1.0f / sqrtf(q / (256.0f * (float)ntn) + eps)};
        }
        asm volatile("s_waitcnt lgkmcnt(0)" ::: "memory"); __builtin_amdgcn_s_barrier(); asm volatile("" ::: "memory");
        return bad;
    }
};
struct EpiLnRes {
    static constexpr bool PERM = false, AFTER_DRAIN = true, MIDK = false;
    const float* base; float* out; int ldc; const float* bias; PanelStats st; unsigned poison;
    __device__ __forceinline__ void fused(f32x4 (&acc)[2][2][4][2], const Unit& u, int wr, int wc, int fr, int fq, PG8_LAS unsigned char* lds, int wid, int lane) const {
        typedef float f32x2v __attribute__((ext_vector_type(2)));
        const PG8_LAS f32x2v* S = (const PG8_LAS f32x2v*)(lds + 8192);
        const int col0 = u.pn * BM + wc * 32 + 4 * fq;
#pragma unroll
        for (int bj = 0; bj < 2; ++bj)
#pragma unroll
            for (int n = 0; n < 2; ++n) { const f32x4 bv = bias ? *(const f32x4*)(bias + col0 + bj * HALF + n * 16) : (f32x4){0.f, 0.f, 0.f, 0.f};
#pragma unroll
                for (int ai = 0; ai < 2; ++ai)
#pragma unroll
                    for (int m = 0; m < 4; ++m) acc[ai][bj][m][n] += bv; }
        f32x4 pre[4][2][2];
#pragma unroll
        for (int m = 0; m < 4; ++m) { const size_t off = (size_t)(u.pm * BM + wr * 64 + m * 16 + fr) * ldc + col0;
#pragma unroll
            for (int bj = 0; bj < 2; ++bj)
#pragma unroll
                for (int n = 0; n < 2; ++n) pre[m][bj][n] = *(const f32x4*)(base + off + bj * HALF + n * 16); }
        const bool bad = st.run(acc, u, wr, wc, fr, fq, lds, wid, lane) || poison != 0u;
        const float qnan = __builtin_nanf("");
#pragma unroll
        for (int ai = 0; ai < 2; ++ai)
#pragma unroll
            for (int m = 0; m < 4; ++m) { const int r = ai * HALF + wr * 64 + m * 16 + fr; const f32x2v sr = S[r]; const size_t off = (size_t)(u.pm * BM + r) * ldc + col0;
#pragma unroll
                for (int bj = 0; bj < 2; ++bj)
#pragma unroll
                    for (int n = 0; n < 2; ++n) { const f32x4 bs = ai == 0 ? pre[m][bj][n] : *(const f32x4*)(base + off + bj * HALF + n * 16); f32x4 o = bs + (acc[ai][bj][m][n] - sr.x) * sr.y;
                        if (bad) o = (f32x4){qnan, qnan, qnan, qnan}; *(f32x4*)(out + off + bj * HALF + n * 16) = o; }
                if (m & 1) asm volatile("" ::: "memory"); }
    }
};
struct EpiLnResLn {
    static constexpr bool PERM = false, AFTER_DRAIN = true, MIDK = false;
    const float* base; float* out; bf16_t* xn; int ldc; const float* bias; PanelStats st1, st2; unsigned poison;
    __device__ __forceinline__ void fused(f32x4 (&acc)[2][2][4][2], const Unit& u, int wr, int wc, int fr, int fq, PG8_LAS unsigned char* lds, int wid, int lane) const {
        typedef float f32x2v __attribute__((ext_vector_type(2))); typedef unsigned u32x2v __attribute__((ext_vector_type(2)));
        const PG8_LAS f32x2v* S = (const PG8_LAS f32x2v*)(lds + 8192);
        const int col0 = u.pn * BM + wc * 32 + 4 * fq;
#pragma unroll
        for (int bj = 0; bj < 2; ++bj)
#pragma unroll
            for (int n = 0; n < 2; ++n) { const f32x4 bv = bias ? *(const f32x4*)(bias + col0 + bj * HALF + n * 16) : (f32x4){0.f, 0.f, 0.f, 0.f};
#pragma unroll
                for (int ai = 0; ai < 2; ++ai)
#pragma unroll
                    for (int m = 0; m < 4; ++m) acc[ai][bj][m][n] += bv; }
        bool bad = st1.run(acc, u, wr, wc, fr, fq, lds, wid, lane) || poison != 0u;
        const float qnan = __builtin_nanf("");
#pragma unroll
        for (int ai = 0; ai < 2; ++ai)
#pragma unroll
            for (int m = 0; m < 4; ++m) { const int r = ai * HALF + wr * 64 + m * 16 + fr; const f32x2v sr = S[r]; const size_t off = (size_t)(u.pm * BM + r) * ldc + col0;
#pragma unroll
                for (int bj = 0; bj < 2; ++bj)
#pragma unroll
                    for (int n = 0; n < 2; ++n) { const f32x4 bs = *(const f32x4*)(base + off + bj * HALF + n * 16); acc[ai][bj][m][n] = bs + (acc[ai][bj][m][n] - sr.x) * sr.y; }
                asm volatile("" : "+v"(acc[ai][0][m][0]), "+v"(acc[ai][0][m][1]), "+v"(acc[ai][1][m][0]), "+v"(acc[ai][1][m][1]));
                if (m & 1) asm volatile("" ::: "memory"); }
        const bool bad1 = bad;
        bad = st2.run(acc, u, wr, wc, fr, fq, lds, wid, lane) || bad;
#pragma unroll
        for (int ai = 0; ai < 2; ++ai)
#pragma unroll
            for (int m = 0; m < 4; ++m) { const int r = ai * HALF + wr * 64 + m * 16 + fr; const f32x2v sr = S[r]; const size_t off = (size_t)(u.pm * BM + r) * ldc + col0;
#pragma unroll
                for (int bj = 0; bj < 2; ++bj)
#pragma unroll
                    for (int n = 0; n < 2; ++n) { const f32x4 x1 = acc[ai][bj][m][n]; *(f32x4*)(out + off + bj * HALF + n * 16) = bad1 ? (f32x4){qnan, qnan, qnan, qnan} : x1;
                        const f32x4 o = (x1 - sr.x) * sr.y; u32x2v w; w.x = cvt_pk_bf16(o[0], o[1]); w.y = cvt_pk_bf16(o[2], o[3]);
                        if (bad) { w.x = 0x7fc07fc0u; w.y = 0x7fc07fc0u; } *(u32x2v*)(xn + off + bj * HALF + n * 16) = w; }
                asm volatile("" ::: "memory"); }
    }
};

template <class Epi, class Sched, bool ALIGN_EPI = false, bool SP2 = false>
__device__ __forceinline__ void gemm_phase(PG8_LAS unsigned char* lds, const Gemm g, const Sched& S, const Epi& E) {
    int tid = threadIdx.x; asm volatile("" : "+v"(tid));
    const int wid = __builtin_amdgcn_readfirstlane(tid >> 6), lane = tid & 63, wr = wid >> 2, wc = wid & 3, fr = lane & 15, fq = lane >> 4;
    int K = g.K; asm volatile("" : "+s"(K)); const int nt = g.nt ? g.nt : K / BK;
    const unsigned pitchA = g.pitchA ? g.pitchA : (unsigned)K * 2u, pitchB = g.pitchB ? g.pitchB : (unsigned)K * 2u;
    unsigned voffA[2], voffB[2];
#pragma unroll
    for (int i = 0; i < 2; ++i) { int R, C; stage_rc(tid * 16 + i * 8192, R, C); const int Rb = Epi::PERM ? ((R & ~31) + perm32(R & 31)) : R;
        voffA[i] = (unsigned)R * pitchA + (unsigned)C * 2u; voffB[i] = (unsigned)Rb * pitchB + (unsigned)C * 2u; }
    const size_t kstepA = g.kstepA ? g.kstepA : (size_t)(BK * 2), kstepB = g.kstepB ? g.kstepB : (size_t)(BK * 2);
    const size_t hstepA = g.hstepA ? g.hstepA : (size_t)HALF * K * 2, hstepB = g.hstepB ? g.hstepB : (size_t)HALF * K * 2;
    const size_t tA_pm = g.tA_pm ? g.tA_pm : (size_t)BM * K * 2, tA_pn = g.tA_pn, tB_pn = g.tB_pn ? g.tB_pn : (size_t)BM * K * 2;
    const unsigned ldsw = (unsigned)wid * 1024u;
    const int aoff = lds_byte(wr * 64 + fr, fq * 8), boff = lds_byte(wc * 32 + fr, fq * 8);
#define PG8_SA(b, h) (((b) * 2 + (h)) * HTB)
#define PG8_SB(b, h) ((4 + (b) * 2 + (h)) * HTB)
#define PG8_STAGE(bufoff, gbase, voff) do { _Pragma("unroll") for (int _i = 0; _i < 2; ++_i) \
        __builtin_amdgcn_global_load_lds((const unsigned*)((const char*)(gbase) + (voff)[_i]), (PG8_LAS unsigned*)(lds + (bufoff) + ldsw + _i * 8192), 16, 0, 0); } while (0)
#define PG8_LDA(dst, b, h) do { _Pragma("unroll") for (int m = 0; m < 4; ++m) _Pragma("unroll") for (int k = 0; k < 2; ++k) dst[m][k] = *(const PG8_LAS bf16x8*)(lds + PG8_SA(b, h) + aoff + m * 2048 + k * 1024); } while (0)
#define PG8_LDB(dst, b, h) do { _Pragma("unroll") for (int n = 0; n < 2; ++n) _Pragma("unroll") for (int k = 0; k < 2; ++k) dst[n][k] = *(const PG8_LAS bf16x8*)(lds + PG8_SB(b, h) + boff + n * 2048 + k * 1024); } while (0)
#define PG8_MMA(ai, bj, At, Bt) do { __builtin_amdgcn_s_setprio(1); _Pragma("unroll") for (int m = 0; m < 4; ++m) _Pragma("unroll") for (int n = 0; n < 2; ++n) _Pragma("unroll") for (int k = 0; k < 2; ++k) \
        acc[ai][bj][m][n] = __builtin_amdgcn_mfma_f32_16x16x32_bf16(Bt[n][k], At[m][k], acc[ai][bj][m][n], 0, 0, 0); __builtin_amdgcn_s_setprio(0); } while (0)
#define PG8_WAIT_V(n) asm volatile("s_waitcnt vmcnt(" #n ")" ::: "memory")
#define PG8_WAIT_L(n) asm volatile("s_waitcnt lgkmcnt(" #n ")" ::: "memory")
#define PG8_BAR __builtin_amdgcn_s_barrier()
#define PG8_SCHED __builtin_amdgcn_sched_barrier(0)
    Unit cur, nxt; int ui = 0;
    if (!S.next(0, cur)) return;
    f32x4 acc[2][2][4][2];
#pragma unroll
    for (int a = 0; a < 2; ++a)
#pragma unroll
        for (int b = 0; b < 2; ++b)
#pragma unroll
            for (int m = 0; m < 4; ++m)
#pragma unroll
                for (int n = 0; n < 2; ++n) acc[a][b][m][n] = (f32x4){0.f, 0.f, 0.f, 0.f};
    bf16x8 At[4][2], B0[2][2], B1[2][2];
    const char* cA = (const char*)g.A + (size_t)cur.pm * tA_pm + (size_t)cur.pn * tA_pn; const char* cB = (const char*)g.Bt + (size_t)cur.pn * tB_pn;
    S.a_ready(cur);
    if constexpr (SP2) {
        PG8_STAGE(PG8_SB(0, 0), cB, voffB); PG8_STAGE(PG8_SB(0, 1), cB + hstepB, voffB); PG8_STAGE(PG8_SA(0, 0), cA, voffA); PG8_STAGE(PG8_SA(0, 1), cA + hstepA, voffA);
        if (wr == 1) PG8_BAR;
        PG8_WAIT_V(2); PG8_BAR;
        PG8_STAGE(PG8_SB(1, 0), cB + kstepB, voffB); PG8_STAGE(PG8_SA(1, 0), cA + kstepA, voffA); PG8_STAGE(PG8_SB(1, 1), cB + hstepB + kstepB, voffB);
        PG8_WAIT_V(6); PG8_BAR;
    } else {
        PG8_STAGE(PG8_SB(0, 0), cB, voffB); PG8_STAGE(PG8_SA(0, 0), cA, voffA); PG8_STAGE(PG8_SB(0, 1), cB + hstepB, voffB); PG8_STAGE(PG8_SA(0, 1), cA + hstepA, voffA);
        if (wr == 1) PG8_BAR;
        PG8_WAIT_V(4); PG8_BAR;
        PG8_STAGE(PG8_SB(1, 0), cB + kstepB, voffB); PG8_STAGE(PG8_SA(1, 0), cA + kstepA, voffA); PG8_STAGE(PG8_SB(1, 1), cB + hstepB + kstepB, voffB);
        PG8_WAIT_V(6); PG8_BAR;
    }
    for (;;) {
        const bool has_next = S.next(ui + 1, nxt);
        const char* nA = has_next ? (const char*)g.A + (size_t)nxt.pm * tA_pm + (size_t)nxt.pn * tA_pn : cA; const char* nB = has_next ? (const char*)g.Bt + (size_t)nxt.pn * tB_pn : cB;
        for (int t = 0; t < nt; t += 2) {
            if constexpr (Epi::MIDK) { if (t == (nt >> 1)) E.midk(acc, cur, wr, wc, fr, fq); }
            const bool last = (t == nt - 2);
            const char* a1 = cA + (size_t)(t + 1) * kstepA;
            const char* a2 = last ? nA : cA + (size_t)(t + 2) * kstepA; const char* b2 = last ? nB : cB + (size_t)(t + 2) * kstepB;
            const char* a3 = a2 + kstepA; const char* b3 = b2 + kstepB;
            if (last && has_next) S.a_ready(nxt);
            if constexpr (SP2) {
            PG8_LDB(B0, 0, 0); PG8_LDB(B1, 0, 1); PG8_SCHED; PG8_LDA(At, 0, 0); PG8_STAGE(PG8_SA(1, 1), a1 + hstepA, voffA);
            PG8_WAIT_V(8); PG8_WAIT_L(0); PG8_BAR; PG8_MMA(0, 0, At, B0); PG8_MMA(0, 1, At, B1); PG8_BAR; PG8_SCHED;
            PG8_LDA(At, 0, 1); PG8_STAGE(PG8_SB(0, 0), b2, voffB); PG8_STAGE(PG8_SB(0, 1), b2 + hstepB, voffB); PG8_STAGE(PG8_SA(0, 0), a2, voffA);
            PG8_WAIT_V(8); PG8_WAIT_L(0); PG8_BAR; PG8_MMA(1, 0, At, B0); PG8_MMA(1, 1, At, B1); PG8_BAR; PG8_SCHED;
            PG8_LDB(B0, 1, 0); PG8_LDB(B1, 1, 1); PG8_SCHED; PG8_LDA(At, 1, 0); PG8_STAGE(PG8_SA(0, 1), a2 + hstepA, voffA);
            PG8_WAIT_V(8); PG8_WAIT_L(0); PG8_BAR; PG8_MMA(0, 0, At, B0); PG8_MMA(0, 1, At, B1); PG8_BAR; PG8_SCHED;
            PG8_LDA(At, 1, 1); PG8_STAGE(PG8_SB(1, 0), b3, voffB); PG8_STAGE(PG8_SB(1, 1), b3 + hstepB, voffB); PG8_STAGE(PG8_SA(1, 0), a3, voffA);
            PG8_WAIT_V(8); PG8_WAIT_L(0); PG8_BAR; PG8_MMA(1, 0, At, B0); PG8_MMA(1, 1, At, B1); PG8_BAR; PG8_SCHED;
            } else {
            PG8_LDB(B0, 0, 0); PG8_SCHED; PG8_LDA(At, 0, 0); PG8_STAGE(PG8_SA(1, 1), a1 + hstepA, voffA);
            PG8_WAIT_L(8); PG8_BAR; PG8_WAIT_L(0); PG8_MMA(0, 0, At, B0); PG8_BAR; PG8_SCHED;
            PG8_LDB(B1, 0, 1); PG8_STAGE(PG8_SB(0, 0), b2, voffB);
            PG8_BAR; PG8_WAIT_L(0); PG8_MMA(0, 1, At, B1); PG8_BAR;
            PG8_LDA(At, 0, 1); PG8_STAGE(PG8_SA(0, 0), a2, voffA);
            PG8_BAR; PG8_WAIT_L(0); PG8_MMA(1, 0, At, B0); PG8_BAR; PG8_SCHED;
            PG8_STAGE(PG8_SB(0, 1), b2 + hstepB, voffB);
            PG8_WAIT_V(6); PG8_BAR; PG8_MMA(1, 1, At, B1); PG8_BAR;
            PG8_LDB(B0, 1, 0); PG8_SCHED; PG8_LDA(At, 1, 0); PG8_STAGE(PG8_SA(0, 1), a2 + hstepA, voffA);
            PG8_WAIT_L(8); PG8_BAR; PG8_WAIT_L(0); PG8_MMA(0, 0, At, B0); PG8_BAR; PG8_SCHED;
            PG8_LDB(B1, 1, 1); PG8_STAGE(PG8_SB(1, 0), b3, voffB);
            PG8_BAR; PG8_WAIT_L(0); PG8_MMA(0, 1, At, B1); PG8_BAR;
            PG8_LDA(At, 1, 1); PG8_STAGE(PG8_SA(1, 0), a3, voffA);
            PG8_BAR; PG8_WAIT_L(0); PG8_MMA(1, 0, At, B0); PG8_BAR; PG8_SCHED;
            PG8_STAGE(PG8_SB(1, 1), b3 + hstepB, voffB);
            PG8_WAIT_V(6); PG8_BAR; PG8_MMA(1, 1, At, B1); PG8_BAR;
            }
        }
        if constexpr (ALIGN_EPI) { if (wr == 0) PG8_BAR; }
        if constexpr (!Epi::AFTER_DRAIN) { E(acc, cur, wr, wc, fr, fq); S.done(cur); }
        if (!has_next) break;
#pragma unroll
        for (int a = 0; a < 2; ++a)
#pragma unroll
            for (int b = 0; b < 2; ++b)
#pragma unroll
                for (int m = 0; m < 4; ++m)
#pragma unroll
                    for (int n = 0; n < 2; ++n) acc[a][b][m][n] = (f32x4){0.f, 0.f, 0.f, 0.f};
        cur = nxt; cA = nA; cB = nB; ++ui;
        if constexpr (ALIGN_EPI) { if (wr == 1) PG8_BAR; }
    }
    PG8_WAIT_V(0);
    if constexpr (!ALIGN_EPI) { if (wr == 0) PG8_BAR; }
    PG8_BAR;
    if constexpr (Epi::AFTER_DRAIN) { E.fused(acc, cur, wr, wc, fr, fq, lds, wid, lane); S.done(cur); }
#undef PG8_SA
#undef PG8_SB
#undef PG8_STAGE
#undef PG8_LDA
#undef PG8_LDB
#undef PG8_MMA
#undef PG8_WAIT_V
#undef PG8_WAIT_L
#undef PG8_BAR
#undef PG8_SCHED
}
}

namespace pg8 {
constexpr float LOG2E = 1.4426950408889634f;
constexpr float QS_NSA = 0.125f * LOG2E;
constexpr float QS_MLA = 0.10206207261596575f * LOG2E;
__device__ __forceinline__ float fast_sigmoid(float x) { return __builtin_amdgcn_rcpf(1.0f + __builtin_amdgcn_exp2f(-LOG2E * x)); }
__device__ __forceinline__ float lo_bf(unsigned u) { return __uint_as_float(u << 16); }
__device__ __forceinline__ float hi_bf(unsigned u) { return __uint_as_float(u & 0xffff0000u); }
struct EpiInProjF {
    static constexpr bool PERM = true, AFTER_DRAIN = false, MIDK = false;
    bf16_t* proj; unsigned char* gates;
    __device__ __forceinline__ void operator()(const f32x4 (&acc)[2][2][4][2], const Unit& u, int wr, int wc, int fr, int fq) const {
        const bool isg = u.pn >= 7;
        bf16_t* base = proj; const int ld = 1792; const int colt = isg ? (u.pn - 7) * BM : u.pn * BM;
        const float sc = (u.pn < 2) ? QS_NSA : 1.0f;
        const int row0 = u.pm * BM + wr * 64 + fr, col0 = colt + wc * 32 + 8 * fq;
#pragma unroll
        for (int ai = 0; ai < 2; ++ai)
#pragma unroll
            for (int m = 0; m < 4; ++m) { bf16_t* rowp = base + (size_t)(row0 + ai * HALF + m * 16) * ld + col0;
#pragma unroll
                for (int bj = 0; bj < 2; ++bj) { f32x4 v0 = acc[ai][bj][m][0], v1 = acc[ai][bj][m][1];
                    if (isg) {
                        unsigned q[8];
#pragma unroll
                        for (int e = 0; e < 4; ++e) { q[e] = (unsigned)(fast_sigmoid(v0[e]) * 255.0f + 0.5f); q[4 + e] = (unsigned)(fast_sigmoid(v1[e]) * 255.0f + 0.5f); }
                        uint2 w; w.x = q[0] | (q[1] << 8) | (q[2] << 16) | (q[3] << 24); w.y = q[4] | (q[5] << 8) | (q[6] << 16) | (q[7] << 24);
                        *(uint2*)(gates + (size_t)(row0 + ai * HALF + m * 16) * 2048 + col0 + bj * HALF) = w;
                    } else { v0 = v0 * sc; v1 = v1 * sc;
                        u32x4 w; w.x = cvt_pk_bf16(v0[0], v0[1]); w.y = cvt_pk_bf16(v0[2], v0[3]); w.z = cvt_pk_bf16(v1[0], v1[1]); w.w = cvt_pk_bf16(v1[2], v1[3]);
                        *(u32x4*)(rowp + bj * HALF) = w; } } }
    }
};
template <int PASS> struct EpiMergeF {
    static constexpr bool PERM = true, AFTER_DRAIN = false, MIDK = false;
    const unsigned char* gates; bf16_t* merged;
    __device__ __forceinline__ void operator()(const f32x4 (&acc)[2][2][4][2], const Unit& u, int wr, int wc, int fr, int fq) const {
        const int row0 = u.pm * BM + wr * 64 + fr, col0 = u.pn * BM + wc * 32 + 8 * fq;
#pragma unroll
        for (int ai = 0; ai < 2; ++ai)
#pragma unroll
            for (int m = 0; m < 4; ++m) { const size_t r = (size_t)(row0 + ai * HALF + m * 16);
#pragma unroll
                for (int bj = 0; bj < 2; ++bj) { const int c = col0 + bj * HALF;
                    const uint2 g = *(const uint2*)(gates + r * 2048 + PASS * 1024 + c);
                    f32x4 v0 = acc[ai][bj][m][0] * (1.0f / 255.0f), v1 = acc[ai][bj][m][1] * (1.0f / 255.0f);
                    v0[0] *= (float)(g.x & 255u); v0[1] *= (float)((g.x >> 8) & 255u); v0[2] *= (float)((g.x >> 16) & 255u); v0[3] *= (float)(g.x >> 24);
                    v1[0] *= (float)(g.y & 255u); v1[1] *= (float)((g.y >> 8) & 255u); v1[2] *= (float)((g.y >> 16) & 255u); v1[3] *= (float)(g.y >> 24);
                    if (PASS == 1) { const u32x4 o = *(const u32x4*)(merged + r * 1024 + c);
                        v0[0] += lo_bf(o.x); v0[1] += hi_bf(o.x); v0[2] += lo_bf(o.y); v0[3] += hi_bf(o.y);
                        v1[0] += lo_bf(o.z); v1[1] += hi_bf(o.z); v1[2] += lo_bf(o.w); v1[3] += hi_bf(o.w); }
                    u32x4 w; w.x = cvt_pk_bf16(v0[0], v0[1]); w.y = cvt_pk_bf16(v0[2], v0[3]); w.z = cvt_pk_bf16(v1[0], v1[1]); w.w = cvt_pk_bf16(v1[2], v1[3]);
                    *(u32x4*)(merged + r * 1024 + c) = w; } }
    }
};
struct EpiMergeFusedF {
    static constexpr bool PERM = true, AFTER_DRAIN = false, MIDK = true;
    const unsigned char* gates; bf16_t* merged;
    __device__ __forceinline__ void midk(f32x4 (&acc)[2][2][4][2], const Unit& u, int wr, int wc, int fr, int fq) const {
        asm volatile("" : "+v"(fr), "+v"(fq));
        const int row0 = u.pm * BM + wr * 64 + fr, col0 = u.pn * BM + wc * 32 + 8 * fq;
#pragma unroll
        for (int ai = 0; ai < 2; ++ai)
#pragma unroll
            for (int m = 0; m < 4; ++m) { const size_t r = (size_t)(row0 + ai * HALF + m * 16);
#pragma unroll
                for (int bj = 0; bj < 2; ++bj) { const int c = col0 + bj * HALF;
                    const uint2 g0 = *(const uint2*)(gates + r * 2048 + c), g1 = *(const uint2*)(gates + r * 2048 + 1024 + c);
#pragma unroll
                    for (int e = 0; e < 4; ++e) {
                        const float a0 = (float)((g0.x >> (8 * e)) & 255u), b0 = fmaxf((float)((g1.x >> (8 * e)) & 255u), 1.0f);
                        const float a1 = (float)((g0.y >> (8 * e)) & 255u), b1 = fmaxf((float)((g1.y >> (8 * e)) & 255u), 1.0f);
                        acc[ai][bj][m][0][e] *= a0 * __builtin_amdgcn_rcpf(b0); acc[ai][bj][m][1][e] *= a1 * __builtin_amdgcn_rcpf(b1); }
                    asm volatile("" ::: "memory"); } }
    }
    __device__ __forceinline__ void operator()(const f32x4 (&acc)[2][2][4][2], const Unit& u, int wr, int wc, int fr, int fq) const {
        const int row0 = u.pm * BM + wr * 64 + fr, col0 = u.pn * BM + wc * 32 + 8 * fq;
#pragma unroll
        for (int ai = 0; ai < 2; ++ai)
#pragma unroll
            for (int m = 0; m < 4; ++m) { const size_t r = (size_t)(row0 + ai * HALF + m * 16);
#pragma unroll
                for (int bj = 0; bj < 2; ++bj) { const int c = col0 + bj * HALF;
                    const uint2 g1 = *(const uint2*)(gates + r * 2048 + 1024 + c);
                    f32x4 v0 = acc[ai][bj][m][0] * (1.0f / 255.0f), v1 = acc[ai][bj][m][1] * (1.0f / 255.0f);
#pragma unroll
                    for (int e = 0; e < 4; ++e) { v0[e] *= fmaxf((float)((g1.x >> (8 * e)) & 255u), 1.0f); v1[e] *= fmaxf((float)((g1.y >> (8 * e)) & 255u), 1.0f); }
                    u32x4 w; w.x = cvt_pk_bf16(v0[0], v0[1]); w.y = cvt_pk_bf16(v0[2], v0[3]); w.z = cvt_pk_bf16(v1[0], v1[1]); w.w = cvt_pk_bf16(v1[2], v1[3]);
                    *(u32x4*)(merged + r * 1024 + c) = w; } }
    }
};
struct EpiCmpOutF {
    static constexpr bool PERM = true, AFTER_DRAIN = false, MIDK = false;
    bf16_t* dst;
    __device__ __forceinline__ void operator()(const f32x4 (&acc)[2][2][4][2], const Unit& u, int wr, int wc, int fr, int fq) const {
        if (wc >= 2) return;
        const int row0 = u.pm * BM + wr * 64 + fr, col0 = wc * 32 + 8 * fq;
#pragma unroll
        for (int ai = 0; ai < 2; ++ai)
#pragma unroll
            for (int m = 0; m < 4; ++m) { const int r = row0 + ai * HALF + m * 16;
                if (r < BATCH * NC * 2) { const int g = r & 1, bc = r >> 1, b = bc / NC, c = bc % NC;
                    const f32x4 v0 = acc[ai][0][m][0], v1 = acc[ai][0][m][1];
                    u32x4 w; w.x = cvt_pk_bf16(v0[0], v0[1]); w.y = cvt_pk_bf16(v0[2], v0[3]); w.z = cvt_pk_bf16(v1[0], v1[1]); w.w = cvt_pk_bf16(v1[2], v1[3]);
                    *(u32x4*)(dst + ((size_t)(b * 2 + g) * 128 + c) * 64 + col0) = w; } }
    }
};
struct EpiSlabF {
    static constexpr bool PERM = false, AFTER_DRAIN = false, MIDK = false;
    float* slab;
    __device__ __forceinline__ void operator()(const f32x4 (&acc)[2][2][4][2], const Unit& u, int wr, int wc, int fr, int fq) const {
        const int row0 = u.pm * BM + wr * 64 + fr, col0 = wc * 32 + 4 * fq;
        float* base = slab + (size_t)u.pn * 2048 * 256;
#pragma unroll
        for (int ai = 0; ai < 2; ++ai)
#pragma unroll
            for (int m = 0; m < 4; ++m) { float* rowp = base + (size_t)(row0 + ai * HALF + m * 16) * 256 + col0;
#pragma unroll
                for (int bj = 0; bj < 2; ++bj)
#pragma unroll
                    for (int n = 0; n < 2; ++n) *(f32x4*)(rowp + bj * HALF + n * 16) = acc[ai][bj][m][n]; }
    }
};
struct EpiResidF {
    static constexpr bool PERM = false, AFTER_DRAIN = false, MIDK = false;
    const float* x; float* h;
    __device__ __forceinline__ void operator()(const f32x4 (&acc)[2][2][4][2], const Unit& u, int wr, int wc, int fr, int fq) const {
        const int row0 = u.pm * BM + wr * 64 + fr, col0 = u.pn * BM + wc * 32 + 4 * fq;
#pragma unroll
        for (int ai = 0; ai < 2; ++ai)
#pragma unroll
            for (int m = 0; m < 4; ++m) { const size_t off = (size_t)(row0 + ai * HALF + m * 16) * 1024 + col0;
#pragma unroll
                for (int bj = 0; bj < 2; ++bj)
#pragma unroll
                    for (int n = 0; n < 2; ++n) { const f32x4 xv = *(const f32x4*)(x + off + bj * HALF + n * 16); *(f32x4*)(h + off + bj * HALF + n * 16) = xv + acc[ai][bj][m][n]; } }
    }
};
struct EpiMlaQF {
    static constexpr bool PERM = false, AFTER_DRAIN = false, MIDK = false;
    bf16_t* q; const float2* cs;
    __device__ __forceinline__ void operator()(const f32x4 (&acc)[2][2][4][2], const Unit& u, int wr, int wc, int fr, int fq) const {
        const int row0 = u.pm * BM + wr * 64 + fr;
#pragma unroll
        for (int bj = 0; bj < 2; ++bj) {
            const int X = u.pn * BM + bj * HALF + wc * 32;
            const bool rope = (X % 96) == 64;
#pragma unroll
            for (int ai = 0; ai < 2; ++ai)
#pragma unroll
                for (int m = 0; m < 4; ++m) { const int r = row0 + ai * HALF + m * 16; const int pos = r & (SEQ - 1);
                    f32x4 v0 = acc[ai][bj][m][0], v1 = acc[ai][bj][m][1];
                    if (rope) {
#pragma unroll
                        for (int j = 0; j < 4; ++j) { const float2 c = cs[pos * 16 + 4 * fq + j]; const float x1 = v0[j], x2 = v1[j]; v0[j] = x1 * c.x - x2 * c.y; v1[j] = x2 * c.x + x1 * c.y; } }
                    v0 = v0 * QS_MLA; v1 = v1 * QS_MLA;
                    bf16_t* p = q + (size_t)r * 768 + X + 4 * fq;
                    uint2 w0, w1; w0.x = cvt_pk_bf16(v0[0], v0[1]); w0.y = cvt_pk_bf16(v0[2], v0[3]); w1.x = cvt_pk_bf16(v1[0], v1[1]); w1.y = cvt_pk_bf16(v1[2], v1[3]);
                    *(uint2*)p = w0; *(uint2*)(p + 16) = w1; }
        }
    }
};
}

#define PG8_SP2 true
#define PG8_ALIGN true
constexpr int NTHR = 512, NWV = NTHR / 64;
#define WAVE_IDS const int lane = threadIdx.x & 63, wv = threadIdx.x >> 6; const int gw = blockIdx.x * NWV + wv, nw = gridDim.x * NWV; (void)lane; (void)gw; (void)nw;

template <bool Q8> DEV void ph_rms1024(const float* __restrict__ src, const float* __restrict__ g, bf16_t* __restrict__ dst, int rows, unsigned* __restrict__ q8 = nullptr, float* __restrict__ qs = nullptr, int gw_o = -1, int nw_o = 0, const bf16_t* __restrict__ add = nullptr) {
  const int lane = threadIdx.x & 63; const int gw = (gw_o >= 0) ? gw_o : (int)(blockIdx.x * NWV + (threadIdx.x >> 6)); const int nw = (gw_o >= 0) ? nw_o : (int)(gridDim.x * NWV);
  float4 gg[4];
#pragma unroll
  for (int j = 0; j < 4; ++j) gg[j] = ((const float4*)g)[j * 64 + lane];
  float4 nx[4]; uint2 na[4];
  if (gw < rows) {
#pragma unroll
    for (int j = 0; j < 4; ++j) { nx[j] = ((const float4*)(src + (size_t)gw * 1024))[j * 64 + lane]; if (add) na[j] = ((const uint2*)(add + (size_t)gw * 1024))[j * 64 + lane]; } }
  for (int r = gw; r < rows; r += nw) {
    float4 v[4]; float ss = 0.f;
#pragma unroll
    for (int j = 0; j < 4; ++j) { v[j] = nx[j];
      if (add) { v[j].x += __uint_as_float(na[j].x << 16); v[j].y += __uint_as_float(na[j].x & 0xffff0000u); v[j].z += __uint_as_float(na[j].y << 16); v[j].w += __uint_as_float(na[j].y & 0xffff0000u); }
      ss += v[j].x * v[j].x + v[j].y * v[j].y + v[j].z * v[j].z + v[j].w * v[j].w; }
    if (r + nw < rows) {
#pragma unroll
      for (int j = 0; j < 4; ++j) { nx[j] = ((const float4*)(src + (size_t)(r + nw) * 1024))[j * 64 + lane]; if (add) na[j] = ((const uint2*)(add + (size_t)(r + nw) * 1024))[j * 64 + lane]; } }
    ss = wsum(ss);
    const float inv = rsqrtf(ss * (1.0f / 1024.0f) + 1e-6f);
    float mx = 0.f;
#pragma unroll
    for (int j = 0; j < 4; ++j) {
      v[j].x *= inv * gg[j].x; v[j].y *= inv * gg[j].y; v[j].z *= inv * gg[j].z; v[j].w *= inv * gg[j].w;
      uint2 o;
      o.x = (unsigned)f2bf(v[j].x) | ((unsigned)f2bf(v[j].y) << 16);
      o.y = (unsigned)f2bf(v[j].z) | ((unsigned)f2bf(v[j].w) << 16);
      ((uint2*)(dst + (size_t)r * 1024))[j * 64 + lane] = o;
      if (Q8) mx = fmaxf(mx, fmaxf(fmaxf(fabsf(v[j].x), fabsf(v[j].y)), fmaxf(fabsf(v[j].z), fabsf(v[j].w))));
    }
    if (Q8) {
      mx = wmaxf(mx);
      const float sc = fmaxf(mx, 1e-30f) * (1.0f / 127.0f), isc = 1.0f / sc;
#pragma unroll
      for (int j = 0; j < 4; ++j) {
        const int q0 = (int)rintf(v[j].x * isc), q1 = (int)rintf(v[j].y * isc), q2 = (int)rintf(v[j].z * isc), q3 = (int)rintf(v[j].w * isc);
        q8[(size_t)r * 256 + j * 64 + lane] = (unsigned)(q0 & 255) | ((unsigned)(q1 & 255) << 8) | ((unsigned)(q2 & 255) << 16) | ((unsigned)(q3 & 255) << 24);
      }
      if (lane == 0) qs[r] = sc;
    }
  }
}
DEV int win_src_col(int n) {
  if (n < 1280) return n;
  if (n < 1536) return 1304 + (n - 1280);
  if (n < 1664) return 1560 + (n - 1536);
  if (n < 1696) return 1688 + (n - 1664);
  if (n < 1720) return 1280 + (n - 1696);
  if (n < 1792) return -1;
  return 1720 + (n - 1792);
}
template <int MODE> DEV void tr_item(const float* __restrict__ W, int K, int Nsrc, bf16_t* __restrict__ WT, int Nblk, int Nvalid, __attribute__((address_space(3))) float* scr, int item, int lane, int pitch = 0, int koff = 0) {
  if (pitch == 0) pitch = K;
  const int kb = item / Nblk, nb = item % Nblk, k0 = 64 * kb, n0 = 32 * nb;
  const int n = n0 + (lane & 31);
  const int sc = (MODE == 1) ? win_src_col(n) : ((n < Nvalid) ? n : -1);
  float tv[32];
#pragma unroll
  for (int i = 0; i < 32; ++i) { const int kk = 2 * i + (lane >> 5); tv[i] = (sc >= 0) ? W[(size_t)(k0 + kk) * Nsrc + sc] : 0.f; }
#pragma unroll
  for (int i = 0; i < 32; ++i) { const int kk = 2 * i + (lane >> 5); scr[kk * 33 + (lane & 31)] = tv[i]; }
  asm volatile("s_waitcnt lgkmcnt(0)" ::: "memory");
  const int c = lane & 7;
#pragma unroll
  for (int j = 0; j < 4; ++j) { const int nn = (lane >> 3) + 8 * j; const __attribute__((address_space(3))) float* sp = scr + (8 * c) * 33 + nn;
    uint4 o;
    o.x = (unsigned)f2bf(sp[0 * 33]) | ((unsigned)f2bf(sp[1 * 33]) << 16); o.y = (unsigned)f2bf(sp[2 * 33]) | ((unsigned)f2bf(sp[3 * 33]) << 16);
    o.z = (unsigned)f2bf(sp[4 * 33]) | ((unsigned)f2bf(sp[5 * 33]) << 16); o.w = (unsigned)f2bf(sp[6 * 33]) | ((unsigned)f2bf(sp[7 * 33]) << 16);
    *(uint4*)(WT + (size_t)(n0 + nn) * pitch + koff + k0 + 8 * c) = o; }
  asm volatile("s_waitcnt lgkmcnt(0)" ::: "memory");
}
DEV void rope_entry(float2* __restrict__ cs, int i) {
  const int j = i & 15, pos = i >> 4;
  const float inv_freq = __builtin_amdgcn_exp2f(-(float)(2 * j) * (13.287712379549449f / 32.0f));
  const float rev = (float)pos * inv_freq * 0.15915494309189535f;
  const float fr = rev - floorf(rev);
  cs[i] = make_float2(__builtin_amdgcn_cosf(fr), __builtin_amdgcn_sinf(fr));
}
namespace att {
#define LAS3 __attribute__((address_space(3)))
typedef LAS3 char* lptr;
typedef LAS3 const char* lcptr;
using bf16x8 = __attribute__((ext_vector_type(8))) short;
using s16x4 = __attribute__((ext_vector_type(4))) short;
using f32x16 = __attribute__((ext_vector_type(16))) float;
typedef short v4i16_t __attribute__((ext_vector_type(4)));
typedef unsigned u32x4 __attribute__((ext_vector_type(4)));
typedef float f32x4_t __attribute__((ext_vector_type(4)));
typedef float f32x2_t __attribute__((ext_vector_type(2)));
typedef __bf16 bf16x2_t __attribute__((ext_vector_type(2)));
constexpr float LOG2E = 1.4426950408889634f;
constexpr float THR = 8.0f;
constexpr float NEG_INF = -__builtin_huge_valf();
constexpr int SLOT = 20480, KOFF = 0, VOFF = 12288;
constexpr int L_WSF = 2 * SLOT;
constexpr int L_TB = L_WSF + 2048;
constexpr int L_ST = L_TB + 8 * 320 * 4;
constexpr int L_SELM = L_ST + 768;
constexpr int L_SC = L_SELM + 256;
constexpr int L_IMPQ = L_SC + 64 * 33 * 4;
constexpr int L_IMPL = L_IMPQ + 4 * 64 * 33 * 4;
constexpr int L_FIN = L_IMPQ;
constexpr int L_END = L_IMPL + 4 * 64 * 33 * 4;
static_assert(L_END <= 131072, "attention LDS map");

__device__ __forceinline__ int crow(int r, int hi) { return (r & 3) + 8 * (r >> 2) + 4 * hi; }
__device__ __forceinline__ s16x4 vtr(lcptr p) { return __builtin_bit_cast(s16x4, __builtin_amdgcn_ds_read_tr16_b64_v4i16((LAS3 v4i16_t*)p)); }
__device__ __forceinline__ unsigned cvtpk(float lo, float hi) { f32x2_t v = {lo, hi}; bf16x2_t b = __builtin_convertvector(v, bf16x2_t); return __builtin_bit_cast(unsigned, b); }
__device__ __forceinline__ float xmax(float v) { auto rr = __builtin_amdgcn_permlane32_swap(__float_as_uint(v), __float_as_uint(v), false, false); return fmaxf(__uint_as_float(rr[0]), __uint_as_float(rr[1])); }
__device__ __forceinline__ float xsum(float v) { auto rr = __builtin_amdgcn_permlane32_swap(__float_as_uint(v), __float_as_uint(v), false, false); return __uint_as_float(rr[0]) + __uint_as_float(rr[1]); }
__device__ __forceinline__ float ex2(float x) { return __builtin_amdgcn_exp2f(x); }

template <int ND0> __device__ __forceinline__ void qkt(f32x16& p0, f32x16& p1, lcptr kb, const bf16x8* qr) {
  p0 = f32x16{}; p1 = f32x16{};
  __builtin_amdgcn_s_setprio(1);
#pragma unroll
  for (int d0 = 0; d0 < ND0; ++d0) {
    const bf16x8 b0 = *(const LAS3 bf16x8*)(kb + d0 * 2048);
    const bf16x8 b1 = *(const LAS3 bf16x8*)(kb + d0 * 2048 + 512);
    p0 = __builtin_amdgcn_mfma_f32_32x32x16_bf16(b0, qr[d0], p0, 0, 0, 0);
    p1 = __builtin_amdgcn_mfma_f32_32x32x16_bf16(b1, qr[d0], p1, 0, 0, 0);
  }
  __builtin_amdgcn_s_setprio(0);
}
template <int ND0> __device__ __forceinline__ void qkt_init(f32x16& p0, f32x16& p1, lcptr kb, const bf16x8* qr, const f32x16& c0, const f32x16& c1) {
  p0 = c0; p1 = c1;
  __builtin_amdgcn_s_setprio(1);
#pragma unroll
  for (int d0 = 0; d0 < ND0; ++d0) {
    const bf16x8 b0 = *(const LAS3 bf16x8*)(kb + d0 * 2048);
    const bf16x8 b1 = *(const LAS3 bf16x8*)(kb + d0 * 2048 + 512);
    p0 = __builtin_amdgcn_mfma_f32_32x32x16_bf16(b0, qr[d0], p0, 0, 0, 0);
    p1 = __builtin_amdgcn_mfma_f32_32x32x16_bf16(b1, qr[d0], p1, 0, 0, 0);
  }
  __builtin_amdgcn_s_setprio(0);
}
__device__ __forceinline__ void pv(f32x16 (&o)[2], lcptr vp, const unsigned (&pw)[16]) {
  __builtin_amdgcn_s_setprio(1);
#pragma unroll
  for (int d0 = 0; d0 < 2; ++d0)
#pragma unroll
    for (int ks = 0; ks < 4; ++ks) {
      const s16x4 lo = vtr(vp + d0 * 4096 + ks * 1024), hi4 = vtr(vp + d0 * 4096 + ks * 1024 + 512);
      const bf16x8 vf = {lo[0], lo[1], lo[2], lo[3], hi4[0], hi4[1], hi4[2], hi4[3]};
      const unsigned pa4[4] = {pw[4 * ks], pw[4 * ks + 1], pw[4 * ks + 2], pw[4 * ks + 3]};
      o[d0] = __builtin_amdgcn_mfma_f32_32x32x16_bf16(__builtin_bit_cast(bf16x8, pa4), vf, o[d0], 0, 0, 0);
    }
  __builtin_amdgcn_s_setprio(0);
}
__device__ __forceinline__ void softmax_step(f32x16& p0, f32x16& p1, float& m, float& l, f32x16 (&o)[2], LAS3 float* wsf, int r32, int hi, unsigned (&pw)[16]) {
  float rm = fmaxf(p0[0], p1[0]);
#pragma unroll
  for (int r = 1; r < 16; ++r) rm = fmaxf(rm, fmaxf(p0[r], p1[r]));
  rm = xmax(rm);
  if (__any(rm > m + THR)) {
    const float mn = fmaxf(m, rm);
    const float al = ex2(m - mn);
    m = mn; l *= al;
    if (hi == 0) wsf[r32] = al;
#pragma unroll
    for (int r = 0; r < 16; ++r) { const float f = wsf[crow(r, hi)]; o[0][r] *= f; o[1][r] *= f; }
  }
  float s = 0.f;
#pragma unroll
  for (int r = 0; r < 16; ++r) { p0[r] = ex2(p0[r] - m); p1[r] = ex2(p1[r] - m); s += p0[r] + p1[r]; }
  l += s;
#pragma unroll
  for (int i = 0; i < 8; ++i) { pw[i] = cvtpk(p0[2 * i], p0[2 * i + 1]); pw[8 + i] = cvtpk(p1[2 * i], p1[2 * i + 1]); }
}
struct KVSrc { const bf16_t* k; const bf16_t* v; int ldk, ldv; };
__device__ __forceinline__ void kv_issue(const KVSrc& s, int row0, u32x4& rk, u32x4& rv, int tid) {
  const int kv = tid & 63, ch = tid >> 6, ln = tid & 63;
  rk = *(const u32x4*)(s.k + (size_t)(row0 + kv) * s.ldk + ch * 8);
  rv = *(const u32x4*)(s.v + (size_t)(row0 + 16 * (ch & 3) + (ln >> 2)) * s.ldv + (ch >> 2) * 32 + (ln & 3) * 8);
}
__device__ __forceinline__ void kv_commit(lptr slot, const u32x4& rk, const u32x4& rv, int tid) {
  *(LAS3 u32x4*)(slot + KOFF + (tid >> 6) * 1024 + (tid & 63) * 16) = rk;
  *(LAS3 u32x4*)(slot + VOFF + tid * 16) = rv;
}
__device__ __forceinline__ void fin_set(LAS3 float* finl, const f32x16 (&o)[2], int lane) {
#pragma unroll
  for (int d0 = 0; d0 < 2; ++d0)
#pragma unroll
    for (int r = 0; r < 16; ++r) finl[(d0 * 16 + r) * 64 + lane] = o[d0][r];
}
__device__ __forceinline__ void fin_add(LAS3 float* finl, const f32x16 (&o)[2], const LAS3 float* wsf, int lane, int hi) {
#pragma unroll
  for (int r = 0; r < 16; ++r) { const float f = wsf[crow(r, hi)];
#pragma unroll
    for (int d0 = 0; d0 < 2; ++d0) finl[(d0 * 16 + r) * 64 + lane] += o[d0][r] * f; }
}
__device__ __forceinline__ void fin_store(const LAS3 float* finl, bf16_t* gout, size_t rowbase, int ld, int colbase, int lane) {
#pragma unroll
  for (int i = 0; i < 4; ++i) {
    const int q = i * 8 + (lane >> 3), ch = lane & 7;
    const int qh = (q >> 2) & 1, r = (q & 3) + 4 * (q >> 3), d0 = ch >> 2, dl = (ch & 3) * 8;
    const LAS3 float* p = finl + (d0 * 16 + r) * 64 + qh * 32 + dl;
    const f32x4_t x0 = *(const LAS3 f32x4_t*)p, x1 = *(const LAS3 f32x4_t*)(p + 4);
    u32x4 v; v.x = cvtpk(x0[0], x0[1]); v.y = cvtpk(x0[2], x0[3]); v.z = cvtpk(x1[0], x1[1]); v.w = cvtpk(x1[2], x1[3]);
    *(u32x4*)(gout + (rowbase + q) * (size_t)ld + colbase + ch * 8) = v;
  }
}

__device__ __forceinline__ void nsa_unit(int b, int g, int c, const bf16_t* __restrict__ proj, const bf16_t* __restrict__ kc, const bf16_t* __restrict__ vc, bf16_t* __restrict__ onsa, lptr lds) {
  int tid = threadIdx.x; asm volatile("" : "+v"(tid));
  const int lane = tid & 63, r32 = lane & 31, hi = lane >> 5;
  const int w = __builtin_amdgcn_readfirstlane(tid >> 6);
  const int rh = w >> 1, head = g * 4 + rh, tokl = 32 * (w & 1) + r32, t = 64 * c + tokl, bg = b * 2 + g;
  const size_t tok = (size_t)b * SEQ + t;
  LAS3 float* wsf = (LAS3 float*)(lds + L_WSF) + w * 64;
  const LAS3 float* tb = (const LAS3 float*)(lds + L_TB) + head * 320 + 64;
  const LAS3 float* stp = (const LAS3 float*)(lds + L_ST);
  LAS3 unsigned* selm = (LAS3 unsigned*)(lds + L_SELM);
  LAS3 float* sc = (LAS3 float*)(lds + L_SC);
  LAS3 float* impq = (LAS3 float*)(lds + L_IMPQ);
  LAS3 float* impl = (LAS3 float*)(lds + L_IMPL);
  const lcptr kb0 = (lcptr)lds + KOFF + hi * 1024 + r32 * 16;
  const lcptr vp0 = (lcptr)lds + VOFF + ((lane >> 4) & 1) * 32 + (lane & 3) * 8 + (4 * hi + ((lane & 15) >> 2)) * 64;
  bf16x8 qr[4];
#pragma unroll
  for (int d0 = 0; d0 < 4; ++d0) qr[d0] = *(const bf16x8*)(proj + tok * PROJ_LD + PC_Q + head * 64 + d0 * 16 + hi * 8);
  float gate[3];
#pragma unroll
  for (int j = 0; j < 3; ++j) gate[j] = 1.0f / (1.0f + ex2(-LOG2E * bf2f(proj[tok * PROJ_LD + PC_GATE + head * 3 + j])));
  LAS3 float* finl = (LAS3 float*)(lds + L_FIN) + w * 2048;
  f32x16 o[2]; unsigned pw[16];
  u32x4 rk, rv;
  {
    const KVSrc src{kc + (size_t)bg * 128 * 64, vc + (size_t)bg * 128 * 64, 64, 64};
    __syncthreads();
    kv_issue(src, 0, rk, rv, tid); kv_commit(lds, rk, rv, tid);
    kv_issue(src, 64, rk, rv, tid); kv_commit(lds + SLOT, rk, rv, tid);
    __syncthreads();
    f32x16 a0, a1, b0, b1;
    const int twmin = 64 * c + 32 * (w & 1), twmax = twmin + 31;
    const bool live0 = true, live1 = (16 * 32 + 31 <= twmax), live2 = (16 * 64 + 31 <= twmax), live3 = (16 * 96 + 31 <= twmax);
    qkt<4>(a0, a1, kb0, qr);
    if (live2) qkt<4>(b0, b1, kb0 + SLOT, qr); else { b0 = f32x16{}; b1 = f32x16{}; }
    float rm = NEG_INF;
#define CMP_QUARTER(P, QTR, LIVE) do { if (LIVE) { \
      if (!(16 * (32 * (QTR) + 31) + 31 + 112 < twmin)) { \
        _Pragma("unroll") for (int r = 0; r < 16; ++r) { int d_ = t - 16 * (32 * (QTR) + crow(r, hi)) - 31; d_ = d_ < -64 ? -64 : (d_ > 255 ? 255 : d_); P[r] += tb[d_]; } } \
      _Pragma("unroll") for (int r = 0; r < 16; ++r) rm = fmaxf(rm, P[r]); } } while (0)
    CMP_QUARTER(a0, 0, live0); CMP_QUARTER(a1, 1, live1); CMP_QUARTER(b0, 2, live2); CMP_QUARTER(b1, 3, live3);
#undef CMP_QUARTER
    rm = xmax(rm);
    const float mref = (rm == NEG_INF) ? 0.f : rm;
    float s = 0.f;
#define CMP_EXP(P, LIVE) do { if (LIVE) { _Pragma("unroll") for (int r = 0; r < 16; ++r) { P[r] = ex2(P[r] - mref); s += P[r]; } } else { _Pragma("unroll") for (int r = 0; r < 16; ++r) P[r] = 0.f; } } while (0)
    CMP_EXP(a0, live0); CMP_EXP(a1, live1); CMP_EXP(b0, live2); CMP_EXP(b1, live3);
#undef CMP_EXP
    s = xsum(s);
    const float inv = (s > 0.f) ? 1.0f / s : 0.f;
#pragma unroll
    for (int r = 0; r < 16; ++r) { a0[r] *= inv; a1[r] *= inv; b0[r] *= inv; b1[r] *= inv; }
    { LAS3 float* iq = impq + (rh * 64 + tokl) * 33; LAS3 float* il = impl + (rh * 64 + tokl) * 33;
#pragma unroll
      for (int q4 = 0; q4 < 4; ++q4) {
        const int gi = 2 * q4 + hi;
        iq[gi] = (a0[4 * q4] + a0[4 * q4 + 1]) + (a0[4 * q4 + 2] + a0[4 * q4 + 3]);           il[gi] = a0[4 * q4 + 3];
        iq[8 + gi] = (a1[4 * q4] + a1[4 * q4 + 1]) + (a1[4 * q4 + 2] + a1[4 * q4 + 3]);       il[8 + gi] = a1[4 * q4 + 3];
        iq[16 + gi] = (b0[4 * q4] + b0[4 * q4 + 1]) + (b0[4 * q4 + 2] + b0[4 * q4 + 3]);      il[16 + gi] = b0[4 * q4 + 3];
        iq[24 + gi] = (b1[4 * q4] + b1[4 * q4 + 1]) + (b1[4 * q4 + 2] + b1[4 * q4 + 3]);      il[24 + gi] = b1[4 * q4 + 3];
      } }
    o[0] = f32x16{}; o[1] = f32x16{};
#pragma unroll
    for (int i = 0; i < 8; ++i) { pw[i] = cvtpk(a0[2 * i], a0[2 * i + 1]); pw[8 + i] = cvtpk(a1[2 * i], a1[2 * i + 1]); }
    pv(o, vp0, pw);
    if (live2) {
#pragma unroll
      for (int i = 0; i < 8; ++i) { pw[i] = cvtpk(b0[2 * i], b0[2 * i + 1]); pw[8 + i] = cvtpk(b1[2 * i], b1[2 * i + 1]); }
      pv(o, vp0 + SLOT, pw); }
    if (hi == 0) wsf[r32] = gate[0];
#pragma unroll
    for (int r = 0; r < 16; ++r) { const float f = wsf[crow(r, hi)]; o[0][r] *= f; o[1][r] *= f; }
  }
  __syncthreads();
  const KVSrc ssrc{proj + (size_t)b * SEQ * PROJ_LD + PC_KV + 2 * 128 + g * 64, proj + (size_t)b * SEQ * PROJ_LD + PC_KV + 3 * 128 + g * 64, PROJ_LD, PROJ_LD};
  kv_issue(ssrc, 0, rk, rv, tid);
  {
    const int stok = tid >> 3, sub = tid & 7;
#pragma unroll
    for (int k = 0; k < 4; ++k) {
      const int n = sub * 4 + k;
      float imp = 0.f;
#pragma unroll
      for (int hh = 0; hh < 4; ++hh) imp += impq[(hh * 64 + stok) * 33 + n] + ((n > 0) ? impl[(hh * 64 + stok) * 33 + n - 1] : 0.f);
      sc[stok * 33 + n] = (n > c) ? -1.0f : ((n == 0 || n == c || n == c - 1) ? 1e4f : imp);
    }
    if (tid < 64) selm[tid] = 0u;
    __syncthreads();
    float srow[32];
#pragma unroll
    for (int mm = 0; mm < 32; ++mm) srow[mm] = sc[stok * 33 + mm];
    unsigned bits = 0u;
#pragma unroll
    for (int k = 0; k < 4; ++k) {
      const int n = sub * 4 + k; const float sv = sc[stok * 33 + n]; int rank = 0;
#pragma unroll
      for (int mm = 0; mm < 32; ++mm) rank += (srow[mm] > sv || (srow[mm] == sv && mm < n)) ? 1 : 0;
      if (rank < 16) bits |= 1u << n;
    }
    if (bits) atomicOr((unsigned*)(selm + stok), bits);
    __syncthreads();
  }
  const unsigned mysel = selm[tokl];
  fin_set(finl, o, lane);
#pragma unroll 1
  for (int br = 0; br < 2; ++br) {
    const KVSrc src = (br == 0) ? ssrc : KVSrc{proj + (size_t)b * SEQ * PROJ_LD + PC_KV + 4 * 128 + g * 64, proj + (size_t)b * SEQ * PROJ_LD + PC_KV + 5 * 128 + g * 64, PROJ_LD, PROJ_LD};
    const int n0 = (br == 0) ? 0 : ((c > 8) ? c - 8 : 0);
    if (br == 1) { __syncthreads(); kv_issue(src, n0 * 64, rk, rv, tid); }
    kv_commit(lds, rk, rv, tid);
    float m = -1e30f, l = 0.f;
    o[0] = f32x16{}; o[1] = f32x16{};
    int cur = 0;
#pragma unroll 1
    for (int n = n0; n <= c; ++n) {
      __syncthreads();
      if (n < c) kv_issue(src, (n + 1) * 64, rk, rv, tid);
      const bool mine = (br == 1) || ((mysel >> n) & 1u);
      if (__any(mine)) {
        f32x16 p0, p1;
        if (n + 2 >= c) {
          const LAS3 float* bp = tb + (t - 64 * n) - 4 * hi - 63;
          f32x16 c0, c1;
#pragma unroll
          for (int r = 0; r < 16; ++r) { c0[r] = bp[63 - ((r & 3) + 8 * (r >> 2))]; c1[r] = bp[31 - ((r & 3) + 8 * (r >> 2))]; }
          qkt_init<4>(p0, p1, kb0 + cur * SLOT, qr, c0, c1);
        } else if (br == 1 && n + 8 == c) {
          const LAS3 float* bp = stp + (607 - (t - 64 * n)) + 4 * hi;
          f32x16 c0, c1;
#pragma unroll
          for (int r = 0; r < 16; ++r) { c0[r] = bp[(r & 3) + 8 * (r >> 2)]; c1[r] = bp[32 + (r & 3) + 8 * (r >> 2)]; }
          qkt_init<4>(p0, p1, kb0 + cur * SLOT, qr, c0, c1);
        } else qkt<4>(p0, p1, kb0 + cur * SLOT, qr);
        if (!mine) {
#pragma unroll
          for (int r = 0; r < 16; ++r) { p0[r] = NEG_INF; p1[r] = NEG_INF; } }
        softmax_step(p0, p1, m, l, o, wsf, r32, hi, pw);
        pv(o, vp0 + cur * SLOT, pw);
      }
      if (n < c) kv_commit(lds + (cur ^ 1) * SLOT, rk, rv, tid);
      cur ^= 1;
    }
    l = xsum(l);
    const float gi = gate[1 + br] / fmaxf(l, 1e-30f);
    if (hi == 0) wsf[r32] = gi;
    fin_add(finl, o, wsf, lane, hi);
  }
  fin_store(finl, onsa, (size_t)b * SEQ + 64 * c + 32 * (w & 1), 1024, head * 64, lane);
}

__device__ __forceinline__ void mla_unit(int b, int h, int qb, const bf16_t* __restrict__ mq, const bf16_t* __restrict__ mkv, const bf16_t* __restrict__ kr, bf16_t* __restrict__ omla, lptr lds) {
  int tid = threadIdx.x; asm volatile("" : "+v"(tid));
  const int lane = tid & 63, r32 = lane & 31, hi = lane >> 5;
  const int w = __builtin_amdgcn_readfirstlane(tid >> 6);
  const int q0 = 256 * qb, qw = q0 + 32 * w, qpos = qw + r32;
  const size_t tokq = (size_t)b * SEQ + qpos;
  LAS3 float* wsf = (LAS3 float*)(lds + L_WSF) + w * 64;
  const lcptr kb0 = (lcptr)lds + KOFF + hi * 1024 + r32 * 16;
  const lcptr vp0 = (lcptr)lds + VOFF + ((lane >> 4) & 1) * 32 + (lane & 3) * 8 + (4 * hi + ((lane & 15) >> 2)) * 64;
  const LAS3 float* stp = (const LAS3 float*)(lds + L_ST);
  bf16x8 qr[6];
#pragma unroll
  for (int d0 = 0; d0 < 6; ++d0) qr[d0] = *(const bf16x8*)(mq + tokq * 768 + h * 96 + d0 * 16 + hi * 8);
  const KVSrc src{mkv + (size_t)b * SEQ * 1024 + h * 128, mkv + (size_t)b * SEQ * 1024 + h * 128 + 64, 1024, 1024};
  const bf16_t* krb = kr + (size_t)b * SEQ * 32;
  const int NTL = 4 * (qb + 1);
  u32x4 rk, rv, rr = {0u, 0u, 0u, 0u};
  f32x16 o[2]; o[0] = f32x16{}; o[1] = f32x16{};
  unsigned pw[16];
  float m = -1e30f, l = 0.f;
  __syncthreads();
  kv_issue(src, 0, rk, rv, tid);
  if (tid < 256) rr = *(const u32x4*)(krb + (size_t)(tid & 63) * 32 + (tid >> 6) * 8);
  kv_commit(lds, rk, rv, tid);
  if (tid < 256) *(LAS3 u32x4*)(lds + KOFF + (8 + (tid >> 6)) * 1024 + (tid & 63) * 16) = rr;
  int cur = 0;
#pragma unroll 1
  for (int tl = 0; tl < NTL; ++tl) {
    __syncthreads();
    if (tl + 1 < NTL) { kv_issue(src, (tl + 1) * 64, rk, rv, tid); if (tid < 256) rr = *(const u32x4*)(krb + (size_t)((tl + 1) * 64 + (tid & 63)) * 32 + (tid >> 6) * 8); }
    if (64 * tl <= qw + 31) {
      f32x16 p0, p1;
      if (64 * tl + 63 > qw) {
        const LAS3 float* bp = stp + 96 + (qpos - 64 * tl) - 4 * hi - 63;
        f32x16 c0, c1;
#pragma unroll
        for (int r = 0; r < 16; ++r) { c0[r] = bp[63 - ((r & 3) + 8 * (r >> 2))]; c1[r] = bp[31 - ((r & 3) + 8 * (r >> 2))]; }
        qkt_init<6>(p0, p1, kb0 + cur * SLOT, qr, c0, c1);
      } else qkt<6>(p0, p1, kb0 + cur * SLOT, qr);
      softmax_step(p0, p1, m, l, o, wsf, r32, hi, pw);
      pv(o, vp0 + cur * SLOT, pw);
    }
    if (tl + 1 < NTL) { kv_commit(lds + (cur ^ 1) * SLOT, rk, rv, tid); if (tid < 256) *(LAS3 u32x4*)(lds + (cur ^ 1) * SLOT + KOFF + (8 + (tid >> 6)) * 1024 + (tid & 63) * 16) = rr; }
    cur ^= 1;
  }
  l = xsum(l);
  if (hi == 0) wsf[r32] = 1.0f / fmaxf(l, 1e-30f);
#pragma unroll
  for (int r = 0; r < 16; ++r) { const float f = wsf[crow(r, hi)]; o[0][r] *= f; o[1][r] *= f; }
  LAS3 float* finl = (LAS3 float*)(lds + L_FIN) + w * 2048;
  fin_set(finl, o, lane);
  fin_store(finl, omla, (size_t)b * SEQ + qw, 1024, 512 + h * 64, lane);
}

__device__ __forceinline__ void attn_phase(const bf16_t* proj, const bf16_t* kc, const bf16_t* vc, const float* t5, bf16_t* onsa,
                                           const bf16_t* mq, const bf16_t* mkv, const bf16_t* kr, bf16_t* omla, lptr lds) {
  const int tid = threadIdx.x;
  { LAS3 float* tb = (LAS3 float*)(lds + L_TB);
    for (int i = tid; i < 8 * 320; i += NTHR) { const int hd = i / 320, d = i % 320 - 64; tb[i] = (d < 0) ? NEG_INF : ((d < 113) ? (t5[(int)T5B[d] * 8 + hd] - t5[31 * 8 + hd]) * LOG2E : 0.f); }
    LAS3 float* st = (LAS3 float*)(lds + L_ST);
    for (int i = tid; i < 192; i += NTHR) st[i] = (i < 96) ? NEG_INF : 0.f; }
  const int G = gridDim.x, bx = blockIdx.x;
  for (int v = (G % 8 == 0) ? (bx % 8) * (G / 8) + bx / 8 : bx; v < 256; v += G) {
    const int bg = v >> 4, p = v & 15, bh = v >> 2, j = v & 3;
#pragma unroll 1
    for (int u = 0; u < 2; ++u) nsa_unit(bg >> 1, bg & 1, u ? p : 31 - p, proj, kc, vc, onsa, lds);
#pragma unroll 1
    for (int u = 0; u < 2; ++u) mla_unit(bh >> 3, bh & 7, u ? j : 7 - j, mq, mkv, kr, omla, lds);
  }
}
#undef LAS3
}


namespace peer {
using bf16x8 = __attribute__((ext_vector_type(8))) short;
using f32x16 = __attribute__((ext_vector_type(16))) float;
typedef unsigned u32x4 __attribute__((ext_vector_type(4)));
typedef float f32x4_t __attribute__((ext_vector_type(4)));
typedef __bf16 bf16x2_t __attribute__((ext_vector_type(2)));
typedef float f32x2_t __attribute__((ext_vector_type(2)));
#define LAS3 __attribute__((address_space(3)))
__device__ __forceinline__ int crow(int r, int hi) { return (r & 3) + 8 * (r >> 2) + 4 * hi; }
__device__ __forceinline__ unsigned enc(float f) { const unsigned u = __float_as_uint(f); return u ^ ((unsigned)((int)u >> 31) | 0x80000000u); }
__device__ __forceinline__ float dec(unsigned k) { return __uint_as_float(k ^ (~(unsigned)((int)k >> 31) | 0x80000000u)); }
__device__ __forceinline__ unsigned umax(unsigned a, unsigned b) { return a > b ? a : b; }
__device__ __forceinline__ unsigned umin(unsigned a, unsigned b) { return a < b ? a : b; }
__device__ __forceinline__ unsigned cvtpk(float lo, float hi) { f32x2_t v = {lo, hi}; bf16x2_t b = __builtin_convertvector(v, bf16x2_t); return __builtin_bit_cast(unsigned, b); }
template <int B, int N> __device__ __forceinline__ void sort16(unsigned (&k)[N]) {
#pragma unroll
  for (int size = 2; size <= 16; size <<= 1)
#pragma unroll
    for (int stride = size >> 1; stride > 0; stride >>= 1)
#pragma unroll
      for (int i = 0; i < 16; ++i) { const int l = i ^ stride;
        if (l > i) { const bool desc = ((i & size) == 0); const unsigned a = k[B + i], b = k[B + l]; const unsigned mx = umax(a, b), mn = umin(a, b); k[B + i] = desc ? mx : mn; k[B + l] = desc ? mn : mx; } }
}
template <int A, int Bo, int N> __device__ __forceinline__ void merge16(unsigned (&k)[N]) {
#pragma unroll
  for (int i = 0; i < 16; ++i) k[A + i] = umax(k[A + i], k[Bo + 15 - i]);
#pragma unroll
  for (int stride = 8; stride > 0; stride >>= 1)
#pragma unroll
    for (int i = 0; i < 16; ++i) { const int l = i ^ stride; if (l > i) { const unsigned a = k[A + i], b = k[A + l]; k[A + i] = umax(a, b); k[A + l] = umin(a, b); } }
}
template <int N> __device__ __forceinline__ void top16_of_64(unsigned (&k)[N]) {
  sort16<0>(k); sort16<16>(k); sort16<32>(k); sort16<48>(k);
  merge16<0, 16>(k); merge16<32, 48>(k); merge16<0, 32>(k);
}

__device__ __forceinline__ void route_phase(const bf16_t* __restrict__ pq, const bf16_t* __restrict__ subk, unsigned* __restrict__ pack, LAS3 char* lds) {
  const int tid = threadIdx.x, lane = tid & 63, r32 = lane & 31, hi = lane >> 5, wv = tid >> 6;
  const int gw = blockIdx.x * NWV + wv, nw = gridDim.x * NWV;
  LAS3 unsigned char* myb = (LAS3 unsigned char*)lds + wv * 2560 + lane * 40;
#pragma unroll 1
  for (int item = gw; item < (T / 32) * 8; item += nw) {
    const int h = item & 7, t0 = (item >> 3) * 32;
    unsigned la[16], lb[16];
#pragma unroll
    for (int i = 0; i < 16; ++i) { la[i] = 0u; lb[i] = 0u; }
#pragma unroll 1
    for (int p = 0; p < 2; ++p) {
      f32x16 acc[4];
#pragma unroll
      for (int kt = 0; kt < 4; ++kt) acc[kt] = f32x16{};
#pragma unroll
      for (int kd = 0; kd < 4; ++kd) {
        const bf16x8 bq = *(const bf16x8*)(pq + (size_t)(t0 + r32) * 1024 + h * 128 + p * 64 + kd * 16 + hi * 8);
#pragma unroll
        for (int kt = 0; kt < 4; ++kt) {
          const bf16x8 ak = *(const bf16x8*)(subk + (size_t)((h * 2 + p) * 128 + kt * 32 + r32) * 64 + kd * 16 + hi * 8);
          acc[kt] = __builtin_amdgcn_mfma_f32_32x32x16_bf16(ak, bq, acc[kt], 0, 0, 0);
        }
      }
      unsigned k[64];
#pragma unroll
      for (int kt = 0; kt < 4; ++kt)
#pragma unroll
        for (int r = 0; r < 16; ++r) k[kt * 16 + r] = (enc(acc[kt][r]) & 0xFFFFFF80u) | (unsigned)(127 - (32 * kt + crow(r, hi)));
      top16_of_64(k);
#pragma unroll
      for (int i = 0; i < 16; ++i) { auto rr = __builtin_amdgcn_permlane32_swap(k[i], k[i], false, false); unsigned r0 = rr[0], r1 = rr[1]; asm volatile("" : "+v"(r0), "+v"(r1)); k[16 + i] = hi ? r0 : r1; }
      merge16<0, 16>(k);
#pragma unroll
      for (int i = 0; i < 16; ++i) { la[i] = (p == 0) ? k[i] : la[i]; lb[i] = (p == 0) ? lb[i] : k[i]; }
      __builtin_amdgcn_sched_barrier(0);
    }
#pragma unroll
    for (int i = 0; i < 4; ++i) {
      const unsigned wa = (127u - (la[4 * i] & 127u)) | ((127u - (la[4 * i + 1] & 127u)) << 8) | ((127u - (la[4 * i + 2] & 127u)) << 16) | ((127u - (la[4 * i + 3] & 127u)) << 24);
      const unsigned wb = (127u - (lb[4 * i] & 127u)) | ((127u - (lb[4 * i + 1] & 127u)) << 8) | ((127u - (lb[4 * i + 2] & 127u)) << 16) | ((127u - (lb[4 * i + 3] & 127u)) << 24);
      *(LAS3 unsigned*)(myb + 4 * i) = wa; *(LAS3 unsigned*)(myb + 16 + 4 * i) = wb;
    }
    float va[16], vb[16];
#pragma unroll
    for (int i = 0; i < 16; ++i) { va[i] = dec(la[i] & 0xFFFFFF80u); vb[i] = dec(lb[i] & 0xFFFFFF80u); }
    unsigned k[64];
#define PEER_CAND(n, i, j) k[n] = (enc(va[i] + vb[j]) & 0xFFFFFF00u) | (unsigned)(255 - ((i) * 16 + (j)))
    PEER_CAND(0, 0, 0); PEER_CAND(1, 0, 1); PEER_CAND(2, 0, 2); PEER_CAND(3, 0, 3); PEER_CAND(4, 0, 4); PEER_CAND(5, 0, 5);
    PEER_CAND(6, 0, 6); PEER_CAND(7, 0, 7); PEER_CAND(8, 0, 8); PEER_CAND(9, 0, 9); PEER_CAND(10, 0, 10); PEER_CAND(11, 0, 11);
    PEER_CAND(12, 0, 12); PEER_CAND(13, 0, 13); PEER_CAND(14, 0, 14); PEER_CAND(15, 0, 15); PEER_CAND(16, 1, 0); PEER_CAND(17, 1, 1);
    PEER_CAND(18, 1, 2); PEER_CAND(19, 1, 3); PEER_CAND(20, 1, 4); PEER_CAND(21, 1, 5); PEER_CAND(22, 1, 6); PEER_CAND(23, 1, 7);
    PEER_CAND(24, 2, 0); PEER_CAND(25, 2, 1); PEER_CAND(26, 2, 2); PEER_CAND(27, 2, 3); PEER_CAND(28, 2, 4); PEER_CAND(29, 3, 0);
    PEER_CAND(30, 3, 1); PEER_CAND(31, 3, 2); PEER_CAND(32, 3, 3); PEER_CAND(33, 4, 0); PEER_CAND(34, 4, 1); PEER_CAND(35, 4, 2);
    PEER_CAND(36, 5, 0); PEER_CAND(37, 5, 1); PEER_CAND(38, 6, 0); PEER_CAND(39, 6, 1); PEER_CAND(40, 7, 0); PEER_CAND(41, 7, 1);
    PEER_CAND(42, 8, 0); PEER_CAND(43, 9, 0); PEER_CAND(44, 10, 0); PEER_CAND(45, 11, 0); PEER_CAND(46, 12, 0); PEER_CAND(47, 13, 0);
    PEER_CAND(48, 14, 0); PEER_CAND(49, 15, 0);
#undef PEER_CAND
#pragma unroll
    for (int z = 50; z < 64; ++z) k[z] = 0u;
    top16_of_64(k);
    const float best0 = dec(k[0] & 0xFFFFFF00u);
    float ev[16]; float den = 0.f;
#pragma unroll
    for (int i = 0; i < 16; ++i) { ev[i] = __expf(dec(k[i] & 0xFFFFFF00u) - best0); den += ev[i]; }
    const float inv = 1.0f / den;
    unsigned outw[8];
#pragma unroll
    for (int i = 0; i < 8; ++i) {
      unsigned k_lo = k[i], k_hi = k[8 + i]; float e_lo = ev[i], e_hi = ev[8 + i];
      asm volatile("" : "+v"(k_lo), "+v"(k_hi), "+v"(e_lo), "+v"(e_hi));
      const unsigned kk = hi ? k_hi : k_lo; const float e = hi ? e_hi : e_lo;
      const unsigned f = 255u - (kk & 255u);
      const unsigned ia = myb[f >> 4], ib = myb[16 + (f & 15u)];
      outw[i] = (ia * 128u + ib) | (cvtpk(0.f, e * inv) & 0xFFFF0000u);
    }
    unsigned* dst = pack + (size_t)(t0 + r32) * 128 + h * 16 + hi * 8;
    *(u32x4*)dst = (u32x4){outw[0], outw[1], outw[2], outw[3]};
    *(u32x4*)(dst + 4) = (u32x4){outw[4], outw[5], outw[6], outw[7]};
  }
}

__device__ __forceinline__ void conv_tables(const float* __restrict__ u, const float* __restrict__ v, unsigned* __restrict__ u8, float* __restrict__ su, unsigned* __restrict__ v8) {
  const int tid = threadIdx.x, lane = tid & 63, wv = tid >> 6;
  const int gw = blockIdx.x * NWV + wv, nw = gridDim.x * NWV;
  for (int e = gw; e < 16384; e += nw) {
    const f32x4_t* ur = (const f32x4_t*)(u + (size_t)e * 1024) + lane * 4;
    f32x4_t a[4]; float mx = 0.f;
#pragma unroll
    for (int i = 0; i < 4; ++i) { a[i] = ur[i]; mx = fmaxf(mx, fmaxf(fmaxf(fabsf(a[i][0]), fabsf(a[i][1])), fmaxf(fabsf(a[i][2]), fabsf(a[i][3])))); }
    mx = wmaxf(mx);
    const float sc = fmaxf(mx, 1e-30f) * (1.0f / 127.0f), isc = 1.0f / sc;
    u32x4 o;
#pragma unroll
    for (int i = 0; i < 4; ++i) {
      const int q0 = (int)rintf(a[i][0] * isc), q1 = (int)rintf(a[i][1] * isc), q2 = (int)rintf(a[i][2] * isc), q3 = (int)rintf(a[i][3] * isc);
      o[i] = (unsigned)(q0 & 255) | ((unsigned)(q1 & 255) << 8) | ((unsigned)(q2 & 255) << 16) | ((unsigned)(q3 & 255) << 24);
    }
    *(u32x4*)(u8 + (size_t)e * 256 + lane * 4) = o;
    if (lane == 0) su[e] = sc;
    const f32x4_t* vr = (const f32x4_t*)(v + (size_t)e * 1024) + lane * 4;
    u32x4 ov;
#pragma unroll
    for (int i = 0; i < 4; ++i) { const f32x4_t b = vr[i]; unsigned w = 0u; w = __builtin_amdgcn_cvt_pk_fp8_f32(2.0f * b[0], 2.0f * b[1], w, false); w = __builtin_amdgcn_cvt_pk_fp8_f32(2.0f * b[2], 2.0f * b[3], w, true); ov[i] = w; }
    *(u32x4*)(v8 + ((size_t)(lane >> 3) * 16384 + e) * 32 + (lane & 7) * 4) = ov;
  }
}
__device__ __forceinline__ float gelu_fast(float v) {
  const float av = __builtin_fabsf(v), t = __builtin_amdgcn_rcpf(av * 0.2316418882f + 1.0f);
  float q = t * 0.5307027145f + (-0.7265760135f); q = q * t + 0.7107068705f; q = q * t + (-0.142248368f); q = q * t + 0.127414796f; q = q * t;
  const float e = __builtin_amdgcn_exp2f((v * v) * (-0.72134752044f));
  const float m = v * (q * e);
  return v < 0.f ? m : v - m;
}
__device__ __forceinline__ unsigned xcc_id() { return (unsigned)__builtin_amdgcn_s_getreg((3 << 11) | 20) & 7u; }
struct ABuf { unsigned w, meta; u32x4 ub[8]; float sue; };
__device__ __forceinline__ void expA_issue(ABuf& B, int k0, int n, const LAS3 unsigned* list, const unsigned* __restrict__ u8, const float* __restrict__ su, int j8) {
  const int k = (k0 < n) ? k0 : 0;
  B.w = list[2 * k]; B.meta = list[2 * k + 1];
  const unsigned e = B.w & 0xFFFFu;
  const unsigned* urow = u8 + (size_t)e * 256 + j8 * 4;
#pragma unroll
  for (int seg = 0; seg < 8; ++seg) B.ub[seg] = *(const u32x4*)(urow + seg * 32);
  B.sue = su[e];
}
__device__ __forceinline__ void expA_consume(const ABuf& B, int k0, int n, const LAS3 char* hl, const LAS3 float* shl, float* __restrict__ co, int t0, int j8) {
  const int tokl = (int)(B.meta >> 8), slot = (int)(B.meta & 255u);
  const LAS3 char* hrow = hl + tokl * 1024 + j8 * 16;
  int a0 = 0, a1 = 0, a2 = 0, a3 = 0;
#pragma unroll
  for (int seg = 0; seg < 8; ++seg) { const u32x4 hq = *(const LAS3 u32x4*)(hrow + seg * 128);
    a0 = __builtin_amdgcn_sdot4((int)B.ub[seg].x, (int)hq.x, a0, false); a1 = __builtin_amdgcn_sdot4((int)B.ub[seg].y, (int)hq.y, a1, false);
    a2 = __builtin_amdgcn_sdot4((int)B.ub[seg].z, (int)hq.z, a2, false); a3 = __builtin_amdgcn_sdot4((int)B.ub[seg].w, (int)hq.w, a3, false); }
  int acc = (a0 + a1) + (a2 + a3);
  acc += dpp_i<0xB1>(acc); acc += dpp_i<0x4E>(acc); acc += dpp_i<0x141>(acc);
  const float d = (float)acc * (B.sue * shl[tokl]);
  const float c = 0.5f * __uint_as_float(B.w & 0xFFFF0000u) * gelu_fast(d);
  if (j8 == 0 && k0 < n) co[(size_t)(t0 + tokl) * 128 + slot] = c;
}
struct AStage { u32x4 pw[4], hst[8]; float shv; };
__device__ __forceinline__ void expA_stage(AStage& S, int item, const unsigned* __restrict__ pack, const unsigned* __restrict__ hn8, const float* __restrict__ shp, int tid) {
  const int t0 = item * 64, tokl = tid >> 3, sb = (tid & 7) * 16;
#pragma unroll
  for (int i = 0; i < 4; ++i) S.pw[i] = *(const u32x4*)(pack + (size_t)(t0 + tokl) * 128 + sb + 4 * i);
#pragma unroll
  for (int i = 0; i < 8; ++i) S.hst[i] = *(const u32x4*)(hn8 + (size_t)t0 * 256 + (tid + 512 * i) * 4);
  S.shv = (tid < 64) ? shp[t0 + tid] : 0.f;
}
__device__ __forceinline__ void expA_item(AStage& S, int item, int nitem, int xs, const unsigned* __restrict__ pack, const unsigned* __restrict__ hn8, const float* __restrict__ shp, const unsigned* __restrict__ u8, const float* __restrict__ su,
                                          float* __restrict__ co, LAS3 char* lds, int tid) {
  const int lane = tid & 63, wv = tid >> 6;
  LAS3 char* hl = lds + 1024;
  LAS3 float* shl = (LAS3 float*)(lds + 1024 + 65536);
  LAS3 unsigned* cnt = (LAS3 unsigned*)(lds + 16);
  LAS3 unsigned* list = (LAS3 unsigned*)(lds + 1024 + 65536 + 256);
  const int t0 = item * 64;
  const int tokl = tid >> 3, sb = (tid & 7) * 16;
#pragma unroll
  for (int i = 0; i < 8; ++i) *(LAS3 u32x4*)(hl + (tid + 512 * i) * 16) = S.hst[i];
  if (tid < 64) shl[tid] = S.shv;
  {
    unsigned long long mk[16]; int tot = 0; int off[16];
#pragma unroll
    for (int j = 0; j < 16; ++j) { const unsigned w = S.pw[j >> 2][j & 3]; mk[j] = __ballot(((w & 0xFFFFu) >> 11) == (unsigned)xs); off[j] = tot; tot += __builtin_popcountll(mk[j]); }
    int base = 0;
    if (lane == 0) base = (int)__hip_atomic_fetch_add(cnt, (unsigned)tot, __ATOMIC_RELAXED, __HIP_MEMORY_SCOPE_WORKGROUP);
    base = __builtin_amdgcn_readfirstlane(base);
#pragma unroll
    for (int j = 0; j < 16; ++j) { const unsigned w = S.pw[j >> 2][j & 3];
      if (((w & 0xFFFFu) >> 11) == (unsigned)xs) { const int pos = base + off[j] + (int)__builtin_amdgcn_mbcnt_hi((unsigned)(mk[j] >> 32), __builtin_amdgcn_mbcnt_lo((unsigned)mk[j], 0u));
        list[2 * pos] = w; list[2 * pos + 1] = (unsigned)((tokl << 8) | (sb + j)); } }
  }
  if (nitem < T / 64) expA_stage(S, nitem, pack, hn8, shp, tid);
  __syncthreads();
  const int n = (int)cnt[0];
  const int j8 = lane & 7, gidx = wv * 8 + (lane >> 3);
  ABuf A, Bb;
  expA_issue(A, gidx, n, list, u8, su, j8);
#pragma unroll 1
  for (int k0 = gidx; k0 < n; k0 += 128) {
    expA_issue(Bb, k0 + 64, n, list, u8, su, j8);
    expA_consume(A, k0, n, hl, shl, co, t0, j8);
    expA_issue(A, k0 + 128, n, list, u8, su, j8);
    expA_consume(Bb, k0 + 64, n, hl, shl, co, t0, j8);
  }
}
struct BBuf { u32x4 vv[8]; f32x4_t c[2]; };
__device__ __forceinline__ void expB_issue(BBuf& B, const LAS3 unsigned* pkl, const LAS3 float* col, int sg8, const unsigned* __restrict__ vbase) {
  const u32x4 p0 = *(const LAS3 u32x4*)(pkl + sg8 * 8), p1 = *(const LAS3 u32x4*)(pkl + sg8 * 8 + 4);
  B.c[0] = *(const LAS3 f32x4_t*)(col + sg8 * 8); B.c[1] = *(const LAS3 f32x4_t*)(col + sg8 * 8 + 4);
#pragma unroll
  for (int j = 0; j < 4; ++j) { B.vv[j] = *(const u32x4*)(vbase + (size_t)(p0[j] & 0xFFFFu) * 32); B.vv[4 + j] = *(const u32x4*)(vbase + (size_t)(p1[j] & 0xFFFFu) * 32); }
}
__device__ __forceinline__ void expB_consume(const BBuf& B, f32x2_t (&y)[8]) {
#pragma unroll
  for (int j = 0; j < 8; ++j) {
    const float cv = B.c[j >> 2][j & 3];
    const f32x2_t c2 = {cv, cv};
#pragma unroll
    for (int w = 0; w < 4; ++w) {
      y[2 * w] = __builtin_elementwise_fma(__builtin_amdgcn_cvt_pk_f32_fp8(B.vv[j][w], false), c2, y[2 * w]);
      y[2 * w + 1] = __builtin_elementwise_fma(__builtin_amdgcn_cvt_pk_f32_fp8(B.vv[j][w], true), c2, y[2 * w + 1]);
    }
  }
}
__device__ __forceinline__ void expB_item(int item, int xs, const unsigned* __restrict__ pack, const float* __restrict__ co, const unsigned* __restrict__ v8, bf16_t* __restrict__ zb, float* __restrict__ ssq, LAS3 char* lds, int tid,
                                          const float* __restrict__ xin, const bf16_t* __restrict__ ob) {
  const int lane = tid & 63, wv = tid >> 6, r8 = lane >> 3, c8 = lane & 7;
  const int t0 = item * 64 + wv * 8;
  LAS3 unsigned* pkw = (LAS3 unsigned*)(lds + 1024 + wv * 8192);
  LAS3 float* cow = (LAS3 float*)(lds + 1024 + wv * 8192 + 4096);
  {
    u32x4 a[4]; f32x4_t b[4];
#pragma unroll
    for (int i = 0; i < 4; ++i) { a[i] = *(const u32x4*)(pack + (size_t)t0 * 128 + (lane + 64 * i) * 4); b[i] = *(const f32x4_t*)(co + (size_t)t0 * 128 + (lane + 64 * i) * 4); }
#pragma unroll
    for (int i = 0; i < 4; ++i) { *(LAS3 u32x4*)(pkw + (lane + 64 * i) * 4) = a[i]; *(LAS3 f32x4_t*)(cow + (lane + 64 * i) * 4) = b[i]; }
  }
  const size_t hoff = (size_t)(t0 + r8) * 1024 + xs * 128 + c8 * 16;
  f32x4_t h[4];
  { const u32x4 o0 = *(const u32x4*)(ob + hoff), o1 = *(const u32x4*)(ob + hoff + 8);
#pragma unroll
    for (int w = 0; w < 4; ++w) h[w] = *(const f32x4_t*)(xin + hoff + 4 * w);
    h[0] += (f32x4_t){__uint_as_float(o0.x << 16), __uint_as_float(o0.x & 0xffff0000u), __uint_as_float(o0.y << 16), __uint_as_float(o0.y & 0xffff0000u)};
    h[1] += (f32x4_t){__uint_as_float(o0.z << 16), __uint_as_float(o0.z & 0xffff0000u), __uint_as_float(o0.w << 16), __uint_as_float(o0.w & 0xffff0000u)};
    h[2] += (f32x4_t){__uint_as_float(o1.x << 16), __uint_as_float(o1.x & 0xffff0000u), __uint_as_float(o1.y << 16), __uint_as_float(o1.y & 0xffff0000u)};
    h[3] += (f32x4_t){__uint_as_float(o1.z << 16), __uint_as_float(o1.z & 0xffff0000u), __uint_as_float(o1.w << 16), __uint_as_float(o1.w & 0xffff0000u)}; }
  wave_lds_sync();
  const LAS3 unsigned* pkl = pkw + r8 * 128; const LAS3 float* col = cow + r8 * 128;
  const unsigned* vbase = v8 + (size_t)xs * 16384 * 32 + c8 * 4;
  f32x2_t y[8];
#pragma unroll
  for (int i = 0; i < 8; ++i) y[i] = (f32x2_t){0.f, 0.f};
  BBuf A, Bb;
  expB_issue(A, pkl, col, 0, vbase);
#pragma unroll 1
  for (int sg = 0; sg < 16; sg += 2) {
    expB_issue(Bb, pkl, col, sg + 1, vbase);
    expB_consume(A, y);
    if (sg + 2 < 16) expB_issue(A, pkl, col, sg + 2, vbase);
    expB_consume(Bb, y);
  }
  float ss = 0.f; unsigned zw[8];
#pragma unroll
  for (int w = 0; w < 4; ++w) {
    const f32x4_t z = {h[w][0] + y[2 * w][0], h[w][1] + y[2 * w][1], h[w][2] + y[2 * w + 1][0], h[w][3] + y[2 * w + 1][1]};
    zw[2 * w] = cvtpk(z[0], z[1]); zw[2 * w + 1] = cvtpk(z[2], z[3]);
    ss += (z[0] * z[0] + z[1] * z[1]) + (z[2] * z[2] + z[3] * z[3]);
  }
  *(u32x4*)(zb + hoff) = (u32x4){zw[0], zw[1], zw[2], zw[3]}; *(u32x4*)(zb + hoff + 8) = (u32x4){zw[4], zw[5], zw[6], zw[7]};
  ss += dpp_f<0xB1>(ss); ss += dpp_f<0x4E>(ss); ss += dpp_f<0x141>(ss);
  if (c8 == 0) ssq[(size_t)xs * T + t0 + r8] = ss;
  wave_lds_sync();
}
template <int PASS> __device__ __forceinline__ void experts_sliced(const unsigned* __restrict__ pack, const unsigned* __restrict__ hn8, const float* __restrict__ shp, const unsigned* __restrict__ u8, const float* __restrict__ su,
                                                                    float* __restrict__ co, const unsigned* __restrict__ v8, float* __restrict__ out, float* __restrict__ ssq, unsigned* __restrict__ ctr, LAS3 char* lds,
                                                                    const float* __restrict__ xin = nullptr, const bf16_t* __restrict__ ob = nullptr) {
  int tid = threadIdx.x; asm volatile("" : "+v"(tid));
  LAS3 volatile int* lw = (LAS3 volatile int*)lds;
  const int xme = (int)xcc_id();
#pragma unroll 1
  for (int s8 = 0; s8 < 8; ++s8) {
    const int xs = (xme + s8) & 7;
    if (PASS == 0) {
      int nxt = 0;
      if (tid == 0) nxt = (int)atomicAdd(ctr + 64 * xs, 1u);
      __syncthreads();
      if (tid == 0) lw[0] = nxt;
      __syncthreads();
      int item = lw[0];
      if (item >= T / 64) continue;
      if (tid == 0) nxt = (int)atomicAdd(ctr + 64 * xs, 1u);
      AStage SA;
      expA_stage(SA, item, pack, hn8, shp, tid);
#pragma unroll 1
      for (;;) {
        __syncthreads();
        if (tid == 0) { lw[0] = nxt; lw[4] = 0; }
        __syncthreads();
        const int nitem = lw[0];
        if (tid == 0) nxt = (int)atomicAdd(ctr + 64 * xs, 1u);
        expA_item(SA, item, nitem, xs, pack, hn8, shp, u8, su, co, lds, tid);
        if (nitem >= T / 64) break;
        item = nitem;
      }
    } else {
      int nxt = 0;
      if (tid == 0) nxt = (int)atomicAdd(ctr + 64 * xs, 1u);
#pragma unroll 1
      for (;;) {
        __syncthreads();
        if (tid == 0) lw[0] = nxt;
        __syncthreads();
        const int item = lw[0];
        if (item >= T / 64) break;
        if (tid == 0) nxt = (int)atomicAdd(ctr + 64 * xs, 1u);
        expB_item(item, xs, pack, co, v8, (bf16_t*)out, ssq, lds, tid, xin, ob);
      }
    }
  }
}
__device__ __forceinline__ void experts_norm(const float* __restrict__ ssq, const float* __restrict__ gfin, const bf16_t* __restrict__ zb, float* __restrict__ out) {
  const int tid = threadIdx.x, lane = tid & 63, wv = tid >> 6;
  const int gw = blockIdx.x * NWV + wv, nw = gridDim.x * NWV;
  for (int t = gw; t < T; t += nw) {
    float ss = 0.f;
#pragma unroll
    for (int x = 0; x < 8; ++x) ss += ssq[(size_t)x * T + t];
    const float inv = rsqrtf(ss * (1.0f / 1024.0f) + 1e-6f);
    float* op = out + (size_t)t * 1024 + lane * 16; const float* gp = gfin + lane * 16;
    const u32x4 z0 = *(const u32x4*)(zb + (size_t)t * 1024 + lane * 16), z1 = *(const u32x4*)(zb + (size_t)t * 1024 + lane * 16 + 8);
    const unsigned zz[8] = {z0.x, z0.y, z0.z, z0.w, z1.x, z1.y, z1.z, z1.w};
#pragma unroll
    for (int i = 0; i < 4; ++i) { const f32x4_t z = {__uint_as_float(zz[2 * i] << 16), __uint_as_float(zz[2 * i] & 0xffff0000u), __uint_as_float(zz[2 * i + 1] << 16), __uint_as_float(zz[2 * i + 1] & 0xffff0000u)};
      const f32x4_t g = *(const f32x4_t*)(gp + 4 * i); *(f32x4_t*)(op + 4 * i) = z * inv * g; }
  }
}
#undef LAS3
}

namespace prep {
typedef unsigned u32x2_t __attribute__((ext_vector_type(2)));
typedef float f32x4_t __attribute__((ext_vector_type(4)));
typedef unsigned u32x4 __attribute__((ext_vector_type(4)));
using bf16x8 = __attribute__((ext_vector_type(8))) short;
using f32x16 = __attribute__((ext_vector_type(16))) float;
__device__ __forceinline__ unsigned pk2(float lo, float hi) { return (unsigned)f2bf(lo) | ((unsigned)f2bf(hi) << 16); }
__device__ __forceinline__ void latent_rows(const bf16_t* __restrict__ proj, const float* __restrict__ gq, const float* __restrict__ gkv, const float2* __restrict__ cs,
                                            bf16_t* __restrict__ cqn, bf16_t* __restrict__ ckvn, bf16_t* __restrict__ krope, int wave_id, int nwaves, int lane) {
  const f32x4_t g4 = *(const f32x4_t*)(gq + lane * 4);
  const float2 g2 = *(const float2*)(gkv + lane * 2);
  for (int r = wave_id; r < T; r += nwaves) {
    const bf16_t* row = proj + (size_t)r * PROJ_LD;
    const u32x2_t q = *(const u32x2_t*)(row + PC_CQ + lane * 4);
    const unsigned kv = *(const unsigned*)(row + PC_CKV + lane * 2);
    const unsigned short kr0 = row[PC_KR + (lane & 15)], kr1 = row[PC_KR + 16 + (lane & 15)];
    const float q0 = __uint_as_float(q.x << 16), q1 = __uint_as_float(q.x & 0xffff0000u), q2 = __uint_as_float(q.y << 16), q3 = __uint_as_float(q.y & 0xffff0000u);
    const float k0 = __uint_as_float(kv << 16), k1 = __uint_as_float(kv & 0xffff0000u);
    float sq = (q0 * q0 + q1 * q1) + (q2 * q2 + q3 * q3), sk = k0 * k0 + k1 * k1;
    sq = wsum(sq); sk = wsum(sk);
    const float iq = rsqrtf(sq * (1.0f / 256.0f) + 1e-6f), ik = rsqrtf(sk * (1.0f / 128.0f) + 1e-6f);
    u32x2_t oq; oq.x = pk2(q0 * iq * g4[0], q1 * iq * g4[1]); oq.y = pk2(q2 * iq * g4[2], q3 * iq * g4[3]);
    *(u32x2_t*)(cqn + (size_t)r * 256 + lane * 4) = oq;
    *(unsigned*)(ckvn + (size_t)r * 128 + lane * 2) = pk2(k0 * ik * g2.x, k1 * ik * g2.y);
    if (lane < 16) {
      const float2 c = cs[(r & (SEQ - 1)) * 16 + lane];
      const float x1 = bf2f(kr0), x2 = bf2f(kr1);
      krope[(size_t)r * 32 + lane] = f2bf(x1 * c.x - x2 * c.y); krope[(size_t)r * 32 + 16 + lane] = f2bf(x2 * c.x + x1 * c.y);
    }
  }
}
__device__ __forceinline__ void cmp_bias(const float* __restrict__ posk, const float* __restrict__ posv, const bf16_t* __restrict__ w1k, const bf16_t* __restrict__ w1v, float* __restrict__ cpos, int wave_id, int nwaves, int lane) {
  for (int o = wave_id; o < 512; o += nwaves) {
    const int tab = o >> 8, n = o & 255;
    const float* pos = tab ? posv : posk; const bf16_t* w = (tab ? w1v : w1k) + (size_t)n * 2048;
    float acc = 0.f;
#pragma unroll
    for (int i = 0; i < 4; ++i) { const int k = (i * 64 + lane) * 8;
      const u32x4 wv = *(const u32x4*)(w + k); const f32x4_t p0 = *(const f32x4_t*)(pos + k), p1 = *(const f32x4_t*)(pos + k + 4);
      acc += p0[0] * __uint_as_float(wv.x << 16) + p0[1] * __uint_as_float(wv.x & 0xffff0000u) + p0[2] * __uint_as_float(wv.y << 16) + p0[3] * __uint_as_float(wv.y & 0xffff0000u);
      acc += p1[0] * __uint_as_float(wv.z << 16) + p1[1] * __uint_as_float(wv.z & 0xffff0000u) + p1[2] * __uint_as_float(wv.w << 16) + p1[3] * __uint_as_float(wv.w & 0xffff0000u); }
    acc = wsum(acc);
    if (lane == 0) cpos[o] = acc;
  }
}
__device__ __forceinline__ void cmp_l2(const float* __restrict__ slab, const float* __restrict__ cpos, const bf16_t* __restrict__ w2t, bf16_t* __restrict__ outkc, int item, int lane) {
  const int r32 = lane & 31, hi = lane >> 5, m0 = item * 32;
  f32x16 acc0 = f32x16{}, acc1 = f32x16{};
  f32x4_t sa[2][8]; f32x4_t cp[2][2]; bf16x8 wb[2][2];
#define CMPL2_LOAD(buf, ks_) do { const int k_ = (ks_) * 16 + hi * 8; \
    cp[buf][0] = *(const f32x4_t*)(cpos + k_); cp[buf][1] = *(const f32x4_t*)(cpos + k_ + 4); \
    _Pragma("unroll") for (int sp = 0; sp < 4; ++sp) { const float* p_ = slab + ((size_t)sp * 2048 + m0 + r32) * 256 + k_; sa[buf][2 * sp] = *(const f32x4_t*)p_; sa[buf][2 * sp + 1] = *(const f32x4_t*)(p_ + 4); } \
    wb[buf][0] = *(const bf16x8*)(w2t + (size_t)r32 * 256 + k_); wb[buf][1] = *(const bf16x8*)(w2t + (size_t)(32 + r32) * 256 + k_); } while (0)
#define CMPL2_MMA(buf) do { f32x4_t a0 = cp[buf][0], a1 = cp[buf][1]; \
    _Pragma("unroll") for (int sp = 0; sp < 4; ++sp) { a0 += sa[buf][2 * sp]; a1 += sa[buf][2 * sp + 1]; } \
    u32x4 aw; aw.x = pk2(peer::gelu_fast(a0[0]), peer::gelu_fast(a0[1])); aw.y = pk2(peer::gelu_fast(a0[2]), peer::gelu_fast(a0[3])); \
    aw.z = pk2(peer::gelu_fast(a1[0]), peer::gelu_fast(a1[1])); aw.w = pk2(peer::gelu_fast(a1[2]), peer::gelu_fast(a1[3])); \
    const bf16x8 af = __builtin_bit_cast(bf16x8, aw); \
    acc0 = __builtin_amdgcn_mfma_f32_32x32x16_bf16(af, wb[buf][0], acc0, 0, 0, 0); acc1 = __builtin_amdgcn_mfma_f32_32x32x16_bf16(af, wb[buf][1], acc1, 0, 0, 0); } while (0)
  CMPL2_LOAD(0, 0);
#pragma unroll 1
  for (int ks = 0; ks < 16; ks += 2) {
    CMPL2_LOAD(1, ks + 1);
    CMPL2_MMA(0);
    if (ks + 2 < 16) CMPL2_LOAD(0, ks + 2);
    CMPL2_MMA(1);
  }
#undef CMPL2_LOAD
#undef CMPL2_MMA
#pragma unroll
  for (int r = 0; r < 16; ++r) {
    const int m = m0 + (r & 3) + 8 * (r >> 2) + 4 * hi;
    const bool pad = (m & 127) == 127;
    outkc[(size_t)m * 64 + r32] = pad ? (bf16_t)0 : f2bf(acc0[r]);
    outkc[(size_t)m * 64 + 32 + r32] = pad ? (bf16_t)0 : f2bf(acc1[r]);
  }
}
}

#define XB_TMO      128
#define XB_XCNT(j)  (256  + 64 * (j))
#define XB_XSUB(j)  (1280 + 64 * (j))
#define XB_XGEN(j)  (2304 + 64 * (j))
#define XB_TOP      3328
#define XB_TOPGEN   3392
#define XCD_BAR_WORDS 3456
#define XB_SPIN_CAP (1u << 18)
#ifndef LAS
#define LAS __attribute__((address_space(3)))
#endif

__device__ __forceinline__ unsigned xb_ld(unsigned* p)              { return __hip_atomic_load(p, __ATOMIC_RELAXED, __HIP_MEMORY_SCOPE_AGENT); }
__device__ __forceinline__ unsigned xb_add(unsigned* p, unsigned v) { return __hip_atomic_fetch_add(p, v, __ATOMIC_RELAXED, __HIP_MEMORY_SCOPE_AGENT); }
__device__ __forceinline__ unsigned xb_xcc_id() { return (unsigned)__builtin_amdgcn_s_getreg((3 << 11) | 20) & 0xFu; }
#define XB_SPIN(cond, bar) do { unsigned _sp = 0; while (cond) { __builtin_amdgcn_s_sleep(1); \
    if ((++_sp & 255u) == 0u) { if (xb_ld(&(bar)[XB_TMO])) break; if (_sp > XB_SPIN_CAP) { atomicAdd(&(bar)[XB_TMO], 1u); break; } } } } while (0)

struct XcdBarrier {
    unsigned* bar; unsigned x;
    volatile LAS unsigned* st;
};

__device__ __forceinline__ XcdBarrier xcd_barrier_post(unsigned* bar, volatile LAS unsigned* st) {
    XcdBarrier b; b.bar = bar; b.x = xb_xcc_id(); b.st = st;
    if (threadIdx.x == 0) (void)xb_add(&bar[XB_XCNT(b.x)], 1u);
    return b;
}
__device__ __forceinline__ void xcd_barrier_complete(unsigned* bar, unsigned x, unsigned& nloc, unsigned& nx) {
    const unsigned G = gridDim.x * gridDim.y * gridDim.z;
    unsigned sum, cnt, mine, sp = 0u;
    for (;;) {
        sum = 0u; cnt = 0u; mine = 0u;
#pragma unroll
        for (unsigned j = 0; j < 16; ++j) { const unsigned c = xb_ld(&bar[XB_XCNT(j)]); sum += c; cnt += (c > 0u) ? 1u : 0u; mine = (j == x) ? c : mine; }
        if (sum == G) break;
        __builtin_amdgcn_s_sleep(1);
        if ((++sp & 255u) == 0u) { if (xb_ld(&bar[XB_TMO])) break; if (sp > XB_SPIN_CAP) { atomicAdd(&bar[XB_TMO], 1u); break; } }
    }
    nloc = mine > 0u ? mine : 1u; nx = cnt > 0u ? cnt : 1u;
}

__device__ __forceinline__ void xcd_barrier(const XcdBarrier& b) {
    asm volatile("s_waitcnt vmcnt(0)" ::: "memory");
    __syncthreads();
    if (threadIdx.x == 0) {
        unsigned* bar = b.bar;
        __builtin_amdgcn_s_waitcnt(0);
        unsigned nloc = b.st[0], nx = b.st[1];
        if (nloc == 0u) { xcd_barrier_complete(bar, b.x, nloc, nx); b.st[0] = nloc; b.st[1] = nx; }
        const unsigned old = xb_add(&bar[XB_XSUB(b.x)], 1u);
        const unsigned gen = old / nloc;
        if (old + 1u == (gen + 1u) * nloc) {
            __builtin_amdgcn_fence(__ATOMIC_RELEASE, "agent");
            asm volatile("s_waitcnt vmcnt(0)" ::: "memory");
            const unsigned og = xb_add(&bar[XB_TOP], 1u);
            const unsigned tg = og / nx;
            if (og + 1u == (tg + 1u) * nx) xb_add(&bar[XB_TOPGEN], 1u);
            else XB_SPIN(xb_ld(&bar[XB_TOPGEN]) == tg, bar);
            __builtin_amdgcn_fence(__ATOMIC_ACQUIRE, "agent");
            xb_add(&bar[XB_XGEN(b.x)], 1u);
            asm volatile("s_waitcnt vmcnt(0)" ::: "memory");
        } else {
            XB_SPIN(xb_ld(&bar[XB_XGEN(b.x)]) == gen, bar);
            __builtin_amdgcn_fence(__ATOMIC_ACQUIRE, "agent");
            asm volatile("s_waitcnt vmcnt(0)" ::: "memory");
        }
    }
    __syncthreads();
}

struct Args { const float* in[23]; float* out; char* ws; };
constexpr int LDS_BYTES = 131072 + 4096;

typedef const __attribute__((address_space(4))) Args* kargs_t;
DEV kargs_t KA() { kargs_t k = (kargs_t)__builtin_amdgcn_kernarg_segment_ptr(); asm volatile("" : "+s"(k)); return k; }
#define WSP(type, off) ((type*)(ws + (off)))

__global__ __launch_bounds__(NTHR, 2) void mega(Args a) {
  extern __shared__ __attribute__((aligned(16))) char lds[];
  cg::grid_group grid = cg::this_grid();
  PG8_LAS unsigned char* glds = (PG8_LAS unsigned char*)lds;
  const int bid = blockIdx.x, G = gridDim.x;
  (void)a;
  volatile LAS unsigned* bst = (volatile LAS unsigned*)((LAS char*)lds + LDS_BYTES - 16);
  if (threadIdx.x < 4) bst[threadIdx.x] = 0u;
  __syncthreads();
  XcdBarrier xbar; { kargs_t k = KA(); xbar = xcd_barrier_post((unsigned*)k->ws, bst); }

  { kargs_t k = KA(); char* ws = k->ws;
    const int wv0_ = threadIdx.x >> 6;
    if (wv0_ < 4) { const int lane_ = threadIdx.x & 63, wv_ = wv0_, gw_ = bid * 4 + wv_, nw_ = G * 4;
      __attribute__((address_space(3))) float* scr = (__attribute__((address_space(3))) float*)((__attribute__((address_space(3))) char*)lds + wv_ * 8448);
      constexpr int I_IN = 16 * 120, I_C1 = 32 * 8;
      for (int it = gw_; it < I_IN + 2 * I_C1; it += nw_) {
        int r = it;
        if (r < I_IN) { tr_item<1>(k->in[2], 1024, IN_COLS, WSP(bf16_t, WS_WIN), 120, 3840, scr, r, lane_); continue; } r -= I_IN;
        if (r < I_C1) { tr_item<0>(k->in[5], 2048, 256, WSP(bf16_t, WS_CKW1), 8, 256, scr, r, lane_); continue; } r -= I_C1;
        tr_item<0>(k->in[7], 2048, 256, WSP(bf16_t, WS_CVW1), 8, 256, scr, r, lane_);
      }
      for (int i = gw_ * 64 + lane_; i < 16 * 128 * 64; i += nw_ * 64) WSP(bf16_t, WS_SUBK)[i] = f2bf(k->in[18][i]);
      for (int i = gw_ * 64 + lane_; i < SEQ * 16; i += nw_ * 64) rope_entry(WSP(float2, WS_ROPE), i);
    } else ph_rms1024<false>(k->in[0], k->in[1], WSP(bf16_t, WS_XN), T, nullptr, nullptr, bid * 4 + (wv0_ - 4), G * 4); }
  grid.sync();
  { kargs_t k = KA(); char* ws = k->ws;
    pg8::Gemm g{WSP(bf16_t, WS_XN), WSP(bf16_t, WS_WIN), T, 3840, 1024}; pg8::StaticOrder S; S.init(T, 3840, G, bid);
    pg8::EpiInProjF E{WSP(bf16_t, WS_PROJ), WSP(unsigned char, WS_GATES)};
    pg8::gemm_phase<pg8::EpiInProjF, pg8::StaticOrder, PG8_ALIGN, PG8_SP2>(glds, g, S, E);
    {
      const bool some = (G == 256); const int nb = some ? 64 : G, b0 = some ? bid - 192 : bid;
      if (b0 >= 0) {
        const int lane_ = threadIdx.x & 63, wv_ = threadIdx.x >> 6;
        __attribute__((address_space(3))) float* scr = (__attribute__((address_space(3))) float*)((__attribute__((address_space(3))) char*)lds + wv_ * 8448);
        constexpr int I_BR = 8 * 32, I_SQ = 16 * 32, I_C2 = 4 * 8, I_UQ = 4 * 24, I_UKV = 2 * 32;
        for (int it = b0 * NWV + wv_; it < 2 * I_BR + 2 * I_SQ + 2 * I_C2 + I_UQ + I_UKV; it += nb * NWV) {
          int r = it;
          if (r < I_UQ) { tr_item<0>(k->in[11], 256, 768, WSP(bf16_t, WS_UQ), 24, 768, scr, r, lane_); continue; } r -= I_UQ;
          if (r < I_UKV) { tr_item<0>(k->in[12], 128, 1024, WSP(bf16_t, WS_UKV), 32, 1024, scr, r, lane_); continue; } r -= I_UKV;
          if (r < I_C2) { tr_item<0>(k->in[6], 256, 64, WSP(bf16_t, WS_CKW2), 8, 64, scr, r, lane_); continue; } r -= I_C2;
          if (r < I_C2) { tr_item<0>(k->in[8], 256, 64, WSP(bf16_t, WS_CVW2), 8, 64, scr, r, lane_); continue; } r -= I_C2;
          if (r < I_BR) { tr_item<0>(k->in[13], 512, 1024, WSP(bf16_t, WS_WBN), 32, 1024, scr, r, lane_, 1024, 0); continue; } r -= I_BR;
          if (r < I_BR) { tr_item<0>(k->in[14], 512, 1024, WSP(bf16_t, WS_WBN), 32, 1024, scr, r, lane_, 1024, 512); continue; } r -= I_BR;
          if (r < I_SQ) { tr_item<0>(k->in[15], 1024, 1024, WSP(bf16_t, WS_WOUT), 32, 1024, scr, r, lane_); continue; } r -= I_SQ;
          tr_item<0>(k->in[17], 1024, 1024, WSP(bf16_t, WS_WQ), 32, 1024, scr, r, lane_);
        } } } }
  xcd_barrier(xbar);
  { kargs_t k = KA(); char* ws = k->ws;
    const int lane_ = threadIdx.x & 63, wv_ = threadIdx.x >> 6;
    if (G >= 128 && bid < 64) {
      const int tab = bid >> 5;
      pg8::Gemm g{WSP(bf16_t, WS_PROJ) + PC_KV + tab * 128, WSP(bf16_t, tab ? WS_CVW1 : WS_CKW1), 2048, 1024, 512};
      g.pitchA = 16u * PROJ_LD * 2u; g.kstepA = PROJ_LD * 2u; g.hstepA = 128; g.tA_pm = (size_t)SEQ * PROJ_LD * 2; g.tA_pn = (size_t)8 * PROJ_LD * 2;
      g.pitchB = 4096u; g.kstepB = 128u; g.hstepB = (size_t)128 * 4096; g.tB_pn = 1024; g.nt = 8;
      pg8::StaticOrder S; S.init(2048, 1024, 32, bid & 31);
      pg8::EpiSlabF E{WSP(float, WS_SLAB) + (size_t)tab * 4 * 2048 * 256};
      pg8::gemm_phase<pg8::EpiSlabF, pg8::StaticOrder, PG8_ALIGN, PG8_SP2>(glds, g, S, E);
    } else {
      const int nb = (G >= 128) ? G - 64 : G, b0 = (G >= 128) ? bid - 64 : bid;
      prep::cmp_bias(k->in[3], k->in[4], WSP(bf16_t, WS_CKW1), WSP(bf16_t, WS_CVW1), WSP(float, WS_CPOS), b0 * NWV + wv_, nb * NWV, lane_);
      prep::latent_rows(WSP(bf16_t, WS_PROJ), k->in[9], k->in[10], WSP(float2, WS_ROPE), WSP(bf16_t, WS_CQN), WSP(bf16_t, WS_CKVN), WSP(bf16_t, WS_KROPE), b0 * NWV + wv_, nb * NWV, lane_);
    } }
  xcd_barrier(xbar);
  if (G == 256 && ((bid + 64) & 255) >= 192) {
    kargs_t k = KA(); char* ws = k->ws;
    const int lane_ = threadIdx.x & 63, wv_ = threadIdx.x >> 6;
    if (wv_ < 2) { const int it = (((bid + 64) & 255) - 192) * 2 + wv_; const int tab = it >> 6;
      prep::cmp_l2(WSP(float, WS_SLAB) + (size_t)tab * 4 * 2048 * 256, WSP(float, WS_CPOS) + tab * 256, WSP(bf16_t, tab ? WS_CVW2 : WS_CKW2), WSP(bf16_t, tab ? WS_VC : WS_KC), it & 63, lane_); }
  } else if (G != 256) {
    kargs_t k = KA(); char* ws = k->ws;
    const int lane_ = threadIdx.x & 63, wv_ = threadIdx.x >> 6;
    for (int it = bid * NWV + wv_; it < 128; it += G * NWV) { const int tab = it >> 6;
      prep::cmp_l2(WSP(float, WS_SLAB) + (size_t)tab * 4 * 2048 * 256, WSP(float, WS_CPOS) + tab * 256, WSP(bf16_t, tab ? WS_CVW2 : WS_CKW2), WSP(bf16_t, tab ? WS_VC : WS_KC), it & 63, lane_); }
  }
  { kargs_t k = KA(); char* ws = k->ws;
    pg8::Gemm g{WSP(bf16_t, WS_CQN), WSP(bf16_t, WS_UQ), T, 768, 256}; pg8::StaticOrder S; S.init(T, 768, G, (bid + 64) & 255);
    pg8::EpiMlaQF E{WSP(bf16_t, WS_MLAQ), WSP(float2, WS_ROPE)};
    pg8::gemm_phase<pg8::EpiMlaQF, pg8::StaticOrder, PG8_ALIGN, PG8_SP2>(glds, g, S, E); }
  { kargs_t k = KA(); char* ws = k->ws;
    pg8::Gemm g{WSP(bf16_t, WS_CKVN), WSP(bf16_t, WS_UKV), T, 1024, 128}; pg8::StaticOrder S; S.init(T, 1024, G, bid);
    pg8::EpiBf16<0> E{WSP(bf16_t, WS_MLAKV), 1024, nullptr, 0, 0, 1.f};
    pg8::gemm_phase<pg8::EpiBf16<0>, pg8::StaticOrder, PG8_ALIGN, PG8_SP2>(glds, g, S, E); }
  xcd_barrier(xbar);
  { kargs_t k = KA(); char* ws = k->ws;
    att::attn_phase(WSP(bf16_t, WS_PROJ), WSP(bf16_t, WS_KC), WSP(bf16_t, WS_VC), k->in[21], WSP(bf16_t, WS_ONSA),
                    WSP(bf16_t, WS_MLAQ), WSP(bf16_t, WS_MLAKV), WSP(bf16_t, WS_KROPE), WSP(bf16_t, WS_ONSA), (att::lptr)lds); }
  xcd_barrier(xbar);
  { kargs_t k = KA(); char* ws = k->ws;
    pg8::Gemm g{WSP(bf16_t, WS_ONSA), WSP(bf16_t, WS_WBN), T, 1024, 1024}; pg8::StaticOrder S; S.init(T, 1024, G, bid);
    pg8::EpiMergeFusedF E{WSP(unsigned char, WS_GATES), WSP(bf16_t, WS_MERGED)};
    pg8::gemm_phase<pg8::EpiMergeFusedF, pg8::StaticOrder, PG8_ALIGN, PG8_SP2>(glds, g, S, E); }
  xcd_barrier(xbar);
  { kargs_t k = KA(); char* ws = k->ws;
    pg8::Gemm g{WSP(bf16_t, WS_MERGED), WSP(bf16_t, WS_WOUT), T, 1024, 1024}; pg8::StaticOrder S; S.init(T, 1024, G, bid);
    pg8::EpiBf16<0> E{WSP(bf16_t, WS_OB), 1024, nullptr, 0, 0, 1.f};
    pg8::gemm_phase<pg8::EpiBf16<0>, pg8::StaticOrder, PG8_ALIGN, PG8_SP2>(glds, g, S, E); }
  xcd_barrier(xbar);
  { kargs_t k = KA(); char* ws = k->ws; ph_rms1024<true>(k->in[0], k->in[16], WSP(bf16_t, WS_HN), T, WSP(unsigned, WS_HN8), WSP(float, WS_SH), -1, 0, WSP(bf16_t, WS_OB));
    peer::conv_tables(k->in[19], k->in[20], WSP(unsigned, WS_U8), WSP(float, WS_SU), WSP(unsigned, WS_V8)); }
  xcd_barrier(xbar);
  { kargs_t k = KA(); char* ws = k->ws;
    pg8::Gemm g{WSP(bf16_t, WS_HN), WSP(bf16_t, WS_WQ), T, 1024, 1024}; pg8::StaticOrder S; S.init(T, 1024, G, bid);
    pg8::EpiBf16<0> E{WSP(bf16_t, WS_PQ), 1024, nullptr, 0, 0, 1.f};
    pg8::gemm_phase<pg8::EpiBf16<0>, pg8::StaticOrder, PG8_ALIGN, PG8_SP2>(glds, g, S, E); }
  xcd_barrier(xbar);
  { kargs_t k = KA(); char* ws = k->ws; peer::route_phase(WSP(bf16_t, WS_PQ), WSP(bf16_t, WS_SUBK), WSP(unsigned, WS_PIDX), (__attribute__((address_space(3))) char*)lds); }
  xcd_barrier(xbar);
  { kargs_t k = KA(); char* ws = k->ws;
    peer::experts_sliced<0>(WSP(unsigned, WS_PIDX), WSP(unsigned, WS_HN8), WSP(float, WS_SH), WSP(unsigned, WS_U8), WSP(float, WS_SU), WSP(float, WS_CO), WSP(unsigned, WS_V8), k->out, WSP(float, WS_SSQ),
                            (unsigned*)ws + CTL_QA, (__attribute__((address_space(3))) char*)lds); }
  xcd_barrier(xbar);
  { kargs_t k = KA(); char* ws = k->ws;
    peer::experts_sliced<1>(WSP(unsigned, WS_PIDX), WSP(unsigned, WS_HN8), WSP(float, WS_SH), WSP(unsigned, WS_U8), WSP(float, WS_SU), WSP(float, WS_CO), WSP(unsigned, WS_V8), (float*)WSP(bf16_t, WS_ZB), WSP(float, WS_SSQ),
                            (unsigned*)ws + CTL_QB, (__attribute__((address_space(3))) char*)lds, k->in[0], WSP(bf16_t, WS_OB)); }
  xcd_barrier(xbar);
  { kargs_t k = KA(); char* ws = k->ws; peer::experts_norm(WSP(float, WS_SSQ), k->in[22], WSP(bf16_t, WS_ZB), k->out); }
}

extern "C" void kernel_launch(void* const* d_in, const int* in_sizes, int n_in, void* d_out, int out_size, void* d_ws, size_t ws_size, hipStream_t stream) {
  if (n_in != 23 || ws_size < 256 * MiB) { fprintf(stderr, "kernel_launch: unexpected n_in %d / ws_size %zu\n", n_in, ws_size); return; }
  static int grid_blocks = 0;
  if (!grid_blocks) {
    int dev = 0, cus = 0, per_cu = 0;
    (void)hipGetDevice(&dev);
    (void)hipDeviceGetAttribute(&cus, hipDeviceAttributeMultiprocessorCount, dev);
    if (hipFuncSetAttribute((const void*)mega, hipFuncAttributeMaxDynamicSharedMemorySize, LDS_BYTES) != hipSuccess) fprintf(stderr, "kernel_launch: hipFuncSetAttribute failed\n");
    (void)hipOccupancyMaxActiveBlocksPerMultiprocessor(&per_cu, (const void*)mega, NTHR, LDS_BYTES);
    if (per_cu < 1) { fprintf(stderr, "kernel_launch: occupancy query returned %d\n", per_cu); per_cu = 1; }
    if (per_cu > 2) per_cu = 2;
    grid_blocks = cus * per_cu;
    fprintf(stderr, "kernel_launch: cus %d per_cu %d grid %d ws %zu\n", cus, per_cu, grid_blocks, ws_size);
  }
  if (hipMemsetAsync(d_ws, 0, 65536, stream) != hipSuccess) fprintf(stderr, "kernel_launch: hipMemsetAsync failed\n");
  Args a{};
  for (int i = 0; i < 23; ++i) a.in[i] = (const float*)d_in[i];
  a.out = (float*)d_out; a.ws = (char*)d_ws;
  void* args[] = {&a};
  hipError_t e = hipLaunchCooperativeKernel((const void*)mega, dim3(grid_blocks), dim3(NTHR), args, LDS_BYTES, stream);
  if (e != hipSuccess) fprintf(stderr, "cooperative launch failed: %s (grid %d)\n", hipGetErrorString(e), grid_blocks);
}
```

```cpp
#include <hip/hip_runtime.h>
#include <stdint.h>
#include <cstdio>
#include <hip/hip_cooperative_groups.h>
namespace cg = cooperative_groups;

typedef unsigned short bf16_t;
#define DEV __device__ __forceinline__

constexpr int BATCH = 8, SEQ = 2048, DM = 1024, T = BATCH * SEQ;
constexpr int IN_COLS = 3768;
constexpr int PROJ_LD = 1792;
constexpr int PC_Q = 0, PC_KV = 512, PC_CQ = 1280, PC_CKV = 1536, PC_KR = 1664, PC_GATE = 1696;
constexpr int NC = 127;
constexpr size_t MiB = 1u << 20;

constexpr size_t WS_WIN = 1 * MiB;
constexpr size_t WS_WBN = 9 * MiB;
constexpr size_t WS_WBM = 10 * MiB;
constexpr size_t WS_WOUT = 11 * MiB;
constexpr size_t WS_WQ = 13 * MiB;
constexpr size_t WS_CKW1 = 15 * MiB;
constexpr size_t WS_CVW1 = 16 * MiB;
constexpr size_t WS_CKW2 = 17 * MiB;
constexpr size_t WS_CVW2 = 17 * MiB + 128 * 1024;
constexpr size_t WS_UQ = 17 * MiB + 256 * 1024;
constexpr size_t WS_UKV = 17 * MiB + 768 * 1024;
constexpr size_t WS_SUBK = 18 * MiB;
constexpr size_t WS_ROPE = 18 * MiB + 512 * 1024;
constexpr size_t WS_GATES = 20 * MiB;
constexpr size_t WS_PQ = 20 * MiB;
constexpr size_t WS_ZB = 20 * MiB;
constexpr size_t WS_OB = 52 * MiB;
constexpr size_t WS_PROJ = 84 * MiB;
constexpr size_t WS_MERGED = 84 * MiB;
constexpr size_t WS_PIDX = 84 * MiB;
constexpr size_t WS_U8 = 172 * MiB;
constexpr size_t WS_V8 = 188 * MiB;
constexpr size_t WS_SU = 204 * MiB;
constexpr size_t WS_SH = 204 * MiB + 65536;
constexpr size_t WS_HN8 = 205 * MiB;
constexpr size_t WS_CO = 221 * MiB;
constexpr size_t WS_SSQ = 229 * MiB;
constexpr int CTL_QA = 4096, CTL_QB = 4096 + 512;
constexpr size_t WS_PW = 92 * MiB;
constexpr size_t WS_XN = 140 * MiB;
constexpr size_t WS_MLAKV = 140 * MiB;
constexpr size_t WS_HN = 140 * MiB;
constexpr size_t WS_MLAQ = 172 * MiB;
constexpr size_t WS_KROPE = 196 * MiB;
constexpr size_t WS_KC = 197 * MiB;
constexpr size_t WS_VC = 197 * MiB + 512 * 1024;
constexpr size_t WS_ONSA = 198 * MiB;
constexpr size_t WS_OMLA = 214 * MiB;
constexpr size_t WS_SLAB = 198 * MiB;
constexpr size_t WS_CPOS = 18 * MiB + 768 * 1024;
constexpr size_t WS_CA = 198 * MiB;
constexpr size_t WS_HID = 206 * MiB;
constexpr size_t WS_HID2 = 207 * MiB;
constexpr size_t WS_CA2 = 214 * MiB;
constexpr size_t WS_CQN = 230 * MiB;
constexpr size_t WS_CKVN = 238 * MiB;
constexpr size_t WS_OCMP = 230 * MiB;
constexpr size_t WS_SEL = 246 * MiB;

__device__ const unsigned char T5B[128] = {
  0, 1, 2, 3, 4, 5, 6, 7, 8, 9, 10, 11, 12, 13, 14, 15, 16, 16, 16, 17, 17, 18, 18, 18, 19, 19, 19, 20, 20, 20, 20, 21,
  21, 21, 21, 22, 22, 22, 22, 22, 23, 23, 23, 23, 23, 23, 24, 24, 24, 24, 24, 24, 25, 25, 25, 25, 25, 25, 25, 26, 26, 26, 26, 26,
  26, 26, 26, 27, 27, 27, 27, 27, 27, 27, 27, 27, 27, 28, 28, 28, 28, 28, 28, 28, 28, 28, 28, 29, 29, 29, 29, 29, 29, 29, 29, 29,
  29, 29, 29, 30, 30, 30, 30, 30, 30, 30, 30, 30, 30, 30, 30, 30, 30, 31, 31, 31, 31, 31, 31, 31, 31, 31, 31, 31, 31, 31, 31, 31};

DEV float bf2f(bf16_t v) { return __uint_as_float(((unsigned)v) << 16); }
DEV bf16_t f2bf(float f) { unsigned u = __float_as_uint(f); u += 0x7fffu + ((u >> 16) & 1u); return (bf16_t)(u >> 16); }
template <int CTRL> DEV int dpp_i(int v) { return __builtin_amdgcn_update_dpp(0, v, CTRL, 0xF, 0xF, true); }
template <int CTRL> DEV float dpp_f(float v) { return __uint_as_float((unsigned)__builtin_amdgcn_update_dpp(0, (int)__float_as_uint(v), CTRL, 0xF, 0xF, true)); }
DEV int sum16_i(int v) { v += dpp_i<0xB1>(v); v += dpp_i<0x4E>(v); v += dpp_i<0x141>(v); v += dpp_i<0x140>(v); return v; }
DEV float sum16_f(float v) { v += dpp_f<0xB1>(v); v += dpp_f<0x4E>(v); v += dpp_f<0x141>(v); v += dpp_f<0x140>(v); return v; }
DEV float max16_f(float v) { v = fmaxf(v, dpp_f<0xB1>(v)); v = fmaxf(v, dpp_f<0x4E>(v)); v = fmaxf(v, dpp_f<0x141>(v)); v = fmaxf(v, dpp_f<0x140>(v)); return v; }
DEV float rl_f(float v, int l) { return __uint_as_float((unsigned)__builtin_amdgcn_readlane((int)__float_as_uint(v), l)); }
DEV float wsum(float v) { v = sum16_f(v); return (rl_f(v, 0) + rl_f(v, 16)) + (rl_f(v, 32) + rl_f(v, 48)); }
DEV float wmaxf(float v) { v = max16_f(v); return fmaxf(fmaxf(rl_f(v, 0), rl_f(v, 16)), fmaxf(rl_f(v, 32), rl_f(v, 48))); }
DEV float sigmoidf_(float x) { return 1.0f / (1.0f + expf(-x)); }
DEV float gelu_exact(float x) { return 0.5f * x * (1.0f + erff(x * 0.70710678118654752f)); }
DEV void wave_lds_sync() { asm volatile("s_waitcnt lgkmcnt(0)" ::: "memory"); __builtin_amdgcn_wave_barrier(); asm volatile("" ::: "memory"); }
DEV float t5bias(const float* t5, int head, int dist) { int d = dist < 127 ? dist : 127; d = d < 0 ? 0 : d; return t5[(int)T5B[d] * 8 + head]; }


namespace pg8 {
#define PG8_LAS __attribute__((address_space(3)))
typedef unsigned short bf16_t;
typedef short bf16x8 __attribute__((ext_vector_type(8)));
typedef float f32x4 __attribute__((ext_vector_type(4)));
typedef unsigned u32x4 __attribute__((ext_vector_type(4)));
constexpr int BM = 256, BK = 64, HALF = 128, HTB = HALF * BK * 2  , STAGE_BYTES = 8 * HTB, NXCD = 8, WGM = 8;

__host__ __device__ __forceinline__ int lds_byte(int r, int c) { const int st = (r >> 4) * 2 + (c >> 5), rr = r & 15, cc = c & 31, ob = rr * 64 + cc * 2; return st * 1024 + (ob ^ (((ob >> 9) & 1) << 5)); }
__host__ __device__ __forceinline__ void stage_rc(int b, int& R, int& C) { const int st = b / 1024, sb = b % 1024, swz = sb ^ (((sb >> 9) & 1) << 5); R = (st >> 1) * 16 + swz / 64; C = (st & 1) * 32 + (swz % 64) / 2; }
__host__ __device__ __forceinline__ int perm32(int rho) { const int n = rho >> 4, i = rho & 15; return 8 * (i >> 2) + 4 * n + (i & 3); }

struct Unit { int pm, pn; };
struct Gemm { const bf16_t* A; const bf16_t* Bt; int M, N, K;
    unsigned pitchA = 0, pitchB = 0, kstepA = 0, kstepB = 0; size_t hstepA = 0, hstepB = 0, tA_pm = 0, tA_pn = 0, tB_pn = 0; int nt = 0; };

struct StaticOrder {
    int nM, nN, nwg, G, c;
    __host__ __device__ void init(int M, int N, int G_, int c_) { nM = M / BM; nN = N / BM; nwg = nM * nN; G = G_; c = c_; }
    __host__ __device__ bool next(int i, Unit& u) const {
        const long L = (long)i * G + c; if (L >= nwg) return false;
        int wgid = (int)L; { const int q = nwg / NXCD, r = nwg % NXCD, xcd = wgid % NXCD, off = wgid / NXCD; wgid = (xcd < r ? xcd * (q + 1) : r * (q + 1) + (xcd - r) * q) + off; }
        const int nig = WGM * nN, gid = wgid / nig, fm = gid * WGM, gsz = (nM - fm) < WGM ? (nM - fm) : WGM;
        u.pm = fm + ((wgid % nig) % gsz); u.pn = (wgid % nig) / gsz; return true;
    }
    __device__ __forceinline__ void a_ready(const Unit&) const {}
    __device__ __forceinline__ void done(const Unit&) const {}
};

__device__ __forceinline__ unsigned cvt_pk_bf16(float lo, float hi) { unsigned r; asm volatile("v_cvt_pk_bf16_f32 %0, %1, %2" : "=v"(r) : "v"(lo), "v"(hi)); return r; }
typedef float f32x2 __attribute__((ext_vector_type(2)));
__device__ __forceinline__ f32x2 gelu_pk(f32x2 v) {
    const f32x2 av = __builtin_elementwise_abs(v), d = av * 0.2316418882f + 1.0f;
    f32x2 t; t.x = __builtin_amdgcn_rcpf(d.x); t.y = __builtin_amdgcn_rcpf(d.y);
    f32x2 q = t * 0.5307027145f + (-0.7265760135f); q = q * t + 0.7107068705f; q = q * t + (-0.142248368f); q = q * t + 0.127414796f; q = q * t;
    const f32x2 s = (v * v) * (-0.72134752044f);
    f32x2 e; e.x = __builtin_amdgcn_exp2f(s.x); e.y = __builtin_amdgcn_exp2f(s.y);
    const f32x2 m = v * (q * e), r = v - m;
    f32x2 o; o.x = v.x < 0.f ? m.x : r.x; o.y = v.y < 0.f ? m.y : r.y; return o;
}

template <int ACT  > struct EpiBf16 {
    static constexpr bool PERM = true, AFTER_DRAIN = false, MIDK = false; static_assert(ACT == 0 || ACT == 1, "EpiBf16: ACT is 0 (none) or 1 (gelu_pk)");
    bf16_t* O; int ldc; const float* bias; int split_cols; size_t split_stride; float scale0;
    __device__ __forceinline__ void operator()(const f32x4 (&acc)[2][2][4][2], const Unit& u, int wr, int wc, int fr, int fq) const {
        const int row0 = u.pm * BM + wr * 64 + fr; int colt = u.pn * BM; bf16_t* base = O;
        float sc = 1.f; if (split_cols) { const int t = colt / split_cols; base += (size_t)t * split_stride; colt -= t * split_cols; if (t == 0) sc = scale0; }
        const int col0 = colt + wc * 32 + 8 * fq, bcol0 = u.pn * BM + wc * 32 + 8 * fq;
        f32x4 bv[2][2];
#pragma unroll
        for (int bj = 0; bj < 2; ++bj)
#pragma unroll
            for (int n = 0; n < 2; ++n) bv[bj][n] = bias ? *(const f32x4*)(bias + bcol0 + bj * HALF + 4 * n) : (f32x4){0.f, 0.f, 0.f, 0.f};
#pragma unroll
        for (int ai = 0; ai < 2; ++ai)
#pragma unroll
            for (int m = 0; m < 4; ++m) { bf16_t* rowp = base + (size_t)(row0 + ai * HALF + m * 16) * ldc + col0;
#pragma unroll
                for (int bj = 0; bj < 2; ++bj) { f32x4 v0 = acc[ai][bj][m][0] + bv[bj][0], v1 = acc[ai][bj][m][1] + bv[bj][1];
                    if (ACT == 1) { f32x2 a = gelu_pk((f32x2){v0[0], v0[1]}), b = gelu_pk((f32x2){v0[2], v0[3]}), c = gelu_pk((f32x2){v1[0], v1[1]}), d = gelu_pk((f32x2){v1[2], v1[3]});
                        v0 = (f32x4){a.x, a.y, b.x, b.y}; v1 = (f32x4){c.x, c.y, d.x, d.y}; }
                    v0 = v0 * sc; v1 = v1 * sc; u32x4 w; w.x = cvt_pk_bf16(v0[0], v0[1]); w.y = cvt_pk_bf16(v0[2], v0[3]); w.z = cvt_pk_bf16(v1[0], v1[1]); w.w = cvt_pk_bf16(v1[2], v1[3]);
                    *(u32x4*)(rowp + bj * HALF) = w; } }
    }
};

struct PanelStats {
    unsigned* xbuf;
    unsigned* cnt;
    unsigned* tmo;
    int ntn; float eps;
    unsigned code;
    __device__ __forceinline__ bool run(const f32x4 (&v)[2][2][4][2], const Unit& u, int wr, int wc, int fr, int fq, PG8_LAS unsigned char* lds, int wid, int lane) const {
        typedef float f32x2v __attribute__((ext_vector_type(2)));
        PG8_LAS f32x2v* P = (PG8_LAS f32x2v*)lds;
        PG8_LAS f32x2v* S = (PG8_LAS f32x2v*)(lds + 8192);
        PG8_LAS unsigned* flag = (PG8_LAS unsigned*)(lds + 8192 + 2048);
#pragma unroll
        for (int ai = 0; ai < 2; ++ai)
#pragma unroll
            for (int m = 0; m < 4; ++m) {
                float s = 0.f;
#pragma unroll
                for (int bj = 0; bj < 2; ++bj)
#pragma unroll
                    for (int n = 0; n < 2; ++n) { const f32x4 x = v[ai][bj][m][n]; s += (x[0] + x[1]) + (x[2] + x[3]); }
                s += __shfl_xor(s, 16); s += __shfl_xor(s, 32);
                const float mw = s * (1.0f / 64.0f); float q = 0.f;
#pragma unroll
                for (int bj = 0; bj < 2; ++bj)
#pragma unroll
                    for (int n = 0; n < 2; ++n) { const f32x4 d = v[ai][bj][m][n] - mw; q += (d[0] * d[0] + d[1] * d[1]) + (d[2] * d[2] + d[3] * d[3]); }
                q += __shfl_xor(q, 16); q += __shfl_xor(q, 32);
                if (fq == 0) P[(ai * HALF + wr * 64 + m * 16 + fr) * 4 + wc] = (f32x2v){mw, q};
            }
        asm volatile("s_waitcnt lgkmcnt(0)" ::: "memory"); __builtin_amdgcn_s_barrier(); asm volatile("" ::: "memory");
#if defined(BROKEN_EXCHANGE_NO_WAIT)
#warning BROKEN CONTROL BUILD: the row-statistics exchange does not wait; results are wrong by design
        if (blockIdx.x >= 64) { const long long t0_ = clock64(); while (clock64() - t0_ < 60000) __builtin_amdgcn_s_sleep(8); }
#endif
        const int row = wid * 32 + (lane & 31);
        if (lane < 32) {
            const f32x2v a = P[row * 4 + 0], b = P[row * 4 + 1], c = P[row * 4 + 2], d = P[row * 4 + 3];
            const float mt = (a.x + b.x + c.x + d.x) * 0.25f;
            const float da = a.x - mt, db = b.x - mt, dc = c.x - mt, dd = d.x - mt;
            const float m2 = (a.y + b.y) + (c.y + d.y) + 64.0f * ((da * da + db * db) + (dc * dc + dd * dd));
            unsigned long long* slot = (unsigned long long*)xbuf + ((size_t)(u.pm * BM + row) * 4 + u.pn);
            __hip_atomic_store(slot, ((unsigned long long)__float_as_uint(m2) << 32) | __float_as_uint(mt), __ATOMIC_RELAXED, __HIP_MEMORY_SCOPE_AGENT);
        }
        asm volatile("s_waitcnt vmcnt(0)" ::: "memory");
        if (lane == 0) __hip_atomic_fetch_add(cnt + 64 * u.pm, 1u, __ATOMIC_RELAXED, __HIP_MEMORY_SCOPE_AGENT);
        if (wid == 0) {
            bool dead = false; const unsigned long long t0 = __builtin_amdgcn_s_memrealtime(); const unsigned want = 8u * (unsigned)ntn;
            for (;;) {
#if defined(BROKEN_EXCHANGE_NO_WAIT)
                break;
#endif
                if ((unsigned)__builtin_amdgcn_readfirstlane(__hip_atomic_load(cnt + 64 * u.pm, __ATOMIC_RELAXED, __HIP_MEMORY_SCOPE_AGENT)) >= want) break;
                if (__builtin_amdgcn_s_memrealtime() - t0 > 2000000ull) {
                    if (lane == 0) { unsigned expect = 0u; __hip_atomic_compare_exchange_strong(tmo + 1, &expect, code | (unsigned)(u.pm & 0xff), __ATOMIC_RELAXED, __ATOMIC_RELAXED, __HIP_MEMORY_SCOPE_AGENT);
                                     __hip_atomic_store(tmo, 1u, __ATOMIC_RELAXED, __HIP_MEMORY_SCOPE_AGENT); }
                    dead = true; break; }
                __builtin_amdgcn_s_sleep(2);
            }
            __builtin_amdgcn_fence(__ATOMIC_ACQUIRE, "agent");
            if (lane == 0) flag[0] = dead ? 1u : 0u;
        }
        asm volatile("s_waitcnt vmcnt(0) lgkmcnt(0)" ::: "memory"); __builtin_amdgcn_s_barrier(); asm volatile("" ::: "memory");
        const bool bad = flag[0] != 0u;
        if (lane < 32) {
            const unsigned long long* slot = (const unsigned long long*)xbuf + (size_t)(u.pm * BM + row) * 4; float mt[4], m2[4]; float ms = 0.f;
#pragma unroll
            for (int t = 0; t < 4; ++t) { if (t < ntn) { const unsigned long long w = __hip_atomic_load(slot + t, __ATOMIC_RELAXED, __HIP_MEMORY_SCOPE_AGENT); mt[t] = __uint_as_float((unsigned)w); m2[t] = __uint_as_float((unsigned)(w >> 32)); } else { mt[t] = 0.f; m2[t] = 0.f; } ms += mt[t]; }
            const float mean = ms / (float)ntn; float q = 0.f;
#pragma unroll
            for (int t = 0; t < 4; ++t) if (t < ntn) { const float dm = mt[t] - mean; q += m2[t] + 256.0f * dm * dm; }
            S[row] = (f32x2v){mean, 1.0f / sqrtf(q / (256.0f * (float)ntn) + eps)};
        }
        asm volatile("s_waitcnt lgkmcnt(0)" ::: "memory"); __builtin_amdgcn_s_barrier(); asm volatile("" ::: "memory");
        return bad;
    }
};
struct EpiLnRes {
    static constexpr bool PERM = false, AFTER_DRAIN = true, MIDK = false;
    const float* base; float* out; int ldc; const float* bias; PanelStats st; unsigned poison;
    __device__ __forceinline__ void fused(f32x4 (&acc)[2][2][4][2], const Unit& u, int wr, int wc, int fr, int fq, PG8_LAS unsigned char* lds, int wid, int lane) const {
        typedef float f32x2v __attribute__((ext_vector_type(2)));
        const PG8_LAS f32x2v* S = (const PG8_LAS f32x2v*)(lds + 8192);
        const int col0 = u.pn * BM + wc * 32 + 4 * fq;
#pragma unroll
        for (int bj = 0; bj < 2; ++bj)
#pragma unroll
            for (int n = 0; n < 2; ++n) { const f32x4 bv = bias ? *(const f32x4*)(bias + col0 + bj * HALF + n * 16) : (f32x4){0.f, 0.f, 0.f, 0.f};
#pragma unroll
                for (int ai = 0; ai < 2; ++ai)
#pragma unroll
                    for (int m = 0; m < 4; ++m) acc[ai][bj][m][n] += bv; }
        f32x4 pre[4][2][2];
#pragma unroll
        for (int m = 0; m < 4; ++m) { const size_t off = (size_t)(u.pm * BM + wr * 64 + m * 16 + fr) * ldc + col0;
#pragma unroll
            for (int bj = 0; bj < 2; ++bj)
#pragma unroll
                for (int n = 0; n < 2; ++n) pre[m][bj][n] = *(const f32x4*)(base + off + bj * HALF + n * 16); }
        const bool bad = st.run(acc, u, wr, wc, fr, fq, lds, wid, lane) || poison != 0u;
        const float qnan = __builtin_nanf("");
#pragma unroll
        for (int ai = 0; ai < 2; ++ai)
#pragma unroll
            for (int m = 0; m < 4; ++m) { const int r = ai * HALF + wr * 64 + m * 16 + fr; const f32x2v sr = S[r]; const size_t off = (size_t)(u.pm * BM + r) * ldc + col0;
#pragma unroll
                for (int bj = 0; bj < 2; ++bj)
#pragma unroll
                    for (int n = 0; n < 2; ++n) { const f32x4 bs = ai == 0 ? pre[m][bj][n] : *(const f32x4*)(base + off + bj * HALF + n * 16); f32x4 o = bs + (acc[ai][bj][m][n] - sr.x) * sr.y;
                        if (bad) o = (f32x4){qnan, qnan, qnan, qnan}; *(f32x4*)(out + off + bj * HALF + n * 16) = o; }
                if (m & 1) asm volatile("" ::: "memory"); }
    }
};
struct EpiLnResLn {
    static constexpr bool PERM = false, AFTER_DRAIN = true, MIDK = false;
    const float* base; float* out; bf16_t* xn; int ldc; const float* bias; PanelStats st1, st2; unsigned poison;
    __device__ __forceinline__ void fused(f32x4 (&acc)[2][2][4][2], const Unit& u, int wr, int wc, int fr, int fq, PG8_LAS unsigned char* lds, int wid, int lane) const {
        typedef float f32x2v __attribute__((ext_vector_type(2))); typedef unsigned u32x2v __attribute__((ext_vector_type(2)));
        const PG8_LAS f32x2v* S = (const PG8_LAS f32x2v*)(lds + 8192);
        const int col0 = u.pn * BM + wc * 32 + 4 * fq;
#pragma unroll
        for (int bj = 0; bj < 2; ++bj)
#pragma unroll
            for (int n = 0; n < 2; ++n) { const f32x4 bv = bias ? *(const f32x4*)(bias + col0 + bj * HALF + n * 16) : (f32x4){0.f, 0.f, 0.f, 0.f};
#pragma unroll
                for (int ai = 0; ai < 2; ++ai)
#pragma unroll
                    for (int m = 0; m < 4; ++m) acc[ai][bj][m][n] += bv; }
        bool bad = st1.run(acc, u, wr, wc, fr, fq, lds, wid, lane) || poison != 0u;
        const float qnan = __builtin_nanf("");
#pragma unroll
        for (int ai = 0; ai < 2; ++ai)
#pragma unroll
            for (int m = 0; m < 4; ++m) { const int r = ai * HALF + wr * 64 + m * 16 + fr; const f32x2v sr = S[r]; const size_t off = (size_t)(u.pm * BM + r) * ldc + col0;
#pragma unroll
                for (int bj = 0; bj < 2; ++bj)
#pragma unroll
                    for (int n = 0; n < 2; ++n) { const f32x4 bs = *(const f32x4*)(base + off + bj * HALF + n * 16); acc[ai][bj][m][n] = bs + (acc[ai][bj][m][n] - sr.x) * sr.y; }
                asm volatile("" : "+v"(acc[ai][0][m][0]), "+v"(acc[ai][0][m][1]), "+v"(acc[ai][1][m][0]), "+v"(acc[ai][1][m][1]));
                if (m & 1) asm volatile("" ::: "memory"); }
        const bool bad1 = bad;
        bad = st2.run(acc, u, wr, wc, fr, fq, lds, wid, lane) || bad;
#pragma unroll
        for (int ai = 0; ai < 2; ++ai)
#pragma unroll
            for (int m = 0; m < 4; ++m) { const int r = ai * HALF + wr * 64 + m * 16 + fr; const f32x2v sr = S[r]; const size_t off = (size_t)(u.pm * BM + r) * ldc + col0;
#pragma unroll
                for (int bj = 0; bj < 2; ++bj)
#pragma unroll
                    for (int n = 0; n < 2; ++n) { const f32x4 x1 = acc[ai][bj][m][n]; *(f32x4*)(out + off + bj * HALF + n * 16) = bad1 ? (f32x4){qnan, qnan, qnan, qnan} : x1;
                        const f32x4 o = (x1 - sr.x) * sr.y; u32x2v w; w.x = cvt_pk_bf16(o[0], o[1]); w.y = cvt_pk_bf16(o[2], o[3]);
                        if (bad) { w.x = 0x7fc07fc0u; w.y = 0x7fc07fc0u; } *(u32x2v*)(xn + off + bj * HALF + n * 16) = w; }
                asm volatile("" ::: "memory"); }
    }
};

template <class Epi, class Sched, bool ALIGN_EPI = false, bool SP2 = false>
__device__ __forceinline__ void gemm_phase(PG8_LAS unsigned char* lds, const Gemm g, const Sched& S, const Epi& E) {
    int tid = threadIdx.x; asm volatile("" : "+v"(tid));
    const int wid = __builtin_amdgcn_readfirstlane(tid >> 6), lane = tid & 63, wr = wid >> 2, wc = wid & 3, fr = lane & 15, fq = lane >> 4;
    int K = g.K; asm volatile("" : "+s"(K)); const int nt = g.nt ? g.nt : K / BK;
    const unsigned pitchA = g.pitchA ? g.pitchA : (unsigned)K * 2u, pitchB = g.pitchB ? g.pitchB : (unsigned)K * 2u;
    unsigned voffA[2], voffB[2];
#pragma unroll
    for (int i = 0; i < 2; ++i) { int R, C; stage_rc(tid * 16 + i * 8192, R, C); const int Rb = Epi::PERM ? ((R & ~31) + perm32(R & 31)) : R;
        voffA[i] = (unsigned)R * pitchA + (unsigned)C * 2u; voffB[i] = (unsigned)Rb * pitchB + (unsigned)C * 2u; }
    const size_t kstepA = g.kstepA ? g.kstepA : (size_t)(BK * 2), kstepB = g.kstepB ? g.kstepB : (size_t)(BK * 2);
    const size_t hstepA = g.hstepA ? g.hstepA : (size_t)HALF * K * 2, hstepB = g.hstepB ? g.hstepB : (size_t)HALF * K * 2;
    const size_t tA_pm = g.tA_pm ? g.tA_pm : (size_t)BM * K * 2, tA_pn = g.tA_pn, tB_pn = g.tB_pn ? g.tB_pn : (size_t)BM * K * 2;
    const unsigned ldsw = (unsigned)wid * 1024u;
    const int aoff = lds_byte(wr * 64 + fr, fq * 8), boff = lds_byte(wc * 32 + fr, fq * 8);
#define PG8_SA(b, h) (((b) * 2 + (h)) * HTB)
#define PG8_SB(b, h) ((4 + (b) * 2 + (h)) * HTB)
#define PG8_STAGE(bufoff, gbase, voff) do { _Pragma("unroll") for (int _i = 0; _i < 2; ++_i) \
        __builtin_amdgcn_global_load_lds((const unsigned*)((const char*)(gbase) + (voff)[_i]), (PG8_LAS unsigned*)(lds + (bufoff) + ldsw + _i * 8192), 16, 0, 0); } while (0)
#define PG8_LDA(dst, b, h) do { _Pragma("unroll") for (int m = 0; m < 4; ++m) _Pragma("unroll") for (int k = 0; k < 2; ++k) dst[m][k] = *(const PG8_LAS bf16x8*)(lds + PG8_SA(b, h) + aoff + m * 2048 + k * 1024); } while (0)
#define PG8_LDB(dst, b, h) do { _Pragma("unroll") for (int n = 0; n < 2; ++n) _Pragma("unroll") for (int k = 0; k < 2; ++k) dst[n][k] = *(const PG8_LAS bf16x8*)(lds + PG8_SB(b, h) + boff + n * 2048 + k * 1024); } while (0)
#define PG8_MMA(ai, bj, At, Bt) do { __builtin_amdgcn_s_setprio(1); _Pragma("unroll") for (int m = 0; m < 4; ++m) _Pragma("unroll") for (int n = 0; n < 2; ++n) _Pragma("unroll") for (int k = 0; k < 2; ++k) \
        acc[ai][bj][m][n] = __builtin_amdgcn_mfma_f32_16x16x32_bf16(Bt[n][k], At[m][k], acc[ai][bj][m][n], 0, 0, 0); __builtin_amdgcn_s_setprio(0); } while (0)
#define PG8_WAIT_V(n) asm volatile("s_waitcnt vmcnt(" #n ")" ::: "memory")
#define PG8_WAIT_L(n) asm volatile("s_waitcnt lgkmcnt(" #n ")" ::: "memory")
#define PG8_BAR __builtin_amdgcn_s_barrier()
#define PG8_SCHED __builtin_amdgcn_sched_barrier(0)
    Unit cur, nxt; int ui = 0;
    if (!S.next(0, cur)) return;
    f32x4 acc[2][2][4][2];
#pragma unroll
    for (int a = 0; a < 2; ++a)
#pragma unroll
        for (int b = 0; b < 2; ++b)
#pragma unroll
            for (int m = 0; m < 4; ++m)
#pragma unroll
                for (int n = 0; n < 2; ++n) acc[a][b][m][n] = (f32x4){0.f, 0.f, 0.f, 0.f};
    bf16x8 At[4][2], B0[2][2], B1[2][2];
    const char* cA = (const char*)g.A + (size_t)cur.pm * tA_pm + (size_t)cur.pn * tA_pn; const char* cB = (const char*)g.Bt + (size_t)cur.pn * tB_pn;
    S.a_ready(cur);
    if constexpr (SP2) {
        PG8_STAGE(PG8_SB(0, 0), cB, voffB); PG8_STAGE(PG8_SB(0, 1), cB + hstepB, voffB); PG8_STAGE(PG8_SA(0, 0), cA, voffA); PG8_STAGE(PG8_SA(0, 1), cA + hstepA, voffA);
        if (wr == 1) PG8_BAR;
        PG8_WAIT_V(2); PG8_BAR;
        PG8_STAGE(PG8_SB(1, 0), cB + kstepB, voffB); PG8_STAGE(PG8_SA(1, 0), cA + kstepA, voffA); PG8_STAGE(PG8_SB(1, 1), cB + hstepB + kstepB, voffB);
        PG8_WAIT_V(6); PG8_BAR;
    } else {
        PG8_STAGE(PG8_SB(0, 0), cB, voffB); PG8_STAGE(PG8_SA(0, 0), cA, voffA); PG8_STAGE(PG8_SB(0, 1), cB + hstepB, voffB); PG8_STAGE(PG8_SA(0, 1), cA + hstepA, voffA);
        if (wr == 1) PG8_BAR;
        PG8_WAIT_V(4); PG8_BAR;
        PG8_STAGE(PG8_SB(1, 0), cB + kstepB, voffB); PG8_STAGE(PG8_SA(1, 0), cA + kstepA, voffA); PG8_STAGE(PG8_SB(1, 1), cB + hstepB + kstepB, voffB);
        PG8_WAIT_V(6); PG8_BAR;
    }
    for (;;) {
        const bool has_next = S.next(ui + 1, nxt);
        const char* nA = has_next ? (const char*)g.A + (size_t)nxt.pm * tA_pm + (size_t)nxt.pn * tA_pn : cA; const char* nB = has_next ? (const char*)g.Bt + (size_t)nxt.pn * tB_pn : cB;
        for (int t = 0; t < nt; t += 2) {
            if constexpr (Epi::MIDK) { if (t == (nt >> 1)) E.midk(acc, cur, wr, wc, fr, fq); }
            const bool last = (t == nt - 2);
            const char* a1 = cA + (size_t)(t + 1) * kstepA;
            const char* a2 = last ? nA : cA + (size_t)(t + 2) * kstepA; const char* b2 = last ? nB : cB + (size_t)(t + 2) * kstepB;
            const char* a3 = a2 + kstepA; const char* b3 = b2 + kstepB;
            if (last && has_next) S.a_ready(nxt);
            if constexpr (SP2) {
            PG8_LDB(B0, 0, 0); PG8_LDB(B1, 0, 1); PG8_SCHED; PG8_LDA(At, 0, 0); PG8_STAGE(PG8_SA(1, 1), a1 + hstepA, voffA);
            PG8_WAIT_V(8); PG8_WAIT_L(0); PG8_BAR; PG8_MMA(0, 0, At, B0); PG8_MMA(0, 1, At, B1); PG8_BAR; PG8_SCHED;
            PG8_LDA(At, 0, 1); PG8_STAGE(PG8_SB(0, 0), b2, voffB); PG8_STAGE(PG8_SB(0, 1), b2 + hstepB, voffB); PG8_STAGE(PG8_SA(0, 0), a2, voffA);
            PG8_WAIT_V(8); PG8_WAIT_L(0); PG8_BAR; PG8_MMA(1, 0, At, B0); PG8_MMA(1, 1, At, B1); PG8_BAR; PG8_SCHED;
            PG8_LDB(B0, 1, 0); PG8_LDB(B1, 1, 1); PG8_SCHED; PG8_LDA(At, 1, 0); PG8_STAGE(PG8_SA(0, 1), a2 + hstepA, voffA);
            PG8_WAIT_V(8); PG8_WAIT_L(0); PG8_BAR; PG8_MMA(0, 0, At, B0); PG8_MMA(0, 1, At, B1); PG8_BAR; PG8_SCHED;
            PG8_LDA(At, 1, 1); PG8_STAGE(PG8_SB(1, 0), b3, voffB); PG8_STAGE(PG8_SB(1, 1), b3 + hstepB, voffB); PG8_STAGE(PG8_SA(1, 0), a3, voffA);
            PG8_WAIT_V(8); PG8_WAIT_L(0); PG8_BAR; PG8_MMA(1, 0, At, B0); PG8_MMA(1, 1, At, B1); PG8_BAR; PG8_SCHED;
            } else {
            PG8_LDB(B0, 0, 0); PG8_SCHED; PG8_LDA(At, 0, 0); PG8_STAGE(PG8_SA(1, 1), a1 + hstepA, voffA);
            PG8_WAIT_L(8); PG8_BAR; PG8_WAIT_L(0); PG8_MMA(0, 0, At, B0); PG8_BAR; PG8_SCHED;
            PG8_LDB(B1, 0, 1); PG8_STAGE(PG8_SB(0, 0), b2, voffB);
            PG8_BAR; PG8_WAIT_L(0); PG8_MMA(0, 1, At, B1); PG8_BAR;
            PG8_LDA(At, 0, 1); PG8_STAGE(PG8_SA(0, 0), a2, voffA);
            PG8_BAR; PG8_WAIT_L(0); PG8_MMA(1, 0, At, B0); PG8_BAR; PG8_SCHED;
            PG8_STAGE(PG8_SB(0, 1), b2 + hstepB, voffB);
            PG8_WAIT_V(6); PG8_BAR; PG8_MMA(1, 1, At, B1); PG8_BAR;
            PG8_LDB(B0, 1, 0); PG8_SCHED; PG8_LDA(At, 1, 0); PG8_STAGE(PG8_SA(0, 1), a2 + hstepA, voffA);
            PG8_WAIT_L(8); PG8_BAR; PG8_WAIT_L(0); PG8_MMA(0, 0, At, B0); PG8_BAR; PG8_SCHED;
            PG8_LDB(B1, 1, 1); PG8_STAGE(PG8_SB(1, 0), b3, voffB);
            PG8_BAR; PG8_WAIT_L(0); PG8_MMA(0, 1, At, B1); PG8_BAR;
            PG8_LDA(At, 1, 1); PG8_STAGE(PG8_SA(1, 0), a3, voffA);
            PG8_BAR; PG8_WAIT_L(0); PG8_MMA(1, 0, At, B0); PG8_BAR; PG8_SCHED;
            PG8_STAGE(PG8_SB(1, 1), b3 + hstepB, voffB);
            PG8_WAIT_V(6); PG8_BAR; PG8_MMA(1, 1, At, B1); PG8_BAR;
            }
        }
        if constexpr (ALIGN_EPI) { if (wr == 0) PG8_BAR; }
        if constexpr (!Epi::AFTER_DRAIN) { E(acc, cur, wr, wc, fr, fq); S.done(cur); }
        if (!has_next) break;
#pragma unroll
        for (int a = 0; a < 2; ++a)
#pragma unroll
            for (int b = 0; b < 2; ++b)
#pragma unroll
                for (int m = 0; m < 4; ++m)
#pragma unroll
                    for (int n = 0; n < 2; ++n) acc[a][b][m][n] = (f32x4){0.f, 0.f, 0.f, 0.f};
        cur = nxt; cA = nA; cB = nB; ++ui;
        if constexpr (ALIGN_EPI) { if (wr == 1) PG8_BAR; }
    }
    PG8_WAIT_V(0);
    if constexpr (!ALIGN_EPI) { if (wr == 0) PG8_BAR; }
    PG8_BAR;
    if constexpr (Epi::AFTER_DRAIN) { E.fused(acc, cur, wr, wc, fr, fq, lds, wid, lane); S.done(cur); }
#undef PG8_SA
#undef PG8_SB
#undef PG8_STAGE
#undef PG8_LDA
#undef PG8_LDB
#undef PG8_MMA
#undef PG8_WAIT_V
#undef PG8_WAIT_L
#undef PG8_BAR
#undef PG8_SCHED
}
}

namespace pg8 {
constexpr float LOG2E = 1.4426950408889634f;
constexpr float QS_NSA = 0.125f * LOG2E;
constexpr float QS_MLA = 0.10206207261596575f * LOG2E;
__device__ __forceinline__ float fast_sigmoid(float x) { return __builtin_amdgcn_rcpf(1.0f + __builtin_amdgcn_exp2f(-LOG2E * x)); }
__device__ __forceinline__ float lo_bf(unsigned u) { return __uint_as_float(u << 16); }
__device__ __forceinline__ float hi_bf(unsigned u) { return __uint_as_float(u & 0xffff0000u); }
struct EpiInProjF {
    static constexpr bool PERM = true, AFTER_DRAIN = false, MIDK = false;
    bf16_t* proj; unsigned char* gates;
    __device__ __forceinline__ void operator()(const f32x4 (&acc)[2][2][4][2], const Unit& u, int wr, int wc, int fr, int fq) const {
        const bool isg = u.pn >= 7;
        bf16_t* base = proj; const int ld = 1792; const int colt = isg ? (u.pn - 7) * BM : u.pn * BM;
        const float sc = (u.pn < 2) ? QS_NSA : 1.0f;
        const int row0 = u.pm * BM + wr * 64 + fr, col0 = colt + wc * 32 + 8 * fq;
#pragma unroll
        for (int ai = 0; ai < 2; ++ai)
#pragma unroll
            for (int m = 0; m < 4; ++m) { bf16_t* rowp = base + (size_t)(row0 + ai * HALF + m * 16) * ld + col0;
#pragma unroll
                for (int bj = 0; bj < 2; ++bj) { f32x4 v0 = acc[ai][bj][m][0], v1 = acc[ai][bj][m][1];
                    if (isg) {
                        unsigned q[8];
#pragma unroll
                        for (int e = 0; e < 4; ++e) { q[e] = (unsigned)(fast_sigmoid(v0[e]) * 255.0f + 0.5f); q[4 + e] = (unsigned)(fast_sigmoid(v1[e]) * 255.0f + 0.5f); }
                        uint2 w; w.x = q[0] | (q[1] << 8) | (q[2] << 16) | (q[3] << 24); w.y = q[4] | (q[5] << 8) | (q[6] << 16) | (q[7] << 24);
                        *(uint2*)(gates + (size_t)(row0 + ai * HALF + m * 16) * 2048 + col0 + bj * HALF) = w;
                    } else { v0 = v0 * sc; v1 = v1 * sc;
                        u32x4 w; w.x = cvt_pk_bf16(v0[0], v0[1]); w.y = cvt_pk_bf16(v0[2], v0[3]); w.z = cvt_pk_bf16(v1[0], v1[1]); w.w = cvt_pk_bf16(v1[2], v1[3]);
                        *(u32x4*)(rowp + bj * HALF) = w; } } }
    }
};
template <int PASS> struct EpiMergeF {
    static constexpr bool PERM = true, AFTER_DRAIN = false, MIDK = false;
    const unsigned char* gates; bf16_t* merged;
    __device__ __forceinline__ void operator()(const f32x4 (&acc)[2][2][4][2], const Unit& u, int wr, int wc, int fr, int fq) const {
        const int row0 = u.pm * BM + wr * 64 + fr, col0 = u.pn * BM + wc * 32 + 8 * fq;
#pragma unroll
        for (int ai = 0; ai < 2; ++ai)
#pragma unroll
            for (int m = 0; m < 4; ++m) { const size_t r = (size_t)(row0 + ai * HALF + m * 16);
#pragma unroll
                for (int bj = 0; bj < 2; ++bj) { const int c = col0 + bj * HALF;
                    const uint2 g = *(const uint2*)(gates + r * 2048 + PASS * 1024 + c);
                    f32x4 v0 = acc[ai][bj][m][0] * (1.0f / 255.0f), v1 = acc[ai][bj][m][1] * (1.0f / 255.0f);
                    v0[0] *= (float)(g.x & 255u); v0[1] *= (float)((g.x >> 8) & 255u); v0[2] *= (float)((g.x >> 16) & 255u); v0[3] *= (float)(g.x >> 24);
                    v1[0] *= (float)(g.y & 255u); v1[1] *= (float)((g.y >> 8) & 255u); v1[2] *= (float)((g.y >> 16) & 255u); v1[3] *= (float)(g.y >> 24);
                    if (PASS == 1) { const u32x4 o = *(const u32x4*)(merged + r * 1024 + c);
                        v0[0] += lo_bf(o.x); v0[1] += hi_bf(o.x); v0[2] += lo_bf(o.y); v0[3] += hi_bf(o.y);
                        v1[0] += lo_bf(o.z); v1[1] += hi_bf(o.z); v1[2] += lo_bf(o.w); v1[3] += hi_bf(o.w); }
                    u32x4 w; w.x = cvt_pk_bf16(v0[0], v0[1]); w.y = cvt_pk_bf16(v0[2], v0[3]); w.z = cvt_pk_bf16(v1[0], v1[1]); w.w = cvt_pk_bf16(v1[2], v1[3]);
                    *(u32x4*)(merged + r * 1024 + c) = w; } }
    }
};
struct EpiMergeFusedF {
    static constexpr bool PERM = true, AFTER_DRAIN = false, MIDK = true;
    const unsigned char* gates; bf16_t* merged;
    __device__ __forceinline__ void midk(f32x4 (&acc)[2][2][4][2], const Unit& u, int wr, int wc, int fr, int fq) const {
        asm volatile("" : "+v"(fr), "+v"(fq));
        const int row0 = u.pm * BM + wr * 64 + fr, col0 = u.pn * BM + wc * 32 + 8 * fq;
#pragma unroll
        for (int ai = 0; ai < 2; ++ai)
#pragma unroll
            for (int m = 0; m < 4; ++m) { const size_t r = (size_t)(row0 + ai * HALF + m * 16);
#pragma unroll
                for (int bj = 0; bj < 2; ++bj) { const int c = col0 + bj * HALF;
                    const uint2 g0 = *(const uint2*)(gates + r * 2048 + c), g1 = *(const uint2*)(gates + r * 2048 + 1024 + c);
#pragma unroll
                    for (int e = 0; e < 4; ++e) {
                        const float a0 = (float)((g0.x >> (8 * e)) & 255u), b0 = fmaxf((float)((g1.x >> (8 * e)) & 255u), 1.0f);
                        const float a1 = (float)((g0.y >> (8 * e)) & 255u), b1 = fmaxf((float)((g1.y >> (8 * e)) & 255u), 1.0f);
                        acc[ai][bj][m][0][e] *= a0 * __builtin_amdgcn_rcpf(b0); acc[ai][bj][m][1][e] *= a1 * __builtin_amdgcn_rcpf(b1); }
                    asm volatile("" ::: "memory"); } }
    }
    __device__ __forceinline__ void operator()(const f32x4 (&acc)[2][2][4][2], const Unit& u, int wr, int wc, int fr, int fq) const {
        const int row0 = u.pm * BM + wr * 64 + fr, col0 = u.pn * BM + wc * 32 + 8 * fq;
#pragma unroll
        for (int ai = 0; ai < 2; ++ai)
#pragma unroll
            for (int m = 0; m < 4; ++m) { const size_t r = (size_t)(row0 + ai * HALF + m * 16);
#pragma unroll
                for (int bj = 0; bj < 2; ++bj) { const int c = col0 + bj * HALF;
                    const uint2 g1 = *(const uint2*)(gates + r * 2048 + 1024 + c);
                    f32x4 v0 = acc[ai][bj][m][0] * (1.0f / 255.0f), v1 = acc[ai][bj][m][1] * (1.0f / 255.0f);
#pragma unroll
                    for (int e = 0; e < 4; ++e) { v0[e] *= fmaxf((float)((g1.x >> (8 * e)) & 255u), 1.0f); v1[e] *= fmaxf((float)((g1.y >> (8 * e)) & 255u), 1.0f); }
                    u32x4 w; w.x = cvt_pk_bf16(v0[0], v0[1]); w.y = cvt_pk_bf16(v0[2], v0[3]); w.z = cvt_pk_bf16(v1[0], v1[1]); w.w = cvt_pk_bf16(v1[2], v1[3]);
                    *(u32x4*)(merged + r * 1024 + c) = w; } }
    }
};
struct EpiCmpOutF {
    static constexpr bool PERM = true, AFTER_DRAIN = false, MIDK = false;
    bf16_t* dst;
    __device__ __forceinline__ void operator()(const f32x4 (&acc)[2][2][4][2], const Unit& u, int wr, int wc, int fr, int fq) const {
        if (wc >= 2) return;
        const int row0 = u.pm * BM + wr * 64 + fr, col0 = wc * 32 + 8 * fq;
#pragma unroll
        for (int ai = 0; ai < 2; ++ai)
#pragma unroll
            for (int m = 0; m < 4; ++m) { const int r = row0 + ai * HALF + m * 16;
                if (r < BATCH * NC * 2) { const int g = r & 1, bc = r >> 1, b = bc / NC, c = bc % NC;
                    const f32x4 v0 = acc[ai][0][m][0], v1 = acc[ai][0][m][1];
                    u32x4 w; w.x = cvt_pk_bf16(v0[0], v0[1]); w.y = cvt_pk_bf16(v0[2], v0[3]); w.z = cvt_pk_bf16(v1[0], v1[1]); w.w = cvt_pk_bf16(v1[2], v1[3]);
                    *(u32x4*)(dst + ((size_t)(b * 2 + g) * 128 + c) * 64 + col0) = w; } }
    }
};
struct EpiSlabF {
    static constexpr bool PERM = false, AFTER_DRAIN = false, MIDK = false;
    float* slab;
    __device__ __forceinline__ void operator()(const f32x4 (&acc)[2][2][4][2], const Unit& u, int wr, int wc, int fr, int fq) const {
        const int row0 = u.pm * BM + wr * 64 + fr, col0 = wc * 32 + 4 * fq;
        float* base = slab + (size_t)u.pn * 2048 * 256;
#pragma unroll
        for (int ai = 0; ai < 2; ++ai)
#pragma unroll
            for (int m = 0; m < 4; ++m) { float* rowp = base + (size_t)(row0 + ai * HALF + m * 16) * 256 + col0;
#pragma unroll
                for (int bj = 0; bj < 2; ++bj)
#pragma unroll
                    for (int n = 0; n < 2; ++n) *(f32x4*)(rowp + bj * HALF + n * 16) = acc[ai][bj][m][n]; }
    }
};
struct EpiResidF {
    static constexpr bool PERM = false, AFTER_DRAIN = false, MIDK = false;
    const float* x; float* h;
    __device__ __forceinline__ void operator()(const f32x4 (&acc)[2][2][4][2], const Unit& u, int wr, int wc, int fr, int fq) const {
        const int row0 = u.pm * BM + wr * 64 + fr, col0 = u.pn * BM + wc * 32 + 4 * fq;
#pragma unroll
        for (int ai = 0; ai < 2; ++ai)
#pragma unroll
            for (int m = 0; m < 4; ++m) { const size_t off = (size_t)(row0 + ai * HALF + m * 16) * 1024 + col0;
#pragma unroll
                for (int bj = 0; bj < 2; ++bj)
#pragma unroll
                    for (int n = 0; n < 2; ++n) { const f32x4 xv = *(const f32x4*)(x + off + bj * HALF + n * 16); *(f32x4*)(h + off + bj * HALF + n * 16) = xv + acc[ai][bj][m][n]; } }
    }
};
struct EpiMlaQF {
    static constexpr bool PERM = false, AFTER_DRAIN = false, MIDK = false;
    bf16_t* q; const float2* cs;
    __device__ __forceinline__ void operator()(const f32x4 (&acc)[2][2][4][2], const Unit& u, int wr, int wc, int fr, int fq) const {
        const int row0 = u.pm * BM + wr * 64 + fr;
#pragma unroll
        for (int bj = 0; bj < 2; ++bj) {
            const int X = u.pn * BM + bj * HALF + wc * 32;
            const bool rope = (X % 96) == 64;
#pragma unroll
            for (int ai = 0; ai < 2; ++ai)
#pragma unroll
                for (int m = 0; m < 4; ++m) { const int r = row0 + ai * HALF + m * 16; const int pos = r & (SEQ - 1);
                    f32x4 v0 = acc[ai][bj][m][0], v1 = acc[ai][bj][m][1];
                    if (rope) {
#pragma unroll
                        for (int j = 0; j < 4; ++j) { const float2 c = cs[pos * 16 + 4 * fq + j]; const float x1 = v0[j], x2 = v1[j]; v0[j] = x1 * c.x - x2 * c.y; v1[j] = x2 * c.x + x1 * c.y; } }
                    v0 = v0 * QS_MLA; v1 = v1 * QS_MLA;
                    bf16_t* p = q + (size_t)r * 768 + X + 4 * fq;
                    uint2 w0, w1; w0.x = cvt_pk_bf16(v0[0], v0[1]); w0.y = cvt_pk_bf16(v0[2], v0[3]); w1.x = cvt_pk_bf16(v1[0], v1[1]); w1.y = cvt_pk_bf16(v1[2], v1[3]);
                    *(uint2*)p = w0; *(uint2*)(p + 16) = w1; }
        }
    }
};
}

#define PG8_SP2 true
#define PG8_ALIGN true
constexpr int NTHR = 512, NWV = NTHR / 64;
#define WAVE_IDS const int lane = threadIdx.x & 63, wv = threadIdx.x >> 6; const int gw = blockIdx.x * NWV + wv, nw = gridDim.x * NWV; (void)lane; (void)gw; (void)nw;

template <bool Q8> DEV void ph_rms1024(const float* __restrict__ src, const float* __restrict__ g, bf16_t* __restrict__ dst, int rows, unsigned* __restrict__ q8 = nullptr, float* __restrict__ qs = nullptr, int gw_o = -1, int nw_o = 0, const bf16_t* __restrict__ add = nullptr) {
  const int lane = threadIdx.x & 63; const int gw = (gw_o >= 0) ? gw_o : (int)(blockIdx.x * NWV + (threadIdx.x >> 6)); const int nw = (gw_o >= 0) ? nw_o : (int)(gridDim.x * NWV);
  float4 gg[4];
#pragma unroll
  for (int j = 0; j < 4; ++j) gg[j] = ((const float4*)g)[j * 64 + lane];
  float4 nx[4]; uint2 na[4];
  if (gw < rows) {
#pragma unroll
    for (int j = 0; j < 4; ++j) { nx[j] = ((const float4*)(src + (size_t)gw * 1024))[j * 64 + lane]; if (add) na[j] = ((const uint2*)(add + (size_t)gw * 1024))[j * 64 + lane]; } }
  for (int r = gw; r < rows; r += nw) {
    float4 v[4]; float ss = 0.f;
#pragma unroll
    for (int j = 0; j < 4; ++j) { v[j] = nx[j];
      if (add) { v[j].x += __uint_as_float(na[j].x << 16); v[j].y += __uint_as_float(na[j].x & 0xffff0000u); v[j].z += __uint_as_float(na[j].y << 16); v[j].w += __uint_as_float(na[j].y & 0xffff0000u); }
      ss += v[j].x * v[j].x + v[j].y * v[j].y + v[j].z * v[j].z + v[j].w * v[j].w; }
    if (r + nw < rows) {
#pragma unroll
      for (int j = 0; j < 4; ++j) { nx[j] = ((const float4*)(src + (size_t)(r + nw) * 1024))[j * 64 + lane]; if (add) na[j] = ((const uint2*)(add + (size_t)(r + nw) * 1024))[j * 64 + lane]; } }
    ss = wsum(ss);
    const float inv = rsqrtf(ss * (1.0f / 1024.0f) + 1e-6f);
    float mx = 0.f;
#pragma unroll
    for (int j = 0; j < 4; ++j) {
      v[j].x *= inv * gg[j].x; v[j].y *= inv * gg[j].y; v[j].z *= inv * gg[j].z; v[j].w *= inv * gg[j].w;
      uint2 o;
      o.x = (unsigned)f2bf(v[j].x) | ((unsigned)f2bf(v[j].y) << 16);
      o.y = (unsigned)f2bf(v[j].z) | ((unsigned)f2bf(v[j].w) << 16);
      ((uint2*)(dst + (size_t)r * 1024))[j * 64 + lane] = o;
      if (Q8) mx = fmaxf(mx, fmaxf(fmaxf(fabsf(v[j].x), fabsf(v[j].y)), fmaxf(fabsf(v[j].z), fabsf(v[j].w))));
    }
    if (Q8) {
      mx = wmaxf(mx);
      const float sc = fmaxf(mx, 1e-30f) * (1.0f / 127.0f), isc = 1.0f / sc;
#pragma unroll
      for (int j = 0; j < 4; ++j) {
        const int q0 = (int)rintf(v[j].x * isc), q1 = (int)rintf(v[j].y * isc), q2 = (int)rintf(v[j].z * isc), q3 = (int)rintf(v[j].w * isc);
        q8[(size_t)r * 256 + j * 64 + lane] = (unsigned)(q0 & 255) | ((unsigned)(q1 & 255) << 8) | ((unsigned)(q2 & 255) << 16) | ((unsigned)(q3 & 255) << 24);
      }
      if (lane == 0) qs[r] = sc;
    }
  }
}
DEV int win_src_col(int n) {
  if (n < 1280) return n;
  if (n < 1536) return 1304 + (n - 1280);
  if (n < 1664) return 1560 + (n - 1536);
  if (n < 1696) return 1688 + (n - 1664);
  if (n < 1720) return 1280 + (n - 1696);
  if (n < 1792) return -1;
  return 1720 + (n - 1792);
}
template <int MODE> DEV void tr_item(const float* __restrict__ W, int K, int Nsrc, bf16_t* __restrict__ WT, int Nblk, int Nvalid, __attribute__((address_space(3))) float* scr, int item, int lane, int pitch = 0, int koff = 0) {
  if (pitch == 0) pitch = K;
  const int kb = item / Nblk, nb = item % Nblk, k0 = 64 * kb, n0 = 32 * nb;
  const int n = n0 + (lane & 31);
  const int sc = (MODE == 1) ? win_src_col(n) : ((n < Nvalid) ? n : -1);
  float tv[32];
#pragma unroll
  for (int i = 0; i < 32; ++i) { const int kk = 2 * i + (lane >> 5); tv[i] = (sc >= 0) ? W[(size_t)(k0 + kk) * Nsrc + sc] : 0.f; }
#pragma unroll
  for (int i = 0; i < 32; ++i) { const int kk = 2 * i + (lane >> 5); scr[kk * 33 + (lane & 31)] = tv[i]; }
  asm volatile("s_waitcnt lgkmcnt(0)" ::: "memory");
  const int c = lane & 7;
#pragma unroll
  for (int j = 0; j < 4; ++j) { const int nn = (lane >> 3) + 8 * j; const __attribute__((address_space(3))) float* sp = scr + (8 * c) * 33 + nn;
    uint4 o;
    o.x = (unsigned)f2bf(sp[0 * 33]) | ((unsigned)f2bf(sp[1 * 33]) << 16); o.y = (unsigned)f2bf(sp[2 * 33]) | ((unsigned)f2bf(sp[3 * 33]) << 16);
    o.z = (unsigned)f2bf(sp[4 * 33]) | ((unsigned)f2bf(sp[5 * 33]) << 16); o.w = (unsigned)f2bf(sp[6 * 33]) | ((unsigned)f2bf(sp[7 * 33]) << 16);
    *(uint4*)(WT + (size_t)(n0 + nn) * pitch + koff + k0 + 8 * c) = o; }
  asm volatile("s_waitcnt lgkmcnt(0)" ::: "memory");
}
DEV void rope_entry(float2* __restrict__ cs, int i) {
  const int j = i & 15, pos = i >> 4;
  const float inv_freq = __builtin_amdgcn_exp2f(-(float)(2 * j) * (13.287712379549449f / 32.0f));
  const float rev = (float)pos * inv_freq * 0.15915494309189535f;
  const float fr = rev - floorf(rev);
  cs[i] = make_float2(__builtin_amdgcn_cosf(fr), __builtin_amdgcn_sinf(fr));
}
namespace att {
#define LAS3 __attribute__((address_space(3)))
typedef LAS3 char* lptr;
typedef LAS3 const char* lcptr;
using bf16x8 = __attribute__((ext_vector_type(8))) short;
using s16x4 = __attribute__((ext_vector_type(4))) short;
using f32x16 = __attribute__((ext_vector_type(16))) float;
typedef short v4i16_t __attribute__((ext_vector_type(4)));
typedef unsigned u32x4 __attribute__((ext_vector_type(4)));
typedef float f32x4_t __attribute__((ext_vector_type(4)));
typedef float f32x2_t __attribute__((ext_vector_type(2)));
typedef __bf16 bf16x2_t __attribute__((ext_vector_type(2)));
constexpr float LOG2E = 1.4426950408889634f;
constexpr float THR = 8.0f;
constexpr float NEG_INF = -__builtin_huge_valf();
constexpr int SLOT = 20480, KOFF = 0, VOFF = 12288;
constexpr int L_WSF = 2 * SLOT;
constexpr int L_TB = L_WSF + 2048;
constexpr int L_ST = L_TB + 8 * 320 * 4;
constexpr int L_SELM = L_ST + 768;
constexpr int L_SC = L_SELM + 256;
constexpr int L_IMPQ = L_SC + 64 * 33 * 4;
constexpr int L_IMPL = L_IMPQ + 4 * 64 * 33 * 4;
constexpr int L_FIN = L_IMPQ;
constexpr int L_END = L_IMPL + 4 * 64 * 33 * 4;
static_assert(L_END <= 131072, "attention LDS map");

__device__ __forceinline__ int crow(int r, int hi) { return (r & 3) + 8 * (r >> 2) + 4 * hi; }
__device__ __forceinline__ s16x4 vtr(lcptr p) { return __builtin_bit_cast(s16x4, __builtin_amdgcn_ds_read_tr16_b64_v4i16((LAS3 v4i16_t*)p)); }
__device__ __forceinline__ unsigned cvtpk(float lo, float hi) { f32x2_t v = {lo, hi}; bf16x2_t b = __builtin_convertvector(v, bf16x2_t); return __builtin_bit_cast(unsigned, b); }
__device__ __forceinline__ float xmax(float v) { auto rr = __builtin_amdgcn_permlane32_swap(__float_as_uint(v), __float_as_uint(v), false, false); return fmaxf(__uint_as_float(rr[0]), __uint_as_float(rr[1])); }
__device__ __forceinline__ float xsum(float v) { auto rr = __builtin_amdgcn_permlane32_swap(__float_as_uint(v), __float_as_uint(v), false, false); return __uint_as_float(rr[0]) + __uint_as_float(rr[1]); }
__device__ __forceinline__ float ex2(float x) { return __builtin_amdgcn_exp2f(x); }

template <int ND0> __device__ __forceinline__ void qkt(f32x16& p0, f32x16& p1, lcptr kb, const bf16x8* qr) {
  p0 = f32x16{}; p1 = f32x16{};
  __builtin_amdgcn_s_setprio(1);
#pragma unroll
  for (int d0 = 0; d0 < ND0; ++d0) {
    const bf16x8 b0 = *(const LAS3 bf16x8*)(kb + d0 * 2048);
    const bf16x8 b1 = *(const LAS3 bf16x8*)(kb + d0 * 2048 + 512);
    p0 = __builtin_amdgcn_mfma_f32_32x32x16_bf16(b0, qr[d0], p0, 0, 0, 0);
    p1 = __builtin_amdgcn_mfma_f32_32x32x16_bf16(b1, qr[d0], p1, 0, 0, 0);
  }
  __builtin_amdgcn_s_setprio(0);
}
template <int ND0> __device__ __forceinline__ void qkt_init(f32x16& p0, f32x16& p1, lcptr kb, const bf16x8* qr, const f32x16& c0, const f32x16& c1) {
  p0 = c0; p1 = c1;
  __builtin_amdgcn_s_setprio(1);
#pragma unroll
  for (int d0 = 0; d0 < ND0; ++d0) {
    const bf16x8 b0 = *(const LAS3 bf16x8*)(kb + d0 * 2048);
    const bf16x8 b1 = *(const LAS3 bf16x8*)(kb + d0 * 2048 + 512);
    p0 = __builtin_amdgcn_mfma_f32_32x32x16_bf16(b0, qr[d0], p0, 0, 0, 0);
    p1 = __builtin_amdgcn_mfma_f32_32x32x16_bf16(b1, qr[d0], p1, 0, 0, 0);
  }
  __builtin_amdgcn_s_setprio(0);
}
__device__ __forceinline__ void pv(f32x16 (&o)[2], lcptr vp, const unsigned (&pw)[16]) {
  __builtin_amdgcn_s_setprio(1);
#pragma unroll
  for (int d0 = 0; d0 < 2; ++d0)
#pragma unroll
    for (int ks = 0; ks < 4; ++ks) {
      const s16x4 lo = vtr(vp + d0 * 4096 + ks * 1024), hi4 = vtr(vp + d0 * 4096 + ks * 1024 + 512);
      const bf16x8 vf = {lo[0], lo[1], lo[2], lo[3], hi4[0], hi4[1], hi4[2], hi4[3]};
      const unsigned pa4[4] = {pw[4 * ks], pw[4 * ks + 1], pw[4 * ks + 2], pw[4 * ks + 3]};
      o[d0] = __builtin_amdgcn_mfma_f32_32x32x16_bf16(__builtin_bit_cast(bf16x8, pa4), vf, o[d0], 0, 0, 0);
    }
  __builtin_amdgcn_s_setprio(0);
}
__device__ __forceinline__ void softmax_step(f32x16& p0, f32x16& p1, float& m, float& l, f32x16 (&o)[2], LAS3 float* wsf, int r32, int hi, unsigned (&pw)[16]) {
  float rm = fmaxf(p0[0], p1[0]);
#pragma unroll
  for (int r = 1; r < 16; ++r) rm = fmaxf(rm, fmaxf(p0[r], p1[r]));
  rm = xmax(rm);
  if (__any(rm > m + THR)) {
    const float mn = fmaxf(m, rm);
    const float al = ex2(m - mn);
    m = mn; l *= al;
    if (hi == 0) wsf[r32] = al;
#pragma unroll
    for (int r = 0; r < 16; ++r) { const float f = wsf[crow(r, hi)]; o[0][r] *= f; o[1][r] *= f; }
  }
  float s = 0.f;
#pragma unroll
  for (int r = 0; r < 16; ++r) { p0[r] = ex2(p0[r] - m); p1[r] = ex2(p1[r] - m); s += p0[r] + p1[r]; }
  l += s;
#pragma unroll
  for (int i = 0; i < 8; ++i) { pw[i] = cvtpk(p0[2 * i], p0[2 * i + 1]); pw[8 + i] = cvtpk(p1[2 * i], p1[2 * i + 1]); }
}
struct KVSrc { const bf16_t* k; const bf16_t* v; int ldk, ldv; };
__device__ __forceinline__ void kv_issue(const KVSrc& s, int row0, u32x4& rk, u32x4& rv, int tid) {
  const int kv = tid & 63, ch = tid >> 6, ln = tid & 63;
  rk = *(const u32x4*)(s.k + (size_t)(row0 + kv) * s.ldk + ch * 8);
  rv = *(const u32x4*)(s.v + (size_t)(row0 + 16 * (ch & 3) + (ln >> 2)) * s.ldv + (ch >> 2) * 32 + (ln & 3) * 8);
}
__device__ __forceinline__ void kv_commit(lptr slot, const u32x4& rk, const u32x4& rv, int tid) {
  *(LAS3 u32x4*)(slot + KOFF + (tid >> 6) * 1024 + (tid & 63) * 16) = rk;
  *(LAS3 u32x4*)(slot + VOFF + tid * 16) = rv;
}
__device__ __forceinline__ void fin_set(LAS3 float* finl, const f32x16 (&o)[2], int lane) {
#pragma unroll
  for (int d0 = 0; d0 < 2; ++d0)
#pragma unroll
    for (int r = 0; r < 16; ++r) finl[(d0 * 16 + r) * 64 + lane] = o[d0][r];
}
__device__ __forceinline__ void fin_add(LAS3 float* finl, const f32x16 (&o)[2], const LAS3 float* wsf, int lane, int hi) {
#pragma unroll
  for (int r = 0; r < 16; ++r) { const float f = wsf[crow(r, hi)];
#pragma unroll
    for (int d0 = 0; d0 < 2; ++d0) finl[(d0 * 16 + r) * 64 + lane] += o[d0][r] * f; }
}
__device__ __forceinline__ void fin_store(const LAS3 float* finl, bf16_t* gout, size_t rowbase, int ld, int colbase, int lane) {
#pragma unroll
  for (int i = 0; i < 4; ++i) {
    const int q = i * 8 + (lane >> 3), ch = lane & 7;
    const int qh = (q >> 2) & 1, r = (q & 3) + 4 * (q >> 3), d0 = ch >> 2, dl = (ch & 3) * 8;
    const LAS3 float* p = finl + (d0 * 16 + r) * 64 + qh * 32 + dl;
    const f32x4_t x0 = *(const LAS3 f32x4_t*)p, x1 = *(const LAS3 f32x4_t*)(p + 4);
    u32x4 v; v.x = cvtpk(x0[0], x0[1]); v.y = cvtpk(x0[2], x0[3]); v.z = cvtpk(x1[0], x1[1]); v.w = cvtpk(x1[2], x1[3]);
    *(u32x4*)(gout + (rowbase + q) * (size_t)ld + colbase + ch * 8) = v;
  }
}

__device__ __forceinline__ void nsa_unit(int b, int g, int c, const bf16_t* __restrict__ proj, const bf16_t* __restrict__ kc, const bf16_t* __restrict__ vc, bf16_t* __restrict__ onsa, lptr lds) {
  int tid = threadIdx.x; asm volatile("" : "+v"(tid));
  const int lane = tid & 63, r32 = lane & 31, hi = lane >> 5;
  const int w = __builtin_amdgcn_readfirstlane(tid >> 6);
  const int rh = w >> 1, head = g * 4 + rh, tokl = 32 * (w & 1) + r32, t = 64 * c + tokl, bg = b * 2 + g;
  const size_t tok = (size_t)b * SEQ + t;
  LAS3 float* wsf = (LAS3 float*)(lds + L_WSF) + w * 64;
  const LAS3 float* tb = (const LAS3 float*)(lds + L_TB) + head * 320 + 64;
  const LAS3 float* stp = (const LAS3 float*)(lds + L_ST);
  LAS3 unsigned* selm = (LAS3 unsigned*)(lds + L_SELM);
  LAS3 float* sc = (LAS3 float*)(lds + L_SC);
  LAS3 float* impq = (LAS3 float*)(lds + L_IMPQ);
  LAS3 float* impl = (LAS3 float*)(lds + L_IMPL);
  const lcptr kb0 = (lcptr)lds + KOFF + hi * 1024 + r32 * 16;
  const lcptr vp0 = (lcptr)lds + VOFF + ((lane >> 4) & 1) * 32 + (lane & 3) * 8 + (4 * hi + ((lane & 15) >> 2)) * 64;
  bf16x8 qr[4];
#pragma unroll
  for (int d0 = 0; d0 < 4; ++d0) qr[d0] = *(const bf16x8*)(proj + tok * PROJ_LD + PC_Q + head * 64 + d0 * 16 + hi * 8);
  float gate[3];
#pragma unroll
  for (int j = 0; j < 3; ++j) gate[j] = 1.0f / (1.0f + ex2(-LOG2E * bf2f(proj[tok * PROJ_LD + PC_GATE + head * 3 + j])));
  LAS3 float* finl = (LAS3 float*)(lds + L_FIN) + w * 2048;
  f32x16 o[2]; unsigned pw[16];
  u32x4 rk, rv;
  {
    const KVSrc src{kc + (size_t)bg * 128 * 64, vc + (size_t)bg * 128 * 64, 64, 64};
    __syncthreads();
    kv_issue(src, 0, rk, rv, tid); kv_commit(lds, rk, rv, tid);
    kv_issue(src, 64, rk, rv, tid); kv_commit(lds + SLOT, rk, rv, tid);
    __syncthreads();
    f32x16 a0, a1, b0, b1;
    const int twmin = 64 * c + 32 * (w & 1), twmax = twmin + 31;
    const bool live0 = true, live1 = (16 * 32 + 31 <= twmax), live2 = (16 * 64 + 31 <= twmax), live3 = (16 * 96 + 31 <= twmax);
    qkt<4>(a0, a1, kb0, qr);
    if (live2) qkt<4>(b0, b1, kb0 + SLOT, qr); else { b0 = f32x16{}; b1 = f32x16{}; }
    float rm = NEG_INF;
#define CMP_QUARTER(P, QTR, LIVE) do { if (LIVE) { \
      if (!(16 * (32 * (QTR) + 31) + 31 + 112 < twmin)) { \
        _Pragma("unroll") for (int r = 0; r < 16; ++r) { int d_ = t - 16 * (32 * (QTR) + crow(r, hi)) - 31; d_ = d_ < -64 ? -64 : (d_ > 255 ? 255 : d_); P[r] += tb[d_]; } } \
      _Pragma("unroll") for (int r = 0; r < 16; ++r) rm = fmaxf(rm, P[r]); } } while (0)
    CMP_QUARTER(a0, 0, live0); CMP_QUARTER(a1, 1, live1); CMP_QUARTER(b0, 2, live2); CMP_QUARTER(b1, 3, live3);
#undef CMP_QUARTER
    rm = xmax(rm);
    const float mref = (rm == NEG_INF) ? 0.f : rm;
    float s = 0.f;
#define CMP_EXP(P, LIVE) do { if (LIVE) { _Pragma("unroll") for (int r = 0; r < 16; ++r) { P[r] = ex2(P[r] - mref); s += P[r]; } } else { _Pragma("unroll") for (int r = 0; r < 16; ++r) P[r] = 0.f; } } while (0)
    CMP_EXP(a0, live0); CMP_EXP(a1, live1); CMP_EXP(b0, live2); CMP_EXP(b1, live3);
#undef CMP_EXP
    s = xsum(s);
    const float inv = (s > 0.f) ? 1.0f / s : 0.f;
#pragma unroll
    for (int r = 0; r < 16; ++r) { a0[r] *= inv; a1[r] *= inv; b0[r] *= inv; b1[r] *= inv; }
    { LAS3 float* iq = impq + (rh * 64 + tokl) * 33; LAS3 float* il = impl + (rh * 64 + tokl) * 33;
#pragma unroll
      for (int q4 = 0; q4 < 4; ++q4) {
        const int gi = 2 * q4 + hi;
        iq[gi] = (a0[4 * q4] + a0[4 * q4 + 1]) + (a0[4 * q4 + 2] + a0[4 * q4 + 3]);           il[gi] = a0[4 * q4 + 3];
        iq[8 + gi] = (a1[4 * q4] + a1[4 * q4 + 1]) + (a1[4 * q4 + 2] + a1[4 * q4 + 3]);       il[8 + gi] = a1[4 * q4 + 3];
        iq[16 + gi] = (b0[4 * q4] + b0[4 * q4 + 1]) + (b0[4 * q4 + 2] + b0[4 * q4 + 3]);      il[16 + gi] = b0[4 * q4 + 3];
        iq[24 + gi] = (b1[4 * q4] + b1[4 * q4 + 1]) + (b1[4 * q4 + 2] + b1[4 * q4 + 3]);      il[24 + gi] = b1[4 * q4 + 3];
      } }
    o[0] = f32x16{}; o[1] = f32x16{};
#pragma unroll
    for (int i = 0; i < 8; ++i) { pw[i] = cvtpk(a0[2 * i], a0[2 * i + 1]); pw[8 + i] = cvtpk(a1[2 * i], a1[2 * i + 1]); }
    pv(o, vp0, pw);
    if (live2) {
#pragma unroll
      for (int i = 0; i < 8; ++i) { pw[i] = cvtpk(b0[2 * i], b0[2 * i + 1]); pw[8 + i] = cvtpk(b1[2 * i], b1[2 * i + 1]); }
      pv(o, vp0 + SLOT, pw); }
    if (hi == 0) wsf[r32] = gate[0];
#pragma unroll
    for (int r = 0; r < 16; ++r) { const float f = wsf[crow(r, hi)]; o[0][r] *= f; o[1][r] *= f; }
  }
  __syncthreads();
  const KVSrc ssrc{proj + (size_t)b * SEQ * PROJ_LD + PC_KV + 2 * 128 + g * 64, proj + (size_t)b * SEQ * PROJ_LD + PC_KV + 3 * 128 + g * 64, PROJ_LD, PROJ_LD};
  kv_issue(ssrc, 0, rk, rv, tid);
  {
    const int stok = tid >> 3, sub = tid & 7;
#pragma unroll
    for (int k = 0; k < 4; ++k) {
      const int n = sub * 4 + k;
      float imp = 0.f;
#pragma unroll
      for (int hh = 0; hh < 4; ++hh) imp += impq[(hh * 64 + stok) * 33 + n] + ((n > 0) ? impl[(hh * 64 + stok) * 33 + n - 1] : 0.f);
      sc[stok * 33 + n] = (n > c) ? -1.0f : ((n == 0 || n == c || n == c - 1) ? 1e4f : imp);
    }
    if (tid < 64) selm[tid] = 0u;
    __syncthreads();
    float srow[32];
#pragma unroll
    for (int mm = 0; mm < 32; ++mm) srow[mm] = sc[stok * 33 + mm];
    unsigned bits = 0u;
#pragma unroll
    for (int k = 0; k < 4; ++k) {
      const int n = sub * 4 + k; const float sv = sc[stok * 33 + n]; int rank = 0;
#pragma unroll
      for (int mm = 0; mm < 32; ++mm) rank += (srow[mm] > sv || (srow[mm] == sv && mm < n)) ? 1 : 0;
      if (rank < 16) bits |= 1u << n;
    }
    if (bits) atomicOr((unsigned*)(selm + stok), bits);
    __syncthreads();
  }
  const unsigned mysel = selm[tokl];
  fin_set(finl, o, lane);
#pragma unroll 1
  for (int br = 0; br < 2; ++br) {
    const KVSrc src = (br == 0) ? ssrc : KVSrc{proj + (size_t)b * SEQ * PROJ_LD + PC_KV + 4 * 128 + g * 64, proj + (size_t)b * SEQ * PROJ_LD + PC_KV + 5 * 128 + g * 64, PROJ_LD, PROJ_LD};
    const int n0 = (br == 0) ? 0 : ((c > 8) ? c - 8 : 0);
    if (br == 1) { __syncthreads(); kv_issue(src, n0 * 64, rk, rv, tid); }
    kv_commit(lds, rk, rv, tid);
    float m = -1e30f, l = 0.f;
    o[0] = f32x16{}; o[1] = f32x16{};
    int cur = 0;
#pragma unroll 1
    for (int n = n0; n <= c; ++n) {
      __syncthreads();
      if (n < c) kv_issue(src, (n + 1) * 64, rk, rv, tid);
      const bool mine = (br == 1) || ((mysel >> n) & 1u);
      if (__any(mine)) {
        f32x16 p0, p1;
        if (n + 2 >= c) {
          const LAS3 float* bp = tb + (t - 64 * n) - 4 * hi - 63;
          f32x16 c0, c1;
#pragma unroll
          for (int r = 0; r < 16; ++r) { c0[r] = bp[63 - ((r & 3) + 8 * (r >> 2))]; c1[r] = bp[31 - ((r & 3) + 8 * (r >> 2))]; }
          qkt_init<4>(p0, p1, kb0 + cur * SLOT, qr, c0, c1);
        } else if (br == 1 && n + 8 == c) {
          const LAS3 float* bp = stp + (607 - (t - 64 * n)) + 4 * hi;
          f32x16 c0, c1;
#pragma unroll
          for (int r = 0; r < 16; ++r) { c0[r] = bp[(r & 3) + 8 * (r >> 2)]; c1[r] = bp[32 + (r & 3) + 8 * (r >> 2)]; }
          qkt_init<4>(p0, p1, kb0 + cur * SLOT, qr, c0, c1);
        } else qkt<4>(p0, p1, kb0 + cur * SLOT, qr);
        if (!mine) {
#pragma unroll
          for (int r = 0; r < 16; ++r) { p0[r] = NEG_INF; p1[r] = NEG_INF; } }
        softmax_step(p0, p1, m, l, o, wsf, r32, hi, pw);
        pv(o, vp0 + cur * SLOT, pw);
      }
      if (n < c) kv_commit(lds + (cur ^ 1) * SLOT, rk, rv, tid);
      cur ^= 1;
    }
    l = xsum(l);
    const float gi = gate[1 + br] / fmaxf(l, 1e-30f);
    if (hi == 0) wsf[r32] = gi;
    fin_add(finl, o, wsf, lane, hi);
  }
  fin_store(finl, onsa, (size_t)b * SEQ + 64 * c + 32 * (w & 1), 1024, head * 64, lane);
}

__device__ __forceinline__ void mla_unit(int b, int h, int qb, const bf16_t* __restrict__ mq, const bf16_t* __restrict__ mkv, const bf16_t* __restrict__ kr, bf16_t* __restrict__ omla, lptr lds) {
  int tid = threadIdx.x; asm volatile("" : "+v"(tid));
  const int lane = tid & 63, r32 = lane & 31, hi = lane >> 5;
  const int w = __builtin_amdgcn_readfirstlane(tid >> 6);
  const int q0 = 256 * qb, qw = q0 + 32 * w, qpos = qw + r32;
  const size_t tokq = (size_t)b * SEQ + qpos;
  LAS3 float* wsf = (LAS3 float*)(lds + L_WSF) + w * 64;
  const lcptr kb0 = (lcptr)lds + KOFF + hi * 1024 + r32 * 16;
  const lcptr vp0 = (lcptr)lds + VOFF + ((lane >> 4) & 1) * 32 + (lane & 3) * 8 + (4 * hi + ((lane & 15) >> 2)) * 64;
  const LAS3 float* stp = (const LAS3 float*)(lds + L_ST);
  bf16x8 qr[6];
#pragma unroll
  for (int d0 = 0; d0 < 6; ++d0) qr[d0] = *(const bf16x8*)(mq + tokq * 768 + h * 96 + d0 * 16 + hi * 8);
  const KVSrc src{mkv + (size_t)b * SEQ * 1024 + h * 128, mkv + (size_t)b * SEQ * 1024 + h * 128 + 64, 1024, 1024};
  const bf16_t* krb = kr + (size_t)b * SEQ * 32;
  const int NTL = 4 * (qb + 1);
  u32x4 rk, rv, rr = {0u, 0u, 0u, 0u};
  f32x16 o[2]; o[0] = f32x16{}; o[1] = f32x16{};
  unsigned pw[16];
  float m = -1e30f, l = 0.f;
  __syncthreads();
  kv_issue(src, 0, rk, rv, tid);
  if (tid < 256) rr = *(const u32x4*)(krb + (size_t)(tid & 63) * 32 + (tid >> 6) * 8);
  kv_commit(lds, rk, rv, tid);
  if (tid < 256) *(LAS3 u32x4*)(lds + KOFF + (8 + (tid >> 6)) * 1024 + (tid & 63) * 16) = rr;
  int cur = 0;
#pragma unroll 1
  for (int tl = 0; tl < NTL; ++tl) {
    __syncthreads();
    if (tl + 1 < NTL) { kv_issue(src, (tl + 1) * 64, rk, rv, tid); if (tid < 256) rr = *(const u32x4*)(krb + (size_t)((tl + 1) * 64 + (tid & 63)) * 32 + (tid >> 6) * 8); }
    if (64 * tl <= qw + 31) {
      f32x16 p0, p1;
      if (64 * tl + 63 > qw) {
        const LAS3 float* bp = stp + 96 + (qpos - 64 * tl) - 4 * hi - 63;
        f32x16 c0, c1;
#pragma unroll
        for (int r = 0; r < 16; ++r) { c0[r] = bp[63 - ((r & 3) + 8 * (r >> 2))]; c1[r] = bp[31 - ((r & 3) + 8 * (r >> 2))]; }
        qkt_init<6>(p0, p1, kb0 + cur * SLOT, qr, c0, c1);
      } else qkt<6>(p0, p1, kb0 + cur * SLOT, qr);
      softmax_step(p0, p1, m, l, o, wsf, r32, hi, pw);
      pv(o, vp0 + cur * SLOT, pw);
    }
    if (tl + 1 < NTL) { kv_commit(lds + (cur ^ 1) * SLOT, rk, rv, tid); if (tid < 256) *(LAS3 u32x4*)(lds + (cur ^ 1) * SLOT + KOFF + (8 + (tid >> 6)) * 1024 + (tid & 63) * 16) = rr; }
    cur ^= 1;
  }
  l = xsum(l);
  if (hi == 0) wsf[r32] = 1.0f / fmaxf(l, 1e-30f);
#pragma unroll
  for (int r = 0; r < 16; ++r) { const float f = wsf[crow(r, hi)]; o[0][r] *= f; o[1][r] *= f; }
  LAS3 float* finl = (LAS3 float*)(lds + L_FIN) + w * 2048;
  fin_set(finl, o, lane);
  fin_store(finl, omla, (size_t)b * SEQ + qw, 1024, 512 + h * 64, lane);
}

__device__ __forceinline__ void attn_phase(const bf16_t* proj, const bf16_t* kc, const bf16_t* vc, const float* t5, bf16_t* onsa,
                                           const bf16_t* mq, const bf16_t* mkv, const bf16_t* kr, bf16_t* omla, lptr lds) {
  const int tid = threadIdx.x;
  { LAS3 float* tb = (LAS3 float*)(lds + L_TB);
    for (int i = tid; i < 8 * 320; i += NTHR) { const int hd = i / 320, d = i % 320 - 64; tb[i] = (d < 0) ? NEG_INF : ((d < 113) ? (t5[(int)T5B[d] * 8 + hd] - t5[31 * 8 + hd]) * LOG2E : 0.f); }
    LAS3 float* st = (LAS3 float*)(lds + L_ST);
    for (int i = tid; i < 192; i += NTHR) st[i] = (i < 96) ? NEG_INF : 0.f; }
  const int G = gridDim.x, bx = blockIdx.x;
  for (int v = (G % 8 == 0) ? (bx % 8) * (G / 8) + bx / 8 : bx; v < 256; v += G) {
    const int bg = v >> 4, p = v & 15, bh = v >> 2, j = v & 3;
#pragma unroll 1
    for (int u = 0; u < 2; ++u) nsa_unit(bg >> 1, bg & 1, u ? p : 31 - p, proj, kc, vc, onsa, lds);
#pragma unroll 1
    for (int u = 0; u < 2; ++u) mla_unit(bh >> 3, bh & 7, u ? j : 7 - j, mq, mkv, kr, omla, lds);
  }
}
#undef LAS3
}


namespace peer {
using bf16x8 = __attribute__((ext_vector_type(8))) short;
using f32x16 = __attribute__((ext_vector_type(16))) float;
typedef unsigned u32x4 __attribute__((ext_vector_type(4)));
typedef float f32x4_t __attribute__((ext_vector_type(4)));
typedef __bf16 bf16x2_t __attribute__((ext_vector_type(2)));
typedef float f32x2_t __attribute__((ext_vector_type(2)));
#define LAS3 __attribute__((address_space(3)))
__device__ __forceinline__ int crow(int r, int hi) { return (r & 3) + 8 * (r >> 2) + 4 * hi; }
__device__ __forceinline__ unsigned enc(float f) { const unsigned u = __float_as_uint(f); return u ^ ((unsigned)((int)u >> 31) | 0x80000000u); }
__device__ __forceinline__ float dec(unsigned k) { return __uint_as_float(k ^ (~(unsigned)((int)k >> 31) | 0x80000000u)); }
__device__ __forceinline__ unsigned umax(unsigned a, unsigned b) { return a > b ? a : b; }
__device__ __forceinline__ unsigned umin(unsigned a, unsigned b) { return a < b ? a : b; }
__device__ __forceinline__ unsigned cvtpk(float lo, float hi) { f32x2_t v = {lo, hi}; bf16x2_t b = __builtin_convertvector(v, bf16x2_t); return __builtin_bit_cast(unsigned, b); }
template <int B, int N> __device__ __forceinline__ void sort16(unsigned (&k)[N]) {
#pragma unroll
  for (int size = 2; size <= 16; size <<= 1)
#pragma unroll
    for (int stride = size >> 1; stride > 0; stride >>= 1)
#pragma unroll
      for (int i = 0; i < 16; ++i) { const int l = i ^ stride;
        if (l > i) { const bool desc = ((i & size) == 0); const unsigned a = k[B + i], b = k[B + l]; const unsigned mx = umax(a, b), mn = umin(a, b); k[B + i] = desc ? mx : mn; k[B + l] = desc ? mn : mx; } }
}
template <int A, int Bo, int N> __device__ __forceinline__ void merge16(unsigned (&k)[N]) {
#pragma unroll
  for (int i = 0; i < 16; ++i) k[A + i] = umax(k[A + i], k[Bo + 15 - i]);
#pragma unroll
  for (int stride = 8; stride > 0; stride >>= 1)
#pragma unroll
    for (int i = 0; i < 16; ++i) { const int l = i ^ stride; if (l > i) { const unsigned a = k[A + i], b = k[A + l]; k[A + i] = umax(a, b); k[A + l] = umin(a, b); } }
}
template <int N> __device__ __forceinline__ void top16_of_64(unsigned (&k)[N]) {
  sort16<0>(k); sort16<16>(k); sort16<32>(k); sort16<48>(k);
  merge16<0, 16>(k); merge16<32, 48>(k); merge16<0, 32>(k);
}

__device__ __forceinline__ void route_phase(const bf16_t* __restrict__ pq, const bf16_t* __restrict__ subk, unsigned* __restrict__ pack, LAS3 char* lds) {
  const int tid = threadIdx.x, lane = tid & 63, r32 = lane & 31, hi = lane >> 5, wv = tid >> 6;
  const int gw = blockIdx.x * NWV + wv, nw = gridDim.x * NWV;
  LAS3 unsigned char* myb = (LAS3 unsigned char*)lds + wv * 2560 + lane * 40;
#pragma unroll 1
  for (int item = gw; item < (T / 32) * 8; item += nw) {
    const int h = item & 7, t0 = (item >> 3) * 32;
    unsigned la[16], lb[16];
#pragma unroll
    for (int i = 0; i < 16; ++i) { la[i] = 0u; lb[i] = 0u; }
#pragma unroll 1
    for (int p = 0; p < 2; ++p) {
      f32x16 acc[4];
#pragma unroll
      for (int kt = 0; kt < 4; ++kt) acc[kt] = f32x16{};
#pragma unroll
      for (int kd = 0; kd < 4; ++kd) {
        const bf16x8 bq = *(const bf16x8*)(pq + (size_t)(t0 + r32) * 1024 + h * 128 + p * 64 + kd * 16 + hi * 8);
#pragma unroll
        for (int kt = 0; kt < 4; ++kt) {
          const bf16x8 ak = *(const bf16x8*)(subk + (size_t)((h * 2 + p) * 128 + kt * 32 + r32) * 64 + kd * 16 + hi * 8);
          acc[kt] = __builtin_amdgcn_mfma_f32_32x32x16_bf16(ak, bq, acc[kt], 0, 0, 0);
        }
      }
      unsigned k[64];
#pragma unroll
      for (int kt = 0; kt < 4; ++kt)
#pragma unroll
        for (int r = 0; r < 16; ++r) k[kt * 16 + r] = (enc(acc[kt][r]) & 0xFFFFFF80u) | (unsigned)(127 - (32 * kt + crow(r, hi)));
      top16_of_64(k);
#pragma unroll
      for (int i = 0; i < 16; ++i) { auto rr = __builtin_amdgcn_permlane32_swap(k[i], k[i], false, false); unsigned r0 = rr[0], r1 = rr[1]; asm volatile("" : "+v"(r0), "+v"(r1)); k[16 + i] = hi ? r0 : r1; }
      merge16<0, 16>(k);
#pragma unroll
      for (int i = 0; i < 16; ++i) { la[i] = (p == 0) ? k[i] : la[i]; lb[i] = (p == 0) ? lb[i] : k[i]; }
      __builtin_amdgcn_sched_barrier(0);
    }
#pragma unroll
    for (int i = 0; i < 4; ++i) {
      const unsigned wa = (127u - (la[4 * i] & 127u)) | ((127u - (la[4 * i + 1] & 127u)) << 8) | ((127u - (la[4 * i + 2] & 127u)) << 16) | ((127u - (la[4 * i + 3] & 127u)) << 24);
      const unsigned wb = (127u - (lb[4 * i] & 127u)) | ((127u - (lb[4 * i + 1] & 127u)) << 8) | ((127u - (lb[4 * i + 2] & 127u)) << 16) | ((127u - (lb[4 * i + 3] & 127u)) << 24);
      *(LAS3 unsigned*)(myb + 4 * i) = wa; *(LAS3 unsigned*)(myb + 16 + 4 * i) = wb;
    }
    float va[16], vb[16];
#pragma unroll
    for (int i = 0; i < 16; ++i) { va[i] = dec(la[i] & 0xFFFFFF80u); vb[i] = dec(lb[i] & 0xFFFFFF80u); }
    unsigned k[64];
#define PEER_CAND(n, i, j) k[n] = (enc(va[i] + vb[j]) & 0xFFFFFF00u) | (unsigned)(255 - ((i) * 16 + (j)))
    PEER_CAND(0, 0, 0); PEER_CAND(1, 0, 1); PEER_CAND(2, 0, 2); PEER_CAND(3, 0, 3); PEER_CAND(4, 0, 4); PEER_CAND(5, 0, 5);
    PEER_CAND(6, 0, 6); PEER_CAND(7, 0, 7); PEER_CAND(8, 0, 8); PEER_CAND(9, 0, 9); PEER_CAND(10, 0, 10); PEER_CAND(11, 0, 11);
    PEER_CAND(12, 0, 12); PEER_CAND(13, 0, 13); PEER_CAND(14, 0, 14); PEER_CAND(15, 0, 15); PEER_CAND(16, 1, 0); PEER_CAND(17, 1, 1);
    PEER_CAND(18, 1, 2); PEER_CAND(19, 1, 3); PEER_CAND(20, 1, 4); PEER_CAND(21, 1, 5); PEER_CAND(22, 1, 6); PEER_CAND(23, 1, 7);
    PEER_CAND(24, 2, 0); PEER_CAND(25, 2, 1); PEER_CAND(26, 2, 2); PEER_CAND(27, 2, 3); PEER_CAND(28, 2, 4); PEER_CAND(29, 3, 0);
    PEER_CAND(30, 3, 1); PEER_CAND(31, 3, 2); PEER_CAND(32, 3, 3); PEER_CAND(33, 4, 0); PEER_CAND(34, 4, 1); PEER_CAND(35, 4, 2);
    PEER_CAND(36, 5, 0); PEER_CAND(37, 5, 1); PEER_CAND(38, 6, 0); PEER_CAND(39, 6, 1); PEER_CAND(40, 7, 0); PEER_CAND(41, 7, 1);
    PEER_CAND(42, 8, 0); PEER_CAND(43, 9, 0); PEER_CAND(44, 10, 0); PEER_CAND(45, 11, 0); PEER_CAND(46, 12, 0); PEER_CAND(47, 13, 0);
    PEER_CAND(48, 14, 0); PEER_CAND(49, 15, 0);
#undef PEER_CAND
#pragma unroll
    for (int z = 50; z < 64; ++z) k[z] = 0u;
    top16_of_64(k);
    const float best0 = dec(k[0] & 0xFFFFFF00u);
    float ev[16]; float den = 0.f;
#pragma unroll
    for (int i = 0; i < 16; ++i) { ev[i] = __expf(dec(k[i] & 0xFFFFFF00u) - best0); den += ev[i]; }
    const float inv = 1.0f / den;
    unsigned outw[8];
#pragma unroll
    for (int i = 0; i < 8; ++i) {
      unsigned k_lo = k[i], k_hi = k[8 + i]; float e_lo = ev[i], e_hi = ev[8 + i];
      asm volatile("" : "+v"(k_lo), "+v"(k_hi), "+v"(e_lo), "+v"(e_hi));
      const unsigned kk = hi ? k_hi : k_lo; const float e = hi ? e_hi : e_lo;
      const unsigned f = 255u - (kk & 255u);
      const unsigned ia = myb[f >> 4], ib = myb[16 + (f & 15u)];
      outw[i] = (ia * 128u + ib) | (cvtpk(0.f, e * inv) & 0xFFFF0000u);
    }
    unsigned* dst = pack + (size_t)(t0 + r32) * 128 + h * 16 + hi * 8;
    *(u32x4*)dst = (u32x4){outw[0], outw[1], outw[2], outw[3]};
    *(u32x4*)(dst + 4) = (u32x4){outw[4], outw[5], outw[6], outw[7]};
  }
}

__device__ __forceinline__ void conv_tables(const float* __restrict__ u, const float* __restrict__ v, unsigned* __restrict__ u8, float* __restrict__ su, unsigned* __restrict__ v8) {
  const int tid = threadIdx.x, lane = tid & 63, wv = tid >> 6;
  const int gw = blockIdx.x * NWV + wv, nw = gridDim.x * NWV;
  for (int e = gw; e < 16384; e += nw) {
    const f32x4_t* ur = (const f32x4_t*)(u + (size_t)e * 1024) + lane * 4;
    f32x4_t a[4]; float mx = 0.f;
#pragma unroll
    for (int i = 0; i < 4; ++i) { a[i] = ur[i]; mx = fmaxf(mx, fmaxf(fmaxf(fabsf(a[i][0]), fabsf(a[i][1])), fmaxf(fabsf(a[i][2]), fabsf(a[i][3])))); }
    mx = wmaxf(mx);
    const float sc = fmaxf(mx, 1e-30f) * (1.0f / 127.0f), isc = 1.0f / sc;
    u32x4 o;
#pragma unroll
    for (int i = 0; i < 4; ++i) {
      const int q0 = (int)rintf(a[i][0] * isc), q1 = (int)rintf(a[i][1] * isc), q2 = (int)rintf(a[i][2] * isc), q3 = (int)rintf(a[i][3] * isc);
      o[i] = (unsigned)(q0 & 255) | ((unsigned)(q1 & 255) << 8) | ((unsigned)(q2 & 255) << 16) | ((unsigned)(q3 & 255) << 24);
    }
    *(u32x4*)(u8 + (size_t)e * 256 + lane * 4) = o;
    if (lane == 0) su[e] = sc;
    const f32x4_t* vr = (const f32x4_t*)(v + (size_t)e * 1024) + lane * 4;
    u32x4 ov;
#pragma unroll
    for (int i = 0; i < 4; ++i) { const f32x4_t b = vr[i]; unsigned w = 0u; w = __builtin_amdgcn_cvt_pk_fp8_f32(2.0f * b[0], 2.0f * b[1], w, false); w = __builtin_amdgcn_cvt_pk_fp8_f32(2.0f * b[2], 2.0f * b[3], w, true); ov[i] = w; }
    *(u32x4*)(v8 + ((size_t)(lane >> 3) * 16384 + e) * 32 + (lane & 7) * 4) = ov;
  }
}
__device__ __forceinline__ float gelu_fast(float v) {
  const float av = __builtin_fabsf(v), t = __builtin_amdgcn_rcpf(av * 0.2316418882f + 1.0f);
  float q = t * 0.5307027145f + (-0.7265760135f); q = q * t + 0.7107068705f; q = q * t + (-0.142248368f); q = q * t + 0.127414796f; q = q * t;
  const float e = __builtin_amdgcn_exp2f((v * v) * (-0.72134752044f));
  const float m = v * (q * e);
  return v < 0.f ? m : v - m;
}
__device__ __forceinline__ unsigned xcc_id() { return (unsigned)__builtin_amdgcn_s_getreg((3 << 11) | 20) & 7u; }
struct ABuf { unsigned w, meta; u32x4 ub[8]; float sue; };
__device__ __forceinline__ void expA_issue(ABuf& B, int k0, int n, const LAS3 unsigned* list, const unsigned* __restrict__ u8, const float* __restrict__ su, int j8) {
  const int k = (k0 < n) ? k0 : 0;
  B.w = list[2 * k]; B.meta = list[2 * k + 1];
  const unsigned e = B.w & 0xFFFFu;
  const unsigned* urow = u8 + (size_t)e * 256 + j8 * 4;
#pragma unroll
  for (int seg = 0; seg < 8; ++seg) B.ub[seg] = *(const u32x4*)(urow + seg * 32);
  B.sue = su[e];
}
__device__ __forceinline__ void expA_consume(const ABuf& B, int k0, int n, const LAS3 char* hl, const LAS3 float* shl, float* __restrict__ co, int t0, int j8) {
  const int tokl = (int)(B.meta >> 8), slot = (int)(B.meta & 255u);
  const LAS3 char* hrow = hl + tokl * 1024 + j8 * 16;
  int a0 = 0, a1 = 0, a2 = 0, a3 = 0;
#pragma unroll
  for (int seg = 0; seg < 8; ++seg) { const u32x4 hq = *(const LAS3 u32x4*)(hrow + seg * 128);
    a0 = __builtin_amdgcn_sdot4((int)B.ub[seg].x, (int)hq.x, a0, false); a1 = __builtin_amdgcn_sdot4((int)B.ub[seg].y, (int)hq.y, a1, false);
    a2 = __builtin_amdgcn_sdot4((int)B.ub[seg].z, (int)hq.z, a2, false); a3 = __builtin_amdgcn_sdot4((int)B.ub[seg].w, (int)hq.w, a3, false); }
  int acc = (a0 + a1) + (a2 + a3);
  acc += dpp_i<0xB1>(acc); acc += dpp_i<0x4E>(acc); acc += dpp_i<0x141>(acc);
  const float d = (float)acc * (B.sue * shl[tokl]);
  const float c = 0.5f * __uint_as_float(B.w & 0xFFFF0000u) * gelu_fast(d);
  if (j8 == 0 && k0 < n) co[(size_t)(t0 + tokl) * 128 + slot] = c;
}
struct AStage { u32x4 pw[4], hst[8]; float shv; };
__device__ __forceinline__ void expA_stage(AStage& S, int item, const unsigned* __restrict__ pack, const unsigned* __restrict__ hn8, const float* __restrict__ shp, int tid) {
  const int t0 = item * 64, tokl = tid >> 3, sb = (tid & 7) * 16;
#pragma unroll
  for (int i = 0; i < 4; ++i) S.pw[i] = *(const u32x4*)(pack + (size_t)(t0 + tokl) * 128 + sb + 4 * i);
#pragma unroll
  for (int i = 0; i < 8; ++i) S.hst[i] = *(const u32x4*)(hn8 + (size_t)t0 * 256 + (tid + 512 * i) * 4);
  S.shv = (tid < 64) ? shp[t0 + tid] : 0.f;
}
__device__ __forceinline__ void expA_item(AStage& S, int item, int nitem, int xs, const unsigned* __restrict__ pack, const unsigned* __restrict__ hn8, const float* __restrict__ shp, const unsigned* __restrict__ u8, const float* __restrict__ su,
                                          float* __restrict__ co, LAS3 char* lds, int tid) {
  const int lane = tid & 63, wv = tid >> 6;
  LAS3 char* hl = lds + 1024;
  LAS3 float* shl = (LAS3 float*)(lds + 1024 + 65536);
  LAS3 unsigned* cnt = (LAS3 unsigned*)(lds + 16);
  LAS3 unsigned* list = (LAS3 unsigned*)(lds + 1024 + 65536 + 256);
  const int t0 = item * 64;
  const int tokl = tid >> 3, sb = (tid & 7) * 16;
#pragma unroll
  for (int i = 0; i < 8; ++i) *(LAS3 u32x4*)(hl + (tid + 512 * i) * 16) = S.hst[i];
  if (tid < 64) shl[tid] = S.shv;
  {
    unsigned long long mk[16]; int tot = 0; int off[16];
#pragma unroll
    for (int j = 0; j < 16; ++j) { const unsigned w = S.pw[j >> 2][j & 3]; mk[j] = __ballot(((w & 0xFFFFu) >> 11) == (unsigned)xs); off[j] = tot; tot += __builtin_popcountll(mk[j]); }
    int base = 0;
    if (lane == 0) base = (int)__hip_atomic_fetch_add(cnt, (unsigned)tot, __ATOMIC_RELAXED, __HIP_MEMORY_SCOPE_WORKGROUP);
    base = __builtin_amdgcn_readfirstlane(base);
#pragma unroll
    for (int j = 0; j < 16; ++j) { const unsigned w = S.pw[j >> 2][j & 3];
      if (((w & 0xFFFFu) >> 11) == (unsigned)xs) { const int pos = base + off[j] + (int)__builtin_amdgcn_mbcnt_hi((unsigned)(mk[j] >> 32), __builtin_amdgcn_mbcnt_lo((unsigned)mk[j], 0u));
        list[2 * pos] = w; list[2 * pos + 1] = (unsigned)((tokl << 8) | (sb + j)); } }
  }
  if (nitem < T / 64) expA_stage(S, nitem, pack, hn8, shp, tid);
  __syncthreads();
  const int n = (int)cnt[0];
  const int j8 = lane & 7, gidx = wv * 8 + (lane >> 3);
  ABuf A, Bb;
  expA_issue(A, gidx, n, list, u8, su, j8);
#pragma unroll 1
  for (int k0 = gidx; k0 < n; k0 += 128) {
    expA_issue(Bb, k0 + 64, n, list, u8, su, j8);
    expA_consume(A, k0, n, hl, shl, co, t0, j8);
    expA_issue(A, k0 + 128, n, list, u8, su, j8);
    expA_consume(Bb, k0 + 64, n, hl, shl, co, t0, j8);
  }
}
struct BBuf { u32x4 vv[8]; f32x4_t c[2]; };
__device__ __forceinline__ void expB_issue(BBuf& B, const LAS3 unsigned* pkl, const LAS3 float* col, int sg8, const unsigned* __restrict__ vbase) {
  const u32x4 p0 = *(const LAS3 u32x4*)(pkl + sg8 * 8), p1 = *(const LAS3 u32x4*)(pkl + sg8 * 8 + 4);
  B.c[0] = *(const LAS3 f32x4_t*)(col + sg8 * 8); B.c[1] = *(const LAS3 f32x4_t*)(col + sg8 * 8 + 4);
#pragma unroll
  for (int j = 0; j < 4; ++j) { B.vv[j] = *(const u32x4*)(vbase + (size_t)(p0[j] & 0xFFFFu) * 32); B.vv[4 + j] = *(const u32x4*)(vbase + (size_t)(p1[j] & 0xFFFFu) * 32); }
}
__device__ __forceinline__ void expB_consume(const BBuf& B, f32x2_t (&y)[8]) {
#pragma unroll
  for (int j = 0; j < 8; ++j) {
    const float cv = B.c[j >> 2][j & 3];
    const f32x2_t c2 = {cv, cv};
#pragma unroll
    for (int w = 0; w < 4; ++w) {
      y[2 * w] = __builtin_elementwise_fma(__builtin_amdgcn_cvt_pk_f32_fp8(B.vv[j][w], false), c2, y[2 * w]);
      y[2 * w + 1] = __builtin_elementwise_fma(__builtin_amdgcn_cvt_pk_f32_fp8(B.vv[j][w], true), c2, y[2 * w + 1]);
    }
  }
}
__device__ __forceinline__ void expB_item(int item, int xs, const unsigned* __restrict__ pack, const float* __restrict__ co, const unsigned* __restrict__ v8, bf16_t* __restrict__ zb, float* __restrict__ ssq, LAS3 char* lds, int tid,
                                          const float* __restrict__ xin, const bf16_t* __restrict__ ob) {
  const int lane = tid & 63, wv = tid >> 6, r8 = lane >> 3, c8 = lane & 7;
  const int t0 = item * 64 + wv * 8;
  LAS3 unsigned* pkw = (LAS3 unsigned*)(lds + 1024 + wv * 8192);
  LAS3 float* cow = (LAS3 float*)(lds + 1024 + wv * 8192 + 4096);
  {
    u32x4 a[4]; f32x4_t b[4];
#pragma unroll
    for (int i = 0; i < 4; ++i) { a[i] = *(const u32x4*)(pack + (size_t)t0 * 128 + (lane + 64 * i) * 4); b[i] = *(const f32x4_t*)(co + (size_t)t0 * 128 + (lane + 64 * i) * 4); }
#pragma unroll
    for (int i = 0; i < 4; ++i) { *(LAS3 u32x4*)(pkw + (lane + 64 * i) * 4) = a[i]; *(LAS3 f32x4_t*)(cow + (lane + 64 * i) * 4) = b[i]; }
  }
  const size_t hoff = (size_t)(t0 + r8) * 1024 + xs * 128 + c8 * 16;
  f32x4_t h[4];
  { const u32x4 o0 = *(const u32x4*)(ob + hoff), o1 = *(const u32x4*)(ob + hoff + 8);
#pragma unroll
    for (int w = 0; w < 4; ++w) h[w] = *(const f32x4_t*)(xin + hoff + 4 * w);
    h[0] += (f32x4_t){__uint_as_float(o0.x << 16), __uint_as_float(o0.x & 0xffff0000u), __uint_as_float(o0.y << 16), __uint_as_float(o0.y & 0xffff0000u)};
    h[1] += (f32x4_t){__uint_as_float(o0.z << 16), __uint_as_float(o0.z & 0xffff0000u), __uint_as_float(o0.w << 16), __uint_as_float(o0.w & 0xffff0000u)};
    h[2] += (f32x4_t){__uint_as_float(o1.x << 16), __uint_as_float(o1.x & 0xffff0000u), __uint_as_float(o1.y << 16), __uint_as_float(o1.y & 0xffff0000u)};
    h[3] += (f32x4_t){__uint_as_float(o1.z << 16), __uint_as_float(o1.z & 0xffff0000u), __uint_as_float(o1.w << 16), __uint_as_float(o1.w & 0xffff0000u)}; }
  wave_lds_sync();
  const LAS3 unsigned* pkl = pkw + r8 * 128; const LAS3 float* col = cow + r8 * 128;
  const unsigned* vbase = v8 + (size_t)xs * 16384 * 32 + c8 * 4;
  f32x2_t y[8];
#pragma unroll
  for (int i = 0; i < 8; ++i) y[i] = (f32x2_t){0.f, 0.f};
  BBuf A, Bb;
  expB_issue(A, pkl, col, 0, vbase);
#pragma unroll 1
  for (int sg = 0; sg < 16; sg += 2) {
    expB_issue(Bb, pkl, col, sg + 1, vbase);
    expB_consume(A, y);
    if (sg + 2 < 16) expB_issue(A, pkl, col, sg + 2, vbase);
    expB_consume(Bb, y);
  }
  float ss = 0.f; unsigned zw[8];
#pragma unroll
  for (int w = 0; w < 4; ++w) {
    const f32x4_t z = {h[w][0] + y[2 * w][0], h[w][1] + y[2 * w][1], h[w][2] + y[2 * w + 1][0], h[w][3] + y[2 * w + 1][1]};
    zw[2 * w] = cvtpk(z[0], z[1]); zw[2 * w + 1] = cvtpk(z[2], z[3]);
    ss += (z[0] * z[0] + z[1] * z[1]) + (z[2] * z[2] + z[3] * z[3]);
  }
  *(u32x4*)(zb + hoff) = (u32x4){zw[0], zw[1], zw[2], zw[3]}; *(u32x4*)(zb + hoff + 8) = (u32x4){zw[4], zw[5], zw[6], zw[7]};
  ss += dpp_f<0xB1>(ss); ss += dpp_f<0x4E>(ss); ss += dpp_f<0x141>(ss);
  if (c8 == 0) ssq[(size_t)xs * T + t0 + r8] = ss;
  wave_lds_sync();
}
template <int PASS> __device__ __forceinline__ void experts_sliced(const unsigned* __restrict__ pack, const unsigned* __restrict__ hn8, const float* __restrict__ shp, const unsigned* __restrict__ u8, const float* __restrict__ su,
                                                                    float* __restrict__ co, const unsigned* __restrict__ v8, float* __restrict__ out, float* __restrict__ ssq, unsigned* __restrict__ ctr, LAS3 char* lds,
                                                                    const float* __restrict__ xin = nullptr, const bf16_t* __restrict__ ob = nullptr) {
  int tid = threadIdx.x; asm volatile("" : "+v"(tid));
  LAS3 volatile int* lw = (LAS3 volatile int*)lds;
  const int xme = (int)xcc_id();
#pragma unroll 1
  for (int s8 = 0; s8 < 8; ++s8) {
    const int xs = (xme + s8) & 7;
    if (PASS == 0) {
      int nxt = 0;
      if (tid == 0) nxt = (int)atomicAdd(ctr + 64 * xs, 1u);
      __syncthreads();
      if (tid == 0) lw[0] = nxt;
      __syncthreads();
      int item = lw[0];
      if (item >= T / 64) continue;
      if (tid == 0) nxt = (int)atomicAdd(ctr + 64 * xs, 1u);
      AStage SA;
      expA_stage(SA, item, pack, hn8, shp, tid);
#pragma unroll 1
      for (;;) {
        __syncthreads();
        if (tid == 0) { lw[0] = nxt; lw[4] = 0; }
        __syncthreads();
        const int nitem = lw[0];
        if (tid == 0) nxt = (int)atomicAdd(ctr + 64 * xs, 1u);
        expA_item(SA, item, nitem, xs, pack, hn8, shp, u8, su, co, lds, tid);
        if (nitem >= T / 64) break;
        item = nitem;
      }
    } else {
      int nxt = 0;
      if (tid == 0) nxt = (int)atomicAdd(ctr + 64 * xs, 1u);
#pragma unroll 1
      for (;;) {
        __syncthreads();
        if (tid == 0) lw[0] = nxt;
        __syncthreads();
        const int item = lw[0];
        if (item >= T / 64) break;
        if (tid == 0) nxt = (int)atomicAdd(ctr + 64 * xs, 1u);
        expB_item(item, xs, pack, co, v8, (bf16_t*)out, ssq, lds, tid, xin, ob);
      }
    }
  }
}
__device__ __forceinline__ void experts_norm(const float* __restrict__ ssq, const float* __restrict__ gfin, const bf16_t* __restrict__ zb, float* __restrict__ out) {
  const int tid = threadIdx.x, lane = tid & 63, wv = tid >> 6;
  const int gw = blockIdx.x * NWV + wv, nw = gridDim.x * NWV;
  for (int t = gw; t < T; t += nw) {
    float ss = 0.f;
#pragma unroll
    for (int x = 0; x < 8; ++x) ss += ssq[(size_t)x * T + t];
    const float inv = rsqrtf(ss * (1.0f / 1024.0f) + 1e-6f);
    float* op = out + (size_t)t * 1024 + lane * 16; const float* gp = gfin + lane * 16;
    const u32x4 z0 = *(const u32x4*)(zb + (size_t)t * 1024 + lane * 16), z1 = *(const u32x4*)(zb + (size_t)t * 1024 + lane * 16 + 8);
    const unsigned zz[8] = {z0.x, z0.y, z0.z, z0.w, z1.x, z1.y, z1.z, z1.w};
#pragma unroll
    for (int i = 0; i < 4; ++i) { const f32x4_t z = {__uint_as_float(zz[2 * i] << 16), __uint_as_float(zz[2 * i] & 0xffff0000u), __uint_as_float(zz[2 * i + 1] << 16), __uint_as_float(zz[2 * i + 1] & 0xffff0000u)};
      const f32x4_t g = *(const f32x4_t*)(gp + 4 * i); *(f32x4_t*)(op + 4 * i) = z * inv * g; }
  }
}
#undef LAS3
}

namespace prep {
typedef unsigned u32x2_t __attribute__((ext_vector_type(2)));
typedef float f32x4_t __attribute__((ext_vector_type(4)));
typedef unsigned u32x4 __attribute__((ext_vector_type(4)));
using bf16x8 = __attribute__((ext_vector_type(8))) short;
using f32x16 = __attribute__((ext_vector_type(16))) float;
__device__ __forceinline__ unsigned pk2(float lo, float hi) { return (unsigned)f2bf(lo) | ((unsigned)f2bf(hi) << 16); }
__device__ __forceinline__ void latent_rows(const bf16_t* __restrict__ proj, const float* __restrict__ gq, const float* __restrict__ gkv, const float2* __restrict__ cs,
                                            bf16_t* __restrict__ cqn, bf16_t* __restrict__ ckvn, bf16_t* __restrict__ krope, int wave_id, int nwaves, int lane) {
  const f32x4_t g4 = *(const f32x4_t*)(gq + lane * 4);
  const float2 g2 = *(const float2*)(gkv + lane * 2);
  for (int r = wave_id; r < T; r += nwaves) {
    const bf16_t* row = proj + (size_t)r * PROJ_LD;
    const u32x2_t q = *(const u32x2_t*)(row + PC_CQ + lane * 4);
    const unsigned kv = *(const unsigned*)(row + PC_CKV + lane * 2);
    const unsigned short kr0 = row[PC_KR + (lane & 15)], kr1 = row[PC_KR + 16 + (lane & 15)];
    const float q0 = __uint_as_float(q.x << 16), q1 = __uint_as_float(q.x & 0xffff0000u), q2 = __uint_as_float(q.y << 16), q3 = __uint_as_float(q.y & 0xffff0000u);
    const float k0 = __uint_as_float(kv << 16), k1 = __uint_as_float(kv & 0xffff0000u);
    float sq = (q0 * q0 + q1 * q1) + (q2 * q2 + q3 * q3), sk = k0 * k0 + k1 * k1;
    sq = wsum(sq); sk = wsum(sk);
    const float iq = rsqrtf(sq * (1.0f / 256.0f) + 1e-6f), ik = rsqrtf(sk * (1.0f / 128.0f) + 1e-6f);
    u32x2_t oq; oq.x = pk2(q0 * iq * g4[0], q1 * iq * g4[1]); oq.y = pk2(q2 * iq * g4[2], q3 * iq * g4[3]);
    *(u32x2_t*)(cqn + (size_t)r * 256 + lane * 4) = oq;
    *(unsigned*)(ckvn + (size_t)r * 128 + lane * 2) = pk2(k0 * ik * g2.x, k1 * ik * g2.y);
    if (lane < 16) {
      const float2 c = cs[(r & (SEQ - 1)) * 16 + lane];
      const float x1 = bf2f(kr0), x2 = bf2f(kr1);
      krope[(size_t)r * 32 + lane] = f2bf(x1 * c.x - x2 * c.y); krope[(size_t)r * 32 + 16 + lane] = f2bf(x2 * c.x + x1 * c.y);
    }
  }
}
__device__ __forceinline__ void cmp_bias(const float* __restrict__ posk, const float* __restrict__ posv, const bf16_t* __restrict__ w1k, const bf16_t* __restrict__ w1v, float* __restrict__ cpos, int wave_id, int nwaves, int lane) {
  for (int o = wave_id; o < 512; o += nwaves) {
    const int tab = o >> 8, n = o & 255;
    const float* pos = tab ? posv : posk; const bf16_t* w = (tab ? w1v : w1k) + (size_t)n * 2048;
    float acc = 0.f;
#pragma unroll
    for (int i = 0; i < 4; ++i) { const int k = (i * 64 + lane) * 8;
      const u32x4 wv = *(const u32x4*)(w + k); const f32x4_t p0 = *(const f32x4_t*)(pos + k), p1 = *(const f32x4_t*)(pos + k + 4);
      acc += p0[0] * __uint_as_float(wv.x << 16) + p0[1] * __uint_as_float(wv.x & 0xffff0000u) + p0[2] * __uint_as_float(wv.y << 16) + p0[3] * __uint_as_float(wv.y & 0xffff0000u);
      acc += p1[0] * __uint_as_float(wv.z << 16) + p1[1] * __uint_as_float(wv.z & 0xffff0000u) + p1[2] * __uint_as_float(wv.w << 16) + p1[3] * __uint_as_float(wv.w & 0xffff0000u); }
    acc = wsum(acc);
    if (lane == 0) cpos[o] = acc;
  }
}
__device__ __forceinline__ void cmp_l2(const float* __restrict__ slab, const float* __restrict__ cpos, const bf16_t* __restrict__ w2t, bf16_t* __restrict__ outkc, int item, int lane) {
  const int r32 = lane & 31, hi = lane >> 5, m0 = item * 32;
  f32x16 acc0 = f32x16{}, acc1 = f32x16{};
  f32x4_t sa[2][8]; f32x4_t cp[2][2]; bf16x8 wb[2][2];
#define CMPL2_LOAD(buf, ks_) do { const int k_ = (ks_) * 16 + hi * 8; \
    cp[buf][0] = *(const f32x4_t*)(cpos + k_); cp[buf][1] = *(const f32x4_t*)(cpos + k_ + 4); \
    _Pragma("unroll") for (int sp = 0; sp < 4; ++sp) { const float* p_ = slab + ((size_t)sp * 2048 + m0 + r32) * 256 + k_; sa[buf][2 * sp] = *(const f32x4_t*)p_; sa[buf][2 * sp + 1] = *(const f32x4_t*)(p_ + 4); } \
    wb[buf][0] = *(const bf16x8*)(w2t + (size_t)r32 * 256 + k_); wb[buf][1] = *(const bf16x8*)(w2t + (size_t)(32 + r32) * 256 + k_); } while (0)
#define CMPL2_MMA(buf) do { f32x4_t a0 = cp[buf][0], a1 = cp[buf][1]; \
    _Pragma("unroll") for (int sp = 0; sp < 4; ++sp) { a0 += sa[buf][2 * sp]; a1 += sa[buf][2 * sp + 1]; } \
    u32x4 aw; aw.x = pk2(peer::gelu_fast(a0[0]), peer::gelu_fast(a0[1])); aw.y = pk2(peer::gelu_fast(a0[2]), peer::gelu_fast(a0[3])); \
    aw.z = pk2(peer::gelu_fast(a1[0]), peer::gelu_fast(a1[1])); aw.w = pk2(peer::gelu_fast(a1[2]), peer::gelu_fast(a1[3])); \
    const bf16x8 af = __builtin_bit_cast(bf16x8, aw); \
    acc0 = __builtin_amdgcn_mfma_f32_32x32x16_bf16(af, wb[buf][0], acc0, 0, 0, 0); acc1 = __builtin_amdgcn_mfma_f32_32x32x16_bf16(af, wb[buf][1], acc1, 0, 0, 0); } while (0)
  CMPL2_LOAD(0, 0);
#pragma unroll 1
  for (int ks = 0; ks < 16; ks += 2) {
    CMPL2_LOAD(1, ks + 1);
    CMPL2_MMA(0);
    if (ks + 2 < 16) CMPL2_LOAD(0, ks + 2);
    CMPL2_MMA(1);
  }
#undef CMPL2_LOAD
#undef CMPL2_MMA
#pragma unroll
  for (int r = 0; r < 16; ++r) {
    const int m = m0 + (r & 3) + 8 * (r >> 2) + 4 * hi;
    const bool pad = (m & 127) == 127;
    outkc[(size_t)m * 64 + r32] = pad ? (bf16_t)0 : f2bf(acc0[r]);
    outkc[(size_t)m * 64 + 32 + r32] = pad ? (bf16_t)0 : f2bf(acc1[r]);
  }
}
}

#define XB_TMO      128
#define XB_XCNT(j)  (256  + 64 * (j))
#define XB_XSUB(j)  (1280 + 64 * (j))
#define XB_XGEN(j)  (2304 + 64 * (j))
#define XB_TOP      3328
#define XB_TOPGEN   3392
#define XCD_BAR_WORDS 3456
#define XB_SPIN_CAP (1u << 18)
#ifndef LAS
#define LAS __attribute__((address_space(3)))
#endif

__device__ __forceinline__ unsigned xb_ld(unsigned* p)              { return __hip_atomic_load(p, __ATOMIC_RELAXED, __HIP_MEMORY_SCOPE_AGENT); }
__device__ __forceinline__ unsigned xb_add(unsigned* p, unsigned v) { return __hip_atomic_fetch_add(p, v, __ATOMIC_RELAXED, __HIP_MEMORY_SCOPE_AGENT); }
__device__ __forceinline__ unsigned xb_xcc_id() { return (unsigned)__builtin_amdgcn_s_getreg((3 << 11) | 20) & 0xFu; }
#define XB_SPIN(cond, bar) do { unsigned _sp = 0; while (cond) { __builtin_amdgcn_s_sleep(1); \
    if ((++_sp & 255u) == 0u) { if (xb_ld(&(bar)[XB_TMO])) break; if (_sp > XB_SPIN_CAP) { atomicAdd(&(bar)[XB_TMO], 1u); break; } } } } while (0)

struct XcdBarrier {
    unsigned* bar; unsigned x;
    volatile LAS unsigned* st;
};

__device__ __forceinline__ XcdBarrier xcd_barrier_post(unsigned* bar, volatile LAS unsigned* st) {
    XcdBarrier b; b.bar = bar; b.x = xb_xcc_id(); b.st = st;
    if (threadIdx.x == 0) (void)xb_add(&bar[XB_XCNT(b.x)], 1u);
    return b;
}
__device__ __forceinline__ void xcd_barrier_complete(unsigned* bar, unsigned x, unsigned& nloc, unsigned& nx) {
    const unsigned G = gridDim.x * gridDim.y * gridDim.z;
    unsigned sum, cnt, mine, sp = 0u;
    for (;;) {
        sum = 0u; cnt = 0u; mine = 0u;
#pragma unroll
        for (unsigned j = 0; j < 16; ++j) { const unsigned c = xb_ld(&bar[XB_XCNT(j)]); sum += c; cnt += (c > 0u) ? 1u : 0u; mine = (j == x) ? c : mine; }
        if (sum == G) break;
        __builtin_amdgcn_s_sleep(1);
        if ((++sp & 255u) == 0u) { if (xb_ld(&bar[XB_TMO])) break; if (sp > XB_SPIN_CAP) { atomicAdd(&bar[XB_TMO], 1u); break; } }
    }
    nloc = mine > 0u ? mine : 1u; nx = cnt > 0u ? cnt : 1u;
}

__device__ __forceinline__ void xcd_barrier(const XcdBarrier& b) {
    asm volatile("s_waitcnt vmcnt(0)" ::: "memory");
    __syncthreads();
    if (threadIdx.x == 0) {
        unsigned* bar = b.bar;
        __builtin_amdgcn_s_waitcnt(0);
        unsigned nloc = b.st[0], nx = b.st[1];
        if (nloc == 0u) { xcd_barrier_complete(bar, b.x, nloc, nx); b.st[0] = nloc; b.st[1] = nx; }
        const unsigned old = xb_add(&bar[XB_XSUB(b.x)], 1u);
        const unsigned gen = old / nloc;
        if (old + 1u == (gen + 1u) * nloc) {
            __builtin_amdgcn_fence(__ATOMIC_RELEASE, "agent");
            asm volatile("s_waitcnt vmcnt(0)" ::: "memory");
            const unsigned og = xb_add(&bar[XB_TOP], 1u);
            const unsigned tg = og / nx;
            if (og + 1u == (tg + 1u) * nx) xb_add(&bar[XB_TOPGEN], 1u);
            else XB_SPIN(xb_ld(&bar[XB_TOPGEN]) == tg, bar);
            __builtin_amdgcn_fence(__ATOMIC_ACQUIRE, "agent");
            xb_add(&bar[XB_XGEN(b.x)], 1u);
            asm volatile("s_waitcnt vmcnt(0)" ::: "memory");
        } else {
            XB_SPIN(xb_ld(&bar[XB_XGEN(b.x)]) == gen, bar);
            __builtin_amdgcn_fence(__ATOMIC_ACQUIRE, "agent");
            asm volatile("s_waitcnt vmcnt(0)" ::: "memory");
        }
    }
    __syncthreads();
}

struct Args { const float* in[23]; float* out; char* ws; };
constexpr int LDS_BYTES = 131072 + 4096;

typedef const __attribute__((address_space(4))) Args* kargs_t;
DEV kargs_t KA() { kargs_t k = (kargs_t)__builtin_amdgcn_kernarg_segment_ptr(); asm volatile("" : "+s"(k)); return k; }
#define WSP(type, off) ((type*)(ws + (off)))

__global__ __launch_bounds__(NTHR, 2) void mega(Args a) {
  extern __shared__ __attribute__((aligned(16))) char lds[];
  PG8_LAS unsigned char* glds = (PG8_LAS unsigned char*)lds;
  const int bid = blockIdx.x, G = gridDim.x;
  (void)a;
  volatile LAS unsigned* bst = (volatile LAS unsigned*)((LAS char*)lds + LDS_BYTES - 16);
  if (threadIdx.x < 4) bst[threadIdx.x] = 0u;
  __syncthreads();
  XcdBarrier xbar; { kargs_t k = KA(); xbar = xcd_barrier_post((unsigned*)k->ws, bst); }

  { kargs_t k = KA(); char* ws = k->ws;
    const int wv0_ = threadIdx.x >> 6;
    if (wv0_ < 4) { const int lane_ = threadIdx.x & 63, wv_ = wv0_, gw_ = bid * 4 + wv_, nw_ = G * 4;
      __attribute__((address_space(3))) float* scr = (__attribute__((address_space(3))) float*)((__attribute__((address_space(3))) char*)lds + wv_ * 8448);
      constexpr int I_IN = 16 * 120, I_C1 = 32 * 8;
      for (int it = gw_; it < I_IN + 2 * I_C1; it += nw_) {
        int r = it;
        if (r < I_IN) { tr_item<1>(k->in[2], 1024, IN_COLS, WSP(bf16_t, WS_WIN), 120, 3840, scr, r, lane_); continue; } r -= I_IN;
        if (r < I_C1) { tr_item<0>(k->in[5], 2048, 256, WSP(bf16_t, WS_CKW1), 8, 256, scr, r, lane_); continue; } r -= I_C1;
        tr_item<0>(k->in[7], 2048, 256, WSP(bf16_t, WS_CVW1), 8, 256, scr, r, lane_);
      }
      for (int i = gw_ * 64 + lane_; i < 16 * 128 * 64; i += nw_ * 64) WSP(bf16_t, WS_SUBK)[i] = f2bf(k->in[18][i]);
      for (int i = gw_ * 64 + lane_; i < SEQ * 16; i += nw_ * 64) rope_entry(WSP(float2, WS_ROPE), i);
    } else ph_rms1024<false>(k->in[0], k->in[1], WSP(bf16_t, WS_XN), T, nullptr, nullptr, bid * 4 + (wv0_ - 4), G * 4); }
  xcd_barrier(xbar);
  { kargs_t k = KA(); char* ws = k->ws;
    pg8::Gemm g{WSP(bf16_t, WS_XN), WSP(bf16_t, WS_WIN), T, 3840, 1024}; pg8::StaticOrder S; S.init(T, 3840, G, bid);
    pg8::EpiInProjF E{WSP(bf16_t, WS_PROJ), WSP(unsigned char, WS_GATES)};
    pg8::gemm_phase<pg8::EpiInProjF, pg8::StaticOrder, PG8_ALIGN, PG8_SP2>(glds, g, S, E);
    {
      const bool some = (G == 256); const int nb = some ? 64 : G, b0 = some ? bid - 192 : bid;
      if (b0 >= 0) {
        const int lane_ = threadIdx.x & 63, wv_ = threadIdx.x >> 6;
        __attribute__((address_space(3))) float* scr = (__attribute__((address_space(3))) float*)((__attribute__((address_space(3))) char*)lds + wv_ * 8448);
        constexpr int I_BR = 8 * 32, I_SQ = 16 * 32, I_C2 = 4 * 8, I_UQ = 4 * 24, I_UKV = 2 * 32;
        for (int it = b0 * NWV + wv_; it < 2 * I_BR + 2 * I_SQ + 2 * I_C2 + I_UQ + I_UKV; it += nb * NWV) {
          int r = it;
          if (r < I_UQ) { tr_item<0>(k->in[11], 256, 768, WSP(bf16_t, WS_UQ), 24, 768, scr, r, lane_); continue; } r -= I_UQ;
          if (r < I_UKV) { tr_item<0>(k->in[12], 128, 1024, WSP(bf16_t, WS_UKV), 32, 1024, scr, r, lane_); continue; } r -= I_UKV;
          if (r < I_C2) { tr_item<0>(k->in[6], 256, 64, WSP(bf16_t, WS_CKW2), 8, 64, scr, r, lane_); continue; } r -= I_C2;
          if (r < I_C2) { tr_item<0>(k->in[8], 256, 64, WSP(bf16_t, WS_CVW2), 8, 64, scr, r, lane_); continue; } r -= I_C2;
          if (r < I_BR) { tr_item<0>(k->in[13], 512, 1024, WSP(bf16_t, WS_WBN), 32, 1024, scr, r, lane_, 1024, 0); continue; } r -= I_BR;
          if (r < I_BR) { tr_item<0>(k->in[14], 512, 1024, WSP(bf16_t, WS_WBN), 32, 1024, scr, r, lane_, 1024, 512); continue; } r -= I_BR;
          if (r < I_SQ) { tr_item<0>(k->in[15], 1024, 1024, WSP(bf16_t, WS_WOUT), 32, 1024, scr, r, lane_); continue; } r -= I_SQ;
          tr_item<0>(k->in[17], 1024, 1024, WSP(bf16_t, WS_WQ), 32, 1024, scr, r, lane_);
        } } } }
  xcd_barrier(xbar);
  { kargs_t k = KA(); char* ws = k->ws;
    const int lane_ = threadIdx.x & 63, wv_ = threadIdx.x >> 6;
    if (G >= 128 && bid < 64) {
      const int tab = bid >> 5;
      pg8::Gemm g{WSP(bf16_t, WS_PROJ) + PC_KV + tab * 128, WSP(bf16_t, tab ? WS_CVW1 : WS_CKW1), 2048, 1024, 512};
      g.pitchA = 16u * PROJ_LD * 2u; g.kstepA = PROJ_LD * 2u; g.hstepA = 128; g.tA_pm = (size_t)SEQ * PROJ_LD * 2; g.tA_pn = (size_t)8 * PROJ_LD * 2;
      g.pitchB = 4096u; g.kstepB = 128u; g.hstepB = (size_t)128 * 4096; g.tB_pn = 1024; g.nt = 8;
      pg8::StaticOrder S; S.init(2048, 1024, 32, bid & 31);
      pg8::EpiSlabF E{WSP(float, WS_SLAB) + (size_t)tab * 4 * 2048 * 256};
      pg8::gemm_phase<pg8::EpiSlabF, pg8::StaticOrder, PG8_ALIGN, PG8_SP2>(glds, g, S, E);
    } else {
      const int nb = (G >= 128) ? G - 64 : G, b0 = (G >= 128) ? bid - 64 : bid;
      prep::cmp_bias(k->in[3], k->in[4], WSP(bf16_t, WS_CKW1), WSP(bf16_t, WS_CVW1), WSP(float, WS_CPOS), b0 * NWV + wv_, nb * NWV, lane_);
      prep::latent_rows(WSP(bf16_t, WS_PROJ), k->in[9], k->in[10], WSP(float2, WS_ROPE), WSP(bf16_t, WS_CQN), WSP(bf16_t, WS_CKVN), WSP(bf16_t, WS_KROPE), b0 * NWV + wv_, nb * NWV, lane_);
    } }
  xcd_barrier(xbar);
  if (G == 256 && ((bid + 64) & 255) >= 192) {
    kargs_t k = KA(); char* ws = k->ws;
    const int lane_ = threadIdx.x & 63, wv_ = threadIdx.x >> 6;
    if (wv_ < 2) { const int it = (((bid + 64) & 255) - 192) * 2 + wv_; const int tab = it >> 6;
      prep::cmp_l2(WSP(float, WS_SLAB) + (size_t)tab * 4 * 2048 * 256, WSP(float, WS_CPOS) + tab * 256, WSP(bf16_t, tab ? WS_CVW2 : WS_CKW2), WSP(bf16_t, tab ? WS_VC : WS_KC), it & 63, lane_); }
  } else if (G != 256) {
    kargs_t k = KA(); char* ws = k->ws;
    const int lane_ = threadIdx.x & 63, wv_ = threadIdx.x >> 6;
    for (int it = bid * NWV + wv_; it < 128; it += G * NWV) { const int tab = it >> 6;
      prep::cmp_l2(WSP(float, WS_SLAB) + (size_t)tab * 4 * 2048 * 256, WSP(float, WS_CPOS) + tab * 256, WSP(bf16_t, tab ? WS_CVW2 : WS_CKW2), WSP(bf16_t, tab ? WS_VC : WS_KC), it & 63, lane_); }
  }
  { kargs_t k = KA(); char* ws = k->ws;
    pg8::Gemm g{WSP(bf16_t, WS_CQN), WSP(bf16_t, WS_UQ), T, 768, 256}; pg8::StaticOrder S; S.init(T, 768, G, (bid + 64) & 255);
    pg8::EpiMlaQF E{WSP(bf16_t, WS_MLAQ), WSP(float2, WS_ROPE)};
    pg8::gemm_phase<pg8::EpiMlaQF, pg8::StaticOrder, PG8_ALIGN, PG8_SP2>(glds, g, S, E); }
  { kargs_t k = KA(); char* ws = k->ws;
    pg8::Gemm g{WSP(bf16_t, WS_CKVN), WSP(bf16_t, WS_UKV), T, 1024, 128}; pg8::StaticOrder S; S.init(T, 1024, G, bid);
    pg8::EpiBf16<0> E{WSP(bf16_t, WS_MLAKV), 1024, nullptr, 0, 0, 1.f};
    pg8::gemm_phase<pg8::EpiBf16<0>, pg8::StaticOrder, PG8_ALIGN, PG8_SP2>(glds, g, S, E); }
  xcd_barrier(xbar);
  { kargs_t k = KA(); char* ws = k->ws;
    att::attn_phase(WSP(bf16_t, WS_PROJ), WSP(bf16_t, WS_KC), WSP(bf16_t, WS_VC), k->in[21], WSP(bf16_t, WS_ONSA),
                    WSP(bf16_t, WS_MLAQ), WSP(bf16_t, WS_MLAKV), WSP(bf16_t, WS_KROPE), WSP(bf16_t, WS_ONSA), (att::lptr)lds); }
  xcd_barrier(xbar);
  { kargs_t k = KA(); char* ws = k->ws;
    pg8::Gemm g{WSP(bf16_t, WS_ONSA), WSP(bf16_t, WS_WBN), T, 1024, 1024}; pg8::StaticOrder S; S.init(T, 1024, G, bid);
    pg8::EpiMergeFusedF E{WSP(unsigned char, WS_GATES), WSP(bf16_t, WS_MERGED)};
    pg8::gemm_phase<pg8::EpiMergeFusedF, pg8::StaticOrder, PG8_ALIGN, PG8_SP2>(glds, g, S, E); }
  xcd_barrier(xbar);
  { kargs_t k = KA(); char* ws = k->ws;
    pg8::Gemm g{WSP(bf16_t, WS_MERGED), WSP(bf16_t, WS_WOUT), T, 1024, 1024}; pg8::StaticOrder S; S.init(T, 1024, G, bid);
    pg8::EpiBf16<0> E{WSP(bf16_t, WS_OB), 1024, nullptr, 0, 0, 1.f};
    pg8::gemm_phase<pg8::EpiBf16<0>, pg8::StaticOrder, PG8_ALIGN, PG8_SP2>(glds, g, S, E); }
  xcd_barrier(xbar);
  { kargs_t k = KA(); char* ws = k->ws; ph_rms1024<true>(k->in[0], k->in[16], WSP(bf16_t, WS_HN), T, WSP(unsigned, WS_HN8), WSP(float, WS_SH), -1, 0, WSP(bf16_t, WS_OB));
    peer::conv_tables(k->in[19], k->in[20], WSP(unsigned, WS_U8), WSP(float, WS_SU), WSP(unsigned, WS_V8)); }
  xcd_barrier(xbar);
  { kargs_t k = KA(); char* ws = k->ws;
    pg8::Gemm g{WSP(bf16_t, WS_HN), WSP(bf16_t, WS_WQ), T, 1024, 1024}; pg8::StaticOrder S; S.init(T, 1024, G, bid);
    pg8::EpiBf16<0> E{WSP(bf16_t, WS_PQ), 1024, nullptr, 0, 0, 1.f};
    pg8::gemm_phase<pg8::EpiBf16<0>, pg8::StaticOrder, PG8_ALIGN, PG8_SP2>(glds, g, S, E); }
  xcd_barrier(xbar);
  { kargs_t k = KA(); char* ws = k->ws; peer::route_phase(WSP(bf16_t, WS_PQ), WSP(bf16_t, WS_SUBK), WSP(unsigned, WS_PIDX), (__attribute__((address_space(3))) char*)lds); }
  xcd_barrier(xbar);
  { kargs_t k = KA(); char* ws = k->ws;
    peer::experts_sliced<0>(WSP(unsigned, WS_PIDX), WSP(unsigned, WS_HN8), WSP(float, WS_SH), WSP(unsigned, WS_U8), WSP(float, WS_SU), WSP(float, WS_CO), WSP(unsigned, WS_V8), k->out, WSP(float, WS_SSQ),
                            (unsigned*)ws + CTL_QA, (__attribute__((address_space(3))) char*)lds); }
  xcd_barrier(xbar);
  { kargs_t k = KA(); char* ws = k->ws;
    peer::experts_sliced<1>(WSP(unsigned, WS_PIDX), WSP(unsigned, WS_HN8), WSP(float, WS_SH), WSP(unsigned, WS_U8), WSP(float, WS_SU), WSP(float, WS_CO), WSP(unsigned, WS_V8), (float*)WSP(bf16_t, WS_ZB), WSP(float, WS_SSQ),
                            (unsigned*)ws + CTL_QB, (__attribute__((address_space(3))) char*)lds, k->in[0], WSP(bf16_t, WS_OB)); }
  xcd_barrier(xbar);
  { kargs_t k = KA(); char* ws = k->ws; peer::experts_norm(WSP(float, WS_SSQ), k->in[22], WSP(bf16_t, WS_ZB), k->out); }
}

extern "C" void kernel_launch(void* const* d_in, const int* in_sizes, int n_in, void* d_out, int out_size, void* d_ws, size_t ws_size, hipStream_t stream) {
  if (n_in != 23 || ws_size < 256 * MiB) { fprintf(stderr, "kernel_launch: unexpected n_in %d / ws_size %zu\n", n_in, ws_size); return; }
  static int grid_blocks = 0;
  if (!grid_blocks) {
    int dev = 0, cus = 0, per_cu = 0;
    (void)hipGetDevice(&dev);
    (void)hipDeviceGetAttribute(&cus, hipDeviceAttributeMultiprocessorCount, dev);
    if (hipFuncSetAttribute((const void*)mega, hipFuncAttributeMaxDynamicSharedMemorySize, LDS_BYTES) != hipSuccess) fprintf(stderr, "kernel_launch: hipFuncSetAttribute failed\n");
    (void)hipOccupancyMaxActiveBlocksPerMultiprocessor(&per_cu, (const void*)mega, NTHR, LDS_BYTES);
    if (per_cu < 1) { fprintf(stderr, "kernel_launch: occupancy query returned %d\n", per_cu); per_cu = 1; }
    if (per_cu > 2) per_cu = 2;
    grid_blocks = cus * per_cu;
    fprintf(stderr, "kernel_launch: cus %d per_cu %d grid %d ws %zu\n", cus, per_cu, grid_blocks, ws_size);
  }
  if (hipMemsetAsync(d_ws, 0, 65536, stream) != hipSuccess) fprintf(stderr, "kernel_launch: hipMemsetAsync failed\n");
  Args a{};
  for (int i = 0; i < 23; ++i) a.in[i] = (const float*)d_in[i];
  a.out = (float*)d_out; a.ws = (char*)d_ws;
  void* args[] = {&a};
  hipError_t e = hipLaunchCooperativeKernel((const void*)mega, dim3(grid_blocks), dim3(NTHR), args, LDS_BYTES, stream);
  if (e != hipSuccess) fprintf(stderr, "cooperative launch failed: %s (grid %d)\n", hipGetErrorString(e), grid_blocks);
}
```

```cpp
#include <hip/hip_runtime.h>
#include <stdint.h>
#include <cstdio>
#include <hip/hip_cooperative_groups.h>
namespace cg = cooperative_groups;

typedef unsigned short bf16_t;
#define DEV __device__ __forceinline__

constexpr int BATCH = 8, SEQ = 2048, DM = 1024, T = BATCH * SEQ;
constexpr int IN_COLS = 3768;
constexpr int PROJ_LD = 1792;
constexpr int PC_Q = 0, PC_KV = 512, PC_CQ = 1280, PC_CKV = 1536, PC_KR = 1664, PC_GATE = 1696;
constexpr int NC = 127;
constexpr size_t MiB = 1u << 20;

constexpr size_t WS_WIN = 1 * MiB;
constexpr size_t WS_WBN = 9 * MiB;
constexpr size_t WS_WBM = 10 * MiB;
constexpr size_t WS_WOUT = 11 * MiB;
constexpr size_t WS_WQ = 13 * MiB;
constexpr size_t WS_CKW1 = 15 * MiB;
constexpr size_t WS_CVW1 = 16 * MiB;
constexpr size_t WS_CKW2 = 17 * MiB;
constexpr size_t WS_CVW2 = 17 * MiB + 128 * 1024;
constexpr size_t WS_UQ = 17 * MiB + 256 * 1024;
constexpr size_t WS_UKV = 17 * MiB + 768 * 1024;
constexpr size_t WS_SUBK = 18 * MiB;
constexpr size_t WS_ROPE = 18 * MiB + 512 * 1024;
constexpr size_t WS_GATES = 20 * MiB;
constexpr size_t WS_PQ = 20 * MiB;
constexpr size_t WS_ZB = 20 * MiB;
constexpr size_t WS_OB = 52 * MiB;
constexpr size_t WS_PROJ = 84 * MiB;
constexpr size_t WS_MERGED = 84 * MiB;
constexpr size_t WS_PIDX = 84 * MiB;
constexpr size_t WS_U8 = 172 * MiB;
constexpr size_t WS_V8 = 188 * MiB;
constexpr size_t WS_SU = 204 * MiB;
constexpr size_t WS_SH = 204 * MiB + 65536;
constexpr size_t WS_HN8 = 205 * MiB;
constexpr size_t WS_CO = 221 * MiB;
constexpr size_t WS_SSQ = 229 * MiB;
constexpr int CTL_QA = 4096, CTL_QB = 4096 + 512;
constexpr size_t WS_PW = 92 * MiB;
constexpr size_t WS_XN = 140 * MiB;
constexpr size_t WS_MLAKV = 140 * MiB;
constexpr size_t WS_HN = 140 * MiB;
constexpr size_t WS_MLAQ = 172 * MiB;
constexpr size_t WS_KROPE = 196 * MiB;
constexpr size_t WS_KC = 197 * MiB;
constexpr size_t WS_VC = 197 * MiB + 512 * 1024;
constexpr size_t WS_ONSA = 198 * MiB;
constexpr size_t WS_OMLA = 214 * MiB;
constexpr size_t WS_SLAB = 198 * MiB;
constexpr size_t WS_CPOS = 18 * MiB + 768 * 1024;
constexpr size_t WS_CA = 198 * MiB;
constexpr size_t WS_HID = 206 * MiB;
constexpr size_t WS_HID2 = 207 * MiB;
constexpr size_t WS_CA2 = 214 * MiB;
constexpr size_t WS_CQN = 230 * MiB;
constexpr size_t WS_CKVN = 238 * MiB;
constexpr size_t WS_OCMP = 230 * MiB;
constexpr size_t WS_SEL = 246 * MiB;

__device__ const unsigned char T5B[128] = {
  0, 1, 2, 3, 4, 5, 6, 7, 8, 9, 10, 11, 12, 13, 14, 15, 16, 16, 16, 17, 17, 18, 18, 18, 19, 19, 19, 20, 20, 20, 20, 21,
  21, 21, 21, 22, 22, 22, 22, 22, 23, 23, 23, 23, 23, 23, 24, 24, 24, 24, 24, 24, 25, 25, 25, 25, 25, 25, 25, 26, 26, 26, 26, 26,
  26, 26, 26, 27, 27, 27, 27, 27, 27, 27, 27, 27, 27, 28, 28, 28, 28, 28, 28, 28, 28, 28, 28, 29, 29, 29, 29, 29, 29, 29, 29, 29,
  29, 29, 29, 30, 30, 30, 30, 30, 30, 30, 30, 30, 30, 30, 30, 30, 30, 31, 31, 31, 31, 31, 31, 31, 31, 31, 31, 31, 31, 31, 31, 31};

DEV float bf2f(bf16_t v) { return __uint_as_float(((unsigned)v) << 16); }
DEV bf16_t f2bf(float f) { unsigned u = __float_as_uint(f); u += 0x7fffu + ((u >> 16) & 1u); return (bf16_t)(u >> 16); }
template <int CTRL> DEV int dpp_i(int v) { return __builtin_amdgcn_update_dpp(0, v, CTRL, 0xF, 0xF, true); }
template <int CTRL> DEV float dpp_f(float v) { return __uint_as_float((unsigned)__builtin_amdgcn_update_dpp(0, (int)__float_as_uint(v), CTRL, 0xF, 0xF, true)); }
DEV int sum16_i(int v) { v += dpp_i<0xB1>(v); v += dpp_i<0x4E>(v); v += dpp_i<0x141>(v); v += dpp_i<0x140>(v); return v; }
DEV float sum16_f(float v) { v += dpp_f<0xB1>(v); v += dpp_f<0x4E>(v); v += dpp_f<0x141>(v); v += dpp_f<0x140>(v); return v; }
DEV float max16_f(float v) { v = fmaxf(v, dpp_f<0xB1>(v)); v = fmaxf(v, dpp_f<0x4E>(v)); v = fmaxf(v, dpp_f<0x141>(v)); v = fmaxf(v, dpp_f<0x140>(v)); return v; }
DEV float rl_f(float v, int l) { return __uint_as_float((unsigned)__builtin_amdgcn_readlane((int)__float_as_uint(v), l)); }
DEV float wsum(float v) { v = sum16_f(v); return (rl_f(v, 0) + rl_f(v, 16)) + (rl_f(v, 32) + rl_f(v, 48)); }
DEV float wmaxf(float v) { v = max16_f(v); return fmaxf(fmaxf(rl_f(v, 0), rl_f(v, 16)), fmaxf(rl_f(v, 32), rl_f(v, 48))); }
DEV float sigmoidf_(float x) { return 1.0f / (1.0f + expf(-x)); }
DEV float gelu_exact(float x) { return 0.5f * x * (1.0f + erff(x * 0.70710678118654752f)); }
DEV void wave_lds_sync() { asm volatile("s_waitcnt lgkmcnt(0)" ::: "memory"); __builtin_amdgcn_wave_barrier(); asm volatile("" ::: "memory"); }
DEV float t5bias(const float* t5, int head, int dist) { int d = dist < 127 ? dist : 127; d = d < 0 ? 0 : d; return t5[(int)T5B[d] * 8 + head]; }


namespace pg8 {
#define PG8_LAS __attribute__((address_space(3)))
typedef unsigned short bf16_t;
typedef short bf16x8 __attribute__((ext_vector_type(8)));
typedef float f32x4 __attribute__((ext_vector_type(4)));
typedef unsigned u32x4 __attribute__((ext_vector_type(4)));
constexpr int BM = 256, BK = 64, HALF = 128, HTB = HALF * BK * 2  , STAGE_BYTES = 8 * HTB, NXCD = 8, WGM = 8;

__host__ __device__ __forceinline__ int lds_byte(int r, int c) { const int st = (r >> 4) * 2 + (c >> 5), rr = r & 15, cc = c & 31, ob = rr * 64 + cc * 2; return st * 1024 + (ob ^ (((ob >> 9) & 1) << 5)); }
__host__ __device__ __forceinline__ void stage_rc(int b, int& R, int& C) { const int st = b / 1024, sb = b % 1024, swz = sb ^ (((sb >> 9) & 1) << 5); R = (st >> 1) * 16 + swz / 64; C = (st & 1) * 32 + (swz % 64) / 2; }
__host__ __device__ __forceinline__ int perm32(int rho) { const int n = rho >> 4, i = rho & 15; return 8 * (i >> 2) + 4 * n + (i & 3); }

struct Unit { int pm, pn; };
struct Gemm { const bf16_t* A; const bf16_t* Bt; int M, N, K;
    unsigned pitchA = 0, pitchB = 0, kstepA = 0, kstepB = 0; size_t hstepA = 0, hstepB = 0, tA_pm = 0, tA_pn = 0, tB_pn = 0; int nt = 0; };

struct StaticOrder {
    int nM, nN, nwg, G, c;
    __host__ __device__ void init(int M, int N, int G_, int c_) { nM = M / BM; nN = N / BM; nwg = nM * nN; G = G_; c = c_; }
    __host__ __device__ __forceinline__ bool next(int i, Unit& u) const {
        const long L = (long)i * G + c; if (L >= nwg) return false;
        int wgid = (int)L; { const int q = nwg / NXCD, r = nwg % NXCD, xcd = wgid % NXCD, off = wgid / NXCD; wgid = (xcd < r ? xcd * (q + 1) : r * (q + 1) + (xcd - r) * q) + off; }
        const int nig = WGM * nN, gid = wgid / nig, fm = gid * WGM, gsz = (nM - fm) < WGM ? (nM - fm) : WGM;
        u.pm = fm + ((wgid % nig) % gsz); u.pn = (wgid % nig) / gsz; return true;
    }
    __device__ __forceinline__ void a_ready(const Unit&) const {}
    __device__ __forceinline__ void done(const Unit&) const {}
};

__device__ __forceinline__ unsigned cvt_pk_bf16(float lo, float hi) { unsigned r; asm volatile("v_cvt_pk_bf16_f32 %0, %1, %2" : "=v"(r) : "v"(lo), "v"(hi)); return r; }
typedef float f32x2 __attribute__((ext_vector_type(2)));
__device__ __forceinline__ f32x2 gelu_pk(f32x2 v) {
    const f32x2 av = __builtin_elementwise_abs(v), d = av * 0.2316418882f + 1.0f;
    f32x2 t; t.x = __builtin_amdgcn_rcpf(d.x); t.y = __builtin_amdgcn_rcpf(d.y);
    f32x2 q = t * 0.5307027145f + (-0.7265760135f); q = q * t + 0.7107068705f; q = q * t + (-0.142248368f); q = q * t + 0.127414796f; q = q * t;
    const f32x2 s = (v * v) * (-0.72134752044f);
    f32x2 e; e.x = __builtin_amdgcn_exp2f(s.x); e.y = __builtin_amdgcn_exp2f(s.y);
    const f32x2 m = v * (q * e), r = v - m;
    f32x2 o; o.x = v.x < 0.f ? m.x : r.x; o.y = v.y < 0.f ? m.y : r.y; return o;
}

template <int ACT  > struct EpiBf16 {
    static constexpr bool PERM = true, AFTER_DRAIN = false, MIDK = false; static_assert(ACT == 0 || ACT == 1, "EpiBf16: ACT is 0 (none) or 1 (gelu_pk)");
    bf16_t* O; int ldc; const float* bias; int split_cols; size_t split_stride; float scale0;
    __device__ __forceinline__ void operator()(const f32x4 (&acc)[2][2][4][2], const Unit& u, int wr, int wc, int fr, int fq) const {
        const int row0 = u.pm * BM + wr * 64 + fr; int colt = u.pn * BM; bf16_t* base = O;
        float sc = 1.f; if (split_cols) { const int t = colt / split_cols; base += (size_t)t * split_stride; colt -= t * split_cols; if (t == 0) sc = scale0; }
        const int col0 = colt + wc * 32 + 8 * fq, bcol0 = u.pn * BM + wc * 32 + 8 * fq;
        f32x4 bv[2][2];
#pragma unroll
        for (int bj = 0; bj < 2; ++bj)
#pragma unroll
            for (int n = 0; n < 2; ++n) bv[bj][n] = bias ? *(const f32x4*)(bias + bcol0 + bj * HALF + 4 * n) : (f32x4){0.f, 0.f, 0.f, 0.f};
#pragma unroll
        for (int ai = 0; ai < 2; ++ai)
#pragma unroll
            for (int m = 0; m < 4; ++m) { bf16_t* rowp = base + (size_t)(row0 + ai * HALF + m * 16) * ldc + col0;
#pragma unroll
                for (int bj = 0; bj < 2; ++bj) { f32x4 v0 = acc[ai][bj][m][0] + bv[bj][0], v1 = acc[ai][bj][m][1] + bv[bj][1];
                    if (ACT == 1) { f32x2 a = gelu_pk((f32x2){v0[0], v0[1]}), b = gelu_pk((f32x2){v0[2], v0[3]}), c = gelu_pk((f32x2){v1[0], v1[1]}), d = gelu_pk((f32x2){v1[2], v1[3]});
                        v0 = (f32x4){a.x, a.y, b.x, b.y}; v1 = (f32x4){c.x, c.y, d.x, d.y}; }
                    v0 = v0 * sc; v1 = v1 * sc; u32x4 w; w.x = cvt_pk_bf16(v0[0], v0[1]); w.y = cvt_pk_bf16(v0[2], v0[3]); w.z = cvt_pk_bf16(v1[0], v1[1]); w.w = cvt_pk_bf16(v1[2], v1[3]);
                    *(u32x4*)(rowp + bj * HALF) = w; } }
    }
};

struct PanelStats {
    unsigned* xbuf;
    unsigned* cnt;
    unsigned* tmo;
    int ntn; float eps;
    unsigned code;
    __device__ __forceinline__ bool run(const f32x4 (&v)[2][2][4][2], const Unit& u, int wr, int wc, int fr, int fq, PG8_LAS unsigned char* lds, int wid, int lane) const {
        typedef float f32x2v __attribute__((ext_vector_type(2)));
        PG8_LAS f32x2v* P = (PG8_LAS f32x2v*)lds;
        PG8_LAS f32x2v* S = (PG8_LAS f32x2v*)(lds + 8192);
        PG8_LAS unsigned* flag = (PG8_LAS unsigned*)(lds + 8192 + 2048);
#pragma unroll
        for (int ai = 0; ai < 2; ++ai)
#pragma unroll
            for (int m = 0; m < 4; ++m) {
                float s = 0.f;
#pragma unroll
                for (int bj = 0; bj < 2; ++bj)
#pragma unroll
                    for (int n = 0; n < 2; ++n) { const f32x4 x = v[ai][bj][m][n]; s += (x[0] + x[1]) + (x[2] + x[3]); }
                s += __shfl_xor(s, 16); s += __shfl_xor(s, 32);
                const float mw = s * (1.0f / 64.0f); float q = 0.f;
#pragma unroll
                for (int bj = 0; bj < 2; ++bj)
#pragma unroll
                    for (int n = 0; n < 2; ++n) { const f32x4 d = v[ai][bj][m][n] - mw; q += (d[0] * d[0] + d[1] * d[1]) + (d[2] * d[2] + d[3] * d[3]); }
                q += __shfl_xor(q, 16); q += __shfl_xor(q, 32);
                if (fq == 0) P[(ai * HALF + wr * 64 + m * 16 + fr) * 4 + wc] = (f32x2v){mw, q};
            }
        asm volatile("s_waitcnt lgkmcnt(0)" ::: "memory"); __builtin_amdgcn_s_barrier(); asm volatile("" ::: "memory");
#if defined(BROKEN_EXCHANGE_NO_WAIT)
#warning BROKEN CONTROL BUILD: the row-statistics exchange does not wait; results are wrong by design
        if (blockIdx.x >= 64) { const long long t0_ = clock64(); while (clock64() - t0_ < 60000) __builtin_amdgcn_s_sleep(8); }
#endif
        const int row = wid * 32 + (lane & 31);
        if (lane < 32) {
            const f32x2v a = P[row * 4 + 0], b = P[row * 4 + 1], c = P[row * 4 + 2], d = P[row * 4 + 3];
            const float mt = (a.x + b.x + c.x + d.x) * 0.25f;
            const float da = a.x - mt, db = b.x - mt, dc = c.x - mt, dd = d.x - mt;
            const float m2 = (a.y + b.y) + (c.y + d.y) + 64.0f * ((da * da + db * db) + (dc * dc + dd * dd));
            unsigned long long* slot = (unsigned long long*)xbuf + ((size_t)(u.pm * BM + row) * 4 + u.pn);
            __hip_atomic_store(slot, ((unsigned long long)__float_as_uint(m2) << 32) | __float_as_uint(mt), __ATOMIC_RELAXED, __HIP_MEMORY_SCOPE_AGENT);
        }
        asm volatile("s_waitcnt vmcnt(0)" ::: "memory");
        if (lane == 0) __hip_atomic_fetch_add(cnt + 64 * u.pm, 1u, __ATOMIC_RELAXED, __HIP_MEMORY_SCOPE_AGENT);
        if (wid == 0) {
            bool dead = false; const unsigned long long t0 = __builtin_amdgcn_s_memrealtime(); const unsigned want = 8u * (unsigned)ntn;
            for (;;) {
#if defined(BROKEN_EXCHANGE_NO_WAIT)
                break;
#endif
                if ((unsigned)__builtin_amdgcn_readfirstlane(__hip_atomic_load(cnt + 64 * u.pm, __ATOMIC_RELAXED, __HIP_MEMORY_SCOPE_AGENT)) >= want) break;
                if (__builtin_amdgcn_s_memrealtime() - t0 > 2000000ull) {
                    if (lane == 0) { unsigned expect = 0u; __hip_atomic_compare_exchange_strong(tmo + 1, &expect, code | (unsigned)(u.pm & 0xff), __ATOMIC_RELAXED, __ATOMIC_RELAXED, __HIP_MEMORY_SCOPE_AGENT);
                                     __hip_atomic_store(tmo, 1u, __ATOMIC_RELAXED, __HIP_MEMORY_SCOPE_AGENT); }
                    dead = true; break; }
                __builtin_amdgcn_s_sleep(2);
            }
            __builtin_amdgcn_fence(__ATOMIC_ACQUIRE, "agent");
            if (lane == 0) flag[0] = dead ? 1u : 0u;
        }
        asm volatile("s_waitcnt vmcnt(0) lgkmcnt(0)" ::: "memory"); __builtin_amdgcn_s_barrier(); asm volatile("" ::: "memory");
        const bool bad = flag[0] != 0u;
        if (lane < 32) {
            const unsigned long long* slot = (const unsigned long long*)xbuf + (size_t)(u.pm * BM + row) * 4; float mt[4], m2[4]; float ms = 0.f;
#pragma unroll
            for (int t = 0; t < 4; ++t) { if (t < ntn) { const unsigned long long w = __hip_atomic_load(slot + t, __ATOMIC_RELAXED, __HIP_MEMORY_SCOPE_AGENT); mt[t] = __uint_as_float((unsigned)w); m2[t] = __uint_as_float((unsigned)(w >> 32)); } else { mt[t] = 0.f; m2[t] = 0.f; } ms += mt[t]; }
            const float mean = ms / (float)ntn; float q = 0.f;
#pragma unroll
            for (int t = 0; t < 4; ++t) if (t < ntn) { const float dm = mt[t] - mean; q += m2[t] + 256.0f * dm * dm; }
            S[row] = (f32x2v){mean, 1.0f / sqrtf(q / (256.0f * (float)ntn) + eps)};
        }
        asm volatile("s_waitcnt lgkmcnt(0)" ::: "memory"); __builtin_amdgcn_s_barrier(); asm volatile("" ::: "memory");
        return bad;
    }
};
struct EpiLnRes {
    static constexpr bool PERM = false, AFTER_DRAIN = true, MIDK = false;
    const float* base; float* out; int ldc; const float* bias; PanelStats st; unsigned poison;
    __device__ __forceinline__ void fused(f32x4 (&acc)[2][2][4][2], const Unit& u, int wr, int wc, int fr, int fq, PG8_LAS unsigned char* lds, int wid, int lane) const {
        typedef float f32x2v __attribute__((ext_vector_type(2)));
        const PG8_LAS f32x2v* S = (const PG8_LAS f32x2v*)(lds + 8192);
        const int col0 = u.pn * BM + wc * 32 + 4 * fq;
#pragma unroll
        for (int bj = 0; bj < 2; ++bj)
#pragma unroll
            for (int n = 0; n < 2; ++n) { const f32x4 bv = bias ? *(const f32x4*)(bias + col0 + bj * HALF + n * 16) : (f32x4){0.f, 0.f, 0.f, 0.f};
#pragma unroll
                for (int ai = 0; ai < 2; ++ai)
#pragma unroll
                    for (int m = 0; m < 4; ++m) acc[ai][bj][m][n] += bv; }
        f32x4 pre[4][2][2];
#pragma unroll
        for (int m = 0; m < 4; ++m) { const size_t off = (size_t)(u.pm * BM + wr * 64 + m * 16 + fr) * ldc + col0;
#pragma unroll
            for (int bj = 0; bj < 2; ++bj)
#pragma unroll
                for (int n = 0; n < 2; ++n) pre[m][bj][n] = *(const f32x4*)(base + off + bj * HALF + n * 16); }
        const bool bad = st.run(acc, u, wr, wc, fr, fq, lds, wid, lane) || poison != 0u;
        const float qnan = __builtin_nanf("");
#pragma unroll
        for (int ai = 0; ai < 2; ++ai)
#pragma unroll
            for (int m = 0; m < 4; ++m) { const int r = ai * HALF + wr * 64 + m * 16 + fr; const f32x2v sr = S[r]; const size_t off = (size_t)(u.pm * BM + r) * ldc + col0;
#pragma unroll
                for (int bj = 0; bj < 2; ++bj)
#pragma unroll
                    for (int n = 0; n < 2; ++n) { const f32x4 bs = ai == 0 ? pre[m][bj][n] : *(const f32x4*)(base + off + bj * HALF + n * 16); f32x4 o = bs + (acc[ai][bj][m][n] - sr.x) * sr.y;
                        if (bad) o = (f32x4){qnan, qnan, qnan, qnan}; *(f32x4*)(out + off + bj * HALF + n * 16) = o; }
                if (m & 1) asm volatile("" ::: "memory"); }
    }
};
struct EpiLnResLn {
    static constexpr bool PERM = false, AFTER_DRAIN = true, MIDK = false;
    const float* base; float* out; bf16_t* xn; int ldc; const float* bias; PanelStats st1, st2; unsigned poison;
    __device__ __forceinline__ void fused(f32x4 (&acc)[2][2][4][2], const Unit& u, int wr, int wc, int fr, int fq, PG8_LAS unsigned char* lds, int wid, int lane) const {
        typedef float f32x2v __attribute__((ext_vector_type(2))); typedef unsigned u32x2v __attribute__((ext_vector_type(2)));
        const PG8_LAS f32x2v* S = (const PG8_LAS f32x2v*)(lds + 8192);
        const int col0 = u.pn * BM + wc * 32 + 4 * fq;
#pragma unroll
        for (int bj = 0; bj < 2; ++bj)
#pragma unroll
            for (int n = 0; n < 2; ++n) { const f32x4 bv = bias ? *(const f32x4*)(bias + col0 + bj * HALF + n * 16) : (f32x4){0.f, 0.f, 0.f, 0.f};
#pragma unroll
                for (int ai = 0; ai < 2; ++ai)
#pragma unroll
                    for (int m = 0; m < 4; ++m) acc[ai][bj][m][n] += bv; }
        bool bad = st1.run(acc, u, wr, wc, fr, fq, lds, wid, lane) || poison != 0u;
        const float qnan = __builtin_nanf("");
#pragma unroll
        for (int ai = 0; ai < 2; ++ai)
#pragma unroll
            for (int m = 0; m < 4; ++m) { const int r = ai * HALF + wr * 64 + m * 16 + fr; const f32x2v sr = S[r]; const size_t off = (size_t)(u.pm * BM + r) * ldc + col0;
#pragma unroll
                for (int bj = 0; bj < 2; ++bj)
#pragma unroll
                    for (int n = 0; n < 2; ++n) { const f32x4 bs = *(const f32x4*)(base + off + bj * HALF + n * 16); acc[ai][bj][m][n] = bs + (acc[ai][bj][m][n] - sr.x) * sr.y; }
                asm volatile("" : "+v"(acc[ai][0][m][0]), "+v"(acc[ai][0][m][1]), "+v"(acc[ai][1][m][0]), "+v"(acc[ai][1][m][1]));
                if (m & 1) asm volatile("" ::: "memory"); }
        const bool bad1 = bad;
        bad = st2.run(acc, u, wr, wc, fr, fq, lds, wid, lane) || bad;
#pragma unroll
        for (int ai = 0; ai < 2; ++ai)
#pragma unroll
            for (int m = 0; m < 4; ++m) { const int r = ai * HALF + wr * 64 + m * 16 + fr; const f32x2v sr = S[r]; const size_t off = (size_t)(u.pm * BM + r) * ldc + col0;
#pragma unroll
                for (int bj = 0; bj < 2; ++bj)
#pragma unroll
                    for (int n = 0; n < 2; ++n) { const f32x4 x1 = acc[ai][bj][m][n]; *(f32x4*)(out + off + bj * HALF + n * 16) = bad1 ? (f32x4){qnan, qnan, qnan, qnan} : x1;
                        const f32x4 o = (x1 - sr.x) * sr.y; u32x2v w; w.x = cvt_pk_bf16(o[0], o[1]); w.y = cvt_pk_bf16(o[2], o[3]);
                        if (bad) { w.x = 0x7fc07fc0u; w.y = 0x7fc07fc0u; } *(u32x2v*)(xn + off + bj * HALF + n * 16) = w; }
                asm volatile("" ::: "memory"); }
    }
};

template <class Epi, class Sched, bool ALIGN_EPI = false, bool SP2 = false>
__device__ __forceinline__ void gemm_phase(PG8_LAS unsigned char* lds, const Gemm g, const Sched& S, const Epi& E) {
    int tid = threadIdx.x; asm volatile("" : "+v"(tid));
    const int wid = __builtin_amdgcn_readfirstlane(tid >> 6), lane = tid & 63, wr = wid >> 2, wc = wid & 3, fr = lane & 15, fq = lane >> 4;
    int K = g.K; asm volatile("" : "+s"(K)); const int nt = g.nt ? g.nt : K / BK;
    const unsigned pitchA = g.pitchA ? g.pitchA : (unsigned)K * 2u, pitchB = g.pitchB ? g.pitchB : (unsigned)K * 2u;
    unsigned voffA[2], voffB[2];
#pragma unroll
    for (int i = 0; i < 2; ++i) { int R, C; stage_rc(tid * 16 + i * 8192, R, C); const int Rb = Epi::PERM ? ((R & ~31) + perm32(R & 31)) : R;
        voffA[i] = (unsigned)R * pitchA + (unsigned)C * 2u; voffB[i] = (unsigned)Rb * pitchB + (unsigned)C * 2u; }
    const size_t kstepA = g.kstepA ? g.kstepA : (size_t)(BK * 2), kstepB = g.kstepB ? g.kstepB : (size_t)(BK * 2);
    const size_t hstepA = g.hstepA ? g.hstepA : (size_t)HALF * K * 2, hstepB = g.hstepB ? g.hstepB : (size_t)HALF * K * 2;
    const size_t tA_pm = g.tA_pm ? g.tA_pm : (size_t)BM * K * 2, tA_pn = g.tA_pn, tB_pn = g.tB_pn ? g.tB_pn : (size_t)BM * K * 2;
    const unsigned ldsw = (unsigned)wid * 1024u;
    const int aoff = lds_byte(wr * 64 + fr, fq * 8), boff = lds_byte(wc * 32 + fr, fq * 8);
#define PG8_SA(b, h) (((b) * 2 + (h)) * HTB)
#define PG8_SB(b, h) ((4 + (b) * 2 + (h)) * HTB)
#define PG8_STAGE(bufoff, gbase, voff) do { _Pragma("unroll") for (int _i = 0; _i < 2; ++_i) \
        __builtin_amdgcn_global_load_lds((const unsigned*)((const char*)(gbase) + (voff)[_i]), (PG8_LAS unsigned*)(lds + (bufoff) + ldsw + _i * 8192), 16, 0, 0); } while (0)
#define PG8_LDA(dst, b, h) do { _Pragma("unroll") for (int m = 0; m < 4; ++m) _Pragma("unroll") for (int k = 0; k < 2; ++k) dst[m][k] = *(const PG8_LAS bf16x8*)(lds + PG8_SA(b, h) + aoff + m * 2048 + k * 1024); } while (0)
#define PG8_LDB(dst, b, h) do { _Pragma("unroll") for (int n = 0; n < 2; ++n) _Pragma("unroll") for (int k = 0; k < 2; ++k) dst[n][k] = *(const PG8_LAS bf16x8*)(lds + PG8_SB(b, h) + boff + n * 2048 + k * 1024); } while (0)
#define PG8_MMA(ai, bj, At, Bt) do { __builtin_amdgcn_s_setprio(1); _Pragma("unroll") for (int m = 0; m < 4; ++m) _Pragma("unroll") for (int n = 0; n < 2; ++n) _Pragma("unroll") for (int k = 0; k < 2; ++k) \
        acc[ai][bj][m][n] = __builtin_amdgcn_mfma_f32_16x16x32_bf16(Bt[n][k], At[m][k], acc[ai][bj][m][n], 0, 0, 0); __builtin_amdgcn_s_setprio(0); } while (0)
#define PG8_WAIT_V(n) asm volatile("s_waitcnt vmcnt(" #n ")" ::: "memory")
#define PG8_WAIT_L(n) asm volatile("s_waitcnt lgkmcnt(" #n ")" ::: "memory")
#define PG8_BAR __builtin_amdgcn_s_barrier()
#define PG8_SCHED __builtin_amdgcn_sched_barrier(0)
    Unit cur, nxt; int ui = 0;
    if (!S.next(0, cur)) return;
    f32x4 acc[2][2][4][2];
#pragma unroll
    for (int a = 0; a < 2; ++a)
#pragma unroll
        for (int b = 0; b < 2; ++b)
#pragma unroll
            for (int m = 0; m < 4; ++m)
#pragma unroll
                for (int n = 0; n < 2; ++n) acc[a][b][m][n] = (f32x4){0.f, 0.f, 0.f, 0.f};
    bf16x8 At[4][2], B0[2][2], B1[2][2];
    const char* cA = (const char*)g.A + (size_t)cur.pm * tA_pm + (size_t)cur.pn * tA_pn; const char* cB = (const char*)g.Bt + (size_t)cur.pn * tB_pn;
    S.a_ready(cur);
    if constexpr (SP2) {
        PG8_STAGE(PG8_SB(0, 0), cB, voffB); PG8_STAGE(PG8_SB(0, 1), cB + hstepB, voffB); PG8_STAGE(PG8_SA(0, 0), cA, voffA); PG8_STAGE(PG8_SA(0, 1), cA + hstepA, voffA);
        if (wr == 1) PG8_BAR;
        PG8_WAIT_V(2); PG8_BAR;
        PG8_STAGE(PG8_SB(1, 0), cB + kstepB, voffB); PG8_STAGE(PG8_SA(1, 0), cA + kstepA, voffA); PG8_STAGE(PG8_SB(1, 1), cB + hstepB + kstepB, voffB);
        PG8_WAIT_V(6); PG8_BAR;
    } else {
        PG8_STAGE(PG8_SB(0, 0), cB, voffB); PG8_STAGE(PG8_SA(0, 0), cA, voffA); PG8_STAGE(PG8_SB(0, 1), cB + hstepB, voffB); PG8_STAGE(PG8_SA(0, 1), cA + hstepA, voffA);
        if (wr == 1) PG8_BAR;
        PG8_WAIT_V(4); PG8_BAR;
        PG8_STAGE(PG8_SB(1, 0), cB + kstepB, voffB); PG8_STAGE(PG8_SA(1, 0), cA + kstepA, voffA); PG8_STAGE(PG8_SB(1, 1), cB + hstepB + kstepB, voffB);
        PG8_WAIT_V(6); PG8_BAR;
    }
    for (;;) {
        const bool has_next = S.next(ui + 1, nxt);
        const char* nA = has_next ? (const char*)g.A + (size_t)nxt.pm * tA_pm + (size_t)nxt.pn * tA_pn : cA; const char* nB = has_next ? (const char*)g.Bt + (size_t)nxt.pn * tB_pn : cB;
        for (int t = 0; t < nt; t += 2) {
            if constexpr (Epi::MIDK) { if (t == (nt >> 1)) E.midk(acc, cur, wr, wc, fr, fq); }
            const bool last = (t == nt - 2);
            const char* a1 = cA + (size_t)(t + 1) * kstepA;
            const char* a2 = last ? nA : cA + (size_t)(t + 2) * kstepA; const char* b2 = last ? nB : cB + (size_t)(t + 2) * kstepB;
            const char* a3 = a2 + kstepA; const char* b3 = b2 + kstepB;
            if (last && has_next) S.a_ready(nxt);
            if constexpr (SP2) {
            PG8_LDB(B0, 0, 0); PG8_LDB(B1, 0, 1); PG8_SCHED; PG8_LDA(At, 0, 0); PG8_STAGE(PG8_SA(1, 1), a1 + hstepA, voffA);
            PG8_WAIT_V(8); PG8_WAIT_L(0); PG8_BAR; PG8_MMA(0, 0, At, B0); PG8_MMA(0, 1, At, B1); PG8_BAR; PG8_SCHED;
            PG8_LDA(At, 0, 1); PG8_STAGE(PG8_SB(0, 0), b2, voffB); PG8_STAGE(PG8_SB(0, 1), b2 + hstepB, voffB); PG8_STAGE(PG8_SA(0, 0), a2, voffA);
            PG8_WAIT_V(8); PG8_WAIT_L(0); PG8_BAR; PG8_MMA(1, 0, At, B0); PG8_MMA(1, 1, At, B1); PG8_BAR; PG8_SCHED;
            PG8_LDB(B0, 1, 0); PG8_LDB(B1, 1, 1); PG8_SCHED; PG8_LDA(At, 1, 0); PG8_STAGE(PG8_SA(0, 1), a2 + hstepA, voffA);
            PG8_WAIT_V(8); PG8_WAIT_L(0); PG8_BAR; PG8_MMA(0, 0, At, B0); PG8_MMA(0, 1, At, B1); PG8_BAR; PG8_SCHED;
            PG8_LDA(At, 1, 1); PG8_STAGE(PG8_SB(1, 0), b3, voffB); PG8_STAGE(PG8_SB(1, 1), b3 + hstepB, voffB); PG8_STAGE(PG8_SA(1, 0), a3, voffA);
            PG8_WAIT_V(8); PG8_WAIT_L(0); PG8_BAR; PG8_MMA(1, 0, At, B0); PG8_MMA(1, 1, At, B1); PG8_BAR; PG8_SCHED;
            } else {
            PG8_LDB(B0, 0, 0); PG8_SCHED; PG8_LDA(At, 0, 0); PG8_STAGE(PG8_SA(1, 1), a1 + hstepA, voffA);
            PG8_WAIT_L(8); PG8_BAR; PG8_WAIT_L(0); PG8_MMA(0, 0, At, B0); PG8_BAR; PG8_SCHED;
            PG8_LDB(B1, 0, 1); PG8_STAGE(PG8_SB(0, 0), b2, voffB);
            PG8_BAR; PG8_WAIT_L(0); PG8_MMA(0, 1, At, B1); PG8_BAR;
            PG8_LDA(At, 0, 1); PG8_STAGE(PG8_SA(0, 0), a2, voffA);
            PG8_BAR; PG8_WAIT_L(0); PG8_MMA(1, 0, At, B0); PG8_BAR; PG8_SCHED;
            PG8_STAGE(PG8_SB(0, 1), b2 + hstepB, voffB);
            PG8_WAIT_V(6); PG8_BAR; PG8_MMA(1, 1, At, B1); PG8_BAR;
            PG8_LDB(B0, 1, 0); PG8_SCHED; PG8_LDA(At, 1, 0); PG8_STAGE(PG8_SA(0, 1), a2 + hstepA, voffA);
            PG8_WAIT_L(8); PG8_BAR; PG8_WAIT_L(0); PG8_MMA(0, 0, At, B0); PG8_BAR; PG8_SCHED;
            PG8_LDB(B1, 1, 1); PG8_STAGE(PG8_SB(1, 0), b3, voffB);
            PG8_BAR; PG8_WAIT_L(0); PG8_MMA(0, 1, At, B1); PG8_BAR;
            PG8_LDA(At, 1, 1); PG8_STAGE(PG8_SA(1, 0), a3, voffA);
            PG8_BAR; PG8_WAIT_L(0); PG8_MMA(1, 0, At, B0); PG8_BAR; PG8_SCHED;
            PG8_STAGE(PG8_SB(1, 1), b3 + hstepB, voffB);
            PG8_WAIT_V(6); PG8_BAR; PG8_MMA(1, 1, At, B1); PG8_BAR;
            }
        }
        if constexpr (ALIGN_EPI) { if (wr == 0) PG8_BAR; }
        if constexpr (!Epi::AFTER_DRAIN) { E(acc, cur, wr, wc, fr, fq); S.done(cur); }
        if (!has_next) break;
#pragma unroll
        for (int a = 0; a < 2; ++a)
#pragma unroll
            for (int b = 0; b < 2; ++b)
#pragma unroll
                for (int m = 0; m < 4; ++m)
#pragma unroll
                    for (int n = 0; n < 2; ++n) acc[a][b][m][n] = (f32x4){0.f, 0.f, 0.f, 0.f};
        cur = nxt; cA = nA; cB = nB; ++ui;
        if constexpr (ALIGN_EPI) { if (wr == 1) PG8_BAR; }
    }
    PG8_WAIT_V(0);
    if constexpr (!ALIGN_EPI) { if (wr == 0) PG8_BAR; }
    PG8_BAR;
    if constexpr (Epi::AFTER_DRAIN) { E.fused(acc, cur, wr, wc, fr, fq, lds, wid, lane); S.done(cur); }
#undef PG8_SA
#undef PG8_SB
#undef PG8_STAGE
#undef PG8_LDA
#undef PG8_LDB
#undef PG8_MMA
#undef PG8_WAIT_V
#undef PG8_WAIT_L
#undef PG8_BAR
#undef PG8_SCHED
}
}

namespace pg8 {
constexpr float LOG2E = 1.4426950408889634f;
constexpr float QS_NSA = 0.125f * LOG2E;
constexpr float QS_MLA = 0.10206207261596575f * LOG2E;
__device__ __forceinline__ float fast_sigmoid(float x) { return __builtin_amdgcn_rcpf(1.0f + __builtin_amdgcn_exp2f(-LOG2E * x)); }
__device__ __forceinline__ float lo_bf(unsigned u) { return __uint_as_float(u << 16); }
__device__ __forceinline__ float hi_bf(unsigned u) { return __uint_as_float(u & 0xffff0000u); }
struct EpiInProjF {
    static constexpr bool PERM = true, AFTER_DRAIN = false, MIDK = false;
    bf16_t* proj; unsigned char* gates;
    __device__ __forceinline__ void operator()(const f32x4 (&acc)[2][2][4][2], const Unit& u, int wr, int wc, int fr, int fq) const {
        const bool isg = u.pn >= 7;
        bf16_t* base = proj; const int ld = 1792; const int colt = isg ? (u.pn - 7) * BM : u.pn * BM;
        const float sc = (u.pn < 2) ? QS_NSA : 1.0f;
        const int row0 = u.pm * BM + wr * 64 + fr, col0 = colt + wc * 32 + 8 * fq;
#pragma unroll
        for (int ai = 0; ai < 2; ++ai)
#pragma unroll
            for (int m = 0; m < 4; ++m) { bf16_t* rowp = base + (size_t)(row0 + ai * HALF + m * 16) * ld + col0;
#pragma unroll
                for (int bj = 0; bj < 2; ++bj) { f32x4 v0 = acc[ai][bj][m][0], v1 = acc[ai][bj][m][1];
                    if (isg) {
                        unsigned q[8];
#pragma unroll
                        for (int e = 0; e < 4; ++e) { q[e] = (unsigned)(fast_sigmoid(v0[e]) * 255.0f + 0.5f); q[4 + e] = (unsigned)(fast_sigmoid(v1[e]) * 255.0f + 0.5f); }
                        uint2 w; w.x = q[0] | (q[1] << 8) | (q[2] << 16) | (q[3] << 24); w.y = q[4] | (q[5] << 8) | (q[6] << 16) | (q[7] << 24);
                        *(uint2*)(gates + (size_t)(row0 + ai * HALF + m * 16) * 2048 + col0 + bj * HALF) = w;
                    } else { v0 = v0 * sc; v1 = v1 * sc;
                        u32x4 w; w.x = cvt_pk_bf16(v0[0], v0[1]); w.y = cvt_pk_bf16(v0[2], v0[3]); w.z = cvt_pk_bf16(v1[0], v1[1]); w.w = cvt_pk_bf16(v1[2], v1[3]);
                        *(u32x4*)(rowp + bj * HALF) = w; } } }
    }
};
template <int PASS> struct EpiMergeF {
    static constexpr bool PERM = true, AFTER_DRAIN = false, MIDK = false;
    const unsigned char* gates; bf16_t* merged;
    __device__ __forceinline__ void operator()(const f32x4 (&acc)[2][2][4][2], const Unit& u, int wr, int wc, int fr, int fq) const {
        const int row0 = u.pm * BM + wr * 64 + fr, col0 = u.pn * BM + wc * 32 + 8 * fq;
#pragma unroll
        for (int ai = 0; ai < 2; ++ai)
#pragma unroll
            for (int m = 0; m < 4; ++m) { const size_t r = (size_t)(row0 + ai * HALF + m * 16);
#pragma unroll
                for (int bj = 0; bj < 2; ++bj) { const int c = col0 + bj * HALF;
                    const uint2 g = *(const uint2*)(gates + r * 2048 + PASS * 1024 + c);
                    f32x4 v0 = acc[ai][bj][m][0] * (1.0f / 255.0f), v1 = acc[ai][bj][m][1] * (1.0f / 255.0f);
                    v0[0] *= (float)(g.x & 255u); v0[1] *= (float)((g.x >> 8) & 255u); v0[2] *= (float)((g.x >> 16) & 255u); v0[3] *= (float)(g.x >> 24);
                    v1[0] *= (float)(g.y & 255u); v1[1] *= (float)((g.y >> 8) & 255u); v1[2] *= (float)((g.y >> 16) & 255u); v1[3] *= (float)(g.y >> 24);
                    if (PASS == 1) { const u32x4 o = *(const u32x4*)(merged + r * 1024 + c);
                        v0[0] += lo_bf(o.x); v0[1] += hi_bf(o.x); v0[2] += lo_bf(o.y); v0[3] += hi_bf(o.y);
                        v1[0] += lo_bf(o.z); v1[1] += hi_bf(o.z); v1[2] += lo_bf(o.w); v1[3] += hi_bf(o.w); }
                    u32x4 w; w.x = cvt_pk_bf16(v0[0], v0[1]); w.y = cvt_pk_bf16(v0[2], v0[3]); w.z = cvt_pk_bf16(v1[0], v1[1]); w.w = cvt_pk_bf16(v1[2], v1[3]);
                    *(u32x4*)(merged + r * 1024 + c) = w; } }
    }
};
struct EpiMergeFusedF {
    static constexpr bool PERM = true, AFTER_DRAIN = false, MIDK = true;
    const unsigned char* gates; bf16_t* merged;
    __device__ __forceinline__ void midk(f32x4 (&acc)[2][2][4][2], const Unit& u, int wr, int wc, int fr, int fq) const {
        asm volatile("" : "+v"(fr), "+v"(fq));
        const int row0 = u.pm * BM + wr * 64 + fr, col0 = u.pn * BM + wc * 32 + 8 * fq;
#pragma unroll
        for (int ai = 0; ai < 2; ++ai)
#pragma unroll
            for (int m = 0; m < 4; ++m) { const size_t r = (size_t)(row0 + ai * HALF + m * 16);
#pragma unroll
                for (int bj = 0; bj < 2; ++bj) { const int c = col0 + bj * HALF;
                    const uint2 g0 = *(const uint2*)(gates + r * 2048 + c), g1 = *(const uint2*)(gates + r * 2048 + 1024 + c);
#pragma unroll
                    for (int e = 0; e < 4; ++e) {
                        const float a0 = (float)((g0.x >> (8 * e)) & 255u), b0 = fmaxf((float)((g1.x >> (8 * e)) & 255u), 1.0f);
                        const float a1 = (float)((g0.y >> (8 * e)) & 255u), b1 = fmaxf((float)((g1.y >> (8 * e)) & 255u), 1.0f);
                        acc[ai][bj][m][0][e] *= a0 * __builtin_amdgcn_rcpf(b0); acc[ai][bj][m][1][e] *= a1 * __builtin_amdgcn_rcpf(b1); }
                    asm volatile("" ::: "memory"); } }
    }
    __device__ __forceinline__ void operator()(const f32x4 (&acc)[2][2][4][2], const Unit& u, int wr, int wc, int fr, int fq) const {
        const int row0 = u.pm * BM + wr * 64 + fr, col0 = u.pn * BM + wc * 32 + 8 * fq;
#pragma unroll
        for (int ai = 0; ai < 2; ++ai)
#pragma unroll
            for (int m = 0; m < 4; ++m) { const size_t r = (size_t)(row0 + ai * HALF + m * 16);
#pragma unroll
                for (int bj = 0; bj < 2; ++bj) { const int c = col0 + bj * HALF;
                    const uint2 g1 = *(const uint2*)(gates + r * 2048 + 1024 + c);
                    f32x4 v0 = acc[ai][bj][m][0] * (1.0f / 255.0f), v1 = acc[ai][bj][m][1] * (1.0f / 255.0f);
#pragma unroll
                    for (int e = 0; e < 4; ++e) { v0[e] *= fmaxf((float)((g1.x >> (8 * e)) & 255u), 1.0f); v1[e] *= fmaxf((float)((g1.y >> (8 * e)) & 255u), 1.0f); }
                    u32x4 w; w.x = cvt_pk_bf16(v0[0], v0[1]); w.y = cvt_pk_bf16(v0[2], v0[3]); w.z = cvt_pk_bf16(v1[0], v1[1]); w.w = cvt_pk_bf16(v1[2], v1[3]);
                    *(u32x4*)(merged + r * 1024 + c) = w; } }
    }
};
struct EpiCmpOutF {
    static constexpr bool PERM = true, AFTER_DRAIN = false, MIDK = false;
    bf16_t* dst;
    __device__ __forceinline__ void operator()(const f32x4 (&acc)[2][2][4][2], const Unit& u, int wr, int wc, int fr, int fq) const {
        if (wc >= 2) return;
        const int row0 = u.pm * BM + wr * 64 + fr, col0 = wc * 32 + 8 * fq;
#pragma unroll
        for (int ai = 0; ai < 2; ++ai)
#pragma unroll
            for (int m = 0; m < 4; ++m) { const int r = row0 + ai * HALF + m * 16;
                if (r < BATCH * NC * 2) { const int g = r & 1, bc = r >> 1, b = bc / NC, c = bc % NC;
                    const f32x4 v0 = acc[ai][0][m][0], v1 = acc[ai][0][m][1];
                    u32x4 w; w.x = cvt_pk_bf16(v0[0], v0[1]); w.y = cvt_pk_bf16(v0[2], v0[3]); w.z = cvt_pk_bf16(v1[0], v1[1]); w.w = cvt_pk_bf16(v1[2], v1[3]);
                    *(u32x4*)(dst + ((size_t)(b * 2 + g) * 128 + c) * 64 + col0) = w; } }
    }
};
struct EpiSlabF {
    static constexpr bool PERM = false, AFTER_DRAIN = false, MIDK = false;
    float* slab;
    __device__ __forceinline__ void operator()(const f32x4 (&acc)[2][2][4][2], const Unit& u, int wr, int wc, int fr, int fq) const {
        const int row0 = u.pm * BM + wr * 64 + fr, col0 = wc * 32 + 4 * fq;
        float* base = slab + (size_t)u.pn * 2048 * 256;
#pragma unroll
        for (int ai = 0; ai < 2; ++ai)
#pragma unroll
            for (int m = 0; m < 4; ++m) { float* rowp = base + (size_t)(row0 + ai * HALF + m * 16) * 256 + col0;
#pragma unroll
                for (int bj = 0; bj < 2; ++bj)
#pragma unroll
                    for (int n = 0; n < 2; ++n) *(f32x4*)(rowp + bj * HALF + n * 16) = acc[ai][bj][m][n]; }
    }
};
struct EpiResidF {
    static constexpr bool PERM = false, AFTER_DRAIN = false, MIDK = false;
    const float* x; float* h;
    __device__ __forceinline__ void operator()(const f32x4 (&acc)[2][2][4][2], const Unit& u, int wr, int wc, int fr, int fq) const {
        const int row0 = u.pm * BM + wr * 64 + fr, col0 = u.pn * BM + wc * 32 + 4 * fq;
#pragma unroll
        for (int ai = 0; ai < 2; ++ai)
#pragma unroll
            for (int m = 0; m < 4; ++m) { const size_t off = (size_t)(row0 + ai * HALF + m * 16) * 1024 + col0;
#pragma unroll
                for (int bj = 0; bj < 2; ++bj)
#pragma unroll
                    for (int n = 0; n < 2; ++n) { const f32x4 xv = *(const f32x4*)(x + off + bj * HALF + n * 16); *(f32x4*)(h + off + bj * HALF + n * 16) = xv + acc[ai][bj][m][n]; } }
    }
};
struct EpiMlaQF {
    static constexpr bool PERM = false, AFTER_DRAIN = false, MIDK = false;
    bf16_t* q; const float2* cs;
    __device__ __forceinline__ void operator()(const f32x4 (&acc)[2][2][4][2], const Unit& u, int wr, int wc, int fr, int fq) const {
        const int row0 = u.pm * BM + wr * 64 + fr;
#pragma unroll
        for (int bj = 0; bj < 2; ++bj) {
            const int X = u.pn * BM + bj * HALF + wc * 32;
            const bool rope = (X % 96) == 64;
#pragma unroll
            for (int ai = 0; ai < 2; ++ai)
#pragma unroll
                for (int m = 0; m < 4; ++m) { const int r = row0 + ai * HALF + m * 16; const int pos = r & (SEQ - 1);
                    f32x4 v0 = acc[ai][bj][m][0], v1 = acc[ai][bj][m][1];
                    if (rope) {
#pragma unroll
                        for (int j = 0; j < 4; ++j) { const float2 c = cs[pos * 16 + 4 * fq + j]; const float x1 = v0[j], x2 = v1[j]; v0[j] = x1 * c.x - x2 * c.y; v1[j] = x2 * c.x + x1 * c.y; } }
                    v0 = v0 * QS_MLA; v1 = v1 * QS_MLA;
                    bf16_t* p = q + (size_t)r * 768 + X + 4 * fq;
                    uint2 w0, w1; w0.x = cvt_pk_bf16(v0[0], v0[1]); w0.y = cvt_pk_bf16(v0[2], v0[3]); w1.x = cvt_pk_bf16(v1[0], v1[1]); w1.y = cvt_pk_bf16(v1[2], v1[3]);
                    *(uint2*)p = w0; *(uint2*)(p + 16) = w1; }
        }
    }
};
}

#define PG8_SP2 true
#define PG8_ALIGN true
constexpr int NTHR = 512, NWV = NTHR / 64;
#define WAVE_IDS const int lane = threadIdx.x & 63, wv = threadIdx.x >> 6; const int gw = blockIdx.x * NWV + wv, nw = gridDim.x * NWV; (void)lane; (void)gw; (void)nw;

template <bool Q8> DEV void ph_rms1024(const float* __restrict__ src, const float* __restrict__ g, bf16_t* __restrict__ dst, int rows, unsigned* __restrict__ q8 = nullptr, float* __restrict__ qs = nullptr, int gw_o = -1, int nw_o = 0, const bf16_t* __restrict__ add = nullptr) {
  const int lane = threadIdx.x & 63; const int gw = (gw_o >= 0) ? gw_o : (int)(blockIdx.x * NWV + (threadIdx.x >> 6)); const int nw = (gw_o >= 0) ? nw_o : (int)(gridDim.x * NWV);
  float4 gg[4];
#pragma unroll
  for (int j = 0; j < 4; ++j) gg[j] = ((const float4*)g)[j * 64 + lane];
  float4 nx[4]; uint2 na[4];
  if (gw < rows) {
#pragma unroll
    for (int j = 0; j < 4; ++j) { nx[j] = ((const float4*)(src + (size_t)gw * 1024))[j * 64 + lane]; if (add) na[j] = ((const uint2*)(add + (size_t)gw * 1024))[j * 64 + lane]; } }
  for (int r = gw; r < rows; r += nw) {
    float4 v[4]; float ss = 0.f;
#pragma unroll
    for (int j = 0; j < 4; ++j) { v[j] = nx[j];
      if (add) { v[j].x += __uint_as_float(na[j].x << 16); v[j].y += __uint_as_float(na[j].x & 0xffff0000u); v[j].z += __uint_as_float(na[j].y << 16); v[j].w += __uint_as_float(na[j].y & 0xffff0000u); }
      ss += v[j].x * v[j].x + v[j].y * v[j].y + v[j].z * v[j].z + v[j].w * v[j].w; }
    if (r + nw < rows) {
#pragma unroll
      for (int j = 0; j < 4; ++j) { nx[j] = ((const float4*)(src + (size_t)(r + nw) * 1024))[j * 64 + lane]; if (add) na[j] = ((const uint2*)(add + (size_t)(r + nw) * 1024))[j * 64 + lane]; } }
    ss = wsum(ss);
    const float inv = rsqrtf(ss * (1.0f / 1024.0f) + 1e-6f);
    float mx = 0.f;
#pragma unroll
    for (int j = 0; j < 4; ++j) {
      v[j].x *= inv * gg[j].x; v[j].y *= inv * gg[j].y; v[j].z *= inv * gg[j].z; v[j].w *= inv * gg[j].w;
      uint2 o;
      o.x = (unsigned)f2bf(v[j].x) | ((unsigned)f2bf(v[j].y) << 16);
      o.y = (unsigned)f2bf(v[j].z) | ((unsigned)f2bf(v[j].w) << 16);
      ((uint2*)(dst + (size_t)r * 1024))[j * 64 + lane] = o;
      if (Q8) mx = fmaxf(mx, fmaxf(fmaxf(fabsf(v[j].x), fabsf(v[j].y)), fmaxf(fabsf(v[j].z), fabsf(v[j].w))));
    }
    if (Q8) {
      mx = wmaxf(mx);
      const float sc = fmaxf(mx, 1e-30f) * (1.0f / 127.0f), isc = 1.0f / sc;
#pragma unroll
      for (int j = 0; j < 4; ++j) {
        const int q0 = (int)rintf(v[j].x * isc), q1 = (int)rintf(v[j].y * isc), q2 = (int)rintf(v[j].z * isc), q3 = (int)rintf(v[j].w * isc);
        q8[(size_t)r * 256 + j * 64 + lane] = (unsigned)(q0 & 255) | ((unsigned)(q1 & 255) << 8) | ((unsigned)(q2 & 255) << 16) | ((unsigned)(q3 & 255) << 24);
      }
      if (lane == 0) qs[r] = sc;
    }
  }
}
DEV int win_src_col(int n) {
  if (n < 1280) return n;
  if (n < 1536) return 1304 + (n - 1280);
  if (n < 1664) return 1560 + (n - 1536);
  if (n < 1696) return 1688 + (n - 1664);
  if (n < 1720) return 1280 + (n - 1696);
  if (n < 1792) return -1;
  return 1720 + (n - 1792);
}
template <int MODE> DEV void tr_item(const float* __restrict__ W, int K, int Nsrc, bf16_t* __restrict__ WT, int Nblk, int Nvalid, __attribute__((address_space(3))) float* scr, int item, int lane, int pitch = 0, int koff = 0) {
  if (pitch == 0) pitch = K;
  const int kb = item / Nblk, nb = item % Nblk, k0 = 64 * kb, n0 = 32 * nb;
  const int n = n0 + (lane & 31);
  const int sc = (MODE == 1) ? win_src_col(n) : ((n < Nvalid) ? n : -1);
  float tv[32];
#pragma unroll
  for (int i = 0; i < 32; ++i) { const int kk = 2 * i + (lane >> 5); tv[i] = (sc >= 0) ? W[(size_t)(k0 + kk) * Nsrc + sc] : 0.f; }
#pragma unroll
  for (int i = 0; i < 32; ++i) { const int kk = 2 * i + (lane >> 5); scr[kk * 33 + (lane & 31)] = tv[i]; }
  asm volatile("s_waitcnt lgkmcnt(0)" ::: "memory");
  const int c = lane & 7;
#pragma unroll
  for (int j = 0; j < 4; ++j) { const int nn = (lane >> 3) + 8 * j; const __attribute__((address_space(3))) float* sp = scr + (8 * c) * 33 + nn;
    uint4 o;
    o.x = (unsigned)f2bf(sp[0 * 33]) | ((unsigned)f2bf(sp[1 * 33]) << 16); o.y = (unsigned)f2bf(sp[2 * 33]) | ((unsigned)f2bf(sp[3 * 33]) << 16);
    o.z = (unsigned)f2bf(sp[4 * 33]) | ((unsigned)f2bf(sp[5 * 33]) << 16); o.w = (unsigned)f2bf(sp[6 * 33]) | ((unsigned)f2bf(sp[7 * 33]) << 16);
    *(uint4*)(WT + (size_t)(n0 + nn) * pitch + koff + k0 + 8 * c) = o; }
  asm volatile("s_waitcnt lgkmcnt(0)" ::: "memory");
}
DEV void rope_entry(float2* __restrict__ cs, int i) {
  const int j = i & 15, pos = i >> 4;
  const float inv_freq = __builtin_amdgcn_exp2f(-(float)(2 * j) * (13.287712379549449f / 32.0f));
  const float rev = (float)pos * inv_freq * 0.15915494309189535f;
  const float fr = rev - floorf(rev);
  cs[i] = make_float2(__builtin_amdgcn_cosf(fr), __builtin_amdgcn_sinf(fr));
}
namespace att {
#define LAS3 __attribute__((address_space(3)))
typedef LAS3 char* lptr;
typedef LAS3 const char* lcptr;
using bf16x8 = __attribute__((ext_vector_type(8))) short;
using s16x4 = __attribute__((ext_vector_type(4))) short;
using f32x16 = __attribute__((ext_vector_type(16))) float;
typedef short v4i16_t __attribute__((ext_vector_type(4)));
typedef unsigned u32x4 __attribute__((ext_vector_type(4)));
typedef float f32x4_t __attribute__((ext_vector_type(4)));
typedef float f32x2_t __attribute__((ext_vector_type(2)));
typedef __bf16 bf16x2_t __attribute__((ext_vector_type(2)));
constexpr float LOG2E = 1.4426950408889634f;
constexpr float THR = 8.0f;
constexpr float NEG_INF = -__builtin_huge_valf();
constexpr int SLOT = 20480, KOFF = 0, VOFF = 12288;
constexpr int L_WSF = 2 * SLOT;
constexpr int L_TB = L_WSF + 2048;
constexpr int L_ST = L_TB + 8 * 320 * 4;
constexpr int L_SELM = L_ST + 768;
constexpr int L_SC = L_SELM + 256;
constexpr int L_IMPQ = L_SC + 64 * 33 * 4;
constexpr int L_IMPL = L_IMPQ + 4 * 64 * 33 * 4;
constexpr int L_FIN = L_IMPQ;
constexpr int L_END = L_IMPL + 4 * 64 * 33 * 4;
static_assert(L_END <= 131072, "attention LDS map");

__device__ __forceinline__ int crow(int r, int hi) { return (r & 3) + 8 * (r >> 2) + 4 * hi; }
__device__ __forceinline__ s16x4 vtr(lcptr p) { return __builtin_bit_cast(s16x4, __builtin_amdgcn_ds_read_tr16_b64_v4i16((LAS3 v4i16_t*)p)); }
__device__ __forceinline__ unsigned cvtpk(float lo, float hi) { f32x2_t v = {lo, hi}; bf16x2_t b = __builtin_convertvector(v, bf16x2_t); return __builtin_bit_cast(unsigned, b); }
__device__ __forceinline__ float xmax(float v) { auto rr = __builtin_amdgcn_permlane32_swap(__float_as_uint(v), __float_as_uint(v), false, false); return fmaxf(__uint_as_float(rr[0]), __uint_as_float(rr[1])); }
__device__ __forceinline__ float xsum(float v) { auto rr = __builtin_amdgcn_permlane32_swap(__float_as_uint(v), __float_as_uint(v), false, false); return __uint_as_float(rr[0]) + __uint_as_float(rr[1]); }
__device__ __forceinline__ float ex2(float x) { return __builtin_amdgcn_exp2f(x); }

template <int ND0> __device__ __forceinline__ void qkt(f32x16& p0, f32x16& p1, lcptr kb, const bf16x8* qr) {
  p0 = f32x16{}; p1 = f32x16{};
  __builtin_amdgcn_s_setprio(1);
#pragma unroll
  for (int d0 = 0; d0 < ND0; ++d0) {
    const bf16x8 b0 = *(const LAS3 bf16x8*)(kb + d0 * 2048);
    const bf16x8 b1 = *(const LAS3 bf16x8*)(kb + d0 * 2048 + 512);
    p0 = __builtin_amdgcn_mfma_f32_32x32x16_bf16(b0, qr[d0], p0, 0, 0, 0);
    p1 = __builtin_amdgcn_mfma_f32_32x32x16_bf16(b1, qr[d0], p1, 0, 0, 0);
  }
  __builtin_amdgcn_s_setprio(0);
}
template <int ND0> __device__ __forceinline__ void qkt_init(f32x16& p0, f32x16& p1, lcptr kb, const bf16x8* qr, const f32x16& c0, const f32x16& c1) {
  p0 = c0; p1 = c1;
  __builtin_amdgcn_s_setprio(1);
#pragma unroll
  for (int d0 = 0; d0 < ND0; ++d0) {
    const bf16x8 b0 = *(const LAS3 bf16x8*)(kb + d0 * 2048);
    const bf16x8 b1 = *(const LAS3 bf16x8*)(kb + d0 * 2048 + 512);
    p0 = __builtin_amdgcn_mfma_f32_32x32x16_bf16(b0, qr[d0], p0, 0, 0, 0);
    p1 = __builtin_amdgcn_mfma_f32_32x32x16_bf16(b1, qr[d0], p1, 0, 0, 0);
  }
  __builtin_amdgcn_s_setprio(0);
}
__device__ __forceinline__ void pv(f32x16 (&o)[2], lcptr vp, const unsigned (&pw)[16]) {
  __builtin_amdgcn_s_setprio(1);
#pragma unroll
  for (int d0 = 0; d0 < 2; ++d0)
#pragma unroll
    for (int ks = 0; ks < 4; ++ks) {
      const s16x4 lo = vtr(vp + d0 * 4096 + ks * 1024), hi4 = vtr(vp + d0 * 4096 + ks * 1024 + 512);
      const bf16x8 vf = {lo[0], lo[1], lo[2], lo[3], hi4[0], hi4[1], hi4[2], hi4[3]};
      const unsigned pa4[4] = {pw[4 * ks], pw[4 * ks + 1], pw[4 * ks + 2], pw[4 * ks + 3]};
      o[d0] = __builtin_amdgcn_mfma_f32_32x32x16_bf16(__builtin_bit_cast(bf16x8, pa4), vf, o[d0], 0, 0, 0);
    }
  __builtin_amdgcn_s_setprio(0);
}
__device__ __forceinline__ void softmax_step(f32x16& p0, f32x16& p1, float& m, float& l, f32x16 (&o)[2], LAS3 float* wsf, int r32, int hi, unsigned (&pw)[16]) {
  float rm = fmaxf(p0[0], p1[0]);
#pragma unroll
  for (int r = 1; r < 16; ++r) rm = fmaxf(rm, fmaxf(p0[r], p1[r]));
  rm = xmax(rm);
  if (__any(rm > m + THR)) {
    const float mn = fmaxf(m, rm);
    const float al = ex2(m - mn);
    m = mn; l *= al;
    if (hi == 0) wsf[r32] = al;
#pragma unroll
    for (int r = 0; r < 16; ++r) { const float f = wsf[crow(r, hi)]; o[0][r] *= f; o[1][r] *= f; }
  }
  float s = 0.f;
#pragma unroll
  for (int r = 0; r < 16; ++r) { p0[r] = ex2(p0[r] - m); p1[r] = ex2(p1[r] - m); s += p0[r] + p1[r]; }
  l += s;
#pragma unroll
  for (int i = 0; i < 8; ++i) { pw[i] = cvtpk(p0[2 * i], p0[2 * i + 1]); pw[8 + i] = cvtpk(p1[2 * i], p1[2 * i + 1]); }
}
struct KVSrc { const bf16_t* k; const bf16_t* v; int ldk, ldv; };
__device__ __forceinline__ void kv_issue(const KVSrc& s, int row0, u32x4& rk, u32x4& rv, int tid) {
  const int kv = tid & 63, ch = tid >> 6, ln = tid & 63;
  rk = *(const u32x4*)(s.k + (size_t)(row0 + kv) * s.ldk + ch * 8);
  rv = *(const u32x4*)(s.v + (size_t)(row0 + 16 * (ch & 3) + (ln >> 2)) * s.ldv + (ch >> 2) * 32 + (ln & 3) * 8);
}
__device__ __forceinline__ void kv_commit(lptr slot, const u32x4& rk, const u32x4& rv, int tid) {
  *(LAS3 u32x4*)(slot + KOFF + (tid >> 6) * 1024 + (tid & 63) * 16) = rk;
  *(LAS3 u32x4*)(slot + VOFF + tid * 16) = rv;
}
__device__ __forceinline__ void fin_set(LAS3 float* finl, const f32x16 (&o)[2], int lane) {
#pragma unroll
  for (int d0 = 0; d0 < 2; ++d0)
#pragma unroll
    for (int r = 0; r < 16; ++r) finl[(d0 * 16 + r) * 64 + lane] = o[d0][r];
}
__device__ __forceinline__ void fin_add(LAS3 float* finl, const f32x16 (&o)[2], const LAS3 float* wsf, int lane, int hi) {
#pragma unroll
  for (int r = 0; r < 16; ++r) { const float f = wsf[crow(r, hi)];
#pragma unroll
    for (int d0 = 0; d0 < 2; ++d0) finl[(d0 * 16 + r) * 64 + lane] += o[d0][r] * f; }
}
__device__ __forceinline__ void fin_store(const LAS3 float* finl, bf16_t* gout, size_t rowbase, int ld, int colbase, int lane) {
#pragma unroll
  for (int i = 0; i < 4; ++i) {
    const int q = i * 8 + (lane >> 3), ch = lane & 7;
    const int qh = (q >> 2) & 1, r = (q & 3) + 4 * (q >> 3), d0 = ch >> 2, dl = (ch & 3) * 8;
    const LAS3 float* p = finl + (d0 * 16 + r) * 64 + qh * 32 + dl;
    const f32x4_t x0 = *(const LAS3 f32x4_t*)p, x1 = *(const LAS3 f32x4_t*)(p + 4);
    u32x4 v; v.x = cvtpk(x0[0], x0[1]); v.y = cvtpk(x0[2], x0[3]); v.z = cvtpk(x1[0], x1[1]); v.w = cvtpk(x1[2], x1[3]);
    *(u32x4*)(gout + (rowbase + q) * (size_t)ld + colbase + ch * 8) = v;
  }
}

__device__ __forceinline__ void nsa_unit(int b, int g, int c, const bf16_t* __restrict__ proj, const bf16_t* __restrict__ kc, const bf16_t* __restrict__ vc, bf16_t* __restrict__ onsa, lptr lds) {
  int tid = threadIdx.x; asm volatile("" : "+v"(tid));
  const int lane = tid & 63, r32 = lane & 31, hi = lane >> 5;
  const int w = __builtin_amdgcn_readfirstlane(tid >> 6);
  const int rh = w >> 1, head = g * 4 + rh, tokl = 32 * (w & 1) + r32, t = 64 * c + tokl, bg = b * 2 + g;
  const size_t tok = (size_t)b * SEQ + t;
  LAS3 float* wsf = (LAS3 float*)(lds + L_WSF) + w * 64;
  const LAS3 float* tb = (const LAS3 float*)(lds + L_TB) + head * 320 + 64;
  const LAS3 float* stp = (const LAS3 float*)(lds + L_ST);
  LAS3 unsigned* selm = (LAS3 unsigned*)(lds + L_SELM);
  LAS3 float* sc = (LAS3 float*)(lds + L_SC);
  LAS3 float* impq = (LAS3 float*)(lds + L_IMPQ);
  LAS3 float* impl = (LAS3 float*)(lds + L_IMPL);
  const lcptr kb0 = (lcptr)lds + KOFF + hi * 1024 + r32 * 16;
  const lcptr vp0 = (lcptr)lds + VOFF + ((lane >> 4) & 1) * 32 + (lane & 3) * 8 + (4 * hi + ((lane & 15) >> 2)) * 64;
  bf16x8 qr[4];
#pragma unroll
  for (int d0 = 0; d0 < 4; ++d0) qr[d0] = *(const bf16x8*)(proj + tok * PROJ_LD + PC_Q + head * 64 + d0 * 16 + hi * 8);
  float gate[3];
#pragma unroll
  for (int j = 0; j < 3; ++j) gate[j] = 1.0f / (1.0f + ex2(-LOG2E * bf2f(proj[tok * PROJ_LD + PC_GATE + head * 3 + j])));
  LAS3 float* finl = (LAS3 float*)(lds + L_FIN) + w * 2048;
  f32x16 o[2]; unsigned pw[16];
  u32x4 rk, rv;
  {
    const KVSrc src{kc + (size_t)bg * 128 * 64, vc + (size_t)bg * 128 * 64, 64, 64};
    __syncthreads();
    kv_issue(src, 0, rk, rv, tid); kv_commit(lds, rk, rv, tid);
    kv_issue(src, 64, rk, rv, tid); kv_commit(lds + SLOT, rk, rv, tid);
    __syncthreads();
    f32x16 a0, a1, b0, b1;
    const int twmin = 64 * c + 32 * (w & 1), twmax = twmin + 31;
    const bool live0 = true, live1 = (16 * 32 + 31 <= twmax), live2 = (16 * 64 + 31 <= twmax), live3 = (16 * 96 + 31 <= twmax);
    qkt<4>(a0, a1, kb0, qr);
    if (live2) qkt<4>(b0, b1, kb0 + SLOT, qr); else { b0 = f32x16{}; b1 = f32x16{}; }
    float rm = NEG_INF;
#define CMP_QUARTER(P, QTR, LIVE) do { if (LIVE) { \
      if (!(16 * (32 * (QTR) + 31) + 31 + 112 < twmin)) { \
        _Pragma("unroll") for (int r = 0; r < 16; ++r) { int d_ = t - 16 * (32 * (QTR) + crow(r, hi)) - 31; d_ = d_ < -64 ? -64 : (d_ > 255 ? 255 : d_); P[r] += tb[d_]; } } \
      _Pragma("unroll") for (int r = 0; r < 16; ++r) rm = fmaxf(rm, P[r]); } } while (0)
    CMP_QUARTER(a0, 0, live0); CMP_QUARTER(a1, 1, live1); CMP_QUARTER(b0, 2, live2); CMP_QUARTER(b1, 3, live3);
#undef CMP_QUARTER
    rm = xmax(rm);
    const float mref = (rm == NEG_INF) ? 0.f : rm;
    float s = 0.f;
#define CMP_EXP(P, LIVE) do { if (LIVE) { _Pragma("unroll") for (int r = 0; r < 16; ++r) { P[r] = ex2(P[r] - mref); s += P[r]; } } else { _Pragma("unroll") for (int r = 0; r < 16; ++r) P[r] = 0.f; } } while (0)
    CMP_EXP(a0, live0); CMP_EXP(a1, live1); CMP_EXP(b0, live2); CMP_EXP(b1, live3);
#undef CMP_EXP
    s = xsum(s);
    const float inv = (s > 0.f) ? 1.0f / s : 0.f;
#pragma unroll
    for (int r = 0; r < 16; ++r) { a0[r] *= inv; a1[r] *= inv; b0[r] *= inv; b1[r] *= inv; }
    { LAS3 float* iq = impq + (rh * 64 + tokl) * 33; LAS3 float* il = impl + (rh * 64 + tokl) * 33;
#pragma unroll
      for (int q4 = 0; q4 < 4; ++q4) {
        const int gi = 2 * q4 + hi;
        iq[gi] = (a0[4 * q4] + a0[4 * q4 + 1]) + (a0[4 * q4 + 2] + a0[4 * q4 + 3]);           il[gi] = a0[4 * q4 + 3];
        iq[8 + gi] = (a1[4 * q4] + a1[4 * q4 + 1]) + (a1[4 * q4 + 2] + a1[4 * q4 + 3]);       il[8 + gi] = a1[4 * q4 + 3];
        iq[16 + gi] = (b0[4 * q4] + b0[4 * q4 + 1]) + (b0[4 * q4 + 2] + b0[4 * q4 + 3]);      il[16 + gi] = b0[4 * q4 + 3];
        iq[24 + gi] = (b1[4 * q4] + b1[4 * q4 + 1]) + (b1[4 * q4 + 2] + b1[4 * q4 + 3]);      il[24 + gi] = b1[4 * q4 + 3];
      } }
    o[0] = f32x16{}; o[1] = f32x16{};
#pragma unroll
    for (int i = 0; i < 8; ++i) { pw[i] = cvtpk(a0[2 * i], a0[2 * i + 1]); pw[8 + i] = cvtpk(a1[2 * i], a1[2 * i + 1]); }
    pv(o, vp0, pw);
    if (live2) {
#pragma unroll
      for (int i = 0; i < 8; ++i) { pw[i] = cvtpk(b0[2 * i], b0[2 * i + 1]); pw[8 + i] = cvtpk(b1[2 * i], b1[2 * i + 1]); }
      pv(o, vp0 + SLOT, pw); }
    if (hi == 0) wsf[r32] = gate[0];
#pragma unroll
    for (int r = 0; r < 16; ++r) { const float f = wsf[crow(r, hi)]; o[0][r] *= f; o[1][r] *= f; }
  }
  __syncthreads();
  const KVSrc ssrc{proj + (size_t)b * SEQ * PROJ_LD + PC_KV + 2 * 128 + g * 64, proj + (size_t)b * SEQ * PROJ_LD + PC_KV + 3 * 128 + g * 64, PROJ_LD, PROJ_LD};
  kv_issue(ssrc, 0, rk, rv, tid);
  {
    const int stok = tid >> 3, sub = tid & 7;
#pragma unroll
    for (int k = 0; k < 4; ++k) {
      const int n = sub * 4 + k;
      float imp = 0.f;
#pragma unroll
      for (int hh = 0; hh < 4; ++hh) imp += impq[(hh * 64 + stok) * 33 + n] + ((n > 0) ? impl[(hh * 64 + stok) * 33 + n - 1] : 0.f);
      sc[stok * 33 + n] = (n > c) ? -1.0f : ((n == 0 || n == c || n == c - 1) ? 1e4f : imp);
    }
    if (tid < 64) selm[tid] = 0u;
    __syncthreads();
    float srow[32];
#pragma unroll
    for (int mm = 0; mm < 32; ++mm) srow[mm] = sc[stok * 33 + mm];
    unsigned bits = 0u;
#pragma unroll
    for (int k = 0; k < 4; ++k) {
      const int n = sub * 4 + k; const float sv = sc[stok * 33 + n]; int rank = 0;
#pragma unroll
      for (int mm = 0; mm < 32; ++mm) rank += (srow[mm] > sv || (srow[mm] == sv && mm < n)) ? 1 : 0;
      if (rank < 16) bits |= 1u << n;
    }
    if (bits) atomicOr((unsigned*)(selm + stok), bits);
    __syncthreads();
  }
  const unsigned mysel = selm[tokl];
  fin_set(finl, o, lane);
#pragma unroll 1
  for (int br = 0; br < 2; ++br) {
    const KVSrc src = (br == 0) ? ssrc : KVSrc{proj + (size_t)b * SEQ * PROJ_LD + PC_KV + 4 * 128 + g * 64, proj + (size_t)b * SEQ * PROJ_LD + PC_KV + 5 * 128 + g * 64, PROJ_LD, PROJ_LD};
    const int n0 = (br == 0) ? 0 : ((c > 8) ? c - 8 : 0);
    if (br == 1) { __syncthreads(); kv_issue(src, n0 * 64, rk, rv, tid); }
    kv_commit(lds, rk, rv, tid);
    float m = -1e30f, l = 0.f;
    o[0] = f32x16{}; o[1] = f32x16{};
    int cur = 0;
#pragma unroll 1
    for (int n = n0; n <= c; ++n) {
      __syncthreads();
      if (n < c) kv_issue(src, (n + 1) * 64, rk, rv, tid);
      const bool mine = (br == 1) || ((mysel >> n) & 1u);
      if (__any(mine)) {
        f32x16 p0, p1;
        if (n + 2 >= c) {
          const LAS3 float* bp = tb + (t - 64 * n) - 4 * hi - 63;
          f32x16 c0, c1;
#pragma unroll
          for (int r = 0; r < 16; ++r) { c0[r] = bp[63 - ((r & 3) + 8 * (r >> 2))]; c1[r] = bp[31 - ((r & 3) + 8 * (r >> 2))]; }
          qkt_init<4>(p0, p1, kb0 + cur * SLOT, qr, c0, c1);
        } else if (br == 1 && n + 8 == c) {
          const LAS3 float* bp = stp + (607 - (t - 64 * n)) + 4 * hi;
          f32x16 c0, c1;
#pragma unroll
          for (int r = 0; r < 16; ++r) { c0[r] = bp[(r & 3) + 8 * (r >> 2)]; c1[r] = bp[32 + (r & 3) + 8 * (r >> 2)]; }
          qkt_init<4>(p0, p1, kb0 + cur * SLOT, qr, c0, c1);
        } else qkt<4>(p0, p1, kb0 + cur * SLOT, qr);
        if (!mine) {
#pragma unroll
          for (int r = 0; r < 16; ++r) { p0[r] = NEG_INF; p1[r] = NEG_INF; } }
        softmax_step(p0, p1, m, l, o, wsf, r32, hi, pw);
        pv(o, vp0 + cur * SLOT, pw);
      }
      if (n < c) kv_commit(lds + (cur ^ 1) * SLOT, rk, rv, tid);
      cur ^= 1;
    }
    l = xsum(l);
    const float gi = gate[1 + br] / fmaxf(l, 1e-30f);
    if (hi == 0) wsf[r32] = gi;
    fin_add(finl, o, wsf, lane, hi);
  }
  fin_store(finl, onsa, (size_t)b * SEQ + 64 * c + 32 * (w & 1), 1024, head * 64, lane);
}

__device__ __forceinline__ void mla_unit(int b, int h, int qb, const bf16_t* __restrict__ mq, const bf16_t* __restrict__ mkv, const bf16_t* __restrict__ kr, bf16_t* __restrict__ omla, lptr lds) {
  int tid = threadIdx.x; asm volatile("" : "+v"(tid));
  const int lane = tid & 63, r32 = lane & 31, hi = lane >> 5;
  const int w = __builtin_amdgcn_readfirstlane(tid >> 6);
  const int q0 = 256 * qb, qw = q0 + 32 * w, qpos = qw + r32;
  const size_t tokq = (size_t)b * SEQ + qpos;
  LAS3 float* wsf = (LAS3 float*)(lds + L_WSF) + w * 64;
  const lcptr kb0 = (lcptr)lds + KOFF + hi * 1024 + r32 * 16;
  const lcptr vp0 = (lcptr)lds + VOFF + ((lane >> 4) & 1) * 32 + (lane & 3) * 8 + (4 * hi + ((lane & 15) >> 2)) * 64;
  const LAS3 float* stp = (const LAS3 float*)(lds + L_ST);
  bf16x8 qr[6];
#pragma unroll
  for (int d0 = 0; d0 < 6; ++d0) qr[d0] = *(const bf16x8*)(mq + tokq * 768 + h * 96 + d0 * 16 + hi * 8);
  const KVSrc src{mkv + (size_t)b * SEQ * 1024 + h * 128, mkv + (size_t)b * SEQ * 1024 + h * 128 + 64, 1024, 1024};
  const bf16_t* krb = kr + (size_t)b * SEQ * 32;
  const int NTL = 4 * (qb + 1);
  u32x4 rk, rv, rr = {0u, 0u, 0u, 0u};
  f32x16 o[2]; o[0] = f32x16{}; o[1] = f32x16{};
  unsigned pw[16];
  float m = -1e30f, l = 0.f;
  __syncthreads();
  kv_issue(src, 0, rk, rv, tid);
  if (tid < 256) rr = *(const u32x4*)(krb + (size_t)(tid & 63) * 32 + (tid >> 6) * 8);
  kv_commit(lds, rk, rv, tid);
  if (tid < 256) *(LAS3 u32x4*)(lds + KOFF + (8 + (tid >> 6)) * 1024 + (tid & 63) * 16) = rr;
  int cur = 0;
#pragma unroll 1
  for (int tl = 0; tl < NTL; ++tl) {
    __syncthreads();
    if (tl + 1 < NTL) { kv_issue(src, (tl + 1) * 64, rk, rv, tid); if (tid < 256) rr = *(const u32x4*)(krb + (size_t)((tl + 1) * 64 + (tid & 63)) * 32 + (tid >> 6) * 8); }
    if (64 * tl <= qw + 31) {
      f32x16 p0, p1;
      if (64 * tl + 63 > qw) {
        const LAS3 float* bp = stp + 96 + (qpos - 64 * tl) - 4 * hi - 63;
        f32x16 c0, c1;
#pragma unroll
        for (int r = 0; r < 16; ++r) { c0[r] = bp[63 - ((r & 3) + 8 * (r >> 2))]; c1[r] = bp[31 - ((r & 3) + 8 * (r >> 2))]; }
        qkt_init<6>(p0, p1, kb0 + cur * SLOT, qr, c0, c1);
      } else qkt<6>(p0, p1, kb0 + cur * SLOT, qr);
      softmax_step(p0, p1, m, l, o, wsf, r32, hi, pw);
      pv(o, vp0 + cur * SLOT, pw);
    }
    if (tl + 1 < NTL) { kv_commit(lds + (cur ^ 1) * SLOT, rk, rv, tid); if (tid < 256) *(LAS3 u32x4*)(lds + (cur ^ 1) * SLOT + KOFF + (8 + (tid >> 6)) * 1024 + (tid & 63) * 16) = rr; }
    cur ^= 1;
  }
  l = xsum(l);
  if (hi == 0) wsf[r32] = 1.0f / fmaxf(l, 1e-30f);
#pragma unroll
  for (int r = 0; r < 16; ++r) { const float f = wsf[crow(r, hi)]; o[0][r] *= f; o[1][r] *= f; }
  LAS3 float* finl = (LAS3 float*)(lds + L_FIN) + w * 2048;
  fin_set(finl, o, lane);
  fin_store(finl, omla, (size_t)b * SEQ + qw, 1024, 512 + h * 64, lane);
}

__device__ __forceinline__ void attn_phase(const bf16_t* proj, const bf16_t* kc, const bf16_t* vc, const float* t5, bf16_t* onsa,
                                           const bf16_t* mq, const bf16_t* mkv, const bf16_t* kr, bf16_t* omla, lptr lds) {
  const int tid = threadIdx.x;
  { LAS3 float* tb = (LAS3 float*)(lds + L_TB);
    for (int i = tid; i < 8 * 320; i += NTHR) { const int hd = i / 320, d = i % 320 - 64; tb[i] = (d < 0) ? NEG_INF : ((d < 113) ? (t5[(int)T5B[d] * 8 + hd] - t5[31 * 8 + hd]) * LOG2E : 0.f); }
    LAS3 float* st = (LAS3 float*)(lds + L_ST);
    for (int i = tid; i < 192; i += NTHR) st[i] = (i < 96) ? NEG_INF : 0.f; }
  const int G = gridDim.x, bx = blockIdx.x;
  for (int v = (G % 8 == 0) ? (bx % 8) * (G / 8) + bx / 8 : bx; v < 256; v += G) {
    const int bg = v >> 4, p = v & 15, bh = v >> 2, j = v & 3;
#pragma unroll 1
    for (int u = 0; u < 2; ++u) nsa_unit(bg >> 1, bg & 1, u ? p : 31 - p, proj, kc, vc, onsa, lds);
#pragma unroll 1
    for (int u = 0; u < 2; ++u) mla_unit(bh >> 3, bh & 7, u ? j : 7 - j, mq, mkv, kr, omla, lds);
  }
}
#undef LAS3
}


namespace peer {
using bf16x8 = __attribute__((ext_vector_type(8))) short;
using f32x16 = __attribute__((ext_vector_type(16))) float;
typedef unsigned u32x4 __attribute__((ext_vector_type(4)));
typedef float f32x4_t __attribute__((ext_vector_type(4)));
typedef __bf16 bf16x2_t __attribute__((ext_vector_type(2)));
typedef float f32x2_t __attribute__((ext_vector_type(2)));
#define LAS3 __attribute__((address_space(3)))
__device__ __forceinline__ int crow(int r, int hi) { return (r & 3) + 8 * (r >> 2) + 4 * hi; }
__device__ __forceinline__ unsigned enc(float f) { const unsigned u = __float_as_uint(f); return u ^ ((unsigned)((int)u >> 31) | 0x80000000u); }
__device__ __forceinline__ float dec(unsigned k) { return __uint_as_float(k ^ (~(unsigned)((int)k >> 31) | 0x80000000u)); }
__device__ __forceinline__ unsigned umax(unsigned a, unsigned b) { return a > b ? a : b; }
__device__ __forceinline__ unsigned umin(unsigned a, unsigned b) { return a < b ? a : b; }
__device__ __forceinline__ unsigned cvtpk(float lo, float hi) { f32x2_t v = {lo, hi}; bf16x2_t b = __builtin_convertvector(v, bf16x2_t); return __builtin_bit_cast(unsigned, b); }
template <int B, int N> __device__ __forceinline__ void sort16(unsigned (&k)[N]) {
#pragma unroll
  for (int size = 2; size <= 16; size <<= 1)
#pragma unroll
    for (int stride = size >> 1; stride > 0; stride >>= 1)
#pragma unroll
      for (int i = 0; i < 16; ++i) { const int l = i ^ stride;
        if (l > i) { const bool desc = ((i & size) == 0); const unsigned a = k[B + i], b = k[B + l]; const unsigned mx = umax(a, b), mn = umin(a, b); k[B + i] = desc ? mx : mn; k[B + l] = desc ? mn : mx; } }
}
template <int A, int Bo, int N> __device__ __forceinline__ void merge16(unsigned (&k)[N]) {
#pragma unroll
  for (int i = 0; i < 16; ++i) k[A + i] = umax(k[A + i], k[Bo + 15 - i]);
#pragma unroll
  for (int stride = 8; stride > 0; stride >>= 1)
#pragma unroll
    for (int i = 0; i < 16; ++i) { const int l = i ^ stride; if (l > i) { const unsigned a = k[A + i], b = k[A + l]; k[A + i] = umax(a, b); k[A + l] = umin(a, b); } }
}
template <int N> __device__ __forceinline__ void top16_of_64(unsigned (&k)[N]) {
  sort16<0>(k); sort16<16>(k); sort16<32>(k); sort16<48>(k);
  merge16<0, 16>(k); merge16<32, 48>(k); merge16<0, 32>(k);
}

__device__ __forceinline__ void route_phase(const bf16_t* __restrict__ pq, const bf16_t* __restrict__ subk, unsigned* __restrict__ pack, LAS3 char* lds, int pm, int pn) {
  int tid = threadIdx.x; asm volatile("" : "+v"(tid));
  const int lane = tid & 63, r32 = lane & 31, hi = lane >> 5, wv = tid >> 6;
  LAS3 unsigned char* myb = (LAS3 unsigned char*)lds + wv * 2560 + lane * 40;
#pragma unroll 1
  for (int item = wv; item < 16; item += NWV) {
    const int h = pn * 2 + (item >> 3), t0 = pm * 256 + (item & 7) * 32;
    unsigned la[16], lb[16];
#pragma unroll
    for (int i = 0; i < 16; ++i) { la[i] = 0u; lb[i] = 0u; }
#pragma unroll 1
    for (int p = 0; p < 2; ++p) {
      f32x16 acc[4];
#pragma unroll
      for (int kt = 0; kt < 4; ++kt) acc[kt] = f32x16{};
#pragma unroll
      for (int kd = 0; kd < 4; ++kd) {
        const bf16x8 bq = *(const bf16x8*)(pq + (size_t)(t0 + r32) * 1024 + h * 128 + p * 64 + kd * 16 + hi * 8);
#pragma unroll
        for (int kt = 0; kt < 4; ++kt) {
          const bf16x8 ak = *(const bf16x8*)(subk + (size_t)((h * 2 + p) * 128 + kt * 32 + r32) * 64 + kd * 16 + hi * 8);
          acc[kt] = __builtin_amdgcn_mfma_f32_32x32x16_bf16(ak, bq, acc[kt], 0, 0, 0);
        }
      }
      unsigned k[64];
#pragma unroll
      for (int kt = 0; kt < 4; ++kt)
#pragma unroll
        for (int r = 0; r < 16; ++r) k[kt * 16 + r] = (enc(acc[kt][r]) & 0xFFFFFF80u) | (unsigned)(127 - (32 * kt + crow(r, hi)));
      top16_of_64(k);
#pragma unroll
      for (int i = 0; i < 16; ++i) { auto rr = __builtin_amdgcn_permlane32_swap(k[i], k[i], false, false); unsigned r0 = rr[0], r1 = rr[1]; asm volatile("" : "+v"(r0), "+v"(r1)); k[16 + i] = hi ? r0 : r1; }
      merge16<0, 16>(k);
#pragma unroll
      for (int i = 0; i < 16; ++i) { la[i] = (p == 0) ? k[i] : la[i]; lb[i] = (p == 0) ? lb[i] : k[i]; }
      __builtin_amdgcn_sched_barrier(0);
    }
#pragma unroll
    for (int i = 0; i < 4; ++i) {
      const unsigned wa = (127u - (la[4 * i] & 127u)) | ((127u - (la[4 * i + 1] & 127u)) << 8) | ((127u - (la[4 * i + 2] & 127u)) << 16) | ((127u - (la[4 * i + 3] & 127u)) << 24);
      const unsigned wb = (127u - (lb[4 * i] & 127u)) | ((127u - (lb[4 * i + 1] & 127u)) << 8) | ((127u - (lb[4 * i + 2] & 127u)) << 16) | ((127u - (lb[4 * i + 3] & 127u)) << 24);
      *(LAS3 unsigned*)(myb + 4 * i) = wa; *(LAS3 unsigned*)(myb + 16 + 4 * i) = wb;
    }
    float va[16], vb[16];
#pragma unroll
    for (int i = 0; i < 16; ++i) { va[i] = dec(la[i] & 0xFFFFFF80u); vb[i] = dec(lb[i] & 0xFFFFFF80u); }
    unsigned k[64];
#define PEER_CAND(n, i, j) k[n] = (enc(va[i] + vb[j]) & 0xFFFFFF00u) | (unsigned)(255 - ((i) * 16 + (j)))
    PEER_CAND(0, 0, 0); PEER_CAND(1, 0, 1); PEER_CAND(2, 0, 2); PEER_CAND(3, 0, 3); PEER_CAND(4, 0, 4); PEER_CAND(5, 0, 5);
    PEER_CAND(6, 0, 6); PEER_CAND(7, 0, 7); PEER_CAND(8, 0, 8); PEER_CAND(9, 0, 9); PEER_CAND(10, 0, 10); PEER_CAND(11, 0, 11);
    PEER_CAND(12, 0, 12); PEER_CAND(13, 0, 13); PEER_CAND(14, 0, 14); PEER_CAND(15, 0, 15); PEER_CAND(16, 1, 0); PEER_CAND(17, 1, 1);
    PEER_CAND(18, 1, 2); PEER_CAND(19, 1, 3); PEER_CAND(20, 1, 4); PEER_CAND(21, 1, 5); PEER_CAND(22, 1, 6); PEER_CAND(23, 1, 7);
    PEER_CAND(24, 2, 0); PEER_CAND(25, 2, 1); PEER_CAND(26, 2, 2); PEER_CAND(27, 2, 3); PEER_CAND(28, 2, 4); PEER_CAND(29, 3, 0);
    PEER_CAND(30, 3, 1); PEER_CAND(31, 3, 2); PEER_CAND(32, 3, 3); PEER_CAND(33, 4, 0); PEER_CAND(34, 4, 1); PEER_CAND(35, 4, 2);
    PEER_CAND(36, 5, 0); PEER_CAND(37, 5, 1); PEER_CAND(38, 6, 0); PEER_CAND(39, 6, 1); PEER_CAND(40, 7, 0); PEER_CAND(41, 7, 1);
    PEER_CAND(42, 8, 0); PEER_CAND(43, 9, 0); PEER_CAND(44, 10, 0); PEER_CAND(45, 11, 0); PEER_CAND(46, 12, 0); PEER_CAND(47, 13, 0);
    PEER_CAND(48, 14, 0); PEER_CAND(49, 15, 0);
#undef PEER_CAND
#pragma unroll
    for (int z = 50; z < 64; ++z) k[z] = 0u;
    top16_of_64(k);
    const float best0 = dec(k[0] & 0xFFFFFF00u);
    float ev[16]; float den = 0.f;
#pragma unroll
    for (int i = 0; i < 16; ++i) { ev[i] = __expf(dec(k[i] & 0xFFFFFF00u) - best0); den += ev[i]; }
    const float inv = 1.0f / den;
    unsigned outw[8];
#pragma unroll
    for (int i = 0; i < 8; ++i) {
      unsigned k_lo = k[i], k_hi = k[8 + i]; float e_lo = ev[i], e_hi = ev[8 + i];
      asm volatile("" : "+v"(k_lo), "+v"(k_hi), "+v"(e_lo), "+v"(e_hi));
      const unsigned kk = hi ? k_hi : k_lo; const float e = hi ? e_hi : e_lo;
      const unsigned f = 255u - (kk & 255u);
      const unsigned ia = myb[f >> 4], ib = myb[16 + (f & 15u)];
      outw[i] = (ia * 128u + ib) | (cvtpk(0.f, e * inv) & 0xFFFF0000u);
    }
    unsigned* dst = pack + (size_t)(t0 + r32) * 128 + h * 16 + hi * 8;
    *(u32x4*)dst = (u32x4){outw[0], outw[1], outw[2], outw[3]};
    *(u32x4*)(dst + 4) = (u32x4){outw[4], outw[5], outw[6], outw[7]};
  }
}

__device__ __forceinline__ void conv_tables(const float* __restrict__ u, const float* __restrict__ v, unsigned* __restrict__ u8, float* __restrict__ su, unsigned* __restrict__ v8) {
  const int tid = threadIdx.x, lane = tid & 63, wv = tid >> 6;
  const int gw = blockIdx.x * NWV + wv, nw = gridDim.x * NWV;
  for (int e = gw; e < 16384; e += nw) {
    const f32x4_t* ur = (const f32x4_t*)(u + (size_t)e * 1024) + lane * 4;
    f32x4_t a[4]; float mx = 0.f;
#pragma unroll
    for (int i = 0; i < 4; ++i) { a[i] = ur[i]; mx = fmaxf(mx, fmaxf(fmaxf(fabsf(a[i][0]), fabsf(a[i][1])), fmaxf(fabsf(a[i][2]), fabsf(a[i][3])))); }
    mx = wmaxf(mx);
    const float sc = fmaxf(mx, 1e-30f) * (1.0f / 127.0f), isc = 1.0f / sc;
    u32x4 o;
#pragma unroll
    for (int i = 0; i < 4; ++i) {
      const int q0 = (int)rintf(a[i][0] * isc), q1 = (int)rintf(a[i][1] * isc), q2 = (int)rintf(a[i][2] * isc), q3 = (int)rintf(a[i][3] * isc);
      o[i] = (unsigned)(q0 & 255) | ((unsigned)(q1 & 255) << 8) | ((unsigned)(q2 & 255) << 16) | ((unsigned)(q3 & 255) << 24);
    }
    *(u32x4*)(u8 + (size_t)e * 256 + lane * 4) = o;
    if (lane == 0) su[e] = sc;
    const f32x4_t* vr = (const f32x4_t*)(v + (size_t)e * 1024) + lane * 4;
    u32x4 ov;
#pragma unroll
    for (int i = 0; i < 4; ++i) { const f32x4_t b = vr[i]; unsigned w = 0u; w = __builtin_amdgcn_cvt_pk_fp8_f32(2.0f * b[0], 2.0f * b[1], w, false); w = __builtin_amdgcn_cvt_pk_fp8_f32(2.0f * b[2], 2.0f * b[3], w, true); ov[i] = w; }
    *(u32x4*)(v8 + ((size_t)(lane >> 3) * 16384 + e) * 32 + (lane & 7) * 4) = ov;
  }
}
__device__ __forceinline__ float gelu_fast(float v) {
  const float av = __builtin_fabsf(v), t = __builtin_amdgcn_rcpf(av * 0.2316418882f + 1.0f);
  float q = t * 0.5307027145f + (-0.7265760135f); q = q * t + 0.7107068705f; q = q * t + (-0.142248368f); q = q * t + 0.127414796f; q = q * t;
  const float e = __builtin_amdgcn_exp2f((v * v) * (-0.72134752044f));
  const float m = v * (q * e);
  return v < 0.f ? m : v - m;
}
__device__ __forceinline__ unsigned xcc_id() { return (unsigned)__builtin_amdgcn_s_getreg((3 << 11) | 20) & 7u; }
struct ABuf { unsigned w, meta; u32x4 ub[8]; float sue; };
__device__ __forceinline__ void expA_issue(ABuf& B, int k0, int n, const LAS3 unsigned* list, const unsigned* __restrict__ u8, const float* __restrict__ su, int j8) {
  const int k = (k0 < n) ? k0 : 0;
  B.w = list[2 * k]; B.meta = list[2 * k + 1];
  const unsigned e = B.w & 0xFFFFu;
  const unsigned* urow = u8 + (size_t)e * 256 + j8 * 4;
#pragma unroll
  for (int seg = 0; seg < 8; ++seg) B.ub[seg] = *(const u32x4*)(urow + seg * 32);
  B.sue = su[e];
}
__device__ __forceinline__ void expA_consume(const ABuf& B, int k0, int n, const LAS3 char* hl, const LAS3 float* shl, float* __restrict__ co, int t0, int j8) {
  const int tokl = (int)(B.meta >> 8), slot = (int)(B.meta & 255u);
  const LAS3 char* hrow = hl + tokl * 1024 + j8 * 16;
  int a0 = 0, a1 = 0, a2 = 0, a3 = 0;
#pragma unroll
  for (int seg = 0; seg < 8; ++seg) { const u32x4 hq = *(const LAS3 u32x4*)(hrow + seg * 128);
    a0 = __builtin_amdgcn_sdot4((int)B.ub[seg].x, (int)hq.x, a0, false); a1 = __builtin_amdgcn_sdot4((int)B.ub[seg].y, (int)hq.y, a1, false);
    a2 = __builtin_amdgcn_sdot4((int)B.ub[seg].z, (int)hq.z, a2, false); a3 = __builtin_amdgcn_sdot4((int)B.ub[seg].w, (int)hq.w, a3, false); }
  int acc = (a0 + a1) + (a2 + a3);
  acc += dpp_i<0xB1>(acc); acc += dpp_i<0x4E>(acc); acc += dpp_i<0x141>(acc);
  const float d = (float)acc * (B.sue * shl[tokl]);
  const float c = 0.5f * __uint_as_float(B.w & 0xFFFF0000u) * gelu_fast(d);
  if (j8 == 0 && k0 < n) co[(size_t)(t0 + tokl) * 128 + slot] = c;
}
struct AStage { u32x4 pw[4], hst[8]; float shv; };
__device__ __forceinline__ void expA_stage(AStage& S, int item, const unsigned* __restrict__ pack, const unsigned* __restrict__ hn8, const float* __restrict__ shp, int tid) {
  const int t0 = item * 64, tokl = tid >> 3, sb = (tid & 7) * 16;
#pragma unroll
  for (int i = 0; i < 4; ++i) S.pw[i] = *(const u32x4*)(pack + (size_t)(t0 + tokl) * 128 + sb + 4 * i);
#pragma unroll
  for (int i = 0; i < 8; ++i) S.hst[i] = *(const u32x4*)(hn8 + (size_t)t0 * 256 + (tid + 512 * i) * 4);
  S.shv = (tid < 64) ? shp[t0 + tid] : 0.f;
}
__device__ __forceinline__ void expA_item(AStage& S, int item, int nitem, int xs, const unsigned* __restrict__ pack, const unsigned* __restrict__ hn8, const float* __restrict__ shp, const unsigned* __restrict__ u8, const float* __restrict__ su,
                                          float* __restrict__ co, LAS3 char* lds, int tid) {
  const int lane = tid & 63, wv = tid >> 6;
  LAS3 char* hl = lds + 1024;
  LAS3 float* shl = (LAS3 float*)(lds + 1024 + 65536);
  LAS3 unsigned* cnt = (LAS3 unsigned*)(lds + 16);
  LAS3 unsigned* list = (LAS3 unsigned*)(lds + 1024 + 65536 + 256);
  const int t0 = item * 64;
  const int tokl = tid >> 3, sb = (tid & 7) * 16;
#pragma unroll
  for (int i = 0; i < 8; ++i) *(LAS3 u32x4*)(hl + (tid + 512 * i) * 16) = S.hst[i];
  if (tid < 64) shl[tid] = S.shv;
  {
    unsigned long long mk[16]; int tot = 0; int off[16];
#pragma unroll
    for (int j = 0; j < 16; ++j) { const unsigned w = S.pw[j >> 2][j & 3]; mk[j] = __ballot(((w & 0xFFFFu) >> 11) == (unsigned)xs); off[j] = tot; tot += __builtin_popcountll(mk[j]); }
    int base = 0;
    if (lane == 0) base = (int)__hip_atomic_fetch_add(cnt, (unsigned)tot, __ATOMIC_RELAXED, __HIP_MEMORY_SCOPE_WORKGROUP);
    base = __builtin_amdgcn_readfirstlane(base);
#pragma unroll
    for (int j = 0; j < 16; ++j) { const unsigned w = S.pw[j >> 2][j & 3];
      if (((w & 0xFFFFu) >> 11) == (unsigned)xs) { const int pos = base + off[j] + (int)__builtin_amdgcn_mbcnt_hi((unsigned)(mk[j] >> 32), __builtin_amdgcn_mbcnt_lo((unsigned)mk[j], 0u));
        list[2 * pos] = w; list[2 * pos + 1] = (unsigned)((tokl << 8) | (sb + j)); } }
  }
  if (nitem < T / 64) expA_stage(S, nitem, pack, hn8, shp, tid);
  __syncthreads();
  const int n = (int)cnt[0];
  const int j8 = lane & 7, gidx = wv * 8 + (lane >> 3);
  ABuf A, Bb;
  expA_issue(A, gidx, n, list, u8, su, j8);
#pragma unroll 1
  for (int k0 = gidx; k0 < n; k0 += 128) {
    expA_issue(Bb, k0 + 64, n, list, u8, su, j8);
    expA_consume(A, k0, n, hl, shl, co, t0, j8);
    expA_issue(A, k0 + 128, n, list, u8, su, j8);
    expA_consume(Bb, k0 + 64, n, hl, shl, co, t0, j8);
  }
}
struct BBuf { u32x4 vv[8]; f32x4_t c[2]; };
__device__ __forceinline__ void expB_issue(BBuf& B, const LAS3 unsigned* pkl, const LAS3 float* col, int sg8, const unsigned* __restrict__ vbase) {
  const u32x4 p0 = *(const LAS3 u32x4*)(pkl + sg8 * 8), p1 = *(const LAS3 u32x4*)(pkl + sg8 * 8 + 4);
  B.c[0] = *(const LAS3 f32x4_t*)(col + sg8 * 8); B.c[1] = *(const LAS3 f32x4_t*)(col + sg8 * 8 + 4);
#pragma unroll
  for (int j = 0; j < 4; ++j) { B.vv[j] = *(const u32x4*)(vbase + (size_t)(p0[j] & 0xFFFFu) * 32); B.vv[4 + j] = *(const u32x4*)(vbase + (size_t)(p1[j] & 0xFFFFu) * 32); }
}
__device__ __forceinline__ void expB_consume(const BBuf& B, f32x2_t (&y)[8]) {
#pragma unroll
  for (int j = 0; j < 8; ++j) {
    const float cv = B.c[j >> 2][j & 3];
    const f32x2_t c2 = {cv, cv};
#pragma unroll
    for (int w = 0; w < 4; ++w) {
      y[2 * w] = __builtin_elementwise_fma(__builtin_amdgcn_cvt_pk_f32_fp8(B.vv[j][w], false), c2, y[2 * w]);
      y[2 * w + 1] = __builtin_elementwise_fma(__builtin_amdgcn_cvt_pk_f32_fp8(B.vv[j][w], true), c2, y[2 * w + 1]);
    }
  }
}
__device__ __forceinline__ void expB_item(int item, int xs, const unsigned* __restrict__ pack, const float* __restrict__ co, const unsigned* __restrict__ v8, bf16_t* __restrict__ zb, float* __restrict__ ssq, LAS3 char* lds, int tid,
                                          const float* __restrict__ xin, const bf16_t* __restrict__ ob) {
  const int lane = tid & 63, wv = tid >> 6, r8 = lane >> 3, c8 = lane & 7;
  const int t0 = item * 64 + wv * 8;
  LAS3 unsigned* pkw = (LAS3 unsigned*)(lds + 1024 + wv * 8192);
  LAS3 float* cow = (LAS3 float*)(lds + 1024 + wv * 8192 + 4096);
  {
    u32x4 a[4]; f32x4_t b[4];
#pragma unroll
    for (int i = 0; i < 4; ++i) { a[i] = *(const u32x4*)(pack + (size_t)t0 * 128 + (lane + 64 * i) * 4); b[i] = *(const f32x4_t*)(co + (size_t)t0 * 128 + (lane + 64 * i) * 4); }
#pragma unroll
    for (int i = 0; i < 4; ++i) { *(LAS3 u32x4*)(pkw + (lane + 64 * i) * 4) = a[i]; *(LAS3 f32x4_t*)(cow + (lane + 64 * i) * 4) = b[i]; }
  }
  const size_t hoff = (size_t)(t0 + r8) * 1024 + xs * 128 + c8 * 16;
  f32x4_t h[4];
  { const u32x4 o0 = *(const u32x4*)(ob + hoff), o1 = *(const u32x4*)(ob + hoff + 8);
#pragma unroll
    for (int w = 0; w < 4; ++w) h[w] = *(const f32x4_t*)(xin + hoff + 4 * w);
    h[0] += (f32x4_t){__uint_as_float(o0.x << 16), __uint_as_float(o0.x & 0xffff0000u), __uint_as_float(o0.y << 16), __uint_as_float(o0.y & 0xffff0000u)};
    h[1] += (f32x4_t){__uint_as_float(o0.z << 16), __uint_as_float(o0.z & 0xffff0000u), __uint_as_float(o0.w << 16), __uint_as_float(o0.w & 0xffff0000u)};
    h[2] += (f32x4_t){__uint_as_float(o1.x << 16), __uint_as_float(o1.x & 0xffff0000u), __uint_as_float(o1.y << 16), __uint_as_float(o1.y & 0xffff0000u)};
    h[3] += (f32x4_t){__uint_as_float(o1.z << 16), __uint_as_float(o1.z & 0xffff0000u), __uint_as_float(o1.w << 16), __uint_as_float(o1.w & 0xffff0000u)}; }
  wave_lds_sync();
  const LAS3 unsigned* pkl = pkw + r8 * 128; const LAS3 float* col = cow + r8 * 128;
  const unsigned* vbase = v8 + (size_t)xs * 16384 * 32 + c8 * 4;
  f32x2_t y[8];
#pragma unroll
  for (int i = 0; i < 8; ++i) y[i] = (f32x2_t){0.f, 0.f};
  BBuf A, Bb;
  expB_issue(A, pkl, col, 0, vbase);
#pragma unroll 1
  for (int sg = 0; sg < 16; sg += 2) {
    expB_issue(Bb, pkl, col, sg + 1, vbase);
    expB_consume(A, y);
    if (sg + 2 < 16) expB_issue(A, pkl, col, sg + 2, vbase);
    expB_consume(Bb, y);
  }
  float ss = 0.f; unsigned zw[8];
#pragma unroll
  for (int w = 0; w < 4; ++w) {
    const f32x4_t z = {h[w][0] + y[2 * w][0], h[w][1] + y[2 * w][1], h[w][2] + y[2 * w + 1][0], h[w][3] + y[2 * w + 1][1]};
    zw[2 * w] = cvtpk(z[0], z[1]); zw[2 * w + 1] = cvtpk(z[2], z[3]);
    ss += (z[0] * z[0] + z[1] * z[1]) + (z[2] * z[2] + z[3] * z[3]);
  }
  *(u32x4*)(zb + hoff) = (u32x4){zw[0], zw[1], zw[2], zw[3]}; *(u32x4*)(zb + hoff + 8) = (u32x4){zw[4], zw[5], zw[6], zw[7]};
  ss += dpp_f<0xB1>(ss); ss += dpp_f<0x4E>(ss); ss += dpp_f<0x141>(ss);
  if (c8 == 0) ssq[(size_t)xs * T + t0 + r8] = ss;
  wave_lds_sync();
}
template <int PASS> __device__ __forceinline__ void experts_sliced(const unsigned* __restrict__ pack, const unsigned* __restrict__ hn8, const float* __restrict__ shp, const unsigned* __restrict__ u8, const float* __restrict__ su,
                                                                    float* __restrict__ co, const unsigned* __restrict__ v8, float* __restrict__ out, float* __restrict__ ssq, unsigned* __restrict__ ctr, LAS3 char* lds,
                                                                    const float* __restrict__ xin = nullptr, const bf16_t* __restrict__ ob = nullptr) {
  int tid = threadIdx.x; asm volatile("" : "+v"(tid));
  LAS3 volatile int* lw = (LAS3 volatile int*)lds;
  const int xme = (int)xcc_id();
#pragma unroll 1
  for (int s8 = 0; s8 < 8; ++s8) {
    const int xs = (xme + s8) & 7;
    if (PASS == 0) {
      int nxt = 0;
      if (tid == 0) nxt = (int)atomicAdd(ctr + 64 * xs, 1u);
      __syncthreads();
      if (tid == 0) lw[0] = nxt;
      __syncthreads();
      int item = lw[0];
      if (item >= T / 64) continue;
      if (tid == 0) nxt = (int)atomicAdd(ctr + 64 * xs, 1u);
      AStage SA;
      expA_stage(SA, item, pack, hn8, shp, tid);
#pragma unroll 1
      for (;;) {
        __syncthreads();
        if (tid == 0) { lw[0] = nxt; lw[4] = 0; }
        __syncthreads();
        const int nitem = lw[0];
        if (tid == 0) nxt = (int)atomicAdd(ctr + 64 * xs, 1u);
        expA_item(SA, item, nitem, xs, pack, hn8, shp, u8, su, co, lds, tid);
        if (nitem >= T / 64) break;
        item = nitem;
      }
    } else {
      int nxt = 0;
      if (tid == 0) nxt = (int)atomicAdd(ctr + 64 * xs, 1u);
#pragma unroll 1
      for (;;) {
        __syncthreads();
        if (tid == 0) lw[0] = nxt;
        __syncthreads();
        const int item = lw[0];
        if (item >= T / 64) break;
        if (tid == 0) nxt = (int)atomicAdd(ctr + 64 * xs, 1u);
        expB_item(item, xs, pack, co, v8, (bf16_t*)out, ssq, lds, tid, xin, ob);
      }
    }
  }
}
__device__ __forceinline__ void experts_norm(const float* __restrict__ ssq, const float* __restrict__ gfin, const bf16_t* __restrict__ zb, float* __restrict__ out) {
  const int tid = threadIdx.x, lane = tid & 63, wv = tid >> 6;
  const int gw = blockIdx.x * NWV + wv, nw = gridDim.x * NWV;
  for (int t = gw; t < T; t += nw) {
    float ss = 0.f;
#pragma unroll
    for (int x = 0; x < 8; ++x) ss += ssq[(size_t)x * T + t];
    const float inv = rsqrtf(ss * (1.0f / 1024.0f) + 1e-6f);
    float* op = out + (size_t)t * 1024 + lane * 16; const float* gp = gfin + lane * 16;
    const u32x4 z0 = *(const u32x4*)(zb + (size_t)t * 1024 + lane * 16), z1 = *(const u32x4*)(zb + (size_t)t * 1024 + lane * 16 + 8);
    const unsigned zz[8] = {z0.x, z0.y, z0.z, z0.w, z1.x, z1.y, z1.z, z1.w};
#pragma unroll
    for (int i = 0; i < 4; ++i) { const f32x4_t z = {__uint_as_float(zz[2 * i] << 16), __uint_as_float(zz[2 * i] & 0xffff0000u), __uint_as_float(zz[2 * i + 1] << 16), __uint_as_float(zz[2 * i + 1] & 0xffff0000u)};
      const f32x4_t g = *(const f32x4_t*)(gp + 4 * i); *(f32x4_t*)(op + 4 * i) = z * inv * g; }
  }
}
#undef LAS3
}

namespace prep {
typedef unsigned u32x2_t __attribute__((ext_vector_type(2)));
typedef float f32x4_t __attribute__((ext_vector_type(4)));
typedef unsigned u32x4 __attribute__((ext_vector_type(4)));
using bf16x8 = __attribute__((ext_vector_type(8))) short;
using f32x16 = __attribute__((ext_vector_type(16))) float;
__device__ __forceinline__ unsigned pk2(float lo, float hi) { return (unsigned)f2bf(lo) | ((unsigned)f2bf(hi) << 16); }
__device__ __forceinline__ void latent_rows(const bf16_t* __restrict__ proj, const float* __restrict__ gq, const float* __restrict__ gkv, const float2* __restrict__ cs,
                                            bf16_t* __restrict__ cqn, bf16_t* __restrict__ ckvn, bf16_t* __restrict__ krope, int wave_id, int nwaves, int lane) {
  const f32x4_t g4 = *(const f32x4_t*)(gq + lane * 4);
  const float2 g2 = *(const float2*)(gkv + lane * 2);
  for (int r = wave_id; r < T; r += nwaves) {
    const bf16_t* row = proj + (size_t)r * PROJ_LD;
    const u32x2_t q = *(const u32x2_t*)(row + PC_CQ + lane * 4);
    const unsigned kv = *(const unsigned*)(row + PC_CKV + lane * 2);
    const unsigned short kr0 = row[PC_KR + (lane & 15)], kr1 = row[PC_KR + 16 + (lane & 15)];
    const float q0 = __uint_as_float(q.x << 16), q1 = __uint_as_float(q.x & 0xffff0000u), q2 = __uint_as_float(q.y << 16), q3 = __uint_as_float(q.y & 0xffff0000u);
    const float k0 = __uint_as_float(kv << 16), k1 = __uint_as_float(kv & 0xffff0000u);
    float sq = (q0 * q0 + q1 * q1) + (q2 * q2 + q3 * q3), sk = k0 * k0 + k1 * k1;
    sq = wsum(sq); sk = wsum(sk);
    const float iq = rsqrtf(sq * (1.0f / 256.0f) + 1e-6f), ik = rsqrtf(sk * (1.0f / 128.0f) + 1e-6f);
    u32x2_t oq; oq.x = pk2(q0 * iq * g4[0], q1 * iq * g4[1]); oq.y = pk2(q2 * iq * g4[2], q3 * iq * g4[3]);
    *(u32x2_t*)(cqn + (size_t)r * 256 + lane * 4) = oq;
    *(unsigned*)(ckvn + (size_t)r * 128 + lane * 2) = pk2(k0 * ik * g2.x, k1 * ik * g2.y);
    if (lane < 16) {
      const float2 c = cs[(r & (SEQ - 1)) * 16 + lane];
      const float x1 = bf2f(kr0), x2 = bf2f(kr1);
      krope[(size_t)r * 32 + lane] = f2bf(x1 * c.x - x2 * c.y); krope[(size_t)r * 32 + 16 + lane] = f2bf(x2 * c.x + x1 * c.y);
    }
  }
}
__device__ __forceinline__ void cmp_bias(const float* __restrict__ posk, const float* __restrict__ posv, const bf16_t* __restrict__ w1k, const bf16_t* __restrict__ w1v, float* __restrict__ cpos, int wave_id, int nwaves, int lane) {
  for (int o = wave_id; o < 512; o += nwaves) {
    const int tab = o >> 8, n = o & 255;
    const float* pos = tab ? posv : posk; const bf16_t* w = (tab ? w1v : w1k) + (size_t)n * 2048;
    float acc = 0.f;
#pragma unroll
    for (int i = 0; i < 4; ++i) { const int k = (i * 64 + lane) * 8;
      const u32x4 wv = *(const u32x4*)(w + k); const f32x4_t p0 = *(const f32x4_t*)(pos + k), p1 = *(const f32x4_t*)(pos + k + 4);
      acc += p0[0] * __uint_as_float(wv.x << 16) + p0[1] * __uint_as_float(wv.x & 0xffff0000u) + p0[2] * __uint_as_float(wv.y << 16) + p0[3] * __uint_as_float(wv.y & 0xffff0000u);
      acc += p1[0] * __uint_as_float(wv.z << 16) + p1[1] * __uint_as_float(wv.z & 0xffff0000u) + p1[2] * __uint_as_float(wv.w << 16) + p1[3] * __uint_as_float(wv.w & 0xffff0000u); }
    acc = wsum(acc);
    if (lane == 0) cpos[o] = acc;
  }
}
__device__ __forceinline__ void cmp_l2(const float* __restrict__ slab, const float* __restrict__ cpos, const bf16_t* __restrict__ w2t, bf16_t* __restrict__ outkc, int item, int lane) {
  const int r32 = lane & 31, hi = lane >> 5, m0 = item * 32;
  f32x16 acc0 = f32x16{}, acc1 = f32x16{};
  f32x4_t sa[2][8]; f32x4_t cp[2][2]; bf16x8 wb[2][2];
#define CMPL2_LOAD(buf, ks_) do { const int k_ = (ks_) * 16 + hi * 8; \
    cp[buf][0] = *(const f32x4_t*)(cpos + k_); cp[buf][1] = *(const f32x4_t*)(cpos + k_ + 4); \
    _Pragma("unroll") for (int sp = 0; sp < 4; ++sp) { const float* p_ = slab + ((size_t)sp * 2048 + m0 + r32) * 256 + k_; sa[buf][2 * sp] = *(const f32x4_t*)p_; sa[buf][2 * sp + 1] = *(const f32x4_t*)(p_ + 4); } \
    wb[buf][0] = *(const bf16x8*)(w2t + (size_t)r32 * 256 + k_); wb[buf][1] = *(const bf16x8*)(w2t + (size_t)(32 + r32) * 256 + k_); } while (0)
#define CMPL2_MMA(buf) do { f32x4_t a0 = cp[buf][0], a1 = cp[buf][1]; \
    _Pragma("unroll") for (int sp = 0; sp < 4; ++sp) { a0 += sa[buf][2 * sp]; a1 += sa[buf][2 * sp + 1]; } \
    u32x4 aw; aw.x = pk2(peer::gelu_fast(a0[0]), peer::gelu_fast(a0[1])); aw.y = pk2(peer::gelu_fast(a0[2]), peer::gelu_fast(a0[3])); \
    aw.z = pk2(peer::gelu_fast(a1[0]), peer::gelu_fast(a1[1])); aw.w = pk2(peer::gelu_fast(a1[2]), peer::gelu_fast(a1[3])); \
    const bf16x8 af = __builtin_bit_cast(bf16x8, aw); \
    acc0 = __builtin_amdgcn_mfma_f32_32x32x16_bf16(af, wb[buf][0], acc0, 0, 0, 0); acc1 = __builtin_amdgcn_mfma_f32_32x32x16_bf16(af, wb[buf][1], acc1, 0, 0, 0); } while (0)
  CMPL2_LOAD(0, 0);
#pragma unroll 1
  for (int ks = 0; ks < 16; ks += 2) {
    CMPL2_LOAD(1, ks + 1);
    CMPL2_MMA(0);
    if (ks + 2 < 16) CMPL2_LOAD(0, ks + 2);
    CMPL2_MMA(1);
  }
#undef CMPL2_LOAD
#undef CMPL2_MMA
#pragma unroll
  for (int r = 0; r < 16; ++r) {
    const int m = m0 + (r & 3) + 8 * (r >> 2) + 4 * hi;
    const bool pad = (m & 127) == 127;
    outkc[(size_t)m * 64 + r32] = pad ? (bf16_t)0 : f2bf(acc0[r]);
    outkc[(size_t)m * 64 + 32 + r32] = pad ? (bf16_t)0 : f2bf(acc1[r]);
  }
}
__device__ __forceinline__ void cmp_l2_w4(const float* __restrict__ slab, const float* __restrict__ cpos, const bf16_t* __restrict__ w2t, bf16_t* __restrict__ outkc, int item, int q, int lane,
                                          __attribute__((address_space(3))) float* red) {
  const int r32 = lane & 31, hi = lane >> 5, m0 = item * 32;
  f32x16 acc0 = f32x16{}, acc1 = f32x16{};
  f32x4_t sa[2][8]; f32x4_t cp[2][2]; bf16x8 wb[2][2];
#define CMPL2_LOAD(buf, ks_) do { const int k_ = (ks_) * 16 + hi * 8; \
    cp[buf][0] = *(const f32x4_t*)(cpos + k_); cp[buf][1] = *(const f32x4_t*)(cpos + k_ + 4); \
    _Pragma("unroll") for (int sp = 0; sp < 4; ++sp) { const float* p_ = slab + ((size_t)sp * 2048 + m0 + r32) * 256 + k_; sa[buf][2 * sp] = *(const f32x4_t*)p_; sa[buf][2 * sp + 1] = *(const f32x4_t*)(p_ + 4); } \
    wb[buf][0] = *(const bf16x8*)(w2t + (size_t)r32 * 256 + k_); wb[buf][1] = *(const bf16x8*)(w2t + (size_t)(32 + r32) * 256 + k_); } while (0)
#define CMPL2_MMA(buf) do { f32x4_t a0 = cp[buf][0], a1 = cp[buf][1]; \
    _Pragma("unroll") for (int sp = 0; sp < 4; ++sp) { a0 += sa[buf][2 * sp]; a1 += sa[buf][2 * sp + 1]; } \
    u32x4 aw; aw.x = pk2(peer::gelu_fast(a0[0]), peer::gelu_fast(a0[1])); aw.y = pk2(peer::gelu_fast(a0[2]), peer::gelu_fast(a0[3])); \
    aw.z = pk2(peer::gelu_fast(a1[0]), peer::gelu_fast(a1[1])); aw.w = pk2(peer::gelu_fast(a1[2]), peer::gelu_fast(a1[3])); \
    const bf16x8 af = __builtin_bit_cast(bf16x8, aw); \
    acc0 = __builtin_amdgcn_mfma_f32_32x32x16_bf16(af, wb[buf][0], acc0, 0, 0, 0); acc1 = __builtin_amdgcn_mfma_f32_32x32x16_bf16(af, wb[buf][1], acc1, 0, 0, 0); } while (0)
  const int k0 = q * 4;
  CMPL2_LOAD(0, k0); CMPL2_LOAD(1, k0 + 1);
  CMPL2_MMA(0); CMPL2_LOAD(0, k0 + 2);
  CMPL2_MMA(1); CMPL2_LOAD(1, k0 + 3);
  CMPL2_MMA(0); CMPL2_MMA(1);
#undef CMPL2_LOAD
#undef CMPL2_MMA
#pragma unroll
  for (int r = 0; r < 16; ++r) { red[(q * 32 + r) * 64 + lane] = acc0[r]; red[(q * 32 + 16 + r) * 64 + lane] = acc1[r]; }
  __syncthreads();
#pragma unroll
  for (int rr = 0; rr < 4; ++rr) {
    const int r = q * 4 + rr;
    float s0 = 0.f, s1 = 0.f;
#pragma unroll
    for (int p = 0; p < 4; ++p) { s0 += red[(p * 32 + r) * 64 + lane]; s1 += red[(p * 32 + 16 + r) * 64 + lane]; }
    const int m = m0 + rr + 8 * q + 4 * hi;
    const bool pad = (m & 127) == 127;
    outkc[(size_t)m * 64 + r32] = pad ? (bf16_t)0 : f2bf(s0);
    outkc[(size_t)m * 64 + 32 + r32] = pad ? (bf16_t)0 : f2bf(s1);
  }
}
}

#define XB_TMO      128
#define XB_XCNT(j)  (256  + 64 * (j))
#define XB_XSUB(j)  (1280 + 64 * (j))
#define XB_XGEN(j)  (2304 + 64 * (j))
#define XB_TOP      3328
#define XB_TOPGEN   3392
#define XCD_BAR_WORDS 3456
#define XB_SPIN_CAP (1u << 18)
#ifndef LAS
#define LAS __attribute__((address_space(3)))
#endif

__device__ __forceinline__ unsigned xb_ld(unsigned* p)              { return __hip_atomic_load(p, __ATOMIC_RELAXED, __HIP_MEMORY_SCOPE_AGENT); }
__device__ __forceinline__ unsigned xb_add(unsigned* p, unsigned v) { return __hip_atomic_fetch_add(p, v, __ATOMIC_RELAXED, __HIP_MEMORY_SCOPE_AGENT); }
__device__ __forceinline__ unsigned xb_xcc_id() { return (unsigned)__builtin_amdgcn_s_getreg((3 << 11) | 20) & 0xFu; }
#define XB_SPIN(cond, bar) do { unsigned _sp = 0; while (cond) { __builtin_amdgcn_s_sleep(1); \
    if ((++_sp & 255u) == 0u) { if (xb_ld(&(bar)[XB_TMO])) break; if (_sp > XB_SPIN_CAP) { atomicAdd(&(bar)[XB_TMO], 1u); break; } } } } while (0)

struct XcdBarrier {
    unsigned* bar; unsigned x;
    volatile LAS unsigned* st;
};

__device__ __forceinline__ XcdBarrier xcd_barrier_post(unsigned* bar, volatile LAS unsigned* st) {
    XcdBarrier b; b.bar = bar; b.x = xb_xcc_id(); b.st = st;
    if (threadIdx.x == 0) (void)xb_add(&bar[XB_XCNT(b.x)], 1u);
    return b;
}
__device__ __forceinline__ void xcd_barrier_complete(unsigned* bar, unsigned x, unsigned& nloc, unsigned& nx) {
    const unsigned G = gridDim.x * gridDim.y * gridDim.z;
    unsigned sum, cnt, mine, sp = 0u;
    for (;;) {
        sum = 0u; cnt = 0u; mine = 0u;
#pragma unroll
        for (unsigned j = 0; j < 16; ++j) { const unsigned c = xb_ld(&bar[XB_XCNT(j)]); sum += c; cnt += (c > 0u) ? 1u : 0u; mine = (j == x) ? c : mine; }
        if (sum == G) break;
        __builtin_amdgcn_s_sleep(1);
        if ((++sp & 255u) == 0u) { if (xb_ld(&bar[XB_TMO])) break; if (sp > XB_SPIN_CAP) { atomicAdd(&bar[XB_TMO], 1u); break; } }
    }
    nloc = mine > 0u ? mine : 1u; nx = cnt > 0u ? cnt : 1u;
}

__device__ __forceinline__ void xcd_barrier(const XcdBarrier& b) {
    asm volatile("s_waitcnt vmcnt(0)" ::: "memory");
    __syncthreads();
    if (threadIdx.x == 0) {
        unsigned* bar = b.bar;
        __builtin_amdgcn_s_waitcnt(0);
        unsigned nloc = b.st[0], nx = b.st[1];
        if (nloc == 0u) { xcd_barrier_complete(bar, b.x, nloc, nx); b.st[0] = nloc; b.st[1] = nx; }
        const unsigned old = xb_add(&bar[XB_XSUB(b.x)], 1u);
        const unsigned gen = old / nloc;
        if (old + 1u == (gen + 1u) * nloc) {
            __builtin_amdgcn_fence(__ATOMIC_RELEASE, "agent");
            asm volatile("s_waitcnt vmcnt(0)" ::: "memory");
            const unsigned og = xb_add(&bar[XB_TOP], 1u);
            const unsigned tg = og / nx;
            if (og + 1u == (tg + 1u) * nx) xb_add(&bar[XB_TOPGEN], 1u);
            else XB_SPIN(xb_ld(&bar[XB_TOPGEN]) == tg, bar);
            __builtin_amdgcn_fence(__ATOMIC_ACQUIRE, "agent");
            xb_add(&bar[XB_XGEN(b.x)], 1u);
            asm volatile("s_waitcnt vmcnt(0)" ::: "memory");
        } else {
            XB_SPIN(xb_ld(&bar[XB_XGEN(b.x)]) == gen, bar);
            __builtin_amdgcn_fence(__ATOMIC_ACQUIRE, "agent");
            asm volatile("s_waitcnt vmcnt(0)" ::: "memory");
        }
    }
    __syncthreads();
}

struct Args { const float* in[23]; float* out; char* ws; };
constexpr int LDS_BYTES = 131072 + 4096;

typedef const __attribute__((address_space(4))) Args* kargs_t;
DEV kargs_t KA() { kargs_t k = (kargs_t)__builtin_amdgcn_kernarg_segment_ptr(); asm volatile("" : "+s"(k)); return k; }
#define WSP(type, off) ((type*)(ws + (off)))

__global__ __launch_bounds__(NTHR, 2) void mega(Args a) {
  extern __shared__ __attribute__((aligned(16))) char lds[];
  PG8_LAS unsigned char* glds = (PG8_LAS unsigned char*)lds;
  const int bid = blockIdx.x, G = gridDim.x;
  (void)a;
  volatile LAS unsigned* bst = (volatile LAS unsigned*)((LAS char*)lds + LDS_BYTES - 16);
  if (threadIdx.x < 4) bst[threadIdx.x] = 0u;
  __syncthreads();
  XcdBarrier xbar; { kargs_t k = KA(); xbar = xcd_barrier_post((unsigned*)k->ws, bst); }

  { kargs_t k = KA(); char* ws = k->ws;
    const int wv0_ = threadIdx.x >> 6;
    if (wv0_ < 4) { const int lane_ = threadIdx.x & 63, wv_ = wv0_, gw_ = bid * 4 + wv_, nw_ = G * 4;
      __attribute__((address_space(3))) float* scr = (__attribute__((address_space(3))) float*)((__attribute__((address_space(3))) char*)lds + wv_ * 8448);
      constexpr int I_IN = 16 * 120, I_C1 = 32 * 8;
      for (int it = gw_; it < I_IN + 2 * I_C1; it += nw_) {
        int r = it;
        if (r < I_IN) { tr_item<1>(k->in[2], 1024, IN_COLS, WSP(bf16_t, WS_WIN), 120, 3840, scr, r, lane_); continue; } r -= I_IN;
        if (r < I_C1) { tr_item<0>(k->in[5], 2048, 256, WSP(bf16_t, WS_CKW1), 8, 256, scr, r, lane_); continue; } r -= I_C1;
        tr_item<0>(k->in[7], 2048, 256, WSP(bf16_t, WS_CVW1), 8, 256, scr, r, lane_);
      }
      for (int i = gw_ * 64 + lane_; i < 16 * 128 * 64; i += nw_ * 64) WSP(bf16_t, WS_SUBK)[i] = f2bf(k->in[18][i]);
      for (int i = gw_ * 64 + lane_; i < SEQ * 16; i += nw_ * 64) rope_entry(WSP(float2, WS_ROPE), i);
    } else ph_rms1024<false>(k->in[0], k->in[1], WSP(bf16_t, WS_XN), T, nullptr, nullptr, bid * 4 + (wv0_ - 4), G * 4); }
  xcd_barrier(xbar);
  { kargs_t k = KA(); char* ws = k->ws;
    pg8::Gemm g{WSP(bf16_t, WS_XN), WSP(bf16_t, WS_WIN), T, 3840, 1024}; pg8::StaticOrder S; S.init(T, 3840, G, bid);
    pg8::EpiInProjF E{WSP(bf16_t, WS_PROJ), WSP(unsigned char, WS_GATES)};
    pg8::gemm_phase<pg8::EpiInProjF, pg8::StaticOrder, PG8_ALIGN, PG8_SP2>(glds, g, S, E);
    {
      const bool some = (G == 256); const int nb = some ? 64 : G, b0 = some ? bid - 192 : bid;
      if (b0 >= 0) {
        const int lane_ = threadIdx.x & 63, wv_ = threadIdx.x >> 6;
        __attribute__((address_space(3))) float* scr = (__attribute__((address_space(3))) float*)((__attribute__((address_space(3))) char*)lds + wv_ * 8448);
        constexpr int I_BR = 8 * 32, I_SQ = 16 * 32, I_C2 = 4 * 8, I_UQ = 4 * 24, I_UKV = 2 * 32;
        for (int it = b0 * NWV + wv_; it < 2 * I_BR + 2 * I_SQ + 2 * I_C2 + I_UQ + I_UKV; it += nb * NWV) {
          int r = it;
          if (r < I_UQ) { tr_item<0>(k->in[11], 256, 768, WSP(bf16_t, WS_UQ), 24, 768, scr, r, lane_); continue; } r -= I_UQ;
          if (r < I_UKV) { tr_item<0>(k->in[12], 128, 1024, WSP(bf16_t, WS_UKV), 32, 1024, scr, r, lane_); continue; } r -= I_UKV;
          if (r < I_C2) { tr_item<0>(k->in[6], 256, 64, WSP(bf16_t, WS_CKW2), 8, 64, scr, r, lane_); continue; } r -= I_C2;
          if (r < I_C2) { tr_item<0>(k->in[8], 256, 64, WSP(bf16_t, WS_CVW2), 8, 64, scr, r, lane_); continue; } r -= I_C2;
          if (r < I_BR) { tr_item<0>(k->in[13], 512, 1024, WSP(bf16_t, WS_WBN), 32, 1024, scr, r, lane_, 1024, 0); continue; } r -= I_BR;
          if (r < I_BR) { tr_item<0>(k->in[14], 512, 1024, WSP(bf16_t, WS_WBN), 32, 1024, scr, r, lane_, 1024, 512); continue; } r -= I_BR;
          if (r < I_SQ) { tr_item<0>(k->in[15], 1024, 1024, WSP(bf16_t, WS_WOUT), 32, 1024, scr, r, lane_); continue; } r -= I_SQ;
          tr_item<0>(k->in[17], 1024, 1024, WSP(bf16_t, WS_WQ), 32, 1024, scr, r, lane_);
        } } } }
  xcd_barrier(xbar);
  { kargs_t k = KA(); char* ws = k->ws;
    const int lane_ = threadIdx.x & 63, wv_ = threadIdx.x >> 6;
    if (G >= 128 && bid < 64) {
      const int tab = bid >> 5;
      pg8::Gemm g{WSP(bf16_t, WS_PROJ) + PC_KV + tab * 128, WSP(bf16_t, tab ? WS_CVW1 : WS_CKW1), 2048, 1024, 512};
      g.pitchA = 16u * PROJ_LD * 2u; g.kstepA = PROJ_LD * 2u; g.hstepA = 128; g.tA_pm = (size_t)SEQ * PROJ_LD * 2; g.tA_pn = (size_t)8 * PROJ_LD * 2;
      g.pitchB = 4096u; g.kstepB = 128u; g.hstepB = (size_t)128 * 4096; g.tB_pn = 1024; g.nt = 8;
      pg8::StaticOrder S; S.init(2048, 1024, 32, bid & 31);
      pg8::EpiSlabF E{WSP(float, WS_SLAB) + (size_t)tab * 4 * 2048 * 256};
      pg8::gemm_phase<pg8::EpiSlabF, pg8::StaticOrder, PG8_ALIGN, PG8_SP2>(glds, g, S, E);
    } else {
      const int nb = (G >= 128) ? G - 64 : G, b0 = (G >= 128) ? bid - 64 : bid;
      prep::cmp_bias(k->in[3], k->in[4], WSP(bf16_t, WS_CKW1), WSP(bf16_t, WS_CVW1), WSP(float, WS_CPOS), b0 * NWV + wv_, nb * NWV, lane_);
      prep::latent_rows(WSP(bf16_t, WS_PROJ), k->in[9], k->in[10], WSP(float2, WS_ROPE), WSP(bf16_t, WS_CQN), WSP(bf16_t, WS_CKVN), WSP(bf16_t, WS_KROPE), b0 * NWV + wv_, nb * NWV, lane_);
    } }
  xcd_barrier(xbar);
  if (G == 256 && ((bid + 64) & 255) >= 192) {
    kargs_t k = KA(); char* ws = k->ws;
    const int lane_ = threadIdx.x & 63, wv_ = threadIdx.x >> 6;
    { const int it = (((bid + 64) & 255) - 192) * 2 + (wv_ >> 2); const int tab = it >> 6;
      prep::cmp_l2_w4(WSP(float, WS_SLAB) + (size_t)tab * 4 * 2048 * 256, WSP(float, WS_CPOS) + tab * 256, WSP(bf16_t, tab ? WS_CVW2 : WS_CKW2), WSP(bf16_t, tab ? WS_VC : WS_KC), it & 63, wv_ & 3, lane_,
                      (__attribute__((address_space(3))) float*)lds + (wv_ >> 2) * 8192); }
    __syncthreads();
  } else if (G != 256) {
    kargs_t k = KA(); char* ws = k->ws;
    const int lane_ = threadIdx.x & 63, wv_ = threadIdx.x >> 6;
    for (int it = bid * NWV + wv_; it < 128; it += G * NWV) { const int tab = it >> 6;
      prep::cmp_l2(WSP(float, WS_SLAB) + (size_t)tab * 4 * 2048 * 256, WSP(float, WS_CPOS) + tab * 256, WSP(bf16_t, tab ? WS_CVW2 : WS_CKW2), WSP(bf16_t, tab ? WS_VC : WS_KC), it & 63, lane_); }
  }
  { kargs_t k = KA(); char* ws = k->ws;
    pg8::Gemm g{WSP(bf16_t, WS_CQN), WSP(bf16_t, WS_UQ), T, 768, 256}; pg8::StaticOrder S; S.init(T, 768, G, (bid + 64) & 255);
    pg8::EpiMlaQF E{WSP(bf16_t, WS_MLAQ), WSP(float2, WS_ROPE)};
    pg8::gemm_phase<pg8::EpiMlaQF, pg8::StaticOrder, PG8_ALIGN, PG8_SP2>(glds, g, S, E); }
  { kargs_t k = KA(); char* ws = k->ws;
    pg8::Gemm g{WSP(bf16_t, WS_CKVN), WSP(bf16_t, WS_UKV), T, 1024, 128}; pg8::StaticOrder S; S.init(T, 1024, G, bid);
    pg8::EpiBf16<0> E{WSP(bf16_t, WS_MLAKV), 1024, nullptr, 0, 0, 1.f};
    pg8::gemm_phase<pg8::EpiBf16<0>, pg8::StaticOrder, PG8_ALIGN, PG8_SP2>(glds, g, S, E); }
  xcd_barrier(xbar);
  { kargs_t k = KA(); char* ws = k->ws;
    att::attn_phase(WSP(bf16_t, WS_PROJ), WSP(bf16_t, WS_KC), WSP(bf16_t, WS_VC), k->in[21], WSP(bf16_t, WS_ONSA),
                    WSP(bf16_t, WS_MLAQ), WSP(bf16_t, WS_MLAKV), WSP(bf16_t, WS_KROPE), WSP(bf16_t, WS_ONSA), (att::lptr)lds); }
  xcd_barrier(xbar);
  { kargs_t k = KA(); char* ws = k->ws;
    pg8::Gemm g{WSP(bf16_t, WS_ONSA), WSP(bf16_t, WS_WBN), T, 1024, 1024}; pg8::StaticOrder S; S.init(T, 1024, G, bid);
    pg8::EpiMergeFusedF E{WSP(unsigned char, WS_GATES), WSP(bf16_t, WS_MERGED)};
    pg8::gemm_phase<pg8::EpiMergeFusedF, pg8::StaticOrder, PG8_ALIGN, PG8_SP2>(glds, g, S, E); }
  xcd_barrier(xbar);
  { kargs_t k = KA(); char* ws = k->ws;
    pg8::Gemm g{WSP(bf16_t, WS_MERGED), WSP(bf16_t, WS_WOUT), T, 1024, 1024}; pg8::StaticOrder S; S.init(T, 1024, G, bid);
    pg8::EpiBf16<0> E{WSP(bf16_t, WS_OB), 1024, nullptr, 0, 0, 1.f};
    pg8::gemm_phase<pg8::EpiBf16<0>, pg8::StaticOrder, PG8_ALIGN, PG8_SP2>(glds, g, S, E); }
  xcd_barrier(xbar);
  { kargs_t k = KA(); char* ws = k->ws; ph_rms1024<true>(k->in[0], k->in[16], WSP(bf16_t, WS_HN), T, WSP(unsigned, WS_HN8), WSP(float, WS_SH), -1, 0, WSP(bf16_t, WS_OB));
    peer::conv_tables(k->in[19], k->in[20], WSP(unsigned, WS_U8), WSP(float, WS_SU), WSP(unsigned, WS_V8)); }
  xcd_barrier(xbar);
  { kargs_t k = KA(); char* ws = k->ws;
    pg8::Gemm g{WSP(bf16_t, WS_HN), WSP(bf16_t, WS_WQ), T, 1024, 1024}; pg8::StaticOrder S; S.init(T, 1024, G, bid);
    pg8::EpiBf16<0> E{WSP(bf16_t, WS_PQ), 1024, nullptr, 0, 0, 1.f};
    pg8::gemm_phase<pg8::EpiBf16<0>, pg8::StaticOrder, PG8_ALIGN, PG8_SP2>(glds, g, S, E); }
  __builtin_amdgcn_fence(__ATOMIC_RELEASE, "workgroup"); __syncthreads(); __builtin_amdgcn_fence(__ATOMIC_ACQUIRE, "workgroup");
  { kargs_t k = KA(); char* ws = k->ws; pg8::StaticOrder S; S.init(T, 1024, G, bid); pg8::Unit u;
#pragma unroll 1
    for (int i = 0; S.next(i, u); ++i) peer::route_phase(WSP(bf16_t, WS_PQ), WSP(bf16_t, WS_SUBK), WSP(unsigned, WS_PIDX), (__attribute__((address_space(3))) char*)lds, u.pm, u.pn); }
  xcd_barrier(xbar);
  { kargs_t k = KA(); char* ws = k->ws;
    peer::experts_sliced<0>(WSP(unsigned, WS_PIDX), WSP(unsigned, WS_HN8), WSP(float, WS_SH), WSP(unsigned, WS_U8), WSP(float, WS_SU), WSP(float, WS_CO), WSP(unsigned, WS_V8), k->out, WSP(float, WS_SSQ),
                            (unsigned*)ws + CTL_QA, (__attribute__((address_space(3))) char*)lds); }
  xcd_barrier(xbar);
  { kargs_t k = KA(); char* ws = k->ws;
    peer::experts_sliced<1>(WSP(unsigned, WS_PIDX), WSP(unsigned, WS_HN8), WSP(float, WS_SH), WSP(unsigned, WS_U8), WSP(float, WS_SU), WSP(float, WS_CO), WSP(unsigned, WS_V8), (float*)WSP(bf16_t, WS_ZB), WSP(float, WS_SSQ),
                            (unsigned*)ws + CTL_QB, (__attribute__((address_space(3))) char*)lds, k->in[0], WSP(bf16_t, WS_OB)); }
  xcd_barrier(xbar);
  { kargs_t k = KA(); char* ws = k->ws; peer::experts_norm(WSP(float, WS_SSQ), k->in[22], WSP(bf16_t, WS_ZB), k->out); }
}

extern "C" void kernel_launch(void* const* d_in, const int* in_sizes, int n_in, void* d_out, int out_size, void* d_ws, size_t ws_size, hipStream_t stream) {
  if (n_in != 23 || ws_size < 256 * MiB) { fprintf(stderr, "kernel_launch: unexpected n_in %d / ws_size %zu\n", n_in, ws_size); return; }
  static int grid_blocks = 0;
  if (!grid_blocks) {
    int dev = 0, cus = 0, per_cu = 0;
    (void)hipGetDevice(&dev);
    (void)hipDeviceGetAttribute(&cus, hipDeviceAttributeMultiprocessorCount, dev);
    if (hipFuncSetAttribute((const void*)mega, hipFuncAttributeMaxDynamicSharedMemorySize, LDS_BYTES) != hipSuccess) fprintf(stderr, "kernel_launch: hipFuncSetAttribute failed\n");
    (void)hipOccupancyMaxActiveBlocksPerMultiprocessor(&per_cu, (const void*)mega, NTHR, LDS_BYTES);
    if (per_cu < 1) { fprintf(stderr, "kernel_launch: occupancy query returned %d\n", per_cu); per_cu = 1; }
    if (per_cu > 2) per_cu = 2;
    grid_blocks = cus * per_cu;
    fprintf(stderr, "kernel_launch: cus %d per_cu %d grid %d ws %zu\n", cus, per_cu, grid_blocks, ws_size);
  }
  if (hipMemsetAsync(d_ws, 0, 65536, stream) != hipSuccess) fprintf(stderr, "kernel_launch: hipMemsetAsync failed\n");
  Args a{};
  for (int i = 0; i < 23; ++i) a.in[i] = (const float*)d_in[i];
  a.out = (float*)d_out; a.ws = (char*)d_ws;
  void* args[] = {&a};
  hipError_t e = hipLaunchCooperativeKernel((const void*)mega, dim3(grid_blocks), dim3(NTHR), args, LDS_BYTES, stream);
  if (e != hipSuccess) fprintf(stderr, "cooperative launch failed: %s (grid %d)\n", hipGetErrorString(e), grid_blocks);
}
```

```cpp
#include <hip/hip_runtime.h>
#include <stdint.h>
#include <cstdio>
#include <hip/hip_cooperative_groups.h>
namespace cg = cooperative_groups;

typedef unsigned short bf16_t;
#define DEV __device__ __forceinline__

constexpr int BATCH = 8, SEQ = 2048, DM = 1024, T = BATCH * SEQ;
constexpr int IN_COLS = 3768;
constexpr int PROJ_LD = 1792;
constexpr int PC_Q = 0, PC_KV = 512, PC_CQ = 1280, PC_CKV = 1536, PC_KR = 1664, PC_GATE = 1696;
constexpr int NC = 127;
constexpr size_t MiB = 1u << 20;

constexpr size_t WS_WIN = 1 * MiB;
constexpr size_t WS_WBN = 9 * MiB;
constexpr size_t WS_WBM = 10 * MiB;
constexpr size_t WS_WOUT = 11 * MiB;
constexpr size_t WS_WQ = 13 * MiB;
constexpr size_t WS_CKW1 = 15 * MiB;
constexpr size_t WS_CVW1 = 16 * MiB;
constexpr size_t WS_CKW2 = 17 * MiB;
constexpr size_t WS_CVW2 = 17 * MiB + 128 * 1024;
constexpr size_t WS_UQ = 17 * MiB + 256 * 1024;
constexpr size_t WS_UKV = 17 * MiB + 768 * 1024;
constexpr size_t WS_SUBK = 18 * MiB;
constexpr size_t WS_ROPE = 18 * MiB + 512 * 1024;
constexpr size_t WS_GATES = 20 * MiB;
constexpr size_t WS_PQ = 20 * MiB;
constexpr size_t WS_ZB = 20 * MiB;
constexpr size_t WS_OB = 52 * MiB;
constexpr size_t WS_PROJ = 84 * MiB;
constexpr size_t WS_MERGED = 84 * MiB;
constexpr size_t WS_PIDX = 84 * MiB;
constexpr size_t WS_U8 = 172 * MiB;
constexpr size_t WS_V8 = 188 * MiB;
constexpr size_t WS_SU = 204 * MiB;
constexpr size_t WS_SH = 204 * MiB + 65536;
constexpr size_t WS_HN8 = 205 * MiB;
constexpr size_t WS_CO = 221 * MiB;
constexpr size_t WS_SSQ = 229 * MiB;
constexpr int CTL_QA = 4096, CTL_QB = 4096 + 512;
constexpr size_t WS_PW = 92 * MiB;
constexpr size_t WS_XN = 140 * MiB;
constexpr size_t WS_MLAKV = 140 * MiB;
constexpr size_t WS_HN = 140 * MiB;
constexpr size_t WS_MLAQ = 172 * MiB;
constexpr size_t WS_KROPE = 196 * MiB;
constexpr size_t WS_KC = 197 * MiB;
constexpr size_t WS_VC = 197 * MiB + 512 * 1024;
constexpr size_t WS_ONSA = 198 * MiB;
constexpr size_t WS_OMLA = 214 * MiB;
constexpr size_t WS_SLAB = 198 * MiB;
constexpr size_t WS_CPOS = 18 * MiB + 768 * 1024;
constexpr size_t WS_CA = 198 * MiB;
constexpr size_t WS_HID = 206 * MiB;
constexpr size_t WS_HID2 = 207 * MiB;
constexpr size_t WS_CA2 = 214 * MiB;
constexpr size_t WS_CQN = 230 * MiB;
constexpr size_t WS_CKVN = 238 * MiB;
constexpr size_t WS_OCMP = 230 * MiB;
constexpr size_t WS_SEL = 246 * MiB;

__device__ const unsigned char T5B[128] = {
  0, 1, 2, 3, 4, 5, 6, 7, 8, 9, 10, 11, 12, 13, 14, 15, 16, 16, 16, 17, 17, 18, 18, 18, 19, 19, 19, 20, 20, 20, 20, 21,
  21, 21, 21, 22, 22, 22, 22, 22, 23, 23, 23, 23, 23, 23, 24, 24, 24, 24, 24, 24, 25, 25, 25, 25, 25, 25, 25, 26, 26, 26, 26, 26,
  26, 26, 26, 27, 27, 27, 27, 27, 27, 27, 27, 27, 27, 28, 28, 28, 28, 28, 28, 28, 28, 28, 28, 29, 29, 29, 29, 29, 29, 29, 29, 29,
  29, 29, 29, 30, 30, 30, 30, 30, 30, 30, 30, 30, 30, 30, 30, 30, 30, 31, 31, 31, 31, 31, 31, 31, 31, 31, 31, 31, 31, 31, 31, 31};

DEV float bf2f(bf16_t v) { return __uint_as_float(((unsigned)v) << 16); }
DEV bf16_t f2bf(float f) { unsigned u = __float_as_uint(f); u += 0x7fffu + ((u >> 16) & 1u); return (bf16_t)(u >> 16); }
template <int CTRL> DEV int dpp_i(int v) { return __builtin_amdgcn_update_dpp(0, v, CTRL, 0xF, 0xF, true); }
template <int CTRL> DEV float dpp_f(float v) { return __uint_as_float((unsigned)__builtin_amdgcn_update_dpp(0, (int)__float_as_uint(v), CTRL, 0xF, 0xF, true)); }
DEV int sum16_i(int v) { v += dpp_i<0xB1>(v); v += dpp_i<0x4E>(v); v += dpp_i<0x141>(v); v += dpp_i<0x140>(v); return v; }
DEV float sum16_f(float v) { v += dpp_f<0xB1>(v); v += dpp_f<0x4E>(v); v += dpp_f<0x141>(v); v += dpp_f<0x140>(v); return v; }
DEV float max16_f(float v) { v = fmaxf(v, dpp_f<0xB1>(v)); v = fmaxf(v, dpp_f<0x4E>(v)); v = fmaxf(v, dpp_f<0x141>(v)); v = fmaxf(v, dpp_f<0x140>(v)); return v; }
DEV float rl_f(float v, int l) { return __uint_as_float((unsigned)__builtin_amdgcn_readlane((int)__float_as_uint(v), l)); }
DEV float wsum(float v) { v = sum16_f(v); return (rl_f(v, 0) + rl_f(v, 16)) + (rl_f(v, 32) + rl_f(v, 48)); }
DEV float wmaxf(float v) { v = max16_f(v); return fmaxf(fmaxf(rl_f(v, 0), rl_f(v, 16)), fmaxf(rl_f(v, 32), rl_f(v, 48))); }
DEV float sigmoidf_(float x) { return 1.0f / (1.0f + expf(-x)); }
DEV float gelu_exact(float x) { return 0.5f * x * (1.0f + erff(x * 0.70710678118654752f)); }
DEV void wave_lds_sync() { asm volatile("s_waitcnt lgkmcnt(0)" ::: "memory"); __builtin_amdgcn_wave_barrier(); asm volatile("" ::: "memory"); }
DEV float t5bias(const float* t5, int head, int dist) { int d = dist < 127 ? dist : 127; d = d < 0 ? 0 : d; return t5[(int)T5B[d] * 8 + head]; }


namespace pg8 {
#define PG8_LAS __attribute__((address_space(3)))
typedef unsigned short bf16_t;
typedef short bf16x8 __attribute__((ext_vector_type(8)));
typedef float f32x4 __attribute__((ext_vector_type(4)));
typedef unsigned u32x4 __attribute__((ext_vector_type(4)));
constexpr int BM = 256, BK = 64, HALF = 128, HTB = HALF * BK * 2  , STAGE_BYTES = 8 * HTB, NXCD = 8, WGM = 8;

__host__ __device__ __forceinline__ int lds_byte(int r, int c) { const int st = (r >> 4) * 2 + (c >> 5), rr = r & 15, cc = c & 31, ob = rr * 64 + cc * 2; return st * 1024 + (ob ^ (((ob >> 9) & 1) << 5)); }
__host__ __device__ __forceinline__ void stage_rc(int b, int& R, int& C) { const int st = b / 1024, sb = b % 1024, swz = sb ^ (((sb >> 9) & 1) << 5); R = (st >> 1) * 16 + swz / 64; C = (st & 1) * 32 + (swz % 64) / 2; }
__host__ __device__ __forceinline__ int perm32(int rho) { const int n = rho >> 4, i = rho & 15; return 8 * (i >> 2) + 4 * n + (i & 3); }

struct Unit { int pm, pn; };
struct Gemm { const bf16_t* A; const bf16_t* Bt; int M, N, K;
    unsigned pitchA = 0, pitchB = 0, kstepA = 0, kstepB = 0; size_t hstepA = 0, hstepB = 0, tA_pm = 0, tA_pn = 0, tB_pn = 0; int nt = 0; };

struct StaticOrder {
    int nM, nN, nwg, G, c;
    __host__ __device__ void init(int M, int N, int G_, int c_) { nM = M / BM; nN = N / BM; nwg = nM * nN; G = G_; c = c_; }
    __host__ __device__ __forceinline__ bool next(int i, Unit& u) const {
        const long L = (long)i * G + c; if (L >= nwg) return false;
        int wgid = (int)L; { const int q = nwg / NXCD, r = nwg % NXCD, xcd = wgid % NXCD, off = wgid / NXCD; wgid = (xcd < r ? xcd * (q + 1) : r * (q + 1) + (xcd - r) * q) + off; }
        const int nig = WGM * nN, gid = wgid / nig, fm = gid * WGM, gsz = (nM - fm) < WGM ? (nM - fm) : WGM;
        u.pm = fm + ((wgid % nig) % gsz); u.pn = (wgid % nig) / gsz; return true;
    }
    __device__ __forceinline__ void a_ready(const Unit&) const {}
    __device__ __forceinline__ void done(const Unit&) const {}
};

__device__ __forceinline__ unsigned cvt_pk_bf16(float lo, float hi) { unsigned r; asm volatile("v_cvt_pk_bf16_f32 %0, %1, %2" : "=v"(r) : "v"(lo), "v"(hi)); return r; }
typedef float f32x2 __attribute__((ext_vector_type(2)));
__device__ __forceinline__ f32x2 gelu_pk(f32x2 v) {
    const f32x2 av = __builtin_elementwise_abs(v), d = av * 0.2316418882f + 1.0f;
    f32x2 t; t.x = __builtin_amdgcn_rcpf(d.x); t.y = __builtin_amdgcn_rcpf(d.y);
    f32x2 q = t * 0.5307027145f + (-0.7265760135f); q = q * t + 0.7107068705f; q = q * t + (-0.142248368f); q = q * t + 0.127414796f; q = q * t;
    const f32x2 s = (v * v) * (-0.72134752044f);
    f32x2 e; e.x = __builtin_amdgcn_exp2f(s.x); e.y = __builtin_amdgcn_exp2f(s.y);
    const f32x2 m = v * (q * e), r = v - m;
    f32x2 o; o.x = v.x < 0.f ? m.x : r.x; o.y = v.y < 0.f ? m.y : r.y; return o;
}

template <int ACT  > struct EpiBf16 {
    static constexpr bool PERM = true, AFTER_DRAIN = false, MIDK = false; static_assert(ACT == 0 || ACT == 1, "EpiBf16: ACT is 0 (none) or 1 (gelu_pk)");
    bf16_t* O; int ldc; const float* bias; int split_cols; size_t split_stride; float scale0;
    __device__ __forceinline__ void operator()(const f32x4 (&acc)[2][2][4][2], const Unit& u, int wr, int wc, int fr, int fq) const {
        const int row0 = u.pm * BM + wr * 64 + fr; int colt = u.pn * BM; bf16_t* base = O;
        float sc = 1.f; if (split_cols) { const int t = colt / split_cols; base += (size_t)t * split_stride; colt -= t * split_cols; if (t == 0) sc = scale0; }
        const int col0 = colt + wc * 32 + 8 * fq, bcol0 = u.pn * BM + wc * 32 + 8 * fq;
        f32x4 bv[2][2];
#pragma unroll
        for (int bj = 0; bj < 2; ++bj)
#pragma unroll
            for (int n = 0; n < 2; ++n) bv[bj][n] = bias ? *(const f32x4*)(bias + bcol0 + bj * HALF + 4 * n) : (f32x4){0.f, 0.f, 0.f, 0.f};
#pragma unroll
        for (int ai = 0; ai < 2; ++ai)
#pragma unroll
            for (int m = 0; m < 4; ++m) { bf16_t* rowp = base + (size_t)(row0 + ai * HALF + m * 16) * ldc + col0;
#pragma unroll
                for (int bj = 0; bj < 2; ++bj) { f32x4 v0 = acc[ai][bj][m][0] + bv[bj][0], v1 = acc[ai][bj][m][1] + bv[bj][1];
                    if (ACT == 1) { f32x2 a = gelu_pk((f32x2){v0[0], v0[1]}), b = gelu_pk((f32x2){v0[2], v0[3]}), c = gelu_pk((f32x2){v1[0], v1[1]}), d = gelu_pk((f32x2){v1[2], v1[3]});
                        v0 = (f32x4){a.x, a.y, b.x, b.y}; v1 = (f32x4){c.x, c.y, d.x, d.y}; }
                    v0 = v0 * sc; v1 = v1 * sc; u32x4 w; w.x = cvt_pk_bf16(v0[0], v0[1]); w.y = cvt_pk_bf16(v0[2], v0[3]); w.z = cvt_pk_bf16(v1[0], v1[1]); w.w = cvt_pk_bf16(v1[2], v1[3]);
                    *(u32x4*)(rowp + bj * HALF) = w; } }
    }
};

struct PanelStats {
    unsigned* xbuf;
    unsigned* cnt;
    unsigned* tmo;
    int ntn; float eps;
    unsigned code;
    __device__ __forceinline__ bool run(const f32x4 (&v)[2][2][4][2], const Unit& u, int wr, int wc, int fr, int fq, PG8_LAS unsigned char* lds, int wid, int lane) const {
        typedef float f32x2v __attribute__((ext_vector_type(2)));
        PG8_LAS f32x2v* P = (PG8_LAS f32x2v*)lds;
        PG8_LAS f32x2v* S = (PG8_LAS f32x2v*)(lds + 8192);
        PG8_LAS unsigned* flag = (PG8_LAS unsigned*)(lds + 8192 + 2048);
#pragma unroll
        for (int ai = 0; ai < 2; ++ai)
#pragma unroll
            for (int m = 0; m < 4; ++m) {
                float s = 0.f;
#pragma unroll
                for (int bj = 0; bj < 2; ++bj)
#pragma unroll
                    for (int n = 0; n < 2; ++n) { const f32x4 x = v[ai][bj][m][n]; s += (x[0] + x[1]) + (x[2] + x[3]); }
                s += __shfl_xor(s, 16); s += __shfl_xor(s, 32);
                const float mw = s * (1.0f / 64.0f); float q = 0.f;
#pragma unroll
                for (int bj = 0; bj < 2; ++bj)
#pragma unroll
                    for (int n = 0; n < 2; ++n) { const f32x4 d = v[ai][bj][m][n] - mw; q += (d[0] * d[0] + d[1] * d[1]) + (d[2] * d[2] + d[3] * d[3]); }
                q += __shfl_xor(q, 16); q += __shfl_xor(q, 32);
                if (fq == 0) P[(ai * HALF + wr * 64 + m * 16 + fr) * 4 + wc] = (f32x2v){mw, q};
            }
        asm volatile("s_waitcnt lgkmcnt(0)" ::: "memory"); __builtin_amdgcn_s_barrier(); asm volatile("" ::: "memory");
#if defined(BROKEN_EXCHANGE_NO_WAIT)
#warning BROKEN CONTROL BUILD: the row-statistics exchange does not wait; results are wrong by design
        if (blockIdx.x >= 64) { const long long t0_ = clock64(); while (clock64() - t0_ < 60000) __builtin_amdgcn_s_sleep(8); }
#endif
        const int row = wid * 32 + (lane & 31);
        if (lane < 32) {
            const f32x2v a = P[row * 4 + 0], b = P[row * 4 + 1], c = P[row * 4 + 2], d = P[row * 4 + 3];
            const float mt = (a.x + b.x + c.x + d.x) * 0.25f;
            const float da = a.x - mt, db = b.x - mt, dc = c.x - mt, dd = d.x - mt;
            const float m2 = (a.y + b.y) + (c.y + d.y) + 64.0f * ((da * da + db * db) + (dc * dc + dd * dd));
            unsigned long long* slot = (unsigned long long*)xbuf + ((size_t)(u.pm * BM + row) * 4 + u.pn);
            __hip_atomic_store(slot, ((unsigned long long)__float_as_uint(m2) << 32) | __float_as_uint(mt), __ATOMIC_RELAXED, __HIP_MEMORY_SCOPE_AGENT);
        }
        asm volatile("s_waitcnt vmcnt(0)" ::: "memory");
        if (lane == 0) __hip_atomic_fetch_add(cnt + 64 * u.pm, 1u, __ATOMIC_RELAXED, __HIP_MEMORY_SCOPE_AGENT);
        if (wid == 0) {
            bool dead = false; const unsigned long long t0 = __builtin_amdgcn_s_memrealtime(); const unsigned want = 8u * (unsigned)ntn;
            for (;;) {
#if defined(BROKEN_EXCHANGE_NO_WAIT)
                break;
#endif
                if ((unsigned)__builtin_amdgcn_readfirstlane(__hip_atomic_load(cnt + 64 * u.pm, __ATOMIC_RELAXED, __HIP_MEMORY_SCOPE_AGENT)) >= want) break;
                if (__builtin_amdgcn_s_memrealtime() - t0 > 2000000ull) {
                    if (lane == 0) { unsigned expect = 0u; __hip_atomic_compare_exchange_strong(tmo + 1, &expect, code | (unsigned)(u.pm & 0xff), __ATOMIC_RELAXED, __ATOMIC_RELAXED, __HIP_MEMORY_SCOPE_AGENT);
                                     __hip_atomic_store(tmo, 1u, __ATOMIC_RELAXED, __HIP_MEMORY_SCOPE_AGENT); }
                    dead = true; break; }
                __builtin_amdgcn_s_sleep(2);
            }
            __builtin_amdgcn_fence(__ATOMIC_ACQUIRE, "agent");
            if (lane == 0) flag[0] = dead ? 1u : 0u;
        }
        asm volatile("s_waitcnt vmcnt(0) lgkmcnt(0)" ::: "memory"); __builtin_amdgcn_s_barrier(); asm volatile("" ::: "memory");
        const bool bad = flag[0] != 0u;
        if (lane < 32) {
            const unsigned long long* slot = (const unsigned long long*)xbuf + (size_t)(u.pm * BM + row) * 4; float mt[4], m2[4]; float ms = 0.f;
#pragma unroll
            for (int t = 0; t < 4; ++t) { if (t < ntn) { const unsigned long long w = __hip_atomic_load(slot + t, __ATOMIC_RELAXED, __HIP_MEMORY_SCOPE_AGENT); mt[t] = __uint_as_float((unsigned)w); m2[t] = __uint_as_float((unsigned)(w >> 32)); } else { mt[t] = 0.f; m2[t] = 0.f; } ms += mt[t]; }
            const float mean = ms / (float)ntn; float q = 0.f;
#pragma unroll
            for (int t = 0; t < 4; ++t) if (t < ntn) { const float dm = mt[t] - mean; q += m2[t] + 256.0f * dm * dm; }
            S[row] = (f32x2v){mean, 1.0f / sqrtf(q / (256.0f * (float)ntn) + eps)};
        }
        asm volatile("s_waitcnt lgkmcnt(0)" ::: "memory"); __builtin_amdgcn_s_barrier(); asm volatile("" ::: "memory");
        return bad;
    }
};
struct EpiLnRes {
    static constexpr bool PERM = false, AFTER_DRAIN = true, MIDK = false;
    const float* base; float* out; int ldc; const float* bias; PanelStats st; unsigned poison;
    __device__ __forceinline__ void fused(f32x4 (&acc)[2][2][4][2], const Unit& u, int wr, int wc, int fr, int fq, PG8_LAS unsigned char* lds, int wid, int lane) const {
        typedef float f32x2v __attribute__((ext_vector_type(2)));
        const PG8_LAS f32x2v* S = (const PG8_LAS f32x2v*)(lds + 8192);
        const int col0 = u.pn * BM + wc * 32 + 4 * fq;
#pragma unroll
        for (int bj = 0; bj < 2; ++bj)
#pragma unroll
            for (int n = 0; n < 2; ++n) { const f32x4 bv = bias ? *(const f32x4*)(bias + col0 + bj * HALF + n * 16) : (f32x4){0.f, 0.f, 0.f, 0.f};
#pragma unroll
                for (int ai = 0; ai < 2; ++ai)
#pragma unroll
                    for (int m = 0; m < 4; ++m) acc[ai][bj][m][n] += bv; }
        f32x4 pre[4][2][2];
#pragma unroll
        for (int m = 0; m < 4; ++m) { const size_t off = (size_t)(u.pm * BM + wr * 64 + m * 16 + fr) * ldc + col0;
#pragma unroll
            for (int bj = 0; bj < 2; ++bj)
#pragma unroll
                for (int n = 0; n < 2; ++n) pre[m][bj][n] = *(const f32x4*)(base + off + bj * HALF + n * 16); }
        const bool bad = st.run(acc, u, wr, wc, fr, fq, lds, wid, lane) || poison != 0u;
        const float qnan = __builtin_nanf("");
#pragma unroll
        for (int ai = 0; ai < 2; ++ai)
#pragma unroll
            for (int m = 0; m < 4; ++m) { const int r = ai * HALF + wr * 64 + m * 16 + fr; const f32x2v sr = S[r]; const size_t off = (size_t)(u.pm * BM + r) * ldc + col0;
#pragma unroll
                for (int bj = 0; bj < 2; ++bj)
#pragma unroll
                    for (int n = 0; n < 2; ++n) { const f32x4 bs = ai == 0 ? pre[m][bj][n] : *(const f32x4*)(base + off + bj * HALF + n * 16); f32x4 o = bs + (acc[ai][bj][m][n] - sr.x) * sr.y;
                        if (bad) o = (f32x4){qnan, qnan, qnan, qnan}; *(f32x4*)(out + off + bj * HALF + n * 16) = o; }
                if (m & 1) asm volatile("" ::: "memory"); }
    }
};
struct EpiLnResLn {
    static constexpr bool PERM = false, AFTER_DRAIN = true, MIDK = false;
    const float* base; float* out; bf16_t* xn; int ldc; const float* bias; PanelStats st1, st2; unsigned poison;
    __device__ __forceinline__ void fused(f32x4 (&acc)[2][2][4][2], const Unit& u, int wr, int wc, int fr, int fq, PG8_LAS unsigned char* lds, int wid, int lane) const {
        typedef float f32x2v __attribute__((ext_vector_type(2))); typedef unsigned u32x2v __attribute__((ext_vector_type(2)));
        const PG8_LAS f32x2v* S = (const PG8_LAS f32x2v*)(lds + 8192);
        const int col0 = u.pn * BM + wc * 32 + 4 * fq;
#pragma unroll
        for (int bj = 0; bj < 2; ++bj)
#pragma unroll
            for (int n = 0; n < 2; ++n) { const f32x4 bv = bias ? *(const f32x4*)(bias + col0 + bj * HALF + n * 16) : (f32x4){0.f, 0.f, 0.f, 0.f};
#pragma unroll
                for (int ai = 0; ai < 2; ++ai)
#pragma unroll
                    for (int m = 0; m < 4; ++m) acc[ai][bj][m][n] += bv; }
        bool bad = st1.run(acc, u, wr, wc, fr, fq, lds, wid, lane) || poison != 0u;
        const float qnan = __builtin_nanf("");
#pragma unroll
        for (int ai = 0; ai < 2; ++ai)
#pragma unroll
            for (int m = 0; m < 4; ++m) { const int r = ai * HALF + wr * 64 + m * 16 + fr; const f32x2v sr = S[r]; const size_t off = (size_t)(u.pm * BM + r) * ldc + col0;
#pragma unroll
                for (int bj = 0; bj < 2; ++bj)
#pragma unroll
                    for (int n = 0; n < 2; ++n) { const f32x4 bs = *(const f32x4*)(base + off + bj * HALF + n * 16); acc[ai][bj][m][n] = bs + (acc[ai][bj][m][n] - sr.x) * sr.y; }
                asm volatile("" : "+v"(acc[ai][0][m][0]), "+v"(acc[ai][0][m][1]), "+v"(acc[ai][1][m][0]), "+v"(acc[ai][1][m][1]));
                if (m & 1) asm volatile("" ::: "memory"); }
        const bool bad1 = bad;
        bad = st2.run(acc, u, wr, wc, fr, fq, lds, wid, lane) || bad;
#pragma unroll
        for (int ai = 0; ai < 2; ++ai)
#pragma unroll
            for (int m = 0; m < 4; ++m) { const int r = ai * HALF + wr * 64 + m * 16 + fr; const f32x2v sr = S[r]; const size_t off = (size_t)(u.pm * BM + r) * ldc + col0;
#pragma unroll
                for (int bj = 0; bj < 2; ++bj)
#pragma unroll
                    for (int n = 0; n < 2; ++n) { const f32x4 x1 = acc[ai][bj][m][n]; *(f32x4*)(out + off + bj * HALF + n * 16) = bad1 ? (f32x4){qnan, qnan, qnan, qnan} : x1;
                        const f32x4 o = (x1 - sr.x) * sr.y; u32x2v w; w.x = cvt_pk_bf16(o[0], o[1]); w.y = cvt_pk_bf16(o[2], o[3]);
                        if (bad) { w.x = 0x7fc07fc0u; w.y = 0x7fc07fc0u; } *(u32x2v*)(xn + off + bj * HALF + n * 16) = w; }
                asm volatile("" ::: "memory"); }
    }
};

template <class Epi, class Sched, bool ALIGN_EPI = false, bool SP2 = false>
__device__ __forceinline__ void gemm_phase(PG8_LAS unsigned char* lds, const Gemm g, const Sched& S, const Epi& E) {
    int tid = threadIdx.x; asm volatile("" : "+v"(tid));
    const int wid = __builtin_amdgcn_readfirstlane(tid >> 6), lane = tid & 63, wr = wid >> 2, wc = wid & 3, fr = lane & 15, fq = lane >> 4;
    int K = g.K; asm volatile("" : "+s"(K)); const int nt = g.nt ? g.nt : K / BK;
    const unsigned pitchA = g.pitchA ? g.pitchA : (unsigned)K * 2u, pitchB = g.pitchB ? g.pitchB : (unsigned)K * 2u;
    unsigned voffA[2], voffB[2];
#pragma unroll
    for (int i = 0; i < 2; ++i) { int R, C; stage_rc(tid * 16 + i * 8192, R, C); const int Rb = Epi::PERM ? ((R & ~31) + perm32(R & 31)) : R;
        voffA[i] = (unsigned)R * pitchA + (unsigned)C * 2u; voffB[i] = (unsigned)Rb * pitchB + (unsigned)C * 2u; }
    const size_t kstepA = g.kstepA ? g.kstepA : (size_t)(BK * 2), kstepB = g.kstepB ? g.kstepB : (size_t)(BK * 2);
    const size_t hstepA = g.hstepA ? g.hstepA : (size_t)HALF * K * 2, hstepB = g.hstepB ? g.hstepB : (size_t)HALF * K * 2;
    const size_t tA_pm = g.tA_pm ? g.tA_pm : (size_t)BM * K * 2, tA_pn = g.tA_pn, tB_pn = g.tB_pn ? g.tB_pn : (size_t)BM * K * 2;
    const unsigned ldsw = (unsigned)wid * 1024u;
    const int aoff = lds_byte(wr * 64 + fr, fq * 8), boff = lds_byte(wc * 32 + fr, fq * 8);
#define PG8_SA(b, h) (((b) * 2 + (h)) * HTB)
#define PG8_SB(b, h) ((4 + (b) * 2 + (h)) * HTB)
#define PG8_STAGE(bufoff, gbase, voff) do { _Pragma("unroll") for (int _i = 0; _i < 2; ++_i) \
        __builtin_amdgcn_global_load_lds((const unsigned*)((const char*)(gbase) + (voff)[_i]), (PG8_LAS unsigned*)(lds + (bufoff) + ldsw + _i * 8192), 16, 0, 0); } while (0)
#define PG8_LDA(dst, b, h) do { _Pragma("unroll") for (int m = 0; m < 4; ++m) _Pragma("unroll") for (int k = 0; k < 2; ++k) dst[m][k] = *(const PG8_LAS bf16x8*)(lds + PG8_SA(b, h) + aoff + m * 2048 + k * 1024); } while (0)
#define PG8_LDB(dst, b, h) do { _Pragma("unroll") for (int n = 0; n < 2; ++n) _Pragma("unroll") for (int k = 0; k < 2; ++k) dst[n][k] = *(const PG8_LAS bf16x8*)(lds + PG8_SB(b, h) + boff + n * 2048 + k * 1024); } while (0)
#define PG8_MMA(ai, bj, At, Bt) do { __builtin_amdgcn_s_setprio(1); _Pragma("unroll") for (int m = 0; m < 4; ++m) _Pragma("unroll") for (int n = 0; n < 2; ++n) _Pragma("unroll") for (int k = 0; k < 2; ++k) \
        acc[ai][bj][m][n] = __builtin_amdgcn_mfma_f32_16x16x32_bf16(Bt[n][k], At[m][k], acc[ai][bj][m][n], 0, 0, 0); __builtin_amdgcn_s_setprio(0); } while (0)
#define PG8_WAIT_V(n) asm volatile("s_waitcnt vmcnt(" #n ")" ::: "memory")
#define PG8_WAIT_L(n) asm volatile("s_waitcnt lgkmcnt(" #n ")" ::: "memory")
#define PG8_BAR __builtin_amdgcn_s_barrier()
#define PG8_SCHED __builtin_amdgcn_sched_barrier(0)
    Unit cur, nxt; int ui = 0;
    if (!S.next(0, cur)) return;
    f32x4 acc[2][2][4][2];
#pragma unroll
    for (int a = 0; a < 2; ++a)
#pragma unroll
        for (int b = 0; b < 2; ++b)
#pragma unroll
            for (int m = 0; m < 4; ++m)
#pragma unroll
                for (int n = 0; n < 2; ++n) acc[a][b][m][n] = (f32x4){0.f, 0.f, 0.f, 0.f};
    bf16x8 At[4][2], B0[2][2], B1[2][2];
    const char* cA = (const char*)g.A + (size_t)cur.pm * tA_pm + (size_t)cur.pn * tA_pn; const char* cB = (const char*)g.Bt + (size_t)cur.pn * tB_pn;
    S.a_ready(cur);
    if constexpr (SP2) {
        PG8_STAGE(PG8_SB(0, 0), cB, voffB); PG8_STAGE(PG8_SB(0, 1), cB + hstepB, voffB); PG8_STAGE(PG8_SA(0, 0), cA, voffA); PG8_STAGE(PG8_SA(0, 1), cA + hstepA, voffA);
        if (wr == 1) PG8_BAR;
        PG8_WAIT_V(2); PG8_BAR;
        PG8_STAGE(PG8_SB(1, 0), cB + kstepB, voffB); PG8_STAGE(PG8_SA(1, 0), cA + kstepA, voffA); PG8_STAGE(PG8_SB(1, 1), cB + hstepB + kstepB, voffB);
        PG8_WAIT_V(6); PG8_BAR;
    } else {
        PG8_STAGE(PG8_SB(0, 0), cB, voffB); PG8_STAGE(PG8_SA(0, 0), cA, voffA); PG8_STAGE(PG8_SB(0, 1), cB + hstepB, voffB); PG8_STAGE(PG8_SA(0, 1), cA + hstepA, voffA);
        if (wr == 1) PG8_BAR;
        PG8_WAIT_V(4); PG8_BAR;
        PG8_STAGE(PG8_SB(1, 0), cB + kstepB, voffB); PG8_STAGE(PG8_SA(1, 0), cA + kstepA, voffA); PG8_STAGE(PG8_SB(1, 1), cB + hstepB + kstepB, voffB);
        PG8_WAIT_V(6); PG8_BAR;
    }
    for (;;) {
        const bool has_next = S.next(ui + 1, nxt);
        const char* nA = has_next ? (const char*)g.A + (size_t)nxt.pm * tA_pm + (size_t)nxt.pn * tA_pn : cA; const char* nB = has_next ? (const char*)g.Bt + (size_t)nxt.pn * tB_pn : cB;
        for (int t = 0; t < nt; t += 2) {
            if constexpr (Epi::MIDK) { if (t == (nt >> 1)) E.midk(acc, cur, wr, wc, fr, fq); }
            const bool last = (t == nt - 2);
            const char* a1 = cA + (size_t)(t + 1) * kstepA;
            const char* a2 = last ? nA : cA + (size_t)(t + 2) * kstepA; const char* b2 = last ? nB : cB + (size_t)(t + 2) * kstepB;
            const char* a3 = a2 + kstepA; const char* b3 = b2 + kstepB;
            if (last && has_next) S.a_ready(nxt);
            if constexpr (SP2) {
            PG8_LDB(B0, 0, 0); PG8_LDB(B1, 0, 1); PG8_SCHED; PG8_LDA(At, 0, 0); PG8_STAGE(PG8_SA(1, 1), a1 + hstepA, voffA);
            PG8_WAIT_V(8); PG8_WAIT_L(0); PG8_BAR; PG8_MMA(0, 0, At, B0); PG8_MMA(0, 1, At, B1); PG8_BAR; PG8_SCHED;
            PG8_LDA(At, 0, 1); PG8_STAGE(PG8_SB(0, 0), b2, voffB); PG8_STAGE(PG8_SB(0, 1), b2 + hstepB, voffB); PG8_STAGE(PG8_SA(0, 0), a2, voffA);
            PG8_WAIT_V(8); PG8_WAIT_L(0); PG8_BAR; PG8_MMA(1, 0, At, B0); PG8_MMA(1, 1, At, B1); PG8_BAR; PG8_SCHED;
            PG8_LDB(B0, 1, 0); PG8_LDB(B1, 1, 1); PG8_SCHED; PG8_LDA(At, 1, 0); PG8_STAGE(PG8_SA(0, 1), a2 + hstepA, voffA);
            PG8_WAIT_V(8); PG8_WAIT_L(0); PG8_BAR; PG8_MMA(0, 0, At, B0); PG8_MMA(0, 1, At, B1); PG8_BAR; PG8_SCHED;
            PG8_LDA(At, 1, 1); PG8_STAGE(PG8_SB(1, 0), b3, voffB); PG8_STAGE(PG8_SB(1, 1), b3 + hstepB, voffB); PG8_STAGE(PG8_SA(1, 0), a3, voffA);
            PG8_WAIT_V(8); PG8_WAIT_L(0); PG8_BAR; PG8_MMA(1, 0, At, B0); PG8_MMA(1, 1, At, B1); PG8_BAR; PG8_SCHED;
            } else {
            PG8_LDB(B0, 0, 0); PG8_SCHED; PG8_LDA(At, 0, 0); PG8_STAGE(PG8_SA(1, 1), a1 + hstepA, voffA);
            PG8_WAIT_L(8); PG8_BAR; PG8_WAIT_L(0); PG8_MMA(0, 0, At, B0); PG8_BAR; PG8_SCHED;
            PG8_LDB(B1, 0, 1); PG8_STAGE(PG8_SB(0, 0), b2, voffB);
            PG8_BAR; PG8_WAIT_L(0); PG8_MMA(0, 1, At, B1); PG8_BAR;
            PG8_LDA(At, 0, 1); PG8_STAGE(PG8_SA(0, 0), a2, voffA);
            PG8_BAR; PG8_WAIT_L(0); PG8_MMA(1, 0, At, B0); PG8_BAR; PG8_SCHED;
            PG8_STAGE(PG8_SB(0, 1), b2 + hstepB, voffB);
            PG8_WAIT_V(6); PG8_BAR; PG8_MMA(1, 1, At, B1); PG8_BAR;
            PG8_LDB(B0, 1, 0); PG8_SCHED; PG8_LDA(At, 1, 0); PG8_STAGE(PG8_SA(0, 1), a2 + hstepA, voffA);
            PG8_WAIT_L(8); PG8_BAR; PG8_WAIT_L(0); PG8_MMA(0, 0, At, B0); PG8_BAR; PG8_SCHED;
            PG8_LDB(B1, 1, 1); PG8_STAGE(PG8_SB(1, 0), b3, voffB);
            PG8_BAR; PG8_WAIT_L(0); PG8_MMA(0, 1, At, B1); PG8_BAR;
            PG8_LDA(At, 1, 1); PG8_STAGE(PG8_SA(1, 0), a3, voffA);
            PG8_BAR; PG8_WAIT_L(0); PG8_MMA(1, 0, At, B0); PG8_BAR; PG8_SCHED;
            PG8_STAGE(PG8_SB(1, 1), b3 + hstepB, voffB);
            PG8_WAIT_V(6); PG8_BAR; PG8_MMA(1, 1, At, B1); PG8_BAR;
            }
        }
        if constexpr (ALIGN_EPI) { if (wr == 0) PG8_BAR; }
        if constexpr (!Epi::AFTER_DRAIN) { E(acc, cur, wr, wc, fr, fq); S.done(cur); }
        if (!has_next) break;
#pragma unroll
        for (int a = 0; a < 2; ++a)
#pragma unroll
            for (int b = 0; b < 2; ++b)
#pragma unroll
                for (int m = 0; m < 4; ++m)
#pragma unroll
                    for (int n = 0; n < 2; ++n) acc[a][b][m][n] = (f32x4){0.f, 0.f, 0.f, 0.f};
        cur = nxt; cA = nA; cB = nB; ++ui;
        if constexpr (ALIGN_EPI) { if (wr == 1) PG8_BAR; }
    }
    PG8_WAIT_V(0);
    if constexpr (!ALIGN_EPI) { if (wr == 0) PG8_BAR; }
    PG8_BAR;
    if constexpr (Epi::AFTER_DRAIN) { E.fused(acc, cur, wr, wc, fr, fq, lds, wid, lane); S.done(cur); }
#undef PG8_SA
#undef PG8_SB
#undef PG8_STAGE
#undef PG8_LDA
#undef PG8_LDB
#undef PG8_MMA
#undef PG8_WAIT_V
#undef PG8_WAIT_L
#undef PG8_BAR
#undef PG8_SCHED
}
}

namespace pg8 {
constexpr float LOG2E = 1.4426950408889634f;
constexpr float QS_NSA = 0.125f * LOG2E;
constexpr float QS_MLA = 0.10206207261596575f * LOG2E;
__device__ __forceinline__ float fast_sigmoid(float x) { return __builtin_amdgcn_rcpf(1.0f + __builtin_amdgcn_exp2f(-LOG2E * x)); }
__device__ __forceinline__ float lo_bf(unsigned u) { return __uint_as_float(u << 16); }
__device__ __forceinline__ float hi_bf(unsigned u) { return __uint_as_float(u & 0xffff0000u); }
struct EpiInProjF {
    static constexpr bool PERM = true, AFTER_DRAIN = false, MIDK = false;
    bf16_t* proj; unsigned char* gates;
    __device__ __forceinline__ void operator()(const f32x4 (&acc)[2][2][4][2], const Unit& u, int wr, int wc, int fr, int fq) const {
        const bool isg = u.pn >= 7;
        bf16_t* base = proj; const int ld = 1792; const int colt = isg ? (u.pn - 7) * BM : u.pn * BM;
        const float sc = (u.pn < 2) ? QS_NSA : 1.0f;
        const int row0 = u.pm * BM + wr * 64 + fr, col0 = colt + wc * 32 + 8 * fq;
#pragma unroll
        for (int ai = 0; ai < 2; ++ai)
#pragma unroll
            for (int m = 0; m < 4; ++m) { bf16_t* rowp = base + (size_t)(row0 + ai * HALF + m * 16) * ld + col0;
#pragma unroll
                for (int bj = 0; bj < 2; ++bj) { f32x4 v0 = acc[ai][bj][m][0], v1 = acc[ai][bj][m][1];
                    if (isg) {
                        unsigned q[8];
#pragma unroll
                        for (int e = 0; e < 4; ++e) { q[e] = (unsigned)(fast_sigmoid(v0[e]) * 255.0f + 0.5f); q[4 + e] = (unsigned)(fast_sigmoid(v1[e]) * 255.0f + 0.5f); }
                        uint2 w; w.x = q[0] | (q[1] << 8) | (q[2] << 16) | (q[3] << 24); w.y = q[4] | (q[5] << 8) | (q[6] << 16) | (q[7] << 24);
                        *(uint2*)(gates + (size_t)(row0 + ai * HALF + m * 16) * 2048 + col0 + bj * HALF) = w;
                    } else { v0 = v0 * sc; v1 = v1 * sc;
                        u32x4 w; w.x = cvt_pk_bf16(v0[0], v0[1]); w.y = cvt_pk_bf16(v0[2], v0[3]); w.z = cvt_pk_bf16(v1[0], v1[1]); w.w = cvt_pk_bf16(v1[2], v1[3]);
                        *(u32x4*)(rowp + bj * HALF) = w; } } }
    }
};
template <int PASS> struct EpiMergeF {
    static constexpr bool PERM = true, AFTER_DRAIN = false, MIDK = false;
    const unsigned char* gates; bf16_t* merged;
    __device__ __forceinline__ void operator()(const f32x4 (&acc)[2][2][4][2], const Unit& u, int wr, int wc, int fr, int fq) const {
        const int row0 = u.pm * BM + wr * 64 + fr, col0 = u.pn * BM + wc * 32 + 8 * fq;
#pragma unroll
        for (int ai = 0; ai < 2; ++ai)
#pragma unroll
            for (int m = 0; m < 4; ++m) { const size_t r = (size_t)(row0 + ai * HALF + m * 16);
#pragma unroll
                for (int bj = 0; bj < 2; ++bj) { const int c = col0 + bj * HALF;
                    const uint2 g = *(const uint2*)(gates + r * 2048 + PASS * 1024 + c);
                    f32x4 v0 = acc[ai][bj][m][0] * (1.0f / 255.0f), v1 = acc[ai][bj][m][1] * (1.0f / 255.0f);
                    v0[0] *= (float)(g.x & 255u); v0[1] *= (float)((g.x >> 8) & 255u); v0[2] *= (float)((g.x >> 16) & 255u); v0[3] *= (float)(g.x >> 24);
                    v1[0] *= (float)(g.y & 255u); v1[1] *= (float)((g.y >> 8) & 255u); v1[2] *= (float)((g.y >> 16) & 255u); v1[3] *= (float)(g.y >> 24);
                    if (PASS == 1) { const u32x4 o = *(const u32x4*)(merged + r * 1024 + c);
                        v0[0] += lo_bf(o.x); v0[1] += hi_bf(o.x); v0[2] += lo_bf(o.y); v0[3] += hi_bf(o.y);
                        v1[0] += lo_bf(o.z); v1[1] += hi_bf(o.z); v1[2] += lo_bf(o.w); v1[3] += hi_bf(o.w); }
                    u32x4 w; w.x = cvt_pk_bf16(v0[0], v0[1]); w.y = cvt_pk_bf16(v0[2], v0[3]); w.z = cvt_pk_bf16(v1[0], v1[1]); w.w = cvt_pk_bf16(v1[2], v1[3]);
                    *(u32x4*)(merged + r * 1024 + c) = w; } }
    }
};
struct EpiMergeFusedF {
    static constexpr bool PERM = true, AFTER_DRAIN = false, MIDK = true;
    const unsigned char* gates; bf16_t* merged;
    __device__ __forceinline__ void midk(f32x4 (&acc)[2][2][4][2], const Unit& u, int wr, int wc, int fr, int fq) const {
        asm volatile("" : "+v"(fr), "+v"(fq));
        const int row0 = u.pm * BM + wr * 64 + fr, col0 = u.pn * BM + wc * 32 + 8 * fq;
#pragma unroll
        for (int ai = 0; ai < 2; ++ai)
#pragma unroll
            for (int m = 0; m < 4; ++m) { const size_t r = (size_t)(row0 + ai * HALF + m * 16);
#pragma unroll
                for (int bj = 0; bj < 2; ++bj) { const int c = col0 + bj * HALF;
                    const uint2 g0 = *(const uint2*)(gates + r * 2048 + c), g1 = *(const uint2*)(gates + r * 2048 + 1024 + c);
#pragma unroll
                    for (int e = 0; e < 4; ++e) {
                        const float a0 = (float)((g0.x >> (8 * e)) & 255u), b0 = fmaxf((float)((g1.x >> (8 * e)) & 255u), 1.0f);
                        const float a1 = (float)((g0.y >> (8 * e)) & 255u), b1 = fmaxf((float)((g1.y >> (8 * e)) & 255u), 1.0f);
                        acc[ai][bj][m][0][e] *= a0 * __builtin_amdgcn_rcpf(b0); acc[ai][bj][m][1][e] *= a1 * __builtin_amdgcn_rcpf(b1); }
                    asm volatile("" ::: "memory"); } }
    }
    __device__ __forceinline__ void operator()(const f32x4 (&acc)[2][2][4][2], const Unit& u, int wr, int wc, int fr, int fq) const {
        const int row0 = u.pm * BM + wr * 64 + fr, col0 = u.pn * BM + wc * 32 + 8 * fq;
#pragma unroll
        for (int ai = 0; ai < 2; ++ai)
#pragma unroll
            for (int m = 0; m < 4; ++m) { const size_t r = (size_t)(row0 + ai * HALF + m * 16);
#pragma unroll
                for (int bj = 0; bj < 2; ++bj) { const int c = col0 + bj * HALF;
                    const uint2 g1 = *(const uint2*)(gates + r * 2048 + 1024 + c);
                    f32x4 v0 = acc[ai][bj][m][0] * (1.0f / 255.0f), v1 = acc[ai][bj][m][1] * (1.0f / 255.0f);
#pragma unroll
                    for (int e = 0; e < 4; ++e) { v0[e] *= fmaxf((float)((g1.x >> (8 * e)) & 255u), 1.0f); v1[e] *= fmaxf((float)((g1.y >> (8 * e)) & 255u), 1.0f); }
                    u32x4 w; w.x = cvt_pk_bf16(v0[0], v0[1]); w.y = cvt_pk_bf16(v0[2], v0[3]); w.z = cvt_pk_bf16(v1[0], v1[1]); w.w = cvt_pk_bf16(v1[2], v1[3]);
                    *(u32x4*)(merged + r * 1024 + c) = w; } }
    }
};
struct EpiCmpOutF {
    static constexpr bool PERM = true, AFTER_DRAIN = false, MIDK = false;
    bf16_t* dst;
    __device__ __forceinline__ void operator()(const f32x4 (&acc)[2][2][4][2], const Unit& u, int wr, int wc, int fr, int fq) const {
        if (wc >= 2) return;
        const int row0 = u.pm * BM + wr * 64 + fr, col0 = wc * 32 + 8 * fq;
#pragma unroll
        for (int ai = 0; ai < 2; ++ai)
#pragma unroll
            for (int m = 0; m < 4; ++m) { const int r = row0 + ai * HALF + m * 16;
                if (r < BATCH * NC * 2) { const int g = r & 1, bc = r >> 1, b = bc / NC, c = bc % NC;
                    const f32x4 v0 = acc[ai][0][m][0], v1 = acc[ai][0][m][1];
                    u32x4 w; w.x = cvt_pk_bf16(v0[0], v0[1]); w.y = cvt_pk_bf16(v0[2], v0[3]); w.z = cvt_pk_bf16(v1[0], v1[1]); w.w = cvt_pk_bf16(v1[2], v1[3]);
                    *(u32x4*)(dst + ((size_t)(b * 2 + g) * 128 + c) * 64 + col0) = w; } }
    }
};
struct EpiSlabF {
    static constexpr bool PERM = false, AFTER_DRAIN = false, MIDK = false;
    float* slab;
    __device__ __forceinline__ void operator()(const f32x4 (&acc)[2][2][4][2], const Unit& u, int wr, int wc, int fr, int fq) const {
        const int row0 = u.pm * BM + wr * 64 + fr, col0 = wc * 32 + 4 * fq;
        float* base = slab + (size_t)u.pn * 2048 * 256;
#pragma unroll
        for (int ai = 0; ai < 2; ++ai)
#pragma unroll
            for (int m = 0; m < 4; ++m) { float* rowp = base + (size_t)(row0 + ai * HALF + m * 16) * 256 + col0;
#pragma unroll
                for (int bj = 0; bj < 2; ++bj)
#pragma unroll
                    for (int n = 0; n < 2; ++n) *(f32x4*)(rowp + bj * HALF + n * 16) = acc[ai][bj][m][n]; }
    }
};
struct EpiResidF {
    static constexpr bool PERM = false, AFTER_DRAIN = false, MIDK = false;
    const float* x; float* h;
    __device__ __forceinline__ void operator()(const f32x4 (&acc)[2][2][4][2], const Unit& u, int wr, int wc, int fr, int fq) const {
        const int row0 = u.pm * BM + wr * 64 + fr, col0 = u.pn * BM + wc * 32 + 4 * fq;
#pragma unroll
        for (int ai = 0; ai < 2; ++ai)
#pragma unroll
            for (int m = 0; m < 4; ++m) { const size_t off = (size_t)(row0 + ai * HALF + m * 16) * 1024 + col0;
#pragma unroll
                for (int bj = 0; bj < 2; ++bj)
#pragma unroll
                    for (int n = 0; n < 2; ++n) { const f32x4 xv = *(const f32x4*)(x + off + bj * HALF + n * 16); *(f32x4*)(h + off + bj * HALF + n * 16) = xv + acc[ai][bj][m][n]; } }
    }
};
struct EpiMlaQF {
    static constexpr bool PERM = false, AFTER_DRAIN = false, MIDK = false;
    bf16_t* q; const float2* cs;
    __device__ __forceinline__ void operator()(const f32x4 (&acc)[2][2][4][2], const Unit& u, int wr, int wc, int fr, int fq) const {
        const int row0 = u.pm * BM + wr * 64 + fr;
#pragma unroll
        for (int bj = 0; bj < 2; ++bj) {
            const int X = u.pn * BM + bj * HALF + wc * 32;
            const bool rope = (X % 96) == 64;
#pragma unroll
            for (int ai = 0; ai < 2; ++ai)
#pragma unroll
                for (int m = 0; m < 4; ++m) { const int r = row0 + ai * HALF + m * 16; const int pos = r & (SEQ - 1);
                    f32x4 v0 = acc[ai][bj][m][0], v1 = acc[ai][bj][m][1];
                    if (rope) {
#pragma unroll
                        for (int j = 0; j < 4; ++j) { const float2 c = cs[pos * 16 + 4 * fq + j]; const float x1 = v0[j], x2 = v1[j]; v0[j] = x1 * c.x - x2 * c.y; v1[j] = x2 * c.x + x1 * c.y; } }
                    v0 = v0 * QS_MLA; v1 = v1 * QS_MLA;
                    bf16_t* p = q + (size_t)r * 768 + X + 4 * fq;
                    uint2 w0, w1; w0.x = cvt_pk_bf16(v0[0], v0[1]); w0.y = cvt_pk_bf16(v0[2], v0[3]); w1.x = cvt_pk_bf16(v1[0], v1[1]); w1.y = cvt_pk_bf16(v1[2], v1[3]);
                    *(uint2*)p = w0; *(uint2*)(p + 16) = w1; }
        }
    }
};
}

#define PG8_SP2 true
#define PG8_ALIGN true
constexpr int NTHR = 512, NWV = NTHR / 64;
#define WAVE_IDS const int lane = threadIdx.x & 63, wv = threadIdx.x >> 6; const int gw = blockIdx.x * NWV + wv, nw = gridDim.x * NWV; (void)lane; (void)gw; (void)nw;

template <bool Q8> DEV void ph_rms1024(const float* __restrict__ src, const float* __restrict__ g, bf16_t* __restrict__ dst, int rows, unsigned* __restrict__ q8 = nullptr, float* __restrict__ qs = nullptr, int gw_o = -1, int nw_o = 0, const bf16_t* __restrict__ add = nullptr) {
  const int lane = threadIdx.x & 63; const int gw = (gw_o >= 0) ? gw_o : (int)(blockIdx.x * NWV + (threadIdx.x >> 6)); const int nw = (gw_o >= 0) ? nw_o : (int)(gridDim.x * NWV);
  float4 gg[4];
#pragma unroll
  for (int j = 0; j < 4; ++j) gg[j] = ((const float4*)g)[j * 64 + lane];
  float4 nx[4]; uint2 na[4];
  if (gw < rows) {
#pragma unroll
    for (int j = 0; j < 4; ++j) { nx[j] = ((const float4*)(src + (size_t)gw * 1024))[j * 64 + lane]; if (add) na[j] = ((const uint2*)(add + (size_t)gw * 1024))[j * 64 + lane]; } }
  for (int r = gw; r < rows; r += nw) {
    float4 v[4]; float ss = 0.f;
#pragma unroll
    for (int j = 0; j < 4; ++j) { v[j] = nx[j];
      if (add) { v[j].x += __uint_as_float(na[j].x << 16); v[j].y += __uint_as_float(na[j].x & 0xffff0000u); v[j].z += __uint_as_float(na[j].y << 16); v[j].w += __uint_as_float(na[j].y & 0xffff0000u); }
      ss += v[j].x * v[j].x + v[j].y * v[j].y + v[j].z * v[j].z + v[j].w * v[j].w; }
    if (r + nw < rows) {
#pragma unroll
      for (int j = 0; j < 4; ++j) { nx[j] = ((const float4*)(src + (size_t)(r + nw) * 1024))[j * 64 + lane]; if (add) na[j] = ((const uint2*)(add + (size_t)(r + nw) * 1024))[j * 64 + lane]; } }
    ss = wsum(ss);
    const float inv = rsqrtf(ss * (1.0f / 1024.0f) + 1e-6f);
    float mx = 0.f;
#pragma unroll
    for (int j = 0; j < 4; ++j) {
      v[j].x *= inv * gg[j].x; v[j].y *= inv * gg[j].y; v[j].z *= inv * gg[j].z; v[j].w *= inv * gg[j].w;
      uint2 o;
      o.x = (unsigned)f2bf(v[j].x) | ((unsigned)f2bf(v[j].y) << 16);
      o.y = (unsigned)f2bf(v[j].z) | ((unsigned)f2bf(v[j].w) << 16);
      ((uint2*)(dst + (size_t)r * 1024))[j * 64 + lane] = o;
      if (Q8) mx = fmaxf(mx, fmaxf(fmaxf(fabsf(v[j].x), fabsf(v[j].y)), fmaxf(fabsf(v[j].z), fabsf(v[j].w))));
    }
    if (Q8) {
      mx = wmaxf(mx);
      const float sc = fmaxf(mx, 1e-30f) * (1.0f / 127.0f), isc = 1.0f / sc;
#pragma unroll
      for (int j = 0; j < 4; ++j) {
        const int q0 = (int)rintf(v[j].x * isc), q1 = (int)rintf(v[j].y * isc), q2 = (int)rintf(v[j].z * isc), q3 = (int)rintf(v[j].w * isc);
        q8[(size_t)r * 256 + j * 64 + lane] = (unsigned)(q0 & 255) | ((unsigned)(q1 & 255) << 8) | ((unsigned)(q2 & 255) << 16) | ((unsigned)(q3 & 255) << 24);
      }
      if (lane == 0) qs[r] = sc;
    }
  }
}
DEV int win_src_col(int n) {
  if (n < 1280) return n;
  if (n < 1536) return 1304 + (n - 1280);
  if (n < 1664) return 1560 + (n - 1536);
  if (n < 1696) return 1688 + (n - 1664);
  if (n < 1720) return 1280 + (n - 1696);
  if (n < 1792) return -1;
  return 1720 + (n - 1792);
}
template <int MODE> DEV void tr_item(const float* __restrict__ W, int K, int Nsrc, bf16_t* __restrict__ WT, int Nblk, int Nvalid, __attribute__((address_space(3))) float* scr, int item, int lane, int pitch = 0, int koff = 0) {
  if (pitch == 0) pitch = K;
  const int kb = item / Nblk, nb = item % Nblk, k0 = 64 * kb, n0 = 32 * nb;
  const int n = n0 + (lane & 31);
  const int sc = (MODE == 1) ? win_src_col(n) : ((n < Nvalid) ? n : -1);
  float tv[32];
#pragma unroll
  for (int i = 0; i < 32; ++i) { const int kk = 2 * i + (lane >> 5); tv[i] = (sc >= 0) ? W[(size_t)(k0 + kk) * Nsrc + sc] : 0.f; }
#pragma unroll
  for (int i = 0; i < 32; ++i) { const int kk = 2 * i + (lane >> 5); scr[kk * 33 + (lane & 31)] = tv[i]; }
  asm volatile("s_waitcnt lgkmcnt(0)" ::: "memory");
  const int c = lane & 7;
#pragma unroll
  for (int j = 0; j < 4; ++j) { const int nn = (lane >> 3) + 8 * j; const __attribute__((address_space(3))) float* sp = scr + (8 * c) * 33 + nn;
    uint4 o;
    o.x = (unsigned)f2bf(sp[0 * 33]) | ((unsigned)f2bf(sp[1 * 33]) << 16); o.y = (unsigned)f2bf(sp[2 * 33]) | ((unsigned)f2bf(sp[3 * 33]) << 16);
    o.z = (unsigned)f2bf(sp[4 * 33]) | ((unsigned)f2bf(sp[5 * 33]) << 16); o.w = (unsigned)f2bf(sp[6 * 33]) | ((unsigned)f2bf(sp[7 * 33]) << 16);
    *(uint4*)(WT + (size_t)(n0 + nn) * pitch + koff + k0 + 8 * c) = o; }
  asm volatile("s_waitcnt lgkmcnt(0)" ::: "memory");
}
DEV void rope_entry(float2* __restrict__ cs, int i) {
  const int j = i & 15, pos = i >> 4;
  const float inv_freq = __builtin_amdgcn_exp2f(-(float)(2 * j) * (13.287712379549449f / 32.0f));
  const float rev = (float)pos * inv_freq * 0.15915494309189535f;
  const float fr = rev - floorf(rev);
  cs[i] = make_float2(__builtin_amdgcn_cosf(fr), __builtin_amdgcn_sinf(fr));
}
namespace att {
#define LAS3 __attribute__((address_space(3)))
typedef LAS3 char* lptr;
typedef LAS3 const char* lcptr;
using bf16x8 = __attribute__((ext_vector_type(8))) short;
using s16x4 = __attribute__((ext_vector_type(4))) short;
using f32x16 = __attribute__((ext_vector_type(16))) float;
typedef short v4i16_t __attribute__((ext_vector_type(4)));
typedef unsigned u32x4 __attribute__((ext_vector_type(4)));
typedef float f32x4_t __attribute__((ext_vector_type(4)));
typedef float f32x2_t __attribute__((ext_vector_type(2)));
typedef __bf16 bf16x2_t __attribute__((ext_vector_type(2)));
constexpr float LOG2E = 1.4426950408889634f;
constexpr float THR = 8.0f;
constexpr float NEG_INF = -__builtin_huge_valf();
constexpr int SLOT = 20480, KOFF = 0, VOFF = 12288;
constexpr int L_WSF = 2 * SLOT;
constexpr int L_TB = L_WSF + 2048;
constexpr int L_ST = L_TB + 8 * 320 * 4;
constexpr int L_SELM = L_ST + 768;
constexpr int L_SC = L_SELM + 256;
constexpr int L_IMPQ = L_SC + 64 * 33 * 4;
constexpr int L_IMPL = L_IMPQ + 4 * 64 * 33 * 4;
constexpr int L_FIN = L_IMPQ;
constexpr int L_END = L_IMPL + 4 * 64 * 33 * 4;
static_assert(L_END <= 131072, "attention LDS map");

__device__ __forceinline__ int crow(int r, int hi) { return (r & 3) + 8 * (r >> 2) + 4 * hi; }
__device__ __forceinline__ s16x4 vtr(lcptr p) { return __builtin_bit_cast(s16x4, __builtin_amdgcn_ds_read_tr16_b64_v4i16((LAS3 v4i16_t*)p)); }
__device__ __forceinline__ unsigned cvtpk(float lo, float hi) { f32x2_t v = {lo, hi}; bf16x2_t b = __builtin_convertvector(v, bf16x2_t); return __builtin_bit_cast(unsigned, b); }
typedef float f32x2_t __attribute__((ext_vector_type(2)));
__device__ __forceinline__ float max3(float a, float b, float c) { float d; asm("v_max3_f32 %0, %1, %2, %3" : "=v"(d) : "v"(a), "v"(b), "v"(c)); return d; }
__device__ __forceinline__ float xmax(float v) { auto rr = __builtin_amdgcn_permlane32_swap(__float_as_uint(v), __float_as_uint(v), false, false); return fmaxf(__uint_as_float(rr[0]), __uint_as_float(rr[1])); }
__device__ __forceinline__ float xsum(float v) { auto rr = __builtin_amdgcn_permlane32_swap(__float_as_uint(v), __float_as_uint(v), false, false); return __uint_as_float(rr[0]) + __uint_as_float(rr[1]); }
__device__ __forceinline__ float ex2(float x) { return __builtin_amdgcn_exp2f(x); }

template <int ND0> __device__ __forceinline__ void qkt(f32x16& p0, f32x16& p1, lcptr kb, const bf16x8* qr) {
  p0 = f32x16{}; p1 = f32x16{};
  __builtin_amdgcn_s_setprio(1);
#pragma unroll
  for (int d0 = 0; d0 < ND0; ++d0) {
    const bf16x8 b0 = *(const LAS3 bf16x8*)(kb + d0 * 2048);
    const bf16x8 b1 = *(const LAS3 bf16x8*)(kb + d0 * 2048 + 512);
    p0 = __builtin_amdgcn_mfma_f32_32x32x16_bf16(b0, qr[d0], p0, 0, 0, 0);
    p1 = __builtin_amdgcn_mfma_f32_32x32x16_bf16(b1, qr[d0], p1, 0, 0, 0);
  }
  __builtin_amdgcn_s_setprio(0);
}
template <int ND0> __device__ __forceinline__ void qkt_init(f32x16& p0, f32x16& p1, lcptr kb, const bf16x8* qr, const f32x16& c0, const f32x16& c1) {
  p0 = c0; p1 = c1;
  __builtin_amdgcn_s_setprio(1);
#pragma unroll
  for (int d0 = 0; d0 < ND0; ++d0) {
    const bf16x8 b0 = *(const LAS3 bf16x8*)(kb + d0 * 2048);
    const bf16x8 b1 = *(const LAS3 bf16x8*)(kb + d0 * 2048 + 512);
    p0 = __builtin_amdgcn_mfma_f32_32x32x16_bf16(b0, qr[d0], p0, 0, 0, 0);
    p1 = __builtin_amdgcn_mfma_f32_32x32x16_bf16(b1, qr[d0], p1, 0, 0, 0);
  }
  __builtin_amdgcn_s_setprio(0);
}
__device__ __forceinline__ void pv(f32x16 (&o)[2], lcptr vp, const unsigned (&pw)[16]) {
  __builtin_amdgcn_s_setprio(1);
#pragma unroll
  for (int d0 = 0; d0 < 2; ++d0)
#pragma unroll
    for (int ks = 0; ks < 4; ++ks) {
      const s16x4 lo = vtr(vp + d0 * 4096 + ks * 1024), hi4 = vtr(vp + d0 * 4096 + ks * 1024 + 512);
      const bf16x8 vf = {lo[0], lo[1], lo[2], lo[3], hi4[0], hi4[1], hi4[2], hi4[3]};
      const unsigned pa4[4] = {pw[4 * ks], pw[4 * ks + 1], pw[4 * ks + 2], pw[4 * ks + 3]};
      o[d0] = __builtin_amdgcn_mfma_f32_32x32x16_bf16(__builtin_bit_cast(bf16x8, pa4), vf, o[d0], 0, 0, 0);
    }
  __builtin_amdgcn_s_setprio(0);
}
__device__ __forceinline__ void softmax_step(f32x16& p0, f32x16& p1, float& m, float& l, f32x16 (&o)[2], LAS3 float* wsf, int r32, int hi, unsigned (&pw)[16]) {
  float rm = max3(p0[0], p1[0], p0[1]), rm2 = max3(p1[1], p0[2], p1[2]);
#pragma unroll
  for (int r = 3; r < 15; r += 2) { rm = max3(rm, p0[r], p1[r]); rm2 = max3(rm2, p0[r + 1], p1[r + 1]); }
  rm = max3(rm, p0[15], p1[15]); rm = max3(rm, rm2, rm2);
  rm = xmax(rm);
  if (__any(rm > m + THR)) {
    const float mn = fmaxf(m, rm);
    const float al = ex2(m - mn);
    m = mn; l *= al;
    if (hi == 0) wsf[r32] = al;
#pragma unroll
    for (int r = 0; r < 16; ++r) { const float f = wsf[crow(r, hi)]; o[0][r] *= f; o[1][r] *= f; }
  }
  f32x2_t s2 = {0.f, 0.f}; const f32x2_t nm = {-m, -m};
#pragma unroll
  for (int r = 0; r < 16; r += 2) {
    const f32x2_t a = (f32x2_t){p0[r], p0[r + 1]} + nm, b = (f32x2_t){p1[r], p1[r + 1]} + nm;
    p0[r] = ex2(a[0]); p0[r + 1] = ex2(a[1]); p1[r] = ex2(b[0]); p1[r + 1] = ex2(b[1]);
    s2 += (f32x2_t){p0[r], p0[r + 1]} + (f32x2_t){p1[r], p1[r + 1]};
  }
  l += s2[0] + s2[1];
#pragma unroll
  for (int i = 0; i < 8; ++i) { pw[i] = cvtpk(p0[2 * i], p0[2 * i + 1]); pw[8 + i] = cvtpk(p1[2 * i], p1[2 * i + 1]); }
}
struct KVSrc { const bf16_t* k; const bf16_t* v; int ldk, ldv; };
__device__ __forceinline__ void kv_issue(const KVSrc& s, int row0, u32x4& rk, u32x4& rv, int tid) {
  const int kv = tid & 63, ch = tid >> 6, ln = tid & 63;
  rk = *(const u32x4*)(s.k + (size_t)(row0 + kv) * s.ldk + ch * 8);
  rv = *(const u32x4*)(s.v + (size_t)(row0 + 16 * (ch & 3) + (ln >> 2)) * s.ldv + (ch >> 2) * 32 + (ln & 3) * 8);
}
__device__ __forceinline__ void kv_commit(lptr slot, const u32x4& rk, const u32x4& rv, int tid) {
  *(LAS3 u32x4*)(slot + KOFF + (tid >> 6) * 1024 + (tid & 63) * 16) = rk;
  *(LAS3 u32x4*)(slot + VOFF + tid * 16) = rv;
}
__device__ __forceinline__ void fin_set(LAS3 float* finl, const f32x16 (&o)[2], int lane) {
#pragma unroll
  for (int d0 = 0; d0 < 2; ++d0)
#pragma unroll
    for (int r = 0; r < 16; ++r) finl[(d0 * 16 + r) * 64 + lane] = o[d0][r];
}
__device__ __forceinline__ void fin_add(LAS3 float* finl, const f32x16 (&o)[2], const LAS3 float* wsf, int lane, int hi) {
#pragma unroll
  for (int r = 0; r < 16; ++r) { const float f = wsf[crow(r, hi)];
#pragma unroll
    for (int d0 = 0; d0 < 2; ++d0) finl[(d0 * 16 + r) * 64 + lane] += o[d0][r] * f; }
}
__device__ __forceinline__ void fin_store(const LAS3 float* finl, bf16_t* gout, size_t rowbase, int ld, int colbase, int lane) {
#pragma unroll
  for (int i = 0; i < 4; ++i) {
    const int q = i * 8 + (lane >> 3), ch = lane & 7;
    const int qh = (q >> 2) & 1, r = (q & 3) + 4 * (q >> 3), d0 = ch >> 2, dl = (ch & 3) * 8;
    const LAS3 float* p = finl + (d0 * 16 + r) * 64 + qh * 32 + dl;
    const f32x4_t x0 = *(const LAS3 f32x4_t*)p, x1 = *(const LAS3 f32x4_t*)(p + 4);
    u32x4 v; v.x = cvtpk(x0[0], x0[1]); v.y = cvtpk(x0[2], x0[3]); v.z = cvtpk(x1[0], x1[1]); v.w = cvtpk(x1[2], x1[3]);
    *(u32x4*)(gout + (rowbase + q) * (size_t)ld + colbase + ch * 8) = v;
  }
}

__device__ __forceinline__ void nsa_unit(int b, int g, int c, const bf16_t* __restrict__ proj, const bf16_t* __restrict__ kc, const bf16_t* __restrict__ vc, bf16_t* __restrict__ onsa, lptr lds) {
  int tid = threadIdx.x; asm volatile("" : "+v"(tid));
  const int lane = tid & 63, r32 = lane & 31, hi = lane >> 5;
  const int w = __builtin_amdgcn_readfirstlane(tid >> 6);
  const int rh = w >> 1, head = g * 4 + rh, tokl = 32 * (w & 1) + r32, t = 64 * c + tokl, bg = b * 2 + g;
  const size_t tok = (size_t)b * SEQ + t;
  LAS3 float* wsf = (LAS3 float*)(lds + L_WSF) + w * 64;
  const LAS3 float* tb = (const LAS3 float*)(lds + L_TB) + head * 320 + 64;
  const LAS3 float* stp = (const LAS3 float*)(lds + L_ST);
  LAS3 unsigned* selm = (LAS3 unsigned*)(lds + L_SELM);
  LAS3 float* sc = (LAS3 float*)(lds + L_SC);
  LAS3 float* impq = (LAS3 float*)(lds + L_IMPQ);
  LAS3 float* impl = (LAS3 float*)(lds + L_IMPL);
  const lcptr kb0 = (lcptr)lds + KOFF + hi * 1024 + r32 * 16;
  const lcptr vp0 = (lcptr)lds + VOFF + ((lane >> 4) & 1) * 32 + (lane & 3) * 8 + (4 * hi + ((lane & 15) >> 2)) * 64;
  bf16x8 qr[4];
#pragma unroll
  for (int d0 = 0; d0 < 4; ++d0) qr[d0] = *(const bf16x8*)(proj + tok * PROJ_LD + PC_Q + head * 64 + d0 * 16 + hi * 8);
  float gate[3];
#pragma unroll
  for (int j = 0; j < 3; ++j) gate[j] = 1.0f / (1.0f + ex2(-LOG2E * bf2f(proj[tok * PROJ_LD + PC_GATE + head * 3 + j])));
  LAS3 float* finl = (LAS3 float*)(lds + L_FIN) + w * 2048;
  f32x16 o[2]; unsigned pw[16];
  u32x4 rk, rv;
  {
    const KVSrc src{kc + (size_t)bg * 128 * 64, vc + (size_t)bg * 128 * 64, 64, 64};
    __syncthreads();
    kv_issue(src, 0, rk, rv, tid); kv_commit(lds, rk, rv, tid);
    kv_issue(src, 64, rk, rv, tid); kv_commit(lds + SLOT, rk, rv, tid);
    __syncthreads();
    f32x16 a0, a1, b0, b1;
    const int twmin = 64 * c + 32 * (w & 1), twmax = twmin + 31;
    const bool live0 = true, live1 = (16 * 32 + 31 <= twmax), live2 = (16 * 64 + 31 <= twmax), live3 = (16 * 96 + 31 <= twmax);
    qkt<4>(a0, a1, kb0, qr);
    if (live2) qkt<4>(b0, b1, kb0 + SLOT, qr); else { b0 = f32x16{}; b1 = f32x16{}; }
    float rm = NEG_INF;
#define CMP_QUARTER(P, QTR, LIVE) do { if (LIVE) { \
      if (!(16 * (32 * (QTR) + 31) + 31 + 112 < twmin)) { \
        _Pragma("unroll") for (int r = 0; r < 16; ++r) { int d_ = t - 16 * (32 * (QTR) + crow(r, hi)) - 31; d_ = d_ < -64 ? -64 : (d_ > 255 ? 255 : d_); P[r] += tb[d_]; } } \
      _Pragma("unroll") for (int r = 0; r < 16; ++r) rm = fmaxf(rm, P[r]); } } while (0)
    CMP_QUARTER(a0, 0, live0); CMP_QUARTER(a1, 1, live1); CMP_QUARTER(b0, 2, live2); CMP_QUARTER(b1, 3, live3);
#undef CMP_QUARTER
    rm = xmax(rm);
    const float mref = (rm == NEG_INF) ? 0.f : rm;
    float s = 0.f;
#define CMP_EXP(P, LIVE) do { if (LIVE) { _Pragma("unroll") for (int r = 0; r < 16; ++r) { P[r] = ex2(P[r] - mref); s += P[r]; } } else { _Pragma("unroll") for (int r = 0; r < 16; ++r) P[r] = 0.f; } } while (0)
    CMP_EXP(a0, live0); CMP_EXP(a1, live1); CMP_EXP(b0, live2); CMP_EXP(b1, live3);
#undef CMP_EXP
    s = xsum(s);
    const float inv = (s > 0.f) ? 1.0f / s : 0.f;
#pragma unroll
    for (int r = 0; r < 16; ++r) { a0[r] *= inv; a1[r] *= inv; b0[r] *= inv; b1[r] *= inv; }
    { LAS3 float* iq = impq + (rh * 64 + tokl) * 33; LAS3 float* il = impl + (rh * 64 + tokl) * 33;
#pragma unroll
      for (int q4 = 0; q4 < 4; ++q4) {
        const int gi = 2 * q4 + hi;
        iq[gi] = (a0[4 * q4] + a0[4 * q4 + 1]) + (a0[4 * q4 + 2] + a0[4 * q4 + 3]);           il[gi] = a0[4 * q4 + 3];
        iq[8 + gi] = (a1[4 * q4] + a1[4 * q4 + 1]) + (a1[4 * q4 + 2] + a1[4 * q4 + 3]);       il[8 + gi] = a1[4 * q4 + 3];
        iq[16 + gi] = (b0[4 * q4] + b0[4 * q4 + 1]) + (b0[4 * q4 + 2] + b0[4 * q4 + 3]);      il[16 + gi] = b0[4 * q4 + 3];
        iq[24 + gi] = (b1[4 * q4] + b1[4 * q4 + 1]) + (b1[4 * q4 + 2] + b1[4 * q4 + 3]);      il[24 + gi] = b1[4 * q4 + 3];
      } }
    o[0] = f32x16{}; o[1] = f32x16{};
#pragma unroll
    for (int i = 0; i < 8; ++i) { pw[i] = cvtpk(a0[2 * i], a0[2 * i + 1]); pw[8 + i] = cvtpk(a1[2 * i], a1[2 * i + 1]); }
    pv(o, vp0, pw);
    if (live2) {
#pragma unroll
      for (int i = 0; i < 8; ++i) { pw[i] = cvtpk(b0[2 * i], b0[2 * i + 1]); pw[8 + i] = cvtpk(b1[2 * i], b1[2 * i + 1]); }
      pv(o, vp0 + SLOT, pw); }
    if (hi == 0) wsf[r32] = gate[0];
#pragma unroll
    for (int r = 0; r < 16; ++r) { const float f = wsf[crow(r, hi)]; o[0][r] *= f; o[1][r] *= f; }
  }
  __syncthreads();
  const KVSrc ssrc{proj + (size_t)b * SEQ * PROJ_LD + PC_KV + 2 * 128 + g * 64, proj + (size_t)b * SEQ * PROJ_LD + PC_KV + 3 * 128 + g * 64, PROJ_LD, PROJ_LD};
  kv_issue(ssrc, 0, rk, rv, tid);
  {
    const int stok = tid >> 3, sub = tid & 7;
#pragma unroll
    for (int k = 0; k < 4; ++k) {
      const int n = sub * 4 + k;
      float imp = 0.f;
#pragma unroll
      for (int hh = 0; hh < 4; ++hh) imp += impq[(hh * 64 + stok) * 33 + n] + ((n > 0) ? impl[(hh * 64 + stok) * 33 + n - 1] : 0.f);
      sc[stok * 33 + n] = (n > c) ? -1.0f : ((n == 0 || n == c || n == c - 1) ? 1e4f : imp);
    }
    if (tid < 64) selm[tid] = 0u;
    __syncthreads();
    float srow[32];
#pragma unroll
    for (int mm = 0; mm < 32; ++mm) srow[mm] = sc[stok * 33 + mm];
    unsigned bits = 0u;
#pragma unroll
    for (int k = 0; k < 4; ++k) {
      const int n = sub * 4 + k; const float sv = sc[stok * 33 + n]; int rank = 0;
#pragma unroll
      for (int mm = 0; mm < 32; ++mm) rank += (srow[mm] > sv || (srow[mm] == sv && mm < n)) ? 1 : 0;
      if (rank < 16) bits |= 1u << n;
    }
    if (bits) atomicOr((unsigned*)(selm + stok), bits);
    __syncthreads();
  }
  const unsigned mysel = selm[tokl];
  fin_set(finl, o, lane);
#pragma unroll 1
  for (int br = 0; br < 2; ++br) {
    const KVSrc src = (br == 0) ? ssrc : KVSrc{proj + (size_t)b * SEQ * PROJ_LD + PC_KV + 4 * 128 + g * 64, proj + (size_t)b * SEQ * PROJ_LD + PC_KV + 5 * 128 + g * 64, PROJ_LD, PROJ_LD};
    const int n0 = (br == 0) ? 0 : ((c > 8) ? c - 8 : 0);
    if (br == 1) { __syncthreads(); kv_issue(src, n0 * 64, rk, rv, tid); }
    kv_commit(lds, rk, rv, tid);
    float m = -1e30f, l = 0.f;
    o[0] = f32x16{}; o[1] = f32x16{};
    int cur = 0;
#pragma unroll 1
    for (int n = n0; n <= c; ++n) {
      __syncthreads();
      if (n < c) kv_issue(src, (n + 1) * 64, rk, rv, tid);
      const bool mine = (br == 1) || ((mysel >> n) & 1u);
      if (__any(mine)) {
        f32x16 p0, p1;
        if (n + 2 >= c) {
          const LAS3 float* bp = tb + (t - 64 * n) - 4 * hi - 63;
          f32x16 c0, c1;
#pragma unroll
          for (int r = 0; r < 16; ++r) { c0[r] = bp[63 - ((r & 3) + 8 * (r >> 2))]; c1[r] = bp[31 - ((r & 3) + 8 * (r >> 2))]; }
          qkt_init<4>(p0, p1, kb0 + cur * SLOT, qr, c0, c1);
        } else if (br == 1 && n + 8 == c) {
          const LAS3 float* bp = stp + (607 - (t - 64 * n)) + 4 * hi;
          f32x16 c0, c1;
#pragma unroll
          for (int r = 0; r < 16; ++r) { c0[r] = bp[(r & 3) + 8 * (r >> 2)]; c1[r] = bp[32 + (r & 3) + 8 * (r >> 2)]; }
          qkt_init<4>(p0, p1, kb0 + cur * SLOT, qr, c0, c1);
        } else qkt<4>(p0, p1, kb0 + cur * SLOT, qr);
        if (!mine) {
#pragma unroll
          for (int r = 0; r < 16; ++r) { p0[r] = NEG_INF; p1[r] = NEG_INF; } }
        softmax_step(p0, p1, m, l, o, wsf, r32, hi, pw);
        pv(o, vp0 + cur * SLOT, pw);
      }
      if (n < c) kv_commit(lds + (cur ^ 1) * SLOT, rk, rv, tid);
      cur ^= 1;
    }
    l = xsum(l);
    const float gi = gate[1 + br] / fmaxf(l, 1e-30f);
    if (hi == 0) wsf[r32] = gi;
    fin_add(finl, o, wsf, lane, hi);
  }
  fin_store(finl, onsa, (size_t)b * SEQ + 64 * c + 32 * (w & 1), 1024, head * 64, lane);
}

__device__ __forceinline__ void mla_unit(int b, int h, int qb, const bf16_t* __restrict__ mq, const bf16_t* __restrict__ mkv, const bf16_t* __restrict__ kr, bf16_t* __restrict__ omla, lptr lds) {
  int tid = threadIdx.x; asm volatile("" : "+v"(tid));
  const int lane = tid & 63, r32 = lane & 31, hi = lane >> 5;
  const int w = __builtin_amdgcn_readfirstlane(tid >> 6);
  const int q0 = 256 * qb, qw = q0 + 32 * w, qpos = qw + r32;
  const size_t tokq = (size_t)b * SEQ + qpos;
  LAS3 float* wsf = (LAS3 float*)(lds + L_WSF) + w * 64;
  const lcptr kb0 = (lcptr)lds + KOFF + hi * 1024 + r32 * 16;
  const lcptr vp0 = (lcptr)lds + VOFF + ((lane >> 4) & 1) * 32 + (lane & 3) * 8 + (4 * hi + ((lane & 15) >> 2)) * 64;
  const LAS3 float* stp = (const LAS3 float*)(lds + L_ST);
  bf16x8 qr[6];
#pragma unroll
  for (int d0 = 0; d0 < 6; ++d0) qr[d0] = *(const bf16x8*)(mq + tokq * 768 + h * 96 + d0 * 16 + hi * 8);
  const KVSrc src{mkv + (size_t)b * SEQ * 1024 + h * 128, mkv + (size_t)b * SEQ * 1024 + h * 128 + 64, 1024, 1024};
  const bf16_t* krb = kr + (size_t)b * SEQ * 32;
  const int NTL = 4 * (qb + 1);
  u32x4 rk, rv, rr = {0u, 0u, 0u, 0u};
  f32x16 o[2]; o[0] = f32x16{}; o[1] = f32x16{};
  unsigned pw[16];
  float m = -1e30f, l = 0.f;
  __syncthreads();
  kv_issue(src, 0, rk, rv, tid);
  if (tid < 256) rr = *(const u32x4*)(krb + (size_t)(tid & 63) * 32 + (tid >> 6) * 8);
  kv_commit(lds, rk, rv, tid);
  if (tid < 256) *(LAS3 u32x4*)(lds + KOFF + (8 + (tid >> 6)) * 1024 + (tid & 63) * 16) = rr;
  int cur = 0;
#pragma unroll 1
  for (int tl = 0; tl < NTL; ++tl) {
    __syncthreads();
    if (tl + 1 < NTL) { kv_issue(src, (tl + 1) * 64, rk, rv, tid); if (tid < 256) rr = *(const u32x4*)(krb + (size_t)((tl + 1) * 64 + (tid & 63)) * 32 + (tid >> 6) * 8); }
    if (64 * tl <= qw + 31) {
      f32x16 p0, p1;
      if (64 * tl + 63 > qw) {
        const LAS3 float* bp = stp + 96 + (qpos - 64 * tl) - 4 * hi - 63;
        f32x16 c0, c1;
#pragma unroll
        for (int r = 0; r < 16; ++r) { c0[r] = bp[63 - ((r & 3) + 8 * (r >> 2))]; c1[r] = bp[31 - ((r & 3) + 8 * (r >> 2))]; }
        qkt_init<6>(p0, p1, kb0 + cur * SLOT, qr, c0, c1);
      } else qkt<6>(p0, p1, kb0 + cur * SLOT, qr);
      softmax_step(p0, p1, m, l, o, wsf, r32, hi, pw);
      pv(o, vp0 + cur * SLOT, pw);
    }
    if (tl + 1 < NTL) { kv_commit(lds + (cur ^ 1) * SLOT, rk, rv, tid); if (tid < 256) *(LAS3 u32x4*)(lds + (cur ^ 1) * SLOT + KOFF + (8 + (tid >> 6)) * 1024 + (tid & 63) * 16) = rr; }
    cur ^= 1;
  }
  l = xsum(l);
  if (hi == 0) wsf[r32] = 1.0f / fmaxf(l, 1e-30f);
#pragma unroll
  for (int r = 0; r < 16; ++r) { const float f = wsf[crow(r, hi)]; o[0][r] *= f; o[1][r] *= f; }
  LAS3 float* finl = (LAS3 float*)(lds + L_FIN) + w * 2048;
  fin_set(finl, o, lane);
  fin_store(finl, omla, (size_t)b * SEQ + qw, 1024, 512 + h * 64, lane);
}

__device__ __forceinline__ void attn_phase(const bf16_t* proj, const bf16_t* kc, const bf16_t* vc, const float* t5, bf16_t* onsa,
                                           const bf16_t* mq, const bf16_t* mkv, const bf16_t* kr, bf16_t* omla, lptr lds) {
  const int tid = threadIdx.x;
  { LAS3 float* tb = (LAS3 float*)(lds + L_TB);
    for (int i = tid; i < 8 * 320; i += NTHR) { const int hd = i / 320, d = i % 320 - 64; tb[i] = (d < 0) ? NEG_INF : ((d < 113) ? (t5[(int)T5B[d] * 8 + hd] - t5[31 * 8 + hd]) * LOG2E : 0.f); }
    LAS3 float* st = (LAS3 float*)(lds + L_ST);
    for (int i = tid; i < 192; i += NTHR) st[i] = (i < 96) ? NEG_INF : 0.f; }
  const int G = gridDim.x, bx = blockIdx.x;
  for (int v = (G % 8 == 0) ? (bx % 8) * (G / 8) + bx / 8 : bx; v < 256; v += G) {
    const int bg = v >> 4, p = v & 15, bh = v >> 2, j = v & 3;
#pragma unroll 1
    for (int u = 0; u < 2; ++u) nsa_unit(bg >> 1, bg & 1, u ? p : 31 - p, proj, kc, vc, onsa, lds);
#pragma unroll 1
    for (int u = 0; u < 2; ++u) mla_unit(bh >> 3, bh & 7, u ? j : 7 - j, mq, mkv, kr, omla, lds);
  }
}
#undef LAS3
}


namespace peer {
using bf16x8 = __attribute__((ext_vector_type(8))) short;
using f32x16 = __attribute__((ext_vector_type(16))) float;
typedef unsigned u32x4 __attribute__((ext_vector_type(4)));
typedef float f32x4_t __attribute__((ext_vector_type(4)));
typedef __bf16 bf16x2_t __attribute__((ext_vector_type(2)));
typedef float f32x2_t __attribute__((ext_vector_type(2)));
#define LAS3 __attribute__((address_space(3)))
__device__ __forceinline__ int crow(int r, int hi) { return (r & 3) + 8 * (r >> 2) + 4 * hi; }
__device__ __forceinline__ unsigned enc(float f) { const unsigned u = __float_as_uint(f); return u ^ ((unsigned)((int)u >> 31) | 0x80000000u); }
__device__ __forceinline__ float dec(unsigned k) { return __uint_as_float(k ^ (~(unsigned)((int)k >> 31) | 0x80000000u)); }
__device__ __forceinline__ unsigned umax(unsigned a, unsigned b) { return a > b ? a : b; }
__device__ __forceinline__ unsigned umin(unsigned a, unsigned b) { return a < b ? a : b; }
__device__ __forceinline__ unsigned cvtpk(float lo, float hi) { f32x2_t v = {lo, hi}; bf16x2_t b = __builtin_convertvector(v, bf16x2_t); return __builtin_bit_cast(unsigned, b); }
template <int B, int N> __device__ __forceinline__ void sort16(unsigned (&k)[N]) {
#pragma unroll
  for (int size = 2; size <= 16; size <<= 1)
#pragma unroll
    for (int stride = size >> 1; stride > 0; stride >>= 1)
#pragma unroll
      for (int i = 0; i < 16; ++i) { const int l = i ^ stride;
        if (l > i) { const bool desc = ((i & size) == 0); const unsigned a = k[B + i], b = k[B + l]; const unsigned mx = umax(a, b), mn = umin(a, b); k[B + i] = desc ? mx : mn; k[B + l] = desc ? mn : mx; } }
}
template <int A, int Bo, int N> __device__ __forceinline__ void merge16(unsigned (&k)[N]) {
#pragma unroll
  for (int i = 0; i < 16; ++i) k[A + i] = umax(k[A + i], k[Bo + 15 - i]);
#pragma unroll
  for (int stride = 8; stride > 0; stride >>= 1)
#pragma unroll
    for (int i = 0; i < 16; ++i) { const int l = i ^ stride; if (l > i) { const unsigned a = k[A + i], b = k[A + l]; k[A + i] = umax(a, b); k[A + l] = umin(a, b); } }
}
template <int N> __device__ __forceinline__ void top16_of_64(unsigned (&k)[N]) {
  sort16<0>(k); sort16<16>(k); sort16<32>(k); sort16<48>(k);
  merge16<0, 16>(k); merge16<32, 48>(k); merge16<0, 32>(k);
}

__device__ __forceinline__ void route_phase(const bf16_t* __restrict__ pq, const bf16_t* __restrict__ subk, unsigned* __restrict__ pack, LAS3 char* lds, int pm, int pn) {
  int tid = threadIdx.x; asm volatile("" : "+v"(tid));
  const int lane = tid & 63, r32 = lane & 31, hi = lane >> 5, wv = tid >> 6;
  LAS3 unsigned char* myb = (LAS3 unsigned char*)lds + wv * 2560 + lane * 40;
#pragma unroll 1
  for (int item = wv; item < 16; item += NWV) {
    const int h = pn * 2 + (item >> 3), t0 = pm * 256 + (item & 7) * 32;
    unsigned la[16], lb[16];
#pragma unroll
    for (int i = 0; i < 16; ++i) { la[i] = 0u; lb[i] = 0u; }
#pragma unroll 1
    for (int p = 0; p < 2; ++p) {
      f32x16 acc[4];
#pragma unroll
      for (int kt = 0; kt < 4; ++kt) acc[kt] = f32x16{};
#pragma unroll
      for (int kd = 0; kd < 4; ++kd) {
        const bf16x8 bq = *(const bf16x8*)(pq + (size_t)(t0 + r32) * 1024 + h * 128 + p * 64 + kd * 16 + hi * 8);
#pragma unroll
        for (int kt = 0; kt < 4; ++kt) {
          const bf16x8 ak = *(const bf16x8*)(subk + (size_t)((h * 2 + p) * 128 + kt * 32 + r32) * 64 + kd * 16 + hi * 8);
          acc[kt] = __builtin_amdgcn_mfma_f32_32x32x16_bf16(ak, bq, acc[kt], 0, 0, 0);
        }
      }
      unsigned k[64];
#pragma unroll
      for (int kt = 0; kt < 4; ++kt)
#pragma unroll
        for (int r = 0; r < 16; ++r) k[kt * 16 + r] = (enc(acc[kt][r]) & 0xFFFFFF80u) | (unsigned)(127 - (32 * kt + crow(r, hi)));
      top16_of_64(k);
#pragma unroll
      for (int i = 0; i < 16; ++i) { auto rr = __builtin_amdgcn_permlane32_swap(k[i], k[i], false, false); unsigned r0 = rr[0], r1 = rr[1]; asm volatile("" : "+v"(r0), "+v"(r1)); k[16 + i] = hi ? r0 : r1; }
      merge16<0, 16>(k);
#pragma unroll
      for (int i = 0; i < 16; ++i) { la[i] = (p == 0) ? k[i] : la[i]; lb[i] = (p == 0) ? lb[i] : k[i]; }
      __builtin_amdgcn_sched_barrier(0);
    }
#pragma unroll
    for (int i = 0; i < 4; ++i) {
      const unsigned wa = (127u - (la[4 * i] & 127u)) | ((127u - (la[4 * i + 1] & 127u)) << 8) | ((127u - (la[4 * i + 2] & 127u)) << 16) | ((127u - (la[4 * i + 3] & 127u)) << 24);
      const unsigned wb = (127u - (lb[4 * i] & 127u)) | ((127u - (lb[4 * i + 1] & 127u)) << 8) | ((127u - (lb[4 * i + 2] & 127u)) << 16) | ((127u - (lb[4 * i + 3] & 127u)) << 24);
      *(LAS3 unsigned*)(myb + 4 * i) = wa; *(LAS3 unsigned*)(myb + 16 + 4 * i) = wb;
    }
    float va[16], vb[16];
#pragma unroll
    for (int i = 0; i < 16; ++i) { va[i] = dec(la[i] & 0xFFFFFF80u); vb[i] = dec(lb[i] & 0xFFFFFF80u); }
    unsigned k[64];
#define PEER_CAND(n, i, j) k[n] = (enc(va[i] + vb[j]) & 0xFFFFFF00u) | (unsigned)(255 - ((i) * 16 + (j)))
    PEER_CAND(0, 0, 0); PEER_CAND(1, 0, 1); PEER_CAND(2, 0, 2); PEER_CAND(3, 0, 3); PEER_CAND(4, 0, 4); PEER_CAND(5, 0, 5);
    PEER_CAND(6, 0, 6); PEER_CAND(7, 0, 7); PEER_CAND(8, 0, 8); PEER_CAND(9, 0, 9); PEER_CAND(10, 0, 10); PEER_CAND(11, 0, 11);
    PEER_CAND(12, 0, 12); PEER_CAND(13, 0, 13); PEER_CAND(14, 0, 14); PEER_CAND(15, 0, 15); PEER_CAND(16, 1, 0); PEER_CAND(17, 1, 1);
    PEER_CAND(18, 1, 2); PEER_CAND(19, 1, 3); PEER_CAND(20, 1, 4); PEER_CAND(21, 1, 5); PEER_CAND(22, 1, 6); PEER_CAND(23, 1, 7);
    PEER_CAND(24, 2, 0); PEER_CAND(25, 2, 1); PEER_CAND(26, 2, 2); PEER_CAND(27, 2, 3); PEER_CAND(28, 2, 4); PEER_CAND(29, 3, 0);
    PEER_CAND(30, 3, 1); PEER_CAND(31, 3, 2); PEER_CAND(32, 3, 3); PEER_CAND(33, 4, 0); PEER_CAND(34, 4, 1); PEER_CAND(35, 4, 2);
    PEER_CAND(36, 5, 0); PEER_CAND(37, 5, 1); PEER_CAND(38, 6, 0); PEER_CAND(39, 6, 1); PEER_CAND(40, 7, 0); PEER_CAND(41, 7, 1);
    PEER_CAND(42, 8, 0); PEER_CAND(43, 9, 0); PEER_CAND(44, 10, 0); PEER_CAND(45, 11, 0); PEER_CAND(46, 12, 0); PEER_CAND(47, 13, 0);
    PEER_CAND(48, 14, 0); PEER_CAND(49, 15, 0);
#undef PEER_CAND
#pragma unroll
    for (int z = 50; z < 64; ++z) k[z] = 0u;
    top16_of_64(k);
    const float best0 = dec(k[0] & 0xFFFFFF00u);
    float ev[16]; float den = 0.f;
#pragma unroll
    for (int i = 0; i < 16; ++i) { ev[i] = __expf(dec(k[i] & 0xFFFFFF00u) - best0); den += ev[i]; }
    const float inv = 1.0f / den;
    unsigned outw[8];
#pragma unroll
    for (int i = 0; i < 8; ++i) {
      unsigned k_lo = k[i], k_hi = k[8 + i]; float e_lo = ev[i], e_hi = ev[8 + i];
      asm volatile("" : "+v"(k_lo), "+v"(k_hi), "+v"(e_lo), "+v"(e_hi));
      const unsigned kk = hi ? k_hi : k_lo; const float e = hi ? e_hi : e_lo;
      const unsigned f = 255u - (kk & 255u);
      const unsigned ia = myb[f >> 4], ib = myb[16 + (f & 15u)];
      outw[i] = (ia * 128u + ib) | (cvtpk(0.f, e * inv) & 0xFFFF0000u);
    }
    unsigned* dst = pack + (size_t)(t0 + r32) * 128 + h * 16 + hi * 8;
    *(u32x4*)dst = (u32x4){outw[0], outw[1], outw[2], outw[3]};
    *(u32x4*)(dst + 4) = (u32x4){outw[4], outw[5], outw[6], outw[7]};
  }
}

__device__ __forceinline__ void conv_tables(const float* __restrict__ u, const float* __restrict__ v, unsigned* __restrict__ u8, float* __restrict__ su, unsigned* __restrict__ v8) {
  const int tid = threadIdx.x, lane = tid & 63, wv = tid >> 6;
  const int gw = blockIdx.x * NWV + wv, nw = gridDim.x * NWV;
  for (int e = gw; e < 16384; e += nw) {
    const f32x4_t* ur = (const f32x4_t*)(u + (size_t)e * 1024) + lane * 4;
    f32x4_t a[4]; float mx = 0.f;
#pragma unroll
    for (int i = 0; i < 4; ++i) { a[i] = ur[i]; mx = fmaxf(mx, fmaxf(fmaxf(fabsf(a[i][0]), fabsf(a[i][1])), fmaxf(fabsf(a[i][2]), fabsf(a[i][3])))); }
    mx = wmaxf(mx);
    const float sc = fmaxf(mx, 1e-30f) * (1.0f / 127.0f), isc = 1.0f / sc;
    u32x4 o;
#pragma unroll
    for (int i = 0; i < 4; ++i) {
      const int q0 = (int)rintf(a[i][0] * isc), q1 = (int)rintf(a[i][1] * isc), q2 = (int)rintf(a[i][2] * isc), q3 = (int)rintf(a[i][3] * isc);
      o[i] = (unsigned)(q0 & 255) | ((unsigned)(q1 & 255) << 8) | ((unsigned)(q2 & 255) << 16) | ((unsigned)(q3 & 255) << 24);
    }
    *(u32x4*)(u8 + (size_t)e * 256 + lane * 4) = o;
    if (lane == 0) su[e] = sc;
    const f32x4_t* vr = (const f32x4_t*)(v + (size_t)e * 1024) + lane * 4;
    u32x4 ov;
#pragma unroll
    for (int i = 0; i < 4; ++i) { const f32x4_t b = vr[i]; unsigned w = 0u; w = __builtin_amdgcn_cvt_pk_fp8_f32(2.0f * b[0], 2.0f * b[1], w, false); w = __builtin_amdgcn_cvt_pk_fp8_f32(2.0f * b[2], 2.0f * b[3], w, true); ov[i] = w; }
    *(u32x4*)(v8 + ((size_t)(lane >> 3) * 16384 + e) * 32 + (lane & 7) * 4) = ov;
  }
}
__device__ __forceinline__ float gelu_fast(float v) {
  const float av = __builtin_fabsf(v), t = __builtin_amdgcn_rcpf(av * 0.2316418882f + 1.0f);
  float q = t * 0.5307027145f + (-0.7265760135f); q = q * t + 0.7107068705f; q = q * t + (-0.142248368f); q = q * t + 0.127414796f; q = q * t;
  const float e = __builtin_amdgcn_exp2f((v * v) * (-0.72134752044f));
  const float m = v * (q * e);
  return v < 0.f ? m : v - m;
}
__device__ __forceinline__ unsigned xcc_id() { return (unsigned)__builtin_amdgcn_s_getreg((3 << 11) | 20) & 7u; }
struct ABuf { unsigned w, meta; u32x4 ub[8]; float sue; };
__device__ __forceinline__ void expA_issue(ABuf& B, int k0, int n, const LAS3 unsigned* list, const unsigned* __restrict__ u8, const float* __restrict__ su, int j8) {
  const int k = (k0 < n) ? k0 : 0;
  B.w = list[2 * k]; B.meta = list[2 * k + 1];
  const unsigned e = B.w & 0xFFFFu;
  const unsigned* urow = u8 + (size_t)e * 256 + j8 * 4;
#pragma unroll
  for (int seg = 0; seg < 8; ++seg) B.ub[seg] = *(const u32x4*)(urow + seg * 32);
  B.sue = su[e];
}
__device__ __forceinline__ void expA_consume(const ABuf& B, int k0, int n, const LAS3 char* hl, const LAS3 float* shl, float* __restrict__ co, int t0, int j8) {
  const int tokl = (int)(B.meta >> 8), slot = (int)(B.meta & 255u);
  const LAS3 char* hrow = hl + tokl * 1024 + j8 * 16;
  int a0 = 0, a1 = 0, a2 = 0, a3 = 0;
#pragma unroll
  for (int seg = 0; seg < 8; ++seg) { const u32x4 hq = *(const LAS3 u32x4*)(hrow + seg * 128);
    a0 = __builtin_amdgcn_sdot4((int)B.ub[seg].x, (int)hq.x, a0, false); a1 = __builtin_amdgcn_sdot4((int)B.ub[seg].y, (int)hq.y, a1, false);
    a2 = __builtin_amdgcn_sdot4((int)B.ub[seg].z, (int)hq.z, a2, false); a3 = __builtin_amdgcn_sdot4((int)B.ub[seg].w, (int)hq.w, a3, false); }
  int acc = (a0 + a1) + (a2 + a3);
  acc += dpp_i<0xB1>(acc); acc += dpp_i<0x4E>(acc); acc += dpp_i<0x141>(acc);
  const float d = (float)acc * (B.sue * shl[tokl]);
  const float c = 0.5f * __uint_as_float(B.w & 0xFFFF0000u) * gelu_fast(d);
  if (j8 == 0 && k0 < n) co[(size_t)(t0 + tokl) * 128 + slot] = c;
}
struct AStage { u32x4 pw[4], hst[8]; float shv; };
__device__ __forceinline__ void expA_stage(AStage& S, int item, const unsigned* __restrict__ pack, const unsigned* __restrict__ hn8, const float* __restrict__ shp, int tid) {
  const int t0 = item * 64, tokl = tid >> 3, sb = (tid & 7) * 16;
#pragma unroll
  for (int i = 0; i < 4; ++i) S.pw[i] = *(const u32x4*)(pack + (size_t)(t0 + tokl) * 128 + sb + 4 * i);
#pragma unroll
  for (int i = 0; i < 8; ++i) S.hst[i] = *(const u32x4*)(hn8 + (size_t)t0 * 256 + (tid + 512 * i) * 4);
  S.shv = (tid < 64) ? shp[t0 + tid] : 0.f;
}
__device__ __forceinline__ void expA_item(AStage& S, int item, int nitem, int xs, const unsigned* __restrict__ pack, const unsigned* __restrict__ hn8, const float* __restrict__ shp, const unsigned* __restrict__ u8, const float* __restrict__ su,
                                          float* __restrict__ co, LAS3 char* lds, int tid) {
  const int lane = tid & 63, wv = tid >> 6;
  LAS3 char* hl = lds + 1024;
  LAS3 float* shl = (LAS3 float*)(lds + 1024 + 65536);
  LAS3 unsigned* cnt = (LAS3 unsigned*)(lds + 16);
  LAS3 unsigned* list = (LAS3 unsigned*)(lds + 1024 + 65536 + 256);
  const int t0 = item * 64;
  const int tokl = tid >> 3, sb = (tid & 7) * 16;
#pragma unroll
  for (int i = 0; i < 8; ++i) *(LAS3 u32x4*)(hl + (tid + 512 * i) * 16) = S.hst[i];
  if (tid < 64) shl[tid] = S.shv;
  {
    unsigned long long mk[16]; int tot = 0; int off[16];
#pragma unroll
    for (int j = 0; j < 16; ++j) { const unsigned w = S.pw[j >> 2][j & 3]; mk[j] = __ballot(((w & 0xFFFFu) >> 11) == (unsigned)xs); off[j] = tot; tot += __builtin_popcountll(mk[j]); }
    int base = 0;
    if (lane == 0) base = (int)__hip_atomic_fetch_add(cnt, (unsigned)tot, __ATOMIC_RELAXED, __HIP_MEMORY_SCOPE_WORKGROUP);
    base = __builtin_amdgcn_readfirstlane(base);
#pragma unroll
    for (int j = 0; j < 16; ++j) { const unsigned w = S.pw[j >> 2][j & 3];
      if (((w & 0xFFFFu) >> 11) == (unsigned)xs) { const int pos = base + off[j] + (int)__builtin_amdgcn_mbcnt_hi((unsigned)(mk[j] >> 32), __builtin_amdgcn_mbcnt_lo((unsigned)mk[j], 0u));
        list[2 * pos] = w; list[2 * pos + 1] = (unsigned)((tokl << 8) | (sb + j)); } }
  }
  if (nitem < T / 64) expA_stage(S, nitem, pack, hn8, shp, tid);
  __syncthreads();
  const int n = (int)cnt[0];
  const int j8 = lane & 7, gidx = wv * 8 + (lane >> 3);
  ABuf A, Bb;
  expA_issue(A, gidx, n, list, u8, su, j8);
#pragma unroll 1
  for (int k0 = gidx; k0 < n; k0 += 128) {
    expA_issue(Bb, k0 + 64, n, list, u8, su, j8);
    expA_consume(A, k0, n, hl, shl, co, t0, j8);
    expA_issue(A, k0 + 128, n, list, u8, su, j8);
    expA_consume(Bb, k0 + 64, n, hl, shl, co, t0, j8);
  }
}
struct BBuf { u32x4 vv[8]; f32x4_t c[2]; };
__device__ __forceinline__ void expB_issue(BBuf& B, const LAS3 unsigned* pkl, const LAS3 float* col, int sg8, const unsigned* __restrict__ vbase) {
  const u32x4 p0 = *(const LAS3 u32x4*)(pkl + sg8 * 8), p1 = *(const LAS3 u32x4*)(pkl + sg8 * 8 + 4);
  B.c[0] = *(const LAS3 f32x4_t*)(col + sg8 * 8); B.c[1] = *(const LAS3 f32x4_t*)(col + sg8 * 8 + 4);
#pragma unroll
  for (int j = 0; j < 4; ++j) { B.vv[j] = *(const u32x4*)(vbase + (size_t)(p0[j] & 0xFFFFu) * 32); B.vv[4 + j] = *(const u32x4*)(vbase + (size_t)(p1[j] & 0xFFFFu) * 32); }
}
__device__ __forceinline__ void expB_consume(const BBuf& B, f32x2_t (&y)[8]) {
#pragma unroll
  for (int j = 0; j < 8; ++j) {
    const float cv = B.c[j >> 2][j & 3];
    const f32x2_t c2 = {cv, cv};
#pragma unroll
    for (int w = 0; w < 4; ++w) {
      y[2 * w] = __builtin_elementwise_fma(__builtin_amdgcn_cvt_pk_f32_fp8(B.vv[j][w], false), c2, y[2 * w]);
      y[2 * w + 1] = __builtin_elementwise_fma(__builtin_amdgcn_cvt_pk_f32_fp8(B.vv[j][w], true), c2, y[2 * w + 1]);
    }
  }
}
__device__ __forceinline__ void expB_item(int item, int xs, const unsigned* __restrict__ pack, const float* __restrict__ co, const unsigned* __restrict__ v8, bf16_t* __restrict__ zb, float* __restrict__ ssq, LAS3 char* lds, int tid,
                                          const float* __restrict__ xin, const bf16_t* __restrict__ ob) {
  const int lane = tid & 63, wv = tid >> 6, r8 = lane >> 3, c8 = lane & 7;
  const int t0 = item * 64 + wv * 8;
  LAS3 unsigned* pkw = (LAS3 unsigned*)(lds + 1024 + wv * 8192);
  LAS3 float* cow = (LAS3 float*)(lds + 1024 + wv * 8192 + 4096);
  {
    u32x4 a[4]; f32x4_t b[4];
#pragma unroll
    for (int i = 0; i < 4; ++i) { a[i] = *(const u32x4*)(pack + (size_t)t0 * 128 + (lane + 64 * i) * 4); b[i] = *(const f32x4_t*)(co + (size_t)t0 * 128 + (lane + 64 * i) * 4); }
#pragma unroll
    for (int i = 0; i < 4; ++i) { *(LAS3 u32x4*)(pkw + (lane + 64 * i) * 4) = a[i]; *(LAS3 f32x4_t*)(cow + (lane + 64 * i) * 4) = b[i]; }
  }
  const size_t hoff = (size_t)(t0 + r8) * 1024 + xs * 128 + c8 * 16;
  f32x4_t h[4];
  { const u32x4 o0 = *(const u32x4*)(ob + hoff), o1 = *(const u32x4*)(ob + hoff + 8);
#pragma unroll
    for (int w = 0; w < 4; ++w) h[w] = *(const f32x4_t*)(xin + hoff + 4 * w);
    h[0] += (f32x4_t){__uint_as_float(o0.x << 16), __uint_as_float(o0.x & 0xffff0000u), __uint_as_float(o0.y << 16), __uint_as_float(o0.y & 0xffff0000u)};
    h[1] += (f32x4_t){__uint_as_float(o0.z << 16), __uint_as_float(o0.z & 0xffff0000u), __uint_as_float(o0.w << 16), __uint_as_float(o0.w & 0xffff0000u)};
    h[2] += (f32x4_t){__uint_as_float(o1.x << 16), __uint_as_float(o1.x & 0xffff0000u), __uint_as_float(o1.y << 16), __uint_as_float(o1.y & 0xffff0000u)};
    h[3] += (f32x4_t){__uint_as_float(o1.z << 16), __uint_as_float(o1.z & 0xffff0000u), __uint_as_float(o1.w << 16), __uint_as_float(o1.w & 0xffff0000u)}; }
  wave_lds_sync();
  const LAS3 unsigned* pkl = pkw + r8 * 128; const LAS3 float* col = cow + r8 * 128;
  const unsigned* vbase = v8 + (size_t)xs * 16384 * 32 + c8 * 4;
  f32x2_t y[8];
#pragma unroll
  for (int i = 0; i < 8; ++i) y[i] = (f32x2_t){0.f, 0.f};
  BBuf A, Bb;
  expB_issue(A, pkl, col, 0, vbase);
#pragma unroll 1
  for (int sg = 0; sg < 16; sg += 2) {
    expB_issue(Bb, pkl, col, sg + 1, vbase);
    expB_consume(A, y);
    if (sg + 2 < 16) expB_issue(A, pkl, col, sg + 2, vbase);
    expB_consume(Bb, y);
  }
  float ss = 0.f; unsigned zw[8];
#pragma unroll
  for (int w = 0; w < 4; ++w) {
    const f32x4_t z = {h[w][0] + y[2 * w][0], h[w][1] + y[2 * w][1], h[w][2] + y[2 * w + 1][0], h[w][3] + y[2 * w + 1][1]};
    zw[2 * w] = cvtpk(z[0], z[1]); zw[2 * w + 1] = cvtpk(z[2], z[3]);
    ss += (z[0] * z[0] + z[1] * z[1]) + (z[2] * z[2] + z[3] * z[3]);
  }
  *(u32x4*)(zb + hoff) = (u32x4){zw[0], zw[1], zw[2], zw[3]}; *(u32x4*)(zb + hoff + 8) = (u32x4){zw[4], zw[5], zw[6], zw[7]};
  ss += dpp_f<0xB1>(ss); ss += dpp_f<0x4E>(ss); ss += dpp_f<0x141>(ss);
  if (c8 == 0) ssq[(size_t)xs * T + t0 + r8] = ss;
  wave_lds_sync();
}
template <int PASS> __device__ __forceinline__ void experts_sliced(const unsigned* __restrict__ pack, const unsigned* __restrict__ hn8, const float* __restrict__ shp, const unsigned* __restrict__ u8, const float* __restrict__ su,
                                                                    float* __restrict__ co, const unsigned* __restrict__ v8, float* __restrict__ out, float* __restrict__ ssq, unsigned* __restrict__ ctr, LAS3 char* lds,
                                                                    const float* __restrict__ xin = nullptr, const bf16_t* __restrict__ ob = nullptr) {
  int tid = threadIdx.x; asm volatile("" : "+v"(tid));
  LAS3 volatile int* lw = (LAS3 volatile int*)lds;
  const int xme = (int)xcc_id();
#pragma unroll 1
  for (int s8 = 0; s8 < 8; ++s8) {
    const int xs = (xme + s8) & 7;
    if (PASS == 0) {
      int nxt = 0;
      if (tid == 0) nxt = (int)atomicAdd(ctr + 64 * xs, 1u);
      __syncthreads();
      if (tid == 0) lw[0] = nxt;
      __syncthreads();
      int item = lw[0];
      if (item >= T / 64) continue;
      if (tid == 0) nxt = (int)atomicAdd(ctr + 64 * xs, 1u);
      AStage SA;
      expA_stage(SA, item, pack, hn8, shp, tid);
#pragma unroll 1
      for (;;) {
        __syncthreads();
        if (tid == 0) { lw[0] = nxt; lw[4] = 0; }
        __syncthreads();
        const int nitem = lw[0];
        if (tid == 0) nxt = (int)atomicAdd(ctr + 64 * xs, 1u);
        expA_item(SA, item, nitem, xs, pack, hn8, shp, u8, su, co, lds, tid);
        if (nitem >= T / 64) break;
        item = nitem;
      }
    } else {
      int nxt = 0;
      if (tid == 0) nxt = (int)atomicAdd(ctr + 64 * xs, 1u);
#pragma unroll 1
      for (;;) {
        __syncthreads();
        if (tid == 0) lw[0] = nxt;
        __syncthreads();
        const int item = lw[0];
        if (item >= T / 64) break;
        if (tid == 0) nxt = (int)atomicAdd(ctr + 64 * xs, 1u);
        expB_item(item, xs, pack, co, v8, (bf16_t*)out, ssq, lds, tid, xin, ob);
      }
    }
  }
}
__device__ __forceinline__ void experts_norm(const float* __restrict__ ssq, const float* __restrict__ gfin, const bf16_t* __restrict__ zb, float* __restrict__ out) {
  const int tid = threadIdx.x, lane = tid & 63, wv = tid >> 6;
  const int gw = blockIdx.x * NWV + wv, nw = gridDim.x * NWV;
  for (int t = gw; t < T; t += nw) {
    float ss = 0.f;
#pragma unroll
    for (int x = 0; x < 8; ++x) ss += ssq[(size_t)x * T + t];
    const float inv = rsqrtf(ss * (1.0f / 1024.0f) + 1e-6f);
    float* op = out + (size_t)t * 1024 + lane * 16; const float* gp = gfin + lane * 16;
    const u32x4 z0 = *(const u32x4*)(zb + (size_t)t * 1024 + lane * 16), z1 = *(const u32x4*)(zb + (size_t)t * 1024 + lane * 16 + 8);
    const unsigned zz[8] = {z0.x, z0.y, z0.z, z0.w, z1.x, z1.y, z1.z, z1.w};
#pragma unroll
    for (int i = 0; i < 4; ++i) { const f32x4_t z = {__uint_as_float(zz[2 * i] << 16), __uint_as_float(zz[2 * i] & 0xffff0000u), __uint_as_float(zz[2 * i + 1] << 16), __uint_as_float(zz[2 * i + 1] & 0xffff0000u)};
      const f32x4_t g = *(const f32x4_t*)(gp + 4 * i); *(f32x4_t*)(op + 4 * i) = z * inv * g; }
  }
}
#undef LAS3
}

namespace prep {
typedef unsigned u32x2_t __attribute__((ext_vector_type(2)));
typedef float f32x4_t __attribute__((ext_vector_type(4)));
typedef unsigned u32x4 __attribute__((ext_vector_type(4)));
using bf16x8 = __attribute__((ext_vector_type(8))) short;
using f32x16 = __attribute__((ext_vector_type(16))) float;
__device__ __forceinline__ unsigned pk2(float lo, float hi) { return (unsigned)f2bf(lo) | ((unsigned)f2bf(hi) << 16); }
__device__ __forceinline__ void latent_rows(const bf16_t* __restrict__ proj, const float* __restrict__ gq, const float* __restrict__ gkv, const float2* __restrict__ cs,
                                            bf16_t* __restrict__ cqn, bf16_t* __restrict__ ckvn, bf16_t* __restrict__ krope, int wave_id, int nwaves, int lane) {
  const f32x4_t g4 = *(const f32x4_t*)(gq + lane * 4);
  const float2 g2 = *(const float2*)(gkv + lane * 2);
  for (int r = wave_id; r < T; r += nwaves) {
    const bf16_t* row = proj + (size_t)r * PROJ_LD;
    const u32x2_t q = *(const u32x2_t*)(row + PC_CQ + lane * 4);
    const unsigned kv = *(const unsigned*)(row + PC_CKV + lane * 2);
    const unsigned short kr0 = row[PC_KR + (lane & 15)], kr1 = row[PC_KR + 16 + (lane & 15)];
    const float q0 = __uint_as_float(q.x << 16), q1 = __uint_as_float(q.x & 0xffff0000u), q2 = __uint_as_float(q.y << 16), q3 = __uint_as_float(q.y & 0xffff0000u);
    const float k0 = __uint_as_float(kv << 16), k1 = __uint_as_float(kv & 0xffff0000u);
    float sq = (q0 * q0 + q1 * q1) + (q2 * q2 + q3 * q3), sk = k0 * k0 + k1 * k1;
    sq = wsum(sq); sk = wsum(sk);
    const float iq = rsqrtf(sq * (1.0f / 256.0f) + 1e-6f), ik = rsqrtf(sk * (1.0f / 128.0f) + 1e-6f);
    u32x2_t oq; oq.x = pk2(q0 * iq * g4[0], q1 * iq * g4[1]); oq.y = pk2(q2 * iq * g4[2], q3 * iq * g4[3]);
    *(u32x2_t*)(cqn + (size_t)r * 256 + lane * 4) = oq;
    *(unsigned*)(ckvn + (size_t)r * 128 + lane * 2) = pk2(k0 * ik * g2.x, k1 * ik * g2.y);
    if (lane < 16) {
      const float2 c = cs[(r & (SEQ - 1)) * 16 + lane];
      const float x1 = bf2f(kr0), x2 = bf2f(kr1);
      krope[(size_t)r * 32 + lane] = f2bf(x1 * c.x - x2 * c.y); krope[(size_t)r * 32 + 16 + lane] = f2bf(x2 * c.x + x1 * c.y);
    }
  }
}
__device__ __forceinline__ void cmp_bias(const float* __restrict__ posk, const float* __restrict__ posv, const bf16_t* __restrict__ w1k, const bf16_t* __restrict__ w1v, float* __restrict__ cpos, int wave_id, int nwaves, int lane) {
  for (int o = wave_id; o < 512; o += nwaves) {
    const int tab = o >> 8, n = o & 255;
    const float* pos = tab ? posv : posk; const bf16_t* w = (tab ? w1v : w1k) + (size_t)n * 2048;
    float acc = 0.f;
#pragma unroll
    for (int i = 0; i < 4; ++i) { const int k = (i * 64 + lane) * 8;
      const u32x4 wv = *(const u32x4*)(w + k); const f32x4_t p0 = *(const f32x4_t*)(pos + k), p1 = *(const f32x4_t*)(pos + k + 4);
      acc += p0[0] * __uint_as_float(wv.x << 16) + p0[1] * __uint_as_float(wv.x & 0xffff0000u) + p0[2] * __uint_as_float(wv.y << 16) + p0[3] * __uint_as_float(wv.y & 0xffff0000u);
      acc += p1[0] * __uint_as_float(wv.z << 16) + p1[1] * __uint_as_float(wv.z & 0xffff0000u) + p1[2] * __uint_as_float(wv.w << 16) + p1[3] * __uint_as_float(wv.w & 0xffff0000u); }
    acc = wsum(acc);
    if (lane == 0) cpos[o] = acc;
  }
}
__device__ __forceinline__ void cmp_l2(const float* __restrict__ slab, const float* __restrict__ cpos, const bf16_t* __restrict__ w2t, bf16_t* __restrict__ outkc, int item, int lane) {
  const int r32 = lane & 31, hi = lane >> 5, m0 = item * 32;
  f32x16 acc0 = f32x16{}, acc1 = f32x16{};
  f32x4_t sa[2][8]; f32x4_t cp[2][2]; bf16x8 wb[2][2];
#define CMPL2_LOAD(buf, ks_) do { const int k_ = (ks_) * 16 + hi * 8; \
    cp[buf][0] = *(const f32x4_t*)(cpos + k_); cp[buf][1] = *(const f32x4_t*)(cpos + k_ + 4); \
    _Pragma("unroll") for (int sp = 0; sp < 4; ++sp) { const float* p_ = slab + ((size_t)sp * 2048 + m0 + r32) * 256 + k_; sa[buf][2 * sp] = *(const f32x4_t*)p_; sa[buf][2 * sp + 1] = *(const f32x4_t*)(p_ + 4); } \
    wb[buf][0] = *(const bf16x8*)(w2t + (size_t)r32 * 256 + k_); wb[buf][1] = *(const bf16x8*)(w2t + (size_t)(32 + r32) * 256 + k_); } while (0)
#define CMPL2_MMA(buf) do { f32x4_t a0 = cp[buf][0], a1 = cp[buf][1]; \
    _Pragma("unroll") for (int sp = 0; sp < 4; ++sp) { a0 += sa[buf][2 * sp]; a1 += sa[buf][2 * sp + 1]; } \
    u32x4 aw; aw.x = pk2(peer::gelu_fast(a0[0]), peer::gelu_fast(a0[1])); aw.y = pk2(peer::gelu_fast(a0[2]), peer::gelu_fast(a0[3])); \
    aw.z = pk2(peer::gelu_fast(a1[0]), peer::gelu_fast(a1[1])); aw.w = pk2(peer::gelu_fast(a1[2]), peer::gelu_fast(a1[3])); \
    const bf16x8 af = __builtin_bit_cast(bf16x8, aw); \
    acc0 = __builtin_amdgcn_mfma_f32_32x32x16_bf16(af, wb[buf][0], acc0, 0, 0, 0); acc1 = __builtin_amdgcn_mfma_f32_32x32x16_bf16(af, wb[buf][1], acc1, 0, 0, 0); } while (0)
  CMPL2_LOAD(0, 0);
#pragma unroll 1
  for (int ks = 0; ks < 16; ks += 2) {
    CMPL2_LOAD(1, ks + 1);
    CMPL2_MMA(0);
    if (ks + 2 < 16) CMPL2_LOAD(0, ks + 2);
    CMPL2_MMA(1);
  }
#undef CMPL2_LOAD
#undef CMPL2_MMA
#pragma unroll
  for (int r = 0; r < 16; ++r) {
    const int m = m0 + (r & 3) + 8 * (r >> 2) + 4 * hi;
    const bool pad = (m & 127) == 127;
    outkc[(size_t)m * 64 + r32] = pad ? (bf16_t)0 : f2bf(acc0[r]);
    outkc[(size_t)m * 64 + 32 + r32] = pad ? (bf16_t)0 : f2bf(acc1[r]);
  }
}
__device__ __forceinline__ void cmp_l2_w4(const float* __restrict__ slab, const float* __restrict__ cpos, const bf16_t* __restrict__ w2t, bf16_t* __restrict__ outkc, int item, int q, int lane,
                                          __attribute__((address_space(3))) float* red) {
  const int r32 = lane & 31, hi = lane >> 5, m0 = item * 32;
  f32x16 acc0 = f32x16{}, acc1 = f32x16{};
  f32x4_t sa[2][8]; f32x4_t cp[2][2]; bf16x8 wb[2][2];
#define CMPL2_LOAD(buf, ks_) do { const int k_ = (ks_) * 16 + hi * 8; \
    cp[buf][0] = *(const f32x4_t*)(cpos + k_); cp[buf][1] = *(const f32x4_t*)(cpos + k_ + 4); \
    _Pragma("unroll") for (int sp = 0; sp < 4; ++sp) { const float* p_ = slab + ((size_t)sp * 2048 + m0 + r32) * 256 + k_; sa[buf][2 * sp] = *(const f32x4_t*)p_; sa[buf][2 * sp + 1] = *(const f32x4_t*)(p_ + 4); } \
    wb[buf][0] = *(const bf16x8*)(w2t + (size_t)r32 * 256 + k_); wb[buf][1] = *(const bf16x8*)(w2t + (size_t)(32 + r32) * 256 + k_); } while (0)
#define CMPL2_MMA(buf) do { f32x4_t a0 = cp[buf][0], a1 = cp[buf][1]; \
    _Pragma("unroll") for (int sp = 0; sp < 4; ++sp) { a0 += sa[buf][2 * sp]; a1 += sa[buf][2 * sp + 1]; } \
    u32x4 aw; aw.x = pk2(peer::gelu_fast(a0[0]), peer::gelu_fast(a0[1])); aw.y = pk2(peer::gelu_fast(a0[2]), peer::gelu_fast(a0[3])); \
    aw.z = pk2(peer::gelu_fast(a1[0]), peer::gelu_fast(a1[1])); aw.w = pk2(peer::gelu_fast(a1[2]), peer::gelu_fast(a1[3])); \
    const bf16x8 af = __builtin_bit_cast(bf16x8, aw); \
    acc0 = __builtin_amdgcn_mfma_f32_32x32x16_bf16(af, wb[buf][0], acc0, 0, 0, 0); acc1 = __builtin_amdgcn_mfma_f32_32x32x16_bf16(af, wb[buf][1], acc1, 0, 0, 0); } while (0)
  const int k0 = q * 4;
  CMPL2_LOAD(0, k0); CMPL2_LOAD(1, k0 + 1);
  CMPL2_MMA(0); CMPL2_LOAD(0, k0 + 2);
  CMPL2_MMA(1); CMPL2_LOAD(1, k0 + 3);
  CMPL2_MMA(0); CMPL2_MMA(1);
#undef CMPL2_LOAD
#undef CMPL2_MMA
#pragma unroll
  for (int r = 0; r < 16; ++r) { red[(q * 32 + r) * 64 + lane] = acc0[r]; red[(q * 32 + 16 + r) * 64 + lane] = acc1[r]; }
  __syncthreads();
#pragma unroll
  for (int rr = 0; rr < 4; ++rr) {
    const int r = q * 4 + rr;
    float s0 = 0.f, s1 = 0.f;
#pragma unroll
    for (int p = 0; p < 4; ++p) { s0 += red[(p * 32 + r) * 64 + lane]; s1 += red[(p * 32 + 16 + r) * 64 + lane]; }
    const int m = m0 + rr + 8 * q + 4 * hi;
    const bool pad = (m & 127) == 127;
    outkc[(size_t)m * 64 + r32] = pad ? (bf16_t)0 : f2bf(s0);
    outkc[(size_t)m * 64 + 32 + r32] = pad ? (bf16_t)0 : f2bf(s1);
  }
}
}

#define XB_TMO      128
#define XB_XCNT(j)  (256  + 64 * (j))
#define XB_XSUB(j)  (1280 + 64 * (j))
#define XB_XGEN(j)  (2304 + 64 * (j))
#define XB_TOP      3328
#define XB_TOPGEN   3392
#define XCD_BAR_WORDS 3456
#define XB_SPIN_CAP (1u << 18)
#ifndef LAS
#define LAS __attribute__((address_space(3)))
#endif

__device__ __forceinline__ unsigned xb_ld(unsigned* p)              { return __hip_atomic_load(p, __ATOMIC_RELAXED, __HIP_MEMORY_SCOPE_AGENT); }
__device__ __forceinline__ unsigned xb_add(unsigned* p, unsigned v) { return __hip_atomic_fetch_add(p, v, __ATOMIC_RELAXED, __HIP_MEMORY_SCOPE_AGENT); }
__device__ __forceinline__ unsigned xb_xcc_id() { return (unsigned)__builtin_amdgcn_s_getreg((3 << 11) | 20) & 0xFu; }
#define XB_SPIN(cond, bar) do { unsigned _sp = 0; while (cond) { __builtin_amdgcn_s_sleep(1); \
    if ((++_sp & 255u) == 0u) { if (xb_ld(&(bar)[XB_TMO])) break; if (_sp > XB_SPIN_CAP) { atomicAdd(&(bar)[XB_TMO], 1u); break; } } } } while (0)

struct XcdBarrier {
    unsigned* bar; unsigned x;
    volatile LAS unsigned* st;
};

__device__ __forceinline__ XcdBarrier xcd_barrier_post(unsigned* bar, volatile LAS unsigned* st) {
    XcdBarrier b; b.bar = bar; b.x = xb_xcc_id(); b.st = st;
    if (threadIdx.x == 0) (void)xb_add(&bar[XB_XCNT(b.x)], 1u);
    return b;
}
__device__ __forceinline__ void xcd_barrier_complete(unsigned* bar, unsigned x, unsigned& nloc, unsigned& nx) {
    const unsigned G = gridDim.x * gridDim.y * gridDim.z;
    unsigned sum, cnt, mine, sp = 0u;
    for (;;) {
        sum = 0u; cnt = 0u; mine = 0u;
#pragma unroll
        for (unsigned j = 0; j < 16; ++j) { const unsigned c = xb_ld(&bar[XB_XCNT(j)]); sum += c; cnt += (c > 0u) ? 1u : 0u; mine = (j == x) ? c : mine; }
        if (sum == G) break;
        __builtin_amdgcn_s_sleep(1);
        if ((++sp & 255u) == 0u) { if (xb_ld(&bar[XB_TMO])) break; if (sp > XB_SPIN_CAP) { atomicAdd(&bar[XB_TMO], 1u); break; } }
    }
    nloc = mine > 0u ? mine : 1u; nx = cnt > 0u ? cnt : 1u;
}

__device__ __forceinline__ void xcd_barrier(const XcdBarrier& b) {
    asm volatile("s_waitcnt vmcnt(0)" ::: "memory");
    __syncthreads();
    if (threadIdx.x == 0) {
        unsigned* bar = b.bar;
        __builtin_amdgcn_s_waitcnt(0);
        unsigned nloc = b.st[0], nx = b.st[1];
        if (nloc == 0u) { xcd_barrier_complete(bar, b.x, nloc, nx); b.st[0] = nloc; b.st[1] = nx; }
        const unsigned old = xb_add(&bar[XB_XSUB(b.x)], 1u);
        const unsigned gen = old / nloc;
        if (old + 1u == (gen + 1u) * nloc) {
            __builtin_amdgcn_fence(__ATOMIC_RELEASE, "agent");
            asm volatile("s_waitcnt vmcnt(0)" ::: "memory");
            const unsigned og = xb_add(&bar[XB_TOP], 1u);
            const unsigned tg = og / nx;
            if (og + 1u == (tg + 1u) * nx) xb_add(&bar[XB_TOPGEN], 1u);
            else XB_SPIN(xb_ld(&bar[XB_TOPGEN]) == tg, bar);
            __builtin_amdgcn_fence(__ATOMIC_ACQUIRE, "agent");
            xb_add(&bar[XB_XGEN(b.x)], 1u);
            asm volatile("s_waitcnt vmcnt(0)" ::: "memory");
        } else {
            XB_SPIN(xb_ld(&bar[XB_XGEN(b.x)]) == gen, bar);
            __builtin_amdgcn_fence(__ATOMIC_ACQUIRE, "agent");
            asm volatile("s_waitcnt vmcnt(0)" ::: "memory");
        }
    }
    __syncthreads();
}

struct Args { const float* in[23]; float* out; char* ws; };
constexpr int LDS_BYTES = 131072 + 4096;

typedef const __attribute__((address_space(4))) Args* kargs_t;
DEV kargs_t KA() { kargs_t k = (kargs_t)__builtin_amdgcn_kernarg_segment_ptr(); asm volatile("" : "+s"(k)); return k; }
#define WSP(type, off) ((type*)(ws + (off)))

__global__ __launch_bounds__(NTHR, 2) void mega(Args a) {
  extern __shared__ __attribute__((aligned(16))) char lds[];
  PG8_LAS unsigned char* glds = (PG8_LAS unsigned char*)lds;
  const int bid = blockIdx.x, G = gridDim.x;
  (void)a;
  volatile LAS unsigned* bst = (volatile LAS unsigned*)((LAS char*)lds + LDS_BYTES - 16);
  if (threadIdx.x < 4) bst[threadIdx.x] = 0u;
  __syncthreads();
  XcdBarrier xbar; { kargs_t k = KA(); xbar = xcd_barrier_post((unsigned*)k->ws, bst); }

  { kargs_t k = KA(); char* ws = k->ws;
    const int wv0_ = threadIdx.x >> 6;
    if (wv0_ < 4) { const int lane_ = threadIdx.x & 63, wv_ = wv0_, gw_ = bid * 4 + wv_, nw_ = G * 4;
      __attribute__((address_space(3))) float* scr = (__attribute__((address_space(3))) float*)((__attribute__((address_space(3))) char*)lds + wv_ * 8448);
      constexpr int I_IN = 16 * 120, I_C1 = 32 * 8;
      for (int it = gw_; it < I_IN + 2 * I_C1; it += nw_) {
        int r = it;
        if (r < I_IN) { tr_item<1>(k->in[2], 1024, IN_COLS, WSP(bf16_t, WS_WIN), 120, 3840, scr, r, lane_); continue; } r -= I_IN;
        if (r < I_C1) { tr_item<0>(k->in[5], 2048, 256, WSP(bf16_t, WS_CKW1), 8, 256, scr, r, lane_); continue; } r -= I_C1;
        tr_item<0>(k->in[7], 2048, 256, WSP(bf16_t, WS_CVW1), 8, 256, scr, r, lane_);
      }
      for (int i = gw_ * 64 + lane_; i < 16 * 128 * 64; i += nw_ * 64) WSP(bf16_t, WS_SUBK)[i] = f2bf(k->in[18][i]);
      for (int i = gw_ * 64 + lane_; i < SEQ * 16; i += nw_ * 64) rope_entry(WSP(float2, WS_ROPE), i);
    } else ph_rms1024<false>(k->in[0], k->in[1], WSP(bf16_t, WS_XN), T, nullptr, nullptr, bid * 4 + (wv0_ - 4), G * 4); }
  xcd_barrier(xbar);
  { kargs_t k = KA(); char* ws = k->ws;
    pg8::Gemm g{WSP(bf16_t, WS_XN), WSP(bf16_t, WS_WIN), T, 3840, 1024}; pg8::StaticOrder S; S.init(T, 3840, G, bid);
    pg8::EpiInProjF E{WSP(bf16_t, WS_PROJ), WSP(unsigned char, WS_GATES)};
    pg8::gemm_phase<pg8::EpiInProjF, pg8::StaticOrder, PG8_ALIGN, PG8_SP2>(glds, g, S, E);
    {
      const bool some = (G == 256); const int nb = some ? 64 : G, b0 = some ? bid - 192 : bid;
      if (b0 >= 0) {
        const int lane_ = threadIdx.x & 63, wv_ = threadIdx.x >> 6;
        __attribute__((address_space(3))) float* scr = (__attribute__((address_space(3))) float*)((__attribute__((address_space(3))) char*)lds + wv_ * 8448);
        constexpr int I_BR = 8 * 32, I_SQ = 16 * 32, I_C2 = 4 * 8, I_UQ = 4 * 24, I_UKV = 2 * 32;
        for (int it = b0 * NWV + wv_; it < 2 * I_BR + 2 * I_SQ + 2 * I_C2 + I_UQ + I_UKV; it += nb * NWV) {
          int r = it;
          if (r < I_UQ) { tr_item<0>(k->in[11], 256, 768, WSP(bf16_t, WS_UQ), 24, 768, scr, r, lane_); continue; } r -= I_UQ;
          if (r < I_UKV) { tr_item<0>(k->in[12], 128, 1024, WSP(bf16_t, WS_UKV), 32, 1024, scr, r, lane_); continue; } r -= I_UKV;
          if (r < I_C2) { tr_item<0>(k->in[6], 256, 64, WSP(bf16_t, WS_CKW2), 8, 64, scr, r, lane_); continue; } r -= I_C2;
          if (r < I_C2) { tr_item<0>(k->in[8], 256, 64, WSP(bf16_t, WS_CVW2), 8, 64, scr, r, lane_); continue; } r -= I_C2;
          if (r < I_BR) { tr_item<0>(k->in[13], 512, 1024, WSP(bf16_t, WS_WBN), 32, 1024, scr, r, lane_, 1024, 0); continue; } r -= I_BR;
          if (r < I_BR) { tr_item<0>(k->in[14], 512, 1024, WSP(bf16_t, WS_WBN), 32, 1024, scr, r, lane_, 1024, 512); continue; } r -= I_BR;
          if (r < I_SQ) { tr_item<0>(k->in[15], 1024, 1024, WSP(bf16_t, WS_WOUT), 32, 1024, scr, r, lane_); continue; } r -= I_SQ;
          tr_item<0>(k->in[17], 1024, 1024, WSP(bf16_t, WS_WQ), 32, 1024, scr, r, lane_);
        } } } }
  xcd_barrier(xbar);
  { kargs_t k = KA(); char* ws = k->ws;
    const int lane_ = threadIdx.x & 63, wv_ = threadIdx.x >> 6;
    if (G >= 128 && bid < 64) {
      const int tab = bid >> 5;
      pg8::Gemm g{WSP(bf16_t, WS_PROJ) + PC_KV + tab * 128, WSP(bf16_t, tab ? WS_CVW1 : WS_CKW1), 2048, 1024, 512};
      g.pitchA = 16u * PROJ_LD * 2u; g.kstepA = PROJ_LD * 2u; g.hstepA = 128; g.tA_pm = (size_t)SEQ * PROJ_LD * 2; g.tA_pn = (size_t)8 * PROJ_LD * 2;
      g.pitchB = 4096u; g.kstepB = 128u; g.hstepB = (size_t)128 * 4096; g.tB_pn = 1024; g.nt = 8;
      pg8::StaticOrder S; S.init(2048, 1024, 32, bid & 31);
      pg8::EpiSlabF E{WSP(float, WS_SLAB) + (size_t)tab * 4 * 2048 * 256};
      pg8::gemm_phase<pg8::EpiSlabF, pg8::StaticOrder, PG8_ALIGN, PG8_SP2>(glds, g, S, E);
    } else {
      const int nb = (G >= 128) ? G - 64 : G, b0 = (G >= 128) ? bid - 64 : bid;
      prep::cmp_bias(k->in[3], k->in[4], WSP(bf16_t, WS_CKW1), WSP(bf16_t, WS_CVW1), WSP(float, WS_CPOS), b0 * NWV + wv_, nb * NWV, lane_);
      prep::latent_rows(WSP(bf16_t, WS_PROJ), k->in[9], k->in[10], WSP(float2, WS_ROPE), WSP(bf16_t, WS_CQN), WSP(bf16_t, WS_CKVN), WSP(bf16_t, WS_KROPE), b0 * NWV + wv_, nb * NWV, lane_);
    } }
  xcd_barrier(xbar);
  if (G == 256 && ((bid + 64) & 255) >= 192) {
    kargs_t k = KA(); char* ws = k->ws;
    const int lane_ = threadIdx.x & 63, wv_ = threadIdx.x >> 6;
    { const int it = (((bid + 64) & 255) - 192) * 2 + (wv_ >> 2); const int tab = it >> 6;
      prep::cmp_l2_w4(WSP(float, WS_SLAB) + (size_t)tab * 4 * 2048 * 256, WSP(float, WS_CPOS) + tab * 256, WSP(bf16_t, tab ? WS_CVW2 : WS_CKW2), WSP(bf16_t, tab ? WS_VC : WS_KC), it & 63, wv_ & 3, lane_,
                      (__attribute__((address_space(3))) float*)lds + (wv_ >> 2) * 8192); }
    __syncthreads();
  } else if (G != 256) {
    kargs_t k = KA(); char* ws = k->ws;
    const int lane_ = threadIdx.x & 63, wv_ = threadIdx.x >> 6;
    for (int it = bid * NWV + wv_; it < 128; it += G * NWV) { const int tab = it >> 6;
      prep::cmp_l2(WSP(float, WS_SLAB) + (size_t)tab * 4 * 2048 * 256, WSP(float, WS_CPOS) + tab * 256, WSP(bf16_t, tab ? WS_CVW2 : WS_CKW2), WSP(bf16_t, tab ? WS_VC : WS_KC), it & 63, lane_); }
  }
  { kargs_t k = KA(); char* ws = k->ws;
    pg8::Gemm g{WSP(bf16_t, WS_CQN), WSP(bf16_t, WS_UQ), T, 768, 256}; pg8::StaticOrder S; S.init(T, 768, G, (bid + 64) & 255);
    pg8::EpiMlaQF E{WSP(bf16_t, WS_MLAQ), WSP(float2, WS_ROPE)};
    pg8::gemm_phase<pg8::EpiMlaQF, pg8::StaticOrder, PG8_ALIGN, PG8_SP2>(glds, g, S, E); }
  { kargs_t k = KA(); char* ws = k->ws;
    pg8::Gemm g{WSP(bf16_t, WS_CKVN), WSP(bf16_t, WS_UKV), T, 1024, 128}; pg8::StaticOrder S; S.init(T, 1024, G, bid);
    pg8::EpiBf16<0> E{WSP(bf16_t, WS_MLAKV), 1024, nullptr, 0, 0, 1.f};
    pg8::gemm_phase<pg8::EpiBf16<0>, pg8::StaticOrder, PG8_ALIGN, PG8_SP2>(glds, g, S, E); }
  xcd_barrier(xbar);
  { kargs_t k = KA(); char* ws = k->ws;
    att::attn_phase(WSP(bf16_t, WS_PROJ), WSP(bf16_t, WS_KC), WSP(bf16_t, WS_VC), k->in[21], WSP(bf16_t, WS_ONSA),
                    WSP(bf16_t, WS_MLAQ), WSP(bf16_t, WS_MLAKV), WSP(bf16_t, WS_KROPE), WSP(bf16_t, WS_ONSA), (att::lptr)lds); }
  xcd_barrier(xbar);
  { kargs_t k = KA(); char* ws = k->ws;
    pg8::Gemm g{WSP(bf16_t, WS_ONSA), WSP(bf16_t, WS_WBN), T, 1024, 1024}; pg8::StaticOrder S; S.init(T, 1024, G, bid);
    pg8::EpiMergeFusedF E{WSP(unsigned char, WS_GATES), WSP(bf16_t, WS_MERGED)};
    pg8::gemm_phase<pg8::EpiMergeFusedF, pg8::StaticOrder, PG8_ALIGN, PG8_SP2>(glds, g, S, E); }
  xcd_barrier(xbar);
  { kargs_t k = KA(); char* ws = k->ws;
    pg8::Gemm g{WSP(bf16_t, WS_MERGED), WSP(bf16_t, WS_WOUT), T, 1024, 1024}; pg8::StaticOrder S; S.init(T, 1024, G, bid);
    pg8::EpiBf16<0> E{WSP(bf16_t, WS_OB), 1024, nullptr, 0, 0, 1.f};
    pg8::gemm_phase<pg8::EpiBf16<0>, pg8::StaticOrder, PG8_ALIGN, PG8_SP2>(glds, g, S, E); }
  xcd_barrier(xbar);
  { kargs_t k = KA(); char* ws = k->ws; ph_rms1024<true>(k->in[0], k->in[16], WSP(bf16_t, WS_HN), T, WSP(unsigned, WS_HN8), WSP(float, WS_SH), -1, 0, WSP(bf16_t, WS_OB));
    peer::conv_tables(k->in[19], k->in[20], WSP(unsigned, WS_U8), WSP(float, WS_SU), WSP(unsigned, WS_V8)); }
  xcd_barrier(xbar);
  { kargs_t k = KA(); char* ws = k->ws;
    pg8::Gemm g{WSP(bf16_t, WS_HN), WSP(bf16_t, WS_WQ), T, 1024, 1024}; pg8::StaticOrder S; S.init(T, 1024, G, bid);
    pg8::EpiBf16<0> E{WSP(bf16_t, WS_PQ), 1024, nullptr, 0, 0, 1.f};
    pg8::gemm_phase<pg8::EpiBf16<0>, pg8::StaticOrder, PG8_ALIGN, PG8_SP2>(glds, g, S, E); }
  __builtin_amdgcn_fence(__ATOMIC_RELEASE, "workgroup"); __syncthreads(); __builtin_amdgcn_fence(__ATOMIC_ACQUIRE, "workgroup");
  { kargs_t k = KA(); char* ws = k->ws; pg8::StaticOrder S; S.init(T, 1024, G, bid); pg8::Unit u;
    if (S.next(0, u)) peer::route_phase(WSP(bf16_t, WS_PQ), WSP(bf16_t, WS_SUBK), WSP(unsigned, WS_PIDX), (__attribute__((address_space(3))) char*)lds, u.pm, u.pn); }
  xcd_barrier(xbar);
  { kargs_t k = KA(); char* ws = k->ws;
    peer::experts_sliced<0>(WSP(unsigned, WS_PIDX), WSP(unsigned, WS_HN8), WSP(float, WS_SH), WSP(unsigned, WS_U8), WSP(float, WS_SU), WSP(float, WS_CO), WSP(unsigned, WS_V8), k->out, WSP(float, WS_SSQ),
                            (unsigned*)ws + CTL_QA, (__attribute__((address_space(3))) char*)lds); }
  xcd_barrier(xbar);
  { kargs_t k = KA(); char* ws = k->ws;
    peer::experts_sliced<1>(WSP(unsigned, WS_PIDX), WSP(unsigned, WS_HN8), WSP(float, WS_SH), WSP(unsigned, WS_U8), WSP(float, WS_SU), WSP(float, WS_CO), WSP(unsigned, WS_V8), (float*)WSP(bf16_t, WS_ZB), WSP(float, WS_SSQ),
                            (unsigned*)ws + CTL_QB, (__attribute__((address_space(3))) char*)lds, k->in[0], WSP(bf16_t, WS_OB)); }
  xcd_barrier(xbar);
  { kargs_t k = KA(); char* ws = k->ws; peer::experts_norm(WSP(float, WS_SSQ), k->in[22], WSP(bf16_t, WS_ZB), k->out); }
}

extern "C" void kernel_launch(void* const* d_in, const int* in_sizes, int n_in, void* d_out, int out_size, void* d_ws, size_t ws_size, hipStream_t stream) {
  if (n_in != 23 || ws_size < 256 * MiB) { fprintf(stderr, "kernel_launch: unexpected n_in %d / ws_size %zu\n", n_in, ws_size); return; }
  static int grid_blocks = 0;
  if (!grid_blocks) {
    int dev = 0, cus = 0, per_cu = 0;
    (void)hipGetDevice(&dev);
    (void)hipDeviceGetAttribute(&cus, hipDeviceAttributeMultiprocessorCount, dev);
    if (hipFuncSetAttribute((const void*)mega, hipFuncAttributeMaxDynamicSharedMemorySize, LDS_BYTES) != hipSuccess) fprintf(stderr, "kernel_launch: hipFuncSetAttribute failed\n");
    (void)hipOccupancyMaxActiveBlocksPerMultiprocessor(&per_cu, (const void*)mega, NTHR, LDS_BYTES);
    if (per_cu < 1) { fprintf(stderr, "kernel_launch: occupancy query returned %d\n", per_cu); per_cu = 1; }
    if (per_cu > 2) per_cu = 2;
    grid_blocks = cus * per_cu;
    fprintf(stderr, "kernel_launch: cus %d per_cu %d grid %d ws %zu\n", cus, per_cu, grid_blocks, ws_size);
  }
  if (hipMemsetAsync(d_ws, 0, 65536, stream) != hipSuccess) fprintf(stderr, "kernel_launch: hipMemsetAsync failed\n");
  Args a{};
  for (int i = 0; i < 23; ++i) a.in[i] = (const float*)d_in[i];
  a.out = (float*)d_out; a.ws = (char*)d_ws;
  void* args[] = {&a};
  hipError_t e = hipLaunchCooperativeKernel((const void*)mega, dim3(grid_blocks), dim3(NTHR), args, LDS_BYTES, stream);
  if (e != hipSuccess) fprintf(stderr, "cooperative launch failed: %s (grid %d)\n", hipGetErrorString(e), grid_blocks);
}
```

```cpp
#include <hip/hip_runtime.h>
#include <stdint.h>
#include <cstdio>
#include <hip/hip_cooperative_groups.h>
namespace cg = cooperative_groups;

typedef unsigned short bf16_t;
#define DEV __device__ __forceinline__

constexpr int BATCH = 8, SEQ = 2048, DM = 1024, T = BATCH * SEQ;
constexpr int IN_COLS = 3768;
constexpr int PROJ_LD = 1792;
constexpr int PC_Q = 0, PC_KV = 512, PC_CQ = 1280, PC_CKV = 1536, PC_KR = 1664, PC_GATE = 1696;
constexpr int NC = 127;
constexpr size_t MiB = 1u << 20;

constexpr size_t WS_WIN = 1 * MiB;
constexpr size_t WS_WBN = 9 * MiB;
constexpr size_t WS_WBM = 10 * MiB;
constexpr size_t WS_WOUT = 11 * MiB;
constexpr size_t WS_WQ = 13 * MiB;
constexpr size_t WS_CKW1 = 15 * MiB;
constexpr size_t WS_CVW1 = 16 * MiB;
constexpr size_t WS_CKW2 = 17 * MiB;
constexpr size_t WS_CVW2 = 17 * MiB + 128 * 1024;
constexpr size_t WS_UQ = 17 * MiB + 256 * 1024;
constexpr size_t WS_UKV = 17 * MiB + 768 * 1024;
constexpr size_t WS_SUBK = 18 * MiB;
constexpr size_t WS_ROPE = 18 * MiB + 512 * 1024;
constexpr size_t WS_GATES = 20 * MiB;
constexpr size_t WS_PQ = 20 * MiB;
constexpr size_t WS_ZB = 20 * MiB;
constexpr size_t WS_OB = 52 * MiB;
constexpr size_t WS_PROJ = 84 * MiB;
constexpr size_t WS_MERGED = 84 * MiB;
constexpr size_t WS_PIDX = 84 * MiB;
constexpr size_t WS_U8 = 172 * MiB;
constexpr size_t WS_V8 = 188 * MiB;
constexpr size_t WS_SU = 204 * MiB;
constexpr size_t WS_SH = 204 * MiB + 65536;
constexpr size_t WS_HN8 = 205 * MiB;
constexpr size_t WS_CO = 221 * MiB;
constexpr size_t WS_SSQ = 229 * MiB;
constexpr int CTL_QA = 4096, CTL_QB = 4096 + 512;
constexpr size_t WS_PW = 92 * MiB;
constexpr size_t WS_XN = 140 * MiB;
constexpr size_t WS_MLAKV = 140 * MiB;
constexpr size_t WS_HN = 140 * MiB;
constexpr size_t WS_MLAQ = 172 * MiB;
constexpr size_t WS_KROPE = 196 * MiB;
constexpr size_t WS_KC = 197 * MiB;
constexpr size_t WS_VC = 197 * MiB + 512 * 1024;
constexpr size_t WS_ONSA = 198 * MiB;
constexpr size_t WS_OMLA = 214 * MiB;
constexpr size_t WS_SLAB = 198 * MiB;
constexpr size_t WS_CPOS = 18 * MiB + 768 * 1024;
constexpr size_t WS_CA = 198 * MiB;
constexpr size_t WS_HID = 206 * MiB;
constexpr size_t WS_HID2 = 207 * MiB;
constexpr size_t WS_CA2 = 214 * MiB;
constexpr size_t WS_CQN = 230 * MiB;
constexpr size_t WS_CKVN = 238 * MiB;
constexpr size_t WS_OCMP = 230 * MiB;
constexpr size_t WS_SEL = 246 * MiB;

__device__ const unsigned char T5B[128] = {
  0, 1, 2, 3, 4, 5, 6, 7, 8, 9, 10, 11, 12, 13, 14, 15, 16, 16, 16, 17, 17, 18, 18, 18, 19, 19, 19, 20, 20, 20, 20, 21,
  21, 21, 21, 22, 22, 22, 22, 22, 23, 23, 23, 23, 23, 23, 24, 24, 24, 24, 24, 24, 25, 25, 25, 25, 25, 25, 25, 26, 26, 26, 26, 26,
  26, 26, 26, 27, 27, 27, 27, 27, 27, 27, 27, 27, 27, 28, 28, 28, 28, 28, 28, 28, 28, 28, 28, 29, 29, 29, 29, 29, 29, 29, 29, 29,
  29, 29, 29, 30, 30, 30, 30, 30, 30, 30, 30, 30, 30, 30, 30, 30, 30, 31, 31, 31, 31, 31, 31, 31, 31, 31, 31, 31, 31, 31, 31, 31};

DEV float bf2f(bf16_t v) { return __uint_as_float(((unsigned)v) << 16); }
DEV bf16_t f2bf(float f) { unsigned u = __float_as_uint(f); u += 0x7fffu + ((u >> 16) & 1u); return (bf16_t)(u >> 16); }
template <int CTRL> DEV int dpp_i(int v) { return __builtin_amdgcn_update_dpp(0, v, CTRL, 0xF, 0xF, true); }
template <int CTRL> DEV float dpp_f(float v) { return __uint_as_float((unsigned)__builtin_amdgcn_update_dpp(0, (int)__float_as_uint(v), CTRL, 0xF, 0xF, true)); }
DEV int sum16_i(int v) { v += dpp_i<0xB1>(v); v += dpp_i<0x4E>(v); v += dpp_i<0x141>(v); v += dpp_i<0x140>(v); return v; }
DEV float sum16_f(float v) { v += dpp_f<0xB1>(v); v += dpp_f<0x4E>(v); v += dpp_f<0x141>(v); v += dpp_f<0x140>(v); return v; }
DEV float max16_f(float v) { v = fmaxf(v, dpp_f<0xB1>(v)); v = fmaxf(v, dpp_f<0x4E>(v)); v = fmaxf(v, dpp_f<0x141>(v)); v = fmaxf(v, dpp_f<0x140>(v)); return v; }
DEV float rl_f(float v, int l) { return __uint_as_float((unsigned)__builtin_amdgcn_readlane((int)__float_as_uint(v), l)); }
DEV float wsum(float v) { v = sum16_f(v); return (rl_f(v, 0) + rl_f(v, 16)) + (rl_f(v, 32) + rl_f(v, 48)); }
DEV float wmaxf(float v) { v = max16_f(v); return fmaxf(fmaxf(rl_f(v, 0), rl_f(v, 16)), fmaxf(rl_f(v, 32), rl_f(v, 48))); }
DEV float sigmoidf_(float x) { return 1.0f / (1.0f + expf(-x)); }
DEV float gelu_exact(float x) { return 0.5f * x * (1.0f + erff(x * 0.70710678118654752f)); }
DEV void wave_lds_sync() { asm volatile("s_waitcnt lgkmcnt(0)" ::: "memory"); __builtin_amdgcn_wave_barrier(); asm volatile("" ::: "memory"); }
DEV float t5bias(const float* t5, int head, int dist) { int d = dist < 127 ? dist : 127; d = d < 0 ? 0 : d; return t5[(int)T5B[d] * 8 + head]; }


namespace pg8 {
#define PG8_LAS __attribute__((address_space(3)))
typedef unsigned short bf16_t;
typedef short bf16x8 __attribute__((ext_vector_type(8)));
typedef float f32x4 __attribute__((ext_vector_type(4)));
typedef unsigned u32x4 __attribute__((ext_vector_type(4)));
constexpr int BM = 256, BK = 64, HALF = 128, HTB = HALF * BK * 2  , STAGE_BYTES = 8 * HTB, NXCD = 8, WGM = 8;

__host__ __device__ __forceinline__ int lds_byte(int r, int c) { const int st = (r >> 4) * 2 + (c >> 5), rr = r & 15, cc = c & 31, ob = rr * 64 + cc * 2; return st * 1024 + (ob ^ (((ob >> 9) & 1) << 5)); }
__host__ __device__ __forceinline__ void stage_rc(int b, int& R, int& C) { const int st = b / 1024, sb = b % 1024, swz = sb ^ (((sb >> 9) & 1) << 5); R = (st >> 1) * 16 + swz / 64; C = (st & 1) * 32 + (swz % 64) / 2; }
__host__ __device__ __forceinline__ int perm32(int rho) { const int n = rho >> 4, i = rho & 15; return 8 * (i >> 2) + 4 * n + (i & 3); }

struct Unit { int pm, pn; };
struct Gemm { const bf16_t* A; const bf16_t* Bt; int M, N, K;
    unsigned pitchA = 0, pitchB = 0, kstepA = 0, kstepB = 0; size_t hstepA = 0, hstepB = 0, tA_pm = 0, tA_pn = 0, tB_pn = 0; int nt = 0; };

struct StaticOrder {
    int nM, nN, nwg, G, c;
    __host__ __device__ void init(int M, int N, int G_, int c_) { nM = M / BM; nN = N / BM; nwg = nM * nN; G = G_; c = c_; }
    __host__ __device__ __forceinline__ bool next(int i, Unit& u) const {
        const long L = (long)i * G + c; if (L >= nwg) return false;
        int wgid = (int)L; { const int q = nwg / NXCD, r = nwg % NXCD, xcd = wgid % NXCD, off = wgid / NXCD; wgid = (xcd < r ? xcd * (q + 1) : r * (q + 1) + (xcd - r) * q) + off; }
        const int nig = WGM * nN, gid = wgid / nig, fm = gid * WGM, gsz = (nM - fm) < WGM ? (nM - fm) : WGM;
        u.pm = fm + ((wgid % nig) % gsz); u.pn = (wgid % nig) / gsz; return true;
    }
    __device__ __forceinline__ void a_ready(const Unit&) const {}
    __device__ __forceinline__ void done(const Unit&) const {}
};

__device__ __forceinline__ unsigned cvt_pk_bf16(float lo, float hi) { unsigned r; asm volatile("v_cvt_pk_bf16_f32 %0, %1, %2" : "=v"(r) : "v"(lo), "v"(hi)); return r; }
typedef float f32x2 __attribute__((ext_vector_type(2)));
__device__ __forceinline__ f32x2 gelu_pk(f32x2 v) {
    const f32x2 av = __builtin_elementwise_abs(v), d = av * 0.2316418882f + 1.0f;
    f32x2 t; t.x = __builtin_amdgcn_rcpf(d.x); t.y = __builtin_amdgcn_rcpf(d.y);
    f32x2 q = t * 0.5307027145f + (-0.7265760135f); q = q * t + 0.7107068705f; q = q * t + (-0.142248368f); q = q * t + 0.127414796f; q = q * t;
    const f32x2 s = (v * v) * (-0.72134752044f);
    f32x2 e; e.x = __builtin_amdgcn_exp2f(s.x); e.y = __builtin_amdgcn_exp2f(s.y);
    const f32x2 m = v * (q * e), r = v - m;
    f32x2 o; o.x = v.x < 0.f ? m.x : r.x; o.y = v.y < 0.f ? m.y : r.y; return o;
}

template <int ACT  > struct EpiBf16 {
    static constexpr bool PERM = true, AFTER_DRAIN = false, MIDK = false; static_assert(ACT == 0 || ACT == 1, "EpiBf16: ACT is 0 (none) or 1 (gelu_pk)");
    bf16_t* O; int ldc; const float* bias; int split_cols; size_t split_stride; float scale0;
    __device__ __forceinline__ void operator()(const f32x4 (&acc)[2][2][4][2], const Unit& u, int wr, int wc, int fr, int fq) const {
        const int row0 = u.pm * BM + wr * 64 + fr; int colt = u.pn * BM; bf16_t* base = O;
        float sc = 1.f; if (split_cols) { const int t = colt / split_cols; base += (size_t)t * split_stride; colt -= t * split_cols; if (t == 0) sc = scale0; }
        const int col0 = colt + wc * 32 + 8 * fq, bcol0 = u.pn * BM + wc * 32 + 8 * fq;
        f32x4 bv[2][2];
#pragma unroll
        for (int bj = 0; bj < 2; ++bj)
#pragma unroll
            for (int n = 0; n < 2; ++n) bv[bj][n] = bias ? *(const f32x4*)(bias + bcol0 + bj * HALF + 4 * n) : (f32x4){0.f, 0.f, 0.f, 0.f};
#pragma unroll
        for (int ai = 0; ai < 2; ++ai)
#pragma unroll
            for (int m = 0; m < 4; ++m) { bf16_t* rowp = base + (size_t)(row0 + ai * HALF + m * 16) * ldc + col0;
#pragma unroll
                for (int bj = 0; bj < 2; ++bj) { f32x4 v0 = acc[ai][bj][m][0] + bv[bj][0], v1 = acc[ai][bj][m][1] + bv[bj][1];
                    if (ACT == 1) { f32x2 a = gelu_pk((f32x2){v0[0], v0[1]}), b = gelu_pk((f32x2){v0[2], v0[3]}), c = gelu_pk((f32x2){v1[0], v1[1]}), d = gelu_pk((f32x2){v1[2], v1[3]});
                        v0 = (f32x4){a.x, a.y, b.x, b.y}; v1 = (f32x4){c.x, c.y, d.x, d.y}; }
                    v0 = v0 * sc; v1 = v1 * sc; u32x4 w; w.x = cvt_pk_bf16(v0[0], v0[1]); w.y = cvt_pk_bf16(v0[2], v0[3]); w.z = cvt_pk_bf16(v1[0], v1[1]); w.w = cvt_pk_bf16(v1[2], v1[3]);
                    *(u32x4*)(rowp + bj * HALF) = w; } }
    }
};

struct PanelStats {
    unsigned* xbuf;
    unsigned* cnt;
    unsigned* tmo;
    int ntn; float eps;
    unsigned code;
    __device__ __forceinline__ bool run(const f32x4 (&v)[2][2][4][2], const Unit& u, int wr, int wc, int fr, int fq, PG8_LAS unsigned char* lds, int wid, int lane) const {
        typedef float f32x2v __attribute__((ext_vector_type(2)));
        PG8_LAS f32x2v* P = (PG8_LAS f32x2v*)lds;
        PG8_LAS f32x2v* S = (PG8_LAS f32x2v*)(lds + 8192);
        PG8_LAS unsigned* flag = (PG8_LAS unsigned*)(lds + 8192 + 2048);
#pragma unroll
        for (int ai = 0; ai < 2; ++ai)
#pragma unroll
            for (int m = 0; m < 4; ++m) {
                float s = 0.f;
#pragma unroll
                for (int bj = 0; bj < 2; ++bj)
#pragma unroll
                    for (int n = 0; n < 2; ++n) { const f32x4 x = v[ai][bj][m][n]; s += (x[0] + x[1]) + (x[2] + x[3]); }
                s += __shfl_xor(s, 16); s += __shfl_xor(s, 32);
                const float mw = s * (1.0f / 64.0f); float q = 0.f;
#pragma unroll
                for (int bj = 0; bj < 2; ++bj)
#pragma unroll
                    for (int n = 0; n < 2; ++n) { const f32x4 d = v[ai][bj][m][n] - mw; q += (d[0] * d[0] + d[1] * d[1]) + (d[2] * d[2] + d[3] * d[3]); }
                q += __shfl_xor(q, 16); q += __shfl_xor(q, 32);
                if (fq == 0) P[(ai * HALF + wr * 64 + m * 16 + fr) * 4 + wc] = (f32x2v){mw, q};
            }
        asm volatile("s_waitcnt lgkmcnt(0)" ::: "memory"); __builtin_amdgcn_s_barrier(); asm volatile("" ::: "memory");
#if defined(BROKEN_EXCHANGE_NO_WAIT)
#warning BROKEN CONTROL BUILD: the row-statistics exchange does not wait; results are wrong by design
        if (blockIdx.x >= 64) { const long long t0_ = clock64(); while (clock64() - t0_ < 60000) __builtin_amdgcn_s_sleep(8); }
#endif
        const int row = wid * 32 + (lane & 31);
        if (lane < 32) {
            const f32x2v a = P[row * 4 + 0], b = P[row * 4 + 1], c = P[row * 4 + 2], d = P[row * 4 + 3];
            const float mt = (a.x + b.x + c.x + d.x) * 0.25f;
            const float da = a.x - mt, db = b.x - mt, dc = c.x - mt, dd = d.x - mt;
            const float m2 = (a.y + b.y) + (c.y + d.y) + 64.0f * ((da * da + db * db) + (dc * dc + dd * dd));
            unsigned long long* slot = (unsigned long long*)xbuf + ((size_t)(u.pm * BM + row) * 4 + u.pn);
            __hip_atomic_store(slot, ((unsigned long long)__float_as_uint(m2) << 32) | __float_as_uint(mt), __ATOMIC_RELAXED, __HIP_MEMORY_SCOPE_AGENT);
        }
        asm volatile("s_waitcnt vmcnt(0)" ::: "memory");
        if (lane == 0) __hip_atomic_fetch_add(cnt + 64 * u.pm, 1u, __ATOMIC_RELAXED, __HIP_MEMORY_SCOPE_AGENT);
        if (wid == 0) {
            bool dead = false; const unsigned long long t0 = __builtin_amdgcn_s_memrealtime(); const unsigned want = 8u * (unsigned)ntn;
            for (;;) {
#if defined(BROKEN_EXCHANGE_NO_WAIT)
                break;
#endif
                if ((unsigned)__builtin_amdgcn_readfirstlane(__hip_atomic_load(cnt + 64 * u.pm, __ATOMIC_RELAXED, __HIP_MEMORY_SCOPE_AGENT)) >= want) break;
                if (__builtin_amdgcn_s_memrealtime() - t0 > 2000000ull) {
                    if (lane == 0) { unsigned expect = 0u; __hip_atomic_compare_exchange_strong(tmo + 1, &expect, code | (unsigned)(u.pm & 0xff), __ATOMIC_RELAXED, __ATOMIC_RELAXED, __HIP_MEMORY_SCOPE_AGENT);
                                     __hip_atomic_store(tmo, 1u, __ATOMIC_RELAXED, __HIP_MEMORY_SCOPE_AGENT); }
                    dead = true; break; }
                __builtin_amdgcn_s_sleep(2);
            }
            __builtin_amdgcn_fence(__ATOMIC_ACQUIRE, "agent");
            if (lane == 0) flag[0] = dead ? 1u : 0u;
        }
        asm volatile("s_waitcnt vmcnt(0) lgkmcnt(0)" ::: "memory"); __builtin_amdgcn_s_barrier(); asm volatile("" ::: "memory");
        const bool bad = flag[0] != 0u;
        if (lane < 32) {
            const unsigned long long* slot = (const unsigned long long*)xbuf + (size_t)(u.pm * BM + row) * 4; float mt[4], m2[4]; float ms = 0.f;
#pragma unroll
            for (int t = 0; t < 4; ++t) { if (t < ntn) { const unsigned long long w = __hip_atomic_load(slot + t, __ATOMIC_RELAXED, __HIP_MEMORY_SCOPE_AGENT); mt[t] = __uint_as_float((unsigned)w); m2[t] = __uint_as_float((unsigned)(w >> 32)); } else { mt[t] = 0.f; m2[t] = 0.f; } ms += mt[t]; }
            const float mean = ms / (float)ntn; float q = 0.f;
#pragma unroll
            for (int t = 0; t < 4; ++t) if (t < ntn) { const float dm = mt[t] - mean; q += m2[t] + 256.0f * dm * dm; }
            S[row] = (f32x2v){mean, 1.0f / sqrtf(q / (256.0f * (float)ntn) + eps)};
        }
        asm volatile("s_waitcnt lgkmcnt(0)" ::: "memory"); __builtin_amdgcn_s_barrier(); asm volatile("" ::: "memory");
        return bad;
    }
};
struct EpiLnRes {
    static constexpr bool PERM = false, AFTER_DRAIN = true, MIDK = false;
    const float* base; float* out; int ldc; const float* bias; PanelStats st; unsigned poison;
    __device__ __forceinline__ void fused(f32x4 (&acc)[2][2][4][2], const Unit& u, int wr, int wc, int fr, int fq, PG8_LAS unsigned char* lds, int wid, int lane) const {
        typedef float f32x2v __attribute__((ext_vector_type(2)));
        const PG8_LAS f32x2v* S = (const PG8_LAS f32x2v*)(lds + 8192);
        const int col0 = u.pn * BM + wc * 32 + 4 * fq;
#pragma unroll
        for (int bj = 0; bj < 2; ++bj)
#pragma unroll
            for (int n = 0; n < 2; ++n) { const f32x4 bv = bias ? *(const f32x4*)(bias + col0 + bj * HALF + n * 16) : (f32x4){0.f, 0.f, 0.f, 0.f};
#pragma unroll
                for (int ai = 0; ai < 2; ++ai)
#pragma unroll
                    for (int m = 0; m < 4; ++m) acc[ai][bj][m][n] += bv; }
        f32x4 pre[4][2][2];
#pragma unroll
        for (int m = 0; m < 4; ++m) { const size_t off = (size_t)(u.pm * BM + wr * 64 + m * 16 + fr) * ldc + col0;
#pragma unroll
            for (int bj = 0; bj < 2; ++bj)
#pragma unroll
                for (int n = 0; n < 2; ++n) pre[m][bj][n] = *(const f32x4*)(base + off + bj * HALF + n * 16); }
        const bool bad = st.run(acc, u, wr, wc, fr, fq, lds, wid, lane) || poison != 0u;
        const float qnan = __builtin_nanf("");
#pragma unroll
        for (int ai = 0; ai < 2; ++ai)
#pragma unroll
            for (int m = 0; m < 4; ++m) { const int r = ai * HALF + wr * 64 + m * 16 + fr; const f32x2v sr = S[r]; const size_t off = (size_t)(u.pm * BM + r) * ldc + col0;
#pragma unroll
                for (int bj = 0; bj < 2; ++bj)
#pragma unroll
                    for (int n = 0; n < 2; ++n) { const f32x4 bs = ai == 0 ? pre[m][bj][n] : *(const f32x4*)(base + off + bj * HALF + n * 16); f32x4 o = bs + (acc[ai][bj][m][n] - sr.x) * sr.y;
                        if (bad) o = (f32x4){qnan, qnan, qnan, qnan}; *(f32x4*)(out + off + bj * HALF + n * 16) = o; }
                if (m & 1) asm volatile("" ::: "memory"); }
    }
};
struct EpiLnResLn {
    static constexpr bool PERM = false, AFTER_DRAIN = true, MIDK = false;
    const float* base; float* out; bf16_t* xn; int ldc; const float* bias; PanelStats st1, st2; unsigned poison;
    __device__ __forceinline__ void fused(f32x4 (&acc)[2][2][4][2], const Unit& u, int wr, int wc, int fr, int fq, PG8_LAS unsigned char* lds, int wid, int lane) const {
        typedef float f32x2v __attribute__((ext_vector_type(2))); typedef unsigned u32x2v __attribute__((ext_vector_type(2)));
        const PG8_LAS f32x2v* S = (const PG8_LAS f32x2v*)(lds + 8192);
        const int col0 = u.pn * BM + wc * 32 + 4 * fq;
#pragma unroll
        for (int bj = 0; bj < 2; ++bj)
#pragma unroll
            for (int n = 0; n < 2; ++n) { const f32x4 bv = bias ? *(const f32x4*)(bias + col0 + bj * HALF + n * 16) : (f32x4){0.f, 0.f, 0.f, 0.f};
#pragma unroll
                for (int ai = 0; ai < 2; ++ai)
#pragma unroll
                    for (int m = 0; m < 4; ++m) acc[ai][bj][m][n] += bv; }
        bool bad = st1.run(acc, u, wr, wc, fr, fq, lds, wid, lane) || poison != 0u;
        const float qnan = __builtin_nanf("");
#pragma unroll
        for (int ai = 0; ai < 2; ++ai)
#pragma unroll
            for (int m = 0; m < 4; ++m) { const int r = ai * HALF + wr * 64 + m * 16 + fr; const f32x2v sr = S[r]; const size_t off = (size_t)(u.pm * BM + r) * ldc + col0;
#pragma unroll
                for (int bj = 0; bj < 2; ++bj)
#pragma unroll
                    for (int n = 0; n < 2; ++n) { const f32x4 bs = *(const f32x4*)(base + off + bj * HALF + n * 16); acc[ai][bj][m][n] = bs + (acc[ai][bj][m][n] - sr.x) * sr.y; }
                asm volatile("" : "+v"(acc[ai][0][m][0]), "+v"(acc[ai][0][m][1]), "+v"(acc[ai][1][m][0]), "+v"(acc[ai][1][m][1]));
                if (m & 1) asm volatile("" ::: "memory"); }
        const bool bad1 = bad;
        bad = st2.run(acc, u, wr, wc, fr, fq, lds, wid, lane) || bad;
#pragma unroll
        for (int ai = 0; ai < 2; ++ai)
#pragma unroll
            for (int m = 0; m < 4; ++m) { const int r = ai * HALF + wr * 64 + m * 16 + fr; const f32x2v sr = S[r]; const size_t off = (size_t)(u.pm * BM + r) * ldc + col0;
#pragma unroll
                for (int bj = 0; bj < 2; ++bj)
#pragma unroll
                    for (int n = 0; n < 2; ++n) { const f32x4 x1 = acc[ai][bj][m][n]; *(f32x4*)(out + off + bj * HALF + n * 16) = bad1 ? (f32x4){qnan, qnan, qnan, qnan} : x1;
                        const f32x4 o = (x1 - sr.x) * sr.y; u32x2v w; w.x = cvt_pk_bf16(o[0], o[1]); w.y = cvt_pk_bf16(o[2], o[3]);
                        if (bad) { w.x = 0x7fc07fc0u; w.y = 0x7fc07fc0u; } *(u32x2v*)(xn + off + bj * HALF + n * 16) = w; }
                asm volatile("" ::: "memory"); }
    }
};

template <class Epi, class Sched, bool ALIGN_EPI = false, bool SP2 = false>
__device__ __forceinline__ void gemm_phase(PG8_LAS unsigned char* lds, const Gemm g, const Sched& S, const Epi& E) {
    int tid = threadIdx.x; asm volatile("" : "+v"(tid));
    const int wid = __builtin_amdgcn_readfirstlane(tid >> 6), lane = tid & 63, wr = wid >> 2, wc = wid & 3, fr = lane & 15, fq = lane >> 4;
    int K = g.K; asm volatile("" : "+s"(K)); const int nt = g.nt ? g.nt : K / BK;
    const unsigned pitchA = g.pitchA ? g.pitchA : (unsigned)K * 2u, pitchB = g.pitchB ? g.pitchB : (unsigned)K * 2u;
    unsigned voffA[2], voffB[2];
#pragma unroll
    for (int i = 0; i < 2; ++i) { int R, C; stage_rc(tid * 16 + i * 8192, R, C); const int Rb = Epi::PERM ? ((R & ~31) + perm32(R & 31)) : R;
        voffA[i] = (unsigned)R * pitchA + (unsigned)C * 2u; voffB[i] = (unsigned)Rb * pitchB + (unsigned)C * 2u; }
    const size_t kstepA = g.kstepA ? g.kstepA : (size_t)(BK * 2), kstepB = g.kstepB ? g.kstepB : (size_t)(BK * 2);
    const size_t hstepA = g.hstepA ? g.hstepA : (size_t)HALF * K * 2, hstepB = g.hstepB ? g.hstepB : (size_t)HALF * K * 2;
    const size_t tA_pm = g.tA_pm ? g.tA_pm : (size_t)BM * K * 2, tA_pn = g.tA_pn, tB_pn = g.tB_pn ? g.tB_pn : (size_t)BM * K * 2;
    const unsigned ldsw = (unsigned)wid * 1024u;
    const int aoff = lds_byte(wr * 64 + fr, fq * 8), boff = lds_byte(wc * 32 + fr, fq * 8);
#define PG8_SA(b, h) (((b) * 2 + (h)) * HTB)
#define PG8_SB(b, h) ((4 + (b) * 2 + (h)) * HTB)
#define PG8_STAGE(bufoff, gbase, voff) do { _Pragma("unroll") for (int _i = 0; _i < 2; ++_i) \
        __builtin_amdgcn_global_load_lds((const unsigned*)((const char*)(gbase) + (voff)[_i]), (PG8_LAS unsigned*)(lds + (bufoff) + ldsw + _i * 8192), 16, 0, 0); } while (0)
#define PG8_LDA(dst, b, h) do { _Pragma("unroll") for (int m = 0; m < 4; ++m) _Pragma("unroll") for (int k = 0; k < 2; ++k) dst[m][k] = *(const PG8_LAS bf16x8*)(lds + PG8_SA(b, h) + aoff + m * 2048 + k * 1024); } while (0)
#define PG8_LDB(dst, b, h) do { _Pragma("unroll") for (int n = 0; n < 2; ++n) _Pragma("unroll") for (int k = 0; k < 2; ++k) dst[n][k] = *(const PG8_LAS bf16x8*)(lds + PG8_SB(b, h) + boff + n * 2048 + k * 1024); } while (0)
#define PG8_MMA(ai, bj, At, Bt) do { __builtin_amdgcn_s_setprio(1); _Pragma("unroll") for (int m = 0; m < 4; ++m) _Pragma("unroll") for (int n = 0; n < 2; ++n) _Pragma("unroll") for (int k = 0; k < 2; ++k) \
        acc[ai][bj][m][n] = __builtin_amdgcn_mfma_f32_16x16x32_bf16(Bt[n][k], At[m][k], acc[ai][bj][m][n], 0, 0, 0); __builtin_amdgcn_s_setprio(0); } while (0)
#define PG8_WAIT_V(n) asm volatile("s_waitcnt vmcnt(" #n ")" ::: "memory")
#define PG8_WAIT_L(n) asm volatile("s_waitcnt lgkmcnt(" #n ")" ::: "memory")
#define PG8_BAR __builtin_amdgcn_s_barrier()
#define PG8_SCHED __builtin_amdgcn_sched_barrier(0)
    Unit cur, nxt; int ui = 0;
    if (!S.next(0, cur)) return;
    f32x4 acc[2][2][4][2];
#pragma unroll
    for (int a = 0; a < 2; ++a)
#pragma unroll
        for (int b = 0; b < 2; ++b)
#pragma unroll
            for (int m = 0; m < 4; ++m)
#pragma unroll
                for (int n = 0; n < 2; ++n) acc[a][b][m][n] = (f32x4){0.f, 0.f, 0.f, 0.f};
    bf16x8 At[4][2], B0[2][2], B1[2][2];
    const char* cA = (const char*)g.A + (size_t)cur.pm * tA_pm + (size_t)cur.pn * tA_pn; const char* cB = (const char*)g.Bt + (size_t)cur.pn * tB_pn;
    S.a_ready(cur);
    if constexpr (SP2) {
        PG8_STAGE(PG8_SB(0, 0), cB, voffB); PG8_STAGE(PG8_SB(0, 1), cB + hstepB, voffB); PG8_STAGE(PG8_SA(0, 0), cA, voffA); PG8_STAGE(PG8_SA(0, 1), cA + hstepA, voffA);
        if (wr == 1) PG8_BAR;
        PG8_WAIT_V(2); PG8_BAR;
        PG8_STAGE(PG8_SB(1, 0), cB + kstepB, voffB); PG8_STAGE(PG8_SA(1, 0), cA + kstepA, voffA); PG8_STAGE(PG8_SB(1, 1), cB + hstepB + kstepB, voffB);
        PG8_WAIT_V(6); PG8_BAR;
    } else {
        PG8_STAGE(PG8_SB(0, 0), cB, voffB); PG8_STAGE(PG8_SA(0, 0), cA, voffA); PG8_STAGE(PG8_SB(0, 1), cB + hstepB, voffB); PG8_STAGE(PG8_SA(0, 1), cA + hstepA, voffA);
        if (wr == 1) PG8_BAR;
        PG8_WAIT_V(4); PG8_BAR;
        PG8_STAGE(PG8_SB(1, 0), cB + kstepB, voffB); PG8_STAGE(PG8_SA(1, 0), cA + kstepA, voffA); PG8_STAGE(PG8_SB(1, 1), cB + hstepB + kstepB, voffB);
        PG8_WAIT_V(6); PG8_BAR;
    }
    for (;;) {
        const bool has_next = S.next(ui + 1, nxt);
        const char* nA = has_next ? (const char*)g.A + (size_t)nxt.pm * tA_pm + (size_t)nxt.pn * tA_pn : cA; const char* nB = has_next ? (const char*)g.Bt + (size_t)nxt.pn * tB_pn : cB;
        for (int t = 0; t < nt; t += 2) {
            if constexpr (Epi::MIDK) { if (t == (nt >> 1)) E.midk(acc, cur, wr, wc, fr, fq); }
            const bool last = (t == nt - 2);
            const char* a1 = cA + (size_t)(t + 1) * kstepA;
            const char* a2 = last ? nA : cA + (size_t)(t + 2) * kstepA; const char* b2 = last ? nB : cB + (size_t)(t + 2) * kstepB;
            const char* a3 = a2 + kstepA; const char* b3 = b2 + kstepB;
            if (last && has_next) S.a_ready(nxt);
            if constexpr (SP2) {
            PG8_LDB(B0, 0, 0); PG8_LDB(B1, 0, 1); PG8_SCHED; PG8_LDA(At, 0, 0); PG8_STAGE(PG8_SA(1, 1), a1 + hstepA, voffA);
            PG8_WAIT_V(8); PG8_WAIT_L(0); PG8_BAR; PG8_MMA(0, 0, At, B0); PG8_MMA(0, 1, At, B1); PG8_BAR; PG8_SCHED;
            PG8_LDA(At, 0, 1); PG8_STAGE(PG8_SB(0, 0), b2, voffB); PG8_STAGE(PG8_SB(0, 1), b2 + hstepB, voffB); PG8_STAGE(PG8_SA(0, 0), a2, voffA);
            PG8_WAIT_V(8); PG8_WAIT_L(0); PG8_BAR; PG8_MMA(1, 0, At, B0); PG8_MMA(1, 1, At, B1); PG8_BAR; PG8_SCHED;
            PG8_LDB(B0, 1, 0); PG8_LDB(B1, 1, 1); PG8_SCHED; PG8_LDA(At, 1, 0); PG8_STAGE(PG8_SA(0, 1), a2 + hstepA, voffA);
            PG8_WAIT_V(8); PG8_WAIT_L(0); PG8_BAR; PG8_MMA(0, 0, At, B0); PG8_MMA(0, 1, At, B1); PG8_BAR; PG8_SCHED;
            PG8_LDA(At, 1, 1); PG8_STAGE(PG8_SB(1, 0), b3, voffB); PG8_STAGE(PG8_SB(1, 1), b3 + hstepB, voffB); PG8_STAGE(PG8_SA(1, 0), a3, voffA);
            PG8_WAIT_V(8); PG8_WAIT_L(0); PG8_BAR; PG8_MMA(1, 0, At, B0); PG8_MMA(1, 1, At, B1); PG8_BAR; PG8_SCHED;
            } else {
            PG8_LDB(B0, 0, 0); PG8_SCHED; PG8_LDA(At, 0, 0); PG8_STAGE(PG8_SA(1, 1), a1 + hstepA, voffA);
            PG8_WAIT_L(8); PG8_BAR; PG8_WAIT_L(0); PG8_MMA(0, 0, At, B0); PG8_BAR; PG8_SCHED;
            PG8_LDB(B1, 0, 1); PG8_STAGE(PG8_SB(0, 0), b2, voffB);
            PG8_BAR; PG8_WAIT_L(0); PG8_MMA(0, 1, At, B1); PG8_BAR;
            PG8_LDA(At, 0, 1); PG8_STAGE(PG8_SA(0, 0), a2, voffA);
            PG8_BAR; PG8_WAIT_L(0); PG8_MMA(1, 0, At, B0); PG8_BAR; PG8_SCHED;
            PG8_STAGE(PG8_SB(0, 1), b2 + hstepB, voffB);
            PG8_WAIT_V(6); PG8_BAR; PG8_MMA(1, 1, At, B1); PG8_BAR;
            PG8_LDB(B0, 1, 0); PG8_SCHED; PG8_LDA(At, 1, 0); PG8_STAGE(PG8_SA(0, 1), a2 + hstepA, voffA);
            PG8_WAIT_L(8); PG8_BAR; PG8_WAIT_L(0); PG8_MMA(0, 0, At, B0); PG8_BAR; PG8_SCHED;
            PG8_LDB(B1, 1, 1); PG8_STAGE(PG8_SB(1, 0), b3, voffB);
            PG8_BAR; PG8_WAIT_L(0); PG8_MMA(0, 1, At, B1); PG8_BAR;
            PG8_LDA(At, 1, 1); PG8_STAGE(PG8_SA(1, 0), a3, voffA);
            PG8_BAR; PG8_WAIT_L(0); PG8_MMA(1, 0, At, B0); PG8_BAR; PG8_SCHED;
            PG8_STAGE(PG8_SB(1, 1), b3 + hstepB, voffB);
            PG8_WAIT_V(6); PG8_BAR; PG8_MMA(1, 1, At, B1); PG8_BAR;
            }
        }
        if constexpr (ALIGN_EPI) { if (wr == 0) PG8_BAR; }
        if constexpr (!Epi::AFTER_DRAIN) { E(acc, cur, wr, wc, fr, fq); S.done(cur); }
        if (!has_next) break;
#pragma unroll
        for (int a = 0; a < 2; ++a)
#pragma unroll
            for (int b = 0; b < 2; ++b)
#pragma unroll
                for (int m = 0; m < 4; ++m)
#pragma unroll
                    for (int n = 0; n < 2; ++n) acc[a][b][m][n] = (f32x4){0.f, 0.f, 0.f, 0.f};
        cur = nxt; cA = nA; cB = nB; ++ui;
        if constexpr (ALIGN_EPI) { if (wr == 1) PG8_BAR; }
    }
    PG8_WAIT_V(0);
    if constexpr (!ALIGN_EPI) { if (wr == 0) PG8_BAR; }
    PG8_BAR;
    if constexpr (Epi::AFTER_DRAIN) { E.fused(acc, cur, wr, wc, fr, fq, lds, wid, lane); S.done(cur); }
#undef PG8_SA
#undef PG8_SB
#undef PG8_STAGE
#undef PG8_LDA
#undef PG8_LDB
#undef PG8_MMA
#undef PG8_WAIT_V
#undef PG8_WAIT_L
#undef PG8_BAR
#undef PG8_SCHED
}
}

namespace pg8 {
constexpr float LOG2E = 1.4426950408889634f;
constexpr float QS_NSA = 0.125f * LOG2E;
constexpr float QS_MLA = 0.10206207261596575f * LOG2E;
__device__ __forceinline__ float fast_sigmoid(float x) { return __builtin_amdgcn_rcpf(1.0f + __builtin_amdgcn_exp2f(-LOG2E * x)); }
__device__ __forceinline__ float lo_bf(unsigned u) { return __uint_as_float(u << 16); }
__device__ __forceinline__ float hi_bf(unsigned u) { return __uint_as_float(u & 0xffff0000u); }
struct EpiInProjF {
    static constexpr bool PERM = true, AFTER_DRAIN = false, MIDK = false;
    bf16_t* proj; unsigned char* gates;
    __device__ __forceinline__ void operator()(const f32x4 (&acc)[2][2][4][2], const Unit& u, int wr, int wc, int fr, int fq) const {
        const bool isg = u.pn >= 7;
        bf16_t* base = proj; const int ld = 1792; const int colt = isg ? (u.pn - 7) * BM : u.pn * BM;
        const float sc = (u.pn < 2) ? QS_NSA : 1.0f;
        const int row0 = u.pm * BM + wr * 64 + fr, col0 = colt + wc * 32 + 8 * fq;
#pragma unroll
        for (int ai = 0; ai < 2; ++ai)
#pragma unroll
            for (int m = 0; m < 4; ++m) { bf16_t* rowp = base + (size_t)(row0 + ai * HALF + m * 16) * ld + col0;
#pragma unroll
                for (int bj = 0; bj < 2; ++bj) { f32x4 v0 = acc[ai][bj][m][0], v1 = acc[ai][bj][m][1];
                    if (isg) {
                        unsigned q[8];
#pragma unroll
                        for (int e = 0; e < 4; ++e) { q[e] = (unsigned)(fast_sigmoid(v0[e]) * 255.0f + 0.5f); q[4 + e] = (unsigned)(fast_sigmoid(v1[e]) * 255.0f + 0.5f); }
                        uint2 w; w.x = q[0] | (q[1] << 8) | (q[2] << 16) | (q[3] << 24); w.y = q[4] | (q[5] << 8) | (q[6] << 16) | (q[7] << 24);
                        *(uint2*)(gates + (size_t)(row0 + ai * HALF + m * 16) * 2048 + col0 + bj * HALF) = w;
                    } else { v0 = v0 * sc; v1 = v1 * sc;
                        u32x4 w; w.x = cvt_pk_bf16(v0[0], v0[1]); w.y = cvt_pk_bf16(v0[2], v0[3]); w.z = cvt_pk_bf16(v1[0], v1[1]); w.w = cvt_pk_bf16(v1[2], v1[3]);
                        *(u32x4*)(rowp + bj * HALF) = w; } } }
    }
};
template <int PASS> struct EpiMergeF {
    static constexpr bool PERM = true, AFTER_DRAIN = false, MIDK = false;
    const unsigned char* gates; bf16_t* merged;
    __device__ __forceinline__ void operator()(const f32x4 (&acc)[2][2][4][2], const Unit& u, int wr, int wc, int fr, int fq) const {
        const int row0 = u.pm * BM + wr * 64 + fr, col0 = u.pn * BM + wc * 32 + 8 * fq;
#pragma unroll
        for (int ai = 0; ai < 2; ++ai)
#pragma unroll
            for (int m = 0; m < 4; ++m) { const size_t r = (size_t)(row0 + ai * HALF + m * 16);
#pragma unroll
                for (int bj = 0; bj < 2; ++bj) { const int c = col0 + bj * HALF;
                    const uint2 g = *(const uint2*)(gates + r * 2048 + PASS * 1024 + c);
                    f32x4 v0 = acc[ai][bj][m][0] * (1.0f / 255.0f), v1 = acc[ai][bj][m][1] * (1.0f / 255.0f);
                    v0[0] *= (float)(g.x & 255u); v0[1] *= (float)((g.x >> 8) & 255u); v0[2] *= (float)((g.x >> 16) & 255u); v0[3] *= (float)(g.x >> 24);
                    v1[0] *= (float)(g.y & 255u); v1[1] *= (float)((g.y >> 8) & 255u); v1[2] *= (float)((g.y >> 16) & 255u); v1[3] *= (float)(g.y >> 24);
                    if (PASS == 1) { const u32x4 o = *(const u32x4*)(merged + r * 1024 + c);
                        v0[0] += lo_bf(o.x); v0[1] += hi_bf(o.x); v0[2] += lo_bf(o.y); v0[3] += hi_bf(o.y);
                        v1[0] += lo_bf(o.z); v1[1] += hi_bf(o.z); v1[2] += lo_bf(o.w); v1[3] += hi_bf(o.w); }
                    u32x4 w; w.x = cvt_pk_bf16(v0[0], v0[1]); w.y = cvt_pk_bf16(v0[2], v0[3]); w.z = cvt_pk_bf16(v1[0], v1[1]); w.w = cvt_pk_bf16(v1[2], v1[3]);
                    *(u32x4*)(merged + r * 1024 + c) = w; } }
    }
};
struct EpiMergeFusedF {
    static constexpr bool PERM = true, AFTER_DRAIN = false, MIDK = true;
    const unsigned char* gates; bf16_t* merged;
    __device__ __forceinline__ void midk(f32x4 (&acc)[2][2][4][2], const Unit& u, int wr, int wc, int fr, int fq) const {
        asm volatile("" : "+v"(fr), "+v"(fq));
        const int row0 = u.pm * BM + wr * 64 + fr, col0 = u.pn * BM + wc * 32 + 8 * fq;
#pragma unroll
        for (int ai = 0; ai < 2; ++ai)
#pragma unroll
            for (int m = 0; m < 4; ++m) { const size_t r = (size_t)(row0 + ai * HALF + m * 16);
#pragma unroll
                for (int bj = 0; bj < 2; ++bj) { const int c = col0 + bj * HALF;
                    const uint2 g0 = *(const uint2*)(gates + r * 2048 + c), g1 = *(const uint2*)(gates + r * 2048 + 1024 + c);
#pragma unroll
                    for (int e = 0; e < 4; ++e) {
                        const float a0 = (float)((g0.x >> (8 * e)) & 255u), b0 = fmaxf((float)((g1.x >> (8 * e)) & 255u), 1.0f);
                        const float a1 = (float)((g0.y >> (8 * e)) & 255u), b1 = fmaxf((float)((g1.y >> (8 * e)) & 255u), 1.0f);
                        acc[ai][bj][m][0][e] *= a0 * __builtin_amdgcn_rcpf(b0); acc[ai][bj][m][1][e] *= a1 * __builtin_amdgcn_rcpf(b1); }
                    asm volatile("" ::: "memory"); } }
    }
    __device__ __forceinline__ void operator()(const f32x4 (&acc)[2][2][4][2], const Unit& u, int wr, int wc, int fr, int fq) const {
        const int row0 = u.pm * BM + wr * 64 + fr, col0 = u.pn * BM + wc * 32 + 8 * fq;
#pragma unroll
        for (int ai = 0; ai < 2; ++ai)
#pragma unroll
            for (int m = 0; m < 4; ++m) { const size_t r = (size_t)(row0 + ai * HALF + m * 16);
#pragma unroll
                for (int bj = 0; bj < 2; ++bj) { const int c = col0 + bj * HALF;
                    const uint2 g1 = *(const uint2*)(gates + r * 2048 + 1024 + c);
                    f32x4 v0 = acc[ai][bj][m][0] * (1.0f / 255.0f), v1 = acc[ai][bj][m][1] * (1.0f / 255.0f);
#pragma unroll
                    for (int e = 0; e < 4; ++e) { v0[e] *= fmaxf((float)((g1.x >> (8 * e)) & 255u), 1.0f); v1[e] *= fmaxf((float)((g1.y >> (8 * e)) & 255u), 1.0f); }
                    u32x4 w; w.x = cvt_pk_bf16(v0[0], v0[1]); w.y = cvt_pk_bf16(v0[2], v0[3]); w.z = cvt_pk_bf16(v1[0], v1[1]); w.w = cvt_pk_bf16(v1[2], v1[3]);
                    *(u32x4*)(merged + r * 1024 + c) = w; } }
    }
};
struct EpiCmpOutF {
    static constexpr bool PERM = true, AFTER_DRAIN = false, MIDK = false;
    bf16_t* dst;
    __device__ __forceinline__ void operator()(const f32x4 (&acc)[2][2][4][2], const Unit& u, int wr, int wc, int fr, int fq) const {
        if (wc >= 2) return;
        const int row0 = u.pm * BM + wr * 64 + fr, col0 = wc * 32 + 8 * fq;
#pragma unroll
        for (int ai = 0; ai < 2; ++ai)
#pragma unroll
            for (int m = 0; m < 4; ++m) { const int r = row0 + ai * HALF + m * 16;
                if (r < BATCH * NC * 2) { const int g = r & 1, bc = r >> 1, b = bc / NC, c = bc % NC;
                    const f32x4 v0 = acc[ai][0][m][0], v1 = acc[ai][0][m][1];
                    u32x4 w; w.x = cvt_pk_bf16(v0[0], v0[1]); w.y = cvt_pk_bf16(v0[2], v0[3]); w.z = cvt_pk_bf16(v1[0], v1[1]); w.w = cvt_pk_bf16(v1[2], v1[3]);
                    *(u32x4*)(dst + ((size_t)(b * 2 + g) * 128 + c) * 64 + col0) = w; } }
    }
};
struct EpiSlabF {
    static constexpr bool PERM = false, AFTER_DRAIN = false, MIDK = false;
    float* slab;
    __device__ __forceinline__ void operator()(const f32x4 (&acc)[2][2][4][2], const Unit& u, int wr, int wc, int fr, int fq) const {
        const int row0 = u.pm * BM + wr * 64 + fr, col0 = wc * 32 + 4 * fq;
        float* base = slab + (size_t)u.pn * 2048 * 256;
#pragma unroll
        for (int ai = 0; ai < 2; ++ai)
#pragma unroll
            for (int m = 0; m < 4; ++m) { float* rowp = base + (size_t)(row0 + ai * HALF + m * 16) * 256 + col0;
#pragma unroll
                for (int bj = 0; bj < 2; ++bj)
#pragma unroll
                    for (int n = 0; n < 2; ++n) *(f32x4*)(rowp + bj * HALF + n * 16) = acc[ai][bj][m][n]; }
    }
};
struct EpiResidF {
    static constexpr bool PERM = false, AFTER_DRAIN = false, MIDK = false;
    const float* x; float* h;
    __device__ __forceinline__ void operator()(const f32x4 (&acc)[2][2][4][2], const Unit& u, int wr, int wc, int fr, int fq) const {
        const int row0 = u.pm * BM + wr * 64 + fr, col0 = u.pn * BM + wc * 32 + 4 * fq;
#pragma unroll
        for (int ai = 0; ai < 2; ++ai)
#pragma unroll
            for (int m = 0; m < 4; ++m) { const size_t off = (size_t)(row0 + ai * HALF + m * 16) * 1024 + col0;
#pragma unroll
                for (int bj = 0; bj < 2; ++bj)
#pragma unroll
                    for (int n = 0; n < 2; ++n) { const f32x4 xv = *(const f32x4*)(x + off + bj * HALF + n * 16); *(f32x4*)(h + off + bj * HALF + n * 16) = xv + acc[ai][bj][m][n]; } }
    }
};
struct EpiMlaQF {
    static constexpr bool PERM = false, AFTER_DRAIN = false, MIDK = false;
    bf16_t* q; const float2* cs;
    __device__ __forceinline__ void operator()(const f32x4 (&acc)[2][2][4][2], const Unit& u, int wr, int wc, int fr, int fq) const {
        const int row0 = u.pm * BM + wr * 64 + fr;
#pragma unroll
        for (int bj = 0; bj < 2; ++bj) {
            const int X = u.pn * BM + bj * HALF + wc * 32;
            const bool rope = (X % 96) == 64;
#pragma unroll
            for (int ai = 0; ai < 2; ++ai)
#pragma unroll
                for (int m = 0; m < 4; ++m) { const int r = row0 + ai * HALF + m * 16; const int pos = r & (SEQ - 1);
                    f32x4 v0 = acc[ai][bj][m][0], v1 = acc[ai][bj][m][1];
                    if (rope) {
#pragma unroll
                        for (int j = 0; j < 4; ++j) { const float2 c = cs[pos * 16 + 4 * fq + j]; const float x1 = v0[j], x2 = v1[j]; v0[j] = x1 * c.x - x2 * c.y; v1[j] = x2 * c.x + x1 * c.y; } }
                    v0 = v0 * QS_MLA; v1 = v1 * QS_MLA;
                    bf16_t* p = q + (size_t)r * 768 + X + 4 * fq;
                    uint2 w0, w1; w0.x = cvt_pk_bf16(v0[0], v0[1]); w0.y = cvt_pk_bf16(v0[2], v0[3]); w1.x = cvt_pk_bf16(v1[0], v1[1]); w1.y = cvt_pk_bf16(v1[2], v1[3]);
                    *(uint2*)p = w0; *(uint2*)(p + 16) = w1; }
        }
    }
};
}

#define PG8_SP2 true
#define PG8_ALIGN true
constexpr int NTHR = 512, NWV = NTHR / 64;
#define WAVE_IDS const int lane = threadIdx.x & 63, wv = threadIdx.x >> 6; const int gw = blockIdx.x * NWV + wv, nw = gridDim.x * NWV; (void)lane; (void)gw; (void)nw;

template <bool Q8> DEV void ph_rms1024(const float* __restrict__ src, const float* __restrict__ g, bf16_t* __restrict__ dst, int rows, unsigned* __restrict__ q8 = nullptr, float* __restrict__ qs = nullptr, int gw_o = -1, int nw_o = 0, const bf16_t* __restrict__ add = nullptr) {
  const int lane = threadIdx.x & 63; const int gw = (gw_o >= 0) ? gw_o : (int)(blockIdx.x * NWV + (threadIdx.x >> 6)); const int nw = (gw_o >= 0) ? nw_o : (int)(gridDim.x * NWV);
  float4 gg[4];
#pragma unroll
  for (int j = 0; j < 4; ++j) gg[j] = ((const float4*)g)[j * 64 + lane];
  float4 nx[4]; uint2 na[4];
  if (gw < rows) {
#pragma unroll
    for (int j = 0; j < 4; ++j) { nx[j] = ((const float4*)(src + (size_t)gw * 1024))[j * 64 + lane]; if (add) na[j] = ((const uint2*)(add + (size_t)gw * 1024))[j * 64 + lane]; } }
  for (int r = gw; r < rows; r += nw) {
    float4 v[4]; float ss = 0.f;
#pragma unroll
    for (int j = 0; j < 4; ++j) { v[j] = nx[j];
      if (add) { v[j].x += __uint_as_float(na[j].x << 16); v[j].y += __uint_as_float(na[j].x & 0xffff0000u); v[j].z += __uint_as_float(na[j].y << 16); v[j].w += __uint_as_float(na[j].y & 0xffff0000u); }
      ss += v[j].x * v[j].x + v[j].y * v[j].y + v[j].z * v[j].z + v[j].w * v[j].w; }
    if (r + nw < rows) {
#pragma unroll
      for (int j = 0; j < 4; ++j) { nx[j] = ((const float4*)(src + (size_t)(r + nw) * 1024))[j * 64 + lane]; if (add) na[j] = ((const uint2*)(add + (size_t)(r + nw) * 1024))[j * 64 + lane]; } }
    ss = wsum(ss);
    const float inv = rsqrtf(ss * (1.0f / 1024.0f) + 1e-6f);
    float mx = 0.f;
#pragma unroll
    for (int j = 0; j < 4; ++j) {
      v[j].x *= inv * gg[j].x; v[j].y *= inv * gg[j].y; v[j].z *= inv * gg[j].z; v[j].w *= inv * gg[j].w;
      uint2 o;
      o.x = (unsigned)f2bf(v[j].x) | ((unsigned)f2bf(v[j].y) << 16);
      o.y = (unsigned)f2bf(v[j].z) | ((unsigned)f2bf(v[j].w) << 16);
      ((uint2*)(dst + (size_t)r * 1024))[j * 64 + lane] = o;
      if (Q8) mx = fmaxf(mx, fmaxf(fmaxf(fabsf(v[j].x), fabsf(v[j].y)), fmaxf(fabsf(v[j].z), fabsf(v[j].w))));
    }
    if (Q8) {
      mx = wmaxf(mx);
      const float sc = fmaxf(mx, 1e-30f) * (1.0f / 127.0f), isc = 1.0f / sc;
#pragma unroll
      for (int j = 0; j < 4; ++j) {
        const int q0 = (int)rintf(v[j].x * isc), q1 = (int)rintf(v[j].y * isc), q2 = (int)rintf(v[j].z * isc), q3 = (int)rintf(v[j].w * isc);
        q8[(size_t)r * 256 + j * 64 + lane] = (unsigned)(q0 & 255) | ((unsigned)(q1 & 255) << 8) | ((unsigned)(q2 & 255) << 16) | ((unsigned)(q3 & 255) << 24);
      }
      if (lane == 0) qs[r] = sc;
    }
  }
}
DEV int win_src_col(int n) {
  if (n < 1280) return n;
  if (n < 1536) return 1304 + (n - 1280);
  if (n < 1664) return 1560 + (n - 1536);
  if (n < 1696) return 1688 + (n - 1664);
  if (n < 1720) return 1280 + (n - 1696);
  if (n < 1792) return -1;
  return 1720 + (n - 1792);
}
template <int MODE> DEV void tr_item(const float* __restrict__ W, int K, int Nsrc, bf16_t* __restrict__ WT, int Nblk, int Nvalid, __attribute__((address_space(3))) float* scr, int item, int lane, int pitch = 0, int koff = 0) {
  if (pitch == 0) pitch = K;
  const int kb = item / Nblk, nb = item % Nblk, k0 = 64 * kb, n0 = 32 * nb;
  const int n = n0 + (lane & 31);
  const int sc = (MODE == 1) ? win_src_col(n) : ((n < Nvalid) ? n : -1);
  float tv[32];
#pragma unroll
  for (int i = 0; i < 32; ++i) { const int kk = 2 * i + (lane >> 5); tv[i] = (sc >= 0) ? W[(size_t)(k0 + kk) * Nsrc + sc] : 0.f; }
#pragma unroll
  for (int i = 0; i < 32; ++i) { const int kk = 2 * i + (lane >> 5); scr[kk * 33 + (lane & 31)] = tv[i]; }
  asm volatile("s_waitcnt lgkmcnt(0)" ::: "memory");
  const int c = lane & 7;
#pragma unroll
  for (int j = 0; j < 4; ++j) { const int nn = (lane >> 3) + 8 * j; const __attribute__((address_space(3))) float* sp = scr + (8 * c) * 33 + nn;
    uint4 o;
    o.x = (unsigned)f2bf(sp[0 * 33]) | ((unsigned)f2bf(sp[1 * 33]) << 16); o.y = (unsigned)f2bf(sp[2 * 33]) | ((unsigned)f2bf(sp[3 * 33]) << 16);
    o.z = (unsigned)f2bf(sp[4 * 33]) | ((unsigned)f2bf(sp[5 * 33]) << 16); o.w = (unsigned)f2bf(sp[6 * 33]) | ((unsigned)f2bf(sp[7 * 33]) << 16);
    *(uint4*)(WT + (size_t)(n0 + nn) * pitch + koff + k0 + 8 * c) = o; }
  asm volatile("s_waitcnt lgkmcnt(0)" ::: "memory");
}
DEV void rope_entry(float2* __restrict__ cs, int i) {
  const int j = i & 15, pos = i >> 4;
  const float inv_freq = __builtin_amdgcn_exp2f(-(float)(2 * j) * (13.287712379549449f / 32.0f));
  const float rev = (float)pos * inv_freq * 0.15915494309189535f;
  const float fr = rev - floorf(rev);
  cs[i] = make_float2(__builtin_amdgcn_cosf(fr), __builtin_amdgcn_sinf(fr));
}
namespace att {
#define LAS3 __attribute__((address_space(3)))
typedef LAS3 char* lptr;
typedef LAS3 const char* lcptr;
using bf16x8 = __attribute__((ext_vector_type(8))) short;
using s16x4 = __attribute__((ext_vector_type(4))) short;
using f32x16 = __attribute__((ext_vector_type(16))) float;
typedef short v4i16_t __attribute__((ext_vector_type(4)));
typedef unsigned u32x4 __attribute__((ext_vector_type(4)));
typedef float f32x4_t __attribute__((ext_vector_type(4)));
typedef float f32x2_t __attribute__((ext_vector_type(2)));
typedef __bf16 bf16x2_t __attribute__((ext_vector_type(2)));
constexpr float LOG2E = 1.4426950408889634f;
constexpr float THR = 8.0f;
constexpr float NEG_INF = -__builtin_huge_valf();
constexpr int SLOT = 20480, KOFF = 0, VOFF = 12288;
constexpr int L_WSF = 2 * SLOT;
constexpr int L_TB = L_WSF + 2048;
constexpr int L_ST = L_TB + 8 * 320 * 4;
constexpr int L_SELM = L_ST + 768;
constexpr int L_SC = L_SELM + 256;
constexpr int L_IMPQ = L_SC + 64 * 33 * 4;
constexpr int L_IMPL = L_IMPQ + 4 * 64 * 33 * 4;
constexpr int L_FIN = L_IMPQ;
constexpr int L_END = L_IMPL + 4 * 64 * 33 * 4;
static_assert(L_END <= 131072, "attention LDS map");

__device__ __forceinline__ int crow(int r, int hi) { return (r & 3) + 8 * (r >> 2) + 4 * hi; }
__device__ __forceinline__ s16x4 vtr(lcptr p) { return __builtin_bit_cast(s16x4, __builtin_amdgcn_ds_read_tr16_b64_v4i16((LAS3 v4i16_t*)p)); }
__device__ __forceinline__ unsigned cvtpk(float lo, float hi) { f32x2_t v = {lo, hi}; bf16x2_t b = __builtin_convertvector(v, bf16x2_t); return __builtin_bit_cast(unsigned, b); }
typedef float f32x2_t __attribute__((ext_vector_type(2)));
__device__ __forceinline__ float max3(float a, float b, float c) { float d; asm("v_max3_f32 %0, %1, %2, %3" : "=v"(d) : "v"(a), "v"(b), "v"(c)); return d; }
__device__ __forceinline__ float xmax(float v) { auto rr = __builtin_amdgcn_permlane32_swap(__float_as_uint(v), __float_as_uint(v), false, false); return fmaxf(__uint_as_float(rr[0]), __uint_as_float(rr[1])); }
__device__ __forceinline__ float xsum(float v) { auto rr = __builtin_amdgcn_permlane32_swap(__float_as_uint(v), __float_as_uint(v), false, false); return __uint_as_float(rr[0]) + __uint_as_float(rr[1]); }
__device__ __forceinline__ float ex2(float x) { return __builtin_amdgcn_exp2f(x); }

template <int ND0> __device__ __forceinline__ void qkt(f32x16& p0, f32x16& p1, lcptr kb, const bf16x8* qr) {
  p0 = f32x16{}; p1 = f32x16{};
  __builtin_amdgcn_s_setprio(1);
#pragma unroll
  for (int d0 = 0; d0 < ND0; ++d0) {
    const bf16x8 b0 = *(const LAS3 bf16x8*)(kb + d0 * 2048);
    const bf16x8 b1 = *(const LAS3 bf16x8*)(kb + d0 * 2048 + 512);
    p0 = __builtin_amdgcn_mfma_f32_32x32x16_bf16(b0, qr[d0], p0, 0, 0, 0);
    p1 = __builtin_amdgcn_mfma_f32_32x32x16_bf16(b1, qr[d0], p1, 0, 0, 0);
  }
  __builtin_amdgcn_s_setprio(0);
}
template <int ND0> __device__ __forceinline__ void qkt_init(f32x16& p0, f32x16& p1, lcptr kb, const bf16x8* qr, const f32x16& c0, const f32x16& c1) {
  p0 = c0; p1 = c1;
  __builtin_amdgcn_s_setprio(1);
#pragma unroll
  for (int d0 = 0; d0 < ND0; ++d0) {
    const bf16x8 b0 = *(const LAS3 bf16x8*)(kb + d0 * 2048);
    const bf16x8 b1 = *(const LAS3 bf16x8*)(kb + d0 * 2048 + 512);
    p0 = __builtin_amdgcn_mfma_f32_32x32x16_bf16(b0, qr[d0], p0, 0, 0, 0);
    p1 = __builtin_amdgcn_mfma_f32_32x32x16_bf16(b1, qr[d0], p1, 0, 0, 0);
  }
  __builtin_amdgcn_s_setprio(0);
}
__device__ __forceinline__ void pv(f32x16 (&o)[2], lcptr vp, const unsigned (&pw)[16]) {
  __builtin_amdgcn_s_setprio(1);
#pragma unroll
  for (int d0 = 0; d0 < 2; ++d0)
#pragma unroll
    for (int ks = 0; ks < 4; ++ks) {
      const s16x4 lo = vtr(vp + d0 * 4096 + ks * 1024), hi4 = vtr(vp + d0 * 4096 + ks * 1024 + 512);
      const bf16x8 vf = {lo[0], lo[1], lo[2], lo[3], hi4[0], hi4[1], hi4[2], hi4[3]};
      const unsigned pa4[4] = {pw[4 * ks], pw[4 * ks + 1], pw[4 * ks + 2], pw[4 * ks + 3]};
      o[d0] = __builtin_amdgcn_mfma_f32_32x32x16_bf16(__builtin_bit_cast(bf16x8, pa4), vf, o[d0], 0, 0, 0);
    }
  __builtin_amdgcn_s_setprio(0);
}
__device__ __forceinline__ void softmax_step(f32x16& p0, f32x16& p1, float& m, float& l, f32x16 (&o)[2], LAS3 float* wsf, int r32, int hi, unsigned (&pw)[16], bool mine = true) {
  float rm, rm2;
  asm("s_nop 11\n\tv_max3_f32 %0, %2, %3, %4\n\tv_max3_f32 %1, %5, %6, %7" : "=&v"(rm), "=&v"(rm2) : "v"(p0[0]), "v"(p1[0]), "v"(p0[1]), "v"(p1[1]), "v"(p0[2]), "v"(p1[2]));
#pragma unroll
  for (int r = 3; r < 15; r += 2) { rm = max3(rm, p0[r], p1[r]); rm2 = max3(rm2, p0[r + 1], p1[r + 1]); }
  rm = max3(rm, p0[15], p1[15]); rm = max3(rm, rm2, rm2);
  rm = mine ? rm : NEG_INF;
  rm = xmax(rm);
  if (__any(rm > m + THR)) {
    const float mn = fmaxf(m, rm);
    const float al = ex2(m - mn);
    m = mn; l *= al;
    if (hi == 0) wsf[r32] = al;
#pragma unroll
    for (int r = 0; r < 16; ++r) { const float f = wsf[crow(r, hi)]; o[0][r] *= f; o[1][r] *= f; }
  }
  f32x2_t s2 = {0.f, 0.f}; const float nm1 = mine ? -m : NEG_INF; const f32x2_t nm = {nm1, nm1};
#pragma unroll
  for (int r = 0; r < 16; r += 2) {
    const f32x2_t a = (f32x2_t){p0[r], p0[r + 1]} + nm, b = (f32x2_t){p1[r], p1[r + 1]} + nm;
    p0[r] = ex2(a[0]); p0[r + 1] = ex2(a[1]); p1[r] = ex2(b[0]); p1[r + 1] = ex2(b[1]);
    s2 += (f32x2_t){p0[r], p0[r + 1]} + (f32x2_t){p1[r], p1[r + 1]};
  }
  l += s2[0] + s2[1];
#pragma unroll
  for (int i = 0; i < 8; ++i) { pw[i] = cvtpk(p0[2 * i], p0[2 * i + 1]); pw[8 + i] = cvtpk(p1[2 * i], p1[2 * i + 1]); }
}
struct KVSrc { const bf16_t* k; const bf16_t* v; int ldk, ldv; };
__device__ __forceinline__ void kv_issue(const KVSrc& s, int row0, u32x4& rk, u32x4& rv, int tid) {
  const int kv = tid & 63, ch = tid >> 6, ln = tid & 63;
  rk = *(const u32x4*)(s.k + (size_t)(row0 + kv) * s.ldk + ch * 8);
  rv = *(const u32x4*)(s.v + (size_t)(row0 + 16 * (ch & 3) + (ln >> 2)) * s.ldv + (ch >> 2) * 32 + (ln & 3) * 8);
}
__device__ __forceinline__ void kv_commit(lptr slot, const u32x4& rk, const u32x4& rv, int tid) {
  *(LAS3 u32x4*)(slot + KOFF + (tid >> 6) * 1024 + (tid & 63) * 16) = rk;
  *(LAS3 u32x4*)(slot + VOFF + tid * 16) = rv;
}
__device__ __forceinline__ void fin_set(LAS3 float* finl, const f32x16 (&o)[2], int lane) {
#pragma unroll
  for (int d0 = 0; d0 < 2; ++d0)
#pragma unroll
    for (int r = 0; r < 16; ++r) finl[(d0 * 16 + r) * 64 + lane] = o[d0][r];
}
__device__ __forceinline__ void fin_add(LAS3 float* finl, const f32x16 (&o)[2], const LAS3 float* wsf, int lane, int hi) {
#pragma unroll
  for (int r = 0; r < 16; ++r) { const float f = wsf[crow(r, hi)];
#pragma unroll
    for (int d0 = 0; d0 < 2; ++d0) finl[(d0 * 16 + r) * 64 + lane] += o[d0][r] * f; }
}
__device__ __forceinline__ void fin_store(const LAS3 float* finl, bf16_t* gout, size_t rowbase, int ld, int colbase, int lane) {
#pragma unroll
  for (int i = 0; i < 4; ++i) {
    const int q = i * 8 + (lane >> 3), ch = lane & 7;
    const int qh = (q >> 2) & 1, r = (q & 3) + 4 * (q >> 3), d0 = ch >> 2, dl = (ch & 3) * 8;
    const LAS3 float* p = finl + (d0 * 16 + r) * 64 + qh * 32 + dl;
    const f32x4_t x0 = *(const LAS3 f32x4_t*)p, x1 = *(const LAS3 f32x4_t*)(p + 4);
    u32x4 v; v.x = cvtpk(x0[0], x0[1]); v.y = cvtpk(x0[2], x0[3]); v.z = cvtpk(x1[0], x1[1]); v.w = cvtpk(x1[2], x1[3]);
    *(u32x4*)(gout + (rowbase + q) * (size_t)ld + colbase + ch * 8) = v;
  }
}

__device__ __forceinline__ void nsa_unit(int b, int g, int c, const bf16_t* __restrict__ proj, const bf16_t* __restrict__ kc, const bf16_t* __restrict__ vc, bf16_t* __restrict__ onsa, lptr lds) {
  int tid = threadIdx.x; asm volatile("" : "+v"(tid));
  const int lane = tid & 63, r32 = lane & 31, hi = lane >> 5;
  const int w = __builtin_amdgcn_readfirstlane(tid >> 6);
  const int rh = w >> 1, head = g * 4 + rh, tokl = 32 * (w & 1) + r32, t = 64 * c + tokl, bg = b * 2 + g;
  const size_t tok = (size_t)b * SEQ + t;
  LAS3 float* wsf = (LAS3 float*)(lds + L_WSF) + w * 64;
  const LAS3 float* tb = (const LAS3 float*)(lds + L_TB) + head * 320 + 64;
  const LAS3 float* stp = (const LAS3 float*)(lds + L_ST);
  LAS3 unsigned* selm = (LAS3 unsigned*)(lds + L_SELM);
  LAS3 float* sc = (LAS3 float*)(lds + L_SC);
  LAS3 float* impq = (LAS3 float*)(lds + L_IMPQ);
  LAS3 float* impl = (LAS3 float*)(lds + L_IMPL);
  const lcptr kb0 = (lcptr)lds + KOFF + hi * 1024 + r32 * 16;
  const lcptr vp0 = (lcptr)lds + VOFF + ((lane >> 4) & 1) * 32 + (lane & 3) * 8 + (4 * hi + ((lane & 15) >> 2)) * 64;
  bf16x8 qr[4];
#pragma unroll
  for (int d0 = 0; d0 < 4; ++d0) qr[d0] = *(const bf16x8*)(proj + tok * PROJ_LD + PC_Q + head * 64 + d0 * 16 + hi * 8);
  float gate[3];
#pragma unroll
  for (int j = 0; j < 3; ++j) gate[j] = 1.0f / (1.0f + ex2(-LOG2E * bf2f(proj[tok * PROJ_LD + PC_GATE + head * 3 + j])));
  LAS3 float* finl = (LAS3 float*)(lds + L_FIN) + w * 2048;
  f32x16 o[2]; unsigned pw[16];
  u32x4 rk, rv;
  {
    const KVSrc src{kc + (size_t)bg * 128 * 64, vc + (size_t)bg * 128 * 64, 64, 64};
    __syncthreads();
    kv_issue(src, 0, rk, rv, tid); kv_commit(lds, rk, rv, tid);
    kv_issue(src, 64, rk, rv, tid); kv_commit(lds + SLOT, rk, rv, tid);
    __syncthreads();
    f32x16 a0, a1, b0, b1;
    const int twmin = 64 * c + 32 * (w & 1), twmax = twmin + 31;
    const bool live0 = true, live1 = (16 * 32 + 31 <= twmax), live2 = (16 * 64 + 31 <= twmax), live3 = (16 * 96 + 31 <= twmax);
    qkt<4>(a0, a1, kb0, qr);
    if (live2) qkt<4>(b0, b1, kb0 + SLOT, qr); else { b0 = f32x16{}; b1 = f32x16{}; }
    float rm = NEG_INF;
#define CMP_QUARTER(P, QTR, LIVE) do { if (LIVE) { \
      if (!(16 * (32 * (QTR) + 31) + 31 + 112 < twmin)) { \
        _Pragma("unroll") for (int r = 0; r < 16; ++r) { int d_ = t - 16 * (32 * (QTR) + crow(r, hi)) - 31; d_ = d_ < -64 ? -64 : (d_ > 255 ? 255 : d_); P[r] += tb[d_]; } } \
      _Pragma("unroll") for (int r = 0; r < 16; ++r) rm = fmaxf(rm, P[r]); } } while (0)
    CMP_QUARTER(a0, 0, live0); CMP_QUARTER(a1, 1, live1); CMP_QUARTER(b0, 2, live2); CMP_QUARTER(b1, 3, live3);
#undef CMP_QUARTER
    rm = xmax(rm);
    const float mref = (rm == NEG_INF) ? 0.f : rm;
    float s = 0.f;
#define CMP_EXP(P, LIVE) do { if (LIVE) { _Pragma("unroll") for (int r = 0; r < 16; ++r) { P[r] = ex2(P[r] - mref); s += P[r]; } } else { _Pragma("unroll") for (int r = 0; r < 16; ++r) P[r] = 0.f; } } while (0)
    CMP_EXP(a0, live0); CMP_EXP(a1, live1); CMP_EXP(b0, live2); CMP_EXP(b1, live3);
#undef CMP_EXP
    s = xsum(s);
    const float inv = (s > 0.f) ? 1.0f / s : 0.f;
#pragma unroll
    for (int r = 0; r < 16; ++r) { a0[r] *= inv; a1[r] *= inv; b0[r] *= inv; b1[r] *= inv; }
    { LAS3 float* iq = impq + (rh * 64 + tokl) * 33; LAS3 float* il = impl + (rh * 64 + tokl) * 33;
#pragma unroll
      for (int q4 = 0; q4 < 4; ++q4) {
        const int gi = 2 * q4 + hi;
        iq[gi] = (a0[4 * q4] + a0[4 * q4 + 1]) + (a0[4 * q4 + 2] + a0[4 * q4 + 3]);           il[gi] = a0[4 * q4 + 3];
        iq[8 + gi] = (a1[4 * q4] + a1[4 * q4 + 1]) + (a1[4 * q4 + 2] + a1[4 * q4 + 3]);       il[8 + gi] = a1[4 * q4 + 3];
        iq[16 + gi] = (b0[4 * q4] + b0[4 * q4 + 1]) + (b0[4 * q4 + 2] + b0[4 * q4 + 3]);      il[16 + gi] = b0[4 * q4 + 3];
        iq[24 + gi] = (b1[4 * q4] + b1[4 * q4 + 1]) + (b1[4 * q4 + 2] + b1[4 * q4 + 3]);      il[24 + gi] = b1[4 * q4 + 3];
      } }
    o[0] = f32x16{}; o[1] = f32x16{};
#pragma unroll
    for (int i = 0; i < 8; ++i) { pw[i] = cvtpk(a0[2 * i], a0[2 * i + 1]); pw[8 + i] = cvtpk(a1[2 * i], a1[2 * i + 1]); }
    pv(o, vp0, pw);
    if (live2) {
#pragma unroll
      for (int i = 0; i < 8; ++i) { pw[i] = cvtpk(b0[2 * i], b0[2 * i + 1]); pw[8 + i] = cvtpk(b1[2 * i], b1[2 * i + 1]); }
      pv(o, vp0 + SLOT, pw); }
    if (hi == 0) wsf[r32] = gate[0];
#pragma unroll
    for (int r = 0; r < 16; ++r) { const float f = wsf[crow(r, hi)]; o[0][r] *= f; o[1][r] *= f; }
  }
  __syncthreads();
  const KVSrc ssrc{proj + (size_t)b * SEQ * PROJ_LD + PC_KV + 2 * 128 + g * 64, proj + (size_t)b * SEQ * PROJ_LD + PC_KV + 3 * 128 + g * 64, PROJ_LD, PROJ_LD};
  kv_issue(ssrc, 0, rk, rv, tid);
  {
    const int stok = tid >> 3, sub = tid & 7;
#pragma unroll
    for (int k = 0; k < 4; ++k) {
      const int n = sub * 4 + k;
      float imp = 0.f;
#pragma unroll
      for (int hh = 0; hh < 4; ++hh) imp += impq[(hh * 64 + stok) * 33 + n] + ((n > 0) ? impl[(hh * 64 + stok) * 33 + n - 1] : 0.f);
      sc[stok * 33 + n] = (n > c) ? -1.0f : ((n == 0 || n == c || n == c - 1) ? 1e4f : imp);
    }
    if (tid < 64) selm[tid] = 0u;
    __syncthreads();
    float srow[32];
#pragma unroll
    for (int mm = 0; mm < 32; ++mm) srow[mm] = sc[stok * 33 + mm];
    unsigned bits = 0u;
#pragma unroll
    for (int k = 0; k < 4; ++k) {
      const int n = sub * 4 + k; const float sv = sc[stok * 33 + n]; int rank = 0;
#pragma unroll
      for (int mm = 0; mm < 32; ++mm) rank += (srow[mm] > sv || (srow[mm] == sv && mm < n)) ? 1 : 0;
      if (rank < 16) bits |= 1u << n;
    }
    if (bits) atomicOr((unsigned*)(selm + stok), bits);
    __syncthreads();
  }
  const unsigned mysel = selm[tokl];
  fin_set(finl, o, lane);
#pragma unroll 1
  for (int br = 0; br < 2; ++br) {
    const KVSrc src = (br == 0) ? ssrc : KVSrc{proj + (size_t)b * SEQ * PROJ_LD + PC_KV + 4 * 128 + g * 64, proj + (size_t)b * SEQ * PROJ_LD + PC_KV + 5 * 128 + g * 64, PROJ_LD, PROJ_LD};
    const int n0 = (br == 0) ? 0 : ((c > 8) ? c - 8 : 0);
    if (br == 1) { __syncthreads(); kv_issue(src, n0 * 64, rk, rv, tid); }
    kv_commit(lds, rk, rv, tid);
    float m = -1e30f, l = 0.f;
    o[0] = f32x16{}; o[1] = f32x16{};
    int cur = 0;
#pragma unroll 1
    for (int n = n0; n <= c; ++n) {
      __syncthreads();
      if (n < c) kv_issue(src, (n + 1) * 64, rk, rv, tid);
      const bool mine = (br == 1) || ((mysel >> n) & 1u);
      if (__any(mine)) {
        f32x16 p0, p1;
        if (n + 2 >= c) {
          const LAS3 float* bp = tb + (t - 64 * n) - 4 * hi - 63;
          f32x16 c0, c1;
#pragma unroll
          for (int r = 0; r < 16; ++r) { c0[r] = bp[63 - ((r & 3) + 8 * (r >> 2))]; c1[r] = bp[31 - ((r & 3) + 8 * (r >> 2))]; }
          qkt_init<4>(p0, p1, kb0 + cur * SLOT, qr, c0, c1);
        } else if (br == 1 && n + 8 == c) {
          const LAS3 float* bp = stp + (607 - (t - 64 * n)) + 4 * hi;
          f32x16 c0, c1;
#pragma unroll
          for (int r = 0; r < 16; ++r) { c0[r] = bp[(r & 3) + 8 * (r >> 2)]; c1[r] = bp[32 + (r & 3) + 8 * (r >> 2)]; }
          qkt_init<4>(p0, p1, kb0 + cur * SLOT, qr, c0, c1);
        } else qkt<4>(p0, p1, kb0 + cur * SLOT, qr);
        softmax_step(p0, p1, m, l, o, wsf, r32, hi, pw, mine);
        pv(o, vp0 + cur * SLOT, pw);
      }
      if (n < c) kv_commit(lds + (cur ^ 1) * SLOT, rk, rv, tid);
      cur ^= 1;
    }
    l = xsum(l);
    const float gi = gate[1 + br] / fmaxf(l, 1e-30f);
    if (hi == 0) wsf[r32] = gi;
    fin_add(finl, o, wsf, lane, hi);
  }
  fin_store(finl, onsa, (size_t)b * SEQ + 64 * c + 32 * (w & 1), 1024, head * 64, lane);
}

__device__ __forceinline__ void mla_unit(int b, int h, int qb, const bf16_t* __restrict__ mq, const bf16_t* __restrict__ mkv, const bf16_t* __restrict__ kr, bf16_t* __restrict__ omla, lptr lds) {
  int tid = threadIdx.x; asm volatile("" : "+v"(tid));
  const int lane = tid & 63, r32 = lane & 31, hi = lane >> 5;
  const int w = __builtin_amdgcn_readfirstlane(tid >> 6);
  const int q0 = 256 * qb, qw = q0 + 32 * w, qpos = qw + r32;
  const size_t tokq = (size_t)b * SEQ + qpos;
  LAS3 float* wsf = (LAS3 float*)(lds + L_WSF) + w * 64;
  const lcptr kb0 = (lcptr)lds + KOFF + hi * 1024 + r32 * 16;
  const lcptr vp0 = (lcptr)lds + VOFF + ((lane >> 4) & 1) * 32 + (lane & 3) * 8 + (4 * hi + ((lane & 15) >> 2)) * 64;
  const LAS3 float* stp = (const LAS3 float*)(lds + L_ST);
  bf16x8 qr[6];
#pragma unroll
  for (int d0 = 0; d0 < 6; ++d0) qr[d0] = *(const bf16x8*)(mq + tokq * 768 + h * 96 + d0 * 16 + hi * 8);
  const KVSrc src{mkv + (size_t)b * SEQ * 1024 + h * 128, mkv + (size_t)b * SEQ * 1024 + h * 128 + 64, 1024, 1024};
  const bf16_t* krb = kr + (size_t)b * SEQ * 32;
  const int NTL = 4 * (qb + 1);
  u32x4 rk, rv, rr = {0u, 0u, 0u, 0u};
  f32x16 o[2]; o[0] = f32x16{}; o[1] = f32x16{};
  unsigned pw[16];
  float m = -1e30f, l = 0.f;
  __syncthreads();
  kv_issue(src, 0, rk, rv, tid);
  if (tid < 256) rr = *(const u32x4*)(krb + (size_t)(tid & 63) * 32 + (tid >> 6) * 8);
  kv_commit(lds, rk, rv, tid);
  if (tid < 256) *(LAS3 u32x4*)(lds + KOFF + (8 + (tid >> 6)) * 1024 + (tid & 63) * 16) = rr;
  int cur = 0;
#pragma unroll 1
  for (int tl = 0; tl < NTL; ++tl) {
    __syncthreads();
    if (tl + 1 < NTL) { kv_issue(src, (tl + 1) * 64, rk, rv, tid); if (tid < 256) rr = *(const u32x4*)(krb + (size_t)((tl + 1) * 64 + (tid & 63)) * 32 + (tid >> 6) * 8); }
    if (64 * tl <= qw + 31) {
      f32x16 p0, p1;
      if (64 * tl + 63 > qw) {
        const LAS3 float* bp = stp + 96 + (qpos - 64 * tl) - 4 * hi - 63;
        f32x16 c0, c1;
#pragma unroll
        for (int r = 0; r < 16; ++r) { c0[r] = bp[63 - ((r & 3) + 8 * (r >> 2))]; c1[r] = bp[31 - ((r & 3) + 8 * (r >> 2))]; }
        qkt_init<6>(p0, p1, kb0 + cur * SLOT, qr, c0, c1);
      } else qkt<6>(p0, p1, kb0 + cur * SLOT, qr);
      softmax_step(p0, p1, m, l, o, wsf, r32, hi, pw);
      pv(o, vp0 + cur * SLOT, pw);
    }
    if (tl + 1 < NTL) { kv_commit(lds + (cur ^ 1) * SLOT, rk, rv, tid); if (tid < 256) *(LAS3 u32x4*)(lds + (cur ^ 1) * SLOT + KOFF + (8 + (tid >> 6)) * 1024 + (tid & 63) * 16) = rr; }
    cur ^= 1;
  }
  l = xsum(l);
  if (hi == 0) wsf[r32] = 1.0f / fmaxf(l, 1e-30f);
#pragma unroll
  for (int r = 0; r < 16; ++r) { const float f = wsf[crow(r, hi)]; o[0][r] *= f; o[1][r] *= f; }
  LAS3 float* finl = (LAS3 float*)(lds + L_FIN) + w * 2048;
  fin_set(finl, o, lane);
  fin_store(finl, omla, (size_t)b * SEQ + qw, 1024, 512 + h * 64, lane);
}

__device__ __forceinline__ void attn_phase(const bf16_t* proj, const bf16_t* kc, const bf16_t* vc, const float* t5, bf16_t* onsa,
                                           const bf16_t* mq, const bf16_t* mkv, const bf16_t* kr, bf16_t* omla, lptr lds) {
  const int tid = threadIdx.x;
  { LAS3 float* tb = (LAS3 float*)(lds + L_TB);
    for (int i = tid; i < 8 * 320; i += NTHR) { const int hd = i / 320, d = i % 320 - 64; tb[i] = (d < 0) ? NEG_INF : ((d < 113) ? (t5[(int)T5B[d] * 8 + hd] - t5[31 * 8 + hd]) * LOG2E : 0.f); }
    LAS3 float* st = (LAS3 float*)(lds + L_ST);
    for (int i = tid; i < 192; i += NTHR) st[i] = (i < 96) ? NEG_INF : 0.f; }
  const int G = gridDim.x, bx = blockIdx.x;
  for (int v = (G % 8 == 0) ? (bx % 8) * (G / 8) + bx / 8 : bx; v < 256; v += G) {
    const int bg = v >> 4, p = v & 15, bh = v >> 2, j = v & 3;
#pragma unroll 1
    for (int u = 0; u < 2; ++u) nsa_unit(bg >> 1, bg & 1, u ? p : 31 - p, proj, kc, vc, onsa, lds);
#pragma unroll 1
    for (int u = 0; u < 2; ++u) mla_unit(bh >> 3, bh & 7, u ? j : 7 - j, mq, mkv, kr, omla, lds);
  }
}
#undef LAS3
}


namespace peer {
using bf16x8 = __attribute__((ext_vector_type(8))) short;
using f32x16 = __attribute__((ext_vector_type(16))) float;
typedef unsigned u32x4 __attribute__((ext_vector_type(4)));
typedef float f32x4_t __attribute__((ext_vector_type(4)));
typedef __bf16 bf16x2_t __attribute__((ext_vector_type(2)));
typedef float f32x2_t __attribute__((ext_vector_type(2)));
#define LAS3 __attribute__((address_space(3)))
__device__ __forceinline__ int crow(int r, int hi) { return (r & 3) + 8 * (r >> 2) + 4 * hi; }
__device__ __forceinline__ unsigned enc(float f) { const unsigned u = __float_as_uint(f); return u ^ ((unsigned)((int)u >> 31) | 0x80000000u); }
__device__ __forceinline__ float dec(unsigned k) { return __uint_as_float(k ^ (~(unsigned)((int)k >> 31) | 0x80000000u)); }
__device__ __forceinline__ unsigned umax(unsigned a, unsigned b) { return a > b ? a : b; }
__device__ __forceinline__ unsigned umin(unsigned a, unsigned b) { return a < b ? a : b; }
__device__ __forceinline__ unsigned cvtpk(float lo, float hi) { f32x2_t v = {lo, hi}; bf16x2_t b = __builtin_convertvector(v, bf16x2_t); return __builtin_bit_cast(unsigned, b); }
template <int B, int N> __device__ __forceinline__ void sort16(unsigned (&k)[N]) {
#pragma unroll
  for (int size = 2; size <= 16; size <<= 1)
#pragma unroll
    for (int stride = size >> 1; stride > 0; stride >>= 1)
#pragma unroll
      for (int i = 0; i < 16; ++i) { const int l = i ^ stride;
        if (l > i) { const bool desc = ((i & size) == 0); const unsigned a = k[B + i], b = k[B + l]; const unsigned mx = umax(a, b), mn = umin(a, b); k[B + i] = desc ? mx : mn; k[B + l] = desc ? mn : mx; } }
}
template <int A, int Bo, int N> __device__ __forceinline__ void merge16(unsigned (&k)[N]) {
#pragma unroll
  for (int i = 0; i < 16; ++i) k[A + i] = umax(k[A + i], k[Bo + 15 - i]);
#pragma unroll
  for (int stride = 8; stride > 0; stride >>= 1)
#pragma unroll
    for (int i = 0; i < 16; ++i) { const int l = i ^ stride; if (l > i) { const unsigned a = k[A + i], b = k[A + l]; k[A + i] = umax(a, b); k[A + l] = umin(a, b); } }
}
template <int N> __device__ __forceinline__ void top16_of_64(unsigned (&k)[N]) {
  sort16<0>(k); sort16<16>(k); sort16<32>(k); sort16<48>(k);
  merge16<0, 16>(k); merge16<32, 48>(k); merge16<0, 32>(k);
}

__device__ __forceinline__ void route_phase(const bf16_t* __restrict__ pq, const bf16_t* __restrict__ subk, unsigned* __restrict__ pack, LAS3 char* lds, int pm, int pn) {
  int tid = threadIdx.x; asm volatile("" : "+v"(tid));
  const int lane = tid & 63, r32 = lane & 31, hi = lane >> 5, wv = tid >> 6;
  LAS3 unsigned char* myb = (LAS3 unsigned char*)lds + wv * 2560 + lane * 40;
#pragma unroll 1
  for (int item = wv; item < 16; item += NWV) {
    const int h = pn * 2 + (item >> 3), t0 = pm * 256 + (item & 7) * 32;
    unsigned la[16], lb[16];
#pragma unroll
    for (int i = 0; i < 16; ++i) { la[i] = 0u; lb[i] = 0u; }
#pragma unroll 1
    for (int p = 0; p < 2; ++p) {
      f32x16 acc[4];
#pragma unroll
      for (int kt = 0; kt < 4; ++kt) acc[kt] = f32x16{};
#pragma unroll
      for (int kd = 0; kd < 4; ++kd) {
        const bf16x8 bq = *(const bf16x8*)(pq + (size_t)(t0 + r32) * 1024 + h * 128 + p * 64 + kd * 16 + hi * 8);
#pragma unroll
        for (int kt = 0; kt < 4; ++kt) {
          const bf16x8 ak = *(const bf16x8*)(subk + (size_t)((h * 2 + p) * 128 + kt * 32 + r32) * 64 + kd * 16 + hi * 8);
          acc[kt] = __builtin_amdgcn_mfma_f32_32x32x16_bf16(ak, bq, acc[kt], 0, 0, 0);
        }
      }
      unsigned k[64];
#pragma unroll
      for (int kt = 0; kt < 4; ++kt)
#pragma unroll
        for (int r = 0; r < 16; ++r) k[kt * 16 + r] = (enc(acc[kt][r]) & 0xFFFFFF80u) | (unsigned)(127 - (32 * kt + crow(r, hi)));
      top16_of_64(k);
#pragma unroll
      for (int i = 0; i < 16; ++i) { auto rr = __builtin_amdgcn_permlane32_swap(k[i], k[i], false, false); unsigned r0 = rr[0], r1 = rr[1]; asm volatile("" : "+v"(r0), "+v"(r1)); k[16 + i] = hi ? r0 : r1; }
      merge16<0, 16>(k);
#pragma unroll
      for (int i = 0; i < 16; ++i) { la[i] = (p == 0) ? k[i] : la[i]; lb[i] = (p == 0) ? lb[i] : k[i]; }
      __builtin_amdgcn_sched_barrier(0);
    }
#pragma unroll
    for (int i = 0; i < 4; ++i) {
      const unsigned wa = (127u - (la[4 * i] & 127u)) | ((127u - (la[4 * i + 1] & 127u)) << 8) | ((127u - (la[4 * i + 2] & 127u)) << 16) | ((127u - (la[4 * i + 3] & 127u)) << 24);
      const unsigned wb = (127u - (lb[4 * i] & 127u)) | ((127u - (lb[4 * i + 1] & 127u)) << 8) | ((127u - (lb[4 * i + 2] & 127u)) << 16) | ((127u - (lb[4 * i + 3] & 127u)) << 24);
      *(LAS3 unsigned*)(myb + 4 * i) = wa; *(LAS3 unsigned*)(myb + 16 + 4 * i) = wb;
    }
    float va[16], vb[16];
#pragma unroll
    for (int i = 0; i < 16; ++i) { va[i] = dec(la[i] & 0xFFFFFF80u); vb[i] = dec(lb[i] & 0xFFFFFF80u); }
    unsigned k[64];
#define PEER_CAND(n, i, j) k[n] = (enc(va[i] + vb[j]) & 0xFFFFFF00u) | (unsigned)(255 - ((i) * 16 + (j)))
    PEER_CAND(0, 0, 0); PEER_CAND(1, 0, 1); PEER_CAND(2, 0, 2); PEER_CAND(3, 0, 3); PEER_CAND(4, 0, 4); PEER_CAND(5, 0, 5);
    PEER_CAND(6, 0, 6); PEER_CAND(7, 0, 7); PEER_CAND(8, 0, 8); PEER_CAND(9, 0, 9); PEER_CAND(10, 0, 10); PEER_CAND(11, 0, 11);
    PEER_CAND(12, 0, 12); PEER_CAND(13, 0, 13); PEER_CAND(14, 0, 14); PEER_CAND(15, 0, 15); PEER_CAND(16, 1, 0); PEER_CAND(17, 1, 1);
    PEER_CAND(18, 1, 2); PEER_CAND(19, 1, 3); PEER_CAND(20, 1, 4); PEER_CAND(21, 1, 5); PEER_CAND(22, 1, 6); PEER_CAND(23, 1, 7);
    PEER_CAND(24, 2, 0); PEER_CAND(25, 2, 1); PEER_CAND(26, 2, 2); PEER_CAND(27, 2, 3); PEER_CAND(28, 2, 4); PEER_CAND(29, 3, 0);
    PEER_CAND(30, 3, 1); PEER_CAND(31, 3, 2); PEER_CAND(32, 3, 3); PEER_CAND(33, 4, 0); PEER_CAND(34, 4, 1); PEER_CAND(35, 4, 2);
    PEER_CAND(36, 5, 0); PEER_CAND(37, 5, 1); PEER_CAND(38, 6, 0); PEER_CAND(39, 6, 1); PEER_CAND(40, 7, 0); PEER_CAND(41, 7, 1);
    PEER_CAND(42, 8, 0); PEER_CAND(43, 9, 0); PEER_CAND(44, 10, 0); PEER_CAND(45, 11, 0); PEER_CAND(46, 12, 0); PEER_CAND(47, 13, 0);
    PEER_CAND(48, 14, 0); PEER_CAND(49, 15, 0);
#undef PEER_CAND
#pragma unroll
    for (int z = 50; z < 64; ++z) k[z] = 0u;
    top16_of_64(k);
    const float best0 = dec(k[0] & 0xFFFFFF00u);
    float ev[16]; float den = 0.f;
#pragma unroll
    for (int i = 0; i < 16; ++i) { ev[i] = __expf(dec(k[i] & 0xFFFFFF00u) - best0); den += ev[i]; }
    const float inv = 1.0f / den;
    unsigned outw[8];
#pragma unroll
    for (int i = 0; i < 8; ++i) {
      unsigned k_lo = k[i], k_hi = k[8 + i]; float e_lo = ev[i], e_hi = ev[8 + i];
      asm volatile("" : "+v"(k_lo), "+v"(k_hi), "+v"(e_lo), "+v"(e_hi));
      const unsigned kk = hi ? k_hi : k_lo; const float e = hi ? e_hi : e_lo;
      const unsigned f = 255u - (kk & 255u);
      const unsigned ia = myb[f >> 4], ib = myb[16 + (f & 15u)];
      outw[i] = (ia * 128u + ib) | (cvtpk(0.f, e * inv) & 0xFFFF0000u);
    }
    unsigned* dst = pack + (size_t)(t0 + r32) * 128 + h * 16 + hi * 8;
    *(u32x4*)dst = (u32x4){outw[0], outw[1], outw[2], outw[3]};
    *(u32x4*)(dst + 4) = (u32x4){outw[4], outw[5], outw[6], outw[7]};
  }
}

__device__ __forceinline__ void conv_tables(const float* __restrict__ u, const float* __restrict__ v, unsigned* __restrict__ u8, float* __restrict__ su, unsigned* __restrict__ v8) {
  const int tid = threadIdx.x, lane = tid & 63, wv = tid >> 6;
  const int gw = blockIdx.x * NWV + wv, nw = gridDim.x * NWV;
  for (int e = gw; e < 16384; e += nw) {
    const f32x4_t* ur = (const f32x4_t*)(u + (size_t)e * 1024) + lane * 4;
    f32x4_t a[4]; float mx = 0.f;
#pragma unroll
    for (int i = 0; i < 4; ++i) { a[i] = ur[i]; mx = fmaxf(mx, fmaxf(fmaxf(fabsf(a[i][0]), fabsf(a[i][1])), fmaxf(fabsf(a[i][2]), fabsf(a[i][3])))); }
    mx = wmaxf(mx);
    const float sc = fmaxf(mx, 1e-30f) * (1.0f / 127.0f), isc = 1.0f / sc;
    u32x4 o;
#pragma unroll
    for (int i = 0; i < 4; ++i) {
      const int q0 = (int)rintf(a[i][0] * isc), q1 = (int)rintf(a[i][1] * isc), q2 = (int)rintf(a[i][2] * isc), q3 = (int)rintf(a[i][3] * isc);
      o[i] = (unsigned)(q0 & 255) | ((unsigned)(q1 & 255) << 8) | ((unsigned)(q2 & 255) << 16) | ((unsigned)(q3 & 255) << 24);
    }
    *(u32x4*)(u8 + (size_t)e * 256 + lane * 4) = o;
    if (lane == 0) su[e] = sc;
    const f32x4_t* vr = (const f32x4_t*)(v + (size_t)e * 1024) + lane * 4;
    u32x4 ov;
#pragma unroll
    for (int i = 0; i < 4; ++i) { const f32x4_t b = vr[i]; unsigned w = 0u; w = __builtin_amdgcn_cvt_pk_fp8_f32(2.0f * b[0], 2.0f * b[1], w, false); w = __builtin_amdgcn_cvt_pk_fp8_f32(2.0f * b[2], 2.0f * b[3], w, true); ov[i] = w; }
    *(u32x4*)(v8 + ((size_t)(lane >> 3) * 16384 + e) * 32 + (lane & 7) * 4) = ov;
  }
}
__device__ __forceinline__ float gelu_fast(float v) {
  const float av = __builtin_fabsf(v), t = __builtin_amdgcn_rcpf(av * 0.2316418882f + 1.0f);
  float q = t * 0.5307027145f + (-0.7265760135f); q = q * t + 0.7107068705f; q = q * t + (-0.142248368f); q = q * t + 0.127414796f; q = q * t;
  const float e = __builtin_amdgcn_exp2f((v * v) * (-0.72134752044f));
  const float m = v * (q * e);
  return v < 0.f ? m : v - m;
}
__device__ __forceinline__ unsigned xcc_id() { return (unsigned)__builtin_amdgcn_s_getreg((3 << 11) | 20) & 7u; }
struct ABuf { unsigned w, meta; u32x4 ub[8]; float sue; };
__device__ __forceinline__ void expA_issue(ABuf& B, int k0, int n, const LAS3 unsigned* list, const unsigned* __restrict__ u8, const float* __restrict__ su, int j8) {
  const int k = (k0 < n) ? k0 : 0;
  B.w = list[2 * k]; B.meta = list[2 * k + 1];
  const unsigned e = B.w & 0xFFFFu;
  const unsigned* urow = u8 + (size_t)e * 256 + j8 * 4;
#pragma unroll
  for (int seg = 0; seg < 8; ++seg) B.ub[seg] = *(const u32x4*)(urow + seg * 32);
  B.sue = su[e];
}
__device__ __forceinline__ void expA_consume(const ABuf& B, int k0, int n, const LAS3 char* hl, const LAS3 float* shl, float* __restrict__ co, int t0, int j8) {
  const int tokl = (int)(B.meta >> 8), slot = (int)(B.meta & 255u);
  const LAS3 char* hrow = hl + tokl * 1024 + j8 * 16;
  int a0 = 0, a1 = 0, a2 = 0, a3 = 0;
#pragma unroll
  for (int seg = 0; seg < 8; ++seg) { const u32x4 hq = *(const LAS3 u32x4*)(hrow + seg * 128);
    a0 = __builtin_amdgcn_sdot4((int)B.ub[seg].x, (int)hq.x, a0, false); a1 = __builtin_amdgcn_sdot4((int)B.ub[seg].y, (int)hq.y, a1, false);
    a2 = __builtin_amdgcn_sdot4((int)B.ub[seg].z, (int)hq.z, a2, false); a3 = __builtin_amdgcn_sdot4((int)B.ub[seg].w, (int)hq.w, a3, false); }
  int acc = (a0 + a1) + (a2 + a3);
  acc += dpp_i<0xB1>(acc); acc += dpp_i<0x4E>(acc); acc += dpp_i<0x141>(acc);
  const float d = (float)acc * (B.sue * shl[tokl]);
  const float c = 0.5f * __uint_as_float(B.w & 0xFFFF0000u) * gelu_fast(d);
  if (j8 == 0 && k0 < n) co[(size_t)(t0 + tokl) * 128 + slot] = c;
}
struct AStage { u32x4 pw[4], hst[8]; float shv; };
__device__ __forceinline__ void expA_stage(AStage& S, int item, const unsigned* __restrict__ pack, const unsigned* __restrict__ hn8, const float* __restrict__ shp, int tid) {
  const int t0 = item * 64, tokl = tid >> 3, sb = (tid & 7) * 16;
#pragma unroll
  for (int i = 0; i < 4; ++i) S.pw[i] = *(const u32x4*)(pack + (size_t)(t0 + tokl) * 128 + sb + 4 * i);
#pragma unroll
  for (int i = 0; i < 8; ++i) S.hst[i] = *(const u32x4*)(hn8 + (size_t)t0 * 256 + (tid + 512 * i) * 4);
  S.shv = (tid < 64) ? shp[t0 + tid] : 0.f;
}
__device__ __forceinline__ void expA_item(AStage& S, int item, int nitem, int xs, const unsigned* __restrict__ pack, const unsigned* __restrict__ hn8, const float* __restrict__ shp, const unsigned* __restrict__ u8, const float* __restrict__ su,
                                          float* __restrict__ co, LAS3 char* lds, int tid) {
  const int lane = tid & 63, wv = tid >> 6;
  LAS3 char* hl = lds + 1024;
  LAS3 float* shl = (LAS3 float*)(lds + 1024 + 65536);
  LAS3 unsigned* cnt = (LAS3 unsigned*)(lds + 16);
  LAS3 unsigned* list = (LAS3 unsigned*)(lds + 1024 + 65536 + 256);
  const int t0 = item * 64;
  const int tokl = tid >> 3, sb = (tid & 7) * 16;
#pragma unroll
  for (int i = 0; i < 8; ++i) *(LAS3 u32x4*)(hl + (tid + 512 * i) * 16) = S.hst[i];
  if (tid < 64) shl[tid] = S.shv;
  {
    unsigned long long mk[16]; int tot = 0; int off[16];
#pragma unroll
    for (int j = 0; j < 16; ++j) { const unsigned w = S.pw[j >> 2][j & 3]; mk[j] = __ballot(((w & 0xFFFFu) >> 11) == (unsigned)xs); off[j] = tot; tot += __builtin_popcountll(mk[j]); }
    int base = 0;
    if (lane == 0) base = (int)__hip_atomic_fetch_add(cnt, (unsigned)tot, __ATOMIC_RELAXED, __HIP_MEMORY_SCOPE_WORKGROUP);
    base = __builtin_amdgcn_readfirstlane(base);
#pragma unroll
    for (int j = 0; j < 16; ++j) { const unsigned w = S.pw[j >> 2][j & 3];
      if (((w & 0xFFFFu) >> 11) == (unsigned)xs) { const int pos = base + off[j] + (int)__builtin_amdgcn_mbcnt_hi((unsigned)(mk[j] >> 32), __builtin_amdgcn_mbcnt_lo((unsigned)mk[j], 0u));
        list[2 * pos] = w; list[2 * pos + 1] = (unsigned)((tokl << 8) | (sb + j)); } }
  }
  if (nitem < T / 64) expA_stage(S, nitem, pack, hn8, shp, tid);
  __syncthreads();
  const int n = (int)cnt[0];
  const int j8 = lane & 7, gidx = wv * 8 + (lane >> 3);
  ABuf A, Bb;
  expA_issue(A, gidx, n, list, u8, su, j8);
#pragma unroll 1
  for (int k0 = gidx; k0 < n; k0 += 128) {
    expA_issue(Bb, k0 + 64, n, list, u8, su, j8);
    expA_consume(A, k0, n, hl, shl, co, t0, j8);
    expA_issue(A, k0 + 128, n, list, u8, su, j8);
    expA_consume(Bb, k0 + 64, n, hl, shl, co, t0, j8);
  }
}
struct BBuf { u32x4 vv[8]; f32x4_t c[2]; };
__device__ __forceinline__ void expB_issue(BBuf& B, const LAS3 unsigned* pkl, const LAS3 float* col, int sg8, const unsigned* __restrict__ vbase) {
  const u32x4 p0 = *(const LAS3 u32x4*)(pkl + sg8 * 8), p1 = *(const LAS3 u32x4*)(pkl + sg8 * 8 + 4);
  B.c[0] = *(const LAS3 f32x4_t*)(col + sg8 * 8); B.c[1] = *(const LAS3 f32x4_t*)(col + sg8 * 8 + 4);
#pragma unroll
  for (int j = 0; j < 4; ++j) { B.vv[j] = *(const u32x4*)(vbase + (size_t)(p0[j] & 0xFFFFu) * 32); B.vv[4 + j] = *(const u32x4*)(vbase + (size_t)(p1[j] & 0xFFFFu) * 32); }
}
__device__ __forceinline__ void expB_consume(const BBuf& B, f32x2_t (&y)[8]) {
#pragma unroll
  for (int j = 0; j < 8; ++j) {
    const float cv = B.c[j >> 2][j & 3];
    const f32x2_t c2 = {cv, cv};
#pragma unroll
    for (int w = 0; w < 4; ++w) {
      y[2 * w] = __builtin_elementwise_fma(__builtin_amdgcn_cvt_pk_f32_fp8(B.vv[j][w], false), c2, y[2 * w]);
      y[2 * w + 1] = __builtin_elementwise_fma(__builtin_amdgcn_cvt_pk_f32_fp8(B.vv[j][w], true), c2, y[2 * w + 1]);
    }
  }
}
__device__ __forceinline__ void expB_item(int item, int xs, const unsigned* __restrict__ pack, const float* __restrict__ co, const unsigned* __restrict__ v8, bf16_t* __restrict__ zb, float* __restrict__ ssq, LAS3 char* lds, int tid,
                                          const float* __restrict__ xin, const bf16_t* __restrict__ ob) {
  const int lane = tid & 63, wv = tid >> 6, r8 = lane >> 3, c8 = lane & 7;
  const int t0 = item * 64 + wv * 8;
  LAS3 unsigned* pkw = (LAS3 unsigned*)(lds + 1024 + wv * 8192);
  LAS3 float* cow = (LAS3 float*)(lds + 1024 + wv * 8192 + 4096);
  {
    u32x4 a[4]; f32x4_t b[4];
#pragma unroll
    for (int i = 0; i < 4; ++i) { a[i] = *(const u32x4*)(pack + (size_t)t0 * 128 + (lane + 64 * i) * 4); b[i] = *(const f32x4_t*)(co + (size_t)t0 * 128 + (lane + 64 * i) * 4); }
#pragma unroll
    for (int i = 0; i < 4; ++i) { *(LAS3 u32x4*)(pkw + (lane + 64 * i) * 4) = a[i]; *(LAS3 f32x4_t*)(cow + (lane + 64 * i) * 4) = b[i]; }
  }
  const size_t hoff = (size_t)(t0 + r8) * 1024 + xs * 128 + c8 * 16;
  f32x4_t h[4];
  { const u32x4 o0 = *(const u32x4*)(ob + hoff), o1 = *(const u32x4*)(ob + hoff + 8);
#pragma unroll
    for (int w = 0; w < 4; ++w) h[w] = *(const f32x4_t*)(xin + hoff + 4 * w);
    h[0] += (f32x4_t){__uint_as_float(o0.x << 16), __uint_as_float(o0.x & 0xffff0000u), __uint_as_float(o0.y << 16), __uint_as_float(o0.y & 0xffff0000u)};
    h[1] += (f32x4_t){__uint_as_float(o0.z << 16), __uint_as_float(o0.z & 0xffff0000u), __uint_as_float(o0.w << 16), __uint_as_float(o0.w & 0xffff0000u)};
    h[2] += (f32x4_t){__uint_as_float(o1.x << 16), __uint_as_float(o1.x & 0xffff0000u), __uint_as_float(o1.y << 16), __uint_as_float(o1.y & 0xffff0000u)};
    h[3] += (f32x4_t){__uint_as_float(o1.z << 16), __uint_as_float(o1.z & 0xffff0000u), __uint_as_float(o1.w << 16), __uint_as_float(o1.w & 0xffff0000u)}; }
  wave_lds_sync();
  const LAS3 unsigned* pkl = pkw + r8 * 128; const LAS3 float* col = cow + r8 * 128;
  const unsigned* vbase = v8 + (size_t)xs * 16384 * 32 + c8 * 4;
  f32x2_t y[8];
#pragma unroll
  for (int i = 0; i < 8; ++i) y[i] = (f32x2_t){0.f, 0.f};
  BBuf A, Bb;
  expB_issue(A, pkl, col, 0, vbase);
#pragma unroll 1
  for (int sg = 0; sg < 16; sg += 2) {
    expB_issue(Bb, pkl, col, sg + 1, vbase);
    expB_consume(A, y);
    if (sg + 2 < 16) expB_issue(A, pkl, col, sg + 2, vbase);
    expB_consume(Bb, y);
  }
  float ss = 0.f; unsigned zw[8];
#pragma unroll
  for (int w = 0; w < 4; ++w) {
    const f32x4_t z = {h[w][0] + y[2 * w][0], h[w][1] + y[2 * w][1], h[w][2] + y[2 * w + 1][0], h[w][3] + y[2 * w + 1][1]};
    zw[2 * w] = cvtpk(z[0], z[1]); zw[2 * w + 1] = cvtpk(z[2], z[3]);
    ss += (z[0] * z[0] + z[1] * z[1]) + (z[2] * z[2] + z[3] * z[3]);
  }
  *(u32x4*)(zb + hoff) = (u32x4){zw[0], zw[1], zw[2], zw[3]}; *(u32x4*)(zb + hoff + 8) = (u32x4){zw[4], zw[5], zw[6], zw[7]};
  ss += dpp_f<0xB1>(ss); ss += dpp_f<0x4E>(ss); ss += dpp_f<0x141>(ss);
  if (c8 == 0) ssq[(size_t)xs * T + t0 + r8] = ss;
  wave_lds_sync();
}
template <int PASS> __device__ __forceinline__ void experts_sliced(const unsigned* __restrict__ pack, const unsigned* __restrict__ hn8, const float* __restrict__ shp, const unsigned* __restrict__ u8, const float* __restrict__ su,
                                                                    float* __restrict__ co, const unsigned* __restrict__ v8, float* __restrict__ out, float* __restrict__ ssq, unsigned* __restrict__ ctr, LAS3 char* lds,
                                                                    const float* __restrict__ xin = nullptr, const bf16_t* __restrict__ ob = nullptr) {
  int tid = threadIdx.x; asm volatile("" : "+v"(tid));
  LAS3 volatile int* lw = (LAS3 volatile int*)lds;
  const int xme = (int)xcc_id();
#pragma unroll 1
  for (int s8 = 0; s8 < 8; ++s8) {
    const int xs = (xme + s8) & 7;
    if (PASS == 0) {
      int nxt = 0;
      if (tid == 0) nxt = (int)atomicAdd(ctr + 64 * xs, 1u);
      __syncthreads();
      if (tid == 0) lw[0] = nxt;
      __syncthreads();
      int item = lw[0];
      if (item >= T / 64) continue;
      if (tid == 0) nxt = (int)atomicAdd(ctr + 64 * xs, 1u);
      AStage SA;
      expA_stage(SA, item, pack, hn8, shp, tid);
#pragma unroll 1
      for (;;) {
        __syncthreads();
        if (tid == 0) { lw[0] = nxt; lw[4] = 0; }
        __syncthreads();
        const int nitem = lw[0];
        if (tid == 0) nxt = (int)atomicAdd(ctr + 64 * xs, 1u);
        expA_item(SA, item, nitem, xs, pack, hn8, shp, u8, su, co, lds, tid);
        if (nitem >= T / 64) break;
        item = nitem;
      }
    } else {
      int nxt = 0;
      if (tid == 0) nxt = (int)atomicAdd(ctr + 64 * xs, 1u);
#pragma unroll 1
      for (;;) {
        __syncthreads();
        if (tid == 0) lw[0] = nxt;
        __syncthreads();
        const int item = lw[0];
        if (item >= T / 64) break;
        if (tid == 0) nxt = (int)atomicAdd(ctr + 64 * xs, 1u);
        expB_item(item, xs, pack, co, v8, (bf16_t*)out, ssq, lds, tid, xin, ob);
      }
    }
  }
}
__device__ __forceinline__ void experts_norm(const float* __restrict__ ssq, const float* __restrict__ gfin, const bf16_t* __restrict__ zb, float* __restrict__ out) {
  const int tid = threadIdx.x, lane = tid & 63, wv = tid >> 6;
  const int gw = blockIdx.x * NWV + wv, nw = gridDim.x * NWV;
  for (int t = gw; t < T; t += nw) {
    float ss = 0.f;
#pragma unroll
    for (int x = 0; x < 8; ++x) ss += ssq[(size_t)x * T + t];
    const float inv = rsqrtf(ss * (1.0f / 1024.0f) + 1e-6f);
    float* op = out + (size_t)t * 1024 + lane * 16; const float* gp = gfin + lane * 16;
    const u32x4 z0 = *(const u32x4*)(zb + (size_t)t * 1024 + lane * 16), z1 = *(const u32x4*)(zb + (size_t)t * 1024 + lane * 16 + 8);
    const unsigned zz[8] = {z0.x, z0.y, z0.z, z0.w, z1.x, z1.y, z1.z, z1.w};
#pragma unroll
    for (int i = 0; i < 4; ++i) { const f32x4_t z = {__uint_as_float(zz[2 * i] << 16), __uint_as_float(zz[2 * i] & 0xffff0000u), __uint_as_float(zz[2 * i + 1] << 16), __uint_as_float(zz[2 * i + 1] & 0xffff0000u)};
      const f32x4_t g = *(const f32x4_t*)(gp + 4 * i); *(f32x4_t*)(op + 4 * i) = z * inv * g; }
  }
}
#undef LAS3
}

namespace prep {
typedef unsigned u32x2_t __attribute__((ext_vector_type(2)));
typedef float f32x4_t __attribute__((ext_vector_type(4)));
typedef unsigned u32x4 __attribute__((ext_vector_type(4)));
using bf16x8 = __attribute__((ext_vector_type(8))) short;
using f32x16 = __attribute__((ext_vector_type(16))) float;
__device__ __forceinline__ unsigned pk2(float lo, float hi) { return (unsigned)f2bf(lo) | ((unsigned)f2bf(hi) << 16); }
__device__ __forceinline__ void latent_rows(const bf16_t* __restrict__ proj, const float* __restrict__ gq, const float* __restrict__ gkv, const float2* __restrict__ cs,
                                            bf16_t* __restrict__ cqn, bf16_t* __restrict__ ckvn, bf16_t* __restrict__ krope, int wave_id, int nwaves, int lane) {
  const f32x4_t g4 = *(const f32x4_t*)(gq + lane * 4);
  const float2 g2 = *(const float2*)(gkv + lane * 2);
  for (int r = wave_id; r < T; r += nwaves) {
    const bf16_t* row = proj + (size_t)r * PROJ_LD;
    const u32x2_t q = *(const u32x2_t*)(row + PC_CQ + lane * 4);
    const unsigned kv = *(const unsigned*)(row + PC_CKV + lane * 2);
    const unsigned short kr0 = row[PC_KR + (lane & 15)], kr1 = row[PC_KR + 16 + (lane & 15)];
    const float q0 = __uint_as_float(q.x << 16), q1 = __uint_as_float(q.x & 0xffff0000u), q2 = __uint_as_float(q.y << 16), q3 = __uint_as_float(q.y & 0xffff0000u);
    const float k0 = __uint_as_float(kv << 16), k1 = __uint_as_float(kv & 0xffff0000u);
    float sq = (q0 * q0 + q1 * q1) + (q2 * q2 + q3 * q3), sk = k0 * k0 + k1 * k1;
    sq = wsum(sq); sk = wsum(sk);
    const float iq = rsqrtf(sq * (1.0f / 256.0f) + 1e-6f), ik = rsqrtf(sk * (1.0f / 128.0f) + 1e-6f);
    u32x2_t oq; oq.x = pk2(q0 * iq * g4[0], q1 * iq * g4[1]); oq.y = pk2(q2 * iq * g4[2], q3 * iq * g4[3]);
    *(u32x2_t*)(cqn + (size_t)r * 256 + lane * 4) = oq;
    *(unsigned*)(ckvn + (size_t)r * 128 + lane * 2) = pk2(k0 * ik * g2.x, k1 * ik * g2.y);
    if (lane < 16) {
      const float2 c = cs[(r & (SEQ - 1)) * 16 + lane];
      const float x1 = bf2f(kr0), x2 = bf2f(kr1);
      krope[(size_t)r * 32 + lane] = f2bf(x1 * c.x - x2 * c.y); krope[(size_t)r * 32 + 16 + lane] = f2bf(x2 * c.x + x1 * c.y);
    }
  }
}
__device__ __forceinline__ void cmp_bias(const float* __restrict__ posk, const float* __restrict__ posv, const bf16_t* __restrict__ w1k, const bf16_t* __restrict__ w1v, float* __restrict__ cpos, int wave_id, int nwaves, int lane) {
  for (int o = wave_id; o < 512; o += nwaves) {
    const int tab = o >> 8, n = o & 255;
    const float* pos = tab ? posv : posk; const bf16_t* w = (tab ? w1v : w1k) + (size_t)n * 2048;
    float acc = 0.f;
#pragma unroll
    for (int i = 0; i < 4; ++i) { const int k = (i * 64 + lane) * 8;
      const u32x4 wv = *(const u32x4*)(w + k); const f32x4_t p0 = *(const f32x4_t*)(pos + k), p1 = *(const f32x4_t*)(pos + k + 4);
      acc += p0[0] * __uint_as_float(wv.x << 16) + p0[1] * __uint_as_float(wv.x & 0xffff0000u) + p0[2] * __uint_as_float(wv.y << 16) + p0[3] * __uint_as_float(wv.y & 0xffff0000u);
      acc += p1[0] * __uint_as_float(wv.z << 16) + p1[1] * __uint_as_float(wv.z & 0xffff0000u) + p1[2] * __uint_as_float(wv.w << 16) + p1[3] * __uint_as_float(wv.w & 0xffff0000u); }
    acc = wsum(acc);
    if (lane == 0) cpos[o] = acc;
  }
}
__device__ __forceinline__ void cmp_l2(const float* __restrict__ slab, const float* __restrict__ cpos, const bf16_t* __restrict__ w2t, bf16_t* __restrict__ outkc, int item, int lane) {
  const int r32 = lane & 31, hi = lane >> 5, m0 = item * 32;
  f32x16 acc0 = f32x16{}, acc1 = f32x16{};
  f32x4_t sa[2][8]; f32x4_t cp[2][2]; bf16x8 wb[2][2];
#define CMPL2_LOAD(buf, ks_) do { const int k_ = (ks_) * 16 + hi * 8; \
    cp[buf][0] = *(const f32x4_t*)(cpos + k_); cp[buf][1] = *(const f32x4_t*)(cpos + k_ + 4); \
    _Pragma("unroll") for (int sp = 0; sp < 4; ++sp) { const float* p_ = slab + ((size_t)sp * 2048 + m0 + r32) * 256 + k_; sa[buf][2 * sp] = *(const f32x4_t*)p_; sa[buf][2 * sp + 1] = *(const f32x4_t*)(p_ + 4); } \
    wb[buf][0] = *(const bf16x8*)(w2t + (size_t)r32 * 256 + k_); wb[buf][1] = *(const bf16x8*)(w2t + (size_t)(32 + r32) * 256 + k_); } while (0)
#define CMPL2_MMA(buf) do { f32x4_t a0 = cp[buf][0], a1 = cp[buf][1]; \
    _Pragma("unroll") for (int sp = 0; sp < 4; ++sp) { a0 += sa[buf][2 * sp]; a1 += sa[buf][2 * sp + 1]; } \
    u32x4 aw; aw.x = pk2(peer::gelu_fast(a0[0]), peer::gelu_fast(a0[1])); aw.y = pk2(peer::gelu_fast(a0[2]), peer::gelu_fast(a0[3])); \
    aw.z = pk2(peer::gelu_fast(a1[0]), peer::gelu_fast(a1[1])); aw.w = pk2(peer::gelu_fast(a1[2]), peer::gelu_fast(a1[3])); \
    const bf16x8 af = __builtin_bit_cast(bf16x8, aw); \
    acc0 = __builtin_amdgcn_mfma_f32_32x32x16_bf16(af, wb[buf][0], acc0, 0, 0, 0); acc1 = __builtin_amdgcn_mfma_f32_32x32x16_bf16(af, wb[buf][1], acc1, 0, 0, 0); } while (0)
  CMPL2_LOAD(0, 0);
#pragma unroll 1
  for (int ks = 0; ks < 16; ks += 2) {
    CMPL2_LOAD(1, ks + 1);
    CMPL2_MMA(0);
    if (ks + 2 < 16) CMPL2_LOAD(0, ks + 2);
    CMPL2_MMA(1);
  }
#undef CMPL2_LOAD
#undef CMPL2_MMA
#pragma unroll
  for (int r = 0; r < 16; ++r) {
    const int m = m0 + (r & 3) + 8 * (r >> 2) + 4 * hi;
    const bool pad = (m & 127) == 127;
    outkc[(size_t)m * 64 + r32] = pad ? (bf16_t)0 : f2bf(acc0[r]);
    outkc[(size_t)m * 64 + 32 + r32] = pad ? (bf16_t)0 : f2bf(acc1[r]);
  }
}
__device__ __forceinline__ void cmp_l2_w4(const float* __restrict__ slab, const float* __restrict__ cpos, const bf16_t* __restrict__ w2t, bf16_t* __restrict__ outkc, int item, int q, int lane,
                                          __attribute__((address_space(3))) float* red) {
  const int r32 = lane & 31, hi = lane >> 5, m0 = item * 32;
  f32x16 acc0 = f32x16{}, acc1 = f32x16{};
  f32x4_t sa[2][8]; f32x4_t cp[2][2]; bf16x8 wb[2][2];
#define CMPL2_LOAD(buf, ks_) do { const int k_ = (ks_) * 16 + hi * 8; \
    cp[buf][0] = *(const f32x4_t*)(cpos + k_); cp[buf][1] = *(const f32x4_t*)(cpos + k_ + 4); \
    _Pragma("unroll") for (int sp = 0; sp < 4; ++sp) { const float* p_ = slab + ((size_t)sp * 2048 + m0 + r32) * 256 + k_; sa[buf][2 * sp] = *(const f32x4_t*)p_; sa[buf][2 * sp + 1] = *(const f32x4_t*)(p_ + 4); } \
    wb[buf][0] = *(const bf16x8*)(w2t + (size_t)r32 * 256 + k_); wb[buf][1] = *(const bf16x8*)(w2t + (size_t)(32 + r32) * 256 + k_); } while (0)
#define CMPL2_MMA(buf) do { f32x4_t a0 = cp[buf][0], a1 = cp[buf][1]; \
    _Pragma("unroll") for (int sp = 0; sp < 4; ++sp) { a0 += sa[buf][2 * sp]; a1 += sa[buf][2 * sp + 1]; } \
    u32x4 aw; aw.x = pk2(peer::gelu_fast(a0[0]), peer::gelu_fast(a0[1])); aw.y = pk2(peer::gelu_fast(a0[2]), peer::gelu_fast(a0[3])); \
    aw.z = pk2(peer::gelu_fast(a1[0]), peer::gelu_fast(a1[1])); aw.w = pk2(peer::gelu_fast(a1[2]), peer::gelu_fast(a1[3])); \
    const bf16x8 af = __builtin_bit_cast(bf16x8, aw); \
    acc0 = __builtin_amdgcn_mfma_f32_32x32x16_bf16(af, wb[buf][0], acc0, 0, 0, 0); acc1 = __builtin_amdgcn_mfma_f32_32x32x16_bf16(af, wb[buf][1], acc1, 0, 0, 0); } while (0)
  const int k0 = q * 4;
  CMPL2_LOAD(0, k0); CMPL2_LOAD(1, k0 + 1);
  CMPL2_MMA(0); CMPL2_LOAD(0, k0 + 2);
  CMPL2_MMA(1); CMPL2_LOAD(1, k0 + 3);
  CMPL2_MMA(0); CMPL2_MMA(1);
#undef CMPL2_LOAD
#undef CMPL2_MMA
#pragma unroll
  for (int r = 0; r < 16; ++r) { red[(q * 32 + r) * 64 + lane] = acc0[r]; red[(q * 32 + 16 + r) * 64 + lane] = acc1[r]; }
  __syncthreads();
#pragma unroll
  for (int rr = 0; rr < 4; ++rr) {
    const int r = q * 4 + rr;
    float s0 = 0.f, s1 = 0.f;
#pragma unroll
    for (int p = 0; p < 4; ++p) { s0 += red[(p * 32 + r) * 64 + lane]; s1 += red[(p * 32 + 16 + r) * 64 + lane]; }
    const int m = m0 + rr + 8 * q + 4 * hi;
    const bool pad = (m & 127) == 127;
    outkc[(size_t)m * 64 + r32] = pad ? (bf16_t)0 : f2bf(s0);
    outkc[(size_t)m * 64 + 32 + r32] = pad ? (bf16_t)0 : f2bf(s1);
  }
}
}

#define XB_TMO      128
#define XB_XCNT(j)  (256  + 64 * (j))
#define XB_XSUB(j)  (1280 + 64 * (j))
#define XB_XGEN(j)  (2304 + 64 * (j))
#define XB_TOP      3328
#define XB_TOPGEN   3392
#define XCD_BAR_WORDS 3456
#define XB_SPIN_CAP (1u << 18)
#ifndef LAS
#define LAS __attribute__((address_space(3)))
#endif

__device__ __forceinline__ unsigned xb_ld(unsigned* p)              { return __hip_atomic_load(p, __ATOMIC_RELAXED, __HIP_MEMORY_SCOPE_AGENT); }
__device__ __forceinline__ unsigned xb_add(unsigned* p, unsigned v) { return __hip_atomic_fetch_add(p, v, __ATOMIC_RELAXED, __HIP_MEMORY_SCOPE_AGENT); }
__device__ __forceinline__ unsigned xb_xcc_id() { return (unsigned)__builtin_amdgcn_s_getreg((3 << 11) | 20) & 0xFu; }
#define XB_SPIN(cond, bar) do { unsigned _sp = 0; while (cond) { __builtin_amdgcn_s_sleep(1); \
    if ((++_sp & 255u) == 0u) { if (xb_ld(&(bar)[XB_TMO])) break; if (_sp > XB_SPIN_CAP) { atomicAdd(&(bar)[XB_TMO], 1u); break; } } } } while (0)

struct XcdBarrier {
    unsigned* bar; unsigned x;
    volatile LAS unsigned* st;
};

__device__ __forceinline__ XcdBarrier xcd_barrier_post(unsigned* bar, volatile LAS unsigned* st) {
    XcdBarrier b; b.bar = bar; b.x = xb_xcc_id(); b.st = st;
    if (threadIdx.x == 0) (void)xb_add(&bar[XB_XCNT(b.x)], 1u);
    return b;
}
__device__ __forceinline__ void xcd_barrier_complete(unsigned* bar, unsigned x, unsigned& nloc, unsigned& nx) {
    const unsigned G = gridDim.x * gridDim.y * gridDim.z;
    unsigned sum, cnt, mine, sp = 0u;
    for (;;) {
        sum = 0u; cnt = 0u; mine = 0u;
#pragma unroll
        for (unsigned j = 0; j < 16; ++j) { const unsigned c = xb_ld(&bar[XB_XCNT(j)]); sum += c; cnt += (c > 0u) ? 1u : 0u; mine = (j == x) ? c : mine; }
        if (sum == G) break;
        __builtin_amdgcn_s_sleep(1);
        if ((++sp & 255u) == 0u) { if (xb_ld(&bar[XB_TMO])) break; if (sp > XB_SPIN_CAP) { atomicAdd(&bar[XB_TMO], 1u); break; } }
    }
    nloc = mine > 0u ? mine : 1u; nx = cnt > 0u ? cnt : 1u;
}

__device__ __forceinline__ void xcd_barrier(const XcdBarrier& b) {
    asm volatile("s_waitcnt vmcnt(0)" ::: "memory");
    __syncthreads();
    if (threadIdx.x == 0) {
        unsigned* bar = b.bar;
        __builtin_amdgcn_s_waitcnt(0);
        unsigned nloc = b.st[0], nx = b.st[1];
        if (nloc == 0u) { xcd_barrier_complete(bar, b.x, nloc, nx); b.st[0] = nloc; b.st[1] = nx; }
        const unsigned old = xb_add(&bar[XB_XSUB(b.x)], 1u);
        const unsigned gen = old / nloc;
        if (old + 1u == (gen + 1u) * nloc) {
            __builtin_amdgcn_fence(__ATOMIC_RELEASE, "agent");
            asm volatile("s_waitcnt vmcnt(0)" ::: "memory");
            const unsigned og = xb_add(&bar[XB_TOP], 1u);
            const unsigned tg = og / nx;
            if (og + 1u == (tg + 1u) * nx) xb_add(&bar[XB_TOPGEN], 1u);
            else XB_SPIN(xb_ld(&bar[XB_TOPGEN]) == tg, bar);
            __builtin_amdgcn_fence(__ATOMIC_ACQUIRE, "agent");
            xb_add(&bar[XB_XGEN(b.x)], 1u);
            asm volatile("s_waitcnt vmcnt(0)" ::: "memory");
        } else {
            XB_SPIN(xb_ld(&bar[XB_XGEN(b.x)]) == gen, bar);
            __builtin_amdgcn_fence(__ATOMIC_ACQUIRE, "agent");
            asm volatile("s_waitcnt vmcnt(0)" ::: "memory");
        }
    }
    __syncthreads();
}

struct Args { const float* in[23]; float* out; char* ws; };
constexpr int LDS_BYTES = 131072 + 4096;

typedef const __attribute__((address_space(4))) Args* kargs_t;
DEV kargs_t KA() { kargs_t k = (kargs_t)__builtin_amdgcn_kernarg_segment_ptr(); asm volatile("" : "+s"(k)); return k; }
#define WSP(type, off) ((type*)(ws + (off)))

__global__ __launch_bounds__(NTHR, 2) void mega(Args a) {
  extern __shared__ __attribute__((aligned(16))) char lds[];
  PG8_LAS unsigned char* glds = (PG8_LAS unsigned char*)lds;
  const int bid = blockIdx.x, G = gridDim.x;
  (void)a;
  volatile LAS unsigned* bst = (volatile LAS unsigned*)((LAS char*)lds + LDS_BYTES - 16);
  if (threadIdx.x < 4) bst[threadIdx.x] = 0u;
  __syncthreads();
  XcdBarrier xbar; { kargs_t k = KA(); xbar = xcd_barrier_post((unsigned*)k->ws, bst); }

  { kargs_t k = KA(); char* ws = k->ws;
    const int wv0_ = threadIdx.x >> 6;
    if (wv0_ < 4) { const int lane_ = threadIdx.x & 63, wv_ = wv0_, gw_ = bid * 4 + wv_, nw_ = G * 4;
      __attribute__((address_space(3))) float* scr = (__attribute__((address_space(3))) float*)((__attribute__((address_space(3))) char*)lds + wv_ * 8448);
      constexpr int I_IN = 16 * 120, I_C1 = 32 * 8;
      for (int it = gw_; it < I_IN + 2 * I_C1; it += nw_) {
        int r = it;
        if (r < I_IN) { tr_item<1>(k->in[2], 1024, IN_COLS, WSP(bf16_t, WS_WIN), 120, 3840, scr, r, lane_); continue; } r -= I_IN;
        if (r < I_C1) { tr_item<0>(k->in[5], 2048, 256, WSP(bf16_t, WS_CKW1), 8, 256, scr, r, lane_); continue; } r -= I_C1;
        tr_item<0>(k->in[7], 2048, 256, WSP(bf16_t, WS_CVW1), 8, 256, scr, r, lane_);
      }
      for (int i = gw_ * 64 + lane_; i < 16 * 128 * 64; i += nw_ * 64) WSP(bf16_t, WS_SUBK)[i] = f2bf(k->in[18][i]);
      for (int i = gw_ * 64 + lane_; i < SEQ * 16; i += nw_ * 64) rope_entry(WSP(float2, WS_ROPE), i);
    } else ph_rms1024<false>(k->in[0], k->in[1], WSP(bf16_t, WS_XN), T, nullptr, nullptr, bid * 4 + (wv0_ - 4), G * 4); }
  xcd_barrier(xbar);
  { kargs_t k = KA(); char* ws = k->ws;
    pg8::Gemm g{WSP(bf16_t, WS_XN), WSP(bf16_t, WS_WIN), T, 3840, 1024}; pg8::StaticOrder S; S.init(T, 3840, G, bid);
    pg8::EpiInProjF E{WSP(bf16_t, WS_PROJ), WSP(unsigned char, WS_GATES)};
    pg8::gemm_phase<pg8::EpiInProjF, pg8::StaticOrder, PG8_ALIGN, PG8_SP2>(glds, g, S, E);
    {
      const bool some = (G == 256); const int nb = some ? 64 : G, b0 = some ? bid - 192 : bid;
      if (b0 >= 0) {
        const int lane_ = threadIdx.x & 63, wv_ = threadIdx.x >> 6;
        __attribute__((address_space(3))) float* scr = (__attribute__((address_space(3))) float*)((__attribute__((address_space(3))) char*)lds + wv_ * 8448);
        constexpr int I_BR = 8 * 32, I_SQ = 16 * 32, I_C2 = 4 * 8, I_UQ = 4 * 24, I_UKV = 2 * 32;
        for (int it = b0 * NWV + wv_; it < 2 * I_BR + 2 * I_SQ + 2 * I_C2 + I_UQ + I_UKV; it += nb * NWV) {
          int r = it;
          if (r < I_UQ) { tr_item<0>(k->in[11], 256, 768, WSP(bf16_t, WS_UQ), 24, 768, scr, r, lane_); continue; } r -= I_UQ;
          if (r < I_UKV) { tr_item<0>(k->in[12], 128, 1024, WSP(bf16_t, WS_UKV), 32, 1024, scr, r, lane_); continue; } r -= I_UKV;
          if (r < I_C2) { tr_item<0>(k->in[6], 256, 64, WSP(bf16_t, WS_CKW2), 8, 64, scr, r, lane_); continue; } r -= I_C2;
          if (r < I_C2) { tr_item<0>(k->in[8], 256, 64, WSP(bf16_t, WS_CVW2), 8, 64, scr, r, lane_); continue; } r -= I_C2;
          if (r < I_BR) { tr_item<0>(k->in[13], 512, 1024, WSP(bf16_t, WS_WBN), 32, 1024, scr, r, lane_, 1024, 0); continue; } r -= I_BR;
          if (r < I_BR) { tr_item<0>(k->in[14], 512, 1024, WSP(bf16_t, WS_WBN), 32, 1024, scr, r, lane_, 1024, 512); continue; } r -= I_BR;
          if (r < I_SQ) { tr_item<0>(k->in[15], 1024, 1024, WSP(bf16_t, WS_WOUT), 32, 1024, scr, r, lane_); continue; } r -= I_SQ;
          tr_item<0>(k->in[17], 1024, 1024, WSP(bf16_t, WS_WQ), 32, 1024, scr, r, lane_);
        } } } }
  xcd_barrier(xbar);
  { kargs_t k = KA(); char* ws = k->ws;
    const int lane_ = threadIdx.x & 63, wv_ = threadIdx.x >> 6;
    if (G >= 128 && bid < 64) {
      const int tab = bid >> 5;
      pg8::Gemm g{WSP(bf16_t, WS_PROJ) + PC_KV + tab * 128, WSP(bf16_t, tab ? WS_CVW1 : WS_CKW1), 2048, 1024, 512};
      g.pitchA = 16u * PROJ_LD * 2u; g.kstepA = PROJ_LD * 2u; g.hstepA = 128; g.tA_pm = (size_t)SEQ * PROJ_LD * 2; g.tA_pn = (size_t)8 * PROJ_LD * 2;
      g.pitchB = 4096u; g.kstepB = 128u; g.hstepB = (size_t)128 * 4096; g.tB_pn = 1024; g.nt = 8;
      pg8::StaticOrder S; S.init(2048, 1024, 32, bid & 31);
      pg8::EpiSlabF E{WSP(float, WS_SLAB) + (size_t)tab * 4 * 2048 * 256};
      pg8::gemm_phase<pg8::EpiSlabF, pg8::StaticOrder, PG8_ALIGN, PG8_SP2>(glds, g, S, E);
    } else {
      const int nb = (G >= 128) ? G - 64 : G, b0 = (G >= 128) ? bid - 64 : bid;
      prep::cmp_bias(k->in[3], k->in[4], WSP(bf16_t, WS_CKW1), WSP(bf16_t, WS_CVW1), WSP(float, WS_CPOS), b0 * NWV + wv_, nb * NWV, lane_);
      prep::latent_rows(WSP(bf16_t, WS_PROJ), k->in[9], k->in[10], WSP(float2, WS_ROPE), WSP(bf16_t, WS_CQN), WSP(bf16_t, WS_CKVN), WSP(bf16_t, WS_KROPE), b0 * NWV + wv_, nb * NWV, lane_);
    } }
  xcd_barrier(xbar);
  if (G == 256 && ((bid + 64) & 255) >= 192) {
    kargs_t k = KA(); char* ws = k->ws;
    const int lane_ = threadIdx.x & 63, wv_ = threadIdx.x >> 6;
    { const int it = (((bid + 64) & 255) - 192) * 2 + (wv_ >> 2); const int tab = it >> 6;
      prep::cmp_l2_w4(WSP(float, WS_SLAB) + (size_t)tab * 4 * 2048 * 256, WSP(float, WS_CPOS) + tab * 256, WSP(bf16_t, tab ? WS_CVW2 : WS_CKW2), WSP(bf16_t, tab ? WS_VC : WS_KC), it & 63, wv_ & 3, lane_,
                      (__attribute__((address_space(3))) float*)lds + (wv_ >> 2) * 8192); }
    __syncthreads();
  } else if (G != 256) {
    kargs_t k = KA(); char* ws = k->ws;
    const int lane_ = threadIdx.x & 63, wv_ = threadIdx.x >> 6;
    for (int it = bid * NWV + wv_; it < 128; it += G * NWV) { const int tab = it >> 6;
      prep::cmp_l2(WSP(float, WS_SLAB) + (size_t)tab * 4 * 2048 * 256, WSP(float, WS_CPOS) + tab * 256, WSP(bf16_t, tab ? WS_CVW2 : WS_CKW2), WSP(bf16_t, tab ? WS_VC : WS_KC), it & 63, lane_); }
  }
  { kargs_t k = KA(); char* ws = k->ws;
    pg8::Gemm g{WSP(bf16_t, WS_CQN), WSP(bf16_t, WS_UQ), T, 768, 256}; pg8::StaticOrder S; S.init(T, 768, G, (bid + 64) & 255);
    pg8::EpiMlaQF E{WSP(bf16_t, WS_MLAQ), WSP(float2, WS_ROPE)};
    pg8::gemm_phase<pg8::EpiMlaQF, pg8::StaticOrder, PG8_ALIGN, PG8_SP2>(glds, g, S, E); }
  { kargs_t k = KA(); char* ws = k->ws;
    pg8::Gemm g{WSP(bf16_t, WS_CKVN), WSP(bf16_t, WS_UKV), T, 1024, 128}; pg8::StaticOrder S; S.init(T, 1024, G, bid);
    pg8::EpiBf16<0> E{WSP(bf16_t, WS_MLAKV), 1024, nullptr, 0, 0, 1.f};
    pg8::gemm_phase<pg8::EpiBf16<0>, pg8::StaticOrder, PG8_ALIGN, PG8_SP2>(glds, g, S, E); }
  xcd_barrier(xbar);
  { kargs_t k = KA(); char* ws = k->ws;
    att::attn_phase(WSP(bf16_t, WS_PROJ), WSP(bf16_t, WS_KC), WSP(bf16_t, WS_VC), k->in[21], WSP(bf16_t, WS_ONSA),
                    WSP(bf16_t, WS_MLAQ), WSP(bf16_t, WS_MLAKV), WSP(bf16_t, WS_KROPE), WSP(bf16_t, WS_ONSA), (att::lptr)lds); }
  xcd_barrier(xbar);
  { kargs_t k = KA(); char* ws = k->ws;
    pg8::Gemm g{WSP(bf16_t, WS_ONSA), WSP(bf16_t, WS_WBN), T, 1024, 1024}; pg8::StaticOrder S; S.init(T, 1024, G, bid);
    pg8::EpiMergeFusedF E{WSP(unsigned char, WS_GATES), WSP(bf16_t, WS_MERGED)};
    pg8::gemm_phase<pg8::EpiMergeFusedF, pg8::StaticOrder, PG8_ALIGN, PG8_SP2>(glds, g, S, E); }
  xcd_barrier(xbar);
  { kargs_t k = KA(); char* ws = k->ws;
    pg8::Gemm g{WSP(bf16_t, WS_MERGED), WSP(bf16_t, WS_WOUT), T, 1024, 1024}; pg8::StaticOrder S; S.init(T, 1024, G, bid);
    pg8::EpiBf16<0> E{WSP(bf16_t, WS_OB), 1024, nullptr, 0, 0, 1.f};
    pg8::gemm_phase<pg8::EpiBf16<0>, pg8::StaticOrder, PG8_ALIGN, PG8_SP2>(glds, g, S, E); }
  xcd_barrier(xbar);
  { kargs_t k = KA(); char* ws = k->ws; ph_rms1024<true>(k->in[0], k->in[16], WSP(bf16_t, WS_HN), T, WSP(unsigned, WS_HN8), WSP(float, WS_SH), -1, 0, WSP(bf16_t, WS_OB));
    peer::conv_tables(k->in[19], k->in[20], WSP(unsigned, WS_U8), WSP(float, WS_SU), WSP(unsigned, WS_V8)); }
  xcd_barrier(xbar);
  { kargs_t k = KA(); char* ws = k->ws;
    pg8::Gemm g{WSP(bf16_t, WS_HN), WSP(bf16_t, WS_WQ), T, 1024, 1024}; pg8::StaticOrder S; S.init(T, 1024, G, bid);
    pg8::EpiBf16<0> E{WSP(bf16_t, WS_PQ), 1024, nullptr, 0, 0, 1.f};
    pg8::gemm_phase<pg8::EpiBf16<0>, pg8::StaticOrder, PG8_ALIGN, PG8_SP2>(glds, g, S, E); }
  __builtin_amdgcn_fence(__ATOMIC_RELEASE, "workgroup"); __syncthreads(); __builtin_amdgcn_fence(__ATOMIC_ACQUIRE, "workgroup");
  { kargs_t k = KA(); char* ws = k->ws; pg8::StaticOrder S; S.init(T, 1024, G, bid); pg8::Unit u;
    if (S.next(0, u)) peer::route_phase(WSP(bf16_t, WS_PQ), WSP(bf16_t, WS_SUBK), WSP(unsigned, WS_PIDX), (__attribute__((address_space(3))) char*)lds, u.pm, u.pn); }
  xcd_barrier(xbar);
  { kargs_t k = KA(); char* ws = k->ws;
    peer::experts_sliced<0>(WSP(unsigned, WS_PIDX), WSP(unsigned, WS_HN8), WSP(float, WS_SH), WSP(unsigned, WS_U8), WSP(float, WS_SU), WSP(float, WS_CO), WSP(unsigned, WS_V8), k->out, WSP(float, WS_SSQ),
                            (unsigned*)ws + CTL_QA, (__attribute__((address_space(3))) char*)lds); }
  xcd_barrier(xbar);
  { kargs_t k = KA(); char* ws = k->ws;
    peer::experts_sliced<1>(WSP(unsigned, WS_PIDX), WSP(unsigned, WS_HN8), WSP(float, WS_SH), WSP(unsigned, WS_U8), WSP(float, WS_SU), WSP(float, WS_CO), WSP(unsigned, WS_V8), (float*)WSP(bf16_t, WS_ZB), WSP(float, WS_SSQ),
                            (unsigned*)ws + CTL_QB, (__attribute__((address_space(3))) char*)lds, k->in[0], WSP(bf16_t, WS_OB)); }
  xcd_barrier(xbar);
  { kargs_t k = KA(); char* ws = k->ws; peer::experts_norm(WSP(float, WS_SSQ), k->in[22], WSP(bf16_t, WS_ZB), k->out); }
}

extern "C" void kernel_launch(void* const* d_in, const int* in_sizes, int n_in, void* d_out, int out_size, void* d_ws, size_t ws_size, hipStream_t stream) {
  if (n_in != 23 || ws_size < 256 * MiB) { fprintf(stderr, "kernel_launch: unexpected n_in %d / ws_size %zu\n", n_in, ws_size); return; }
  static int grid_blocks = 0;
  if (!grid_blocks) {
    int dev = 0, cus = 0, per_cu = 0;
    (void)hipGetDevice(&dev);
    (void)hipDeviceGetAttribute(&cus, hipDeviceAttributeMultiprocessorCount, dev);
    if (hipFuncSetAttribute((const void*)mega, hipFuncAttributeMaxDynamicSharedMemorySize, LDS_BYTES) != hipSuccess) fprintf(stderr, "kernel_launch: hipFuncSetAttribute failed\n");
    (void)hipOccupancyMaxActiveBlocksPerMultiprocessor(&per_cu, (const void*)mega, NTHR, LDS_BYTES);
    if (per_cu < 1) { fprintf(stderr, "kernel_launch: occupancy query returned %d\n", per_cu); per_cu = 1; }
    if (per_cu > 2) per_cu = 2;
    grid_blocks = cus * per_cu;
    fprintf(stderr, "kernel_launch: cus %d per_cu %d grid %d ws %zu\n", cus, per_cu, grid_blocks, ws_size);
  }
  if (hipMemsetAsync(d_ws, 0, 65536, stream) != hipSuccess) fprintf(stderr, "kernel_launch: hipMemsetAsync failed\n");
  Args a{};
  for (int i = 0; i < 23; ++i) a.in[i] = (const float*)d_in[i];
  a.out = (float*)d_out; a.ws = (char*)d_ws;
  void* args[] = {&a};
  hipError_t e = hipLaunchCooperativeKernel((const void*)mega, dim3(grid_blocks), dim3(NTHR), args, LDS_BYTES, stream);
  if (e != hipSuccess) fprintf(stderr, "cooperative launch failed: %s (grid %d)\n", hipGetErrorString(e), grid_blocks);
}
```

```cpp
#include <hip/hip_runtime.h>
#include <stdint.h>
#include <cstdio>
#include <hip/hip_cooperative_groups.h>
namespace cg = cooperative_groups;

typedef unsigned short bf16_t;
#define DEV __device__ __forceinline__

constexpr int BATCH = 8, SEQ = 2048, DM = 1024, T = BATCH * SEQ;
constexpr int IN_COLS = 3768;
constexpr int PROJ_LD = 1792;
constexpr int PC_Q = 0, PC_KV = 512, PC_CQ = 1280, PC_CKV = 1536, PC_KR = 1664, PC_GATE = 1696;
constexpr int NC = 127;
constexpr size_t MiB = 1u << 20;

constexpr size_t WS_WIN = 1 * MiB;
constexpr size_t WS_WBN = 9 * MiB;
constexpr size_t WS_WBM = 10 * MiB;
constexpr size_t WS_WOUT = 11 * MiB;
constexpr size_t WS_WQ = 13 * MiB;
constexpr size_t WS_CKW1 = 15 * MiB;
constexpr size_t WS_CVW1 = 16 * MiB;
constexpr size_t WS_CKW2 = 17 * MiB;
constexpr size_t WS_CVW2 = 17 * MiB + 128 * 1024;
constexpr size_t WS_UQ = 17 * MiB + 256 * 1024;
constexpr size_t WS_UKV = 17 * MiB + 768 * 1024;
constexpr size_t WS_SUBK = 18 * MiB;
constexpr size_t WS_ROPE = 18 * MiB + 512 * 1024;
constexpr size_t WS_GATES = 20 * MiB;
constexpr size_t WS_PQ = 20 * MiB;
constexpr size_t WS_ZB = 20 * MiB;
constexpr size_t WS_OB = 52 * MiB;
constexpr size_t WS_PROJ = 84 * MiB;
constexpr size_t WS_MERGED = 84 * MiB;
constexpr size_t WS_PIDX = 84 * MiB;
constexpr size_t WS_U8 = 172 * MiB;
constexpr size_t WS_V8 = 188 * MiB;
constexpr size_t WS_SU = 204 * MiB;
constexpr size_t WS_SH = 204 * MiB + 65536;
constexpr size_t WS_HN8 = 205 * MiB;
constexpr size_t WS_CO = 221 * MiB;
constexpr size_t WS_SSQ = 229 * MiB;
constexpr int CTL_QA = 4096, CTL_QB = 4096 + 512;
constexpr size_t WS_PW = 92 * MiB;
constexpr size_t WS_XN = 140 * MiB;
constexpr size_t WS_MLAKV = 140 * MiB;
constexpr size_t WS_HN = 140 * MiB;
constexpr size_t WS_MLAQ = 172 * MiB;
constexpr size_t WS_KROPE = 196 * MiB;
constexpr size_t WS_KC = 197 * MiB;
constexpr size_t WS_VC = 197 * MiB + 512 * 1024;
constexpr size_t WS_ONSA = 198 * MiB;
constexpr size_t WS_OMLA = 214 * MiB;
constexpr size_t WS_SLAB = 198 * MiB;
constexpr size_t WS_CPOS = 18 * MiB + 768 * 1024;
constexpr size_t WS_CA = 198 * MiB;
constexpr size_t WS_HID = 206 * MiB;
constexpr size_t WS_HID2 = 207 * MiB;
constexpr size_t WS_CA2 = 214 * MiB;
constexpr size_t WS_CQN = 230 * MiB;
constexpr size_t WS_CKVN = 238 * MiB;
constexpr size_t WS_OCMP = 230 * MiB;
constexpr size_t WS_SEL = 246 * MiB;

__device__ const unsigned char T5B[128] = {
  0, 1, 2, 3, 4, 5, 6, 7, 8, 9, 10, 11, 12, 13, 14, 15, 16, 16, 16, 17, 17, 18, 18, 18, 19, 19, 19, 20, 20, 20, 20, 21,
  21, 21, 21, 22, 22, 22, 22, 22, 23, 23, 23, 23, 23, 23, 24, 24, 24, 24, 24, 24, 25, 25, 25, 25, 25, 25, 25, 26, 26, 26, 26, 26,
  26, 26, 26, 27, 27, 27, 27, 27, 27, 27, 27, 27, 27, 28, 28, 28, 28, 28, 28, 28, 28, 28, 28, 29, 29, 29, 29, 29, 29, 29, 29, 29,
  29, 29, 29, 30, 30, 30, 30, 30, 30, 30, 30, 30, 30, 30, 30, 30, 30, 31, 31, 31, 31, 31, 31, 31, 31, 31, 31, 31, 31, 31, 31, 31};

DEV float bf2f(bf16_t v) { return __uint_as_float(((unsigned)v) << 16); }
DEV bf16_t f2bf(float f) { unsigned u = __float_as_uint(f); u += 0x7fffu + ((u >> 16) & 1u); return (bf16_t)(u >> 16); }
template <int CTRL> DEV int dpp_i(int v) { return __builtin_amdgcn_update_dpp(0, v, CTRL, 0xF, 0xF, true); }
template <int CTRL> DEV float dpp_f(float v) { return __uint_as_float((unsigned)__builtin_amdgcn_update_dpp(0, (int)__float_as_uint(v), CTRL, 0xF, 0xF, true)); }
DEV int sum16_i(int v) { v += dpp_i<0xB1>(v); v += dpp_i<0x4E>(v); v += dpp_i<0x141>(v); v += dpp_i<0x140>(v); return v; }
DEV float sum16_f(float v) { v += dpp_f<0xB1>(v); v += dpp_f<0x4E>(v); v += dpp_f<0x141>(v); v += dpp_f<0x140>(v); return v; }
DEV float max16_f(float v) { v = fmaxf(v, dpp_f<0xB1>(v)); v = fmaxf(v, dpp_f<0x4E>(v)); v = fmaxf(v, dpp_f<0x141>(v)); v = fmaxf(v, dpp_f<0x140>(v)); return v; }
DEV float rl_f(float v, int l) { return __uint_as_float((unsigned)__builtin_amdgcn_readlane((int)__float_as_uint(v), l)); }
DEV float wsum(float v) { v = sum16_f(v); return (rl_f(v, 0) + rl_f(v, 16)) + (rl_f(v, 32) + rl_f(v, 48)); }
DEV float wmaxf(float v) { v = max16_f(v); return fmaxf(fmaxf(rl_f(v, 0), rl_f(v, 16)), fmaxf(rl_f(v, 32), rl_f(v, 48))); }
DEV float sigmoidf_(float x) { return 1.0f / (1.0f + expf(-x)); }
DEV float gelu_exact(float x) { return 0.5f * x * (1.0f + erff(x * 0.70710678118654752f)); }
DEV void wave_lds_sync() { asm volatile("s_waitcnt lgkmcnt(0)" ::: "memory"); __builtin_amdgcn_wave_barrier(); asm volatile("" ::: "memory"); }
DEV float t5bias(const float* t5, int head, int dist) { int d = dist < 127 ? dist : 127; d = d < 0 ? 0 : d; return t5[(int)T5B[d] * 8 + head]; }


namespace pg8 {
#define PG8_LAS __attribute__((address_space(3)))
typedef unsigned short bf16_t;
typedef short bf16x8 __attribute__((ext_vector_type(8)));
typedef float f32x4 __attribute__((ext_vector_type(4)));
typedef unsigned u32x4 __attribute__((ext_vector_type(4)));
constexpr int BM = 256, BK = 64, HALF = 128, HTB = HALF * BK * 2  , STAGE_BYTES = 8 * HTB, NXCD = 8, WGM = 8;

__host__ __device__ __forceinline__ int lds_byte(int r, int c) { const int st = (r >> 4) * 2 + (c >> 5), rr = r & 15, cc = c & 31, ob = rr * 64 + cc * 2; return st * 1024 + (ob ^ (((ob >> 9) & 1) << 5)); }
__host__ __device__ __forceinline__ void stage_rc(int b, int& R, int& C) { const int st = b / 1024, sb = b % 1024, swz = sb ^ (((sb >> 9) & 1) << 5); R = (st >> 1) * 16 + swz / 64; C = (st & 1) * 32 + (swz % 64) / 2; }
__host__ __device__ __forceinline__ int perm32(int rho) { const int n = rho >> 4, i = rho & 15; return 8 * (i >> 2) + 4 * n + (i & 3); }

struct Unit { int pm, pn; };
struct Gemm { const bf16_t* A; const bf16_t* Bt; int M, N, K;
    unsigned pitchA = 0, pitchB = 0, kstepA = 0, kstepB = 0; size_t hstepA = 0, hstepB = 0, tA_pm = 0, tA_pn = 0, tB_pn = 0; int nt = 0; };

struct StaticOrder {
    int nM, nN, nwg, G, c;
    __host__ __device__ void init(int M, int N, int G_, int c_) { nM = M / BM; nN = N / BM; nwg = nM * nN; G = G_; c = c_; }
    __host__ __device__ __forceinline__ bool next(int i, Unit& u) const {
        const long L = (long)i * G + c; if (L >= nwg) return false;
        int wgid = (int)L; { const int q = nwg / NXCD, r = nwg % NXCD, xcd = wgid % NXCD, off = wgid / NXCD; wgid = (xcd < r ? xcd * (q + 1) : r * (q + 1) + (xcd - r) * q) + off; }
        const int nig = WGM * nN, gid = wgid / nig, fm = gid * WGM, gsz = (nM - fm) < WGM ? (nM - fm) : WGM;
        u.pm = fm + ((wgid % nig) % gsz); u.pn = (wgid % nig) / gsz; return true;
    }
    __device__ __forceinline__ void a_ready(const Unit&) const {}
    __device__ __forceinline__ void done(const Unit&) const {}
};

__device__ __forceinline__ unsigned cvt_pk_bf16(float lo, float hi) { unsigned r; asm volatile("v_cvt_pk_bf16_f32 %0, %1, %2" : "=v"(r) : "v"(lo), "v"(hi)); return r; }
typedef float f32x2 __attribute__((ext_vector_type(2)));
__device__ __forceinline__ f32x2 gelu_pk(f32x2 v) {
    const f32x2 av = __builtin_elementwise_abs(v), d = av * 0.2316418882f + 1.0f;
    f32x2 t; t.x = __builtin_amdgcn_rcpf(d.x); t.y = __builtin_amdgcn_rcpf(d.y);
    f32x2 q = t * 0.5307027145f + (-0.7265760135f); q = q * t + 0.7107068705f; q = q * t + (-0.142248368f); q = q * t + 0.127414796f; q = q * t;
    const f32x2 s = (v * v) * (-0.72134752044f);
    f32x2 e; e.x = __builtin_amdgcn_exp2f(s.x); e.y = __builtin_amdgcn_exp2f(s.y);
    const f32x2 m = v * (q * e), r = v - m;
    f32x2 o; o.x = v.x < 0.f ? m.x : r.x; o.y = v.y < 0.f ? m.y : r.y; return o;
}

template <int ACT  > struct EpiBf16 {
    static constexpr bool PERM = true, AFTER_DRAIN = false, MIDK = false; static_assert(ACT == 0 || ACT == 1, "EpiBf16: ACT is 0 (none) or 1 (gelu_pk)");
    bf16_t* O; int ldc; const float* bias; int split_cols; size_t split_stride; float scale0;
    __device__ __forceinline__ void operator()(const f32x4 (&acc)[2][2][4][2], const Unit& u, int wr, int wc, int fr, int fq) const {
        const int row0 = u.pm * BM + wr * 64 + fr; int colt = u.pn * BM; bf16_t* base = O;
        float sc = 1.f; if (split_cols) { const int t = colt / split_cols; base += (size_t)t * split_stride; colt -= t * split_cols; if (t == 0) sc = scale0; }
        const int col0 = colt + wc * 32 + 8 * fq, bcol0 = u.pn * BM + wc * 32 + 8 * fq;
        f32x4 bv[2][2];
#pragma unroll
        for (int bj = 0; bj < 2; ++bj)
#pragma unroll
            for (int n = 0; n < 2; ++n) bv[bj][n] = bias ? *(const f32x4*)(bias + bcol0 + bj * HALF + 4 * n) : (f32x4){0.f, 0.f, 0.f, 0.f};
#pragma unroll
        for (int ai = 0; ai < 2; ++ai)
#pragma unroll
            for (int m = 0; m < 4; ++m) { bf16_t* rowp = base + (size_t)(row0 + ai * HALF + m * 16) * ldc + col0;
#pragma unroll
                for (int bj = 0; bj < 2; ++bj) { f32x4 v0 = acc[ai][bj][m][0] + bv[bj][0], v1 = acc[ai][bj][m][1] + bv[bj][1];
                    if (ACT == 1) { f32x2 a = gelu_pk((f32x2){v0[0], v0[1]}), b = gelu_pk((f32x2){v0[2], v0[3]}), c = gelu_pk((f32x2){v1[0], v1[1]}), d = gelu_pk((f32x2){v1[2], v1[3]});
                        v0 = (f32x4){a.x, a.y, b.x, b.y}; v1 = (f32x4){c.x, c.y, d.x, d.y}; }
                    v0 = v0 * sc; v1 = v1 * sc; u32x4 w; w.x = cvt_pk_bf16(v0[0], v0[1]); w.y = cvt_pk_bf16(v0[2], v0[3]); w.z = cvt_pk_bf16(v1[0], v1[1]); w.w = cvt_pk_bf16(v1[2], v1[3]);
                    *(u32x4*)(rowp + bj * HALF) = w; } }
    }
};

struct PanelStats {
    unsigned* xbuf;
    unsigned* cnt;
    unsigned* tmo;
    int ntn; float eps;
    unsigned code;
    __device__ __forceinline__ bool run(const f32x4 (&v)[2][2][4][2], const Unit& u, int wr, int wc, int fr, int fq, PG8_LAS unsigned char* lds, int wid, int lane) const {
        typedef float f32x2v __attribute__((ext_vector_type(2)));
        PG8_LAS f32x2v* P = (PG8_LAS f32x2v*)lds;
        PG8_LAS f32x2v* S = (PG8_LAS f32x2v*)(lds + 8192);
        PG8_LAS unsigned* flag = (PG8_LAS unsigned*)(lds + 8192 + 2048);
#pragma unroll
        for (int ai = 0; ai < 2; ++ai)
#pragma unroll
            for (int m = 0; m < 4; ++m) {
                float s = 0.f;
#pragma unroll
                for (int bj = 0; bj < 2; ++bj)
#pragma unroll
                    for (int n = 0; n < 2; ++n) { const f32x4 x = v[ai][bj][m][n]; s += (x[0] + x[1]) + (x[2] + x[3]); }
                s += __shfl_xor(s, 16); s += __shfl_xor(s, 32);
                const float mw = s * (1.0f / 64.0f); float q = 0.f;
#pragma unroll
                for (int bj = 0; bj < 2; ++bj)
#pragma unroll
                    for (int n = 0; n < 2; ++n) { const f32x4 d = v[ai][bj][m][n] - mw; q += (d[0] * d[0] + d[1] * d[1]) + (d[2] * d[2] + d[3] * d[3]); }
                q += __shfl_xor(q, 16); q += __shfl_xor(q, 32);
                if (fq == 0) P[(ai * HALF + wr * 64 + m * 16 + fr) * 4 + wc] = (f32x2v){mw, q};
            }
        asm volatile("s_waitcnt lgkmcnt(0)" ::: "memory"); __builtin_amdgcn_s_barrier(); asm volatile("" ::: "memory");
#if defined(BROKEN_EXCHANGE_NO_WAIT)
#warning BROKEN CONTROL BUILD: the row-statistics exchange does not wait; results are wrong by design
        if (blockIdx.x >= 64) { const long long t0_ = clock64(); while (clock64() - t0_ < 60000) __builtin_amdgcn_s_sleep(8); }
#endif
        const int row = wid * 32 + (lane & 31);
        if (lane < 32) {
            const f32x2v a = P[row * 4 + 0], b = P[row * 4 + 1], c = P[row * 4 + 2], d = P[row * 4 + 3];
            const float mt = (a.x + b.x + c.x + d.x) * 0.25f;
            const float da = a.x - mt, db = b.x - mt, dc = c.x - mt, dd = d.x - mt;
            const float m2 = (a.y + b.y) + (c.y + d.y) + 64.0f * ((da * da + db * db) + (dc * dc + dd * dd));
            unsigned long long* slot = (unsigned long long*)xbuf + ((size_t)(u.pm * BM + row) * 4 + u.pn);
            __hip_atomic_store(slot, ((unsigned long long)__float_as_uint(m2) << 32) | __float_as_uint(mt), __ATOMIC_RELAXED, __HIP_MEMORY_SCOPE_AGENT);
        }
        asm volatile("s_waitcnt vmcnt(0)" ::: "memory");
        if (lane == 0) __hip_atomic_fetch_add(cnt + 64 * u.pm, 1u, __ATOMIC_RELAXED, __HIP_MEMORY_SCOPE_AGENT);
        if (wid == 0) {
            bool dead = false; const unsigned long long t0 = __builtin_amdgcn_s_memrealtime(); const unsigned want = 8u * (unsigned)ntn;
            for (;;) {
#if defined(BROKEN_EXCHANGE_NO_WAIT)
                break;
#endif
                if ((unsigned)__builtin_amdgcn_readfirstlane(__hip_atomic_load(cnt + 64 * u.pm, __ATOMIC_RELAXED, __HIP_MEMORY_SCOPE_AGENT)) >= want) break;
                if (__builtin_amdgcn_s_memrealtime() - t0 > 2000000ull) {
                    if (lane == 0) { unsigned expect = 0u; __hip_atomic_compare_exchange_strong(tmo + 1, &expect, code | (unsigned)(u.pm & 0xff), __ATOMIC_RELAXED, __ATOMIC_RELAXED, __HIP_MEMORY_SCOPE_AGENT);
                                     __hip_atomic_store(tmo, 1u, __ATOMIC_RELAXED, __HIP_MEMORY_SCOPE_AGENT); }
                    dead = true; break; }
                __builtin_amdgcn_s_sleep(2);
            }
            __builtin_amdgcn_fence(__ATOMIC_ACQUIRE, "agent");
            if (lane == 0) flag[0] = dead ? 1u : 0u;
        }
        asm volatile("s_waitcnt vmcnt(0) lgkmcnt(0)" ::: "memory"); __builtin_amdgcn_s_barrier(); asm volatile("" ::: "memory");
        const bool bad = flag[0] != 0u;
        if (lane < 32) {
            const unsigned long long* slot = (const unsigned long long*)xbuf + (size_t)(u.pm * BM + row) * 4; float mt[4], m2[4]; float ms = 0.f;
#pragma unroll
            for (int t = 0; t < 4; ++t) { if (t < ntn) { const unsigned long long w = __hip_atomic_load(slot + t, __ATOMIC_RELAXED, __HIP_MEMORY_SCOPE_AGENT); mt[t] = __uint_as_float((unsigned)w); m2[t] = __uint_as_float((unsigned)(w >> 32)); } else { mt[t] = 0.f; m2[t] = 0.f; } ms += mt[t]; }
            const float mean = ms / (float)ntn; float q = 0.f;
#pragma unroll
            for (int t = 0; t < 4; ++t) if (t < ntn) { const float dm = mt[t] - mean; q += m2[t] + 256.0f * dm * dm; }
            S[row] = (f32x2v){mean, 1.0f / sqrtf(q / (256.0f * (float)ntn) + eps)};
        }
        asm volatile("s_waitcnt lgkmcnt(0)" ::: "memory"); __builtin_amdgcn_s_barrier(); asm volatile("" ::: "memory");
        return bad;
    }
};
struct EpiLnRes {
    static constexpr bool PERM = false, AFTER_DRAIN = true, MIDK = false;
    const float* base; float* out; int ldc; const float* bias; PanelStats st; unsigned poison;
    __device__ __forceinline__ void fused(f32x4 (&acc)[2][2][4][2], const Unit& u, int wr, int wc, int fr, int fq, PG8_LAS unsigned char* lds, int wid, int lane) const {
        typedef float f32x2v __attribute__((ext_vector_type(2)));
        const PG8_LAS f32x2v* S = (const PG8_LAS f32x2v*)(lds + 8192);
        const int col0 = u.pn * BM + wc * 32 + 4 * fq;
#pragma unroll
        for (int bj = 0; bj < 2; ++bj)
#pragma unroll
            for (int n = 0; n < 2; ++n) { const f32x4 bv = bias ? *(const f32x4*)(bias + col0 + bj * HALF + n * 16) : (f32x4){0.f, 0.f, 0.f, 0.f};
#pragma unroll
                for (int ai = 0; ai < 2; ++ai)
#pragma unroll
                    for (int m = 0; m < 4; ++m) acc[ai][bj][m][n] += bv; }
        f32x4 pre[4][2][2];
#pragma unroll
        for (int m = 0; m < 4; ++m) { const size_t off = (size_t)(u.pm * BM + wr * 64 + m * 16 + fr) * ldc + col0;
#pragma unroll
            for (int bj = 0; bj < 2; ++bj)
#pragma unroll
                for (int n = 0; n < 2; ++n) pre[m][bj][n] = *(const f32x4*)(base + off + bj * HALF + n * 16); }
        const bool bad = st.run(acc, u, wr, wc, fr, fq, lds, wid, lane) || poison != 0u;
        const float qnan = __builtin_nanf("");
#pragma unroll
        for (int ai = 0; ai < 2; ++ai)
#pragma unroll
            for (int m = 0; m < 4; ++m) { const int r = ai * HALF + wr * 64 + m * 16 + fr; const f32x2v sr = S[r]; const size_t off = (size_t)(u.pm * BM + r) * ldc + col0;
#pragma unroll
                for (int bj = 0; bj < 2; ++bj)
#pragma unroll
                    for (int n = 0; n < 2; ++n) { const f32x4 bs = ai == 0 ? pre[m][bj][n] : *(const f32x4*)(base + off + bj * HALF + n * 16); f32x4 o = bs + (acc[ai][bj][m][n] - sr.x) * sr.y;
                        if (bad) o = (f32x4){qnan, qnan, qnan, qnan}; *(f32x4*)(out + off + bj * HALF + n * 16) = o; }
                if (m & 1) asm volatile("" ::: "memory"); }
    }
};
struct EpiLnResLn {
    static constexpr bool PERM = false, AFTER_DRAIN = true, MIDK = false;
    const float* base; float* out; bf16_t* xn; int ldc; const float* bias; PanelStats st1, st2; unsigned poison;
    __device__ __forceinline__ void fused(f32x4 (&acc)[2][2][4][2], const Unit& u, int wr, int wc, int fr, int fq, PG8_LAS unsigned char* lds, int wid, int lane) const {
        typedef float f32x2v __attribute__((ext_vector_type(2))); typedef unsigned u32x2v __attribute__((ext_vector_type(2)));
        const PG8_LAS f32x2v* S = (const PG8_LAS f32x2v*)(lds + 8192);
        const int col0 = u.pn * BM + wc * 32 + 4 * fq;
#pragma unroll
        for (int bj = 0; bj < 2; ++bj)
#pragma unroll
            for (int n = 0; n < 2; ++n) { const f32x4 bv = bias ? *(const f32x4*)(bias + col0 + bj * HALF + n * 16) : (f32x4){0.f, 0.f, 0.f, 0.f};
#pragma unroll
                for (int ai = 0; ai < 2; ++ai)
#pragma unroll
                    for (int m = 0; m < 4; ++m) acc[ai][bj][m][n] += bv; }
        bool bad = st1.run(acc, u, wr, wc, fr, fq, lds, wid, lane) || poison != 0u;
        const float qnan = __builtin_nanf("");
#pragma unroll
        for (int ai = 0; ai < 2; ++ai)
#pragma unroll
            for (int m = 0; m < 4; ++m) { const int r = ai * HALF + wr * 64 + m * 16 + fr; const f32x2v sr = S[r]; const size_t off = (size_t)(u.pm * BM + r) * ldc + col0;
#pragma unroll
                for (int bj = 0; bj < 2; ++bj)
#pragma unroll
                    for (int n = 0; n < 2; ++n) { const f32x4 bs = *(const f32x4*)(base + off + bj * HALF + n * 16); acc[ai][bj][m][n] = bs + (acc[ai][bj][m][n] - sr.x) * sr.y; }
                asm volatile("" : "+v"(acc[ai][0][m][0]), "+v"(acc[ai][0][m][1]), "+v"(acc[ai][1][m][0]), "+v"(acc[ai][1][m][1]));
                if (m & 1) asm volatile("" ::: "memory"); }
        const bool bad1 = bad;
        bad = st2.run(acc, u, wr, wc, fr, fq, lds, wid, lane) || bad;
#pragma unroll
        for (int ai = 0; ai < 2; ++ai)
#pragma unroll
            for (int m = 0; m < 4; ++m) { const int r = ai * HALF + wr * 64 + m * 16 + fr; const f32x2v sr = S[r]; const size_t off = (size_t)(u.pm * BM + r) * ldc + col0;
#pragma unroll
                for (int bj = 0; bj < 2; ++bj)
#pragma unroll
                    for (int n = 0; n < 2; ++n) { const f32x4 x1 = acc[ai][bj][m][n]; *(f32x4*)(out + off + bj * HALF + n * 16) = bad1 ? (f32x4){qnan, qnan, qnan, qnan} : x1;
                        const f32x4 o = (x1 - sr.x) * sr.y; u32x2v w; w.x = cvt_pk_bf16(o[0], o[1]); w.y = cvt_pk_bf16(o[2], o[3]);
                        if (bad) { w.x = 0x7fc07fc0u; w.y = 0x7fc07fc0u; } *(u32x2v*)(xn + off + bj * HALF + n * 16) = w; }
                asm volatile("" ::: "memory"); }
    }
};

template <class Epi, class Sched, bool ALIGN_EPI = false, bool SP2 = false>
__device__ __forceinline__ void gemm_phase(PG8_LAS unsigned char* lds, const Gemm g, const Sched& S, const Epi& E) {
    int tid = threadIdx.x; asm volatile("" : "+v"(tid));
    const int wid = __builtin_amdgcn_readfirstlane(tid >> 6), lane = tid & 63, wr = wid >> 2, wc = wid & 3, fr = lane & 15, fq = lane >> 4;
    int K = g.K; asm volatile("" : "+s"(K)); const int nt = g.nt ? g.nt : K / BK;
    const unsigned pitchA = g.pitchA ? g.pitchA : (unsigned)K * 2u, pitchB = g.pitchB ? g.pitchB : (unsigned)K * 2u;
    unsigned voffA[2], voffB[2];
#pragma unroll
    for (int i = 0; i < 2; ++i) { int R, C; stage_rc(tid * 16 + i * 8192, R, C); const int Rb = Epi::PERM ? ((R & ~31) + perm32(R & 31)) : R;
        voffA[i] = (unsigned)R * pitchA + (unsigned)C * 2u; voffB[i] = (unsigned)Rb * pitchB + (unsigned)C * 2u; }
    const size_t kstepA = g.kstepA ? g.kstepA : (size_t)(BK * 2), kstepB = g.kstepB ? g.kstepB : (size_t)(BK * 2);
    const size_t hstepA = g.hstepA ? g.hstepA : (size_t)HALF * K * 2, hstepB = g.hstepB ? g.hstepB : (size_t)HALF * K * 2;
    const size_t tA_pm = g.tA_pm ? g.tA_pm : (size_t)BM * K * 2, tA_pn = g.tA_pn, tB_pn = g.tB_pn ? g.tB_pn : (size_t)BM * K * 2;
    const unsigned ldsw = (unsigned)wid * 1024u;
    const int aoff = lds_byte(wr * 64 + fr, fq * 8), boff = lds_byte(wc * 32 + fr, fq * 8);
#define PG8_SA(b, h) (((b) * 2 + (h)) * HTB)
#define PG8_SB(b, h) ((4 + (b) * 2 + (h)) * HTB)
#define PG8_STAGE(bufoff, gbase, voff) do { _Pragma("unroll") for (int _i = 0; _i < 2; ++_i) \
        __builtin_amdgcn_global_load_lds((const unsigned*)((const char*)(gbase) + (voff)[_i]), (PG8_LAS unsigned*)(lds + (bufoff) + ldsw + _i * 8192), 16, 0, 0); } while (0)
#define PG8_LDA(dst, b, h) do { _Pragma("unroll") for (int m = 0; m < 4; ++m) _Pragma("unroll") for (int k = 0; k < 2; ++k) dst[m][k] = *(const PG8_LAS bf16x8*)(lds + PG8_SA(b, h) + aoff + m * 2048 + k * 1024); } while (0)
#define PG8_LDB(dst, b, h) do { _Pragma("unroll") for (int n = 0; n < 2; ++n) _Pragma("unroll") for (int k = 0; k < 2; ++k) dst[n][k] = *(const PG8_LAS bf16x8*)(lds + PG8_SB(b, h) + boff + n * 2048 + k * 1024); } while (0)
#define PG8_MMA(ai, bj, At, Bt) do { __builtin_amdgcn_s_setprio(1); _Pragma("unroll") for (int m = 0; m < 4; ++m) _Pragma("unroll") for (int n = 0; n < 2; ++n) _Pragma("unroll") for (int k = 0; k < 2; ++k) \
        acc[ai][bj][m][n] = __builtin_amdgcn_mfma_f32_16x16x32_bf16(Bt[n][k], At[m][k], acc[ai][bj][m][n], 0, 0, 0); __builtin_amdgcn_s_setprio(0); } while (0)
#define PG8_WAIT_V(n) asm volatile("s_waitcnt vmcnt(" #n ")" ::: "memory")
#define PG8_WAIT_L(n) asm volatile("s_waitcnt lgkmcnt(" #n ")" ::: "memory")
#define PG8_BAR __builtin_amdgcn_s_barrier()
#define PG8_SCHED __builtin_amdgcn_sched_barrier(0)
    Unit cur, nxt; int ui = 0;
    if (!S.next(0, cur)) return;
    f32x4 acc[2][2][4][2];
#pragma unroll
    for (int a = 0; a < 2; ++a)
#pragma unroll
        for (int b = 0; b < 2; ++b)
#pragma unroll
            for (int m = 0; m < 4; ++m)
#pragma unroll
                for (int n = 0; n < 2; ++n) acc[a][b][m][n] = (f32x4){0.f, 0.f, 0.f, 0.f};
    bf16x8 At[4][2], B0[2][2], B1[2][2];
    const char* cA = (const char*)g.A + (size_t)cur.pm * tA_pm + (size_t)cur.pn * tA_pn; const char* cB = (const char*)g.Bt + (size_t)cur.pn * tB_pn;
    S.a_ready(cur);
    if constexpr (SP2) {
        PG8_STAGE(PG8_SB(0, 0), cB, voffB); PG8_STAGE(PG8_SB(0, 1), cB + hstepB, voffB); PG8_STAGE(PG8_SA(0, 0), cA, voffA); PG8_STAGE(PG8_SA(0, 1), cA + hstepA, voffA);
        if (wr == 1) PG8_BAR;
        PG8_WAIT_V(2); PG8_BAR;
        PG8_STAGE(PG8_SB(1, 0), cB + kstepB, voffB); PG8_STAGE(PG8_SA(1, 0), cA + kstepA, voffA); PG8_STAGE(PG8_SB(1, 1), cB + hstepB + kstepB, voffB);
        PG8_WAIT_V(6); PG8_BAR;
    } else {
        PG8_STAGE(PG8_SB(0, 0), cB, voffB); PG8_STAGE(PG8_SA(0, 0), cA, voffA); PG8_STAGE(PG8_SB(0, 1), cB + hstepB, voffB); PG8_STAGE(PG8_SA(0, 1), cA + hstepA, voffA);
        if (wr == 1) PG8_BAR;
        PG8_WAIT_V(4); PG8_BAR;
        PG8_STAGE(PG8_SB(1, 0), cB + kstepB, voffB); PG8_STAGE(PG8_SA(1, 0), cA + kstepA, voffA); PG8_STAGE(PG8_SB(1, 1), cB + hstepB + kstepB, voffB);
        PG8_WAIT_V(6); PG8_BAR;
    }
    for (;;) {
        const bool has_next = S.next(ui + 1, nxt);
        const char* nA = has_next ? (const char*)g.A + (size_t)nxt.pm * tA_pm + (size_t)nxt.pn * tA_pn : cA; const char* nB = has_next ? (const char*)g.Bt + (size_t)nxt.pn * tB_pn : cB;
        for (int t = 0; t < nt; t += 2) {
            if constexpr (Epi::MIDK) { if (t == (nt >> 1)) E.midk(acc, cur, wr, wc, fr, fq); }
            const bool last = (t == nt - 2);
            const char* a1 = cA + (size_t)(t + 1) * kstepA;
            const char* a2 = last ? nA : cA + (size_t)(t + 2) * kstepA; const char* b2 = last ? nB : cB + (size_t)(t + 2) * kstepB;
            const char* a3 = a2 + kstepA; const char* b3 = b2 + kstepB;
            if (last && has_next) S.a_ready(nxt);
            if constexpr (SP2) {
            PG8_LDB(B0, 0, 0); PG8_LDB(B1, 0, 1); PG8_SCHED; PG8_LDA(At, 0, 0); PG8_STAGE(PG8_SA(1, 1), a1 + hstepA, voffA);
            PG8_WAIT_V(8); PG8_WAIT_L(0); PG8_BAR; PG8_MMA(0, 0, At, B0); PG8_MMA(0, 1, At, B1); PG8_BAR; PG8_SCHED;
            PG8_LDA(At, 0, 1); PG8_STAGE(PG8_SB(0, 0), b2, voffB); PG8_STAGE(PG8_SB(0, 1), b2 + hstepB, voffB); PG8_STAGE(PG8_SA(0, 0), a2, voffA);
            PG8_WAIT_V(8); PG8_WAIT_L(0); PG8_BAR; PG8_MMA(1, 0, At, B0); PG8_MMA(1, 1, At, B1); PG8_BAR; PG8_SCHED;
            PG8_LDB(B0, 1, 0); PG8_LDB(B1, 1, 1); PG8_SCHED; PG8_LDA(At, 1, 0); PG8_STAGE(PG8_SA(0, 1), a2 + hstepA, voffA);
            PG8_WAIT_V(8); PG8_WAIT_L(0); PG8_BAR; PG8_MMA(0, 0, At, B0); PG8_MMA(0, 1, At, B1); PG8_BAR; PG8_SCHED;
            PG8_LDA(At, 1, 1); PG8_STAGE(PG8_SB(1, 0), b3, voffB); PG8_STAGE(PG8_SB(1, 1), b3 + hstepB, voffB); PG8_STAGE(PG8_SA(1, 0), a3, voffA);
            PG8_WAIT_V(8); PG8_WAIT_L(0); PG8_BAR; PG8_MMA(1, 0, At, B0); PG8_MMA(1, 1, At, B1); PG8_BAR; PG8_SCHED;
            } else {
            PG8_LDB(B0, 0, 0); PG8_SCHED; PG8_LDA(At, 0, 0); PG8_STAGE(PG8_SA(1, 1), a1 + hstepA, voffA);
            PG8_WAIT_L(8); PG8_BAR; PG8_WAIT_L(0); PG8_MMA(0, 0, At, B0); PG8_BAR; PG8_SCHED;
            PG8_LDB(B1, 0, 1); PG8_STAGE(PG8_SB(0, 0), b2, voffB);
            PG8_BAR; PG8_WAIT_L(0); PG8_MMA(0, 1, At, B1); PG8_BAR;
            PG8_LDA(At, 0, 1); PG8_STAGE(PG8_SA(0, 0), a2, voffA);
            PG8_BAR; PG8_WAIT_L(0); PG8_MMA(1, 0, At, B0); PG8_BAR; PG8_SCHED;
            PG8_STAGE(PG8_SB(0, 1), b2 + hstepB, voffB);
            PG8_WAIT_V(6); PG8_BAR; PG8_MMA(1, 1, At, B1); PG8_BAR;
            PG8_LDB(B0, 1, 0); PG8_SCHED; PG8_LDA(At, 1, 0); PG8_STAGE(PG8_SA(0, 1), a2 + hstepA, voffA);
            PG8_WAIT_L(8); PG8_BAR; PG8_WAIT_L(0); PG8_MMA(0, 0, At, B0); PG8_BAR; PG8_SCHED;
            PG8_LDB(B1, 1, 1); PG8_STAGE(PG8_SB(1, 0), b3, voffB);
            PG8_BAR; PG8_WAIT_L(0); PG8_MMA(0, 1, At, B1); PG8_BAR;
            PG8_LDA(At, 1, 1); PG8_STAGE(PG8_SA(1, 0), a3, voffA);
            PG8_BAR; PG8_WAIT_L(0); PG8_MMA(1, 0, At, B0); PG8_BAR; PG8_SCHED;
            PG8_STAGE(PG8_SB(1, 1), b3 + hstepB, voffB);
            PG8_WAIT_V(6); PG8_BAR; PG8_MMA(1, 1, At, B1); PG8_BAR;
            }
        }
        if constexpr (ALIGN_EPI) { if (wr == 0) PG8_BAR; }
        if constexpr (!Epi::AFTER_DRAIN) { E(acc, cur, wr, wc, fr, fq); S.done(cur); }
        if (!has_next) break;
#pragma unroll
        for (int a = 0; a < 2; ++a)
#pragma unroll
            for (int b = 0; b < 2; ++b)
#pragma unroll
                for (int m = 0; m < 4; ++m)
#pragma unroll
                    for (int n = 0; n < 2; ++n) acc[a][b][m][n] = (f32x4){0.f, 0.f, 0.f, 0.f};
        cur = nxt; cA = nA; cB = nB; ++ui;
        if constexpr (ALIGN_EPI) { if (wr == 1) PG8_BAR; }
    }
    PG8_WAIT_V(0);
    if constexpr (!ALIGN_EPI) { if (wr == 0) PG8_BAR; }
    PG8_BAR;
    if constexpr (Epi::AFTER_DRAIN) { E.fused(acc, cur, wr, wc, fr, fq, lds, wid, lane); S.done(cur); }
#undef PG8_SA
#undef PG8_SB
#undef PG8_STAGE
#undef PG8_LDA
#undef PG8_LDB
#undef PG8_MMA
#undef PG8_WAIT_V
#undef PG8_WAIT_L
#undef PG8_BAR
#undef PG8_SCHED
}
}

namespace pg8 {
constexpr float LOG2E = 1.4426950408889634f;
constexpr float QS_NSA = 0.125f * LOG2E;
constexpr float QS_MLA = 0.10206207261596575f * LOG2E;
__device__ __forceinline__ float fast_sigmoid(float x) { return __builtin_amdgcn_rcpf(1.0f + __builtin_amdgcn_exp2f(-LOG2E * x)); }
__device__ __forceinline__ float lo_bf(unsigned u) { return __uint_as_float(u << 16); }
__device__ __forceinline__ float hi_bf(unsigned u) { return __uint_as_float(u & 0xffff0000u); }
struct EpiInProjF {
    static constexpr bool PERM = true, AFTER_DRAIN = false, MIDK = false;
    bf16_t* proj; unsigned char* gates;
    __device__ __forceinline__ void operator()(const f32x4 (&acc)[2][2][4][2], const Unit& u, int wr, int wc, int fr, int fq) const {
        const bool isg = u.pn >= 7;
        bf16_t* base = proj; const int ld = 1792; const int colt = isg ? (u.pn - 7) * BM : u.pn * BM;
        const float sc = (u.pn < 2) ? QS_NSA : 1.0f;
        const int row0 = u.pm * BM + wr * 64 + fr, col0 = colt + wc * 32 + 8 * fq;
#pragma unroll
        for (int ai = 0; ai < 2; ++ai)
#pragma unroll
            for (int m = 0; m < 4; ++m) { bf16_t* rowp = base + (size_t)(row0 + ai * HALF + m * 16) * ld + col0;
#pragma unroll
                for (int bj = 0; bj < 2; ++bj) { f32x4 v0 = acc[ai][bj][m][0], v1 = acc[ai][bj][m][1];
                    if (isg) {
                        unsigned q[8];
#pragma unroll
                        for (int e = 0; e < 4; ++e) { q[e] = (unsigned)(fast_sigmoid(v0[e]) * 255.0f + 0.5f); q[4 + e] = (unsigned)(fast_sigmoid(v1[e]) * 255.0f + 0.5f); }
                        uint2 w; w.x = q[0] | (q[1] << 8) | (q[2] << 16) | (q[3] << 24); w.y = q[4] | (q[5] << 8) | (q[6] << 16) | (q[7] << 24);
                        *(uint2*)(gates + (size_t)(row0 + ai * HALF + m * 16) * 2048 + col0 + bj * HALF) = w;
                    } else { v0 = v0 * sc; v1 = v1 * sc;
                        u32x4 w; w.x = cvt_pk_bf16(v0[0], v0[1]); w.y = cvt_pk_bf16(v0[2], v0[3]); w.z = cvt_pk_bf16(v1[0], v1[1]); w.w = cvt_pk_bf16(v1[2], v1[3]);
                        *(u32x4*)(rowp + bj * HALF) = w; } } }
    }
};
template <int PASS> struct EpiMergeF {
    static constexpr bool PERM = true, AFTER_DRAIN = false, MIDK = false;
    const unsigned char* gates; bf16_t* merged;
    __device__ __forceinline__ void operator()(const f32x4 (&acc)[2][2][4][2], const Unit& u, int wr, int wc, int fr, int fq) const {
        const int row0 = u.pm * BM + wr * 64 + fr, col0 = u.pn * BM + wc * 32 + 8 * fq;
#pragma unroll
        for (int ai = 0; ai < 2; ++ai)
#pragma unroll
            for (int m = 0; m < 4; ++m) { const size_t r = (size_t)(row0 + ai * HALF + m * 16);
#pragma unroll
                for (int bj = 0; bj < 2; ++bj) { const int c = col0 + bj * HALF;
                    const uint2 g = *(const uint2*)(gates + r * 2048 + PASS * 1024 + c);
                    f32x4 v0 = acc[ai][bj][m][0] * (1.0f / 255.0f), v1 = acc[ai][bj][m][1] * (1.0f / 255.0f);
                    v0[0] *= (float)(g.x & 255u); v0[1] *= (float)((g.x >> 8) & 255u); v0[2] *= (float)((g.x >> 16) & 255u); v0[3] *= (float)(g.x >> 24);
                    v1[0] *= (float)(g.y & 255u); v1[1] *= (float)((g.y >> 8) & 255u); v1[2] *= (float)((g.y >> 16) & 255u); v1[3] *= (float)(g.y >> 24);
                    if (PASS == 1) { const u32x4 o = *(const u32x4*)(merged + r * 1024 + c);
                        v0[0] += lo_bf(o.x); v0[1] += hi_bf(o.x); v0[2] += lo_bf(o.y); v0[3] += hi_bf(o.y);
                        v1[0] += lo_bf(o.z); v1[1] += hi_bf(o.z); v1[2] += lo_bf(o.w); v1[3] += hi_bf(o.w); }
                    u32x4 w; w.x = cvt_pk_bf16(v0[0], v0[1]); w.y = cvt_pk_bf16(v0[2], v0[3]); w.z = cvt_pk_bf16(v1[0], v1[1]); w.w = cvt_pk_bf16(v1[2], v1[3]);
                    *(u32x4*)(merged + r * 1024 + c) = w; } }
    }
};
struct EpiMergeFusedF {
    static constexpr bool PERM = true, AFTER_DRAIN = false, MIDK = true;
    const unsigned char* gates; bf16_t* merged;
    __device__ __forceinline__ void midk(f32x4 (&acc)[2][2][4][2], const Unit& u, int wr, int wc, int fr, int fq) const {
        asm volatile("" : "+v"(fr), "+v"(fq));
        const int row0 = u.pm * BM + wr * 64 + fr, col0 = u.pn * BM + wc * 32 + 8 * fq;
#pragma unroll
        for (int ai = 0; ai < 2; ++ai)
#pragma unroll
            for (int m = 0; m < 4; ++m) { const size_t r = (size_t)(row0 + ai * HALF + m * 16);
#pragma unroll
                for (int bj = 0; bj < 2; ++bj) { const int c = col0 + bj * HALF;
                    const uint2 g0 = *(const uint2*)(gates + r * 2048 + c), g1 = *(const uint2*)(gates + r * 2048 + 1024 + c);
#pragma unroll
                    for (int e = 0; e < 4; ++e) {
                        const float a0 = (float)((g0.x >> (8 * e)) & 255u), b0 = fmaxf((float)((g1.x >> (8 * e)) & 255u), 1.0f);
                        const float a1 = (float)((g0.y >> (8 * e)) & 255u), b1 = fmaxf((float)((g1.y >> (8 * e)) & 255u), 1.0f);
                        acc[ai][bj][m][0][e] *= a0 * __builtin_amdgcn_rcpf(b0); acc[ai][bj][m][1][e] *= a1 * __builtin_amdgcn_rcpf(b1); }
                    asm volatile("" ::: "memory"); } }
    }
    __device__ __forceinline__ void operator()(const f32x4 (&acc)[2][2][4][2], const Unit& u, int wr, int wc, int fr, int fq) const {
        const int row0 = u.pm * BM + wr * 64 + fr, col0 = u.pn * BM + wc * 32 + 8 * fq;
#pragma unroll
        for (int ai = 0; ai < 2; ++ai)
#pragma unroll
            for (int m = 0; m < 4; ++m) { const size_t r = (size_t)(row0 + ai * HALF + m * 16);
#pragma unroll
                for (int bj = 0; bj < 2; ++bj) { const int c = col0 + bj * HALF;
                    const uint2 g1 = *(const uint2*)(gates + r * 2048 + 1024 + c);
                    f32x4 v0 = acc[ai][bj][m][0] * (1.0f / 255.0f), v1 = acc[ai][bj][m][1] * (1.0f / 255.0f);
#pragma unroll
                    for (int e = 0; e < 4; ++e) { v0[e] *= fmaxf((float)((g1.x >> (8 * e)) & 255u), 1.0f); v1[e] *= fmaxf((float)((g1.y >> (8 * e)) & 255u), 1.0f); }
                    u32x4 w; w.x = cvt_pk_bf16(v0[0], v0[1]); w.y = cvt_pk_bf16(v0[2], v0[3]); w.z = cvt_pk_bf16(v1[0], v1[1]); w.w = cvt_pk_bf16(v1[2], v1[3]);
                    *(u32x4*)(merged + r * 1024 + c) = w; } }
    }
};
struct EpiCmpOutF {
    static constexpr bool PERM = true, AFTER_DRAIN = false, MIDK = false;
    bf16_t* dst;
    __device__ __forceinline__ void operator()(const f32x4 (&acc)[2][2][4][2], const Unit& u, int wr, int wc, int fr, int fq) const {
        if (wc >= 2) return;
        const int row0 = u.pm * BM + wr * 64 + fr, col0 = wc * 32 + 8 * fq;
#pragma unroll
        for (int ai = 0; ai < 2; ++ai)
#pragma unroll
            for (int m = 0; m < 4; ++m) { const int r = row0 + ai * HALF + m * 16;
                if (r < BATCH * NC * 2) { const int g = r & 1, bc = r >> 1, b = bc / NC, c = bc % NC;
                    const f32x4 v0 = acc[ai][0][m][0], v1 = acc[ai][0][m][1];
                    u32x4 w; w.x = cvt_pk_bf16(v0[0], v0[1]); w.y = cvt_pk_bf16(v0[2], v0[3]); w.z = cvt_pk_bf16(v1[0], v1[1]); w.w = cvt_pk_bf16(v1[2], v1[3]);
                    *(u32x4*)(dst + ((size_t)(b * 2 + g) * 128 + c) * 64 + col0) = w; } }
    }
};
struct EpiSlabF {
    static constexpr bool PERM = false, AFTER_DRAIN = false, MIDK = false;
    float* slab;
    __device__ __forceinline__ void operator()(const f32x4 (&acc)[2][2][4][2], const Unit& u, int wr, int wc, int fr, int fq) const {
        const int row0 = u.pm * BM + wr * 64 + fr, col0 = wc * 32 + 4 * fq;
        float* base = slab + (size_t)u.pn * 2048 * 256;
#pragma unroll
        for (int ai = 0; ai < 2; ++ai)
#pragma unroll
            for (int m = 0; m < 4; ++m) { float* rowp = base + (size_t)(row0 + ai * HALF + m * 16) * 256 + col0;
#pragma unroll
                for (int bj = 0; bj < 2; ++bj)
#pragma unroll
                    for (int n = 0; n < 2; ++n) *(f32x4*)(rowp + bj * HALF + n * 16) = acc[ai][bj][m][n]; }
    }
};
struct EpiResidF {
    static constexpr bool PERM = false, AFTER_DRAIN = false, MIDK = false;
    const float* x; float* h;
    __device__ __forceinline__ void operator()(const f32x4 (&acc)[2][2][4][2], const Unit& u, int wr, int wc, int fr, int fq) const {
        const int row0 = u.pm * BM + wr * 64 + fr, col0 = u.pn * BM + wc * 32 + 4 * fq;
#pragma unroll
        for (int ai = 0; ai < 2; ++ai)
#pragma unroll
            for (int m = 0; m < 4; ++m) { const size_t off = (size_t)(row0 + ai * HALF + m * 16) * 1024 + col0;
#pragma unroll
                for (int bj = 0; bj < 2; ++bj)
#pragma unroll
                    for (int n = 0; n < 2; ++n) { const f32x4 xv = *(const f32x4*)(x + off + bj * HALF + n * 16); *(f32x4*)(h + off + bj * HALF + n * 16) = xv + acc[ai][bj][m][n]; } }
    }
};
struct EpiMlaQF {
    static constexpr bool PERM = false, AFTER_DRAIN = false, MIDK = false;
    bf16_t* q; const float2* cs;
    __device__ __forceinline__ void operator()(const f32x4 (&acc)[2][2][4][2], const Unit& u, int wr, int wc, int fr, int fq) const {
        const int row0 = u.pm * BM + wr * 64 + fr;
#pragma unroll
        for (int bj = 0; bj < 2; ++bj) {
            const int X = u.pn * BM + bj * HALF + wc * 32;
            const bool rope = (X % 96) == 64;
#pragma unroll
            for (int ai = 0; ai < 2; ++ai)
#pragma unroll
                for (int m = 0; m < 4; ++m) { const int r = row0 + ai * HALF + m * 16; const int pos = r & (SEQ - 1);
                    f32x4 v0 = acc[ai][bj][m][0], v1 = acc[ai][bj][m][1];
                    if (rope) {
#pragma unroll
                        for (int j = 0; j < 4; ++j) { const float2 c = cs[pos * 16 + 4 * fq + j]; const float x1 = v0[j], x2 = v1[j]; v0[j] = x1 * c.x - x2 * c.y; v1[j] = x2 * c.x + x1 * c.y; } }
                    v0 = v0 * QS_MLA; v1 = v1 * QS_MLA;
                    bf16_t* p = q + (size_t)r * 768 + X + 4 * fq;
                    uint2 w0, w1; w0.x = cvt_pk_bf16(v0[0], v0[1]); w0.y = cvt_pk_bf16(v0[2], v0[3]); w1.x = cvt_pk_bf16(v1[0], v1[1]); w1.y = cvt_pk_bf16(v1[2], v1[3]);
                    *(uint2*)p = w0; *(uint2*)(p + 16) = w1; }
        }
    }
};
}

#define PG8_SP2 true
#define PG8_ALIGN true
constexpr int NTHR = 512, NWV = NTHR / 64;
#define WAVE_IDS const int lane = threadIdx.x & 63, wv = threadIdx.x >> 6; const int gw = blockIdx.x * NWV + wv, nw = gridDim.x * NWV; (void)lane; (void)gw; (void)nw;

template <bool Q8> DEV void ph_rms1024(const float* __restrict__ src, const float* __restrict__ g, bf16_t* __restrict__ dst, int rows, unsigned* __restrict__ q8 = nullptr, float* __restrict__ qs = nullptr, int gw_o = -1, int nw_o = 0, const bf16_t* __restrict__ add = nullptr) {
  const int lane = threadIdx.x & 63; const int gw = (gw_o >= 0) ? gw_o : (int)(blockIdx.x * NWV + (threadIdx.x >> 6)); const int nw = (gw_o >= 0) ? nw_o : (int)(gridDim.x * NWV);
  float4 gg[4];
#pragma unroll
  for (int j = 0; j < 4; ++j) gg[j] = ((const float4*)g)[j * 64 + lane];
  float4 nx[4]; uint2 na[4];
  if (gw < rows) {
#pragma unroll
    for (int j = 0; j < 4; ++j) { nx[j] = ((const float4*)(src + (size_t)gw * 1024))[j * 64 + lane]; if (add) na[j] = ((const uint2*)(add + (size_t)gw * 1024))[j * 64 + lane]; } }
  for (int r = gw; r < rows; r += nw) {
    float4 v[4]; float ss = 0.f;
#pragma unroll
    for (int j = 0; j < 4; ++j) { v[j] = nx[j];
      if (add) { v[j].x += __uint_as_float(na[j].x << 16); v[j].y += __uint_as_float(na[j].x & 0xffff0000u); v[j].z += __uint_as_float(na[j].y << 16); v[j].w += __uint_as_float(na[j].y & 0xffff0000u); }
      ss += v[j].x * v[j].x + v[j].y * v[j].y + v[j].z * v[j].z + v[j].w * v[j].w; }
    if (r + nw < rows) {
#pragma unroll
      for (int j = 0; j < 4; ++j) { nx[j] = ((const float4*)(src + (size_t)(r + nw) * 1024))[j * 64 + lane]; if (add) na[j] = ((const uint2*)(add + (size_t)(r + nw) * 1024))[j * 64 + lane]; } }
    ss = wsum(ss);
    const float inv = rsqrtf(ss * (1.0f / 1024.0f) + 1e-6f);
    float mx = 0.f;
#pragma unroll
    for (int j = 0; j < 4; ++j) {
      v[j].x *= inv * gg[j].x; v[j].y *= inv * gg[j].y; v[j].z *= inv * gg[j].z; v[j].w *= inv * gg[j].w;
      uint2 o;
      o.x = (unsigned)f2bf(v[j].x) | ((unsigned)f2bf(v[j].y) << 16);
      o.y = (unsigned)f2bf(v[j].z) | ((unsigned)f2bf(v[j].w) << 16);
      ((uint2*)(dst + (size_t)r * 1024))[j * 64 + lane] = o;
      if (Q8) mx = fmaxf(mx, fmaxf(fmaxf(fabsf(v[j].x), fabsf(v[j].y)), fmaxf(fabsf(v[j].z), fabsf(v[j].w))));
    }
    if (Q8) {
      mx = wmaxf(mx);
      const float sc = fmaxf(mx, 1e-30f) * (1.0f / 127.0f), isc = 1.0f / sc;
#pragma unroll
      for (int j = 0; j < 4; ++j) {
        const int q0 = (int)rintf(v[j].x * isc), q1 = (int)rintf(v[j].y * isc), q2 = (int)rintf(v[j].z * isc), q3 = (int)rintf(v[j].w * isc);
        q8[(size_t)r * 256 + j * 64 + lane] = (unsigned)(q0 & 255) | ((unsigned)(q1 & 255) << 8) | ((unsigned)(q2 & 255) << 16) | ((unsigned)(q3 & 255) << 24);
      }
      if (lane == 0) qs[r] = sc;
    }
  }
}
DEV int win_src_col(int n) {
  if (n < 1280) return n;
  if (n < 1536) return 1304 + (n - 1280);
  if (n < 1664) return 1560 + (n - 1536);
  if (n < 1696) return 1688 + (n - 1664);
  if (n < 1720) return 1280 + (n - 1696);
  if (n < 1792) return -1;
  return 1720 + (n - 1792);
}
template <int MODE> DEV void tr_item(const float* __restrict__ W, int K, int Nsrc, bf16_t* __restrict__ WT, int Nblk, int Nvalid, __attribute__((address_space(3))) float* scr, int item, int lane, int pitch = 0, int koff = 0) {
  if (pitch == 0) pitch = K;
  const int kb = item / Nblk, nb = item % Nblk, k0 = 64 * kb, n0 = 32 * nb;
  const int n = n0 + (lane & 31);
  const int sc = (MODE == 1) ? win_src_col(n) : ((n < Nvalid) ? n : -1);
  float tv[32];
#pragma unroll
  for (int i = 0; i < 32; ++i) { const int kk = 2 * i + (lane >> 5); tv[i] = (sc >= 0) ? W[(size_t)(k0 + kk) * Nsrc + sc] : 0.f; }
#pragma unroll
  for (int i = 0; i < 32; ++i) { const int kk = 2 * i + (lane >> 5); scr[kk * 33 + (lane & 31)] = tv[i]; }
  asm volatile("s_waitcnt lgkmcnt(0)" ::: "memory");
  const int c = lane & 7;
#pragma unroll
  for (int j = 0; j < 4; ++j) { const int nn = (lane >> 3) + 8 * j; const __attribute__((address_space(3))) float* sp = scr + (8 * c) * 33 + nn;
    uint4 o;
    o.x = (unsigned)f2bf(sp[0 * 33]) | ((unsigned)f2bf(sp[1 * 33]) << 16); o.y = (unsigned)f2bf(sp[2 * 33]) | ((unsigned)f2bf(sp[3 * 33]) << 16);
    o.z = (unsigned)f2bf(sp[4 * 33]) | ((unsigned)f2bf(sp[5 * 33]) << 16); o.w = (unsigned)f2bf(sp[6 * 33]) | ((unsigned)f2bf(sp[7 * 33]) << 16);
    *(uint4*)(WT + (size_t)(n0 + nn) * pitch + koff + k0 + 8 * c) = o; }
  asm volatile("s_waitcnt lgkmcnt(0)" ::: "memory");
}
DEV void rope_entry(float2* __restrict__ cs, int i) {
  const int j = i & 15, pos = i >> 4;
  const float inv_freq = __builtin_amdgcn_exp2f(-(float)(2 * j) * (13.287712379549449f / 32.0f));
  const float rev = (float)pos * inv_freq * 0.15915494309189535f;
  const float fr = rev - floorf(rev);
  cs[i] = make_float2(__builtin_amdgcn_cosf(fr), __builtin_amdgcn_sinf(fr));
}
namespace att {
#define LAS3 __attribute__((address_space(3)))
typedef LAS3 char* lptr;
typedef LAS3 const char* lcptr;
using bf16x8 = __attribute__((ext_vector_type(8))) short;
using s16x4 = __attribute__((ext_vector_type(4))) short;
using f32x16 = __attribute__((ext_vector_type(16))) float;
typedef short v4i16_t __attribute__((ext_vector_type(4)));
typedef unsigned u32x4 __attribute__((ext_vector_type(4)));
typedef float f32x4_t __attribute__((ext_vector_type(4)));
typedef float f32x2_t __attribute__((ext_vector_type(2)));
typedef __bf16 bf16x2_t __attribute__((ext_vector_type(2)));
constexpr float LOG2E = 1.4426950408889634f;
constexpr float THR = 8.0f;
constexpr float NEG_INF = -__builtin_huge_valf();
constexpr int SLOT = 20480, KOFF = 0, VOFF = 12288;
constexpr int L_WSF = 2 * SLOT;
constexpr int L_TB = L_WSF + 2048;
constexpr int L_ST = L_TB + 8 * 320 * 4;
constexpr int L_SELM = L_ST + 768;
constexpr int L_SC = L_SELM + 256;
constexpr int L_IMPQ = L_SC + 64 * 33 * 4;
constexpr int L_IMPL = L_IMPQ + 4 * 64 * 33 * 4;
constexpr int L_FIN = L_IMPQ;
constexpr int L_END = L_IMPL + 4 * 64 * 33 * 4;
static_assert(L_END <= 131072, "attention LDS map");

__device__ __forceinline__ int crow(int r, int hi) { return (r & 3) + 8 * (r >> 2) + 4 * hi; }
__device__ __forceinline__ s16x4 vtr(lcptr p) { return __builtin_bit_cast(s16x4, __builtin_amdgcn_ds_read_tr16_b64_v4i16((LAS3 v4i16_t*)p)); }
__device__ __forceinline__ unsigned cvtpk(float lo, float hi) { f32x2_t v = {lo, hi}; bf16x2_t b = __builtin_convertvector(v, bf16x2_t); return __builtin_bit_cast(unsigned, b); }
typedef float f32x2_t __attribute__((ext_vector_type(2)));
__device__ __forceinline__ float max3(float a, float b, float c) { float d; asm("v_max3_f32 %0, %1, %2, %3" : "=v"(d) : "v"(a), "v"(b), "v"(c)); return d; }
__device__ __forceinline__ float xmax(float v) { auto rr = __builtin_amdgcn_permlane32_swap(__float_as_uint(v), __float_as_uint(v), false, false); return fmaxf(__uint_as_float(rr[0]), __uint_as_float(rr[1])); }
__device__ __forceinline__ float xsum(float v) { auto rr = __builtin_amdgcn_permlane32_swap(__float_as_uint(v), __float_as_uint(v), false, false); return __uint_as_float(rr[0]) + __uint_as_float(rr[1]); }
__device__ __forceinline__ float ex2(float x) { return __builtin_amdgcn_exp2f(x); }

template <int ND0> __device__ __forceinline__ void qkt(f32x16& p0, f32x16& p1, lcptr kb, const bf16x8* qr) {
  bf16x8 kf[2 * ND0];
#pragma unroll
  for (int d0 = 0; d0 < ND0; ++d0) { kf[2 * d0] = *(const LAS3 bf16x8*)(kb + d0 * 2048); kf[2 * d0 + 1] = *(const LAS3 bf16x8*)(kb + d0 * 2048 + 512); }
  __builtin_amdgcn_sched_barrier(0);
  p0 = f32x16{}; p1 = f32x16{};
  __builtin_amdgcn_s_setprio(1);
#pragma unroll
  for (int d0 = 0; d0 < ND0; ++d0) {
    p0 = __builtin_amdgcn_mfma_f32_32x32x16_bf16(kf[2 * d0], qr[d0], p0, 0, 0, 0);
    p1 = __builtin_amdgcn_mfma_f32_32x32x16_bf16(kf[2 * d0 + 1], qr[d0], p1, 0, 0, 0);
  }
  __builtin_amdgcn_s_setprio(0);
}
template <int ND0> __device__ __forceinline__ void qkt_init(f32x16& p0, f32x16& p1, lcptr kb, const bf16x8* qr, const f32x16& c0, const f32x16& c1) {
  bf16x8 kf[2 * ND0];
#pragma unroll
  for (int d0 = 0; d0 < ND0; ++d0) { kf[2 * d0] = *(const LAS3 bf16x8*)(kb + d0 * 2048); kf[2 * d0 + 1] = *(const LAS3 bf16x8*)(kb + d0 * 2048 + 512); }
  __builtin_amdgcn_sched_barrier(0);
  p0 = c0; p1 = c1;
  __builtin_amdgcn_s_setprio(1);
#pragma unroll
  for (int d0 = 0; d0 < ND0; ++d0) {
    p0 = __builtin_amdgcn_mfma_f32_32x32x16_bf16(kf[2 * d0], qr[d0], p0, 0, 0, 0);
    p1 = __builtin_amdgcn_mfma_f32_32x32x16_bf16(kf[2 * d0 + 1], qr[d0], p1, 0, 0, 0);
  }
  __builtin_amdgcn_s_setprio(0);
}
__device__ __forceinline__ void pv_load(bf16x8 (&vf)[8], lcptr vp) {
#pragma unroll
  for (int d0 = 0; d0 < 2; ++d0)
#pragma unroll
    for (int ks = 0; ks < 4; ++ks) {
      const s16x4 lo = vtr(vp + d0 * 4096 + ks * 1024), hi4 = vtr(vp + d0 * 4096 + ks * 1024 + 512);
      vf[d0 * 4 + ks] = (bf16x8){lo[0], lo[1], lo[2], lo[3], hi4[0], hi4[1], hi4[2], hi4[3]};
    }
}
__device__ __forceinline__ void pv_mma(f32x16 (&o)[2], const bf16x8 (&vf)[8], const unsigned (&pw)[16]) {
  __builtin_amdgcn_s_setprio(1);
#pragma unroll
  for (int d0 = 0; d0 < 2; ++d0)
#pragma unroll
    for (int ks = 0; ks < 4; ++ks) {
      const unsigned pa4[4] = {pw[4 * ks], pw[4 * ks + 1], pw[4 * ks + 2], pw[4 * ks + 3]};
      o[d0] = __builtin_amdgcn_mfma_f32_32x32x16_bf16(__builtin_bit_cast(bf16x8, pa4), vf[d0 * 4 + ks], o[d0], 0, 0, 0);
    }
  __builtin_amdgcn_s_setprio(0);
}
__device__ __forceinline__ void pv(f32x16 (&o)[2], lcptr vp, const unsigned (&pw)[16]) {
  __builtin_amdgcn_s_setprio(1);
#pragma unroll
  for (int d0 = 0; d0 < 2; ++d0)
#pragma unroll
    for (int ks = 0; ks < 4; ++ks) {
      const s16x4 lo = vtr(vp + d0 * 4096 + ks * 1024), hi4 = vtr(vp + d0 * 4096 + ks * 1024 + 512);
      const bf16x8 vf = {lo[0], lo[1], lo[2], lo[3], hi4[0], hi4[1], hi4[2], hi4[3]};
      const unsigned pa4[4] = {pw[4 * ks], pw[4 * ks + 1], pw[4 * ks + 2], pw[4 * ks + 3]};
      o[d0] = __builtin_amdgcn_mfma_f32_32x32x16_bf16(__builtin_bit_cast(bf16x8, pa4), vf, o[d0], 0, 0, 0);
    }
  __builtin_amdgcn_s_setprio(0);
}
__device__ __forceinline__ void softmax_step(f32x16& p0, f32x16& p1, float& m, float& l, f32x16 (&o)[2], LAS3 float* wsf, int r32, int hi, unsigned (&pw)[16], bool mine = true) {
  float rm, rm2;
  asm("s_nop 11\n\tv_max3_f32 %0, %2, %3, %4\n\tv_max3_f32 %1, %5, %6, %7" : "=&v"(rm), "=&v"(rm2) : "v"(p0[0]), "v"(p1[0]), "v"(p0[1]), "v"(p1[1]), "v"(p0[2]), "v"(p1[2]));
#pragma unroll
  for (int r = 3; r < 15; r += 2) { rm = max3(rm, p0[r], p1[r]); rm2 = max3(rm2, p0[r + 1], p1[r + 1]); }
  rm = max3(rm, p0[15], p1[15]); rm = max3(rm, rm2, rm2);
  rm = mine ? rm : NEG_INF;
  rm = xmax(rm);
  if (__any(rm > m + THR)) {
    const float mn = fmaxf(m, rm);
    const float al = ex2(m - mn);
    m = mn; l *= al;
    if (hi == 0) wsf[r32] = al;
#pragma unroll
    for (int r = 0; r < 16; ++r) { const float f = wsf[crow(r, hi)]; o[0][r] *= f; o[1][r] *= f; }
  }
  f32x2_t s2 = {0.f, 0.f}; const float nm1 = mine ? -m : NEG_INF; const f32x2_t nm = {nm1, nm1};
#pragma unroll
  for (int r = 0; r < 16; r += 2) {
    const f32x2_t a = (f32x2_t){p0[r], p0[r + 1]} + nm, b = (f32x2_t){p1[r], p1[r + 1]} + nm;
    p0[r] = ex2(a[0]); p0[r + 1] = ex2(a[1]); p1[r] = ex2(b[0]); p1[r + 1] = ex2(b[1]);
    s2 += (f32x2_t){p0[r], p0[r + 1]} + (f32x2_t){p1[r], p1[r + 1]};
  }
  l += s2[0] + s2[1];
#pragma unroll
  for (int i = 0; i < 8; ++i) { pw[i] = cvtpk(p0[2 * i], p0[2 * i + 1]); pw[8 + i] = cvtpk(p1[2 * i], p1[2 * i + 1]); }
}
struct KVSrc { const bf16_t* k; const bf16_t* v; int ldk, ldv; };
__device__ __forceinline__ void kv_issue(const KVSrc& s, int row0, u32x4& rk, u32x4& rv, int tid) {
  const int kv = tid & 63, ch = tid >> 6, ln = tid & 63;
  rk = *(const u32x4*)(s.k + (size_t)(row0 + kv) * s.ldk + ch * 8);
  rv = *(const u32x4*)(s.v + (size_t)(row0 + 16 * (ch & 3) + (ln >> 2)) * s.ldv + (ch >> 2) * 32 + (ln & 3) * 8);
}
__device__ __forceinline__ void kv_commit(lptr slot, const u32x4& rk, const u32x4& rv, int tid) {
  *(LAS3 u32x4*)(slot + KOFF + (tid >> 6) * 1024 + (tid & 63) * 16) = rk;
  *(LAS3 u32x4*)(slot + VOFF + tid * 16) = rv;
}
__device__ __forceinline__ void fin_set(LAS3 float* finl, const f32x16 (&o)[2], int lane) {
#pragma unroll
  for (int d0 = 0; d0 < 2; ++d0)
#pragma unroll
    for (int r = 0; r < 16; ++r) finl[(d0 * 16 + r) * 64 + lane] = o[d0][r];
}
__device__ __forceinline__ void fin_add(LAS3 float* finl, const f32x16 (&o)[2], const LAS3 float* wsf, int lane, int hi) {
#pragma unroll
  for (int r = 0; r < 16; ++r) { const float f = wsf[crow(r, hi)];
#pragma unroll
    for (int d0 = 0; d0 < 2; ++d0) finl[(d0 * 16 + r) * 64 + lane] += o[d0][r] * f; }
}
__device__ __forceinline__ void fin_store(const LAS3 float* finl, bf16_t* gout, size_t rowbase, int ld, int colbase, int lane) {
#pragma unroll
  for (int i = 0; i < 4; ++i) {
    const int q = i * 8 + (lane >> 3), ch = lane & 7;
    const int qh = (q >> 2) & 1, r = (q & 3) + 4 * (q >> 3), d0 = ch >> 2, dl = (ch & 3) * 8;
    const LAS3 float* p = finl + (d0 * 16 + r) * 64 + qh * 32 + dl;
    const f32x4_t x0 = *(const LAS3 f32x4_t*)p, x1 = *(const LAS3 f32x4_t*)(p + 4);
    u32x4 v; v.x = cvtpk(x0[0], x0[1]); v.y = cvtpk(x0[2], x0[3]); v.z = cvtpk(x1[0], x1[1]); v.w = cvtpk(x1[2], x1[3]);
    *(u32x4*)(gout + (rowbase + q) * (size_t)ld + colbase + ch * 8) = v;
  }
}

__device__ __forceinline__ void nsa_unit(int b, int g, int c, const bf16_t* __restrict__ proj, const bf16_t* __restrict__ kc, const bf16_t* __restrict__ vc, bf16_t* __restrict__ onsa, lptr lds) {
  int tid = threadIdx.x; asm volatile("" : "+v"(tid));
  const int lane = tid & 63, r32 = lane & 31, hi = lane >> 5;
  const int w = __builtin_amdgcn_readfirstlane(tid >> 6);
  const int rh = w >> 1, head = g * 4 + rh, tokl = 32 * (w & 1) + r32, t = 64 * c + tokl, bg = b * 2 + g;
  const size_t tok = (size_t)b * SEQ + t;
  LAS3 float* wsf = (LAS3 float*)(lds + L_WSF) + w * 64;
  const LAS3 float* tb = (const LAS3 float*)(lds + L_TB) + head * 320 + 64;
  const LAS3 float* stp = (const LAS3 float*)(lds + L_ST);
  LAS3 unsigned* selm = (LAS3 unsigned*)(lds + L_SELM);
  LAS3 float* sc = (LAS3 float*)(lds + L_SC);
  LAS3 float* impq = (LAS3 float*)(lds + L_IMPQ);
  LAS3 float* impl = (LAS3 float*)(lds + L_IMPL);
  const lcptr kb0 = (lcptr)lds + KOFF + hi * 1024 + r32 * 16;
  const lcptr vp0 = (lcptr)lds + VOFF + ((lane >> 4) & 1) * 32 + (lane & 3) * 8 + (4 * hi + ((lane & 15) >> 2)) * 64;
  bf16x8 qr[4];
#pragma unroll
  for (int d0 = 0; d0 < 4; ++d0) qr[d0] = *(const bf16x8*)(proj + tok * PROJ_LD + PC_Q + head * 64 + d0 * 16 + hi * 8);
  float gate[3];
#pragma unroll
  for (int j = 0; j < 3; ++j) gate[j] = 1.0f / (1.0f + ex2(-LOG2E * bf2f(proj[tok * PROJ_LD + PC_GATE + head * 3 + j])));
  LAS3 float* finl = (LAS3 float*)(lds + L_FIN) + w * 2048;
  f32x16 o[2]; unsigned pw[16];
  u32x4 rk, rv;
  {
    const KVSrc src{kc + (size_t)bg * 128 * 64, vc + (size_t)bg * 128 * 64, 64, 64};
    __syncthreads();
    kv_issue(src, 0, rk, rv, tid); kv_commit(lds, rk, rv, tid);
    kv_issue(src, 64, rk, rv, tid); kv_commit(lds + SLOT, rk, rv, tid);
    __syncthreads();
    f32x16 a0, a1, b0, b1;
    const int twmin = 64 * c + 32 * (w & 1), twmax = twmin + 31;
    const bool live0 = true, live1 = (16 * 32 + 31 <= twmax), live2 = (16 * 64 + 31 <= twmax), live3 = (16 * 96 + 31 <= twmax);
    qkt<4>(a0, a1, kb0, qr);
    if (live2) qkt<4>(b0, b1, kb0 + SLOT, qr); else { b0 = f32x16{}; b1 = f32x16{}; }
    float rm = NEG_INF;
#define CMP_QUARTER(P, QTR, LIVE) do { if (LIVE) { \
      if (!(16 * (32 * (QTR) + 31) + 31 + 112 < twmin)) { \
        _Pragma("unroll") for (int r = 0; r < 16; ++r) { int d_ = t - 16 * (32 * (QTR) + crow(r, hi)) - 31; d_ = d_ < -64 ? -64 : (d_ > 255 ? 255 : d_); P[r] += tb[d_]; } } \
      _Pragma("unroll") for (int r = 0; r < 16; ++r) rm = fmaxf(rm, P[r]); } } while (0)
    CMP_QUARTER(a0, 0, live0); CMP_QUARTER(a1, 1, live1); CMP_QUARTER(b0, 2, live2); CMP_QUARTER(b1, 3, live3);
#undef CMP_QUARTER
    rm = xmax(rm);
    const float mref = (rm == NEG_INF) ? 0.f : rm;
    float s = 0.f;
#define CMP_EXP(P, LIVE) do { if (LIVE) { _Pragma("unroll") for (int r = 0; r < 16; ++r) { P[r] = ex2(P[r] - mref); s += P[r]; } } else { _Pragma("unroll") for (int r = 0; r < 16; ++r) P[r] = 0.f; } } while (0)
    CMP_EXP(a0, live0); CMP_EXP(a1, live1); CMP_EXP(b0, live2); CMP_EXP(b1, live3);
#undef CMP_EXP
    s = xsum(s);
    const float inv = (s > 0.f) ? 1.0f / s : 0.f;
#pragma unroll
    for (int r = 0; r < 16; ++r) { a0[r] *= inv; a1[r] *= inv; b0[r] *= inv; b1[r] *= inv; }
    { LAS3 float* iq = impq + (rh * 64 + tokl) * 33; LAS3 float* il = impl + (rh * 64 + tokl) * 33;
#pragma unroll
      for (int q4 = 0; q4 < 4; ++q4) {
        const int gi = 2 * q4 + hi;
        iq[gi] = (a0[4 * q4] + a0[4 * q4 + 1]) + (a0[4 * q4 + 2] + a0[4 * q4 + 3]);           il[gi] = a0[4 * q4 + 3];
        iq[8 + gi] = (a1[4 * q4] + a1[4 * q4 + 1]) + (a1[4 * q4 + 2] + a1[4 * q4 + 3]);       il[8 + gi] = a1[4 * q4 + 3];
        iq[16 + gi] = (b0[4 * q4] + b0[4 * q4 + 1]) + (b0[4 * q4 + 2] + b0[4 * q4 + 3]);      il[16 + gi] = b0[4 * q4 + 3];
        iq[24 + gi] = (b1[4 * q4] + b1[4 * q4 + 1]) + (b1[4 * q4 + 2] + b1[4 * q4 + 3]);      il[24 + gi] = b1[4 * q4 + 3];
      } }
    o[0] = f32x16{}; o[1] = f32x16{};
#pragma unroll
    for (int i = 0; i < 8; ++i) { pw[i] = cvtpk(a0[2 * i], a0[2 * i + 1]); pw[8 + i] = cvtpk(a1[2 * i], a1[2 * i + 1]); }
    pv(o, vp0, pw);
    if (live2) {
#pragma unroll
      for (int i = 0; i < 8; ++i) { pw[i] = cvtpk(b0[2 * i], b0[2 * i + 1]); pw[8 + i] = cvtpk(b1[2 * i], b1[2 * i + 1]); }
      pv(o, vp0 + SLOT, pw); }
    if (hi == 0) wsf[r32] = gate[0];
#pragma unroll
    for (int r = 0; r < 16; ++r) { const float f = wsf[crow(r, hi)]; o[0][r] *= f; o[1][r] *= f; }
  }
  __syncthreads();
  const KVSrc ssrc{proj + (size_t)b * SEQ * PROJ_LD + PC_KV + 2 * 128 + g * 64, proj + (size_t)b * SEQ * PROJ_LD + PC_KV + 3 * 128 + g * 64, PROJ_LD, PROJ_LD};
  kv_issue(ssrc, 0, rk, rv, tid);
  {
    const int stok = tid >> 3, sub = tid & 7;
#pragma unroll
    for (int k = 0; k < 4; ++k) {
      const int n = sub * 4 + k;
      float imp = 0.f;
#pragma unroll
      for (int hh = 0; hh < 4; ++hh) imp += impq[(hh * 64 + stok) * 33 + n] + ((n > 0) ? impl[(hh * 64 + stok) * 33 + n - 1] : 0.f);
      sc[stok * 33 + n] = (n > c) ? -1.0f : ((n == 0 || n == c || n == c - 1) ? 1e4f : imp);
    }
    if (tid < 64) selm[tid] = 0u;
    __syncthreads();
    float srow[32];
#pragma unroll
    for (int mm = 0; mm < 32; ++mm) srow[mm] = sc[stok * 33 + mm];
    unsigned bits = 0u;
#pragma unroll
    for (int k = 0; k < 4; ++k) {
      const int n = sub * 4 + k; const float sv = sc[stok * 33 + n]; int rank = 0;
#pragma unroll
      for (int mm = 0; mm < 32; ++mm) rank += (srow[mm] > sv || (srow[mm] == sv && mm < n)) ? 1 : 0;
      if (rank < 16) bits |= 1u << n;
    }
    if (bits) atomicOr((unsigned*)(selm + stok), bits);
    __syncthreads();
  }
  const unsigned mysel = selm[tokl];
  fin_set(finl, o, lane);
#pragma unroll 1
  for (int br = 0; br < 2; ++br) {
    const KVSrc src = (br == 0) ? ssrc : KVSrc{proj + (size_t)b * SEQ * PROJ_LD + PC_KV + 4 * 128 + g * 64, proj + (size_t)b * SEQ * PROJ_LD + PC_KV + 5 * 128 + g * 64, PROJ_LD, PROJ_LD};
    const int n0 = (br == 0) ? 0 : ((c > 8) ? c - 8 : 0);
    if (br == 1) { __syncthreads(); kv_issue(src, n0 * 64, rk, rv, tid); }
    kv_commit(lds, rk, rv, tid);
    float m = -1e30f, l = 0.f;
    o[0] = f32x16{}; o[1] = f32x16{};
    int cur = 0;
#pragma unroll 1
    for (int n = n0; n <= c; ++n) {
      __syncthreads();
      if (n < c) kv_issue(src, (n + 1) * 64, rk, rv, tid);
      const bool mine = (br == 1) || ((mysel >> n) & 1u);
      if (__any(mine)) {
        f32x16 p0, p1;
        if (n + 2 >= c) {
          const LAS3 float* bp = tb + (t - 64 * n) - 4 * hi - 63;
          f32x16 c0, c1;
#pragma unroll
          for (int r = 0; r < 16; ++r) { c0[r] = bp[63 - ((r & 3) + 8 * (r >> 2))]; c1[r] = bp[31 - ((r & 3) + 8 * (r >> 2))]; }
          qkt_init<4>(p0, p1, kb0 + cur * SLOT, qr, c0, c1);
        } else if (br == 1 && n + 8 == c) {
          const LAS3 float* bp = stp + (607 - (t - 64 * n)) + 4 * hi;
          f32x16 c0, c1;
#pragma unroll
          for (int r = 0; r < 16; ++r) { c0[r] = bp[(r & 3) + 8 * (r >> 2)]; c1[r] = bp[32 + (r & 3) + 8 * (r >> 2)]; }
          qkt_init<4>(p0, p1, kb0 + cur * SLOT, qr, c0, c1);
        } else qkt<4>(p0, p1, kb0 + cur * SLOT, qr);
        bf16x8 vf[8]; pv_load(vf, vp0 + cur * SLOT);
        __builtin_amdgcn_sched_barrier(0);
        softmax_step(p0, p1, m, l, o, wsf, r32, hi, pw, mine);
        pv_mma(o, vf, pw);
      }
      if (n < c) kv_commit(lds + (cur ^ 1) * SLOT, rk, rv, tid);
      cur ^= 1;
    }
    l = xsum(l);
    const float gi = gate[1 + br] / fmaxf(l, 1e-30f);
    if (hi == 0) wsf[r32] = gi;
    fin_add(finl, o, wsf, lane, hi);
  }
  fin_store(finl, onsa, (size_t)b * SEQ + 64 * c + 32 * (w & 1), 1024, head * 64, lane);
}

__device__ __forceinline__ void mla_unit(int b, int h, int qb, const bf16_t* __restrict__ mq, const bf16_t* __restrict__ mkv, const bf16_t* __restrict__ kr, bf16_t* __restrict__ omla, lptr lds) {
  int tid = threadIdx.x; asm volatile("" : "+v"(tid));
  const int lane = tid & 63, r32 = lane & 31, hi = lane >> 5;
  const int w = __builtin_amdgcn_readfirstlane(tid >> 6);
  const int q0 = 256 * qb, qw = q0 + 32 * w, qpos = qw + r32;
  const size_t tokq = (size_t)b * SEQ + qpos;
  LAS3 float* wsf = (LAS3 float*)(lds + L_WSF) + w * 64;
  const lcptr kb0 = (lcptr)lds + KOFF + hi * 1024 + r32 * 16;
  const lcptr vp0 = (lcptr)lds + VOFF + ((lane >> 4) & 1) * 32 + (lane & 3) * 8 + (4 * hi + ((lane & 15) >> 2)) * 64;
  const LAS3 float* stp = (const LAS3 float*)(lds + L_ST);
  bf16x8 qr[6];
#pragma unroll
  for (int d0 = 0; d0 < 6; ++d0) qr[d0] = *(const bf16x8*)(mq + tokq * 768 + h * 96 + d0 * 16 + hi * 8);
  const KVSrc src{mkv + (size_t)b * SEQ * 1024 + h * 128, mkv + (size_t)b * SEQ * 1024 + h * 128 + 64, 1024, 1024};
  const bf16_t* krb = kr + (size_t)b * SEQ * 32;
  const int NTL = 4 * (qb + 1);
  u32x4 rk, rv, rr = {0u, 0u, 0u, 0u};
  f32x16 o[2]; o[0] = f32x16{}; o[1] = f32x16{};
  unsigned pw[16];
  float m = -1e30f, l = 0.f;
  __syncthreads();
  kv_issue(src, 0, rk, rv, tid);
  if (tid < 256) rr = *(const u32x4*)(krb + (size_t)(tid & 63) * 32 + (tid >> 6) * 8);
  kv_commit(lds, rk, rv, tid);
  if (tid < 256) *(LAS3 u32x4*)(lds + KOFF + (8 + (tid >> 6)) * 1024 + (tid & 63) * 16) = rr;
  int cur = 0;
#pragma unroll 1
  for (int tl = 0; tl < NTL; ++tl) {
    __syncthreads();
    if (tl + 1 < NTL) { kv_issue(src, (tl + 1) * 64, rk, rv, tid); if (tid < 256) rr = *(const u32x4*)(krb + (size_t)((tl + 1) * 64 + (tid & 63)) * 32 + (tid >> 6) * 8); }
    if (64 * tl <= qw + 31) {
      f32x16 p0, p1;
      if (64 * tl + 63 > qw) {
        const LAS3 float* bp = stp + 96 + (qpos - 64 * tl) - 4 * hi - 63;
        f32x16 c0, c1;
#pragma unroll
        for (int r = 0; r < 16; ++r) { c0[r] = bp[63 - ((r & 3) + 8 * (r >> 2))]; c1[r] = bp[31 - ((r & 3) + 8 * (r >> 2))]; }
        qkt_init<6>(p0, p1, kb0 + cur * SLOT, qr, c0, c1);
      } else qkt<6>(p0, p1, kb0 + cur * SLOT, qr);
      bf16x8 vf[8]; pv_load(vf, vp0 + cur * SLOT);
      __builtin_amdgcn_sched_barrier(0);
      softmax_step(p0, p1, m, l, o, wsf, r32, hi, pw);
      pv_mma(o, vf, pw);
    }
    if (tl + 1 < NTL) { kv_commit(lds + (cur ^ 1) * SLOT, rk, rv, tid); if (tid < 256) *(LAS3 u32x4*)(lds + (cur ^ 1) * SLOT + KOFF + (8 + (tid >> 6)) * 1024 + (tid & 63) * 16) = rr; }
    cur ^= 1;
  }
  l = xsum(l);
  if (hi == 0) wsf[r32] = 1.0f / fmaxf(l, 1e-30f);
#pragma unroll
  for (int r = 0; r < 16; ++r) { const float f = wsf[crow(r, hi)]; o[0][r] *= f; o[1][r] *= f; }
  LAS3 float* finl = (LAS3 float*)(lds + L_FIN) + w * 2048;
  fin_set(finl, o, lane);
  fin_store(finl, omla, (size_t)b * SEQ + qw, 1024, 512 + h * 64, lane);
}

__device__ __forceinline__ void attn_phase(const bf16_t* proj, const bf16_t* kc, const bf16_t* vc, const float* t5, bf16_t* onsa,
                                           const bf16_t* mq, const bf16_t* mkv, const bf16_t* kr, bf16_t* omla, lptr lds) {
  const int tid = threadIdx.x;
  { LAS3 float* tb = (LAS3 float*)(lds + L_TB);
    for (int i = tid; i < 8 * 320; i += NTHR) { const int hd = i / 320, d = i % 320 - 64; tb[i] = (d < 0) ? NEG_INF : ((d < 113) ? (t5[(int)T5B[d] * 8 + hd] - t5[31 * 8 + hd]) * LOG2E : 0.f); }
    LAS3 float* st = (LAS3 float*)(lds + L_ST);
    for (int i = tid; i < 192; i += NTHR) st[i] = (i < 96) ? NEG_INF : 0.f; }
  const int G = gridDim.x, bx = blockIdx.x;
  for (int v = (G % 8 == 0) ? (bx % 8) * (G / 8) + bx / 8 : bx; v < 256; v += G) {
    const int bg = v >> 4, p = v & 15, bh = v >> 2, j = v & 3;
#pragma unroll 1
    for (int u = 0; u < 2; ++u) nsa_unit(bg >> 1, bg & 1, u ? p : 31 - p, proj, kc, vc, onsa, lds);
#pragma unroll 1
    for (int u = 0; u < 2; ++u) mla_unit(bh >> 3, bh & 7, u ? j : 7 - j, mq, mkv, kr, omla, lds);
  }
}
#undef LAS3
}


namespace peer {
using bf16x8 = __attribute__((ext_vector_type(8))) short;
using f32x16 = __attribute__((ext_vector_type(16))) float;
typedef unsigned u32x4 __attribute__((ext_vector_type(4)));
typedef float f32x4_t __attribute__((ext_vector_type(4)));
typedef __bf16 bf16x2_t __attribute__((ext_vector_type(2)));
typedef float f32x2_t __attribute__((ext_vector_type(2)));
#define LAS3 __attribute__((address_space(3)))
__device__ __forceinline__ int crow(int r, int hi) { return (r & 3) + 8 * (r >> 2) + 4 * hi; }
__device__ __forceinline__ unsigned enc(float f) { const unsigned u = __float_as_uint(f); return u ^ ((unsigned)((int)u >> 31) | 0x80000000u); }
__device__ __forceinline__ float dec(unsigned k) { return __uint_as_float(k ^ (~(unsigned)((int)k >> 31) | 0x80000000u)); }
__device__ __forceinline__ unsigned umax(unsigned a, unsigned b) { return a > b ? a : b; }
__device__ __forceinline__ unsigned umin(unsigned a, unsigned b) { return a < b ? a : b; }
__device__ __forceinline__ unsigned cvtpk(float lo, float hi) { f32x2_t v = {lo, hi}; bf16x2_t b = __builtin_convertvector(v, bf16x2_t); return __builtin_bit_cast(unsigned, b); }
template <int B, int N> __device__ __forceinline__ void sort16(unsigned (&k)[N]) {
#pragma unroll
  for (int size = 2; size <= 16; size <<= 1)
#pragma unroll
    for (int stride = size >> 1; stride > 0; stride >>= 1)
#pragma unroll
      for (int i = 0; i < 16; ++i) { const int l = i ^ stride;
        if (l > i) { const bool desc = ((i & size) == 0); const unsigned a = k[B + i], b = k[B + l]; const unsigned mx = umax(a, b), mn = umin(a, b); k[B + i] = desc ? mx : mn; k[B + l] = desc ? mn : mx; } }
}
template <int A, int Bo, int N> __device__ __forceinline__ void merge16(unsigned (&k)[N]) {
#pragma unroll
  for (int i = 0; i < 16; ++i) k[A + i] = umax(k[A + i], k[Bo + 15 - i]);
#pragma unroll
  for (int stride = 8; stride > 0; stride >>= 1)
#pragma unroll
    for (int i = 0; i < 16; ++i) { const int l = i ^ stride; if (l > i) { const unsigned a = k[A + i], b = k[A + l]; k[A + i] = umax(a, b); k[A + l] = umin(a, b); } }
}
template <int N> __device__ __forceinline__ void top16_of_64(unsigned (&k)[N]) {
  sort16<0>(k); sort16<16>(k); sort16<32>(k); sort16<48>(k);
  merge16<0, 16>(k); merge16<32, 48>(k); merge16<0, 32>(k);
}

__device__ __forceinline__ void route_phase(const bf16_t* __restrict__ pq, const bf16_t* __restrict__ subk, unsigned* __restrict__ pack, LAS3 char* lds, int pm, int pn) {
  int tid = threadIdx.x; asm volatile("" : "+v"(tid));
  const int lane = tid & 63, r32 = lane & 31, hi = lane >> 5, wv = tid >> 6;
  LAS3 unsigned char* myb = (LAS3 unsigned char*)lds + wv * 2560 + lane * 40;
#pragma unroll 1
  for (int item = wv; item < 16; item += NWV) {
    const int h = pn * 2 + (item >> 3), t0 = pm * 256 + (item & 7) * 32;
    unsigned la[16], lb[16];
#pragma unroll
    for (int i = 0; i < 16; ++i) { la[i] = 0u; lb[i] = 0u; }
#pragma unroll 1
    for (int p = 0; p < 2; ++p) {
      f32x16 acc[4];
#pragma unroll
      for (int kt = 0; kt < 4; ++kt) acc[kt] = f32x16{};
#pragma unroll
      for (int kd = 0; kd < 4; ++kd) {
        const bf16x8 bq = *(const bf16x8*)(pq + (size_t)(t0 + r32) * 1024 + h * 128 + p * 64 + kd * 16 + hi * 8);
#pragma unroll
        for (int kt = 0; kt < 4; ++kt) {
          const bf16x8 ak = *(const bf16x8*)(subk + (size_t)((h * 2 + p) * 128 + kt * 32 + r32) * 64 + kd * 16 + hi * 8);
          acc[kt] = __builtin_amdgcn_mfma_f32_32x32x16_bf16(ak, bq, acc[kt], 0, 0, 0);
        }
      }
      unsigned k[64];
#pragma unroll
      for (int kt = 0; kt < 4; ++kt)
#pragma unroll
        for (int r = 0; r < 16; ++r) k[kt * 16 + r] = (enc(acc[kt][r]) & 0xFFFFFF80u) | (unsigned)(127 - (32 * kt + crow(r, hi)));
      top16_of_64(k);
#pragma unroll
      for (int i = 0; i < 16; ++i) { auto rr = __builtin_amdgcn_permlane32_swap(k[i], k[i], false, false); unsigned r0 = rr[0], r1 = rr[1]; asm volatile("" : "+v"(r0), "+v"(r1)); k[16 + i] = hi ? r0 : r1; }
      merge16<0, 16>(k);
#pragma unroll
      for (int i = 0; i < 16; ++i) { la[i] = (p == 0) ? k[i] : la[i]; lb[i] = (p == 0) ? lb[i] : k[i]; }
      __builtin_amdgcn_sched_barrier(0);
    }
#pragma unroll
    for (int i = 0; i < 4; ++i) {
      const unsigned wa = (127u - (la[4 * i] & 127u)) | ((127u - (la[4 * i + 1] & 127u)) << 8) | ((127u - (la[4 * i + 2] & 127u)) << 16) | ((127u - (la[4 * i + 3] & 127u)) << 24);
      const unsigned wb = (127u - (lb[4 * i] & 127u)) | ((127u - (lb[4 * i + 1] & 127u)) << 8) | ((127u - (lb[4 * i + 2] & 127u)) << 16) | ((127u - (lb[4 * i + 3] & 127u)) << 24);
      *(LAS3 unsigned*)(myb + 4 * i) = wa; *(LAS3 unsigned*)(myb + 16 + 4 * i) = wb;
    }
    float va[16], vb[16];
#pragma unroll
    for (int i = 0; i < 16; ++i) { va[i] = dec(la[i] & 0xFFFFFF80u); vb[i] = dec(lb[i] & 0xFFFFFF80u); }
    unsigned k[64];
#define PEER_CAND(n, i, j) k[n] = (enc(va[i] + vb[j]) & 0xFFFFFF00u) | (unsigned)(255 - ((i) * 16 + (j)))
    PEER_CAND(0, 0, 0); PEER_CAND(1, 0, 1); PEER_CAND(2, 0, 2); PEER_CAND(3, 0, 3); PEER_CAND(4, 0, 4); PEER_CAND(5, 0, 5);
    PEER_CAND(6, 0, 6); PEER_CAND(7, 0, 7); PEER_CAND(8, 0, 8); PEER_CAND(9, 0, 9); PEER_CAND(10, 0, 10); PEER_CAND(11, 0, 11);
    PEER_CAND(12, 0, 12); PEER_CAND(13, 0, 13); PEER_CAND(14, 0, 14); PEER_CAND(15, 0, 15); PEER_CAND(16, 1, 0); PEER_CAND(17, 1, 1);
    PEER_CAND(18, 1, 2); PEER_CAND(19, 1, 3); PEER_CAND(20, 1, 4); PEER_CAND(21, 1, 5); PEER_CAND(22, 1, 6); PEER_CAND(23, 1, 7);
    PEER_CAND(24, 2, 0); PEER_CAND(25, 2, 1); PEER_CAND(26, 2, 2); PEER_CAND(27, 2, 3); PEER_CAND(28, 2, 4); PEER_CAND(29, 3, 0);
    PEER_CAND(30, 3, 1); PEER_CAND(31, 3, 2); PEER_CAND(32, 3, 3); PEER_CAND(33, 4, 0); PEER_CAND(34, 4, 1); PEER_CAND(35, 4, 2);
    PEER_CAND(36, 5, 0); PEER_CAND(37, 5, 1); PEER_CAND(38, 6, 0); PEER_CAND(39, 6, 1); PEER_CAND(40, 7, 0); PEER_CAND(41, 7, 1);
    PEER_CAND(42, 8, 0); PEER_CAND(43, 9, 0); PEER_CAND(44, 10, 0); PEER_CAND(45, 11, 0); PEER_CAND(46, 12, 0); PEER_CAND(47, 13, 0);
    PEER_CAND(48, 14, 0); PEER_CAND(49, 15, 0);
#undef PEER_CAND
#pragma unroll
    for (int z = 50; z < 64; ++z) k[z] = 0u;
    top16_of_64(k);
    const float best0 = dec(k[0] & 0xFFFFFF00u);
    float ev[16]; float den = 0.f;
#pragma unroll
    for (int i = 0; i < 16; ++i) { ev[i] = __expf(dec(k[i] & 0xFFFFFF00u) - best0); den += ev[i]; }
    const float inv = 1.0f / den;
    unsigned outw[8];
#pragma unroll
    for (int i = 0; i < 8; ++i) {
      unsigned k_lo = k[i], k_hi = k[8 + i]; float e_lo = ev[i], e_hi = ev[8 + i];
      asm volatile("" : "+v"(k_lo), "+v"(k_hi), "+v"(e_lo), "+v"(e_hi));
      const unsigned kk = hi ? k_hi : k_lo; const float e = hi ? e_hi : e_lo;
      const unsigned f = 255u - (kk & 255u);
      const unsigned ia = myb[f >> 4], ib = myb[16 + (f & 15u)];
      outw[i] = (ia * 128u + ib) | (cvtpk(0.f, e * inv) & 0xFFFF0000u);
    }
    unsigned* dst = pack + (size_t)(t0 + r32) * 128 + h * 16 + hi * 8;
    *(u32x4*)dst = (u32x4){outw[0], outw[1], outw[2], outw[3]};
    *(u32x4*)(dst + 4) = (u32x4){outw[4], outw[5], outw[6], outw[7]};
  }
}

__device__ __forceinline__ void conv_tables(const float* __restrict__ u, const float* __restrict__ v, unsigned* __restrict__ u8, float* __restrict__ su, unsigned* __restrict__ v8) {
  const int tid = threadIdx.x, lane = tid & 63, wv = tid >> 6;
  const int gw = blockIdx.x * NWV + wv, nw = gridDim.x * NWV;
  for (int e = gw; e < 16384; e += nw) {
    const f32x4_t* ur = (const f32x4_t*)(u + (size_t)e * 1024) + lane * 4;
    f32x4_t a[4]; float mx = 0.f;
#pragma unroll
    for (int i = 0; i < 4; ++i) { a[i] = ur[i]; mx = fmaxf(mx, fmaxf(fmaxf(fabsf(a[i][0]), fabsf(a[i][1])), fmaxf(fabsf(a[i][2]), fabsf(a[i][3])))); }
    mx = wmaxf(mx);
    const float sc = fmaxf(mx, 1e-30f) * (1.0f / 127.0f), isc = 1.0f / sc;
    u32x4 o;
#pragma unroll
    for (int i = 0; i < 4; ++i) {
      const int q0 = (int)rintf(a[i][0] * isc), q1 = (int)rintf(a[i][1] * isc), q2 = (int)rintf(a[i][2] * isc), q3 = (int)rintf(a[i][3] * isc);
      o[i] = (unsigned)(q0 & 255) | ((unsigned)(q1 & 255) << 8) | ((unsigned)(q2 & 255) << 16) | ((unsigned)(q3 & 255) << 24);
    }
    *(u32x4*)(u8 + (size_t)e * 256 + lane * 4) = o;
    if (lane == 0) su[e] = sc;
    const f32x4_t* vr = (const f32x4_t*)(v + (size_t)e * 1024) + lane * 4;
    u32x4 ov;
#pragma unroll
    for (int i = 0; i < 4; ++i) { const f32x4_t b = vr[i]; unsigned w = 0u; w = __builtin_amdgcn_cvt_pk_fp8_f32(2.0f * b[0], 2.0f * b[1], w, false); w = __builtin_amdgcn_cvt_pk_fp8_f32(2.0f * b[2], 2.0f * b[3], w, true); ov[i] = w; }
    *(u32x4*)(v8 + ((size_t)(lane >> 3) * 16384 + e) * 32 + (lane & 7) * 4) = ov;
  }
}
__device__ __forceinline__ float gelu_fast(float v) {
  const float av = __builtin_fabsf(v), t = __builtin_amdgcn_rcpf(av * 0.2316418882f + 1.0f);
  float q = t * 0.5307027145f + (-0.7265760135f); q = q * t + 0.7107068705f; q = q * t + (-0.142248368f); q = q * t + 0.127414796f; q = q * t;
  const float e = __builtin_amdgcn_exp2f((v * v) * (-0.72134752044f));
  const float m = v * (q * e);
  return v < 0.f ? m : v - m;
}
__device__ __forceinline__ unsigned xcc_id() { return (unsigned)__builtin_amdgcn_s_getreg((3 << 11) | 20) & 7u; }
struct ABuf { unsigned w, meta; u32x4 ub[8]; float sue; };
__device__ __forceinline__ void expA_issue(ABuf& B, int k0, int n, const LAS3 unsigned* list, const unsigned* __restrict__ u8, const float* __restrict__ su, int j8) {
  const int k = (k0 < n) ? k0 : 0;
  B.w = list[2 * k]; B.meta = list[2 * k + 1];
  const unsigned e = B.w & 0xFFFFu;
  const unsigned* urow = u8 + (size_t)e * 256 + j8 * 4;
#pragma unroll
  for (int seg = 0; seg < 8; ++seg) B.ub[seg] = *(const u32x4*)(urow + seg * 32);
  B.sue = su[e];
}
__device__ __forceinline__ void expA_consume(const ABuf& B, int k0, int n, const LAS3 char* hl, const LAS3 float* shl, float* __restrict__ co, int t0, int j8) {
  const int tokl = (int)(B.meta >> 8), slot = (int)(B.meta & 255u);
  const LAS3 char* hrow = hl + tokl * 1024 + j8 * 16;
  int a0 = 0, a1 = 0, a2 = 0, a3 = 0;
#pragma unroll
  for (int seg = 0; seg < 8; ++seg) { const u32x4 hq = *(const LAS3 u32x4*)(hrow + seg * 128);
    a0 = __builtin_amdgcn_sdot4((int)B.ub[seg].x, (int)hq.x, a0, false); a1 = __builtin_amdgcn_sdot4((int)B.ub[seg].y, (int)hq.y, a1, false);
    a2 = __builtin_amdgcn_sdot4((int)B.ub[seg].z, (int)hq.z, a2, false); a3 = __builtin_amdgcn_sdot4((int)B.ub[seg].w, (int)hq.w, a3, false); }
  int acc = (a0 + a1) + (a2 + a3);
  acc += dpp_i<0xB1>(acc); acc += dpp_i<0x4E>(acc); acc += dpp_i<0x141>(acc);
  const float d = (float)acc * (B.sue * shl[tokl]);
  const float c = 0.5f * __uint_as_float(B.w & 0xFFFF0000u) * gelu_fast(d);
  if (j8 == 0 && k0 < n) co[(size_t)(t0 + tokl) * 128 + slot] = c;
}
struct AStage { u32x4 pw[4], hst[8]; float shv; };
__device__ __forceinline__ void expA_stage(AStage& S, int item, const unsigned* __restrict__ pack, const unsigned* __restrict__ hn8, const float* __restrict__ shp, int tid) {
  const int t0 = item * 64, tokl = tid >> 3, sb = (tid & 7) * 16;
#pragma unroll
  for (int i = 0; i < 4; ++i) S.pw[i] = *(const u32x4*)(pack + (size_t)(t0 + tokl) * 128 + sb + 4 * i);
#pragma unroll
  for (int i = 0; i < 8; ++i) S.hst[i] = *(const u32x4*)(hn8 + (size_t)t0 * 256 + (tid + 512 * i) * 4);
  S.shv = (tid < 64) ? shp[t0 + tid] : 0.f;
}
__device__ __forceinline__ void expA_item(AStage& S, int item, int nitem, int xs, const unsigned* __restrict__ pack, const unsigned* __restrict__ hn8, const float* __restrict__ shp, const unsigned* __restrict__ u8, const float* __restrict__ su,
                                          float* __restrict__ co, LAS3 char* lds, int tid) {
  const int lane = tid & 63, wv = tid >> 6;
  LAS3 char* hl = lds + 1024;
  LAS3 float* shl = (LAS3 float*)(lds + 1024 + 65536);
  LAS3 unsigned* cnt = (LAS3 unsigned*)(lds + 16);
  LAS3 unsigned* list = (LAS3 unsigned*)(lds + 1024 + 65536 + 256);
  const int t0 = item * 64;
  const int tokl = tid >> 3, sb = (tid & 7) * 16;
#pragma unroll
  for (int i = 0; i < 8; ++i) *(LAS3 u32x4*)(hl + (tid + 512 * i) * 16) = S.hst[i];
  if (tid < 64) shl[tid] = S.shv;
  {
    unsigned long long mk[16]; int tot = 0; int off[16];
#pragma unroll
    for (int j = 0; j < 16; ++j) { const unsigned w = S.pw[j >> 2][j & 3]; mk[j] = __ballot(((w & 0xFFFFu) >> 11) == (unsigned)xs); off[j] = tot; tot += __builtin_popcountll(mk[j]); }
    int base = 0;
    if (lane == 0) base = (int)__hip_atomic_fetch_add(cnt, (unsigned)tot, __ATOMIC_RELAXED, __HIP_MEMORY_SCOPE_WORKGROUP);
    base = __builtin_amdgcn_readfirstlane(base);
#pragma unroll
    for (int j = 0; j < 16; ++j) { const unsigned w = S.pw[j >> 2][j & 3];
      if (((w & 0xFFFFu) >> 11) == (unsigned)xs) { const int pos = base + off[j] + (int)__builtin_amdgcn_mbcnt_hi((unsigned)(mk[j] >> 32), __builtin_amdgcn_mbcnt_lo((unsigned)mk[j], 0u));
        list[2 * pos] = w; list[2 * pos + 1] = (unsigned)((tokl << 8) | (sb + j)); } }
  }
  if (nitem < T / 64) expA_stage(S, nitem, pack, hn8, shp, tid);
  __syncthreads();
  const int n = (int)cnt[0];
  const int j8 = lane & 7, gidx = wv * 8 + (lane >> 3);
  ABuf A, Bb;
  expA_issue(A, gidx, n, list, u8, su, j8);
#pragma unroll 1
  for (int k0 = gidx; k0 < n; k0 += 128) {
    expA_issue(Bb, k0 + 64, n, list, u8, su, j8);
    expA_consume(A, k0, n, hl, shl, co, t0, j8);
    expA_issue(A, k0 + 128, n, list, u8, su, j8);
    expA_consume(Bb, k0 + 64, n, hl, shl, co, t0, j8);
  }
}
struct BBuf { u32x4 vv[8]; f32x4_t c[2]; };
__device__ __forceinline__ void expB_issue(BBuf& B, const LAS3 unsigned* pkl, const LAS3 float* col, int sg8, const unsigned* __restrict__ vbase) {
  const u32x4 p0 = *(const LAS3 u32x4*)(pkl + sg8 * 8), p1 = *(const LAS3 u32x4*)(pkl + sg8 * 8 + 4);
  B.c[0] = *(const LAS3 f32x4_t*)(col + sg8 * 8); B.c[1] = *(const LAS3 f32x4_t*)(col + sg8 * 8 + 4);
#pragma unroll
  for (int j = 0; j < 4; ++j) { B.vv[j] = *(const u32x4*)(vbase + (size_t)(p0[j] & 0xFFFFu) * 32); B.vv[4 + j] = *(const u32x4*)(vbase + (size_t)(p1[j] & 0xFFFFu) * 32); }
}
__device__ __forceinline__ void expB_consume(const BBuf& B, f32x2_t (&y)[8]) {
#pragma unroll
  for (int j = 0; j < 8; ++j) {
    const float cv = B.c[j >> 2][j & 3];
    const f32x2_t c2 = {cv, cv};
#pragma unroll
    for (int w = 0; w < 4; ++w) {
      y[2 * w] = __builtin_elementwise_fma(__builtin_amdgcn_cvt_pk_f32_fp8(B.vv[j][w], false), c2, y[2 * w]);
      y[2 * w + 1] = __builtin_elementwise_fma(__builtin_amdgcn_cvt_pk_f32_fp8(B.vv[j][w], true), c2, y[2 * w + 1]);
    }
  }
}
__device__ __forceinline__ void expB_item(int item, int xs, const unsigned* __restrict__ pack, const float* __restrict__ co, const unsigned* __restrict__ v8, bf16_t* __restrict__ zb, float* __restrict__ ssq, LAS3 char* lds, int tid,
                                          const float* __restrict__ xin, const bf16_t* __restrict__ ob) {
  const int lane = tid & 63, wv = tid >> 6, r8 = lane >> 3, c8 = lane & 7;
  const int t0 = item * 64 + wv * 8;
  LAS3 unsigned* pkw = (LAS3 unsigned*)(lds + 1024 + wv * 8192);
  LAS3 float* cow = (LAS3 float*)(lds + 1024 + wv * 8192 + 4096);
  {
    u32x4 a[4]; f32x4_t b[4];
#pragma unroll
    for (int i = 0; i < 4; ++i) { a[i] = *(const u32x4*)(pack + (size_t)t0 * 128 + (lane + 64 * i) * 4); b[i] = *(const f32x4_t*)(co + (size_t)t0 * 128 + (lane + 64 * i) * 4); }
#pragma unroll
    for (int i = 0; i < 4; ++i) { *(LAS3 u32x4*)(pkw + (lane + 64 * i) * 4) = a[i]; *(LAS3 f32x4_t*)(cow + (lane + 64 * i) * 4) = b[i]; }
  }
  const size_t hoff = (size_t)(t0 + r8) * 1024 + xs * 128 + c8 * 16;
  f32x4_t h[4];
  { const u32x4 o0 = *(const u32x4*)(ob + hoff), o1 = *(const u32x4*)(ob + hoff + 8);
#pragma unroll
    for (int w = 0; w < 4; ++w) h[w] = *(const f32x4_t*)(xin + hoff + 4 * w);
    h[0] += (f32x4_t){__uint_as_float(o0.x << 16), __uint_as_float(o0.x & 0xffff0000u), __uint_as_float(o0.y << 16), __uint_as_float(o0.y & 0xffff0000u)};
    h[1] += (f32x4_t){__uint_as_float(o0.z << 16), __uint_as_float(o0.z & 0xffff0000u), __uint_as_float(o0.w << 16), __uint_as_float(o0.w & 0xffff0000u)};
    h[2] += (f32x4_t){__uint_as_float(o1.x << 16), __uint_as_float(o1.x & 0xffff0000u), __uint_as_float(o1.y << 16), __uint_as_float(o1.y & 0xffff0000u)};
    h[3] += (f32x4_t){__uint_as_float(o1.z << 16), __uint_as_float(o1.z & 0xffff0000u), __uint_as_float(o1.w << 16), __uint_as_float(o1.w & 0xffff0000u)}; }
  wave_lds_sync();
  const LAS3 unsigned* pkl = pkw + r8 * 128; const LAS3 float* col = cow + r8 * 128;
  const unsigned* vbase = v8 + (size_t)xs * 16384 * 32 + c8 * 4;
  f32x2_t y[8];
#pragma unroll
  for (int i = 0; i < 8; ++i) y[i] = (f32x2_t){0.f, 0.f};
  BBuf A, Bb;
  expB_issue(A, pkl, col, 0, vbase);
#pragma unroll 1
  for (int sg = 0; sg < 16; sg += 2) {
    expB_issue(Bb, pkl, col, sg + 1, vbase);
    expB_consume(A, y);
    if (sg + 2 < 16) expB_issue(A, pkl, col, sg + 2, vbase);
    expB_consume(Bb, y);
  }
  float ss = 0.f; unsigned zw[8];
#pragma unroll
  for (int w = 0; w < 4; ++w) {
    const f32x4_t z = {h[w][0] + y[2 * w][0], h[w][1] + y[2 * w][1], h[w][2] + y[2 * w + 1][0], h[w][3] + y[2 * w + 1][1]};
    zw[2 * w] = cvtpk(z[0], z[1]); zw[2 * w + 1] = cvtpk(z[2], z[3]);
    ss += (z[0] * z[0] + z[1] * z[1]) + (z[2] * z[2] + z[3] * z[3]);
  }
  *(u32x4*)(zb + hoff) = (u32x4){zw[0], zw[1], zw[2], zw[3]}; *(u32x4*)(zb + hoff + 8) = (u32x4){zw[4], zw[5], zw[6], zw[7]};
  ss += dpp_f<0xB1>(ss); ss += dpp_f<0x4E>(ss); ss += dpp_f<0x141>(ss);
  if (c8 == 0) ssq[(size_t)xs * T + t0 + r8] = ss;
  wave_lds_sync();
}
template <int PASS> __device__ __forceinline__ void experts_sliced(const unsigned* __restrict__ pack, const unsigned* __restrict__ hn8, const float* __restrict__ shp, const unsigned* __restrict__ u8, const float* __restrict__ su,
                                                                    float* __restrict__ co, const unsigned* __restrict__ v8, float* __restrict__ out, float* __restrict__ ssq, unsigned* __restrict__ ctr, LAS3 char* lds,
                                                                    const float* __restrict__ xin = nullptr, const bf16_t* __restrict__ ob = nullptr) {
  int tid = threadIdx.x; asm volatile("" : "+v"(tid));
  LAS3 volatile int* lw = (LAS3 volatile int*)lds;
  const int xme = (int)xcc_id();
#pragma unroll 1
  for (int s8 = 0; s8 < 8; ++s8) {
    const int xs = (xme + s8) & 7;
    if (PASS == 0) {
      int nxt = 0;
      if (tid == 0) nxt = (int)atomicAdd(ctr + 64 * xs, 1u);
      __syncthreads();
      if (tid == 0) lw[0] = nxt;
      __syncthreads();
      int item = lw[0];
      if (item >= T / 64) continue;
      if (tid == 0) nxt = (int)atomicAdd(ctr + 64 * xs, 1u);
      AStage SA;
      expA_stage(SA, item, pack, hn8, shp, tid);
#pragma unroll 1
      for (;;) {
        __syncthreads();
        if (tid == 0) { lw[0] = nxt; lw[4] = 0; }
        __syncthreads();
        const int nitem = lw[0];
        if (tid == 0) nxt = (int)atomicAdd(ctr + 64 * xs, 1u);
        expA_item(SA, item, nitem, xs, pack, hn8, shp, u8, su, co, lds, tid);
        if (nitem >= T / 64) break;
        item = nitem;
      }
    } else {
      int nxt = 0;
      if (tid == 0) nxt = (int)atomicAdd(ctr + 64 * xs, 1u);
#pragma unroll 1
      for (;;) {
        __syncthreads();
        if (tid == 0) lw[0] = nxt;
        __syncthreads();
        const int item = lw[0];
        if (item >= T / 64) break;
        if (tid == 0) nxt = (int)atomicAdd(ctr + 64 * xs, 1u);
        expB_item(item, xs, pack, co, v8, (bf16_t*)out, ssq, lds, tid, xin, ob);
      }
    }
  }
}
__device__ __forceinline__ void experts_norm(const float* __restrict__ ssq, const float* __restrict__ gfin, const bf16_t* __restrict__ zb, float* __restrict__ out) {
  const int tid = threadIdx.x, lane = tid & 63, wv = tid >> 6;
  const int gw = blockIdx.x * NWV + wv, nw = gridDim.x * NWV;
  for (int t = gw; t < T; t += nw) {
    float ss = 0.f;
#pragma unroll
    for (int x = 0; x < 8; ++x) ss += ssq[(size_t)x * T + t];
    const float inv = rsqrtf(ss * (1.0f / 1024.0f) + 1e-6f);
    float* op = out + (size_t)t * 1024 + lane * 16; const float* gp = gfin + lane * 16;
    const u32x4 z0 = *(const u32x4*)(zb + (size_t)t * 1024 + lane * 16), z1 = *(const u32x4*)(zb + (size_t)t * 1024 + lane * 16 + 8);
    const unsigned zz[8] = {z0.x, z0.y, z0.z, z0.w, z1.x, z1.y, z1.z, z1.w};
#pragma unroll
    for (int i = 0; i < 4; ++i) { const f32x4_t z = {__uint_as_float(zz[2 * i] << 16), __uint_as_float(zz[2 * i] & 0xffff0000u), __uint_as_float(zz[2 * i + 1] << 16), __uint_as_float(zz[2 * i + 1] & 0xffff0000u)};
      const f32x4_t g = *(const f32x4_t*)(gp + 4 * i); *(f32x4_t*)(op + 4 * i) = z * inv * g; }
  }
}
#undef LAS3
}

namespace prep {
typedef unsigned u32x2_t __attribute__((ext_vector_type(2)));
typedef float f32x4_t __attribute__((ext_vector_type(4)));
typedef unsigned u32x4 __attribute__((ext_vector_type(4)));
using bf16x8 = __attribute__((ext_vector_type(8))) short;
using f32x16 = __attribute__((ext_vector_type(16))) float;
__device__ __forceinline__ unsigned pk2(float lo, float hi) { return (unsigned)f2bf(lo) | ((unsigned)f2bf(hi) << 16); }
__device__ __forceinline__ void latent_rows(const bf16_t* __restrict__ proj, const float* __restrict__ gq, const float* __restrict__ gkv, const float2* __restrict__ cs,
                                            bf16_t* __restrict__ cqn, bf16_t* __restrict__ ckvn, bf16_t* __restrict__ krope, int wave_id, int nwaves, int lane) {
  const f32x4_t g4 = *(const f32x4_t*)(gq + lane * 4);
  const float2 g2 = *(const float2*)(gkv + lane * 2);
  for (int r = wave_id; r < T; r += nwaves) {
    const bf16_t* row = proj + (size_t)r * PROJ_LD;
    const u32x2_t q = *(const u32x2_t*)(row + PC_CQ + lane * 4);
    const unsigned kv = *(const unsigned*)(row + PC_CKV + lane * 2);
    const unsigned short kr0 = row[PC_KR + (lane & 15)], kr1 = row[PC_KR + 16 + (lane & 15)];
    const float q0 = __uint_as_float(q.x << 16), q1 = __uint_as_float(q.x & 0xffff0000u), q2 = __uint_as_float(q.y << 16), q3 = __uint_as_float(q.y & 0xffff0000u);
    const float k0 = __uint_as_float(kv << 16), k1 = __uint_as_float(kv & 0xffff0000u);
    float sq = (q0 * q0 + q1 * q1) + (q2 * q2 + q3 * q3), sk = k0 * k0 + k1 * k1;
    sq = wsum(sq); sk = wsum(sk);
    const float iq = rsqrtf(sq * (1.0f / 256.0f) + 1e-6f), ik = rsqrtf(sk * (1.0f / 128.0f) + 1e-6f);
    u32x2_t oq; oq.x = pk2(q0 * iq * g4[0], q1 * iq * g4[1]); oq.y = pk2(q2 * iq * g4[2], q3 * iq * g4[3]);
    *(u32x2_t*)(cqn + (size_t)r * 256 + lane * 4) = oq;
    *(unsigned*)(ckvn + (size_t)r * 128 + lane * 2) = pk2(k0 * ik * g2.x, k1 * ik * g2.y);
    if (lane < 16) {
      const float2 c = cs[(r & (SEQ - 1)) * 16 + lane];
      const float x1 = bf2f(kr0), x2 = bf2f(kr1);
      krope[(size_t)r * 32 + lane] = f2bf(x1 * c.x - x2 * c.y); krope[(size_t)r * 32 + 16 + lane] = f2bf(x2 * c.x + x1 * c.y);
    }
  }
}
__device__ __forceinline__ void cmp_bias(const float* __restrict__ posk, const float* __restrict__ posv, const bf16_t* __restrict__ w1k, const bf16_t* __restrict__ w1v, float* __restrict__ cpos, int wave_id, int nwaves, int lane) {
  for (int o = wave_id; o < 512; o += nwaves) {
    const int tab = o >> 8, n = o & 255;
    const float* pos = tab ? posv : posk; const bf16_t* w = (tab ? w1v : w1k) + (size_t)n * 2048;
    float acc = 0.f;
#pragma unroll
    for (int i = 0; i < 4; ++i) { const int k = (i * 64 + lane) * 8;
      const u32x4 wv = *(const u32x4*)(w + k); const f32x4_t p0 = *(const f32x4_t*)(pos + k), p1 = *(const f32x4_t*)(pos + k + 4);
      acc += p0[0] * __uint_as_float(wv.x << 16) + p0[1] * __uint_as_float(wv.x & 0xffff0000u) + p0[2] * __uint_as_float(wv.y << 16) + p0[3] * __uint_as_float(wv.y & 0xffff0000u);
      acc += p1[0] * __uint_as_float(wv.z << 16) + p1[1] * __uint_as_float(wv.z & 0xffff0000u) + p1[2] * __uint_as_float(wv.w << 16) + p1[3] * __uint_as_float(wv.w & 0xffff0000u); }
    acc = wsum(acc);
    if (lane == 0) cpos[o] = acc;
  }
}
__device__ __forceinline__ void cmp_l2(const float* __restrict__ slab, const float* __restrict__ cpos, const bf16_t* __restrict__ w2t, bf16_t* __restrict__ outkc, int item, int lane) {
  const int r32 = lane & 31, hi = lane >> 5, m0 = item * 32;
  f32x16 acc0 = f32x16{}, acc1 = f32x16{};
  f32x4_t sa[2][8]; f32x4_t cp[2][2]; bf16x8 wb[2][2];
#define CMPL2_LOAD(buf, ks_) do { const int k_ = (ks_) * 16 + hi * 8; \
    cp[buf][0] = *(const f32x4_t*)(cpos + k_); cp[buf][1] = *(const f32x4_t*)(cpos + k_ + 4); \
    _Pragma("unroll") for (int sp = 0; sp < 4; ++sp) { const float* p_ = slab + ((size_t)sp * 2048 + m0 + r32) * 256 + k_; sa[buf][2 * sp] = *(const f32x4_t*)p_; sa[buf][2 * sp + 1] = *(const f32x4_t*)(p_ + 4); } \
    wb[buf][0] = *(const bf16x8*)(w2t + (size_t)r32 * 256 + k_); wb[buf][1] = *(const bf16x8*)(w2t + (size_t)(32 + r32) * 256 + k_); } while (0)
#define CMPL2_MMA(buf) do { f32x4_t a0 = cp[buf][0], a1 = cp[buf][1]; \
    _Pragma("unroll") for (int sp = 0; sp < 4; ++sp) { a0 += sa[buf][2 * sp]; a1 += sa[buf][2 * sp + 1]; } \
    u32x4 aw; aw.x = pk2(peer::gelu_fast(a0[0]), peer::gelu_fast(a0[1])); aw.y = pk2(peer::gelu_fast(a0[2]), peer::gelu_fast(a0[3])); \
    aw.z = pk2(peer::gelu_fast(a1[0]), peer::gelu_fast(a1[1])); aw.w = pk2(peer::gelu_fast(a1[2]), peer::gelu_fast(a1[3])); \
    const bf16x8 af = __builtin_bit_cast(bf16x8, aw); \
    acc0 = __builtin_amdgcn_mfma_f32_32x32x16_bf16(af, wb[buf][0], acc0, 0, 0, 0); acc1 = __builtin_amdgcn_mfma_f32_32x32x16_bf16(af, wb[buf][1], acc1, 0, 0, 0); } while (0)
  CMPL2_LOAD(0, 0);
#pragma unroll 1
  for (int ks = 0; ks < 16; ks += 2) {
    CMPL2_LOAD(1, ks + 1);
    CMPL2_MMA(0);
    if (ks + 2 < 16) CMPL2_LOAD(0, ks + 2);
    CMPL2_MMA(1);
  }
#undef CMPL2_LOAD
#undef CMPL2_MMA
#pragma unroll
  for (int r = 0; r < 16; ++r) {
    const int m = m0 + (r & 3) + 8 * (r >> 2) + 4 * hi;
    const bool pad = (m & 127) == 127;
    outkc[(size_t)m * 64 + r32] = pad ? (bf16_t)0 : f2bf(acc0[r]);
    outkc[(size_t)m * 64 + 32 + r32] = pad ? (bf16_t)0 : f2bf(acc1[r]);
  }
}
__device__ __forceinline__ void cmp_l2_w4(const float* __restrict__ slab, const float* __restrict__ cpos, const bf16_t* __restrict__ w2t, bf16_t* __restrict__ outkc, int item, int q, int lane,
                                          __attribute__((address_space(3))) float* red) {
  const int r32 = lane & 31, hi = lane >> 5, m0 = item * 32;
  f32x16 acc0 = f32x16{}, acc1 = f32x16{};
  f32x4_t sa[2][8]; f32x4_t cp[2][2]; bf16x8 wb[2][2];
#define CMPL2_LOAD(buf, ks_) do { const int k_ = (ks_) * 16 + hi * 8; \
    cp[buf][0] = *(const f32x4_t*)(cpos + k_); cp[buf][1] = *(const f32x4_t*)(cpos + k_ + 4); \
    _Pragma("unroll") for (int sp = 0; sp < 4; ++sp) { const float* p_ = slab + ((size_t)sp * 2048 + m0 + r32) * 256 + k_; sa[buf][2 * sp] = *(const f32x4_t*)p_; sa[buf][2 * sp + 1] = *(const f32x4_t*)(p_ + 4); } \
    wb[buf][0] = *(const bf16x8*)(w2t + (size_t)r32 * 256 + k_); wb[buf][1] = *(const bf16x8*)(w2t + (size_t)(32 + r32) * 256 + k_); } while (0)
#define CMPL2_MMA(buf) do { f32x4_t a0 = cp[buf][0], a1 = cp[buf][1]; \
    _Pragma("unroll") for (int sp = 0; sp < 4; ++sp) { a0 += sa[buf][2 * sp]; a1 += sa[buf][2 * sp + 1]; } \
    u32x4 aw; aw.x = pk2(peer::gelu_fast(a0[0]), peer::gelu_fast(a0[1])); aw.y = pk2(peer::gelu_fast(a0[2]), peer::gelu_fast(a0[3])); \
    aw.z = pk2(peer::gelu_fast(a1[0]), peer::gelu_fast(a1[1])); aw.w = pk2(peer::gelu_fast(a1[2]), peer::gelu_fast(a1[3])); \
    const bf16x8 af = __builtin_bit_cast(bf16x8, aw); \
    acc0 = __builtin_amdgcn_mfma_f32_32x32x16_bf16(af, wb[buf][0], acc0, 0, 0, 0); acc1 = __builtin_amdgcn_mfma_f32_32x32x16_bf16(af, wb[buf][1], acc1, 0, 0, 0); } while (0)
  const int k0 = q * 4;
  CMPL2_LOAD(0, k0); CMPL2_LOAD(1, k0 + 1);
  CMPL2_MMA(0); CMPL2_LOAD(0, k0 + 2);
  CMPL2_MMA(1); CMPL2_LOAD(1, k0 + 3);
  CMPL2_MMA(0); CMPL2_MMA(1);
#undef CMPL2_LOAD
#undef CMPL2_MMA
#pragma unroll
  for (int r = 0; r < 16; ++r) { red[(q * 32 + r) * 64 + lane] = acc0[r]; red[(q * 32 + 16 + r) * 64 + lane] = acc1[r]; }
  __syncthreads();
#pragma unroll
  for (int rr = 0; rr < 4; ++rr) {
    const int r = q * 4 + rr;
    float s0 = 0.f, s1 = 0.f;
#pragma unroll
    for (int p = 0; p < 4; ++p) { s0 += red[(p * 32 + r) * 64 + lane]; s1 += red[(p * 32 + 16 + r) * 64 + lane]; }
    const int m = m0 + rr + 8 * q + 4 * hi;
    const bool pad = (m & 127) == 127;
    outkc[(size_t)m * 64 + r32] = pad ? (bf16_t)0 : f2bf(s0);
    outkc[(size_t)m * 64 + 32 + r32] = pad ? (bf16_t)0 : f2bf(s1);
  }
}
}

#define XB_TMO      128
#define XB_XCNT(j)  (256  + 64 * (j))
#define XB_XSUB(j)  (1280 + 64 * (j))
#define XB_XGEN(j)  (2304 + 64 * (j))
#define XB_TOP      3328
#define XB_TOPGEN   3392
#define XCD_BAR_WORDS 3456
#define XB_SPIN_CAP (1u << 18)
#ifndef LAS
#define LAS __attribute__((address_space(3)))
#endif

__device__ __forceinline__ unsigned xb_ld(unsigned* p)              { return __hip_atomic_load(p, __ATOMIC_RELAXED, __HIP_MEMORY_SCOPE_AGENT); }
__device__ __forceinline__ unsigned xb_add(unsigned* p, unsigned v) { return __hip_atomic_fetch_add(p, v, __ATOMIC_RELAXED, __HIP_MEMORY_SCOPE_AGENT); }
__device__ __forceinline__ unsigned xb_xcc_id() { return (unsigned)__builtin_amdgcn_s_getreg((3 << 11) | 20) & 0xFu; }
#define XB_SPIN(cond, bar) do { unsigned _sp = 0; while (cond) { __builtin_amdgcn_s_sleep(1); \
    if ((++_sp & 255u) == 0u) { if (xb_ld(&(bar)[XB_TMO])) break; if (_sp > XB_SPIN_CAP) { atomicAdd(&(bar)[XB_TMO], 1u); break; } } } } while (0)

struct XcdBarrier {
    unsigned* bar; unsigned x;
    volatile LAS unsigned* st;
};

__device__ __forceinline__ XcdBarrier xcd_barrier_post(unsigned* bar, volatile LAS unsigned* st) {
    XcdBarrier b; b.bar = bar; b.x = xb_xcc_id(); b.st = st;
    if (threadIdx.x == 0) (void)xb_add(&bar[XB_XCNT(b.x)], 1u);
    return b;
}
__device__ __forceinline__ void xcd_barrier_complete(unsigned* bar, unsigned x, unsigned& nloc, unsigned& nx) {
    const unsigned G = gridDim.x * gridDim.y * gridDim.z;
    unsigned sum, cnt, mine, sp = 0u;
    for (;;) {
        sum = 0u; cnt = 0u; mine = 0u;
#pragma unroll
        for (unsigned j = 0; j < 16; ++j) { const unsigned c = xb_ld(&bar[XB_XCNT(j)]); sum += c; cnt += (c > 0u) ? 1u : 0u; mine = (j == x) ? c : mine; }
        if (sum == G) break;
        __builtin_amdgcn_s_sleep(1);
        if ((++sp & 255u) == 0u) { if (xb_ld(&bar[XB_TMO])) break; if (sp > XB_SPIN_CAP) { atomicAdd(&bar[XB_TMO], 1u); break; } }
    }
    nloc = mine > 0u ? mine : 1u; nx = cnt > 0u ? cnt : 1u;
}

__device__ __forceinline__ void xcd_barrier(const XcdBarrier& b) {
    asm volatile("s_waitcnt vmcnt(0)" ::: "memory");
    __syncthreads();
    if (threadIdx.x == 0) {
        unsigned* bar = b.bar;
        __builtin_amdgcn_s_waitcnt(0);
        unsigned nloc = b.st[0], nx = b.st[1];
        if (nloc == 0u) { xcd_barrier_complete(bar, b.x, nloc, nx); b.st[0] = nloc; b.st[1] = nx; }
        const unsigned old = xb_add(&bar[XB_XSUB(b.x)], 1u);
        const unsigned gen = old / nloc;
        if (old + 1u == (gen + 1u) * nloc) {
            __builtin_amdgcn_fence(__ATOMIC_RELEASE, "agent");
            asm volatile("s_waitcnt vmcnt(0)" ::: "memory");
            const unsigned og = xb_add(&bar[XB_TOP], 1u);
            const unsigned tg = og / nx;
            if (og + 1u == (tg + 1u) * nx) xb_add(&bar[XB_TOPGEN], 1u);
            else XB_SPIN(xb_ld(&bar[XB_TOPGEN]) == tg, bar);
            __builtin_amdgcn_fence(__ATOMIC_ACQUIRE, "agent");
            xb_add(&bar[XB_XGEN(b.x)], 1u);
            asm volatile("s_waitcnt vmcnt(0)" ::: "memory");
        } else {
            XB_SPIN(xb_ld(&bar[XB_XGEN(b.x)]) == gen, bar);
            __builtin_amdgcn_fence(__ATOMIC_ACQUIRE, "agent");
            asm volatile("s_waitcnt vmcnt(0)" ::: "memory");
        }
    }
    __syncthreads();
}

struct Args { const float* in[23]; float* out; char* ws; };
constexpr int LDS_BYTES = 131072 + 4096;

typedef const __attribute__((address_space(4))) Args* kargs_t;
DEV kargs_t KA() { kargs_t k = (kargs_t)__builtin_amdgcn_kernarg_segment_ptr(); asm volatile("" : "+s"(k)); return k; }
#define WSP(type, off) ((type*)(ws + (off)))

__global__ __launch_bounds__(NTHR, 2) void mega(Args a) {
  extern __shared__ __attribute__((aligned(16))) char lds[];
  PG8_LAS unsigned char* glds = (PG8_LAS unsigned char*)lds;
  const int bid = blockIdx.x, G = gridDim.x;
  (void)a;
  volatile LAS unsigned* bst = (volatile LAS unsigned*)((LAS char*)lds + LDS_BYTES - 16);
  if (threadIdx.x < 4) bst[threadIdx.x] = 0u;
  __syncthreads();
  XcdBarrier xbar; { kargs_t k = KA(); xbar = xcd_barrier_post((unsigned*)k->ws, bst); }

  { kargs_t k = KA(); char* ws = k->ws;
    const int wv0_ = threadIdx.x >> 6;
    if (wv0_ < 4) { const int lane_ = threadIdx.x & 63, wv_ = wv0_, gw_ = bid * 4 + wv_, nw_ = G * 4;
      __attribute__((address_space(3))) float* scr = (__attribute__((address_space(3))) float*)((__attribute__((address_space(3))) char*)lds + wv_ * 8448);
      constexpr int I_IN = 16 * 120, I_C1 = 32 * 8;
      for (int it = gw_; it < I_IN + 2 * I_C1; it += nw_) {
        int r = it;
        if (r < I_IN) { tr_item<1>(k->in[2], 1024, IN_COLS, WSP(bf16_t, WS_WIN), 120, 3840, scr, r, lane_); continue; } r -= I_IN;
        if (r < I_C1) { tr_item<0>(k->in[5], 2048, 256, WSP(bf16_t, WS_CKW1), 8, 256, scr, r, lane_); continue; } r -= I_C1;
        tr_item<0>(k->in[7], 2048, 256, WSP(bf16_t, WS_CVW1), 8, 256, scr, r, lane_);
      }
      for (int i = gw_ * 64 + lane_; i < 16 * 128 * 64; i += nw_ * 64) WSP(bf16_t, WS_SUBK)[i] = f2bf(k->in[18][i]);
      for (int i = gw_ * 64 + lane_; i < SEQ * 16; i += nw_ * 64) rope_entry(WSP(float2, WS_ROPE), i);
    } else ph_rms1024<false>(k->in[0], k->in[1], WSP(bf16_t, WS_XN), T, nullptr, nullptr, bid * 4 + (wv0_ - 4), G * 4); }
  xcd_barrier(xbar);
  { kargs_t k = KA(); char* ws = k->ws;
    pg8::Gemm g{WSP(bf16_t, WS_XN), WSP(bf16_t, WS_WIN), T, 3840, 1024}; pg8::StaticOrder S; S.init(T, 3840, G, bid);
    pg8::EpiInProjF E{WSP(bf16_t, WS_PROJ), WSP(unsigned char, WS_GATES)};
    pg8::gemm_phase<pg8::EpiInProjF, pg8::StaticOrder, PG8_ALIGN, PG8_SP2>(glds, g, S, E);
    {
      const bool some = (G == 256); const int nb = some ? 64 : G, b0 = some ? bid - 192 : bid;
      if (b0 >= 0) {
        const int lane_ = threadIdx.x & 63, wv_ = threadIdx.x >> 6;
        __attribute__((address_space(3))) float* scr = (__attribute__((address_space(3))) float*)((__attribute__((address_space(3))) char*)lds + wv_ * 8448);
        constexpr int I_BR = 8 * 32, I_SQ = 16 * 32, I_C2 = 4 * 8, I_UQ = 4 * 24, I_UKV = 2 * 32;
        for (int it = b0 * NWV + wv_; it < 2 * I_BR + 2 * I_SQ + 2 * I_C2 + I_UQ + I_UKV; it += nb * NWV) {
          int r = it;
          if (r < I_UQ) { tr_item<0>(k->in[11], 256, 768, WSP(bf16_t, WS_UQ), 24, 768, scr, r, lane_); continue; } r -= I_UQ;
          if (r < I_UKV) { tr_item<0>(k->in[12], 128, 1024, WSP(bf16_t, WS_UKV), 32, 1024, scr, r, lane_); continue; } r -= I_UKV;
          if (r < I_C2) { tr_item<0>(k->in[6], 256, 64, WSP(bf16_t, WS_CKW2), 8, 64, scr, r, lane_); continue; } r -= I_C2;
          if (r < I_C2) { tr_item<0>(k->in[8], 256, 64, WSP(bf16_t, WS_CVW2), 8, 64, scr, r, lane_); continue; } r -= I_C2;
          if (r < I_BR) { tr_item<0>(k->in[13], 512, 1024, WSP(bf16_t, WS_WBN), 32, 1024, scr, r, lane_, 1024, 0); continue; } r -= I_BR;
          if (r < I_BR) { tr_item<0>(k->in[14], 512, 1024, WSP(bf16_t, WS_WBN), 32, 1024, scr, r, lane_, 1024, 512); continue; } r -= I_BR;
          if (r < I_SQ) { tr_item<0>(k->in[15], 1024, 1024, WSP(bf16_t, WS_WOUT), 32, 1024, scr, r, lane_); continue; } r -= I_SQ;
          tr_item<0>(k->in[17], 1024, 1024, WSP(bf16_t, WS_WQ), 32, 1024, scr, r, lane_);
        } } } }
  xcd_barrier(xbar);
  { kargs_t k = KA(); char* ws = k->ws;
    const int lane_ = threadIdx.x & 63, wv_ = threadIdx.x >> 6;
    if (G >= 128 && bid < 64) {
      const int tab = bid >> 5;
      pg8::Gemm g{WSP(bf16_t, WS_PROJ) + PC_KV + tab * 128, WSP(bf16_t, tab ? WS_CVW1 : WS_CKW1), 2048, 1024, 512};
      g.pitchA = 16u * PROJ_LD * 2u; g.kstepA = PROJ_LD * 2u; g.hstepA = 128; g.tA_pm = (size_t)SEQ * PROJ_LD * 2; g.tA_pn = (size_t)8 * PROJ_LD * 2;
      g.pitchB = 4096u; g.kstepB = 128u; g.hstepB = (size_t)128 * 4096; g.tB_pn = 1024; g.nt = 8;
      pg8::StaticOrder S; S.init(2048, 1024, 32, bid & 31);
      pg8::EpiSlabF E{WSP(float, WS_SLAB) + (size_t)tab * 4 * 2048 * 256};
      pg8::gemm_phase<pg8::EpiSlabF, pg8::StaticOrder, PG8_ALIGN, PG8_SP2>(glds, g, S, E);
    } else {
      const int nb = (G >= 128) ? G - 64 : G, b0 = (G >= 128) ? bid - 64 : bid;
      prep::cmp_bias(k->in[3], k->in[4], WSP(bf16_t, WS_CKW1), WSP(bf16_t, WS_CVW1), WSP(float, WS_CPOS), b0 * NWV + wv_, nb * NWV, lane_);
      prep::latent_rows(WSP(bf16_t, WS_PROJ), k->in[9], k->in[10], WSP(float2, WS_ROPE), WSP(bf16_t, WS_CQN), WSP(bf16_t, WS_CKVN), WSP(bf16_t, WS_KROPE), b0 * NWV + wv_, nb * NWV, lane_);
    } }
  xcd_barrier(xbar);
  if (G == 256 && ((bid + 64) & 255) >= 192) {
    kargs_t k = KA(); char* ws = k->ws;
    const int lane_ = threadIdx.x & 63, wv_ = threadIdx.x >> 6;
    { const int it = (((bid + 64) & 255) - 192) * 2 + (wv_ >> 2); const int tab = it >> 6;
      prep::cmp_l2_w4(WSP(float, WS_SLAB) + (size_t)tab * 4 * 2048 * 256, WSP(float, WS_CPOS) + tab * 256, WSP(bf16_t, tab ? WS_CVW2 : WS_CKW2), WSP(bf16_t, tab ? WS_VC : WS_KC), it & 63, wv_ & 3, lane_,
                      (__attribute__((address_space(3))) float*)lds + (wv_ >> 2) * 8192); }
    __syncthreads();
  } else if (G != 256) {
    kargs_t k = KA(); char* ws = k->ws;
    const int lane_ = threadIdx.x & 63, wv_ = threadIdx.x >> 6;
    for (int it = bid * NWV + wv_; it < 128; it += G * NWV) { const int tab = it >> 6;
      prep::cmp_l2(WSP(float, WS_SLAB) + (size_t)tab * 4 * 2048 * 256, WSP(float, WS_CPOS) + tab * 256, WSP(bf16_t, tab ? WS_CVW2 : WS_CKW2), WSP(bf16_t, tab ? WS_VC : WS_KC), it & 63, lane_); }
  }
  { kargs_t k = KA(); char* ws = k->ws;
    pg8::Gemm g{WSP(bf16_t, WS_CQN), WSP(bf16_t, WS_UQ), T, 768, 256}; pg8::StaticOrder S; S.init(T, 768, G, (bid + 64) & 255);
    pg8::EpiMlaQF E{WSP(bf16_t, WS_MLAQ), WSP(float2, WS_ROPE)};
    pg8::gemm_phase<pg8::EpiMlaQF, pg8::StaticOrder, PG8_ALIGN, PG8_SP2>(glds, g, S, E); }
  { kargs_t k = KA(); char* ws = k->ws;
    pg8::Gemm g{WSP(bf16_t, WS_CKVN), WSP(bf16_t, WS_UKV), T, 1024, 128}; pg8::StaticOrder S; S.init(T, 1024, G, bid);
    pg8::EpiBf16<0> E{WSP(bf16_t, WS_MLAKV), 1024, nullptr, 0, 0, 1.f};
    pg8::gemm_phase<pg8::EpiBf16<0>, pg8::StaticOrder, PG8_ALIGN, PG8_SP2>(glds, g, S, E); }
  xcd_barrier(xbar);
  { kargs_t k = KA(); char* ws = k->ws;
    att::attn_phase(WSP(bf16_t, WS_PROJ), WSP(bf16_t, WS_KC), WSP(bf16_t, WS_VC), k->in[21], WSP(bf16_t, WS_ONSA),
                    WSP(bf16_t, WS_MLAQ), WSP(bf16_t, WS_MLAKV), WSP(bf16_t, WS_KROPE), WSP(bf16_t, WS_ONSA), (att::lptr)lds); }
  xcd_barrier(xbar);
  { kargs_t k = KA(); char* ws = k->ws;
    pg8::Gemm g{WSP(bf16_t, WS_ONSA), WSP(bf16_t, WS_WBN), T, 1024, 1024}; pg8::StaticOrder S; S.init(T, 1024, G, bid);
    pg8::EpiMergeFusedF E{WSP(unsigned char, WS_GATES), WSP(bf16_t, WS_MERGED)};
    pg8::gemm_phase<pg8::EpiMergeFusedF, pg8::StaticOrder, PG8_ALIGN, PG8_SP2>(glds, g, S, E); }
  xcd_barrier(xbar);
  { kargs_t k = KA(); char* ws = k->ws;
    pg8::Gemm g{WSP(bf16_t, WS_MERGED), WSP(bf16_t, WS_WOUT), T, 1024, 1024}; pg8::StaticOrder S; S.init(T, 1024, G, bid);
    pg8::EpiBf16<0> E{WSP(bf16_t, WS_OB), 1024, nullptr, 0, 0, 1.f};
    pg8::gemm_phase<pg8::EpiBf16<0>, pg8::StaticOrder, PG8_ALIGN, PG8_SP2>(glds, g, S, E); }
  xcd_barrier(xbar);
  { kargs_t k = KA(); char* ws = k->ws; ph_rms1024<true>(k->in[0], k->in[16], WSP(bf16_t, WS_HN), T, WSP(unsigned, WS_HN8), WSP(float, WS_SH), -1, 0, WSP(bf16_t, WS_OB));
    peer::conv_tables(k->in[19], k->in[20], WSP(unsigned, WS_U8), WSP(float, WS_SU), WSP(unsigned, WS_V8)); }
  xcd_barrier(xbar);
  { kargs_t k = KA(); char* ws = k->ws;
    pg8::Gemm g{WSP(bf16_t, WS_HN), WSP(bf16_t, WS_WQ), T, 1024, 1024}; pg8::StaticOrder S; S.init(T, 1024, G, bid);
    pg8::EpiBf16<0> E{WSP(bf16_t, WS_PQ), 1024, nullptr, 0, 0, 1.f};
    pg8::gemm_phase<pg8::EpiBf16<0>, pg8::StaticOrder, PG8_ALIGN, PG8_SP2>(glds, g, S, E); }
  __builtin_amdgcn_fence(__ATOMIC_RELEASE, "workgroup"); __syncthreads(); __builtin_amdgcn_fence(__ATOMIC_ACQUIRE, "workgroup");
  { kargs_t k = KA(); char* ws = k->ws; pg8::StaticOrder S; S.init(T, 1024, G, bid); pg8::Unit u;
    if (S.next(0, u)) peer::route_phase(WSP(bf16_t, WS_PQ), WSP(bf16_t, WS_SUBK), WSP(unsigned, WS_PIDX), (__attribute__((address_space(3))) char*)lds, u.pm, u.pn); }
  xcd_barrier(xbar);
  { kargs_t k = KA(); char* ws = k->ws;
    peer::experts_sliced<0>(WSP(unsigned, WS_PIDX), WSP(unsigned, WS_HN8), WSP(float, WS_SH), WSP(unsigned, WS_U8), WSP(float, WS_SU), WSP(float, WS_CO), WSP(unsigned, WS_V8), k->out, WSP(float, WS_SSQ),
                            (unsigned*)ws + CTL_QA, (__attribute__((address_space(3))) char*)lds); }
  xcd_barrier(xbar);
  { kargs_t k = KA(); char* ws = k->ws;
    peer::experts_sliced<1>(WSP(unsigned, WS_PIDX), WSP(unsigned, WS_HN8), WSP(float, WS_SH), WSP(unsigned, WS_U8), WSP(float, WS_SU), WSP(float, WS_CO), WSP(unsigned, WS_V8), (float*)WSP(bf16_t, WS_ZB), WSP(float, WS_SSQ),
                            (unsigned*)ws + CTL_QB, (__attribute__((address_space(3))) char*)lds, k->in[0], WSP(bf16_t, WS_OB)); }
  xcd_barrier(xbar);
  { kargs_t k = KA(); char* ws = k->ws; peer::experts_norm(WSP(float, WS_SSQ), k->in[22], WSP(bf16_t, WS_ZB), k->out); }
}

extern "C" void kernel_launch(void* const* d_in, const int* in_sizes, int n_in, void* d_out, int out_size, void* d_ws, size_t ws_size, hipStream_t stream) {
  if (n_in != 23 || ws_size < 256 * MiB) { fprintf(stderr, "kernel_launch: unexpected n_in %d / ws_size %zu\n", n_in, ws_size); return; }
  static int grid_blocks = 0;
  if (!grid_blocks) {
    int dev = 0, cus = 0, per_cu = 0;
    (void)hipGetDevice(&dev);
    (void)hipDeviceGetAttribute(&cus, hipDeviceAttributeMultiprocessorCount, dev);
    if (hipFuncSetAttribute((const void*)mega, hipFuncAttributeMaxDynamicSharedMemorySize, LDS_BYTES) != hipSuccess) fprintf(stderr, "kernel_launch: hipFuncSetAttribute failed\n");
    (void)hipOccupancyMaxActiveBlocksPerMultiprocessor(&per_cu, (const void*)mega, NTHR, LDS_BYTES);
    if (per_cu < 1) { fprintf(stderr, "kernel_launch: occupancy query returned %d\n", per_cu); per_cu = 1; }
    if (per_cu > 2) per_cu = 2;
    grid_blocks = cus * per_cu;
    fprintf(stderr, "kernel_launch: cus %d per_cu %d grid %d ws %zu\n", cus, per_cu, grid_blocks, ws_size);
  }
  if (hipMemsetAsync(d_ws, 0, 65536, stream) != hipSuccess) fprintf(stderr, "kernel_launch: hipMemsetAsync failed\n");
  Args a{};
  for (int i = 0; i < 23; ++i) a.in[i] = (const float*)d_in[i];
  a.out = (float*)d_out; a.ws = (char*)d_ws;
  void* args[] = {&a};
  hipError_t e = hipLaunchCooperativeKernel((const void*)mega, dim3(grid_blocks), dim3(NTHR), args, LDS_BYTES, stream);
  if (e != hipSuccess) fprintf(stderr, "cooperative launch failed: %s (grid %d)\n", hipGetErrorString(e), grid_blocks);
}
```
